# Optimizing an MI355X kernel written in HIP

```python
import math
import jax, jax.numpy as jnp
from jax import lax
import numpy as np

D_MODEL = 1024
BATCH = 32
SEQ = 256
DEPTH = 2
DEC_BATCH = 4
DEC_SEQ = 1024
PAST_LEN = 512

GRID_W = 64
D_MIX = D_MODEL
D_RWKV = D_MIX // 2
HEAD_A = 64
N_HEADS_A = D_RWKV // HEAD_A
D_FNET = D_MIX // 4
N_FNET_GROUPS = 4
FNET_GW = D_FNET // N_FNET_GROUPS
D_POOL = D_MIX - D_RWKV - D_FNET
POOL_WINDOWS = (2, 4, 8, 16)
POOL_GW = D_POOL // len(POOL_WINDOWS)
DECAY_LORA = 64
AAA_LORA = 64
GATE_LORA = 128
N_DIR = 2
D_FF = 4 * D_MODEL
RMS_EPS = 1e-6
GN_EPS = 64e-5

R_OFF = 0
K_OFF = R_OFF + D_RWKV
V_OFF = K_OFF + D_RWKV
WD_OFF = V_OFF + D_RWKV
AD_OFF = WD_OFF + N_DIR * DECAY_LORA
GD_OFF = AD_OFF + N_DIR * AAA_LORA
SHIFT_END = GD_OFF + GATE_LORA
F_OFF = SHIFT_END
P_OFF = F_OFF + D_FNET
D_IN = P_OFF + D_POOL

kernel_name = "hybrid_rwkv7_fnet_pool_prefix_dit_step"

F32 = jnp.float32


def rms_norm(x, g):
    xf = x.astype(F32)
    y = xf * lax.rsqrt(jnp.mean(xf * xf, axis=-1, keepdims=True) + RMS_EPS)
    return (y * g.astype(F32)).astype(x.dtype)


def centred_shift(p, mu):
    zero = jnp.zeros_like(p[:, :1])
    prev = jnp.concatenate([zero, p[:, :-1]], axis=1)
    nxt = jnp.concatenate([p[:, 1:], zero], axis=1)
    return p + mu * (0.5 * (prev + nxt) - p)


def window_mean(x, w, axis):
    n = x.shape[axis]
    cs = jnp.cumsum(x.astype(F32), axis=axis)
    pad = [(0, 0)] * x.ndim
    pad[axis] = (1, 0)
    cs = jnp.pad(cs, pad)
    t = jnp.arange(n)
    lo = jnp.clip(t - w // 2, 0, n)
    hi = jnp.clip(t + w - w // 2, 0, n)
    s = jnp.take(cs, hi, axis=axis) - jnp.take(cs, lo, axis=axis)
    shape = [1] * x.ndim
    shape[axis] = n
    return s / (hi - lo).astype(F32).reshape(shape)


def pool_mixer(p, w_pool, pool_scale, grid):
    B, L, _ = p.shape
    pg = p.reshape(B, L, len(POOL_WINDOWS), POOL_GW)
    means = []
    for i, w in enumerate(POOL_WINDOWS):
        xi = pg[:, :, i]
        if grid:
            rows = L // GRID_W
            xi2 = xi.reshape(B, rows, GRID_W, POOL_GW)
            m = window_mean(window_mean(xi2, w, 1), w, 2).reshape(B, L, POOL_GW)
        else:
            m = window_mean(xi, w, 1)
        means.append(m)
    d = (jnp.stack(means, axis=2) - pg.astype(F32)).astype(p.dtype)
    y = jnp.einsum('blgc,gcd->blgd', d, w_pool).reshape(B, L, D_POOL)
    return y * pool_scale


def fourier_mixer(f, w_fnet):
    B, L, _ = f.shape
    fg = f.reshape(B, L, N_FNET_GROUPS, FNET_GW).astype(F32)
    z = jnp.fft.fft2(fg, axes=(1, 3)).real * (1.0 / math.sqrt(L * FNET_GW))
    y = jnp.einsum('blgc,gcd->blgd', z.astype(f.dtype), w_fnet)
    return y.reshape(B, L, D_FNET)


def wkv_step(S, inp):
    r, w, k, v, a, b = inp
    sa = jnp.einsum('dbhvk,dbhk->dbhv', S, a)
    S = S * w[..., None, :] + sa[..., :, None] * b[..., None, :] + v[..., :, None] * k[..., None, :]
    y = jnp.einsum('dbhvk,dbhk->dbhv', S, r)
    return S, y


def rwkv_mixer(u, s0, w0, w_up, a0, a_up, g_up, k_k, k_a, r_k, ln_w, ln_b):
    B, L, _ = u.shape
    H, N = N_HEADS_A, HEAD_A
    uf = u.astype(F32)
    r = uf[..., R_OFF:R_OFF + D_RWKV]
    k = uf[..., K_OFF:K_OFF + D_RWKV]
    v = uf[..., V_OFF:V_OFF + D_RWKV]
    wd = uf[..., WD_OFF:WD_OFF + N_DIR * DECAY_LORA].reshape(B, L, N_DIR, DECAY_LORA)
    ad = uf[..., AD_OFF:AD_OFF + N_DIR * AAA_LORA].reshape(B, L, N_DIR, AAA_LORA)
    gd = uf[..., GD_OFF:GD_OFF + GATE_LORA]
    w_log = -jax.nn.softplus(-(w0.astype(F32) + jnp.einsum('bldr,drc->bldc', jnp.tanh(wd), w_up.astype(F32)))) - 0.5
    decay = jnp.exp(-jnp.exp(w_log))
    a = jax.nn.sigmoid(a0.astype(F32) + jnp.einsum('bldr,drc->bldc', ad, a_up.astype(F32)))
    g = jnp.einsum('blr,rc->blc', jax.nn.sigmoid(gd), g_up.astype(F32))
    kk = (k * k_k.astype(F32)).reshape(B, L, H, N)
    kk = kk / jnp.maximum(jnp.sqrt(jnp.sum(kk * kk, axis=-1, keepdims=True)), 1e-12)
    kd = k[:, :, None] * (1.0 + (a - 1.0) * k_a.astype(F32))
    a_h = a.reshape(B, L, N_DIR, H, N)
    kd_h = kd.reshape(B, L, N_DIR, H, N)
    dec_h = decay.reshape(B, L, N_DIR, H, N)
    r_h = r.reshape(B, L, H, N)
    v_h = v.reshape(B, L, H, N)
    b_h = kk[:, :, None] * a_h

    def both(z):
        return jnp.broadcast_to(z[:, :, None], (B, L, N_DIR, H, N))

    def time_major(z):
        z = jnp.stack([z[:, :, 0], z[:, ::-1, 1]], axis=0)
        return jnp.transpose(z, (2, 0, 1, 3, 4))

    xs = (time_major(both(r_h)), time_major(dec_h), time_major(kd_h),
          time_major(both(v_h)), time_major(both(-kk)), time_major(b_h))
    s_init = jnp.transpose(s0.astype(F32), (1, 0, 2, 3, 4))
    s_fin, ys = lax.scan(wkv_step, s_init, xs)
    ys = jnp.transpose(ys, (1, 2, 0, 3, 4))
    y = ys[0] + ys[1][:, ::-1]
    mean = jnp.mean(y, axis=-1, keepdims=True)
    var = jnp.mean(jnp.square(y - mean), axis=-1, keepdims=True)
    y = ((y - mean) * lax.rsqrt(var + GN_EPS)).reshape(B, L, D_RWKV)
    y = y * ln_w.astype(F32) + ln_b.astype(F32)
    bonus = jnp.einsum('blhn,bldhn,hn->blh', r_h, kd_h, r_k.astype(F32))[..., None] * v_h
    out = (y + bonus.reshape(B, L, D_RWKV)) * g
    return out.astype(u.dtype), jnp.transpose(s_fin, (1, 0, 2, 3, 4))


def trunk_layer(x, mod, s0, grid, norm1_g, w_in, mu_shift, w0, w_up, a0, a_up, g_up, k_k, k_a, r_k,
                ln_x_w, ln_x_b, w_fnet, w_pool, pool_scale, w_out, norm2_g, w_ff1, w_ff2):
    shift1, scale1, gate1, shift2, scale2, gate2 = jnp.split(mod, 6, axis=-1)
    h = rms_norm(x, norm1_g) * (1 + scale1) + shift1
    proj = jnp.einsum('bld,de->ble', h, w_in)
    u = centred_shift(proj[..., :SHIFT_END], mu_shift)
    y_a, s_fin = rwkv_mixer(u, s0, w0, w_up, a0, a_up, g_up, k_k, k_a, r_k, ln_x_w, ln_x_b)
    y_b = fourier_mixer(proj[..., F_OFF:F_OFF + D_FNET], w_fnet)
    y_c = pool_mixer(proj[..., P_OFF:P_OFF + D_POOL], w_pool, pool_scale, grid)
    mixed = jnp.concatenate([y_a, y_b, y_c], axis=-1)
    x = x + gate1 * jnp.einsum('blc,cd->bld', mixed, w_out)
    h = rms_norm(x, norm2_g) * (1 + scale2) + shift2
    ff = jnp.square(jax.nn.relu(jnp.einsum('bld,df->blf', h, w_ff1)))
    x = x + gate2 * jnp.einsum('blf,fd->bld', ff, w_ff2)
    return x, s_fin


def setup_inputs(seed: int = 0) -> dict:
    key = jax.random.key(seed)
    ks = jax.random.split(key, 32)
    nrm = lambda k, shape, s: jax.random.normal(k, shape, F32) * s
    D = D_MODEL
    return {
        "x_prompt": nrm(ks[0], (BATCH, SEQ, D), 1.0),
        "x_sample": nrm(ks[1], (DEC_BATCH, DEC_SEQ, D), 1.0),
        "state_wkv": nrm(ks[2], (DEC_BATCH, DEPTH, N_DIR, N_HEADS_A, HEAD_A, HEAD_A), 0.5),
        "c": nrm(ks[3], (DEC_BATCH, D), 1.0),
        "c_ctx": nrm(ks[4], (D,), 1.0),
        "w_ada": nrm(ks[5], (DEPTH, D, 6 * D), 0.5 * D ** -0.5),
        "b_ada": nrm(ks[6], (DEPTH, 6 * D), 0.02),
        "norm1_g": 1.0 + nrm(ks[7], (DEPTH, D), 0.05),
        "w_in": nrm(ks[8], (DEPTH, D, D_IN), D ** -0.5),
        "mu_shift": jax.random.uniform(ks[9], (DEPTH, SHIFT_END), F32),
        "w0": jax.random.uniform(ks[10], (DEPTH, N_DIR, D_RWKV), F32, -6.0, -1.0),
        "w_up": nrm(ks[11], (DEPTH, N_DIR, DECAY_LORA, D_RWKV), 0.1 * DECAY_LORA ** -0.5),
        "a0": nrm(ks[12], (DEPTH, N_DIR, D_RWKV), 0.1),
        "a_up": nrm(ks[13], (DEPTH, N_DIR, AAA_LORA, D_RWKV), 0.1 * AAA_LORA ** -0.5),
        "g_up": nrm(ks[14], (DEPTH, GATE_LORA, D_RWKV), GATE_LORA ** -0.5),
        "k_k": 0.85 + nrm(ks[15], (DEPTH, D_RWKV), 0.05),
        "k_a": 1.0 + nrm(ks[16], (DEPTH, D_RWKV), 0.05),
        "r_k": nrm(ks[17], (DEPTH, N_HEADS_A, HEAD_A), 0.1),
        "ln_x_w": 1.0 + nrm(ks[18], (DEPTH, D_RWKV), 0.05),
        "ln_x_b": nrm(ks[19], (DEPTH, D_RWKV), 0.02),
        "w_fnet": nrm(ks[20], (DEPTH, N_FNET_GROUPS, FNET_GW, FNET_GW), FNET_GW ** -0.5),
        "w_pool": nrm(ks[21], (DEPTH, len(POOL_WINDOWS), POOL_GW, POOL_GW), POOL_GW ** -0.5),
        "pool_scale": 1.0 + nrm(ks[22], (DEPTH, D_POOL), 0.05),
        "w_out": nrm(ks[23], (DEPTH, D_MIX, D), D_MIX ** -0.5),
        "norm2_g": 1.0 + nrm(ks[24], (DEPTH, D), 0.05),
        "w_ff1": nrm(ks[25], (DEPTH, D, D_FF), D ** -0.5),
        "w_ff2": nrm(ks[26], (DEPTH, D_FF, D), D_FF ** -0.5),
        "final_norm_g": 1.0 + nrm(ks[27], (D,), 0.05),
    }


def reference(x_prompt, x_sample, state_wkv, c, c_ctx, w_ada, b_ada, norm1_g, w_in, mu_shift, w0, w_up,
              a0, a_up, g_up, k_k, k_a, r_k, ln_x_w, ln_x_b, w_fnet, w_pool, pool_scale, w_out, norm2_g,
              w_ff1, w_ff2, final_norm_g):
    xp = x_prompt
    xs = x_sample
    s_zero = jnp.zeros((xp.shape[0], N_DIR, N_HEADS_A, HEAD_A, HEAD_A), F32)
    new_states = []
    for l in range(DEPTH):
        lw = (norm1_g[l], w_in[l], mu_shift[l], w0[l], w_up[l], a0[l], a_up[l], g_up[l], k_k[l], k_a[l],
              r_k[l], ln_x_w[l], ln_x_b[l], w_fnet[l], w_pool[l], pool_scale[l], w_out[l], norm2_g[l],
              w_ff1[l], w_ff2[l])
        mod_ctx = (jax.nn.silu(c_ctx) @ w_ada[l] + b_ada[l])[None, None, :]
        mod_lat = (jax.nn.silu(c) @ w_ada[l] + b_ada[l])[:, None, :]
        xp, s_ctx = trunk_layer(xp, mod_ctx, s_zero, False, *lw)
        new_states.append(s_ctx)
        xs, _ = trunk_layer(xs, mod_lat, state_wkv[:, l], True, *lw)
    new_state_wkv = jnp.stack(new_states, axis=1).astype(x_prompt.dtype)
    y_prompt = rms_norm(xp, final_norm_g)
    y_sample = rms_norm(xs, final_norm_g)
    return (y_prompt, y_sample, new_state_wkv)
```

```cpp
#include <hip/hip_runtime.h>
#include <hip/hip_cooperative_groups.h>
#include <cstdio>
#include <cstdint>
namespace cg = cooperative_groups;
namespace pg8 {
#define PG8_LAS __attribute__((address_space(3)))
typedef unsigned short bf16_t;
typedef short bf16x8 __attribute__((ext_vector_type(8)));
typedef float f32x4 __attribute__((ext_vector_type(4)));
typedef unsigned u32x4 __attribute__((ext_vector_type(4)));
constexpr int BM = 256, BK = 64, HALF = 128, HTB = HALF * BK * 2  , STAGE_BYTES = 8 * HTB, NXCD = 8, WGM = 8;

__host__ __device__ __forceinline__ int lds_byte(int r, int c) { const int st = (r >> 4) * 2 + (c >> 5), rr = r & 15, cc = c & 31, ob = rr * 64 + cc * 2; return st * 1024 + (ob ^ (((ob >> 9) & 1) << 5)); }
__host__ __device__ __forceinline__ void stage_rc(int b, int& R, int& C) { const int st = b / 1024, sb = b % 1024, swz = sb ^ (((sb >> 9) & 1) << 5); R = (st >> 1) * 16 + swz / 64; C = (st & 1) * 32 + (swz % 64) / 2; }
__host__ __device__ __forceinline__ int perm32(int rho) { const int n = rho >> 4, i = rho & 15; return 8 * (i >> 2) + 4 * n + (i & 3); }

struct Unit { int pm, pn; };
struct Gemm { const bf16_t* A; const bf16_t* Bt; int M, N, K, lda, ldb; };

struct StaticOrder {
    int nM, nN, nwg, G, c;
    __host__ __device__ void init(int M, int N, int G_, int c_) { nM = M / BM; nN = N / BM; nwg = nM * nN; G = G_; c = c_; }
    __host__ __device__ bool next(int i, Unit& u) const {
        const long L = (long)i * G + c; if (L >= nwg) return false;
        int wgid = (int)L; { const int q = nwg / NXCD, r = nwg % NXCD, xcd = wgid % NXCD, off = wgid / NXCD; wgid = (xcd < r ? xcd * (q + 1) : r * (q + 1) + (xcd - r) * q) + off; }
        const int nig = WGM * nN, gid = wgid / nig, fm = gid * WGM, gsz = (nM - fm) < WGM ? (nM - fm) : WGM;
        u.pm = fm + ((wgid % nig) % gsz); u.pn = (wgid % nig) / gsz; return true;
    }
    __device__ __forceinline__ void a_ready(const Unit&) const {}
    __device__ __forceinline__ void done(const Unit&) const {}
};

__device__ __forceinline__ unsigned cvt_pk_bf16(float lo, float hi) { unsigned r; asm volatile("v_cvt_pk_bf16_f32 %0, %1, %2" : "=v"(r) : "v"(lo), "v"(hi)); return r; }
template <int ACT  > struct EpiBf {
    static constexpr bool PERM = true, AFTER_DRAIN = false;
    bf16_t* O; int ldc;
    __device__ __forceinline__ void operator()(const f32x4 (&acc)[2][2][4][2], const Unit& u, int wr, int wc, int fr, int fq) const {
        const int row0 = u.pm * BM + wr * 64 + fr, col0 = u.pn * BM + wc * 32 + 8 * fq;
#pragma unroll
        for (int ai = 0; ai < 2; ++ai)
#pragma unroll
            for (int m = 0; m < 4; ++m) { bf16_t* rowp = O + (size_t)(row0 + ai * HALF + m * 16) * ldc + col0;
#pragma unroll
                for (int bj = 0; bj < 2; ++bj) { f32x4 v0 = acc[ai][bj][m][0], v1 = acc[ai][bj][m][1];
                    if (ACT == 1) {
#pragma unroll
                        for (int e = 0; e < 4; ++e) { float a = v0[e] > 0.f ? v0[e] : 0.f; v0[e] = a * a; float b = v1[e] > 0.f ? v1[e] : 0.f; v1[e] = b * b; } }
                    u32x4 w; w.x = cvt_pk_bf16(v0[0], v0[1]); w.y = cvt_pk_bf16(v0[2], v0[3]); w.z = cvt_pk_bf16(v1[0], v1[1]); w.w = cvt_pk_bf16(v1[2], v1[3]);
                    *(u32x4*)(rowp + bj * HALF) = w; } }
    }
};
struct EpiRes {
    static constexpr bool PERM = false, AFTER_DRAIN = false;
    float* X; const float* gate;
    __device__ __forceinline__ void operator()(const f32x4 (&acc)[2][2][4][2], const Unit& u, int wr, int wc, int fr, int fq) const {
        const int row0 = u.pm * BM + wr * 64 + fr, col0 = u.pn * BM + wc * 32 + 4 * fq;
        const int cond = u.pm < 32 ? 0 : 1 + ((u.pm - 32) >> 2);
        const float* gp = gate + cond * 6144 + col0;
        f32x4 gv[2][2];
#pragma unroll
        for (int bj = 0; bj < 2; ++bj)
#pragma unroll
            for (int n = 0; n < 2; ++n) gv[bj][n] = *(const f32x4*)(gp + bj * HALF + n * 16);
#pragma unroll
        for (int ai = 0; ai < 2; ++ai)
#pragma unroll
            for (int m = 0; m < 4; ++m) { float* rowp = X + (size_t)(row0 + ai * HALF + m * 16) * 1024 + col0;
#pragma unroll
                for (int bj = 0; bj < 2; ++bj)
#pragma unroll
                    for (int n = 0; n < 2; ++n) { f32x4* q = (f32x4*)(rowp + bj * HALF + n * 16); *q = *q + gv[bj][n] * acc[ai][bj][m][n]; } }
    }
};
struct EpiFnet {
    static constexpr bool PERM = true, AFTER_DRAIN = false;
    bf16_t* MIX; int rowbase, L;
    __device__ __forceinline__ void operator()(const f32x4 (&acc)[2][2][4][2], const Unit& u, int wr, int wc, int fr, int fq) const {
        const int row0 = u.pm * BM + wr * 64 + fr, colw = wc * 32 + 8 * fq;
        bf16_t* base = MIX + (size_t)(rowbase + u.pn * L) * 1024 + 512 + colw;
#pragma unroll
        for (int ai = 0; ai < 2; ++ai)
#pragma unroll
            for (int m = 0; m < 4; ++m) { bf16_t* rowp = base + (size_t)(row0 + ai * HALF + m * 16) * 1024;
#pragma unroll
                for (int bj = 0; bj < 2; ++bj) { const f32x4 v0 = acc[ai][bj][m][0], v1 = acc[ai][bj][m][1];
                    u32x4 w; w.x = cvt_pk_bf16(v0[0], v0[1]); w.y = cvt_pk_bf16(v0[2], v0[3]); w.z = cvt_pk_bf16(v1[0], v1[1]); w.w = cvt_pk_bf16(v1[2], v1[3]);
                    *(u32x4*)(rowp + bj * HALF) = w; } }
    }
};
template <class Epi, class Sched, bool ALIGN_EPI = false, bool SP2 = false>
__device__ __forceinline__ void gemm_phase(PG8_LAS unsigned char* lds, const Gemm g, const Sched& S, const Epi& E) {
    const int tid = threadIdx.x, wid = __builtin_amdgcn_readfirstlane(tid >> 6), lane = tid & 63, wr = wid >> 2, wc = wid & 3, fr = lane & 15, fq = lane >> 4;
    const int K = g.K, nt = K / BK;
    unsigned voffA[2], voffB[2];
#pragma unroll
    for (int i = 0; i < 2; ++i) { int R, C; stage_rc(tid * 16 + i * 8192, R, C); const int Rb = Epi::PERM ? ((R & ~31) + perm32(R & 31)) : R;
        voffA[i] = (unsigned)(R * g.lda + C) * 2u; voffB[i] = (unsigned)(Rb * g.ldb + C) * 2u; }
    const size_t kstep = (size_t)(BK * 2);
    const size_t hstepA = (size_t)HALF * g.lda * 2, hstepB = (size_t)HALF * g.ldb * 2;
    const size_t tstepA = 2 * hstepA, tstepB = 2 * hstepB;
    const unsigned ldsw = (unsigned)wid * 1024u;
    const int aoff = lds_byte(wr * 64 + fr, fq * 8), boff = lds_byte(wc * 32 + fr, fq * 8);
#define PG8_SA(b, h) (((b) * 2 + (h)) * HTB)
#define PG8_SB(b, h) ((4 + (b) * 2 + (h)) * HTB)
#define PG8_STAGE(bufoff, gbase, voff) do { _Pragma("unroll") for (int _i = 0; _i < 2; ++_i) \
        __builtin_amdgcn_global_load_lds((const unsigned*)((const char*)(gbase) + (voff)[_i]), (PG8_LAS unsigned*)(lds + (bufoff) + ldsw + _i * 8192), 16, 0, 0); } while (0)
#define PG8_LDA(dst, b, h) do { _Pragma("unroll") for (int m = 0; m < 4; ++m) _Pragma("unroll") for (int k = 0; k < 2; ++k) dst[m][k] = *(const PG8_LAS bf16x8*)(lds + PG8_SA(b, h) + aoff + m * 2048 + k * 1024); } while (0)
#define PG8_LDB(dst, b, h) do { _Pragma("unroll") for (int n = 0; n < 2; ++n) _Pragma("unroll") for (int k = 0; k < 2; ++k) dst[n][k] = *(const PG8_LAS bf16x8*)(lds + PG8_SB(b, h) + boff + n * 2048 + k * 1024); } while (0)
#define PG8_MMA(ai, bj, At, Bt) do { __builtin_amdgcn_s_setprio(1); _Pragma("unroll") for (int m = 0; m < 4; ++m) _Pragma("unroll") for (int n = 0; n < 2; ++n) _Pragma("unroll") for (int k = 0; k < 2; ++k) \
        acc[ai][bj][m][n] = __builtin_amdgcn_mfma_f32_16x16x32_bf16(Bt[n][k], At[m][k], acc[ai][bj][m][n], 0, 0, 0); __builtin_amdgcn_s_setprio(0); } while (0)
#define PG8_WAIT_V(n) asm volatile("s_waitcnt vmcnt(" #n ")" ::: "memory")
#define PG8_WAIT_L(n) asm volatile("s_waitcnt lgkmcnt(" #n ")" ::: "memory")
#define PG8_BAR __builtin_amdgcn_s_barrier()
#define PG8_SCHED __builtin_amdgcn_sched_barrier(0)
    Unit cur, nxt; int ui = 0;
    if (!S.next(0, cur)) return;
    f32x4 acc[2][2][4][2];
#pragma unroll
    for (int a = 0; a < 2; ++a)
#pragma unroll
        for (int b = 0; b < 2; ++b)
#pragma unroll
            for (int m = 0; m < 4; ++m)
#pragma unroll
                for (int n = 0; n < 2; ++n) acc[a][b][m][n] = (f32x4){0.f, 0.f, 0.f, 0.f};
    bf16x8 At[4][2], B0[2][2], B1[2][2];
    const char* cA = (const char*)g.A + (size_t)cur.pm * tstepA; const char* cB = (const char*)g.Bt + (size_t)cur.pn * tstepB;
    S.a_ready(cur);
    if constexpr (SP2) {
        PG8_STAGE(PG8_SB(0, 0), cB, voffB); PG8_STAGE(PG8_SB(0, 1), cB + hstepB, voffB); PG8_STAGE(PG8_SA(0, 0), cA, voffA); PG8_STAGE(PG8_SA(0, 1), cA + hstepA, voffA);
        if (wr == 1) PG8_BAR;
        PG8_WAIT_V(2); PG8_BAR;
        PG8_STAGE(PG8_SB(1, 0), cB + kstep, voffB); PG8_STAGE(PG8_SA(1, 0), cA + kstep, voffA); PG8_STAGE(PG8_SB(1, 1), cB + hstepB + kstep, voffB);
        PG8_WAIT_V(6); PG8_BAR;
    } else {
        PG8_STAGE(PG8_SB(0, 0), cB, voffB); PG8_STAGE(PG8_SA(0, 0), cA, voffA); PG8_STAGE(PG8_SB(0, 1), cB + hstepB, voffB); PG8_STAGE(PG8_SA(0, 1), cA + hstepA, voffA);
        if (wr == 1) PG8_BAR;
        PG8_WAIT_V(4); PG8_BAR;
        PG8_STAGE(PG8_SB(1, 0), cB + kstep, voffB); PG8_STAGE(PG8_SA(1, 0), cA + kstep, voffA); PG8_STAGE(PG8_SB(1, 1), cB + hstepB + kstep, voffB);
        PG8_WAIT_V(6); PG8_BAR;
    }
    for (;;) {
        const bool has_next = S.next(ui + 1, nxt);
        const char* nA = has_next ? (const char*)g.A + (size_t)nxt.pm * tstepA : cA; const char* nB = has_next ? (const char*)g.Bt + (size_t)nxt.pn * tstepB : cB;
        for (int t = 0; t < nt; t += 2) {
            const bool last = (t == nt - 2);
            const char* a1 = cA + (size_t)(t + 1) * kstep;
            const char* a2 = last ? nA : cA + (size_t)(t + 2) * kstep; const char* b2 = last ? nB : cB + (size_t)(t + 2) * kstep;
            const char* a3 = a2 + kstep; const char* b3 = b2 + kstep;
            if (last && has_next) S.a_ready(nxt);
            if constexpr (SP2) {
            PG8_LDB(B0, 0, 0); PG8_LDB(B1, 0, 1); PG8_SCHED; PG8_LDA(At, 0, 0); PG8_STAGE(PG8_SA(1, 1), a1 + hstepA, voffA);
            PG8_WAIT_V(8); PG8_WAIT_L(0); PG8_BAR; PG8_MMA(0, 0, At, B0); PG8_MMA(0, 1, At, B1); PG8_BAR; PG8_SCHED;
            PG8_LDA(At, 0, 1); PG8_STAGE(PG8_SB(0, 0), b2, voffB); PG8_STAGE(PG8_SB(0, 1), b2 + hstepB, voffB); PG8_STAGE(PG8_SA(0, 0), a2, voffA);
            PG8_WAIT_V(8); PG8_WAIT_L(0); PG8_BAR; PG8_MMA(1, 0, At, B0); PG8_MMA(1, 1, At, B1); PG8_BAR; PG8_SCHED;
            PG8_LDB(B0, 1, 0); PG8_LDB(B1, 1, 1); PG8_SCHED; PG8_LDA(At, 1, 0); PG8_STAGE(PG8_SA(0, 1), a2 + hstepA, voffA);
            PG8_WAIT_V(8); PG8_WAIT_L(0); PG8_BAR; PG8_MMA(0, 0, At, B0); PG8_MMA(0, 1, At, B1); PG8_BAR; PG8_SCHED;
            PG8_LDA(At, 1, 1); PG8_STAGE(PG8_SB(1, 0), b3, voffB); PG8_STAGE(PG8_SB(1, 1), b3 + hstepB, voffB); PG8_STAGE(PG8_SA(1, 0), a3, voffA);
            PG8_WAIT_V(8); PG8_WAIT_L(0); PG8_BAR; PG8_MMA(1, 0, At, B0); PG8_MMA(1, 1, At, B1); PG8_BAR; PG8_SCHED;
            } else {
            PG8_LDB(B0, 0, 0); PG8_SCHED; PG8_LDA(At, 0, 0); PG8_STAGE(PG8_SA(1, 1), a1 + hstepA, voffA);
            PG8_WAIT_L(8); PG8_BAR; PG8_WAIT_L(0); PG8_MMA(0, 0, At, B0); PG8_BAR; PG8_SCHED;
            PG8_LDB(B1, 0, 1); PG8_STAGE(PG8_SB(0, 0), b2, voffB);
            PG8_BAR; PG8_WAIT_L(0); PG8_MMA(0, 1, At, B1); PG8_BAR;
            PG8_LDA(At, 0, 1); PG8_STAGE(PG8_SA(0, 0), a2, voffA);
            PG8_BAR; PG8_WAIT_L(0); PG8_MMA(1, 0, At, B0); PG8_BAR; PG8_SCHED;
            PG8_STAGE(PG8_SB(0, 1), b2 + hstepB, voffB);
            PG8_WAIT_V(6); PG8_BAR; PG8_MMA(1, 1, At, B1); PG8_BAR;
            PG8_LDB(B0, 1, 0); PG8_SCHED; PG8_LDA(At, 1, 0); PG8_STAGE(PG8_SA(0, 1), a2 + hstepA, voffA);
            PG8_WAIT_L(8); PG8_BAR; PG8_WAIT_L(0); PG8_MMA(0, 0, At, B0); PG8_BAR; PG8_SCHED;
            PG8_LDB(B1, 1, 1); PG8_STAGE(PG8_SB(1, 0), b3, voffB);
            PG8_BAR; PG8_WAIT_L(0); PG8_MMA(0, 1, At, B1); PG8_BAR;
            PG8_LDA(At, 1, 1); PG8_STAGE(PG8_SA(1, 0), a3, voffA);
            PG8_BAR; PG8_WAIT_L(0); PG8_MMA(1, 0, At, B0); PG8_BAR; PG8_SCHED;
            PG8_STAGE(PG8_SB(1, 1), b3 + hstepB, voffB);
            PG8_WAIT_V(6); PG8_BAR; PG8_MMA(1, 1, At, B1); PG8_BAR;
            }
        }
        if constexpr (ALIGN_EPI) { if (wr == 0) PG8_BAR; }
        if constexpr (!Epi::AFTER_DRAIN) { E(acc, cur, wr, wc, fr, fq); S.done(cur); }
        if (!has_next) break;
#pragma unroll
        for (int a = 0; a < 2; ++a)
#pragma unroll
            for (int b = 0; b < 2; ++b)
#pragma unroll
                for (int m = 0; m < 4; ++m)
#pragma unroll
                    for (int n = 0; n < 2; ++n) acc[a][b][m][n] = (f32x4){0.f, 0.f, 0.f, 0.f};
        cur = nxt; cA = nA; cB = nB; ++ui;
        if constexpr (ALIGN_EPI) { if (wr == 1) PG8_BAR; }
    }
    PG8_WAIT_V(0);
    if constexpr (!ALIGN_EPI) { if (wr == 0) PG8_BAR; }
    PG8_BAR;
    if constexpr (Epi::AFTER_DRAIN) { E.fused(acc, cur, wr, wc, fr, fq, lds, wid, lane); S.done(cur); }
#undef PG8_SA
#undef PG8_SB
#undef PG8_STAGE
#undef PG8_LDA
#undef PG8_LDB
#undef PG8_MMA
#undef PG8_WAIT_V
#undef PG8_WAIT_L
#undef PG8_BAR
#undef PG8_SCHED
}
}

#define LAS __attribute__((address_space(3)))
typedef unsigned short bf16;
typedef float f32x4 __attribute__((ext_vector_type(4)));
typedef unsigned u32x4 __attribute__((ext_vector_type(4)));
typedef unsigned u32x2 __attribute__((ext_vector_type(2)));
constexpr int DM = 1024, NCTX = 8192, MTOK = 12288, DINP = 2560, DFF = 4096;
constexpr int R_OFF = 0, K_OFF = 512, V_OFF = 1024, WD_OFF = 1536, AD_OFF = 1664, GD_OFF = 1792, F_OFF = 1920, P_OFF = 2176, DIN = 2432;
constexpr size_t MiB = 1u << 20;
constexpr size_t WS_CTL = 0, WS_MOD = 1 * MiB, WS_FW = 1 * MiB + 512 * 1024, WS_BC = 2 * MiB, WS_CS256 = 3 * MiB, WS_CS1024 = 4 * MiB, WS_WIN = 8 * MiB, WS_WOUT = 18 * MiB,
                 WS_W1 = 22 * MiB, WS_W2 = 38 * MiB, WS_H = 54 * MiB, WS_MIXED = 78 * MiB, WS_PROJ = 102 * MiB, WS_YCS = 162 * MiB, WS_YF = 174 * MiB, WS_YB = 198 * MiB,
                 WS_FF = 102 * MiB, WS_END = 222 * MiB;
constexpr int LDS_BYTES = 147456, RING_BYTES = 131072, MISC_OFF = RING_BYTES + 320;
constexpr int NTHR = 512;
enum { I_XP = 0, I_XS, I_STATE, I_C, I_CCTX, I_WADA, I_BADA, I_N1G, I_WIN, I_MU, I_W0, I_WUP, I_A0, I_AUP, I_GUP, I_KK, I_KA, I_RK, I_LNW, I_LNB, I_WFNET, I_WPOOL, I_PSCALE, I_WOUT, I_N2G, I_WFF1, I_WFF2, I_FNG, N_IN };
struct KP { const float* in[N_IN]; float* out; unsigned char* ws; int ph_lo, ph_hi; };

__device__ __forceinline__ unsigned f2bf(float f) { unsigned u = __builtin_bit_cast(unsigned, f); return (u + 0x7fffu + ((u >> 16) & 1u)) >> 16; }
__device__ __forceinline__ unsigned pk2(float lo, float hi) { return f2bf(lo) | (f2bf(hi) << 16); }
__device__ __forceinline__ float bflo(unsigned w) { return __builtin_bit_cast(float, w << 16); }
__device__ __forceinline__ float bfhi(unsigned w) { return __builtin_bit_cast(float, w & 0xffff0000u); }
__device__ __forceinline__ float bf1(bf16 h) { return __builtin_bit_cast(float, (unsigned)h << 16); }
template <int CTRL> __device__ __forceinline__ float dppf(float x) { return __builtin_bit_cast(float, __builtin_amdgcn_update_dpp(0, __builtin_bit_cast(int, x), CTRL, 0xF, 0xF, true)); }
__device__ __forceinline__ float red8(float x)  { x += dppf<0xB1>(x); x += dppf<0x4E>(x); x += dppf<0x141>(x); return x; }
__device__ __forceinline__ float red16(float x) { x += dppf<0xB1>(x); x += dppf<0x4E>(x); x += dppf<0x141>(x); x += dppf<0x140>(x); return x; }
__device__ __forceinline__ float wave_sum(float v) {
#pragma unroll
    for (int o = 1; o < 64; o <<= 1) v += __shfl_xor(v, o);
    return v;
}
__device__ __forceinline__ void load4bf(const bf16* p, float (&o)[4]) { const u32x2 w = *(const u32x2*)p; o[0] = bflo(w.x); o[1] = bfhi(w.x); o[2] = bflo(w.y); o[3] = bfhi(w.y); }
__device__ __forceinline__ void load8bf(const bf16* p, float (&o)[8]) { const u32x4 w = *(const u32x4*)p; o[0] = bflo(w.x); o[1] = bfhi(w.x); o[2] = bflo(w.y); o[3] = bfhi(w.y); o[4] = bflo(w.z); o[5] = bfhi(w.z); o[6] = bflo(w.w); o[7] = bfhi(w.w); }
__device__ __forceinline__ void shift4(const bf16* proj, int row, bool hasp, bool hasn, int col, const float* mu, float (&u)[4]) {
    float p[4], a[4] = {0.f, 0.f, 0.f, 0.f}, b[4] = {0.f, 0.f, 0.f, 0.f};
    load4bf(proj + (size_t)row * DINP + col, p);
    if (hasp) load4bf(proj + (size_t)(row - 1) * DINP + col, a);
    if (hasn) load4bf(proj + (size_t)(row + 1) * DINP + col, b);
    const f32x4 m = *(const f32x4*)(mu + col);
#pragma unroll
    for (int j = 0; j < 4; ++j) u[j] = p[j] + m[j] * (0.5f * (a[j] + b[j]) - p[j]);
}

__device__ __forceinline__ void transpose_item(const float* W, int K, int N, bf16* WT, LAS float* scr, int item, int lane) {
    const int nblk = N / 32, kb = item / nblk, nb = item % nblk, k0 = 64 * kb, n0 = 32 * nb;
#pragma unroll 8
    for (int i = 0; i < 32; ++i) { const int kk = 2 * i + (lane >> 5); scr[kk * 33 + (lane & 31)] = W[(size_t)(k0 + kk) * N + n0 + (lane & 31)]; }
    asm volatile("s_waitcnt lgkmcnt(0)" ::: "memory");
    const int c = lane & 7;
#pragma unroll
    for (int j = 0; j < 4; ++j) { const int n = (lane >> 3) + 8 * j; const LAS float* s = scr + (8 * c) * 33 + n;
        u32x4 o; o.x = pk2(s[0 * 33], s[1 * 33]); o.y = pk2(s[2 * 33], s[3 * 33]); o.z = pk2(s[4 * 33], s[5 * 33]); o.w = pk2(s[6 * 33], s[7 * 33]);
        *(u32x4*)(WT + (size_t)(n0 + n) * K + k0 + 8 * c) = o; }
    asm volatile("s_waitcnt lgkmcnt(0)" ::: "memory");
}
__device__ __forceinline__ void stage_prologue(const KP& p, LAS unsigned char* lds, int bid, int nb) {
    const int tid = threadIdx.x, lane = tid & 63, wave = tid >> 6;
    unsigned char* ws = p.ws;
    {
        LAS float* scr = (LAS float*)(lds + wave * 16384);
        const int gw = bid * 8 + wave, NGW = nb * 8;
        constexpr int I_IN = 16 * 76, I_OUT = 16 * 32, I_1 = 16 * 128, I_2 = 64 * 32, I_L = I_IN + I_OUT + I_1 + I_2;
        for (int it = gw; it < 2 * I_L; it += NGW) {
            const int l = it / I_L; int r = it % I_L;
            if (r < I_IN) { transpose_item(p.in[I_WIN] + (size_t)l * DM * DIN, DM, DIN, (bf16*)(ws + WS_WIN) + (size_t)l * DINP * DM, scr, r, lane); continue; } r -= I_IN;
            if (r < I_OUT) { transpose_item(p.in[I_WOUT] + (size_t)l * DM * DM, DM, DM, (bf16*)(ws + WS_WOUT) + (size_t)l * DM * DM, scr, r, lane); continue; } r -= I_OUT;
            if (r < I_1) { transpose_item(p.in[I_WFF1] + (size_t)l * DM * DFF, DM, DFF, (bf16*)(ws + WS_W1) + (size_t)l * DFF * DM, scr, r, lane); continue; } r -= I_1;
            transpose_item(p.in[I_WFF2] + (size_t)l * DFF * DM, DFF, DM, (bf16*)(ws + WS_W2) + (size_t)l * DM * DFF, scr, r, lane);
        }
    }
    const int gt = bid * NTHR + tid, NGT = nb * NTHR;
    for (int i = gt; i < 2 * 128 * DM / 8; i += NGT) { const int l = i / (128 * DM / 8), r = i % (128 * DM / 8);
        *(u32x4*)((bf16*)(ws + WS_WIN) + (size_t)l * DINP * DM + (size_t)DIN * DM + (size_t)r * 8) = (u32x4){0u, 0u, 0u, 0u}; }
    for (int i = gt; i < 256 * 512 + 1024 * 2048; i += NGT) {
        int L, k, j; bf16* dst;
        if (i < 256 * 512) { L = 256; k = i / 512; j = i % 512; dst = (bf16*)(ws + WS_CS256) + i; }
        else { const int i2 = i - 256 * 512; L = 1024; k = i2 / 2048; j = i2 % 2048; dst = (bf16*)(ws + WS_CS1024) + i2; }
        const int jj = j >= L ? j - L : j; const int idx = (k * jj) & (L - 1);
        float s, c; sincospif(2.0f * (float)idx / (float)L, &s, &c);
        *dst = (bf16)f2bf(j >= L ? -s : c);
    }
    for (int i = gt; i < 2 * 4 * 64 * 128; i += NGT) {
        const int o = i & 127, c = (i >> 7) & 63, lg = i >> 13; const float* wf = p.in[I_WFNET] + (size_t)lg * 4096 + (o & 63);
        float acc = 0.f;
        for (int cp = 0; cp < 64; ++cp) { float s, co; sincospif(2.0f * (float)((c * cp) & 63) / 64.0f, &s, &co); acc += (o < 64 ? co : s) * wf[cp * 64]; }
        ((float*)(ws + WS_FW))[i] = acc;
    }
    for (int i = gt; i < MTOK * DM / 4; i += NGT) {
        const f32x4 v = i < NCTX * DM / 4 ? ((const f32x4*)p.in[I_XP])[i] : ((const f32x4*)p.in[I_XS])[i - NCTX * DM / 4];
        ((f32x4*)p.out)[i] = v;
    }
    __syncthreads();
    LAS float* sc = (LAS float*)lds; LAS float* red = (LAS float*)(lds + 20480);
    for (int it = bid; it < 192; it += nb) {
        const int l = it / 96, cgp = it % 96;
        for (int i = tid; i < 5 * 1024; i += NTHR) { const int cond = i >> 10, k = i & 1023; const float v = cond == 0 ? p.in[I_CCTX][k] : p.in[I_C][(cond - 1) * 1024 + k]; sc[i] = v / (1.0f + __expf(-v)); }
        __syncthreads();
        const int cgi = tid & 15, kg = tid >> 4;
        f32x4 acc[5];
#pragma unroll
        for (int c = 0; c < 5; ++c) acc[c] = (f32x4){0.f, 0.f, 0.f, 0.f};
        const float* wp = p.in[I_WADA] + ((size_t)l * 1024 + kg * 32) * 6144 + cgp * 64 + cgi * 4;
#pragma unroll 4
        for (int kk = 0; kk < 32; ++kk) { const f32x4 w = *(const f32x4*)(wp + (size_t)kk * 6144);
#pragma unroll
            for (int c = 0; c < 5; ++c) acc[c] += sc[c * 1024 + kg * 32 + kk] * w; }
#pragma unroll
        for (int c = 0; c < 5; ++c) *(LAS f32x4*)(red + (kg * 5 + c) * 64 + cgi * 4) = acc[c];
        __syncthreads();
        if (tid < 320) { const int cond = tid >> 6, col = tid & 63; float s = p.in[I_BADA][l * 6144 + cgp * 64 + col];
            for (int g = 0; g < 32; ++g) s += red[(g * 5 + cond) * 64 + col];
            ((float*)(ws + WS_MOD))[(l * 5 + cond) * 6144 + cgp * 64 + col] = s; }
        __syncthreads();
    }
}

__device__ __forceinline__ void stage_norm(const KP& p, int l, int which, int bid, int nb) {
    const int tid = threadIdx.x, lane = tid & 63, wave = tid >> 6;
    const float* g = p.in[which ? I_N2G : I_N1G] + l * DM;
    const float* mod = (const float*)(p.ws + WS_MOD) + (size_t)l * 5 * 6144 + (which ? 3 * 1024 : 0);
    bf16* H = (bf16*)(p.ws + WS_H);
    for (int row = bid * 8 + wave; row < MTOK; row += nb * 8) {
        const f32x4* xr = (const f32x4*)(p.out + (size_t)row * DM) + lane;
        f32x4 v[4]; float s = 0.f;
#pragma unroll
        for (int j = 0; j < 4; ++j) { v[j] = xr[64 * j]; s += (v[j].x * v[j].x + v[j].y * v[j].y) + (v[j].z * v[j].z + v[j].w * v[j].w); }
        const float rstd = 1.0f / sqrtf(wave_sum(s) * (1.0f / DM) + 1e-6f);
        const int cond = row < NCTX ? 0 : 1 + ((row - NCTX) >> 10);
        const float* sh = mod + cond * 6144; const float* scl = sh + 1024;
        unsigned long long* o8 = (unsigned long long*)(H + (size_t)row * DM) + lane;
#pragma unroll
        for (int j = 0; j < 4; ++j) { const int col = 4 * lane + 256 * j; const f32x4 gg = *(const f32x4*)(g + col), a = *(const f32x4*)(sh + col), b = *(const f32x4*)(scl + col);
            const f32x4 y = v[j] * rstd * gg * (b + 1.0f) + a;
            o8[64 * j] = (unsigned long long)pk2(y.x, y.y) | ((unsigned long long)pk2(y.z, y.w) << 32); }
    }
}
__device__ __forceinline__ void stage_final(const KP& p, int bid, int nb) {
    const int tid = threadIdx.x, lane = tid & 63, wave = tid >> 6;
    const float* g = p.in[I_FNG];
    for (int row = bid * 8 + wave; row < MTOK; row += nb * 8) {
        f32x4* xr = (f32x4*)(p.out + (size_t)row * DM) + lane;
        f32x4 v[4]; float s = 0.f;
#pragma unroll
        for (int j = 0; j < 4; ++j) { v[j] = xr[64 * j]; s += (v[j].x * v[j].x + v[j].y * v[j].y) + (v[j].z * v[j].z + v[j].w * v[j].w); }
        const float rstd = 1.0f / sqrtf(wave_sum(s) * (1.0f / DM) + 1e-6f);
#pragma unroll
        for (int j = 0; j < 4; ++j) xr[64 * j] = v[j] * rstd * *(const f32x4*)(g + 4 * lane + 256 * j);
    }
}

__device__ __forceinline__ void rwkv_item(const KP& p, int l, LAS unsigned char* lds, int item) {
    const int tid = threadIdx.x;
    int bseq, h, dir, L, base; bool lat;
    if (item < 64) { lat = true; bseq = item >> 4; h = (item >> 1) & 7; dir = item & 1; L = 1024; base = NCTX + bseq * 1024; }
    else { const int i2 = item - 64; lat = false; bseq = i2 >> 4; h = (i2 >> 1) & 7; dir = i2 & 1; L = 256; base = bseq * 256; }
    const bf16* proj = (const bf16*)(p.ws + WS_PROJ);
    const float* mu = p.in[I_MU] + l * 1920;
    LAS float* WUP = (LAS float*)lds;
    LAS float* AUP = WUP + 4096;
    LAS float* WD = AUP + 4096;
    LAS float* AD = WD + 2048;
    LAS float* VA = AD + 2048;
    LAS float* VQ = VA + 2048; LAS float* VW = VQ + 2048; LAS float* VB = VW + 2048; LAS float* VK = VB + 2048; LAS float* VV = VK + 2048;
    LAS float* YS = VV + 2048;
    LAS float* BR = YS + 2048;
    LAS float* KR = BR + 32;
    for (int i = tid; i < 4096; i += NTHR) { const int r = i >> 6, c = i & 63;
        WUP[i] = p.in[I_WUP][((size_t)(l * 2 + dir) * 64 + r) * 512 + h * 64 + c];
        AUP[i] = p.in[I_AUP][((size_t)(l * 2 + dir) * 64 + r) * 512 + h * 64 + c]; }
    const int row = tid >> 3, k8 = (tid & 7) * 8;
    float s[8];
    if (lat) { const float* sp = p.in[I_STATE] + ((((size_t)bseq * 2 + l) * 2 + dir) * 8 + h) * 4096 + row * 64 + k8;
#pragma unroll
        for (int j = 0; j < 8; ++j) s[j] = sp[j]; }
    else {
#pragma unroll
        for (int j = 0; j < 8; ++j) s[j] = 0.f; }
    const int ti = tid >> 4, c4 = (tid & 15) * 4, hc = h * 64 + c4;
    const f32x4 w0v = *(const f32x4*)(p.in[I_W0] + (l * 2 + dir) * 512 + hc), a0v = *(const f32x4*)(p.in[I_A0] + (l * 2 + dir) * 512 + hc);
    const f32x4 kkv = *(const f32x4*)(p.in[I_KK] + l * 512 + hc), kav = *(const f32x4*)(p.in[I_KA] + l * 512 + hc), rkv = *(const f32x4*)(p.in[I_RK] + l * 512 + hc);
    float* Yout = (float*)(p.ws + (dir ? WS_YB : WS_YF));
    float* BC = (float*)(p.ws + WS_BC) + (size_t)dir * MTOK * 8;
    __syncthreads();
    for (int ch = 0; ch < L / 32; ++ch) {
        const int step = ch * 32 + ti, t = dir ? L - 1 - step : step, grow = base + t;
        const bool hasp = t > 0, hasn = t < L - 1;
        { float u[4];
          shift4(proj, grow, hasp, hasn, WD_OFF + dir * 64 + c4, mu, u);
#pragma unroll
          for (int j = 0; j < 4; ++j) WD[ti * 64 + c4 + j] = tanhf(u[j]);
          shift4(proj, grow, hasp, hasn, AD_OFF + dir * 64 + c4, mu, u);
#pragma unroll
          for (int j = 0; j < 4; ++j) AD[ti * 64 + c4 + j] = u[j]; }
        __syncthreads();
        { f32x4 wp = w0v, ap = a0v;
#pragma unroll 8
          for (int r = 0; r < 64; ++r) { const float wd = WD[ti * 64 + r], ad = AD[ti * 64 + r];
              wp += wd * *(const LAS f32x4*)(WUP + r * 64 + c4); ap += ad * *(const LAS f32x4*)(AUP + r * 64 + c4); }
          float rr[4], kk[4], vv[4];
          shift4(proj, grow, hasp, hasn, R_OFF + hc, mu, rr); shift4(proj, grow, hasp, hasn, K_OFF + hc, mu, kk); shift4(proj, grow, hasp, hasn, V_OFF + hc, mu, vv);
          float dec[4], asg[4], kn[4], kd[4], ss = 0.f;
#pragma unroll
          for (int j = 0; j < 4; ++j) {
              const float z = -wp[j]; const float sp = z > 20.f ? z : log1pf(__expf(z));
              const float wlog = -sp - 0.5f; dec[j] = __expf(-__expf(wlog));
              asg[j] = 1.0f / (1.0f + __expf(-ap[j]));
              kn[j] = kk[j] * kkv[j]; ss += kn[j] * kn[j];
              kd[j] = kk[j] * (1.0f + (asg[j] - 1.0f) * kav[j]); }
          ss = red16(ss);
          const float inv = 1.0f / fmaxf(sqrtf(ss), 1e-12f);
          float br = 0.f, kr = 0.f, bc = 0.f; f32x4 va, vq, vw, vb, vk, v4;
#pragma unroll
          for (int j = 0; j < 4; ++j) { const float kj = kn[j] * inv, bj = kj * asg[j];
              va[j] = -kj; vq[j] = dec[j] * rr[j]; vw[j] = dec[j]; vb[j] = bj; vk[j] = kd[j]; v4[j] = vv[j];
              br += bj * rr[j]; kr += kd[j] * rr[j]; bc += rr[j] * kd[j] * rkv[j]; }
          br = red16(br); kr = red16(kr); bc = red16(bc);
          *(LAS f32x4*)(VA + ti * 64 + c4) = va; *(LAS f32x4*)(VQ + ti * 64 + c4) = vq; *(LAS f32x4*)(VW + ti * 64 + c4) = vw;
          *(LAS f32x4*)(VB + ti * 64 + c4) = vb; *(LAS f32x4*)(VK + ti * 64 + c4) = vk; *(LAS f32x4*)(VV + ti * 64 + c4) = v4;
          if ((tid & 15) == 0) { BR[ti] = br; KR[ti] = kr; BC[(size_t)grow * 8 + h] = bc; } }
        __syncthreads();
#pragma unroll 2
        for (int i = 0; i < 32; ++i) {
            const f32x4 a0 = *(const LAS f32x4*)(VA + i * 64 + k8), a1 = *(const LAS f32x4*)(VA + i * 64 + k8 + 4);
            const f32x4 q0 = *(const LAS f32x4*)(VQ + i * 64 + k8), q1 = *(const LAS f32x4*)(VQ + i * 64 + k8 + 4);
            const f32x4 w0 = *(const LAS f32x4*)(VW + i * 64 + k8), w1 = *(const LAS f32x4*)(VW + i * 64 + k8 + 4);
            const f32x4 b0 = *(const LAS f32x4*)(VB + i * 64 + k8), b1 = *(const LAS f32x4*)(VB + i * 64 + k8 + 4);
            const f32x4 kk0 = *(const LAS f32x4*)(VK + i * 64 + k8), kk1 = *(const LAS f32x4*)(VK + i * 64 + k8 + 4);
            const float vt = VV[i * 64 + row], brt = BR[i], krt = KR[i];
            float sa = 0.f, yp = 0.f;
#pragma unroll
            for (int j = 0; j < 4; ++j) { sa += s[j] * a0[j]; yp += s[j] * q0[j]; }
#pragma unroll
            for (int j = 0; j < 4; ++j) { sa += s[4 + j] * a1[j]; yp += s[4 + j] * q1[j]; }
            sa = red8(sa); yp = red8(yp);
#pragma unroll
            for (int j = 0; j < 4; ++j) { s[j] = s[j] * w0[j] + sa * b0[j] + vt * kk0[j]; s[4 + j] = s[4 + j] * w1[j] + sa * b1[j] + vt * kk1[j]; }
            if ((tid & 7) == 0) YS[i * 64 + row] = yp + sa * brt + vt * krt;
        }
        __syncthreads();
        *(f32x4*)(Yout + (size_t)grow * 512 + hc) = *(const LAS f32x4*)(YS + ti * 64 + c4);
    }
    if (!lat) { float* sp = p.out + (size_t)MTOK * DM + ((((size_t)bseq * 2 + l) * 2 + dir) * 8 + h) * 4096 + row * 64 + k8;
#pragma unroll
        for (int j = 0; j < 8; ++j) sp[j] = s[j]; }
    __syncthreads();
}

__device__ __forceinline__ void fnet1_item(const KP& p, int l, LAS unsigned char* lds, int item) {
    const int tid = threadIdx.x, tb = item >> 2, g = item & 3, tok0 = tb * 64;
    const bf16* proj = (const bf16*)(p.ws + WS_PROJ);
    LAS float* XT = (LAS float*)lds;
    LAS float* FWL = XT + 64 * 65;
    { const int ti = tid >> 3, c8 = (tid & 7) * 8; float x[8]; load8bf(proj + (size_t)(tok0 + ti) * DINP + F_OFF + g * 64 + c8, x);
#pragma unroll
      for (int j = 0; j < 8; ++j) XT[ti * 65 + c8 + j] = x[j]; }
    const float* fw = (const float*)(p.ws + WS_FW) + (size_t)(l * 4 + g) * 8192;
    for (int i = tid; i < 2048; i += NTHR) *(LAS f32x4*)(FWL + i * 4) = *(const f32x4*)(fw + i * 4);
    __syncthreads();
    const int ti = tid & 63, og = tid >> 6;
    f32x4 acc[4];
#pragma unroll
    for (int j = 0; j < 4; ++j) acc[j] = (f32x4){0.f, 0.f, 0.f, 0.f};
#pragma unroll 4
    for (int c = 0; c < 64; ++c) { const float x = XT[ti * 65 + c];
#pragma unroll
        for (int j = 0; j < 4; ++j) acc[j] += x * *(const LAS f32x4*)(FWL + c * 128 + og * 16 + j * 4); }
    const bool lat = tok0 >= NCTX;
    const int L = lat ? 1024 : 256, bq = lat ? (tok0 - NCTX) >> 10 : tok0 >> 8, t = (lat ? (tok0 - NCTX) & 1023 : tok0 & 255) + ti;
    const float scale = lat ? (1.0f / 256.0f) : (1.0f / 128.0f);
    bf16* Y = (bf16*)(p.ws + WS_YCS) + (lat ? (size_t)8192 * 512 : 0);
    const int cs = og >> 2, K2 = 2 * L;
#pragma unroll
    for (int j = 0; j < 4; ++j)
#pragma unroll
        for (int e = 0; e < 4; ++e) { const int d = (og & 3) * 16 + j * 4 + e;
            Y[(size_t)((bq * 4 + g) * 64 + d) * K2 + cs * L + t] = (bf16)f2bf(acc[j][e] * scale); }
    __syncthreads();
}

__device__ __forceinline__ void pool_item(const KP& p, int l, LAS unsigned char* lds, int item) {
    const int tid = threadIdx.x, tb = item >> 2, gi = item & 3, tok0 = tb * 64, hw = 1 << gi;
    const bf16* proj = (const bf16*)(p.ws + WS_PROJ);
    LAS float* DT = (LAS float*)lds;
    LAS float* WP = DT + 64 * 65;
    const float* wpool = p.in[I_WPOOL] + (size_t)(l * 4 + gi) * 4096;
    for (int i = tid; i < 1024; i += NTHR) *(LAS f32x4*)(WP + i * 4) = *(const f32x4*)(wpool + i * 4);
    const int ti = tid >> 3, c8 = (tid & 7) * 8, tok = tok0 + ti, col = P_OFF + gi * 64 + c8;
    { float sum[8], x[8];
#pragma unroll
      for (int j = 0; j < 8; ++j) sum[j] = 0.f;
      load8bf(proj + (size_t)tok * DINP + col, x);
      float cnt;
      if (tok < NCTX) { const int t = tok & 255, sb = tok - t, lo = max(t - hw, 0), hi = min(t + hw, 256);
          for (int q = lo; q < hi; ++q) { float y[8]; load8bf(proj + (size_t)(sb + q) * DINP + col, y);
#pragma unroll
              for (int j = 0; j < 8; ++j) sum[j] += y[j]; }
          cnt = (float)(hi - lo); }
      else { const int t = (tok - NCTX) & 1023, sb = tok - t, r = t >> 6, c = t & 63, rlo = max(r - hw, 0), rhi = min(r + hw, 16), clo = max(c - hw, 0), chi = min(c + hw, 64);
          for (int rq = rlo; rq < rhi; ++rq) for (int cq = clo; cq < chi; ++cq) { float y[8]; load8bf(proj + (size_t)(sb + rq * 64 + cq) * DINP + col, y);
#pragma unroll
              for (int j = 0; j < 8; ++j) sum[j] += y[j]; }
          cnt = (float)((rhi - rlo) * (chi - clo)); }
      const float ic = 1.0f / cnt;
#pragma unroll
      for (int j = 0; j < 8; ++j) DT[ti * 65 + c8 + j] = sum[j] * ic - x[j]; }
    __syncthreads();
    f32x4 a0 = (f32x4){0.f, 0.f, 0.f, 0.f}, a1 = a0;
#pragma unroll 4
    for (int c = 0; c < 64; ++c) { const float d = DT[ti * 65 + c]; a0 += d * *(const LAS f32x4*)(WP + c * 64 + c8); a1 += d * *(const LAS f32x4*)(WP + c * 64 + c8 + 4); }
    const float* ps = p.in[I_PSCALE] + l * 256 + gi * 64 + c8;
    const f32x4 s0 = *(const f32x4*)ps, s1 = *(const f32x4*)(ps + 4);
    a0 *= s0; a1 *= s1;
    u32x4 w; w.x = pk2(a0[0], a0[1]); w.y = pk2(a0[2], a0[3]); w.z = pk2(a1[0], a1[1]); w.w = pk2(a1[2], a1[3]);
    *(u32x4*)((bf16*)(p.ws + WS_MIXED) + (size_t)tok * DM + 768 + gi * 64 + c8) = w;
    __syncthreads();
}

__device__ __forceinline__ void post_item(const KP& p, int l, LAS unsigned char* lds, int item) {
    const int tid = threadIdx.x, tok0 = item * 16;
    const bf16* proj = (const bf16*)(p.ws + WS_PROJ);
    const float* mu = p.in[I_MU] + l * 1920;
    LAS float* SG = (LAS float*)lds;
    const bool lat = tok0 >= NCTX; const int L = lat ? 1024 : 256, tseq0 = lat ? (tok0 - NCTX) & 1023 : tok0 & 255;
    { const int ti = tid >> 5, r4 = (tid & 31) * 4, t = tseq0 + ti; float u[4];
      shift4(proj, tok0 + ti, t > 0, t < L - 1, GD_OFF + r4, mu, u);
#pragma unroll
      for (int j = 0; j < 4; ++j) SG[ti * 128 + r4 + j] = 1.0f / (1.0f + __expf(-u[j])); }
    __syncthreads();
    const int c = tid, head = tid >> 6;
    float g[16];
#pragma unroll
    for (int i = 0; i < 16; ++i) g[i] = 0.f;
    const float* gup = p.in[I_GUP] + (size_t)l * 128 * 512 + c;
    for (int r = 0; r < 128; r += 4) { const float w0 = gup[(r + 0) * 512], w1 = gup[(r + 1) * 512], w2 = gup[(r + 2) * 512], w3 = gup[(r + 3) * 512];
#pragma unroll
        for (int i = 0; i < 16; ++i) { const f32x4 sg = *(const LAS f32x4*)(SG + i * 128 + r); g[i] += (sg.x * w0 + sg.y * w1) + (sg.z * w2 + sg.w * w3); } }
    const float lnw = p.in[I_LNW][l * 512 + c], lnb = p.in[I_LNB][l * 512 + c], muv = mu[V_OFF + c];
    const float* YF = (const float*)(p.ws + WS_YF); const float* YB = (const float*)(p.ws + WS_YB);
    const float* BC0 = (const float*)(p.ws + WS_BC); const float* BC1 = BC0 + (size_t)MTOK * 8;
    bf16* MIX = (bf16*)(p.ws + WS_MIXED);
#pragma unroll 4
    for (int i = 0; i < 16; ++i) { const int tok = tok0 + i, t = tseq0 + i;
        const float y = YF[(size_t)tok * 512 + c] + YB[(size_t)tok * 512 + c];
        const float mean = wave_sum(y) * (1.0f / 64.0f), dlt = y - mean, var = wave_sum(dlt * dlt) * (1.0f / 64.0f);
        const float yn = dlt * (1.0f / sqrtf(var + 64e-5f)) * lnw + lnb;
        const float pv = bf1(proj[(size_t)tok * DINP + V_OFF + c]);
        const float pa = t > 0 ? bf1(proj[(size_t)(tok - 1) * DINP + V_OFF + c]) : 0.f, pb = t < L - 1 ? bf1(proj[(size_t)(tok + 1) * DINP + V_OFF + c]) : 0.f;
        const float v = pv + muv * (0.5f * (pa + pb) - pv);
        const float bonus = (BC0[(size_t)tok * 8 + head] + BC1[(size_t)tok * 8 + head]) * v;
        MIX[(size_t)tok * DM + c] = (bf16)f2bf((yn + bonus) * g[i]); }
    __syncthreads();
}

constexpr int N_PHASES = 18;
template <class Epi> __device__ __forceinline__ void run_gemm(LAS unsigned char* lds, const bf16* A, const bf16* Bt, int M, int N, int K, int lda, int ldb, int G, int c, const Epi& E) {
    const pg8::Gemm g{A, Bt, M, N, K, lda, ldb}; pg8::StaticOrder S; S.init(M, N, G, c);
    pg8::gemm_phase<Epi, pg8::StaticOrder, true, true>(lds, g, S, E);
}
template <int SUB> __device__ __forceinline__ void run_sub(const KP& p, int l, LAS unsigned char* lds, int bid, int nb) {
    unsigned char* ws = p.ws;
    const float* mod = (const float*)(ws + WS_MOD) + (size_t)l * 5 * 6144;
    if constexpr (SUB == -1) stage_prologue(p, lds, bid, nb);
    if constexpr (SUB == 0) stage_norm(p, l, 0, bid, nb);
    if constexpr (SUB == 1) {
        pg8::EpiBf<0> E{(bf16*)(ws + WS_PROJ), DINP};
        run_gemm(lds, (const bf16*)(ws + WS_H), (const bf16*)(ws + WS_WIN) + (size_t)l * DINP * DM, MTOK, DINP, DM, DM, DM, nb, bid, E);
    }
    if constexpr (SUB == 2) {
        if (nb >= 256) { if (bid < 64) rwkv_item(p, l, lds, bid); else for (int it = 64 + (bid - 64); it < 576; it += nb - 64) rwkv_item(p, l, lds, it); }
        else for (int it = bid; it < 576; it += nb) rwkv_item(p, l, lds, it);
        for (int it = bid; it < 768; it += nb) fnet1_item(p, l, lds, it);
        for (int it = bid; it < 768; it += nb) pool_item(p, l, lds, it);
    }
    if constexpr (SUB == 3) {
        { pg8::EpiFnet E{(bf16*)(ws + WS_MIXED), 0, 256};
          run_gemm(lds, (const bf16*)(ws + WS_CS256), (const bf16*)(ws + WS_YCS), 256, 8192, 512, 512, 512, nb, bid, E); }
        { pg8::EpiFnet E{(bf16*)(ws + WS_MIXED), NCTX, 1024};
          run_gemm(lds, (const bf16*)(ws + WS_CS1024), (const bf16*)(ws + WS_YCS) + (size_t)8192 * 512, 1024, 1024, 2048, 2048, 2048, nb, (bid + nb - 32) % nb, E); }
        __syncthreads();
        for (int it = bid; it < 768; it += nb) post_item(p, l, lds, it);
    }
    if constexpr (SUB == 4) {
        pg8::EpiRes E{p.out, mod + 2 * 1024};
        run_gemm(lds, (const bf16*)(ws + WS_MIXED), (const bf16*)(ws + WS_WOUT) + (size_t)l * DM * DM, MTOK, DM, DM, DM, DM, nb, bid, E);
    }
    if constexpr (SUB == 5) stage_norm(p, l, 1, bid, nb);
    if constexpr (SUB == 6) {
        pg8::EpiBf<1> E{(bf16*)(ws + WS_FF), DFF};
        run_gemm(lds, (const bf16*)(ws + WS_H), (const bf16*)(ws + WS_W1) + (size_t)l * DFF * DM, MTOK, DFF, DM, DM, DM, nb, bid, E);
    }
    if constexpr (SUB == 7) {
        pg8::EpiRes E{p.out, mod + 5 * 1024};
        run_gemm(lds, (const bf16*)(ws + WS_FF), (const bf16*)(ws + WS_W2) + (size_t)l * DM * DFF, MTOK, DM, DFF, DFF, DFF, nb, bid, E);
    }
    if constexpr (SUB == 8) stage_final(p, bid, nb);
}
template <int SUB> __global__ void __launch_bounds__(NTHR, 2) k_sub(KP p) {
    extern __shared__ __attribute__((aligned(16))) unsigned char lds_raw[];
    run_sub<SUB>(p, p.ph_lo, (LAS unsigned char*)lds_raw, blockIdx.x, gridDim.x);
}

template <int SUB> static void launch_sub(const KP& a, int l, int grid, hipStream_t stream) {
    static bool attr = false;
    if (!attr) { (void)hipFuncSetAttribute((const void*)k_sub<SUB>, hipFuncAttributeMaxDynamicSharedMemorySize, LDS_BYTES); attr = true; }
    KP b = a; b.ph_lo = l; b.ph_hi = 0;
    hipLaunchKernelGGL(k_sub<SUB>, dim3(grid), dim3(NTHR), LDS_BYTES, stream, b);
}
extern "C" void kernel_launch(void* const* d_in, const int* in_sizes, int n_in, void* d_out, int out_size, void* d_ws, size_t ws_size, hipStream_t stream) {
    static int grid = 0;
    if (grid == 0) {
        if (n_in != N_IN || ws_size < WS_END) { fprintf(stderr, "kernel_launch: unexpected inputs (n_in %d, ws %zu)\n", n_in, ws_size); grid = -1; return; }
        int dev = 0, cus = 0;
        (void)hipGetDevice(&dev); (void)hipDeviceGetAttribute(&cus, hipDeviceAttributeMultiprocessorCount, dev);
        grid = cus > 0 ? cus : 256;
    }
    if (grid < 0) return;
    KP a{};
    for (int i = 0; i < N_IN; ++i) a.in[i] = (const float*)d_in[i];
    a.out = (float*)d_out; a.ws = (unsigned char*)d_ws;
    launch_sub<-1>(a, 0, grid, stream);
    for (int l = 0; l < 2; ++l) {
        launch_sub<0>(a, l, grid, stream); launch_sub<1>(a, l, grid, stream); launch_sub<2>(a, l, grid, stream); launch_sub<3>(a, l, grid, stream);
        launch_sub<4>(a, l, grid, stream); launch_sub<5>(a, l, grid, stream); launch_sub<6>(a, l, grid, stream); launch_sub<7>(a, l, grid, stream);
    }
    launch_sub<8>(a, 0, grid, stream);
}
```

```cpp
#include <hip/hip_runtime.h>
#include <hip/hip_cooperative_groups.h>
#include <cstdio>
#include <cstdint>
namespace cg = cooperative_groups;
__device__ __forceinline__ int opaque_tid() { int t = threadIdx.x; asm volatile("" : "+v"(t)); return t; }
namespace pg8 {
#define PG8_LAS __attribute__((address_space(3)))
typedef unsigned short bf16_t;
typedef short bf16x8 __attribute__((ext_vector_type(8)));
typedef float f32x4 __attribute__((ext_vector_type(4)));
typedef unsigned u32x4 __attribute__((ext_vector_type(4)));
constexpr int BM = 256, BK = 64, HALF = 128, HTB = HALF * BK * 2  , STAGE_BYTES = 8 * HTB, NXCD = 8, WGM = 8;

__host__ __device__ __forceinline__ int lds_byte(int r, int c) { const int st = (r >> 4) * 2 + (c >> 5), rr = r & 15, cc = c & 31, ob = rr * 64 + cc * 2; return st * 1024 + (ob ^ (((ob >> 9) & 1) << 5)); }
__host__ __device__ __forceinline__ void stage_rc(int b, int& R, int& C) { const int st = b / 1024, sb = b % 1024, swz = sb ^ (((sb >> 9) & 1) << 5); R = (st >> 1) * 16 + swz / 64; C = (st & 1) * 32 + (swz % 64) / 2; }
__host__ __device__ __forceinline__ int perm32(int rho) { const int n = rho >> 4, i = rho & 15; return 8 * (i >> 2) + 4 * n + (i & 3); }

struct Unit { int pm, pn; };
struct Gemm { const bf16_t* A; const bf16_t* Bt; int M, N, K, lda, ldb; };

struct StaticOrder {
    int nM, nN, nwg, G, c;
    __host__ __device__ void init(int M, int N, int G_, int c_) { nM = M / BM; nN = N / BM; nwg = nM * nN; G = G_; c = c_; }
    __host__ __device__ bool next(int i, Unit& u) const {
        const long L = (long)i * G + c; if (L >= nwg) return false;
        int wgid = (int)L; { const int q = nwg / NXCD, r = nwg % NXCD, xcd = wgid % NXCD, off = wgid / NXCD; wgid = (xcd < r ? xcd * (q + 1) : r * (q + 1) + (xcd - r) * q) + off; }
        const int nig = WGM * nN, gid = wgid / nig, fm = gid * WGM, gsz = (nM - fm) < WGM ? (nM - fm) : WGM;
        u.pm = fm + ((wgid % nig) % gsz); u.pn = (wgid % nig) / gsz; return true;
    }
    __device__ __forceinline__ void a_ready(const Unit&) const {}
    __device__ __forceinline__ void done(const Unit&) const {}
};

__device__ __forceinline__ unsigned cvt_pk_bf16(float lo, float hi) { unsigned r; asm volatile("v_cvt_pk_bf16_f32 %0, %1, %2" : "=v"(r) : "v"(lo), "v"(hi)); return r; }
template <int ACT  > struct EpiBf {
    static constexpr bool PERM = true, AFTER_DRAIN = false;
    bf16_t* O; int ldc;
    __device__ __forceinline__ void operator()(const f32x4 (&acc)[2][2][4][2], const Unit& u, int wr, int wc, int fr, int fq) const {
        const int row0 = u.pm * BM + wr * 64 + fr, col0 = u.pn * BM + wc * 32 + 8 * fq;
#pragma unroll
        for (int ai = 0; ai < 2; ++ai)
#pragma unroll
            for (int m = 0; m < 4; ++m) { bf16_t* rowp = O + (size_t)(row0 + ai * HALF + m * 16) * ldc + col0;
#pragma unroll
                for (int bj = 0; bj < 2; ++bj) { f32x4 v0 = acc[ai][bj][m][0], v1 = acc[ai][bj][m][1];
                    if (ACT == 1) {
#pragma unroll
                        for (int e = 0; e < 4; ++e) { float a = v0[e] > 0.f ? v0[e] : 0.f; v0[e] = a * a; float b = v1[e] > 0.f ? v1[e] : 0.f; v1[e] = b * b; } }
                    u32x4 w; w.x = cvt_pk_bf16(v0[0], v0[1]); w.y = cvt_pk_bf16(v0[2], v0[3]); w.z = cvt_pk_bf16(v1[0], v1[1]); w.w = cvt_pk_bf16(v1[2], v1[3]);
                    *(u32x4*)(rowp + bj * HALF) = w; } }
    }
};
struct EpiRes {
    static constexpr bool PERM = false, AFTER_DRAIN = false;
    float* X; const float* gate;
    __device__ __forceinline__ void operator()(const f32x4 (&acc)[2][2][4][2], const Unit& u, int wr, int wc, int fr, int fq) const {
        const int row0 = u.pm * BM + wr * 64 + fr, col0 = u.pn * BM + wc * 32 + 4 * fq;
        const int cond = u.pm < 32 ? 0 : 1 + ((u.pm - 32) >> 2);
        const float* gp = gate + cond * 6144 + col0;
        f32x4 gv[2][2];
#pragma unroll
        for (int bj = 0; bj < 2; ++bj)
#pragma unroll
            for (int n = 0; n < 2; ++n) gv[bj][n] = *(const f32x4*)(gp + bj * HALF + n * 16);
#pragma unroll
        for (int ai = 0; ai < 2; ++ai)
#pragma unroll
            for (int m = 0; m < 4; ++m) { float* rowp = X + (size_t)(row0 + ai * HALF + m * 16) * 1024 + col0;
#pragma unroll
                for (int bj = 0; bj < 2; ++bj)
#pragma unroll
                    for (int n = 0; n < 2; ++n) { f32x4* q = (f32x4*)(rowp + bj * HALF + n * 16); *q = *q + gv[bj][n] * acc[ai][bj][m][n]; } }
    }
};
struct EpiFnet {
    static constexpr bool PERM = true, AFTER_DRAIN = false;
    bf16_t* MIX; int rowbase, L;
    __device__ __forceinline__ void operator()(const f32x4 (&acc)[2][2][4][2], const Unit& u, int wr, int wc, int fr, int fq) const {
        const int row0 = u.pm * BM + wr * 64 + fr, colw = wc * 32 + 8 * fq;
        bf16_t* base = MIX + (size_t)(rowbase + u.pn * L) * 1024 + 512 + colw;
#pragma unroll
        for (int ai = 0; ai < 2; ++ai)
#pragma unroll
            for (int m = 0; m < 4; ++m) { bf16_t* rowp = base + (size_t)(row0 + ai * HALF + m * 16) * 1024;
#pragma unroll
                for (int bj = 0; bj < 2; ++bj) { const f32x4 v0 = acc[ai][bj][m][0], v1 = acc[ai][bj][m][1];
                    u32x4 w; w.x = cvt_pk_bf16(v0[0], v0[1]); w.y = cvt_pk_bf16(v0[2], v0[3]); w.z = cvt_pk_bf16(v1[0], v1[1]); w.w = cvt_pk_bf16(v1[2], v1[3]);
                    *(u32x4*)(rowp + bj * HALF) = w; } }
    }
};

struct EpiAny {
    static constexpr bool AFTER_DRAIN = false;
    int mode; bool PERM; void* out; const float* aux; int i0, i1;
    __device__ __forceinline__ void operator()(const f32x4 (&acc)[2][2][4][2], const Unit& u, int wr, int wc, int fr, int fq) const {
        if (mode == 0) { const EpiBf<0> e{(bf16_t*)out, i0}; e(acc, u, wr, wc, fr, fq); }
        else if (mode == 1) { const EpiBf<1> e{(bf16_t*)out, i0}; e(acc, u, wr, wc, fr, fq); }
        else if (mode == 2) { const EpiRes e{(float*)out, aux}; e(acc, u, wr, wc, fr, fq); }
        else { const EpiFnet e{(bf16_t*)out, i0, i1}; e(acc, u, wr, wc, fr, fq); }
    }
};
template <class Epi, class Sched, bool ALIGN_EPI = false, bool SP2 = false>
__device__ __forceinline__ void gemm_phase(PG8_LAS unsigned char* lds, const Gemm g, const Sched& S, const Epi& E) {
    const int tid = opaque_tid(), wid = __builtin_amdgcn_readfirstlane(tid >> 6), lane = tid & 63, wr = wid >> 2, wc = wid & 3, fr = lane & 15, fq = lane >> 4;
    const int K = g.K, nt = K / BK;
    unsigned voffA[2], voffB[2];
#pragma unroll
    for (int i = 0; i < 2; ++i) { int R, C; stage_rc(tid * 16 + i * 8192, R, C); const int Rb = E.PERM ? ((R & ~31) + perm32(R & 31)) : R;
        voffA[i] = (unsigned)(R * g.lda + C) * 2u; voffB[i] = (unsigned)(Rb * g.ldb + C) * 2u; }
    const size_t kstep = (size_t)(BK * 2);
    const size_t hstepA = (size_t)HALF * g.lda * 2, hstepB = (size_t)HALF * g.ldb * 2;
    const size_t tstepA = 2 * hstepA, tstepB = 2 * hstepB;
    const unsigned ldsw = (unsigned)wid * 1024u;
    const int aoff = lds_byte(wr * 64 + fr, fq * 8), boff = lds_byte(wc * 32 + fr, fq * 8);
#define PG8_SA(b, h) (((b) * 2 + (h)) * HTB)
#define PG8_SB(b, h) ((4 + (b) * 2 + (h)) * HTB)
#define PG8_STAGE(bufoff, gbase, voff) do { _Pragma("unroll") for (int _i = 0; _i < 2; ++_i) \
        __builtin_amdgcn_global_load_lds((const unsigned*)((const char*)(gbase) + (voff)[_i]), (PG8_LAS unsigned*)(lds + (bufoff) + ldsw + _i * 8192), 16, 0, 0); } while (0)
#define PG8_LDA(dst, b, h) do { _Pragma("unroll") for (int m = 0; m < 4; ++m) _Pragma("unroll") for (int k = 0; k < 2; ++k) dst[m][k] = *(const PG8_LAS bf16x8*)(lds + PG8_SA(b, h) + aoff + m * 2048 + k * 1024); } while (0)
#define PG8_LDB(dst, b, h) do { _Pragma("unroll") for (int n = 0; n < 2; ++n) _Pragma("unroll") for (int k = 0; k < 2; ++k) dst[n][k] = *(const PG8_LAS bf16x8*)(lds + PG8_SB(b, h) + boff + n * 2048 + k * 1024); } while (0)
#define PG8_MMA(ai, bj, At, Bt) do { __builtin_amdgcn_s_setprio(1); _Pragma("unroll") for (int m = 0; m < 4; ++m) _Pragma("unroll") for (int n = 0; n < 2; ++n) _Pragma("unroll") for (int k = 0; k < 2; ++k) \
        acc[ai][bj][m][n] = __builtin_amdgcn_mfma_f32_16x16x32_bf16(Bt[n][k], At[m][k], acc[ai][bj][m][n], 0, 0, 0); __builtin_amdgcn_s_setprio(0); } while (0)
#define PG8_WAIT_V(n) asm volatile("s_waitcnt vmcnt(" #n ")" ::: "memory")
#define PG8_WAIT_L(n) asm volatile("s_waitcnt lgkmcnt(" #n ")" ::: "memory")
#define PG8_BAR __builtin_amdgcn_s_barrier()
#define PG8_SCHED __builtin_amdgcn_sched_barrier(0)
    Unit cur, nxt; int ui = 0;
    if (!S.next(0, cur)) return;
    f32x4 acc[2][2][4][2];
#pragma unroll
    for (int a = 0; a < 2; ++a)
#pragma unroll
        for (int b = 0; b < 2; ++b)
#pragma unroll
            for (int m = 0; m < 4; ++m)
#pragma unroll
                for (int n = 0; n < 2; ++n) acc[a][b][m][n] = (f32x4){0.f, 0.f, 0.f, 0.f};
    bf16x8 At[4][2], B0[2][2], B1[2][2];
    const char* cA = (const char*)g.A + (size_t)cur.pm * tstepA; const char* cB = (const char*)g.Bt + (size_t)cur.pn * tstepB;
    S.a_ready(cur);
    if constexpr (SP2) {
        PG8_STAGE(PG8_SB(0, 0), cB, voffB); PG8_STAGE(PG8_SB(0, 1), cB + hstepB, voffB); PG8_STAGE(PG8_SA(0, 0), cA, voffA); PG8_STAGE(PG8_SA(0, 1), cA + hstepA, voffA);
        if (wr == 1) PG8_BAR;
        PG8_WAIT_V(2); PG8_BAR;
        PG8_STAGE(PG8_SB(1, 0), cB + kstep, voffB); PG8_STAGE(PG8_SA(1, 0), cA + kstep, voffA); PG8_STAGE(PG8_SB(1, 1), cB + hstepB + kstep, voffB);
        PG8_WAIT_V(6); PG8_BAR;
    } else {
        PG8_STAGE(PG8_SB(0, 0), cB, voffB); PG8_STAGE(PG8_SA(0, 0), cA, voffA); PG8_STAGE(PG8_SB(0, 1), cB + hstepB, voffB); PG8_STAGE(PG8_SA(0, 1), cA + hstepA, voffA);
        if (wr == 1) PG8_BAR;
        PG8_WAIT_V(4); PG8_BAR;
        PG8_STAGE(PG8_SB(1, 0), cB + kstep, voffB); PG8_STAGE(PG8_SA(1, 0), cA + kstep, voffA); PG8_STAGE(PG8_SB(1, 1), cB + hstepB + kstep, voffB);
        PG8_WAIT_V(6); PG8_BAR;
    }
    for (;;) {
        const bool has_next = S.next(ui + 1, nxt);
        const char* nA = has_next ? (const char*)g.A + (size_t)nxt.pm * tstepA : cA; const char* nB = has_next ? (const char*)g.Bt + (size_t)nxt.pn * tstepB : cB;
        for (int t = 0; t < nt; t += 2) {
            const bool last = (t == nt - 2);
            const char* a1 = cA + (size_t)(t + 1) * kstep;
            const char* a2 = last ? nA : cA + (size_t)(t + 2) * kstep; const char* b2 = last ? nB : cB + (size_t)(t + 2) * kstep;
            const char* a3 = a2 + kstep; const char* b3 = b2 + kstep;
            if (last && has_next) S.a_ready(nxt);
            if constexpr (SP2) {
            PG8_LDB(B0, 0, 0); PG8_LDB(B1, 0, 1); PG8_SCHED; PG8_LDA(At, 0, 0); PG8_STAGE(PG8_SA(1, 1), a1 + hstepA, voffA);
            PG8_WAIT_V(8); PG8_WAIT_L(0); PG8_BAR; PG8_MMA(0, 0, At, B0); PG8_MMA(0, 1, At, B1); PG8_BAR; PG8_SCHED;
            PG8_LDA(At, 0, 1); PG8_STAGE(PG8_SB(0, 0), b2, voffB); PG8_STAGE(PG8_SB(0, 1), b2 + hstepB, voffB); PG8_STAGE(PG8_SA(0, 0), a2, voffA);
            PG8_WAIT_V(8); PG8_WAIT_L(0); PG8_BAR; PG8_MMA(1, 0, At, B0); PG8_MMA(1, 1, At, B1); PG8_BAR; PG8_SCHED;
            PG8_LDB(B0, 1, 0); PG8_LDB(B1, 1, 1); PG8_SCHED; PG8_LDA(At, 1, 0); PG8_STAGE(PG8_SA(0, 1), a2 + hstepA, voffA);
            PG8_WAIT_V(8); PG8_WAIT_L(0); PG8_BAR; PG8_MMA(0, 0, At, B0); PG8_MMA(0, 1, At, B1); PG8_BAR; PG8_SCHED;
            PG8_LDA(At, 1, 1); PG8_STAGE(PG8_SB(1, 0), b3, voffB); PG8_STAGE(PG8_SB(1, 1), b3 + hstepB, voffB); PG8_STAGE(PG8_SA(1, 0), a3, voffA);
            PG8_WAIT_V(8); PG8_WAIT_L(0); PG8_BAR; PG8_MMA(1, 0, At, B0); PG8_MMA(1, 1, At, B1); PG8_BAR; PG8_SCHED;
            } else {
            PG8_LDB(B0, 0, 0); PG8_SCHED; PG8_LDA(At, 0, 0); PG8_STAGE(PG8_SA(1, 1), a1 + hstepA, voffA);
            PG8_WAIT_L(8); PG8_BAR; PG8_WAIT_L(0); PG8_MMA(0, 0, At, B0); PG8_BAR; PG8_SCHED;
            PG8_LDB(B1, 0, 1); PG8_STAGE(PG8_SB(0, 0), b2, voffB);
            PG8_BAR; PG8_WAIT_L(0); PG8_MMA(0, 1, At, B1); PG8_BAR;
            PG8_LDA(At, 0, 1); PG8_STAGE(PG8_SA(0, 0), a2, voffA);
            PG8_BAR; PG8_WAIT_L(0); PG8_MMA(1, 0, At, B0); PG8_BAR; PG8_SCHED;
            PG8_STAGE(PG8_SB(0, 1), b2 + hstepB, voffB);
            PG8_WAIT_V(6); PG8_BAR; PG8_MMA(1, 1, At, B1); PG8_BAR;
            PG8_LDB(B0, 1, 0); PG8_SCHED; PG8_LDA(At, 1, 0); PG8_STAGE(PG8_SA(0, 1), a2 + hstepA, voffA);
            PG8_WAIT_L(8); PG8_BAR; PG8_WAIT_L(0); PG8_MMA(0, 0, At, B0); PG8_BAR; PG8_SCHED;
            PG8_LDB(B1, 1, 1); PG8_STAGE(PG8_SB(1, 0), b3, voffB);
            PG8_BAR; PG8_WAIT_L(0); PG8_MMA(0, 1, At, B1); PG8_BAR;
            PG8_LDA(At, 1, 1); PG8_STAGE(PG8_SA(1, 0), a3, voffA);
            PG8_BAR; PG8_WAIT_L(0); PG8_MMA(1, 0, At, B0); PG8_BAR; PG8_SCHED;
            PG8_STAGE(PG8_SB(1, 1), b3 + hstepB, voffB);
            PG8_WAIT_V(6); PG8_BAR; PG8_MMA(1, 1, At, B1); PG8_BAR;
            }
        }
        if constexpr (ALIGN_EPI) { if (wr == 0) PG8_BAR; }
        if constexpr (!Epi::AFTER_DRAIN) { E(acc, cur, wr, wc, fr, fq); S.done(cur); }
        if (!has_next) break;
#pragma unroll
        for (int a = 0; a < 2; ++a)
#pragma unroll
            for (int b = 0; b < 2; ++b)
#pragma unroll
                for (int m = 0; m < 4; ++m)
#pragma unroll
                    for (int n = 0; n < 2; ++n) acc[a][b][m][n] = (f32x4){0.f, 0.f, 0.f, 0.f};
        cur = nxt; cA = nA; cB = nB; ++ui;
        if constexpr (ALIGN_EPI) { if (wr == 1) PG8_BAR; }
    }
    PG8_WAIT_V(0);
    if constexpr (!ALIGN_EPI) { if (wr == 0) PG8_BAR; }
    PG8_BAR;
    if constexpr (Epi::AFTER_DRAIN) { E.fused(acc, cur, wr, wc, fr, fq, lds, wid, lane); S.done(cur); }
#undef PG8_SA
#undef PG8_SB
#undef PG8_STAGE
#undef PG8_LDA
#undef PG8_LDB
#undef PG8_MMA
#undef PG8_WAIT_V
#undef PG8_WAIT_L
#undef PG8_BAR
#undef PG8_SCHED
}
}

#define LAS __attribute__((address_space(3)))
typedef unsigned short bf16;
typedef float f32x4 __attribute__((ext_vector_type(4)));
typedef unsigned u32x4 __attribute__((ext_vector_type(4)));
typedef unsigned u32x2 __attribute__((ext_vector_type(2)));
constexpr int DM = 1024, NCTX = 8192, MTOK = 12288, DINP = 2560, DFF = 4096;
constexpr int R_OFF = 0, K_OFF = 512, V_OFF = 1024, WD_OFF = 1536, AD_OFF = 1664, GD_OFF = 1792, F_OFF = 1920, P_OFF = 2176, DIN = 2432;
constexpr size_t MiB = 1u << 20;
constexpr size_t WS_CTL = 0, WS_MOD = 1 * MiB, WS_FW = 1 * MiB + 512 * 1024, WS_BC = 2 * MiB, WS_CS256 = 3 * MiB, WS_CS1024 = 4 * MiB, WS_WIN = 8 * MiB, WS_WOUT = 18 * MiB,
                 WS_W1 = 22 * MiB, WS_W2 = 38 * MiB, WS_H = 54 * MiB, WS_MIXED = 78 * MiB, WS_PROJ = 102 * MiB, WS_YCS = 162 * MiB, WS_YF = 174 * MiB, WS_YB = 198 * MiB,
                 WS_FF = 102 * MiB, WS_END = 222 * MiB;
constexpr int LDS_BYTES = 147456, RING_BYTES = 131072, MISC_OFF = RING_BYTES + 320;
constexpr int NTHR = 512;
enum { I_XP = 0, I_XS, I_STATE, I_C, I_CCTX, I_WADA, I_BADA, I_N1G, I_WIN, I_MU, I_W0, I_WUP, I_A0, I_AUP, I_GUP, I_KK, I_KA, I_RK, I_LNW, I_LNB, I_WFNET, I_WPOOL, I_PSCALE, I_WOUT, I_N2G, I_WFF1, I_WFF2, I_FNG, N_IN };
struct KP { const float* in[N_IN]; float* out; unsigned char* ws; int ph_lo, ph_hi; };
typedef const __attribute__((address_space(4))) KP CKP;

__device__ __forceinline__ unsigned f2bf(float f) { unsigned u = __builtin_bit_cast(unsigned, f); return (u + 0x7fffu + ((u >> 16) & 1u)) >> 16; }
__device__ __forceinline__ unsigned pk2(float lo, float hi) { return f2bf(lo) | (f2bf(hi) << 16); }
__device__ __forceinline__ float bflo(unsigned w) { return __builtin_bit_cast(float, w << 16); }
__device__ __forceinline__ float bfhi(unsigned w) { return __builtin_bit_cast(float, w & 0xffff0000u); }
__device__ __forceinline__ float bf1(bf16 h) { return __builtin_bit_cast(float, (unsigned)h << 16); }
template <int CTRL> __device__ __forceinline__ float dppf(float x) { return __builtin_bit_cast(float, __builtin_amdgcn_update_dpp(0, __builtin_bit_cast(int, x), CTRL, 0xF, 0xF, true)); }
__device__ __forceinline__ float red8(float x)  { x += dppf<0xB1>(x); x += dppf<0x4E>(x); x += dppf<0x141>(x); return x; }
__device__ __forceinline__ float red16(float x) { x += dppf<0xB1>(x); x += dppf<0x4E>(x); x += dppf<0x141>(x); x += dppf<0x140>(x); return x; }
__device__ __forceinline__ float wave_sum(float v) {
#pragma unroll
    for (int o = 1; o < 64; o <<= 1) v += __shfl_xor(v, o);
    return v;
}
__device__ __forceinline__ void load4bf(const bf16* p, float (&o)[4]) { const u32x2 w = *(const u32x2*)p; o[0] = bflo(w.x); o[1] = bfhi(w.x); o[2] = bflo(w.y); o[3] = bfhi(w.y); }
__device__ __forceinline__ void load8bf(const bf16* p, float (&o)[8]) { const u32x4 w = *(const u32x4*)p; o[0] = bflo(w.x); o[1] = bfhi(w.x); o[2] = bflo(w.y); o[3] = bfhi(w.y); o[4] = bflo(w.z); o[5] = bfhi(w.z); o[6] = bflo(w.w); o[7] = bfhi(w.w); }
__device__ __forceinline__ void shift4(const bf16* proj, int row, bool hasp, bool hasn, int col, const float* mu, float (&u)[4]) {
    float p[4], a[4] = {0.f, 0.f, 0.f, 0.f}, b[4] = {0.f, 0.f, 0.f, 0.f};
    load4bf(proj + (size_t)row * DINP + col, p);
    if (hasp) load4bf(proj + (size_t)(row - 1) * DINP + col, a);
    if (hasn) load4bf(proj + (size_t)(row + 1) * DINP + col, b);
    const f32x4 m = *(const f32x4*)(mu + col);
#pragma unroll
    for (int j = 0; j < 4; ++j) u[j] = p[j] + m[j] * (0.5f * (a[j] + b[j]) - p[j]);
}

__device__ __forceinline__ void transpose_item(const float* W, int K, int N, bf16* WT, LAS float* scr, int item, int lane) {
    const int nblk = N / 32, kb = item / nblk, nb = item % nblk, k0 = 64 * kb, n0 = 32 * nb;
#pragma unroll 8
    for (int i = 0; i < 32; ++i) { const int kk = 2 * i + (lane >> 5); scr[kk * 33 + (lane & 31)] = W[(size_t)(k0 + kk) * N + n0 + (lane & 31)]; }
    asm volatile("s_waitcnt lgkmcnt(0)" ::: "memory");
    const int c = lane & 7;
#pragma unroll
    for (int j = 0; j < 4; ++j) { const int n = (lane >> 3) + 8 * j; const LAS float* s = scr + (8 * c) * 33 + n;
        u32x4 o; o.x = pk2(s[0 * 33], s[1 * 33]); o.y = pk2(s[2 * 33], s[3 * 33]); o.z = pk2(s[4 * 33], s[5 * 33]); o.w = pk2(s[6 * 33], s[7 * 33]);
        *(u32x4*)(WT + (size_t)(n0 + n) * K + k0 + 8 * c) = o; }
    asm volatile("s_waitcnt lgkmcnt(0)" ::: "memory");
}
__device__ __forceinline__ void stage_prologue(CKP& p, LAS unsigned char* lds, int bid, int nb) {
    const int tid = opaque_tid(), lane = tid & 63, wave = tid >> 6;
    unsigned char* ws = p.ws;
    {
        LAS float* scr = (LAS float*)(lds + wave * 16384);
        const int gw = bid * 8 + wave, NGW = nb * 8;
        constexpr int I_IN = 16 * 76, I_OUT = 16 * 32, I_1 = 16 * 128, I_2 = 64 * 32, I_L = I_IN + I_OUT + I_1 + I_2;
        for (int it = gw; it < 2 * I_L; it += NGW) {
            const int l = it / I_L; int r = it % I_L;
            if (r < I_IN) { transpose_item(p.in[I_WIN] + (size_t)l * DM * DIN, DM, DIN, (bf16*)(ws + WS_WIN) + (size_t)l * DINP * DM, scr, r, lane); continue; } r -= I_IN;
            if (r < I_OUT) { transpose_item(p.in[I_WOUT] + (size_t)l * DM * DM, DM, DM, (bf16*)(ws + WS_WOUT) + (size_t)l * DM * DM, scr, r, lane); continue; } r -= I_OUT;
            if (r < I_1) { transpose_item(p.in[I_WFF1] + (size_t)l * DM * DFF, DM, DFF, (bf16*)(ws + WS_W1) + (size_t)l * DFF * DM, scr, r, lane); continue; } r -= I_1;
            transpose_item(p.in[I_WFF2] + (size_t)l * DFF * DM, DFF, DM, (bf16*)(ws + WS_W2) + (size_t)l * DM * DFF, scr, r, lane);
        }
    }
    const int gt = bid * NTHR + tid, NGT = nb * NTHR;
    for (int i = gt; i < 2 * 128 * DM / 8; i += NGT) { const int l = i / (128 * DM / 8), r = i % (128 * DM / 8);
        *(u32x4*)((bf16*)(ws + WS_WIN) + (size_t)l * DINP * DM + (size_t)DIN * DM + (size_t)r * 8) = (u32x4){0u, 0u, 0u, 0u}; }
    for (int i = gt; i < 256 * 512 + 1024 * 2048; i += NGT) {
        int L, k, j; bf16* dst;
        if (i < 256 * 512) { L = 256; k = i / 512; j = i % 512; dst = (bf16*)(ws + WS_CS256) + i; }
        else { const int i2 = i - 256 * 512; L = 1024; k = i2 / 2048; j = i2 % 2048; dst = (bf16*)(ws + WS_CS1024) + i2; }
        const int jj = j >= L ? j - L : j; const int idx = (k * jj) & (L - 1);
        float s, c; sincospif(2.0f * (float)idx / (float)L, &s, &c);
        *dst = (bf16)f2bf(j >= L ? -s : c);
    }
    for (int i = gt; i < 2 * 4 * 64 * 128; i += NGT) {
        const int o = i & 127, c = (i >> 7) & 63, lg = i >> 13; const float* wf = p.in[I_WFNET] + (size_t)lg * 4096 + (o & 63);
        float acc = 0.f;
        for (int cp = 0; cp < 64; ++cp) { float s, co; sincospif(2.0f * (float)((c * cp) & 63) / 64.0f, &s, &co); acc += (o < 64 ? co : s) * wf[cp * 64]; }
        ((float*)(ws + WS_FW))[i] = acc;
    }
    for (int i = gt; i < MTOK * DM / 4; i += NGT) {
        const f32x4 v = i < NCTX * DM / 4 ? ((const f32x4*)p.in[I_XP])[i] : ((const f32x4*)p.in[I_XS])[i - NCTX * DM / 4];
        ((f32x4*)p.out)[i] = v;
    }
    __syncthreads();
    LAS float* sc = (LAS float*)lds; LAS float* red = (LAS float*)(lds + 20480);
    for (int it = bid; it < 192; it += nb) {
        const int l = it / 96, cgp = it % 96;
        for (int i = tid; i < 5 * 1024; i += NTHR) { const int cond = i >> 10, k = i & 1023; const float v = cond == 0 ? p.in[I_CCTX][k] : p.in[I_C][(cond - 1) * 1024 + k]; sc[i] = v / (1.0f + __expf(-v)); }
        __syncthreads();
        const int cgi = tid & 15, kg = tid >> 4;
        f32x4 acc[5];
#pragma unroll
        for (int c = 0; c < 5; ++c) acc[c] = (f32x4){0.f, 0.f, 0.f, 0.f};
        const float* wp = p.in[I_WADA] + ((size_t)l * 1024 + kg * 32) * 6144 + cgp * 64 + cgi * 4;
#pragma unroll 4
        for (int kk = 0; kk < 32; ++kk) { const f32x4 w = *(const f32x4*)(wp + (size_t)kk * 6144);
#pragma unroll
            for (int c = 0; c < 5; ++c) acc[c] += sc[c * 1024 + kg * 32 + kk] * w; }
#pragma unroll
        for (int c = 0; c < 5; ++c) *(LAS f32x4*)(red + (kg * 5 + c) * 64 + cgi * 4) = acc[c];
        __syncthreads();
        if (tid < 320) { const int cond = tid >> 6, col = tid & 63; float s = p.in[I_BADA][l * 6144 + cgp * 64 + col];
            for (int g = 0; g < 32; ++g) s += red[(g * 5 + cond) * 64 + col];
            ((float*)(ws + WS_MOD))[(l * 5 + cond) * 6144 + cgp * 64 + col] = s; }
        __syncthreads();
    }
}

__device__ __forceinline__ void stage_norm(CKP& p, int l, int which, int bid, int nb) {
    const int tid = opaque_tid(), lane = tid & 63, wave = tid >> 6;
    const float* g = p.in[which ? I_N2G : I_N1G] + l * DM;
    const float* mod = (const float*)(p.ws + WS_MOD) + (size_t)l * 5 * 6144 + (which ? 3 * 1024 : 0);
    bf16* H = (bf16*)(p.ws + WS_H);
    for (int row = bid * 8 + wave; row < MTOK; row += nb * 8) {
        const f32x4* xr = (const f32x4*)(p.out + (size_t)row * DM) + lane;
        f32x4 v[4]; float s = 0.f;
#pragma unroll
        for (int j = 0; j < 4; ++j) { v[j] = xr[64 * j]; s += (v[j].x * v[j].x + v[j].y * v[j].y) + (v[j].z * v[j].z + v[j].w * v[j].w); }
        const float rstd = 1.0f / sqrtf(wave_sum(s) * (1.0f / DM) + 1e-6f);
        const int cond = row < NCTX ? 0 : 1 + ((row - NCTX) >> 10);
        const float* sh = mod + cond * 6144; const float* scl = sh + 1024;
        unsigned long long* o8 = (unsigned long long*)(H + (size_t)row * DM) + lane;
#pragma unroll
        for (int j = 0; j < 4; ++j) { const int col = 4 * lane + 256 * j; const f32x4 gg = *(const f32x4*)(g + col), a = *(const f32x4*)(sh + col), b = *(const f32x4*)(scl + col);
            const f32x4 y = v[j] * rstd * gg * (b + 1.0f) + a;
            o8[64 * j] = (unsigned long long)pk2(y.x, y.y) | ((unsigned long long)pk2(y.z, y.w) << 32); }
    }
}
__device__ __forceinline__ void stage_final(CKP& p, int bid, int nb) {
    const int tid = opaque_tid(), lane = tid & 63, wave = tid >> 6;
    const float* g = p.in[I_FNG];
    for (int row = bid * 8 + wave; row < MTOK; row += nb * 8) {
        f32x4* xr = (f32x4*)(p.out + (size_t)row * DM) + lane;
        f32x4 v[4]; float s = 0.f;
#pragma unroll
        for (int j = 0; j < 4; ++j) { v[j] = xr[64 * j]; s += (v[j].x * v[j].x + v[j].y * v[j].y) + (v[j].z * v[j].z + v[j].w * v[j].w); }
        const float rstd = 1.0f / sqrtf(wave_sum(s) * (1.0f / DM) + 1e-6f);
#pragma unroll
        for (int j = 0; j < 4; ++j) xr[64 * j] = v[j] * rstd * *(const f32x4*)(g + 4 * lane + 256 * j);
    }
}

__device__ __forceinline__ void rwkv_item(CKP& p, int l, LAS unsigned char* lds, int item) {
    const int tid = opaque_tid();
    int bseq, h, dir, L, base; bool lat;
    if (item < 64) { lat = true; bseq = item >> 4; h = (item >> 1) & 7; dir = item & 1; L = 1024; base = NCTX + bseq * 1024; }
    else { const int i2 = item - 64; lat = false; bseq = i2 >> 4; h = (i2 >> 1) & 7; dir = i2 & 1; L = 256; base = bseq * 256; }
    const bf16* proj = (const bf16*)(p.ws + WS_PROJ);
    const float* mu = p.in[I_MU] + l * 1920;
    LAS float* WUP = (LAS float*)lds;
    LAS float* AUP = WUP + 4096;
    LAS float* WD = AUP + 4096;
    LAS float* AD = WD + 2048;
    LAS float* VA = AD + 2048;
    LAS float* VQ = VA + 2048; LAS float* VW = VQ + 2048; LAS float* VB = VW + 2048; LAS float* VK = VB + 2048; LAS float* VV = VK + 2048;
    LAS float* YS = VV + 2048;
    LAS float* BR = YS + 2048;
    LAS float* KR = BR + 32;
    for (int i = tid; i < 4096; i += NTHR) { const int r = i >> 6, c = i & 63;
        WUP[i] = p.in[I_WUP][((size_t)(l * 2 + dir) * 64 + r) * 512 + h * 64 + c];
        AUP[i] = p.in[I_AUP][((size_t)(l * 2 + dir) * 64 + r) * 512 + h * 64 + c]; }
    const int row = tid >> 3, k8 = (tid & 7) * 8;
    float s[8];
    if (lat) { const float* sp = p.in[I_STATE] + ((((size_t)bseq * 2 + l) * 2 + dir) * 8 + h) * 4096 + row * 64 + k8;
#pragma unroll
        for (int j = 0; j < 8; ++j) s[j] = sp[j]; }
    else {
#pragma unroll
        for (int j = 0; j < 8; ++j) s[j] = 0.f; }
    const int ti = tid >> 4, c4 = (tid & 15) * 4, hc = h * 64 + c4;
    const f32x4 w0v = *(const f32x4*)(p.in[I_W0] + (l * 2 + dir) * 512 + hc), a0v = *(const f32x4*)(p.in[I_A0] + (l * 2 + dir) * 512 + hc);
    const f32x4 kkv = *(const f32x4*)(p.in[I_KK] + l * 512 + hc), kav = *(const f32x4*)(p.in[I_KA] + l * 512 + hc), rkv = *(const f32x4*)(p.in[I_RK] + l * 512 + hc);
    float* Yout = (float*)(p.ws + (dir ? WS_YB : WS_YF));
    float* BC = (float*)(p.ws + WS_BC) + (size_t)dir * MTOK * 8;
    __syncthreads();
    for (int ch = 0; ch < L / 32; ++ch) {
        const int step = ch * 32 + ti, t = dir ? L - 1 - step : step, grow = base + t;
        const bool hasp = t > 0, hasn = t < L - 1;
        { float u[4];
          shift4(proj, grow, hasp, hasn, WD_OFF + dir * 64 + c4, mu, u);
#pragma unroll
          for (int j = 0; j < 4; ++j) WD[ti * 64 + c4 + j] = tanhf(u[j]);
          shift4(proj, grow, hasp, hasn, AD_OFF + dir * 64 + c4, mu, u);
#pragma unroll
          for (int j = 0; j < 4; ++j) AD[ti * 64 + c4 + j] = u[j]; }
        __syncthreads();
        { f32x4 wp = w0v, ap = a0v;
#pragma unroll 8
          for (int r = 0; r < 64; ++r) { const float wd = WD[ti * 64 + r], ad = AD[ti * 64 + r];
              wp += wd * *(const LAS f32x4*)(WUP + r * 64 + c4); ap += ad * *(const LAS f32x4*)(AUP + r * 64 + c4); }
          float rr[4], kk[4], vv[4];
          shift4(proj, grow, hasp, hasn, R_OFF + hc, mu, rr); shift4(proj, grow, hasp, hasn, K_OFF + hc, mu, kk); shift4(proj, grow, hasp, hasn, V_OFF + hc, mu, vv);
          float dec[4], asg[4], kn[4], kd[4], ss = 0.f;
#pragma unroll
          for (int j = 0; j < 4; ++j) {
              const float z = -wp[j]; const float sp = z > 20.f ? z : log1pf(__expf(z));
              const float wlog = -sp - 0.5f; dec[j] = __expf(-__expf(wlog));
              asg[j] = 1.0f / (1.0f + __expf(-ap[j]));
              kn[j] = kk[j] * kkv[j]; ss += kn[j] * kn[j];
              kd[j] = kk[j] * (1.0f + (asg[j] - 1.0f) * kav[j]); }
          ss = red16(ss);
          const float inv = 1.0f / fmaxf(sqrtf(ss), 1e-12f);
          float br = 0.f, kr = 0.f, bc = 0.f; f32x4 va, vq, vw, vb, vk, v4;
#pragma unroll
          for (int j = 0; j < 4; ++j) { const float kj = kn[j] * inv, bj = kj * asg[j];
              va[j] = -kj; vq[j] = dec[j] * rr[j]; vw[j] = dec[j]; vb[j] = bj; vk[j] = kd[j]; v4[j] = vv[j];
              br += bj * rr[j]; kr += kd[j] * rr[j]; bc += rr[j] * kd[j] * rkv[j]; }
          br = red16(br); kr = red16(kr); bc = red16(bc);
          *(LAS f32x4*)(VA + ti * 64 + c4) = va; *(LAS f32x4*)(VQ + ti * 64 + c4) = vq; *(LAS f32x4*)(VW + ti * 64 + c4) = vw;
          *(LAS f32x4*)(VB + ti * 64 + c4) = vb; *(LAS f32x4*)(VK + ti * 64 + c4) = vk; *(LAS f32x4*)(VV + ti * 64 + c4) = v4;
          if ((tid & 15) == 0) { BR[ti] = br; KR[ti] = kr; BC[(size_t)grow * 8 + h] = bc; } }
        __syncthreads();
#pragma unroll 2
        for (int i = 0; i < 32; ++i) {
            const f32x4 a0 = *(const LAS f32x4*)(VA + i * 64 + k8), a1 = *(const LAS f32x4*)(VA + i * 64 + k8 + 4);
            const f32x4 q0 = *(const LAS f32x4*)(VQ + i * 64 + k8), q1 = *(const LAS f32x4*)(VQ + i * 64 + k8 + 4);
            const f32x4 w0 = *(const LAS f32x4*)(VW + i * 64 + k8), w1 = *(const LAS f32x4*)(VW + i * 64 + k8 + 4);
            const f32x4 b0 = *(const LAS f32x4*)(VB + i * 64 + k8), b1 = *(const LAS f32x4*)(VB + i * 64 + k8 + 4);
            const f32x4 kk0 = *(const LAS f32x4*)(VK + i * 64 + k8), kk1 = *(const LAS f32x4*)(VK + i * 64 + k8 + 4);
            const float vt = VV[i * 64 + row], brt = BR[i], krt = KR[i];
            float sa = 0.f, yp = 0.f;
#pragma unroll
            for (int j = 0; j < 4; ++j) { sa += s[j] * a0[j]; yp += s[j] * q0[j]; }
#pragma unroll
            for (int j = 0; j < 4; ++j) { sa += s[4 + j] * a1[j]; yp += s[4 + j] * q1[j]; }
            sa = red8(sa); yp = red8(yp);
#pragma unroll
            for (int j = 0; j < 4; ++j) { s[j] = s[j] * w0[j] + sa * b0[j] + vt * kk0[j]; s[4 + j] = s[4 + j] * w1[j] + sa * b1[j] + vt * kk1[j]; }
            if ((tid & 7) == 0) YS[i * 64 + row] = yp + sa * brt + vt * krt;
        }
        __syncthreads();
        *(f32x4*)(Yout + (size_t)grow * 512 + hc) = *(const LAS f32x4*)(YS + ti * 64 + c4);
    }
    if (!lat) { float* sp = p.out + (size_t)MTOK * DM + ((((size_t)bseq * 2 + l) * 2 + dir) * 8 + h) * 4096 + row * 64 + k8;
#pragma unroll
        for (int j = 0; j < 8; ++j) sp[j] = s[j]; }
    __syncthreads();
}

__device__ __forceinline__ void fnet1_item(CKP& p, int l, LAS unsigned char* lds, int item) {
    const int tid = opaque_tid(), tb = item >> 2, g = item & 3, tok0 = tb * 64;
    const bf16* proj = (const bf16*)(p.ws + WS_PROJ);
    LAS float* XT = (LAS float*)lds;
    LAS float* FWL = XT + 64 * 65;
    { const int ti = tid >> 3, c8 = (tid & 7) * 8; float x[8]; load8bf(proj + (size_t)(tok0 + ti) * DINP + F_OFF + g * 64 + c8, x);
#pragma unroll
      for (int j = 0; j < 8; ++j) XT[ti * 65 + c8 + j] = x[j]; }
    const float* fw = (const float*)(p.ws + WS_FW) + (size_t)(l * 4 + g) * 8192;
    for (int i = tid; i < 2048; i += NTHR) *(LAS f32x4*)(FWL + i * 4) = *(const f32x4*)(fw + i * 4);
    __syncthreads();
    const int ti = tid & 63, og = tid >> 6;
    f32x4 acc[4];
#pragma unroll
    for (int j = 0; j < 4; ++j) acc[j] = (f32x4){0.f, 0.f, 0.f, 0.f};
#pragma unroll 4
    for (int c = 0; c < 64; ++c) { const float x = XT[ti * 65 + c];
#pragma unroll
        for (int j = 0; j < 4; ++j) acc[j] += x * *(const LAS f32x4*)(FWL + c * 128 + og * 16 + j * 4); }
    const bool lat = tok0 >= NCTX;
    const int L = lat ? 1024 : 256, bq = lat ? (tok0 - NCTX) >> 10 : tok0 >> 8, t = (lat ? (tok0 - NCTX) & 1023 : tok0 & 255) + ti;
    const float scale = lat ? (1.0f / 256.0f) : (1.0f / 128.0f);
    bf16* Y = (bf16*)(p.ws + WS_YCS) + (lat ? (size_t)8192 * 512 : 0);
    const int cs = og >> 2, K2 = 2 * L;
#pragma unroll
    for (int j = 0; j < 4; ++j)
#pragma unroll
        for (int e = 0; e < 4; ++e) { const int d = (og & 3) * 16 + j * 4 + e;
            Y[(size_t)((bq * 4 + g) * 64 + d) * K2 + cs * L + t] = (bf16)f2bf(acc[j][e] * scale); }
    __syncthreads();
}

__device__ __forceinline__ void pool_item(CKP& p, int l, LAS unsigned char* lds, int item) {
    const int tid = opaque_tid(), tb = item >> 2, gi = item & 3, tok0 = tb * 64, hw = 1 << gi;
    const bf16* proj = (const bf16*)(p.ws + WS_PROJ);
    LAS float* DT = (LAS float*)lds;
    LAS float* WP = DT + 64 * 65;
    const float* wpool = p.in[I_WPOOL] + (size_t)(l * 4 + gi) * 4096;
    for (int i = tid; i < 1024; i += NTHR) *(LAS f32x4*)(WP + i * 4) = *(const f32x4*)(wpool + i * 4);
    const int ti = tid >> 3, c8 = (tid & 7) * 8, tok = tok0 + ti, col = P_OFF + gi * 64 + c8;
    { float sum[8], x[8];
#pragma unroll
      for (int j = 0; j < 8; ++j) sum[j] = 0.f;
      load8bf(proj + (size_t)tok * DINP + col, x);
      float cnt;
      if (tok < NCTX) { const int t = tok & 255, sb = tok - t, lo = max(t - hw, 0), hi = min(t + hw, 256);
          for (int q = lo; q < hi; ++q) { float y[8]; load8bf(proj + (size_t)(sb + q) * DINP + col, y);
#pragma unroll
              for (int j = 0; j < 8; ++j) sum[j] += y[j]; }
          cnt = (float)(hi - lo); }
      else { const int t = (tok - NCTX) & 1023, sb = tok - t, r = t >> 6, c = t & 63, rlo = max(r - hw, 0), rhi = min(r + hw, 16), clo = max(c - hw, 0), chi = min(c + hw, 64);
          for (int rq = rlo; rq < rhi; ++rq) for (int cq = clo; cq < chi; ++cq) { float y[8]; load8bf(proj + (size_t)(sb + rq * 64 + cq) * DINP + col, y);
#pragma unroll
              for (int j = 0; j < 8; ++j) sum[j] += y[j]; }
          cnt = (float)((rhi - rlo) * (chi - clo)); }
      const float ic = 1.0f / cnt;
#pragma unroll
      for (int j = 0; j < 8; ++j) DT[ti * 65 + c8 + j] = sum[j] * ic - x[j]; }
    __syncthreads();
    f32x4 a0 = (f32x4){0.f, 0.f, 0.f, 0.f}, a1 = a0;
#pragma unroll 4
    for (int c = 0; c < 64; ++c) { const float d = DT[ti * 65 + c]; a0 += d * *(const LAS f32x4*)(WP + c * 64 + c8); a1 += d * *(const LAS f32x4*)(WP + c * 64 + c8 + 4); }
    const float* ps = p.in[I_PSCALE] + l * 256 + gi * 64 + c8;
    const f32x4 s0 = *(const f32x4*)ps, s1 = *(const f32x4*)(ps + 4);
    a0 *= s0; a1 *= s1;
    u32x4 w; w.x = pk2(a0[0], a0[1]); w.y = pk2(a0[2], a0[3]); w.z = pk2(a1[0], a1[1]); w.w = pk2(a1[2], a1[3]);
    *(u32x4*)((bf16*)(p.ws + WS_MIXED) + (size_t)tok * DM + 768 + gi * 64 + c8) = w;
    __syncthreads();
}

__device__ __forceinline__ void post_item(CKP& p, int l, LAS unsigned char* lds, int item) {
    const int tid = opaque_tid(), tok0 = item * 16;
    const bf16* proj = (const bf16*)(p.ws + WS_PROJ);
    const float* mu = p.in[I_MU] + l * 1920;
    LAS float* SG = (LAS float*)lds;
    const bool lat = tok0 >= NCTX; const int L = lat ? 1024 : 256, tseq0 = lat ? (tok0 - NCTX) & 1023 : tok0 & 255;
    { const int ti = tid >> 5, r4 = (tid & 31) * 4, t = tseq0 + ti; float u[4];
      shift4(proj, tok0 + ti, t > 0, t < L - 1, GD_OFF + r4, mu, u);
#pragma unroll
      for (int j = 0; j < 4; ++j) SG[ti * 128 + r4 + j] = 1.0f / (1.0f + __expf(-u[j])); }
    __syncthreads();
    const int c = tid, head = tid >> 6;
    float g[16];
#pragma unroll
    for (int i = 0; i < 16; ++i) g[i] = 0.f;
    const float* gup = p.in[I_GUP] + (size_t)l * 128 * 512 + c;
    for (int r = 0; r < 128; r += 4) { const float w0 = gup[(r + 0) * 512], w1 = gup[(r + 1) * 512], w2 = gup[(r + 2) * 512], w3 = gup[(r + 3) * 512];
#pragma unroll
        for (int i = 0; i < 16; ++i) { const f32x4 sg = *(const LAS f32x4*)(SG + i * 128 + r); g[i] += (sg.x * w0 + sg.y * w1) + (sg.z * w2 + sg.w * w3); } }
    const float lnw = p.in[I_LNW][l * 512 + c], lnb = p.in[I_LNB][l * 512 + c], muv = mu[V_OFF + c];
    const float* YF = (const float*)(p.ws + WS_YF); const float* YB = (const float*)(p.ws + WS_YB);
    const float* BC0 = (const float*)(p.ws + WS_BC); const float* BC1 = BC0 + (size_t)MTOK * 8;
    bf16* MIX = (bf16*)(p.ws + WS_MIXED);
#pragma unroll 4
    for (int i = 0; i < 16; ++i) { const int tok = tok0 + i, t = tseq0 + i;
        const float y = YF[(size_t)tok * 512 + c] + YB[(size_t)tok * 512 + c];
        const float mean = wave_sum(y) * (1.0f / 64.0f), dlt = y - mean, var = wave_sum(dlt * dlt) * (1.0f / 64.0f);
        const float yn = dlt * (1.0f / sqrtf(var + 64e-5f)) * lnw + lnb;
        const float pv = bf1(proj[(size_t)tok * DINP + V_OFF + c]);
        const float pa = t > 0 ? bf1(proj[(size_t)(tok - 1) * DINP + V_OFF + c]) : 0.f, pb = t < L - 1 ? bf1(proj[(size_t)(tok + 1) * DINP + V_OFF + c]) : 0.f;
        const float v = pv + muv * (0.5f * (pa + pb) - pv);
        const float bonus = (BC0[(size_t)tok * 8 + head] + BC1[(size_t)tok * 8 + head]) * v;
        MIX[(size_t)tok * DM + c] = (bf16)f2bf((yn + bonus) * g[i]); }
    __syncthreads();
}

constexpr int N_STEPS = 22;
__device__ __forceinline__ bool step_seam(int st) { if (st == 0) return true; if (st >= 21) return false; const int s = (st - 1) % 10; return !(s == 3 || s == 4); }
__global__ void __launch_bounds__(NTHR, 2) mega_fwd(KP p_unused) {
    extern __shared__ __attribute__((aligned(16))) unsigned char lds_raw[];
    CKP* kp0 = (CKP*)__builtin_amdgcn_kernarg_segment_ptr();
    const int ph_lo = kp0->ph_lo, ph_hi = kp0->ph_hi;
#pragma unroll 1
    for (int st = ph_lo; st < ph_hi; ++st) {
        CKP* kp = kp0; asm volatile("" : "+s"(kp));
        CKP& p = *kp; unsigned char* ws = p.ws;
        int bid = blockIdx.x, nb = gridDim.x; unsigned ldsb = (unsigned)(size_t)(LAS unsigned char*)lds_raw;
        asm volatile("" : "+s"(bid), "+s"(nb), "+s"(ldsb));
        LAS unsigned char* lds = (LAS unsigned char*)(size_t)ldsb;
        const int l = st == 0 ? 0 : (st - 1) / 10, s = st == 0 ? -1 : (st == 21 ? 10 : (st - 1) % 10);
        const float* mod = (const float*)(ws + WS_MOD) + (size_t)l * 5 * 6144;
        pg8::Gemm g{nullptr, nullptr, 0, 0, 0, 0, 0}; pg8::EpiAny E{-1, true, nullptr, nullptr, 0, 0}; int corder = bid;
        if (s == 1) { g = pg8::Gemm{(const bf16*)(ws + WS_H), (const bf16*)(ws + WS_WIN) + (size_t)l * DINP * DM, MTOK, DINP, DM, DM, DM}; E = pg8::EpiAny{0, true, ws + WS_PROJ, nullptr, DINP, 0}; }
        else if (s == 3) { g = pg8::Gemm{(const bf16*)(ws + WS_CS256), (const bf16*)(ws + WS_YCS), 256, 8192, 512, 512, 512}; E = pg8::EpiAny{3, true, ws + WS_MIXED, nullptr, 0, 256}; }
        else if (s == 4) { g = pg8::Gemm{(const bf16*)(ws + WS_CS1024), (const bf16*)(ws + WS_YCS) + (size_t)8192 * 512, 1024, 1024, 2048, 2048, 2048}; E = pg8::EpiAny{3, true, ws + WS_MIXED, nullptr, NCTX, 1024}; corder = (bid + nb - 32) % nb; }
        else if (s == 6) { g = pg8::Gemm{(const bf16*)(ws + WS_MIXED), (const bf16*)(ws + WS_WOUT) + (size_t)l * DM * DM, MTOK, DM, DM, DM, DM}; E = pg8::EpiAny{2, false, p.out, mod + 2 * 1024, 0, 0}; }
        else if (s == 8) { g = pg8::Gemm{(const bf16*)(ws + WS_H), (const bf16*)(ws + WS_W1) + (size_t)l * DFF * DM, MTOK, DFF, DM, DM, DM}; E = pg8::EpiAny{1, true, ws + WS_FF, nullptr, DFF, 0}; }
        else if (s == 9) { g = pg8::Gemm{(const bf16*)(ws + WS_FF), (const bf16*)(ws + WS_W2) + (size_t)l * DM * DFF, MTOK, DM, DFF, DFF, DFF}; E = pg8::EpiAny{2, false, p.out, mod + 5 * 1024, 0, 0}; }
        if (E.mode >= 0) {
            pg8::StaticOrder S; S.init(g.M, g.N, nb, corder);
            pg8::gemm_phase<pg8::EpiAny, pg8::StaticOrder, true, true>(lds, g, S, E);
            __syncthreads();
        } else if (s == -1) stage_prologue(p, lds, bid, nb);
        else if (s == 0) stage_norm(p, l, 0, bid, nb);
        else if (s == 2) {
            if (nb >= 256) { if (bid < 64) rwkv_item(p, l, lds, bid); else for (int it = 64 + (bid - 64); it < 576; it += nb - 64) rwkv_item(p, l, lds, it); }
            else for (int it = bid; it < 576; it += nb) rwkv_item(p, l, lds, it);
            for (int it = bid; it < 768; it += nb) fnet1_item(p, l, lds, it);
            for (int it = bid; it < 768; it += nb) pool_item(p, l, lds, it);
        }
        else if (s == 5) { for (int it = bid; it < 768; it += nb) post_item(p, l, lds, it); }
        else if (s == 7) stage_norm(p, l, 1, bid, nb);
        else stage_final(p, bid, nb);
        if (st + 1 < ph_hi && step_seam(st)) cg::this_grid().sync();
    }
}

extern "C" void kernel_launch(void* const* d_in, const int* in_sizes, int n_in, void* d_out, int out_size, void* d_ws, size_t ws_size, hipStream_t stream) {
    static int grid = 0;
    if (grid == 0) {
        if (n_in != N_IN || ws_size < WS_END) { fprintf(stderr, "kernel_launch: unexpected inputs (n_in %d, ws %zu)\n", n_in, ws_size); grid = -1; return; }
        int dev = 0, cus = 0, per_cu = 0;
        (void)hipGetDevice(&dev); (void)hipDeviceGetAttribute(&cus, hipDeviceAttributeMultiprocessorCount, dev);
        (void)hipFuncSetAttribute((const void*)mega_fwd, hipFuncAttributeMaxDynamicSharedMemorySize, LDS_BYTES);
        if (hipOccupancyMaxActiveBlocksPerMultiprocessor(&per_cu, (const void*)mega_fwd, NTHR, LDS_BYTES) != hipSuccess || per_cu < 1) {
            fprintf(stderr, "kernel_launch: occupancy query reports %d blocks/CU\n", per_cu); (void)hipGetLastError(); grid = -1; return; }
        grid = cus * 1;
    }
    if (grid < 0) return;
    KP a{};
    for (int i = 0; i < N_IN; ++i) a.in[i] = (const float*)d_in[i];
    a.out = (float*)d_out; a.ws = (unsigned char*)d_ws; a.ph_lo = 0; a.ph_hi = N_STEPS;
    void* args[] = {&a};
    hipError_t e = hipLaunchCooperativeKernel((const void*)mega_fwd, dim3(grid), dim3(NTHR), args, LDS_BYTES, stream);
    if (e != hipSuccess) fprintf(stderr, "cooperative launch failed: %s (grid %d)\n", hipGetErrorString(e), grid);
}
```

```cpp
#include <hip/hip_runtime.h>
#include <hip/hip_cooperative_groups.h>
#include <cstdio>
#include <cstdint>
namespace cg = cooperative_groups;
__device__ __forceinline__ int opaque_tid() { int t = threadIdx.x; asm volatile("" : "+v"(t)); return t; }
namespace pg8 {
#define PG8_LAS __attribute__((address_space(3)))
typedef unsigned short bf16_t;
typedef short bf16x8 __attribute__((ext_vector_type(8)));
typedef float f32x4 __attribute__((ext_vector_type(4)));
typedef unsigned u32x4 __attribute__((ext_vector_type(4)));
constexpr int BM = 256, BK = 64, HALF = 128, HTB = HALF * BK * 2  , STAGE_BYTES = 8 * HTB, NXCD = 8, WGM = 8;

__host__ __device__ __forceinline__ int lds_byte(int r, int c) { const int st = (r >> 4) * 2 + (c >> 5), rr = r & 15, cc = c & 31, ob = rr * 64 + cc * 2; return st * 1024 + (ob ^ (((ob >> 9) & 1) << 5)); }
__host__ __device__ __forceinline__ void stage_rc(int b, int& R, int& C) { const int st = b / 1024, sb = b % 1024, swz = sb ^ (((sb >> 9) & 1) << 5); R = (st >> 1) * 16 + swz / 64; C = (st & 1) * 32 + (swz % 64) / 2; }
__host__ __device__ __forceinline__ int perm32(int rho) { const int n = rho >> 4, i = rho & 15; return 8 * (i >> 2) + 4 * n + (i & 3); }

struct Unit { int pm, pn; };
struct Gemm { const bf16_t* A; const bf16_t* Bt; int M, N, K, lda, ldb; };

struct StaticOrder {
    int nM, nN, nwg, G, c;
    __host__ __device__ void init(int M, int N, int G_, int c_) { nM = M / BM; nN = N / BM; nwg = nM * nN; G = G_; c = c_; }
    __host__ __device__ bool next(int i, Unit& u) const {
        const long L = (long)i * G + c; if (L >= nwg) return false;
        int wgid = (int)L; { const int q = nwg / NXCD, r = nwg % NXCD, xcd = wgid % NXCD, off = wgid / NXCD; wgid = (xcd < r ? xcd * (q + 1) : r * (q + 1) + (xcd - r) * q) + off; }
        const int nig = WGM * nN, gid = wgid / nig, fm = gid * WGM, gsz = (nM - fm) < WGM ? (nM - fm) : WGM;
        u.pm = fm + ((wgid % nig) % gsz); u.pn = (wgid % nig) / gsz; return true;
    }
    __device__ __forceinline__ void a_ready(const Unit&) const {}
    __device__ __forceinline__ void done(const Unit&) const {}
};

__device__ __forceinline__ unsigned cvt_pk_bf16(float lo, float hi) { unsigned r; asm volatile("v_cvt_pk_bf16_f32 %0, %1, %2" : "=v"(r) : "v"(lo), "v"(hi)); return r; }
template <int ACT  > struct EpiBf {
    static constexpr bool PERM = true, AFTER_DRAIN = false;
    bf16_t* O; int ldc;
    __device__ __forceinline__ void operator()(const f32x4 (&acc)[2][2][4][2], const Unit& u, int wr, int wc, int fr, int fq) const {
        const int row0 = u.pm * BM + wr * 64 + fr, col0 = u.pn * BM + wc * 32 + 8 * fq;
#pragma unroll
        for (int ai = 0; ai < 2; ++ai)
#pragma unroll
            for (int m = 0; m < 4; ++m) { bf16_t* rowp = O + (size_t)(row0 + ai * HALF + m * 16) * ldc + col0;
#pragma unroll
                for (int bj = 0; bj < 2; ++bj) { f32x4 v0 = acc[ai][bj][m][0], v1 = acc[ai][bj][m][1];
                    if (ACT == 1) {
#pragma unroll
                        for (int e = 0; e < 4; ++e) { float a = v0[e] > 0.f ? v0[e] : 0.f; v0[e] = a * a; float b = v1[e] > 0.f ? v1[e] : 0.f; v1[e] = b * b; } }
                    u32x4 w; w.x = cvt_pk_bf16(v0[0], v0[1]); w.y = cvt_pk_bf16(v0[2], v0[3]); w.z = cvt_pk_bf16(v1[0], v1[1]); w.w = cvt_pk_bf16(v1[2], v1[3]);
                    *(u32x4*)(rowp + bj * HALF) = w; } }
    }
};
struct EpiRes {
    static constexpr bool PERM = false, AFTER_DRAIN = false;
    float* X; const float* gate;
    __device__ __forceinline__ void operator()(const f32x4 (&acc)[2][2][4][2], const Unit& u, int wr, int wc, int fr, int fq) const {
        const int row0 = u.pm * BM + wr * 64 + fr, col0 = u.pn * BM + wc * 32 + 4 * fq;
        const int cond = u.pm < 32 ? 0 : 1 + ((u.pm - 32) >> 2);
        const float* gp = gate + cond * 6144 + col0;
        f32x4 gv[2][2];
#pragma unroll
        for (int bj = 0; bj < 2; ++bj)
#pragma unroll
            for (int n = 0; n < 2; ++n) gv[bj][n] = *(const f32x4*)(gp + bj * HALF + n * 16);
#pragma unroll
        for (int ai = 0; ai < 2; ++ai)
#pragma unroll
            for (int m = 0; m < 4; ++m) { float* rowp = X + (size_t)(row0 + ai * HALF + m * 16) * 1024 + col0;
#pragma unroll
                for (int bj = 0; bj < 2; ++bj)
#pragma unroll
                    for (int n = 0; n < 2; ++n) { f32x4* q = (f32x4*)(rowp + bj * HALF + n * 16); *q = *q + gv[bj][n] * acc[ai][bj][m][n]; } }
    }
};
struct EpiFnet {
    static constexpr bool PERM = true, AFTER_DRAIN = false;
    bf16_t* MIX; int rowbase, L;
    __device__ __forceinline__ void operator()(const f32x4 (&acc)[2][2][4][2], const Unit& u, int wr, int wc, int fr, int fq) const {
        const int row0 = u.pm * BM + wr * 64 + fr, colw = wc * 32 + 8 * fq;
        bf16_t* base = MIX + (size_t)(rowbase + u.pn * L) * 1024 + 512 + colw;
#pragma unroll
        for (int ai = 0; ai < 2; ++ai)
#pragma unroll
            for (int m = 0; m < 4; ++m) { bf16_t* rowp = base + (size_t)(row0 + ai * HALF + m * 16) * 1024;
#pragma unroll
                for (int bj = 0; bj < 2; ++bj) { const f32x4 v0 = acc[ai][bj][m][0], v1 = acc[ai][bj][m][1];
                    u32x4 w; w.x = cvt_pk_bf16(v0[0], v0[1]); w.y = cvt_pk_bf16(v0[2], v0[3]); w.z = cvt_pk_bf16(v1[0], v1[1]); w.w = cvt_pk_bf16(v1[2], v1[3]);
                    *(u32x4*)(rowp + bj * HALF) = w; } }
    }
};

struct EpiAny {
    static constexpr bool AFTER_DRAIN = false;
    int mode; bool PERM; void* out; const float* aux; int i0, i1;
    __device__ __forceinline__ void operator()(const f32x4 (&acc)[2][2][4][2], const Unit& u, int wr, int wc, int fr, int fq) const {
        if (mode == 0) { const EpiBf<0> e{(bf16_t*)out, i0}; e(acc, u, wr, wc, fr, fq); }
        else if (mode == 1) { const EpiBf<1> e{(bf16_t*)out, i0}; e(acc, u, wr, wc, fr, fq); }
        else if (mode == 2) { const EpiRes e{(float*)out, aux}; e(acc, u, wr, wc, fr, fq); }
        else { const EpiFnet e{(bf16_t*)out, i0, i1}; e(acc, u, wr, wc, fr, fq); }
    }
};
template <class Epi, class Sched, bool ALIGN_EPI = false, bool SP2 = false>
__device__ __forceinline__ void gemm_phase(PG8_LAS unsigned char* lds, const Gemm g, const Sched& S, const Epi& E) {
    const int tid = opaque_tid(), wid = __builtin_amdgcn_readfirstlane(tid >> 6), lane = tid & 63, wr = wid >> 2, wc = wid & 3, fr = lane & 15, fq = lane >> 4;
    const int K = g.K, nt = K / BK;
    unsigned voffA[2], voffB[2];
#pragma unroll
    for (int i = 0; i < 2; ++i) { int R, C; stage_rc(tid * 16 + i * 8192, R, C); const int Rb = E.PERM ? ((R & ~31) + perm32(R & 31)) : R;
        voffA[i] = (unsigned)(R * g.lda + C) * 2u; voffB[i] = (unsigned)(Rb * g.ldb + C) * 2u; }
    const size_t kstep = (size_t)(BK * 2);
    const size_t hstepA = (size_t)HALF * g.lda * 2, hstepB = (size_t)HALF * g.ldb * 2;
    const size_t tstepA = 2 * hstepA, tstepB = 2 * hstepB;
    const unsigned ldsw = (unsigned)wid * 1024u;
    const int aoff = lds_byte(wr * 64 + fr, fq * 8), boff = lds_byte(wc * 32 + fr, fq * 8);
#define PG8_SA(b, h) (((b) * 2 + (h)) * HTB)
#define PG8_SB(b, h) ((4 + (b) * 2 + (h)) * HTB)
#define PG8_STAGE(bufoff, gbase, voff) do { _Pragma("unroll") for (int _i = 0; _i < 2; ++_i) \
        __builtin_amdgcn_global_load_lds((const unsigned*)((const char*)(gbase) + (voff)[_i]), (PG8_LAS unsigned*)(lds + (bufoff) + ldsw + _i * 8192), 16, 0, 0); } while (0)
#define PG8_LDA(dst, b, h) do { _Pragma("unroll") for (int m = 0; m < 4; ++m) _Pragma("unroll") for (int k = 0; k < 2; ++k) dst[m][k] = *(const PG8_LAS bf16x8*)(lds + PG8_SA(b, h) + aoff + m * 2048 + k * 1024); } while (0)
#define PG8_LDB(dst, b, h) do { _Pragma("unroll") for (int n = 0; n < 2; ++n) _Pragma("unroll") for (int k = 0; k < 2; ++k) dst[n][k] = *(const PG8_LAS bf16x8*)(lds + PG8_SB(b, h) + boff + n * 2048 + k * 1024); } while (0)
#define PG8_MMA(ai, bj, At, Bt) do { __builtin_amdgcn_s_setprio(1); _Pragma("unroll") for (int m = 0; m < 4; ++m) _Pragma("unroll") for (int n = 0; n < 2; ++n) _Pragma("unroll") for (int k = 0; k < 2; ++k) \
        acc[ai][bj][m][n] = __builtin_amdgcn_mfma_f32_16x16x32_bf16(Bt[n][k], At[m][k], acc[ai][bj][m][n], 0, 0, 0); __builtin_amdgcn_s_setprio(0); } while (0)
#define PG8_WAIT_V(n) asm volatile("s_waitcnt vmcnt(" #n ")" ::: "memory")
#define PG8_WAIT_L(n) asm volatile("s_waitcnt lgkmcnt(" #n ")" ::: "memory")
#define PG8_BAR __builtin_amdgcn_s_barrier()
#define PG8_SCHED __builtin_amdgcn_sched_barrier(0)
    Unit cur, nxt; int ui = 0;
    if (!S.next(0, cur)) return;
    f32x4 acc[2][2][4][2];
#pragma unroll
    for (int a = 0; a < 2; ++a)
#pragma unroll
        for (int b = 0; b < 2; ++b)
#pragma unroll
            for (int m = 0; m < 4; ++m)
#pragma unroll
                for (int n = 0; n < 2; ++n) acc[a][b][m][n] = (f32x4){0.f, 0.f, 0.f, 0.f};
    bf16x8 At[4][2], B0[2][2], B1[2][2];
    const char* cA = (const char*)g.A + (size_t)cur.pm * tstepA; const char* cB = (const char*)g.Bt + (size_t)cur.pn * tstepB;
    S.a_ready(cur);
    if constexpr (SP2) {
        PG8_STAGE(PG8_SB(0, 0), cB, voffB); PG8_STAGE(PG8_SB(0, 1), cB + hstepB, voffB); PG8_STAGE(PG8_SA(0, 0), cA, voffA); PG8_STAGE(PG8_SA(0, 1), cA + hstepA, voffA);
        if (wr == 1) PG8_BAR;
        PG8_WAIT_V(2); PG8_BAR;
        PG8_STAGE(PG8_SB(1, 0), cB + kstep, voffB); PG8_STAGE(PG8_SA(1, 0), cA + kstep, voffA); PG8_STAGE(PG8_SB(1, 1), cB + hstepB + kstep, voffB);
        PG8_WAIT_V(6); PG8_BAR;
    } else {
        PG8_STAGE(PG8_SB(0, 0), cB, voffB); PG8_STAGE(PG8_SA(0, 0), cA, voffA); PG8_STAGE(PG8_SB(0, 1), cB + hstepB, voffB); PG8_STAGE(PG8_SA(0, 1), cA + hstepA, voffA);
        if (wr == 1) PG8_BAR;
        PG8_WAIT_V(4); PG8_BAR;
        PG8_STAGE(PG8_SB(1, 0), cB + kstep, voffB); PG8_STAGE(PG8_SA(1, 0), cA + kstep, voffA); PG8_STAGE(PG8_SB(1, 1), cB + hstepB + kstep, voffB);
        PG8_WAIT_V(6); PG8_BAR;
    }
    for (;;) {
        const bool has_next = S.next(ui + 1, nxt);
        const char* nA = has_next ? (const char*)g.A + (size_t)nxt.pm * tstepA : cA; const char* nB = has_next ? (const char*)g.Bt + (size_t)nxt.pn * tstepB : cB;
        for (int t = 0; t < nt; t += 2) {
            const bool last = (t == nt - 2);
            const char* a1 = cA + (size_t)(t + 1) * kstep;
            const char* a2 = last ? nA : cA + (size_t)(t + 2) * kstep; const char* b2 = last ? nB : cB + (size_t)(t + 2) * kstep;
            const char* a3 = a2 + kstep; const char* b3 = b2 + kstep;
            if (last && has_next) S.a_ready(nxt);
            if constexpr (SP2) {
            PG8_LDB(B0, 0, 0); PG8_LDB(B1, 0, 1); PG8_SCHED; PG8_LDA(At, 0, 0); PG8_STAGE(PG8_SA(1, 1), a1 + hstepA, voffA);
            PG8_WAIT_V(8); PG8_WAIT_L(0); PG8_BAR; PG8_MMA(0, 0, At, B0); PG8_MMA(0, 1, At, B1); PG8_BAR; PG8_SCHED;
            PG8_LDA(At, 0, 1); PG8_STAGE(PG8_SB(0, 0), b2, voffB); PG8_STAGE(PG8_SB(0, 1), b2 + hstepB, voffB); PG8_STAGE(PG8_SA(0, 0), a2, voffA);
            PG8_WAIT_V(8); PG8_WAIT_L(0); PG8_BAR; PG8_MMA(1, 0, At, B0); PG8_MMA(1, 1, At, B1); PG8_BAR; PG8_SCHED;
            PG8_LDB(B0, 1, 0); PG8_LDB(B1, 1, 1); PG8_SCHED; PG8_LDA(At, 1, 0); PG8_STAGE(PG8_SA(0, 1), a2 + hstepA, voffA);
            PG8_WAIT_V(8); PG8_WAIT_L(0); PG8_BAR; PG8_MMA(0, 0, At, B0); PG8_MMA(0, 1, At, B1); PG8_BAR; PG8_SCHED;
            PG8_LDA(At, 1, 1); PG8_STAGE(PG8_SB(1, 0), b3, voffB); PG8_STAGE(PG8_SB(1, 1), b3 + hstepB, voffB); PG8_STAGE(PG8_SA(1, 0), a3, voffA);
            PG8_WAIT_V(8); PG8_WAIT_L(0); PG8_BAR; PG8_MMA(1, 0, At, B0); PG8_MMA(1, 1, At, B1); PG8_BAR; PG8_SCHED;
            } else {
            PG8_LDB(B0, 0, 0); PG8_SCHED; PG8_LDA(At, 0, 0); PG8_STAGE(PG8_SA(1, 1), a1 + hstepA, voffA);
            PG8_WAIT_L(8); PG8_BAR; PG8_WAIT_L(0); PG8_MMA(0, 0, At, B0); PG8_BAR; PG8_SCHED;
            PG8_LDB(B1, 0, 1); PG8_STAGE(PG8_SB(0, 0), b2, voffB);
            PG8_BAR; PG8_WAIT_L(0); PG8_MMA(0, 1, At, B1); PG8_BAR;
            PG8_LDA(At, 0, 1); PG8_STAGE(PG8_SA(0, 0), a2, voffA);
            PG8_BAR; PG8_WAIT_L(0); PG8_MMA(1, 0, At, B0); PG8_BAR; PG8_SCHED;
            PG8_STAGE(PG8_SB(0, 1), b2 + hstepB, voffB);
            PG8_WAIT_V(6); PG8_BAR; PG8_MMA(1, 1, At, B1); PG8_BAR;
            PG8_LDB(B0, 1, 0); PG8_SCHED; PG8_LDA(At, 1, 0); PG8_STAGE(PG8_SA(0, 1), a2 + hstepA, voffA);
            PG8_WAIT_L(8); PG8_BAR; PG8_WAIT_L(0); PG8_MMA(0, 0, At, B0); PG8_BAR; PG8_SCHED;
            PG8_LDB(B1, 1, 1); PG8_STAGE(PG8_SB(1, 0), b3, voffB);
            PG8_BAR; PG8_WAIT_L(0); PG8_MMA(0, 1, At, B1); PG8_BAR;
            PG8_LDA(At, 1, 1); PG8_STAGE(PG8_SA(1, 0), a3, voffA);
            PG8_BAR; PG8_WAIT_L(0); PG8_MMA(1, 0, At, B0); PG8_BAR; PG8_SCHED;
            PG8_STAGE(PG8_SB(1, 1), b3 + hstepB, voffB);
            PG8_WAIT_V(6); PG8_BAR; PG8_MMA(1, 1, At, B1); PG8_BAR;
            }
        }
        if constexpr (ALIGN_EPI) { if (wr == 0) PG8_BAR; }
        if constexpr (!Epi::AFTER_DRAIN) { E(acc, cur, wr, wc, fr, fq); S.done(cur); }
        if (!has_next) break;
#pragma unroll
        for (int a = 0; a < 2; ++a)
#pragma unroll
            for (int b = 0; b < 2; ++b)
#pragma unroll
                for (int m = 0; m < 4; ++m)
#pragma unroll
                    for (int n = 0; n < 2; ++n) acc[a][b][m][n] = (f32x4){0.f, 0.f, 0.f, 0.f};
        cur = nxt; cA = nA; cB = nB; ++ui;
        if constexpr (ALIGN_EPI) { if (wr == 1) PG8_BAR; }
    }
    PG8_WAIT_V(0);
    if constexpr (!ALIGN_EPI) { if (wr == 0) PG8_BAR; }
    PG8_BAR;
    if constexpr (Epi::AFTER_DRAIN) { E.fused(acc, cur, wr, wc, fr, fq, lds, wid, lane); S.done(cur); }
#undef PG8_SA
#undef PG8_SB
#undef PG8_STAGE
#undef PG8_LDA
#undef PG8_LDB
#undef PG8_MMA
#undef PG8_WAIT_V
#undef PG8_WAIT_L
#undef PG8_BAR
#undef PG8_SCHED
}
}

#define LAS __attribute__((address_space(3)))
typedef unsigned short bf16;
typedef float f32x4 __attribute__((ext_vector_type(4)));
typedef unsigned u32x4 __attribute__((ext_vector_type(4)));
typedef unsigned u32x2 __attribute__((ext_vector_type(2)));
constexpr int DM = 1024, NCTX = 8192, MTOK = 12288, DINP = 2560, DFF = 4096;
constexpr int R_OFF = 0, K_OFF = 512, V_OFF = 1024, WD_OFF = 1536, AD_OFF = 1664, GD_OFF = 1792, F_OFF = 1920, P_OFF = 2176, DIN = 2432;
constexpr size_t MiB = 1u << 20;
constexpr size_t WS_CTL = 0, WS_MOD = 1 * MiB, WS_FW = 1 * MiB + 512 * 1024, WS_BC = 2 * MiB, WS_CS256 = 3 * MiB, WS_CS1024 = 4 * MiB, WS_WIN = 8 * MiB, WS_WOUT = 18 * MiB,
                 WS_W1 = 22 * MiB, WS_W2 = 38 * MiB, WS_H = 54 * MiB, WS_MIXED = 78 * MiB, WS_PROJ = 102 * MiB, WS_YCS = 162 * MiB, WS_YF = 174 * MiB, WS_YB = 198 * MiB,
                 WS_FF = 102 * MiB, WS_END = 222 * MiB;
constexpr int LDS_BYTES = 147456, RING_BYTES = 131072, MISC_OFF = RING_BYTES + 320;
constexpr int NTHR = 512;
enum { I_XP = 0, I_XS, I_STATE, I_C, I_CCTX, I_WADA, I_BADA, I_N1G, I_WIN, I_MU, I_W0, I_WUP, I_A0, I_AUP, I_GUP, I_KK, I_KA, I_RK, I_LNW, I_LNB, I_WFNET, I_WPOOL, I_PSCALE, I_WOUT, I_N2G, I_WFF1, I_WFF2, I_FNG, N_IN };
struct KP { const float* in[N_IN]; float* out; unsigned char* ws; int ph_lo, ph_hi; };
typedef const __attribute__((address_space(4))) KP CKP;

__device__ __forceinline__ unsigned f2bf(float f) { unsigned u = __builtin_bit_cast(unsigned, f); return (u + 0x7fffu + ((u >> 16) & 1u)) >> 16; }
__device__ __forceinline__ unsigned pk2(float lo, float hi) { return f2bf(lo) | (f2bf(hi) << 16); }
__device__ __forceinline__ float bflo(unsigned w) { return __builtin_bit_cast(float, w << 16); }
__device__ __forceinline__ float bfhi(unsigned w) { return __builtin_bit_cast(float, w & 0xffff0000u); }
__device__ __forceinline__ float bf1(bf16 h) { return __builtin_bit_cast(float, (unsigned)h << 16); }
template <int CTRL> __device__ __forceinline__ float dppf(float x) { return __builtin_bit_cast(float, __builtin_amdgcn_update_dpp(0, __builtin_bit_cast(int, x), CTRL, 0xF, 0xF, true)); }
__device__ __forceinline__ float red8(float x)  { x += dppf<0xB1>(x); x += dppf<0x4E>(x); x += dppf<0x141>(x); return x; }
__device__ __forceinline__ float red16(float x) { x += dppf<0xB1>(x); x += dppf<0x4E>(x); x += dppf<0x141>(x); x += dppf<0x140>(x); return x; }
__device__ __forceinline__ float wave_sum(float v) {
#pragma unroll
    for (int o = 1; o < 64; o <<= 1) v += __shfl_xor(v, o);
    return v;
}
__device__ __forceinline__ void load4bf(const bf16* p, float (&o)[4]) { const u32x2 w = *(const u32x2*)p; o[0] = bflo(w.x); o[1] = bfhi(w.x); o[2] = bflo(w.y); o[3] = bfhi(w.y); }
__device__ __forceinline__ void load8bf(const bf16* p, float (&o)[8]) { const u32x4 w = *(const u32x4*)p; o[0] = bflo(w.x); o[1] = bfhi(w.x); o[2] = bflo(w.y); o[3] = bfhi(w.y); o[4] = bflo(w.z); o[5] = bfhi(w.z); o[6] = bflo(w.w); o[7] = bfhi(w.w); }
__device__ __forceinline__ void shift4(const bf16* proj, int row, bool hasp, bool hasn, int col, const float* mu, float (&u)[4]) {
    float p[4], a[4] = {0.f, 0.f, 0.f, 0.f}, b[4] = {0.f, 0.f, 0.f, 0.f};
    load4bf(proj + (size_t)row * DINP + col, p);
    if (hasp) load4bf(proj + (size_t)(row - 1) * DINP + col, a);
    if (hasn) load4bf(proj + (size_t)(row + 1) * DINP + col, b);
    const f32x4 m = *(const f32x4*)(mu + col);
#pragma unroll
    for (int j = 0; j < 4; ++j) u[j] = p[j] + m[j] * (0.5f * (a[j] + b[j]) - p[j]);
}

__device__ __forceinline__ void transpose_item(const float* W, int K, int N, bf16* WT, LAS float* scr, int item, int lane) {
    const int nblk = N / 32, kb = item / nblk, nb = item % nblk, k0 = 64 * kb, n0 = 32 * nb;
#pragma unroll 8
    for (int i = 0; i < 32; ++i) { const int kk = 2 * i + (lane >> 5); scr[kk * 33 + (lane & 31)] = W[(size_t)(k0 + kk) * N + n0 + (lane & 31)]; }
    asm volatile("s_waitcnt lgkmcnt(0)" ::: "memory");
    const int c = lane & 7;
#pragma unroll
    for (int j = 0; j < 4; ++j) { const int n = (lane >> 3) + 8 * j; const LAS float* s = scr + (8 * c) * 33 + n;
        u32x4 o; o.x = pk2(s[0 * 33], s[1 * 33]); o.y = pk2(s[2 * 33], s[3 * 33]); o.z = pk2(s[4 * 33], s[5 * 33]); o.w = pk2(s[6 * 33], s[7 * 33]);
        *(u32x4*)(WT + (size_t)(n0 + n) * K + k0 + 8 * c) = o; }
    asm volatile("s_waitcnt lgkmcnt(0)" ::: "memory");
}
__device__ __forceinline__ void stage_prologue(CKP& p, LAS unsigned char* lds, int bid, int nb) {
    const int tid = opaque_tid(), lane = tid & 63, wave = tid >> 6;
    unsigned char* ws = p.ws;
    {
        LAS float* scr = (LAS float*)(lds + wave * 16384);
        const int gw = bid * 8 + wave, NGW = nb * 8;
        constexpr int I_IN = 16 * 76, I_OUT = 16 * 32, I_1 = 16 * 128, I_2 = 64 * 32, I_L = I_IN + I_OUT + I_1 + I_2;
        for (int it = gw; it < 2 * I_L; it += NGW) {
            const int l = it / I_L; int r = it % I_L;
            if (r < I_IN) { transpose_item(p.in[I_WIN] + (size_t)l * DM * DIN, DM, DIN, (bf16*)(ws + WS_WIN) + (size_t)l * DINP * DM, scr, r, lane); continue; } r -= I_IN;
            if (r < I_OUT) { transpose_item(p.in[I_WOUT] + (size_t)l * DM * DM, DM, DM, (bf16*)(ws + WS_WOUT) + (size_t)l * DM * DM, scr, r, lane); continue; } r -= I_OUT;
            if (r < I_1) { transpose_item(p.in[I_WFF1] + (size_t)l * DM * DFF, DM, DFF, (bf16*)(ws + WS_W1) + (size_t)l * DFF * DM, scr, r, lane); continue; } r -= I_1;
            transpose_item(p.in[I_WFF2] + (size_t)l * DFF * DM, DFF, DM, (bf16*)(ws + WS_W2) + (size_t)l * DM * DFF, scr, r, lane);
        }
    }
    const int gt = bid * NTHR + tid, NGT = nb * NTHR;
    for (int i = gt; i < 2 * 128 * DM / 8; i += NGT) { const int l = i / (128 * DM / 8), r = i % (128 * DM / 8);
        *(u32x4*)((bf16*)(ws + WS_WIN) + (size_t)l * DINP * DM + (size_t)DIN * DM + (size_t)r * 8) = (u32x4){0u, 0u, 0u, 0u}; }
    for (int i = gt; i < 256 * 512 + 1024 * 2048; i += NGT) {
        int L, k, j; bf16* dst;
        if (i < 256 * 512) { L = 256; k = i / 512; j = i % 512; dst = (bf16*)(ws + WS_CS256) + i; }
        else { const int i2 = i - 256 * 512; L = 1024; k = i2 / 2048; j = i2 % 2048; dst = (bf16*)(ws + WS_CS1024) + i2; }
        const int jj = j >= L ? j - L : j; const int idx = (k * jj) & (L - 1);
        float s, c; sincospif(2.0f * (float)idx / (float)L, &s, &c);
        *dst = (bf16)f2bf(j >= L ? -s : c);
    }
    for (int i = gt; i < 2 * 4 * 64 * 128; i += NGT) {
        const int o = i & 127, c = (i >> 7) & 63, lg = i >> 13; const float* wf = p.in[I_WFNET] + (size_t)lg * 4096 + (o & 63);
        float acc = 0.f;
        for (int cp = 0; cp < 64; ++cp) { float s, co; sincospif(2.0f * (float)((c * cp) & 63) / 64.0f, &s, &co); acc += (o < 64 ? co : s) * wf[cp * 64]; }
        ((float*)(ws + WS_FW))[i] = acc;
    }
    for (int i = gt; i < MTOK * DM / 4; i += NGT) {
        const f32x4 v = i < NCTX * DM / 4 ? ((const f32x4*)p.in[I_XP])[i] : ((const f32x4*)p.in[I_XS])[i - NCTX * DM / 4];
        ((f32x4*)p.out)[i] = v;
    }
    __syncthreads();
    LAS float* sc = (LAS float*)lds; LAS float* red = (LAS float*)(lds + 20480);
    for (int it = bid; it < 192; it += nb) {
        const int l = it / 96, cgp = it % 96;
        for (int i = tid; i < 5 * 1024; i += NTHR) { const int cond = i >> 10, k = i & 1023; const float v = cond == 0 ? p.in[I_CCTX][k] : p.in[I_C][(cond - 1) * 1024 + k]; sc[i] = v / (1.0f + __expf(-v)); }
        __syncthreads();
        const int cgi = tid & 15, kg = tid >> 4;
        f32x4 acc[5];
#pragma unroll
        for (int c = 0; c < 5; ++c) acc[c] = (f32x4){0.f, 0.f, 0.f, 0.f};
        const float* wp = p.in[I_WADA] + ((size_t)l * 1024 + kg * 32) * 6144 + cgp * 64 + cgi * 4;
#pragma unroll 4
        for (int kk = 0; kk < 32; ++kk) { const f32x4 w = *(const f32x4*)(wp + (size_t)kk * 6144);
#pragma unroll
            for (int c = 0; c < 5; ++c) acc[c] += sc[c * 1024 + kg * 32 + kk] * w; }
#pragma unroll
        for (int c = 0; c < 5; ++c) *(LAS f32x4*)(red + (kg * 5 + c) * 64 + cgi * 4) = acc[c];
        __syncthreads();
        if (tid < 320) { const int cond = tid >> 6, col = tid & 63; float s = p.in[I_BADA][l * 6144 + cgp * 64 + col];
            for (int g = 0; g < 32; ++g) s += red[(g * 5 + cond) * 64 + col];
            ((float*)(ws + WS_MOD))[(l * 5 + cond) * 6144 + cgp * 64 + col] = s; }
        __syncthreads();
    }
}

__device__ __forceinline__ void stage_norm(CKP& p, int l, int which, int bid, int nb) {
    const int tid = opaque_tid(), lane = tid & 63, wave = tid >> 6;
    const float* g = p.in[which ? I_N2G : I_N1G] + l * DM;
    const float* mod = (const float*)(p.ws + WS_MOD) + (size_t)l * 5 * 6144 + (which ? 3 * 1024 : 0);
    bf16* H = (bf16*)(p.ws + WS_H);
    for (int row = bid * 8 + wave; row < MTOK; row += nb * 8) {
        const f32x4* xr = (const f32x4*)(p.out + (size_t)row * DM) + lane;
        f32x4 v[4]; float s = 0.f;
#pragma unroll
        for (int j = 0; j < 4; ++j) { v[j] = xr[64 * j]; s += (v[j].x * v[j].x + v[j].y * v[j].y) + (v[j].z * v[j].z + v[j].w * v[j].w); }
        const float rstd = 1.0f / sqrtf(wave_sum(s) * (1.0f / DM) + 1e-6f);
        const int cond = row < NCTX ? 0 : 1 + ((row - NCTX) >> 10);
        const float* sh = mod + cond * 6144; const float* scl = sh + 1024;
        unsigned long long* o8 = (unsigned long long*)(H + (size_t)row * DM) + lane;
#pragma unroll
        for (int j = 0; j < 4; ++j) { const int col = 4 * lane + 256 * j; const f32x4 gg = *(const f32x4*)(g + col), a = *(const f32x4*)(sh + col), b = *(const f32x4*)(scl + col);
            const f32x4 y = v[j] * rstd * gg * (b + 1.0f) + a;
            o8[64 * j] = (unsigned long long)pk2(y.x, y.y) | ((unsigned long long)pk2(y.z, y.w) << 32); }
    }
}
__device__ __forceinline__ void stage_final(CKP& p, int bid, int nb) {
    const int tid = opaque_tid(), lane = tid & 63, wave = tid >> 6;
    const float* g = p.in[I_FNG];
    for (int row = bid * 8 + wave; row < MTOK; row += nb * 8) {
        f32x4* xr = (f32x4*)(p.out + (size_t)row * DM) + lane;
        f32x4 v[4]; float s = 0.f;
#pragma unroll
        for (int j = 0; j < 4; ++j) { v[j] = xr[64 * j]; s += (v[j].x * v[j].x + v[j].y * v[j].y) + (v[j].z * v[j].z + v[j].w * v[j].w); }
        const float rstd = 1.0f / sqrtf(wave_sum(s) * (1.0f / DM) + 1e-6f);
#pragma unroll
        for (int j = 0; j < 4; ++j) xr[64 * j] = v[j] * rstd * *(const f32x4*)(g + 4 * lane + 256 * j);
    }
}

__device__ __forceinline__ void rwkv_item(CKP& p, int l, LAS unsigned char* lds, int item) {
    const int tid = opaque_tid();
    int bseq, h, dir, L, base; bool lat;
    if (item < 64) { lat = true; bseq = item >> 4; h = (item >> 1) & 7; dir = item & 1; L = 1024; base = NCTX + bseq * 1024; }
    else { const int i2 = item - 64; lat = false; bseq = i2 >> 4; h = (i2 >> 1) & 7; dir = i2 & 1; L = 256; base = bseq * 256; }
    const bf16* proj = (const bf16*)(p.ws + WS_PROJ);
    const float* mu = p.in[I_MU] + l * 1920;
    LAS float* WUP = (LAS float*)lds;
    LAS float* AUP = WUP + 4096;
    LAS float* WD = AUP + 4096;
    LAS float* AD = WD + 2048;
    LAS float* VA = AD + 2048;
    LAS float* VQ = VA + 2048; LAS float* VW = VQ + 2048; LAS float* VB = VW + 2048; LAS float* VK = VB + 2048; LAS float* VV = VK + 2048;
    LAS float* YS = VV + 2048;
    LAS float* BR = YS + 2048;
    LAS float* KR = BR + 32;
    for (int i = tid; i < 4096; i += NTHR) { const int r = i >> 6, c = i & 63;
        WUP[i] = p.in[I_WUP][((size_t)(l * 2 + dir) * 64 + r) * 512 + h * 64 + c];
        AUP[i] = p.in[I_AUP][((size_t)(l * 2 + dir) * 64 + r) * 512 + h * 64 + c]; }
    const int row = tid >> 3, k8 = (tid & 7) * 8;
    float s[8];
    if (lat) { const float* sp = p.in[I_STATE] + ((((size_t)bseq * 2 + l) * 2 + dir) * 8 + h) * 4096 + row * 64 + k8;
#pragma unroll
        for (int j = 0; j < 8; ++j) s[j] = sp[j]; }
    else {
#pragma unroll
        for (int j = 0; j < 8; ++j) s[j] = 0.f; }
    const int ti = tid >> 4, c4 = (tid & 15) * 4, hc = h * 64 + c4;
    const f32x4 w0v = *(const f32x4*)(p.in[I_W0] + (l * 2 + dir) * 512 + hc), a0v = *(const f32x4*)(p.in[I_A0] + (l * 2 + dir) * 512 + hc);
    const f32x4 kkv = *(const f32x4*)(p.in[I_KK] + l * 512 + hc), kav = *(const f32x4*)(p.in[I_KA] + l * 512 + hc), rkv = *(const f32x4*)(p.in[I_RK] + l * 512 + hc);
    float* Yout = (float*)(p.ws + (dir ? WS_YB : WS_YF));
    float* BC = (float*)(p.ws + WS_BC) + (size_t)dir * MTOK * 8;
    __syncthreads();
    for (int ch = 0; ch < L / 32; ++ch) {
        const int step = ch * 32 + ti, t = dir ? L - 1 - step : step, grow = base + t;
        const bool hasp = t > 0, hasn = t < L - 1;
        { float u[4];
          shift4(proj, grow, hasp, hasn, WD_OFF + dir * 64 + c4, mu, u);
#pragma unroll
          for (int j = 0; j < 4; ++j) WD[ti * 64 + c4 + j] = tanhf(u[j]);
          shift4(proj, grow, hasp, hasn, AD_OFF + dir * 64 + c4, mu, u);
#pragma unroll
          for (int j = 0; j < 4; ++j) AD[ti * 64 + c4 + j] = u[j]; }
        __syncthreads();
        { f32x4 wp = w0v, ap = a0v;
#pragma unroll 8
          for (int r = 0; r < 64; ++r) { const float wd = WD[ti * 64 + r], ad = AD[ti * 64 + r];
              wp += wd * *(const LAS f32x4*)(WUP + r * 64 + c4); ap += ad * *(const LAS f32x4*)(AUP + r * 64 + c4); }
          float rr[4], kk[4], vv[4];
          shift4(proj, grow, hasp, hasn, R_OFF + hc, mu, rr); shift4(proj, grow, hasp, hasn, K_OFF + hc, mu, kk); shift4(proj, grow, hasp, hasn, V_OFF + hc, mu, vv);
          float dec[4], asg[4], kn[4], kd[4], ss = 0.f;
#pragma unroll
          for (int j = 0; j < 4; ++j) {
              const float z = -wp[j]; const float sp = z > 20.f ? z : log1pf(__expf(z));
              const float wlog = -sp - 0.5f; dec[j] = __expf(-__expf(wlog));
              asg[j] = 1.0f / (1.0f + __expf(-ap[j]));
              kn[j] = kk[j] * kkv[j]; ss += kn[j] * kn[j];
              kd[j] = kk[j] * (1.0f + (asg[j] - 1.0f) * kav[j]); }
          ss = red16(ss);
          const float inv = 1.0f / fmaxf(sqrtf(ss), 1e-12f);
          float br = 0.f, kr = 0.f, bc = 0.f; f32x4 va, vq, vw, vb, vk, v4;
#pragma unroll
          for (int j = 0; j < 4; ++j) { const float kj = kn[j] * inv, bj = kj * asg[j];
              va[j] = -kj; vq[j] = dec[j] * rr[j]; vw[j] = dec[j]; vb[j] = bj; vk[j] = kd[j]; v4[j] = vv[j];
              br += bj * rr[j]; kr += kd[j] * rr[j]; bc += rr[j] * kd[j] * rkv[j]; }
          br = red16(br); kr = red16(kr); bc = red16(bc);
          *(LAS f32x4*)(VA + ti * 64 + c4) = va; *(LAS f32x4*)(VQ + ti * 64 + c4) = vq; *(LAS f32x4*)(VW + ti * 64 + c4) = vw;
          *(LAS f32x4*)(VB + ti * 64 + c4) = vb; *(LAS f32x4*)(VK + ti * 64 + c4) = vk; *(LAS f32x4*)(VV + ti * 64 + c4) = v4;
          if ((tid & 15) == 0) { BR[ti] = br; KR[ti] = kr; BC[(size_t)grow * 8 + h] = bc; } }
        __syncthreads();
#pragma unroll 2
        for (int i = 0; i < 32; ++i) {
            const f32x4 a0 = *(const LAS f32x4*)(VA + i * 64 + k8), a1 = *(const LAS f32x4*)(VA + i * 64 + k8 + 4);
            const f32x4 q0 = *(const LAS f32x4*)(VQ + i * 64 + k8), q1 = *(const LAS f32x4*)(VQ + i * 64 + k8 + 4);
            const f32x4 w0 = *(const LAS f32x4*)(VW + i * 64 + k8), w1 = *(const LAS f32x4*)(VW + i * 64 + k8 + 4);
            const f32x4 b0 = *(const LAS f32x4*)(VB + i * 64 + k8), b1 = *(const LAS f32x4*)(VB + i * 64 + k8 + 4);
            const f32x4 kk0 = *(const LAS f32x4*)(VK + i * 64 + k8), kk1 = *(const LAS f32x4*)(VK + i * 64 + k8 + 4);
            const float vt = VV[i * 64 + row], brt = BR[i], krt = KR[i];
            float sa = 0.f, yp = 0.f;
#pragma unroll
            for (int j = 0; j < 4; ++j) { sa += s[j] * a0[j]; yp += s[j] * q0[j]; }
#pragma unroll
            for (int j = 0; j < 4; ++j) { sa += s[4 + j] * a1[j]; yp += s[4 + j] * q1[j]; }
            sa = red8(sa); yp = red8(yp);
#pragma unroll
            for (int j = 0; j < 4; ++j) { s[j] = s[j] * w0[j] + sa * b0[j] + vt * kk0[j]; s[4 + j] = s[4 + j] * w1[j] + sa * b1[j] + vt * kk1[j]; }
            if ((tid & 7) == 0) YS[i * 64 + row] = yp + sa * brt + vt * krt;
        }
        __syncthreads();
        *(f32x4*)(Yout + (size_t)grow * 512 + hc) = *(const LAS f32x4*)(YS + ti * 64 + c4);
    }
    if (!lat) { float* sp = p.out + (size_t)MTOK * DM + ((((size_t)bseq * 2 + l) * 2 + dir) * 8 + h) * 4096 + row * 64 + k8;
#pragma unroll
        for (int j = 0; j < 8; ++j) sp[j] = s[j]; }
    __syncthreads();
}

__device__ __forceinline__ void fnet1_item(CKP& p, int l, LAS unsigned char* lds, int item) {
    const int tid = opaque_tid(), tb = item >> 2, g = item & 3, tok0 = tb * 64;
    const bf16* proj = (const bf16*)(p.ws + WS_PROJ);
    LAS float* XT = (LAS float*)lds;
    LAS float* FWL = XT + 64 * 65;
    { const int ti = tid >> 3, c8 = (tid & 7) * 8; float x[8]; load8bf(proj + (size_t)(tok0 + ti) * DINP + F_OFF + g * 64 + c8, x);
#pragma unroll
      for (int j = 0; j < 8; ++j) XT[ti * 65 + c8 + j] = x[j]; }
    const float* fw = (const float*)(p.ws + WS_FW) + (size_t)(l * 4 + g) * 8192;
    for (int i = tid; i < 2048; i += NTHR) *(LAS f32x4*)(FWL + i * 4) = *(const f32x4*)(fw + i * 4);
    __syncthreads();
    const int ti = tid & 63, og = tid >> 6;
    f32x4 acc[4];
#pragma unroll
    for (int j = 0; j < 4; ++j) acc[j] = (f32x4){0.f, 0.f, 0.f, 0.f};
#pragma unroll 4
    for (int c = 0; c < 64; ++c) { const float x = XT[ti * 65 + c];
#pragma unroll
        for (int j = 0; j < 4; ++j) acc[j] += x * *(const LAS f32x4*)(FWL + c * 128 + og * 16 + j * 4); }
    const bool lat = tok0 >= NCTX;
    const int L = lat ? 1024 : 256, bq = lat ? (tok0 - NCTX) >> 10 : tok0 >> 8, t = (lat ? (tok0 - NCTX) & 1023 : tok0 & 255) + ti;
    const float scale = lat ? (1.0f / 256.0f) : (1.0f / 128.0f);
    bf16* Y = (bf16*)(p.ws + WS_YCS) + (lat ? (size_t)8192 * 512 : 0);
    const int cs = og >> 2, K2 = 2 * L;
#pragma unroll
    for (int j = 0; j < 4; ++j)
#pragma unroll
        for (int e = 0; e < 4; ++e) { const int d = (og & 3) * 16 + j * 4 + e;
            Y[(size_t)((bq * 4 + g) * 64 + d) * K2 + cs * L + t] = (bf16)f2bf(acc[j][e] * scale); }
    __syncthreads();
}

__device__ __forceinline__ void pool_item(CKP& p, int l, LAS unsigned char* lds, int item) {
    const int tid = opaque_tid(), tb = item >> 2, gi = item & 3, tok0 = tb * 64, hw = 1 << gi;
    const bf16* proj = (const bf16*)(p.ws + WS_PROJ);
    LAS float* DT = (LAS float*)lds;
    LAS float* WP = DT + 64 * 65;
    const float* wpool = p.in[I_WPOOL] + (size_t)(l * 4 + gi) * 4096;
    for (int i = tid; i < 1024; i += NTHR) *(LAS f32x4*)(WP + i * 4) = *(const f32x4*)(wpool + i * 4);
    const int ti = tid >> 3, c8 = (tid & 7) * 8, tok = tok0 + ti, col = P_OFF + gi * 64 + c8;
    { float sum[8], x[8];
#pragma unroll
      for (int j = 0; j < 8; ++j) sum[j] = 0.f;
      load8bf(proj + (size_t)tok * DINP + col, x);
      float cnt;
      if (tok < NCTX) { const int t = tok & 255, sb = tok - t, lo = max(t - hw, 0), hi = min(t + hw, 256);
          for (int q = lo; q < hi; ++q) { float y[8]; load8bf(proj + (size_t)(sb + q) * DINP + col, y);
#pragma unroll
              for (int j = 0; j < 8; ++j) sum[j] += y[j]; }
          cnt = (float)(hi - lo); }
      else { const int t = (tok - NCTX) & 1023, sb = tok - t, r = t >> 6, c = t & 63, rlo = max(r - hw, 0), rhi = min(r + hw, 16), clo = max(c - hw, 0), chi = min(c + hw, 64);
          for (int rq = rlo; rq < rhi; ++rq) for (int cq = clo; cq < chi; ++cq) { float y[8]; load8bf(proj + (size_t)(sb + rq * 64 + cq) * DINP + col, y);
#pragma unroll
              for (int j = 0; j < 8; ++j) sum[j] += y[j]; }
          cnt = (float)((rhi - rlo) * (chi - clo)); }
      const float ic = 1.0f / cnt;
#pragma unroll
      for (int j = 0; j < 8; ++j) DT[ti * 65 + c8 + j] = sum[j] * ic - x[j]; }
    __syncthreads();
    f32x4 a0 = (f32x4){0.f, 0.f, 0.f, 0.f}, a1 = a0;
#pragma unroll 4
    for (int c = 0; c < 64; ++c) { const float d = DT[ti * 65 + c]; a0 += d * *(const LAS f32x4*)(WP + c * 64 + c8); a1 += d * *(const LAS f32x4*)(WP + c * 64 + c8 + 4); }
    const float* ps = p.in[I_PSCALE] + l * 256 + gi * 64 + c8;
    const f32x4 s0 = *(const f32x4*)ps, s1 = *(const f32x4*)(ps + 4);
    a0 *= s0; a1 *= s1;
    u32x4 w; w.x = pk2(a0[0], a0[1]); w.y = pk2(a0[2], a0[3]); w.z = pk2(a1[0], a1[1]); w.w = pk2(a1[2], a1[3]);
    *(u32x4*)((bf16*)(p.ws + WS_MIXED) + (size_t)tok * DM + 768 + gi * 64 + c8) = w;
    __syncthreads();
}

__device__ __forceinline__ void post_item(CKP& p, int l, LAS unsigned char* lds, int item) {
    const int tid = opaque_tid(), tok0 = item * 16;
    const bf16* proj = (const bf16*)(p.ws + WS_PROJ);
    const float* mu = p.in[I_MU] + l * 1920;
    LAS float* SG = (LAS float*)lds;
    const bool lat = tok0 >= NCTX; const int L = lat ? 1024 : 256, tseq0 = lat ? (tok0 - NCTX) & 1023 : tok0 & 255;
    { const int ti = tid >> 5, r4 = (tid & 31) * 4, t = tseq0 + ti; float u[4];
      shift4(proj, tok0 + ti, t > 0, t < L - 1, GD_OFF + r4, mu, u);
#pragma unroll
      for (int j = 0; j < 4; ++j) SG[ti * 128 + r4 + j] = 1.0f / (1.0f + __expf(-u[j])); }
    __syncthreads();
    const int c = tid, head = tid >> 6;
    float g[16];
#pragma unroll
    for (int i = 0; i < 16; ++i) g[i] = 0.f;
    const float* gup = p.in[I_GUP] + (size_t)l * 128 * 512 + c;
    for (int r = 0; r < 128; r += 4) { const float w0 = gup[(r + 0) * 512], w1 = gup[(r + 1) * 512], w2 = gup[(r + 2) * 512], w3 = gup[(r + 3) * 512];
#pragma unroll
        for (int i = 0; i < 16; ++i) { const f32x4 sg = *(const LAS f32x4*)(SG + i * 128 + r); g[i] += (sg.x * w0 + sg.y * w1) + (sg.z * w2 + sg.w * w3); } }
    const float lnw = p.in[I_LNW][l * 512 + c], lnb = p.in[I_LNB][l * 512 + c], muv = mu[V_OFF + c];
    const float* YF = (const float*)(p.ws + WS_YF); const float* YB = (const float*)(p.ws + WS_YB);
    const float* BC0 = (const float*)(p.ws + WS_BC); const float* BC1 = BC0 + (size_t)MTOK * 8;
    bf16* MIX = (bf16*)(p.ws + WS_MIXED);
#pragma unroll 4
    for (int i = 0; i < 16; ++i) { const int tok = tok0 + i, t = tseq0 + i;
        const float y = YF[(size_t)tok * 512 + c] + YB[(size_t)tok * 512 + c];
        const float mean = wave_sum(y) * (1.0f / 64.0f), dlt = y - mean, var = wave_sum(dlt * dlt) * (1.0f / 64.0f);
        const float yn = dlt * (1.0f / sqrtf(var + 64e-5f)) * lnw + lnb;
        const float pv = bf1(proj[(size_t)tok * DINP + V_OFF + c]);
        const float pa = t > 0 ? bf1(proj[(size_t)(tok - 1) * DINP + V_OFF + c]) : 0.f, pb = t < L - 1 ? bf1(proj[(size_t)(tok + 1) * DINP + V_OFF + c]) : 0.f;
        const float v = pv + muv * (0.5f * (pa + pb) - pv);
        const float bonus = (BC0[(size_t)tok * 8 + head] + BC1[(size_t)tok * 8 + head]) * v;
        MIX[(size_t)tok * DM + c] = (bf16)f2bf((yn + bonus) * g[i]); }
    __syncthreads();
}

#define XB_TMO      128
#define XB_XCNT(j)  (256  + 64 * (j))
#define XB_XSUB(j)  (1280 + 64 * (j))
#define XB_XGEN(j)  (2304 + 64 * (j))
#define XB_TOP      3328
#define XB_TOPGEN   3392
#define XCD_BAR_WORDS 3456
#define XB_SPIN_CAP (1u << 18)

__device__ __forceinline__ unsigned xb_ld(unsigned* p)              { return __hip_atomic_load(p, __ATOMIC_RELAXED, __HIP_MEMORY_SCOPE_AGENT); }
__device__ __forceinline__ unsigned xb_add(unsigned* p, unsigned v) { return __hip_atomic_fetch_add(p, v, __ATOMIC_RELAXED, __HIP_MEMORY_SCOPE_AGENT); }
__device__ __forceinline__ unsigned xb_xcc_id() { return (unsigned)__builtin_amdgcn_s_getreg((3 << 11) | 20) & 0xFu; }
#define XB_SPIN(cond, bar) do { unsigned _sp = 0; while (cond) { __builtin_amdgcn_s_sleep(1); \
    if ((++_sp & 255u) == 0u) { if (xb_ld(&(bar)[XB_TMO])) break; if (_sp > XB_SPIN_CAP) { atomicAdd(&(bar)[XB_TMO], 1u); break; } } } } while (0)

struct XcdBarrier {
    unsigned* bar; unsigned x;
    volatile LAS unsigned* st;
};

__device__ __forceinline__ XcdBarrier xcd_barrier_post(unsigned* bar, volatile LAS unsigned* st) {
    XcdBarrier b; b.bar = bar; b.x = xb_xcc_id(); b.st = st;
    if (threadIdx.x == 0) (void)xb_add(&bar[XB_XCNT(b.x)], 1u);
    return b;
}
__device__ __forceinline__ void xcd_barrier_complete(unsigned* bar, unsigned x, unsigned& nloc, unsigned& nx) {
    const unsigned G = gridDim.x * gridDim.y * gridDim.z;
    unsigned sum, cnt, mine, sp = 0u;
    for (;;) {
        sum = 0u; cnt = 0u; mine = 0u;
#pragma unroll
        for (unsigned j = 0; j < 16; ++j) { const unsigned c = xb_ld(&bar[XB_XCNT(j)]); sum += c; cnt += (c > 0u) ? 1u : 0u; mine = (j == x) ? c : mine; }
        if (sum == G) break;
        __builtin_amdgcn_s_sleep(1);
        if ((++sp & 255u) == 0u) { if (xb_ld(&bar[XB_TMO])) break; if (sp > XB_SPIN_CAP) { atomicAdd(&bar[XB_TMO], 1u); break; } }
    }
    nloc = mine > 0u ? mine : 1u; nx = cnt > 0u ? cnt : 1u;
}

__device__ __forceinline__ void xcd_barrier(const XcdBarrier& b) {
    asm volatile("s_waitcnt vmcnt(0)" ::: "memory");
    __syncthreads();
    if (threadIdx.x == 0) {
        unsigned* bar = b.bar;
        __builtin_amdgcn_s_waitcnt(0);
        unsigned nloc = b.st[0], nx = b.st[1];
        if (nloc == 0u) { xcd_barrier_complete(bar, b.x, nloc, nx); b.st[0] = nloc; b.st[1] = nx; }
        const unsigned old = xb_add(&bar[XB_XSUB(b.x)], 1u);
        const unsigned gen = old / nloc;
        if (old + 1u == (gen + 1u) * nloc) {
            __builtin_amdgcn_fence(__ATOMIC_RELEASE, "agent");
            asm volatile("s_waitcnt vmcnt(0)" ::: "memory");
            const unsigned og = xb_add(&bar[XB_TOP], 1u);
            const unsigned tg = og / nx;
            if (og + 1u == (tg + 1u) * nx) xb_add(&bar[XB_TOPGEN], 1u);
            else XB_SPIN(xb_ld(&bar[XB_TOPGEN]) == tg, bar);
            __builtin_amdgcn_fence(__ATOMIC_ACQUIRE, "agent");
            xb_add(&bar[XB_XGEN(b.x)], 1u);
            asm volatile("s_waitcnt vmcnt(0)" ::: "memory");
        } else {
            XB_SPIN(xb_ld(&bar[XB_XGEN(b.x)]) == gen, bar);
            __builtin_amdgcn_fence(__ATOMIC_ACQUIRE, "agent");
            asm volatile("s_waitcnt vmcnt(0)" ::: "memory");
        }
    }
    __syncthreads();
}

constexpr int N_STEPS = 22;
__device__ __forceinline__ bool step_seam(int st) { if (st == 0) return true; if (st >= 21) return false; const int s = (st - 1) % 10; return !(s == 3 || s == 4); }
__global__ void __launch_bounds__(NTHR, 2) mega_fwd(KP p_unused) {
    extern __shared__ __attribute__((aligned(16))) unsigned char lds_raw[];
    CKP* kp0 = (CKP*)__builtin_amdgcn_kernarg_segment_ptr();
    { LAS unsigned* ctlw = (LAS unsigned*)((LAS unsigned char*)lds_raw + RING_BYTES);
      for (int u = threadIdx.x; u < (LDS_BYTES - RING_BYTES) / 4; u += NTHR) ctlw[u] = 0u; }
    __syncthreads();
    const XcdBarrier bar = xcd_barrier_post((unsigned*)(kp0->ws + WS_CTL) + 4096, (volatile LAS unsigned*)((LAS unsigned char*)lds_raw + MISC_OFF + 32));
    const int ph_lo = kp0->ph_lo, ph_hi = kp0->ph_hi;
#pragma unroll 1
    for (int st = ph_lo; st < ph_hi; ++st) {
        CKP* kp = kp0; asm volatile("" : "+s"(kp));
        CKP& p = *kp; unsigned char* ws = p.ws;
        int bid = blockIdx.x, nb = gridDim.x; unsigned ldsb = (unsigned)(size_t)(LAS unsigned char*)lds_raw;
        asm volatile("" : "+s"(bid), "+s"(nb), "+s"(ldsb));
        LAS unsigned char* lds = (LAS unsigned char*)(size_t)ldsb;
        const int l = st == 0 ? 0 : (st - 1) / 10, s = st == 0 ? -1 : (st == 21 ? 10 : (st - 1) % 10);
        const float* mod = (const float*)(ws + WS_MOD) + (size_t)l * 5 * 6144;
        pg8::Gemm g{nullptr, nullptr, 0, 0, 0, 0, 0}; pg8::EpiAny E{-1, true, nullptr, nullptr, 0, 0}; int corder = bid;
        if (s == 1) { g = pg8::Gemm{(const bf16*)(ws + WS_H), (const bf16*)(ws + WS_WIN) + (size_t)l * DINP * DM, MTOK, DINP, DM, DM, DM}; E = pg8::EpiAny{0, true, ws + WS_PROJ, nullptr, DINP, 0}; }
        else if (s == 3) { g = pg8::Gemm{(const bf16*)(ws + WS_CS256), (const bf16*)(ws + WS_YCS), 256, 8192, 512, 512, 512}; E = pg8::EpiAny{3, true, ws + WS_MIXED, nullptr, 0, 256}; }
        else if (s == 4) { g = pg8::Gemm{(const bf16*)(ws + WS_CS1024), (const bf16*)(ws + WS_YCS) + (size_t)8192 * 512, 1024, 1024, 2048, 2048, 2048}; E = pg8::EpiAny{3, true, ws + WS_MIXED, nullptr, NCTX, 1024}; corder = (bid + nb - 32) % nb; }
        else if (s == 6) { g = pg8::Gemm{(const bf16*)(ws + WS_MIXED), (const bf16*)(ws + WS_WOUT) + (size_t)l * DM * DM, MTOK, DM, DM, DM, DM}; E = pg8::EpiAny{2, false, p.out, mod + 2 * 1024, 0, 0}; }
        else if (s == 8) { g = pg8::Gemm{(const bf16*)(ws + WS_H), (const bf16*)(ws + WS_W1) + (size_t)l * DFF * DM, MTOK, DFF, DM, DM, DM}; E = pg8::EpiAny{1, true, ws + WS_FF, nullptr, DFF, 0}; }
        else if (s == 9) { g = pg8::Gemm{(const bf16*)(ws + WS_FF), (const bf16*)(ws + WS_W2) + (size_t)l * DM * DFF, MTOK, DM, DFF, DFF, DFF}; E = pg8::EpiAny{2, false, p.out, mod + 5 * 1024, 0, 0}; }
        if (E.mode >= 0) {
            pg8::StaticOrder S; S.init(g.M, g.N, nb, corder);
            pg8::gemm_phase<pg8::EpiAny, pg8::StaticOrder, true, true>(lds, g, S, E);
            __syncthreads();
        } else if (s == -1) stage_prologue(p, lds, bid, nb);
        else if (s == 0) stage_norm(p, l, 0, bid, nb);
        else if (s == 2) {
            if (nb >= 256) { if (bid < 64) rwkv_item(p, l, lds, bid); else for (int it = 64 + (bid - 64); it < 576; it += nb - 64) rwkv_item(p, l, lds, it); }
            else for (int it = bid; it < 576; it += nb) rwkv_item(p, l, lds, it);
            for (int it = bid; it < 768; it += nb) fnet1_item(p, l, lds, it);
            for (int it = bid; it < 768; it += nb) pool_item(p, l, lds, it);
        }
        else if (s == 5) { for (int it = bid; it < 768; it += nb) post_item(p, l, lds, it); }
        else if (s == 7) stage_norm(p, l, 1, bid, nb);
        else stage_final(p, bid, nb);
        if (st + 1 < ph_hi && step_seam(st)) xcd_barrier(bar);
    }
}

extern "C" void kernel_launch(void* const* d_in, const int* in_sizes, int n_in, void* d_out, int out_size, void* d_ws, size_t ws_size, hipStream_t stream) {
    static int grid = 0;
    if (grid == 0) {
        if (n_in != N_IN || ws_size < WS_END) { fprintf(stderr, "kernel_launch: unexpected inputs (n_in %d, ws %zu)\n", n_in, ws_size); grid = -1; return; }
        int dev = 0, cus = 0, per_cu = 0;
        (void)hipGetDevice(&dev); (void)hipDeviceGetAttribute(&cus, hipDeviceAttributeMultiprocessorCount, dev);
        (void)hipFuncSetAttribute((const void*)mega_fwd, hipFuncAttributeMaxDynamicSharedMemorySize, LDS_BYTES);
        if (hipOccupancyMaxActiveBlocksPerMultiprocessor(&per_cu, (const void*)mega_fwd, NTHR, LDS_BYTES) != hipSuccess || per_cu < 1) {
            fprintf(stderr, "kernel_launch: occupancy query reports %d blocks/CU\n", per_cu); (void)hipGetLastError(); grid = -1; return; }
        grid = cus * 1;
    }
    if (grid < 0) return;
    KP a{};
    for (int i = 0; i < N_IN; ++i) a.in[i] = (const float*)d_in[i];
    a.out = (float*)d_out; a.ws = (unsigned char*)d_ws; a.ph_lo = 0; a.ph_hi = N_STEPS;
    if (hipMemsetAsync((char*)d_ws + WS_CTL, 0, 1 * MiB, stream) != hipSuccess) { fprintf(stderr, "kernel_launch: memset failed\n"); return; }
    void* args[] = {&a};
    hipError_t e = hipLaunchCooperativeKernel((const void*)mega_fwd, dim3(grid), dim3(NTHR), args, LDS_BYTES, stream);
    if (e != hipSuccess) fprintf(stderr, "cooperative launch failed: %s (grid %d)\n", hipGetErrorString(e), grid);
}
```

```cpp
#include <hip/hip_runtime.h>
#include <hip/hip_cooperative_groups.h>
#include <cstdio>
#include <cstdint>
namespace cg = cooperative_groups;
__device__ __forceinline__ int opaque_tid() { int t = threadIdx.x; asm volatile("" : "+v"(t)); return t; }
namespace pg8 {
#define PG8_LAS __attribute__((address_space(3)))
typedef unsigned short bf16_t;
typedef short bf16x8 __attribute__((ext_vector_type(8)));
typedef float f32x4 __attribute__((ext_vector_type(4)));
typedef unsigned u32x4 __attribute__((ext_vector_type(4)));
constexpr int BM = 256, BK = 64, HALF = 128, HTB = HALF * BK * 2  , STAGE_BYTES = 8 * HTB, NXCD = 8, WGM = 8;

__host__ __device__ __forceinline__ int lds_byte(int r, int c) { const int st = (r >> 4) * 2 + (c >> 5), rr = r & 15, cc = c & 31, ob = rr * 64 + cc * 2; return st * 1024 + (ob ^ (((ob >> 9) & 1) << 5)); }
__host__ __device__ __forceinline__ void stage_rc(int b, int& R, int& C) { const int st = b / 1024, sb = b % 1024, swz = sb ^ (((sb >> 9) & 1) << 5); R = (st >> 1) * 16 + swz / 64; C = (st & 1) * 32 + (swz % 64) / 2; }
__host__ __device__ __forceinline__ int perm32(int rho) { const int n = rho >> 4, i = rho & 15; return 8 * (i >> 2) + 4 * n + (i & 3); }

struct Unit { int pm, pn; };
struct Gemm { const bf16_t* A; const bf16_t* Bt; int M, N, K, lda, ldb; };

struct StaticOrder {
    int nM, nN, nwg, G, c;
    __host__ __device__ void init(int M, int N, int G_, int c_) { nM = M / BM; nN = N / BM; nwg = nM * nN; G = G_; c = c_; }
    __host__ __device__ bool next(int i, Unit& u) const {
        const long L = (long)i * G + c; if (L >= nwg) return false;
        int wgid = (int)L; { const int q = nwg / NXCD, r = nwg % NXCD, xcd = wgid % NXCD, off = wgid / NXCD; wgid = (xcd < r ? xcd * (q + 1) : r * (q + 1) + (xcd - r) * q) + off; }
        const int nig = WGM * nN, gid = wgid / nig, fm = gid * WGM, gsz = (nM - fm) < WGM ? (nM - fm) : WGM;
        u.pm = fm + ((wgid % nig) % gsz); u.pn = (wgid % nig) / gsz; return true;
    }
    __device__ __forceinline__ void a_ready(const Unit&) const {}
    __device__ __forceinline__ void done(const Unit&) const {}
};

__device__ __forceinline__ unsigned cvt_pk_bf16(float lo, float hi) { unsigned r; asm volatile("v_cvt_pk_bf16_f32 %0, %1, %2" : "=v"(r) : "v"(lo), "v"(hi)); return r; }
template <int ACT  > struct EpiBf {
    static constexpr bool PERM = true, AFTER_DRAIN = false;
    bf16_t* O; int ldc;
    __device__ __forceinline__ void operator()(const f32x4 (&acc)[2][2][4][2], const Unit& u, int wr, int wc, int fr, int fq) const {
        const int row0 = u.pm * BM + wr * 64 + fr, col0 = u.pn * BM + wc * 32 + 8 * fq;
#pragma unroll
        for (int ai = 0; ai < 2; ++ai)
#pragma unroll
            for (int m = 0; m < 4; ++m) { bf16_t* rowp = O + (size_t)(row0 + ai * HALF + m * 16) * ldc + col0;
#pragma unroll
                for (int bj = 0; bj < 2; ++bj) { f32x4 v0 = acc[ai][bj][m][0], v1 = acc[ai][bj][m][1];
                    if (ACT == 1) {
#pragma unroll
                        for (int e = 0; e < 4; ++e) { float a = v0[e] > 0.f ? v0[e] : 0.f; v0[e] = a * a; float b = v1[e] > 0.f ? v1[e] : 0.f; v1[e] = b * b; } }
                    u32x4 w; w.x = cvt_pk_bf16(v0[0], v0[1]); w.y = cvt_pk_bf16(v0[2], v0[3]); w.z = cvt_pk_bf16(v1[0], v1[1]); w.w = cvt_pk_bf16(v1[2], v1[3]);
                    *(u32x4*)(rowp + bj * HALF) = w; } }
    }
};
struct EpiRes {
    static constexpr bool PERM = false, AFTER_DRAIN = false;
    float* X; const float* gate;
    __device__ __forceinline__ void operator()(const f32x4 (&acc)[2][2][4][2], const Unit& u, int wr, int wc, int fr, int fq) const {
        const int row0 = u.pm * BM + wr * 64 + fr, col0 = u.pn * BM + wc * 32 + 4 * fq;
        const int cond = u.pm < 32 ? 0 : 1 + ((u.pm - 32) >> 2);
        const float* gp = gate + cond * 6144 + col0;
        f32x4 gv[2][2];
#pragma unroll
        for (int bj = 0; bj < 2; ++bj)
#pragma unroll
            for (int n = 0; n < 2; ++n) gv[bj][n] = *(const f32x4*)(gp + bj * HALF + n * 16);
#pragma unroll
        for (int ai = 0; ai < 2; ++ai)
#pragma unroll
            for (int m = 0; m < 4; ++m) { float* rowp = X + (size_t)(row0 + ai * HALF + m * 16) * 1024 + col0;
#pragma unroll
                for (int bj = 0; bj < 2; ++bj)
#pragma unroll
                    for (int n = 0; n < 2; ++n) { f32x4* q = (f32x4*)(rowp + bj * HALF + n * 16); *q = *q + gv[bj][n] * acc[ai][bj][m][n]; }
                if (m & 1) asm volatile("" ::: "memory"); }
    }
};
struct EpiFnet {
    static constexpr bool PERM = true, AFTER_DRAIN = false;
    bf16_t* MIX; int rowbase, L;
    __device__ __forceinline__ void operator()(const f32x4 (&acc)[2][2][4][2], const Unit& u, int wr, int wc, int fr, int fq) const {
        const int row0 = u.pm * BM + wr * 64 + fr, colw = wc * 32 + 8 * fq;
        bf16_t* base = MIX + (size_t)(rowbase + u.pn * L) * 1024 + 512 + colw;
#pragma unroll
        for (int ai = 0; ai < 2; ++ai)
#pragma unroll
            for (int m = 0; m < 4; ++m) { bf16_t* rowp = base + (size_t)(row0 + ai * HALF + m * 16) * 1024;
#pragma unroll
                for (int bj = 0; bj < 2; ++bj) { const f32x4 v0 = acc[ai][bj][m][0], v1 = acc[ai][bj][m][1];
                    u32x4 w; w.x = cvt_pk_bf16(v0[0], v0[1]); w.y = cvt_pk_bf16(v0[2], v0[3]); w.z = cvt_pk_bf16(v1[0], v1[1]); w.w = cvt_pk_bf16(v1[2], v1[3]);
                    *(u32x4*)(rowp + bj * HALF) = w; } }
    }
};

struct EpiAny {
    static constexpr bool AFTER_DRAIN = false;
    int mode; bool PERM; void* out; const float* aux; int i0, i1;
    __device__ __forceinline__ void operator()(const f32x4 (&acc)[2][2][4][2], const Unit& u, int wr, int wc, int fr, int fq) const {
        if (mode == 0) { const EpiBf<0> e{(bf16_t*)out, i0}; e(acc, u, wr, wc, fr, fq); }
        else if (mode == 1) { const EpiBf<1> e{(bf16_t*)out, i0}; e(acc, u, wr, wc, fr, fq); }
        else if (mode == 2) { const EpiRes e{(float*)out, aux}; e(acc, u, wr, wc, fr, fq); }
        else { const EpiFnet e{(bf16_t*)out, i0, i1}; e(acc, u, wr, wc, fr, fq); }
    }
};
template <class Epi, class Sched, bool ALIGN_EPI = false, bool SP2 = false>
__device__ __forceinline__ void gemm_phase(PG8_LAS unsigned char* lds, const Gemm g, const Sched& S, const Epi& E) {
    const int tid = opaque_tid(), wid = __builtin_amdgcn_readfirstlane(tid >> 6), lane = tid & 63, wr = wid >> 2, wc = wid & 3, fr = lane & 15, fq = lane >> 4;
    const int K = g.K, nt = K / BK;
    unsigned voffA[2], voffB[2];
#pragma unroll
    for (int i = 0; i < 2; ++i) { int R, C; stage_rc(tid * 16 + i * 8192, R, C); const int Rb = E.PERM ? ((R & ~31) + perm32(R & 31)) : R;
        voffA[i] = (unsigned)(R * g.lda + C) * 2u; voffB[i] = (unsigned)(Rb * g.ldb + C) * 2u; }
    const size_t kstep = (size_t)(BK * 2);
    const size_t hstepA = (size_t)HALF * g.lda * 2, hstepB = (size_t)HALF * g.ldb * 2;
    const size_t tstepA = 2 * hstepA, tstepB = 2 * hstepB;
    const unsigned ldsw = (unsigned)wid * 1024u;
    const int aoff = lds_byte(wr * 64 + fr, fq * 8), boff = lds_byte(wc * 32 + fr, fq * 8);
#define PG8_SA(b, h) (((b) * 2 + (h)) * HTB)
#define PG8_SB(b, h) ((4 + (b) * 2 + (h)) * HTB)
#define PG8_STAGE(bufoff, gbase, voff) do { _Pragma("unroll") for (int _i = 0; _i < 2; ++_i) \
        __builtin_amdgcn_global_load_lds((const unsigned*)((const char*)(gbase) + (voff)[_i]), (PG8_LAS unsigned*)(lds + (bufoff) + ldsw + _i * 8192), 16, 0, 0); } while (0)
#define PG8_LDA(dst, b, h) do { _Pragma("unroll") for (int m = 0; m < 4; ++m) _Pragma("unroll") for (int k = 0; k < 2; ++k) dst[m][k] = *(const PG8_LAS bf16x8*)(lds + PG8_SA(b, h) + aoff + m * 2048 + k * 1024); } while (0)
#define PG8_LDB(dst, b, h) do { _Pragma("unroll") for (int n = 0; n < 2; ++n) _Pragma("unroll") for (int k = 0; k < 2; ++k) dst[n][k] = *(const PG8_LAS bf16x8*)(lds + PG8_SB(b, h) + boff + n * 2048 + k * 1024); } while (0)
#define PG8_MMA(ai, bj, At, Bt) do { __builtin_amdgcn_s_setprio(1); _Pragma("unroll") for (int m = 0; m < 4; ++m) _Pragma("unroll") for (int n = 0; n < 2; ++n) _Pragma("unroll") for (int k = 0; k < 2; ++k) \
        acc[ai][bj][m][n] = __builtin_amdgcn_mfma_f32_16x16x32_bf16(Bt[n][k], At[m][k], acc[ai][bj][m][n], 0, 0, 0); __builtin_amdgcn_s_setprio(0); } while (0)
#define PG8_WAIT_V(n) asm volatile("s_waitcnt vmcnt(" #n ")" ::: "memory")
#define PG8_WAIT_L(n) asm volatile("s_waitcnt lgkmcnt(" #n ")" ::: "memory")
#define PG8_BAR __builtin_amdgcn_s_barrier()
#define PG8_SCHED __builtin_amdgcn_sched_barrier(0)
    Unit cur, nxt; int ui = 0;
    if (!S.next(0, cur)) return;
    f32x4 acc[2][2][4][2];
#pragma unroll
    for (int a = 0; a < 2; ++a)
#pragma unroll
        for (int b = 0; b < 2; ++b)
#pragma unroll
            for (int m = 0; m < 4; ++m)
#pragma unroll
                for (int n = 0; n < 2; ++n) acc[a][b][m][n] = (f32x4){0.f, 0.f, 0.f, 0.f};
    bf16x8 At[4][2], B0[2][2], B1[2][2];
    const char* cA = (const char*)g.A + (size_t)cur.pm * tstepA; const char* cB = (const char*)g.Bt + (size_t)cur.pn * tstepB;
    S.a_ready(cur);
    if constexpr (SP2) {
        PG8_STAGE(PG8_SB(0, 0), cB, voffB); PG8_STAGE(PG8_SB(0, 1), cB + hstepB, voffB); PG8_STAGE(PG8_SA(0, 0), cA, voffA); PG8_STAGE(PG8_SA(0, 1), cA + hstepA, voffA);
        if (wr == 1) PG8_BAR;
        PG8_WAIT_V(2); PG8_BAR;
        PG8_STAGE(PG8_SB(1, 0), cB + kstep, voffB); PG8_STAGE(PG8_SA(1, 0), cA + kstep, voffA); PG8_STAGE(PG8_SB(1, 1), cB + hstepB + kstep, voffB);
        PG8_WAIT_V(6); PG8_BAR;
    } else {
        PG8_STAGE(PG8_SB(0, 0), cB, voffB); PG8_STAGE(PG8_SA(0, 0), cA, voffA); PG8_STAGE(PG8_SB(0, 1), cB + hstepB, voffB); PG8_STAGE(PG8_SA(0, 1), cA + hstepA, voffA);
        if (wr == 1) PG8_BAR;
        PG8_WAIT_V(4); PG8_BAR;
        PG8_STAGE(PG8_SB(1, 0), cB + kstep, voffB); PG8_STAGE(PG8_SA(1, 0), cA + kstep, voffA); PG8_STAGE(PG8_SB(1, 1), cB + hstepB + kstep, voffB);
        PG8_WAIT_V(6); PG8_BAR;
    }
    for (;;) {
        const bool has_next = S.next(ui + 1, nxt);
        const char* nA = has_next ? (const char*)g.A + (size_t)nxt.pm * tstepA : cA; const char* nB = has_next ? (const char*)g.Bt + (size_t)nxt.pn * tstepB : cB;
        for (int t = 0; t < nt; t += 2) {
            const bool last = (t == nt - 2);
            const char* a1 = cA + (size_t)(t + 1) * kstep;
            const char* a2 = last ? nA : cA + (size_t)(t + 2) * kstep; const char* b2 = last ? nB : cB + (size_t)(t + 2) * kstep;
            const char* a3 = a2 + kstep; const char* b3 = b2 + kstep;
            if (last && has_next) S.a_ready(nxt);
            if constexpr (SP2) {
            PG8_LDB(B0, 0, 0); PG8_LDB(B1, 0, 1); PG8_SCHED; PG8_LDA(At, 0, 0); PG8_STAGE(PG8_SA(1, 1), a1 + hstepA, voffA);
            PG8_WAIT_V(8); PG8_WAIT_L(0); PG8_BAR; PG8_MMA(0, 0, At, B0); PG8_MMA(0, 1, At, B1); PG8_BAR; PG8_SCHED;
            PG8_LDA(At, 0, 1); PG8_STAGE(PG8_SB(0, 0), b2, voffB); PG8_STAGE(PG8_SB(0, 1), b2 + hstepB, voffB); PG8_STAGE(PG8_SA(0, 0), a2, voffA);
            PG8_WAIT_V(8); PG8_WAIT_L(0); PG8_BAR; PG8_MMA(1, 0, At, B0); PG8_MMA(1, 1, At, B1); PG8_BAR; PG8_SCHED;
            PG8_LDB(B0, 1, 0); PG8_LDB(B1, 1, 1); PG8_SCHED; PG8_LDA(At, 1, 0); PG8_STAGE(PG8_SA(0, 1), a2 + hstepA, voffA);
            PG8_WAIT_V(8); PG8_WAIT_L(0); PG8_BAR; PG8_MMA(0, 0, At, B0); PG8_MMA(0, 1, At, B1); PG8_BAR; PG8_SCHED;
            PG8_LDA(At, 1, 1); PG8_STAGE(PG8_SB(1, 0), b3, voffB); PG8_STAGE(PG8_SB(1, 1), b3 + hstepB, voffB); PG8_STAGE(PG8_SA(1, 0), a3, voffA);
            PG8_WAIT_V(8); PG8_WAIT_L(0); PG8_BAR; PG8_MMA(1, 0, At, B0); PG8_MMA(1, 1, At, B1); PG8_BAR; PG8_SCHED;
            } else {
            PG8_LDB(B0, 0, 0); PG8_SCHED; PG8_LDA(At, 0, 0); PG8_STAGE(PG8_SA(1, 1), a1 + hstepA, voffA);
            PG8_WAIT_L(8); PG8_BAR; PG8_WAIT_L(0); PG8_MMA(0, 0, At, B0); PG8_BAR; PG8_SCHED;
            PG8_LDB(B1, 0, 1); PG8_STAGE(PG8_SB(0, 0), b2, voffB);
            PG8_BAR; PG8_WAIT_L(0); PG8_MMA(0, 1, At, B1); PG8_BAR;
            PG8_LDA(At, 0, 1); PG8_STAGE(PG8_SA(0, 0), a2, voffA);
            PG8_BAR; PG8_WAIT_L(0); PG8_MMA(1, 0, At, B0); PG8_BAR; PG8_SCHED;
            PG8_STAGE(PG8_SB(0, 1), b2 + hstepB, voffB);
            PG8_WAIT_V(6); PG8_BAR; PG8_MMA(1, 1, At, B1); PG8_BAR;
            PG8_LDB(B0, 1, 0); PG8_SCHED; PG8_LDA(At, 1, 0); PG8_STAGE(PG8_SA(0, 1), a2 + hstepA, voffA);
            PG8_WAIT_L(8); PG8_BAR; PG8_WAIT_L(0); PG8_MMA(0, 0, At, B0); PG8_BAR; PG8_SCHED;
            PG8_LDB(B1, 1, 1); PG8_STAGE(PG8_SB(1, 0), b3, voffB);
            PG8_BAR; PG8_WAIT_L(0); PG8_MMA(0, 1, At, B1); PG8_BAR;
            PG8_LDA(At, 1, 1); PG8_STAGE(PG8_SA(1, 0), a3, voffA);
            PG8_BAR; PG8_WAIT_L(0); PG8_MMA(1, 0, At, B0); PG8_BAR; PG8_SCHED;
            PG8_STAGE(PG8_SB(1, 1), b3 + hstepB, voffB);
            PG8_WAIT_V(6); PG8_BAR; PG8_MMA(1, 1, At, B1); PG8_BAR;
            }
        }
        if constexpr (ALIGN_EPI) { if (wr == 0) PG8_BAR; }
        if constexpr (!Epi::AFTER_DRAIN) { int fr2 = fr, fq2 = fq; asm volatile("" : "+v"(fr2), "+v"(fq2)); E(acc, cur, wr, wc, fr2, fq2); S.done(cur); }
        if (!has_next) break;
#pragma unroll
        for (int a = 0; a < 2; ++a)
#pragma unroll
            for (int b = 0; b < 2; ++b)
#pragma unroll
                for (int m = 0; m < 4; ++m)
#pragma unroll
                    for (int n = 0; n < 2; ++n) acc[a][b][m][n] = (f32x4){0.f, 0.f, 0.f, 0.f};
        cur = nxt; cA = nA; cB = nB; ++ui;
        if constexpr (ALIGN_EPI) { if (wr == 1) PG8_BAR; }
    }
    PG8_WAIT_V(0);
    if constexpr (!ALIGN_EPI) { if (wr == 0) PG8_BAR; }
    PG8_BAR;
    if constexpr (Epi::AFTER_DRAIN) { E.fused(acc, cur, wr, wc, fr, fq, lds, wid, lane); S.done(cur); }
#undef PG8_SA
#undef PG8_SB
#undef PG8_STAGE
#undef PG8_LDA
#undef PG8_LDB
#undef PG8_MMA
#undef PG8_WAIT_V
#undef PG8_WAIT_L
#undef PG8_BAR
#undef PG8_SCHED
}
}

#define LAS __attribute__((address_space(3)))
typedef unsigned short bf16;
typedef float f32x4 __attribute__((ext_vector_type(4)));
typedef unsigned u32x4 __attribute__((ext_vector_type(4)));
typedef unsigned u32x2 __attribute__((ext_vector_type(2)));
constexpr int DM = 1024, NCTX = 8192, MTOK = 12288, DINP = 2560, DFF = 4096;
constexpr int R_OFF = 0, K_OFF = 512, V_OFF = 1024, WD_OFF = 1536, AD_OFF = 1664, GD_OFF = 1792, F_OFF = 1920, P_OFF = 2176, DIN = 2432;
constexpr size_t MiB = 1u << 20;
constexpr size_t WS_CTL = 0, WS_MOD = 1 * MiB, WS_FW = 1 * MiB + 512 * 1024, WS_BC = 2 * MiB, WS_CS256 = 3 * MiB, WS_CS1024 = 4 * MiB, WS_WIN = 8 * MiB, WS_WOUT = 18 * MiB,
                 WS_W1 = 22 * MiB, WS_W2 = 38 * MiB, WS_H = 54 * MiB, WS_MIXED = 78 * MiB, WS_PROJ = 102 * MiB, WS_YCS = 162 * MiB, WS_YF = 174 * MiB, WS_YB = 198 * MiB,
                 WS_FF = 102 * MiB, WS_WUPT = 222 * MiB, WS_AUPT = 222 * MiB + 256 * 1024, WS_END = 223 * MiB;
constexpr int LDS_BYTES = 147456, RING_BYTES = 131072, MISC_OFF = RING_BYTES + 320;
constexpr int NTHR = 512;
enum { I_XP = 0, I_XS, I_STATE, I_C, I_CCTX, I_WADA, I_BADA, I_N1G, I_WIN, I_MU, I_W0, I_WUP, I_A0, I_AUP, I_GUP, I_KK, I_KA, I_RK, I_LNW, I_LNB, I_WFNET, I_WPOOL, I_PSCALE, I_WOUT, I_N2G, I_WFF1, I_WFF2, I_FNG, N_IN };
struct KP { const float* in[N_IN]; float* out; unsigned char* ws; int ph_lo, ph_hi; };
typedef const __attribute__((address_space(4))) KP CKP;

__device__ __forceinline__ unsigned f2bf(float f) { unsigned u = __builtin_bit_cast(unsigned, f); return (u + 0x7fffu + ((u >> 16) & 1u)) >> 16; }
__device__ __forceinline__ unsigned pk2(float lo, float hi) { return f2bf(lo) | (f2bf(hi) << 16); }
__device__ __forceinline__ float bflo(unsigned w) { return __builtin_bit_cast(float, w << 16); }
__device__ __forceinline__ float bfhi(unsigned w) { return __builtin_bit_cast(float, w & 0xffff0000u); }
__device__ __forceinline__ float bf1(bf16 h) { return __builtin_bit_cast(float, (unsigned)h << 16); }
__device__ __forceinline__ float fexp(float x) { return __builtin_amdgcn_exp2f(x * 1.4426950408889634f); }
__device__ __forceinline__ float flog(float x) { return __builtin_amdgcn_logf(x) * 0.6931471805599453f; }
__device__ __forceinline__ float frcp(float x) { return __builtin_amdgcn_rcpf(x); }
__device__ __forceinline__ float frsq(float x) { return __builtin_amdgcn_rsqf(x); }
__device__ __forceinline__ float fsigmoid(float x) { return frcp(1.0f + fexp(-x)); }
template <int CTRL> __device__ __forceinline__ float dppf(float x) { return __builtin_bit_cast(float, __builtin_amdgcn_update_dpp(0, __builtin_bit_cast(int, x), CTRL, 0xF, 0xF, true)); }
__device__ __forceinline__ float red8(float x)  { x += dppf<0xB1>(x); x += dppf<0x4E>(x); x += dppf<0x141>(x); return x; }
__device__ __forceinline__ float red16(float x) { x += dppf<0xB1>(x); x += dppf<0x4E>(x); x += dppf<0x141>(x); x += dppf<0x140>(x); return x; }
__device__ __forceinline__ float wave_sum(float v) {
    v = red16(v);
    const float s0 = __builtin_bit_cast(float, __builtin_amdgcn_readlane(__builtin_bit_cast(int, v), 0)), s1 = __builtin_bit_cast(float, __builtin_amdgcn_readlane(__builtin_bit_cast(int, v), 16));
    const float s2 = __builtin_bit_cast(float, __builtin_amdgcn_readlane(__builtin_bit_cast(int, v), 32)), s3 = __builtin_bit_cast(float, __builtin_amdgcn_readlane(__builtin_bit_cast(int, v), 48));
    return (s0 + s1) + (s2 + s3);
}
__device__ __forceinline__ void load4bf(const bf16* p, float (&o)[4]) { const u32x2 w = *(const u32x2*)p; o[0] = bflo(w.x); o[1] = bfhi(w.x); o[2] = bflo(w.y); o[3] = bfhi(w.y); }
__device__ __forceinline__ void load8bf(const bf16* p, float (&o)[8]) { const u32x4 w = *(const u32x4*)p; o[0] = bflo(w.x); o[1] = bfhi(w.x); o[2] = bflo(w.y); o[3] = bfhi(w.y); o[4] = bflo(w.z); o[5] = bfhi(w.z); o[6] = bflo(w.w); o[7] = bfhi(w.w); }
__device__ __forceinline__ void shift4(const bf16* proj, int row, bool hasp, bool hasn, int col, const float* mu, float (&u)[4]) {
    float p[4], a[4] = {0.f, 0.f, 0.f, 0.f}, b[4] = {0.f, 0.f, 0.f, 0.f};
    load4bf(proj + (size_t)row * DINP + col, p);
    if (hasp) load4bf(proj + (size_t)(row - 1) * DINP + col, a);
    if (hasn) load4bf(proj + (size_t)(row + 1) * DINP + col, b);
    const f32x4 m = *(const f32x4*)(mu + col);
#pragma unroll
    for (int j = 0; j < 4; ++j) u[j] = p[j] + m[j] * (0.5f * (a[j] + b[j]) - p[j]);
}

__device__ __forceinline__ void transpose_item(const float* W, int K, int N, bf16* WT, LAS float* scr, int item, int lane) {
    const int nblk = N / 32, kb = item / nblk, nb = item % nblk, k0 = 64 * kb, n0 = 32 * nb;
#pragma unroll 8
    for (int i = 0; i < 32; ++i) { const int kk = 2 * i + (lane >> 5); scr[kk * 33 + (lane & 31)] = W[(size_t)(k0 + kk) * N + n0 + (lane & 31)]; }
    asm volatile("s_waitcnt lgkmcnt(0)" ::: "memory");
    const int c = lane & 7;
#pragma unroll
    for (int j = 0; j < 4; ++j) { const int n = (lane >> 3) + 8 * j; const LAS float* s = scr + (8 * c) * 33 + n;
        u32x4 o; o.x = pk2(s[0 * 33], s[1 * 33]); o.y = pk2(s[2 * 33], s[3 * 33]); o.z = pk2(s[4 * 33], s[5 * 33]); o.w = pk2(s[6 * 33], s[7 * 33]);
        *(u32x4*)(WT + (size_t)(n0 + n) * K + k0 + 8 * c) = o; }
    asm volatile("s_waitcnt lgkmcnt(0)" ::: "memory");
}
__device__ __forceinline__ void stage_prologue(CKP& p, LAS unsigned char* lds, int bid, int nb) {
    const int tid = opaque_tid(), lane = tid & 63, wave = tid >> 6;
    unsigned char* ws = p.ws;
    {
        LAS float* scr = (LAS float*)(lds + wave * 16384);
        const int gw = bid * 8 + wave, NGW = nb * 8;
        constexpr int I_IN = 16 * 76, I_OUT = 16 * 32, I_1 = 16 * 128, I_2 = 64 * 32, I_L = I_IN + I_OUT + I_1 + I_2;
#pragma unroll 1
        for (int it = gw; it < 2 * I_L; it += NGW) {
            const int l = it / I_L; int r = it % I_L;
            if (r < I_IN) { transpose_item(p.in[I_WIN] + (size_t)l * DM * DIN, DM, DIN, (bf16*)(ws + WS_WIN) + (size_t)l * DINP * DM, scr, r, lane); continue; } r -= I_IN;
            if (r < I_OUT) { transpose_item(p.in[I_WOUT] + (size_t)l * DM * DM, DM, DM, (bf16*)(ws + WS_WOUT) + (size_t)l * DM * DM, scr, r, lane); continue; } r -= I_OUT;
            if (r < I_1) { transpose_item(p.in[I_WFF1] + (size_t)l * DM * DFF, DM, DFF, (bf16*)(ws + WS_W1) + (size_t)l * DFF * DM, scr, r, lane); continue; } r -= I_1;
            transpose_item(p.in[I_WFF2] + (size_t)l * DFF * DM, DFF, DM, (bf16*)(ws + WS_W2) + (size_t)l * DM * DFF, scr, r, lane);
        }
    }
    const int gt = bid * NTHR + tid, NGT = nb * NTHR;
#pragma unroll 1
    for (int i = gt; i < 2 * 128 * DM / 8; i += NGT) { const int l = i / (128 * DM / 8), r = i % (128 * DM / 8);
        *(u32x4*)((bf16*)(ws + WS_WIN) + (size_t)l * DINP * DM + (size_t)DIN * DM + (size_t)r * 8) = (u32x4){0u, 0u, 0u, 0u}; }
#pragma unroll 1
    for (int i = gt; i < 256 * 512 + 1024 * 2048; i += NGT) {
        int L, k, j; bf16* dst;
        if (i < 256 * 512) { L = 256; k = i / 512; j = i % 512; dst = (bf16*)(ws + WS_CS256) + i; }
        else { const int i2 = i - 256 * 512; L = 1024; k = i2 / 2048; j = i2 % 2048; dst = (bf16*)(ws + WS_CS1024) + i2; }
        const int jj = j >= L ? j - L : j; const int idx = (k * jj) & (L - 1);
        const float rev = (float)idx / (float)L; const float s = __builtin_amdgcn_sinf(rev), c = __builtin_amdgcn_cosf(rev);
        *dst = (bf16)f2bf(j >= L ? -s : c);
    }
#pragma unroll 1
    for (int i = gt; i < 2 * 4 * 64 * 128; i += NGT) {
        const int o = i & 127, c = (i >> 7) & 63, lg = i >> 13; const float* wf = p.in[I_WFNET] + (size_t)lg * 4096 + (o & 63);
        float acc = 0.f;
        for (int cp = 0; cp < 64; ++cp) { const float rev = (float)((c * cp) & 63) * (1.0f / 64.0f); const float s = __builtin_amdgcn_sinf(rev), co = __builtin_amdgcn_cosf(rev); acc += (o < 64 ? co : s) * wf[cp * 64]; }
        ((float*)(ws + WS_FW))[i] = acc;
    }
#pragma unroll 1
    for (int i = gt; i < 2 * 2 * 64 * 512; i += NGT) { const int c = i & 511, r = (i >> 9) & 63, ld = i >> 15;
        ((bf16*)(ws + WS_WUPT))[(size_t)(ld * 512 + c) * 64 + r] = (bf16)f2bf(p.in[I_WUP][i]);
        ((bf16*)(ws + WS_AUPT))[(size_t)(ld * 512 + c) * 64 + r] = (bf16)f2bf(p.in[I_AUP][i]); }
#pragma unroll 1
    for (int i = gt; i < MTOK * DM / 4; i += NGT) {
        const f32x4 v = i < NCTX * DM / 4 ? ((const f32x4*)p.in[I_XP])[i] : ((const f32x4*)p.in[I_XS])[i - NCTX * DM / 4];
        ((f32x4*)p.out)[i] = v;
    }
    __syncthreads();
    LAS float* sc = (LAS float*)lds; LAS float* red = (LAS float*)(lds + 20480);
#pragma unroll 1
    for (int it = bid; it < 192; it += nb) {
        const int l = it / 96, cgp = it % 96;
        for (int i = tid; i < 5 * 1024; i += NTHR) { const int cond = i >> 10, k = i & 1023; const float v = cond == 0 ? p.in[I_CCTX][k] : p.in[I_C][(cond - 1) * 1024 + k]; sc[i] = v * fsigmoid(v); }
        __syncthreads();
        const int cgi = tid & 15, kg = tid >> 4;
        f32x4 acc[5];
#pragma unroll
        for (int c = 0; c < 5; ++c) acc[c] = (f32x4){0.f, 0.f, 0.f, 0.f};
        const float* wp = p.in[I_WADA] + ((size_t)l * 1024 + kg * 32) * 6144 + cgp * 64 + cgi * 4;
#pragma unroll 4
        for (int kk = 0; kk < 32; ++kk) { const f32x4 w = *(const f32x4*)(wp + (size_t)kk * 6144);
#pragma unroll
            for (int c = 0; c < 5; ++c) acc[c] += sc[c * 1024 + kg * 32 + kk] * w; }
#pragma unroll
        for (int c = 0; c < 5; ++c) *(LAS f32x4*)(red + (kg * 5 + c) * 64 + cgi * 4) = acc[c];
        __syncthreads();
        if (tid < 320) { const int cond = tid >> 6, col = tid & 63; float s = p.in[I_BADA][l * 6144 + cgp * 64 + col];
            for (int g = 0; g < 32; ++g) s += red[(g * 5 + cond) * 64 + col];
            ((float*)(ws + WS_MOD))[(l * 5 + cond) * 6144 + cgp * 64 + col] = s; }
        __syncthreads();
    }
}

__device__ __forceinline__ void stage_norm(CKP& p, int l, int which, int bid, int nb) {
    const int tid = opaque_tid(), lane = tid & 63, wave = tid >> 6;
    const float* g = p.in[which ? I_N2G : I_N1G] + l * DM;
    const float* mod = (const float*)(p.ws + WS_MOD) + (size_t)l * 5 * 6144 + (which ? 3 * 1024 : 0);
    bf16* H = (bf16*)(p.ws + WS_H);
#pragma unroll 1
    for (int row = bid * 8 + wave; row < MTOK; row += nb * 8) {
        const f32x4* xr = (const f32x4*)(p.out + (size_t)row * DM) + lane;
        f32x4 v[4]; float s = 0.f;
#pragma unroll
        for (int j = 0; j < 4; ++j) { v[j] = xr[64 * j]; s += (v[j].x * v[j].x + v[j].y * v[j].y) + (v[j].z * v[j].z + v[j].w * v[j].w); }
        const float rstd = frsq(wave_sum(s) * (1.0f / DM) + 1e-6f);
        const int cond = row < NCTX ? 0 : 1 + ((row - NCTX) >> 10);
        const float* sh = mod + cond * 6144; const float* scl = sh + 1024;
        unsigned long long* o8 = (unsigned long long*)(H + (size_t)row * DM) + lane;
#pragma unroll
        for (int j = 0; j < 4; ++j) { const int col = 4 * lane + 256 * j; const f32x4 gg = *(const f32x4*)(g + col), a = *(const f32x4*)(sh + col), b = *(const f32x4*)(scl + col);
            const f32x4 y = v[j] * rstd * gg * (b + 1.0f) + a;
            o8[64 * j] = (unsigned long long)pk2(y.x, y.y) | ((unsigned long long)pk2(y.z, y.w) << 32); }
    }
}
__device__ __forceinline__ void stage_final(CKP& p, int bid, int nb) {
    const int tid = opaque_tid(), lane = tid & 63, wave = tid >> 6;
    const float* g = p.in[I_FNG];
#pragma unroll 1
    for (int row = bid * 8 + wave; row < MTOK; row += nb * 8) {
        f32x4* xr = (f32x4*)(p.out + (size_t)row * DM) + lane;
        f32x4 v[4]; float s = 0.f;
#pragma unroll
        for (int j = 0; j < 4; ++j) { v[j] = xr[64 * j]; s += (v[j].x * v[j].x + v[j].y * v[j].y) + (v[j].z * v[j].z + v[j].w * v[j].w); }
        const float rstd = frsq(wave_sum(s) * (1.0f / DM) + 1e-6f);
#pragma unroll
        for (int j = 0; j < 4; ++j) xr[64 * j] = v[j] * rstd * *(const f32x4*)(g + 4 * lane + 256 * j);
    }
}


typedef short bf16x8 __attribute__((ext_vector_type(8)));
typedef float f32x2v __attribute__((ext_vector_type(2)));
typedef __bf16 bf16x2v __attribute__((ext_vector_type(2)));
#define MFMA16(a, b, c) __builtin_amdgcn_mfma_f32_16x16x32_bf16((a), (b), (c), 0, 0, 0)
__device__ __forceinline__ unsigned cvt2(float lo, float hi) { f32x2v v = {lo, hi}; bf16x2v b = __builtin_convertvector(v, bf16x2v); return __builtin_bit_cast(unsigned, b); }
__device__ __forceinline__ u32x4 pack8(const float (&x)[8]) { u32x4 w; w.x = cvt2(x[0], x[1]); w.y = cvt2(x[2], x[3]); w.z = cvt2(x[4], x[5]); w.w = cvt2(x[6], x[7]); return w; }
__device__ __forceinline__ void shift8(const bf16* proj, int row, bool hasp, bool hasn, int col, const float* mu, float (&u)[8]) {
    float p[8], a[8], b[8];
    load8bf(proj + (size_t)row * DINP + col, p);
    if (hasp) load8bf(proj + (size_t)(row - 1) * DINP + col, a); else {
#pragma unroll
        for (int j = 0; j < 8; ++j) a[j] = 0.f; }
    if (hasn) load8bf(proj + (size_t)(row + 1) * DINP + col, b); else {
#pragma unroll
        for (int j = 0; j < 8; ++j) b[j] = 0.f; }
    const f32x4 m0 = *(const f32x4*)(mu + col), m1 = *(const f32x4*)(mu + col + 4);
#pragma unroll
    for (int j = 0; j < 4; ++j) { u[j] = p[j] + m0[j] * (0.5f * (a[j] + b[j]) - p[j]); u[4 + j] = p[4 + j] + m1[j] * (0.5f * (a[4 + j] + b[4 + j]) - p[4 + j]); }
}
__device__ __forceinline__ int opq(int x) { asm volatile("" : "+v"(x)); return x; }
constexpr int TS = 72, TB = 64 * TS * 2;
constexpr int L_HT = 0, L_TW = 9216, L_AD = 18432, L_LP = 27648, L_AP = 45056, L_AT = 62464, L_RT = L_AT + TB, L_BH = L_RT + TB, L_KH = L_BH + TB, L_BBT = L_KH + TB, L_KBT = L_BBT + TB,
              L_VT = L_KBT + TB, L_GE = L_VT + TB;
constexpr int L_VR = L_TW, L_BBR = L_AD, L_KBR = L_AP;
constexpr int L_AAB = 9216, L_AAK = L_AAB + 4096, L_ARB = L_AAK + 3072, L_ARK = L_ARB + 3072, L_AHAT = L_ARK + 3072, L_W1 = 32768, L_UT = L_W1 + 17408;
static_assert(L_AHAT + 4 * 16 * TS * 2 <= L_W1 && L_UT + 64 * 24 * 2 <= L_AT && L_GE + 1024 <= RING_BYTES, "scan LDS map");
constexpr int LPS = 68;

__device__ __forceinline__ void rwkv_item2(CKP& p, int l, LAS unsigned char* lds, int item) {
    const int tid0 = opaque_tid(), w = __builtin_amdgcn_readfirstlane(tid0 >> 6);
    int tid = tid0, fr = tid & 15, fg = (tid & 63) >> 4;
    int bseq, h, dir, L, base; bool lat;
    if (item < 64) { lat = true; bseq = item >> 4; h = (item >> 1) & 7; dir = item & 1; L = 1024; base = NCTX + bseq * 1024; }
    else { const int i2 = item - 64; lat = false; bseq = i2 >> 4; h = (i2 >> 1) & 7; dir = i2 & 1; L = 256; base = bseq * 256; }
    const bf16* proj = (const bf16*)(p.ws + WS_PROJ);
    const float* mu = p.in[I_MU] + l * 1920;
    float* Yout = (float*)(p.ws + (dir ? WS_YB : WS_YF));
    float* BC = (float*)(p.ws + WS_BC) + (size_t)dir * MTOK * 8;
    const bf16* wupt = (const bf16*)(p.ws + WS_WUPT) + ((size_t)(l * 2 + dir) * 512 + h * 64) * 64;
    const bf16* aupt = (const bf16*)(p.ws + WS_AUPT) + ((size_t)(l * 2 + dir) * 512 + h * 64) * 64;
    LAS bf16* HT = (LAS bf16*)(lds + L_HT);   LAS bf16* TW = (LAS bf16*)(lds + L_TW);   LAS bf16* AD = (LAS bf16*)(lds + L_AD);
    LAS float* LP = (LAS float*)(lds + L_LP); LAS float* AP = (LAS float*)(lds + L_AP);
    LAS bf16* AT = (LAS bf16*)(lds + L_AT);   LAS bf16* RT = (LAS bf16*)(lds + L_RT);   LAS bf16* BH = (LAS bf16*)(lds + L_BH);   LAS bf16* KH = (LAS bf16*)(lds + L_KH);
    LAS bf16* BBT = (LAS bf16*)(lds + L_BBT); LAS bf16* KBT = (LAS bf16*)(lds + L_KBT); LAS bf16* VT = (LAS bf16*)(lds + L_VT);   LAS float* GE = (LAS float*)(lds + L_GE);
    LAS bf16* VR = (LAS bf16*)(lds + L_VR);   LAS bf16* BBR = (LAS bf16*)(lds + L_BBR); LAS bf16* KBR = (LAS bf16*)(lds + L_KBR);
    LAS float* AAB = (LAS float*)(lds + L_AAB); LAS bf16* AAK = (LAS bf16*)(lds + L_AAK); LAS bf16* ARB = (LAS bf16*)(lds + L_ARB); LAS bf16* ARK = (LAS bf16*)(lds + L_ARK);
    LAS bf16* AHAT = (LAS bf16*)(lds + L_AHAT); LAS float* W1 = (LAS float*)(lds + L_W1); LAS bf16* UT = (LAS bf16*)(lds + L_UT);
    const bf16x8 zero8 = {0, 0, 0, 0, 0, 0, 0, 0};
    const int tv = w & 3, tk0 = 2 * (w >> 2);
    f32x4 hacc[2];
#pragma unroll
    for (int x = 0; x < 2; ++x) {
        if (lat) hacc[x] = *(const f32x4*)(p.in[I_STATE] + ((((size_t)bseq * 2 + l) * 2 + dir) * 8 + h) * 4096 + (16 * tv + fr) * 64 + 16 * (tk0 + x) + 4 * fg);
        else hacc[x] = (f32x4){0.f, 0.f, 0.f, 0.f};
        u32x2 hw; hw.x = cvt2(hacc[x][0], hacc[x][1]); hw.y = cvt2(hacc[x][2], hacc[x][3]);
        *(LAS u32x2*)(HT + (16 * tv + fr) * TS + 16 * (tk0 + x) + 4 * fg) = hw; }
    int ei = tid >> 3, ec8 = (tid & 7) * 8; const int hc8 = h * 64 + ec8;
    float kkp[8], kap[8], rkp[8];
#pragma unroll
    for (int e = 0; e < 8; ++e) { kkp[e] = p.in[I_KK][l * 512 + hc8 + e]; kap[e] = p.in[I_KA][l * 512 + hc8 + e]; rkp[e] = p.in[I_RK][l * 512 + hc8 + e]; }
    __syncthreads();
#pragma unroll 1
    for (int sc = 0; sc < L / 64; ++sc) {
        float rr[8], kk[8], vv[8];
        tid = opq(tid0); fr = tid & 15; fg = (tid & 63) >> 4; ei = tid >> 3; ec8 = (tid & 7) * 8;
        const int step = sc * 64 + ei, t = dir ? L - 1 - step : step, grow = base + t;
        const bool hasp = t > 0, hasn = t < L - 1;
        { float u[8];
          shift8(proj, grow, hasp, hasn, WD_OFF + dir * 64 + ec8, mu, u);
#pragma unroll
          for (int e = 0; e < 8; ++e) u[e] = 1.0f - 2.0f * frcp(fexp(2.0f * u[e]) + 1.0f);
          *(LAS u32x4*)(TW + ei * TS + ec8) = pack8(u);
          shift8(proj, grow, hasp, hasn, AD_OFF + dir * 64 + ec8, mu, u);
          *(LAS u32x4*)(AD + ei * TS + ec8) = pack8(u); }
        shift8(proj, grow, hasp, hasn, R_OFF + hc8, mu, rr); shift8(proj, grow, hasp, hasn, K_OFF + hc8, mu, kk); shift8(proj, grow, hasp, hasn, V_OFF + hc8, mu, vv);
        __syncthreads();
        tid = opq(tid0); fr = tid & 15; fg = (tid & 63) >> 4; ei = tid >> 3; ec8 = (tid & 7) * 8;
        { const int ti = w >> 1;
          const bf16x8 aw0 = *(const LAS bf16x8*)(TW + (ti * 16 + fr) * TS + fg * 8), aw1 = *(const LAS bf16x8*)(TW + (ti * 16 + fr) * TS + 32 + fg * 8);
          const bf16x8 aa0 = *(const LAS bf16x8*)(AD + (ti * 16 + fr) * TS + fg * 8), aa1 = *(const LAS bf16x8*)(AD + (ti * 16 + fr) * TS + 32 + fg * 8);
#pragma unroll
          for (int x = 0; x < 2; ++x) { const int c = ((w & 1) * 2 + x) * 16 + fr;
              const bf16x8 bw0 = *(const bf16x8*)(wupt + c * 64 + fg * 8), bw1 = *(const bf16x8*)(wupt + c * 64 + 32 + fg * 8);
              const bf16x8 ba0 = *(const bf16x8*)(aupt + c * 64 + fg * 8), ba1 = *(const bf16x8*)(aupt + c * 64 + 32 + fg * 8);
              const float w0c = p.in[I_W0][(l * 2 + dir) * 512 + h * 64 + c], a0c = p.in[I_A0][(l * 2 + dir) * 512 + h * 64 + c];
              f32x4 cw = (f32x4){w0c, w0c, w0c, w0c}, ca = (f32x4){a0c, a0c, a0c, a0c};
              cw = MFMA16(aw0, bw0, cw); cw = MFMA16(aw1, bw1, cw); ca = MFMA16(aa0, ba0, ca); ca = MFMA16(aa1, ba1, ca);
#pragma unroll
              for (int r = 0; r < 4; ++r) { LP[(ti * 16 + 4 * fg + r) * LPS + c] = cw[r]; AP[(ti * 16 + 4 * fg + r) * LPS + c] = ca[r]; } } }
        __syncthreads();
        tid = opq(tid0); fr = tid & 15; fg = (tid & 63) >> 4; ei = tid >> 3; ec8 = (tid & 7) * 8;
        float lw[8], av[8], bv[8], kd[8];
        { const f32x4 wp0 = *(const LAS f32x4*)(LP + ei * LPS + ec8), wp1 = *(const LAS f32x4*)(LP + ei * LPS + ec8 + 4);
          const f32x4 ap0 = *(const LAS f32x4*)(AP + ei * LPS + ec8), ap1 = *(const LAS f32x4*)(AP + ei * LPS + ec8 + 4);
          float asg[8], kn[8], ss = 0.f, bc = 0.f;
#pragma unroll
          for (int e = 0; e < 8; ++e) { const float wpre = e < 4 ? wp0[e & 3] : wp1[e & 3], apre = e < 4 ? ap0[e & 3] : ap1[e & 3];
              const float z = -wpre, sp = z > 20.f ? z : flog(1.0f + fexp(z));
              lw[e] = -fexp(-sp - 0.5f);
              asg[e] = fsigmoid(apre);
              kn[e] = kk[e] * kkp[e]; ss += kn[e] * kn[e];
              kd[e] = kk[e] * (1.0f + (asg[e] - 1.0f) * kap[e]); bc += rr[e] * kd[e] * rkp[e]; }
          ss = red8(ss); bc = red8(bc);
          const float inv = fminf(frsq(ss), 1e12f);
#pragma unroll
          for (int e = 0; e < 8; ++e) { const float kj = kn[e] * inv; av[e] = -kj; bv[e] = kj * asg[e]; }
          if ((tid & 7) == 0) BC[(size_t)grow * 8 + h] = bc;
          *(LAS f32x4*)(LP + ei * LPS + ec8) = (f32x4){lw[0], lw[1], lw[2], lw[3]}; *(LAS f32x4*)(LP + ei * LPS + ec8 + 4) = (f32x4){lw[4], lw[5], lw[6], lw[7]}; }
        __syncthreads();
        tid = opq(tid0); fr = tid & 15; fg = (tid & 63) >> 4; ei = tid >> 3; ec8 = (tid & 7) * 8;
        if (tid < 256) { const int c = tid & 63, q = tid >> 6; float run = 0.f;
#pragma unroll
            for (int i = 0; i < 16; ++i) { run += LP[(16 * q + i) * LPS + c]; LP[(16 * q + i) * LPS + c] = run; } }
        __syncthreads();
        tid = opq(tid0); fr = tid & 15; fg = (tid & 63) >> 4; ei = tid >> 3; ec8 = (tid & 7) * 8;
        { const f32x4 c0 = *(const LAS f32x4*)(LP + ei * LPS + ec8), c1 = *(const LAS f32x4*)(LP + ei * LPS + ec8 + 4);
          const int ie = (ei & ~15) + 15;
          const f32x4 d0 = *(const LAS f32x4*)(LP + ie * LPS + ec8), d1 = *(const LAS f32x4*)(LP + ie * LPS + ec8 + 4);
          float xa[8], xr[8], xb[8], xk[8], yb[8], yk[8];
#pragma unroll
          for (int e = 0; e < 8; ++e) { const float cum = e < 4 ? c0[e & 3] : c1[e & 3], cend = e < 4 ? d0[e & 3] : d1[e & 3];
              const float e2 = fexp(cum), e1 = fexp(cum - lw[e]), e3 = fexp(-cum), e4 = fexp(cend - cum);
              xa[e] = av[e] * e1; xr[e] = rr[e] * e2; xb[e] = bv[e] * e3; xk[e] = kd[e] * e3; yb[e] = bv[e] * e4; yk[e] = kd[e] * e4;
              if ((ei & 15) == 15) GE[(ei >> 4) * 64 + ec8 + e] = e2; }
          *(LAS u32x4*)(AT + ei * TS + ec8) = pack8(xa); *(LAS u32x4*)(RT + ei * TS + ec8) = pack8(xr); *(LAS u32x4*)(BH + ei * TS + ec8) = pack8(xb); *(LAS u32x4*)(KH + ei * TS + ec8) = pack8(xk);
          *(LAS u32x4*)(BBR + ei * TS + ec8) = pack8(yb); *(LAS u32x4*)(KBR + ei * TS + ec8) = pack8(yk); *(LAS u32x4*)(VR + ei * TS + ec8) = pack8(vv); }
        __syncthreads();
        tid = opq(tid0); fr = tid & 15; fg = (tid & 63) >> 4; ei = tid >> 3; ec8 = (tid & 7) * 8;
        { const int col = tid & 63, jg = tid >> 6;
#pragma unroll
          for (int m = 0; m < 3; ++m) { const LAS bf16* src = m == 0 ? VR : (m == 1 ? BBR : KBR); LAS bf16* dst = m == 0 ? VT : (m == 1 ? BBT : KBT);
              unsigned short x[8];
#pragma unroll
              for (int e = 0; e < 8; ++e) x[e] = src[(8 * jg + e) * TS + col];
              u32x4 o; o.x = x[0] | ((unsigned)x[1] << 16); o.y = x[2] | ((unsigned)x[3] << 16); o.z = x[4] | ((unsigned)x[5] << 16); o.w = x[6] | ((unsigned)x[7] << 16);
              *(LAS u32x4*)(dst + col * TS + 8 * jg) = o; } }
        __syncthreads();
        tid = opq(tid0); fr = tid & 15; fg = (tid & 63) >> 4; ei = tid >> 3; ec8 = (tid & 7) * 8;
        { const int q = w >> 1, half = w & 1; const LAS bf16* Asrc = half ? RT : AT;
          const bf16x8 af0 = *(const LAS bf16x8*)(Asrc + (16 * q + fr) * TS + fg * 8), af1 = *(const LAS bf16x8*)(Asrc + (16 * q + fr) * TS + 32 + fg * 8);
#pragma unroll
          for (int x = 0; x < 2; ++x) { const LAS bf16* Bsrc = x ? KH : BH;
              const bf16x8 bf0 = *(const LAS bf16x8*)(Bsrc + (16 * q + fr) * TS + fg * 8), bf1_ = *(const LAS bf16x8*)(Bsrc + (16 * q + fr) * TS + 32 + fg * 8);
              f32x4 c = (f32x4){0.f, 0.f, 0.f, 0.f}; c = MFMA16(af0, bf0, c); c = MFMA16(af1, bf1_, c);
#pragma unroll
              for (int r = 0; r < 4; ++r) { const int i = 4 * fg + r, j = fr; const float val = (half ? j <= i : j < i) ? c[r] : 0.f;
                  if (half == 0 && x == 0) AAB[(q * 16 + i) * 16 + j] = val;
                  else { LAS bf16* dst = half == 0 ? AAK : (x == 0 ? ARB : ARK); dst[(q * 16 + i) * 24 + j] = (bf16)(cvt2(val, 0.f) & 0xffffu); } } } }
        __syncthreads();
        tid = opq(tid0); fr = tid & 15; fg = (tid & 63) >> 4; ei = tid >> 3; ec8 = (tid & 7) * 8;
        { const int q = w >> 1;
          const bf16x8 af = fg < 2 ? *(const LAS bf16x8*)(AAK + (q * 16 + fr) * 24 + fg * 8) : zero8;
#pragma unroll
          for (int x = 0; x < 2; ++x) { const int tvv = (w & 1) * 2 + x;
              const bf16x8 bfv = fg < 2 ? *(const LAS bf16x8*)(VT + (16 * tvv + fr) * TS + 16 * q + fg * 8) : zero8;
              f32x4 c = (f32x4){0.f, 0.f, 0.f, 0.f}; c = MFMA16(af, bfv, c);
#pragma unroll
              for (int r = 0; r < 4; ++r) W1[(q * 16 + 4 * fg + r) * LPS + 16 * tvv + fr] = c[r]; } }
        __syncthreads();
        tid = opq(tid0); fr = tid & 15; fg = (tid & 63) >> 4; ei = tid >> 3; ec8 = (tid & 7) * 8;
        { const int q = tid >> 7, col = tid & 127; float x[16];
          if (col < 64) {
#pragma unroll
              for (int i = 0; i < 16; ++i) x[i] = bf1(AT[(16 * q + i) * TS + col]); }
          else {
#pragma unroll
              for (int i = 0; i < 16; ++i) x[i] = W1[(q * 16 + i) * LPS + col - 64]; }
#pragma unroll
          for (int i = 1; i < 16; ++i) {
#pragma unroll
              for (int j = 0; j < i; ++j) x[i] += AAB[(q * 16 + i) * 16 + j] * x[j]; }
          if (col < 64) {
#pragma unroll
              for (int i = 0; i < 16; ++i) AHAT[(q * 16 + i) * TS + col] = (bf16)(cvt2(x[i], 0.f) & 0xffffu); }
          else {
#pragma unroll
              for (int i = 0; i < 16; ++i) W1[(q * 16 + i) * LPS + col - 64] = x[i]; } }
        __syncthreads();
        tid = opq(tid0); fr = tid & 15; fg = (tid & 63) >> 4; ei = tid >> 3; ec8 = (tid & 7) * 8;
#pragma unroll 1
        for (int q = 0; q < 4; ++q) {
            f32x4 yacc = (f32x4){0.f, 0.f, 0.f, 0.f};
            tid = opq(tid0); fr = tid & 15; fg = (tid & 63) >> 4;
            { const bf16x8 h0 = *(const LAS bf16x8*)(HT + (16 * tv + fr) * TS + fg * 8), h1 = *(const LAS bf16x8*)(HT + (16 * tv + fr) * TS + 32 + fg * 8);
              if (w < 4) {
                  const bf16x8 a0 = *(const LAS bf16x8*)(AHAT + (q * 16 + fr) * TS + fg * 8), a1 = *(const LAS bf16x8*)(AHAT + (q * 16 + fr) * TS + 32 + fg * 8);
                  f32x4 u;
#pragma unroll
                  for (int r = 0; r < 4; ++r) u[r] = W1[(q * 16 + 4 * fg + r) * LPS + 16 * tv + fr];
                  u = MFMA16(a0, h0, u); u = MFMA16(a1, h1, u);
                  u32x2 uw; uw.x = cvt2(u[0], u[1]); uw.y = cvt2(u[2], u[3]);
                  *(LAS u32x2*)(UT + (16 * tv + fr) * 24 + 4 * fg) = uw;
              } else {
                  const bf16x8 a0 = *(const LAS bf16x8*)(RT + (16 * q + fr) * TS + fg * 8), a1 = *(const LAS bf16x8*)(RT + (16 * q + fr) * TS + 32 + fg * 8);
                  yacc = MFMA16(a0, h0, yacc); yacc = MFMA16(a1, h1, yacc);
              } }
            __syncthreads();
            tid = opq(tid0); fr = tid & 15; fg = (tid & 63) >> 4;
            { const bf16x8 bU = fg < 2 ? *(const LAS bf16x8*)(UT + (16 * tv + fr) * 24 + fg * 8) : *(const LAS bf16x8*)(VT + (16 * tv + fr) * TS + 16 * q + (fg - 2) * 8);
#pragma unroll
              for (int x = 0; x < 2; ++x) { const int tk = tk0 + x;
                  const bf16x8 aF = fg < 2 ? *(const LAS bf16x8*)(BBT + (16 * tk + fr) * TS + 16 * q + fg * 8) : *(const LAS bf16x8*)(KBT + (16 * tk + fr) * TS + 16 * q + (fg - 2) * 8);
                  const f32x4 ge = *(const LAS f32x4*)(GE + q * 64 + 16 * tk + 4 * fg);
                  hacc[x] = MFMA16(aF, bU, hacc[x] * ge);
                  u32x2 hw; hw.x = cvt2(hacc[x][0], hacc[x][1]); hw.y = cvt2(hacc[x][2], hacc[x][3]);
                  *(LAS u32x2*)(HT + (16 * tv + fr) * TS + 16 * tk + 4 * fg) = hw; }
              if (w >= 4) {
                  const bf16x8 aY = fg < 2 ? *(const LAS bf16x8*)(ARB + (q * 16 + fr) * 24 + fg * 8) : *(const LAS bf16x8*)(ARK + (q * 16 + fr) * 24 + (fg - 2) * 8);
                  yacc = MFMA16(aY, bU, yacc);
#pragma unroll
                  for (int r = 0; r < 4; ++r) { const int st2 = sc * 64 + 16 * q + 4 * fg + r, t2 = dir ? L - 1 - st2 : st2;
                      Yout[(size_t)(base + t2) * 512 + h * 64 + 16 * tv + fr] = yacc[r]; } } }
            __syncthreads();
        }
    }
    if (!lat) {
#pragma unroll
        for (int x = 0; x < 2; ++x) *(f32x4*)(p.out + (size_t)MTOK * DM + ((((size_t)bseq * 2 + l) * 2 + dir) * 8 + h) * 4096 + (16 * tv + fr) * 64 + 16 * (tk0 + x) + 4 * fg) = hacc[x]; }
    __syncthreads();
}

__device__ __forceinline__ void fnet1_item(CKP& p, int l, LAS unsigned char* lds, int item) {
    const int tid = opaque_tid(), tb = item >> 2, g = item & 3, tok0 = tb * 64;
    const bf16* proj = (const bf16*)(p.ws + WS_PROJ);
    LAS float* XT = (LAS float*)lds;
    LAS float* FWL = XT + 64 * 65;
    { const int ti = tid >> 3, c8 = (tid & 7) * 8; float x[8]; load8bf(proj + (size_t)(tok0 + ti) * DINP + F_OFF + g * 64 + c8, x);
#pragma unroll
      for (int j = 0; j < 8; ++j) XT[ti * 65 + c8 + j] = x[j]; }
    const float* fw = (const float*)(p.ws + WS_FW) + (size_t)(l * 4 + g) * 8192;
    for (int i = tid; i < 2048; i += NTHR) *(LAS f32x4*)(FWL + i * 4) = *(const f32x4*)(fw + i * 4);
    __syncthreads();
    const int ti = tid & 63, og = tid >> 6;
    f32x4 acc[4];
#pragma unroll
    for (int j = 0; j < 4; ++j) acc[j] = (f32x4){0.f, 0.f, 0.f, 0.f};
#pragma unroll 4
    for (int c = 0; c < 64; ++c) { const float x = XT[ti * 65 + c];
#pragma unroll
        for (int j = 0; j < 4; ++j) acc[j] += x * *(const LAS f32x4*)(FWL + c * 128 + og * 16 + j * 4); }
    const bool lat = tok0 >= NCTX;
    const int L = lat ? 1024 : 256, bq = lat ? (tok0 - NCTX) >> 10 : tok0 >> 8, t = (lat ? (tok0 - NCTX) & 1023 : tok0 & 255) + ti;
    const float scale = lat ? (1.0f / 256.0f) : (1.0f / 128.0f);
    bf16* Y = (bf16*)(p.ws + WS_YCS) + (lat ? (size_t)8192 * 512 : 0);
    const int cs = og >> 2, K2 = 2 * L;
#pragma unroll
    for (int j = 0; j < 4; ++j)
#pragma unroll
        for (int e = 0; e < 4; ++e) { const int d = (og & 3) * 16 + j * 4 + e;
            Y[(size_t)((bq * 4 + g) * 64 + d) * K2 + cs * L + t] = (bf16)f2bf(acc[j][e] * scale); }
    __syncthreads();
}

__device__ __forceinline__ void pool_item(CKP& p, int l, LAS unsigned char* lds, int item) {
    const int tid = opaque_tid(), tb = item >> 2, gi = item & 3, tok0 = tb * 64, hw = 1 << gi;
    const bf16* proj = (const bf16*)(p.ws + WS_PROJ);
    LAS float* DT = (LAS float*)lds;
    LAS float* WP = DT + 64 * 65;
    const float* wpool = p.in[I_WPOOL] + (size_t)(l * 4 + gi) * 4096;
    for (int i = tid; i < 1024; i += NTHR) *(LAS f32x4*)(WP + i * 4) = *(const f32x4*)(wpool + i * 4);
    const int ti = tid >> 3, c8 = (tid & 7) * 8, tok = tok0 + ti, col = P_OFF + gi * 64 + c8;
    { float sum[8], x[8];
#pragma unroll
      for (int j = 0; j < 8; ++j) sum[j] = 0.f;
      load8bf(proj + (size_t)tok * DINP + col, x);
      float cnt;
      if (tok < NCTX) { const int t = tok & 255, sb = tok - t, lo = max(t - hw, 0), hi = min(t + hw, 256);
          for (int q = lo; q < hi; ++q) { float y[8]; load8bf(proj + (size_t)(sb + q) * DINP + col, y);
#pragma unroll
              for (int j = 0; j < 8; ++j) sum[j] += y[j]; }
          cnt = (float)(hi - lo); }
      else { const int t = (tok - NCTX) & 1023, sb = tok - t, r = t >> 6, c = t & 63, rlo = max(r - hw, 0), rhi = min(r + hw, 16), clo = max(c - hw, 0), chi = min(c + hw, 64);
          for (int rq = rlo; rq < rhi; ++rq) for (int cq = clo; cq < chi; ++cq) { float y[8]; load8bf(proj + (size_t)(sb + rq * 64 + cq) * DINP + col, y);
#pragma unroll
              for (int j = 0; j < 8; ++j) sum[j] += y[j]; }
          cnt = (float)((rhi - rlo) * (chi - clo)); }
      const float ic = frcp(cnt);
#pragma unroll
      for (int j = 0; j < 8; ++j) DT[ti * 65 + c8 + j] = sum[j] * ic - x[j]; }
    __syncthreads();
    f32x4 a0 = (f32x4){0.f, 0.f, 0.f, 0.f}, a1 = a0;
#pragma unroll 4
    for (int c = 0; c < 64; ++c) { const float d = DT[ti * 65 + c]; a0 += d * *(const LAS f32x4*)(WP + c * 64 + c8); a1 += d * *(const LAS f32x4*)(WP + c * 64 + c8 + 4); }
    const float* ps = p.in[I_PSCALE] + l * 256 + gi * 64 + c8;
    const f32x4 s0 = *(const f32x4*)ps, s1 = *(const f32x4*)(ps + 4);
    a0 *= s0; a1 *= s1;
    u32x4 w; w.x = pk2(a0[0], a0[1]); w.y = pk2(a0[2], a0[3]); w.z = pk2(a1[0], a1[1]); w.w = pk2(a1[2], a1[3]);
    *(u32x4*)((bf16*)(p.ws + WS_MIXED) + (size_t)tok * DM + 768 + gi * 64 + c8) = w;
    __syncthreads();
}

__device__ __forceinline__ void post_item(CKP& p, int l, LAS unsigned char* lds, int item) {
    const int tid = opaque_tid(), tok0 = item * 16;
    const bf16* proj = (const bf16*)(p.ws + WS_PROJ);
    const float* mu = p.in[I_MU] + l * 1920;
    LAS float* SG = (LAS float*)lds;
    const bool lat = tok0 >= NCTX; const int L = lat ? 1024 : 256, tseq0 = lat ? (tok0 - NCTX) & 1023 : tok0 & 255;
    { const int ti = tid >> 5, r4 = (tid & 31) * 4, t = tseq0 + ti; float u[4];
      shift4(proj, tok0 + ti, t > 0, t < L - 1, GD_OFF + r4, mu, u);
#pragma unroll
      for (int j = 0; j < 4; ++j) SG[ti * 128 + r4 + j] = fsigmoid(u[j]); }
    __syncthreads();
    const int c = tid, head = tid >> 6;
    float g[16];
#pragma unroll
    for (int i = 0; i < 16; ++i) g[i] = 0.f;
    const float* gup = p.in[I_GUP] + (size_t)l * 128 * 512 + c;
    for (int r = 0; r < 128; r += 4) { const float w0 = gup[(r + 0) * 512], w1 = gup[(r + 1) * 512], w2 = gup[(r + 2) * 512], w3 = gup[(r + 3) * 512];
#pragma unroll
        for (int i = 0; i < 16; ++i) { const f32x4 sg = *(const LAS f32x4*)(SG + i * 128 + r); g[i] += (sg.x * w0 + sg.y * w1) + (sg.z * w2 + sg.w * w3); } }
    const float lnw = p.in[I_LNW][l * 512 + c], lnb = p.in[I_LNB][l * 512 + c], muv = mu[V_OFF + c];
    const float* YF = (const float*)(p.ws + WS_YF); const float* YB = (const float*)(p.ws + WS_YB);
    const float* BC0 = (const float*)(p.ws + WS_BC); const float* BC1 = BC0 + (size_t)MTOK * 8;
    bf16* MIX = (bf16*)(p.ws + WS_MIXED);
#pragma unroll 4
    for (int i = 0; i < 16; ++i) { const int tok = tok0 + i, t = tseq0 + i;
        const float y = YF[(size_t)tok * 512 + c] + YB[(size_t)tok * 512 + c];
        const float mean = wave_sum(y) * (1.0f / 64.0f), dlt = y - mean, var = wave_sum(dlt * dlt) * (1.0f / 64.0f);
        const float yn = dlt * frsq(var + 64e-5f) * lnw + lnb;
        const float pv = bf1(proj[(size_t)tok * DINP + V_OFF + c]);
        const float pa = t > 0 ? bf1(proj[(size_t)(tok - 1) * DINP + V_OFF + c]) : 0.f, pb = t < L - 1 ? bf1(proj[(size_t)(tok + 1) * DINP + V_OFF + c]) : 0.f;
        const float v = pv + muv * (0.5f * (pa + pb) - pv);
        const float bonus = (BC0[(size_t)tok * 8 + head] + BC1[(size_t)tok * 8 + head]) * v;
        MIX[(size_t)tok * DM + c] = (bf16)f2bf((yn + bonus) * g[i]); }
    __syncthreads();
}

#define XB_TMO      128
#define XB_XCNT(j)  (256  + 64 * (j))
#define XB_XSUB(j)  (1280 + 64 * (j))
#define XB_XGEN(j)  (2304 + 64 * (j))
#define XB_TOP      3328
#define XB_TOPGEN   3392
#define XCD_BAR_WORDS 3456
#define XB_SPIN_CAP (1u << 18)

__device__ __forceinline__ unsigned xb_ld(unsigned* p)              { return __hip_atomic_load(p, __ATOMIC_RELAXED, __HIP_MEMORY_SCOPE_AGENT); }
__device__ __forceinline__ unsigned xb_add(unsigned* p, unsigned v) { return __hip_atomic_fetch_add(p, v, __ATOMIC_RELAXED, __HIP_MEMORY_SCOPE_AGENT); }
__device__ __forceinline__ unsigned xb_xcc_id() { return (unsigned)__builtin_amdgcn_s_getreg((3 << 11) | 20) & 0xFu; }
#define XB_SPIN(cond, bar) do { unsigned _sp = 0; while (cond) { __builtin_amdgcn_s_sleep(1); \
    if ((++_sp & 255u) == 0u) { if (xb_ld(&(bar)[XB_TMO])) break; if (_sp > XB_SPIN_CAP) { atomicAdd(&(bar)[XB_TMO], 1u); break; } } } } while (0)

struct XcdBarrier {
    unsigned* bar; unsigned x;
    volatile LAS unsigned* st;
};

__device__ __forceinline__ XcdBarrier xcd_barrier_post(unsigned* bar, volatile LAS unsigned* st) {
    XcdBarrier b; b.bar = bar; b.x = xb_xcc_id(); b.st = st;
    if (threadIdx.x == 0) (void)xb_add(&bar[XB_XCNT(b.x)], 1u);
    return b;
}
__device__ __forceinline__ void xcd_barrier_complete(unsigned* bar, unsigned x, unsigned& nloc, unsigned& nx) {
    const unsigned G = gridDim.x * gridDim.y * gridDim.z;
    unsigned sum, cnt, mine, sp = 0u;
    for (;;) {
        sum = 0u; cnt = 0u; mine = 0u;
#pragma unroll
        for (unsigned j = 0; j < 16; ++j) { const unsigned c = xb_ld(&bar[XB_XCNT(j)]); sum += c; cnt += (c > 0u) ? 1u : 0u; mine = (j == x) ? c : mine; }
        if (sum == G) break;
        __builtin_amdgcn_s_sleep(1);
        if ((++sp & 255u) == 0u) { if (xb_ld(&bar[XB_TMO])) break; if (sp > XB_SPIN_CAP) { atomicAdd(&bar[XB_TMO], 1u); break; } }
    }
    nloc = mine > 0u ? mine : 1u; nx = cnt > 0u ? cnt : 1u;
}

__device__ __forceinline__ void xcd_barrier(const XcdBarrier& b) {
    asm volatile("s_waitcnt vmcnt(0)" ::: "memory");
    __syncthreads();
    if (threadIdx.x == 0) {
        unsigned* bar = b.bar;
        __builtin_amdgcn_s_waitcnt(0);
        unsigned nloc = b.st[0], nx = b.st[1];
        if (nloc == 0u) { xcd_barrier_complete(bar, b.x, nloc, nx); b.st[0] = nloc; b.st[1] = nx; }
        const unsigned old = xb_add(&bar[XB_XSUB(b.x)], 1u);
        const unsigned gen = old / nloc;
        if (old + 1u == (gen + 1u) * nloc) {
            __builtin_amdgcn_fence(__ATOMIC_RELEASE, "agent");
            asm volatile("s_waitcnt vmcnt(0)" ::: "memory");
            const unsigned og = xb_add(&bar[XB_TOP], 1u);
            const unsigned tg = og / nx;
            if (og + 1u == (tg + 1u) * nx) xb_add(&bar[XB_TOPGEN], 1u);
            else XB_SPIN(xb_ld(&bar[XB_TOPGEN]) == tg, bar);
            __builtin_amdgcn_fence(__ATOMIC_ACQUIRE, "agent");
            xb_add(&bar[XB_XGEN(b.x)], 1u);
            asm volatile("s_waitcnt vmcnt(0)" ::: "memory");
        } else {
            XB_SPIN(xb_ld(&bar[XB_XGEN(b.x)]) == gen, bar);
            __builtin_amdgcn_fence(__ATOMIC_ACQUIRE, "agent");
            asm volatile("s_waitcnt vmcnt(0)" ::: "memory");
        }
    }
    __syncthreads();
}

constexpr int N_STEPS = 22;
__device__ __forceinline__ bool step_seam(int st) { if (st == 0) return true; if (st >= 21) return false; const int s = (st - 1) % 10; return !(s == 3 || s == 4); }
__global__ void __launch_bounds__(NTHR, 2) mega_fwd(KP p_unused) {
    extern __shared__ __attribute__((aligned(16))) unsigned char lds_raw[];
    CKP* kp0 = (CKP*)__builtin_amdgcn_kernarg_segment_ptr();
    { LAS unsigned* ctlw = (LAS unsigned*)((LAS unsigned char*)lds_raw + RING_BYTES);
      for (int u = threadIdx.x; u < (LDS_BYTES - RING_BYTES) / 4; u += NTHR) ctlw[u] = 0u; }
    __syncthreads();
    const XcdBarrier bar = xcd_barrier_post((unsigned*)(kp0->ws + WS_CTL) + 4096, (volatile LAS unsigned*)((LAS unsigned char*)lds_raw + MISC_OFF + 32));
    const int ph_lo = kp0->ph_lo, ph_hi = kp0->ph_hi;
#pragma unroll 1
    for (int st = ph_lo; st < ph_hi; ++st) {
        CKP* kp = kp0; asm volatile("" : "+s"(kp));
        CKP& p = *kp; unsigned char* ws = p.ws;
        int bid = blockIdx.x, nb = gridDim.x; unsigned ldsb = (unsigned)(size_t)(LAS unsigned char*)lds_raw;
        asm volatile("" : "+s"(bid), "+s"(nb), "+s"(ldsb));
        LAS unsigned char* lds = (LAS unsigned char*)(size_t)ldsb;
        const int l = st == 0 ? 0 : (st - 1) / 10, s = st == 0 ? -1 : (st == 21 ? 10 : (st - 1) % 10);
        const float* mod = (const float*)(ws + WS_MOD) + (size_t)l * 5 * 6144;
        pg8::Gemm g{nullptr, nullptr, 0, 0, 0, 0, 0}; pg8::EpiAny E{-1, true, nullptr, nullptr, 0, 0}; int corder = bid;
        if (s == 1) { g = pg8::Gemm{(const bf16*)(ws + WS_H), (const bf16*)(ws + WS_WIN) + (size_t)l * DINP * DM, MTOK, DINP, DM, DM, DM}; E = pg8::EpiAny{0, true, ws + WS_PROJ, nullptr, DINP, 0}; }
        else if (s == 3) { g = pg8::Gemm{(const bf16*)(ws + WS_CS256), (const bf16*)(ws + WS_YCS), 256, 8192, 512, 512, 512}; E = pg8::EpiAny{3, true, ws + WS_MIXED, nullptr, 0, 256}; }
        else if (s == 4) { g = pg8::Gemm{(const bf16*)(ws + WS_CS1024), (const bf16*)(ws + WS_YCS) + (size_t)8192 * 512, 1024, 1024, 2048, 2048, 2048}; E = pg8::EpiAny{3, true, ws + WS_MIXED, nullptr, NCTX, 1024}; corder = (bid + nb - 32) % nb; }
        else if (s == 6) { g = pg8::Gemm{(const bf16*)(ws + WS_MIXED), (const bf16*)(ws + WS_WOUT) + (size_t)l * DM * DM, MTOK, DM, DM, DM, DM}; E = pg8::EpiAny{2, false, p.out, mod + 2 * 1024, 0, 0}; }
        else if (s == 8) { g = pg8::Gemm{(const bf16*)(ws + WS_H), (const bf16*)(ws + WS_W1) + (size_t)l * DFF * DM, MTOK, DFF, DM, DM, DM}; E = pg8::EpiAny{1, true, ws + WS_FF, nullptr, DFF, 0}; }
        else if (s == 9) { g = pg8::Gemm{(const bf16*)(ws + WS_FF), (const bf16*)(ws + WS_W2) + (size_t)l * DM * DFF, MTOK, DM, DFF, DFF, DFF}; E = pg8::EpiAny{2, false, p.out, mod + 5 * 1024, 0, 0}; }
#ifdef REP_MASK
        for (int rep = 0; rep < (((REP_MASK) >> (s + 1)) & 1 ? 2 : 1); ++rep) { if (rep) xcd_barrier(bar);
#endif
        if (E.mode >= 0) {
            pg8::StaticOrder S; S.init(g.M, g.N, nb, corder);
            pg8::gemm_phase<pg8::EpiAny, pg8::StaticOrder, true, true>(lds, g, S, E);
            __syncthreads();
        } else if (s == -1) stage_prologue(p, lds, bid, nb);
        else if (s == 0) stage_norm(p, l, 0, bid, nb);
        else if (s == 2) {
            if (nb >= 256) { if (bid < 64) rwkv_item2(p, l, lds, bid); else for (int it = 64 + (bid - 64); it < 576; it += nb - 64) rwkv_item2(p, l, lds, it); }
            else for (int it = bid; it < 576; it += nb) rwkv_item2(p, l, lds, it);
#ifdef REP_FP
            for (int rep = 0; rep < 2; ++rep) {
#endif
#pragma unroll 1
            for (int it = bid; it < 768; it += nb) fnet1_item(p, l, lds, it);
#pragma unroll 1
            for (int it = bid; it < 768; it += nb) pool_item(p, l, lds, it);
#ifdef REP_FP
            }
#endif
        }
        else if (s == 5) { for (int it = bid; it < 768; it += nb) post_item(p, l, lds, it); }
        else if (s == 7) stage_norm(p, l, 1, bid, nb);
        else stage_final(p, bid, nb);
#ifdef REP_MASK
        }
#endif
        if (st + 1 < ph_hi && step_seam(st)) xcd_barrier(bar);
    }
}

extern "C" void kernel_launch(void* const* d_in, const int* in_sizes, int n_in, void* d_out, int out_size, void* d_ws, size_t ws_size, hipStream_t stream) {
    static int grid = 0;
    if (grid == 0) {
        if (n_in != N_IN || ws_size < WS_END) { fprintf(stderr, "kernel_launch: unexpected inputs (n_in %d, ws %zu)\n", n_in, ws_size); grid = -1; return; }
        int dev = 0, cus = 0, per_cu = 0;
        (void)hipGetDevice(&dev); (void)hipDeviceGetAttribute(&cus, hipDeviceAttributeMultiprocessorCount, dev);
        (void)hipFuncSetAttribute((const void*)mega_fwd, hipFuncAttributeMaxDynamicSharedMemorySize, LDS_BYTES);
        if (hipOccupancyMaxActiveBlocksPerMultiprocessor(&per_cu, (const void*)mega_fwd, NTHR, LDS_BYTES) != hipSuccess || per_cu < 1) {
            fprintf(stderr, "kernel_launch: occupancy query reports %d blocks/CU\n", per_cu); (void)hipGetLastError(); grid = -1; return; }
        grid = cus * 1;
    }
    if (grid < 0) return;
    KP a{};
    for (int i = 0; i < N_IN; ++i) a.in[i] = (const float*)d_in[i];
    a.out = (float*)d_out; a.ws = (unsigned char*)d_ws; a.ph_lo = 0; a.ph_hi = N_STEPS;
    if (hipMemsetAsync((char*)d_ws + WS_CTL, 0, 1 * MiB, stream) != hipSuccess) { fprintf(stderr, "kernel_launch: memset failed\n"); return; }
    void* args[] = {&a};
    hipError_t e = hipLaunchCooperativeKernel((const void*)mega_fwd, dim3(grid), dim3(NTHR), args, LDS_BYTES, stream);
    if (e != hipSuccess) fprintf(stderr, "cooperative launch failed: %s (grid %d)\n", hipGetErrorString(e), grid);
}
```

```cpp
#include <hip/hip_runtime.h>
#include <hip/hip_cooperative_groups.h>
#include <cstdio>
#include <cstdint>
namespace cg = cooperative_groups;
__device__ __forceinline__ int opaque_tid() { int t = threadIdx.x; asm volatile("" : "+v"(t)); return t; }
namespace pg8 {
#define PG8_LAS __attribute__((address_space(3)))
typedef unsigned short bf16_t;
typedef short bf16x8 __attribute__((ext_vector_type(8)));
typedef float f32x4 __attribute__((ext_vector_type(4)));
typedef unsigned u32x4 __attribute__((ext_vector_type(4)));
constexpr int BM = 256, BK = 64, HALF = 128, HTB = HALF * BK * 2  , STAGE_BYTES = 8 * HTB, NXCD = 8, WGM = 8;

__host__ __device__ __forceinline__ int lds_byte(int r, int c) { const int st = (r >> 4) * 2 + (c >> 5), rr = r & 15, cc = c & 31, ob = rr * 64 + cc * 2; return st * 1024 + (ob ^ (((ob >> 9) & 1) << 5)); }
__host__ __device__ __forceinline__ void stage_rc(int b, int& R, int& C) { const int st = b / 1024, sb = b % 1024, swz = sb ^ (((sb >> 9) & 1) << 5); R = (st >> 1) * 16 + swz / 64; C = (st & 1) * 32 + (swz % 64) / 2; }
__host__ __device__ __forceinline__ int perm32(int rho) { const int n = rho >> 4, i = rho & 15; return 8 * (i >> 2) + 4 * n + (i & 3); }

struct Unit { int pm, pn; };
struct Gemm { const bf16_t* A; const bf16_t* Bt; int M, N, K, lda, ldb; };

struct StaticOrder {
    int nM, nN, nwg, G, c;
    __host__ __device__ void init(int M, int N, int G_, int c_) { nM = M / BM; nN = N / BM; nwg = nM * nN; G = G_; c = c_; }
    __host__ __device__ bool next(int i, Unit& u) const {
        const long L = (long)i * G + c; if (L >= nwg) return false;
        int wgid = (int)L; { const int q = nwg / NXCD, r = nwg % NXCD, xcd = wgid % NXCD, off = wgid / NXCD; wgid = (xcd < r ? xcd * (q + 1) : r * (q + 1) + (xcd - r) * q) + off; }
        const int nig = WGM * nN, gid = wgid / nig, fm = gid * WGM, gsz = (nM - fm) < WGM ? (nM - fm) : WGM;
        u.pm = fm + ((wgid % nig) % gsz); u.pn = (wgid % nig) / gsz; return true;
    }
    __device__ __forceinline__ void a_ready(const Unit&) const {}
    __device__ __forceinline__ void done(const Unit&) const {}
};

__device__ __forceinline__ unsigned cvt_pk_bf16(float lo, float hi) { unsigned r; asm volatile("v_cvt_pk_bf16_f32 %0, %1, %2" : "=v"(r) : "v"(lo), "v"(hi)); return r; }
template <int ACT  > struct EpiBf {
    static constexpr bool PERM = true, AFTER_DRAIN = false;
    bf16_t* O; int ldc;
    __device__ __forceinline__ void operator()(const f32x4 (&acc)[2][2][4][2], const Unit& u, int wr, int wc, int fr, int fq) const {
        const int row0 = u.pm * BM + wr * 64 + fr, col0 = u.pn * BM + wc * 32 + 8 * fq;
#pragma unroll
        for (int ai = 0; ai < 2; ++ai)
#pragma unroll
            for (int m = 0; m < 4; ++m) { bf16_t* rowp = O + (size_t)(row0 + ai * HALF + m * 16) * ldc + col0;
#pragma unroll
                for (int bj = 0; bj < 2; ++bj) { f32x4 v0 = acc[ai][bj][m][0], v1 = acc[ai][bj][m][1];
                    if (ACT == 1) {
#pragma unroll
                        for (int e = 0; e < 4; ++e) { float a = v0[e] > 0.f ? v0[e] : 0.f; v0[e] = a * a; float b = v1[e] > 0.f ? v1[e] : 0.f; v1[e] = b * b; } }
                    u32x4 w; w.x = cvt_pk_bf16(v0[0], v0[1]); w.y = cvt_pk_bf16(v0[2], v0[3]); w.z = cvt_pk_bf16(v1[0], v1[1]); w.w = cvt_pk_bf16(v1[2], v1[3]);
                    *(u32x4*)(rowp + bj * HALF) = w; } }
    }
};
struct EpiRes {
    static constexpr bool PERM = false, AFTER_DRAIN = false;
    float* X; const float* gate;
    __device__ __forceinline__ void operator()(const f32x4 (&acc)[2][2][4][2], const Unit& u, int wr, int wc, int fr, int fq) const {
        const int row0 = u.pm * BM + wr * 64 + fr, col0 = u.pn * BM + wc * 32 + 4 * fq;
        const int cond = u.pm < 32 ? 0 : 1 + ((u.pm - 32) >> 2);
        const float* gp = gate + cond * 6144 + col0;
        f32x4 gv[2][2];
#pragma unroll
        for (int bj = 0; bj < 2; ++bj)
#pragma unroll
            for (int n = 0; n < 2; ++n) gv[bj][n] = *(const f32x4*)(gp + bj * HALF + n * 16);
#pragma unroll
        for (int ai = 0; ai < 2; ++ai)
#pragma unroll
            for (int m = 0; m < 4; ++m) { float* rowp = X + (size_t)(row0 + ai * HALF + m * 16) * 1024 + col0;
#pragma unroll
                for (int bj = 0; bj < 2; ++bj)
#pragma unroll
                    for (int n = 0; n < 2; ++n) { f32x4* q = (f32x4*)(rowp + bj * HALF + n * 16); *q = *q + gv[bj][n] * acc[ai][bj][m][n]; }
                if (m & 1) asm volatile("" ::: "memory"); }
    }
};
struct EpiFnet {
    static constexpr bool PERM = true, AFTER_DRAIN = false;
    bf16_t* MIX; int rowbase, L;
    __device__ __forceinline__ void operator()(const f32x4 (&acc)[2][2][4][2], const Unit& u, int wr, int wc, int fr, int fq) const {
        const int row0 = u.pm * BM + wr * 64 + fr, colw = wc * 32 + 8 * fq;
        bf16_t* base = MIX + (size_t)(rowbase + u.pn * L) * 1024 + 512 + colw;
#pragma unroll
        for (int ai = 0; ai < 2; ++ai)
#pragma unroll
            for (int m = 0; m < 4; ++m) { bf16_t* rowp = base + (size_t)(row0 + ai * HALF + m * 16) * 1024;
#pragma unroll
                for (int bj = 0; bj < 2; ++bj) { const f32x4 v0 = acc[ai][bj][m][0], v1 = acc[ai][bj][m][1];
                    u32x4 w; w.x = cvt_pk_bf16(v0[0], v0[1]); w.y = cvt_pk_bf16(v0[2], v0[3]); w.z = cvt_pk_bf16(v1[0], v1[1]); w.w = cvt_pk_bf16(v1[2], v1[3]);
                    *(u32x4*)(rowp + bj * HALF) = w; } }
    }
};

struct EpiAny {
    static constexpr bool AFTER_DRAIN = false;
    int mode; bool PERM; void* out; const float* aux; int i0, i1;
    __device__ __forceinline__ void operator()(const f32x4 (&acc)[2][2][4][2], const Unit& u, int wr, int wc, int fr, int fq) const {
        if (mode == 0) { const EpiBf<0> e{(bf16_t*)out, i0}; e(acc, u, wr, wc, fr, fq); }
        else if (mode == 1) { const EpiBf<1> e{(bf16_t*)out, i0}; e(acc, u, wr, wc, fr, fq); }
        else if (mode == 2) { const EpiRes e{(float*)out, aux}; e(acc, u, wr, wc, fr, fq); }
        else { const EpiFnet e{(bf16_t*)out, i0, i1}; e(acc, u, wr, wc, fr, fq); }
    }
};
template <class Epi, class Sched, bool ALIGN_EPI = false, bool SP2 = false>
__device__ __forceinline__ void gemm_phase(PG8_LAS unsigned char* lds, const Gemm g, const Sched& S, const Epi& E) {
    const int tid = opaque_tid(), wid = __builtin_amdgcn_readfirstlane(tid >> 6), lane = tid & 63, wr = wid >> 2, wc = wid & 3, fr = lane & 15, fq = lane >> 4;
    const int K = g.K, nt = K / BK;
    unsigned voffA[2], voffB[2];
#pragma unroll
    for (int i = 0; i < 2; ++i) { int R, C; stage_rc(tid * 16 + i * 8192, R, C); const int Rb = E.PERM ? ((R & ~31) + perm32(R & 31)) : R;
        voffA[i] = (unsigned)(R * g.lda + C) * 2u; voffB[i] = (unsigned)(Rb * g.ldb + C) * 2u; }
    const size_t kstep = (size_t)(BK * 2);
    const size_t hstepA = (size_t)HALF * g.lda * 2, hstepB = (size_t)HALF * g.ldb * 2;
    const size_t tstepA = 2 * hstepA, tstepB = 2 * hstepB;
    const unsigned ldsw = (unsigned)wid * 1024u;
    const int aoff = lds_byte(wr * 64 + fr, fq * 8), boff = lds_byte(wc * 32 + fr, fq * 8);
#define PG8_SA(b, h) (((b) * 2 + (h)) * HTB)
#define PG8_SB(b, h) ((4 + (b) * 2 + (h)) * HTB)
#define PG8_STAGE(bufoff, gbase, voff) do { _Pragma("unroll") for (int _i = 0; _i < 2; ++_i) \
        __builtin_amdgcn_global_load_lds((const unsigned*)((const char*)(gbase) + (voff)[_i]), (PG8_LAS unsigned*)(lds + (bufoff) + ldsw + _i * 8192), 16, 0, 0); } while (0)
#define PG8_LDA(dst, b, h) do { _Pragma("unroll") for (int m = 0; m < 4; ++m) _Pragma("unroll") for (int k = 0; k < 2; ++k) dst[m][k] = *(const PG8_LAS bf16x8*)(lds + PG8_SA(b, h) + aoff + m * 2048 + k * 1024); } while (0)
#define PG8_LDB(dst, b, h) do { _Pragma("unroll") for (int n = 0; n < 2; ++n) _Pragma("unroll") for (int k = 0; k < 2; ++k) dst[n][k] = *(const PG8_LAS bf16x8*)(lds + PG8_SB(b, h) + boff + n * 2048 + k * 1024); } while (0)
#define PG8_MMA(ai, bj, At, Bt) do { __builtin_amdgcn_s_setprio(1); _Pragma("unroll") for (int m = 0; m < 4; ++m) _Pragma("unroll") for (int n = 0; n < 2; ++n) _Pragma("unroll") for (int k = 0; k < 2; ++k) \
        acc[ai][bj][m][n] = __builtin_amdgcn_mfma_f32_16x16x32_bf16(Bt[n][k], At[m][k], acc[ai][bj][m][n], 0, 0, 0); __builtin_amdgcn_s_setprio(0); } while (0)
#define PG8_WAIT_V(n) asm volatile("s_waitcnt vmcnt(" #n ")" ::: "memory")
#define PG8_WAIT_L(n) asm volatile("s_waitcnt lgkmcnt(" #n ")" ::: "memory")
#define PG8_BAR __builtin_amdgcn_s_barrier()
#define PG8_SCHED __builtin_amdgcn_sched_barrier(0)
    Unit cur, nxt; int ui = 0;
    if (!S.next(0, cur)) return;
    f32x4 acc[2][2][4][2];
#pragma unroll
    for (int a = 0; a < 2; ++a)
#pragma unroll
        for (int b = 0; b < 2; ++b)
#pragma unroll
            for (int m = 0; m < 4; ++m)
#pragma unroll
                for (int n = 0; n < 2; ++n) acc[a][b][m][n] = (f32x4){0.f, 0.f, 0.f, 0.f};
    bf16x8 At[4][2], B0[2][2], B1[2][2];
    const char* cA = (const char*)g.A + (size_t)cur.pm * tstepA; const char* cB = (const char*)g.Bt + (size_t)cur.pn * tstepB;
    S.a_ready(cur);
    if constexpr (SP2) {
        PG8_STAGE(PG8_SB(0, 0), cB, voffB); PG8_STAGE(PG8_SB(0, 1), cB + hstepB, voffB); PG8_STAGE(PG8_SA(0, 0), cA, voffA); PG8_STAGE(PG8_SA(0, 1), cA + hstepA, voffA);
        if (wr == 1) PG8_BAR;
        PG8_WAIT_V(2); PG8_BAR;
        PG8_STAGE(PG8_SB(1, 0), cB + kstep, voffB); PG8_STAGE(PG8_SA(1, 0), cA + kstep, voffA); PG8_STAGE(PG8_SB(1, 1), cB + hstepB + kstep, voffB);
        PG8_WAIT_V(6); PG8_BAR;
    } else {
        PG8_STAGE(PG8_SB(0, 0), cB, voffB); PG8_STAGE(PG8_SA(0, 0), cA, voffA); PG8_STAGE(PG8_SB(0, 1), cB + hstepB, voffB); PG8_STAGE(PG8_SA(0, 1), cA + hstepA, voffA);
        if (wr == 1) PG8_BAR;
        PG8_WAIT_V(4); PG8_BAR;
        PG8_STAGE(PG8_SB(1, 0), cB + kstep, voffB); PG8_STAGE(PG8_SA(1, 0), cA + kstep, voffA); PG8_STAGE(PG8_SB(1, 1), cB + hstepB + kstep, voffB);
        PG8_WAIT_V(6); PG8_BAR;
    }
    for (;;) {
        const bool has_next = S.next(ui + 1, nxt);
        const char* nA = has_next ? (const char*)g.A + (size_t)nxt.pm * tstepA : cA; const char* nB = has_next ? (const char*)g.Bt + (size_t)nxt.pn * tstepB : cB;
        for (int t = 0; t < nt; t += 2) {
            const bool last = (t == nt - 2);
            const char* a1 = cA + (size_t)(t + 1) * kstep;
            const char* a2 = last ? nA : cA + (size_t)(t + 2) * kstep; const char* b2 = last ? nB : cB + (size_t)(t + 2) * kstep;
            const char* a3 = a2 + kstep; const char* b3 = b2 + kstep;
            if (last && has_next) S.a_ready(nxt);
            if constexpr (SP2) {
            PG8_LDB(B0, 0, 0); PG8_LDB(B1, 0, 1); PG8_SCHED; PG8_LDA(At, 0, 0); PG8_STAGE(PG8_SA(1, 1), a1 + hstepA, voffA);
            PG8_WAIT_V(8); PG8_WAIT_L(0); PG8_BAR; PG8_MMA(0, 0, At, B0); PG8_MMA(0, 1, At, B1); PG8_BAR; PG8_SCHED;
            PG8_LDA(At, 0, 1); PG8_STAGE(PG8_SB(0, 0), b2, voffB); PG8_STAGE(PG8_SB(0, 1), b2 + hstepB, voffB); PG8_STAGE(PG8_SA(0, 0), a2, voffA);
            PG8_WAIT_V(8); PG8_WAIT_L(0); PG8_BAR; PG8_MMA(1, 0, At, B0); PG8_MMA(1, 1, At, B1); PG8_BAR; PG8_SCHED;
            PG8_LDB(B0, 1, 0); PG8_LDB(B1, 1, 1); PG8_SCHED; PG8_LDA(At, 1, 0); PG8_STAGE(PG8_SA(0, 1), a2 + hstepA, voffA);
            PG8_WAIT_V(8); PG8_WAIT_L(0); PG8_BAR; PG8_MMA(0, 0, At, B0); PG8_MMA(0, 1, At, B1); PG8_BAR; PG8_SCHED;
            PG8_LDA(At, 1, 1); PG8_STAGE(PG8_SB(1, 0), b3, voffB); PG8_STAGE(PG8_SB(1, 1), b3 + hstepB, voffB); PG8_STAGE(PG8_SA(1, 0), a3, voffA);
            PG8_WAIT_V(8); PG8_WAIT_L(0); PG8_BAR; PG8_MMA(1, 0, At, B0); PG8_MMA(1, 1, At, B1); PG8_BAR; PG8_SCHED;
            } else {
            PG8_LDB(B0, 0, 0); PG8_SCHED; PG8_LDA(At, 0, 0); PG8_STAGE(PG8_SA(1, 1), a1 + hstepA, voffA);
            PG8_WAIT_L(8); PG8_BAR; PG8_WAIT_L(0); PG8_MMA(0, 0, At, B0); PG8_BAR; PG8_SCHED;
            PG8_LDB(B1, 0, 1); PG8_STAGE(PG8_SB(0, 0), b2, voffB);
            PG8_BAR; PG8_WAIT_L(0); PG8_MMA(0, 1, At, B1); PG8_BAR;
            PG8_LDA(At, 0, 1); PG8_STAGE(PG8_SA(0, 0), a2, voffA);
            PG8_BAR; PG8_WAIT_L(0); PG8_MMA(1, 0, At, B0); PG8_BAR; PG8_SCHED;
            PG8_STAGE(PG8_SB(0, 1), b2 + hstepB, voffB);
            PG8_WAIT_V(6); PG8_BAR; PG8_MMA(1, 1, At, B1); PG8_BAR;
            PG8_LDB(B0, 1, 0); PG8_SCHED; PG8_LDA(At, 1, 0); PG8_STAGE(PG8_SA(0, 1), a2 + hstepA, voffA);
            PG8_WAIT_L(8); PG8_BAR; PG8_WAIT_L(0); PG8_MMA(0, 0, At, B0); PG8_BAR; PG8_SCHED;
            PG8_LDB(B1, 1, 1); PG8_STAGE(PG8_SB(1, 0), b3, voffB);
            PG8_BAR; PG8_WAIT_L(0); PG8_MMA(0, 1, At, B1); PG8_BAR;
            PG8_LDA(At, 1, 1); PG8_STAGE(PG8_SA(1, 0), a3, voffA);
            PG8_BAR; PG8_WAIT_L(0); PG8_MMA(1, 0, At, B0); PG8_BAR; PG8_SCHED;
            PG8_STAGE(PG8_SB(1, 1), b3 + hstepB, voffB);
            PG8_WAIT_V(6); PG8_BAR; PG8_MMA(1, 1, At, B1); PG8_BAR;
            }
        }
        if constexpr (ALIGN_EPI) { if (wr == 0) PG8_BAR; }
        if constexpr (!Epi::AFTER_DRAIN) { int fr2 = fr, fq2 = fq; asm volatile("" : "+v"(fr2), "+v"(fq2)); E(acc, cur, wr, wc, fr2, fq2); S.done(cur); }
        if (!has_next) break;
#pragma unroll
        for (int a = 0; a < 2; ++a)
#pragma unroll
            for (int b = 0; b < 2; ++b)
#pragma unroll
                for (int m = 0; m < 4; ++m)
#pragma unroll
                    for (int n = 0; n < 2; ++n) acc[a][b][m][n] = (f32x4){0.f, 0.f, 0.f, 0.f};
        cur = nxt; cA = nA; cB = nB; ++ui;
        if constexpr (ALIGN_EPI) { if (wr == 1) PG8_BAR; }
    }
    PG8_WAIT_V(0);
    if constexpr (!ALIGN_EPI) { if (wr == 0) PG8_BAR; }
    PG8_BAR;
    if constexpr (Epi::AFTER_DRAIN) { E.fused(acc, cur, wr, wc, fr, fq, lds, wid, lane); S.done(cur); }
#undef PG8_SA
#undef PG8_SB
#undef PG8_STAGE
#undef PG8_LDA
#undef PG8_LDB
#undef PG8_MMA
#undef PG8_WAIT_V
#undef PG8_WAIT_L
#undef PG8_BAR
#undef PG8_SCHED
}
}

#define LAS __attribute__((address_space(3)))
typedef unsigned short bf16;
typedef float f32x4 __attribute__((ext_vector_type(4)));
typedef unsigned u32x4 __attribute__((ext_vector_type(4)));
typedef unsigned u32x2 __attribute__((ext_vector_type(2)));
constexpr int DM = 1024, NCTX = 8192, MTOK = 12288, DINP = 2560, DFF = 4096;
constexpr int R_OFF = 0, K_OFF = 512, V_OFF = 1024, WD_OFF = 1536, AD_OFF = 1664, GD_OFF = 1792, F_OFF = 1920, P_OFF = 2176, DIN = 2432;
constexpr size_t MiB = 1u << 20;
constexpr size_t WS_CTL = 0, WS_MOD = 1 * MiB, WS_FW = 1 * MiB + 512 * 1024, WS_BC = 2 * MiB, WS_CS256 = 3 * MiB, WS_CS1024 = 4 * MiB, WS_WIN = 8 * MiB, WS_WOUT = 18 * MiB,
                 WS_W1 = 22 * MiB, WS_W2 = 38 * MiB, WS_H = 54 * MiB, WS_MIXED = 78 * MiB, WS_PROJ = 102 * MiB, WS_YCS = 162 * MiB, WS_YF = 102 * MiB, WS_YB = 126 * MiB  , WS_U = 174 * MiB, WS_KINV = 220 * MiB, WS_GUPT = 221 * MiB,
                 WS_FF = 102 * MiB, WS_WUPT = 222 * MiB, WS_AUPT = 222 * MiB + 256 * 1024, WS_END = 223 * MiB;
constexpr int LDS_BYTES = 147456, RING_BYTES = 131072, MISC_OFF = RING_BYTES + 320;
constexpr int NTHR = 512;
enum { I_XP = 0, I_XS, I_STATE, I_C, I_CCTX, I_WADA, I_BADA, I_N1G, I_WIN, I_MU, I_W0, I_WUP, I_A0, I_AUP, I_GUP, I_KK, I_KA, I_RK, I_LNW, I_LNB, I_WFNET, I_WPOOL, I_PSCALE, I_WOUT, I_N2G, I_WFF1, I_WFF2, I_FNG, N_IN };
struct KP { const float* in[N_IN]; float* out; unsigned char* ws; int ph_lo, ph_hi; };
typedef const __attribute__((address_space(4))) KP CKP;

__device__ __forceinline__ unsigned f2bf(float f) { unsigned u = __builtin_bit_cast(unsigned, f); return (u + 0x7fffu + ((u >> 16) & 1u)) >> 16; }
__device__ __forceinline__ unsigned pk2(float lo, float hi) { return f2bf(lo) | (f2bf(hi) << 16); }
__device__ __forceinline__ float bflo(unsigned w) { return __builtin_bit_cast(float, w << 16); }
__device__ __forceinline__ float bfhi(unsigned w) { return __builtin_bit_cast(float, w & 0xffff0000u); }
__device__ __forceinline__ float bf1(bf16 h) { return __builtin_bit_cast(float, (unsigned)h << 16); }
__device__ __forceinline__ float fexp(float x) { return __builtin_amdgcn_exp2f(x * 1.4426950408889634f); }
__device__ __forceinline__ float flog(float x) { return __builtin_amdgcn_logf(x) * 0.6931471805599453f; }
__device__ __forceinline__ float frcp(float x) { return __builtin_amdgcn_rcpf(x); }
__device__ __forceinline__ float frsq(float x) { return __builtin_amdgcn_rsqf(x); }
__device__ __forceinline__ float fsigmoid(float x) { return frcp(1.0f + fexp(-x)); }
template <int CTRL> __device__ __forceinline__ float dppf(float x) { return __builtin_bit_cast(float, __builtin_amdgcn_update_dpp(0, __builtin_bit_cast(int, x), CTRL, 0xF, 0xF, true)); }
__device__ __forceinline__ float red8(float x)  { x += dppf<0xB1>(x); x += dppf<0x4E>(x); x += dppf<0x141>(x); return x; }
__device__ __forceinline__ float red16(float x) { x += dppf<0xB1>(x); x += dppf<0x4E>(x); x += dppf<0x141>(x); x += dppf<0x140>(x); return x; }
__device__ __forceinline__ float wave_sum(float v) {
    v = red16(v);
    const float s0 = __builtin_bit_cast(float, __builtin_amdgcn_readlane(__builtin_bit_cast(int, v), 0)), s1 = __builtin_bit_cast(float, __builtin_amdgcn_readlane(__builtin_bit_cast(int, v), 16));
    const float s2 = __builtin_bit_cast(float, __builtin_amdgcn_readlane(__builtin_bit_cast(int, v), 32)), s3 = __builtin_bit_cast(float, __builtin_amdgcn_readlane(__builtin_bit_cast(int, v), 48));
    return (s0 + s1) + (s2 + s3);
}
__device__ __forceinline__ void load4bf(const bf16* p, float (&o)[4]) { const u32x2 w = *(const u32x2*)p; o[0] = bflo(w.x); o[1] = bfhi(w.x); o[2] = bflo(w.y); o[3] = bfhi(w.y); }
__device__ __forceinline__ void load8bf(const bf16* p, float (&o)[8]) { const u32x4 w = *(const u32x4*)p; o[0] = bflo(w.x); o[1] = bfhi(w.x); o[2] = bflo(w.y); o[3] = bfhi(w.y); o[4] = bflo(w.z); o[5] = bfhi(w.z); o[6] = bflo(w.w); o[7] = bfhi(w.w); }
__device__ __forceinline__ void shift4(const bf16* proj, int row, bool hasp, bool hasn, int col, const float* mu, float (&u)[4]) {
    float p[4], a[4] = {0.f, 0.f, 0.f, 0.f}, b[4] = {0.f, 0.f, 0.f, 0.f};
    load4bf(proj + (size_t)row * DINP + col, p);
    if (hasp) load4bf(proj + (size_t)(row - 1) * DINP + col, a);
    if (hasn) load4bf(proj + (size_t)(row + 1) * DINP + col, b);
    const f32x4 m = *(const f32x4*)(mu + col);
#pragma unroll
    for (int j = 0; j < 4; ++j) u[j] = p[j] + m[j] * (0.5f * (a[j] + b[j]) - p[j]);
}

__device__ __forceinline__ void transpose_item(const float* W, int K, int N, bf16* WT, LAS float* scr, int item, int lane) {
    const int nblk = N / 32, kb = item / nblk, nb = item % nblk, k0 = 64 * kb, n0 = 32 * nb;
#pragma unroll 8
    for (int i = 0; i < 32; ++i) { const int kk = 2 * i + (lane >> 5); scr[kk * 33 + (lane & 31)] = W[(size_t)(k0 + kk) * N + n0 + (lane & 31)]; }
    asm volatile("s_waitcnt lgkmcnt(0)" ::: "memory");
    const int c = lane & 7;
#pragma unroll
    for (int j = 0; j < 4; ++j) { const int n = (lane >> 3) + 8 * j; const LAS float* s = scr + (8 * c) * 33 + n;
        u32x4 o; o.x = pk2(s[0 * 33], s[1 * 33]); o.y = pk2(s[2 * 33], s[3 * 33]); o.z = pk2(s[4 * 33], s[5 * 33]); o.w = pk2(s[6 * 33], s[7 * 33]);
        *(u32x4*)(WT + (size_t)(n0 + n) * K + k0 + 8 * c) = o; }
    asm volatile("s_waitcnt lgkmcnt(0)" ::: "memory");
}
__device__ __forceinline__ void stage_prologue(CKP& p, LAS unsigned char* lds, int bid, int nb) {
    const int tid = opaque_tid(), lane = tid & 63, wave = tid >> 6;
    unsigned char* ws = p.ws;
    {
        LAS float* scr = (LAS float*)(lds + wave * 16384);
        const int gw = bid * 8 + wave, NGW = nb * 8;
        constexpr int I_IN = 16 * 76, I_OUT = 16 * 32, I_1 = 16 * 128, I_2 = 64 * 32, I_L = I_IN + I_OUT + I_1 + I_2;
#pragma unroll 1
        for (int it = gw; it < 2 * I_L; it += NGW) {
            const int l = it / I_L; int r = it % I_L;
            if (r < I_IN) { transpose_item(p.in[I_WIN] + (size_t)l * DM * DIN, DM, DIN, (bf16*)(ws + WS_WIN) + (size_t)l * DINP * DM, scr, r, lane); continue; } r -= I_IN;
            if (r < I_OUT) { transpose_item(p.in[I_WOUT] + (size_t)l * DM * DM, DM, DM, (bf16*)(ws + WS_WOUT) + (size_t)l * DM * DM, scr, r, lane); continue; } r -= I_OUT;
            if (r < I_1) { transpose_item(p.in[I_WFF1] + (size_t)l * DM * DFF, DM, DFF, (bf16*)(ws + WS_W1) + (size_t)l * DFF * DM, scr, r, lane); continue; } r -= I_1;
            transpose_item(p.in[I_WFF2] + (size_t)l * DFF * DM, DFF, DM, (bf16*)(ws + WS_W2) + (size_t)l * DM * DFF, scr, r, lane);
        }
    }
    const int gt = bid * NTHR + tid, NGT = nb * NTHR;
#pragma unroll 1
    for (int i = gt; i < 2 * 128 * DM / 8; i += NGT) { const int l = i / (128 * DM / 8), r = i % (128 * DM / 8);
        *(u32x4*)((bf16*)(ws + WS_WIN) + (size_t)l * DINP * DM + (size_t)DIN * DM + (size_t)r * 8) = (u32x4){0u, 0u, 0u, 0u}; }
#pragma unroll 1
    for (int i = gt; i < 256 * 512 + 1024 * 2048; i += NGT) {
        int L, k, j; bf16* dst;
        if (i < 256 * 512) { L = 256; k = i / 512; j = i % 512; dst = (bf16*)(ws + WS_CS256) + i; }
        else { const int i2 = i - 256 * 512; L = 1024; k = i2 / 2048; j = i2 % 2048; dst = (bf16*)(ws + WS_CS1024) + i2; }
        const int jj = j >= L ? j - L : j; const int idx = (k * jj) & (L - 1);
        const float rev = (float)idx / (float)L; const float s = __builtin_amdgcn_sinf(rev), c = __builtin_amdgcn_cosf(rev);
        *dst = (bf16)f2bf(j >= L ? -s : c);
    }
#pragma unroll 1
    for (int i = gt; i < 2 * 4 * 64 * 128; i += NGT) {
        const int o = i & 127, c = (i >> 7) & 63, lg = i >> 13; const float* wf = p.in[I_WFNET] + (size_t)lg * 4096 + (o & 63);
        float acc = 0.f;
        for (int cp = 0; cp < 64; ++cp) { const float rev = (float)((c * cp) & 63) * (1.0f / 64.0f); const float s = __builtin_amdgcn_sinf(rev), co = __builtin_amdgcn_cosf(rev); acc += (o < 64 ? co : s) * wf[cp * 64]; }
        ((float*)(ws + WS_FW))[i] = acc;
    }
#pragma unroll 1
    for (int i = gt; i < 2 * 2 * 64 * 512; i += NGT) { const int c = i & 511, r = (i >> 9) & 63, ld = i >> 15;
        ((bf16*)(ws + WS_WUPT))[(size_t)(ld * 512 + c) * 64 + r] = (bf16)f2bf(p.in[I_WUP][i]);
        ((bf16*)(ws + WS_AUPT))[(size_t)(ld * 512 + c) * 64 + r] = (bf16)f2bf(p.in[I_AUP][i]); }
#pragma unroll 1
    for (int i = gt; i < 2 * 128 * 512; i += NGT) { const int c = i & 511, r = (i >> 9) & 127, ll = i >> 16;
        ((bf16*)(ws + WS_GUPT))[(size_t)(ll * 512 + c) * 128 + r] = (bf16)f2bf(p.in[I_GUP][i]); }
#pragma unroll 1
    for (int i = gt; i < MTOK * DM / 4; i += NGT) {
        const f32x4 v = i < NCTX * DM / 4 ? ((const f32x4*)p.in[I_XP])[i] : ((const f32x4*)p.in[I_XS])[i - NCTX * DM / 4];
        ((f32x4*)p.out)[i] = v;
    }
    __syncthreads();
    LAS float* sc = (LAS float*)lds; LAS float* red = (LAS float*)(lds + 20480);
#pragma unroll 1
    for (int it = bid; it < 192; it += nb) {
        const int l = it / 96, cgp = it % 96;
        for (int i = tid; i < 5 * 1024; i += NTHR) { const int cond = i >> 10, k = i & 1023; const float v = cond == 0 ? p.in[I_CCTX][k] : p.in[I_C][(cond - 1) * 1024 + k]; sc[i] = v * fsigmoid(v); }
        __syncthreads();
        const int cgi = tid & 15, kg = tid >> 4;
        f32x4 acc[5];
#pragma unroll
        for (int c = 0; c < 5; ++c) acc[c] = (f32x4){0.f, 0.f, 0.f, 0.f};
        const float* wp = p.in[I_WADA] + ((size_t)l * 1024 + kg * 32) * 6144 + cgp * 64 + cgi * 4;
#pragma unroll 4
        for (int kk = 0; kk < 32; ++kk) { const f32x4 w = *(const f32x4*)(wp + (size_t)kk * 6144);
#pragma unroll
            for (int c = 0; c < 5; ++c) acc[c] += sc[c * 1024 + kg * 32 + kk] * w; }
#pragma unroll
        for (int c = 0; c < 5; ++c) *(LAS f32x4*)(red + (kg * 5 + c) * 64 + cgi * 4) = acc[c];
        __syncthreads();
        if (tid < 320) { const int cond = tid >> 6, col = tid & 63; float s = p.in[I_BADA][l * 6144 + cgp * 64 + col];
            for (int g = 0; g < 32; ++g) s += red[(g * 5 + cond) * 64 + col];
            ((float*)(ws + WS_MOD))[(l * 5 + cond) * 6144 + cgp * 64 + col] = s; }
        __syncthreads();
    }
}

__device__ __forceinline__ void stage_norm(CKP& p, int l, int which, int bid, int nb) {
    const int tid = opaque_tid(), lane = tid & 63, wave = tid >> 6;
    const float* g = p.in[which ? I_N2G : I_N1G] + l * DM;
    const float* mod = (const float*)(p.ws + WS_MOD) + (size_t)l * 5 * 6144 + (which ? 3 * 1024 : 0);
    bf16* H = (bf16*)(p.ws + WS_H);
#pragma unroll 1
    for (int row = bid * 8 + wave; row < MTOK; row += nb * 8) {
        const f32x4* xr = (const f32x4*)(p.out + (size_t)row * DM) + lane;
        f32x4 v[4]; float s = 0.f;
#pragma unroll
        for (int j = 0; j < 4; ++j) { v[j] = xr[64 * j]; s += (v[j].x * v[j].x + v[j].y * v[j].y) + (v[j].z * v[j].z + v[j].w * v[j].w); }
        const float rstd = frsq(wave_sum(s) * (1.0f / DM) + 1e-6f);
        const int cond = row < NCTX ? 0 : 1 + ((row - NCTX) >> 10);
        const float* sh = mod + cond * 6144; const float* scl = sh + 1024;
        unsigned long long* o8 = (unsigned long long*)(H + (size_t)row * DM) + lane;
#pragma unroll
        for (int j = 0; j < 4; ++j) { const int col = 4 * lane + 256 * j; const f32x4 gg = *(const f32x4*)(g + col), a = *(const f32x4*)(sh + col), b = *(const f32x4*)(scl + col);
            const f32x4 y = v[j] * rstd * gg * (b + 1.0f) + a;
            o8[64 * j] = (unsigned long long)pk2(y.x, y.y) | ((unsigned long long)pk2(y.z, y.w) << 32); }
    }
}
__device__ __forceinline__ void stage_final(CKP& p, int bid, int nb) {
    const int tid = opaque_tid(), lane = tid & 63, wave = tid >> 6;
    const float* g = p.in[I_FNG];
#pragma unroll 1
    for (int row = bid * 8 + wave; row < MTOK; row += nb * 8) {
        f32x4* xr = (f32x4*)(p.out + (size_t)row * DM) + lane;
        f32x4 v[4]; float s = 0.f;
#pragma unroll
        for (int j = 0; j < 4; ++j) { v[j] = xr[64 * j]; s += (v[j].x * v[j].x + v[j].y * v[j].y) + (v[j].z * v[j].z + v[j].w * v[j].w); }
        const float rstd = frsq(wave_sum(s) * (1.0f / DM) + 1e-6f);
#pragma unroll
        for (int j = 0; j < 4; ++j) xr[64 * j] = v[j] * rstd * *(const f32x4*)(g + 4 * lane + 256 * j);
    }
}


typedef short bf16x8 __attribute__((ext_vector_type(8)));
typedef float f32x2v __attribute__((ext_vector_type(2)));
typedef __bf16 bf16x2v __attribute__((ext_vector_type(2)));
#define MFMA16(a, b, c) __builtin_amdgcn_mfma_f32_16x16x32_bf16((a), (b), (c), 0, 0, 0)
__device__ __forceinline__ unsigned cvt2(float lo, float hi) { f32x2v v = {lo, hi}; bf16x2v b = __builtin_convertvector(v, bf16x2v); return __builtin_bit_cast(unsigned, b); }
__device__ __forceinline__ u32x4 pack8(const float (&x)[8]) { u32x4 w; w.x = cvt2(x[0], x[1]); w.y = cvt2(x[2], x[3]); w.z = cvt2(x[4], x[5]); w.w = cvt2(x[6], x[7]); return w; }
__device__ __forceinline__ void shift8(const bf16* proj, int row, bool hasp, bool hasn, int col, const float* mu, float (&u)[8]) {
    float p[8], a[8], b[8];
    load8bf(proj + (size_t)row * DINP + col, p);
    if (hasp) load8bf(proj + (size_t)(row - 1) * DINP + col, a); else {
#pragma unroll
        for (int j = 0; j < 8; ++j) a[j] = 0.f; }
    if (hasn) load8bf(proj + (size_t)(row + 1) * DINP + col, b); else {
#pragma unroll
        for (int j = 0; j < 8; ++j) b[j] = 0.f; }
    const f32x4 m0 = *(const f32x4*)(mu + col), m1 = *(const f32x4*)(mu + col + 4);
#pragma unroll
    for (int j = 0; j < 4; ++j) { u[j] = p[j] + m0[j] * (0.5f * (a[j] + b[j]) - p[j]); u[4 + j] = p[4 + j] + m1[j] * (0.5f * (a[4 + j] + b[4 + j]) - p[4 + j]); }
}
__device__ __forceinline__ int opq(int x) { asm volatile("" : "+v"(x)); return x; }
constexpr int TS = 72, TB = 64 * TS * 2;
constexpr int L_HT = 0, L_TW = 9216, L_AD = 18432, L_LP = 27648, L_AP = 45056, L_AT = 62464, L_RT = L_AT + TB, L_BH = L_RT + TB, L_KH = L_BH + TB, L_VR = L_KH + TB, L_YS = L_VR + TB;
constexpr int L_AAB = L_TW, L_AAK = L_AAB + 4096, L_ARB = L_AAK + 3072, L_ARK = L_ARB + 3072, L_UT = L_ARK + 3072, L_W1 = L_AP;
static_assert(L_UT + 64 * 24 * 2 <= L_LP && L_YS + 17408 <= RING_BYTES, "scan LDS map");
constexpr int LPS = 68;
#define LBAR() asm volatile("s_waitcnt lgkmcnt(0)\n\ts_barrier" ::: "memory")
typedef short s16x4v __attribute__((ext_vector_type(4)));
__device__ __forceinline__ bf16x8 tr8(const LAS bf16* p) {
    const s16x4v lo = __builtin_bit_cast(s16x4v, __builtin_amdgcn_ds_read_tr16_b64_v4i16((LAS s16x4v*)p));
    const s16x4v hi = __builtin_bit_cast(s16x4v, __builtin_amdgcn_ds_read_tr16_b64_v4i16((LAS s16x4v*)(p + 4 * TS)));
    return (bf16x8){lo[0], lo[1], lo[2], lo[3], hi[0], hi[1], hi[2], hi[3]};
}

__device__ __forceinline__ void rwkv_item3(CKP& p, int l, LAS unsigned char* lds, int item) {
    const int tid0 = opaque_tid(), w = __builtin_amdgcn_readfirstlane(tid0 >> 6);
    int tid = tid0, fr = tid & 15, fg = (tid & 63) >> 4;
    int bseq, h, dir, L, base; bool lat;
    if (item < 64) { lat = true; bseq = item >> 4; h = (item >> 1) & 7; dir = item & 1; L = 1024; base = NCTX + bseq * 1024; }
    else { const int i2 = item - 64; lat = false; bseq = i2 >> 4; h = (i2 >> 1) & 7; dir = i2 & 1; L = 256; base = bseq * 256; }
    const bf16* U = (const bf16*)(p.ws + WS_U);
    const float* KINV = (const float*)(p.ws + WS_KINV);
    float* Yout = (float*)(p.ws + (dir ? WS_YB : WS_YF));
    float* BC = (float*)(p.ws + WS_BC) + (size_t)dir * MTOK * 8;
    const bf16* wupt = (const bf16*)(p.ws + WS_WUPT) + ((size_t)(l * 2 + dir) * 512 + h * 64) * 64;
    const bf16* aupt = (const bf16*)(p.ws + WS_AUPT) + ((size_t)(l * 2 + dir) * 512 + h * 64) * 64;
    LAS bf16* HT = (LAS bf16*)(lds + L_HT);   LAS bf16* TW = (LAS bf16*)(lds + L_TW);   LAS bf16* AD = (LAS bf16*)(lds + L_AD);
    LAS float* LP = (LAS float*)(lds + L_LP); LAS float* AP = (LAS float*)(lds + L_AP);
    LAS bf16* AT = (LAS bf16*)(lds + L_AT);   LAS bf16* RT = (LAS bf16*)(lds + L_RT);   LAS bf16* BH = (LAS bf16*)(lds + L_BH);   LAS bf16* KH = (LAS bf16*)(lds + L_KH);
    LAS bf16* VR = (LAS bf16*)(lds + L_VR);   LAS float* YS = (LAS float*)(lds + L_YS);
    LAS float* AAB = (LAS float*)(lds + L_AAB); LAS bf16* AAK = (LAS bf16*)(lds + L_AAK); LAS bf16* ARB = (LAS bf16*)(lds + L_ARB); LAS bf16* ARK = (LAS bf16*)(lds + L_ARK);
    LAS bf16* UT = (LAS bf16*)(lds + L_UT); LAS float* W1 = (LAS float*)(lds + L_W1);
    const bf16x8 zero8 = {0, 0, 0, 0, 0, 0, 0, 0};
    const int tv = w & 3, tk0 = 2 * (w >> 2);
    f32x4 hacc[2];
#pragma unroll
    for (int x = 0; x < 2; ++x) {
        if (lat) hacc[x] = *(const f32x4*)(p.in[I_STATE] + ((((size_t)bseq * 2 + l) * 2 + dir) * 8 + h) * 4096 + (16 * tv + fr) * 64 + 16 * (tk0 + x) + 4 * fg);
        else hacc[x] = (f32x4){0.f, 0.f, 0.f, 0.f};
        u32x2 hw; hw.x = cvt2(hacc[x][0], hacc[x][1]); hw.y = cvt2(hacc[x][2], hacc[x][3]);
        *(LAS u32x2*)(HT + (16 * tv + fr) * TS + 16 * (tk0 + x) + 4 * fg) = hw; }
    int ei = tid >> 3, ec8 = (tid & 7) * 8; const int hc8 = h * 64 + ec8;
    float kkp[8], kap[8], rkp[8];
#pragma unroll
    for (int e = 0; e < 8; ++e) { kkp[e] = p.in[I_KK][l * 512 + hc8 + e]; kap[e] = p.in[I_KA][l * 512 + hc8 + e]; rkp[e] = p.in[I_RK][l * 512 + hc8 + e]; }
#define SCAN_PREFETCH(SC) do { const int _t0 = opq(tid0), _ei = _t0 >> 3, _ec8 = (_t0 & 7) * 8; const int _step = (SC) * 64 + _ei, _t = dir ? L - 1 - _step : _step; \
        const bf16* _u = U + (size_t)(base + _t) * 1920; \
        nwd = *(const u32x4*)(_u + WD_OFF + dir * 64 + _ec8); nad = *(const u32x4*)(_u + AD_OFF + dir * 64 + _ec8); \
        nr = *(const u32x4*)(_u + R_OFF + h * 64 + _ec8); nk = *(const u32x4*)(_u + K_OFF + h * 64 + _ec8); nv = *(const u32x4*)(_u + V_OFF + h * 64 + _ec8); \
        ninv = KINV[(size_t)(base + _t) * 8 + h]; } while (0)
    bf16x8 lbw[2][2], lba[2][2]; float lw0c[2], la0c[2];
#pragma unroll
    for (int x = 0; x < 2; ++x) { const int c = ((w & 1) * 2 + x) * 16 + fr;
        lbw[x][0] = *(const bf16x8*)(wupt + c * 64 + fg * 8); lbw[x][1] = *(const bf16x8*)(wupt + c * 64 + 32 + fg * 8);
        lba[x][0] = *(const bf16x8*)(aupt + c * 64 + fg * 8); lba[x][1] = *(const bf16x8*)(aupt + c * 64 + 32 + fg * 8);
        lw0c[x] = p.in[I_W0][(l * 2 + dir) * 512 + h * 64 + c]; la0c[x] = p.in[I_A0][(l * 2 + dir) * 512 + h * 64 + c]; }
    u32x4 nwd, nad, nr, nk, nv; float ninv;
    SCAN_PREFETCH(0);
    __syncthreads();
#pragma unroll 1
    for (int sc = 0; sc < L / 64; ++sc) {
        tid = opq(tid0); fr = tid & 15; fg = (tid & 63) >> 4; ei = tid >> 3; ec8 = (tid & 7) * 8;
        *(LAS u32x4*)(TW + ei * TS + ec8) = nwd; *(LAS u32x4*)(AD + ei * TS + ec8) = nad;
        const u32x4 cr = nr, ck = nk, cv = nv; const float kinv = ninv;
        __syncthreads();
        tid = opq(tid0); fr = tid & 15; fg = (tid & 63) >> 4; ei = tid >> 3; ec8 = (tid & 7) * 8;
        { const int ti = w >> 1;
          const bf16x8 aw0 = *(const LAS bf16x8*)(TW + (ti * 16 + fr) * TS + fg * 8), aw1 = *(const LAS bf16x8*)(TW + (ti * 16 + fr) * TS + 32 + fg * 8);
          const bf16x8 aa0 = *(const LAS bf16x8*)(AD + (ti * 16 + fr) * TS + fg * 8), aa1 = *(const LAS bf16x8*)(AD + (ti * 16 + fr) * TS + 32 + fg * 8);
#pragma unroll
          for (int x = 0; x < 2; ++x) { const int c = ((w & 1) * 2 + x) * 16 + fr;
              f32x4 cw = (f32x4){lw0c[x], lw0c[x], lw0c[x], lw0c[x]}, ca = (f32x4){la0c[x], la0c[x], la0c[x], la0c[x]};
              cw = MFMA16(aw0, lbw[x][0], cw); cw = MFMA16(aw1, lbw[x][1], cw); ca = MFMA16(aa0, lba[x][0], ca); ca = MFMA16(aa1, lba[x][1], ca);
#pragma unroll
              for (int r = 0; r < 4; ++r) { LP[(ti * 16 + 4 * fg + r) * LPS + c] = cw[r]; AP[(ti * 16 + 4 * fg + r) * LPS + c] = ca[r]; } } }
        __syncthreads();
        tid = opq(tid0); fr = tid & 15; fg = (tid & 63) >> 4; ei = tid >> 3; ec8 = (tid & 7) * 8;
        float av[8], bv[8], kd[8], rr[8], bcv;
        { const f32x4 wp0 = *(const LAS f32x4*)(LP + ei * LPS + ec8), wp1 = *(const LAS f32x4*)(LP + ei * LPS + ec8 + 4);
          const f32x4 ap0 = *(const LAS f32x4*)(AP + ei * LPS + ec8), ap1 = *(const LAS f32x4*)(AP + ei * LPS + ec8 + 4);
          float kk[8], lw[8], bc = 0.f;
          rr[0] = bflo(cr.x); rr[1] = bfhi(cr.x); rr[2] = bflo(cr.y); rr[3] = bfhi(cr.y); rr[4] = bflo(cr.z); rr[5] = bfhi(cr.z); rr[6] = bflo(cr.w); rr[7] = bfhi(cr.w);
          kk[0] = bflo(ck.x); kk[1] = bfhi(ck.x); kk[2] = bflo(ck.y); kk[3] = bfhi(ck.y); kk[4] = bflo(ck.z); kk[5] = bfhi(ck.z); kk[6] = bflo(ck.w); kk[7] = bfhi(ck.w);
#pragma unroll
          for (int e = 0; e < 8; ++e) { const float wpre = e < 4 ? wp0[e & 3] : wp1[e & 3], apre = e < 4 ? ap0[e & 3] : ap1[e & 3];
              lw[e] = -0.6065306597126334f * fsigmoid(wpre);
              const float asg = fsigmoid(apre), kj = kk[e] * kkp[e] * kinv;
              av[e] = -kj; bv[e] = kj * asg;
              kd[e] = kk[e] * (1.0f + (asg - 1.0f) * kap[e]); bc += rr[e] * kd[e] * rkp[e]; }
          bcv = red8(bc);
          *(LAS f32x4*)(LP + ei * LPS + ec8) = (f32x4){lw[0], lw[1], lw[2], lw[3]}; *(LAS f32x4*)(LP + ei * LPS + ec8 + 4) = (f32x4){lw[4], lw[5], lw[6], lw[7]}; }
        __syncthreads();
        tid = opq(tid0);
        if (tid < 256) { const int c = tid & 63, q = tid >> 6; float run = 0.f;
#pragma unroll
            for (int i = 0; i < 16; ++i) { run += LP[(16 * q + i) * LPS + c]; LP[(16 * q + i) * LPS + c] = fexp(run); } }
        __syncthreads();
        tid = opq(tid0); fr = tid & 15; fg = (tid & 63) >> 4; ei = tid >> 3; ec8 = (tid & 7) * 8;
        { const f32x4 g0 = *(const LAS f32x4*)(LP + ei * LPS + ec8), g1 = *(const LAS f32x4*)(LP + ei * LPS + ec8 + 4);
          const int ip = (ei & 15) ? ei - 1 : ei;
          f32x4 p0 = *(const LAS f32x4*)(LP + ip * LPS + ec8), p1 = *(const LAS f32x4*)(LP + ip * LPS + ec8 + 4);
          if ((ei & 15) == 0) { p0 = (f32x4){1.f, 1.f, 1.f, 1.f}; p1 = p0; }
          float xa[8], xr[8], xb[8], xk[8];
#pragma unroll
          for (int e = 0; e < 8; ++e) { const float gi = e < 4 ? g0[e & 3] : g1[e & 3], gp = e < 4 ? p0[e & 3] : p1[e & 3], ginv = frcp(gi);
              xa[e] = av[e] * gp; xr[e] = rr[e] * gi; xb[e] = bv[e] * ginv; xk[e] = kd[e] * ginv; }
          *(LAS u32x4*)(AT + ei * TS + ec8) = pack8(xa); *(LAS u32x4*)(RT + ei * TS + ec8) = pack8(xr); *(LAS u32x4*)(BH + ei * TS + ec8) = pack8(xb); *(LAS u32x4*)(KH + ei * TS + ec8) = pack8(xk);
          *(LAS u32x4*)(VR + ei * TS + ec8) = cv; }
        __syncthreads();
        tid = opq(tid0); fr = tid & 15; fg = (tid & 63) >> 4;
        { const int q = w >> 1, half = w & 1; const LAS bf16* Asrc = half ? RT : AT;
          const bf16x8 af0 = *(const LAS bf16x8*)(Asrc + (16 * q + fr) * TS + fg * 8), af1 = *(const LAS bf16x8*)(Asrc + (16 * q + fr) * TS + 32 + fg * 8);
#pragma unroll
          for (int x = 0; x < 2; ++x) { const LAS bf16* Bsrc = x ? KH : BH;
              const bf16x8 bf0 = *(const LAS bf16x8*)(Bsrc + (16 * q + fr) * TS + fg * 8), bf1_ = *(const LAS bf16x8*)(Bsrc + (16 * q + fr) * TS + 32 + fg * 8);
              f32x4 c = (f32x4){0.f, 0.f, 0.f, 0.f}; c = MFMA16(af0, bf0, c); c = MFMA16(af1, bf1_, c);
#pragma unroll
              for (int r = 0; r < 4; ++r) { const int i = 4 * fg + r, j = fr; const float val = (half ? j <= i : j < i) ? c[r] : 0.f;
                  if (half == 0 && x == 0) AAB[(q * 16 + i) * 16 + j] = val;
                  else { LAS bf16* dst = half == 0 ? AAK : (x == 0 ? ARB : ARK); dst[(q * 16 + i) * 24 + j] = (bf16)(cvt2(val, 0.f) & 0xffffu); } } } }
        __syncthreads();
        tid = opq(tid0); fr = tid & 15; fg = (tid & 63) >> 4;
        { const int q = w >> 1;
          const bf16x8 afr = *(const LAS bf16x8*)(AAK + (q * 16 + fr) * 24 + (fg & 1) * 8);
          const bf16x8 af = fg < 2 ? afr : zero8;
#pragma unroll
          for (int x = 0; x < 2; ++x) { const int tvv = (w & 1) * 2 + x;
              const bf16x8 bfr = tr8(VR + (16 * q + 8 * (fg & 1) + (fr >> 2)) * TS + 16 * tvv + 4 * (fr & 3));
              const bf16x8 bfv = fg < 2 ? bfr : zero8;
              f32x4 c = (f32x4){0.f, 0.f, 0.f, 0.f}; c = MFMA16(af, bfv, c);
#pragma unroll
              for (int r = 0; r < 4; ++r) W1[(q * 16 + 4 * fg + r) * LPS + 16 * tvv + fr] = c[r]; } }
        __syncthreads();
        tid = opq(tid0);
        { const int q = tid >> 7, col = tid & 127; float x[16];
          if (col < 64) {
#pragma unroll
              for (int i = 0; i < 16; ++i) x[i] = bf1(AT[(16 * q + i) * TS + col]); }
          else {
#pragma unroll
              for (int i = 0; i < 16; ++i) x[i] = W1[(q * 16 + i) * LPS + col - 64]; }
#pragma unroll
          for (int i = 1; i < 16; ++i) {
              const LAS f32x4* ar = (const LAS f32x4*)(AAB + (q * 16 + i) * 16);
              float acc = x[i];
#pragma unroll
              for (int j4 = 0; j4 * 4 < i; ++j4) { const f32x4 a4 = ar[j4];
#pragma unroll
                  for (int e = 0; e < 4; ++e) if (j4 * 4 + e < i) acc += a4[e] * x[j4 * 4 + e]; }
              x[i] = acc; }
          if (col < 64) {
#pragma unroll
              for (int i = 0; i < 16; ++i) AT[(16 * q + i) * TS + col] = (bf16)(cvt2(x[i], 0.f) & 0xffffu); }
          else {
#pragma unroll
              for (int i = 0; i < 16; ++i) W1[(q * 16 + i) * LPS + col - 64] = x[i]; } }
        __syncthreads();
        if (sc + 1 < L / 64) SCAN_PREFETCH(sc + 1);
#pragma unroll 1
        for (int q = 0; q < 4; ++q) {
            f32x4 yacc = (f32x4){0.f, 0.f, 0.f, 0.f};
            tid = opq(tid0); fr = tid & 15; fg = (tid & 63) >> 4;
            { const bf16x8 h0 = *(const LAS bf16x8*)(HT + (16 * tv + fr) * TS + fg * 8), h1 = *(const LAS bf16x8*)(HT + (16 * tv + fr) * TS + 32 + fg * 8);
              if (w < 4) {
                  const bf16x8 a0 = *(const LAS bf16x8*)(AT + (q * 16 + fr) * TS + fg * 8), a1 = *(const LAS bf16x8*)(AT + (q * 16 + fr) * TS + 32 + fg * 8);
                  f32x4 u;
#pragma unroll
                  for (int r = 0; r < 4; ++r) u[r] = W1[(q * 16 + 4 * fg + r) * LPS + 16 * tv + fr];
                  u = MFMA16(a0, h0, u); u = MFMA16(a1, h1, u);
                  u32x2 uw; uw.x = cvt2(u[0], u[1]); uw.y = cvt2(u[2], u[3]);
                  *(LAS u32x2*)(UT + (16 * tv + fr) * 24 + 4 * fg) = uw;
              } else {
                  const bf16x8 a0 = *(const LAS bf16x8*)(RT + (16 * q + fr) * TS + fg * 8), a1 = *(const LAS bf16x8*)(RT + (16 * q + fr) * TS + 32 + fg * 8);
                  yacc = MFMA16(a0, h0, yacc); yacc = MFMA16(a1, h1, yacc);
              } }
            LBAR();
            tid = opq(tid0); fr = tid & 15; fg = (tid & 63) >> 4;
            { const bf16x8 bUr = *(const LAS bf16x8*)(UT + (16 * tv + fr) * 24 + (fg & 1) * 8);
              const bf16x8 bVt = tr8(VR + (16 * q + 8 * (fg & 1) + (fr >> 2)) * TS + 16 * tv + 4 * (fr & 3));
              const bf16x8 bU = fg < 2 ? bUr : bVt;
#pragma unroll
              for (int x = 0; x < 2; ++x) { const int tk = tk0 + x;
                  const LAS bf16* src = fg < 2 ? BH : KH;
                  const bf16x8 aF = tr8(src + (16 * q + 8 * (fg & 1) + (fr >> 2)) * TS + 16 * tk + 4 * (fr & 3));
                  const f32x4 ge = *(const LAS f32x4*)(LP + (16 * q + 15) * LPS + 16 * tk + 4 * fg);
                  hacc[x] = MFMA16(aF, bU, hacc[x]) * ge;
                  u32x2 hw; hw.x = cvt2(hacc[x][0], hacc[x][1]); hw.y = cvt2(hacc[x][2], hacc[x][3]);
                  *(LAS u32x2*)(HT + (16 * tv + fr) * TS + 16 * tk + 4 * fg) = hw; }
              if (w >= 4) {
                  const bf16x8 aY = *(const LAS bf16x8*)((fg < 2 ? ARB : ARK) + (q * 16 + fr) * 24 + (fg & 1) * 8);
                  yacc = MFMA16(aY, bU, yacc);
#pragma unroll
                  for (int r = 0; r < 4; ++r) YS[(16 * q + 4 * fg + r) * LPS + 16 * tv + fr] = yacc[r]; } }
            LBAR();
        }
        tid = opq(tid0); ei = tid >> 3; ec8 = (tid & 7) * 8;
        { const int st2 = sc * 64 + ei, t2 = dir ? L - 1 - st2 : st2; float* yo = Yout + (size_t)(base + t2) * 512 + h * 64 + ec8;
          *(f32x4*)yo = *(const LAS f32x4*)(YS + ei * LPS + ec8); *(f32x4*)(yo + 4) = *(const LAS f32x4*)(YS + ei * LPS + ec8 + 4);
          if ((tid & 7) == 0) BC[(size_t)(base + t2) * 8 + h] = bcv; }
    }
#undef SCAN_PREFETCH
    if (!lat) {
#pragma unroll
        for (int x = 0; x < 2; ++x) *(f32x4*)(p.out + (size_t)MTOK * DM + ((((size_t)bseq * 2 + l) * 2 + dir) * 8 + h) * 4096 + (16 * tv + fr) * 64 + 16 * (tk0 + x) + 4 * fg) = hacc[x]; }
    __syncthreads();
}

__device__ __forceinline__ void stage_upass(CKP& p, int l, int bid, int nb) {
    const int tid = opaque_tid(), sub = tid >= 240 ? 1 : 0, j = tid - sub * 240, col = 8 * j;
    const bf16* proj = (const bf16*)(p.ws + WS_PROJ); bf16* U = (bf16*)(p.ws + WS_U); float* KINV = (float*)(p.ws + WS_KINV);
    const float* mu = p.in[I_MU] + l * 1920;
    if (tid < 480) {
        const bool isk = col >= K_OFF && col < V_OFF;
        const float* kkp = p.in[I_KK] + l * 512 + (isk ? col - K_OFF : 0);
        const f32x4 k0 = *(const f32x4*)kkp, k1 = *(const f32x4*)(kkp + 4);
#pragma unroll 1
        for (int tok0 = bid * 2 + sub; tok0 < MTOK; tok0 += nb * 4) {
            float uu[2][8];
#pragma unroll
            for (int z = 0; z < 2; ++z) { const int tok = min(tok0 + z * nb * 2, MTOK - 1);
                const bool lat = tok >= NCTX; const int L = lat ? 1024 : 256, t = lat ? (tok - NCTX) & 1023 : tok & 255;
                shift8(proj, tok, t > 0, t < L - 1, col, mu, uu[z]); }
#pragma unroll
            for (int z = 0; z < 2; ++z) { const int tok = tok0 + z * nb * 2;
                float ss = 0.f;
#pragma unroll
                for (int e = 0; e < 8; ++e) { const float kn = uu[z][e] * (e < 4 ? k0[e & 3] : k1[e & 3]); ss += kn * kn; }
                ss = red8(ss);
                if (tok < MTOK) {
                    if (isk && (j & 7) == 0) KINV[(size_t)tok * 8 + ((col - K_OFF) >> 6)] = fminf(frsq(ss), 1e12f);
                    if (col >= WD_OFF && col < AD_OFF) {
#pragma unroll
                        for (int e = 0; e < 8; ++e) uu[z][e] = 1.0f - 2.0f * frcp(fexp(2.0f * uu[z][e]) + 1.0f); }
                    if (col >= GD_OFF) {
#pragma unroll
                        for (int e = 0; e < 8; ++e) uu[z][e] = fsigmoid(uu[z][e]); }
                    *(u32x4*)(U + (size_t)tok * 1920 + col) = pack8(uu[z]); } }
        }
    }
}

__device__ __forceinline__ void fnet1_item(CKP& p, int l, LAS unsigned char* lds, int item) {
    const int tid = opaque_tid(), tb = item >> 2, g = item & 3, tok0 = tb * 64;
    const bf16* proj = (const bf16*)(p.ws + WS_PROJ);
    LAS float* XT = (LAS float*)lds;
    LAS float* FWL = XT + 64 * 65;
    { const int ti = tid >> 3, c8 = (tid & 7) * 8; float x[8]; load8bf(proj + (size_t)(tok0 + ti) * DINP + F_OFF + g * 64 + c8, x);
#pragma unroll
      for (int j = 0; j < 8; ++j) XT[ti * 65 + c8 + j] = x[j]; }
    const float* fw = (const float*)(p.ws + WS_FW) + (size_t)(l * 4 + g) * 8192;
    for (int i = tid; i < 2048; i += NTHR) *(LAS f32x4*)(FWL + i * 4) = *(const f32x4*)(fw + i * 4);
    __syncthreads();
    const int ti = tid & 63, og = tid >> 6;
    f32x4 acc[4];
#pragma unroll
    for (int j = 0; j < 4; ++j) acc[j] = (f32x4){0.f, 0.f, 0.f, 0.f};
#pragma unroll 4
    for (int c = 0; c < 64; ++c) { const float x = XT[ti * 65 + c];
#pragma unroll
        for (int j = 0; j < 4; ++j) acc[j] += x * *(const LAS f32x4*)(FWL + c * 128 + og * 16 + j * 4); }
    const bool lat = tok0 >= NCTX;
    const int L = lat ? 1024 : 256, bq = lat ? (tok0 - NCTX) >> 10 : tok0 >> 8, t = (lat ? (tok0 - NCTX) & 1023 : tok0 & 255) + ti;
    const float scale = lat ? (1.0f / 256.0f) : (1.0f / 128.0f);
    bf16* Y = (bf16*)(p.ws + WS_YCS) + (lat ? (size_t)8192 * 512 : 0);
    const int cs = og >> 2, K2 = 2 * L;
#pragma unroll
    for (int j = 0; j < 4; ++j)
#pragma unroll
        for (int e = 0; e < 4; ++e) { const int d = (og & 3) * 16 + j * 4 + e;
            Y[(size_t)((bq * 4 + g) * 64 + d) * K2 + cs * L + t] = (bf16)f2bf(acc[j][e] * scale); }
    __syncthreads();
}

__device__ __forceinline__ void pool_item(CKP& p, int l, LAS unsigned char* lds, int item) {
    const int tid = opaque_tid(), tb = item >> 2, gi = item & 3, tok0 = tb * 64, hw = 1 << gi;
    const bf16* proj = (const bf16*)(p.ws + WS_PROJ);
    LAS float* DT = (LAS float*)lds;
    LAS float* WP = DT + 64 * 65;
    LAS float* CSUM = WP + 4096;
    const float* wpool = p.in[I_WPOOL] + (size_t)(l * 4 + gi) * 4096;
    for (int i = tid; i < 1024; i += NTHR) *(LAS f32x4*)(WP + i * 4) = *(const f32x4*)(wpool + i * 4);
    const int ti = tid >> 3, c8 = (tid & 7) * 8, tok = tok0 + ti, col = P_OFF + gi * 64 + c8;
    { float sum[8], x[8];
#pragma unroll
      for (int j = 0; j < 8; ++j) sum[j] = 0.f;
      load8bf(proj + (size_t)tok * DINP + col, x);
      float cnt;
      if (tok < NCTX) { const int t = tok & 255, sb = tok - t, lo = max(t - hw, 0), hi = min(t + hw, 256);
          for (int q = lo; q < hi; ++q) { float y[8]; load8bf(proj + (size_t)(sb + q) * DINP + col, y);
#pragma unroll
              for (int j = 0; j < 8; ++j) sum[j] += y[j]; }
          cnt = (float)(hi - lo); }
      else {
          const int t = (tok - NCTX) & 1023, sb = tok - t, r = t >> 6, c = t & 63, rlo = max(r - hw, 0), rhi = min(r + hw, 16), clo = max(c - hw, 0), chi = min(c + hw, 64);
          for (int rq = rlo; rq < rhi; ++rq) { float y[8]; load8bf(proj + (size_t)(sb + rq * 64 + c) * DINP + col, y);
#pragma unroll
              for (int j = 0; j < 8; ++j) sum[j] += y[j]; }
          *(LAS f32x4*)(CSUM + ti * 68 + c8) = (f32x4){sum[0], sum[1], sum[2], sum[3]}; *(LAS f32x4*)(CSUM + ti * 68 + c8 + 4) = (f32x4){sum[4], sum[5], sum[6], sum[7]};
          __syncthreads();
#pragma unroll
          for (int j = 0; j < 8; ++j) sum[j] = 0.f;
          for (int cq = clo; cq < chi; ++cq) { const f32x4 a = *(const LAS f32x4*)(CSUM + cq * 68 + c8), b = *(const LAS f32x4*)(CSUM + cq * 68 + c8 + 4);
#pragma unroll
              for (int j = 0; j < 4; ++j) { sum[j] += a[j]; sum[4 + j] += b[j]; } }
          cnt = (float)((rhi - rlo) * (chi - clo)); }
      const float ic = frcp(cnt);
#pragma unroll
      for (int j = 0; j < 8; ++j) DT[ti * 65 + c8 + j] = sum[j] * ic - x[j]; }
    __syncthreads();
    f32x4 a0 = (f32x4){0.f, 0.f, 0.f, 0.f}, a1 = a0;
#pragma unroll 4
    for (int c = 0; c < 64; ++c) { const float d = DT[ti * 65 + c]; a0 += d * *(const LAS f32x4*)(WP + c * 64 + c8); a1 += d * *(const LAS f32x4*)(WP + c * 64 + c8 + 4); }
    const float* ps = p.in[I_PSCALE] + l * 256 + gi * 64 + c8;
    const f32x4 s0 = *(const f32x4*)ps, s1 = *(const f32x4*)(ps + 4);
    a0 *= s0; a1 *= s1;
    u32x4 w; w.x = pk2(a0[0], a0[1]); w.y = pk2(a0[2], a0[3]); w.z = pk2(a1[0], a1[1]); w.w = pk2(a1[2], a1[3]);
    *(u32x4*)((bf16*)(p.ws + WS_MIXED) + (size_t)tok * DM + 768 + gi * 64 + c8) = w;
    __syncthreads();
}

__device__ __forceinline__ void stage_post(CKP& p, int l, int bid, int nb) {
    const int tid = opaque_tid(), lane = tid & 63, head = __builtin_amdgcn_readfirstlane(tid >> 6), fr = lane & 15, fg = lane >> 4;
    const bf16* Ub = (const bf16*)(p.ws + WS_U);
    const bf16* gupt = (const bf16*)(p.ws + WS_GUPT) + ((size_t)l * 512 + head * 64) * 128;
    const float* YF = (const float*)(p.ws + WS_YF); const float* YB = (const float*)(p.ws + WS_YB);
    const float* BC0 = (const float*)(p.ws + WS_BC); const float* BC1 = BC0 + (size_t)MTOK * 8;
    bf16* MIX = (bf16*)(p.ws + WS_MIXED);
    bf16x8 bg[4][4];
    float lnw[4], lnb[4];
#pragma unroll
    for (int t = 0; t < 4; ++t) { const int c = 16 * t + fr;
#pragma unroll
        for (int ks = 0; ks < 4; ++ks) bg[t][ks] = *(const bf16x8*)(gupt + c * 128 + ks * 32 + fg * 8);
        lnw[t] = p.in[I_LNW][l * 512 + head * 64 + c]; lnb[t] = p.in[I_LNB][l * 512 + head * 64 + c]; }
#pragma unroll 1
    for (int item = bid; item < 768; item += nb) {
        const int tok0 = item * 16;
        bf16x8 ag[4];
#pragma unroll
        for (int ks = 0; ks < 4; ++ks) ag[ks] = *(const bf16x8*)(Ub + (size_t)(tok0 + fr) * 1920 + GD_OFF + ks * 32 + fg * 8);
        float y[4][4], vv[4][4], bc[4];
#pragma unroll
        for (int r = 0; r < 4; ++r) { const size_t tok = tok0 + 4 * fg + r;
            bc[r] = BC0[tok * 8 + head] + BC1[tok * 8 + head];
#pragma unroll
            for (int t = 0; t < 4; ++t) { const int c = head * 64 + 16 * t + fr;
                y[t][r] = YF[tok * 512 + c] + YB[tok * 512 + c]; vv[t][r] = bf1(Ub[tok * 1920 + V_OFF + c]); } }
        f32x4 g[4];
#pragma unroll
        for (int t = 0; t < 4; ++t) { g[t] = (f32x4){0.f, 0.f, 0.f, 0.f};
#pragma unroll
            for (int ks = 0; ks < 4; ++ks) g[t] = MFMA16(ag[ks], bg[t][ks], g[t]); }
#pragma unroll
        for (int r = 0; r < 4; ++r) { const size_t tok = tok0 + 4 * fg + r;
            const float mean = red16((y[0][r] + y[1][r]) + (y[2][r] + y[3][r])) * (1.0f / 64.0f);
            float d[4], q = 0.f;
#pragma unroll
            for (int t = 0; t < 4; ++t) { d[t] = y[t][r] - mean; q += d[t] * d[t]; }
            const float rstd = frsq(red16(q) * (1.0f / 64.0f) + 64e-5f);
#pragma unroll
            for (int t = 0; t < 4; ++t) { const float o = (d[t] * rstd * lnw[t] + lnb[t] + bc[r] * vv[t][r]) * g[t][r];
                MIX[tok * DM + head * 64 + 16 * t + fr] = (bf16)f2bf(o); } }
    }
}

#define XB_TMO      128
#define XB_XCNT(j)  (256  + 64 * (j))
#define XB_XSUB(j)  (1280 + 64 * (j))
#define XB_XGEN(j)  (2304 + 64 * (j))
#define XB_TOP      3328
#define XB_TOPGEN   3392
#define XCD_BAR_WORDS 3456
#define XB_SPIN_CAP (1u << 18)

__device__ __forceinline__ unsigned xb_ld(unsigned* p)              { return __hip_atomic_load(p, __ATOMIC_RELAXED, __HIP_MEMORY_SCOPE_AGENT); }
__device__ __forceinline__ unsigned xb_add(unsigned* p, unsigned v) { return __hip_atomic_fetch_add(p, v, __ATOMIC_RELAXED, __HIP_MEMORY_SCOPE_AGENT); }
__device__ __forceinline__ unsigned xb_xcc_id() { return (unsigned)__builtin_amdgcn_s_getreg((3 << 11) | 20) & 0xFu; }
#define XB_SPIN(cond, bar) do { unsigned _sp = 0; while (cond) { __builtin_amdgcn_s_sleep(1); \
    if ((++_sp & 255u) == 0u) { if (xb_ld(&(bar)[XB_TMO])) break; if (_sp > XB_SPIN_CAP) { atomicAdd(&(bar)[XB_TMO], 1u); break; } } } } while (0)

struct XcdBarrier {
    unsigned* bar; unsigned x;
    volatile LAS unsigned* st;
};

__device__ __forceinline__ XcdBarrier xcd_barrier_post(unsigned* bar, volatile LAS unsigned* st) {
    XcdBarrier b; b.bar = bar; b.x = xb_xcc_id(); b.st = st;
    if (threadIdx.x == 0) (void)xb_add(&bar[XB_XCNT(b.x)], 1u);
    return b;
}
__device__ __forceinline__ void xcd_barrier_complete(unsigned* bar, unsigned x, unsigned& nloc, unsigned& nx) {
    const unsigned G = gridDim.x * gridDim.y * gridDim.z;
    unsigned sum, cnt, mine, sp = 0u;
    for (;;) {
        sum = 0u; cnt = 0u; mine = 0u;
#pragma unroll
        for (unsigned j = 0; j < 16; ++j) { const unsigned c = xb_ld(&bar[XB_XCNT(j)]); sum += c; cnt += (c > 0u) ? 1u : 0u; mine = (j == x) ? c : mine; }
        if (sum == G) break;
        __builtin_amdgcn_s_sleep(1);
        if ((++sp & 255u) == 0u) { if (xb_ld(&bar[XB_TMO])) break; if (sp > XB_SPIN_CAP) { atomicAdd(&bar[XB_TMO], 1u); break; } }
    }
    nloc = mine > 0u ? mine : 1u; nx = cnt > 0u ? cnt : 1u;
}

__device__ __forceinline__ void xcd_barrier(const XcdBarrier& b) {
    asm volatile("s_waitcnt vmcnt(0)" ::: "memory");
    __syncthreads();
    if (threadIdx.x == 0) {
        unsigned* bar = b.bar;
        __builtin_amdgcn_s_waitcnt(0);
        unsigned nloc = b.st[0], nx = b.st[1];
        if (nloc == 0u) { xcd_barrier_complete(bar, b.x, nloc, nx); b.st[0] = nloc; b.st[1] = nx; }
        const unsigned old = xb_add(&bar[XB_XSUB(b.x)], 1u);
        const unsigned gen = old / nloc;
        if (old + 1u == (gen + 1u) * nloc) {
            __builtin_amdgcn_fence(__ATOMIC_RELEASE, "agent");
            asm volatile("s_waitcnt vmcnt(0)" ::: "memory");
            const unsigned og = xb_add(&bar[XB_TOP], 1u);
            const unsigned tg = og / nx;
            if (og + 1u == (tg + 1u) * nx) xb_add(&bar[XB_TOPGEN], 1u);
            else XB_SPIN(xb_ld(&bar[XB_TOPGEN]) == tg, bar);
            __builtin_amdgcn_fence(__ATOMIC_ACQUIRE, "agent");
            xb_add(&bar[XB_XGEN(b.x)], 1u);
            asm volatile("s_waitcnt vmcnt(0)" ::: "memory");
        } else {
            XB_SPIN(xb_ld(&bar[XB_XGEN(b.x)]) == gen, bar);
            __builtin_amdgcn_fence(__ATOMIC_ACQUIRE, "agent");
            asm volatile("s_waitcnt vmcnt(0)" ::: "memory");
        }
    }
    __syncthreads();
}

constexpr int N_STEPS = 20;
__device__ __forceinline__ bool step_seam(int st) { return st < 19; }
__global__ void __launch_bounds__(NTHR, 2) mega_fwd(KP p_unused) {
    extern __shared__ __attribute__((aligned(16))) unsigned char lds_raw[];
    CKP* kp0 = (CKP*)__builtin_amdgcn_kernarg_segment_ptr();
    { LAS unsigned* ctlw = (LAS unsigned*)((LAS unsigned char*)lds_raw + RING_BYTES);
      for (int u = threadIdx.x; u < (LDS_BYTES - RING_BYTES) / 4; u += NTHR) ctlw[u] = 0u; }
    __syncthreads();
    const XcdBarrier bar = xcd_barrier_post((unsigned*)(kp0->ws + WS_CTL) + 4096, (volatile LAS unsigned*)((LAS unsigned char*)lds_raw + MISC_OFF + 32));
    const int ph_lo = kp0->ph_lo, ph_hi = kp0->ph_hi;
#pragma unroll 1
    for (int st = ph_lo; st < ph_hi; ++st) {
        CKP* kp = kp0; asm volatile("" : "+s"(kp));
        CKP& p = *kp; unsigned char* ws = p.ws;
        int bid = blockIdx.x, nb = gridDim.x; unsigned ldsb = (unsigned)(size_t)(LAS unsigned char*)lds_raw;
        asm volatile("" : "+s"(bid), "+s"(nb), "+s"(ldsb));
        LAS unsigned char* lds = (LAS unsigned char*)(size_t)ldsb;
        const int l = st == 0 ? 0 : (st - 1) / 9, s = st == 0 ? -1 : (st == 19 ? 9 : (st - 1) % 9);
        const float* mod = (const float*)(ws + WS_MOD) + (size_t)l * 5 * 6144;
        if (s == 3) {
            if (nb >= 256) { if (bid < 64) rwkv_item3(p, l, lds, bid); else for (int it = 64 + (bid - 64); it < 576; it += nb - 64) rwkv_item3(p, l, lds, it); }
            else for (int it = bid; it < 576; it += nb) rwkv_item3(p, l, lds, it);
        }
#pragma unroll 1
        for (int job = 0; job < 2; ++job) {
            pg8::Gemm g{nullptr, nullptr, 0, 0, 0, 0, 0}; pg8::EpiAny E{-1, true, nullptr, nullptr, 0, 0}; int corder = bid;
            if (job == 0) {
                if (s == 1) { g = pg8::Gemm{(const bf16*)(ws + WS_H), (const bf16*)(ws + WS_WIN) + (size_t)l * DINP * DM, MTOK, DINP, DM, DM, DM}; E = pg8::EpiAny{0, true, ws + WS_PROJ, nullptr, DINP, 0}; }
                else if (s == 3) { g = pg8::Gemm{(const bf16*)(ws + WS_CS256), (const bf16*)(ws + WS_YCS), 256, 8192, 512, 512, 512}; E = pg8::EpiAny{3, true, ws + WS_MIXED, nullptr, 0, 256}; corder = (bid + nb - (nb >= 256 ? 192 : 0)) % nb; }
                else if (s == 5) { g = pg8::Gemm{(const bf16*)(ws + WS_MIXED), (const bf16*)(ws + WS_WOUT) + (size_t)l * DM * DM, MTOK, DM, DM, DM, DM}; E = pg8::EpiAny{2, false, p.out, mod + 2 * 1024, 0, 0}; }
                else if (s == 7) { g = pg8::Gemm{(const bf16*)(ws + WS_H), (const bf16*)(ws + WS_W1) + (size_t)l * DFF * DM, MTOK, DFF, DM, DM, DM}; E = pg8::EpiAny{1, true, ws + WS_FF, nullptr, DFF, 0}; }
                else if (s == 8) { g = pg8::Gemm{(const bf16*)(ws + WS_FF), (const bf16*)(ws + WS_W2) + (size_t)l * DM * DFF, MTOK, DM, DFF, DFF, DFF}; E = pg8::EpiAny{2, false, p.out, mod + 5 * 1024, 0, 0}; }
            } else if (s == 3) { g = pg8::Gemm{(const bf16*)(ws + WS_CS1024), (const bf16*)(ws + WS_YCS) + (size_t)8192 * 512, 1024, 1024, 2048, 2048, 2048}; E = pg8::EpiAny{3, true, ws + WS_MIXED, nullptr, NCTX, 1024}; corder = (bid + nb - (nb >= 256 ? 224 : 32)) % nb; }
            if (E.mode >= 0) {
                pg8::StaticOrder S; S.init(g.M, g.N, nb, corder);
                pg8::gemm_phase<pg8::EpiAny, pg8::StaticOrder, true, true>(lds, g, S, E);
                __syncthreads();
            }
        }
        if (s == -1) stage_prologue(p, lds, bid, nb);
        else if (s == 0) stage_norm(p, l, 0, bid, nb);
        else if (s == 2) {
            stage_upass(p, l, bid, nb);
#pragma unroll 1
            for (int it = bid; it < 768; it += nb) fnet1_item(p, l, lds, it);
#pragma unroll 1
            for (int it = bid; it < 768; it += nb) pool_item(p, l, lds, it);
        }
        else if (s == 4) stage_post(p, l, bid, nb);
        else if (s == 6) stage_norm(p, l, 1, bid, nb);
        else if (s == 9) stage_final(p, bid, nb);
        if (st + 1 < ph_hi && step_seam(st)) xcd_barrier(bar);
    }
}

extern "C" void kernel_launch(void* const* d_in, const int* in_sizes, int n_in, void* d_out, int out_size, void* d_ws, size_t ws_size, hipStream_t stream) {
    static int grid = 0;
    if (grid == 0) {
        if (n_in != N_IN || ws_size < WS_END) { fprintf(stderr, "kernel_launch: unexpected inputs (n_in %d, ws %zu)\n", n_in, ws_size); grid = -1; return; }
        int dev = 0, cus = 0, per_cu = 0;
        (void)hipGetDevice(&dev); (void)hipDeviceGetAttribute(&cus, hipDeviceAttributeMultiprocessorCount, dev);
        (void)hipFuncSetAttribute((const void*)mega_fwd, hipFuncAttributeMaxDynamicSharedMemorySize, LDS_BYTES);
        if (hipOccupancyMaxActiveBlocksPerMultiprocessor(&per_cu, (const void*)mega_fwd, NTHR, LDS_BYTES) != hipSuccess || per_cu < 1) {
            fprintf(stderr, "kernel_launch: occupancy query reports %d blocks/CU\n", per_cu); (void)hipGetLastError(); grid = -1; return; }
        grid = cus * 1;
    }
    if (grid < 0) return;
    KP a{};
    for (int i = 0; i < N_IN; ++i) a.in[i] = (const float*)d_in[i];
    a.out = (float*)d_out; a.ws = (unsigned char*)d_ws; a.ph_lo = 0; a.ph_hi = N_STEPS;
    if (hipMemsetAsync((char*)d_ws + WS_CTL, 0, 1 * MiB, stream) != hipSuccess) { fprintf(stderr, "kernel_launch: memset failed\n"); return; }
    void* args[] = {&a};
    hipError_t e = hipLaunchCooperativeKernel((const void*)mega_fwd, dim3(grid), dim3(NTHR), args, LDS_BYTES, stream);
    if (e != hipSuccess) fprintf(stderr, "cooperative launch failed: %s (grid %d)\n", hipGetErrorString(e), grid);
}
```

```cpp
#include <hip/hip_runtime.h>
#include <hip/hip_cooperative_groups.h>
#include <cstdio>
#include <cstdint>
namespace cg = cooperative_groups;
__device__ __forceinline__ int opaque_tid() { int t = threadIdx.x; asm volatile("" : "+v"(t)); return t; }
namespace pg8 {
#define PG8_LAS __attribute__((address_space(3)))
typedef unsigned short bf16_t;
typedef short bf16x8 __attribute__((ext_vector_type(8)));
typedef float f32x4 __attribute__((ext_vector_type(4)));
typedef unsigned u32x4 __attribute__((ext_vector_type(4)));
constexpr int BM = 256, BK = 64, HALF = 128, HTB = HALF * BK * 2  , STAGE_BYTES = 8 * HTB, NXCD = 8, WGM = 8;

__host__ __device__ __forceinline__ int lds_byte(int r, int c) { const int st = (r >> 4) * 2 + (c >> 5), rr = r & 15, cc = c & 31, ob = rr * 64 + cc * 2; return st * 1024 + (ob ^ (((ob >> 9) & 1) << 5)); }
__host__ __device__ __forceinline__ void stage_rc(int b, int& R, int& C) { const int st = b / 1024, sb = b % 1024, swz = sb ^ (((sb >> 9) & 1) << 5); R = (st >> 1) * 16 + swz / 64; C = (st & 1) * 32 + (swz % 64) / 2; }
__host__ __device__ __forceinline__ int perm32(int rho) { const int n = rho >> 4, i = rho & 15; return 8 * (i >> 2) + 4 * n + (i & 3); }

struct Unit { int pm, pn; };
struct Gemm { const bf16_t* A; const bf16_t* Bt; int M, N, K, lda, ldb; };

struct StaticOrder {
    int nM, nN, nwg, G, c;
    __host__ __device__ void init(int M, int N, int G_, int c_) { nM = M / BM; nN = N / BM; nwg = nM * nN; G = G_; c = c_; }
    __host__ __device__ bool next(int i, Unit& u) const {
        const long L = (long)i * G + c; if (L >= nwg) return false;
        int wgid = (int)L; { const int q = nwg / NXCD, r = nwg % NXCD, xcd = wgid % NXCD, off = wgid / NXCD; wgid = (xcd < r ? xcd * (q + 1) : r * (q + 1) + (xcd - r) * q) + off; }
        const int nig = WGM * nN, gid = wgid / nig, fm = gid * WGM, gsz = (nM - fm) < WGM ? (nM - fm) : WGM;
        u.pm = fm + ((wgid % nig) % gsz); u.pn = (wgid % nig) / gsz; return true;
    }
    __device__ __forceinline__ void a_ready(const Unit&) const {}
    __device__ __forceinline__ void done(const Unit&) const {}
};

__device__ __forceinline__ unsigned cvt_pk_bf16(float lo, float hi) { unsigned r; asm volatile("v_cvt_pk_bf16_f32 %0, %1, %2" : "=v"(r) : "v"(lo), "v"(hi)); return r; }
template <int ACT  > struct EpiBf {
    static constexpr bool PERM = true, AFTER_DRAIN = false;
    bf16_t* O; int ldc;
    __device__ __forceinline__ void operator()(const f32x4 (&acc)[2][2][4][2], const Unit& u, int wr, int wc, int fr, int fq) const {
        const int row0 = u.pm * BM + wr * 64 + fr, col0 = u.pn * BM + wc * 32 + 8 * fq;
#pragma unroll
        for (int ai = 0; ai < 2; ++ai)
#pragma unroll
            for (int m = 0; m < 4; ++m) { bf16_t* rowp = O + (size_t)(row0 + ai * HALF + m * 16) * ldc + col0;
#pragma unroll
                for (int bj = 0; bj < 2; ++bj) { f32x4 v0 = acc[ai][bj][m][0], v1 = acc[ai][bj][m][1];
                    if (ACT == 1) {
#pragma unroll
                        for (int e = 0; e < 4; ++e) { float a = v0[e] > 0.f ? v0[e] : 0.f; v0[e] = a * a; float b = v1[e] > 0.f ? v1[e] : 0.f; v1[e] = b * b; } }
                    u32x4 w; w.x = cvt_pk_bf16(v0[0], v0[1]); w.y = cvt_pk_bf16(v0[2], v0[3]); w.z = cvt_pk_bf16(v1[0], v1[1]); w.w = cvt_pk_bf16(v1[2], v1[3]);
                    *(u32x4*)(rowp + bj * HALF) = w; } }
    }
};
struct EpiRes {
    static constexpr bool PERM = false, AFTER_DRAIN = false;
    float* X; const float* gate; const float* Xc; const float* Xl;
    __device__ __forceinline__ void operator()(const f32x4 (&acc)[2][2][4][2], const Unit& u, int wr, int wc, int fr, int fq) const {
        const int row0 = u.pm * BM + wr * 64 + fr, col0 = u.pn * BM + wc * 32 + 4 * fq;
        const int cond = u.pm < 32 ? 0 : 1 + ((u.pm - 32) >> 2);
        const float* gp = gate + cond * 6144 + col0;
        f32x4 gv[2][2];
#pragma unroll
        for (int bj = 0; bj < 2; ++bj)
#pragma unroll
            for (int n = 0; n < 2; ++n) gv[bj][n] = *(const f32x4*)(gp + bj * HALF + n * 16);
#pragma unroll
        for (int ai = 0; ai < 2; ++ai)
#pragma unroll
            for (int m = 0; m < 4; ++m) { const size_t ro = (size_t)(row0 + ai * HALF + m * 16) * 1024 + col0; float* rowp = X + ro; const float* srcp = u.pm < 32 ? Xc + ro : Xl + (ro - (size_t)8192 * 1024);
#pragma unroll
                for (int bj = 0; bj < 2; ++bj)
#pragma unroll
                    for (int n = 0; n < 2; ++n) { *(f32x4*)(rowp + bj * HALF + n * 16) = *(const f32x4*)(srcp + bj * HALF + n * 16) + gv[bj][n] * acc[ai][bj][m][n]; }
                if (m & 1) asm volatile("" ::: "memory"); }
    }
};
struct EpiFnet {
    static constexpr bool PERM = true, AFTER_DRAIN = false;
    bf16_t* MIX; int rowbase, L;
    __device__ __forceinline__ void operator()(const f32x4 (&acc)[2][2][4][2], const Unit& u, int wr, int wc, int fr, int fq) const {
        const int row0 = u.pm * BM + wr * 64 + fr, colw = wc * 32 + 8 * fq;
        bf16_t* base = MIX + (size_t)(rowbase + u.pn * L) * 1024 + 512 + colw;
#pragma unroll
        for (int ai = 0; ai < 2; ++ai)
#pragma unroll
            for (int m = 0; m < 4; ++m) { bf16_t* rowp = base + (size_t)(row0 + ai * HALF + m * 16) * 1024;
#pragma unroll
                for (int bj = 0; bj < 2; ++bj) { const f32x4 v0 = acc[ai][bj][m][0], v1 = acc[ai][bj][m][1];
                    u32x4 w; w.x = cvt_pk_bf16(v0[0], v0[1]); w.y = cvt_pk_bf16(v0[2], v0[3]); w.z = cvt_pk_bf16(v1[0], v1[1]); w.w = cvt_pk_bf16(v1[2], v1[3]);
                    *(u32x4*)(rowp + bj * HALF) = w; } }
    }
};

struct EpiAny {
    static constexpr bool AFTER_DRAIN = false;
    int mode; bool PERM; void* out; const float* aux; int i0, i1; const float* xc; const float* xl;
    __device__ __forceinline__ void operator()(const f32x4 (&acc)[2][2][4][2], const Unit& u, int wr, int wc, int fr, int fq) const {
        if (mode == 0) { const EpiBf<0> e{(bf16_t*)out, i0}; e(acc, u, wr, wc, fr, fq); }
        else if (mode == 1) { const EpiBf<1> e{(bf16_t*)out, i0}; e(acc, u, wr, wc, fr, fq); }
        else if (mode == 2) { const EpiRes e{(float*)out, aux, xc, xl}; e(acc, u, wr, wc, fr, fq); }
        else { const EpiFnet e{(bf16_t*)out, i0, i1}; e(acc, u, wr, wc, fr, fq); }
    }
};
template <class Epi, class Sched, bool ALIGN_EPI = false, bool SP2 = false>
__device__ __forceinline__ void gemm_phase(PG8_LAS unsigned char* lds, const Gemm g, const Sched& S, const Epi& E) {
    const int tid = opaque_tid(), wid = __builtin_amdgcn_readfirstlane(tid >> 6), lane = tid & 63, wr = wid >> 2, wc = wid & 3, fr = lane & 15, fq = lane >> 4;
    const int K = g.K, nt = K / BK;
    unsigned voffA[2], voffB[2];
#pragma unroll
    for (int i = 0; i < 2; ++i) { int R, C; stage_rc(tid * 16 + i * 8192, R, C); const int Rb = E.PERM ? ((R & ~31) + perm32(R & 31)) : R;
        voffA[i] = (unsigned)(R * g.lda + C) * 2u; voffB[i] = (unsigned)(Rb * g.ldb + C) * 2u; }
    const size_t kstep = (size_t)(BK * 2);
    const size_t hstepA = (size_t)HALF * g.lda * 2, hstepB = (size_t)HALF * g.ldb * 2;
    const size_t tstepA = 2 * hstepA, tstepB = 2 * hstepB;
    const unsigned ldsw = (unsigned)wid * 1024u;
    const int aoff = lds_byte(wr * 64 + fr, fq * 8), boff = lds_byte(wc * 32 + fr, fq * 8);
#define PG8_SA(b, h) (((b) * 2 + (h)) * HTB)
#define PG8_SB(b, h) ((4 + (b) * 2 + (h)) * HTB)
#define PG8_STAGE(bufoff, gbase, voff) do { _Pragma("unroll") for (int _i = 0; _i < 2; ++_i) \
        __builtin_amdgcn_global_load_lds((const unsigned*)((const char*)(gbase) + (voff)[_i]), (PG8_LAS unsigned*)(lds + (bufoff) + ldsw + _i * 8192), 16, 0, 0); } while (0)
#define PG8_LDA(dst, b, h) do { _Pragma("unroll") for (int m = 0; m < 4; ++m) _Pragma("unroll") for (int k = 0; k < 2; ++k) dst[m][k] = *(const PG8_LAS bf16x8*)(lds + PG8_SA(b, h) + aoff + m * 2048 + k * 1024); } while (0)
#define PG8_LDB(dst, b, h) do { _Pragma("unroll") for (int n = 0; n < 2; ++n) _Pragma("unroll") for (int k = 0; k < 2; ++k) dst[n][k] = *(const PG8_LAS bf16x8*)(lds + PG8_SB(b, h) + boff + n * 2048 + k * 1024); } while (0)
#define PG8_MMA(ai, bj, At, Bt) do { __builtin_amdgcn_s_setprio(1); _Pragma("unroll") for (int m = 0; m < 4; ++m) _Pragma("unroll") for (int n = 0; n < 2; ++n) _Pragma("unroll") for (int k = 0; k < 2; ++k) \
        acc[ai][bj][m][n] = __builtin_amdgcn_mfma_f32_16x16x32_bf16(Bt[n][k], At[m][k], acc[ai][bj][m][n], 0, 0, 0); __builtin_amdgcn_s_setprio(0); } while (0)
#define PG8_WAIT_V(n) asm volatile("s_waitcnt vmcnt(" #n ")" ::: "memory")
#define PG8_WAIT_L(n) asm volatile("s_waitcnt lgkmcnt(" #n ")" ::: "memory")
#define PG8_BAR __builtin_amdgcn_s_barrier()
#define PG8_SCHED __builtin_amdgcn_sched_barrier(0)
    Unit cur, nxt; int ui = 0;
    if (!S.next(0, cur)) return;
    f32x4 acc[2][2][4][2];
#pragma unroll
    for (int a = 0; a < 2; ++a)
#pragma unroll
        for (int b = 0; b < 2; ++b)
#pragma unroll
            for (int m = 0; m < 4; ++m)
#pragma unroll
                for (int n = 0; n < 2; ++n) acc[a][b][m][n] = (f32x4){0.f, 0.f, 0.f, 0.f};
    bf16x8 At[4][2], B0[2][2], B1[2][2];
    const char* cA = (const char*)g.A + (size_t)cur.pm * tstepA; const char* cB = (const char*)g.Bt + (size_t)cur.pn * tstepB;
    S.a_ready(cur);
    if constexpr (SP2) {
        PG8_STAGE(PG8_SB(0, 0), cB, voffB); PG8_STAGE(PG8_SB(0, 1), cB + hstepB, voffB); PG8_STAGE(PG8_SA(0, 0), cA, voffA); PG8_STAGE(PG8_SA(0, 1), cA + hstepA, voffA);
        if (wr == 1) PG8_BAR;
        PG8_WAIT_V(2); PG8_BAR;
        PG8_STAGE(PG8_SB(1, 0), cB + kstep, voffB); PG8_STAGE(PG8_SA(1, 0), cA + kstep, voffA); PG8_STAGE(PG8_SB(1, 1), cB + hstepB + kstep, voffB);
        PG8_WAIT_V(6); PG8_BAR;
    } else {
        PG8_STAGE(PG8_SB(0, 0), cB, voffB); PG8_STAGE(PG8_SA(0, 0), cA, voffA); PG8_STAGE(PG8_SB(0, 1), cB + hstepB, voffB); PG8_STAGE(PG8_SA(0, 1), cA + hstepA, voffA);
        if (wr == 1) PG8_BAR;
        PG8_WAIT_V(4); PG8_BAR;
        PG8_STAGE(PG8_SB(1, 0), cB + kstep, voffB); PG8_STAGE(PG8_SA(1, 0), cA + kstep, voffA); PG8_STAGE(PG8_SB(1, 1), cB + hstepB + kstep, voffB);
        PG8_WAIT_V(6); PG8_BAR;
    }
    for (;;) {
        const bool has_next = S.next(ui + 1, nxt);
        const char* nA = has_next ? (const char*)g.A + (size_t)nxt.pm * tstepA : cA; const char* nB = has_next ? (const char*)g.Bt + (size_t)nxt.pn * tstepB : cB;
        for (int t = 0; t < nt; t += 2) {
            const bool last = (t == nt - 2);
            const char* a1 = cA + (size_t)(t + 1) * kstep;
            const char* a2 = last ? nA : cA + (size_t)(t + 2) * kstep; const char* b2 = last ? nB : cB + (size_t)(t + 2) * kstep;
            const char* a3 = a2 + kstep; const char* b3 = b2 + kstep;
            if (last && has_next) S.a_ready(nxt);
            if constexpr (SP2) {
            PG8_LDB(B0, 0, 0); PG8_LDB(B1, 0, 1); PG8_SCHED; PG8_LDA(At, 0, 0); PG8_STAGE(PG8_SA(1, 1), a1 + hstepA, voffA);
            PG8_WAIT_V(8); PG8_WAIT_L(0); PG8_BAR; PG8_MMA(0, 0, At, B0); PG8_MMA(0, 1, At, B1); PG8_BAR; PG8_SCHED;
            PG8_LDA(At, 0, 1); PG8_STAGE(PG8_SB(0, 0), b2, voffB); PG8_STAGE(PG8_SB(0, 1), b2 + hstepB, voffB); PG8_STAGE(PG8_SA(0, 0), a2, voffA);
            PG8_WAIT_V(8); PG8_WAIT_L(0); PG8_BAR; PG8_MMA(1, 0, At, B0); PG8_MMA(1, 1, At, B1); PG8_BAR; PG8_SCHED;
            PG8_LDB(B0, 1, 0); PG8_LDB(B1, 1, 1); PG8_SCHED; PG8_LDA(At, 1, 0); PG8_STAGE(PG8_SA(0, 1), a2 + hstepA, voffA);
            PG8_WAIT_V(8); PG8_WAIT_L(0); PG8_BAR; PG8_MMA(0, 0, At, B0); PG8_MMA(0, 1, At, B1); PG8_BAR; PG8_SCHED;
            PG8_LDA(At, 1, 1); PG8_STAGE(PG8_SB(1, 0), b3, voffB); PG8_STAGE(PG8_SB(1, 1), b3 + hstepB, voffB); PG8_STAGE(PG8_SA(1, 0), a3, voffA);
            PG8_WAIT_V(8); PG8_WAIT_L(0); PG8_BAR; PG8_MMA(1, 0, At, B0); PG8_MMA(1, 1, At, B1); PG8_BAR; PG8_SCHED;
            } else {
            PG8_LDB(B0, 0, 0); PG8_SCHED; PG8_LDA(At, 0, 0); PG8_STAGE(PG8_SA(1, 1), a1 + hstepA, voffA);
            PG8_WAIT_L(8); PG8_BAR; PG8_WAIT_L(0); PG8_MMA(0, 0, At, B0); PG8_BAR; PG8_SCHED;
            PG8_LDB(B1, 0, 1); PG8_STAGE(PG8_SB(0, 0), b2, voffB);
            PG8_BAR; PG8_WAIT_L(0); PG8_MMA(0, 1, At, B1); PG8_BAR;
            PG8_LDA(At, 0, 1); PG8_STAGE(PG8_SA(0, 0), a2, voffA);
            PG8_BAR; PG8_WAIT_L(0); PG8_MMA(1, 0, At, B0); PG8_BAR; PG8_SCHED;
            PG8_STAGE(PG8_SB(0, 1), b2 + hstepB, voffB);
            PG8_WAIT_V(6); PG8_BAR; PG8_MMA(1, 1, At, B1); PG8_BAR;
            PG8_LDB(B0, 1, 0); PG8_SCHED; PG8_LDA(At, 1, 0); PG8_STAGE(PG8_SA(0, 1), a2 + hstepA, voffA);
            PG8_WAIT_L(8); PG8_BAR; PG8_WAIT_L(0); PG8_MMA(0, 0, At, B0); PG8_BAR; PG8_SCHED;
            PG8_LDB(B1, 1, 1); PG8_STAGE(PG8_SB(1, 0), b3, voffB);
            PG8_BAR; PG8_WAIT_L(0); PG8_MMA(0, 1, At, B1); PG8_BAR;
            PG8_LDA(At, 1, 1); PG8_STAGE(PG8_SA(1, 0), a3, voffA);
            PG8_BAR; PG8_WAIT_L(0); PG8_MMA(1, 0, At, B0); PG8_BAR; PG8_SCHED;
            PG8_STAGE(PG8_SB(1, 1), b3 + hstepB, voffB);
            PG8_WAIT_V(6); PG8_BAR; PG8_MMA(1, 1, At, B1); PG8_BAR;
            }
        }
        if constexpr (ALIGN_EPI) { if (wr == 0) PG8_BAR; }
        if constexpr (!Epi::AFTER_DRAIN) { int fr2 = fr, fq2 = fq; asm volatile("" : "+v"(fr2), "+v"(fq2)); E(acc, cur, wr, wc, fr2, fq2); S.done(cur); }
        if (!has_next) break;
#pragma unroll
        for (int a = 0; a < 2; ++a)
#pragma unroll
            for (int b = 0; b < 2; ++b)
#pragma unroll
                for (int m = 0; m < 4; ++m)
#pragma unroll
                    for (int n = 0; n < 2; ++n) acc[a][b][m][n] = (f32x4){0.f, 0.f, 0.f, 0.f};
        cur = nxt; cA = nA; cB = nB; ++ui;
        if constexpr (ALIGN_EPI) { if (wr == 1) PG8_BAR; }
    }
    PG8_WAIT_V(0);
    if constexpr (!ALIGN_EPI) { if (wr == 0) PG8_BAR; }
    PG8_BAR;
    if constexpr (Epi::AFTER_DRAIN) { E.fused(acc, cur, wr, wc, fr, fq, lds, wid, lane); S.done(cur); }
#undef PG8_SA
#undef PG8_SB
#undef PG8_STAGE
#undef PG8_LDA
#undef PG8_LDB
#undef PG8_MMA
#undef PG8_WAIT_V
#undef PG8_WAIT_L
#undef PG8_BAR
#undef PG8_SCHED
}
}

#define LAS __attribute__((address_space(3)))
typedef unsigned short bf16;
typedef float f32x4 __attribute__((ext_vector_type(4)));
typedef unsigned u32x4 __attribute__((ext_vector_type(4)));
typedef unsigned u32x2 __attribute__((ext_vector_type(2)));
constexpr int DM = 1024, NCTX = 8192, MTOK = 12288, DINP = 2560, DFF = 4096;
constexpr int R_OFF = 0, K_OFF = 512, V_OFF = 1024, WD_OFF = 1536, AD_OFF = 1664, GD_OFF = 1792, F_OFF = 1920, P_OFF = 2176, DIN = 2432;
constexpr size_t MiB = 1u << 20;
constexpr size_t WS_CTL = 0, WS_MOD = 1 * MiB, WS_FW = 1 * MiB + 512 * 1024, WS_BC = 2 * MiB, WS_CS256 = 3 * MiB, WS_CS1024 = 4 * MiB, WS_WIN = 8 * MiB, WS_WOUT = 18 * MiB,
                 WS_W1 = 22 * MiB, WS_W2 = 38 * MiB, WS_H = 54 * MiB, WS_MIXED = 78 * MiB, WS_PROJ = 102 * MiB, WS_YCS = 162 * MiB, WS_YF = 102 * MiB, WS_YB = 126 * MiB  , WS_U = 174 * MiB, WS_KINV = 220 * MiB, WS_GUPT = 221 * MiB,
                 WS_FF = 102 * MiB, WS_WUPT = 222 * MiB, WS_AUPT = 222 * MiB + 256 * 1024, WS_END = 223 * MiB;
constexpr int LDS_BYTES = 147456, RING_BYTES = 131072, MISC_OFF = RING_BYTES + 320;
constexpr int NTHR = 512;
enum { I_XP = 0, I_XS, I_STATE, I_C, I_CCTX, I_WADA, I_BADA, I_N1G, I_WIN, I_MU, I_W0, I_WUP, I_A0, I_AUP, I_GUP, I_KK, I_KA, I_RK, I_LNW, I_LNB, I_WFNET, I_WPOOL, I_PSCALE, I_WOUT, I_N2G, I_WFF1, I_WFF2, I_FNG, N_IN };
struct KP { const float* in[N_IN]; float* out; unsigned char* ws; int ph_lo, ph_hi; };
typedef const __attribute__((address_space(4))) KP CKP;

__device__ __forceinline__ unsigned f2bf(float f) { unsigned u = __builtin_bit_cast(unsigned, f); return (u + 0x7fffu + ((u >> 16) & 1u)) >> 16; }
__device__ __forceinline__ unsigned pk2(float lo, float hi) { return f2bf(lo) | (f2bf(hi) << 16); }
__device__ __forceinline__ float bflo(unsigned w) { return __builtin_bit_cast(float, w << 16); }
__device__ __forceinline__ float bfhi(unsigned w) { return __builtin_bit_cast(float, w & 0xffff0000u); }
__device__ __forceinline__ float bf1(bf16 h) { return __builtin_bit_cast(float, (unsigned)h << 16); }
__device__ __forceinline__ float fexp(float x) { return __builtin_amdgcn_exp2f(x * 1.4426950408889634f); }
__device__ __forceinline__ float flog(float x) { return __builtin_amdgcn_logf(x) * 0.6931471805599453f; }
__device__ __forceinline__ float frcp(float x) { return __builtin_amdgcn_rcpf(x); }
__device__ __forceinline__ float frsq(float x) { return __builtin_amdgcn_rsqf(x); }
__device__ __forceinline__ float fsigmoid(float x) { return frcp(1.0f + fexp(-x)); }
template <int CTRL> __device__ __forceinline__ float dppf(float x) { return __builtin_bit_cast(float, __builtin_amdgcn_update_dpp(0, __builtin_bit_cast(int, x), CTRL, 0xF, 0xF, true)); }
__device__ __forceinline__ float red8(float x)  { x += dppf<0xB1>(x); x += dppf<0x4E>(x); x += dppf<0x141>(x); return x; }
__device__ __forceinline__ float red16(float x) { x += dppf<0xB1>(x); x += dppf<0x4E>(x); x += dppf<0x141>(x); x += dppf<0x140>(x); return x; }
__device__ __forceinline__ float wave_sum(float v) {
    v = red16(v);
    const float s0 = __builtin_bit_cast(float, __builtin_amdgcn_readlane(__builtin_bit_cast(int, v), 0)), s1 = __builtin_bit_cast(float, __builtin_amdgcn_readlane(__builtin_bit_cast(int, v), 16));
    const float s2 = __builtin_bit_cast(float, __builtin_amdgcn_readlane(__builtin_bit_cast(int, v), 32)), s3 = __builtin_bit_cast(float, __builtin_amdgcn_readlane(__builtin_bit_cast(int, v), 48));
    return (s0 + s1) + (s2 + s3);
}
__device__ __forceinline__ void load4bf(const bf16* p, float (&o)[4]) { const u32x2 w = *(const u32x2*)p; o[0] = bflo(w.x); o[1] = bfhi(w.x); o[2] = bflo(w.y); o[3] = bfhi(w.y); }
__device__ __forceinline__ void load8bf(const bf16* p, float (&o)[8]) { const u32x4 w = *(const u32x4*)p; o[0] = bflo(w.x); o[1] = bfhi(w.x); o[2] = bflo(w.y); o[3] = bfhi(w.y); o[4] = bflo(w.z); o[5] = bfhi(w.z); o[6] = bflo(w.w); o[7] = bfhi(w.w); }
__device__ __forceinline__ void shift4(const bf16* proj, int row, bool hasp, bool hasn, int col, const float* mu, float (&u)[4]) {
    float p[4], a[4] = {0.f, 0.f, 0.f, 0.f}, b[4] = {0.f, 0.f, 0.f, 0.f};
    load4bf(proj + (size_t)row * DINP + col, p);
    if (hasp) load4bf(proj + (size_t)(row - 1) * DINP + col, a);
    if (hasn) load4bf(proj + (size_t)(row + 1) * DINP + col, b);
    const f32x4 m = *(const f32x4*)(mu + col);
#pragma unroll
    for (int j = 0; j < 4; ++j) u[j] = p[j] + m[j] * (0.5f * (a[j] + b[j]) - p[j]);
}

__device__ __forceinline__ void transpose_item(const float* W, int K, int N, bf16* WT, LAS float* scr, int item, int lane) {
    const int nblk = N / 32, kb = item / nblk, nb = item % nblk, k0 = 64 * kb, n0 = 32 * nb;
#pragma unroll 8
    for (int i = 0; i < 32; ++i) { const int kk = 2 * i + (lane >> 5); scr[kk * 33 + (lane & 31)] = W[(size_t)(k0 + kk) * N + n0 + (lane & 31)]; }
    asm volatile("s_waitcnt lgkmcnt(0)" ::: "memory");
    const int c = lane & 7;
#pragma unroll
    for (int j = 0; j < 4; ++j) { const int n = (lane >> 3) + 8 * j; const LAS float* s = scr + (8 * c) * 33 + n;
        u32x4 o; o.x = pk2(s[0 * 33], s[1 * 33]); o.y = pk2(s[2 * 33], s[3 * 33]); o.z = pk2(s[4 * 33], s[5 * 33]); o.w = pk2(s[6 * 33], s[7 * 33]);
        *(u32x4*)(WT + (size_t)(n0 + n) * K + k0 + 8 * c) = o; }
    asm volatile("s_waitcnt lgkmcnt(0)" ::: "memory");
}
constexpr int TI_IN = 16 * 76, TI_OUT = 16 * 32, TI_1 = 16 * 128, TI_2 = 64 * 32, TI_L = TI_IN + TI_OUT + TI_1 + TI_2;
__device__ __forceinline__ void transpose_range(CKP& p, LAS unsigned char* lds, int first, int last, int bid, int nb) {
    const int tid = opaque_tid(), lane = tid & 63, wave = tid >> 6;
    unsigned char* ws = p.ws;
    LAS float* scr = (LAS float*)(lds + wave * 16384);
#pragma unroll 1
    for (int it = first + bid * 8 + wave; it < last; it += nb * 8) {
        const int l = it / TI_L; int r = it % TI_L;
        if (r < TI_IN) { transpose_item(p.in[I_WIN] + (size_t)l * DM * DIN, DM, DIN, (bf16*)(ws + WS_WIN) + (size_t)l * DINP * DM, scr, r, lane); continue; } r -= TI_IN;
        if (r < TI_OUT) { transpose_item(p.in[I_WOUT] + (size_t)l * DM * DM, DM, DM, (bf16*)(ws + WS_WOUT) + (size_t)l * DM * DM, scr, r, lane); continue; } r -= TI_OUT;
        if (r < TI_1) { transpose_item(p.in[I_WFF1] + (size_t)l * DM * DFF, DM, DFF, (bf16*)(ws + WS_W1) + (size_t)l * DFF * DM, scr, r, lane); continue; } r -= TI_1;
        transpose_item(p.in[I_WFF2] + (size_t)l * DFF * DM, DFF, DM, (bf16*)(ws + WS_W2) + (size_t)l * DM * DFF, scr, r, lane);
    }
}
__device__ __forceinline__ void stage_prologue(CKP& p, LAS unsigned char* lds, int bid, int nb) {
    const int tid = opaque_tid();
    unsigned char* ws = p.ws;
    transpose_range(p, lds, 0, TI_IN, bid, nb);
    const int gt = bid * NTHR + tid, NGT = nb * NTHR;
#pragma unroll 1
    for (int i = gt; i < 2 * 128 * DM / 8; i += NGT) { const int l = i / (128 * DM / 8), r = i % (128 * DM / 8);
        *(u32x4*)((bf16*)(ws + WS_WIN) + (size_t)l * DINP * DM + (size_t)DIN * DM + (size_t)r * 8) = (u32x4){0u, 0u, 0u, 0u}; }
#pragma unroll 1
    for (int i = gt; i < 256 * 512 + 1024 * 2048; i += NGT) {
        int L, k, j; bf16* dst;
        if (i < 256 * 512) { L = 256; k = i / 512; j = i % 512; dst = (bf16*)(ws + WS_CS256) + i; }
        else { const int i2 = i - 256 * 512; L = 1024; k = i2 / 2048; j = i2 % 2048; dst = (bf16*)(ws + WS_CS1024) + i2; }
        const int jj = j >= L ? j - L : j; const int idx = (k * jj) & (L - 1);
        const float rev = (float)idx / (float)L; const float s = __builtin_amdgcn_sinf(rev), c = __builtin_amdgcn_cosf(rev);
        *dst = (bf16)f2bf(j >= L ? -s : c);
    }
#pragma unroll 1
    for (int i = gt; i < 2 * 4 * 64 * 128; i += NGT) {
        const int o = i & 127, c = (i >> 7) & 63, lg = i >> 13; const float* wf = p.in[I_WFNET] + (size_t)lg * 4096 + (o & 63);
        float acc = 0.f;
        for (int cp = 0; cp < 64; ++cp) { const float rev = (float)((c * cp) & 63) * (1.0f / 64.0f); const float s = __builtin_amdgcn_sinf(rev), co = __builtin_amdgcn_cosf(rev); acc += (o < 64 ? co : s) * wf[cp * 64]; }
        ((float*)(ws + WS_FW))[i] = acc;
    }
#pragma unroll 1
    for (int i = gt; i < 2 * 2 * 64 * 512; i += NGT) { const int c = i & 511, r = (i >> 9) & 63, ld = i >> 15;
        ((bf16*)(ws + WS_WUPT))[(size_t)(ld * 512 + c) * 64 + r] = (bf16)f2bf(p.in[I_WUP][i]);
        ((bf16*)(ws + WS_AUPT))[(size_t)(ld * 512 + c) * 64 + r] = (bf16)f2bf(p.in[I_AUP][i]); }
#pragma unroll 1
    for (int i = gt; i < 2 * 128 * 512; i += NGT) { const int c = i & 511, r = (i >> 9) & 127, ll = i >> 16;
        ((bf16*)(ws + WS_GUPT))[(size_t)(ll * 512 + c) * 128 + r] = (bf16)f2bf(p.in[I_GUP][i]); }
    __syncthreads();
    LAS float* sc = (LAS float*)lds; LAS float* red = (LAS float*)(lds + 20480);
#pragma unroll 1
    for (int it = bid; it < 192; it += nb) {
        const int l = it / 96, cgp = it % 96;
        for (int i = tid; i < 5 * 1024; i += NTHR) { const int cond = i >> 10, k = i & 1023; const float v = cond == 0 ? p.in[I_CCTX][k] : p.in[I_C][(cond - 1) * 1024 + k]; sc[i] = v * fsigmoid(v); }
        __syncthreads();
        const int cgi = tid & 15, kg = tid >> 4;
        f32x4 acc[5];
#pragma unroll
        for (int c = 0; c < 5; ++c) acc[c] = (f32x4){0.f, 0.f, 0.f, 0.f};
        const float* wp = p.in[I_WADA] + ((size_t)l * 1024 + kg * 32) * 6144 + cgp * 64 + cgi * 4;
#pragma unroll 4
        for (int kk = 0; kk < 32; ++kk) { const f32x4 w = *(const f32x4*)(wp + (size_t)kk * 6144);
#pragma unroll
            for (int c = 0; c < 5; ++c) acc[c] += sc[c * 1024 + kg * 32 + kk] * w; }
#pragma unroll
        for (int c = 0; c < 5; ++c) *(LAS f32x4*)(red + (kg * 5 + c) * 64 + cgi * 4) = acc[c];
        __syncthreads();
        if (tid < 320) { const int cond = tid >> 6, col = tid & 63; float s = p.in[I_BADA][l * 6144 + cgp * 64 + col];
            for (int g = 0; g < 32; ++g) s += red[(g * 5 + cond) * 64 + col];
            ((float*)(ws + WS_MOD))[(l * 5 + cond) * 6144 + cgp * 64 + col] = s; }
        __syncthreads();
    }
}

__device__ __forceinline__ void stage_norm(CKP& p, int l, int which, int bid, int nb) {
    const int tid = opaque_tid(), lane = tid & 63, wave = tid >> 6;
    const float* g = p.in[which ? I_N2G : I_N1G] + l * DM;
    const float* mod = (const float*)(p.ws + WS_MOD) + (size_t)l * 5 * 6144 + (which ? 3 * 1024 : 0);
    bf16* H = (bf16*)(p.ws + WS_H);
#pragma unroll 1
    for (int row = bid * 8 + wave; row < MTOK; row += nb * 8) {
        const float* xsrc = (l == 0 && which == 0) ? (row < NCTX ? p.in[I_XP] + (size_t)row * DM : p.in[I_XS] + (size_t)(row - NCTX) * DM) : p.out + (size_t)row * DM;
        const f32x4* xr = (const f32x4*)xsrc + lane;
        f32x4 v[4]; float s = 0.f;
#pragma unroll
        for (int j = 0; j < 4; ++j) { v[j] = xr[64 * j]; s += (v[j].x * v[j].x + v[j].y * v[j].y) + (v[j].z * v[j].z + v[j].w * v[j].w); }
        const float rstd = frsq(wave_sum(s) * (1.0f / DM) + 1e-6f);
        const int cond = row < NCTX ? 0 : 1 + ((row - NCTX) >> 10);
        const float* sh = mod + cond * 6144; const float* scl = sh + 1024;
        unsigned long long* o8 = (unsigned long long*)(H + (size_t)row * DM) + lane;
#pragma unroll
        for (int j = 0; j < 4; ++j) { const int col = 4 * lane + 256 * j; const f32x4 gg = *(const f32x4*)(g + col), a = *(const f32x4*)(sh + col), b = *(const f32x4*)(scl + col);
            const f32x4 y = v[j] * rstd * gg * (b + 1.0f) + a;
            o8[64 * j] = (unsigned long long)pk2(y.x, y.y) | ((unsigned long long)pk2(y.z, y.w) << 32); }
    }
}
__device__ __forceinline__ void stage_final(CKP& p, int bid, int nb) {
    const int tid = opaque_tid(), lane = tid & 63, wave = tid >> 6;
    const float* g = p.in[I_FNG];
#pragma unroll 1
    for (int row = bid * 8 + wave; row < MTOK; row += nb * 8) {
        f32x4* xr = (f32x4*)(p.out + (size_t)row * DM) + lane;
        f32x4 v[4]; float s = 0.f;
#pragma unroll
        for (int j = 0; j < 4; ++j) { v[j] = xr[64 * j]; s += (v[j].x * v[j].x + v[j].y * v[j].y) + (v[j].z * v[j].z + v[j].w * v[j].w); }
        const float rstd = frsq(wave_sum(s) * (1.0f / DM) + 1e-6f);
#pragma unroll
        for (int j = 0; j < 4; ++j) xr[64 * j] = v[j] * rstd * *(const f32x4*)(g + 4 * lane + 256 * j);
    }
}


typedef short bf16x8 __attribute__((ext_vector_type(8)));
typedef float f32x2v __attribute__((ext_vector_type(2)));
typedef __bf16 bf16x2v __attribute__((ext_vector_type(2)));
#define MFMA16(a, b, c) __builtin_amdgcn_mfma_f32_16x16x32_bf16((a), (b), (c), 0, 0, 0)
__device__ __forceinline__ unsigned cvt2(float lo, float hi) { f32x2v v = {lo, hi}; bf16x2v b = __builtin_convertvector(v, bf16x2v); return __builtin_bit_cast(unsigned, b); }
__device__ __forceinline__ u32x4 pack8(const float (&x)[8]) { u32x4 w; w.x = cvt2(x[0], x[1]); w.y = cvt2(x[2], x[3]); w.z = cvt2(x[4], x[5]); w.w = cvt2(x[6], x[7]); return w; }
__device__ __forceinline__ void shift8(const bf16* proj, int row, bool hasp, bool hasn, int col, const float* mu, float (&u)[8]) {
    float p[8], a[8], b[8];
    load8bf(proj + (size_t)row * DINP + col, p);
    if (hasp) load8bf(proj + (size_t)(row - 1) * DINP + col, a); else {
#pragma unroll
        for (int j = 0; j < 8; ++j) a[j] = 0.f; }
    if (hasn) load8bf(proj + (size_t)(row + 1) * DINP + col, b); else {
#pragma unroll
        for (int j = 0; j < 8; ++j) b[j] = 0.f; }
    const f32x4 m0 = *(const f32x4*)(mu + col), m1 = *(const f32x4*)(mu + col + 4);
#pragma unroll
    for (int j = 0; j < 4; ++j) { u[j] = p[j] + m0[j] * (0.5f * (a[j] + b[j]) - p[j]); u[4 + j] = p[4 + j] + m1[j] * (0.5f * (a[4 + j] + b[4 + j]) - p[4 + j]); }
}
__device__ __forceinline__ int opq(int x) { asm volatile("" : "+v"(x)); return x; }
constexpr int TS = 72, TB = 64 * TS * 2;
constexpr int L_HT = 0, L_TW = 9216, L_AD = 18432, L_LP = 27648, L_AP = 45056, L_AT = 62464, L_RT = L_AT + TB, L_BH = L_RT + TB, L_KH = L_BH + TB, L_VR = L_KH + TB, L_YS = L_VR + TB;
constexpr int L_AAB = L_TW, L_AAK = L_AAB + 4096, L_ARB = L_AAK + 3072, L_ARK = L_ARB + 3072, L_UT = L_ARK + 3072, L_W1 = L_AP;
static_assert(L_UT + 64 * 24 * 2 <= L_LP && L_YS + 17408 <= RING_BYTES, "scan LDS map");
constexpr int LPS = 68;
#define LBAR() asm volatile("s_waitcnt lgkmcnt(0)\n\ts_barrier" ::: "memory")
typedef short s16x4v __attribute__((ext_vector_type(4)));
__device__ __forceinline__ bf16x8 tr8(const LAS bf16* p) {
    const s16x4v lo = __builtin_bit_cast(s16x4v, __builtin_amdgcn_ds_read_tr16_b64_v4i16((LAS s16x4v*)p));
    const s16x4v hi = __builtin_bit_cast(s16x4v, __builtin_amdgcn_ds_read_tr16_b64_v4i16((LAS s16x4v*)(p + 4 * TS)));
    return (bf16x8){lo[0], lo[1], lo[2], lo[3], hi[0], hi[1], hi[2], hi[3]};
}

__device__ __forceinline__ void rwkv_item3(CKP& p, int l, LAS unsigned char* lds, int item) {
    const int tid0 = opaque_tid(), w = __builtin_amdgcn_readfirstlane(tid0 >> 6);
    int tid = tid0, fr = tid & 15, fg = (tid & 63) >> 4;
    int bseq, h, dir, L, base; bool lat;
    if (item < 64) { lat = true; bseq = item >> 4; h = (item >> 1) & 7; dir = item & 1; L = 1024; base = NCTX + bseq * 1024; }
    else { const int i2 = item - 64; lat = false; bseq = i2 >> 4; h = (i2 >> 1) & 7; dir = i2 & 1; L = 256; base = bseq * 256; }
    const bf16* U = (const bf16*)(p.ws + WS_U);
    const float* KINV = (const float*)(p.ws + WS_KINV);
    float* Yout = (float*)(p.ws + (dir ? WS_YB : WS_YF));
    float* BC = (float*)(p.ws + WS_BC) + (size_t)dir * MTOK * 8;
    const bf16* wupt = (const bf16*)(p.ws + WS_WUPT) + ((size_t)(l * 2 + dir) * 512 + h * 64) * 64;
    const bf16* aupt = (const bf16*)(p.ws + WS_AUPT) + ((size_t)(l * 2 + dir) * 512 + h * 64) * 64;
    LAS bf16* TW = (LAS bf16*)(lds + L_TW);   LAS bf16* AD = (LAS bf16*)(lds + L_AD);
    LAS float* LP = (LAS float*)(lds + L_LP); LAS float* AP = (LAS float*)(lds + L_AP);
    LAS bf16* AT = (LAS bf16*)(lds + L_AT);   LAS bf16* RT = (LAS bf16*)(lds + L_RT);   LAS bf16* BH = (LAS bf16*)(lds + L_BH);   LAS bf16* KH = (LAS bf16*)(lds + L_KH);
    LAS bf16* VR = (LAS bf16*)(lds + L_VR);   LAS float* YS = (LAS float*)(lds + L_YS);
    LAS float* AAB = (LAS float*)(lds + L_AAB); LAS bf16* AAK = (LAS bf16*)(lds + L_AAK); LAS bf16* ARB = (LAS bf16*)(lds + L_ARB); LAS bf16* ARK = (LAS bf16*)(lds + L_ARK);
    LAS float* W1 = (LAS float*)(lds + L_W1);
    const bf16x8 zero8 = {0, 0, 0, 0, 0, 0, 0, 0};
    const int tv = w & 3;
    f32x4 hacc[4];
#pragma unroll
    for (int x = 0; x < 4; ++x) {
        if (lat && w < 4) hacc[x] = *(const f32x4*)(p.in[I_STATE] + ((((size_t)bseq * 2 + l) * 2 + dir) * 8 + h) * 4096 + (16 * tv + fr) * 64 + 16 * x + 4 * fg);
        else hacc[x] = (f32x4){0.f, 0.f, 0.f, 0.f}; }
    int ei = tid >> 3, ec8 = (tid & 7) * 8; const int hc8 = h * 64 + ec8;
    float kkp[8], kap[8], rkp[8];
#pragma unroll
    for (int e = 0; e < 8; ++e) { kkp[e] = p.in[I_KK][l * 512 + hc8 + e]; kap[e] = p.in[I_KA][l * 512 + hc8 + e]; rkp[e] = p.in[I_RK][l * 512 + hc8 + e]; }
#define SCAN_PREFETCH(SC) do { const int _t0 = opq(tid0), _ei = _t0 >> 3, _ec8 = (_t0 & 7) * 8; const int _step = (SC) * 64 + _ei, _t = dir ? L - 1 - _step : _step; \
        const bf16* _u = U + (size_t)(base + _t) * 1920; \
        nwd = *(const u32x4*)(_u + WD_OFF + dir * 64 + _ec8); nad = *(const u32x4*)(_u + AD_OFF + dir * 64 + _ec8); \
        nr = *(const u32x4*)(_u + R_OFF + h * 64 + _ec8); nk = *(const u32x4*)(_u + K_OFF + h * 64 + _ec8); nv = *(const u32x4*)(_u + V_OFF + h * 64 + _ec8); \
        ninv = KINV[(size_t)(base + _t) * 8 + h]; } while (0)
    bf16x8 lbw[2][2], lba[2][2]; float lw0c[2], la0c[2];
#pragma unroll
    for (int x = 0; x < 2; ++x) { const int c = ((w & 1) * 2 + x) * 16 + fr;
        lbw[x][0] = *(const bf16x8*)(wupt + c * 64 + fg * 8); lbw[x][1] = *(const bf16x8*)(wupt + c * 64 + 32 + fg * 8);
        lba[x][0] = *(const bf16x8*)(aupt + c * 64 + fg * 8); lba[x][1] = *(const bf16x8*)(aupt + c * 64 + 32 + fg * 8);
        lw0c[x] = p.in[I_W0][(l * 2 + dir) * 512 + h * 64 + c]; la0c[x] = p.in[I_A0][(l * 2 + dir) * 512 + h * 64 + c]; }
    u32x4 nwd, nad, nr, nk, nv; float ninv;
    SCAN_PREFETCH(0);
    __syncthreads();
#pragma unroll 1
    for (int sc = 0; sc < L / 64; ++sc) {
        tid = opq(tid0); fr = tid & 15; fg = (tid & 63) >> 4; ei = tid >> 3; ec8 = (tid & 7) * 8;
        *(LAS u32x4*)(TW + ei * TS + ec8) = nwd; *(LAS u32x4*)(AD + ei * TS + ec8) = nad;
        const u32x4 cr = nr, ck = nk, cv = nv; const float kinv = ninv;
        __syncthreads();
        tid = opq(tid0); fr = tid & 15; fg = (tid & 63) >> 4; ei = tid >> 3; ec8 = (tid & 7) * 8;
        { const int ti = w >> 1;
          const bf16x8 aw0 = *(const LAS bf16x8*)(TW + (ti * 16 + fr) * TS + fg * 8), aw1 = *(const LAS bf16x8*)(TW + (ti * 16 + fr) * TS + 32 + fg * 8);
          const bf16x8 aa0 = *(const LAS bf16x8*)(AD + (ti * 16 + fr) * TS + fg * 8), aa1 = *(const LAS bf16x8*)(AD + (ti * 16 + fr) * TS + 32 + fg * 8);
#pragma unroll
          for (int x = 0; x < 2; ++x) { const int c = ((w & 1) * 2 + x) * 16 + fr;
              f32x4 cw = (f32x4){lw0c[x], lw0c[x], lw0c[x], lw0c[x]}, ca = (f32x4){la0c[x], la0c[x], la0c[x], la0c[x]};
              cw = MFMA16(aw0, lbw[x][0], cw); cw = MFMA16(aw1, lbw[x][1], cw); ca = MFMA16(aa0, lba[x][0], ca); ca = MFMA16(aa1, lba[x][1], ca);
#pragma unroll
              for (int r = 0; r < 4; ++r) { LP[(ti * 16 + 4 * fg + r) * LPS + c] = cw[r]; AP[(ti * 16 + 4 * fg + r) * LPS + c] = ca[r]; } } }
        __syncthreads();
        tid = opq(tid0); fr = tid & 15; fg = (tid & 63) >> 4; ei = tid >> 3; ec8 = (tid & 7) * 8;
        float av[8], bv[8], kd[8], rr[8], bcv;
        { const f32x4 wp0 = *(const LAS f32x4*)(LP + ei * LPS + ec8), wp1 = *(const LAS f32x4*)(LP + ei * LPS + ec8 + 4);
          const f32x4 ap0 = *(const LAS f32x4*)(AP + ei * LPS + ec8), ap1 = *(const LAS f32x4*)(AP + ei * LPS + ec8 + 4);
          float kk[8], lw[8], bc = 0.f;
          rr[0] = bflo(cr.x); rr[1] = bfhi(cr.x); rr[2] = bflo(cr.y); rr[3] = bfhi(cr.y); rr[4] = bflo(cr.z); rr[5] = bfhi(cr.z); rr[6] = bflo(cr.w); rr[7] = bfhi(cr.w);
          kk[0] = bflo(ck.x); kk[1] = bfhi(ck.x); kk[2] = bflo(ck.y); kk[3] = bfhi(ck.y); kk[4] = bflo(ck.z); kk[5] = bfhi(ck.z); kk[6] = bflo(ck.w); kk[7] = bfhi(ck.w);
#pragma unroll
          for (int e = 0; e < 8; ++e) { const float wpre = e < 4 ? wp0[e & 3] : wp1[e & 3], apre = e < 4 ? ap0[e & 3] : ap1[e & 3];
              lw[e] = -0.6065306597126334f * fsigmoid(wpre);
              const float asg = fsigmoid(apre), kj = kk[e] * kkp[e] * kinv;
              av[e] = -kj; bv[e] = kj * asg;
              kd[e] = kk[e] * (1.0f + (asg - 1.0f) * kap[e]); bc += rr[e] * kd[e] * rkp[e]; }
          bcv = red8(bc);
          *(LAS f32x4*)(LP + ei * LPS + ec8) = (f32x4){lw[0], lw[1], lw[2], lw[3]}; *(LAS f32x4*)(LP + ei * LPS + ec8 + 4) = (f32x4){lw[4], lw[5], lw[6], lw[7]}; }
        __syncthreads();
        tid = opq(tid0);
        if (tid < 256) { const int c = tid & 63, q = tid >> 6; float run = 0.f;
#pragma unroll
            for (int i = 0; i < 16; ++i) { run += LP[(16 * q + i) * LPS + c]; LP[(16 * q + i) * LPS + c] = fexp(run); } }
        __syncthreads();
        tid = opq(tid0); fr = tid & 15; fg = (tid & 63) >> 4; ei = tid >> 3; ec8 = (tid & 7) * 8;
        { const f32x4 g0 = *(const LAS f32x4*)(LP + ei * LPS + ec8), g1 = *(const LAS f32x4*)(LP + ei * LPS + ec8 + 4);
          const int ip = (ei & 15) ? ei - 1 : ei;
          f32x4 p0 = *(const LAS f32x4*)(LP + ip * LPS + ec8), p1 = *(const LAS f32x4*)(LP + ip * LPS + ec8 + 4);
          if ((ei & 15) == 0) { p0 = (f32x4){1.f, 1.f, 1.f, 1.f}; p1 = p0; }
          float xa[8], xr[8], xb[8], xk[8];
#pragma unroll
          for (int e = 0; e < 8; ++e) { const float gi = e < 4 ? g0[e & 3] : g1[e & 3], gp = e < 4 ? p0[e & 3] : p1[e & 3], ginv = frcp(gi);
              xa[e] = av[e] * gp; xr[e] = rr[e] * gi; xb[e] = bv[e] * ginv; xk[e] = kd[e] * ginv; }
          *(LAS u32x4*)(AT + ei * TS + ec8) = pack8(xa); *(LAS u32x4*)(RT + ei * TS + ec8) = pack8(xr); *(LAS u32x4*)(BH + ei * TS + ec8) = pack8(xb); *(LAS u32x4*)(KH + ei * TS + ec8) = pack8(xk);
          *(LAS u32x4*)(VR + ei * TS + ec8) = cv; }
        __syncthreads();
        tid = opq(tid0); fr = tid & 15; fg = (tid & 63) >> 4;
        { const int q = w >> 1, half = w & 1; const LAS bf16* Asrc = half ? RT : AT;
          const bf16x8 af0 = *(const LAS bf16x8*)(Asrc + (16 * q + fr) * TS + fg * 8), af1 = *(const LAS bf16x8*)(Asrc + (16 * q + fr) * TS + 32 + fg * 8);
#pragma unroll
          for (int x = 0; x < 2; ++x) { const LAS bf16* Bsrc = x ? KH : BH;
              const bf16x8 bf0 = *(const LAS bf16x8*)(Bsrc + (16 * q + fr) * TS + fg * 8), bf1_ = *(const LAS bf16x8*)(Bsrc + (16 * q + fr) * TS + 32 + fg * 8);
              f32x4 c = (f32x4){0.f, 0.f, 0.f, 0.f}; c = MFMA16(af0, bf0, c); c = MFMA16(af1, bf1_, c);
#pragma unroll
              for (int r = 0; r < 4; ++r) { const int i = 4 * fg + r, j = fr; const float val = (half ? j <= i : j < i) ? c[r] : 0.f;
                  if (half == 0 && x == 0) AAB[(q * 16 + i) * 16 + j] = val;
                  else { LAS bf16* dst = half == 0 ? AAK : (x == 0 ? ARB : ARK); dst[(q * 16 + i) * 24 + j] = (bf16)(cvt2(val, 0.f) & 0xffffu); } } } }
        __syncthreads();
        tid = opq(tid0); fr = tid & 15; fg = (tid & 63) >> 4;
        { const int q = w >> 1;
          const bf16x8 afr = *(const LAS bf16x8*)(AAK + (q * 16 + fr) * 24 + (fg & 1) * 8);
          const bf16x8 af = fg < 2 ? afr : zero8;
#pragma unroll
          for (int x = 0; x < 2; ++x) { const int tvv = (w & 1) * 2 + x;
              const bf16x8 bfr = tr8(VR + (16 * q + 8 * (fg & 1) + (fr >> 2)) * TS + 16 * tvv + 4 * (fr & 3));
              const bf16x8 bfv = fg < 2 ? bfr : zero8;
              f32x4 c = (f32x4){0.f, 0.f, 0.f, 0.f}; c = MFMA16(af, bfv, c);
#pragma unroll
              for (int r = 0; r < 4; ++r) W1[(q * 16 + 4 * fg + r) * LPS + 16 * tvv + fr] = c[r]; } }
        __syncthreads();
        tid = opq(tid0);
        { const int q = tid >> 7, col = tid & 127; float x[16];
          if (col < 64) {
#pragma unroll
              for (int i = 0; i < 16; ++i) x[i] = bf1(AT[(16 * q + i) * TS + col]); }
          else {
#pragma unroll
              for (int i = 0; i < 16; ++i) x[i] = W1[(q * 16 + i) * LPS + col - 64]; }
#pragma unroll
          for (int i = 1; i < 16; ++i) {
              const LAS f32x4* ar = (const LAS f32x4*)(AAB + (q * 16 + i) * 16);
              float acc = x[i];
#pragma unroll
              for (int j4 = 0; j4 * 4 < i; ++j4) { const f32x4 a4 = ar[j4];
#pragma unroll
                  for (int e = 0; e < 4; ++e) if (j4 * 4 + e < i) acc += a4[e] * x[j4 * 4 + e]; }
              x[i] = acc; }
          if (col < 64) {
#pragma unroll
              for (int i = 0; i < 16; ++i) AT[(16 * q + i) * TS + col] = (bf16)(cvt2(x[i], 0.f) & 0xffffu); }
          else {
#pragma unroll
              for (int i = 0; i < 16; ++i) W1[(q * 16 + i) * LPS + col - 64] = x[i]; } }
        __syncthreads();
        if (sc + 1 < L / 64) SCAN_PREFETCH(sc + 1);
        if (w < 4) {
#pragma unroll 1
        for (int q = 0; q < 4; ++q) {
            tid = opq(tid0); fr = tid & 15; fg = (tid & 63) >> 4;
            bf16x8 hb[2];
#pragma unroll
            for (int ks = 0; ks < 2; ++ks) { u32x4 t; t.x = cvt2(hacc[2 * ks][0], hacc[2 * ks][1]); t.y = cvt2(hacc[2 * ks][2], hacc[2 * ks][3]);
                t.z = cvt2(hacc[2 * ks + 1][0], hacc[2 * ks + 1][1]); t.w = cvt2(hacc[2 * ks + 1][2], hacc[2 * ks + 1][3]); hb[ks] = __builtin_bit_cast(bf16x8, t); }
            bf16x8 aU[2], aR[2];
#pragma unroll
            for (int ks = 0; ks < 2; ++ks) {
                const u32x2 a0 = *(const LAS u32x2*)(AT + (16 * q + fr) * TS + 32 * ks + 4 * fg), a1 = *(const LAS u32x2*)(AT + (16 * q + fr) * TS + 32 * ks + 16 + 4 * fg);
                const u32x2 r0 = *(const LAS u32x2*)(RT + (16 * q + fr) * TS + 32 * ks + 4 * fg), r1 = *(const LAS u32x2*)(RT + (16 * q + fr) * TS + 32 * ks + 16 + 4 * fg);
                aU[ks] = __builtin_bit_cast(bf16x8, (u32x4){a0.x, a0.y, a1.x, a1.y}); aR[ks] = __builtin_bit_cast(bf16x8, (u32x4){r0.x, r0.y, r1.x, r1.y}); }
            f32x4 u, yacc = (f32x4){0.f, 0.f, 0.f, 0.f};
#pragma unroll
            for (int r = 0; r < 4; ++r) u[r] = W1[(q * 16 + 4 * fg + r) * LPS + 16 * tv + fr];
            u = MFMA16(aU[0], hb[0], u); u = MFMA16(aU[1], hb[1], u);
            yacc = MFMA16(aR[0], hb[0], yacc); yacc = MFMA16(aR[1], hb[1], yacc);
            const s16x4v vtr = __builtin_bit_cast(s16x4v, __builtin_amdgcn_ds_read_tr16_b64_v4i16((LAS s16x4v*)(VR + (16 * q + 4 * fg + (fr >> 2)) * TS + 16 * tv + 4 * (fr & 3))));
            const u32x2 vt2 = __builtin_bit_cast(u32x2, vtr);
            const bf16x8 bUV = __builtin_bit_cast(bf16x8, (u32x4){cvt2(u[0], u[1]), cvt2(u[2], u[3]), vt2.x, vt2.y});
            { const u32x2 y0 = *(const LAS u32x2*)(ARB + (q * 16 + fr) * 24 + 4 * fg), y1 = *(const LAS u32x2*)(ARK + (q * 16 + fr) * 24 + 4 * fg);
              yacc = MFMA16(__builtin_bit_cast(bf16x8, (u32x4){y0.x, y0.y, y1.x, y1.y}), bUV, yacc); }
#pragma unroll
            for (int r = 0; r < 4; ++r) YS[(16 * q + 4 * fg + r) * LPS + 16 * tv + fr] = yacc[r];
#pragma unroll
            for (int x = 0; x < 4; ++x) {
                const s16x4v bt = __builtin_bit_cast(s16x4v, __builtin_amdgcn_ds_read_tr16_b64_v4i16((LAS s16x4v*)(BH + (16 * q + 4 * fg + (fr >> 2)) * TS + 16 * x + 4 * (fr & 3))));
                const s16x4v kt = __builtin_bit_cast(s16x4v, __builtin_amdgcn_ds_read_tr16_b64_v4i16((LAS s16x4v*)(KH + (16 * q + 4 * fg + (fr >> 2)) * TS + 16 * x + 4 * (fr & 3))));
                const u32x2 b2 = __builtin_bit_cast(u32x2, bt), k2 = __builtin_bit_cast(u32x2, kt);
                const f32x4 ge = *(const LAS f32x4*)(LP + (16 * q + 15) * LPS + 16 * x + 4 * fg);
                hacc[x] = MFMA16(__builtin_bit_cast(bf16x8, (u32x4){b2.x, b2.y, k2.x, k2.y}), bUV, hacc[x]) * ge; }
        }
        }
        __syncthreads();
        tid = opq(tid0); ei = tid >> 3; ec8 = (tid & 7) * 8;
        { const int st2 = sc * 64 + ei, t2 = dir ? L - 1 - st2 : st2; float* yo = Yout + (size_t)(base + t2) * 512 + h * 64 + ec8;
          *(f32x4*)yo = *(const LAS f32x4*)(YS + ei * LPS + ec8); *(f32x4*)(yo + 4) = *(const LAS f32x4*)(YS + ei * LPS + ec8 + 4);
          if ((tid & 7) == 0) BC[(size_t)(base + t2) * 8 + h] = bcv; }
    }
#undef SCAN_PREFETCH
    if (!lat && w < 4) {
#pragma unroll
        for (int x = 0; x < 4; ++x) *(f32x4*)(p.out + (size_t)MTOK * DM + ((((size_t)bseq * 2 + l) * 2 + dir) * 8 + h) * 4096 + (16 * tv + fr) * 64 + 16 * x + 4 * fg) = hacc[x]; }
    __syncthreads();
}

__device__ __forceinline__ void stage_upass(CKP& p, int l, int bid, int nb) {
    const int tid = opaque_tid(), sub = tid >= 240 ? 1 : 0, j = tid - sub * 240, col = 8 * j;
    const bf16* proj = (const bf16*)(p.ws + WS_PROJ); bf16* U = (bf16*)(p.ws + WS_U); float* KINV = (float*)(p.ws + WS_KINV);
    const float* mu = p.in[I_MU] + l * 1920;
    if (tid < 480) {
        const bool isk = col >= K_OFF && col < V_OFF;
        const float* kkp = p.in[I_KK] + l * 512 + (isk ? col - K_OFF : 0);
        const f32x4 k0 = *(const f32x4*)kkp, k1 = *(const f32x4*)(kkp + 4);
#pragma unroll 1
        for (int tok0 = bid * 2 + sub; tok0 < MTOK; tok0 += nb * 4) {
            float uu[2][8];
#pragma unroll
            for (int z = 0; z < 2; ++z) { const int tok = min(tok0 + z * nb * 2, MTOK - 1);
                const bool lat = tok >= NCTX; const int L = lat ? 1024 : 256, t = lat ? (tok - NCTX) & 1023 : tok & 255;
                shift8(proj, tok, t > 0, t < L - 1, col, mu, uu[z]); }
#pragma unroll
            for (int z = 0; z < 2; ++z) { const int tok = tok0 + z * nb * 2;
                float ss = 0.f;
#pragma unroll
                for (int e = 0; e < 8; ++e) { const float kn = uu[z][e] * (e < 4 ? k0[e & 3] : k1[e & 3]); ss += kn * kn; }
                ss = red8(ss);
                if (tok < MTOK) {
                    if (isk && (j & 7) == 0) KINV[(size_t)tok * 8 + ((col - K_OFF) >> 6)] = fminf(frsq(ss), 1e12f);
                    if (col >= WD_OFF && col < AD_OFF) {
#pragma unroll
                        for (int e = 0; e < 8; ++e) uu[z][e] = 1.0f - 2.0f * frcp(fexp(2.0f * uu[z][e]) + 1.0f); }
                    if (col >= GD_OFF) {
#pragma unroll
                        for (int e = 0; e < 8; ++e) uu[z][e] = fsigmoid(uu[z][e]); }
                    *(u32x4*)(U + (size_t)tok * 1920 + col) = pack8(uu[z]); } }
        }
    }
}

__device__ __forceinline__ void fnet1_item(CKP& p, int l, LAS unsigned char* lds, int item) {
    const int tid = opaque_tid(), tb = item >> 2, g = item & 3, tok0 = tb * 64;
    const bf16* proj = (const bf16*)(p.ws + WS_PROJ);
    LAS float* XT = (LAS float*)lds;
    LAS float* FWL = XT + 64 * 65;
    { const int ti = tid >> 3, c8 = (tid & 7) * 8; float x[8]; load8bf(proj + (size_t)(tok0 + ti) * DINP + F_OFF + g * 64 + c8, x);
#pragma unroll
      for (int j = 0; j < 8; ++j) XT[ti * 65 + c8 + j] = x[j]; }
    const float* fw = (const float*)(p.ws + WS_FW) + (size_t)(l * 4 + g) * 8192;
    for (int i = tid; i < 2048; i += NTHR) *(LAS f32x4*)(FWL + i * 4) = *(const f32x4*)(fw + i * 4);
    __syncthreads();
    const int ti = tid & 63, og = tid >> 6;
    f32x4 acc[4];
#pragma unroll
    for (int j = 0; j < 4; ++j) acc[j] = (f32x4){0.f, 0.f, 0.f, 0.f};
#pragma unroll 4
    for (int c = 0; c < 64; ++c) { const float x = XT[ti * 65 + c];
#pragma unroll
        for (int j = 0; j < 4; ++j) acc[j] += x * *(const LAS f32x4*)(FWL + c * 128 + og * 16 + j * 4); }
    const bool lat = tok0 >= NCTX;
    const int L = lat ? 1024 : 256, bq = lat ? (tok0 - NCTX) >> 10 : tok0 >> 8, t = (lat ? (tok0 - NCTX) & 1023 : tok0 & 255) + ti;
    const float scale = lat ? (1.0f / 256.0f) : (1.0f / 128.0f);
    bf16* Y = (bf16*)(p.ws + WS_YCS) + (lat ? (size_t)8192 * 512 : 0);
    const int cs = og >> 2, K2 = 2 * L;
#pragma unroll
    for (int j = 0; j < 4; ++j)
#pragma unroll
        for (int e = 0; e < 4; ++e) { const int d = (og & 3) * 16 + j * 4 + e;
            Y[(size_t)((bq * 4 + g) * 64 + d) * K2 + cs * L + t] = (bf16)f2bf(acc[j][e] * scale); }
    __syncthreads();
}

__device__ __forceinline__ void pool_item(CKP& p, int l, LAS unsigned char* lds, int item) {
    const int tid = opaque_tid(), tb = item >> 2, gi = item & 3, tok0 = tb * 64, hw = 1 << gi;
    const bf16* proj = (const bf16*)(p.ws + WS_PROJ);
    LAS float* DT = (LAS float*)lds;
    LAS float* WP = DT + 64 * 65;
    LAS float* CSUM = WP + 4096;
    const float* wpool = p.in[I_WPOOL] + (size_t)(l * 4 + gi) * 4096;
    for (int i = tid; i < 1024; i += NTHR) *(LAS f32x4*)(WP + i * 4) = *(const f32x4*)(wpool + i * 4);
    const int ti = tid >> 3, c8 = (tid & 7) * 8, tok = tok0 + ti, col = P_OFF + gi * 64 + c8;
    { float sum[8], x[8];
#pragma unroll
      for (int j = 0; j < 8; ++j) sum[j] = 0.f;
      load8bf(proj + (size_t)tok * DINP + col, x);
      float cnt;
      if (tok < NCTX) { const int t = tok & 255, sb = tok - t, lo = max(t - hw, 0), hi = min(t + hw, 256);
          for (int q = lo; q < hi; ++q) { float y[8]; load8bf(proj + (size_t)(sb + q) * DINP + col, y);
#pragma unroll
              for (int j = 0; j < 8; ++j) sum[j] += y[j]; }
          cnt = (float)(hi - lo); }
      else {
          const int t = (tok - NCTX) & 1023, sb = tok - t, r = t >> 6, c = t & 63, rlo = max(r - hw, 0), rhi = min(r + hw, 16), clo = max(c - hw, 0), chi = min(c + hw, 64);
          for (int rq = rlo; rq < rhi; ++rq) { float y[8]; load8bf(proj + (size_t)(sb + rq * 64 + c) * DINP + col, y);
#pragma unroll
              for (int j = 0; j < 8; ++j) sum[j] += y[j]; }
          *(LAS f32x4*)(CSUM + ti * 68 + c8) = (f32x4){sum[0], sum[1], sum[2], sum[3]}; *(LAS f32x4*)(CSUM + ti * 68 + c8 + 4) = (f32x4){sum[4], sum[5], sum[6], sum[7]};
          __syncthreads();
#pragma unroll
          for (int j = 0; j < 8; ++j) sum[j] = 0.f;
          for (int cq = clo; cq < chi; ++cq) { const f32x4 a = *(const LAS f32x4*)(CSUM + cq * 68 + c8), b = *(const LAS f32x4*)(CSUM + cq * 68 + c8 + 4);
#pragma unroll
              for (int j = 0; j < 4; ++j) { sum[j] += a[j]; sum[4 + j] += b[j]; } }
          cnt = (float)((rhi - rlo) * (chi - clo)); }
      const float ic = frcp(cnt);
#pragma unroll
      for (int j = 0; j < 8; ++j) DT[ti * 65 + c8 + j] = sum[j] * ic - x[j]; }
    __syncthreads();
    f32x4 a0 = (f32x4){0.f, 0.f, 0.f, 0.f}, a1 = a0;
#pragma unroll 4
    for (int c = 0; c < 64; ++c) { const float d = DT[ti * 65 + c]; a0 += d * *(const LAS f32x4*)(WP + c * 64 + c8); a1 += d * *(const LAS f32x4*)(WP + c * 64 + c8 + 4); }
    const float* ps = p.in[I_PSCALE] + l * 256 + gi * 64 + c8;
    const f32x4 s0 = *(const f32x4*)ps, s1 = *(const f32x4*)(ps + 4);
    a0 *= s0; a1 *= s1;
    u32x4 w; w.x = pk2(a0[0], a0[1]); w.y = pk2(a0[2], a0[3]); w.z = pk2(a1[0], a1[1]); w.w = pk2(a1[2], a1[3]);
    *(u32x4*)((bf16*)(p.ws + WS_MIXED) + (size_t)tok * DM + 768 + gi * 64 + c8) = w;
    __syncthreads();
}

__device__ __forceinline__ void stage_post(CKP& p, int l, int bid, int nb) {
    const int tid = opaque_tid(), lane = tid & 63, head = __builtin_amdgcn_readfirstlane(tid >> 6), fr = lane & 15, fg = lane >> 4;
    const bf16* Ub = (const bf16*)(p.ws + WS_U);
    const bf16* gupt = (const bf16*)(p.ws + WS_GUPT) + ((size_t)l * 512 + head * 64) * 128;
    const float* YF = (const float*)(p.ws + WS_YF); const float* YB = (const float*)(p.ws + WS_YB);
    const float* BC0 = (const float*)(p.ws + WS_BC); const float* BC1 = BC0 + (size_t)MTOK * 8;
    bf16* MIX = (bf16*)(p.ws + WS_MIXED);
    bf16x8 bg[4][4];
    float lnw[4], lnb[4];
#pragma unroll
    for (int t = 0; t < 4; ++t) { const int c = 16 * t + fr;
#pragma unroll
        for (int ks = 0; ks < 4; ++ks) bg[t][ks] = *(const bf16x8*)(gupt + c * 128 + ks * 32 + fg * 8);
        lnw[t] = p.in[I_LNW][l * 512 + head * 64 + c]; lnb[t] = p.in[I_LNB][l * 512 + head * 64 + c]; }
#pragma unroll 1
    for (int item = bid; item < 768; item += nb) {
        const int tok0 = item * 16;
        bf16x8 ag[4];
#pragma unroll
        for (int ks = 0; ks < 4; ++ks) ag[ks] = *(const bf16x8*)(Ub + (size_t)(tok0 + fr) * 1920 + GD_OFF + ks * 32 + fg * 8);
        float y[4][4], vv[4][4], bc[4];
#pragma unroll
        for (int r = 0; r < 4; ++r) { const size_t tok = tok0 + 4 * fg + r;
            bc[r] = BC0[tok * 8 + head] + BC1[tok * 8 + head];
#pragma unroll
            for (int t = 0; t < 4; ++t) { const int c = head * 64 + 16 * t + fr;
                y[t][r] = YF[tok * 512 + c] + YB[tok * 512 + c]; vv[t][r] = bf1(Ub[tok * 1920 + V_OFF + c]); } }
        f32x4 g[4];
#pragma unroll
        for (int t = 0; t < 4; ++t) { g[t] = (f32x4){0.f, 0.f, 0.f, 0.f};
#pragma unroll
            for (int ks = 0; ks < 4; ++ks) g[t] = MFMA16(ag[ks], bg[t][ks], g[t]); }
#pragma unroll
        for (int r = 0; r < 4; ++r) { const size_t tok = tok0 + 4 * fg + r;
            const float mean = red16((y[0][r] + y[1][r]) + (y[2][r] + y[3][r])) * (1.0f / 64.0f);
            float d[4], q = 0.f;
#pragma unroll
            for (int t = 0; t < 4; ++t) { d[t] = y[t][r] - mean; q += d[t] * d[t]; }
            const float rstd = frsq(red16(q) * (1.0f / 64.0f) + 64e-5f);
#pragma unroll
            for (int t = 0; t < 4; ++t) { const float o = (d[t] * rstd * lnw[t] + lnb[t] + bc[r] * vv[t][r]) * g[t][r];
                MIX[tok * DM + head * 64 + 16 * t + fr] = (bf16)f2bf(o); } }
    }
}

#define XB_TMO      128
#define XB_XCNT(j)  (256  + 64 * (j))
#define XB_XSUB(j)  (1280 + 64 * (j))
#define XB_XGEN(j)  (2304 + 64 * (j))
#define XB_TOP      3328
#define XB_TOPGEN   3392
#define XCD_BAR_WORDS 3456
#define XB_SPIN_CAP (1u << 18)

__device__ __forceinline__ unsigned xb_ld(unsigned* p)              { return __hip_atomic_load(p, __ATOMIC_RELAXED, __HIP_MEMORY_SCOPE_AGENT); }
__device__ __forceinline__ unsigned xb_add(unsigned* p, unsigned v) { return __hip_atomic_fetch_add(p, v, __ATOMIC_RELAXED, __HIP_MEMORY_SCOPE_AGENT); }
__device__ __forceinline__ unsigned xb_xcc_id() { return (unsigned)__builtin_amdgcn_s_getreg((3 << 11) | 20) & 0xFu; }
#define XB_SPIN(cond, bar) do { unsigned _sp = 0; while (cond) { __builtin_amdgcn_s_sleep(1); \
    if ((++_sp & 255u) == 0u) { if (xb_ld(&(bar)[XB_TMO])) break; if (_sp > XB_SPIN_CAP) { atomicAdd(&(bar)[XB_TMO], 1u); break; } } } } while (0)

struct XcdBarrier {
    unsigned* bar; unsigned x;
    volatile LAS unsigned* st;
};

__device__ __forceinline__ XcdBarrier xcd_barrier_post(unsigned* bar, volatile LAS unsigned* st) {
    XcdBarrier b; b.bar = bar; b.x = xb_xcc_id(); b.st = st;
    if (threadIdx.x == 0) (void)xb_add(&bar[XB_XCNT(b.x)], 1u);
    return b;
}
__device__ __forceinline__ void xcd_barrier_complete(unsigned* bar, unsigned x, unsigned& nloc, unsigned& nx) {
    const unsigned G = gridDim.x * gridDim.y * gridDim.z;
    unsigned sum, cnt, mine, sp = 0u;
    for (;;) {
        sum = 0u; cnt = 0u; mine = 0u;
#pragma unroll
        for (unsigned j = 0; j < 16; ++j) { const unsigned c = xb_ld(&bar[XB_XCNT(j)]); sum += c; cnt += (c > 0u) ? 1u : 0u; mine = (j == x) ? c : mine; }
        if (sum == G) break;
        __builtin_amdgcn_s_sleep(1);
        if ((++sp & 255u) == 0u) { if (xb_ld(&bar[XB_TMO])) break; if (sp > XB_SPIN_CAP) { atomicAdd(&bar[XB_TMO], 1u); break; } }
    }
    nloc = mine > 0u ? mine : 1u; nx = cnt > 0u ? cnt : 1u;
}

__device__ __forceinline__ void xcd_barrier(const XcdBarrier& b) {
    asm volatile("s_waitcnt vmcnt(0)" ::: "memory");
    __syncthreads();
    if (threadIdx.x == 0) {
        unsigned* bar = b.bar;
        __builtin_amdgcn_s_waitcnt(0);
        unsigned nloc = b.st[0], nx = b.st[1];
        if (nloc == 0u) { xcd_barrier_complete(bar, b.x, nloc, nx); b.st[0] = nloc; b.st[1] = nx; }
        const unsigned old = xb_add(&bar[XB_XSUB(b.x)], 1u);
        const unsigned gen = old / nloc;
        if (old + 1u == (gen + 1u) * nloc) {
            __builtin_amdgcn_fence(__ATOMIC_RELEASE, "agent");
            asm volatile("s_waitcnt vmcnt(0)" ::: "memory");
            const unsigned og = xb_add(&bar[XB_TOP], 1u);
            const unsigned tg = og / nx;
            if (og + 1u == (tg + 1u) * nx) xb_add(&bar[XB_TOPGEN], 1u);
            else XB_SPIN(xb_ld(&bar[XB_TOPGEN]) == tg, bar);
            __builtin_amdgcn_fence(__ATOMIC_ACQUIRE, "agent");
            xb_add(&bar[XB_XGEN(b.x)], 1u);
            asm volatile("s_waitcnt vmcnt(0)" ::: "memory");
        } else {
            XB_SPIN(xb_ld(&bar[XB_XGEN(b.x)]) == gen, bar);
            __builtin_amdgcn_fence(__ATOMIC_ACQUIRE, "agent");
            asm volatile("s_waitcnt vmcnt(0)" ::: "memory");
        }
    }
    __syncthreads();
}

constexpr int N_STEPS = 20;
__device__ __forceinline__ bool step_seam(int st) { return st < 19; }
__global__ void __launch_bounds__(NTHR, 2) mega_fwd(KP p_unused) {
    extern __shared__ __attribute__((aligned(16))) unsigned char lds_raw[];
    CKP* kp0 = (CKP*)__builtin_amdgcn_kernarg_segment_ptr();
    { LAS unsigned* ctlw = (LAS unsigned*)((LAS unsigned char*)lds_raw + RING_BYTES);
      for (int u = threadIdx.x; u < (LDS_BYTES - RING_BYTES) / 4; u += NTHR) ctlw[u] = 0u; }
    __syncthreads();
    const XcdBarrier bar = xcd_barrier_post((unsigned*)(kp0->ws + WS_CTL) + 4096, (volatile LAS unsigned*)((LAS unsigned char*)lds_raw + MISC_OFF + 32));
    const int ph_lo = kp0->ph_lo, ph_hi = kp0->ph_hi;
#pragma unroll 1
    for (int st = ph_lo; st < ph_hi; ++st) {
        CKP* kp = kp0; asm volatile("" : "+s"(kp));
        CKP& p = *kp; unsigned char* ws = p.ws;
        int bid = blockIdx.x, nb = gridDim.x; unsigned ldsb = (unsigned)(size_t)(LAS unsigned char*)lds_raw;
        asm volatile("" : "+s"(bid), "+s"(nb), "+s"(ldsb));
        LAS unsigned char* lds = (LAS unsigned char*)(size_t)ldsb;
        const int l = st == 0 ? 0 : (st - 1) / 9, s = st == 0 ? -1 : (st == 19 ? 9 : (st - 1) % 9);
        const float* mod = (const float*)(ws + WS_MOD) + (size_t)l * 5 * 6144;
#ifdef REP_S
        for (int rep = 0; rep < (s == (REP_S) ? 2 : 1); ++rep) { if (rep) xcd_barrier(bar);
#endif
        if (s == 3) {
            if (nb >= 256) { if (bid < 64) rwkv_item3(p, l, lds, bid); else for (int it = 64 + (bid - 64); it < 576; it += nb - 64) rwkv_item3(p, l, lds, it); }
            else for (int it = bid; it < 576; it += nb) rwkv_item3(p, l, lds, it);
            if (nb >= 256) { if (bid >= 64 && bid < 192) transpose_range(p, lds, l == 0 ? TI_IN : TI_L + TI_IN, l == 0 ? TI_L + TI_IN : 2 * TI_L, bid - 64, 128); }
            else transpose_range(p, lds, l == 0 ? TI_IN : TI_L + TI_IN, l == 0 ? TI_L + TI_IN : 2 * TI_L, bid, nb);
            __syncthreads();
        }
#pragma unroll 1
        for (int job = 0; job < 2; ++job) {
            pg8::Gemm g{nullptr, nullptr, 0, 0, 0, 0, 0}; pg8::EpiAny E{-1, true, nullptr, nullptr, 0, 0, nullptr, nullptr}; int corder = bid;
            if (job == 0) {
                if (s == 1) { g = pg8::Gemm{(const bf16*)(ws + WS_H), (const bf16*)(ws + WS_WIN) + (size_t)l * DINP * DM, MTOK, DINP, DM, DM, DM}; E = pg8::EpiAny{0, true, ws + WS_PROJ, nullptr, DINP, 0, nullptr, nullptr}; }
                else if (s == 3) { g = pg8::Gemm{(const bf16*)(ws + WS_CS256), (const bf16*)(ws + WS_YCS), 256, 8192, 512, 512, 512}; E = pg8::EpiAny{3, true, ws + WS_MIXED, nullptr, 0, 256, nullptr, nullptr}; corder = (bid + nb - (nb >= 256 ? 192 : 0)) % nb; }
                else if (s == 5) { g = pg8::Gemm{(const bf16*)(ws + WS_MIXED), (const bf16*)(ws + WS_WOUT) + (size_t)l * DM * DM, MTOK, DM, DM, DM, DM}; E = pg8::EpiAny{2, false, p.out, mod + 2 * 1024, 0, 0, l == 0 ? p.in[I_XP] : p.out, l == 0 ? p.in[I_XS] : p.out + (size_t)NCTX * DM}; }
                else if (s == 7) { g = pg8::Gemm{(const bf16*)(ws + WS_H), (const bf16*)(ws + WS_W1) + (size_t)l * DFF * DM, MTOK, DFF, DM, DM, DM}; E = pg8::EpiAny{1, true, ws + WS_FF, nullptr, DFF, 0, nullptr, nullptr}; }
                else if (s == 8) { g = pg8::Gemm{(const bf16*)(ws + WS_FF), (const bf16*)(ws + WS_W2) + (size_t)l * DM * DFF, MTOK, DM, DFF, DFF, DFF}; E = pg8::EpiAny{2, false, p.out, mod + 5 * 1024, 0, 0, p.out, p.out + (size_t)NCTX * DM}; }
            } else if (s == 3) { g = pg8::Gemm{(const bf16*)(ws + WS_CS1024), (const bf16*)(ws + WS_YCS) + (size_t)8192 * 512, 1024, 1024, 2048, 2048, 2048}; E = pg8::EpiAny{3, true, ws + WS_MIXED, nullptr, NCTX, 1024, nullptr, nullptr}; corder = (bid + nb - (nb >= 256 ? 224 : 32)) % nb; }
            if (E.mode >= 0) {
                pg8::StaticOrder S; S.init(g.M, g.N, nb, corder);
                pg8::gemm_phase<pg8::EpiAny, pg8::StaticOrder, true, true>(lds, g, S, E);
                __syncthreads();
            }
        }
        if (s == -1) stage_prologue(p, lds, bid, nb);
        else if (s == 0) stage_norm(p, l, 0, bid, nb);
        else if (s == 2) {
            stage_upass(p, l, bid, nb);
#pragma unroll 1
            for (int it = bid; it < 768; it += nb) fnet1_item(p, l, lds, it);
#pragma unroll 1
            for (int it = bid; it < 768; it += nb) pool_item(p, l, lds, it);
        }
        else if (s == 4) stage_post(p, l, bid, nb);
        else if (s == 6) stage_norm(p, l, 1, bid, nb);
        else if (s == 9) stage_final(p, bid, nb);
#ifdef REP_S
        }
#endif
        if (st + 1 < ph_hi && step_seam(st)) xcd_barrier(bar);
    }
}

extern "C" void kernel_launch(void* const* d_in, const int* in_sizes, int n_in, void* d_out, int out_size, void* d_ws, size_t ws_size, hipStream_t stream) {
    static int grid = 0;
    if (grid == 0) {
        if (n_in != N_IN || ws_size < WS_END) { fprintf(stderr, "kernel_launch: unexpected inputs (n_in %d, ws %zu)\n", n_in, ws_size); grid = -1; return; }
        int dev = 0, cus = 0, per_cu = 0;
        (void)hipGetDevice(&dev); (void)hipDeviceGetAttribute(&cus, hipDeviceAttributeMultiprocessorCount, dev);
        (void)hipFuncSetAttribute((const void*)mega_fwd, hipFuncAttributeMaxDynamicSharedMemorySize, LDS_BYTES);
        if (hipOccupancyMaxActiveBlocksPerMultiprocessor(&per_cu, (const void*)mega_fwd, NTHR, LDS_BYTES) != hipSuccess || per_cu < 1) {
            fprintf(stderr, "kernel_launch: occupancy query reports %d blocks/CU\n", per_cu); (void)hipGetLastError(); grid = -1; return; }
        grid = cus * 1;
    }
    if (grid < 0) return;
    KP a{};
    for (int i = 0; i < N_IN; ++i) a.in[i] = (const float*)d_in[i];
    a.out = (float*)d_out; a.ws = (unsigned char*)d_ws; a.ph_lo = 0; a.ph_hi = N_STEPS;
    if (hipMemsetAsync((char*)d_ws + WS_CTL, 0, 1 * MiB, stream) != hipSuccess) { fprintf(stderr, "kernel_launch: memset failed\n"); return; }
    void* args[] = {&a};
    hipError_t e = hipLaunchCooperativeKernel((const void*)mega_fwd, dim3(grid), dim3(NTHR), args, LDS_BYTES, stream);
    if (e != hipSuccess) fprintf(stderr, "cooperative launch failed: %s (grid %d)\n", hipGetErrorString(e), grid);
}
```

```cpp
#include <hip/hip_runtime.h>
#include <hip/hip_cooperative_groups.h>
#include <cstdio>
#include <cstdint>
namespace cg = cooperative_groups;
__device__ __forceinline__ int opaque_tid() { int t = threadIdx.x; asm volatile("" : "+v"(t)); return t; }
namespace pg8 {
#define PG8_LAS __attribute__((address_space(3)))
typedef unsigned short bf16_t;
typedef short bf16x8 __attribute__((ext_vector_type(8)));
typedef float f32x4 __attribute__((ext_vector_type(4)));
typedef unsigned u32x4 __attribute__((ext_vector_type(4)));
constexpr int BM = 256, BK = 64, HALF = 128, HTB = HALF * BK * 2  , STAGE_BYTES = 8 * HTB, NXCD = 8, WGM = 8;

__host__ __device__ __forceinline__ int lds_byte(int r, int c) { const int st = (r >> 4) * 2 + (c >> 5), rr = r & 15, cc = c & 31, ob = rr * 64 + cc * 2; return st * 1024 + (ob ^ (((ob >> 9) & 1) << 5)); }
__host__ __device__ __forceinline__ void stage_rc(int b, int& R, int& C) { const int st = b / 1024, sb = b % 1024, swz = sb ^ (((sb >> 9) & 1) << 5); R = (st >> 1) * 16 + swz / 64; C = (st & 1) * 32 + (swz % 64) / 2; }
__host__ __device__ __forceinline__ int perm32(int rho) { const int n = rho >> 4, i = rho & 15; return 8 * (i >> 2) + 4 * n + (i & 3); }

struct Unit { int pm, pn; };
struct Gemm { const bf16_t* A; const bf16_t* Bt; int M, N, K, lda, ldb; };

struct StaticOrder {
    int nM, nN, nwg, G, c;
    __host__ __device__ void init(int M, int N, int G_, int c_) { nM = M / BM; nN = N / BM; nwg = nM * nN; G = G_; c = c_; }
    __host__ __device__ bool next(int i, Unit& u) const {
        const long L = (long)i * G + c; if (L >= nwg) return false;
        int wgid = (int)L; { const int q = nwg / NXCD, r = nwg % NXCD, xcd = wgid % NXCD, off = wgid / NXCD; wgid = (xcd < r ? xcd * (q + 1) : r * (q + 1) + (xcd - r) * q) + off; }
        const int nig = WGM * nN, gid = wgid / nig, fm = gid * WGM, gsz = (nM - fm) < WGM ? (nM - fm) : WGM;
        u.pm = fm + ((wgid % nig) % gsz); u.pn = (wgid % nig) / gsz; return true;
    }
    __device__ __forceinline__ void a_ready(const Unit&) const {}
    __device__ __forceinline__ void done(const Unit&) const {}
};

__device__ __forceinline__ unsigned cvt_pk_bf16(float lo, float hi) { unsigned r; asm volatile("v_cvt_pk_bf16_f32 %0, %1, %2" : "=v"(r) : "v"(lo), "v"(hi)); return r; }
typedef unsigned u32x2 __attribute__((ext_vector_type(2)));
template <int ACT  > struct EpiBf {
    static constexpr bool PERM = true, AFTER_DRAIN = false;
    bf16_t* O; int ldc;
    __device__ __forceinline__ void operator()(const f32x4 (&acc)[2][2][4][2], const Unit& u, int wr, int wc, int fr, int fq) const {
        const int row0 = u.pm * BM + wr * 64 + fr, col0 = u.pn * BM + wc * 32 + 8 * fq;
#pragma unroll
        for (int ai = 0; ai < 2; ++ai)
#pragma unroll
            for (int m = 0; m < 4; ++m) { bf16_t* rowp = O + (size_t)(row0 + ai * HALF + m * 16) * ldc + col0;
#pragma unroll
                for (int bj = 0; bj < 2; ++bj) { f32x4 v0 = acc[ai][bj][m][0], v1 = acc[ai][bj][m][1];
                    if (ACT == 1) {
#pragma unroll
                        for (int e = 0; e < 4; ++e) { float a = v0[e] > 0.f ? v0[e] : 0.f; v0[e] = a * a; float b = v1[e] > 0.f ? v1[e] : 0.f; v1[e] = b * b; } }
                    u32x4 w; w.x = cvt_pk_bf16(v0[0], v0[1]); w.y = cvt_pk_bf16(v0[2], v0[3]); w.z = cvt_pk_bf16(v1[0], v1[1]); w.w = cvt_pk_bf16(v1[2], v1[3]);
                    *(u32x4*)(rowp + bj * HALF) = w; } }
    }
};
struct EpiRes {
    static constexpr bool PERM = false, AFTER_DRAIN = false;
    float* X; const float* gate; const float* Xc; const float* Xl;
    __device__ __forceinline__ void operator()(const f32x4 (&acc)[2][2][4][2], const Unit& u, int wr, int wc, int fr, int fq) const {
        const int row0 = u.pm * BM + wr * 64 + fr, col0 = u.pn * BM + wc * 32 + 4 * fq;
        const int cond = u.pm < 32 ? 0 : 1 + ((u.pm - 32) >> 2);
        const float* gp = gate + cond * 6144 + col0;
        f32x4 gv[2][2];
#pragma unroll
        for (int bj = 0; bj < 2; ++bj)
#pragma unroll
            for (int n = 0; n < 2; ++n) gv[bj][n] = *(const f32x4*)(gp + bj * HALF + n * 16);
#pragma unroll
        for (int ai = 0; ai < 2; ++ai)
#pragma unroll
            for (int m = 0; m < 4; ++m) { const size_t ro = (size_t)(row0 + ai * HALF + m * 16) * 1024 + col0; float* rowp = X + ro; const float* srcp = u.pm < 32 ? Xc + ro : Xl + (ro - (size_t)8192 * 1024);
#pragma unroll
                for (int bj = 0; bj < 2; ++bj)
#pragma unroll
                    for (int n = 0; n < 2; ++n) { *(f32x4*)(rowp + bj * HALF + n * 16) = *(const f32x4*)(srcp + bj * HALF + n * 16) + gv[bj][n] * acc[ai][bj][m][n]; }
                if (m & 1) asm volatile("" ::: "memory"); }
    }
};
struct EpiFnet {
    static constexpr bool PERM = true, AFTER_DRAIN = false;
    bf16_t* MIX; int rowbase, L;
    __device__ __forceinline__ void operator()(const f32x4 (&acc)[2][2][4][2], const Unit& u, int wr, int wc, int fr, int fq) const {
        const int row0 = u.pm * BM + wr * 64 + fr, colw = wc * 32 + 8 * fq;
        bf16_t* base = MIX + (size_t)(rowbase + u.pn * L) * 1024 + 512 + colw;
#pragma unroll
        for (int ai = 0; ai < 2; ++ai)
#pragma unroll
            for (int m = 0; m < 4; ++m) { bf16_t* rowp = base + (size_t)(row0 + ai * HALF + m * 16) * 1024;
#pragma unroll
                for (int bj = 0; bj < 2; ++bj) { const f32x4 v0 = acc[ai][bj][m][0], v1 = acc[ai][bj][m][1];
                    u32x4 w; w.x = cvt_pk_bf16(v0[0], v0[1]); w.y = cvt_pk_bf16(v0[2], v0[3]); w.z = cvt_pk_bf16(v1[0], v1[1]); w.w = cvt_pk_bf16(v1[2], v1[3]);
                    *(u32x4*)(rowp + bj * HALF) = w; } }
    }
};

__device__ __forceinline__ float xsum_fq(float s, int fr, int fq) {
    s += __builtin_bit_cast(float, __builtin_amdgcn_ds_bpermute((((fq ^ 1) << 4) | fr) << 2, __builtin_bit_cast(int, s)));
    s += __builtin_bit_cast(float, __builtin_amdgcn_ds_bpermute((((fq ^ 2) << 4) | fr) << 2, __builtin_bit_cast(int, s)));
    return s;
}
template <int ACT> struct EpiNormBf {
    static constexpr bool PERM = true, AFTER_DRAIN = false;
    bf16_t* O; int ldc; const float* ssq; const float* sw; int swld;
    __device__ __forceinline__ void operator()(const f32x4 (&acc)[2][2][4][2], const Unit& u, int wr, int wc, int fr, int fq) const {
        const int row0 = u.pm * BM + wr * 64 + fr, col0 = u.pn * BM + wc * 32 + 8 * fq;
        const int cond = u.pm < 32 ? 0 : 1 + ((u.pm - 32) >> 2);
        f32x4 sv[2][2];
#pragma unroll
        for (int bj = 0; bj < 2; ++bj)
#pragma unroll
            for (int n = 0; n < 2; ++n) sv[bj][n] = *(const f32x4*)(sw + (size_t)cond * swld + col0 + bj * HALF + 4 * n);
        float rs[2][4];
#pragma unroll
        for (int ai = 0; ai < 2; ++ai)
#pragma unroll
            for (int m = 0; m < 4; ++m) rs[ai][m] = ssq[row0 + ai * HALF + m * 16];
#pragma unroll
        for (int ai = 0; ai < 2; ++ai)
#pragma unroll
            for (int m = 0; m < 4; ++m) rs[ai][m] = __builtin_amdgcn_rsqf(rs[ai][m] * (1.0f / 1024.0f) + 1e-6f);
#pragma unroll
        for (int ai = 0; ai < 2; ++ai)
#pragma unroll
            for (int m = 0; m < 4; ++m) { const int row = row0 + ai * HALF + m * 16; bf16_t* rowp = O + (size_t)row * ldc + col0;
                const float rstd = rs[ai][m];
#pragma unroll
                for (int bj = 0; bj < 2; ++bj) { f32x4 v0 = acc[ai][bj][m][0] * rstd + sv[bj][0], v1 = acc[ai][bj][m][1] * rstd + sv[bj][1];
                    if (ACT == 1) {
#pragma unroll
                        for (int e = 0; e < 4; ++e) { float a = v0[e] > 0.f ? v0[e] : 0.f; v0[e] = a * a; float b = v1[e] > 0.f ? v1[e] : 0.f; v1[e] = b * b; } }
                    u32x4 w; w.x = cvt_pk_bf16(v0[0], v0[1]); w.y = cvt_pk_bf16(v0[2], v0[3]); w.z = cvt_pk_bf16(v1[0], v1[1]); w.w = cvt_pk_bf16(v1[2], v1[3]);
                    *(u32x4*)(rowp + bj * HALF) = w; }
                if (m & 1) asm volatile("" ::: "memory"); }
    }
};
struct EpiResNorm {
    static constexpr bool PERM = true, AFTER_DRAIN = false;
    float* X; const float* gate; const float* Xc; const float* Xl; bf16_t* H; const float* gn; const float* scl; float* ssq;
    __device__ __forceinline__ void operator()(const f32x4 (&acc)[2][2][4][2], const Unit& u, int wr, int wc, int fr, int fq) const {
        const int row0 = u.pm * BM + wr * 64 + fr, col0 = u.pn * BM + wc * 32 + 8 * fq;
        const int cond = u.pm < 32 ? 0 : 1 + ((u.pm - 32) >> 2);
        const float* src = u.pm < 32 ? Xc : Xl - (size_t)8192 * 1024;
        f32x4 gt[2][2], gs[2][2];
#pragma unroll
        for (int bj = 0; bj < 2; ++bj)
#pragma unroll
            for (int n = 0; n < 2; ++n) { const int col = col0 + bj * HALF + n * 4;
                gt[bj][n] = *(const f32x4*)(gate + cond * 6144 + col); gs[bj][n] = *(const f32x4*)(gn + col) * (*(const f32x4*)(scl + cond * 6144 + col) + 1.0f); }
#pragma unroll
        for (int ai = 0; ai < 2; ++ai)
#pragma unroll
            for (int m = 0; m < 4; ++m) { const int row = row0 + ai * HALF + m * 16; const unsigned ro = (unsigned)row * 1024u + (unsigned)col0;
                float sq = 0.f;
#pragma unroll
                for (int bj = 0; bj < 2; ++bj) { const unsigned o = ro + bj * HALF;
                    const f32x4 x0 = *(const f32x4*)(src + o) + gt[bj][0] * acc[ai][bj][m][0], x1 = *(const f32x4*)(src + o + 4) + gt[bj][1] * acc[ai][bj][m][1];
                    *(f32x4*)(X + o) = x0; *(f32x4*)(X + o + 4) = x1;
                    sq += ((x0[0] * x0[0] + x0[1] * x0[1]) + (x0[2] * x0[2] + x0[3] * x0[3])) + ((x1[0] * x1[0] + x1[1] * x1[1]) + (x1[2] * x1[2] + x1[3] * x1[3]));
                    const f32x4 h0 = x0 * gs[bj][0], h1 = x1 * gs[bj][1];
                    u32x4 w; w.x = cvt_pk_bf16(h0[0], h0[1]); w.y = cvt_pk_bf16(h0[2], h0[3]); w.z = cvt_pk_bf16(h1[0], h1[1]); w.w = cvt_pk_bf16(h1[2], h1[3]);
                    *(u32x4*)(H + o) = w; }
                const float t = xsum_fq(sq, fr, fq); if (fq == 0) atomicAdd(ssq + row, t);
                asm volatile("" ::: "memory"); }
    }
};
struct EpiAny {
    static constexpr bool AFTER_DRAIN = false;
    int mode; bool PERM; void* out; const float* aux; int i0, i1; const float* xc; const float* xl; bf16_t* h; const float* gn; const float* scl; float* ssq;
    __device__ __forceinline__ void operator()(const f32x4 (&acc)[2][2][4][2], const Unit& u, int wr, int wc, int fr, int fq) const {
        if (mode == 0) { const EpiBf<0> e{(bf16_t*)out, i0}; e(acc, u, wr, wc, fr, fq); }
        else if (mode == 2) { const EpiRes e{(float*)out, aux, xc, xl}; e(acc, u, wr, wc, fr, fq); }
        else if (mode == 3) { const EpiFnet e{(bf16_t*)out, i0, i1}; e(acc, u, wr, wc, fr, fq); }
        else if (mode == 4) { const EpiNormBf<0> e{(bf16_t*)out, i0, ssq, aux, i1}; e(acc, u, wr, wc, fr, fq); }
        else if (mode == 5) { const EpiNormBf<1> e{(bf16_t*)out, i0, ssq, aux, i1}; e(acc, u, wr, wc, fr, fq); }
        else { const EpiResNorm e{(float*)out, aux, xc, xl, h, gn, scl, ssq}; e(acc, u, wr, wc, fr, fq); }
    }
};
template <class Epi, class Sched, bool ALIGN_EPI = false, bool SP2 = false>
__device__ __forceinline__ void gemm_phase(PG8_LAS unsigned char* lds, const Gemm g, const Sched& S, const Epi& E) {
    const int tid = opaque_tid(), wid = __builtin_amdgcn_readfirstlane(tid >> 6), lane = tid & 63, wr = wid >> 2, wc = wid & 3, fr = lane & 15, fq = lane >> 4;
    const int K = g.K, nt = K / BK;
    unsigned voffA[2], voffB[2];
#pragma unroll
    for (int i = 0; i < 2; ++i) { int R, C; stage_rc(tid * 16 + i * 8192, R, C); const int Rb = E.PERM ? ((R & ~31) + perm32(R & 31)) : R;
        voffA[i] = (unsigned)(R * g.lda + C) * 2u; voffB[i] = (unsigned)(Rb * g.ldb + C) * 2u; }
    const size_t kstep = (size_t)(BK * 2);
    const size_t hstepA = (size_t)HALF * g.lda * 2, hstepB = (size_t)HALF * g.ldb * 2;
    const size_t tstepA = 2 * hstepA, tstepB = 2 * hstepB;
    const unsigned ldsw = (unsigned)wid * 1024u;
    const int aoff = lds_byte(wr * 64 + fr, fq * 8), boff = lds_byte(wc * 32 + fr, fq * 8);
#define PG8_SA(b, h) (((b) * 2 + (h)) * HTB)
#define PG8_SB(b, h) ((4 + (b) * 2 + (h)) * HTB)
#define PG8_STAGE(bufoff, gbase, voff) do { _Pragma("unroll") for (int _i = 0; _i < 2; ++_i) \
        __builtin_amdgcn_global_load_lds((const unsigned*)((const char*)(gbase) + (voff)[_i]), (PG8_LAS unsigned*)(lds + (bufoff) + ldsw + _i * 8192), 16, 0, 0); } while (0)
#define PG8_LDA(dst, b, h) do { _Pragma("unroll") for (int m = 0; m < 4; ++m) _Pragma("unroll") for (int k = 0; k < 2; ++k) dst[m][k] = *(const PG8_LAS bf16x8*)(lds + PG8_SA(b, h) + aoff + m * 2048 + k * 1024); } while (0)
#define PG8_LDB(dst, b, h) do { _Pragma("unroll") for (int n = 0; n < 2; ++n) _Pragma("unroll") for (int k = 0; k < 2; ++k) dst[n][k] = *(const PG8_LAS bf16x8*)(lds + PG8_SB(b, h) + boff + n * 2048 + k * 1024); } while (0)
#define PG8_MMA(ai, bj, At, Bt) do { __builtin_amdgcn_s_setprio(1); _Pragma("unroll") for (int m = 0; m < 4; ++m) _Pragma("unroll") for (int n = 0; n < 2; ++n) _Pragma("unroll") for (int k = 0; k < 2; ++k) \
        acc[ai][bj][m][n] = __builtin_amdgcn_mfma_f32_16x16x32_bf16(Bt[n][k], At[m][k], acc[ai][bj][m][n], 0, 0, 0); __builtin_amdgcn_s_setprio(0); } while (0)
#define PG8_WAIT_V(n) asm volatile("s_waitcnt vmcnt(" #n ")" ::: "memory")
#define PG8_WAIT_L(n) asm volatile("s_waitcnt lgkmcnt(" #n ")" ::: "memory")
#define PG8_BAR __builtin_amdgcn_s_barrier()
#define PG8_SCHED __builtin_amdgcn_sched_barrier(0)
    Unit cur, nxt; int ui = 0;
    if (!S.next(0, cur)) return;
    f32x4 acc[2][2][4][2];
#pragma unroll
    for (int a = 0; a < 2; ++a)
#pragma unroll
        for (int b = 0; b < 2; ++b)
#pragma unroll
            for (int m = 0; m < 4; ++m)
#pragma unroll
                for (int n = 0; n < 2; ++n) acc[a][b][m][n] = (f32x4){0.f, 0.f, 0.f, 0.f};
    bf16x8 At[4][2], B0[2][2], B1[2][2];
    const char* cA = (const char*)g.A + (size_t)cur.pm * tstepA; const char* cB = (const char*)g.Bt + (size_t)cur.pn * tstepB;
    S.a_ready(cur);
    if constexpr (SP2) {
        PG8_STAGE(PG8_SB(0, 0), cB, voffB); PG8_STAGE(PG8_SB(0, 1), cB + hstepB, voffB); PG8_STAGE(PG8_SA(0, 0), cA, voffA); PG8_STAGE(PG8_SA(0, 1), cA + hstepA, voffA);
        if (wr == 1) PG8_BAR;
        PG8_WAIT_V(2); PG8_BAR;
        PG8_STAGE(PG8_SB(1, 0), cB + kstep, voffB); PG8_STAGE(PG8_SA(1, 0), cA + kstep, voffA); PG8_STAGE(PG8_SB(1, 1), cB + hstepB + kstep, voffB);
        PG8_WAIT_V(6); PG8_BAR;
    } else {
        PG8_STAGE(PG8_SB(0, 0), cB, voffB); PG8_STAGE(PG8_SA(0, 0), cA, voffA); PG8_STAGE(PG8_SB(0, 1), cB + hstepB, voffB); PG8_STAGE(PG8_SA(0, 1), cA + hstepA, voffA);
        if (wr == 1) PG8_BAR;
        PG8_WAIT_V(4); PG8_BAR;
        PG8_STAGE(PG8_SB(1, 0), cB + kstep, voffB); PG8_STAGE(PG8_SA(1, 0), cA + kstep, voffA); PG8_STAGE(PG8_SB(1, 1), cB + hstepB + kstep, voffB);
        PG8_WAIT_V(6); PG8_BAR;
    }
    for (;;) {
        const bool has_next = S.next(ui + 1, nxt);
        const char* nA = has_next ? (const char*)g.A + (size_t)nxt.pm * tstepA : cA; const char* nB = has_next ? (const char*)g.Bt + (size_t)nxt.pn * tstepB : cB;
        for (int t = 0; t < nt; t += 2) {
            const bool last = (t == nt - 2);
            const char* a1 = cA + (size_t)(t + 1) * kstep;
            const char* a2 = last ? nA : cA + (size_t)(t + 2) * kstep; const char* b2 = last ? nB : cB + (size_t)(t + 2) * kstep;
            const char* a3 = a2 + kstep; const char* b3 = b2 + kstep;
            if (last && has_next) S.a_ready(nxt);
            if constexpr (SP2) {
            PG8_LDB(B0, 0, 0); PG8_LDB(B1, 0, 1); PG8_SCHED; PG8_LDA(At, 0, 0); PG8_STAGE(PG8_SA(1, 1), a1 + hstepA, voffA);
            PG8_WAIT_V(8); PG8_WAIT_L(0); PG8_BAR; PG8_MMA(0, 0, At, B0); PG8_MMA(0, 1, At, B1); PG8_BAR; PG8_SCHED;
            PG8_LDA(At, 0, 1); PG8_STAGE(PG8_SB(0, 0), b2, voffB); PG8_STAGE(PG8_SB(0, 1), b2 + hstepB, voffB); PG8_STAGE(PG8_SA(0, 0), a2, voffA);
            PG8_WAIT_V(8); PG8_WAIT_L(0); PG8_BAR; PG8_MMA(1, 0, At, B0); PG8_MMA(1, 1, At, B1); PG8_BAR; PG8_SCHED;
            PG8_LDB(B0, 1, 0); PG8_LDB(B1, 1, 1); PG8_SCHED; PG8_LDA(At, 1, 0); PG8_STAGE(PG8_SA(0, 1), a2 + hstepA, voffA);
            PG8_WAIT_V(8); PG8_WAIT_L(0); PG8_BAR; PG8_MMA(0, 0, At, B0); PG8_MMA(0, 1, At, B1); PG8_BAR; PG8_SCHED;
            PG8_LDA(At, 1, 1); PG8_STAGE(PG8_SB(1, 0), b3, voffB); PG8_STAGE(PG8_SB(1, 1), b3 + hstepB, voffB); PG8_STAGE(PG8_SA(1, 0), a3, voffA);
            PG8_WAIT_V(8); PG8_WAIT_L(0); PG8_BAR; PG8_MMA(1, 0, At, B0); PG8_MMA(1, 1, At, B1); PG8_BAR; PG8_SCHED;
            } else {
            PG8_LDB(B0, 0, 0); PG8_SCHED; PG8_LDA(At, 0, 0); PG8_STAGE(PG8_SA(1, 1), a1 + hstepA, voffA);
            PG8_WAIT_L(8); PG8_BAR; PG8_WAIT_L(0); PG8_MMA(0, 0, At, B0); PG8_BAR; PG8_SCHED;
            PG8_LDB(B1, 0, 1); PG8_STAGE(PG8_SB(0, 0), b2, voffB);
            PG8_BAR; PG8_WAIT_L(0); PG8_MMA(0, 1, At, B1); PG8_BAR;
            PG8_LDA(At, 0, 1); PG8_STAGE(PG8_SA(0, 0), a2, voffA);
            PG8_BAR; PG8_WAIT_L(0); PG8_MMA(1, 0, At, B0); PG8_BAR; PG8_SCHED;
            PG8_STAGE(PG8_SB(0, 1), b2 + hstepB, voffB);
            PG8_WAIT_V(6); PG8_BAR; PG8_MMA(1, 1, At, B1); PG8_BAR;
            PG8_LDB(B0, 1, 0); PG8_SCHED; PG8_LDA(At, 1, 0); PG8_STAGE(PG8_SA(0, 1), a2 + hstepA, voffA);
            PG8_WAIT_L(8); PG8_BAR; PG8_WAIT_L(0); PG8_MMA(0, 0, At, B0); PG8_BAR; PG8_SCHED;
            PG8_LDB(B1, 1, 1); PG8_STAGE(PG8_SB(1, 0), b3, voffB);
            PG8_BAR; PG8_WAIT_L(0); PG8_MMA(0, 1, At, B1); PG8_BAR;
            PG8_LDA(At, 1, 1); PG8_STAGE(PG8_SA(1, 0), a3, voffA);
            PG8_BAR; PG8_WAIT_L(0); PG8_MMA(1, 0, At, B0); PG8_BAR; PG8_SCHED;
            PG8_STAGE(PG8_SB(1, 1), b3 + hstepB, voffB);
            PG8_WAIT_V(6); PG8_BAR; PG8_MMA(1, 1, At, B1); PG8_BAR;
            }
        }
        if constexpr (ALIGN_EPI) { if (wr == 0) PG8_BAR; }
        if constexpr (!Epi::AFTER_DRAIN) { int fr2 = fr, fq2 = fq; asm volatile("" : "+v"(fr2), "+v"(fq2)); E(acc, cur, wr, wc, fr2, fq2); S.done(cur); }
        if (!has_next) break;
#pragma unroll
        for (int a = 0; a < 2; ++a)
#pragma unroll
            for (int b = 0; b < 2; ++b)
#pragma unroll
                for (int m = 0; m < 4; ++m)
#pragma unroll
                    for (int n = 0; n < 2; ++n) acc[a][b][m][n] = (f32x4){0.f, 0.f, 0.f, 0.f};
        cur = nxt; cA = nA; cB = nB; ++ui;
        if constexpr (ALIGN_EPI) { if (wr == 1) PG8_BAR; }
    }
    PG8_WAIT_V(0);
    if constexpr (!ALIGN_EPI) { if (wr == 0) PG8_BAR; }
    PG8_BAR;
    if constexpr (Epi::AFTER_DRAIN) { E.fused(acc, cur, wr, wc, fr, fq, lds, wid, lane); S.done(cur); }
#undef PG8_SA
#undef PG8_SB
#undef PG8_STAGE
#undef PG8_LDA
#undef PG8_LDB
#undef PG8_MMA
#undef PG8_WAIT_V
#undef PG8_WAIT_L
#undef PG8_BAR
#undef PG8_SCHED
}
}

#define LAS __attribute__((address_space(3)))
typedef unsigned short bf16;
typedef float f32x4 __attribute__((ext_vector_type(4)));
typedef unsigned u32x4 __attribute__((ext_vector_type(4)));
typedef unsigned u32x2 __attribute__((ext_vector_type(2)));
constexpr int DM = 1024, NCTX = 8192, MTOK = 12288, DINP = 2560, DFF = 4096;
constexpr int R_OFF = 0, K_OFF = 512, V_OFF = 1024, WD_OFF = 1536, AD_OFF = 1664, GD_OFF = 1792, F_OFF = 1920, P_OFF = 2176, DIN = 2432;
constexpr size_t MiB = 1u << 20;
constexpr size_t WS_CTL = 0, WS_MOD = 1 * MiB, WS_FW = 1 * MiB + 512 * 1024, WS_BC = 2 * MiB, WS_CS256 = 3 * MiB, WS_CS1024 = 4 * MiB, WS_WIN = 8 * MiB, WS_WOUT = 18 * MiB,
                 WS_W1 = 22 * MiB, WS_W2 = 38 * MiB, WS_H = 54 * MiB, WS_MIXED = 78 * MiB, WS_PROJ = 102 * MiB, WS_YCS = 162 * MiB, WS_YF = 102 * MiB, WS_YB = 126 * MiB  , WS_U = 174 * MiB, WS_KINV = 220 * MiB, WS_GUPT = 221 * MiB,
                 WS_FF = 102 * MiB, WS_WUPT = 222 * MiB, WS_AUPT = 222 * MiB + 256 * 1024, WS_SSQ = 223 * MiB, WS_WPT = 223 * MiB + 512 * 1024, WS_SW1 = 224 * MiB, WS_SWIN = 224 * MiB + 256 * 1024, WS_END = 225 * MiB;
constexpr int LDS_BYTES = 147456, RING_BYTES = 131072, MISC_OFF = RING_BYTES + 320;
constexpr int NTHR = 512;
enum { I_XP = 0, I_XS, I_STATE, I_C, I_CCTX, I_WADA, I_BADA, I_N1G, I_WIN, I_MU, I_W0, I_WUP, I_A0, I_AUP, I_GUP, I_KK, I_KA, I_RK, I_LNW, I_LNB, I_WFNET, I_WPOOL, I_PSCALE, I_WOUT, I_N2G, I_WFF1, I_WFF2, I_FNG, N_IN };
struct KP { const float* in[N_IN]; float* out; unsigned char* ws; int ph_lo, ph_hi; };
typedef const __attribute__((address_space(4))) KP CKP;

__device__ __forceinline__ unsigned f2bf(float f) { unsigned u = __builtin_bit_cast(unsigned, f); return (u + 0x7fffu + ((u >> 16) & 1u)) >> 16; }
__device__ __forceinline__ unsigned pk2(float lo, float hi) { return f2bf(lo) | (f2bf(hi) << 16); }
__device__ __forceinline__ float bflo(unsigned w) { return __builtin_bit_cast(float, w << 16); }
__device__ __forceinline__ float bfhi(unsigned w) { return __builtin_bit_cast(float, w & 0xffff0000u); }
__device__ __forceinline__ float bf1(bf16 h) { return __builtin_bit_cast(float, (unsigned)h << 16); }
__device__ __forceinline__ float fexp(float x) { return __builtin_amdgcn_exp2f(x * 1.4426950408889634f); }
__device__ __forceinline__ float flog(float x) { return __builtin_amdgcn_logf(x) * 0.6931471805599453f; }
__device__ __forceinline__ float frcp(float x) { return __builtin_amdgcn_rcpf(x); }
__device__ __forceinline__ float frsq(float x) { return __builtin_amdgcn_rsqf(x); }
__device__ __forceinline__ float fsigmoid(float x) { return frcp(1.0f + fexp(-x)); }
template <int CTRL> __device__ __forceinline__ float dppf(float x) { return __builtin_bit_cast(float, __builtin_amdgcn_update_dpp(0, __builtin_bit_cast(int, x), CTRL, 0xF, 0xF, true)); }
__device__ __forceinline__ float red8(float x)  { x += dppf<0xB1>(x); x += dppf<0x4E>(x); x += dppf<0x141>(x); return x; }
__device__ __forceinline__ float red16(float x) { x += dppf<0xB1>(x); x += dppf<0x4E>(x); x += dppf<0x141>(x); x += dppf<0x140>(x); return x; }
__device__ __forceinline__ float wave_sum(float v) {
    v = red16(v);
    const float s0 = __builtin_bit_cast(float, __builtin_amdgcn_readlane(__builtin_bit_cast(int, v), 0)), s1 = __builtin_bit_cast(float, __builtin_amdgcn_readlane(__builtin_bit_cast(int, v), 16));
    const float s2 = __builtin_bit_cast(float, __builtin_amdgcn_readlane(__builtin_bit_cast(int, v), 32)), s3 = __builtin_bit_cast(float, __builtin_amdgcn_readlane(__builtin_bit_cast(int, v), 48));
    return (s0 + s1) + (s2 + s3);
}
__device__ __forceinline__ void load4bf(const bf16* p, float (&o)[4]) { const u32x2 w = *(const u32x2*)p; o[0] = bflo(w.x); o[1] = bfhi(w.x); o[2] = bflo(w.y); o[3] = bfhi(w.y); }
__device__ __forceinline__ void load8bf(const bf16* p, float (&o)[8]) { const u32x4 w = *(const u32x4*)p; o[0] = bflo(w.x); o[1] = bfhi(w.x); o[2] = bflo(w.y); o[3] = bfhi(w.y); o[4] = bflo(w.z); o[5] = bfhi(w.z); o[6] = bflo(w.w); o[7] = bfhi(w.w); }
__device__ __forceinline__ void shift4(const bf16* proj, int row, bool hasp, bool hasn, int col, const float* mu, float (&u)[4]) {
    float p[4], a[4] = {0.f, 0.f, 0.f, 0.f}, b[4] = {0.f, 0.f, 0.f, 0.f};
    load4bf(proj + (size_t)row * DINP + col, p);
    if (hasp) load4bf(proj + (size_t)(row - 1) * DINP + col, a);
    if (hasn) load4bf(proj + (size_t)(row + 1) * DINP + col, b);
    const f32x4 m = *(const f32x4*)(mu + col);
#pragma unroll
    for (int j = 0; j < 4; ++j) u[j] = p[j] + m[j] * (0.5f * (a[j] + b[j]) - p[j]);
}

__device__ __forceinline__ void transpose_item(const float* W, int K, int N, bf16* WT, LAS float* scr, int item, int lane) {
    const int nblk = N / 32, kb = item / nblk, nb = item % nblk, k0 = 64 * kb, n0 = 32 * nb;
#pragma unroll 8
    for (int i = 0; i < 32; ++i) { const int kk = 2 * i + (lane >> 5); scr[kk * 33 + (lane & 31)] = W[(size_t)(k0 + kk) * N + n0 + (lane & 31)]; }
    asm volatile("s_waitcnt lgkmcnt(0)" ::: "memory");
    const int c = lane & 7;
#pragma unroll
    for (int j = 0; j < 4; ++j) { const int n = (lane >> 3) + 8 * j; const LAS float* s = scr + (8 * c) * 33 + n;
        u32x4 o; o.x = pk2(s[0 * 33], s[1 * 33]); o.y = pk2(s[2 * 33], s[3 * 33]); o.z = pk2(s[4 * 33], s[5 * 33]); o.w = pk2(s[6 * 33], s[7 * 33]);
        *(u32x4*)(WT + (size_t)(n0 + n) * K + k0 + 8 * c) = o; }
    asm volatile("s_waitcnt lgkmcnt(0)" ::: "memory");
}
__device__ __forceinline__ void gemv5_cols(LAS float* sc, LAS float* red, const float* W, int ldw, int colw, const float* bias, float* out, int ldo, int colo, int tid) {
    const int cgi = tid & 15, kg = tid >> 4;
    f32x4 acc[5];
#pragma unroll
    for (int c = 0; c < 5; ++c) acc[c] = (f32x4){0.f, 0.f, 0.f, 0.f};
    const float* wp = W + (size_t)(kg * 32) * ldw + colw + cgi * 4;
#pragma unroll 8
    for (int kk = 0; kk < 32; ++kk) { const f32x4 w = *(const f32x4*)(wp + (size_t)kk * ldw);
#pragma unroll
        for (int c = 0; c < 5; ++c) acc[c] += sc[c * 1024 + kg * 32 + kk] * w; }
#pragma unroll
    for (int c = 0; c < 5; ++c) *(LAS f32x4*)(red + (kg * 5 + c) * 64 + cgi * 4) = acc[c];
    __syncthreads();
    if (tid < 320) { const int cond = tid >> 6, col = tid & 63; float sm = bias ? bias[colo + col] : 0.f;
        for (int g = 0; g < 32; ++g) sm += red[(g * 5 + cond) * 64 + col];
        out[(size_t)cond * ldo + colo + col] = sm; }
    __syncthreads();
}
constexpr int TI_IN = 16 * 76, TI_OUT = 16 * 32, TI_1 = 16 * 128, TI_2 = 64 * 32, TI_L = TI_IN + TI_OUT + TI_1 + TI_2;
__device__ __forceinline__ void transpose_range(CKP& p, LAS unsigned char* lds, int first, int last, int bid, int nb) {
    const int tid = opaque_tid(), lane = tid & 63, wave = tid >> 6;
    unsigned char* ws = p.ws;
    LAS float* scr = (LAS float*)(lds + wave * 16384);
#pragma unroll 1
    for (int it = first + bid * 8 + wave; it < last; it += nb * 8) {
        const int l = it / TI_L; int r = it % TI_L;
        if (r < TI_IN) { transpose_item(p.in[I_WIN] + (size_t)l * DM * DIN, DM, DIN, (bf16*)(ws + WS_WIN) + (size_t)l * DINP * DM, scr, r, lane); continue; } r -= TI_IN;
        if (r < TI_OUT) { transpose_item(p.in[I_WOUT] + (size_t)l * DM * DM, DM, DM, (bf16*)(ws + WS_WOUT) + (size_t)l * DM * DM, scr, r, lane); continue; } r -= TI_OUT;
        if (r < TI_1) { transpose_item(p.in[I_WFF1] + (size_t)l * DM * DFF, DM, DFF, (bf16*)(ws + WS_W1) + (size_t)l * DFF * DM, scr, r, lane); continue; } r -= TI_1;
        transpose_item(p.in[I_WFF2] + (size_t)l * DFF * DM, DFF, DM, (bf16*)(ws + WS_W2) + (size_t)l * DM * DFF, scr, r, lane);
    }
}
__device__ __forceinline__ void stage_prologue(CKP& p, LAS unsigned char* lds, int bid, int nb) {
    const int tid = opaque_tid();
    unsigned char* ws = p.ws;
    transpose_range(p, lds, 0, TI_IN, bid, nb);
    const int gt = bid * NTHR + tid, NGT = nb * NTHR;
#pragma unroll 1
    for (int i = gt; i < 2 * 128 * DM / 8; i += NGT) { const int l = i / (128 * DM / 8), r = i % (128 * DM / 8);
        u32x4 z = (u32x4){0u, 0u, 0u, 0u}; asm volatile("" : "+v"(z));
        *(u32x4*)((bf16*)(ws + WS_WIN) + (size_t)l * DINP * DM + (size_t)DIN * DM + (size_t)r * 8) = z; }
#pragma unroll 1
    for (int i = gt; i < 256 * 512 + 1024 * 2048; i += NGT) {
        int L, k, j; bf16* dst;
        if (i < 256 * 512) { L = 256; k = i / 512; j = i % 512; dst = (bf16*)(ws + WS_CS256) + i; }
        else { const int i2 = i - 256 * 512; L = 1024; k = i2 / 2048; j = i2 % 2048; dst = (bf16*)(ws + WS_CS1024) + i2; }
        const int jj = j >= L ? j - L : j; const int idx = (k * jj) & (L - 1);
        const float rev = (float)idx / (float)L; const float s = __builtin_amdgcn_sinf(rev), c = __builtin_amdgcn_cosf(rev);
        *dst = (bf16)f2bf(j >= L ? -s : c);
    }
#pragma unroll 1
    for (int i = gt; i < 2 * 4 * 64 * 128; i += NGT) {
        const int o = i & 127, c = (i >> 7) & 63, lg = i >> 13; const float* wf = p.in[I_WFNET] + (size_t)lg * 4096 + (o & 63);
        float acc = 0.f;
        for (int cp = 0; cp < 64; ++cp) { const float rev = (float)((c * cp) & 63) * (1.0f / 64.0f); const float s = __builtin_amdgcn_sinf(rev), co = __builtin_amdgcn_cosf(rev); acc += (o < 64 ? co : s) * wf[cp * 64]; }
        ((bf16*)(ws + WS_FW))[(size_t)(lg * 128 + o) * 64 + c] = (bf16)f2bf(acc);
    }
#pragma unroll 1
    for (int i = gt; i < 2 * 4 * 64 * 64; i += NGT) { const int o = i & 63, c = (i >> 6) & 63, lg = i >> 12;
        ((bf16*)(ws + WS_WPT))[(size_t)(lg * 64 + o) * 64 + c] = (bf16)f2bf(p.in[I_WPOOL][i]); }
#pragma unroll 1
    for (int i = gt; i < 2 * 2 * 64 * 512; i += NGT) { const int c = i & 511, r = (i >> 9) & 63, ld = i >> 15;
        ((bf16*)(ws + WS_WUPT))[(size_t)(ld * 512 + c) * 64 + r] = (bf16)f2bf(p.in[I_WUP][i]);
        ((bf16*)(ws + WS_AUPT))[(size_t)(ld * 512 + c) * 64 + r] = (bf16)f2bf(p.in[I_AUP][i]); }
#pragma unroll 1
    for (int i = gt; i < 2 * 128 * 512; i += NGT) { const int c = i & 511, r = (i >> 9) & 127, ll = i >> 16;
        ((bf16*)(ws + WS_GUPT))[(size_t)(ll * 512 + c) * 128 + r] = (bf16)f2bf(p.in[I_GUP][i]); }
    __syncthreads();
    LAS float* sc = (LAS float*)lds; LAS float* red = (LAS float*)(lds + 20480);
#pragma unroll 1
    for (int it = bid; it < 192; it += nb) {
        const int l = it / 96, cgp = it % 96;
        for (int i = tid; i < 5 * 1024; i += NTHR) { const int cond = i >> 10, k = i & 1023; const float v = cond == 0 ? p.in[I_CCTX][k] : p.in[I_C][(cond - 1) * 1024 + k]; sc[i] = v * fsigmoid(v); }
        __syncthreads();
        gemv5_cols(sc, red, p.in[I_WADA] + (size_t)l * 1024 * 6144, 6144, cgp * 64, p.in[I_BADA] + l * 6144, (float*)(ws + WS_MOD) + (size_t)l * 5 * 6144, 6144, cgp * 64, tid);
    }
}
__device__ __forceinline__ void stage_shiftw(CKP& p, LAS unsigned char* lds, int bid, int nb) {
    const int tid = opaque_tid();
    unsigned char* ws = p.ws;
    LAS float* sc = (LAS float*)lds; LAS float* red = (LAS float*)(lds + 20480);
    __syncthreads();
#pragma unroll 1
    for (int it = bid; it < 166; it += nb) {
        const bool isin = it >= 128; const int l = isin ? 1 : it >> 6, blk = isin ? it - 128 : it & 63;
        const float* shv = (const float*)(ws + WS_MOD) + (size_t)l * 5 * 6144 + (isin ? 0 : 3 * 1024);
        for (int i = tid; i < 5 * 1024; i += NTHR) sc[i] = shv[(i >> 10) * 6144 + (i & 1023)];
        __syncthreads();
        if (isin) gemv5_cols(sc, red, p.in[I_WIN] + (size_t)DM * DIN, DIN, blk * 64, nullptr, (float*)(ws + WS_SWIN), DINP, blk * 64, tid);
        else gemv5_cols(sc, red, p.in[I_WFF1] + (size_t)l * DM * DFF, DFF, blk * 64, nullptr, (float*)(ws + WS_SW1) + (size_t)l * 5 * DFF, DFF, blk * 64, tid);
    }
    if (bid == 0) for (int i = tid; i < 5 * 128; i += NTHR) ((float*)(ws + WS_SWIN))[(i >> 7) * DINP + DIN + (i & 127)] = 0.f;
}

__device__ __forceinline__ void stage_norm(CKP& p, int l, int which, int bid, int nb) {
    const int tid = opaque_tid(), lane = tid & 63, wave = tid >> 6;
    const float* g = p.in[which ? I_N2G : I_N1G] + l * DM;
    const float* mod = (const float*)(p.ws + WS_MOD) + (size_t)l * 5 * 6144 + (which ? 3 * 1024 : 0);
    bf16* H = (bf16*)(p.ws + WS_H);
#pragma unroll 1
    for (int row = bid * 8 + wave; row < MTOK; row += nb * 8) {
        const float* xsrc = (l == 0 && which == 0) ? (row < NCTX ? p.in[I_XP] + (size_t)row * DM : p.in[I_XS] + (size_t)(row - NCTX) * DM) : p.out + (size_t)row * DM;
        const f32x4* xr = (const f32x4*)xsrc + lane;
        f32x4 v[4]; float s = 0.f;
#pragma unroll
        for (int j = 0; j < 4; ++j) { v[j] = xr[64 * j]; s += (v[j].x * v[j].x + v[j].y * v[j].y) + (v[j].z * v[j].z + v[j].w * v[j].w); }
        const float rstd = frsq(wave_sum(s) * (1.0f / DM) + 1e-6f);
        const int cond = row < NCTX ? 0 : 1 + ((row - NCTX) >> 10);
        const float* sh = mod + cond * 6144; const float* scl = sh + 1024;
        unsigned long long* o8 = (unsigned long long*)(H + (size_t)row * DM) + lane;
#pragma unroll
        for (int j = 0; j < 4; ++j) { const int col = 4 * lane + 256 * j; const f32x4 gg = *(const f32x4*)(g + col), a = *(const f32x4*)(sh + col), b = *(const f32x4*)(scl + col);
            const f32x4 y = v[j] * rstd * gg * (b + 1.0f) + a;
            o8[64 * j] = (unsigned long long)pk2(y.x, y.y) | ((unsigned long long)pk2(y.z, y.w) << 32); }
    }
}
__device__ __forceinline__ void stage_final(CKP& p, int bid, int nb) {
    const int tid = opaque_tid(), lane = tid & 63, wave = tid >> 6;
    const float* g = p.in[I_FNG];
#pragma unroll 1
    for (int row = bid * 8 + wave; row < MTOK; row += nb * 8) {
        f32x4* xr = (f32x4*)(p.out + (size_t)row * DM) + lane;
        f32x4 v[4]; float s = 0.f;
#pragma unroll
        for (int j = 0; j < 4; ++j) { v[j] = xr[64 * j]; s += (v[j].x * v[j].x + v[j].y * v[j].y) + (v[j].z * v[j].z + v[j].w * v[j].w); }
        const float rstd = frsq(wave_sum(s) * (1.0f / DM) + 1e-6f);
#pragma unroll
        for (int j = 0; j < 4; ++j) xr[64 * j] = v[j] * rstd * *(const f32x4*)(g + 4 * lane + 256 * j);
    }
}


typedef short bf16x8 __attribute__((ext_vector_type(8)));
typedef float f32x2v __attribute__((ext_vector_type(2)));
typedef __bf16 bf16x2v __attribute__((ext_vector_type(2)));
#define MFMA16(a, b, c) __builtin_amdgcn_mfma_f32_16x16x32_bf16((a), (b), (c), 0, 0, 0)
__device__ __forceinline__ unsigned cvt2(float lo, float hi) { f32x2v v = {lo, hi}; bf16x2v b = __builtin_convertvector(v, bf16x2v); return __builtin_bit_cast(unsigned, b); }
__device__ __forceinline__ u32x4 pack8(const float (&x)[8]) { u32x4 w; w.x = cvt2(x[0], x[1]); w.y = cvt2(x[2], x[3]); w.z = cvt2(x[4], x[5]); w.w = cvt2(x[6], x[7]); return w; }
__device__ __forceinline__ void shift8(const bf16* proj, int row, bool hasp, bool hasn, int col, const float* mu, float (&u)[8]) {
    float p[8], a[8], b[8];
    load8bf(proj + (size_t)row * DINP + col, p);
    if (hasp) load8bf(proj + (size_t)(row - 1) * DINP + col, a); else {
#pragma unroll
        for (int j = 0; j < 8; ++j) a[j] = 0.f; }
    if (hasn) load8bf(proj + (size_t)(row + 1) * DINP + col, b); else {
#pragma unroll
        for (int j = 0; j < 8; ++j) b[j] = 0.f; }
    const f32x4 m0 = *(const f32x4*)(mu + col), m1 = *(const f32x4*)(mu + col + 4);
#pragma unroll
    for (int j = 0; j < 4; ++j) { u[j] = p[j] + m0[j] * (0.5f * (a[j] + b[j]) - p[j]); u[4 + j] = p[4 + j] + m1[j] * (0.5f * (a[4 + j] + b[4 + j]) - p[4 + j]); }
}
__device__ __forceinline__ int opq(int x) { asm volatile("" : "+v"(x)); return x; }
constexpr int TS = 72, TB = 64 * TS * 2;
constexpr int L_HT = 0, L_TW = 9216, L_AD = 18432, L_LP = 27648, L_AP = 45056, L_AT = 62464, L_RT = L_AT + TB, L_BH = L_RT + TB, L_KH = L_BH + TB, L_VR = L_KH + TB, L_YS = L_VR + TB;
constexpr int L_AAB = L_TW, L_AAK = L_AAB + 4096, L_ARB = L_AAK + 3072, L_ARK = L_ARB + 3072, L_UT = L_ARK + 3072, L_W1 = L_AP;
static_assert(L_UT + 64 * 24 * 2 <= L_LP && L_YS + 17408 <= RING_BYTES, "scan LDS map");
constexpr int LPS = 68;
#define LBAR() asm volatile("s_waitcnt lgkmcnt(0)\n\ts_barrier" ::: "memory")
typedef short s16x4v __attribute__((ext_vector_type(4)));
__device__ __forceinline__ bf16x8 tr8(const LAS bf16* p) {
    const s16x4v lo = __builtin_bit_cast(s16x4v, __builtin_amdgcn_ds_read_tr16_b64_v4i16((LAS s16x4v*)p));
    const s16x4v hi = __builtin_bit_cast(s16x4v, __builtin_amdgcn_ds_read_tr16_b64_v4i16((LAS s16x4v*)(p + 4 * TS)));
    return (bf16x8){lo[0], lo[1], lo[2], lo[3], hi[0], hi[1], hi[2], hi[3]};
}

__device__ __forceinline__ void rwkv_item3(CKP& p, int l, LAS unsigned char* lds, int item) {
    const int tid0 = opaque_tid(), w = __builtin_amdgcn_readfirstlane(tid0 >> 6);
    int tid = tid0, fr = tid & 15, fg = (tid & 63) >> 4;
    int bseq, h, dir, L, base; bool lat;
    if (item < 64) { lat = true; bseq = item >> 4; h = (item >> 1) & 7; dir = item & 1; L = 1024; base = NCTX + bseq * 1024; }
    else { const int i2 = item - 64; lat = false; bseq = i2 >> 4; h = (i2 >> 1) & 7; dir = i2 & 1; L = 256; base = bseq * 256; }
    const bf16* U = (const bf16*)(p.ws + WS_U);
    const float* KINV = (const float*)(p.ws + WS_KINV);
    float* Yout = (float*)(p.ws + (dir ? WS_YB : WS_YF));
    float* BC = (float*)(p.ws + WS_BC) + (size_t)dir * MTOK * 8;
    const bf16* wupt = (const bf16*)(p.ws + WS_WUPT) + ((size_t)(l * 2 + dir) * 512 + h * 64) * 64;
    const bf16* aupt = (const bf16*)(p.ws + WS_AUPT) + ((size_t)(l * 2 + dir) * 512 + h * 64) * 64;
    LAS bf16* TW = (LAS bf16*)(lds + L_TW);   LAS bf16* AD = (LAS bf16*)(lds + L_AD);
    LAS float* LP = (LAS float*)(lds + L_LP); LAS float* AP = (LAS float*)(lds + L_AP);
    LAS bf16* AT = (LAS bf16*)(lds + L_AT);   LAS bf16* RT = (LAS bf16*)(lds + L_RT);   LAS bf16* BH = (LAS bf16*)(lds + L_BH);   LAS bf16* KH = (LAS bf16*)(lds + L_KH);
    LAS bf16* VR = (LAS bf16*)(lds + L_VR);   LAS float* YS = (LAS float*)(lds + L_YS);
    LAS float* AAB = (LAS float*)(lds + L_AAB); LAS bf16* AAK = (LAS bf16*)(lds + L_AAK); LAS bf16* ARB = (LAS bf16*)(lds + L_ARB); LAS bf16* ARK = (LAS bf16*)(lds + L_ARK);
    LAS float* W1 = (LAS float*)(lds + L_W1);
    const int tv = w & 3;
    f32x4 hacc[4];
#pragma unroll
    for (int x = 0; x < 4; ++x) {
        if (lat && w < 4) hacc[x] = *(const f32x4*)(p.in[I_STATE] + ((((size_t)bseq * 2 + l) * 2 + dir) * 8 + h) * 4096 + (16 * tv + fr) * 64 + 16 * x + 4 * fg);
        else hacc[x] = (f32x4){0.f, 0.f, 0.f, 0.f}; }
    int ei = tid >> 3, ec8 = (tid & 7) * 8; const int hc8 = h * 64 + ec8;
    float kkp[8], kap[8], rkp[8];
#pragma unroll
    for (int e = 0; e < 8; ++e) { kkp[e] = p.in[I_KK][l * 512 + hc8 + e]; kap[e] = p.in[I_KA][l * 512 + hc8 + e]; rkp[e] = p.in[I_RK][l * 512 + hc8 + e]; }
#define SCAN_PREFETCH(SC) do { const int _t0 = opq(tid0), _ei = _t0 >> 3, _ec8 = (_t0 & 7) * 8; const int _step = (SC) * 64 + _ei, _t = dir ? L - 1 - _step : _step; \
        const bf16* _u = U + (size_t)(base + _t) * 1920; \
        nwd = *(const u32x4*)(_u + WD_OFF + dir * 64 + _ec8); nad = *(const u32x4*)(_u + AD_OFF + dir * 64 + _ec8); \
        nr = *(const u32x4*)(_u + R_OFF + h * 64 + _ec8); nk = *(const u32x4*)(_u + K_OFF + h * 64 + _ec8); nv = *(const u32x4*)(_u + V_OFF + h * 64 + _ec8); \
        ninv = KINV[(size_t)(base + _t) * 8 + h]; } while (0)
    bf16x8 lbw[2][2], lba[2][2]; float lw0c[2], la0c[2];
#pragma unroll
    for (int x = 0; x < 2; ++x) { const int c = ((w & 1) * 2 + x) * 16 + fr;
        lbw[x][0] = *(const bf16x8*)(wupt + c * 64 + fg * 8); lbw[x][1] = *(const bf16x8*)(wupt + c * 64 + 32 + fg * 8);
        lba[x][0] = *(const bf16x8*)(aupt + c * 64 + fg * 8); lba[x][1] = *(const bf16x8*)(aupt + c * 64 + 32 + fg * 8);
        lw0c[x] = p.in[I_W0][(l * 2 + dir) * 512 + h * 64 + c]; la0c[x] = p.in[I_A0][(l * 2 + dir) * 512 + h * 64 + c]; }
    u32x4 nwd, nad, nr, nk, nv; float ninv;
    SCAN_PREFETCH(0);
    __syncthreads();
#pragma unroll 1
    for (int sc = 0; sc < L / 64; ++sc) {
        tid = opq(tid0); fr = tid & 15; fg = (tid & 63) >> 4; ei = tid >> 3; ec8 = (tid & 7) * 8;
        *(LAS u32x4*)(TW + ei * TS + ec8) = nwd; *(LAS u32x4*)(AD + ei * TS + ec8) = nad;
        const u32x4 cr = nr, ck = nk, cv = nv; const float kinv = ninv;
        __syncthreads();
        tid = opq(tid0); fr = tid & 15; fg = (tid & 63) >> 4; ei = tid >> 3; ec8 = (tid & 7) * 8;
        { const int ti = w >> 1;
          const bf16x8 aw0 = *(const LAS bf16x8*)(TW + (ti * 16 + fr) * TS + fg * 8), aw1 = *(const LAS bf16x8*)(TW + (ti * 16 + fr) * TS + 32 + fg * 8);
          const bf16x8 aa0 = *(const LAS bf16x8*)(AD + (ti * 16 + fr) * TS + fg * 8), aa1 = *(const LAS bf16x8*)(AD + (ti * 16 + fr) * TS + 32 + fg * 8);
#pragma unroll
          for (int x = 0; x < 2; ++x) { const int c = ((w & 1) * 2 + x) * 16 + fr;
              f32x4 cw = (f32x4){lw0c[x], lw0c[x], lw0c[x], lw0c[x]}, ca = (f32x4){la0c[x], la0c[x], la0c[x], la0c[x]};
              cw = MFMA16(aw0, lbw[x][0], cw); cw = MFMA16(aw1, lbw[x][1], cw); ca = MFMA16(aa0, lba[x][0], ca); ca = MFMA16(aa1, lba[x][1], ca);
#pragma unroll
              for (int r = 0; r < 4; ++r) { LP[(ti * 16 + 4 * fg + r) * LPS + c] = cw[r]; AP[(ti * 16 + 4 * fg + r) * LPS + c] = ca[r]; } } }
        __syncthreads();
        tid = opq(tid0); fr = tid & 15; fg = (tid & 63) >> 4; ei = tid >> 3; ec8 = (tid & 7) * 8;
        float av[8], bv[8], kd[8], rr[8], bcv;
        { const f32x4 wp0 = *(const LAS f32x4*)(LP + ei * LPS + ec8), wp1 = *(const LAS f32x4*)(LP + ei * LPS + ec8 + 4);
          const f32x4 ap0 = *(const LAS f32x4*)(AP + ei * LPS + ec8), ap1 = *(const LAS f32x4*)(AP + ei * LPS + ec8 + 4);
          float kk[8], lw[8], bc = 0.f;
          rr[0] = bflo(cr.x); rr[1] = bfhi(cr.x); rr[2] = bflo(cr.y); rr[3] = bfhi(cr.y); rr[4] = bflo(cr.z); rr[5] = bfhi(cr.z); rr[6] = bflo(cr.w); rr[7] = bfhi(cr.w);
          kk[0] = bflo(ck.x); kk[1] = bfhi(ck.x); kk[2] = bflo(ck.y); kk[3] = bfhi(ck.y); kk[4] = bflo(ck.z); kk[5] = bfhi(ck.z); kk[6] = bflo(ck.w); kk[7] = bfhi(ck.w);
#pragma unroll
          for (int e = 0; e < 8; ++e) { const float wpre = e < 4 ? wp0[e & 3] : wp1[e & 3], apre = e < 4 ? ap0[e & 3] : ap1[e & 3];
              lw[e] = -0.6065306597126334f * fsigmoid(wpre);
              const float asg = fsigmoid(apre), kj = kk[e] * kkp[e] * kinv;
              av[e] = -kj; bv[e] = kj * asg;
              kd[e] = kk[e] * (1.0f + (asg - 1.0f) * kap[e]); bc += rr[e] * kd[e] * rkp[e]; }
          bcv = red8(bc);
          *(LAS f32x4*)(LP + ei * LPS + ec8) = (f32x4){lw[0], lw[1], lw[2], lw[3]}; *(LAS f32x4*)(LP + ei * LPS + ec8 + 4) = (f32x4){lw[4], lw[5], lw[6], lw[7]}; }
        __syncthreads();
        tid = opq(tid0);
        if (tid < 256) { const int c = tid & 63, q = tid >> 6; float run = 0.f;
#pragma unroll
            for (int i = 0; i < 16; ++i) { run += LP[(16 * q + i) * LPS + c]; LP[(16 * q + i) * LPS + c] = fexp(run); } }
        __syncthreads();
        tid = opq(tid0); fr = tid & 15; fg = (tid & 63) >> 4; ei = tid >> 3; ec8 = (tid & 7) * 8;
        { const f32x4 g0 = *(const LAS f32x4*)(LP + ei * LPS + ec8), g1 = *(const LAS f32x4*)(LP + ei * LPS + ec8 + 4);
          const int ip = (ei & 15) ? ei - 1 : ei;
          f32x4 p0 = *(const LAS f32x4*)(LP + ip * LPS + ec8), p1 = *(const LAS f32x4*)(LP + ip * LPS + ec8 + 4);
          if ((ei & 15) == 0) { p0 = (f32x4){1.f, 1.f, 1.f, 1.f}; p1 = p0; }
          float xa[8], xr[8], xb[8], xk[8];
#pragma unroll
          for (int e = 0; e < 8; ++e) { const float gi = e < 4 ? g0[e & 3] : g1[e & 3], gp = e < 4 ? p0[e & 3] : p1[e & 3], ginv = frcp(gi);
              xa[e] = av[e] * gp; xr[e] = rr[e] * gi; xb[e] = bv[e] * ginv; xk[e] = kd[e] * ginv; }
          *(LAS u32x4*)(AT + ei * TS + ec8) = pack8(xa); *(LAS u32x4*)(RT + ei * TS + ec8) = pack8(xr); *(LAS u32x4*)(BH + ei * TS + ec8) = pack8(xb); *(LAS u32x4*)(KH + ei * TS + ec8) = pack8(xk);
          *(LAS u32x4*)(VR + ei * TS + ec8) = cv; }
        __syncthreads();
        tid = opq(tid0); fr = tid & 15; fg = (tid & 63) >> 4;
        { const int q = w >> 1, half = w & 1; const LAS bf16* Asrc = half ? RT : AT;
          const bf16x8 af0 = *(const LAS bf16x8*)(Asrc + (16 * q + fr) * TS + fg * 8), af1 = *(const LAS bf16x8*)(Asrc + (16 * q + fr) * TS + 32 + fg * 8);
#pragma unroll
          for (int x = 0; x < 2; ++x) { const LAS bf16* Bsrc = x ? KH : BH;
              const bf16x8 bf0 = *(const LAS bf16x8*)(Bsrc + (16 * q + fr) * TS + fg * 8), bf1_ = *(const LAS bf16x8*)(Bsrc + (16 * q + fr) * TS + 32 + fg * 8);
              f32x4 c = (f32x4){0.f, 0.f, 0.f, 0.f}; c = MFMA16(af0, bf0, c); c = MFMA16(af1, bf1_, c);
#pragma unroll
              for (int r = 0; r < 4; ++r) { const int i = 4 * fg + r, j = fr; const float val = (half ? j <= i : j < i) ? c[r] : 0.f;
                  if (half == 0 && x == 0) AAB[(q * 16 + i) * 16 + j] = val;
                  else { LAS bf16* dst = half == 0 ? AAK : (x == 0 ? ARB : ARK); dst[(q * 16 + i) * 24 + j] = (bf16)(cvt2(val, 0.f) & 0xffffu); } } } }
        __syncthreads();
        tid = opq(tid0); fr = tid & 15; fg = (tid & 63) >> 4;
        { const int q = w >> 1;
          const bf16x8 afr = *(const LAS bf16x8*)(AAK + (q * 16 + fr) * 24 + (fg & 1) * 8);
          const unsigned kmask = fg < 2 ? 0xffffffffu : 0u;
          const bf16x8 af = __builtin_bit_cast(bf16x8, __builtin_bit_cast(u32x4, afr) & kmask);
#pragma unroll
          for (int x = 0; x < 2; ++x) { const int tvv = (w & 1) * 2 + x;
              const bf16x8 bfr = tr8(VR + (16 * q + 8 * (fg & 1) + (fr >> 2)) * TS + 16 * tvv + 4 * (fr & 3));
              const bf16x8 bfv = __builtin_bit_cast(bf16x8, __builtin_bit_cast(u32x4, bfr) & kmask);
              f32x4 c = (f32x4){0.f, 0.f, 0.f, 0.f}; c = MFMA16(af, bfv, c);
#pragma unroll
              for (int r = 0; r < 4; ++r) W1[(q * 16 + 4 * fg + r) * LPS + 16 * tvv + fr] = c[r]; } }
        __syncthreads();
        tid = opq(tid0);
        { const int q = tid >> 7, col = tid & 127; float x[16];
          if (col < 64) {
#pragma unroll
              for (int i = 0; i < 16; ++i) x[i] = bf1(AT[(16 * q + i) * TS + col]); }
          else {
#pragma unroll
              for (int i = 0; i < 16; ++i) x[i] = W1[(q * 16 + i) * LPS + col - 64]; }
#pragma unroll
          for (int i = 1; i < 16; ++i) {
              const LAS f32x4* ar = (const LAS f32x4*)(AAB + (q * 16 + i) * 16);
              float acc = x[i];
#pragma unroll
              for (int j4 = 0; j4 * 4 < i; ++j4) { const f32x4 a4 = ar[j4];
#pragma unroll
                  for (int e = 0; e < 4; ++e) if (j4 * 4 + e < i) acc += a4[e] * x[j4 * 4 + e]; }
              x[i] = acc; }
          if (col < 64) {
#pragma unroll
              for (int i = 0; i < 16; ++i) AT[(16 * q + i) * TS + col] = (bf16)(cvt2(x[i], 0.f) & 0xffffu); }
          else {
#pragma unroll
              for (int i = 0; i < 16; ++i) W1[(q * 16 + i) * LPS + col - 64] = x[i]; } }
        __syncthreads();
        if (sc + 1 < L / 64) SCAN_PREFETCH(sc + 1);
        if (w < 4) {
#pragma unroll 1
        for (int q = 0; q < 4; ++q) {
            tid = opq(tid0); fr = tid & 15; fg = (tid & 63) >> 4;
            bf16x8 hb[2];
#pragma unroll
            for (int ks = 0; ks < 2; ++ks) { u32x4 t; t.x = cvt2(hacc[2 * ks][0], hacc[2 * ks][1]); t.y = cvt2(hacc[2 * ks][2], hacc[2 * ks][3]);
                t.z = cvt2(hacc[2 * ks + 1][0], hacc[2 * ks + 1][1]); t.w = cvt2(hacc[2 * ks + 1][2], hacc[2 * ks + 1][3]); hb[ks] = __builtin_bit_cast(bf16x8, t); }
            bf16x8 aU[2], aR[2];
#pragma unroll
            for (int ks = 0; ks < 2; ++ks) {
                const u32x2 a0 = *(const LAS u32x2*)(AT + (16 * q + fr) * TS + 32 * ks + 4 * fg), a1 = *(const LAS u32x2*)(AT + (16 * q + fr) * TS + 32 * ks + 16 + 4 * fg);
                const u32x2 r0 = *(const LAS u32x2*)(RT + (16 * q + fr) * TS + 32 * ks + 4 * fg), r1 = *(const LAS u32x2*)(RT + (16 * q + fr) * TS + 32 * ks + 16 + 4 * fg);
                aU[ks] = __builtin_bit_cast(bf16x8, (u32x4){a0.x, a0.y, a1.x, a1.y}); aR[ks] = __builtin_bit_cast(bf16x8, (u32x4){r0.x, r0.y, r1.x, r1.y}); }
            f32x4 u, yacc = (f32x4){0.f, 0.f, 0.f, 0.f};
#pragma unroll
            for (int r = 0; r < 4; ++r) u[r] = W1[(q * 16 + 4 * fg + r) * LPS + 16 * tv + fr];
            u = MFMA16(aU[0], hb[0], u); u = MFMA16(aU[1], hb[1], u);
            yacc = MFMA16(aR[0], hb[0], yacc); yacc = MFMA16(aR[1], hb[1], yacc);
            const s16x4v vtr = __builtin_bit_cast(s16x4v, __builtin_amdgcn_ds_read_tr16_b64_v4i16((LAS s16x4v*)(VR + (16 * q + 4 * fg + (fr >> 2)) * TS + 16 * tv + 4 * (fr & 3))));
            const u32x2 vt2 = __builtin_bit_cast(u32x2, vtr);
            const bf16x8 bUV = __builtin_bit_cast(bf16x8, (u32x4){cvt2(u[0], u[1]), cvt2(u[2], u[3]), vt2.x, vt2.y});
            { const u32x2 y0 = *(const LAS u32x2*)(ARB + (q * 16 + fr) * 24 + 4 * fg), y1 = *(const LAS u32x2*)(ARK + (q * 16 + fr) * 24 + 4 * fg);
              yacc = MFMA16(__builtin_bit_cast(bf16x8, (u32x4){y0.x, y0.y, y1.x, y1.y}), bUV, yacc); }
#pragma unroll
            for (int r = 0; r < 4; ++r) YS[(16 * q + 4 * fg + r) * LPS + 16 * tv + fr] = yacc[r];
#pragma unroll
            for (int x = 0; x < 4; ++x) {
                const s16x4v bt = __builtin_bit_cast(s16x4v, __builtin_amdgcn_ds_read_tr16_b64_v4i16((LAS s16x4v*)(BH + (16 * q + 4 * fg + (fr >> 2)) * TS + 16 * x + 4 * (fr & 3))));
                const s16x4v kt = __builtin_bit_cast(s16x4v, __builtin_amdgcn_ds_read_tr16_b64_v4i16((LAS s16x4v*)(KH + (16 * q + 4 * fg + (fr >> 2)) * TS + 16 * x + 4 * (fr & 3))));
                const u32x2 b2 = __builtin_bit_cast(u32x2, bt), k2 = __builtin_bit_cast(u32x2, kt);
                const f32x4 ge = *(const LAS f32x4*)(LP + (16 * q + 15) * LPS + 16 * x + 4 * fg);
                hacc[x] = MFMA16(__builtin_bit_cast(bf16x8, (u32x4){b2.x, b2.y, k2.x, k2.y}), bUV, hacc[x]) * ge; }
        }
        }
        __syncthreads();
        tid = opq(tid0); ei = tid >> 3; ec8 = (tid & 7) * 8;
        { const int st2 = sc * 64 + ei, t2 = dir ? L - 1 - st2 : st2; float* yo = Yout + (size_t)(base + t2) * 512 + h * 64 + ec8;
          *(f32x4*)yo = *(const LAS f32x4*)(YS + ei * LPS + ec8); *(f32x4*)(yo + 4) = *(const LAS f32x4*)(YS + ei * LPS + ec8 + 4);
          if ((tid & 7) == 0) BC[(size_t)(base + t2) * 8 + h] = bcv; }
    }
#undef SCAN_PREFETCH
    if (!lat && w < 4) {
#pragma unroll
        for (int x = 0; x < 4; ++x) *(f32x4*)(p.out + (size_t)MTOK * DM + ((((size_t)bseq * 2 + l) * 2 + dir) * 8 + h) * 4096 + (16 * tv + fr) * 64 + 16 * x + 4 * fg) = hacc[x]; }
    __syncthreads();
}

__device__ __forceinline__ void stage_upass(CKP& p, int l, int bid, int nb) {
    const int tid = opaque_tid(), sub = tid >= 240 ? 1 : 0, j = tid - sub * 240, col = 8 * j;
    const bf16* proj = (const bf16*)(p.ws + WS_PROJ); bf16* U = (bf16*)(p.ws + WS_U); float* KINV = (float*)(p.ws + WS_KINV);
    const float* mu = p.in[I_MU] + l * 1920;
    if (tid < 480) {
        const bool isk = col >= K_OFF && col < V_OFF;
        const float* kkp = p.in[I_KK] + l * 512 + (isk ? col - K_OFF : 0);
        const f32x4 k0 = *(const f32x4*)kkp, k1 = *(const f32x4*)(kkp + 4);
#pragma unroll 1
        for (int tok0 = bid * 2 + sub; tok0 < MTOK; tok0 += nb * 8) {
            float uu[4][8];
#pragma unroll
            for (int z = 0; z < 4; ++z) { const int tok = min(tok0 + z * nb * 2, MTOK - 1);
                const bool lat = tok >= NCTX; const int L = lat ? 1024 : 256, t = lat ? (tok - NCTX) & 1023 : tok & 255;
                shift8(proj, tok, t > 0, t < L - 1, col, mu, uu[z]); }
#pragma unroll
            for (int z = 0; z < 4; ++z) { const int tok = tok0 + z * nb * 2;
                float ss = 0.f;
#pragma unroll
                for (int e = 0; e < 8; ++e) { const float kn = uu[z][e] * (e < 4 ? k0[e & 3] : k1[e & 3]); ss += kn * kn; }
                ss = red8(ss);
                if (tok < MTOK) {
                    if (isk && (j & 7) == 0) KINV[(size_t)tok * 8 + ((col - K_OFF) >> 6)] = fminf(frsq(ss), 1e12f);
                    if (col >= WD_OFF && col < AD_OFF) {
#pragma unroll
                        for (int e = 0; e < 8; ++e) uu[z][e] = 1.0f - 2.0f * frcp(fexp(2.0f * uu[z][e]) + 1.0f); }
                    if (col >= GD_OFF) {
#pragma unroll
                        for (int e = 0; e < 8; ++e) uu[z][e] = fsigmoid(uu[z][e]); }
                    *(u32x4*)(U + (size_t)tok * 1920 + col) = pack8(uu[z]); } }
        }
    }
}

__device__ __forceinline__ void fnet1_item(CKP& p, int l, int item) {
    const int tid = opaque_tid(), lane = tid & 63, w = __builtin_amdgcn_readfirstlane(tid >> 6), fr = lane & 15, fg = lane >> 4;
    const int tb = item >> 2, g = item & 3, tok0 = tb * 64, tt = w & 3, cs = w >> 2;
    const bf16* proj = (const bf16*)(p.ws + WS_PROJ);
    const bf16* fwt = (const bf16*)(p.ws + WS_FW) + (size_t)((l * 4 + g) * 128 + cs * 64) * 64;
    const bf16* xr = proj + (size_t)(tok0 + 16 * tt + fr) * DINP + F_OFF + g * 64 + fg * 8;
    const bf16x8 a0 = *(const bf16x8*)xr, a1 = *(const bf16x8*)(xr + 32);
    const bool lat = tok0 >= NCTX;
    const int L = lat ? 1024 : 256, bq = lat ? (tok0 - NCTX) >> 10 : tok0 >> 8, t = (lat ? (tok0 - NCTX) & 1023 : tok0 & 255) + 16 * tt + 4 * fg;
    const float scale = lat ? (1.0f / 256.0f) : (1.0f / 128.0f);
    bf16* Y = (bf16*)(p.ws + WS_YCS) + (lat ? (size_t)8192 * 512 : 0);
#pragma unroll
    for (int ot = 0; ot < 4; ++ot) {
        const bf16x8 b0 = *(const bf16x8*)(fwt + (16 * ot + fr) * 64 + fg * 8), b1 = *(const bf16x8*)(fwt + (16 * ot + fr) * 64 + 32 + fg * 8);
        f32x4 c = (f32x4){0.f, 0.f, 0.f, 0.f}; c = MFMA16(a0, b0, c); c = MFMA16(a1, b1, c);
        u32x2 o; o.x = cvt2(c[0] * scale, c[1] * scale); o.y = cvt2(c[2] * scale, c[3] * scale);
        *(u32x2*)(Y + (size_t)((bq * 4 + g) * 64 + 16 * ot + fr) * (2 * L) + cs * L + t) = o; }
}

__device__ __forceinline__ void pool_item(CKP& p, int l, LAS unsigned char* lds, int item) {
    const int tid = opaque_tid(), tb = item >> 2, gi = item & 3, tok0 = tb * 64, hw = 1 << gi;
    const bf16* proj = (const bf16*)(p.ws + WS_PROJ);
    LAS bf16* DB = (LAS bf16*)lds;
    LAS float* CSUM = (LAS float*)(lds + 9216);
    const int ti = tid >> 3, c8 = (tid & 7) * 8, tok = tok0 + ti, col = P_OFF + gi * 64 + c8;
    { float sum[8], x[8];
#pragma unroll
      for (int j = 0; j < 8; ++j) sum[j] = 0.f;
      load8bf(proj + (size_t)tok * DINP + col, x);
      float cnt;
      if (tok < NCTX) { const int t = tok & 255, sb = tok - t, lo = max(t - hw, 0), hi = min(t + hw, 256);
          for (int q = lo; q < hi; ++q) { float y[8]; load8bf(proj + (size_t)(sb + q) * DINP + col, y);
#pragma unroll
              for (int j = 0; j < 8; ++j) sum[j] += y[j]; }
          cnt = (float)(hi - lo); }
      else {
          const int t = (tok - NCTX) & 1023, sb = tok - t, r = t >> 6, c = t & 63, rlo = max(r - hw, 0), rhi = min(r + hw, 16), clo = max(c - hw, 0), chi = min(c + hw, 64);
          for (int rq = rlo; rq < rhi; ++rq) { float y[8]; load8bf(proj + (size_t)(sb + rq * 64 + c) * DINP + col, y);
#pragma unroll
              for (int j = 0; j < 8; ++j) sum[j] += y[j]; }
          *(LAS f32x4*)(CSUM + ti * 68 + c8) = (f32x4){sum[0], sum[1], sum[2], sum[3]}; *(LAS f32x4*)(CSUM + ti * 68 + c8 + 4) = (f32x4){sum[4], sum[5], sum[6], sum[7]};
          __syncthreads();
#pragma unroll
          for (int j = 0; j < 8; ++j) sum[j] = 0.f;
          for (int cq = clo; cq < chi; ++cq) { const f32x4 a = *(const LAS f32x4*)(CSUM + cq * 68 + c8), b = *(const LAS f32x4*)(CSUM + cq * 68 + c8 + 4);
#pragma unroll
              for (int j = 0; j < 4; ++j) { sum[j] += a[j]; sum[4 + j] += b[j]; } }
          cnt = (float)((rhi - rlo) * (chi - clo)); }
      const float ic = frcp(cnt);
      float dd[8];
#pragma unroll
      for (int j = 0; j < 8; ++j) dd[j] = sum[j] * ic - x[j];
      *(LAS u32x4*)(DB + ti * 72 + c8) = pack8(dd); }
    __syncthreads();
    { const int lane = tid & 63, w = __builtin_amdgcn_readfirstlane(tid >> 6), fr = lane & 15, fg = lane >> 4, tt = w & 3;
      const bf16* wpt = (const bf16*)(p.ws + WS_WPT) + (size_t)(l * 4 + gi) * 4096;
      const bf16x8 b0 = *(const LAS bf16x8*)(DB + (16 * tt + fr) * 72 + fg * 8), b1 = *(const LAS bf16x8*)(DB + (16 * tt + fr) * 72 + 32 + fg * 8);
#pragma unroll
      for (int x = 0; x < 2; ++x) { const int ot = 2 * (w >> 2) + x;
          const bf16x8 a0 = *(const bf16x8*)(wpt + (16 * ot + fr) * 64 + fg * 8), a1 = *(const bf16x8*)(wpt + (16 * ot + fr) * 64 + 32 + fg * 8);
          f32x4 c = (f32x4){0.f, 0.f, 0.f, 0.f}; c = MFMA16(a0, b0, c); c = MFMA16(a1, b1, c);
          const f32x4 ps = *(const f32x4*)(p.in[I_PSCALE] + l * 256 + gi * 64 + 16 * ot + 4 * fg);
          c *= ps;
          u32x2 o; o.x = cvt2(c[0], c[1]); o.y = cvt2(c[2], c[3]);
          *(u32x2*)((bf16*)(p.ws + WS_MIXED) + (size_t)(tok0 + 16 * tt + fr) * DM + 768 + gi * 64 + 16 * ot + 4 * fg) = o; } }
    __syncthreads();
}

__device__ __forceinline__ float xsum_fg(float s, int fr, int fg) {
    s += __builtin_bit_cast(float, __builtin_amdgcn_ds_bpermute((((fg ^ 1) << 4) | fr) << 2, __builtin_bit_cast(int, s)));
    s += __builtin_bit_cast(float, __builtin_amdgcn_ds_bpermute((((fg ^ 2) << 4) | fr) << 2, __builtin_bit_cast(int, s)));
    return s;
}
__device__ __forceinline__ void stage_post(CKP& p, int l, int bid, int nb) {
    const int tid = opaque_tid(), lane = tid & 63, head = __builtin_amdgcn_readfirstlane(tid >> 6), fr = lane & 15, fg = lane >> 4;
    const bf16* Ub = (const bf16*)(p.ws + WS_U);
    const bf16* gupt = (const bf16*)(p.ws + WS_GUPT) + ((size_t)l * 512 + head * 64) * 128;
    const float* YF = (const float*)(p.ws + WS_YF); const float* YB = (const float*)(p.ws + WS_YB);
    const float* BC0 = (const float*)(p.ws + WS_BC); const float* BC1 = BC0 + (size_t)MTOK * 8;
    bf16* MIX = (bf16*)(p.ws + WS_MIXED);
    bf16x8 ag[4][4];
    f32x4 lnw[4], lnb[4];
#pragma unroll
    for (int t = 0; t < 4; ++t) {
#pragma unroll
        for (int ks = 0; ks < 4; ++ks) ag[t][ks] = *(const bf16x8*)(gupt + (16 * t + fr) * 128 + ks * 32 + fg * 8);
        lnw[t] = *(const f32x4*)(p.in[I_LNW] + l * 512 + head * 64 + 16 * t + 4 * fg); lnb[t] = *(const f32x4*)(p.in[I_LNB] + l * 512 + head * 64 + 16 * t + 4 * fg); }
#pragma unroll 1
    for (int item = bid; item < 768; item += nb) {
        const size_t tok = (size_t)item * 16 + fr;
        bf16x8 bs[4];
#pragma unroll
        for (int ks = 0; ks < 4; ++ks) bs[ks] = *(const bf16x8*)(Ub + tok * 1920 + GD_OFF + ks * 32 + fg * 8);
        f32x4 y[4]; u32x2 vw[4];
#pragma unroll
        for (int t = 0; t < 4; ++t) { const int c = head * 64 + 16 * t + 4 * fg;
            y[t] = *(const f32x4*)(YF + tok * 512 + c) + *(const f32x4*)(YB + tok * 512 + c); vw[t] = *(const u32x2*)(Ub + tok * 1920 + V_OFF + c); }
        const float bc = BC0[tok * 8 + head] + BC1[tok * 8 + head];
        f32x4 g[4];
#pragma unroll
        for (int t = 0; t < 4; ++t) { g[t] = (f32x4){0.f, 0.f, 0.f, 0.f};
#pragma unroll
            for (int ks = 0; ks < 4; ++ks) g[t] = MFMA16(ag[t][ks], bs[ks], g[t]); }
        float s = 0.f;
#pragma unroll
        for (int t = 0; t < 4; ++t) s += (y[t][0] + y[t][1]) + (y[t][2] + y[t][3]);
        const float mean = xsum_fg(s, fr, fg) * (1.0f / 64.0f);
        float q = 0.f;
#pragma unroll
        for (int t = 0; t < 4; ++t) { y[t] = y[t] - mean; q += (y[t][0] * y[t][0] + y[t][1] * y[t][1]) + (y[t][2] * y[t][2] + y[t][3] * y[t][3]); }
        const float rstd = frsq(xsum_fg(q, fr, fg) * (1.0f / 64.0f) + 64e-5f);
#pragma unroll
        for (int t = 0; t < 4; ++t) { const f32x4 vv = (f32x4){bflo(vw[t].x), bfhi(vw[t].x), bflo(vw[t].y), bfhi(vw[t].y)};
            const f32x4 o = (y[t] * rstd * lnw[t] + lnb[t] + vv * bc) * g[t];
            u32x2 w; w.x = cvt2(o[0], o[1]); w.y = cvt2(o[2], o[3]);
            *(u32x2*)(MIX + tok * DM + head * 64 + 16 * t + 4 * fg) = w; }
    }
}

#define XB_TMO      128
#define XB_XCNT(j)  (256  + 64 * (j))
#define XB_XSUB(j)  (1280 + 64 * (j))
#define XB_XGEN(j)  (2304 + 64 * (j))
#define XB_TOP      3328
#define XB_TOPGEN   3392
#define XCD_BAR_WORDS 3456
#define XB_SPIN_CAP (1u << 18)

__device__ __forceinline__ unsigned xb_ld(unsigned* p)              { return __hip_atomic_load(p, __ATOMIC_RELAXED, __HIP_MEMORY_SCOPE_AGENT); }
__device__ __forceinline__ unsigned xb_add(unsigned* p, unsigned v) { return __hip_atomic_fetch_add(p, v, __ATOMIC_RELAXED, __HIP_MEMORY_SCOPE_AGENT); }
__device__ __forceinline__ unsigned xb_xcc_id() { return (unsigned)__builtin_amdgcn_s_getreg((3 << 11) | 20) & 0xFu; }
#define XB_SPIN(cond, bar) do { unsigned _sp = 0; while (cond) { __builtin_amdgcn_s_sleep(1); \
    if ((++_sp & 255u) == 0u) { if (xb_ld(&(bar)[XB_TMO])) break; if (_sp > XB_SPIN_CAP) { atomicAdd(&(bar)[XB_TMO], 1u); break; } } } } while (0)

struct XcdBarrier {
    unsigned* bar; unsigned x;
    volatile LAS unsigned* st;
};

__device__ __forceinline__ XcdBarrier xcd_barrier_post(unsigned* bar, volatile LAS unsigned* st) {
    XcdBarrier b; b.bar = bar; b.x = xb_xcc_id(); b.st = st;
    if (threadIdx.x == 0) (void)xb_add(&bar[XB_XCNT(b.x)], 1u);
    return b;
}
__device__ __forceinline__ void xcd_barrier_complete(unsigned* bar, unsigned x, unsigned& nloc, unsigned& nx) {
    const unsigned G = gridDim.x * gridDim.y * gridDim.z;
    unsigned sum, cnt, mine, sp = 0u;
    for (;;) {
        sum = 0u; cnt = 0u; mine = 0u;
#pragma unroll
        for (unsigned j = 0; j < 16; ++j) { const unsigned c = xb_ld(&bar[XB_XCNT(j)]); sum += c; cnt += (c > 0u) ? 1u : 0u; mine = (j == x) ? c : mine; }
        if (sum == G) break;
        __builtin_amdgcn_s_sleep(1);
        if ((++sp & 255u) == 0u) { if (xb_ld(&bar[XB_TMO])) break; if (sp > XB_SPIN_CAP) { atomicAdd(&bar[XB_TMO], 1u); break; } }
    }
    nloc = mine > 0u ? mine : 1u; nx = cnt > 0u ? cnt : 1u;
}

__device__ __forceinline__ void xcd_barrier(const XcdBarrier& b) {
    asm volatile("s_waitcnt vmcnt(0)" ::: "memory");
    __syncthreads();
    if (threadIdx.x == 0) {
        unsigned* bar = b.bar;
        __builtin_amdgcn_s_waitcnt(0);
        unsigned nloc = b.st[0], nx = b.st[1];
        if (nloc == 0u) { xcd_barrier_complete(bar, b.x, nloc, nx); b.st[0] = nloc; b.st[1] = nx; }
        const unsigned old = xb_add(&bar[XB_XSUB(b.x)], 1u);
        const unsigned gen = old / nloc;
        if (old + 1u == (gen + 1u) * nloc) {
            __builtin_amdgcn_fence(__ATOMIC_RELEASE, "agent");
            asm volatile("s_waitcnt vmcnt(0)" ::: "memory");
            const unsigned og = xb_add(&bar[XB_TOP], 1u);
            const unsigned tg = og / nx;
            if (og + 1u == (tg + 1u) * nx) xb_add(&bar[XB_TOPGEN], 1u);
            else XB_SPIN(xb_ld(&bar[XB_TOPGEN]) == tg, bar);
            __builtin_amdgcn_fence(__ATOMIC_ACQUIRE, "agent");
            xb_add(&bar[XB_XGEN(b.x)], 1u);
            asm volatile("s_waitcnt vmcnt(0)" ::: "memory");
        } else {
            XB_SPIN(xb_ld(&bar[XB_XGEN(b.x)]) == gen, bar);
            __builtin_amdgcn_fence(__ATOMIC_ACQUIRE, "agent");
            asm volatile("s_waitcnt vmcnt(0)" ::: "memory");
        }
    }
    __syncthreads();
}

constexpr int N_STEPS = 17;
__device__ __forceinline__ bool step_seam(int st) { return st < 16; }
__global__ void __launch_bounds__(NTHR, 2) mega_fwd(KP p_unused) {
    extern __shared__ __attribute__((aligned(16))) unsigned char lds_raw[];
    CKP* kp0 = (CKP*)__builtin_amdgcn_kernarg_segment_ptr();
    { LAS unsigned* ctlw = (LAS unsigned*)((LAS unsigned char*)lds_raw + RING_BYTES);
      for (int u = threadIdx.x; u < (LDS_BYTES - RING_BYTES) / 4; u += NTHR) ctlw[u] = 0u; }
    __syncthreads();
    const XcdBarrier bar = xcd_barrier_post((unsigned*)(kp0->ws + WS_CTL) + 4096, (volatile LAS unsigned*)((LAS unsigned char*)lds_raw + MISC_OFF + 32));
    const int ph_lo = kp0->ph_lo, ph_hi = kp0->ph_hi;
#pragma unroll 1
    for (int st = ph_lo; st < ph_hi; ++st) {
        CKP* kp = kp0; asm volatile("" : "+s"(kp));
        CKP& p = *kp; unsigned char* ws = p.ws;
        int bid = blockIdx.x, nb = gridDim.x; unsigned ldsb = (unsigned)(size_t)(LAS unsigned char*)lds_raw;
        asm volatile("" : "+s"(bid), "+s"(nb), "+s"(ldsb));
        LAS unsigned char* lds = (LAS unsigned char*)(size_t)ldsb;
        const int l = st < 9 ? 0 : 1, s = st == 0 ? -1 : (st == 1 ? 0 : (st == 16 ? 8 : (st - 2) % 7 + 1));
        const float* mod = (const float*)(ws + WS_MOD) + (size_t)l * 5 * 6144;
#ifdef REP_S
        for (int rep = 0; rep < (s == (REP_S) ? 2 : 1); ++rep) { if (rep) xcd_barrier(bar);
#endif
        if (s == 3) {
            if (nb >= 256) { if (bid < 64) rwkv_item3(p, l, lds, bid); else for (int it = 64 + (bid - 64); it < 576; it += nb - 64) rwkv_item3(p, l, lds, it); }
            else for (int it = bid; it < 576; it += nb) rwkv_item3(p, l, lds, it);
            if (nb >= 256) { if (bid >= 64 && bid < 192) transpose_range(p, lds, l == 0 ? TI_IN : TI_L + TI_IN, l == 0 ? TI_L + TI_IN : 2 * TI_L, bid - 64, 128); }
            else transpose_range(p, lds, l == 0 ? TI_IN : TI_L + TI_IN, l == 0 ? TI_L + TI_IN : 2 * TI_L, bid, nb);
            __syncthreads();
        }
#pragma unroll 1
        for (int job = 0; job < 2; ++job) {
            pg8::Gemm g{nullptr, nullptr, 0, 0, 0, 0, 0}; pg8::EpiAny E{-1, true, nullptr, nullptr, 0, 0, nullptr, nullptr, nullptr, nullptr, nullptr, nullptr}; int corder = bid;
            float* SSQ = (float*)(ws + WS_CTL + 262144);
            bf16* Hb = (bf16*)(ws + WS_H);
            if (job == 0) {
                if (s == 1) { g = pg8::Gemm{(const bf16*)(ws + WS_H), (const bf16*)(ws + WS_WIN) + (size_t)l * DINP * DM, MTOK, DINP, DM, DM, DM};
                    if (l == 0) E = pg8::EpiAny{0, true, ws + WS_PROJ, nullptr, DINP, 0, nullptr, nullptr, nullptr, nullptr, nullptr, nullptr};
                    else E = pg8::EpiAny{4, true, ws + WS_PROJ, (const float*)(ws + WS_SWIN), DINP, DINP, nullptr, nullptr, nullptr, nullptr, nullptr, SSQ + 16384}; }
                else if (s == 3) { g = pg8::Gemm{(const bf16*)(ws + WS_CS256), (const bf16*)(ws + WS_YCS), 256, 8192, 512, 512, 512}; E = pg8::EpiAny{3, true, ws + WS_MIXED, nullptr, 0, 256, nullptr, nullptr, nullptr, nullptr, nullptr, nullptr}; corder = (bid + nb - (nb >= 256 ? 192 : 0)) % nb; }
                else if (s == 5) { g = pg8::Gemm{(const bf16*)(ws + WS_MIXED), (const bf16*)(ws + WS_WOUT) + (size_t)l * DM * DM, MTOK, DM, DM, DM, DM};
                    E = pg8::EpiAny{6, true, p.out, mod + 2 * 1024, 0, 0, l == 0 ? p.in[I_XP] : p.out, l == 0 ? p.in[I_XS] : p.out + (size_t)NCTX * DM, Hb, p.in[I_N2G] + l * DM, mod + 4 * 1024, SSQ + l * 32768}; }
                else if (s == 6) { g = pg8::Gemm{(const bf16*)(ws + WS_H), (const bf16*)(ws + WS_W1) + (size_t)l * DFF * DM, MTOK, DFF, DM, DM, DM};
                    E = pg8::EpiAny{5, true, ws + WS_FF, (const float*)(ws + WS_SW1) + (size_t)l * 5 * DFF, DFF, DFF, nullptr, nullptr, nullptr, nullptr, nullptr, SSQ + l * 32768}; }
                else if (s == 7) { g = pg8::Gemm{(const bf16*)(ws + WS_FF), (const bf16*)(ws + WS_W2) + (size_t)l * DM * DFF, MTOK, DM, DFF, DFF, DFF};
                    if (l == 0) E = pg8::EpiAny{6, true, p.out, mod + 5 * 1024, 0, 0, p.out, p.out + (size_t)NCTX * DM, Hb, p.in[I_N1G] + DM, mod + 5 * 6144 + 1 * 1024, SSQ + 16384};
                    else E = pg8::EpiAny{2, false, p.out, mod + 5 * 1024, 0, 0, p.out, p.out + (size_t)NCTX * DM, nullptr, nullptr, nullptr, nullptr}; }
            } else if (s == 3) { g = pg8::Gemm{(const bf16*)(ws + WS_CS1024), (const bf16*)(ws + WS_YCS) + (size_t)8192 * 512, 1024, 1024, 2048, 2048, 2048}; E = pg8::EpiAny{3, true, ws + WS_MIXED, nullptr, NCTX, 1024, nullptr, nullptr, nullptr, nullptr, nullptr, nullptr}; corder = (bid + nb - (nb >= 256 ? 224 : 32)) % nb; }
            if (E.mode >= 0) {
                pg8::StaticOrder S; S.init(g.M, g.N, nb, corder);
                pg8::gemm_phase<pg8::EpiAny, pg8::StaticOrder, true, true>(lds, g, S, E);
                __syncthreads();
            }
        }
        if (s == -1) stage_prologue(p, lds, bid, nb);
        else if (s == 0) { stage_norm(p, 0, 0, bid, nb); stage_shiftw(p, lds, bid, nb); }
        else if (s == 2) {
            stage_upass(p, l, bid, nb);
#pragma unroll 1
            for (int it = bid; it < 768; it += nb) fnet1_item(p, l, it);
#pragma unroll 1
            for (int it = bid; it < 768; it += nb) pool_item(p, l, lds, it);
        }
        else if (s == 4) stage_post(p, l, bid, nb);
        else if (s == 8) stage_final(p, bid, nb);
#ifdef REP_S
        }
#endif
        if (st + 1 < ph_hi && step_seam(st)) xcd_barrier(bar);
    }
}

extern "C" void kernel_launch(void* const* d_in, const int* in_sizes, int n_in, void* d_out, int out_size, void* d_ws, size_t ws_size, hipStream_t stream) {
    static int grid = 0;
    if (grid == 0) {
        if (n_in != N_IN || ws_size < WS_END) { fprintf(stderr, "kernel_launch: unexpected inputs (n_in %d, ws %zu)\n", n_in, ws_size); grid = -1; return; }
        int dev = 0, cus = 0, per_cu = 0;
        (void)hipGetDevice(&dev); (void)hipDeviceGetAttribute(&cus, hipDeviceAttributeMultiprocessorCount, dev);
        (void)hipFuncSetAttribute((const void*)mega_fwd, hipFuncAttributeMaxDynamicSharedMemorySize, LDS_BYTES);
        if (hipOccupancyMaxActiveBlocksPerMultiprocessor(&per_cu, (const void*)mega_fwd, NTHR, LDS_BYTES) != hipSuccess || per_cu < 1) {
            fprintf(stderr, "kernel_launch: occupancy query reports %d blocks/CU\n", per_cu); (void)hipGetLastError(); grid = -1; return; }
        grid = cus * 1;
    }
    if (grid < 0) return;
    KP a{};
    for (int i = 0; i < N_IN; ++i) a.in[i] = (const float*)d_in[i];
    a.out = (float*)d_out; a.ws = (unsigned char*)d_ws; a.ph_lo = 0; a.ph_hi = N_STEPS;
    if (hipMemsetAsync((char*)d_ws + WS_CTL, 0, 1 * MiB, stream) != hipSuccess) { fprintf(stderr, "kernel_launch: memset failed\n"); return; }
    void* args[] = {&a};
    hipError_t e = hipLaunchCooperativeKernel((const void*)mega_fwd, dim3(grid), dim3(NTHR), args, LDS_BYTES, stream);
    if (e != hipSuccess) fprintf(stderr, "cooperative launch failed: %s (grid %d)\n", hipGetErrorString(e), grid);
}
```

```cpp
#include <hip/hip_runtime.h>
#include <hip/hip_cooperative_groups.h>
#include <cstdio>
#include <cstdint>
namespace cg = cooperative_groups;
__device__ __forceinline__ int opaque_tid() { int t = threadIdx.x; asm volatile("" : "+v"(t)); return t; }
namespace pg8 {
#define PG8_LAS __attribute__((address_space(3)))
typedef unsigned short bf16_t;
typedef short bf16x8 __attribute__((ext_vector_type(8)));
typedef float f32x4 __attribute__((ext_vector_type(4)));
typedef unsigned u32x4 __attribute__((ext_vector_type(4)));
constexpr int BM = 256, BK = 64, HALF = 128, HTB = HALF * BK * 2  , STAGE_BYTES = 8 * HTB, NXCD = 8, WGM = 8;

__host__ __device__ __forceinline__ int lds_byte(int r, int c) { const int st = (r >> 4) * 2 + (c >> 5), rr = r & 15, cc = c & 31, ob = rr * 64 + cc * 2; return st * 1024 + (ob ^ (((ob >> 9) & 1) << 5)); }
__host__ __device__ __forceinline__ void stage_rc(int b, int& R, int& C) { const int st = b / 1024, sb = b % 1024, swz = sb ^ (((sb >> 9) & 1) << 5); R = (st >> 1) * 16 + swz / 64; C = (st & 1) * 32 + (swz % 64) / 2; }
__host__ __device__ __forceinline__ int perm32(int rho) { const int n = rho >> 4, i = rho & 15; return 8 * (i >> 2) + 4 * n + (i & 3); }

struct Unit { int pm, pn; };
struct Gemm { const bf16_t* A; const bf16_t* Bt; int M, N, K, lda, ldb; };

struct StaticOrder {
    int nM, nN, nwg, G, c;
    __host__ __device__ void init(int M, int N, int G_, int c_) { nM = M / BM; nN = N / BM; nwg = nM * nN; G = G_; c = c_; }
    __host__ __device__ bool next(int i, Unit& u) const {
        const long L = (long)i * G + c; if (L >= nwg) return false;
        int wgid = (int)L; { const int q = nwg / NXCD, r = nwg % NXCD, xcd = wgid % NXCD, off = wgid / NXCD; wgid = (xcd < r ? xcd * (q + 1) : r * (q + 1) + (xcd - r) * q) + off; }
        const int nig = WGM * nN, gid = wgid / nig, fm = gid * WGM, gsz = (nM - fm) < WGM ? (nM - fm) : WGM;
        u.pm = fm + ((wgid % nig) % gsz); u.pn = (wgid % nig) / gsz; return true;
    }
    __device__ __forceinline__ void a_ready(const Unit&) const {}
    __device__ __forceinline__ void done(const Unit&) const {}
};

__device__ __forceinline__ unsigned cvt_pk_bf16(float lo, float hi) { unsigned r; asm volatile("v_cvt_pk_bf16_f32 %0, %1, %2" : "=v"(r) : "v"(lo), "v"(hi)); return r; }
typedef unsigned u32x2 __attribute__((ext_vector_type(2)));
template <int ACT  > struct EpiBf {
    static constexpr bool PERM = true, AFTER_DRAIN = false;
    bf16_t* O; int ldc;
    __device__ __forceinline__ void operator()(const f32x4 (&acc)[2][2][4][2], const Unit& u, int wr, int wc, int fr, int fq) const {
        const int row0 = u.pm * BM + wr * 64 + fr, col0 = u.pn * BM + wc * 32 + 8 * fq;
#pragma unroll
        for (int ai = 0; ai < 2; ++ai)
#pragma unroll
            for (int m = 0; m < 4; ++m) { bf16_t* rowp = O + (size_t)(row0 + ai * HALF + m * 16) * ldc + col0;
#pragma unroll
                for (int bj = 0; bj < 2; ++bj) { f32x4 v0 = acc[ai][bj][m][0], v1 = acc[ai][bj][m][1];
                    if (ACT == 1) {
#pragma unroll
                        for (int e = 0; e < 4; ++e) { float a = v0[e] > 0.f ? v0[e] : 0.f; v0[e] = a * a; float b = v1[e] > 0.f ? v1[e] : 0.f; v1[e] = b * b; } }
                    u32x4 w; w.x = cvt_pk_bf16(v0[0], v0[1]); w.y = cvt_pk_bf16(v0[2], v0[3]); w.z = cvt_pk_bf16(v1[0], v1[1]); w.w = cvt_pk_bf16(v1[2], v1[3]);
                    *(u32x4*)(rowp + bj * HALF) = w; } }
    }
};
struct EpiRes {
    static constexpr bool PERM = false, AFTER_DRAIN = false;
    float* X; const float* gate; const float* Xc; const float* Xl;
    __device__ __forceinline__ void operator()(const f32x4 (&acc)[2][2][4][2], const Unit& u, int wr, int wc, int fr, int fq) const {
        const int row0 = u.pm * BM + wr * 64 + fr, col0 = u.pn * BM + wc * 32 + 4 * fq;
        const int cond = u.pm < 32 ? 0 : 1 + ((u.pm - 32) >> 2);
        const float* gp = gate + cond * 6144 + col0;
        f32x4 gv[2][2];
#pragma unroll
        for (int bj = 0; bj < 2; ++bj)
#pragma unroll
            for (int n = 0; n < 2; ++n) gv[bj][n] = *(const f32x4*)(gp + bj * HALF + n * 16);
#pragma unroll
        for (int ai = 0; ai < 2; ++ai)
#pragma unroll
            for (int m = 0; m < 4; ++m) { const size_t ro = (size_t)(row0 + ai * HALF + m * 16) * 1024 + col0; float* rowp = X + ro; const float* srcp = u.pm < 32 ? Xc + ro : Xl + (ro - (size_t)8192 * 1024);
#pragma unroll
                for (int bj = 0; bj < 2; ++bj)
#pragma unroll
                    for (int n = 0; n < 2; ++n) { *(f32x4*)(rowp + bj * HALF + n * 16) = *(const f32x4*)(srcp + bj * HALF + n * 16) + gv[bj][n] * acc[ai][bj][m][n]; }
                if (m & 1) asm volatile("" ::: "memory"); }
    }
};
struct EpiFnet {
    static constexpr bool PERM = true, AFTER_DRAIN = false;
    bf16_t* MIX; int rowbase, L;
    __device__ __forceinline__ void operator()(const f32x4 (&acc)[2][2][4][2], const Unit& u, int wr, int wc, int fr, int fq) const {
        const int row0 = u.pm * BM + wr * 64 + fr, colw = wc * 32 + 8 * fq;
        bf16_t* base = MIX + (size_t)(rowbase + u.pn * L) * 1024 + 512 + colw;
#pragma unroll
        for (int ai = 0; ai < 2; ++ai)
#pragma unroll
            for (int m = 0; m < 4; ++m) { bf16_t* rowp = base + (size_t)(row0 + ai * HALF + m * 16) * 1024;
#pragma unroll
                for (int bj = 0; bj < 2; ++bj) { const f32x4 v0 = acc[ai][bj][m][0], v1 = acc[ai][bj][m][1];
                    u32x4 w; w.x = cvt_pk_bf16(v0[0], v0[1]); w.y = cvt_pk_bf16(v0[2], v0[3]); w.z = cvt_pk_bf16(v1[0], v1[1]); w.w = cvt_pk_bf16(v1[2], v1[3]);
                    *(u32x4*)(rowp + bj * HALF) = w; } }
    }
};

__device__ __forceinline__ float xsum_fq(float s, int fr, int fq) {
    s += __builtin_bit_cast(float, __builtin_amdgcn_ds_bpermute((((fq ^ 1) << 4) | fr) << 2, __builtin_bit_cast(int, s)));
    s += __builtin_bit_cast(float, __builtin_amdgcn_ds_bpermute((((fq ^ 2) << 4) | fr) << 2, __builtin_bit_cast(int, s)));
    return s;
}
template <int ACT> struct EpiNormBf {
    static constexpr bool PERM = true, AFTER_DRAIN = false;
    bf16_t* O; int ldc; const float* ssq; const float* sw; int swld;
    __device__ __forceinline__ void operator()(const f32x4 (&acc)[2][2][4][2], const Unit& u, int wr, int wc, int fr, int fq) const {
        const int row0 = u.pm * BM + wr * 64 + fr, col0 = u.pn * BM + wc * 32 + 8 * fq;
        const int cond = u.pm < 32 ? 0 : 1 + ((u.pm - 32) >> 2);
        f32x4 sv[2][2];
#pragma unroll
        for (int bj = 0; bj < 2; ++bj)
#pragma unroll
            for (int n = 0; n < 2; ++n) sv[bj][n] = *(const f32x4*)(sw + (size_t)cond * swld + col0 + bj * HALF + 4 * n);
        float rs[2][4];
#pragma unroll
        for (int ai = 0; ai < 2; ++ai)
#pragma unroll
            for (int m = 0; m < 4; ++m) rs[ai][m] = ssq[row0 + ai * HALF + m * 16];
#pragma unroll
        for (int ai = 0; ai < 2; ++ai)
#pragma unroll
            for (int m = 0; m < 4; ++m) rs[ai][m] = __builtin_amdgcn_rsqf(rs[ai][m] * (1.0f / 1024.0f) + 1e-6f);
#pragma unroll
        for (int ai = 0; ai < 2; ++ai)
#pragma unroll
            for (int m = 0; m < 4; ++m) { const int row = row0 + ai * HALF + m * 16; bf16_t* rowp = O + (size_t)row * ldc + col0;
                const float rstd = rs[ai][m];
#pragma unroll
                for (int bj = 0; bj < 2; ++bj) { f32x4 v0 = acc[ai][bj][m][0] * rstd + sv[bj][0], v1 = acc[ai][bj][m][1] * rstd + sv[bj][1];
                    if (ACT == 1) {
#pragma unroll
                        for (int e = 0; e < 4; ++e) { float a = v0[e] > 0.f ? v0[e] : 0.f; v0[e] = a * a; float b = v1[e] > 0.f ? v1[e] : 0.f; v1[e] = b * b; } }
                    u32x4 w; w.x = cvt_pk_bf16(v0[0], v0[1]); w.y = cvt_pk_bf16(v0[2], v0[3]); w.z = cvt_pk_bf16(v1[0], v1[1]); w.w = cvt_pk_bf16(v1[2], v1[3]);
                    *(u32x4*)(rowp + bj * HALF) = w; }
                if (m & 1) asm volatile("" ::: "memory"); }
    }
};
struct EpiResNorm {
    static constexpr bool PERM = true, AFTER_DRAIN = false;
    float* X; const float* gate; const float* Xc; const float* Xl; bf16_t* H; const float* gn; const float* scl; float* ssq;
    __device__ __forceinline__ void operator()(const f32x4 (&acc)[2][2][4][2], const Unit& u, int wr, int wc, int fr, int fq) const {
        const int row0 = u.pm * BM + wr * 64 + fr, col0 = u.pn * BM + wc * 32 + 8 * fq;
        const int cond = u.pm < 32 ? 0 : 1 + ((u.pm - 32) >> 2);
        const float* src = u.pm < 32 ? Xc : Xl - (size_t)8192 * 1024;
        f32x4 gt[2][2], gs[2][2];
#pragma unroll
        for (int bj = 0; bj < 2; ++bj)
#pragma unroll
            for (int n = 0; n < 2; ++n) { const int col = col0 + bj * HALF + n * 4;
                gt[bj][n] = *(const f32x4*)(gate + cond * 6144 + col); gs[bj][n] = *(const f32x4*)(gn + col) * (*(const f32x4*)(scl + cond * 6144 + col) + 1.0f); }
#pragma unroll
        for (int ai = 0; ai < 2; ++ai)
#pragma unroll
            for (int m = 0; m < 4; ++m) { const int row = row0 + ai * HALF + m * 16; const unsigned ro = (unsigned)row * 1024u + (unsigned)col0;
                float sq = 0.f;
#pragma unroll
                for (int bj = 0; bj < 2; ++bj) { const unsigned o = ro + bj * HALF;
                    const f32x4 x0 = *(const f32x4*)(src + o) + gt[bj][0] * acc[ai][bj][m][0], x1 = *(const f32x4*)(src + o + 4) + gt[bj][1] * acc[ai][bj][m][1];
                    *(f32x4*)(X + o) = x0; *(f32x4*)(X + o + 4) = x1;
                    sq += ((x0[0] * x0[0] + x0[1] * x0[1]) + (x0[2] * x0[2] + x0[3] * x0[3])) + ((x1[0] * x1[0] + x1[1] * x1[1]) + (x1[2] * x1[2] + x1[3] * x1[3]));
                    const f32x4 h0 = x0 * gs[bj][0], h1 = x1 * gs[bj][1];
                    u32x4 w; w.x = cvt_pk_bf16(h0[0], h0[1]); w.y = cvt_pk_bf16(h0[2], h0[3]); w.z = cvt_pk_bf16(h1[0], h1[1]); w.w = cvt_pk_bf16(h1[2], h1[3]);
                    *(u32x4*)(H + o) = w; }
                const float t = xsum_fq(sq, fr, fq); if (fq == 0) atomicAdd(ssq + row, t);
                asm volatile("" ::: "memory"); }
    }
};
template <class Epi, class Sched, bool ALIGN_EPI = false, bool SP2 = false>
__device__ __forceinline__ void gemm_phase(PG8_LAS unsigned char* lds, const Gemm g, const Sched& S, const Epi& E) {
    const int tid = opaque_tid(), wid = __builtin_amdgcn_readfirstlane(tid >> 6), lane = tid & 63, wr = wid >> 2, wc = wid & 3, fr = lane & 15, fq = lane >> 4;
    const int K = g.K, nt = K / BK;
    unsigned voffA[2], voffB[2];
#pragma unroll
    for (int i = 0; i < 2; ++i) { int R, C; stage_rc(tid * 16 + i * 8192, R, C); const int Rb = E.PERM ? ((R & ~31) + perm32(R & 31)) : R;
        voffA[i] = (unsigned)(R * g.lda + C) * 2u; voffB[i] = (unsigned)(Rb * g.ldb + C) * 2u; }
    const size_t kstep = (size_t)(BK * 2);
    const size_t hstepA = (size_t)HALF * g.lda * 2, hstepB = (size_t)HALF * g.ldb * 2;
    const size_t tstepA = 2 * hstepA, tstepB = 2 * hstepB;
    const unsigned ldsw = (unsigned)wid * 1024u;
    const int aoff = lds_byte(wr * 64 + fr, fq * 8), boff = lds_byte(wc * 32 + fr, fq * 8);
#define PG8_SA(b, h) (((b) * 2 + (h)) * HTB)
#define PG8_SB(b, h) ((4 + (b) * 2 + (h)) * HTB)
#define PG8_STAGE(bufoff, gbase, voff) do { _Pragma("unroll") for (int _i = 0; _i < 2; ++_i) \
        __builtin_amdgcn_global_load_lds((const unsigned*)((const char*)(gbase) + (voff)[_i]), (PG8_LAS unsigned*)(lds + (bufoff) + ldsw + _i * 8192), 16, 0, 0); } while (0)
#define PG8_LDA(dst, b, h) do { _Pragma("unroll") for (int m = 0; m < 4; ++m) _Pragma("unroll") for (int k = 0; k < 2; ++k) dst[m][k] = *(const PG8_LAS bf16x8*)(lds + PG8_SA(b, h) + aoff + m * 2048 + k * 1024); } while (0)
#define PG8_LDB(dst, b, h) do { _Pragma("unroll") for (int n = 0; n < 2; ++n) _Pragma("unroll") for (int k = 0; k < 2; ++k) dst[n][k] = *(const PG8_LAS bf16x8*)(lds + PG8_SB(b, h) + boff + n * 2048 + k * 1024); } while (0)
#define PG8_MMA(ai, bj, At, Bt) do { __builtin_amdgcn_s_setprio(1); _Pragma("unroll") for (int m = 0; m < 4; ++m) _Pragma("unroll") for (int n = 0; n < 2; ++n) _Pragma("unroll") for (int k = 0; k < 2; ++k) \
        acc[ai][bj][m][n] = __builtin_amdgcn_mfma_f32_16x16x32_bf16(Bt[n][k], At[m][k], acc[ai][bj][m][n], 0, 0, 0); __builtin_amdgcn_s_setprio(0); } while (0)
#define PG8_WAIT_V(n) asm volatile("s_waitcnt vmcnt(" #n ")" ::: "memory")
#define PG8_WAIT_L(n) asm volatile("s_waitcnt lgkmcnt(" #n ")" ::: "memory")
#define PG8_BAR __builtin_amdgcn_s_barrier()
#define PG8_SCHED __builtin_amdgcn_sched_barrier(0)
    Unit cur, nxt; int ui = 0;
    if (!S.next(0, cur)) return;
    f32x4 acc[2][2][4][2];
#pragma unroll
    for (int a = 0; a < 2; ++a)
#pragma unroll
        for (int b = 0; b < 2; ++b)
#pragma unroll
            for (int m = 0; m < 4; ++m)
#pragma unroll
                for (int n = 0; n < 2; ++n) acc[a][b][m][n] = (f32x4){0.f, 0.f, 0.f, 0.f};
    bf16x8 At[4][2], B0[2][2], B1[2][2];
    const char* cA = (const char*)g.A + (size_t)cur.pm * tstepA; const char* cB = (const char*)g.Bt + (size_t)cur.pn * tstepB;
    S.a_ready(cur);
    if constexpr (SP2) {
        PG8_STAGE(PG8_SB(0, 0), cB, voffB); PG8_STAGE(PG8_SB(0, 1), cB + hstepB, voffB); PG8_STAGE(PG8_SA(0, 0), cA, voffA); PG8_STAGE(PG8_SA(0, 1), cA + hstepA, voffA);
        if (wr == 1) PG8_BAR;
        PG8_WAIT_V(2); PG8_BAR;
        PG8_STAGE(PG8_SB(1, 0), cB + kstep, voffB); PG8_STAGE(PG8_SA(1, 0), cA + kstep, voffA); PG8_STAGE(PG8_SB(1, 1), cB + hstepB + kstep, voffB);
        PG8_WAIT_V(6); PG8_BAR;
    } else {
        PG8_STAGE(PG8_SB(0, 0), cB, voffB); PG8_STAGE(PG8_SA(0, 0), cA, voffA); PG8_STAGE(PG8_SB(0, 1), cB + hstepB, voffB); PG8_STAGE(PG8_SA(0, 1), cA + hstepA, voffA);
        if (wr == 1) PG8_BAR;
        PG8_WAIT_V(4); PG8_BAR;
        PG8_STAGE(PG8_SB(1, 0), cB + kstep, voffB); PG8_STAGE(PG8_SA(1, 0), cA + kstep, voffA); PG8_STAGE(PG8_SB(1, 1), cB + hstepB + kstep, voffB);
        PG8_WAIT_V(6); PG8_BAR;
    }
    for (;;) {
        const bool has_next = S.next(ui + 1, nxt);
        const char* nA = has_next ? (const char*)g.A + (size_t)nxt.pm * tstepA : cA; const char* nB = has_next ? (const char*)g.Bt + (size_t)nxt.pn * tstepB : cB;
        for (int t = 0; t < nt; t += 2) {
            const bool last = (t == nt - 2);
            const char* a1 = cA + (size_t)(t + 1) * kstep;
            const char* a2 = last ? nA : cA + (size_t)(t + 2) * kstep; const char* b2 = last ? nB : cB + (size_t)(t + 2) * kstep;
            const char* a3 = a2 + kstep; const char* b3 = b2 + kstep;
            if (last && has_next) S.a_ready(nxt);
            if constexpr (SP2) {
            PG8_LDB(B0, 0, 0); PG8_LDB(B1, 0, 1); PG8_SCHED; PG8_LDA(At, 0, 0); PG8_STAGE(PG8_SA(1, 1), a1 + hstepA, voffA);
            PG8_WAIT_V(8); PG8_WAIT_L(0); PG8_BAR; PG8_MMA(0, 0, At, B0); PG8_MMA(0, 1, At, B1); PG8_BAR; PG8_SCHED;
            PG8_LDA(At, 0, 1); PG8_STAGE(PG8_SB(0, 0), b2, voffB); PG8_STAGE(PG8_SB(0, 1), b2 + hstepB, voffB); PG8_STAGE(PG8_SA(0, 0), a2, voffA);
            PG8_WAIT_V(8); PG8_WAIT_L(0); PG8_BAR; PG8_MMA(1, 0, At, B0); PG8_MMA(1, 1, At, B1); PG8_BAR; PG8_SCHED;
            PG8_LDB(B0, 1, 0); PG8_LDB(B1, 1, 1); PG8_SCHED; PG8_LDA(At, 1, 0); PG8_STAGE(PG8_SA(0, 1), a2 + hstepA, voffA);
            PG8_WAIT_V(8); PG8_WAIT_L(0); PG8_BAR; PG8_MMA(0, 0, At, B0); PG8_MMA(0, 1, At, B1); PG8_BAR; PG8_SCHED;
            PG8_LDA(At, 1, 1); PG8_STAGE(PG8_SB(1, 0), b3, voffB); PG8_STAGE(PG8_SB(1, 1), b3 + hstepB, voffB); PG8_STAGE(PG8_SA(1, 0), a3, voffA);
            PG8_WAIT_V(8); PG8_WAIT_L(0); PG8_BAR; PG8_MMA(1, 0, At, B0); PG8_MMA(1, 1, At, B1); PG8_BAR; PG8_SCHED;
            } else {
            PG8_LDB(B0, 0, 0); PG8_SCHED; PG8_LDA(At, 0, 0); PG8_STAGE(PG8_SA(1, 1), a1 + hstepA, voffA);
            PG8_WAIT_L(8); PG8_BAR; PG8_WAIT_L(0); PG8_MMA(0, 0, At, B0); PG8_BAR; PG8_SCHED;
            PG8_LDB(B1, 0, 1); PG8_STAGE(PG8_SB(0, 0), b2, voffB);
            PG8_BAR; PG8_WAIT_L(0); PG8_MMA(0, 1, At, B1); PG8_BAR;
            PG8_LDA(At, 0, 1); PG8_STAGE(PG8_SA(0, 0), a2, voffA);
            PG8_BAR; PG8_WAIT_L(0); PG8_MMA(1, 0, At, B0); PG8_BAR; PG8_SCHED;
            PG8_STAGE(PG8_SB(0, 1), b2 + hstepB, voffB);
            PG8_WAIT_V(6); PG8_BAR; PG8_MMA(1, 1, At, B1); PG8_BAR;
            PG8_LDB(B0, 1, 0); PG8_SCHED; PG8_LDA(At, 1, 0); PG8_STAGE(PG8_SA(0, 1), a2 + hstepA, voffA);
            PG8_WAIT_L(8); PG8_BAR; PG8_WAIT_L(0); PG8_MMA(0, 0, At, B0); PG8_BAR; PG8_SCHED;
            PG8_LDB(B1, 1, 1); PG8_STAGE(PG8_SB(1, 0), b3, voffB);
            PG8_BAR; PG8_WAIT_L(0); PG8_MMA(0, 1, At, B1); PG8_BAR;
            PG8_LDA(At, 1, 1); PG8_STAGE(PG8_SA(1, 0), a3, voffA);
            PG8_BAR; PG8_WAIT_L(0); PG8_MMA(1, 0, At, B0); PG8_BAR; PG8_SCHED;
            PG8_STAGE(PG8_SB(1, 1), b3 + hstepB, voffB);
            PG8_WAIT_V(6); PG8_BAR; PG8_MMA(1, 1, At, B1); PG8_BAR;
            }
        }
        if constexpr (ALIGN_EPI) { if (wr == 0) PG8_BAR; }
        if constexpr (!Epi::AFTER_DRAIN) { int fr2 = fr, fq2 = fq; asm volatile("" : "+v"(fr2), "+v"(fq2)); E(acc, cur, wr, wc, fr2, fq2); S.done(cur); }
        if (!has_next) break;
#pragma unroll
        for (int a = 0; a < 2; ++a)
#pragma unroll
            for (int b = 0; b < 2; ++b)
#pragma unroll
                for (int m = 0; m < 4; ++m)
#pragma unroll
                    for (int n = 0; n < 2; ++n) acc[a][b][m][n] = (f32x4){0.f, 0.f, 0.f, 0.f};
        cur = nxt; cA = nA; cB = nB; ++ui;
        if constexpr (ALIGN_EPI) { if (wr == 1) PG8_BAR; }
    }
    PG8_WAIT_V(0);
    if constexpr (!ALIGN_EPI) { if (wr == 0) PG8_BAR; }
    PG8_BAR;
    if constexpr (Epi::AFTER_DRAIN) { E.fused(acc, cur, wr, wc, fr, fq, lds, wid, lane); S.done(cur); }
#undef PG8_SA
#undef PG8_SB
#undef PG8_STAGE
#undef PG8_LDA
#undef PG8_LDB
#undef PG8_MMA
#undef PG8_WAIT_V
#undef PG8_WAIT_L
#undef PG8_BAR
#undef PG8_SCHED
}
}

#define LAS __attribute__((address_space(3)))
typedef unsigned short bf16;
typedef float f32x4 __attribute__((ext_vector_type(4)));
typedef unsigned u32x4 __attribute__((ext_vector_type(4)));
typedef unsigned u32x2 __attribute__((ext_vector_type(2)));
constexpr int DM = 1024, NCTX = 8192, MTOK = 12288, DINP = 2560, DFF = 4096;
constexpr int R_OFF = 0, K_OFF = 512, V_OFF = 1024, WD_OFF = 1536, AD_OFF = 1664, GD_OFF = 1792, F_OFF = 1920, P_OFF = 2176, DIN = 2432;
constexpr size_t MiB = 1u << 20;
constexpr size_t WS_CTL = 0, WS_MOD = 1 * MiB, WS_FW = 1 * MiB + 512 * 1024, WS_BC = 2 * MiB, WS_CS256 = 3 * MiB, WS_CS1024 = 4 * MiB, WS_WIN = 8 * MiB, WS_WOUT = 18 * MiB,
                 WS_W1 = 22 * MiB, WS_W2 = 38 * MiB, WS_H = 54 * MiB, WS_MIXED = 78 * MiB, WS_PROJ = 102 * MiB, WS_YCS = 162 * MiB, WS_YF = 102 * MiB, WS_YB = 126 * MiB  , WS_U = 174 * MiB, WS_KINV = 220 * MiB, WS_GUPT = 221 * MiB,
                 WS_FF = 102 * MiB, WS_WUPT = 222 * MiB, WS_AUPT = 222 * MiB + 256 * 1024, WS_SSQ = 223 * MiB, WS_WPT = 223 * MiB + 512 * 1024, WS_SW1 = 224 * MiB, WS_SWIN = 224 * MiB + 256 * 1024, WS_END = 225 * MiB;
constexpr int LDS_BYTES = 147456, RING_BYTES = 131072, MISC_OFF = RING_BYTES + 320;
constexpr int NTHR = 512;
enum { I_XP = 0, I_XS, I_STATE, I_C, I_CCTX, I_WADA, I_BADA, I_N1G, I_WIN, I_MU, I_W0, I_WUP, I_A0, I_AUP, I_GUP, I_KK, I_KA, I_RK, I_LNW, I_LNB, I_WFNET, I_WPOOL, I_PSCALE, I_WOUT, I_N2G, I_WFF1, I_WFF2, I_FNG, N_IN };
struct KP { const float* in[N_IN]; float* out; unsigned char* ws; int ph_lo, ph_hi; };
typedef const __attribute__((address_space(4))) KP CKP;

__device__ __forceinline__ unsigned f2bf(float f) { unsigned u = __builtin_bit_cast(unsigned, f); return (u + 0x7fffu + ((u >> 16) & 1u)) >> 16; }
__device__ __forceinline__ unsigned pk2(float lo, float hi) { return f2bf(lo) | (f2bf(hi) << 16); }
__device__ __forceinline__ float bflo(unsigned w) { return __builtin_bit_cast(float, w << 16); }
__device__ __forceinline__ float bfhi(unsigned w) { return __builtin_bit_cast(float, w & 0xffff0000u); }
__device__ __forceinline__ float bf1(bf16 h) { return __builtin_bit_cast(float, (unsigned)h << 16); }
__device__ __forceinline__ float fexp(float x) { return __builtin_amdgcn_exp2f(x * 1.4426950408889634f); }
__device__ __forceinline__ float flog(float x) { return __builtin_amdgcn_logf(x) * 0.6931471805599453f; }
__device__ __forceinline__ float frcp(float x) { return __builtin_amdgcn_rcpf(x); }
__device__ __forceinline__ float frsq(float x) { return __builtin_amdgcn_rsqf(x); }
__device__ __forceinline__ float fsigmoid(float x) { return frcp(1.0f + fexp(-x)); }
template <int CTRL> __device__ __forceinline__ float dppf(float x) { return __builtin_bit_cast(float, __builtin_amdgcn_update_dpp(0, __builtin_bit_cast(int, x), CTRL, 0xF, 0xF, true)); }
__device__ __forceinline__ float red8(float x)  { x += dppf<0xB1>(x); x += dppf<0x4E>(x); x += dppf<0x141>(x); return x; }
__device__ __forceinline__ float red16(float x) { x += dppf<0xB1>(x); x += dppf<0x4E>(x); x += dppf<0x141>(x); x += dppf<0x140>(x); return x; }
__device__ __forceinline__ float wave_sum(float v) {
    v = red16(v);
    const float s0 = __builtin_bit_cast(float, __builtin_amdgcn_readlane(__builtin_bit_cast(int, v), 0)), s1 = __builtin_bit_cast(float, __builtin_amdgcn_readlane(__builtin_bit_cast(int, v), 16));
    const float s2 = __builtin_bit_cast(float, __builtin_amdgcn_readlane(__builtin_bit_cast(int, v), 32)), s3 = __builtin_bit_cast(float, __builtin_amdgcn_readlane(__builtin_bit_cast(int, v), 48));
    return (s0 + s1) + (s2 + s3);
}
__device__ __forceinline__ void load4bf(const bf16* p, float (&o)[4]) { const u32x2 w = *(const u32x2*)p; o[0] = bflo(w.x); o[1] = bfhi(w.x); o[2] = bflo(w.y); o[3] = bfhi(w.y); }
__device__ __forceinline__ void load8bf(const bf16* p, float (&o)[8]) { const u32x4 w = *(const u32x4*)p; o[0] = bflo(w.x); o[1] = bfhi(w.x); o[2] = bflo(w.y); o[3] = bfhi(w.y); o[4] = bflo(w.z); o[5] = bfhi(w.z); o[6] = bflo(w.w); o[7] = bfhi(w.w); }
__device__ __forceinline__ void shift4(const bf16* proj, int row, bool hasp, bool hasn, int col, const float* mu, float (&u)[4]) {
    float p[4], a[4] = {0.f, 0.f, 0.f, 0.f}, b[4] = {0.f, 0.f, 0.f, 0.f};
    load4bf(proj + (size_t)row * DINP + col, p);
    if (hasp) load4bf(proj + (size_t)(row - 1) * DINP + col, a);
    if (hasn) load4bf(proj + (size_t)(row + 1) * DINP + col, b);
    const f32x4 m = *(const f32x4*)(mu + col);
#pragma unroll
    for (int j = 0; j < 4; ++j) u[j] = p[j] + m[j] * (0.5f * (a[j] + b[j]) - p[j]);
}

__device__ __forceinline__ void transpose_item(const float* W, int K, int N, bf16* WT, LAS float* scr, int item, int lane) {
    const int nblk = N / 32, kb = item / nblk, nb = item % nblk, k0 = 64 * kb, n0 = 32 * nb;
#pragma unroll 8
    for (int i = 0; i < 32; ++i) { const int kk = 2 * i + (lane >> 5); scr[kk * 33 + (lane & 31)] = W[(size_t)(k0 + kk) * N + n0 + (lane & 31)]; }
    asm volatile("s_waitcnt lgkmcnt(0)" ::: "memory");
    const int c = lane & 7;
#pragma unroll
    for (int j = 0; j < 4; ++j) { const int n = (lane >> 3) + 8 * j; const LAS float* s = scr + (8 * c) * 33 + n;
        u32x4 o; o.x = pk2(s[0 * 33], s[1 * 33]); o.y = pk2(s[2 * 33], s[3 * 33]); o.z = pk2(s[4 * 33], s[5 * 33]); o.w = pk2(s[6 * 33], s[7 * 33]);
        *(u32x4*)(WT + (size_t)(n0 + n) * K + k0 + 8 * c) = o; }
    asm volatile("s_waitcnt lgkmcnt(0)" ::: "memory");
}
__device__ __forceinline__ void gemv5_cols(LAS float* sc, LAS float* red, const float* W, int ldw, int colw, const float* bias, float* out, int ldo, int colo, int tid) {
    const int cgi = tid & 15, kg = tid >> 4;
    f32x4 acc[5];
#pragma unroll
    for (int c = 0; c < 5; ++c) acc[c] = (f32x4){0.f, 0.f, 0.f, 0.f};
    const float* wp = W + (size_t)(kg * 32) * ldw + colw + cgi * 4;
#pragma unroll 8
    for (int kk = 0; kk < 32; ++kk) { const f32x4 w = *(const f32x4*)(wp + (size_t)kk * ldw);
#pragma unroll
        for (int c = 0; c < 5; ++c) acc[c] += sc[c * 1024 + kg * 32 + kk] * w; }
#pragma unroll
    for (int c = 0; c < 5; ++c) *(LAS f32x4*)(red + (kg * 5 + c) * 64 + cgi * 4) = acc[c];
    __syncthreads();
    if (tid < 320) { const int cond = tid >> 6, col = tid & 63; float sm = bias ? bias[colo + col] : 0.f;
        for (int g = 0; g < 32; ++g) sm += red[(g * 5 + cond) * 64 + col];
        out[(size_t)cond * ldo + colo + col] = sm; }
    __syncthreads();
}
constexpr int TI_IN = 16 * 76, TI_OUT = 16 * 32, TI_1 = 16 * 128, TI_2 = 64 * 32, TI_L = TI_IN + TI_OUT + TI_1 + TI_2;
__device__ __forceinline__ void transpose_range(CKP& p, LAS unsigned char* lds, int first, int last, int bid, int nb) {
    const int tid = opaque_tid(), lane = tid & 63, wave = tid >> 6;
    unsigned char* ws = p.ws;
    LAS float* scr = (LAS float*)(lds + wave * 16384);
#pragma unroll 1
    for (int it = first + bid * 8 + wave; it < last; it += nb * 8) {
        const int l = it / TI_L; int r = it % TI_L;
        if (r < TI_IN) { transpose_item(p.in[I_WIN] + (size_t)l * DM * DIN, DM, DIN, (bf16*)(ws + WS_WIN) + (size_t)l * DINP * DM, scr, r, lane); continue; } r -= TI_IN;
        if (r < TI_OUT) { transpose_item(p.in[I_WOUT] + (size_t)l * DM * DM, DM, DM, (bf16*)(ws + WS_WOUT) + (size_t)l * DM * DM, scr, r, lane); continue; } r -= TI_OUT;
        if (r < TI_1) { transpose_item(p.in[I_WFF1] + (size_t)l * DM * DFF, DM, DFF, (bf16*)(ws + WS_W1) + (size_t)l * DFF * DM, scr, r, lane); continue; } r -= TI_1;
        transpose_item(p.in[I_WFF2] + (size_t)l * DFF * DM, DFF, DM, (bf16*)(ws + WS_W2) + (size_t)l * DM * DFF, scr, r, lane);
    }
}
__device__ __forceinline__ void stage_prologue(CKP& p, LAS unsigned char* lds, int bid, int nb) {
    const int tid = opaque_tid();
    unsigned char* ws = p.ws;
    transpose_range(p, lds, 0, TI_IN, bid, nb);
    const int gt = bid * NTHR + tid, NGT = nb * NTHR;
#pragma unroll 1
    for (int i = gt; i < 2 * 128 * DM / 8; i += NGT) { const int l = i / (128 * DM / 8), r = i % (128 * DM / 8);
        u32x4 z = (u32x4){0u, 0u, 0u, 0u}; asm volatile("" : "+v"(z));
        *(u32x4*)((bf16*)(ws + WS_WIN) + (size_t)l * DINP * DM + (size_t)DIN * DM + (size_t)r * 8) = z; }
#pragma unroll 1
    for (int i = gt; i < 256 * 512 + 1024 * 2048; i += NGT) {
        int L, k, j; bf16* dst;
        if (i < 256 * 512) { L = 256; k = i / 512; j = i % 512; dst = (bf16*)(ws + WS_CS256) + i; }
        else { const int i2 = i - 256 * 512; L = 1024; k = i2 / 2048; j = i2 % 2048; dst = (bf16*)(ws + WS_CS1024) + i2; }
        const int jj = j >= L ? j - L : j; const int idx = (k * jj) & (L - 1);
        const float rev = (float)idx / (float)L; const float s = __builtin_amdgcn_sinf(rev), c = __builtin_amdgcn_cosf(rev);
        *dst = (bf16)f2bf(j >= L ? -s : c);
    }
#pragma unroll 1
    for (int i = gt; i < 2 * 4 * 64 * 128; i += NGT) {
        const int o = i & 127, c = (i >> 7) & 63, lg = i >> 13; const float* wf = p.in[I_WFNET] + (size_t)lg * 4096 + (o & 63);
        float acc = 0.f;
        for (int cp = 0; cp < 64; ++cp) { const float rev = (float)((c * cp) & 63) * (1.0f / 64.0f); const float s = __builtin_amdgcn_sinf(rev), co = __builtin_amdgcn_cosf(rev); acc += (o < 64 ? co : s) * wf[cp * 64]; }
        ((bf16*)(ws + WS_FW))[(size_t)(lg * 128 + o) * 64 + c] = (bf16)f2bf(acc);
    }
#pragma unroll 1
    for (int i = gt; i < 2 * 4 * 64 * 64; i += NGT) { const int o = i & 63, c = (i >> 6) & 63, lg = i >> 12;
        ((bf16*)(ws + WS_WPT))[(size_t)(lg * 64 + o) * 64 + c] = (bf16)f2bf(p.in[I_WPOOL][i]); }
#pragma unroll 1
    for (int i = gt; i < 2 * 2 * 64 * 512; i += NGT) { const int c = i & 511, r = (i >> 9) & 63, ld = i >> 15;
        ((bf16*)(ws + WS_WUPT))[(size_t)(ld * 512 + c) * 64 + r] = (bf16)f2bf(p.in[I_WUP][i]);
        ((bf16*)(ws + WS_AUPT))[(size_t)(ld * 512 + c) * 64 + r] = (bf16)f2bf(p.in[I_AUP][i]); }
#pragma unroll 1
    for (int i = gt; i < 2 * 128 * 512; i += NGT) { const int c = i & 511, r = (i >> 9) & 127, ll = i >> 16;
        ((bf16*)(ws + WS_GUPT))[(size_t)(ll * 512 + c) * 128 + r] = (bf16)f2bf(p.in[I_GUP][i]); }
    __syncthreads();
    LAS float* sc = (LAS float*)lds; LAS float* red = (LAS float*)(lds + 20480);
#pragma unroll 1
    for (int it = bid; it < 192; it += nb) {
        const int l = it / 96, cgp = it % 96;
        for (int i = tid; i < 5 * 1024; i += NTHR) { const int cond = i >> 10, k = i & 1023; const float v = cond == 0 ? p.in[I_CCTX][k] : p.in[I_C][(cond - 1) * 1024 + k]; sc[i] = v * fsigmoid(v); }
        __syncthreads();
        gemv5_cols(sc, red, p.in[I_WADA] + (size_t)l * 1024 * 6144, 6144, cgp * 64, p.in[I_BADA] + l * 6144, (float*)(ws + WS_MOD) + (size_t)l * 5 * 6144, 6144, cgp * 64, tid);
    }
}
__device__ __forceinline__ void shiftw_item(CKP& p, LAS unsigned char* lds, int it) {
    const int tid = opaque_tid();
    unsigned char* ws = p.ws;
    LAS float* sc = (LAS float*)lds; LAS float* red = (LAS float*)(lds + 20480);
    const bool isin = it >= 128; const int l = isin ? 1 : it >> 6, blk = isin ? it - 128 : it & 63;
    const float* shv = (const float*)(ws + WS_MOD) + (size_t)l * 5 * 6144 + (isin ? 0 : 3 * 1024);
    for (int i = tid; i < 5 * 1024; i += NTHR) sc[i] = shv[(i >> 10) * 6144 + (i & 1023)];
    __syncthreads();
    if (isin) gemv5_cols(sc, red, p.in[I_WIN] + (size_t)DM * DIN, DIN, blk * 64, nullptr, (float*)(ws + WS_SWIN), DINP, blk * 64, tid);
    else gemv5_cols(sc, red, p.in[I_WFF1] + (size_t)l * DM * DFF, DFF, blk * 64, nullptr, (float*)(ws + WS_SW1) + (size_t)l * 5 * DFF, DFF, blk * 64, tid);
    if (it == 165) for (int i = tid; i < 5 * 128; i += NTHR) ((float*)(ws + WS_SWIN))[(i >> 7) * DINP + DIN + (i & 127)] = 0.f;
}
__device__ __forceinline__ void side_queue(CKP& p, int l, LAS unsigned char* lds) {
    const int tid = opaque_tid();
    unsigned* ctr = (unsigned*)(p.ws + WS_CTL + 524288) + 64 * l;
    volatile LAS unsigned* slot = (volatile LAS unsigned*)(lds + RING_BYTES + 64);
    const int nsh = l == 0 ? 166 : 0, first = l == 0 ? TI_IN : TI_L + TI_IN, nch = ((l == 0 ? TI_L + TI_IN : 2 * TI_L) - first) / 8;
    __syncthreads();
#pragma unroll 1
    for (;;) {
        if (tid == 0) *slot = atomicAdd(ctr, 1u);
        __syncthreads();
        const int it = (int)*slot;
        __syncthreads();
        if (it >= nsh + nch) break;
        if (it < nsh) shiftw_item(p, lds, it);
        else { const int c0 = first + 8 * (it - nsh); transpose_range(p, lds, c0, c0 + 8, 0, 1); }
        __syncthreads();
    }
}

__device__ __forceinline__ void stage_norm(CKP& p, int l, int which, int bid, int nb) {
    const int tid = opaque_tid(), lane = tid & 63, wave = tid >> 6;
    const float* g = p.in[which ? I_N2G : I_N1G] + l * DM;
    const float* mod = (const float*)(p.ws + WS_MOD) + (size_t)l * 5 * 6144 + (which ? 3 * 1024 : 0);
    bf16* H = (bf16*)(p.ws + WS_H);
#pragma unroll 1
    for (int row = bid * 8 + wave; row < MTOK; row += nb * 8) {
        const float* xsrc = (l == 0 && which == 0) ? (row < NCTX ? p.in[I_XP] + (size_t)row * DM : p.in[I_XS] + (size_t)(row - NCTX) * DM) : p.out + (size_t)row * DM;
        const f32x4* xr = (const f32x4*)xsrc + lane;
        f32x4 v[4]; float s = 0.f;
#pragma unroll
        for (int j = 0; j < 4; ++j) { v[j] = xr[64 * j]; s += (v[j].x * v[j].x + v[j].y * v[j].y) + (v[j].z * v[j].z + v[j].w * v[j].w); }
        const float rstd = frsq(wave_sum(s) * (1.0f / DM) + 1e-6f);
        const int cond = row < NCTX ? 0 : 1 + ((row - NCTX) >> 10);
        const float* sh = mod + cond * 6144; const float* scl = sh + 1024;
        unsigned long long* o8 = (unsigned long long*)(H + (size_t)row * DM) + lane;
#pragma unroll
        for (int j = 0; j < 4; ++j) { const int col = 4 * lane + 256 * j; const f32x4 gg = *(const f32x4*)(g + col), a = *(const f32x4*)(sh + col), b = *(const f32x4*)(scl + col);
            const f32x4 y = v[j] * rstd * gg * (b + 1.0f) + a;
            o8[64 * j] = (unsigned long long)pk2(y.x, y.y) | ((unsigned long long)pk2(y.z, y.w) << 32); }
    }
}
__device__ __forceinline__ void stage_final(CKP& p, int bid, int nb) {
    const int tid = opaque_tid(), lane = tid & 63, wave = tid >> 6;
    const float* g = p.in[I_FNG];
#pragma unroll 1
    for (int row = bid * 8 + wave; row < MTOK; row += nb * 8) {
        f32x4* xr = (f32x4*)(p.out + (size_t)row * DM) + lane;
        f32x4 v[4]; float s = 0.f;
#pragma unroll
        for (int j = 0; j < 4; ++j) { v[j] = xr[64 * j]; s += (v[j].x * v[j].x + v[j].y * v[j].y) + (v[j].z * v[j].z + v[j].w * v[j].w); }
        const float rstd = frsq(wave_sum(s) * (1.0f / DM) + 1e-6f);
#pragma unroll
        for (int j = 0; j < 4; ++j) xr[64 * j] = v[j] * rstd * *(const f32x4*)(g + 4 * lane + 256 * j);
    }
}


typedef short bf16x8 __attribute__((ext_vector_type(8)));
typedef float f32x2v __attribute__((ext_vector_type(2)));
typedef __bf16 bf16x2v __attribute__((ext_vector_type(2)));
#define MFMA16(a, b, c) __builtin_amdgcn_mfma_f32_16x16x32_bf16((a), (b), (c), 0, 0, 0)
__device__ __forceinline__ unsigned cvt2(float lo, float hi) { f32x2v v = {lo, hi}; bf16x2v b = __builtin_convertvector(v, bf16x2v); return __builtin_bit_cast(unsigned, b); }
__device__ __forceinline__ u32x4 pack8(const float (&x)[8]) { u32x4 w; w.x = cvt2(x[0], x[1]); w.y = cvt2(x[2], x[3]); w.z = cvt2(x[4], x[5]); w.w = cvt2(x[6], x[7]); return w; }
__device__ __forceinline__ void shift8(const bf16* proj, int row, bool hasp, bool hasn, int col, const float* mu, float (&u)[8]) {
    float p[8], a[8], b[8];
    load8bf(proj + (size_t)row * DINP + col, p);
    if (hasp) load8bf(proj + (size_t)(row - 1) * DINP + col, a); else {
#pragma unroll
        for (int j = 0; j < 8; ++j) a[j] = 0.f; }
    if (hasn) load8bf(proj + (size_t)(row + 1) * DINP + col, b); else {
#pragma unroll
        for (int j = 0; j < 8; ++j) b[j] = 0.f; }
    const f32x4 m0 = *(const f32x4*)(mu + col), m1 = *(const f32x4*)(mu + col + 4);
#pragma unroll
    for (int j = 0; j < 4; ++j) { u[j] = p[j] + m0[j] * (0.5f * (a[j] + b[j]) - p[j]); u[4 + j] = p[4 + j] + m1[j] * (0.5f * (a[4 + j] + b[4 + j]) - p[4 + j]); }
}
__device__ __forceinline__ int opq(int x) { asm volatile("" : "+v"(x)); return x; }
constexpr int TS = 72, TB = 64 * TS * 2;
constexpr int L_HT = 0, L_TW = 9216, L_AD = 18432, L_LP = 27648, L_AP = 45056, L_AT = 62464, L_RT = L_AT + TB, L_BH = L_RT + TB, L_KH = L_BH + TB, L_VR = L_KH + TB, L_YS = L_VR + TB;
constexpr int L_AAB = L_TW, L_AAK = L_AAB + 4096, L_ARB = L_AAK + 3072, L_ARK = L_ARB + 3072, L_UT = L_ARK + 3072, L_W1 = L_AP;
static_assert(L_UT + 64 * 24 * 2 <= L_LP && L_YS + 17408 <= RING_BYTES, "scan LDS map");
constexpr int LPS = 68;
#define LBAR() asm volatile("s_waitcnt lgkmcnt(0)\n\ts_barrier" ::: "memory")
typedef short s16x4v __attribute__((ext_vector_type(4)));
__device__ __forceinline__ bf16x8 tr8(const LAS bf16* p) {
    const s16x4v lo = __builtin_bit_cast(s16x4v, __builtin_amdgcn_ds_read_tr16_b64_v4i16((LAS s16x4v*)p));
    const s16x4v hi = __builtin_bit_cast(s16x4v, __builtin_amdgcn_ds_read_tr16_b64_v4i16((LAS s16x4v*)(p + 4 * TS)));
    return (bf16x8){lo[0], lo[1], lo[2], lo[3], hi[0], hi[1], hi[2], hi[3]};
}

__device__ __forceinline__ void rwkv_item3(CKP& p, int l, LAS unsigned char* lds, int item) {
    const int tid0 = opaque_tid(), w = __builtin_amdgcn_readfirstlane(tid0 >> 6);
    int tid = tid0, fr = tid & 15, fg = (tid & 63) >> 4;
    int bseq, h, dir, L, base; bool lat;
    if (item < 64) { lat = true; bseq = item >> 4; h = (item >> 1) & 7; dir = item & 1; L = 1024; base = NCTX + bseq * 1024; }
    else { const int i2 = item - 64; lat = false; bseq = i2 >> 4; h = (i2 >> 1) & 7; dir = i2 & 1; L = 256; base = bseq * 256; }
    const bf16* U = (const bf16*)(p.ws + WS_U);
    const float* KINV = (const float*)(p.ws + WS_KINV);
    float* Yout = (float*)(p.ws + (dir ? WS_YB : WS_YF));
    float* BC = (float*)(p.ws + WS_BC) + (size_t)dir * MTOK * 8;
    const bf16* wupt = (const bf16*)(p.ws + WS_WUPT) + ((size_t)(l * 2 + dir) * 512 + h * 64) * 64;
    const bf16* aupt = (const bf16*)(p.ws + WS_AUPT) + ((size_t)(l * 2 + dir) * 512 + h * 64) * 64;

    LAS float* LP = (LAS float*)(lds + L_LP); LAS float* AP = (LAS float*)(lds + L_AP); LAS float* AS = (LAS float*)(lds + L_TW);
    LAS bf16* AT = (LAS bf16*)(lds + L_AT);   LAS bf16* RT = (LAS bf16*)(lds + L_RT);   LAS bf16* BH = (LAS bf16*)(lds + L_BH);   LAS bf16* KH = (LAS bf16*)(lds + L_KH);
    LAS bf16* VR = (LAS bf16*)(lds + L_VR);   LAS float* YS = (LAS float*)(lds + L_YS);
    LAS float* AAB = (LAS float*)(lds + L_AAB); LAS bf16* AAK = (LAS bf16*)(lds + L_AAK); LAS bf16* ARB = (LAS bf16*)(lds + L_ARB); LAS bf16* ARK = (LAS bf16*)(lds + L_ARK);
    LAS float* W1 = (LAS float*)(lds + L_W1);
    const int tv = w & 3;
    f32x4 hacc[4];
#pragma unroll
    for (int x = 0; x < 4; ++x) {
        if (lat && w < 4) hacc[x] = *(const f32x4*)(p.in[I_STATE] + ((((size_t)bseq * 2 + l) * 2 + dir) * 8 + h) * 4096 + (16 * tv + fr) * 64 + 16 * x + 4 * fg);
        else hacc[x] = (f32x4){0.f, 0.f, 0.f, 0.f}; }
    int ei = tid >> 3, ec8 = (tid & 7) * 8; const int hc8 = h * 64 + ec8;
    float kkp[8], kap[8], rkp[8];
#pragma unroll
    for (int e = 0; e < 8; ++e) { kkp[e] = p.in[I_KK][l * 512 + hc8 + e]; kap[e] = p.in[I_KA][l * 512 + hc8 + e]; rkp[e] = p.in[I_RK][l * 512 + hc8 + e]; }
#define SCAN_PREFETCH(SC) do { const int _t0 = opq(tid0), _ei = _t0 >> 3, _ec8 = (_t0 & 7) * 8; const int _step = (SC) * 64 + _ei, _t = dir ? L - 1 - _step : _step; \
        const bf16* _u = U + (size_t)(base + _t) * 1920; \
        nr = *(const u32x4*)(_u + R_OFF + h * 64 + _ec8); nk = *(const u32x4*)(_u + K_OFF + h * 64 + _ec8); nv = *(const u32x4*)(_u + V_OFF + h * 64 + _ec8); \
        ninv = KINV[(size_t)(base + _t) * 8 + h]; \
        const int _st2 = (SC) * 64 + 16 * (w >> 1) + (_t0 & 15), _t2 = dir ? L - 1 - _st2 : _st2; const bf16* _u2 = U + (size_t)(base + _t2) * 1920 + dir * 64 + ((_t0 & 63) >> 4) * 8; \
        paw0 = *(const bf16x8*)(_u2 + WD_OFF); paw1 = *(const bf16x8*)(_u2 + WD_OFF + 32); paa0 = *(const bf16x8*)(_u2 + AD_OFF); paa1 = *(const bf16x8*)(_u2 + AD_OFF + 32); } while (0)
    bf16x8 lbw[2][2], lba[2][2]; float lw0c[2], la0c[2];
#pragma unroll
    for (int x = 0; x < 2; ++x) { const int c = ((w & 1) * 2 + x) * 16 + fr;
        lbw[x][0] = *(const bf16x8*)(wupt + c * 64 + fg * 8); lbw[x][1] = *(const bf16x8*)(wupt + c * 64 + 32 + fg * 8);
        lba[x][0] = *(const bf16x8*)(aupt + c * 64 + fg * 8); lba[x][1] = *(const bf16x8*)(aupt + c * 64 + 32 + fg * 8);
        lw0c[x] = p.in[I_W0][(l * 2 + dir) * 512 + h * 64 + c]; la0c[x] = p.in[I_A0][(l * 2 + dir) * 512 + h * 64 + c]; }
    u32x4 nr, nk, nv; float ninv; bf16x8 paw0, paw1, paa0, paa1;
    SCAN_PREFETCH(0);
    __syncthreads();
#pragma unroll 1
    for (int sc = 0; sc < L / 64; ++sc) {
        tid = opq(tid0); fr = tid & 15; fg = (tid & 63) >> 4; ei = tid >> 3; ec8 = (tid & 7) * 8;
        const u32x4 cr = nr, ck = nk, cv = nv; const float kinv = ninv;
        { const int ti = w >> 1;
          const bf16x8 aw0 = paw0, aw1 = paw1, aa0 = paa0, aa1 = paa1;
          unsigned li[2], ls[2];
#pragma unroll
          for (int pr = 0; pr < 2; ++pr) { const int j0 = 4 * fg + 2 * pr, j1 = j0 + 1;
              li[pr] = (j0 <= fr ? 0x3f80u : 0u) | (j1 <= fr ? 0x3f800000u : 0u); ls[pr] = (j0 < fr ? 0x3f80u : 0u) | (j1 < fr ? 0x3f800000u : 0u); }
          const bf16x8 Li = __builtin_bit_cast(bf16x8, (u32x4){li[0], li[1], 0u, 0u}), Ls = __builtin_bit_cast(bf16x8, (u32x4){ls[0], ls[1], 0u, 0u});
#pragma unroll
          for (int x = 0; x < 2; ++x) { const int c = ((w & 1) * 2 + x) * 16 + fr;
              f32x4 cw = (f32x4){lw0c[x], lw0c[x], lw0c[x], lw0c[x]}, ca = (f32x4){la0c[x], la0c[x], la0c[x], la0c[x]};
              cw = MFMA16(aw0, lbw[x][0], cw); cw = MFMA16(aw1, lbw[x][1], cw); ca = MFMA16(aa0, lba[x][0], ca); ca = MFMA16(aa1, lba[x][1], ca);
              float lw[4], lo[4];
#pragma unroll
              for (int r = 0; r < 4; ++r) lw[r] = -0.6065306597126334f * fsigmoid(cw[r]);
              const unsigned h01 = cvt2(lw[0], lw[1]), h23 = cvt2(lw[2], lw[3]);
              lo[0] = lw[0] - bflo(h01); lo[1] = lw[1] - bfhi(h01); lo[2] = lw[2] - bflo(h23); lo[3] = lw[3] - bfhi(h23);
              const bf16x8 bh = __builtin_bit_cast(bf16x8, (u32x4){h01, h23, 0u, 0u}), bl = __builtin_bit_cast(bf16x8, (u32x4){cvt2(lo[0], lo[1]), cvt2(lo[2], lo[3]), 0u, 0u});
              f32x4 ci = (f32x4){0.f, 0.f, 0.f, 0.f}, cs = ci;
              ci = MFMA16(Li, bh, ci); ci = MFMA16(Li, bl, ci); cs = MFMA16(Ls, bh, cs); cs = MFMA16(Ls, bl, cs);
#pragma unroll
              for (int r = 0; r < 4; ++r) { const int o = (ti * 16 + 4 * fg + r) * LPS + c;
                  LP[o] = fexp(ci[r]); AP[o] = fexp(cs[r]); AS[o] = fsigmoid(ca[r]); } } }
        __syncthreads();
        tid = opq(tid0); fr = tid & 15; fg = (tid & 63) >> 4; ei = tid >> 3; ec8 = (tid & 7) * 8;
        float bcv;
        { const f32x4 g0 = *(const LAS f32x4*)(LP + ei * LPS + ec8), g1 = *(const LAS f32x4*)(LP + ei * LPS + ec8 + 4);
          const f32x4 p0 = *(const LAS f32x4*)(AP + ei * LPS + ec8), p1 = *(const LAS f32x4*)(AP + ei * LPS + ec8 + 4);
          const f32x4 s0 = *(const LAS f32x4*)(AS + ei * LPS + ec8), s1 = *(const LAS f32x4*)(AS + ei * LPS + ec8 + 4);
          float rr[8], kk[8], xa[8], xr[8], xb[8], xk[8], bc = 0.f;
          rr[0] = bflo(cr.x); rr[1] = bfhi(cr.x); rr[2] = bflo(cr.y); rr[3] = bfhi(cr.y); rr[4] = bflo(cr.z); rr[5] = bfhi(cr.z); rr[6] = bflo(cr.w); rr[7] = bfhi(cr.w);
          kk[0] = bflo(ck.x); kk[1] = bfhi(ck.x); kk[2] = bflo(ck.y); kk[3] = bfhi(ck.y); kk[4] = bflo(ck.z); kk[5] = bfhi(ck.z); kk[6] = bflo(ck.w); kk[7] = bfhi(ck.w);
#pragma unroll
          for (int e = 0; e < 8; ++e) { const float gi = e < 4 ? g0[e & 3] : g1[e & 3], gp = e < 4 ? p0[e & 3] : p1[e & 3], asg = e < 4 ? s0[e & 3] : s1[e & 3];
              const float kj = kk[e] * kkp[e] * kinv, kd = kk[e] * (1.0f + (asg - 1.0f) * kap[e]), ginv = frcp(gi);
              bc += rr[e] * kd * rkp[e];
              xa[e] = -kj * gp; xr[e] = rr[e] * gi; xb[e] = kj * asg * ginv; xk[e] = kd * ginv; }
          bcv = red8(bc);
          *(LAS u32x4*)(AT + ei * TS + ec8) = pack8(xa); *(LAS u32x4*)(RT + ei * TS + ec8) = pack8(xr); *(LAS u32x4*)(BH + ei * TS + ec8) = pack8(xb); *(LAS u32x4*)(KH + ei * TS + ec8) = pack8(xk);
          *(LAS u32x4*)(VR + ei * TS + ec8) = cv; }
        __syncthreads();
        tid = opq(tid0); fr = tid & 15; fg = (tid & 63) >> 4;
        { const int q = w >> 1, half = w & 1; const LAS bf16* Asrc = half ? RT : AT;
          const bf16x8 af0 = *(const LAS bf16x8*)(Asrc + (16 * q + fr) * TS + fg * 8), af1 = *(const LAS bf16x8*)(Asrc + (16 * q + fr) * TS + 32 + fg * 8);
#pragma unroll
          for (int x = 0; x < 2; ++x) { const LAS bf16* Bsrc = x ? KH : BH;
              const bf16x8 bf0 = *(const LAS bf16x8*)(Bsrc + (16 * q + fr) * TS + fg * 8), bf1_ = *(const LAS bf16x8*)(Bsrc + (16 * q + fr) * TS + 32 + fg * 8);
              f32x4 c = (f32x4){0.f, 0.f, 0.f, 0.f}; c = MFMA16(af0, bf0, c); c = MFMA16(af1, bf1_, c);
              f32x4 cm;
#pragma unroll
              for (int r = 0; r < 4; ++r) { const int i = 4 * fg + r, j = fr; cm[r] = (half ? j <= i : j < i) ? c[r] : 0.f; }
              if (half == 0 && x == 0) *(LAS f32x4*)(AAB + (q * 16 + fr) * 16 + 4 * fg) = cm;
              else { LAS bf16* dst = half == 0 ? AAK : (x == 0 ? ARB : ARK);
#pragma unroll
                  for (int r = 0; r < 4; ++r) dst[(q * 16 + 4 * fg + r) * 24 + fr] = (bf16)(cvt2(cm[r], 0.f) & 0xffffu); } } }
        __syncthreads();
        tid = opq(tid0); fr = tid & 15; fg = (tid & 63) >> 4;
        { const int q = w >> 1;
          const bf16x8 afr = *(const LAS bf16x8*)(AAK + (q * 16 + fr) * 24 + (fg & 1) * 8);
          const unsigned kmask = fg < 2 ? 0xffffffffu : 0u;
          const bf16x8 af = __builtin_bit_cast(bf16x8, __builtin_bit_cast(u32x4, afr) & kmask);
#pragma unroll
          for (int x = 0; x < 2; ++x) { const int tvv = (w & 1) * 2 + x;
              const bf16x8 bfr = tr8(VR + (16 * q + 8 * (fg & 1) + (fr >> 2)) * TS + 16 * tvv + 4 * (fr & 3));
              const bf16x8 bfv = __builtin_bit_cast(bf16x8, __builtin_bit_cast(u32x4, bfr) & kmask);
              f32x4 c = (f32x4){0.f, 0.f, 0.f, 0.f}; c = MFMA16(af, bfv, c);
#pragma unroll
              for (int r = 0; r < 4; ++r) W1[(q * 16 + 4 * fg + r) * LPS + 16 * tvv + fr] = c[r]; } }
        __syncthreads();
        tid = opq(tid0);
        { const int q = tid >> 7, col = tid & 127; float x[16];
          if (col < 64) {
#pragma unroll
              for (int i = 0; i < 16; ++i) x[i] = bf1(AT[(16 * q + i) * TS + col]); }
          else {
#pragma unroll
              for (int i = 0; i < 16; ++i) x[i] = W1[(q * 16 + i) * LPS + col - 64]; }
#pragma unroll
          for (int j = 0; j < 15; ++j) {
              const LAS f32x4* ac = (const LAS f32x4*)(AAB + (q * 16 + j) * 16);
#pragma unroll
              for (int i4 = (j + 1) / 4; i4 < 4; ++i4) { const f32x4 a4 = ac[i4];
#pragma unroll
                  for (int e = 0; e < 4; ++e) if (i4 * 4 + e > j) x[i4 * 4 + e] += a4[e] * x[j]; } }
          if (col < 64) {
#pragma unroll
              for (int i = 0; i < 16; ++i) AT[(16 * q + i) * TS + col] = (bf16)(cvt2(x[i], 0.f) & 0xffffu); }
          else {
#pragma unroll
              for (int i = 0; i < 16; ++i) W1[(q * 16 + i) * LPS + col - 64] = x[i]; } }
        __syncthreads();
        if (sc + 1 < L / 64) SCAN_PREFETCH(sc + 1);
        if (w < 4) {
#pragma unroll 1
        for (int q = 0; q < 4; ++q) {
            tid = opq(tid0); fr = tid & 15; fg = (tid & 63) >> 4;
            bf16x8 hb[2];
#pragma unroll
            for (int ks = 0; ks < 2; ++ks) { u32x4 t; t.x = cvt2(hacc[2 * ks][0], hacc[2 * ks][1]); t.y = cvt2(hacc[2 * ks][2], hacc[2 * ks][3]);
                t.z = cvt2(hacc[2 * ks + 1][0], hacc[2 * ks + 1][1]); t.w = cvt2(hacc[2 * ks + 1][2], hacc[2 * ks + 1][3]); hb[ks] = __builtin_bit_cast(bf16x8, t); }
            bf16x8 aU[2], aR[2];
#pragma unroll
            for (int ks = 0; ks < 2; ++ks) {
                const u32x2 a0 = *(const LAS u32x2*)(AT + (16 * q + fr) * TS + 32 * ks + 4 * fg), a1 = *(const LAS u32x2*)(AT + (16 * q + fr) * TS + 32 * ks + 16 + 4 * fg);
                const u32x2 r0 = *(const LAS u32x2*)(RT + (16 * q + fr) * TS + 32 * ks + 4 * fg), r1 = *(const LAS u32x2*)(RT + (16 * q + fr) * TS + 32 * ks + 16 + 4 * fg);
                aU[ks] = __builtin_bit_cast(bf16x8, (u32x4){a0.x, a0.y, a1.x, a1.y}); aR[ks] = __builtin_bit_cast(bf16x8, (u32x4){r0.x, r0.y, r1.x, r1.y}); }
            f32x4 u, yacc = (f32x4){0.f, 0.f, 0.f, 0.f};
#pragma unroll
            for (int r = 0; r < 4; ++r) u[r] = W1[(q * 16 + 4 * fg + r) * LPS + 16 * tv + fr];
            u = MFMA16(aU[0], hb[0], u); u = MFMA16(aU[1], hb[1], u);
            yacc = MFMA16(aR[0], hb[0], yacc); yacc = MFMA16(aR[1], hb[1], yacc);
            const s16x4v vtr = __builtin_bit_cast(s16x4v, __builtin_amdgcn_ds_read_tr16_b64_v4i16((LAS s16x4v*)(VR + (16 * q + 4 * fg + (fr >> 2)) * TS + 16 * tv + 4 * (fr & 3))));
            const u32x2 vt2 = __builtin_bit_cast(u32x2, vtr);
            const bf16x8 bUV = __builtin_bit_cast(bf16x8, (u32x4){cvt2(u[0], u[1]), cvt2(u[2], u[3]), vt2.x, vt2.y});
            { const u32x2 y0 = *(const LAS u32x2*)(ARB + (q * 16 + fr) * 24 + 4 * fg), y1 = *(const LAS u32x2*)(ARK + (q * 16 + fr) * 24 + 4 * fg);
              yacc = MFMA16(__builtin_bit_cast(bf16x8, (u32x4){y0.x, y0.y, y1.x, y1.y}), bUV, yacc); }
#pragma unroll
            for (int r = 0; r < 4; ++r) YS[(16 * q + 4 * fg + r) * LPS + 16 * tv + fr] = yacc[r];
#pragma unroll
            for (int x = 0; x < 4; ++x) {
                const s16x4v bt = __builtin_bit_cast(s16x4v, __builtin_amdgcn_ds_read_tr16_b64_v4i16((LAS s16x4v*)(BH + (16 * q + 4 * fg + (fr >> 2)) * TS + 16 * x + 4 * (fr & 3))));
                const s16x4v kt = __builtin_bit_cast(s16x4v, __builtin_amdgcn_ds_read_tr16_b64_v4i16((LAS s16x4v*)(KH + (16 * q + 4 * fg + (fr >> 2)) * TS + 16 * x + 4 * (fr & 3))));
                const u32x2 b2 = __builtin_bit_cast(u32x2, bt), k2 = __builtin_bit_cast(u32x2, kt);
                const f32x4 ge = *(const LAS f32x4*)(LP + (16 * q + 15) * LPS + 16 * x + 4 * fg);
                hacc[x] = MFMA16(__builtin_bit_cast(bf16x8, (u32x4){b2.x, b2.y, k2.x, k2.y}), bUV, hacc[x]) * ge; }
        }
        }
        __syncthreads();
        tid = opq(tid0); ei = tid >> 3; ec8 = (tid & 7) * 8;
        { const int st2 = sc * 64 + ei, t2 = dir ? L - 1 - st2 : st2; float* yo = Yout + (size_t)(base + t2) * 512 + h * 64 + ec8;
          *(f32x4*)yo = *(const LAS f32x4*)(YS + ei * LPS + ec8); *(f32x4*)(yo + 4) = *(const LAS f32x4*)(YS + ei * LPS + ec8 + 4);
          if ((tid & 7) == 0) BC[(size_t)(base + t2) * 8 + h] = bcv; }
    }
#undef SCAN_PREFETCH
    if (!lat && w < 4) {
#pragma unroll
        for (int x = 0; x < 4; ++x) *(f32x4*)(p.out + (size_t)MTOK * DM + ((((size_t)bseq * 2 + l) * 2 + dir) * 8 + h) * 4096 + (16 * tv + fr) * 64 + 16 * x + 4 * fg) = hacc[x]; }
    __syncthreads();
}

__device__ __forceinline__ void stage_upass(CKP& p, int l, int bid, int nb) {
    const int tid = opaque_tid(), sub = tid >= 240 ? 1 : 0, j = tid - sub * 240, col = 8 * j;
    const bf16* proj = (const bf16*)(p.ws + WS_PROJ); bf16* U = (bf16*)(p.ws + WS_U); float* KINV = (float*)(p.ws + WS_KINV);
    const float* mu = p.in[I_MU] + l * 1920;
    if (tid < 480) {
        const bool isk = col >= K_OFF && col < V_OFF;
        const float* kkp = p.in[I_KK] + l * 512 + (isk ? col - K_OFF : 0);
        const f32x4 k0 = *(const f32x4*)kkp, k1 = *(const f32x4*)(kkp + 4);
#pragma unroll 1
        for (int tok0 = bid * 2 + sub; tok0 < MTOK; tok0 += nb * 8) {
            float uu[4][8];
#pragma unroll
            for (int z = 0; z < 4; ++z) { const int tok = min(tok0 + z * nb * 2, MTOK - 1);
                const bool lat = tok >= NCTX; const int L = lat ? 1024 : 256, t = lat ? (tok - NCTX) & 1023 : tok & 255;
                shift8(proj, tok, t > 0, t < L - 1, col, mu, uu[z]); }
#pragma unroll
            for (int z = 0; z < 4; ++z) { const int tok = tok0 + z * nb * 2;
                float ss = 0.f;
#pragma unroll
                for (int e = 0; e < 8; ++e) { const float kn = uu[z][e] * (e < 4 ? k0[e & 3] : k1[e & 3]); ss += kn * kn; }
                ss = red8(ss);
                if (tok < MTOK) {
                    if (isk && (j & 7) == 0) KINV[(size_t)tok * 8 + ((col - K_OFF) >> 6)] = fminf(frsq(ss), 1e12f);
                    if (col >= WD_OFF && col < AD_OFF) {
#pragma unroll
                        for (int e = 0; e < 8; ++e) uu[z][e] = 1.0f - 2.0f * frcp(fexp(2.0f * uu[z][e]) + 1.0f); }
                    if (col >= GD_OFF) {
#pragma unroll
                        for (int e = 0; e < 8; ++e) uu[z][e] = fsigmoid(uu[z][e]); }
                    *(u32x4*)(U + (size_t)tok * 1920 + col) = pack8(uu[z]); } }
        }
    }
}

__device__ __forceinline__ void fnet1_item(CKP& p, int l, int item) {
    const int tid = opaque_tid(), lane = tid & 63, w = __builtin_amdgcn_readfirstlane(tid >> 6), fr = lane & 15, fg = lane >> 4;
    const int tb = item >> 2, g = item & 3, tok0 = tb * 64, tt = w & 3, cs = w >> 2;
    const bf16* proj = (const bf16*)(p.ws + WS_PROJ);
    const bf16* fwt = (const bf16*)(p.ws + WS_FW) + (size_t)((l * 4 + g) * 128 + cs * 64) * 64;
    const bf16* xr = proj + (size_t)(tok0 + 16 * tt + fr) * DINP + F_OFF + g * 64 + fg * 8;
    const bf16x8 a0 = *(const bf16x8*)xr, a1 = *(const bf16x8*)(xr + 32);
    const bool lat = tok0 >= NCTX;
    const int L = lat ? 1024 : 256, bq = lat ? (tok0 - NCTX) >> 10 : tok0 >> 8, t = (lat ? (tok0 - NCTX) & 1023 : tok0 & 255) + 16 * tt + 4 * fg;
    const float scale = lat ? (1.0f / 256.0f) : (1.0f / 128.0f);
    bf16* Y = (bf16*)(p.ws + WS_YCS) + (lat ? (size_t)8192 * 512 : 0);
#pragma unroll
    for (int ot = 0; ot < 4; ++ot) {
        const bf16x8 b0 = *(const bf16x8*)(fwt + (16 * ot + fr) * 64 + fg * 8), b1 = *(const bf16x8*)(fwt + (16 * ot + fr) * 64 + 32 + fg * 8);
        f32x4 c = (f32x4){0.f, 0.f, 0.f, 0.f}; c = MFMA16(a0, b0, c); c = MFMA16(a1, b1, c);
        u32x2 o; o.x = cvt2(c[0] * scale, c[1] * scale); o.y = cvt2(c[2] * scale, c[3] * scale);
        *(u32x2*)(Y + (size_t)((bq * 4 + g) * 64 + 16 * ot + fr) * (2 * L) + cs * L + t) = o; }
}

__device__ __forceinline__ void pool_item(CKP& p, int l, LAS unsigned char* lds, int item) {
    const int tid = opaque_tid(), tb = item >> 2, gi = item & 3, tok0 = tb * 64, hw = 1 << gi;
    const bf16* proj = (const bf16*)(p.ws + WS_PROJ);
    LAS bf16* DB = (LAS bf16*)lds;
    LAS float* CSUM = (LAS float*)(lds + 9216);
    const int ti = tid >> 3, c8 = (tid & 7) * 8, tok = tok0 + ti, col = P_OFF + gi * 64 + c8;
    { float sum[8], x[8];
#pragma unroll
      for (int j = 0; j < 8; ++j) sum[j] = 0.f;
      load8bf(proj + (size_t)tok * DINP + col, x);
      float cnt;
      if (tok < NCTX) { const int t = tok & 255, sb = tok - t, lo = max(t - hw, 0), hi = min(t + hw, 256);
          for (int q = lo; q < hi; ++q) { float y[8]; load8bf(proj + (size_t)(sb + q) * DINP + col, y);
#pragma unroll
              for (int j = 0; j < 8; ++j) sum[j] += y[j]; }
          cnt = (float)(hi - lo); }
      else {
          const int t = (tok - NCTX) & 1023, sb = tok - t, r = t >> 6, c = t & 63, rlo = max(r - hw, 0), rhi = min(r + hw, 16), clo = max(c - hw, 0), chi = min(c + hw, 64);
          for (int rq = rlo; rq < rhi; ++rq) { float y[8]; load8bf(proj + (size_t)(sb + rq * 64 + c) * DINP + col, y);
#pragma unroll
              for (int j = 0; j < 8; ++j) sum[j] += y[j]; }
          *(LAS f32x4*)(CSUM + ti * 68 + c8) = (f32x4){sum[0], sum[1], sum[2], sum[3]}; *(LAS f32x4*)(CSUM + ti * 68 + c8 + 4) = (f32x4){sum[4], sum[5], sum[6], sum[7]};
          __syncthreads();
#pragma unroll
          for (int j = 0; j < 8; ++j) sum[j] = 0.f;
          for (int cq = clo; cq < chi; ++cq) { const f32x4 a = *(const LAS f32x4*)(CSUM + cq * 68 + c8), b = *(const LAS f32x4*)(CSUM + cq * 68 + c8 + 4);
#pragma unroll
              for (int j = 0; j < 4; ++j) { sum[j] += a[j]; sum[4 + j] += b[j]; } }
          cnt = (float)((rhi - rlo) * (chi - clo)); }
      const float ic = frcp(cnt);
      float dd[8];
#pragma unroll
      for (int j = 0; j < 8; ++j) dd[j] = sum[j] * ic - x[j];
      *(LAS u32x4*)(DB + ti * 72 + c8) = pack8(dd); }
    __syncthreads();
    { const int lane = tid & 63, w = __builtin_amdgcn_readfirstlane(tid >> 6), fr = lane & 15, fg = lane >> 4, tt = w & 3;
      const bf16* wpt = (const bf16*)(p.ws + WS_WPT) + (size_t)(l * 4 + gi) * 4096;
      const bf16x8 b0 = *(const LAS bf16x8*)(DB + (16 * tt + fr) * 72 + fg * 8), b1 = *(const LAS bf16x8*)(DB + (16 * tt + fr) * 72 + 32 + fg * 8);
#pragma unroll
      for (int x = 0; x < 2; ++x) { const int ot = 2 * (w >> 2) + x;
          const bf16x8 a0 = *(const bf16x8*)(wpt + (16 * ot + fr) * 64 + fg * 8), a1 = *(const bf16x8*)(wpt + (16 * ot + fr) * 64 + 32 + fg * 8);
          f32x4 c = (f32x4){0.f, 0.f, 0.f, 0.f}; c = MFMA16(a0, b0, c); c = MFMA16(a1, b1, c);
          const f32x4 ps = *(const f32x4*)(p.in[I_PSCALE] + l * 256 + gi * 64 + 16 * ot + 4 * fg);
          c *= ps;
          u32x2 o; o.x = cvt2(c[0], c[1]); o.y = cvt2(c[2], c[3]);
          *(u32x2*)((bf16*)(p.ws + WS_MIXED) + (size_t)(tok0 + 16 * tt + fr) * DM + 768 + gi * 64 + 16 * ot + 4 * fg) = o; } }
    __syncthreads();
}

__device__ __forceinline__ float xsum_fg(float s, int fr, int fg) {
    s += __builtin_bit_cast(float, __builtin_amdgcn_ds_bpermute((((fg ^ 1) << 4) | fr) << 2, __builtin_bit_cast(int, s)));
    s += __builtin_bit_cast(float, __builtin_amdgcn_ds_bpermute((((fg ^ 2) << 4) | fr) << 2, __builtin_bit_cast(int, s)));
    return s;
}
__device__ __forceinline__ void stage_post(CKP& p, int l, int bid, int nb) {
    const int tid = opaque_tid(), lane = tid & 63, head = __builtin_amdgcn_readfirstlane(tid >> 6), fr = lane & 15, fg = lane >> 4;
    const bf16* Ub = (const bf16*)(p.ws + WS_U);
    const bf16* gupt = (const bf16*)(p.ws + WS_GUPT) + ((size_t)l * 512 + head * 64) * 128;
    const float* YF = (const float*)(p.ws + WS_YF); const float* YB = (const float*)(p.ws + WS_YB);
    const float* BC0 = (const float*)(p.ws + WS_BC); const float* BC1 = BC0 + (size_t)MTOK * 8;
    bf16* MIX = (bf16*)(p.ws + WS_MIXED);
    bf16x8 ag[4][4];
    f32x4 lnw[4], lnb[4];
#pragma unroll
    for (int t = 0; t < 4; ++t) {
#pragma unroll
        for (int ks = 0; ks < 4; ++ks) ag[t][ks] = *(const bf16x8*)(gupt + (16 * t + fr) * 128 + ks * 32 + fg * 8);
        lnw[t] = *(const f32x4*)(p.in[I_LNW] + l * 512 + head * 64 + 16 * t + 4 * fg); lnb[t] = *(const f32x4*)(p.in[I_LNB] + l * 512 + head * 64 + 16 * t + 4 * fg); }
#pragma unroll 1
    for (int item = bid; item < 768; item += nb) {
        const size_t tok = (size_t)item * 16 + fr;
        bf16x8 bs[4];
#pragma unroll
        for (int ks = 0; ks < 4; ++ks) bs[ks] = *(const bf16x8*)(Ub + tok * 1920 + GD_OFF + ks * 32 + fg * 8);
        f32x4 y[4]; u32x2 vw[4];
#pragma unroll
        for (int t = 0; t < 4; ++t) { const int c = head * 64 + 16 * t + 4 * fg;
            y[t] = *(const f32x4*)(YF + tok * 512 + c) + *(const f32x4*)(YB + tok * 512 + c); vw[t] = *(const u32x2*)(Ub + tok * 1920 + V_OFF + c); }
        const float bc = BC0[tok * 8 + head] + BC1[tok * 8 + head];
        f32x4 g[4];
#pragma unroll
        for (int t = 0; t < 4; ++t) { g[t] = (f32x4){0.f, 0.f, 0.f, 0.f};
#pragma unroll
            for (int ks = 0; ks < 4; ++ks) g[t] = MFMA16(ag[t][ks], bs[ks], g[t]); }
        float s = 0.f;
#pragma unroll
        for (int t = 0; t < 4; ++t) s += (y[t][0] + y[t][1]) + (y[t][2] + y[t][3]);
        const float mean = xsum_fg(s, fr, fg) * (1.0f / 64.0f);
        float q = 0.f;
#pragma unroll
        for (int t = 0; t < 4; ++t) { y[t] = y[t] - mean; q += (y[t][0] * y[t][0] + y[t][1] * y[t][1]) + (y[t][2] * y[t][2] + y[t][3] * y[t][3]); }
        const float rstd = frsq(xsum_fg(q, fr, fg) * (1.0f / 64.0f) + 64e-5f);
#pragma unroll
        for (int t = 0; t < 4; ++t) { const f32x4 vv = (f32x4){bflo(vw[t].x), bfhi(vw[t].x), bflo(vw[t].y), bfhi(vw[t].y)};
            const f32x4 o = (y[t] * rstd * lnw[t] + lnb[t] + vv * bc) * g[t];
            u32x2 w; w.x = cvt2(o[0], o[1]); w.y = cvt2(o[2], o[3]);
            *(u32x2*)(MIX + tok * DM + head * 64 + 16 * t + 4 * fg) = w; }
    }
}

#define XB_TMO      128
#define XB_XCNT(j)  (256  + 64 * (j))
#define XB_XSUB(j)  (1280 + 64 * (j))
#define XB_XGEN(j)  (2304 + 64 * (j))
#define XB_TOP      3328
#define XB_TOPGEN   3392
#define XCD_BAR_WORDS 3456
#define XB_SPIN_CAP (1u << 18)

__device__ __forceinline__ unsigned xb_ld(unsigned* p)              { return __hip_atomic_load(p, __ATOMIC_RELAXED, __HIP_MEMORY_SCOPE_AGENT); }
__device__ __forceinline__ unsigned xb_add(unsigned* p, unsigned v) { return __hip_atomic_fetch_add(p, v, __ATOMIC_RELAXED, __HIP_MEMORY_SCOPE_AGENT); }
__device__ __forceinline__ unsigned xb_xcc_id() { return (unsigned)__builtin_amdgcn_s_getreg((3 << 11) | 20) & 0xFu; }
#define XB_SPIN(cond, bar) do { unsigned _sp = 0; while (cond) { __builtin_amdgcn_s_sleep(1); \
    if ((++_sp & 255u) == 0u) { if (xb_ld(&(bar)[XB_TMO])) break; if (_sp > XB_SPIN_CAP) { atomicAdd(&(bar)[XB_TMO], 1u); break; } } } } while (0)

struct XcdBarrier {
    unsigned* bar; unsigned x;
    volatile LAS unsigned* st;
};

__device__ __forceinline__ XcdBarrier xcd_barrier_post(unsigned* bar, volatile LAS unsigned* st) {
    XcdBarrier b; b.bar = bar; b.x = xb_xcc_id(); b.st = st;
    if (threadIdx.x == 0) (void)xb_add(&bar[XB_XCNT(b.x)], 1u);
    return b;
}
__device__ __forceinline__ void xcd_barrier_complete(unsigned* bar, unsigned x, unsigned& nloc, unsigned& nx) {
    const unsigned G = gridDim.x * gridDim.y * gridDim.z;
    unsigned sum, cnt, mine, sp = 0u;
    for (;;) {
        sum = 0u; cnt = 0u; mine = 0u;
#pragma unroll
        for (unsigned j = 0; j < 16; ++j) { const unsigned c = xb_ld(&bar[XB_XCNT(j)]); sum += c; cnt += (c > 0u) ? 1u : 0u; mine = (j == x) ? c : mine; }
        if (sum == G) break;
        __builtin_amdgcn_s_sleep(1);
        if ((++sp & 255u) == 0u) { if (xb_ld(&bar[XB_TMO])) break; if (sp > XB_SPIN_CAP) { atomicAdd(&bar[XB_TMO], 1u); break; } }
    }
    nloc = mine > 0u ? mine : 1u; nx = cnt > 0u ? cnt : 1u;
}

__device__ __forceinline__ void xcd_barrier(const XcdBarrier& b) {
    asm volatile("s_waitcnt vmcnt(0)" ::: "memory");
    __syncthreads();
    if (threadIdx.x == 0) {
        unsigned* bar = b.bar;
        __builtin_amdgcn_s_waitcnt(0);
        unsigned nloc = b.st[0], nx = b.st[1];
        if (nloc == 0u) { xcd_barrier_complete(bar, b.x, nloc, nx); b.st[0] = nloc; b.st[1] = nx; }
        const unsigned old = xb_add(&bar[XB_XSUB(b.x)], 1u);
        const unsigned gen = old / nloc;
        if (old + 1u == (gen + 1u) * nloc) {
            __builtin_amdgcn_fence(__ATOMIC_RELEASE, "agent");
            asm volatile("s_waitcnt vmcnt(0)" ::: "memory");
            const unsigned og = xb_add(&bar[XB_TOP], 1u);
            const unsigned tg = og / nx;
            if (og + 1u == (tg + 1u) * nx) xb_add(&bar[XB_TOPGEN], 1u);
            else XB_SPIN(xb_ld(&bar[XB_TOPGEN]) == tg, bar);
            __builtin_amdgcn_fence(__ATOMIC_ACQUIRE, "agent");
            xb_add(&bar[XB_XGEN(b.x)], 1u);
            asm volatile("s_waitcnt vmcnt(0)" ::: "memory");
        } else {
            XB_SPIN(xb_ld(&bar[XB_XGEN(b.x)]) == gen, bar);
            __builtin_amdgcn_fence(__ATOMIC_ACQUIRE, "agent");
            asm volatile("s_waitcnt vmcnt(0)" ::: "memory");
        }
    }
    __syncthreads();
}

struct EpiAny {
    static constexpr bool AFTER_DRAIN = false;
    int mode; bool PERM; int l;
    __device__ __forceinline__ void operator()(const f32x4 (&acc)[2][2][4][2], const pg8::Unit& u, int wr, int wc, int fr, int fq) const {
        CKP* kp = (CKP*)__builtin_amdgcn_kernarg_segment_ptr(); asm volatile("" : "+s"(kp)); CKP& p = *kp;
        unsigned char* ws = p.ws;
        const float* mod = (const float*)(ws + WS_MOD) + (size_t)l * 5 * 6144;
        float* SSQ = (float*)(ws + WS_CTL + 262144);
        bf16* Hb = (bf16*)(ws + WS_H);
        if (mode == 7) {
#pragma unroll
            for (int a = 0; a < 2; ++a)
#pragma unroll
                for (int b = 0; b < 2; ++b)
#pragma unroll
                    for (int m = 0; m < 4; ++m)
#pragma unroll
                        for (int n = 0; n < 2; ++n) asm volatile("" :: "v"(acc[a][b][m][n]));
            return; }
        if (mode == 0) { const pg8::EpiBf<0> e{(bf16*)(ws + WS_PROJ), DINP}; e(acc, u, wr, wc, fr, fq); }
        else if (mode == 2) { const pg8::EpiRes e{p.out, mod + 5 * 1024, p.out, p.out + (size_t)NCTX * DM}; e(acc, u, wr, wc, fr, fq); }
        else if (mode == 3) { const pg8::EpiFnet e{(bf16*)(ws + WS_MIXED), 0, 256}; e(acc, u, wr, wc, fr, fq); }
        else if (mode == 8) { const pg8::EpiFnet e{(bf16*)(ws + WS_MIXED), NCTX, 1024}; e(acc, u, wr, wc, fr, fq); }
        else if (mode == 4) { const pg8::EpiNormBf<0> e{(bf16*)(ws + WS_PROJ), DINP, SSQ + 16384, (const float*)(ws + WS_SWIN), DINP}; e(acc, u, wr, wc, fr, fq); }
        else if (mode == 5) { const pg8::EpiNormBf<1> e{(bf16*)(ws + WS_FF), DFF, SSQ + l * 32768, (const float*)(ws + WS_SW1) + (size_t)l * 5 * DFF, DFF}; e(acc, u, wr, wc, fr, fq); }
        else if (mode == 6) { const pg8::EpiResNorm e{p.out, mod + 2 * 1024, l == 0 ? p.in[I_XP] : p.out, l == 0 ? p.in[I_XS] : p.out + (size_t)NCTX * DM, Hb, p.in[I_N2G] + l * DM, mod + 4 * 1024, SSQ + l * 32768}; e(acc, u, wr, wc, fr, fq); }
        else { const pg8::EpiResNorm e{p.out, mod + 5 * 1024, p.out, p.out + (size_t)NCTX * DM, Hb, p.in[I_N1G] + DM, mod + 5 * 6144 + 1 * 1024, SSQ + 16384}; e(acc, u, wr, wc, fr, fq); }
    }
};

constexpr int N_STEPS = 17;
__device__ __forceinline__ bool step_seam(int st) { return st < 16; }
__global__ void __launch_bounds__(NTHR, 2) mega_fwd(KP p_unused) {
    extern __shared__ __attribute__((aligned(16))) unsigned char lds_raw[];
    CKP* kp0 = (CKP*)__builtin_amdgcn_kernarg_segment_ptr();
    { LAS unsigned* ctlw = (LAS unsigned*)((LAS unsigned char*)lds_raw + RING_BYTES);
      for (int u = threadIdx.x; u < (LDS_BYTES - RING_BYTES) / 4; u += NTHR) ctlw[u] = 0u; }
    __syncthreads();
    const XcdBarrier bar = xcd_barrier_post((unsigned*)(kp0->ws + WS_CTL) + 4096, (volatile LAS unsigned*)((LAS unsigned char*)lds_raw + MISC_OFF + 32));
    const int ph_lo = kp0->ph_lo, ph_hi = kp0->ph_hi;
#pragma unroll 1
#ifdef REP_A
    for (int sti = ph_lo; sti < ph_hi + ((REP_B) >= 0 ? 2 : 1); ++sti) {
        const int st = sti <= (REP_A) ? sti : (((REP_B) < 0 || sti <= (REP_B) + 1) ? sti - 1 : sti - 2);
        const bool isdup = sti == (REP_A) || ((REP_B) >= 0 && sti == (REP_B) + 1); (void)isdup;
#else
    for (int st = ph_lo; st < ph_hi; ++st) {
#endif
        CKP* kp = kp0; asm volatile("" : "+s"(kp));
        CKP& p = *kp; unsigned char* ws = p.ws;
        int bid = blockIdx.x, nb = gridDim.x; unsigned ldsb = (unsigned)(size_t)(LAS unsigned char*)lds_raw;
        asm volatile("" : "+s"(bid), "+s"(nb), "+s"(ldsb));
        LAS unsigned char* lds = (LAS unsigned char*)(size_t)ldsb;
        const int l = st < 9 ? 0 : 1, s = st == 0 ? -1 : (st == 1 ? 0 : (st == 16 ? 8 : (st - 2) % 7 + 1));
        const float* mod = (const float*)(ws + WS_MOD) + (size_t)l * 5 * 6144;
        if (s == 3) {
            if (nb >= 256) { if (bid < 64) rwkv_item3(p, l, lds, bid); else for (int it = 64 + (bid - 64); it < 576; it += nb - 64) rwkv_item3(p, l, lds, it); }
            else for (int it = bid; it < 576; it += nb) rwkv_item3(p, l, lds, it);
        }
#pragma unroll 1
        for (int job = 0; job < 2; ++job) {
            pg8::Gemm g{nullptr, nullptr, 0, 0, 0, 0, 0}; EpiAny E{-1, true, 0}; int corder = bid;
            if (job == 0) {
                if (s == 1) { g = pg8::Gemm{(const bf16*)(ws + WS_H), (const bf16*)(ws + WS_WIN) + (size_t)l * DINP * DM, MTOK, DINP, DM, DM, DM}; E = EpiAny{l == 0 ? 0 : 4, true, l}; }
                else if (s == 3) { g = pg8::Gemm{(const bf16*)(ws + WS_CS256), (const bf16*)(ws + WS_YCS), 256, 8192, 512, 512, 512}; E = EpiAny{3, true, l}; corder = (bid + nb - (nb >= 256 ? 192 : 0)) % nb; }
                else if (s == 5) { g = pg8::Gemm{(const bf16*)(ws + WS_MIXED), (const bf16*)(ws + WS_WOUT) + (size_t)l * DM * DM, MTOK, DM, DM, DM, DM}; E = EpiAny{6, true, l}; }
                else if (s == 6) { g = pg8::Gemm{(const bf16*)(ws + WS_H), (const bf16*)(ws + WS_W1) + (size_t)l * DFF * DM, MTOK, DFF, DM, DM, DM}; E = EpiAny{5, true, l}; }
                else if (s == 7) { g = pg8::Gemm{(const bf16*)(ws + WS_FF), (const bf16*)(ws + WS_W2) + (size_t)l * DM * DFF, MTOK, DM, DFF, DFF, DFF}; E = l == 0 ? EpiAny{9, true, l} : EpiAny{2, false, l}; }
            } else if (s == 3) { g = pg8::Gemm{(const bf16*)(ws + WS_CS1024), (const bf16*)(ws + WS_YCS) + (size_t)8192 * 512, 1024, 1024, 2048, 2048, 2048}; E = EpiAny{8, true, l}; corder = (bid + nb - (nb >= 256 ? 224 : 32)) % nb; }
#ifdef NOEPI_FIRST
            if (isdup && E.mode >= 0) E.mode = 7;
#endif
            if (E.mode >= 0) {
                pg8::StaticOrder S; S.init(g.M, g.N, nb, corder);
                pg8::gemm_phase<EpiAny, pg8::StaticOrder, true, true>(lds, g, S, E);
                __syncthreads();
            }
        }
        if (s == 3) side_queue(p, l, lds);
        if (s == -1) stage_prologue(p, lds, bid, nb);
        else if (s == 0) stage_norm(p, 0, 0, bid, nb);
        else if (s == 2) {
            stage_upass(p, l, bid, nb);
#pragma unroll 1
            for (int it = bid; it < 768; it += nb) fnet1_item(p, l, it);
#pragma unroll 1
            for (int it = bid; it < 768; it += nb) pool_item(p, l, lds, it);
        }
        else if (s == 4) stage_post(p, l, bid, nb);
        else if (s == 8) stage_final(p, bid, nb);
        #ifdef REP_A
        if (sti + 1 < ph_hi + ((REP_B) >= 0 ? 2 : 1)) xcd_barrier(bar);
#else
        if (st + 1 < ph_hi && step_seam(st)) xcd_barrier(bar);
#endif
    }
}

extern "C" void kernel_launch(void* const* d_in, const int* in_sizes, int n_in, void* d_out, int out_size, void* d_ws, size_t ws_size, hipStream_t stream) {
    static int grid = 0;
    if (grid == 0) {
        if (n_in != N_IN || ws_size < WS_END) { fprintf(stderr, "kernel_launch: unexpected inputs (n_in %d, ws %zu)\n", n_in, ws_size); grid = -1; return; }
        int dev = 0, cus = 0, per_cu = 0;
        (void)hipGetDevice(&dev); (void)hipDeviceGetAttribute(&cus, hipDeviceAttributeMultiprocessorCount, dev);
        (void)hipFuncSetAttribute((const void*)mega_fwd, hipFuncAttributeMaxDynamicSharedMemorySize, LDS_BYTES);
        if (hipOccupancyMaxActiveBlocksPerMultiprocessor(&per_cu, (const void*)mega_fwd, NTHR, LDS_BYTES) != hipSuccess || per_cu < 1) {
            fprintf(stderr, "kernel_launch: occupancy query reports %d blocks/CU\n", per_cu); (void)hipGetLastError(); grid = -1; return; }
        grid = cus * 1;
    }
    if (grid < 0) return;
    KP a{};
    for (int i = 0; i < N_IN; ++i) a.in[i] = (const float*)d_in[i];
    a.out = (float*)d_out; a.ws = (unsigned char*)d_ws; a.ph_lo = 0; a.ph_hi = N_STEPS;
    if (hipMemsetAsync((char*)d_ws + WS_CTL, 0, 1 * MiB, stream) != hipSuccess) { fprintf(stderr, "kernel_launch: memset failed\n"); return; }
    void* args[] = {&a};
    hipError_t e = hipLaunchCooperativeKernel((const void*)mega_fwd, dim3(grid), dim3(NTHR), args, LDS_BYTES, stream);
    if (e != hipSuccess) fprintf(stderr, "cooperative launch failed: %s (grid %d)\n", hipGetErrorString(e), grid);
}
```

```cpp
#include <hip/hip_runtime.h>
#include <hip/hip_cooperative_groups.h>
#include <cstdio>
#include <cstdint>
namespace cg = cooperative_groups;
__device__ __forceinline__ int opaque_tid() { int t = threadIdx.x; asm volatile("" : "+v"(t)); return t; }
namespace pg8 {
#define PG8_LAS __attribute__((address_space(3)))
typedef unsigned short bf16_t;
typedef short bf16x8 __attribute__((ext_vector_type(8)));
typedef float f32x4 __attribute__((ext_vector_type(4)));
typedef unsigned u32x4 __attribute__((ext_vector_type(4)));
constexpr int BM = 256, BK = 64, HALF = 128, HTB = HALF * BK * 2  , STAGE_BYTES = 8 * HTB, NXCD = 8, WGM = 8;

__host__ __device__ __forceinline__ int lds_byte(int r, int c) { const int st = (r >> 4) * 2 + (c >> 5), rr = r & 15, cc = c & 31, ob = rr * 64 + cc * 2; return st * 1024 + (ob ^ (((ob >> 9) & 1) << 5)); }
__host__ __device__ __forceinline__ void stage_rc(int b, int& R, int& C) { const int st = b / 1024, sb = b % 1024, swz = sb ^ (((sb >> 9) & 1) << 5); R = (st >> 1) * 16 + swz / 64; C = (st & 1) * 32 + (swz % 64) / 2; }
__host__ __device__ __forceinline__ int perm32(int rho) { const int n = rho >> 4, i = rho & 15; return 8 * (i >> 2) + 4 * n + (i & 3); }

struct Unit { int pm, pn; };
struct Gemm { const bf16_t* A; const bf16_t* Bt; int M, N, K, lda, ldb; };

struct StaticOrder {
    int nM, nN, nwg, G, c;
    __host__ __device__ void init(int M, int N, int G_, int c_) { nM = M / BM; nN = N / BM; nwg = nM * nN; G = G_; c = c_; }
    __host__ __device__ bool next(int i, Unit& u) const {
        const long L = (long)i * G + c; if (L >= nwg) return false;
        int wgid = (int)L; { const int q = nwg / NXCD, r = nwg % NXCD, xcd = wgid % NXCD, off = wgid / NXCD; wgid = (xcd < r ? xcd * (q + 1) : r * (q + 1) + (xcd - r) * q) + off; }
        const int nig = WGM * nN, gid = wgid / nig, fm = gid * WGM, gsz = (nM - fm) < WGM ? (nM - fm) : WGM;
        u.pm = fm + ((wgid % nig) % gsz); u.pn = (wgid % nig) / gsz; return true;
    }
    __device__ __forceinline__ void a_ready(const Unit&) const {}
    __device__ __forceinline__ void done(const Unit&) const {}
};

__device__ __forceinline__ unsigned cvt_pk_bf16(float lo, float hi) { unsigned r; asm volatile("v_cvt_pk_bf16_f32 %0, %1, %2" : "=v"(r) : "v"(lo), "v"(hi)); return r; }
typedef unsigned u32x2 __attribute__((ext_vector_type(2)));
template <int ACT  > struct EpiBf {
    static constexpr bool PERM = true, AFTER_DRAIN = false;
    bf16_t* O; int ldc;
    __device__ __forceinline__ void operator()(const f32x4 (&acc)[2][2][4][2], const Unit& u, int wr, int wc, int fr, int fq) const {
        const int row0 = u.pm * BM + wr * 64 + fr, col0 = u.pn * BM + wc * 32 + 8 * fq;
#pragma unroll
        for (int ai = 0; ai < 2; ++ai)
#pragma unroll
            for (int m = 0; m < 4; ++m) { bf16_t* rowp = O + (size_t)(row0 + ai * HALF + m * 16) * ldc + col0;
#pragma unroll
                for (int bj = 0; bj < 2; ++bj) { f32x4 v0 = acc[ai][bj][m][0], v1 = acc[ai][bj][m][1];
                    if (ACT == 1) {
#pragma unroll
                        for (int e = 0; e < 4; ++e) { float a = v0[e] > 0.f ? v0[e] : 0.f; v0[e] = a * a; float b = v1[e] > 0.f ? v1[e] : 0.f; v1[e] = b * b; } }
                    u32x4 w; w.x = cvt_pk_bf16(v0[0], v0[1]); w.y = cvt_pk_bf16(v0[2], v0[3]); w.z = cvt_pk_bf16(v1[0], v1[1]); w.w = cvt_pk_bf16(v1[2], v1[3]);
                    *(u32x4*)(rowp + bj * HALF) = w; } }
    }
};
struct EpiRes {
    static constexpr bool PERM = false, AFTER_DRAIN = false;
    float* X; const float* gate; const float* Xc; const float* Xl;
    __device__ __forceinline__ void operator()(const f32x4 (&acc)[2][2][4][2], const Unit& u, int wr, int wc, int fr, int fq) const {
        const int row0 = u.pm * BM + wr * 64 + fr, col0 = u.pn * BM + wc * 32 + 4 * fq;
        const int cond = u.pm < 32 ? 0 : 1 + ((u.pm - 32) >> 2);
        const float* gp = gate + cond * 6144 + col0;
        f32x4 gv[2][2];
#pragma unroll
        for (int bj = 0; bj < 2; ++bj)
#pragma unroll
            for (int n = 0; n < 2; ++n) gv[bj][n] = *(const f32x4*)(gp + bj * HALF + n * 16);
#pragma unroll
        for (int ai = 0; ai < 2; ++ai)
#pragma unroll
            for (int m = 0; m < 4; ++m) { const size_t ro = (size_t)(row0 + ai * HALF + m * 16) * 1024 + col0; float* rowp = X + ro; const float* srcp = u.pm < 32 ? Xc + ro : Xl + (ro - (size_t)8192 * 1024);
#pragma unroll
                for (int bj = 0; bj < 2; ++bj)
#pragma unroll
                    for (int n = 0; n < 2; ++n) { *(f32x4*)(rowp + bj * HALF + n * 16) = *(const f32x4*)(srcp + bj * HALF + n * 16) + gv[bj][n] * acc[ai][bj][m][n]; }
                if (m & 1) asm volatile("" ::: "memory"); }
    }
};
struct EpiFnet {
    static constexpr bool PERM = true, AFTER_DRAIN = false;
    bf16_t* MIX; int rowbase, L;
    __device__ __forceinline__ void operator()(const f32x4 (&acc)[2][2][4][2], const Unit& u, int wr, int wc, int fr, int fq) const {
        const int row0 = u.pm * BM + wr * 64 + fr, colw = wc * 32 + 8 * fq;
        bf16_t* base = MIX + (size_t)(rowbase + u.pn * L) * 1024 + 512 + colw;
#pragma unroll
        for (int ai = 0; ai < 2; ++ai)
#pragma unroll
            for (int m = 0; m < 4; ++m) { bf16_t* rowp = base + (size_t)(row0 + ai * HALF + m * 16) * 1024;
#pragma unroll
                for (int bj = 0; bj < 2; ++bj) { const f32x4 v0 = acc[ai][bj][m][0], v1 = acc[ai][bj][m][1];
                    u32x4 w; w.x = cvt_pk_bf16(v0[0], v0[1]); w.y = cvt_pk_bf16(v0[2], v0[3]); w.z = cvt_pk_bf16(v1[0], v1[1]); w.w = cvt_pk_bf16(v1[2], v1[3]);
                    *(u32x4*)(rowp + bj * HALF) = w; } }
    }
};

__device__ __forceinline__ float xsum_fq(float s, int fr, int fq) {
    s += __builtin_bit_cast(float, __builtin_amdgcn_ds_bpermute((((fq ^ 1) << 4) | fr) << 2, __builtin_bit_cast(int, s)));
    s += __builtin_bit_cast(float, __builtin_amdgcn_ds_bpermute((((fq ^ 2) << 4) | fr) << 2, __builtin_bit_cast(int, s)));
    return s;
}
template <int ACT> struct EpiNormBf {
    static constexpr bool PERM = true, AFTER_DRAIN = false;
    bf16_t* O; int ldc; const float* ssq; const float* sw; int swld;
    __device__ __forceinline__ void operator()(const f32x4 (&acc)[2][2][4][2], const Unit& u, int wr, int wc, int fr, int fq) const {
        const int row0 = u.pm * BM + wr * 64 + fr, col0 = u.pn * BM + wc * 32 + 8 * fq;
        const int cond = u.pm < 32 ? 0 : 1 + ((u.pm - 32) >> 2);
        f32x4 sv[2][2];
#pragma unroll
        for (int bj = 0; bj < 2; ++bj)
#pragma unroll
            for (int n = 0; n < 2; ++n) sv[bj][n] = *(const f32x4*)(sw + (size_t)cond * swld + col0 + bj * HALF + 4 * n);
        float rs[2][4];
#pragma unroll
        for (int ai = 0; ai < 2; ++ai)
#pragma unroll
            for (int m = 0; m < 4; ++m) rs[ai][m] = ssq[row0 + ai * HALF + m * 16];
#pragma unroll
        for (int ai = 0; ai < 2; ++ai)
#pragma unroll
            for (int m = 0; m < 4; ++m) rs[ai][m] = __builtin_amdgcn_rsqf(rs[ai][m] * (1.0f / 1024.0f) + 1e-6f);
#pragma unroll
        for (int ai = 0; ai < 2; ++ai)
#pragma unroll
            for (int m = 0; m < 4; ++m) { const int row = row0 + ai * HALF + m * 16; bf16_t* rowp = O + (size_t)row * ldc + col0;
                const float rstd = rs[ai][m];
#pragma unroll
                for (int bj = 0; bj < 2; ++bj) { f32x4 v0 = acc[ai][bj][m][0] * rstd + sv[bj][0], v1 = acc[ai][bj][m][1] * rstd + sv[bj][1];
                    if (ACT == 1) {
#pragma unroll
                        for (int e = 0; e < 4; ++e) { float a = v0[e] > 0.f ? v0[e] : 0.f; v0[e] = a * a; float b = v1[e] > 0.f ? v1[e] : 0.f; v1[e] = b * b; } }
                    u32x4 w; w.x = cvt_pk_bf16(v0[0], v0[1]); w.y = cvt_pk_bf16(v0[2], v0[3]); w.z = cvt_pk_bf16(v1[0], v1[1]); w.w = cvt_pk_bf16(v1[2], v1[3]);
                    *(u32x4*)(rowp + bj * HALF) = w; }
                if (m & 1) asm volatile("" ::: "memory"); }
    }
};
struct EpiResNorm {
    static constexpr bool PERM = true, AFTER_DRAIN = false;
    float* X; const float* gate; const float* Xc; const float* Xl; bf16_t* H; const float* gn; const float* scl; float* ssq;
    __device__ __forceinline__ void operator()(const f32x4 (&acc)[2][2][4][2], const Unit& u, int wr, int wc, int fr, int fq) const {
        const int row0 = u.pm * BM + wr * 64 + fr, col0 = u.pn * BM + wc * 32 + 8 * fq;
        const int cond = u.pm < 32 ? 0 : 1 + ((u.pm - 32) >> 2);
        const float* src = u.pm < 32 ? Xc : Xl - (size_t)8192 * 1024;
        f32x4 gt[2][2], gs[2][2];
#pragma unroll
        for (int bj = 0; bj < 2; ++bj)
#pragma unroll
            for (int n = 0; n < 2; ++n) { const int col = col0 + bj * HALF + n * 4;
                gt[bj][n] = *(const f32x4*)(gate + cond * 6144 + col); gs[bj][n] = *(const f32x4*)(gn + col) * (*(const f32x4*)(scl + cond * 6144 + col) + 1.0f); }
#pragma unroll
        for (int ai = 0; ai < 2; ++ai)
#pragma unroll
            for (int m = 0; m < 4; ++m) { const int row = row0 + ai * HALF + m * 16; const unsigned ro = (unsigned)row * 1024u + (unsigned)col0;
                float sq = 0.f;
#pragma unroll
                for (int bj = 0; bj < 2; ++bj) { const unsigned o = ro + bj * HALF;
                    const f32x4 x0 = *(const f32x4*)(src + o) + gt[bj][0] * acc[ai][bj][m][0], x1 = *(const f32x4*)(src + o + 4) + gt[bj][1] * acc[ai][bj][m][1];
                    *(f32x4*)(X + o) = x0; *(f32x4*)(X + o + 4) = x1;
                    sq += ((x0[0] * x0[0] + x0[1] * x0[1]) + (x0[2] * x0[2] + x0[3] * x0[3])) + ((x1[0] * x1[0] + x1[1] * x1[1]) + (x1[2] * x1[2] + x1[3] * x1[3]));
                    const f32x4 h0 = x0 * gs[bj][0], h1 = x1 * gs[bj][1];
                    u32x4 w; w.x = cvt_pk_bf16(h0[0], h0[1]); w.y = cvt_pk_bf16(h0[2], h0[3]); w.z = cvt_pk_bf16(h1[0], h1[1]); w.w = cvt_pk_bf16(h1[2], h1[3]);
                    *(u32x4*)(H + o) = w; }
                const float t = xsum_fq(sq, fr, fq); if (fq == 0) atomicAdd(ssq + row, t);
                asm volatile("" ::: "memory"); }
    }
};
template <class Epi, class Sched, bool ALIGN_EPI = false, bool SP2 = false>
__device__ __forceinline__ void gemm_phase(PG8_LAS unsigned char* lds, const Gemm g, const Sched& S, const Epi& E) {
    const int tid = opaque_tid(), wid = __builtin_amdgcn_readfirstlane(tid >> 6), lane = tid & 63, wr = wid >> 2, wc = wid & 3, fr = lane & 15, fq = lane >> 4;
    const int K = g.K, nt = K / BK;
    unsigned voffA[2], voffB[2];
#pragma unroll
    for (int i = 0; i < 2; ++i) { int R, C; stage_rc(tid * 16 + i * 8192, R, C); const int Rb = E.PERM ? ((R & ~31) + perm32(R & 31)) : R;
        voffA[i] = (unsigned)(R * g.lda + C) * 2u; voffB[i] = (unsigned)(Rb * g.ldb + C) * 2u; }
    const size_t kstep = (size_t)(BK * 2);
    const size_t hstepA = (size_t)HALF * g.lda * 2, hstepB = (size_t)HALF * g.ldb * 2;
    const size_t tstepA = 2 * hstepA, tstepB = 2 * hstepB;
    const unsigned ldsw = (unsigned)wid * 1024u;
    const int aoff = lds_byte(wr * 64 + fr, fq * 8), boff = lds_byte(wc * 32 + fr, fq * 8);
#define PG8_SA(b, h) (((b) * 2 + (h)) * HTB)
#define PG8_SB(b, h) ((4 + (b) * 2 + (h)) * HTB)
#define PG8_STAGE(bufoff, gbase, voff) do { _Pragma("unroll") for (int _i = 0; _i < 2; ++_i) \
        __builtin_amdgcn_global_load_lds((const unsigned*)((const char*)(gbase) + (voff)[_i]), (PG8_LAS unsigned*)(lds + (bufoff) + ldsw + _i * 8192), 16, 0, 0); } while (0)
#define PG8_LDA(dst, b, h) do { _Pragma("unroll") for (int m = 0; m < 4; ++m) _Pragma("unroll") for (int k = 0; k < 2; ++k) dst[m][k] = *(const PG8_LAS bf16x8*)(lds + PG8_SA(b, h) + aoff + m * 2048 + k * 1024); } while (0)
#define PG8_LDB(dst, b, h) do { _Pragma("unroll") for (int n = 0; n < 2; ++n) _Pragma("unroll") for (int k = 0; k < 2; ++k) dst[n][k] = *(const PG8_LAS bf16x8*)(lds + PG8_SB(b, h) + boff + n * 2048 + k * 1024); } while (0)
#define PG8_MMA(ai, bj, At, Bt) do { __builtin_amdgcn_s_setprio(1); _Pragma("unroll") for (int m = 0; m < 4; ++m) _Pragma("unroll") for (int n = 0; n < 2; ++n) _Pragma("unroll") for (int k = 0; k < 2; ++k) \
        acc[ai][bj][m][n] = __builtin_amdgcn_mfma_f32_16x16x32_bf16(Bt[n][k], At[m][k], acc[ai][bj][m][n], 0, 0, 0); __builtin_amdgcn_s_setprio(0); } while (0)
#define PG8_WAIT_V(n) asm volatile("s_waitcnt vmcnt(" #n ")" ::: "memory")
#define PG8_WAIT_L(n) asm volatile("s_waitcnt lgkmcnt(" #n ")" ::: "memory")
#define PG8_BAR __builtin_amdgcn_s_barrier()
#define PG8_SCHED __builtin_amdgcn_sched_barrier(0)
    Unit cur, nxt; int ui = 0;
    if (!S.next(0, cur)) return;
    f32x4 acc[2][2][4][2];
#pragma unroll
    for (int a = 0; a < 2; ++a)
#pragma unroll
        for (int b = 0; b < 2; ++b)
#pragma unroll
            for (int m = 0; m < 4; ++m)
#pragma unroll
                for (int n = 0; n < 2; ++n) acc[a][b][m][n] = (f32x4){0.f, 0.f, 0.f, 0.f};
    bf16x8 At[4][2], B0[2][2], B1[2][2];
    const char* cA = (const char*)g.A + (size_t)cur.pm * tstepA; const char* cB = (const char*)g.Bt + (size_t)cur.pn * tstepB;
    S.a_ready(cur);
    if constexpr (SP2) {
        PG8_STAGE(PG8_SB(0, 0), cB, voffB); PG8_STAGE(PG8_SB(0, 1), cB + hstepB, voffB); PG8_STAGE(PG8_SA(0, 0), cA, voffA); PG8_STAGE(PG8_SA(0, 1), cA + hstepA, voffA);
        if (wr == 1) PG8_BAR;
        PG8_WAIT_V(2); PG8_BAR;
        PG8_STAGE(PG8_SB(1, 0), cB + kstep, voffB); PG8_STAGE(PG8_SA(1, 0), cA + kstep, voffA); PG8_STAGE(PG8_SB(1, 1), cB + hstepB + kstep, voffB);
        PG8_WAIT_V(6); PG8_BAR;
    } else {
        PG8_STAGE(PG8_SB(0, 0), cB, voffB); PG8_STAGE(PG8_SA(0, 0), cA, voffA); PG8_STAGE(PG8_SB(0, 1), cB + hstepB, voffB); PG8_STAGE(PG8_SA(0, 1), cA + hstepA, voffA);
        if (wr == 1) PG8_BAR;
        PG8_WAIT_V(4); PG8_BAR;
        PG8_STAGE(PG8_SB(1, 0), cB + kstep, voffB); PG8_STAGE(PG8_SA(1, 0), cA + kstep, voffA); PG8_STAGE(PG8_SB(1, 1), cB + hstepB + kstep, voffB);
        PG8_WAIT_V(6); PG8_BAR;
    }
    for (;;) {
        const bool has_next = S.next(ui + 1, nxt);
        const char* nA = has_next ? (const char*)g.A + (size_t)nxt.pm * tstepA : cA; const char* nB = has_next ? (const char*)g.Bt + (size_t)nxt.pn * tstepB : cB;
        for (int t = 0; t < nt; t += 2) {
            const bool last = (t == nt - 2);
            const char* a1 = cA + (size_t)(t + 1) * kstep;
            const char* a2 = last ? nA : cA + (size_t)(t + 2) * kstep; const char* b2 = last ? nB : cB + (size_t)(t + 2) * kstep;
            const char* a3 = a2 + kstep; const char* b3 = b2 + kstep;
            if (last && has_next) S.a_ready(nxt);
            if constexpr (SP2) {
            PG8_LDB(B0, 0, 0); PG8_LDB(B1, 0, 1); PG8_SCHED; PG8_LDA(At, 0, 0); PG8_STAGE(PG8_SA(1, 1), a1 + hstepA, voffA);
            PG8_WAIT_V(8); PG8_WAIT_L(0); PG8_BAR; PG8_MMA(0, 0, At, B0); PG8_MMA(0, 1, At, B1); PG8_BAR; PG8_SCHED;
            PG8_LDA(At, 0, 1); PG8_STAGE(PG8_SB(0, 0), b2, voffB); PG8_STAGE(PG8_SB(0, 1), b2 + hstepB, voffB); PG8_STAGE(PG8_SA(0, 0), a2, voffA);
            PG8_WAIT_V(8); PG8_WAIT_L(0); PG8_BAR; PG8_MMA(1, 0, At, B0); PG8_MMA(1, 1, At, B1); PG8_BAR; PG8_SCHED;
            PG8_LDB(B0, 1, 0); PG8_LDB(B1, 1, 1); PG8_SCHED; PG8_LDA(At, 1, 0); PG8_STAGE(PG8_SA(0, 1), a2 + hstepA, voffA);
            PG8_WAIT_V(8); PG8_WAIT_L(0); PG8_BAR; PG8_MMA(0, 0, At, B0); PG8_MMA(0, 1, At, B1); PG8_BAR; PG8_SCHED;
            PG8_LDA(At, 1, 1); PG8_STAGE(PG8_SB(1, 0), b3, voffB); PG8_STAGE(PG8_SB(1, 1), b3 + hstepB, voffB); PG8_STAGE(PG8_SA(1, 0), a3, voffA);
            PG8_WAIT_V(8); PG8_WAIT_L(0); PG8_BAR; PG8_MMA(1, 0, At, B0); PG8_MMA(1, 1, At, B1); PG8_BAR; PG8_SCHED;
            } else {
            PG8_LDB(B0, 0, 0); PG8_SCHED; PG8_LDA(At, 0, 0); PG8_STAGE(PG8_SA(1, 1), a1 + hstepA, voffA);
            PG8_WAIT_L(8); PG8_BAR; PG8_WAIT_L(0); PG8_MMA(0, 0, At, B0); PG8_BAR; PG8_SCHED;
            PG8_LDB(B1, 0, 1); PG8_STAGE(PG8_SB(0, 0), b2, voffB);
            PG8_BAR; PG8_WAIT_L(0); PG8_MMA(0, 1, At, B1); PG8_BAR;
            PG8_LDA(At, 0, 1); PG8_STAGE(PG8_SA(0, 0), a2, voffA);
            PG8_BAR; PG8_WAIT_L(0); PG8_MMA(1, 0, At, B0); PG8_BAR; PG8_SCHED;
            PG8_STAGE(PG8_SB(0, 1), b2 + hstepB, voffB);
            PG8_WAIT_V(6); PG8_BAR; PG8_MMA(1, 1, At, B1); PG8_BAR;
            PG8_LDB(B0, 1, 0); PG8_SCHED; PG8_LDA(At, 1, 0); PG8_STAGE(PG8_SA(0, 1), a2 + hstepA, voffA);
            PG8_WAIT_L(8); PG8_BAR; PG8_WAIT_L(0); PG8_MMA(0, 0, At, B0); PG8_BAR; PG8_SCHED;
            PG8_LDB(B1, 1, 1); PG8_STAGE(PG8_SB(1, 0), b3, voffB);
            PG8_BAR; PG8_WAIT_L(0); PG8_MMA(0, 1, At, B1); PG8_BAR;
            PG8_LDA(At, 1, 1); PG8_STAGE(PG8_SA(1, 0), a3, voffA);
            PG8_BAR; PG8_WAIT_L(0); PG8_MMA(1, 0, At, B0); PG8_BAR; PG8_SCHED;
            PG8_STAGE(PG8_SB(1, 1), b3 + hstepB, voffB);
            PG8_WAIT_V(6); PG8_BAR; PG8_MMA(1, 1, At, B1); PG8_BAR;
            }
        }
        if constexpr (ALIGN_EPI) { if (wr == 0) PG8_BAR; }
        if constexpr (!Epi::AFTER_DRAIN) { int fr2 = fr, fq2 = fq; asm volatile("" : "+v"(fr2), "+v"(fq2)); E(acc, cur, wr, wc, fr2, fq2); S.done(cur); }
        if (!has_next) break;
#pragma unroll
        for (int a = 0; a < 2; ++a)
#pragma unroll
            for (int b = 0; b < 2; ++b)
#pragma unroll
                for (int m = 0; m < 4; ++m)
#pragma unroll
                    for (int n = 0; n < 2; ++n) acc[a][b][m][n] = (f32x4){0.f, 0.f, 0.f, 0.f};
        cur = nxt; cA = nA; cB = nB; ++ui;
        if constexpr (ALIGN_EPI) { if (wr == 1) PG8_BAR; }
    }
    PG8_WAIT_V(0);
    if constexpr (!ALIGN_EPI) { if (wr == 0) PG8_BAR; }
    PG8_BAR;
    if constexpr (Epi::AFTER_DRAIN) { E.fused(acc, cur, wr, wc, fr, fq, lds, wid, lane); S.done(cur); }
#undef PG8_SA
#undef PG8_SB
#undef PG8_STAGE
#undef PG8_LDA
#undef PG8_LDB
#undef PG8_MMA
#undef PG8_WAIT_V
#undef PG8_WAIT_L
#undef PG8_BAR
#undef PG8_SCHED
}
}

#define LAS __attribute__((address_space(3)))
typedef unsigned short bf16;
typedef float f32x4 __attribute__((ext_vector_type(4)));
typedef unsigned u32x4 __attribute__((ext_vector_type(4)));
typedef unsigned u32x2 __attribute__((ext_vector_type(2)));
constexpr int DM = 1024, NCTX = 8192, MTOK = 12288, DINP = 2560, DFF = 4096;
constexpr int R_OFF = 0, K_OFF = 512, V_OFF = 1024, WD_OFF = 1536, AD_OFF = 1664, GD_OFF = 1792, F_OFF = 1920, P_OFF = 2176, DIN = 2432;
constexpr size_t MiB = 1u << 20;
constexpr size_t WS_CTL = 0, WS_MOD = 1 * MiB, WS_FW = 1 * MiB + 512 * 1024, WS_BC = 2 * MiB, WS_CS256 = 3 * MiB, WS_CS1024 = 4 * MiB, WS_WIN = 8 * MiB, WS_WOUT = 18 * MiB,
                 WS_W1 = 22 * MiB, WS_W2 = 38 * MiB, WS_H = 54 * MiB, WS_MIXED = 78 * MiB, WS_PROJ = 102 * MiB, WS_YCS = 162 * MiB, WS_YF = 102 * MiB, WS_YB = 126 * MiB  , WS_U = 174 * MiB, WS_KINV = 220 * MiB, WS_GUPT = 221 * MiB,
                 WS_FF = 102 * MiB, WS_WUPT = 222 * MiB, WS_AUPT = 222 * MiB + 256 * 1024, WS_SSQ = 223 * MiB, WS_WPT = 223 * MiB + 512 * 1024, WS_SW1 = 224 * MiB, WS_SWIN = 224 * MiB + 256 * 1024, WS_END = 225 * MiB;
constexpr int LDS_BYTES = 147456, RING_BYTES = 131072, MISC_OFF = RING_BYTES + 320;
constexpr int NTHR = 512;
enum { I_XP = 0, I_XS, I_STATE, I_C, I_CCTX, I_WADA, I_BADA, I_N1G, I_WIN, I_MU, I_W0, I_WUP, I_A0, I_AUP, I_GUP, I_KK, I_KA, I_RK, I_LNW, I_LNB, I_WFNET, I_WPOOL, I_PSCALE, I_WOUT, I_N2G, I_WFF1, I_WFF2, I_FNG, N_IN };
struct KP { const float* in[N_IN]; float* out; unsigned char* ws; int ph_lo, ph_hi; };
typedef const __attribute__((address_space(4))) KP CKP;

__device__ __forceinline__ unsigned f2bf(float f) { unsigned u = __builtin_bit_cast(unsigned, f); return (u + 0x7fffu + ((u >> 16) & 1u)) >> 16; }
__device__ __forceinline__ unsigned pk2(float lo, float hi) { return f2bf(lo) | (f2bf(hi) << 16); }
__device__ __forceinline__ float bflo(unsigned w) { return __builtin_bit_cast(float, w << 16); }
__device__ __forceinline__ float bfhi(unsigned w) { return __builtin_bit_cast(float, w & 0xffff0000u); }
__device__ __forceinline__ float bf1(bf16 h) { return __builtin_bit_cast(float, (unsigned)h << 16); }
__device__ __forceinline__ float fexp(float x) { return __builtin_amdgcn_exp2f(x * 1.4426950408889634f); }
__device__ __forceinline__ float flog(float x) { return __builtin_amdgcn_logf(x) * 0.6931471805599453f; }
__device__ __forceinline__ float frcp(float x) { return __builtin_amdgcn_rcpf(x); }
__device__ __forceinline__ float frsq(float x) { return __builtin_amdgcn_rsqf(x); }
__device__ __forceinline__ float fsigmoid(float x) { return frcp(1.0f + fexp(-x)); }
template <int CTRL> __device__ __forceinline__ float dppf(float x) { return __builtin_bit_cast(float, __builtin_amdgcn_update_dpp(0, __builtin_bit_cast(int, x), CTRL, 0xF, 0xF, true)); }
__device__ __forceinline__ float red8(float x)  { x += dppf<0xB1>(x); x += dppf<0x4E>(x); x += dppf<0x141>(x); return x; }
__device__ __forceinline__ float red16(float x) { x += dppf<0xB1>(x); x += dppf<0x4E>(x); x += dppf<0x141>(x); x += dppf<0x140>(x); return x; }
__device__ __forceinline__ float wave_sum(float v) {
    v = red16(v);
    const float s0 = __builtin_bit_cast(float, __builtin_amdgcn_readlane(__builtin_bit_cast(int, v), 0)), s1 = __builtin_bit_cast(float, __builtin_amdgcn_readlane(__builtin_bit_cast(int, v), 16));
    const float s2 = __builtin_bit_cast(float, __builtin_amdgcn_readlane(__builtin_bit_cast(int, v), 32)), s3 = __builtin_bit_cast(float, __builtin_amdgcn_readlane(__builtin_bit_cast(int, v), 48));
    return (s0 + s1) + (s2 + s3);
}
__device__ __forceinline__ void load4bf(const bf16* p, float (&o)[4]) { const u32x2 w = *(const u32x2*)p; o[0] = bflo(w.x); o[1] = bfhi(w.x); o[2] = bflo(w.y); o[3] = bfhi(w.y); }
__device__ __forceinline__ void load8bf(const bf16* p, float (&o)[8]) { const u32x4 w = *(const u32x4*)p; o[0] = bflo(w.x); o[1] = bfhi(w.x); o[2] = bflo(w.y); o[3] = bfhi(w.y); o[4] = bflo(w.z); o[5] = bfhi(w.z); o[6] = bflo(w.w); o[7] = bfhi(w.w); }
__device__ __forceinline__ void shift4(const bf16* proj, int row, bool hasp, bool hasn, int col, const float* mu, float (&u)[4]) {
    float p[4], a[4] = {0.f, 0.f, 0.f, 0.f}, b[4] = {0.f, 0.f, 0.f, 0.f};
    load4bf(proj + (size_t)row * DINP + col, p);
    if (hasp) load4bf(proj + (size_t)(row - 1) * DINP + col, a);
    if (hasn) load4bf(proj + (size_t)(row + 1) * DINP + col, b);
    const f32x4 m = *(const f32x4*)(mu + col);
#pragma unroll
    for (int j = 0; j < 4; ++j) u[j] = p[j] + m[j] * (0.5f * (a[j] + b[j]) - p[j]);
}

__device__ __forceinline__ void transpose_item(const float* W, int K, int N, bf16* WT, LAS float* scr, int item, int lane) {
    const int nblk = N / 32, kb = item / nblk, nb = item % nblk, k0 = 64 * kb, n0 = 32 * nb;
#pragma unroll 8
    for (int i = 0; i < 32; ++i) { const int kk = 2 * i + (lane >> 5); scr[kk * 33 + (lane & 31)] = W[(size_t)(k0 + kk) * N + n0 + (lane & 31)]; }
    asm volatile("s_waitcnt lgkmcnt(0)" ::: "memory");
    const int c = lane & 7;
#pragma unroll
    for (int j = 0; j < 4; ++j) { const int n = (lane >> 3) + 8 * j; const LAS float* s = scr + (8 * c) * 33 + n;
        u32x4 o; o.x = pk2(s[0 * 33], s[1 * 33]); o.y = pk2(s[2 * 33], s[3 * 33]); o.z = pk2(s[4 * 33], s[5 * 33]); o.w = pk2(s[6 * 33], s[7 * 33]);
        *(u32x4*)(WT + (size_t)(n0 + n) * K + k0 + 8 * c) = o; }
    asm volatile("s_waitcnt lgkmcnt(0)" ::: "memory");
}
__device__ __forceinline__ void gemv5_cols(LAS float* sc, LAS float* red, const float* W, int ldw, int colw, const float* bias, float* out, int ldo, int colo, int tid) {
    const int cgi = tid & 15, kg = tid >> 4;
    f32x4 acc[5];
#pragma unroll
    for (int c = 0; c < 5; ++c) acc[c] = (f32x4){0.f, 0.f, 0.f, 0.f};
    const float* wp = W + (size_t)(kg * 32) * ldw + colw + cgi * 4;
#pragma unroll 8
    for (int kk = 0; kk < 32; ++kk) { const f32x4 w = *(const f32x4*)(wp + (size_t)kk * ldw);
#pragma unroll
        for (int c = 0; c < 5; ++c) acc[c] += sc[c * 1024 + kg * 32 + kk] * w; }
#pragma unroll
    for (int c = 0; c < 5; ++c) *(LAS f32x4*)(red + (kg * 5 + c) * 64 + cgi * 4) = acc[c];
    __syncthreads();
    if (tid < 320) { const int cond = tid >> 6, col = tid & 63; float sm = bias ? bias[colo + col] : 0.f;
        for (int g = 0; g < 32; ++g) sm += red[(g * 5 + cond) * 64 + col];
        out[(size_t)cond * ldo + colo + col] = sm; }
    __syncthreads();
}
__device__ __forceinline__ void mod_item(CKP& p, LAS unsigned char* lds, int it) {
    const int tid = opaque_tid(); unsigned char* ws = p.ws;
    LAS float* sc = (LAS float*)lds; LAS float* red = (LAS float*)(lds + 20480);
    const int l = it / 96, cgp = it % 96;
    for (int i = tid; i < 5 * 1024; i += NTHR) { const int cond = i >> 10, k = i & 1023; const float v = cond == 0 ? p.in[I_CCTX][k] : p.in[I_C][(cond - 1) * 1024 + k]; sc[i] = v * fsigmoid(v); }
    __syncthreads();
    gemv5_cols(sc, red, p.in[I_WADA] + (size_t)l * 1024 * 6144, 6144, cgp * 64, p.in[I_BADA] + l * 6144, (float*)(ws + WS_MOD) + (size_t)l * 5 * 6144, 6144, cgp * 64, tid);
}
constexpr int TI_IN = 16 * 76, TI_OUT = 16 * 32, TI_1 = 16 * 128, TI_2 = 64 * 32, TI_L = TI_IN + TI_OUT + TI_1 + TI_2;
__device__ __forceinline__ void transpose_range(CKP& p, LAS unsigned char* lds, int first, int last, int bid, int nb) {
    const int tid = opaque_tid(), lane = tid & 63, wave = tid >> 6;
    unsigned char* ws = p.ws;
    LAS float* scr = (LAS float*)(lds + wave * 16384);
#pragma unroll 1
    for (int it = first + bid * 8 + wave; it < last; it += nb * 8) {
        const int l = it / TI_L; int r = it % TI_L;
        if (r < TI_IN) { transpose_item(p.in[I_WIN] + (size_t)l * DM * DIN, DM, DIN, (bf16*)(ws + WS_WIN) + (size_t)l * DINP * DM, scr, r, lane); continue; } r -= TI_IN;
        if (r < TI_OUT) { transpose_item(p.in[I_WOUT] + (size_t)l * DM * DM, DM, DM, (bf16*)(ws + WS_WOUT) + (size_t)l * DM * DM, scr, r, lane); continue; } r -= TI_OUT;
        if (r < TI_1) { transpose_item(p.in[I_WFF1] + (size_t)l * DM * DFF, DM, DFF, (bf16*)(ws + WS_W1) + (size_t)l * DFF * DM, scr, r, lane); continue; } r -= TI_1;
        transpose_item(p.in[I_WFF2] + (size_t)l * DFF * DM, DFF, DM, (bf16*)(ws + WS_W2) + (size_t)l * DM * DFF, scr, r, lane);
    }
}
__device__ __forceinline__ void stage_prologue(CKP& p, LAS unsigned char* lds, int bid, int nb) {
    const int tid = opaque_tid();
    unsigned char* ws = p.ws;
    transpose_range(p, lds, 0, TI_IN, bid, nb);
    const int gt = bid * NTHR + tid, NGT = nb * NTHR;
#pragma unroll 1
    for (int i = gt; i < 2 * 128 * DM / 8; i += NGT) { const int l = i / (128 * DM / 8), r = i % (128 * DM / 8);
        u32x4 z = (u32x4){0u, 0u, 0u, 0u}; asm volatile("" : "+v"(z));
        *(u32x4*)((bf16*)(ws + WS_WIN) + (size_t)l * DINP * DM + (size_t)DIN * DM + (size_t)r * 8) = z; }
    __syncthreads();
#pragma unroll 1
    for (int it = bid; it < 192; it += nb) mod_item(p, lds, it);
}
__device__ __forceinline__ void stage_tables(CKP& p, int bid, int nb) {
    const int tid = opaque_tid(); unsigned char* ws = p.ws;
    const int gt = bid * NTHR + tid, NGT = nb * NTHR;
#pragma unroll 1
    for (int i = gt; i < 256 * 512 + 1024 * 2048; i += NGT) {
        int L, k, j; bf16* dst;
        if (i < 256 * 512) { L = 256; k = i / 512; j = i % 512; dst = (bf16*)(ws + WS_CS256) + i; }
        else { const int i2 = i - 256 * 512; L = 1024; k = i2 / 2048; j = i2 % 2048; dst = (bf16*)(ws + WS_CS1024) + i2; }
        const int jj = j >= L ? j - L : j; const int idx = (k * jj) & (L - 1);
        const float rev = (float)idx / (float)L; const float s = __builtin_amdgcn_sinf(rev), c = __builtin_amdgcn_cosf(rev);
        *dst = (bf16)f2bf(j >= L ? -s : c);
    }
#pragma unroll 1
    for (int i = gt; i < 2 * 4 * 64 * 128; i += NGT) {
        const int o = i & 127, c = (i >> 7) & 63, lg = i >> 13; const float* wf = p.in[I_WFNET] + (size_t)lg * 4096 + (o & 63);
        float acc = 0.f;
        for (int cp = 0; cp < 64; ++cp) { const float rev = (float)((c * cp) & 63) * (1.0f / 64.0f); const float s = __builtin_amdgcn_sinf(rev), co = __builtin_amdgcn_cosf(rev); acc += (o < 64 ? co : s) * wf[cp * 64]; }
        ((bf16*)(ws + WS_FW))[(size_t)(lg * 128 + o) * 64 + c] = (bf16)f2bf(acc);
    }
#pragma unroll 1
    for (int i = gt; i < 2 * 4 * 64 * 64; i += NGT) { const int o = i & 63, c = (i >> 6) & 63, lg = i >> 12;
        ((bf16*)(ws + WS_WPT))[(size_t)(lg * 64 + o) * 64 + c] = (bf16)f2bf(p.in[I_WPOOL][i]); }
#pragma unroll 1
    for (int i = gt; i < 2 * 2 * 64 * 512; i += NGT) { const int c = i & 511, r = (i >> 9) & 63, ld = i >> 15;
        ((bf16*)(ws + WS_WUPT))[(size_t)(ld * 512 + c) * 64 + r] = (bf16)f2bf(p.in[I_WUP][i]);
        ((bf16*)(ws + WS_AUPT))[(size_t)(ld * 512 + c) * 64 + r] = (bf16)f2bf(p.in[I_AUP][i]); }
#pragma unroll 1
    for (int i = gt; i < 2 * 128 * 512; i += NGT) { const int c = i & 511, r = (i >> 9) & 127, ll = i >> 16;
        ((bf16*)(ws + WS_GUPT))[(size_t)(ll * 512 + c) * 128 + r] = (bf16)f2bf(p.in[I_GUP][i]); }
}
__device__ __forceinline__ void shiftw_item(CKP& p, LAS unsigned char* lds, int it) {
    const int tid = opaque_tid();
    unsigned char* ws = p.ws;
    LAS float* sc = (LAS float*)lds; LAS float* red = (LAS float*)(lds + 20480);
    const bool isin = it >= 128; const int l = isin ? 1 : it >> 6, blk = isin ? it - 128 : it & 63;
    const float* shv = (const float*)(ws + WS_MOD) + (size_t)l * 5 * 6144 + (isin ? 0 : 3 * 1024);
    for (int i = tid; i < 5 * 1024; i += NTHR) sc[i] = shv[(i >> 10) * 6144 + (i & 1023)];
    __syncthreads();
    if (isin) gemv5_cols(sc, red, p.in[I_WIN] + (size_t)DM * DIN, DIN, blk * 64, nullptr, (float*)(ws + WS_SWIN), DINP, blk * 64, tid);
    else gemv5_cols(sc, red, p.in[I_WFF1] + (size_t)l * DM * DFF, DFF, blk * 64, nullptr, (float*)(ws + WS_SW1) + (size_t)l * 5 * DFF, DFF, blk * 64, tid);
    if (it == 165) for (int i = tid; i < 5 * 128; i += NTHR) ((float*)(ws + WS_SWIN))[(i >> 7) * DINP + DIN + (i & 127)] = 0.f;
}
__device__ __forceinline__ void side_queue(CKP& p, int l, LAS unsigned char* lds) {
    const int tid = opaque_tid();
    unsigned* ctr = (unsigned*)(p.ws + WS_CTL + 524288) + 64 * l;
    volatile LAS unsigned* slot = (volatile LAS unsigned*)(lds + RING_BYTES + 64);
    const int nmd = 0, nsh = l == 0 ? 166 : 0, first = l == 0 ? TI_IN : TI_L + TI_IN, nch = ((l == 0 ? TI_L + TI_IN : 2 * TI_L) - first) / 8;
    __syncthreads();
#pragma unroll 1
    for (;;) {
        if (tid == 0) *slot = atomicAdd(ctr, 1u);
        __syncthreads();
        const int it = (int)*slot;
        __syncthreads();
        if (it >= nmd + nsh + nch) break;
        if (it < nmd) mod_item(p, lds, 96 + it);
        else if (it < nmd + nsh) shiftw_item(p, lds, it - nmd);
        else { const int c0 = first + 8 * (it - nmd - nsh); transpose_range(p, lds, c0, c0 + 8, 0, 1); }
        __syncthreads();
    }
}

__device__ __forceinline__ void stage_norm(CKP& p, int l, int which, int bid, int nb) {
    const int tid = opaque_tid(), lane = tid & 63, wave = tid >> 6;
    const float* g = p.in[which ? I_N2G : I_N1G] + l * DM;
    const float* mod = (const float*)(p.ws + WS_MOD) + (size_t)l * 5 * 6144 + (which ? 3 * 1024 : 0);
    bf16* H = (bf16*)(p.ws + WS_H);
#pragma unroll 1
    for (int row = bid * 8 + wave; row < MTOK; row += nb * 8) {
        const float* xsrc = (l == 0 && which == 0) ? (row < NCTX ? p.in[I_XP] + (size_t)row * DM : p.in[I_XS] + (size_t)(row - NCTX) * DM) : p.out + (size_t)row * DM;
        const f32x4* xr = (const f32x4*)xsrc + lane;
        f32x4 v[4]; float s = 0.f;
#pragma unroll
        for (int j = 0; j < 4; ++j) { v[j] = xr[64 * j]; s += (v[j].x * v[j].x + v[j].y * v[j].y) + (v[j].z * v[j].z + v[j].w * v[j].w); }
        const float rstd = frsq(wave_sum(s) * (1.0f / DM) + 1e-6f);
        const int cond = row < NCTX ? 0 : 1 + ((row - NCTX) >> 10);
        const float* sh = mod + cond * 6144; const float* scl = sh + 1024;
        unsigned long long* o8 = (unsigned long long*)(H + (size_t)row * DM) + lane;
#pragma unroll
        for (int j = 0; j < 4; ++j) { const int col = 4 * lane + 256 * j; const f32x4 gg = *(const f32x4*)(g + col), a = *(const f32x4*)(sh + col), b = *(const f32x4*)(scl + col);
            const f32x4 y = v[j] * rstd * gg * (b + 1.0f) + a;
            o8[64 * j] = (unsigned long long)pk2(y.x, y.y) | ((unsigned long long)pk2(y.z, y.w) << 32); }
    }
}
__device__ __forceinline__ void stage_final(CKP& p, int bid, int nb) {
    const int tid = opaque_tid(), lane = tid & 63, wave = tid >> 6;
    const float* g = p.in[I_FNG];
#pragma unroll 1
    for (int row = bid * 8 + wave; row < MTOK; row += nb * 8) {
        f32x4* xr = (f32x4*)(p.out + (size_t)row * DM) + lane;
        f32x4 v[4]; float s = 0.f;
#pragma unroll
        for (int j = 0; j < 4; ++j) { v[j] = xr[64 * j]; s += (v[j].x * v[j].x + v[j].y * v[j].y) + (v[j].z * v[j].z + v[j].w * v[j].w); }
        const float rstd = frsq(wave_sum(s) * (1.0f / DM) + 1e-6f);
#pragma unroll
        for (int j = 0; j < 4; ++j) xr[64 * j] = v[j] * rstd * *(const f32x4*)(g + 4 * lane + 256 * j);
    }
}


typedef short bf16x8 __attribute__((ext_vector_type(8)));
typedef float f32x2v __attribute__((ext_vector_type(2)));
typedef __bf16 bf16x2v __attribute__((ext_vector_type(2)));
#define MFMA16(a, b, c) __builtin_amdgcn_mfma_f32_16x16x32_bf16((a), (b), (c), 0, 0, 0)
__device__ __forceinline__ unsigned cvt2(float lo, float hi) { f32x2v v = {lo, hi}; bf16x2v b = __builtin_convertvector(v, bf16x2v); return __builtin_bit_cast(unsigned, b); }
__device__ __forceinline__ u32x4 pack8(const float (&x)[8]) { u32x4 w; w.x = cvt2(x[0], x[1]); w.y = cvt2(x[2], x[3]); w.z = cvt2(x[4], x[5]); w.w = cvt2(x[6], x[7]); return w; }
__device__ __forceinline__ void shift8(const bf16* proj, int row, bool hasp, bool hasn, int col, const float* mu, float (&u)[8]) {
    float p[8], a[8], b[8];
    load8bf(proj + (size_t)row * DINP + col, p);
    if (hasp) load8bf(proj + (size_t)(row - 1) * DINP + col, a); else {
#pragma unroll
        for (int j = 0; j < 8; ++j) a[j] = 0.f; }
    if (hasn) load8bf(proj + (size_t)(row + 1) * DINP + col, b); else {
#pragma unroll
        for (int j = 0; j < 8; ++j) b[j] = 0.f; }
    const f32x4 m0 = *(const f32x4*)(mu + col), m1 = *(const f32x4*)(mu + col + 4);
#pragma unroll
    for (int j = 0; j < 4; ++j) { u[j] = p[j] + m0[j] * (0.5f * (a[j] + b[j]) - p[j]); u[4 + j] = p[4 + j] + m1[j] * (0.5f * (a[4 + j] + b[4 + j]) - p[4 + j]); }
}
__device__ __forceinline__ int opq(int x) { asm volatile("" : "+v"(x)); return x; }
constexpr int TS = 72, TB = 64 * TS * 2;
constexpr int L_HT = 0, L_TW = 9216, L_AD = 18432, L_LP = 27648, L_AP = 45056, L_AT = 62464, L_RT = L_AT + TB, L_BH = L_RT + TB, L_KH = L_BH + TB, L_VR = L_KH + TB, L_YS = L_VR + TB;
constexpr int L_AAB = L_TW, L_AAK = L_AAB + 4096, L_ARB = L_AAK + 3072, L_ARK = L_ARB + 3072, L_UT = L_ARK + 3072, L_W1 = L_AP;
static_assert(L_UT + 64 * 24 * 2 <= L_LP && L_YS + 17408 <= RING_BYTES, "scan LDS map");
constexpr int LPS = 68;
#define LBAR() asm volatile("s_waitcnt lgkmcnt(0)\n\ts_barrier" ::: "memory")
typedef short s16x4v __attribute__((ext_vector_type(4)));
__device__ __forceinline__ bf16x8 tr8(const LAS bf16* p) {
    const s16x4v lo = __builtin_bit_cast(s16x4v, __builtin_amdgcn_ds_read_tr16_b64_v4i16((LAS s16x4v*)p));
    const s16x4v hi = __builtin_bit_cast(s16x4v, __builtin_amdgcn_ds_read_tr16_b64_v4i16((LAS s16x4v*)(p + 4 * TS)));
    return (bf16x8){lo[0], lo[1], lo[2], lo[3], hi[0], hi[1], hi[2], hi[3]};
}

__device__ __forceinline__ void rwkv_item3(CKP& p, int l, LAS unsigned char* lds, int item) {
    const int tid0 = opaque_tid(), w = __builtin_amdgcn_readfirstlane(tid0 >> 6);
    int tid = tid0, fr = tid & 15, fg = (tid & 63) >> 4;
    int bseq, h, dir, L, base; bool lat;
    if (item < 64) { lat = true; bseq = item >> 4; h = (item >> 1) & 7; dir = item & 1; L = 1024; base = NCTX + bseq * 1024; }
    else { const int i2 = item - 64; lat = false; bseq = i2 >> 4; h = (i2 >> 1) & 7; dir = i2 & 1; L = 256; base = bseq * 256; }
    const bf16* U = (const bf16*)(p.ws + WS_U);
    const float* KINV = (const float*)(p.ws + WS_KINV);
    bf16* Yout = (bf16*)(p.ws + (dir ? WS_YB : WS_YF));
    float* BC = (float*)(p.ws + WS_BC) + (size_t)dir * MTOK * 8;
    const bf16* wupt = (const bf16*)(p.ws + WS_WUPT) + ((size_t)(l * 2 + dir) * 512 + h * 64) * 64;
    const bf16* aupt = (const bf16*)(p.ws + WS_AUPT) + ((size_t)(l * 2 + dir) * 512 + h * 64) * 64;

    LAS float* LP = (LAS float*)(lds + L_LP); LAS float* AP = (LAS float*)(lds + L_AP); LAS float* AS = (LAS float*)(lds + L_TW);
    LAS bf16* AT = (LAS bf16*)(lds + L_AT);   LAS bf16* RT = (LAS bf16*)(lds + L_RT);   LAS bf16* BH = (LAS bf16*)(lds + L_BH);   LAS bf16* KH = (LAS bf16*)(lds + L_KH);
    LAS bf16* VR = (LAS bf16*)(lds + L_VR);   LAS float* YS = (LAS float*)(lds + L_YS);
    LAS float* AAB = (LAS float*)(lds + L_AAB); LAS bf16* AAK = (LAS bf16*)(lds + L_AAK); LAS bf16* ARB = (LAS bf16*)(lds + L_ARB); LAS bf16* ARK = (LAS bf16*)(lds + L_ARK);
    LAS float* W1 = (LAS float*)(lds + L_W1);
    const int tv = w & 3;
    f32x4 hacc[4];
#pragma unroll
    for (int x = 0; x < 4; ++x) {
        if (lat && w < 4) hacc[x] = *(const f32x4*)(p.in[I_STATE] + ((((size_t)bseq * 2 + l) * 2 + dir) * 8 + h) * 4096 + (16 * tv + fr) * 64 + 16 * x + 4 * fg);
        else hacc[x] = (f32x4){0.f, 0.f, 0.f, 0.f}; }
    int ei = tid >> 3, ec8 = (tid & 7) * 8; const int hc8 = h * 64 + ec8;
    float kkp[8], kap[8], rkp[8];
#pragma unroll
    for (int e = 0; e < 8; ++e) { kkp[e] = p.in[I_KK][l * 512 + hc8 + e]; kap[e] = p.in[I_KA][l * 512 + hc8 + e]; rkp[e] = p.in[I_RK][l * 512 + hc8 + e]; }
#define SCAN_PREFETCH(SC) do { const int _t0 = opq(tid0), _ei = _t0 >> 3, _ec8 = (_t0 & 7) * 8; const int _step = (SC) * 64 + _ei, _t = dir ? L - 1 - _step : _step; \
        const bf16* _u = U + (size_t)(base + _t) * 1920; \
        nr = *(const u32x4*)(_u + R_OFF + h * 64 + _ec8); nk = *(const u32x4*)(_u + K_OFF + h * 64 + _ec8); nv = *(const u32x4*)(_u + V_OFF + h * 64 + _ec8); \
        ninv = KINV[(size_t)(base + _t) * 8 + h]; \
        const int _st2 = (SC) * 64 + 16 * (w >> 1) + (_t0 & 15), _t2 = dir ? L - 1 - _st2 : _st2; const bf16* _u2 = U + (size_t)(base + _t2) * 1920 + dir * 64 + ((_t0 & 63) >> 4) * 8; \
        paw0 = *(const bf16x8*)(_u2 + WD_OFF); paw1 = *(const bf16x8*)(_u2 + WD_OFF + 32); paa0 = *(const bf16x8*)(_u2 + AD_OFF); paa1 = *(const bf16x8*)(_u2 + AD_OFF + 32); } while (0)
    bf16x8 lbw[2][2], lba[2][2]; float lw0c[2], la0c[2];
#pragma unroll
    for (int x = 0; x < 2; ++x) { const int c = ((w & 1) * 2 + x) * 16 + fr;
        lbw[x][0] = *(const bf16x8*)(wupt + c * 64 + fg * 8); lbw[x][1] = *(const bf16x8*)(wupt + c * 64 + 32 + fg * 8);
        lba[x][0] = *(const bf16x8*)(aupt + c * 64 + fg * 8); lba[x][1] = *(const bf16x8*)(aupt + c * 64 + 32 + fg * 8);
        lw0c[x] = p.in[I_W0][(l * 2 + dir) * 512 + h * 64 + c]; la0c[x] = p.in[I_A0][(l * 2 + dir) * 512 + h * 64 + c]; }
    u32x4 nr, nk, nv; float ninv; bf16x8 paw0, paw1, paa0, paa1;
    SCAN_PREFETCH(0);
    __syncthreads();
#pragma unroll 1
    for (int sc = 0; sc < L / 64; ++sc) {
        tid = opq(tid0); fr = tid & 15; fg = (tid & 63) >> 4; ei = tid >> 3; ec8 = (tid & 7) * 8;
        const u32x4 cr = nr, ck = nk, cv = nv; const float kinv = ninv;
        { const int ti = w >> 1;
          const bf16x8 aw0 = paw0, aw1 = paw1, aa0 = paa0, aa1 = paa1;
          unsigned li[2], ls[2];
#pragma unroll
          for (int pr = 0; pr < 2; ++pr) { const int j0 = 4 * fg + 2 * pr, j1 = j0 + 1;
              li[pr] = (j0 <= fr ? 0x3f80u : 0u) | (j1 <= fr ? 0x3f800000u : 0u); ls[pr] = (j0 < fr ? 0x3f80u : 0u) | (j1 < fr ? 0x3f800000u : 0u); }
          const bf16x8 Li = __builtin_bit_cast(bf16x8, (u32x4){li[0], li[1], 0u, 0u}), Ls = __builtin_bit_cast(bf16x8, (u32x4){ls[0], ls[1], 0u, 0u});
#pragma unroll
          for (int x = 0; x < 2; ++x) { const int c = ((w & 1) * 2 + x) * 16 + fr;
              f32x4 cw = (f32x4){lw0c[x], lw0c[x], lw0c[x], lw0c[x]}, ca = (f32x4){la0c[x], la0c[x], la0c[x], la0c[x]};
              cw = MFMA16(aw0, lbw[x][0], cw); cw = MFMA16(aw1, lbw[x][1], cw); ca = MFMA16(aa0, lba[x][0], ca); ca = MFMA16(aa1, lba[x][1], ca);
              float lw[4], lo[4];
#pragma unroll
              for (int r = 0; r < 4; ++r) lw[r] = -0.6065306597126334f * fsigmoid(cw[r]);
              const unsigned h01 = cvt2(lw[0], lw[1]), h23 = cvt2(lw[2], lw[3]);
              lo[0] = lw[0] - bflo(h01); lo[1] = lw[1] - bfhi(h01); lo[2] = lw[2] - bflo(h23); lo[3] = lw[3] - bfhi(h23);
              const bf16x8 bh = __builtin_bit_cast(bf16x8, (u32x4){h01, h23, 0u, 0u}), bl = __builtin_bit_cast(bf16x8, (u32x4){cvt2(lo[0], lo[1]), cvt2(lo[2], lo[3]), 0u, 0u});
              f32x4 ci = (f32x4){0.f, 0.f, 0.f, 0.f}, cs = ci;
              ci = MFMA16(Li, bh, ci); ci = MFMA16(Li, bl, ci); cs = MFMA16(Ls, bh, cs); cs = MFMA16(Ls, bl, cs);
#pragma unroll
              for (int r = 0; r < 4; ++r) { const int o = (ti * 16 + 4 * fg + r) * LPS + c;
                  LP[o] = fexp(ci[r]); AP[o] = fexp(cs[r]); AS[o] = fsigmoid(ca[r]); } } }
        __syncthreads();
        tid = opq(tid0); fr = tid & 15; fg = (tid & 63) >> 4; ei = tid >> 3; ec8 = (tid & 7) * 8;
        float bcv;
        { const f32x4 g0 = *(const LAS f32x4*)(LP + ei * LPS + ec8), g1 = *(const LAS f32x4*)(LP + ei * LPS + ec8 + 4);
          const f32x4 p0 = *(const LAS f32x4*)(AP + ei * LPS + ec8), p1 = *(const LAS f32x4*)(AP + ei * LPS + ec8 + 4);
          const f32x4 s0 = *(const LAS f32x4*)(AS + ei * LPS + ec8), s1 = *(const LAS f32x4*)(AS + ei * LPS + ec8 + 4);
          float rr[8], kk[8], xa[8], xr[8], xb[8], xk[8], bc = 0.f;
          rr[0] = bflo(cr.x); rr[1] = bfhi(cr.x); rr[2] = bflo(cr.y); rr[3] = bfhi(cr.y); rr[4] = bflo(cr.z); rr[5] = bfhi(cr.z); rr[6] = bflo(cr.w); rr[7] = bfhi(cr.w);
          kk[0] = bflo(ck.x); kk[1] = bfhi(ck.x); kk[2] = bflo(ck.y); kk[3] = bfhi(ck.y); kk[4] = bflo(ck.z); kk[5] = bfhi(ck.z); kk[6] = bflo(ck.w); kk[7] = bfhi(ck.w);
#pragma unroll
          for (int e = 0; e < 8; ++e) { const float gi = e < 4 ? g0[e & 3] : g1[e & 3], gp = e < 4 ? p0[e & 3] : p1[e & 3], asg = e < 4 ? s0[e & 3] : s1[e & 3];
              const float kj = kk[e] * kkp[e] * kinv, kd = kk[e] * (1.0f + (asg - 1.0f) * kap[e]), ginv = frcp(gi);
              bc += rr[e] * kd * rkp[e];
              xa[e] = -kj * gp; xr[e] = rr[e] * gi; xb[e] = kj * asg * ginv; xk[e] = kd * ginv; }
          bcv = red8(bc);
          *(LAS u32x4*)(AT + ei * TS + ec8) = pack8(xa); *(LAS u32x4*)(RT + ei * TS + ec8) = pack8(xr); *(LAS u32x4*)(BH + ei * TS + ec8) = pack8(xb); *(LAS u32x4*)(KH + ei * TS + ec8) = pack8(xk);
          *(LAS u32x4*)(VR + ei * TS + ec8) = cv; }
        __syncthreads();
        tid = opq(tid0); fr = tid & 15; fg = (tid & 63) >> 4;
        { const int q = w >> 1, half = w & 1; const LAS bf16* Asrc = half ? RT : AT;
          const bf16x8 af0 = *(const LAS bf16x8*)(Asrc + (16 * q + fr) * TS + fg * 8), af1 = *(const LAS bf16x8*)(Asrc + (16 * q + fr) * TS + 32 + fg * 8);
#pragma unroll
          for (int x = 0; x < 2; ++x) { const LAS bf16* Bsrc = x ? KH : BH;
              const bf16x8 bf0 = *(const LAS bf16x8*)(Bsrc + (16 * q + fr) * TS + fg * 8), bf1_ = *(const LAS bf16x8*)(Bsrc + (16 * q + fr) * TS + 32 + fg * 8);
              f32x4 c = (f32x4){0.f, 0.f, 0.f, 0.f}; c = MFMA16(af0, bf0, c); c = MFMA16(af1, bf1_, c);
              f32x4 cm;
#pragma unroll
              for (int r = 0; r < 4; ++r) { const int i = 4 * fg + r, j = fr; cm[r] = (half ? j <= i : j < i) ? c[r] : 0.f; }
              if (half == 0 && x == 0) *(LAS f32x4*)(AAB + (q * 16 + fr) * 16 + 4 * fg) = cm;
              else { LAS bf16* dst = half == 0 ? AAK : (x == 0 ? ARB : ARK);
#pragma unroll
                  for (int r = 0; r < 4; ++r) dst[(q * 16 + 4 * fg + r) * 24 + fr] = (bf16)(cvt2(cm[r], 0.f) & 0xffffu); } } }
        __syncthreads();
        tid = opq(tid0); fr = tid & 15; fg = (tid & 63) >> 4;
        { const int q = w >> 1;
          const bf16x8 afr = *(const LAS bf16x8*)(AAK + (q * 16 + fr) * 24 + (fg & 1) * 8);
          const unsigned kmask = fg < 2 ? 0xffffffffu : 0u;
          const bf16x8 af = __builtin_bit_cast(bf16x8, __builtin_bit_cast(u32x4, afr) & kmask);
#pragma unroll
          for (int x = 0; x < 2; ++x) { const int tvv = (w & 1) * 2 + x;
              const bf16x8 bfr = tr8(VR + (16 * q + 8 * (fg & 1) + (fr >> 2)) * TS + 16 * tvv + 4 * (fr & 3));
              const bf16x8 bfv = __builtin_bit_cast(bf16x8, __builtin_bit_cast(u32x4, bfr) & kmask);
              f32x4 c = (f32x4){0.f, 0.f, 0.f, 0.f}; c = MFMA16(af, bfv, c);
#pragma unroll
              for (int r = 0; r < 4; ++r) W1[(q * 16 + 4 * fg + r) * LPS + 16 * tvv + fr] = c[r]; } }
        __syncthreads();
        tid = opq(tid0);
        { const int q = tid >> 7, col = tid & 127; float x[16];
          if (col < 64) {
#pragma unroll
              for (int i = 0; i < 16; ++i) x[i] = bf1(AT[(16 * q + i) * TS + col]); }
          else {
#pragma unroll
              for (int i = 0; i < 16; ++i) x[i] = W1[(q * 16 + i) * LPS + col - 64]; }
#pragma unroll
          for (int j = 0; j < 15; ++j) {
              const LAS f32x4* ac = (const LAS f32x4*)(AAB + (q * 16 + j) * 16);
#pragma unroll
              for (int i4 = (j + 1) / 4; i4 < 4; ++i4) { const f32x4 a4 = ac[i4];
#pragma unroll
                  for (int e = 0; e < 4; ++e) if (i4 * 4 + e > j) x[i4 * 4 + e] += a4[e] * x[j]; } }
          if (col < 64) {
#pragma unroll
              for (int i = 0; i < 16; ++i) AT[(16 * q + i) * TS + col] = (bf16)(cvt2(x[i], 0.f) & 0xffffu); }
          else {
#pragma unroll
              for (int i = 0; i < 16; ++i) W1[(q * 16 + i) * LPS + col - 64] = x[i]; } }
        __syncthreads();
        if (sc + 1 < L / 64) SCAN_PREFETCH(sc + 1);
        if (w < 4) {
#pragma unroll 1
        for (int q = 0; q < 4; ++q) {
            tid = opq(tid0); fr = tid & 15; fg = (tid & 63) >> 4;
            bf16x8 hb[2];
#pragma unroll
            for (int ks = 0; ks < 2; ++ks) { u32x4 t; t.x = cvt2(hacc[2 * ks][0], hacc[2 * ks][1]); t.y = cvt2(hacc[2 * ks][2], hacc[2 * ks][3]);
                t.z = cvt2(hacc[2 * ks + 1][0], hacc[2 * ks + 1][1]); t.w = cvt2(hacc[2 * ks + 1][2], hacc[2 * ks + 1][3]); hb[ks] = __builtin_bit_cast(bf16x8, t); }
            bf16x8 aU[2], aR[2];
#pragma unroll
            for (int ks = 0; ks < 2; ++ks) {
                const u32x2 a0 = *(const LAS u32x2*)(AT + (16 * q + fr) * TS + 32 * ks + 4 * fg), a1 = *(const LAS u32x2*)(AT + (16 * q + fr) * TS + 32 * ks + 16 + 4 * fg);
                const u32x2 r0 = *(const LAS u32x2*)(RT + (16 * q + fr) * TS + 32 * ks + 4 * fg), r1 = *(const LAS u32x2*)(RT + (16 * q + fr) * TS + 32 * ks + 16 + 4 * fg);
                aU[ks] = __builtin_bit_cast(bf16x8, (u32x4){a0.x, a0.y, a1.x, a1.y}); aR[ks] = __builtin_bit_cast(bf16x8, (u32x4){r0.x, r0.y, r1.x, r1.y}); }
            f32x4 u, yacc = (f32x4){0.f, 0.f, 0.f, 0.f};
#pragma unroll
            for (int r = 0; r < 4; ++r) u[r] = W1[(q * 16 + 4 * fg + r) * LPS + 16 * tv + fr];
            u = MFMA16(aU[0], hb[0], u); u = MFMA16(aU[1], hb[1], u);
            yacc = MFMA16(aR[0], hb[0], yacc); yacc = MFMA16(aR[1], hb[1], yacc);
            const s16x4v vtr = __builtin_bit_cast(s16x4v, __builtin_amdgcn_ds_read_tr16_b64_v4i16((LAS s16x4v*)(VR + (16 * q + 4 * fg + (fr >> 2)) * TS + 16 * tv + 4 * (fr & 3))));
            const u32x2 vt2 = __builtin_bit_cast(u32x2, vtr);
            const bf16x8 bUV = __builtin_bit_cast(bf16x8, (u32x4){cvt2(u[0], u[1]), cvt2(u[2], u[3]), vt2.x, vt2.y});
            { const u32x2 y0 = *(const LAS u32x2*)(ARB + (q * 16 + fr) * 24 + 4 * fg), y1 = *(const LAS u32x2*)(ARK + (q * 16 + fr) * 24 + 4 * fg);
              yacc = MFMA16(__builtin_bit_cast(bf16x8, (u32x4){y0.x, y0.y, y1.x, y1.y}), bUV, yacc); }
#pragma unroll
            for (int r = 0; r < 4; ++r) YS[(16 * q + 4 * fg + r) * LPS + 16 * tv + fr] = yacc[r];
#pragma unroll
            for (int x = 0; x < 4; ++x) {
                const s16x4v bt = __builtin_bit_cast(s16x4v, __builtin_amdgcn_ds_read_tr16_b64_v4i16((LAS s16x4v*)(BH + (16 * q + 4 * fg + (fr >> 2)) * TS + 16 * x + 4 * (fr & 3))));
                const s16x4v kt = __builtin_bit_cast(s16x4v, __builtin_amdgcn_ds_read_tr16_b64_v4i16((LAS s16x4v*)(KH + (16 * q + 4 * fg + (fr >> 2)) * TS + 16 * x + 4 * (fr & 3))));
                const u32x2 b2 = __builtin_bit_cast(u32x2, bt), k2 = __builtin_bit_cast(u32x2, kt);
                const f32x4 ge = *(const LAS f32x4*)(LP + (16 * q + 15) * LPS + 16 * x + 4 * fg);
                hacc[x] = MFMA16(__builtin_bit_cast(bf16x8, (u32x4){b2.x, b2.y, k2.x, k2.y}), bUV, hacc[x]) * ge; }
        }
        }
        __syncthreads();
        tid = opq(tid0); ei = tid >> 3; ec8 = (tid & 7) * 8;
        { const int st2 = sc * 64 + ei, t2 = dir ? L - 1 - st2 : st2; bf16* yo = Yout + (size_t)(base + t2) * 512 + h * 64 + ec8;
          const f32x4 y0 = *(const LAS f32x4*)(YS + ei * LPS + ec8), y1 = *(const LAS f32x4*)(YS + ei * LPS + ec8 + 4);
          u32x4 yw; yw.x = cvt2(y0[0], y0[1]); yw.y = cvt2(y0[2], y0[3]); yw.z = cvt2(y1[0], y1[1]); yw.w = cvt2(y1[2], y1[3]);
          *(u32x4*)yo = yw;
          if ((tid & 7) == 0) BC[(size_t)(base + t2) * 8 + h] = bcv; }
    }
#undef SCAN_PREFETCH
    if (!lat && w < 4) {
#pragma unroll
        for (int x = 0; x < 4; ++x) *(f32x4*)(p.out + (size_t)MTOK * DM + ((((size_t)bseq * 2 + l) * 2 + dir) * 8 + h) * 4096 + (16 * tv + fr) * 64 + 16 * x + 4 * fg) = hacc[x]; }
    __syncthreads();
}

__device__ __forceinline__ void stage_upass(CKP& p, int l, int bid, int nb) {
    const int tid = opaque_tid(), sub = tid >= 240 ? 1 : 0, j = tid - sub * 240, col = 8 * j;
    const bf16* proj = (const bf16*)(p.ws + WS_PROJ); bf16* U = (bf16*)(p.ws + WS_U); float* KINV = (float*)(p.ws + WS_KINV);
    const float* mu = p.in[I_MU] + l * 1920;
    if (tid < 480) {
        const bool isk = col >= K_OFF && col < V_OFF;
        const float* kkp = p.in[I_KK] + l * 512 + (isk ? col - K_OFF : 0);
        const f32x4 k0 = *(const f32x4*)kkp, k1 = *(const f32x4*)(kkp + 4);
#pragma unroll 1
        for (int tok0 = bid * 2 + sub; tok0 < MTOK; tok0 += nb * 8) {
            float uu[4][8];
#pragma unroll
            for (int z = 0; z < 4; ++z) { const int tok = min(tok0 + z * nb * 2, MTOK - 1);
                const bool lat = tok >= NCTX; const int L = lat ? 1024 : 256, t = lat ? (tok - NCTX) & 1023 : tok & 255;
                shift8(proj, tok, t > 0, t < L - 1, col, mu, uu[z]); }
#pragma unroll
            for (int z = 0; z < 4; ++z) { const int tok = tok0 + z * nb * 2;
                float ss = 0.f;
#pragma unroll
                for (int e = 0; e < 8; ++e) { const float kn = uu[z][e] * (e < 4 ? k0[e & 3] : k1[e & 3]); ss += kn * kn; }
                ss = red8(ss);
                if (tok < MTOK) {
                    if (isk && (j & 7) == 0) KINV[(size_t)tok * 8 + ((col - K_OFF) >> 6)] = fminf(frsq(ss), 1e12f);
                    if (col >= WD_OFF && col < AD_OFF) {
#pragma unroll
                        for (int e = 0; e < 8; ++e) uu[z][e] = 1.0f - 2.0f * frcp(fexp(2.0f * uu[z][e]) + 1.0f); }
                    if (col >= GD_OFF) {
#pragma unroll
                        for (int e = 0; e < 8; ++e) uu[z][e] = fsigmoid(uu[z][e]); }
                    *(u32x4*)(U + (size_t)tok * 1920 + col) = pack8(uu[z]); } }
        }
    }
}

__device__ __forceinline__ void fnet1_item(CKP& p, int l, int item) {
    const int tid = opaque_tid(), lane = tid & 63, w = __builtin_amdgcn_readfirstlane(tid >> 6), fr = lane & 15, fg = lane >> 4;
    const int tb = item >> 2, g = item & 3, tok0 = tb * 64, tt = w & 3, cs = w >> 2;
    const bf16* proj = (const bf16*)(p.ws + WS_PROJ);
    const bf16* fwt = (const bf16*)(p.ws + WS_FW) + (size_t)((l * 4 + g) * 128 + cs * 64) * 64;
    const bf16* xr = proj + (size_t)(tok0 + 16 * tt + fr) * DINP + F_OFF + g * 64 + fg * 8;
    const bf16x8 a0 = *(const bf16x8*)xr, a1 = *(const bf16x8*)(xr + 32);
    const bool lat = tok0 >= NCTX;
    const int L = lat ? 1024 : 256, bq = lat ? (tok0 - NCTX) >> 10 : tok0 >> 8, t = (lat ? (tok0 - NCTX) & 1023 : tok0 & 255) + 16 * tt + 4 * fg;
    const float scale = lat ? (1.0f / 256.0f) : (1.0f / 128.0f);
    bf16* Y = (bf16*)(p.ws + WS_YCS) + (lat ? (size_t)8192 * 512 : 0);
#pragma unroll
    for (int ot = 0; ot < 4; ++ot) {
        const bf16x8 b0 = *(const bf16x8*)(fwt + (16 * ot + fr) * 64 + fg * 8), b1 = *(const bf16x8*)(fwt + (16 * ot + fr) * 64 + 32 + fg * 8);
        f32x4 c = (f32x4){0.f, 0.f, 0.f, 0.f}; c = MFMA16(a0, b0, c); c = MFMA16(a1, b1, c);
        u32x2 o; o.x = cvt2(c[0] * scale, c[1] * scale); o.y = cvt2(c[2] * scale, c[3] * scale);
        *(u32x2*)(Y + (size_t)((bq * 4 + g) * 64 + 16 * ot + fr) * (2 * L) + cs * L + t) = o; }
}

__device__ __forceinline__ void pool_item(CKP& p, int l, LAS unsigned char* lds, int item) {
    const int tid = opaque_tid(), tb = item >> 2, gi = item & 3, tok0 = tb * 64, hw = 1 << gi;
    const bf16* proj = (const bf16*)(p.ws + WS_PROJ);
    LAS bf16* DB = (LAS bf16*)lds;
    LAS float* CSUM = (LAS float*)(lds + 9216);
    const int ti = tid >> 3, c8 = (tid & 7) * 8, tok = tok0 + ti, col = P_OFF + gi * 64 + c8;
    { float sum[8], x[8];
#pragma unroll
      for (int j = 0; j < 8; ++j) sum[j] = 0.f;
      load8bf(proj + (size_t)tok * DINP + col, x);
      float cnt;
      if (tok < NCTX) { const int t = tok & 255, sb = tok - t, lo = max(t - hw, 0), hi = min(t + hw, 256);
          for (int q = lo; q < hi; ++q) { float y[8]; load8bf(proj + (size_t)(sb + q) * DINP + col, y);
#pragma unroll
              for (int j = 0; j < 8; ++j) sum[j] += y[j]; }
          cnt = (float)(hi - lo); }
      else {
          const int t = (tok - NCTX) & 1023, sb = tok - t, r = t >> 6, c = t & 63, rlo = max(r - hw, 0), rhi = min(r + hw, 16), clo = max(c - hw, 0), chi = min(c + hw, 64);
          for (int rq = rlo; rq < rhi; ++rq) { float y[8]; load8bf(proj + (size_t)(sb + rq * 64 + c) * DINP + col, y);
#pragma unroll
              for (int j = 0; j < 8; ++j) sum[j] += y[j]; }
          *(LAS f32x4*)(CSUM + ti * 68 + c8) = (f32x4){sum[0], sum[1], sum[2], sum[3]}; *(LAS f32x4*)(CSUM + ti * 68 + c8 + 4) = (f32x4){sum[4], sum[5], sum[6], sum[7]};
          __syncthreads();
#pragma unroll
          for (int j = 0; j < 8; ++j) sum[j] = 0.f;
          for (int cq = clo; cq < chi; ++cq) { const f32x4 a = *(const LAS f32x4*)(CSUM + cq * 68 + c8), b = *(const LAS f32x4*)(CSUM + cq * 68 + c8 + 4);
#pragma unroll
              for (int j = 0; j < 4; ++j) { sum[j] += a[j]; sum[4 + j] += b[j]; } }
          cnt = (float)((rhi - rlo) * (chi - clo)); }
      const float ic = frcp(cnt);
      float dd[8];
#pragma unroll
      for (int j = 0; j < 8; ++j) dd[j] = sum[j] * ic - x[j];
      *(LAS u32x4*)(DB + ti * 72 + c8) = pack8(dd); }
    __syncthreads();
    { const int lane = tid & 63, w = __builtin_amdgcn_readfirstlane(tid >> 6), fr = lane & 15, fg = lane >> 4, tt = w & 3;
      const bf16* wpt = (const bf16*)(p.ws + WS_WPT) + (size_t)(l * 4 + gi) * 4096;
      const bf16x8 b0 = *(const LAS bf16x8*)(DB + (16 * tt + fr) * 72 + fg * 8), b1 = *(const LAS bf16x8*)(DB + (16 * tt + fr) * 72 + 32 + fg * 8);
#pragma unroll
      for (int x = 0; x < 2; ++x) { const int ot = 2 * (w >> 2) + x;
          const bf16x8 a0 = *(const bf16x8*)(wpt + (16 * ot + fr) * 64 + fg * 8), a1 = *(const bf16x8*)(wpt + (16 * ot + fr) * 64 + 32 + fg * 8);
          f32x4 c = (f32x4){0.f, 0.f, 0.f, 0.f}; c = MFMA16(a0, b0, c); c = MFMA16(a1, b1, c);
          const f32x4 ps = *(const f32x4*)(p.in[I_PSCALE] + l * 256 + gi * 64 + 16 * ot + 4 * fg);
          c *= ps;
          u32x2 o; o.x = cvt2(c[0], c[1]); o.y = cvt2(c[2], c[3]);
          *(u32x2*)((bf16*)(p.ws + WS_MIXED) + (size_t)(tok0 + 16 * tt + fr) * DM + 768 + gi * 64 + 16 * ot + 4 * fg) = o; } }
    __syncthreads();
}

__device__ __forceinline__ float xsum_fg(float s, int fr, int fg) {
    s += __builtin_bit_cast(float, __builtin_amdgcn_ds_bpermute((((fg ^ 1) << 4) | fr) << 2, __builtin_bit_cast(int, s)));
    s += __builtin_bit_cast(float, __builtin_amdgcn_ds_bpermute((((fg ^ 2) << 4) | fr) << 2, __builtin_bit_cast(int, s)));
    return s;
}
__device__ __forceinline__ void stage_post(CKP& p, int l, int bid, int nb) {
    const int tid = opaque_tid(), lane = tid & 63, head = __builtin_amdgcn_readfirstlane(tid >> 6), fr = lane & 15, fg = lane >> 4;
    const bf16* Ub = (const bf16*)(p.ws + WS_U);
    const bf16* gupt = (const bf16*)(p.ws + WS_GUPT) + ((size_t)l * 512 + head * 64) * 128;
    const bf16* YF = (const bf16*)(p.ws + WS_YF); const bf16* YB = (const bf16*)(p.ws + WS_YB);
    const float* BC0 = (const float*)(p.ws + WS_BC); const float* BC1 = BC0 + (size_t)MTOK * 8;
    bf16* MIX = (bf16*)(p.ws + WS_MIXED);
    bf16x8 ag[4][4];
    f32x4 lnw[4], lnb[4];
#pragma unroll
    for (int t = 0; t < 4; ++t) {
#pragma unroll
        for (int ks = 0; ks < 4; ++ks) ag[t][ks] = *(const bf16x8*)(gupt + (16 * t + fr) * 128 + ks * 32 + fg * 8);
        lnw[t] = *(const f32x4*)(p.in[I_LNW] + l * 512 + head * 64 + 16 * t + 4 * fg); lnb[t] = *(const f32x4*)(p.in[I_LNB] + l * 512 + head * 64 + 16 * t + 4 * fg); }
#pragma unroll 1
    for (int item = bid; item < 768; item += nb) {
        const size_t tok = (size_t)item * 16 + fr;
        bf16x8 bs[4];
#pragma unroll
        for (int ks = 0; ks < 4; ++ks) bs[ks] = *(const bf16x8*)(Ub + tok * 1920 + GD_OFF + ks * 32 + fg * 8);
        f32x4 y[4]; u32x2 vw[4];
#pragma unroll
        for (int t = 0; t < 4; ++t) { const int c = head * 64 + 16 * t + 4 * fg;
            const u32x2 yf = *(const u32x2*)(YF + tok * 512 + c), yb = *(const u32x2*)(YB + tok * 512 + c);
            y[t] = (f32x4){bflo(yf.x) + bflo(yb.x), bfhi(yf.x) + bfhi(yb.x), bflo(yf.y) + bflo(yb.y), bfhi(yf.y) + bfhi(yb.y)}; vw[t] = *(const u32x2*)(Ub + tok * 1920 + V_OFF + c); }
        const float bc = BC0[tok * 8 + head] + BC1[tok * 8 + head];
        f32x4 g[4];
#pragma unroll
        for (int t = 0; t < 4; ++t) { g[t] = (f32x4){0.f, 0.f, 0.f, 0.f};
#pragma unroll
            for (int ks = 0; ks < 4; ++ks) g[t] = MFMA16(ag[t][ks], bs[ks], g[t]); }
        float s = 0.f;
#pragma unroll
        for (int t = 0; t < 4; ++t) s += (y[t][0] + y[t][1]) + (y[t][2] + y[t][3]);
        const float mean = xsum_fg(s, fr, fg) * (1.0f / 64.0f);
        float q = 0.f;
#pragma unroll
        for (int t = 0; t < 4; ++t) { y[t] = y[t] - mean; q += (y[t][0] * y[t][0] + y[t][1] * y[t][1]) + (y[t][2] * y[t][2] + y[t][3] * y[t][3]); }
        const float rstd = frsq(xsum_fg(q, fr, fg) * (1.0f / 64.0f) + 64e-5f);
#pragma unroll
        for (int t = 0; t < 4; ++t) { const f32x4 vv = (f32x4){bflo(vw[t].x), bfhi(vw[t].x), bflo(vw[t].y), bfhi(vw[t].y)};
            const f32x4 o = (y[t] * rstd * lnw[t] + lnb[t] + vv * bc) * g[t];
            u32x2 w; w.x = cvt2(o[0], o[1]); w.y = cvt2(o[2], o[3]);
            *(u32x2*)(MIX + tok * DM + head * 64 + 16 * t + 4 * fg) = w; }
    }
}

#define XB_TMO      128
#define XB_XCNT(j)  (256  + 64 * (j))
#define XB_XSUB(j)  (1280 + 64 * (j))
#define XB_XGEN(j)  (2304 + 64 * (j))
#define XB_TOP      3328
#define XB_TOPGEN   3392
#define XCD_BAR_WORDS 3456
#define XB_SPIN_CAP (1u << 18)

__device__ __forceinline__ unsigned xb_ld(unsigned* p)              { return __hip_atomic_load(p, __ATOMIC_RELAXED, __HIP_MEMORY_SCOPE_AGENT); }
__device__ __forceinline__ unsigned xb_add(unsigned* p, unsigned v) { return __hip_atomic_fetch_add(p, v, __ATOMIC_RELAXED, __HIP_MEMORY_SCOPE_AGENT); }
__device__ __forceinline__ unsigned xb_xcc_id() { return (unsigned)__builtin_amdgcn_s_getreg((3 << 11) | 20) & 0xFu; }
#define XB_SPIN(cond, bar) do { unsigned _sp = 0; while (cond) { __builtin_amdgcn_s_sleep(1); \
    if ((++_sp & 255u) == 0u) { if (xb_ld(&(bar)[XB_TMO])) break; if (_sp > XB_SPIN_CAP) { atomicAdd(&(bar)[XB_TMO], 1u); break; } } } } while (0)

struct XcdBarrier {
    unsigned* bar; unsigned x;
    volatile LAS unsigned* st;
};

__device__ __forceinline__ XcdBarrier xcd_barrier_post(unsigned* bar, volatile LAS unsigned* st) {
    XcdBarrier b; b.bar = bar; b.x = xb_xcc_id(); b.st = st;
    if (threadIdx.x == 0) (void)xb_add(&bar[XB_XCNT(b.x)], 1u);
    return b;
}
__device__ __forceinline__ void xcd_barrier_complete(unsigned* bar, unsigned x, unsigned& nloc, unsigned& nx) {
    const unsigned G = gridDim.x * gridDim.y * gridDim.z;
    unsigned sum, cnt, mine, sp = 0u;
    for (;;) {
        sum = 0u; cnt = 0u; mine = 0u;
#pragma unroll
        for (unsigned j = 0; j < 16; ++j) { const unsigned c = xb_ld(&bar[XB_XCNT(j)]); sum += c; cnt += (c > 0u) ? 1u : 0u; mine = (j == x) ? c : mine; }
        if (sum == G) break;
        __builtin_amdgcn_s_sleep(1);
        if ((++sp & 255u) == 0u) { if (xb_ld(&bar[XB_TMO])) break; if (sp > XB_SPIN_CAP) { atomicAdd(&bar[XB_TMO], 1u); break; } }
    }
    nloc = mine > 0u ? mine : 1u; nx = cnt > 0u ? cnt : 1u;
}

__device__ __forceinline__ void xcd_barrier(const XcdBarrier& b) {
    asm volatile("s_waitcnt vmcnt(0)" ::: "memory");
    __syncthreads();
    if (threadIdx.x == 0) {
        unsigned* bar = b.bar;
        __builtin_amdgcn_s_waitcnt(0);
        unsigned nloc = b.st[0], nx = b.st[1];
        if (nloc == 0u) { xcd_barrier_complete(bar, b.x, nloc, nx); b.st[0] = nloc; b.st[1] = nx; }
        const unsigned old = xb_add(&bar[XB_XSUB(b.x)], 1u);
        const unsigned gen = old / nloc;
        if (old + 1u == (gen + 1u) * nloc) {
            __builtin_amdgcn_fence(__ATOMIC_RELEASE, "agent");
            asm volatile("s_waitcnt vmcnt(0)" ::: "memory");
            const unsigned og = xb_add(&bar[XB_TOP], 1u);
            const unsigned tg = og / nx;
            if (og + 1u == (tg + 1u) * nx) xb_add(&bar[XB_TOPGEN], 1u);
            else XB_SPIN(xb_ld(&bar[XB_TOPGEN]) == tg, bar);
            __builtin_amdgcn_fence(__ATOMIC_ACQUIRE, "agent");
            xb_add(&bar[XB_XGEN(b.x)], 1u);
            asm volatile("s_waitcnt vmcnt(0)" ::: "memory");
        } else {
            XB_SPIN(xb_ld(&bar[XB_XGEN(b.x)]) == gen, bar);
            __builtin_amdgcn_fence(__ATOMIC_ACQUIRE, "agent");
            asm volatile("s_waitcnt vmcnt(0)" ::: "memory");
        }
    }
    __syncthreads();
}

struct EpiAny {
    static constexpr bool AFTER_DRAIN = false;
    int mode; bool PERM; int l;
    __device__ __forceinline__ void operator()(const f32x4 (&acc)[2][2][4][2], const pg8::Unit& u, int wr, int wc, int fr, int fq) const {
        CKP* kp = (CKP*)__builtin_amdgcn_kernarg_segment_ptr(); asm volatile("" : "+s"(kp)); CKP& p = *kp;
        unsigned char* ws = p.ws;
        const float* mod = (const float*)(ws + WS_MOD) + (size_t)l * 5 * 6144;
        float* SSQ = (float*)(ws + WS_CTL + 262144);
        bf16* Hb = (bf16*)(ws + WS_H);
        if (mode == 7) {
#pragma unroll
            for (int a = 0; a < 2; ++a)
#pragma unroll
                for (int b = 0; b < 2; ++b)
#pragma unroll
                    for (int m = 0; m < 4; ++m)
#pragma unroll
                        for (int n = 0; n < 2; ++n) asm volatile("" :: "v"(acc[a][b][m][n]));
            return; }
        if (mode == 0) { const pg8::EpiBf<0> e{(bf16*)(ws + WS_PROJ), DINP}; e(acc, u, wr, wc, fr, fq); }
        else if (mode == 2) { const pg8::EpiRes e{p.out, mod + 5 * 1024, p.out, p.out + (size_t)NCTX * DM}; e(acc, u, wr, wc, fr, fq); }
        else if (mode == 3) { const pg8::EpiFnet e{(bf16*)(ws + WS_MIXED), 0, 256}; e(acc, u, wr, wc, fr, fq); }
        else if (mode == 8) { const pg8::EpiFnet e{(bf16*)(ws + WS_MIXED), NCTX, 1024}; e(acc, u, wr, wc, fr, fq); }
        else if (mode == 4) { const pg8::EpiNormBf<0> e{(bf16*)(ws + WS_PROJ), DINP, SSQ + 16384, (const float*)(ws + WS_SWIN), DINP}; e(acc, u, wr, wc, fr, fq); }
        else if (mode == 5) { const pg8::EpiNormBf<1> e{(bf16*)(ws + WS_FF), DFF, SSQ + l * 32768, (const float*)(ws + WS_SW1) + (size_t)l * 5 * DFF, DFF}; e(acc, u, wr, wc, fr, fq); }
        else if (mode == 6) { const pg8::EpiResNorm e{p.out, mod + 2 * 1024, l == 0 ? p.in[I_XP] : p.out, l == 0 ? p.in[I_XS] : p.out + (size_t)NCTX * DM, Hb, p.in[I_N2G] + l * DM, mod + 4 * 1024, SSQ + l * 32768}; e(acc, u, wr, wc, fr, fq); }
        else { const pg8::EpiResNorm e{p.out, mod + 5 * 1024, p.out, p.out + (size_t)NCTX * DM, Hb, p.in[I_N1G] + DM, mod + 5 * 6144 + 1 * 1024, SSQ + 16384}; e(acc, u, wr, wc, fr, fq); }
    }
};

constexpr int N_STEPS = 17;
__device__ __forceinline__ bool step_seam(int st) { return st < 16; }
__global__ void __launch_bounds__(NTHR, 2) mega_fwd(KP p_unused) {
    extern __shared__ __attribute__((aligned(16))) unsigned char lds_raw[];
    CKP* kp0 = (CKP*)__builtin_amdgcn_kernarg_segment_ptr();
    { LAS unsigned* ctlw = (LAS unsigned*)((LAS unsigned char*)lds_raw + RING_BYTES);
      for (int u = threadIdx.x; u < (LDS_BYTES - RING_BYTES) / 4; u += NTHR) ctlw[u] = 0u; }
    __syncthreads();
    const XcdBarrier bar = xcd_barrier_post((unsigned*)(kp0->ws + WS_CTL) + 4096, (volatile LAS unsigned*)((LAS unsigned char*)lds_raw + MISC_OFF + 32));
    const int ph_lo = kp0->ph_lo, ph_hi = kp0->ph_hi;
#pragma unroll 1
#ifdef REP_A
    for (int sti = ph_lo; sti < ph_hi + ((REP_B) >= 0 ? 2 : 1); ++sti) {
        const int st = sti <= (REP_A) ? sti : (((REP_B) < 0 || sti <= (REP_B) + 1) ? sti - 1 : sti - 2);
        const bool isdup = sti == (REP_A) || ((REP_B) >= 0 && sti == (REP_B) + 1); (void)isdup;
#else
    for (int st = ph_lo; st < ph_hi; ++st) {
#endif
        CKP* kp = kp0; asm volatile("" : "+s"(kp));
        CKP& p = *kp; unsigned char* ws = p.ws;
        int bid = blockIdx.x, nb = gridDim.x; unsigned ldsb = (unsigned)(size_t)(LAS unsigned char*)lds_raw;
        asm volatile("" : "+s"(bid), "+s"(nb), "+s"(ldsb));
        LAS unsigned char* lds = (LAS unsigned char*)(size_t)ldsb;
        const int l = st < 9 ? 0 : 1, s = st == 0 ? -1 : (st == 1 ? 0 : (st == 16 ? 8 : (st - 2) % 7 + 1));
        const float* mod = (const float*)(ws + WS_MOD) + (size_t)l * 5 * 6144;
        if (s == 3) {
            if (nb >= 256) { if (bid < 64) rwkv_item3(p, l, lds, bid); else for (int it = 64 + (bid - 64); it < 576; it += nb - 64) rwkv_item3(p, l, lds, it); }
            else for (int it = bid; it < 576; it += nb) rwkv_item3(p, l, lds, it);
        }
#pragma unroll 1
        for (int job = 0; job < 2; ++job) {
            pg8::Gemm g{nullptr, nullptr, 0, 0, 0, 0, 0}; EpiAny E{-1, true, 0}; int corder = bid;
            if (job == 0) {
                if (s == 1) { g = pg8::Gemm{(const bf16*)(ws + WS_H), (const bf16*)(ws + WS_WIN) + (size_t)l * DINP * DM, MTOK, DINP, DM, DM, DM}; E = EpiAny{l == 0 ? 0 : 4, true, l}; }
                else if (s == 3) { g = pg8::Gemm{(const bf16*)(ws + WS_CS256), (const bf16*)(ws + WS_YCS), 256, 8192, 512, 512, 512}; E = EpiAny{3, true, l}; corder = (bid + nb - (nb >= 256 ? 192 : 0)) % nb; }
                else if (s == 5) { g = pg8::Gemm{(const bf16*)(ws + WS_MIXED), (const bf16*)(ws + WS_WOUT) + (size_t)l * DM * DM, MTOK, DM, DM, DM, DM}; E = EpiAny{6, true, l}; }
                else if (s == 6) { g = pg8::Gemm{(const bf16*)(ws + WS_H), (const bf16*)(ws + WS_W1) + (size_t)l * DFF * DM, MTOK, DFF, DM, DM, DM}; E = EpiAny{5, true, l}; }
                else if (s == 7) { g = pg8::Gemm{(const bf16*)(ws + WS_FF), (const bf16*)(ws + WS_W2) + (size_t)l * DM * DFF, MTOK, DM, DFF, DFF, DFF}; E = l == 0 ? EpiAny{9, true, l} : EpiAny{2, false, l}; }
            } else if (s == 3) { g = pg8::Gemm{(const bf16*)(ws + WS_CS1024), (const bf16*)(ws + WS_YCS) + (size_t)8192 * 512, 1024, 1024, 2048, 2048, 2048}; E = EpiAny{8, true, l}; corder = (bid + nb - (nb >= 256 ? 224 : 32)) % nb; }
#ifdef NOEPI_FIRST
            if (isdup && E.mode >= 0) E.mode = 7;
#endif
            if (E.mode >= 0) {
                pg8::StaticOrder S; S.init(g.M, g.N, nb, corder);
                pg8::gemm_phase<EpiAny, pg8::StaticOrder, true, true>(lds, g, S, E);
                __syncthreads();
            }
        }
        if (s == 3) side_queue(p, l, lds);
        if (s == -1) stage_prologue(p, lds, bid, nb);
        else if (s == 0) { stage_norm(p, 0, 0, bid, nb); stage_tables(p, bid, nb); }
        else if (s == 2) {
            stage_upass(p, l, bid, nb);
#pragma unroll 1
            for (int it = bid; it < 768; it += nb) fnet1_item(p, l, it);
#pragma unroll 1
            for (int it = bid; it < 768; it += nb) pool_item(p, l, lds, it);
        }
        else if (s == 4) stage_post(p, l, bid, nb);
        else if (s == 8) stage_final(p, bid, nb);
        #ifdef REP_A
        if (sti + 1 < ph_hi + ((REP_B) >= 0 ? 2 : 1)) xcd_barrier(bar);
#else
        if (st + 1 < ph_hi && step_seam(st)) xcd_barrier(bar);
#endif
    }
}

extern "C" void kernel_launch(void* const* d_in, const int* in_sizes, int n_in, void* d_out, int out_size, void* d_ws, size_t ws_size, hipStream_t stream) {
    static int grid = 0;
    if (grid == 0) {
        if (n_in != N_IN || ws_size < WS_END) { fprintf(stderr, "kernel_launch: unexpected inputs (n_in %d, ws %zu)\n", n_in, ws_size); grid = -1; return; }
        int dev = 0, cus = 0, per_cu = 0;
        (void)hipGetDevice(&dev); (void)hipDeviceGetAttribute(&cus, hipDeviceAttributeMultiprocessorCount, dev);
        (void)hipFuncSetAttribute((const void*)mega_fwd, hipFuncAttributeMaxDynamicSharedMemorySize, LDS_BYTES);
        if (hipOccupancyMaxActiveBlocksPerMultiprocessor(&per_cu, (const void*)mega_fwd, NTHR, LDS_BYTES) != hipSuccess || per_cu < 1) {
            fprintf(stderr, "kernel_launch: occupancy query reports %d blocks/CU\n", per_cu); (void)hipGetLastError(); grid = -1; return; }
        grid = cus * 1;
    }
    if (grid < 0) return;
    KP a{};
    for (int i = 0; i < N_IN; ++i) a.in[i] = (const float*)d_in[i];
    a.out = (float*)d_out; a.ws = (unsigned char*)d_ws; a.ph_lo = 0; a.ph_hi = N_STEPS;
    if (hipMemsetAsync((char*)d_ws + WS_CTL, 0, 1 * MiB, stream) != hipSuccess) { fprintf(stderr, "kernel_launch: memset failed\n"); return; }
    void* args[] = {&a};
    hipError_t e = hipLaunchCooperativeKernel((const void*)mega_fwd, dim3(grid), dim3(NTHR), args, LDS_BYTES, stream);
    if (e != hipSuccess) fprintf(stderr, "cooperative launch failed: %s (grid %d)\n", hipGetErrorString(e), grid);
}
```

```cpp
#include <hip/hip_runtime.h>
#include <hip/hip_cooperative_groups.h>
#include <cstdio>
#include <cstdint>
namespace cg = cooperative_groups;
__device__ __forceinline__ int opaque_tid() { int t = threadIdx.x; asm volatile("" : "+v"(t)); return t; }
namespace pg8 {
#define PG8_LAS __attribute__((address_space(3)))
typedef unsigned short bf16_t;
typedef short bf16x8 __attribute__((ext_vector_type(8)));
typedef float f32x4 __attribute__((ext_vector_type(4)));
typedef unsigned u32x4 __attribute__((ext_vector_type(4)));
constexpr int BM = 256, BK = 64, HALF = 128, HTB = HALF * BK * 2  , STAGE_BYTES = 8 * HTB, NXCD = 8, WGM = 8;

__host__ __device__ __forceinline__ int lds_byte(int r, int c) { const int st = (r >> 4) * 2 + (c >> 5), rr = r & 15, cc = c & 31, ob = rr * 64 + cc * 2; return st * 1024 + (ob ^ (((ob >> 9) & 1) << 5)); }
__host__ __device__ __forceinline__ void stage_rc(int b, int& R, int& C) { const int st = b / 1024, sb = b % 1024, swz = sb ^ (((sb >> 9) & 1) << 5); R = (st >> 1) * 16 + swz / 64; C = (st & 1) * 32 + (swz % 64) / 2; }
__host__ __device__ __forceinline__ int perm32(int rho) { const int n = rho >> 4, i = rho & 15; return 8 * (i >> 2) + 4 * n + (i & 3); }

struct Unit { int pm, pn; };
struct Gemm { const bf16_t* A; const bf16_t* Bt; int M, N, K, lda, ldb; };

struct StaticOrder {
    int nM, nN, nwg, G, c;
    __host__ __device__ void init(int M, int N, int G_, int c_) { nM = M / BM; nN = N / BM; nwg = nM * nN; G = G_; c = c_; }
    __host__ __device__ bool next(int i, Unit& u) const {
        const long L = (long)i * G + c; if (L >= nwg) return false;
        int wgid = (int)L; { const int q = nwg / NXCD, r = nwg % NXCD, xcd = wgid % NXCD, off = wgid / NXCD; wgid = (xcd < r ? xcd * (q + 1) : r * (q + 1) + (xcd - r) * q) + off; }
        const int nig = WGM * nN, gid = wgid / nig, fm = gid * WGM, gsz = (nM - fm) < WGM ? (nM - fm) : WGM;
        u.pm = fm + ((wgid % nig) % gsz); u.pn = (wgid % nig) / gsz; return true;
    }
    __device__ __forceinline__ void a_ready(const Unit&) const {}
    __device__ __forceinline__ void done(const Unit&) const {}
};

__device__ __forceinline__ unsigned cvt_pk_bf16(float lo, float hi) { unsigned r; asm volatile("v_cvt_pk_bf16_f32 %0, %1, %2" : "=v"(r) : "v"(lo), "v"(hi)); return r; }
typedef unsigned u32x2 __attribute__((ext_vector_type(2)));
template <int ACT  > struct EpiBf {
    static constexpr bool PERM = true, AFTER_DRAIN = false;
    bf16_t* O; int ldc;
    __device__ __forceinline__ void operator()(const f32x4 (&acc)[2][2][4][2], const Unit& u, int wr, int wc, int fr, int fq) const {
        const int row0 = u.pm * BM + wr * 64 + fr, col0 = u.pn * BM + wc * 32 + 8 * fq;
#pragma unroll
        for (int ai = 0; ai < 2; ++ai)
#pragma unroll
            for (int m = 0; m < 4; ++m) { bf16_t* rowp = O + (size_t)(row0 + ai * HALF + m * 16) * ldc + col0;
#pragma unroll
                for (int bj = 0; bj < 2; ++bj) { f32x4 v0 = acc[ai][bj][m][0], v1 = acc[ai][bj][m][1];
                    if (ACT == 1) {
#pragma unroll
                        for (int e = 0; e < 4; ++e) { float a = v0[e] > 0.f ? v0[e] : 0.f; v0[e] = a * a; float b = v1[e] > 0.f ? v1[e] : 0.f; v1[e] = b * b; } }
                    u32x4 w; w.x = cvt_pk_bf16(v0[0], v0[1]); w.y = cvt_pk_bf16(v0[2], v0[3]); w.z = cvt_pk_bf16(v1[0], v1[1]); w.w = cvt_pk_bf16(v1[2], v1[3]);
                    *(u32x4*)(rowp + bj * HALF) = w; } }
    }
};
struct EpiRes {
    static constexpr bool PERM = false, AFTER_DRAIN = false;
    float* X; const float* gate; const float* Xc; const float* Xl;
    __device__ __forceinline__ void operator()(const f32x4 (&acc)[2][2][4][2], const Unit& u, int wr, int wc, int fr, int fq) const {
        const int row0 = u.pm * BM + wr * 64 + fr, col0 = u.pn * BM + wc * 32 + 4 * fq;
        const int cond = u.pm < 32 ? 0 : 1 + ((u.pm - 32) >> 2);
        const float* gp = gate + cond * 6144 + col0;
        f32x4 gv[2][2];
#pragma unroll
        for (int bj = 0; bj < 2; ++bj)
#pragma unroll
            for (int n = 0; n < 2; ++n) gv[bj][n] = *(const f32x4*)(gp + bj * HALF + n * 16);
#pragma unroll
        for (int ai = 0; ai < 2; ++ai)
#pragma unroll
            for (int m = 0; m < 4; ++m) { const size_t ro = (size_t)(row0 + ai * HALF + m * 16) * 1024 + col0; float* rowp = X + ro; const float* srcp = u.pm < 32 ? Xc + ro : Xl + (ro - (size_t)8192 * 1024);
#pragma unroll
                for (int bj = 0; bj < 2; ++bj)
#pragma unroll
                    for (int n = 0; n < 2; ++n) { *(f32x4*)(rowp + bj * HALF + n * 16) = *(const f32x4*)(srcp + bj * HALF + n * 16) + gv[bj][n] * acc[ai][bj][m][n]; }
                if (m & 1) asm volatile("" ::: "memory"); }
    }
};
struct EpiFnet {
    static constexpr bool PERM = true, AFTER_DRAIN = false;
    bf16_t* MIX; int rowbase, L;
    __device__ __forceinline__ void operator()(const f32x4 (&acc)[2][2][4][2], const Unit& u, int wr, int wc, int fr, int fq) const {
        const int row0 = u.pm * BM + wr * 64 + fr, colw = wc * 32 + 8 * fq;
        bf16_t* base = MIX + (size_t)(rowbase + u.pn * L) * 1024 + 512 + colw;
#pragma unroll
        for (int ai = 0; ai < 2; ++ai)
#pragma unroll
            for (int m = 0; m < 4; ++m) { bf16_t* rowp = base + (size_t)(row0 + ai * HALF + m * 16) * 1024;
#pragma unroll
                for (int bj = 0; bj < 2; ++bj) { const f32x4 v0 = acc[ai][bj][m][0], v1 = acc[ai][bj][m][1];
                    u32x4 w; w.x = cvt_pk_bf16(v0[0], v0[1]); w.y = cvt_pk_bf16(v0[2], v0[3]); w.z = cvt_pk_bf16(v1[0], v1[1]); w.w = cvt_pk_bf16(v1[2], v1[3]);
                    *(u32x4*)(rowp + bj * HALF) = w; } }
    }
};

__device__ __forceinline__ float xsum_fq(float s, int fr, int fq) {
    s += __builtin_bit_cast(float, __builtin_amdgcn_ds_bpermute((((fq ^ 1) << 4) | fr) << 2, __builtin_bit_cast(int, s)));
    s += __builtin_bit_cast(float, __builtin_amdgcn_ds_bpermute((((fq ^ 2) << 4) | fr) << 2, __builtin_bit_cast(int, s)));
    return s;
}
template <int ACT> struct EpiNormBf {
    static constexpr bool PERM = true, AFTER_DRAIN = false;
    bf16_t* O; int ldc; const float* ssq; const float* sw; int swld;
    __device__ __forceinline__ void operator()(const f32x4 (&acc)[2][2][4][2], const Unit& u, int wr, int wc, int fr, int fq) const {
        const int row0 = u.pm * BM + wr * 64 + fr, col0 = u.pn * BM + wc * 32 + 8 * fq;
        const int cond = u.pm < 32 ? 0 : 1 + ((u.pm - 32) >> 2);
        f32x4 sv[2][2];
#pragma unroll
        for (int bj = 0; bj < 2; ++bj)
#pragma unroll
            for (int n = 0; n < 2; ++n) sv[bj][n] = *(const f32x4*)(sw + (size_t)cond * swld + col0 + bj * HALF + 4 * n);
        float rs[2][4];
#pragma unroll
        for (int ai = 0; ai < 2; ++ai)
#pragma unroll
            for (int m = 0; m < 4; ++m) rs[ai][m] = ssq[row0 + ai * HALF + m * 16];
#pragma unroll
        for (int ai = 0; ai < 2; ++ai)
#pragma unroll
            for (int m = 0; m < 4; ++m) rs[ai][m] = __builtin_amdgcn_rsqf(rs[ai][m] * (1.0f / 1024.0f) + 1e-6f);
#pragma unroll
        for (int ai = 0; ai < 2; ++ai)
#pragma unroll
            for (int m = 0; m < 4; ++m) { const int row = row0 + ai * HALF + m * 16; bf16_t* rowp = O + (size_t)row * ldc + col0;
                const float rstd = rs[ai][m];
#pragma unroll
                for (int bj = 0; bj < 2; ++bj) { f32x4 v0 = acc[ai][bj][m][0] * rstd + sv[bj][0], v1 = acc[ai][bj][m][1] * rstd + sv[bj][1];
                    if (ACT == 1) {
#pragma unroll
                        for (int e = 0; e < 4; ++e) { float a = v0[e] > 0.f ? v0[e] : 0.f; v0[e] = a * a; float b = v1[e] > 0.f ? v1[e] : 0.f; v1[e] = b * b; } }
                    u32x4 w; w.x = cvt_pk_bf16(v0[0], v0[1]); w.y = cvt_pk_bf16(v0[2], v0[3]); w.z = cvt_pk_bf16(v1[0], v1[1]); w.w = cvt_pk_bf16(v1[2], v1[3]);
                    *(u32x4*)(rowp + bj * HALF) = w; }
                if (m & 1) asm volatile("" ::: "memory"); }
    }
};
struct EpiResNorm {
    static constexpr bool PERM = true, AFTER_DRAIN = false;
    float* X; const float* gate; const float* Xc; const float* Xl; bf16_t* H; const float* gn; const float* scl; float* ssq;
    __device__ __forceinline__ void operator()(const f32x4 (&acc)[2][2][4][2], const Unit& u, int wr, int wc, int fr, int fq) const {
        const int row0 = u.pm * BM + wr * 64 + fr, col0 = u.pn * BM + wc * 32 + 8 * fq;
        const int cond = u.pm < 32 ? 0 : 1 + ((u.pm - 32) >> 2);
        const float* src = u.pm < 32 ? Xc : Xl - (size_t)8192 * 1024;
        f32x4 gt[2][2], gs[2][2];
#pragma unroll
        for (int bj = 0; bj < 2; ++bj)
#pragma unroll
            for (int n = 0; n < 2; ++n) { const int col = col0 + bj * HALF + n * 4;
                gt[bj][n] = *(const f32x4*)(gate + cond * 6144 + col); gs[bj][n] = *(const f32x4*)(gn + col) * (*(const f32x4*)(scl + cond * 6144 + col) + 1.0f); }
#pragma unroll
        for (int ai = 0; ai < 2; ++ai)
#pragma unroll
            for (int m = 0; m < 4; ++m) { const int row = row0 + ai * HALF + m * 16; const unsigned ro = (unsigned)row * 1024u + (unsigned)col0;
                float sq = 0.f;
#pragma unroll
                for (int bj = 0; bj < 2; ++bj) { const unsigned o = ro + bj * HALF;
                    const f32x4 x0 = *(const f32x4*)(src + o) + gt[bj][0] * acc[ai][bj][m][0], x1 = *(const f32x4*)(src + o + 4) + gt[bj][1] * acc[ai][bj][m][1];
                    *(f32x4*)(X + o) = x0; *(f32x4*)(X + o + 4) = x1;
                    sq += ((x0[0] * x0[0] + x0[1] * x0[1]) + (x0[2] * x0[2] + x0[3] * x0[3])) + ((x1[0] * x1[0] + x1[1] * x1[1]) + (x1[2] * x1[2] + x1[3] * x1[3]));
                    const f32x4 h0 = x0 * gs[bj][0], h1 = x1 * gs[bj][1];
                    u32x4 w; w.x = cvt_pk_bf16(h0[0], h0[1]); w.y = cvt_pk_bf16(h0[2], h0[3]); w.z = cvt_pk_bf16(h1[0], h1[1]); w.w = cvt_pk_bf16(h1[2], h1[3]);
                    *(u32x4*)(H + o) = w; }
                const float t = xsum_fq(sq, fr, fq); if (fq == 0) atomicAdd(ssq + row, t);
                asm volatile("" ::: "memory"); }
    }
};
template <class Epi, class Sched, bool ALIGN_EPI = false, bool SP2 = false>
__device__ __forceinline__ void gemm_phase(PG8_LAS unsigned char* lds, const Gemm g, const Sched& S, const Epi& E) {
    const int tid = opaque_tid(), wid = __builtin_amdgcn_readfirstlane(tid >> 6), lane = tid & 63, wr = wid >> 2, wc = wid & 3, fr = lane & 15, fq = lane >> 4;
    const int K = g.K, nt = K / BK;
    unsigned voffA[2], voffB[2];
#pragma unroll
    for (int i = 0; i < 2; ++i) { int R, C; stage_rc(tid * 16 + i * 8192, R, C); const int Rb = E.PERM ? ((R & ~31) + perm32(R & 31)) : R;
        voffA[i] = (unsigned)(R * g.lda + C) * 2u; voffB[i] = (unsigned)(Rb * g.ldb + C) * 2u; }
    const size_t kstep = (size_t)(BK * 2);
    const size_t hstepA = (size_t)HALF * g.lda * 2, hstepB = (size_t)HALF * g.ldb * 2;
    const size_t tstepA = 2 * hstepA, tstepB = 2 * hstepB;
    const unsigned ldsw = (unsigned)wid * 1024u;
    const int aoff = lds_byte(wr * 64 + fr, fq * 8), boff = lds_byte(wc * 32 + fr, fq * 8);
#define PG8_SA(b, h) (((b) * 2 + (h)) * HTB)
#define PG8_SB(b, h) ((4 + (b) * 2 + (h)) * HTB)
#define PG8_STAGE(bufoff, gbase, voff) do { _Pragma("unroll") for (int _i = 0; _i < 2; ++_i) \
        __builtin_amdgcn_global_load_lds((const unsigned*)((const char*)(gbase) + (voff)[_i]), (PG8_LAS unsigned*)(lds + (bufoff) + ldsw + _i * 8192), 16, 0, 0); } while (0)
#define PG8_LDA(dst, b, h) do { _Pragma("unroll") for (int m = 0; m < 4; ++m) _Pragma("unroll") for (int k = 0; k < 2; ++k) dst[m][k] = *(const PG8_LAS bf16x8*)(lds + PG8_SA(b, h) + aoff + m * 2048 + k * 1024); } while (0)
#define PG8_LDB(dst, b, h) do { _Pragma("unroll") for (int n = 0; n < 2; ++n) _Pragma("unroll") for (int k = 0; k < 2; ++k) dst[n][k] = *(const PG8_LAS bf16x8*)(lds + PG8_SB(b, h) + boff + n * 2048 + k * 1024); } while (0)
#define PG8_MMA(ai, bj, At, Bt) do { __builtin_amdgcn_s_setprio(1); _Pragma("unroll") for (int m = 0; m < 4; ++m) _Pragma("unroll") for (int n = 0; n < 2; ++n) _Pragma("unroll") for (int k = 0; k < 2; ++k) \
        acc[ai][bj][m][n] = __builtin_amdgcn_mfma_f32_16x16x32_bf16(Bt[n][k], At[m][k], acc[ai][bj][m][n], 0, 0, 0); __builtin_amdgcn_s_setprio(0); } while (0)
#define PG8_WAIT_V(n) asm volatile("s_waitcnt vmcnt(" #n ")" ::: "memory")
#define PG8_WAIT_L(n) asm volatile("s_waitcnt lgkmcnt(" #n ")" ::: "memory")
#define PG8_BAR __builtin_amdgcn_s_barrier()
#define PG8_SCHED __builtin_amdgcn_sched_barrier(0)
    Unit cur, nxt; int ui = 0;
    if (!S.next(0, cur)) return;
    f32x4 acc[2][2][4][2];
#pragma unroll
    for (int a = 0; a < 2; ++a)
#pragma unroll
        for (int b = 0; b < 2; ++b)
#pragma unroll
            for (int m = 0; m < 4; ++m)
#pragma unroll
                for (int n = 0; n < 2; ++n) acc[a][b][m][n] = (f32x4){0.f, 0.f, 0.f, 0.f};
    bf16x8 At[4][2], B0[2][2], B1[2][2];
    const char* cA = (const char*)g.A + (size_t)cur.pm * tstepA; const char* cB = (const char*)g.Bt + (size_t)cur.pn * tstepB;
    S.a_ready(cur);
    if constexpr (SP2) {
        PG8_STAGE(PG8_SB(0, 0), cB, voffB); PG8_STAGE(PG8_SB(0, 1), cB + hstepB, voffB); PG8_STAGE(PG8_SA(0, 0), cA, voffA); PG8_STAGE(PG8_SA(0, 1), cA + hstepA, voffA);
        if (wr == 1) PG8_BAR;
        PG8_WAIT_V(2); PG8_BAR;
        PG8_STAGE(PG8_SB(1, 0), cB + kstep, voffB); PG8_STAGE(PG8_SA(1, 0), cA + kstep, voffA); PG8_STAGE(PG8_SB(1, 1), cB + hstepB + kstep, voffB);
        PG8_WAIT_V(6); PG8_BAR;
    } else {
        PG8_STAGE(PG8_SB(0, 0), cB, voffB); PG8_STAGE(PG8_SA(0, 0), cA, voffA); PG8_STAGE(PG8_SB(0, 1), cB + hstepB, voffB); PG8_STAGE(PG8_SA(0, 1), cA + hstepA, voffA);
        if (wr == 1) PG8_BAR;
        PG8_WAIT_V(4); PG8_BAR;
        PG8_STAGE(PG8_SB(1, 0), cB + kstep, voffB); PG8_STAGE(PG8_SA(1, 0), cA + kstep, voffA); PG8_STAGE(PG8_SB(1, 1), cB + hstepB + kstep, voffB);
        PG8_WAIT_V(6); PG8_BAR;
    }
    for (;;) {
        const bool has_next = S.next(ui + 1, nxt);
        const char* nA = has_next ? (const char*)g.A + (size_t)nxt.pm * tstepA : cA; const char* nB = has_next ? (const char*)g.Bt + (size_t)nxt.pn * tstepB : cB;
        for (int t = 0; t < nt; t += 2) {
            const bool last = (t == nt - 2);
            const char* a1 = cA + (size_t)(t + 1) * kstep;
            const char* a2 = last ? nA : cA + (size_t)(t + 2) * kstep; const char* b2 = last ? nB : cB + (size_t)(t + 2) * kstep;
            const char* a3 = a2 + kstep; const char* b3 = b2 + kstep;
            if (last && has_next) S.a_ready(nxt);
            if constexpr (SP2) {
            PG8_LDB(B0, 0, 0); PG8_LDB(B1, 0, 1); PG8_SCHED; PG8_LDA(At, 0, 0); PG8_STAGE(PG8_SA(1, 1), a1 + hstepA, voffA);
            PG8_WAIT_V(8); PG8_WAIT_L(0); PG8_BAR; PG8_MMA(0, 0, At, B0); PG8_MMA(0, 1, At, B1); PG8_BAR; PG8_SCHED;
            PG8_LDA(At, 0, 1); PG8_STAGE(PG8_SB(0, 0), b2, voffB); PG8_STAGE(PG8_SB(0, 1), b2 + hstepB, voffB); PG8_STAGE(PG8_SA(0, 0), a2, voffA);
            PG8_WAIT_V(8); PG8_WAIT_L(0); PG8_BAR; PG8_MMA(1, 0, At, B0); PG8_MMA(1, 1, At, B1); PG8_BAR; PG8_SCHED;
            PG8_LDB(B0, 1, 0); PG8_LDB(B1, 1, 1); PG8_SCHED; PG8_LDA(At, 1, 0); PG8_STAGE(PG8_SA(0, 1), a2 + hstepA, voffA);
            PG8_WAIT_V(8); PG8_WAIT_L(0); PG8_BAR; PG8_MMA(0, 0, At, B0); PG8_MMA(0, 1, At, B1); PG8_BAR; PG8_SCHED;
            PG8_LDA(At, 1, 1); PG8_STAGE(PG8_SB(1, 0), b3, voffB); PG8_STAGE(PG8_SB(1, 1), b3 + hstepB, voffB); PG8_STAGE(PG8_SA(1, 0), a3, voffA);
            PG8_WAIT_V(8); PG8_WAIT_L(0); PG8_BAR; PG8_MMA(1, 0, At, B0); PG8_MMA(1, 1, At, B1); PG8_BAR; PG8_SCHED;
            } else {
            PG8_LDB(B0, 0, 0); PG8_SCHED; PG8_LDA(At, 0, 0); PG8_STAGE(PG8_SA(1, 1), a1 + hstepA, voffA);
            PG8_WAIT_L(8); PG8_BAR; PG8_WAIT_L(0); PG8_MMA(0, 0, At, B0); PG8_BAR; PG8_SCHED;
            PG8_LDB(B1, 0, 1); PG8_STAGE(PG8_SB(0, 0), b2, voffB);
            PG8_BAR; PG8_WAIT_L(0); PG8_MMA(0, 1, At, B1); PG8_BAR;
            PG8_LDA(At, 0, 1); PG8_STAGE(PG8_SA(0, 0), a2, voffA);
            PG8_BAR; PG8_WAIT_L(0); PG8_MMA(1, 0, At, B0); PG8_BAR; PG8_SCHED;
            PG8_STAGE(PG8_SB(0, 1), b2 + hstepB, voffB);
            PG8_WAIT_V(6); PG8_BAR; PG8_MMA(1, 1, At, B1); PG8_BAR;
            PG8_LDB(B0, 1, 0); PG8_SCHED; PG8_LDA(At, 1, 0); PG8_STAGE(PG8_SA(0, 1), a2 + hstepA, voffA);
            PG8_WAIT_L(8); PG8_BAR; PG8_WAIT_L(0); PG8_MMA(0, 0, At, B0); PG8_BAR; PG8_SCHED;
            PG8_LDB(B1, 1, 1); PG8_STAGE(PG8_SB(1, 0), b3, voffB);
            PG8_BAR; PG8_WAIT_L(0); PG8_MMA(0, 1, At, B1); PG8_BAR;
            PG8_LDA(At, 1, 1); PG8_STAGE(PG8_SA(1, 0), a3, voffA);
            PG8_BAR; PG8_WAIT_L(0); PG8_MMA(1, 0, At, B0); PG8_BAR; PG8_SCHED;
            PG8_STAGE(PG8_SB(1, 1), b3 + hstepB, voffB);
            PG8_WAIT_V(6); PG8_BAR; PG8_MMA(1, 1, At, B1); PG8_BAR;
            }
        }
        if constexpr (ALIGN_EPI) { if (wr == 0) PG8_BAR; }
        if constexpr (!Epi::AFTER_DRAIN) { int fr2 = fr, fq2 = fq; asm volatile("" : "+v"(fr2), "+v"(fq2)); E(acc, cur, wr, wc, fr2, fq2); S.done(cur); }
        if (!has_next) break;
#pragma unroll
        for (int a = 0; a < 2; ++a)
#pragma unroll
            for (int b = 0; b < 2; ++b)
#pragma unroll
                for (int m = 0; m < 4; ++m)
#pragma unroll
                    for (int n = 0; n < 2; ++n) acc[a][b][m][n] = (f32x4){0.f, 0.f, 0.f, 0.f};
        cur = nxt; cA = nA; cB = nB; ++ui;
        if constexpr (ALIGN_EPI) { if (wr == 1) PG8_BAR; }
    }
    PG8_WAIT_V(0);
    if constexpr (!ALIGN_EPI) { if (wr == 0) PG8_BAR; }
    PG8_BAR;
    if constexpr (Epi::AFTER_DRAIN) { E.fused(acc, cur, wr, wc, fr, fq, lds, wid, lane); S.done(cur); }
#undef PG8_SA
#undef PG8_SB
#undef PG8_STAGE
#undef PG8_LDA
#undef PG8_LDB
#undef PG8_MMA
#undef PG8_WAIT_V
#undef PG8_WAIT_L
#undef PG8_BAR
#undef PG8_SCHED
}
}

#define LAS __attribute__((address_space(3)))
typedef unsigned short bf16;
typedef float f32x4 __attribute__((ext_vector_type(4)));
typedef unsigned u32x4 __attribute__((ext_vector_type(4)));
typedef unsigned u32x2 __attribute__((ext_vector_type(2)));
constexpr int DM = 1024, NCTX = 8192, MTOK = 12288, DINP = 2560, DFF = 4096;
constexpr int R_OFF = 0, K_OFF = 512, V_OFF = 1024, WD_OFF = 1536, AD_OFF = 1664, GD_OFF = 1792, F_OFF = 1920, P_OFF = 2176, DIN = 2432;
constexpr size_t MiB = 1u << 20;
constexpr size_t WS_CTL = 0, WS_MOD = 1 * MiB, WS_FW = 1 * MiB + 512 * 1024, WS_BC = 2 * MiB, WS_CS256 = 3 * MiB, WS_CS1024 = 4 * MiB, WS_WIN = 8 * MiB, WS_WOUT = 18 * MiB,
                 WS_W1 = 22 * MiB, WS_W2 = 38 * MiB, WS_H = 54 * MiB, WS_MIXED = 78 * MiB, WS_PROJ = 102 * MiB, WS_YCS = 162 * MiB, WS_YF = 102 * MiB, WS_YB = 126 * MiB  , WS_U = 174 * MiB, WS_KINV = 220 * MiB, WS_GUPT = 221 * MiB,
                 WS_FF = 102 * MiB, WS_WUPT = 222 * MiB, WS_AUPT = 222 * MiB + 256 * 1024, WS_SSQ = 223 * MiB, WS_WPT = 223 * MiB + 512 * 1024, WS_SW1 = 224 * MiB, WS_SWIN = 224 * MiB + 256 * 1024, WS_END = 225 * MiB;
constexpr int LDS_BYTES = 147456, RING_BYTES = 131072, MISC_OFF = RING_BYTES + 320;
constexpr int NTHR = 512;
enum { I_XP = 0, I_XS, I_STATE, I_C, I_CCTX, I_WADA, I_BADA, I_N1G, I_WIN, I_MU, I_W0, I_WUP, I_A0, I_AUP, I_GUP, I_KK, I_KA, I_RK, I_LNW, I_LNB, I_WFNET, I_WPOOL, I_PSCALE, I_WOUT, I_N2G, I_WFF1, I_WFF2, I_FNG, N_IN };
struct KP { const float* in[N_IN]; float* out; unsigned char* ws; int ph_lo, ph_hi; };
typedef const __attribute__((address_space(4))) KP CKP;

__device__ __forceinline__ unsigned f2bf(float f) { unsigned u = __builtin_bit_cast(unsigned, f); return (u + 0x7fffu + ((u >> 16) & 1u)) >> 16; }
__device__ __forceinline__ unsigned pk2(float lo, float hi) { return f2bf(lo) | (f2bf(hi) << 16); }
__device__ __forceinline__ float bflo(unsigned w) { return __builtin_bit_cast(float, w << 16); }
__device__ __forceinline__ float bfhi(unsigned w) { return __builtin_bit_cast(float, w & 0xffff0000u); }
__device__ __forceinline__ float bf1(bf16 h) { return __builtin_bit_cast(float, (unsigned)h << 16); }
__device__ __forceinline__ float fexp(float x) { return __builtin_amdgcn_exp2f(x * 1.4426950408889634f); }
__device__ __forceinline__ float flog(float x) { return __builtin_amdgcn_logf(x) * 0.6931471805599453f; }
__device__ __forceinline__ float frcp(float x) { return __builtin_amdgcn_rcpf(x); }
__device__ __forceinline__ float frsq(float x) { return __builtin_amdgcn_rsqf(x); }
__device__ __forceinline__ float fsigmoid(float x) { return frcp(1.0f + fexp(-x)); }
template <int CTRL> __device__ __forceinline__ float dppf(float x) { return __builtin_bit_cast(float, __builtin_amdgcn_update_dpp(0, __builtin_bit_cast(int, x), CTRL, 0xF, 0xF, true)); }
__device__ __forceinline__ float red8(float x)  { x += dppf<0xB1>(x); x += dppf<0x4E>(x); x += dppf<0x141>(x); return x; }
__device__ __forceinline__ float red16(float x) { x += dppf<0xB1>(x); x += dppf<0x4E>(x); x += dppf<0x141>(x); x += dppf<0x140>(x); return x; }
__device__ __forceinline__ float wave_sum(float v) {
    v = red16(v);
    const float s0 = __builtin_bit_cast(float, __builtin_amdgcn_readlane(__builtin_bit_cast(int, v), 0)), s1 = __builtin_bit_cast(float, __builtin_amdgcn_readlane(__builtin_bit_cast(int, v), 16));
    const float s2 = __builtin_bit_cast(float, __builtin_amdgcn_readlane(__builtin_bit_cast(int, v), 32)), s3 = __builtin_bit_cast(float, __builtin_amdgcn_readlane(__builtin_bit_cast(int, v), 48));
    return (s0 + s1) + (s2 + s3);
}
__device__ __forceinline__ void load4bf(const bf16* p, float (&o)[4]) { const u32x2 w = *(const u32x2*)p; o[0] = bflo(w.x); o[1] = bfhi(w.x); o[2] = bflo(w.y); o[3] = bfhi(w.y); }
__device__ __forceinline__ void load8bf(const bf16* p, float (&o)[8]) { const u32x4 w = *(const u32x4*)p; o[0] = bflo(w.x); o[1] = bfhi(w.x); o[2] = bflo(w.y); o[3] = bfhi(w.y); o[4] = bflo(w.z); o[5] = bfhi(w.z); o[6] = bflo(w.w); o[7] = bfhi(w.w); }
__device__ __forceinline__ void shift4(const bf16* proj, int row, bool hasp, bool hasn, int col, const float* mu, float (&u)[4]) {
    float p[4], a[4] = {0.f, 0.f, 0.f, 0.f}, b[4] = {0.f, 0.f, 0.f, 0.f};
    load4bf(proj + (size_t)row * DINP + col, p);
    if (hasp) load4bf(proj + (size_t)(row - 1) * DINP + col, a);
    if (hasn) load4bf(proj + (size_t)(row + 1) * DINP + col, b);
    const f32x4 m = *(const f32x4*)(mu + col);
#pragma unroll
    for (int j = 0; j < 4; ++j) u[j] = p[j] + m[j] * (0.5f * (a[j] + b[j]) - p[j]);
}

__device__ __forceinline__ void transpose_item(const float* W, int K, int N, bf16* WT, LAS float* scr, int item, int lane) {
    const int nblk = N / 32, kb = item / nblk, nb = item % nblk, k0 = 64 * kb, n0 = 32 * nb;
#pragma unroll 8
    for (int i = 0; i < 32; ++i) { const int kk = 2 * i + (lane >> 5); scr[kk * 33 + (lane & 31)] = W[(size_t)(k0 + kk) * N + n0 + (lane & 31)]; }
    asm volatile("s_waitcnt lgkmcnt(0)" ::: "memory");
    const int c = lane & 7;
#pragma unroll
    for (int j = 0; j < 4; ++j) { const int n = (lane >> 3) + 8 * j; const LAS float* s = scr + (8 * c) * 33 + n;
        u32x4 o; o.x = pk2(s[0 * 33], s[1 * 33]); o.y = pk2(s[2 * 33], s[3 * 33]); o.z = pk2(s[4 * 33], s[5 * 33]); o.w = pk2(s[6 * 33], s[7 * 33]);
        *(u32x4*)(WT + (size_t)(n0 + n) * K + k0 + 8 * c) = o; }
    asm volatile("s_waitcnt lgkmcnt(0)" ::: "memory");
}
__device__ __forceinline__ void gemv5_cols(LAS float* sc, LAS float* red, const float* W, int ldw, int colw, const float* bias, float* out, int ldo, int colo, int tid) {
    const int cgi = tid & 15, kg = tid >> 4;
    f32x4 acc[5];
#pragma unroll
    for (int c = 0; c < 5; ++c) acc[c] = (f32x4){0.f, 0.f, 0.f, 0.f};
    const float* wp = W + (size_t)(kg * 32) * ldw + colw + cgi * 4;
#pragma unroll 8
    for (int kk = 0; kk < 32; ++kk) { const f32x4 w = *(const f32x4*)(wp + (size_t)kk * ldw);
#pragma unroll
        for (int c = 0; c < 5; ++c) acc[c] += sc[c * 1024 + kg * 32 + kk] * w; }
#pragma unroll
    for (int c = 0; c < 5; ++c) *(LAS f32x4*)(red + (kg * 5 + c) * 64 + cgi * 4) = acc[c];
    __syncthreads();
    if (tid < 320) { const int cond = tid >> 6, col = tid & 63; float sm = bias ? bias[colo + col] : 0.f;
        for (int g = 0; g < 32; ++g) sm += red[(g * 5 + cond) * 64 + col];
        out[(size_t)cond * ldo + colo + col] = sm; }
    __syncthreads();
}
__device__ __forceinline__ void mod_item(CKP& p, LAS unsigned char* lds, int it) {
    const int tid = opaque_tid(); unsigned char* ws = p.ws;
    LAS float* sc = (LAS float*)lds; LAS float* red = (LAS float*)(lds + 20480);
    const int l = it / 96, cgp = it % 96;
    for (int i = tid; i < 5 * 1024; i += NTHR) { const int cond = i >> 10, k = i & 1023; const float v = cond == 0 ? p.in[I_CCTX][k] : p.in[I_C][(cond - 1) * 1024 + k]; sc[i] = v * fsigmoid(v); }
    __syncthreads();
    gemv5_cols(sc, red, p.in[I_WADA] + (size_t)l * 1024 * 6144, 6144, cgp * 64, p.in[I_BADA] + l * 6144, (float*)(ws + WS_MOD) + (size_t)l * 5 * 6144, 6144, cgp * 64, tid);
}
constexpr int TI_IN = 16 * 76, TI_OUT = 16 * 32, TI_1 = 16 * 128, TI_2 = 64 * 32, TI_L = TI_IN + TI_OUT + TI_1 + TI_2;
__device__ __forceinline__ void transpose_range(CKP& p, LAS unsigned char* lds, int first, int last, int bid, int nb) {
    const int tid = opaque_tid(), lane = tid & 63, wave = tid >> 6;
    unsigned char* ws = p.ws;
    LAS float* scr = (LAS float*)(lds + wave * 16384);
#pragma unroll 1
    for (int it = first + bid * 8 + wave; it < last; it += nb * 8) {
        const int l = it / TI_L; int r = it % TI_L;
        if (r < TI_IN) { transpose_item(p.in[I_WIN] + (size_t)l * DM * DIN, DM, DIN, (bf16*)(ws + WS_WIN) + (size_t)l * DINP * DM, scr, r, lane); continue; } r -= TI_IN;
        if (r < TI_OUT) { transpose_item(p.in[I_WOUT] + (size_t)l * DM * DM, DM, DM, (bf16*)(ws + WS_WOUT) + (size_t)l * DM * DM, scr, r, lane); continue; } r -= TI_OUT;
        if (r < TI_1) { transpose_item(p.in[I_WFF1] + (size_t)l * DM * DFF, DM, DFF, (bf16*)(ws + WS_W1) + (size_t)l * DFF * DM, scr, r, lane); continue; } r -= TI_1;
        transpose_item(p.in[I_WFF2] + (size_t)l * DFF * DM, DFF, DM, (bf16*)(ws + WS_W2) + (size_t)l * DM * DFF, scr, r, lane);
    }
}
__device__ __forceinline__ void stage_prologue(CKP& p, LAS unsigned char* lds, int bid, int nb) {
    const int tid = opaque_tid();
    unsigned char* ws = p.ws;
    transpose_range(p, lds, 0, TI_IN, bid, nb);
    const int gt = bid * NTHR + tid, NGT = nb * NTHR;
#pragma unroll 1
    for (int i = gt; i < 2 * 128 * DM / 8; i += NGT) { const int l = i / (128 * DM / 8), r = i % (128 * DM / 8);
        u32x4 z = (u32x4){0u, 0u, 0u, 0u}; asm volatile("" : "+v"(z));
        *(u32x4*)((bf16*)(ws + WS_WIN) + (size_t)l * DINP * DM + (size_t)DIN * DM + (size_t)r * 8) = z; }
    __syncthreads();
#pragma unroll 1
    for (int it = bid; it < 192; it += nb) mod_item(p, lds, it);
}
__device__ __forceinline__ void stage_tables(CKP& p, int bid, int nb) {
    const int tid = opaque_tid(); unsigned char* ws = p.ws;
    const int gt = bid * NTHR + tid, NGT = nb * NTHR;
#pragma unroll 1
    for (int i = gt; i < 256 * 512 + 1024 * 2048; i += NGT) {
        int L, k, j; bf16* dst;
        if (i < 256 * 512) { L = 256; k = i / 512; j = i % 512; dst = (bf16*)(ws + WS_CS256) + i; }
        else { const int i2 = i - 256 * 512; L = 1024; k = i2 / 2048; j = i2 % 2048; dst = (bf16*)(ws + WS_CS1024) + i2; }
        const int jj = j >= L ? j - L : j; const int idx = (k * jj) & (L - 1);
        const float rev = (float)idx / (float)L; const float s = __builtin_amdgcn_sinf(rev), c = __builtin_amdgcn_cosf(rev);
        *dst = (bf16)f2bf(j >= L ? -s : c);
    }
#pragma unroll 1
    for (int i = gt; i < 2 * 4 * 64 * 128; i += NGT) {
        const int o = i & 127, c = (i >> 7) & 63, lg = i >> 13; const float* wf = p.in[I_WFNET] + (size_t)lg * 4096 + (o & 63);
        float acc = 0.f;
        for (int cp = 0; cp < 64; ++cp) { const float rev = (float)((c * cp) & 63) * (1.0f / 64.0f); const float s = __builtin_amdgcn_sinf(rev), co = __builtin_amdgcn_cosf(rev); acc += (o < 64 ? co : s) * wf[cp * 64]; }
        ((bf16*)(ws + WS_FW))[(size_t)(lg * 128 + o) * 64 + c] = (bf16)f2bf(acc);
    }
#pragma unroll 1
    for (int i = gt; i < 2 * 4 * 64 * 64; i += NGT) { const int o = i & 63, c = (i >> 6) & 63, lg = i >> 12;
        ((bf16*)(ws + WS_WPT))[(size_t)(lg * 64 + o) * 64 + c] = (bf16)f2bf(p.in[I_WPOOL][i]); }
#pragma unroll 1
    for (int i = gt; i < 2 * 2 * 64 * 512; i += NGT) { const int c = i & 511, r = (i >> 9) & 63, ld = i >> 15;
        ((bf16*)(ws + WS_WUPT))[(size_t)(ld * 512 + c) * 64 + r] = (bf16)f2bf(p.in[I_WUP][i]);
        ((bf16*)(ws + WS_AUPT))[(size_t)(ld * 512 + c) * 64 + r] = (bf16)f2bf(p.in[I_AUP][i]); }
#pragma unroll 1
    for (int i = gt; i < 2 * 128 * 512; i += NGT) { const int c = i & 511, r = (i >> 9) & 127, ll = i >> 16;
        ((bf16*)(ws + WS_GUPT))[(size_t)(ll * 512 + c) * 128 + r] = (bf16)f2bf(p.in[I_GUP][i]); }
}
__device__ __forceinline__ void shiftw_item(CKP& p, LAS unsigned char* lds, int it) {
    const int tid = opaque_tid();
    unsigned char* ws = p.ws;
    LAS float* sc = (LAS float*)lds; LAS float* red = (LAS float*)(lds + 20480);
    const bool isin = it >= 128; const int l = isin ? 1 : it >> 6, blk = isin ? it - 128 : it & 63;
    const float* shv = (const float*)(ws + WS_MOD) + (size_t)l * 5 * 6144 + (isin ? 0 : 3 * 1024);
    for (int i = tid; i < 5 * 1024; i += NTHR) sc[i] = shv[(i >> 10) * 6144 + (i & 1023)];
    __syncthreads();
    if (isin) gemv5_cols(sc, red, p.in[I_WIN] + (size_t)DM * DIN, DIN, blk * 64, nullptr, (float*)(ws + WS_SWIN), DINP, blk * 64, tid);
    else gemv5_cols(sc, red, p.in[I_WFF1] + (size_t)l * DM * DFF, DFF, blk * 64, nullptr, (float*)(ws + WS_SW1) + (size_t)l * 5 * DFF, DFF, blk * 64, tid);
    if (it == 165) for (int i = tid; i < 5 * 128; i += NTHR) ((float*)(ws + WS_SWIN))[(i >> 7) * DINP + DIN + (i & 127)] = 0.f;
}
__device__ __forceinline__ void side_queue(CKP& p, int l, LAS unsigned char* lds) {
    const int tid = opaque_tid();
    unsigned* ctr = (unsigned*)(p.ws + WS_CTL + 524288) + 64 * l;
    volatile LAS unsigned* slot = (volatile LAS unsigned*)(lds + RING_BYTES + 64);
    const int nmd = 0, nsh = l == 0 ? 166 : 0, first = l == 0 ? TI_IN : TI_L + TI_IN, nch = ((l == 0 ? TI_L + TI_IN : 2 * TI_L) - first) / 8;
    __syncthreads();
#pragma unroll 1
    for (;;) {
        if (tid == 0) *slot = atomicAdd(ctr, 1u);
        __syncthreads();
        const int it = (int)*slot;
        __syncthreads();
        if (it >= nmd + nsh + nch) break;
        if (it < nmd) mod_item(p, lds, 96 + it);
        else if (it < nmd + nsh) shiftw_item(p, lds, it - nmd);
        else { const int c0 = first + 8 * (it - nmd - nsh); transpose_range(p, lds, c0, c0 + 8, 0, 1); }
        __syncthreads();
    }
}

__device__ __forceinline__ void stage_norm(CKP& p, int l, int which, int bid, int nb) {
    const int tid = opaque_tid(), lane = tid & 63, wave = tid >> 6;
    const float* g = p.in[which ? I_N2G : I_N1G] + l * DM;
    const float* mod = (const float*)(p.ws + WS_MOD) + (size_t)l * 5 * 6144 + (which ? 3 * 1024 : 0);
    bf16* H = (bf16*)(p.ws + WS_H);
#pragma unroll 1
    for (int row = bid * 8 + wave; row < MTOK; row += nb * 8) {
        const float* xsrc = (l == 0 && which == 0) ? (row < NCTX ? p.in[I_XP] + (size_t)row * DM : p.in[I_XS] + (size_t)(row - NCTX) * DM) : p.out + (size_t)row * DM;
        const f32x4* xr = (const f32x4*)xsrc + lane;
        f32x4 v[4]; float s = 0.f;
#pragma unroll
        for (int j = 0; j < 4; ++j) { v[j] = xr[64 * j]; s += (v[j].x * v[j].x + v[j].y * v[j].y) + (v[j].z * v[j].z + v[j].w * v[j].w); }
        const float rstd = frsq(wave_sum(s) * (1.0f / DM) + 1e-6f);
        const int cond = row < NCTX ? 0 : 1 + ((row - NCTX) >> 10);
        const float* sh = mod + cond * 6144; const float* scl = sh + 1024;
        unsigned long long* o8 = (unsigned long long*)(H + (size_t)row * DM) + lane;
#pragma unroll
        for (int j = 0; j < 4; ++j) { const int col = 4 * lane + 256 * j; const f32x4 gg = *(const f32x4*)(g + col), a = *(const f32x4*)(sh + col), b = *(const f32x4*)(scl + col);
            const f32x4 y = v[j] * rstd * gg * (b + 1.0f) + a;
            o8[64 * j] = (unsigned long long)pk2(y.x, y.y) | ((unsigned long long)pk2(y.z, y.w) << 32); }
    }
}
__device__ __forceinline__ void stage_final(CKP& p, int bid, int nb) {
    const int tid = opaque_tid(), lane = tid & 63, wave = tid >> 6;
    const float* g = p.in[I_FNG];
#pragma unroll 1
    for (int row = bid * 8 + wave; row < MTOK; row += nb * 8) {
        f32x4* xr = (f32x4*)(p.out + (size_t)row * DM) + lane;
        f32x4 v[4]; float s = 0.f;
#pragma unroll
        for (int j = 0; j < 4; ++j) { v[j] = xr[64 * j]; s += (v[j].x * v[j].x + v[j].y * v[j].y) + (v[j].z * v[j].z + v[j].w * v[j].w); }
        const float rstd = frsq(wave_sum(s) * (1.0f / DM) + 1e-6f);
#pragma unroll
        for (int j = 0; j < 4; ++j) xr[64 * j] = v[j] * rstd * *(const f32x4*)(g + 4 * lane + 256 * j);
    }
}


typedef short bf16x8 __attribute__((ext_vector_type(8)));
typedef float f32x2v __attribute__((ext_vector_type(2)));
typedef __bf16 bf16x2v __attribute__((ext_vector_type(2)));
#define MFMA16(a, b, c) __builtin_amdgcn_mfma_f32_16x16x32_bf16((a), (b), (c), 0, 0, 0)
__device__ __forceinline__ unsigned cvt2(float lo, float hi) { f32x2v v = {lo, hi}; bf16x2v b = __builtin_convertvector(v, bf16x2v); return __builtin_bit_cast(unsigned, b); }
__device__ __forceinline__ u32x4 pack8(const float (&x)[8]) { u32x4 w; w.x = cvt2(x[0], x[1]); w.y = cvt2(x[2], x[3]); w.z = cvt2(x[4], x[5]); w.w = cvt2(x[6], x[7]); return w; }
__device__ __forceinline__ void shift8(const bf16* proj, int row, bool hasp, bool hasn, int col, const float* mu, float (&u)[8]) {
    float p[8], a[8], b[8];
    load8bf(proj + (size_t)row * DINP + col, p);
    if (hasp) load8bf(proj + (size_t)(row - 1) * DINP + col, a); else {
#pragma unroll
        for (int j = 0; j < 8; ++j) a[j] = 0.f; }
    if (hasn) load8bf(proj + (size_t)(row + 1) * DINP + col, b); else {
#pragma unroll
        for (int j = 0; j < 8; ++j) b[j] = 0.f; }
    const f32x4 m0 = *(const f32x4*)(mu + col), m1 = *(const f32x4*)(mu + col + 4);
#pragma unroll
    for (int j = 0; j < 4; ++j) { u[j] = p[j] + m0[j] * (0.5f * (a[j] + b[j]) - p[j]); u[4 + j] = p[4 + j] + m1[j] * (0.5f * (a[4 + j] + b[4 + j]) - p[4 + j]); }
}
__device__ __forceinline__ int opq(int x) { asm volatile("" : "+v"(x)); return x; }
constexpr int TS = 72, TB = 64 * TS * 2;
constexpr int L_HT = 0, L_TW = 9216, L_AD = 18432, L_LP = 27648, L_AP = 45056, L_AT = 62464, L_RT = L_AT + TB, L_BH = L_RT + TB, L_KH = L_BH + TB, L_VR = L_KH + TB, L_YS = L_VR + TB;
constexpr int L_AAB = L_TW, L_AAK = L_AAB + 4096, L_ARB = L_AAK + 3072, L_ARK = L_ARB + 3072, L_UT = L_ARK + 3072, L_W1 = L_AP;
static_assert(L_UT + 64 * 24 * 2 <= L_LP && L_YS + 17408 <= RING_BYTES, "scan LDS map");
constexpr int LPS = 68;
#define LBAR() asm volatile("s_waitcnt lgkmcnt(0)\n\ts_barrier" ::: "memory")
typedef short s16x4v __attribute__((ext_vector_type(4)));
__device__ __forceinline__ bf16x8 tr8(const LAS bf16* p) {
    const s16x4v lo = __builtin_bit_cast(s16x4v, __builtin_amdgcn_ds_read_tr16_b64_v4i16((LAS s16x4v*)p));
    const s16x4v hi = __builtin_bit_cast(s16x4v, __builtin_amdgcn_ds_read_tr16_b64_v4i16((LAS s16x4v*)(p + 4 * TS)));
    return (bf16x8){lo[0], lo[1], lo[2], lo[3], hi[0], hi[1], hi[2], hi[3]};
}

__device__ __forceinline__ void rwkv_item3(CKP& p, int l, LAS unsigned char* lds, int item) {
    const int tid0 = opaque_tid(), w = __builtin_amdgcn_readfirstlane(tid0 >> 6);
    int tid = tid0, fr = tid & 15, fg = (tid & 63) >> 4;
    int bseq, h, dir, L, base; bool lat;
    if (item < 64) { lat = true; bseq = item >> 4; h = (item >> 1) & 7; dir = item & 1; L = 1024; base = NCTX + bseq * 1024; }
    else { const int i2 = item - 64; lat = false; bseq = i2 >> 4; h = (i2 >> 1) & 7; dir = i2 & 1; L = 256; base = bseq * 256; }
    const bf16* U = (const bf16*)(p.ws + WS_U);
    const float* KINV = (const float*)(p.ws + WS_KINV);
    bf16* Yout = (bf16*)(p.ws + (dir ? WS_YB : WS_YF));
    float* BC = (float*)(p.ws + WS_BC) + (size_t)dir * MTOK * 8;
    const bf16* wupt = (const bf16*)(p.ws + WS_WUPT) + ((size_t)(l * 2 + dir) * 512 + h * 64) * 64;
    const bf16* aupt = (const bf16*)(p.ws + WS_AUPT) + ((size_t)(l * 2 + dir) * 512 + h * 64) * 64;

    LAS float* LP = (LAS float*)(lds + L_LP); LAS float* AP = (LAS float*)(lds + L_AP); LAS float* AS = (LAS float*)(lds + L_TW);
    LAS bf16* AT = (LAS bf16*)(lds + L_AT);   LAS bf16* RT = (LAS bf16*)(lds + L_RT);   LAS bf16* BH = (LAS bf16*)(lds + L_BH);   LAS bf16* KH = (LAS bf16*)(lds + L_KH);
    LAS bf16* VR = (LAS bf16*)(lds + L_VR);   LAS float* YS = (LAS float*)(lds + L_YS);
    LAS float* AAB = (LAS float*)(lds + L_AAB); LAS bf16* AAK = (LAS bf16*)(lds + L_AAK); LAS bf16* ARB = (LAS bf16*)(lds + L_ARB); LAS bf16* ARK = (LAS bf16*)(lds + L_ARK);
    LAS float* W1 = (LAS float*)(lds + L_W1);
    const int tv = w & 3;
    f32x4 hacc[4];
#pragma unroll
    for (int x = 0; x < 4; ++x) {
        if (lat && w < 4) hacc[x] = *(const f32x4*)(p.in[I_STATE] + ((((size_t)bseq * 2 + l) * 2 + dir) * 8 + h) * 4096 + (16 * tv + fr) * 64 + 16 * x + 4 * fg);
        else hacc[x] = (f32x4){0.f, 0.f, 0.f, 0.f}; }
    int ei = tid >> 3, ec8 = (tid & 7) * 8; const int hc8 = h * 64 + ec8;
    float kkp[8], kap[8], rkp[8];
#pragma unroll
    for (int e = 0; e < 8; ++e) { kkp[e] = p.in[I_KK][l * 512 + hc8 + e]; kap[e] = p.in[I_KA][l * 512 + hc8 + e]; rkp[e] = p.in[I_RK][l * 512 + hc8 + e]; }
#define SCAN_PREFETCH(SC) do { const int _t0 = opq(tid0), _ei = _t0 >> 3, _ec8 = (_t0 & 7) * 8; const int _step = (SC) * 64 + _ei, _t = dir ? L - 1 - _step : _step; \
        const bf16* _u = U + (size_t)(base + _t) * 1920; \
        nr = *(const u32x4*)(_u + R_OFF + h * 64 + _ec8); nk = *(const u32x4*)(_u + K_OFF + h * 64 + _ec8); nv = *(const u32x4*)(_u + V_OFF + h * 64 + _ec8); \
        ninv = KINV[(size_t)(base + _t) * 8 + h]; \
        const int _st2 = (SC) * 64 + 16 * (w >> 1) + (_t0 & 15), _t2 = dir ? L - 1 - _st2 : _st2; const bf16* _u2 = U + (size_t)(base + _t2) * 1920 + dir * 64 + ((_t0 & 63) >> 4) * 8; \
        paw0 = *(const bf16x8*)(_u2 + WD_OFF); paw1 = *(const bf16x8*)(_u2 + WD_OFF + 32); paa0 = *(const bf16x8*)(_u2 + AD_OFF); paa1 = *(const bf16x8*)(_u2 + AD_OFF + 32); } while (0)
    bf16x8 lbw[2][2], lba[2][2]; float lw0c[2], la0c[2];
#pragma unroll
    for (int x = 0; x < 2; ++x) { const int c = ((w & 1) * 2 + x) * 16 + fr;
        lbw[x][0] = *(const bf16x8*)(wupt + c * 64 + fg * 8); lbw[x][1] = *(const bf16x8*)(wupt + c * 64 + 32 + fg * 8);
        lba[x][0] = *(const bf16x8*)(aupt + c * 64 + fg * 8); lba[x][1] = *(const bf16x8*)(aupt + c * 64 + 32 + fg * 8);
        lw0c[x] = p.in[I_W0][(l * 2 + dir) * 512 + h * 64 + c]; la0c[x] = p.in[I_A0][(l * 2 + dir) * 512 + h * 64 + c]; }
    u32x4 nr, nk, nv; float ninv; bf16x8 paw0, paw1, paa0, paa1;
    SCAN_PREFETCH(0);
    __syncthreads();
#pragma unroll 1
    for (int sc = 0; sc < L / 64; ++sc) {
        tid = opq(tid0); fr = tid & 15; fg = (tid & 63) >> 4; ei = tid >> 3; ec8 = (tid & 7) * 8;
        const u32x4 cr = nr, ck = nk, cv = nv; const float kinv = ninv;
        { const int ti = w >> 1;
          const bf16x8 aw0 = paw0, aw1 = paw1, aa0 = paa0, aa1 = paa1;
          unsigned li[2], ls[2];
#pragma unroll
          for (int pr = 0; pr < 2; ++pr) { const int j0 = 4 * fg + 2 * pr, j1 = j0 + 1;
              li[pr] = (j0 <= fr ? 0x3f80u : 0u) | (j1 <= fr ? 0x3f800000u : 0u); ls[pr] = (j0 < fr ? 0x3f80u : 0u) | (j1 < fr ? 0x3f800000u : 0u); }
          const bf16x8 Li = __builtin_bit_cast(bf16x8, (u32x4){li[0], li[1], 0u, 0u}), Ls = __builtin_bit_cast(bf16x8, (u32x4){ls[0], ls[1], 0u, 0u});
#pragma unroll
          for (int x = 0; x < 2; ++x) { const int c = ((w & 1) * 2 + x) * 16 + fr;
              f32x4 cw = (f32x4){lw0c[x], lw0c[x], lw0c[x], lw0c[x]}, ca = (f32x4){la0c[x], la0c[x], la0c[x], la0c[x]};
              cw = MFMA16(aw0, lbw[x][0], cw); cw = MFMA16(aw1, lbw[x][1], cw); ca = MFMA16(aa0, lba[x][0], ca); ca = MFMA16(aa1, lba[x][1], ca);
              float lw[4], lo[4];
#pragma unroll
              for (int r = 0; r < 4; ++r) lw[r] = -0.6065306597126334f * fsigmoid(cw[r]);
              const unsigned h01 = cvt2(lw[0], lw[1]), h23 = cvt2(lw[2], lw[3]);
              lo[0] = lw[0] - bflo(h01); lo[1] = lw[1] - bfhi(h01); lo[2] = lw[2] - bflo(h23); lo[3] = lw[3] - bfhi(h23);
              const bf16x8 bh = __builtin_bit_cast(bf16x8, (u32x4){h01, h23, 0u, 0u}), bl = __builtin_bit_cast(bf16x8, (u32x4){cvt2(lo[0], lo[1]), cvt2(lo[2], lo[3]), 0u, 0u});
              f32x4 ci = (f32x4){0.f, 0.f, 0.f, 0.f}, cs = ci;
              ci = MFMA16(Li, bh, ci); ci = MFMA16(Li, bl, ci); cs = MFMA16(Ls, bh, cs); cs = MFMA16(Ls, bl, cs);
#pragma unroll
              for (int r = 0; r < 4; ++r) { const int o = (ti * 16 + 4 * fg + r) * LPS + c;
                  LP[o] = fexp(ci[r]); AP[o] = fexp(cs[r]); AS[o] = fsigmoid(ca[r]); } } }
        __syncthreads();
        tid = opq(tid0); fr = tid & 15; fg = (tid & 63) >> 4; ei = tid >> 3; ec8 = (tid & 7) * 8;
        float bcv;
        { const f32x4 g0 = *(const LAS f32x4*)(LP + ei * LPS + ec8), g1 = *(const LAS f32x4*)(LP + ei * LPS + ec8 + 4);
          const f32x4 p0 = *(const LAS f32x4*)(AP + ei * LPS + ec8), p1 = *(const LAS f32x4*)(AP + ei * LPS + ec8 + 4);
          const f32x4 s0 = *(const LAS f32x4*)(AS + ei * LPS + ec8), s1 = *(const LAS f32x4*)(AS + ei * LPS + ec8 + 4);
          float rr[8], kk[8], xa[8], xr[8], xb[8], xk[8], bc = 0.f;
          rr[0] = bflo(cr.x); rr[1] = bfhi(cr.x); rr[2] = bflo(cr.y); rr[3] = bfhi(cr.y); rr[4] = bflo(cr.z); rr[5] = bfhi(cr.z); rr[6] = bflo(cr.w); rr[7] = bfhi(cr.w);
          kk[0] = bflo(ck.x); kk[1] = bfhi(ck.x); kk[2] = bflo(ck.y); kk[3] = bfhi(ck.y); kk[4] = bflo(ck.z); kk[5] = bfhi(ck.z); kk[6] = bflo(ck.w); kk[7] = bfhi(ck.w);
#pragma unroll
          for (int e = 0; e < 8; ++e) { const float gi = e < 4 ? g0[e & 3] : g1[e & 3], gp = e < 4 ? p0[e & 3] : p1[e & 3], asg = e < 4 ? s0[e & 3] : s1[e & 3];
              const float kj = kk[e] * kkp[e] * kinv, kd = kk[e] * (1.0f + (asg - 1.0f) * kap[e]), ginv = frcp(gi);
              bc += rr[e] * kd * rkp[e];
              xa[e] = -kj * gp; xr[e] = rr[e] * gi; xb[e] = kj * asg * ginv; xk[e] = kd * ginv; }
          bcv = red8(bc);
          *(LAS u32x4*)(AT + ei * TS + ec8) = pack8(xa); *(LAS u32x4*)(RT + ei * TS + ec8) = pack8(xr); *(LAS u32x4*)(BH + ei * TS + ec8) = pack8(xb); *(LAS u32x4*)(KH + ei * TS + ec8) = pack8(xk);
          *(LAS u32x4*)(VR + ei * TS + ec8) = cv; }
        __syncthreads();
        tid = opq(tid0); fr = tid & 15; fg = (tid & 63) >> 4;
        { const int q = w >> 1, half = w & 1; const LAS bf16* Asrc = half ? RT : AT;
          const bf16x8 af0 = *(const LAS bf16x8*)(Asrc + (16 * q + fr) * TS + fg * 8), af1 = *(const LAS bf16x8*)(Asrc + (16 * q + fr) * TS + 32 + fg * 8);
#pragma unroll
          for (int x = 0; x < 2; ++x) { const LAS bf16* Bsrc = x ? KH : BH;
              const bf16x8 bf0 = *(const LAS bf16x8*)(Bsrc + (16 * q + fr) * TS + fg * 8), bf1_ = *(const LAS bf16x8*)(Bsrc + (16 * q + fr) * TS + 32 + fg * 8);
              f32x4 c = (f32x4){0.f, 0.f, 0.f, 0.f}; c = MFMA16(af0, bf0, c); c = MFMA16(af1, bf1_, c);
              f32x4 cm;
#pragma unroll
              for (int r = 0; r < 4; ++r) { const int i = 4 * fg + r, j = fr; cm[r] = (half ? j <= i : j < i) ? c[r] : 0.f; }
              if (half == 0 && x == 0) *(LAS f32x4*)(AAB + (q * 16 + fr) * 16 + 4 * fg) = cm;
              else { LAS bf16* dst = half == 0 ? AAK : (x == 0 ? ARB : ARK);
#pragma unroll
                  for (int r = 0; r < 4; ++r) dst[(q * 16 + 4 * fg + r) * 24 + fr] = (bf16)(cvt2(cm[r], 0.f) & 0xffffu); } }
          if (half == 0) {
              const unsigned kmask = fg < 2 ? 0xffffffffu : 0u;
              const bf16x8 afr = *(const LAS bf16x8*)(AAK + (q * 16 + fr) * 24 + (fg & 1) * 8);
              const bf16x8 af = __builtin_bit_cast(bf16x8, __builtin_bit_cast(u32x4, afr) & kmask);
#pragma unroll
              for (int tvv = 0; tvv < 4; ++tvv) {
                  const bf16x8 bfr = tr8(VR + (16 * q + 8 * (fg & 1) + (fr >> 2)) * TS + 16 * tvv + 4 * (fr & 3));
                  const bf16x8 bfv = __builtin_bit_cast(bf16x8, __builtin_bit_cast(u32x4, bfr) & kmask);
                  f32x4 c = (f32x4){0.f, 0.f, 0.f, 0.f}; c = MFMA16(af, bfv, c);
#pragma unroll
                  for (int r = 0; r < 4; ++r) W1[(q * 16 + 4 * fg + r) * LPS + 16 * tvv + fr] = c[r]; } } }
        __syncthreads();
        tid = opq(tid0);
        { const int q = tid >> 7, col = tid & 127; float x[16];
          if (col < 64) {
#pragma unroll
              for (int i = 0; i < 16; ++i) x[i] = bf1(AT[(16 * q + i) * TS + col]); }
          else {
#pragma unroll
              for (int i = 0; i < 16; ++i) x[i] = W1[(q * 16 + i) * LPS + col - 64]; }
#pragma unroll
          for (int j = 0; j < 15; ++j) {
              const LAS f32x4* ac = (const LAS f32x4*)(AAB + (q * 16 + j) * 16);
#pragma unroll
              for (int i4 = (j + 1) / 4; i4 < 4; ++i4) { const f32x4 a4 = ac[i4];
#pragma unroll
                  for (int e = 0; e < 4; ++e) if (i4 * 4 + e > j) x[i4 * 4 + e] += a4[e] * x[j]; } }
          if (col < 64) {
#pragma unroll
              for (int i = 0; i < 16; ++i) AT[(16 * q + i) * TS + col] = (bf16)(cvt2(x[i], 0.f) & 0xffffu); }
          else {
#pragma unroll
              for (int i = 0; i < 16; ++i) W1[(q * 16 + i) * LPS + col - 64] = x[i]; } }
        __syncthreads();
        if (sc + 1 < L / 64) SCAN_PREFETCH(sc + 1);
        if (w < 4) {
#pragma unroll 1
        for (int q = 0; q < 4; ++q) {
            tid = opq(tid0); fr = tid & 15; fg = (tid & 63) >> 4;
            bf16x8 hb[2];
#pragma unroll
            for (int ks = 0; ks < 2; ++ks) { u32x4 t; t.x = cvt2(hacc[2 * ks][0], hacc[2 * ks][1]); t.y = cvt2(hacc[2 * ks][2], hacc[2 * ks][3]);
                t.z = cvt2(hacc[2 * ks + 1][0], hacc[2 * ks + 1][1]); t.w = cvt2(hacc[2 * ks + 1][2], hacc[2 * ks + 1][3]); hb[ks] = __builtin_bit_cast(bf16x8, t); }
            bf16x8 aU[2], aR[2];
#pragma unroll
            for (int ks = 0; ks < 2; ++ks) {
                const u32x2 a0 = *(const LAS u32x2*)(AT + (16 * q + fr) * TS + 32 * ks + 4 * fg), a1 = *(const LAS u32x2*)(AT + (16 * q + fr) * TS + 32 * ks + 16 + 4 * fg);
                const u32x2 r0 = *(const LAS u32x2*)(RT + (16 * q + fr) * TS + 32 * ks + 4 * fg), r1 = *(const LAS u32x2*)(RT + (16 * q + fr) * TS + 32 * ks + 16 + 4 * fg);
                aU[ks] = __builtin_bit_cast(bf16x8, (u32x4){a0.x, a0.y, a1.x, a1.y}); aR[ks] = __builtin_bit_cast(bf16x8, (u32x4){r0.x, r0.y, r1.x, r1.y}); }
            f32x4 u, yacc = (f32x4){0.f, 0.f, 0.f, 0.f};
#pragma unroll
            for (int r = 0; r < 4; ++r) u[r] = W1[(q * 16 + 4 * fg + r) * LPS + 16 * tv + fr];
            u = MFMA16(aU[0], hb[0], u); u = MFMA16(aU[1], hb[1], u);
            yacc = MFMA16(aR[0], hb[0], yacc); yacc = MFMA16(aR[1], hb[1], yacc);
            const s16x4v vtr = __builtin_bit_cast(s16x4v, __builtin_amdgcn_ds_read_tr16_b64_v4i16((LAS s16x4v*)(VR + (16 * q + 4 * fg + (fr >> 2)) * TS + 16 * tv + 4 * (fr & 3))));
            const u32x2 vt2 = __builtin_bit_cast(u32x2, vtr);
            const bf16x8 bUV = __builtin_bit_cast(bf16x8, (u32x4){cvt2(u[0], u[1]), cvt2(u[2], u[3]), vt2.x, vt2.y});
            { const u32x2 y0 = *(const LAS u32x2*)(ARB + (q * 16 + fr) * 24 + 4 * fg), y1 = *(const LAS u32x2*)(ARK + (q * 16 + fr) * 24 + 4 * fg);
              yacc = MFMA16(__builtin_bit_cast(bf16x8, (u32x4){y0.x, y0.y, y1.x, y1.y}), bUV, yacc); }
#pragma unroll
            for (int r = 0; r < 4; ++r) YS[(16 * q + 4 * fg + r) * LPS + 16 * tv + fr] = yacc[r];
#pragma unroll
            for (int x = 0; x < 4; ++x) {
                const s16x4v bt = __builtin_bit_cast(s16x4v, __builtin_amdgcn_ds_read_tr16_b64_v4i16((LAS s16x4v*)(BH + (16 * q + 4 * fg + (fr >> 2)) * TS + 16 * x + 4 * (fr & 3))));
                const s16x4v kt = __builtin_bit_cast(s16x4v, __builtin_amdgcn_ds_read_tr16_b64_v4i16((LAS s16x4v*)(KH + (16 * q + 4 * fg + (fr >> 2)) * TS + 16 * x + 4 * (fr & 3))));
                const u32x2 b2 = __builtin_bit_cast(u32x2, bt), k2 = __builtin_bit_cast(u32x2, kt);
                const f32x4 ge = *(const LAS f32x4*)(LP + (16 * q + 15) * LPS + 16 * x + 4 * fg);
                hacc[x] = MFMA16(__builtin_bit_cast(bf16x8, (u32x4){b2.x, b2.y, k2.x, k2.y}), bUV, hacc[x]) * ge; }
        }
        }
        __syncthreads();
        tid = opq(tid0); ei = tid >> 3; ec8 = (tid & 7) * 8;
        { const int st2 = sc * 64 + ei, t2 = dir ? L - 1 - st2 : st2; bf16* yo = Yout + (size_t)(base + t2) * 512 + h * 64 + ec8;
          const f32x4 y0 = *(const LAS f32x4*)(YS + ei * LPS + ec8), y1 = *(const LAS f32x4*)(YS + ei * LPS + ec8 + 4);
          u32x4 yw; yw.x = cvt2(y0[0], y0[1]); yw.y = cvt2(y0[2], y0[3]); yw.z = cvt2(y1[0], y1[1]); yw.w = cvt2(y1[2], y1[3]);
          *(u32x4*)yo = yw;
          if ((tid & 7) == 0) BC[(size_t)(base + t2) * 8 + h] = bcv; }
    }
#undef SCAN_PREFETCH
    if (!lat && w < 4) {
#pragma unroll
        for (int x = 0; x < 4; ++x) *(f32x4*)(p.out + (size_t)MTOK * DM + ((((size_t)bseq * 2 + l) * 2 + dir) * 8 + h) * 4096 + (16 * tv + fr) * 64 + 16 * x + 4 * fg) = hacc[x]; }
    __syncthreads();
}

__device__ __forceinline__ void stage_upass(CKP& p, int l, int bid, int nb) {
    const int tid = opaque_tid(), sub = tid >= 240 ? 1 : 0, j = tid - sub * 240, col = 8 * j;
    const bf16* proj = (const bf16*)(p.ws + WS_PROJ); bf16* U = (bf16*)(p.ws + WS_U); float* KINV = (float*)(p.ws + WS_KINV);
    const float* mu = p.in[I_MU] + l * 1920;
    if (tid < 480) {
        const bool isk = col >= K_OFF && col < V_OFF;
        const float* kkp = p.in[I_KK] + l * 512 + (isk ? col - K_OFF : 0);
        const f32x4 k0 = *(const f32x4*)kkp, k1 = *(const f32x4*)(kkp + 4);
#pragma unroll 1
        for (int tok0 = bid * 2 + sub; tok0 < MTOK; tok0 += nb * 8) {
            float uu[4][8];
#pragma unroll
            for (int z = 0; z < 4; ++z) { const int tok = min(tok0 + z * nb * 2, MTOK - 1);
                const bool lat = tok >= NCTX; const int L = lat ? 1024 : 256, t = lat ? (tok - NCTX) & 1023 : tok & 255;
                shift8(proj, tok, t > 0, t < L - 1, col, mu, uu[z]); }
#pragma unroll
            for (int z = 0; z < 4; ++z) { const int tok = tok0 + z * nb * 2;
                float ss = 0.f;
#pragma unroll
                for (int e = 0; e < 8; ++e) { const float kn = uu[z][e] * (e < 4 ? k0[e & 3] : k1[e & 3]); ss += kn * kn; }
                ss = red8(ss);
                if (tok < MTOK) {
                    if (isk && (j & 7) == 0) KINV[(size_t)tok * 8 + ((col - K_OFF) >> 6)] = fminf(frsq(ss), 1e12f);
                    if (col >= WD_OFF && col < AD_OFF) {
#pragma unroll
                        for (int e = 0; e < 8; ++e) uu[z][e] = 1.0f - 2.0f * frcp(fexp(2.0f * uu[z][e]) + 1.0f); }
                    if (col >= GD_OFF) {
#pragma unroll
                        for (int e = 0; e < 8; ++e) uu[z][e] = fsigmoid(uu[z][e]); }
                    *(u32x4*)(U + (size_t)tok * 1920 + col) = pack8(uu[z]); } }
        }
    }
}

__device__ __forceinline__ void fnet1_item(CKP& p, int l, int item) {
    const int tid = opaque_tid(), lane = tid & 63, w = __builtin_amdgcn_readfirstlane(tid >> 6), fr = lane & 15, fg = lane >> 4;
    const int tb = item >> 2, g = item & 3, tok0 = tb * 64, tt = w & 3, cs = w >> 2;
    const bf16* proj = (const bf16*)(p.ws + WS_PROJ);
    const bf16* fwt = (const bf16*)(p.ws + WS_FW) + (size_t)((l * 4 + g) * 128 + cs * 64) * 64;
    const bf16* xr = proj + (size_t)(tok0 + 16 * tt + fr) * DINP + F_OFF + g * 64 + fg * 8;
    const bf16x8 a0 = *(const bf16x8*)xr, a1 = *(const bf16x8*)(xr + 32);
    const bool lat = tok0 >= NCTX;
    const int L = lat ? 1024 : 256, bq = lat ? (tok0 - NCTX) >> 10 : tok0 >> 8, t = (lat ? (tok0 - NCTX) & 1023 : tok0 & 255) + 16 * tt + 4 * fg;
    const float scale = lat ? (1.0f / 256.0f) : (1.0f / 128.0f);
    bf16* Y = (bf16*)(p.ws + WS_YCS) + (lat ? (size_t)8192 * 512 : 0);
#pragma unroll
    for (int ot = 0; ot < 4; ++ot) {
        const bf16x8 b0 = *(const bf16x8*)(fwt + (16 * ot + fr) * 64 + fg * 8), b1 = *(const bf16x8*)(fwt + (16 * ot + fr) * 64 + 32 + fg * 8);
        f32x4 c = (f32x4){0.f, 0.f, 0.f, 0.f}; c = MFMA16(a0, b0, c); c = MFMA16(a1, b1, c);
        u32x2 o; o.x = cvt2(c[0] * scale, c[1] * scale); o.y = cvt2(c[2] * scale, c[3] * scale);
        *(u32x2*)(Y + (size_t)((bq * 4 + g) * 64 + 16 * ot + fr) * (2 * L) + cs * L + t) = o; }
}

__device__ __forceinline__ void pool_item(CKP& p, int l, LAS unsigned char* lds, int item) {
    const int tid = opaque_tid(), tb = item >> 2, gi = item & 3, tok0 = tb * 64, hw = 1 << gi;
    const bf16* proj = (const bf16*)(p.ws + WS_PROJ);
    LAS bf16* DB = (LAS bf16*)lds;
    LAS float* CSUM = (LAS float*)(lds + 9216);
    const int ti = tid >> 3, c8 = (tid & 7) * 8, tok = tok0 + ti, col = P_OFF + gi * 64 + c8;
    { float sum[8], x[8];
#pragma unroll
      for (int j = 0; j < 8; ++j) sum[j] = 0.f;
      load8bf(proj + (size_t)tok * DINP + col, x);
      float cnt;
      if (tok < NCTX) { const int t = tok & 255, sb = tok - t, lo = max(t - hw, 0), hi = min(t + hw, 256);
          for (int q = lo; q < hi; ++q) { float y[8]; load8bf(proj + (size_t)(sb + q) * DINP + col, y);
#pragma unroll
              for (int j = 0; j < 8; ++j) sum[j] += y[j]; }
          cnt = (float)(hi - lo); }
      else {
          const int t = (tok - NCTX) & 1023, sb = tok - t, r = t >> 6, c = t & 63, rlo = max(r - hw, 0), rhi = min(r + hw, 16), clo = max(c - hw, 0), chi = min(c + hw, 64);
          for (int rq = rlo; rq < rhi; ++rq) { float y[8]; load8bf(proj + (size_t)(sb + rq * 64 + c) * DINP + col, y);
#pragma unroll
              for (int j = 0; j < 8; ++j) sum[j] += y[j]; }
          *(LAS f32x4*)(CSUM + ti * 68 + c8) = (f32x4){sum[0], sum[1], sum[2], sum[3]}; *(LAS f32x4*)(CSUM + ti * 68 + c8 + 4) = (f32x4){sum[4], sum[5], sum[6], sum[7]};
          __syncthreads();
#pragma unroll
          for (int j = 0; j < 8; ++j) sum[j] = 0.f;
          for (int cq = clo; cq < chi; ++cq) { const f32x4 a = *(const LAS f32x4*)(CSUM + cq * 68 + c8), b = *(const LAS f32x4*)(CSUM + cq * 68 + c8 + 4);
#pragma unroll
              for (int j = 0; j < 4; ++j) { sum[j] += a[j]; sum[4 + j] += b[j]; } }
          cnt = (float)((rhi - rlo) * (chi - clo)); }
      const float ic = frcp(cnt);
      float dd[8];
#pragma unroll
      for (int j = 0; j < 8; ++j) dd[j] = sum[j] * ic - x[j];
      *(LAS u32x4*)(DB + ti * 72 + c8) = pack8(dd); }
    __syncthreads();
    { const int lane = tid & 63, w = __builtin_amdgcn_readfirstlane(tid >> 6), fr = lane & 15, fg = lane >> 4, tt = w & 3;
      const bf16* wpt = (const bf16*)(p.ws + WS_WPT) + (size_t)(l * 4 + gi) * 4096;
      const bf16x8 b0 = *(const LAS bf16x8*)(DB + (16 * tt + fr) * 72 + fg * 8), b1 = *(const LAS bf16x8*)(DB + (16 * tt + fr) * 72 + 32 + fg * 8);
#pragma unroll
      for (int x = 0; x < 2; ++x) { const int ot = 2 * (w >> 2) + x;
          const bf16x8 a0 = *(const bf16x8*)(wpt + (16 * ot + fr) * 64 + fg * 8), a1 = *(const bf16x8*)(wpt + (16 * ot + fr) * 64 + 32 + fg * 8);
          f32x4 c = (f32x4){0.f, 0.f, 0.f, 0.f}; c = MFMA16(a0, b0, c); c = MFMA16(a1, b1, c);
          const f32x4 ps = *(const f32x4*)(p.in[I_PSCALE] + l * 256 + gi * 64 + 16 * ot + 4 * fg);
          c *= ps;
          u32x2 o; o.x = cvt2(c[0], c[1]); o.y = cvt2(c[2], c[3]);
          *(u32x2*)((bf16*)(p.ws + WS_MIXED) + (size_t)(tok0 + 16 * tt + fr) * DM + 768 + gi * 64 + 16 * ot + 4 * fg) = o; } }
    __syncthreads();
}

__device__ __forceinline__ float xsum_fg(float s, int fr, int fg) {
    s += __builtin_bit_cast(float, __builtin_amdgcn_ds_bpermute((((fg ^ 1) << 4) | fr) << 2, __builtin_bit_cast(int, s)));
    s += __builtin_bit_cast(float, __builtin_amdgcn_ds_bpermute((((fg ^ 2) << 4) | fr) << 2, __builtin_bit_cast(int, s)));
    return s;
}
__device__ __forceinline__ void stage_post(CKP& p, int l, int bid, int nb) {
    const int tid = opaque_tid(), lane = tid & 63, head = __builtin_amdgcn_readfirstlane(tid >> 6), fr = lane & 15, fg = lane >> 4;
    const bf16* Ub = (const bf16*)(p.ws + WS_U);
    const bf16* gupt = (const bf16*)(p.ws + WS_GUPT) + ((size_t)l * 512 + head * 64) * 128;
    const bf16* YF = (const bf16*)(p.ws + WS_YF); const bf16* YB = (const bf16*)(p.ws + WS_YB);
    const float* BC0 = (const float*)(p.ws + WS_BC); const float* BC1 = BC0 + (size_t)MTOK * 8;
    bf16* MIX = (bf16*)(p.ws + WS_MIXED);
    bf16x8 ag[4][4];
    f32x4 lnw[4], lnb[4];
#pragma unroll
    for (int t = 0; t < 4; ++t) {
#pragma unroll
        for (int ks = 0; ks < 4; ++ks) ag[t][ks] = *(const bf16x8*)(gupt + (16 * t + fr) * 128 + ks * 32 + fg * 8);
        lnw[t] = *(const f32x4*)(p.in[I_LNW] + l * 512 + head * 64 + 16 * t + 4 * fg); lnb[t] = *(const f32x4*)(p.in[I_LNB] + l * 512 + head * 64 + 16 * t + 4 * fg); }
#pragma unroll 1
    for (int item = bid; item < 768; item += nb) {
        const size_t tok = (size_t)item * 16 + fr;
        bf16x8 bs[4];
#pragma unroll
        for (int ks = 0; ks < 4; ++ks) bs[ks] = *(const bf16x8*)(Ub + tok * 1920 + GD_OFF + ks * 32 + fg * 8);
        f32x4 y[4]; u32x2 vw[4];
#pragma unroll
        for (int t = 0; t < 4; ++t) { const int c = head * 64 + 16 * t + 4 * fg;
            const u32x2 yf = *(const u32x2*)(YF + tok * 512 + c), yb = *(const u32x2*)(YB + tok * 512 + c);
            y[t] = (f32x4){bflo(yf.x) + bflo(yb.x), bfhi(yf.x) + bfhi(yb.x), bflo(yf.y) + bflo(yb.y), bfhi(yf.y) + bfhi(yb.y)}; vw[t] = *(const u32x2*)(Ub + tok * 1920 + V_OFF + c); }
        const float bc = BC0[tok * 8 + head] + BC1[tok * 8 + head];
        f32x4 g[4];
#pragma unroll
        for (int t = 0; t < 4; ++t) { g[t] = (f32x4){0.f, 0.f, 0.f, 0.f};
#pragma unroll
            for (int ks = 0; ks < 4; ++ks) g[t] = MFMA16(ag[t][ks], bs[ks], g[t]); }
        float s = 0.f;
#pragma unroll
        for (int t = 0; t < 4; ++t) s += (y[t][0] + y[t][1]) + (y[t][2] + y[t][3]);
        const float mean = xsum_fg(s, fr, fg) * (1.0f / 64.0f);
        float q = 0.f;
#pragma unroll
        for (int t = 0; t < 4; ++t) { y[t] = y[t] - mean; q += (y[t][0] * y[t][0] + y[t][1] * y[t][1]) + (y[t][2] * y[t][2] + y[t][3] * y[t][3]); }
        const float rstd = frsq(xsum_fg(q, fr, fg) * (1.0f / 64.0f) + 64e-5f);
#pragma unroll
        for (int t = 0; t < 4; ++t) { const f32x4 vv = (f32x4){bflo(vw[t].x), bfhi(vw[t].x), bflo(vw[t].y), bfhi(vw[t].y)};
            const f32x4 o = (y[t] * rstd * lnw[t] + lnb[t] + vv * bc) * g[t];
            u32x2 w; w.x = cvt2(o[0], o[1]); w.y = cvt2(o[2], o[3]);
            *(u32x2*)(MIX + tok * DM + head * 64 + 16 * t + 4 * fg) = w; }
    }
}

#define XB_TMO      128
#define XB_XCNT(j)  (256  + 64 * (j))
#define XB_XSUB(j)  (1280 + 64 * (j))
#define XB_XGEN(j)  (2304 + 64 * (j))
#define XB_TOP      3328
#define XB_TOPGEN   3392
#define XCD_BAR_WORDS 3456
#define XB_SPIN_CAP (1u << 18)

__device__ __forceinline__ unsigned xb_ld(unsigned* p)              { return __hip_atomic_load(p, __ATOMIC_RELAXED, __HIP_MEMORY_SCOPE_AGENT); }
__device__ __forceinline__ unsigned xb_add(unsigned* p, unsigned v) { return __hip_atomic_fetch_add(p, v, __ATOMIC_RELAXED, __HIP_MEMORY_SCOPE_AGENT); }
__device__ __forceinline__ unsigned xb_xcc_id() { return (unsigned)__builtin_amdgcn_s_getreg((3 << 11) | 20) & 0xFu; }
#define XB_SPIN(cond, bar) do { unsigned _sp = 0; while (cond) { __builtin_amdgcn_s_sleep(1); \
    if ((++_sp & 255u) == 0u) { if (xb_ld(&(bar)[XB_TMO])) break; if (_sp > XB_SPIN_CAP) { atomicAdd(&(bar)[XB_TMO], 1u); break; } } } } while (0)

struct XcdBarrier {
    unsigned* bar; unsigned x;
    volatile LAS unsigned* st;
};

__device__ __forceinline__ XcdBarrier xcd_barrier_post(unsigned* bar, volatile LAS unsigned* st) {
    XcdBarrier b; b.bar = bar; b.x = xb_xcc_id(); b.st = st;
    if (threadIdx.x == 0) (void)xb_add(&bar[XB_XCNT(b.x)], 1u);
    return b;
}
__device__ __forceinline__ void xcd_barrier_complete(unsigned* bar, unsigned x, unsigned& nloc, unsigned& nx) {
    const unsigned G = gridDim.x * gridDim.y * gridDim.z;
    unsigned sum, cnt, mine, sp = 0u;
    for (;;) {
        sum = 0u; cnt = 0u; mine = 0u;
#pragma unroll
        for (unsigned j = 0; j < 16; ++j) { const unsigned c = xb_ld(&bar[XB_XCNT(j)]); sum += c; cnt += (c > 0u) ? 1u : 0u; mine = (j == x) ? c : mine; }
        if (sum == G) break;
        __builtin_amdgcn_s_sleep(1);
        if ((++sp & 255u) == 0u) { if (xb_ld(&bar[XB_TMO])) break; if (sp > XB_SPIN_CAP) { atomicAdd(&bar[XB_TMO], 1u); break; } }
    }
    nloc = mine > 0u ? mine : 1u; nx = cnt > 0u ? cnt : 1u;
}

__device__ __forceinline__ void xcd_barrier(const XcdBarrier& b) {
    asm volatile("s_waitcnt vmcnt(0)" ::: "memory");
    __syncthreads();
    if (threadIdx.x == 0) {
        unsigned* bar = b.bar;
        __builtin_amdgcn_s_waitcnt(0);
        unsigned nloc = b.st[0], nx = b.st[1];
        if (nloc == 0u) { xcd_barrier_complete(bar, b.x, nloc, nx); b.st[0] = nloc; b.st[1] = nx; }
        const unsigned old = xb_add(&bar[XB_XSUB(b.x)], 1u);
        const unsigned gen = old / nloc;
        if (old + 1u == (gen + 1u) * nloc) {
            __builtin_amdgcn_fence(__ATOMIC_RELEASE, "agent");
            asm volatile("s_waitcnt vmcnt(0)" ::: "memory");
            const unsigned og = xb_add(&bar[XB_TOP], 1u);
            const unsigned tg = og / nx;
            if (og + 1u == (tg + 1u) * nx) xb_add(&bar[XB_TOPGEN], 1u);
            else XB_SPIN(xb_ld(&bar[XB_TOPGEN]) == tg, bar);
            __builtin_amdgcn_fence(__ATOMIC_ACQUIRE, "agent");
            xb_add(&bar[XB_XGEN(b.x)], 1u);
            asm volatile("s_waitcnt vmcnt(0)" ::: "memory");
        } else {
            XB_SPIN(xb_ld(&bar[XB_XGEN(b.x)]) == gen, bar);
            __builtin_amdgcn_fence(__ATOMIC_ACQUIRE, "agent");
            asm volatile("s_waitcnt vmcnt(0)" ::: "memory");
        }
    }
    __syncthreads();
}

struct EpiAny {
    static constexpr bool AFTER_DRAIN = false;
    int mode; bool PERM; int l;
    __device__ __forceinline__ void operator()(const f32x4 (&acc)[2][2][4][2], const pg8::Unit& u, int wr, int wc, int fr, int fq) const {
        CKP* kp = (CKP*)__builtin_amdgcn_kernarg_segment_ptr(); asm volatile("" : "+s"(kp)); CKP& p = *kp;
        unsigned char* ws = p.ws;
        const float* mod = (const float*)(ws + WS_MOD) + (size_t)l * 5 * 6144;
        float* SSQ = (float*)(ws + WS_CTL + 262144);
        bf16* Hb = (bf16*)(ws + WS_H);
        if (mode == 7) {
#pragma unroll
            for (int a = 0; a < 2; ++a)
#pragma unroll
                for (int b = 0; b < 2; ++b)
#pragma unroll
                    for (int m = 0; m < 4; ++m)
#pragma unroll
                        for (int n = 0; n < 2; ++n) asm volatile("" :: "v"(acc[a][b][m][n]));
            return; }
        if (mode == 0) { const pg8::EpiBf<0> e{(bf16*)(ws + WS_PROJ), DINP}; e(acc, u, wr, wc, fr, fq); }
        else if (mode == 2) { const pg8::EpiRes e{p.out, mod + 5 * 1024, p.out, p.out + (size_t)NCTX * DM}; e(acc, u, wr, wc, fr, fq); }
        else if (mode == 3) { const pg8::EpiFnet e{(bf16*)(ws + WS_MIXED), 0, 256}; e(acc, u, wr, wc, fr, fq); }
        else if (mode == 8) { const pg8::EpiFnet e{(bf16*)(ws + WS_MIXED), NCTX, 1024}; e(acc, u, wr, wc, fr, fq); }
        else if (mode == 4) { const pg8::EpiNormBf<0> e{(bf16*)(ws + WS_PROJ), DINP, SSQ + 16384, (const float*)(ws + WS_SWIN), DINP}; e(acc, u, wr, wc, fr, fq); }
        else if (mode == 5) { const pg8::EpiNormBf<1> e{(bf16*)(ws + WS_FF), DFF, SSQ + l * 32768, (const float*)(ws + WS_SW1) + (size_t)l * 5 * DFF, DFF}; e(acc, u, wr, wc, fr, fq); }
        else if (mode == 6) { const pg8::EpiResNorm e{p.out, mod + 2 * 1024, l == 0 ? p.in[I_XP] : p.out, l == 0 ? p.in[I_XS] : p.out + (size_t)NCTX * DM, Hb, p.in[I_N2G] + l * DM, mod + 4 * 1024, SSQ + l * 32768}; e(acc, u, wr, wc, fr, fq); }
        else { const pg8::EpiResNorm e{p.out, mod + 5 * 1024, p.out, p.out + (size_t)NCTX * DM, Hb, p.in[I_N1G] + DM, mod + 5 * 6144 + 1 * 1024, SSQ + 16384}; e(acc, u, wr, wc, fr, fq); }
    }
};

constexpr int N_STEPS = 17;
__device__ __forceinline__ bool step_seam(int st) { return st < 16; }
__global__ void __launch_bounds__(NTHR, 2) mega_fwd(KP p_unused) {
    extern __shared__ __attribute__((aligned(16))) unsigned char lds_raw[];
    CKP* kp0 = (CKP*)__builtin_amdgcn_kernarg_segment_ptr();
    { LAS unsigned* ctlw = (LAS unsigned*)((LAS unsigned char*)lds_raw + RING_BYTES);
      for (int u = threadIdx.x; u < (LDS_BYTES - RING_BYTES) / 4; u += NTHR) ctlw[u] = 0u; }
    __syncthreads();
    const XcdBarrier bar = xcd_barrier_post((unsigned*)(kp0->ws + WS_CTL) + 4096, (volatile LAS unsigned*)((LAS unsigned char*)lds_raw + MISC_OFF + 32));
    const int ph_lo = kp0->ph_lo, ph_hi = kp0->ph_hi;
#pragma unroll 1
#ifdef REP_A
    for (int sti = ph_lo; sti < ph_hi + ((REP_B) >= 0 ? 2 : 1); ++sti) {
        const int st = sti <= (REP_A) ? sti : (((REP_B) < 0 || sti <= (REP_B) + 1) ? sti - 1 : sti - 2);
        const bool isdup = sti == (REP_A) || ((REP_B) >= 0 && sti == (REP_B) + 1); (void)isdup;
#else
    for (int st = ph_lo; st < ph_hi; ++st) {
#endif
        CKP* kp = kp0; asm volatile("" : "+s"(kp));
        CKP& p = *kp; unsigned char* ws = p.ws;
        int bid = blockIdx.x, nb = gridDim.x; unsigned ldsb = (unsigned)(size_t)(LAS unsigned char*)lds_raw;
        asm volatile("" : "+s"(bid), "+s"(nb), "+s"(ldsb));
        LAS unsigned char* lds = (LAS unsigned char*)(size_t)ldsb;
        const int l = st < 9 ? 0 : 1, s = st == 0 ? -1 : (st == 1 ? 0 : (st == 16 ? 8 : (st - 2) % 7 + 1));
        const float* mod = (const float*)(ws + WS_MOD) + (size_t)l * 5 * 6144;
#pragma unroll 1
        for (int job = 0; job < 2; ++job) {
            pg8::Gemm g{nullptr, nullptr, 0, 0, 0, 0, 0}; EpiAny E{-1, true, 0}; int corder = bid;
            if (job == 0) {
                if (s == 1) { g = pg8::Gemm{(const bf16*)(ws + WS_H), (const bf16*)(ws + WS_WIN) + (size_t)l * DINP * DM, MTOK, DINP, DM, DM, DM}; E = EpiAny{l == 0 ? 0 : 4, true, l}; }
                else if (s == 3) { g = pg8::Gemm{(const bf16*)(ws + WS_CS256), (const bf16*)(ws + WS_YCS), 256, 8192, 512, 512, 512}; E = EpiAny{3, true, l}; corder = (bid + nb - (nb >= 256 ? 192 : 0)) % nb; }
                else if (s == 5) { g = pg8::Gemm{(const bf16*)(ws + WS_MIXED), (const bf16*)(ws + WS_WOUT) + (size_t)l * DM * DM, MTOK, DM, DM, DM, DM}; E = EpiAny{6, true, l}; }
                else if (s == 6) { g = pg8::Gemm{(const bf16*)(ws + WS_H), (const bf16*)(ws + WS_W1) + (size_t)l * DFF * DM, MTOK, DFF, DM, DM, DM}; E = EpiAny{5, true, l}; }
                else if (s == 7) { g = pg8::Gemm{(const bf16*)(ws + WS_FF), (const bf16*)(ws + WS_W2) + (size_t)l * DM * DFF, MTOK, DM, DFF, DFF, DFF}; E = l == 0 ? EpiAny{9, true, l} : EpiAny{2, false, l}; }
            } else if (s == 3) { g = pg8::Gemm{(const bf16*)(ws + WS_CS1024), (const bf16*)(ws + WS_YCS) + (size_t)8192 * 512, 1024, 1024, 2048, 2048, 2048}; E = EpiAny{8, true, l}; corder = (bid + nb - (nb >= 256 ? 224 : 32)) % nb; }
#ifdef NOEPI_FIRST
            if (isdup && E.mode >= 0) E.mode = 7;
#endif
            if (E.mode >= 0) {
                pg8::StaticOrder S; S.init(g.M, g.N, nb, corder);
                pg8::gemm_phase<EpiAny, pg8::StaticOrder, true, true>(lds, g, S, E);
                __syncthreads();
            }
        }
        if (s == 3) {
            if (nb >= 256) {
                if (bid < 64) rwkv_item3(p, l, lds, bid);
                else { unsigned* ctr = (unsigned*)(ws + WS_CTL + 524288) + 64 * (2 + l); volatile LAS unsigned* slot = (volatile LAS unsigned*)(lds + RING_BYTES + 64);
#pragma unroll 1
                    for (;;) { __syncthreads(); if (threadIdx.x == 0) *slot = atomicAdd(ctr, 1u); __syncthreads(); const int it = (int)*slot; if (it >= 512) break; rwkv_item3(p, l, lds, 64 + it); } }
            } else for (int it = bid; it < 576; it += nb) rwkv_item3(p, l, lds, it);
            side_queue(p, l, lds);
        }
        if (s == -1) stage_prologue(p, lds, bid, nb);
        else if (s == 0) { stage_norm(p, 0, 0, bid, nb); stage_tables(p, bid, nb); }
        else if (s == 2) {
            stage_upass(p, l, bid, nb);
#pragma unroll 1
            for (int it = bid; it < 768; it += nb) fnet1_item(p, l, it);
#pragma unroll 1
            for (int it = bid; it < 768; it += nb) pool_item(p, l, lds, it);
        }
        else if (s == 4) stage_post(p, l, bid, nb);
        else if (s == 8) stage_final(p, bid, nb);
        #ifdef REP_A
        if (sti + 1 < ph_hi + ((REP_B) >= 0 ? 2 : 1)) xcd_barrier(bar);
#else
        if (st + 1 < ph_hi && step_seam(st)) xcd_barrier(bar);
#endif
    }
}

extern "C" void kernel_launch(void* const* d_in, const int* in_sizes, int n_in, void* d_out, int out_size, void* d_ws, size_t ws_size, hipStream_t stream) {
    static int grid = 0;
    if (grid == 0) {
        if (n_in != N_IN || ws_size < WS_END) { fprintf(stderr, "kernel_launch: unexpected inputs (n_in %d, ws %zu)\n", n_in, ws_size); grid = -1; return; }
        int dev = 0, cus = 0, per_cu = 0;
        (void)hipGetDevice(&dev); (void)hipDeviceGetAttribute(&cus, hipDeviceAttributeMultiprocessorCount, dev);
        (void)hipFuncSetAttribute((const void*)mega_fwd, hipFuncAttributeMaxDynamicSharedMemorySize, LDS_BYTES);
        if (hipOccupancyMaxActiveBlocksPerMultiprocessor(&per_cu, (const void*)mega_fwd, NTHR, LDS_BYTES) != hipSuccess || per_cu < 1) {
            fprintf(stderr, "kernel_launch: occupancy query reports %d blocks/CU\n", per_cu); (void)hipGetLastError(); grid = -1; return; }
        grid = cus * 1;
    }
    if (grid < 0) return;
    KP a{};
    for (int i = 0; i < N_IN; ++i) a.in[i] = (const float*)d_in[i];
    a.out = (float*)d_out; a.ws = (unsigned char*)d_ws; a.ph_lo = 0; a.ph_hi = N_STEPS;
    if (hipMemsetAsync((char*)d_ws + WS_CTL, 0, 1 * MiB, stream) != hipSuccess) { fprintf(stderr, "kernel_launch: memset failed\n"); return; }
    void* args[] = {&a};
    hipError_t e = hipLaunchCooperativeKernel((const void*)mega_fwd, dim3(grid), dim3(NTHR), args, LDS_BYTES, stream);
    if (e != hipSuccess) fprintf(stderr, "cooperative launch failed: %s (grid %d)\n", hipGetErrorString(e), grid);
}
```

```cpp
#include <hip/hip_runtime.h>
#include <hip/hip_cooperative_groups.h>
#include <cstdio>
#include <cstdint>
namespace cg = cooperative_groups;
__device__ __forceinline__ int opaque_tid() { int t = threadIdx.x; asm volatile("" : "+v"(t)); return t; }
namespace pg8 {
#define PG8_LAS __attribute__((address_space(3)))
typedef unsigned short bf16_t;
typedef short bf16x8 __attribute__((ext_vector_type(8)));
typedef float f32x4 __attribute__((ext_vector_type(4)));
typedef unsigned u32x4 __attribute__((ext_vector_type(4)));
constexpr int BM = 256, BK = 64, HALF = 128, HTB = HALF * BK * 2  , STAGE_BYTES = 8 * HTB, NXCD = 8, WGM = 8;

__host__ __device__ __forceinline__ int lds_byte(int r, int c) { const int st = (r >> 4) * 2 + (c >> 5), rr = r & 15, cc = c & 31, ob = rr * 64 + cc * 2; return st * 1024 + (ob ^ (((ob >> 9) & 1) << 5)); }
__host__ __device__ __forceinline__ void stage_rc(int b, int& R, int& C) { const int st = b / 1024, sb = b % 1024, swz = sb ^ (((sb >> 9) & 1) << 5); R = (st >> 1) * 16 + swz / 64; C = (st & 1) * 32 + (swz % 64) / 2; }
__host__ __device__ __forceinline__ int perm32(int rho) { const int n = rho >> 4, i = rho & 15; return 8 * (i >> 2) + 4 * n + (i & 3); }

struct Unit { int pm, pn; };
struct Gemm { const bf16_t* A; const bf16_t* Bt; int M, N, K, lda, ldb; };

struct StaticOrder {
    int nM, nN, nwg, G, c;
    __host__ __device__ void init(int M, int N, int G_, int c_) { nM = M / BM; nN = N / BM; nwg = nM * nN; G = G_; c = c_; }
    __host__ __device__ bool next(int i, Unit& u) const {
        const long L = (long)i * G + c; if (L >= nwg) return false;
        int wgid = (int)L; { const int q = nwg / NXCD, r = nwg % NXCD, xcd = wgid % NXCD, off = wgid / NXCD; wgid = (xcd < r ? xcd * (q + 1) : r * (q + 1) + (xcd - r) * q) + off; }
        const int nig = WGM * nN, gid = wgid / nig, fm = gid * WGM, gsz = (nM - fm) < WGM ? (nM - fm) : WGM;
        u.pm = fm + ((wgid % nig) % gsz); u.pn = (wgid % nig) / gsz; return true;
    }
    __device__ __forceinline__ void a_ready(const Unit&) const {}
    __device__ __forceinline__ void done(const Unit&) const {}
};

__device__ __forceinline__ unsigned cvt_pk_bf16(float lo, float hi) { unsigned r; asm volatile("v_cvt_pk_bf16_f32 %0, %1, %2" : "=v"(r) : "v"(lo), "v"(hi)); return r; }
typedef unsigned u32x2 __attribute__((ext_vector_type(2)));
template <int ACT  > struct EpiBf {
    static constexpr bool PERM = true, AFTER_DRAIN = false;
    bf16_t* O; int ldc;
    __device__ __forceinline__ void operator()(const f32x4 (&acc)[2][2][4][2], const Unit& u, int wr, int wc, int fr, int fq) const {
        const int row0 = u.pm * BM + wr * 64 + fr, col0 = u.pn * BM + wc * 32 + 8 * fq;
#pragma unroll
        for (int ai = 0; ai < 2; ++ai)
#pragma unroll
            for (int m = 0; m < 4; ++m) { bf16_t* rowp = O + (size_t)(row0 + ai * HALF + m * 16) * ldc + col0;
#pragma unroll
                for (int bj = 0; bj < 2; ++bj) { f32x4 v0 = acc[ai][bj][m][0], v1 = acc[ai][bj][m][1];
                    if (ACT == 1) {
#pragma unroll
                        for (int e = 0; e < 4; ++e) { float a = v0[e] > 0.f ? v0[e] : 0.f; v0[e] = a * a; float b = v1[e] > 0.f ? v1[e] : 0.f; v1[e] = b * b; } }
                    u32x4 w; w.x = cvt_pk_bf16(v0[0], v0[1]); w.y = cvt_pk_bf16(v0[2], v0[3]); w.z = cvt_pk_bf16(v1[0], v1[1]); w.w = cvt_pk_bf16(v1[2], v1[3]);
                    *(u32x4*)(rowp + bj * HALF) = w; } }
    }
};
struct EpiRes {
    static constexpr bool PERM = false, AFTER_DRAIN = false;
    float* X; const float* gate; const float* Xc; const float* Xl;
    __device__ __forceinline__ void operator()(const f32x4 (&acc)[2][2][4][2], const Unit& u, int wr, int wc, int fr, int fq) const {
        const int row0 = u.pm * BM + wr * 64 + fr, col0 = u.pn * BM + wc * 32 + 4 * fq;
        const int cond = u.pm < 32 ? 0 : 1 + ((u.pm - 32) >> 2);
        const float* gp = gate + cond * 6144 + col0;
        f32x4 gv[2][2];
#pragma unroll
        for (int bj = 0; bj < 2; ++bj)
#pragma unroll
            for (int n = 0; n < 2; ++n) gv[bj][n] = *(const f32x4*)(gp + bj * HALF + n * 16);
#pragma unroll
        for (int ai = 0; ai < 2; ++ai)
#pragma unroll
            for (int m = 0; m < 4; ++m) { const size_t ro = (size_t)(row0 + ai * HALF + m * 16) * 1024 + col0; float* rowp = X + ro; const float* srcp = u.pm < 32 ? Xc + ro : Xl + (ro - (size_t)8192 * 1024);
#pragma unroll
                for (int bj = 0; bj < 2; ++bj)
#pragma unroll
                    for (int n = 0; n < 2; ++n) { *(f32x4*)(rowp + bj * HALF + n * 16) = *(const f32x4*)(srcp + bj * HALF + n * 16) + gv[bj][n] * acc[ai][bj][m][n]; }
                if (m & 1) asm volatile("" ::: "memory"); }
    }
};
struct EpiFnet {
    static constexpr bool PERM = true, AFTER_DRAIN = false;
    bf16_t* MIX; int rowbase, L;
    __device__ __forceinline__ void operator()(const f32x4 (&acc)[2][2][4][2], const Unit& u, int wr, int wc, int fr, int fq) const {
        const int row0 = u.pm * BM + wr * 64 + fr, colw = wc * 32 + 8 * fq;
        bf16_t* base = MIX + (size_t)(rowbase + u.pn * L) * 1024 + 512 + colw;
#pragma unroll
        for (int ai = 0; ai < 2; ++ai)
#pragma unroll
            for (int m = 0; m < 4; ++m) { bf16_t* rowp = base + (size_t)(row0 + ai * HALF + m * 16) * 1024;
#pragma unroll
                for (int bj = 0; bj < 2; ++bj) { const f32x4 v0 = acc[ai][bj][m][0], v1 = acc[ai][bj][m][1];
                    u32x4 w; w.x = cvt_pk_bf16(v0[0], v0[1]); w.y = cvt_pk_bf16(v0[2], v0[3]); w.z = cvt_pk_bf16(v1[0], v1[1]); w.w = cvt_pk_bf16(v1[2], v1[3]);
                    *(u32x4*)(rowp + bj * HALF) = w; } }
    }
};

__device__ __forceinline__ float xsum_fq(float s, int fr, int fq) {
    s += __builtin_bit_cast(float, __builtin_amdgcn_ds_bpermute((((fq ^ 1) << 4) | fr) << 2, __builtin_bit_cast(int, s)));
    s += __builtin_bit_cast(float, __builtin_amdgcn_ds_bpermute((((fq ^ 2) << 4) | fr) << 2, __builtin_bit_cast(int, s)));
    return s;
}
template <int ACT> struct EpiNormBf {
    static constexpr bool PERM = true, AFTER_DRAIN = false;
    bf16_t* O; int ldc; const float* ssq; const float* sw; int swld;
    __device__ __forceinline__ void operator()(const f32x4 (&acc)[2][2][4][2], const Unit& u, int wr, int wc, int fr, int fq) const {
        const int row0 = u.pm * BM + wr * 64 + fr, col0 = u.pn * BM + wc * 32 + 8 * fq;
        const int cond = u.pm < 32 ? 0 : 1 + ((u.pm - 32) >> 2);
        f32x4 sv[2][2];
#pragma unroll
        for (int bj = 0; bj < 2; ++bj)
#pragma unroll
            for (int n = 0; n < 2; ++n) sv[bj][n] = *(const f32x4*)(sw + (size_t)cond * swld + col0 + bj * HALF + 4 * n);
        float rs[2][4];
#pragma unroll
        for (int ai = 0; ai < 2; ++ai)
#pragma unroll
            for (int m = 0; m < 4; ++m) rs[ai][m] = ssq[row0 + ai * HALF + m * 16];
#pragma unroll
        for (int ai = 0; ai < 2; ++ai)
#pragma unroll
            for (int m = 0; m < 4; ++m) rs[ai][m] = __builtin_amdgcn_rsqf(rs[ai][m] * (1.0f / 1024.0f) + 1e-6f);
#pragma unroll
        for (int ai = 0; ai < 2; ++ai)
#pragma unroll
            for (int m = 0; m < 4; ++m) { const int row = row0 + ai * HALF + m * 16; bf16_t* rowp = O + (size_t)row * ldc + col0;
                const float rstd = rs[ai][m];
#pragma unroll
                for (int bj = 0; bj < 2; ++bj) { f32x4 v0 = acc[ai][bj][m][0] * rstd + sv[bj][0], v1 = acc[ai][bj][m][1] * rstd + sv[bj][1];
                    if (ACT == 1) {
#pragma unroll
                        for (int e = 0; e < 4; ++e) { float a = v0[e] > 0.f ? v0[e] : 0.f; v0[e] = a * a; float b = v1[e] > 0.f ? v1[e] : 0.f; v1[e] = b * b; } }
                    u32x4 w; w.x = cvt_pk_bf16(v0[0], v0[1]); w.y = cvt_pk_bf16(v0[2], v0[3]); w.z = cvt_pk_bf16(v1[0], v1[1]); w.w = cvt_pk_bf16(v1[2], v1[3]);
                    *(u32x4*)(rowp + bj * HALF) = w; }
                if (m & 1) asm volatile("" ::: "memory"); }
    }
};
template <bool SRC_F32, bool WRITE_H> struct EpiResNorm {
    static constexpr bool PERM = true, AFTER_DRAIN = false;
    bf16_t* XB; const float* gate; const float* Xc; const float* Xl; bf16_t* H; const float* gn; const float* scl; float* ssq;
    __device__ __forceinline__ void operator()(const f32x4 (&acc)[2][2][4][2], const Unit& u, int wr, int wc, int fr, int fq) const {
        const int row0 = u.pm * BM + wr * 64 + fr, col0 = u.pn * BM + wc * 32 + 8 * fq;
        const int cond = u.pm < 32 ? 0 : 1 + ((u.pm - 32) >> 2);
        const float* src = u.pm < 32 ? Xc : Xl - (size_t)8192 * 1024;
        f32x4 gt[2][2], gs[2][2];
#pragma unroll
        for (int bj = 0; bj < 2; ++bj)
#pragma unroll
            for (int n = 0; n < 2; ++n) { const int col = col0 + bj * HALF + n * 4;
                gt[bj][n] = *(const f32x4*)(gate + cond * 6144 + col);
                if (WRITE_H) gs[bj][n] = *(const f32x4*)(gn + col) * (*(const f32x4*)(scl + cond * 6144 + col) + 1.0f); }
#pragma unroll
        for (int ai = 0; ai < 2; ++ai)
#pragma unroll
            for (int m = 0; m < 4; ++m) { const int row = row0 + ai * HALF + m * 16; const unsigned ro = (unsigned)row * 1024u + (unsigned)col0;
                float sq = 0.f;
#pragma unroll
                for (int bj = 0; bj < 2; ++bj) { const unsigned o = ro + bj * HALF;
                    f32x4 x0, x1;
                    if (SRC_F32) { x0 = *(const f32x4*)(src + o); x1 = *(const f32x4*)(src + o + 4); }
                    else { const u32x4 xw = *(const u32x4*)(XB + o);
                        x0 = (f32x4){__builtin_bit_cast(float, xw.x << 16), __builtin_bit_cast(float, xw.x & 0xffff0000u), __builtin_bit_cast(float, xw.y << 16), __builtin_bit_cast(float, xw.y & 0xffff0000u)};
                        x1 = (f32x4){__builtin_bit_cast(float, xw.z << 16), __builtin_bit_cast(float, xw.z & 0xffff0000u), __builtin_bit_cast(float, xw.w << 16), __builtin_bit_cast(float, xw.w & 0xffff0000u)}; }
                    x0 += gt[bj][0] * acc[ai][bj][m][0]; x1 += gt[bj][1] * acc[ai][bj][m][1];
                    u32x4 xo; xo.x = cvt_pk_bf16(x0[0], x0[1]); xo.y = cvt_pk_bf16(x0[2], x0[3]); xo.z = cvt_pk_bf16(x1[0], x1[1]); xo.w = cvt_pk_bf16(x1[2], x1[3]);
                    *(u32x4*)(XB + o) = xo;
                    sq += ((x0[0] * x0[0] + x0[1] * x0[1]) + (x0[2] * x0[2] + x0[3] * x0[3])) + ((x1[0] * x1[0] + x1[1] * x1[1]) + (x1[2] * x1[2] + x1[3] * x1[3]));
                    if (WRITE_H) { const f32x4 h0 = x0 * gs[bj][0], h1 = x1 * gs[bj][1];
                        u32x4 w; w.x = cvt_pk_bf16(h0[0], h0[1]); w.y = cvt_pk_bf16(h0[2], h0[3]); w.z = cvt_pk_bf16(h1[0], h1[1]); w.w = cvt_pk_bf16(h1[2], h1[3]);
                        *(u32x4*)(H + o) = w; } }
                const float t = xsum_fq(sq, fr, fq); if (fq == 0) atomicAdd(ssq + row, t);
                asm volatile("" ::: "memory"); }
    }
};
template <class Epi, class Sched, bool ALIGN_EPI = false, bool SP2 = false>
__device__ __forceinline__ void gemm_phase(PG8_LAS unsigned char* lds, const Gemm g, const Sched& S, const Epi& E) {
    const int tid = opaque_tid(), wid = __builtin_amdgcn_readfirstlane(tid >> 6), lane = tid & 63, wr = wid >> 2, wc = wid & 3, fr = lane & 15, fq = lane >> 4;
    const int K = g.K, nt = K / BK;
    unsigned voffA[2], voffB[2];
#pragma unroll
    for (int i = 0; i < 2; ++i) { int R, C; stage_rc(tid * 16 + i * 8192, R, C); const int Rb = E.PERM ? ((R & ~31) + perm32(R & 31)) : R;
        voffA[i] = (unsigned)(R * g.lda + C) * 2u; voffB[i] = (unsigned)(Rb * g.ldb + C) * 2u; }
    const size_t kstep = (size_t)(BK * 2);
    const size_t hstepA = (size_t)HALF * g.lda * 2, hstepB = (size_t)HALF * g.ldb * 2;
    const size_t tstepA = 2 * hstepA, tstepB = 2 * hstepB;
    const unsigned ldsw = (unsigned)wid * 1024u;
    const int aoff = lds_byte(wr * 64 + fr, fq * 8), boff = lds_byte(wc * 32 + fr, fq * 8);
#define PG8_SA(b, h) (((b) * 2 + (h)) * HTB)
#define PG8_SB(b, h) ((4 + (b) * 2 + (h)) * HTB)
#define PG8_STAGE(bufoff, gbase, voff) do { _Pragma("unroll") for (int _i = 0; _i < 2; ++_i) \
        __builtin_amdgcn_global_load_lds((const unsigned*)((const char*)(gbase) + (voff)[_i]), (PG8_LAS unsigned*)(lds + (bufoff) + ldsw + _i * 8192), 16, 0, 0); } while (0)
#define PG8_LDA(dst, b, h) do { _Pragma("unroll") for (int m = 0; m < 4; ++m) _Pragma("unroll") for (int k = 0; k < 2; ++k) dst[m][k] = *(const PG8_LAS bf16x8*)(lds + PG8_SA(b, h) + aoff + m * 2048 + k * 1024); } while (0)
#define PG8_LDB(dst, b, h) do { _Pragma("unroll") for (int n = 0; n < 2; ++n) _Pragma("unroll") for (int k = 0; k < 2; ++k) dst[n][k] = *(const PG8_LAS bf16x8*)(lds + PG8_SB(b, h) + boff + n * 2048 + k * 1024); } while (0)
#define PG8_MMA(ai, bj, At, Bt) do { __builtin_amdgcn_s_setprio(1); _Pragma("unroll") for (int m = 0; m < 4; ++m) _Pragma("unroll") for (int n = 0; n < 2; ++n) _Pragma("unroll") for (int k = 0; k < 2; ++k) \
        acc[ai][bj][m][n] = __builtin_amdgcn_mfma_f32_16x16x32_bf16(Bt[n][k], At[m][k], acc[ai][bj][m][n], 0, 0, 0); __builtin_amdgcn_s_setprio(0); } while (0)
#define PG8_WAIT_V(n) asm volatile("s_waitcnt vmcnt(" #n ")" ::: "memory")
#define PG8_WAIT_L(n) asm volatile("s_waitcnt lgkmcnt(" #n ")" ::: "memory")
#define PG8_BAR __builtin_amdgcn_s_barrier()
#define PG8_SCHED __builtin_amdgcn_sched_barrier(0)
    Unit cur, nxt; int ui = 0;
    if (!S.next(0, cur)) return;
    f32x4 acc[2][2][4][2];
#pragma unroll
    for (int a = 0; a < 2; ++a)
#pragma unroll
        for (int b = 0; b < 2; ++b)
#pragma unroll
            for (int m = 0; m < 4; ++m)
#pragma unroll
                for (int n = 0; n < 2; ++n) acc[a][b][m][n] = (f32x4){0.f, 0.f, 0.f, 0.f};
    bf16x8 At[4][2], B0[2][2], B1[2][2];
    const char* cA = (const char*)g.A + (size_t)cur.pm * tstepA; const char* cB = (const char*)g.Bt + (size_t)cur.pn * tstepB;
    S.a_ready(cur);
    if constexpr (SP2) {
        PG8_STAGE(PG8_SB(0, 0), cB, voffB); PG8_STAGE(PG8_SB(0, 1), cB + hstepB, voffB); PG8_STAGE(PG8_SA(0, 0), cA, voffA); PG8_STAGE(PG8_SA(0, 1), cA + hstepA, voffA);
        if (wr == 1) PG8_BAR;
        PG8_WAIT_V(2); PG8_BAR;
        PG8_STAGE(PG8_SB(1, 0), cB + kstep, voffB); PG8_STAGE(PG8_SA(1, 0), cA + kstep, voffA); PG8_STAGE(PG8_SB(1, 1), cB + hstepB + kstep, voffB);
        PG8_WAIT_V(6); PG8_BAR;
    } else {
        PG8_STAGE(PG8_SB(0, 0), cB, voffB); PG8_STAGE(PG8_SA(0, 0), cA, voffA); PG8_STAGE(PG8_SB(0, 1), cB + hstepB, voffB); PG8_STAGE(PG8_SA(0, 1), cA + hstepA, voffA);
        if (wr == 1) PG8_BAR;
        PG8_WAIT_V(4); PG8_BAR;
        PG8_STAGE(PG8_SB(1, 0), cB + kstep, voffB); PG8_STAGE(PG8_SA(1, 0), cA + kstep, voffA); PG8_STAGE(PG8_SB(1, 1), cB + hstepB + kstep, voffB);
        PG8_WAIT_V(6); PG8_BAR;
    }
    for (;;) {
        const bool has_next = S.next(ui + 1, nxt);
        const char* nA = has_next ? (const char*)g.A + (size_t)nxt.pm * tstepA : cA; const char* nB = has_next ? (const char*)g.Bt + (size_t)nxt.pn * tstepB : cB;
        for (int t = 0; t < nt; t += 2) {
            const bool last = (t == nt - 2);
            const char* a1 = cA + (size_t)(t + 1) * kstep;
            const char* a2 = last ? nA : cA + (size_t)(t + 2) * kstep; const char* b2 = last ? nB : cB + (size_t)(t + 2) * kstep;
            const char* a3 = a2 + kstep; const char* b3 = b2 + kstep;
            if (last && has_next) S.a_ready(nxt);
            if constexpr (SP2) {
            PG8_LDB(B0, 0, 0); PG8_LDB(B1, 0, 1); PG8_SCHED; PG8_LDA(At, 0, 0); PG8_STAGE(PG8_SA(1, 1), a1 + hstepA, voffA);
            PG8_WAIT_V(8); PG8_WAIT_L(0); PG8_BAR; PG8_MMA(0, 0, At, B0); PG8_MMA(0, 1, At, B1); PG8_BAR; PG8_SCHED;
            PG8_LDA(At, 0, 1); PG8_STAGE(PG8_SB(0, 0), b2, voffB); PG8_STAGE(PG8_SB(0, 1), b2 + hstepB, voffB); PG8_STAGE(PG8_SA(0, 0), a2, voffA);
            PG8_WAIT_V(8); PG8_WAIT_L(0); PG8_BAR; PG8_MMA(1, 0, At, B0); PG8_MMA(1, 1, At, B1); PG8_BAR; PG8_SCHED;
            PG8_LDB(B0, 1, 0); PG8_LDB(B1, 1, 1); PG8_SCHED; PG8_LDA(At, 1, 0); PG8_STAGE(PG8_SA(0, 1), a2 + hstepA, voffA);
            PG8_WAIT_V(8); PG8_WAIT_L(0); PG8_BAR; PG8_MMA(0, 0, At, B0); PG8_MMA(0, 1, At, B1); PG8_BAR; PG8_SCHED;
            PG8_LDA(At, 1, 1); PG8_STAGE(PG8_SB(1, 0), b3, voffB); PG8_STAGE(PG8_SB(1, 1), b3 + hstepB, voffB); PG8_STAGE(PG8_SA(1, 0), a3, voffA);
            PG8_WAIT_V(8); PG8_WAIT_L(0); PG8_BAR; PG8_MMA(1, 0, At, B0); PG8_MMA(1, 1, At, B1); PG8_BAR; PG8_SCHED;
            } else {
            PG8_LDB(B0, 0, 0); PG8_SCHED; PG8_LDA(At, 0, 0); PG8_STAGE(PG8_SA(1, 1), a1 + hstepA, voffA);
            PG8_WAIT_L(8); PG8_BAR; PG8_WAIT_L(0); PG8_MMA(0, 0, At, B0); PG8_BAR; PG8_SCHED;
            PG8_LDB(B1, 0, 1); PG8_STAGE(PG8_SB(0, 0), b2, voffB);
            PG8_BAR; PG8_WAIT_L(0); PG8_MMA(0, 1, At, B1); PG8_BAR;
            PG8_LDA(At, 0, 1); PG8_STAGE(PG8_SA(0, 0), a2, voffA);
            PG8_BAR; PG8_WAIT_L(0); PG8_MMA(1, 0, At, B0); PG8_BAR; PG8_SCHED;
            PG8_STAGE(PG8_SB(0, 1), b2 + hstepB, voffB);
            PG8_WAIT_V(6); PG8_BAR; PG8_MMA(1, 1, At, B1); PG8_BAR;
            PG8_LDB(B0, 1, 0); PG8_SCHED; PG8_LDA(At, 1, 0); PG8_STAGE(PG8_SA(0, 1), a2 + hstepA, voffA);
            PG8_WAIT_L(8); PG8_BAR; PG8_WAIT_L(0); PG8_MMA(0, 0, At, B0); PG8_BAR; PG8_SCHED;
            PG8_LDB(B1, 1, 1); PG8_STAGE(PG8_SB(1, 0), b3, voffB);
            PG8_BAR; PG8_WAIT_L(0); PG8_MMA(0, 1, At, B1); PG8_BAR;
            PG8_LDA(At, 1, 1); PG8_STAGE(PG8_SA(1, 0), a3, voffA);
            PG8_BAR; PG8_WAIT_L(0); PG8_MMA(1, 0, At, B0); PG8_BAR; PG8_SCHED;
            PG8_STAGE(PG8_SB(1, 1), b3 + hstepB, voffB);
            PG8_WAIT_V(6); PG8_BAR; PG8_MMA(1, 1, At, B1); PG8_BAR;
            }
        }
        if constexpr (ALIGN_EPI) { if (wr == 0) PG8_BAR; }
        if constexpr (!Epi::AFTER_DRAIN) { int fr2 = fr, fq2 = fq; asm volatile("" : "+v"(fr2), "+v"(fq2)); E(acc, cur, wr, wc, fr2, fq2); S.done(cur); }
        if (!has_next) break;
#pragma unroll
        for (int a = 0; a < 2; ++a)
#pragma unroll
            for (int b = 0; b < 2; ++b)
#pragma unroll
                for (int m = 0; m < 4; ++m)
#pragma unroll
                    for (int n = 0; n < 2; ++n) acc[a][b][m][n] = (f32x4){0.f, 0.f, 0.f, 0.f};
        cur = nxt; cA = nA; cB = nB; ++ui;
        if constexpr (ALIGN_EPI) { if (wr == 1) PG8_BAR; }
    }
    PG8_WAIT_V(0);
    if constexpr (!ALIGN_EPI) { if (wr == 0) PG8_BAR; }
    PG8_BAR;
    if constexpr (Epi::AFTER_DRAIN) { E.fused(acc, cur, wr, wc, fr, fq, lds, wid, lane); S.done(cur); }
#undef PG8_SA
#undef PG8_SB
#undef PG8_STAGE
#undef PG8_LDA
#undef PG8_LDB
#undef PG8_MMA
#undef PG8_WAIT_V
#undef PG8_WAIT_L
#undef PG8_BAR
#undef PG8_SCHED
}
}

#define LAS __attribute__((address_space(3)))
typedef unsigned short bf16;
typedef float f32x4 __attribute__((ext_vector_type(4)));
typedef unsigned u32x4 __attribute__((ext_vector_type(4)));
typedef unsigned u32x2 __attribute__((ext_vector_type(2)));
constexpr int DM = 1024, NCTX = 8192, MTOK = 12288, DINP = 2560, DFF = 4096;
constexpr int R_OFF = 0, K_OFF = 512, V_OFF = 1024, WD_OFF = 1536, AD_OFF = 1664, GD_OFF = 1792, F_OFF = 1920, P_OFF = 2176, DIN = 2432;
constexpr size_t MiB = 1u << 20;
constexpr size_t WS_CTL = 0, WS_MOD = 1 * MiB, WS_FW = 1 * MiB + 512 * 1024, WS_BC = 2 * MiB, WS_CS256 = 3 * MiB, WS_CS1024 = 4 * MiB, WS_WIN = 8 * MiB, WS_WOUT = 18 * MiB,
                 WS_W1 = 22 * MiB, WS_W2 = 38 * MiB, WS_H = 54 * MiB, WS_MIXED = 78 * MiB, WS_PROJ = 102 * MiB, WS_YCS = 162 * MiB, WS_YF = 102 * MiB, WS_YB = 126 * MiB  , WS_U = 174 * MiB, WS_KINV = 220 * MiB, WS_GUPT = 221 * MiB,
                 WS_FF = 102 * MiB, WS_WUPT = 222 * MiB, WS_AUPT = 222 * MiB + 256 * 1024, WS_SSQ = 223 * MiB, WS_WPT = 223 * MiB + 512 * 1024, WS_SW1 = 224 * MiB, WS_SWIN = 224 * MiB + 256 * 1024, WS_XB = 226 * MiB, WS_END = 250 * MiB;
constexpr int LDS_BYTES = 147456, RING_BYTES = 131072, MISC_OFF = RING_BYTES + 320;
constexpr int NTHR = 512;
enum { I_XP = 0, I_XS, I_STATE, I_C, I_CCTX, I_WADA, I_BADA, I_N1G, I_WIN, I_MU, I_W0, I_WUP, I_A0, I_AUP, I_GUP, I_KK, I_KA, I_RK, I_LNW, I_LNB, I_WFNET, I_WPOOL, I_PSCALE, I_WOUT, I_N2G, I_WFF1, I_WFF2, I_FNG, N_IN };
struct KP { const float* in[N_IN]; float* out; unsigned char* ws; int ph_lo, ph_hi; };
typedef const __attribute__((address_space(4))) KP CKP;

__device__ __forceinline__ unsigned f2bf(float f) { unsigned u = __builtin_bit_cast(unsigned, f); return (u + 0x7fffu + ((u >> 16) & 1u)) >> 16; }
__device__ __forceinline__ unsigned pk2(float lo, float hi) { return f2bf(lo) | (f2bf(hi) << 16); }
__device__ __forceinline__ float bflo(unsigned w) { return __builtin_bit_cast(float, w << 16); }
__device__ __forceinline__ float bfhi(unsigned w) { return __builtin_bit_cast(float, w & 0xffff0000u); }
__device__ __forceinline__ float bf1(bf16 h) { return __builtin_bit_cast(float, (unsigned)h << 16); }
__device__ __forceinline__ float fexp(float x) { return __builtin_amdgcn_exp2f(x * 1.4426950408889634f); }
__device__ __forceinline__ float flog(float x) { return __builtin_amdgcn_logf(x) * 0.6931471805599453f; }
__device__ __forceinline__ float frcp(float x) { return __builtin_amdgcn_rcpf(x); }
__device__ __forceinline__ float frsq(float x) { return __builtin_amdgcn_rsqf(x); }
__device__ __forceinline__ float fsigmoid(float x) { return frcp(1.0f + fexp(-x)); }
template <int CTRL> __device__ __forceinline__ float dppf(float x) { return __builtin_bit_cast(float, __builtin_amdgcn_update_dpp(0, __builtin_bit_cast(int, x), CTRL, 0xF, 0xF, true)); }
__device__ __forceinline__ float red8(float x)  { x += dppf<0xB1>(x); x += dppf<0x4E>(x); x += dppf<0x141>(x); return x; }
__device__ __forceinline__ float red16(float x) { x += dppf<0xB1>(x); x += dppf<0x4E>(x); x += dppf<0x141>(x); x += dppf<0x140>(x); return x; }
__device__ __forceinline__ float wave_sum(float v) {
    v = red16(v);
    const float s0 = __builtin_bit_cast(float, __builtin_amdgcn_readlane(__builtin_bit_cast(int, v), 0)), s1 = __builtin_bit_cast(float, __builtin_amdgcn_readlane(__builtin_bit_cast(int, v), 16));
    const float s2 = __builtin_bit_cast(float, __builtin_amdgcn_readlane(__builtin_bit_cast(int, v), 32)), s3 = __builtin_bit_cast(float, __builtin_amdgcn_readlane(__builtin_bit_cast(int, v), 48));
    return (s0 + s1) + (s2 + s3);
}
__device__ __forceinline__ void load4bf(const bf16* p, float (&o)[4]) { const u32x2 w = *(const u32x2*)p; o[0] = bflo(w.x); o[1] = bfhi(w.x); o[2] = bflo(w.y); o[3] = bfhi(w.y); }
__device__ __forceinline__ void load8bf(const bf16* p, float (&o)[8]) { const u32x4 w = *(const u32x4*)p; o[0] = bflo(w.x); o[1] = bfhi(w.x); o[2] = bflo(w.y); o[3] = bfhi(w.y); o[4] = bflo(w.z); o[5] = bfhi(w.z); o[6] = bflo(w.w); o[7] = bfhi(w.w); }
__device__ __forceinline__ void shift4(const bf16* proj, int row, bool hasp, bool hasn, int col, const float* mu, float (&u)[4]) {
    float p[4], a[4] = {0.f, 0.f, 0.f, 0.f}, b[4] = {0.f, 0.f, 0.f, 0.f};
    load4bf(proj + (size_t)row * DINP + col, p);
    if (hasp) load4bf(proj + (size_t)(row - 1) * DINP + col, a);
    if (hasn) load4bf(proj + (size_t)(row + 1) * DINP + col, b);
    const f32x4 m = *(const f32x4*)(mu + col);
#pragma unroll
    for (int j = 0; j < 4; ++j) u[j] = p[j] + m[j] * (0.5f * (a[j] + b[j]) - p[j]);
}

__device__ __forceinline__ void transpose_item(const float* W, int K, int N, bf16* WT, LAS float* scr, int item, int lane) {
    const int nblk = N / 32, kb = item / nblk, nb = item % nblk, k0 = 64 * kb, n0 = 32 * nb;
#pragma unroll 8
    for (int i = 0; i < 32; ++i) { const int kk = 2 * i + (lane >> 5); scr[kk * 33 + (lane & 31)] = W[(size_t)(k0 + kk) * N + n0 + (lane & 31)]; }
    asm volatile("s_waitcnt lgkmcnt(0)" ::: "memory");
    const int c = lane & 7;
#pragma unroll
    for (int j = 0; j < 4; ++j) { const int n = (lane >> 3) + 8 * j; const LAS float* s = scr + (8 * c) * 33 + n;
        u32x4 o; o.x = pk2(s[0 * 33], s[1 * 33]); o.y = pk2(s[2 * 33], s[3 * 33]); o.z = pk2(s[4 * 33], s[5 * 33]); o.w = pk2(s[6 * 33], s[7 * 33]);
        *(u32x4*)(WT + (size_t)(n0 + n) * K + k0 + 8 * c) = o; }
    asm volatile("s_waitcnt lgkmcnt(0)" ::: "memory");
}
__device__ __forceinline__ void gemv5_cols(LAS float* sc, LAS float* red, const float* W, int ldw, int colw, const float* bias, float* out, int ldo, int colo, int tid) {
    const int cgi = tid & 15, kg = tid >> 4;
    f32x4 acc[5];
#pragma unroll
    for (int c = 0; c < 5; ++c) acc[c] = (f32x4){0.f, 0.f, 0.f, 0.f};
    const float* wp = W + (size_t)(kg * 32) * ldw + colw + cgi * 4;
#pragma unroll 8
    for (int kk = 0; kk < 32; ++kk) { const f32x4 w = *(const f32x4*)(wp + (size_t)kk * ldw);
#pragma unroll
        for (int c = 0; c < 5; ++c) acc[c] += sc[c * 1024 + kg * 32 + kk] * w; }
#pragma unroll
    for (int c = 0; c < 5; ++c) *(LAS f32x4*)(red + (kg * 5 + c) * 64 + cgi * 4) = acc[c];
    __syncthreads();
    if (tid < 320) { const int cond = tid >> 6, col = tid & 63; float sm = bias ? bias[colo + col] : 0.f;
        for (int g = 0; g < 32; ++g) sm += red[(g * 5 + cond) * 64 + col];
        out[(size_t)cond * ldo + colo + col] = sm; }
    __syncthreads();
}
__device__ __forceinline__ void mod_item(CKP& p, LAS unsigned char* lds, int it) {
    const int tid = opaque_tid(); unsigned char* ws = p.ws;
    LAS float* sc = (LAS float*)lds; LAS float* red = (LAS float*)(lds + 20480);
    const int l = it / 96, cgp = it % 96;
    for (int i = tid; i < 5 * 1024; i += NTHR) { const int cond = i >> 10, k = i & 1023; const float v = cond == 0 ? p.in[I_CCTX][k] : p.in[I_C][(cond - 1) * 1024 + k]; sc[i] = v * fsigmoid(v); }
    __syncthreads();
    gemv5_cols(sc, red, p.in[I_WADA] + (size_t)l * 1024 * 6144, 6144, cgp * 64, p.in[I_BADA] + l * 6144, (float*)(ws + WS_MOD) + (size_t)l * 5 * 6144, 6144, cgp * 64, tid);
}
constexpr int TI_IN = 16 * 76, TI_OUT = 16 * 32, TI_1 = 16 * 128, TI_2 = 64 * 32, TI_L = TI_IN + TI_OUT + TI_1 + TI_2;
__device__ __forceinline__ void transpose_range(CKP& p, LAS unsigned char* lds, int first, int last, int bid, int nb) {
    const int tid = opaque_tid(), lane = tid & 63, wave = tid >> 6;
    unsigned char* ws = p.ws;
    LAS float* scr = (LAS float*)(lds + wave * 16384);
#pragma unroll 1
    for (int it = first + bid * 8 + wave; it < last; it += nb * 8) {
        const int l = it / TI_L; int r = it % TI_L;
        if (r < TI_IN) { transpose_item(p.in[I_WIN] + (size_t)l * DM * DIN, DM, DIN, (bf16*)(ws + WS_WIN) + (size_t)l * DINP * DM, scr, r, lane); continue; } r -= TI_IN;
        if (r < TI_OUT) { transpose_item(p.in[I_WOUT] + (size_t)l * DM * DM, DM, DM, (bf16*)(ws + WS_WOUT) + (size_t)l * DM * DM, scr, r, lane); continue; } r -= TI_OUT;
        if (r < TI_1) { transpose_item(p.in[I_WFF1] + (size_t)l * DM * DFF, DM, DFF, (bf16*)(ws + WS_W1) + (size_t)l * DFF * DM, scr, r, lane); continue; } r -= TI_1;
        transpose_item(p.in[I_WFF2] + (size_t)l * DFF * DM, DFF, DM, (bf16*)(ws + WS_W2) + (size_t)l * DM * DFF, scr, r, lane);
    }
}
__device__ __forceinline__ void stage_prologue(CKP& p, LAS unsigned char* lds, int bid, int nb) {
    const int tid = opaque_tid();
    unsigned char* ws = p.ws;
    transpose_range(p, lds, 0, TI_IN, bid, nb);
    const int gt = bid * NTHR + tid, NGT = nb * NTHR;
#pragma unroll 1
    for (int i = gt; i < 2 * 128 * DM / 8; i += NGT) { const int l = i / (128 * DM / 8), r = i % (128 * DM / 8);
        u32x4 z = (u32x4){0u, 0u, 0u, 0u}; asm volatile("" : "+v"(z));
        *(u32x4*)((bf16*)(ws + WS_WIN) + (size_t)l * DINP * DM + (size_t)DIN * DM + (size_t)r * 8) = z; }
    __syncthreads();
#pragma unroll 1
    for (int it = bid; it < 192; it += nb) mod_item(p, lds, it);
}
__device__ __forceinline__ void stage_tables(CKP& p, int bid, int nb) {
    const int tid = opaque_tid(); unsigned char* ws = p.ws;
    const int gt = bid * NTHR + tid, NGT = nb * NTHR;
#pragma unroll 1
    for (int i = gt; i < 256 * 512 + 1024 * 2048; i += NGT) {
        int L, k, j; bf16* dst;
        if (i < 256 * 512) { L = 256; k = i / 512; j = i % 512; dst = (bf16*)(ws + WS_CS256) + i; }
        else { const int i2 = i - 256 * 512; L = 1024; k = i2 / 2048; j = i2 % 2048; dst = (bf16*)(ws + WS_CS1024) + i2; }
        const int jj = j >= L ? j - L : j; const int idx = (k * jj) & (L - 1);
        const float rev = (float)idx * (L == 256 ? (1.0f / 256.0f) : (1.0f / 1024.0f));
        *dst = (bf16)f2bf(j >= L ? -__builtin_amdgcn_sinf(rev) : __builtin_amdgcn_cosf(rev));
    }
#pragma unroll 1
    for (int i = gt; i < 2 * 4 * 64 * 128; i += NGT) {
        const int o = i & 127, c = (i >> 7) & 63, lg = i >> 13; const float* wf = p.in[I_WFNET] + (size_t)lg * 4096 + (o & 63);
        float acc = 0.f;
        if (o < 64) { for (int cp = 0; cp < 64; ++cp) acc += __builtin_amdgcn_cosf((float)((c * cp) & 63) * (1.0f / 64.0f)) * wf[cp * 64]; }
        else { for (int cp = 0; cp < 64; ++cp) acc += __builtin_amdgcn_sinf((float)((c * cp) & 63) * (1.0f / 64.0f)) * wf[cp * 64]; }
        ((bf16*)(ws + WS_FW))[(size_t)(lg * 128 + o) * 64 + c] = (bf16)f2bf(acc);
    }
#pragma unroll 1
    for (int i = gt; i < 2 * 4 * 64 * 64; i += NGT) { const int o = i & 63, c = (i >> 6) & 63, lg = i >> 12;
        ((bf16*)(ws + WS_WPT))[(size_t)(lg * 64 + o) * 64 + c] = (bf16)f2bf(p.in[I_WPOOL][i]); }
#pragma unroll 1
    for (int i = gt; i < 2 * 2 * 64 * 512; i += NGT) { const int c = i & 511, r = (i >> 9) & 63, ld = i >> 15;
        ((bf16*)(ws + WS_WUPT))[(size_t)(ld * 512 + c) * 64 + r] = (bf16)f2bf(p.in[I_WUP][i]);
        ((bf16*)(ws + WS_AUPT))[(size_t)(ld * 512 + c) * 64 + r] = (bf16)f2bf(p.in[I_AUP][i]); }
#pragma unroll 1
    for (int i = gt; i < 2 * 128 * 512; i += NGT) { const int c = i & 511, r = (i >> 9) & 127, ll = i >> 16;
        ((bf16*)(ws + WS_GUPT))[(size_t)(ll * 512 + c) * 128 + r] = (bf16)f2bf(p.in[I_GUP][i]); }
}
__device__ __forceinline__ void shiftw_item(CKP& p, LAS unsigned char* lds, int it) {
    const int tid = opaque_tid();
    unsigned char* ws = p.ws;
    LAS float* sc = (LAS float*)lds; LAS float* red = (LAS float*)(lds + 20480);
    const bool isin = it >= 128; const int l = isin ? 1 : it >> 6, blk = isin ? it - 128 : it & 63;
    const float* shv = (const float*)(ws + WS_MOD) + (size_t)l * 5 * 6144 + (isin ? 0 : 3 * 1024);
    for (int i = tid; i < 5 * 1024; i += NTHR) sc[i] = shv[(i >> 10) * 6144 + (i & 1023)];
    __syncthreads();
    if (isin) gemv5_cols(sc, red, p.in[I_WIN] + (size_t)DM * DIN, DIN, blk * 64, nullptr, (float*)(ws + WS_SWIN), DINP, blk * 64, tid);
    else gemv5_cols(sc, red, p.in[I_WFF1] + (size_t)l * DM * DFF, DFF, blk * 64, nullptr, (float*)(ws + WS_SW1) + (size_t)l * 5 * DFF, DFF, blk * 64, tid);
    if (it == 165) for (int i = tid; i < 5 * 128; i += NTHR) ((float*)(ws + WS_SWIN))[(i >> 7) * DINP + DIN + (i & 127)] = 0.f;
}
__device__ __forceinline__ void side_queue(CKP& p, int l, LAS unsigned char* lds) {
    const int tid = opaque_tid();
    unsigned* ctr = (unsigned*)(p.ws + WS_CTL + 524288) + 64 * l;
    volatile LAS unsigned* slot = (volatile LAS unsigned*)(lds + RING_BYTES + 64);
    const int nmd = 0, nsh = l == 0 ? 166 : 0, first = l == 0 ? TI_IN : TI_L + TI_IN, nch = ((l == 0 ? TI_L + TI_IN : 2 * TI_L) - first) / 8;
    __syncthreads();
#pragma unroll 1
    for (;;) {
        if (tid == 0) *slot = atomicAdd(ctr, 1u);
        __syncthreads();
        const int it = (int)*slot;
        __syncthreads();
        if (it >= nmd + nsh + nch) break;
        if (it < nmd) mod_item(p, lds, 96 + it);
        else if (it < nmd + nsh) shiftw_item(p, lds, it - nmd);
        else { const int c0 = first + 8 * (it - nmd - nsh); transpose_range(p, lds, c0, c0 + 8, 0, 1); }
        __syncthreads();
    }
}

__device__ __forceinline__ void stage_norm(CKP& p, int l, int which, int bid, int nb) {
    const int tid = opaque_tid(), lane = tid & 63, wave = tid >> 6;
    const float* g = p.in[which ? I_N2G : I_N1G] + l * DM;
    const float* mod = (const float*)(p.ws + WS_MOD) + (size_t)l * 5 * 6144 + (which ? 3 * 1024 : 0);
    bf16* H = (bf16*)(p.ws + WS_H);
#pragma unroll 1
    for (int row0 = bid * 8 + wave; row0 < MTOK; row0 += nb * 16) {
        f32x4 v[2][4]; float s[2];
#pragma unroll
        for (int z = 0; z < 2; ++z) { const int row = min(row0 + z * nb * 8, MTOK - 1);
            const float* xsrc = (l == 0 && which == 0) ? (row < NCTX ? p.in[I_XP] + (size_t)row * DM : p.in[I_XS] + (size_t)(row - NCTX) * DM) : p.out + (size_t)row * DM;
            const f32x4* xr = (const f32x4*)xsrc + lane;
#pragma unroll
            for (int j = 0; j < 4; ++j) v[z][j] = xr[64 * j]; }
#pragma unroll
        for (int z = 0; z < 2; ++z) { const int row = row0 + z * nb * 8;
            s[z] = 0.f;
#pragma unroll
            for (int j = 0; j < 4; ++j) s[z] += (v[z][j].x * v[z][j].x + v[z][j].y * v[z][j].y) + (v[z][j].z * v[z][j].z + v[z][j].w * v[z][j].w);
            const float rstd = frsq(wave_sum(s[z]) * (1.0f / DM) + 1e-6f);
            if (row < MTOK) {
                const int cond = row < NCTX ? 0 : 1 + ((row - NCTX) >> 10);
                const float* sh = mod + cond * 6144; const float* scl = sh + 1024;
                unsigned long long* o8 = (unsigned long long*)(H + (size_t)row * DM) + lane;
#pragma unroll
                for (int j = 0; j < 4; ++j) { const int col = 4 * lane + 256 * j; const f32x4 gg = *(const f32x4*)(g + col), a = *(const f32x4*)(sh + col), b = *(const f32x4*)(scl + col);
                    const f32x4 y = v[z][j] * rstd * gg * (b + 1.0f) + a;
                    o8[64 * j] = (unsigned long long)pk2(y.x, y.y) | ((unsigned long long)pk2(y.z, y.w) << 32); } } }
    }
}
__device__ __forceinline__ void stage_final(CKP& p, int bid, int nb) {
    const int tid = opaque_tid(), lane = tid & 63, wave = tid >> 6;
    const float* g = p.in[I_FNG];
    const bf16* XB = (const bf16*)(p.ws + WS_XB); const float* ssq = (const float*)(p.ws + WS_CTL + 262144) + 49152;
    const f32x4 g0 = *(const f32x4*)(g + 8 * lane), g1 = *(const f32x4*)(g + 8 * lane + 4), g2 = *(const f32x4*)(g + 512 + 8 * lane), g3 = *(const f32x4*)(g + 512 + 8 * lane + 4);
#pragma unroll 1
    for (int row = bid * 8 + wave; row < MTOK; row += nb * 8) {
        const float rstd = frsq(ssq[row] * (1.0f / DM) + 1e-6f);
        const u32x4 a = *(const u32x4*)(XB + (size_t)row * DM + 8 * lane), b = *(const u32x4*)(XB + (size_t)row * DM + 512 + 8 * lane);
        float* o = p.out + (size_t)row * DM + 8 * lane;
        *(f32x4*)o = (f32x4){bflo(a.x), bfhi(a.x), bflo(a.y), bfhi(a.y)} * rstd * g0; *(f32x4*)(o + 4) = (f32x4){bflo(a.z), bfhi(a.z), bflo(a.w), bfhi(a.w)} * rstd * g1;
        *(f32x4*)(o + 512) = (f32x4){bflo(b.x), bfhi(b.x), bflo(b.y), bfhi(b.y)} * rstd * g2; *(f32x4*)(o + 516) = (f32x4){bflo(b.z), bfhi(b.z), bflo(b.w), bfhi(b.w)} * rstd * g3;
    }
}


typedef short bf16x8 __attribute__((ext_vector_type(8)));
typedef float f32x2v __attribute__((ext_vector_type(2)));
typedef __bf16 bf16x2v __attribute__((ext_vector_type(2)));
#define MFMA16(a, b, c) __builtin_amdgcn_mfma_f32_16x16x32_bf16((a), (b), (c), 0, 0, 0)
__device__ __forceinline__ unsigned cvt2(float lo, float hi) { f32x2v v = {lo, hi}; bf16x2v b = __builtin_convertvector(v, bf16x2v); return __builtin_bit_cast(unsigned, b); }
__device__ __forceinline__ u32x4 pack8(const float (&x)[8]) { u32x4 w; w.x = cvt2(x[0], x[1]); w.y = cvt2(x[2], x[3]); w.z = cvt2(x[4], x[5]); w.w = cvt2(x[6], x[7]); return w; }
__device__ __forceinline__ void shift8(const bf16* proj, int row, bool hasp, bool hasn, int col, const float* mu, float (&u)[8]) {
    float p[8], a[8], b[8];
    load8bf(proj + (size_t)row * DINP + col, p);
    if (hasp) load8bf(proj + (size_t)(row - 1) * DINP + col, a); else {
#pragma unroll
        for (int j = 0; j < 8; ++j) a[j] = 0.f; }
    if (hasn) load8bf(proj + (size_t)(row + 1) * DINP + col, b); else {
#pragma unroll
        for (int j = 0; j < 8; ++j) b[j] = 0.f; }
    const f32x4 m0 = *(const f32x4*)(mu + col), m1 = *(const f32x4*)(mu + col + 4);
#pragma unroll
    for (int j = 0; j < 4; ++j) { u[j] = p[j] + m0[j] * (0.5f * (a[j] + b[j]) - p[j]); u[4 + j] = p[4 + j] + m1[j] * (0.5f * (a[4 + j] + b[4 + j]) - p[4 + j]); }
}
__device__ __forceinline__ int opq(int x) { asm volatile("" : "+v"(x)); return x; }
constexpr int TS = 72, TB = 64 * TS * 2;
constexpr int L_HT = 0, L_TW = 9216, L_AD = 18432, L_LP = 27648, L_AP = 45056, L_AT = 62464, L_RT = L_AT + TB, L_BH = L_RT + TB, L_KH = L_BH + TB, L_VR = L_KH + TB, L_YS = L_VR + TB;
constexpr int L_AAB = L_TW, L_AAK = L_AAB + 4096, L_ARB = L_AAK + 3072, L_ARK = L_ARB + 3072, L_UT = L_ARK + 3072, L_W1 = L_AP;
static_assert(L_UT + 64 * 24 * 2 <= L_LP && L_YS + 17408 <= RING_BYTES, "scan LDS map");
constexpr int LPS = 68;
#define LBAR() asm volatile("s_waitcnt lgkmcnt(0)\n\ts_barrier" ::: "memory")
typedef short s16x4v __attribute__((ext_vector_type(4)));
__device__ __forceinline__ bf16x8 tr8(const LAS bf16* p) {
    const s16x4v lo = __builtin_bit_cast(s16x4v, __builtin_amdgcn_ds_read_tr16_b64_v4i16((LAS s16x4v*)p));
    const s16x4v hi = __builtin_bit_cast(s16x4v, __builtin_amdgcn_ds_read_tr16_b64_v4i16((LAS s16x4v*)(p + 4 * TS)));
    return (bf16x8){lo[0], lo[1], lo[2], lo[3], hi[0], hi[1], hi[2], hi[3]};
}

__device__ __forceinline__ void rwkv_item3(CKP& p, int l, LAS unsigned char* lds, int item) {
    const int tid0 = opaque_tid(), w = __builtin_amdgcn_readfirstlane(tid0 >> 6);
    int tid = tid0, fr = tid & 15, fg = (tid & 63) >> 4;
    int bseq, h, dir, L, base; bool lat;
    if (item < 64) { lat = true; bseq = item >> 4; h = (item >> 1) & 7; dir = item & 1; L = 1024; base = NCTX + bseq * 1024; }
    else { const int i2 = item - 64; lat = false; bseq = i2 >> 4; h = (i2 >> 1) & 7; dir = i2 & 1; L = 256; base = bseq * 256; }
    const bf16* U = (const bf16*)(p.ws + WS_U);
    const float* KINV = (const float*)(p.ws + WS_KINV);
    bf16* Yout = (bf16*)(p.ws + (dir ? WS_YB : WS_YF));
    float* BC = (float*)(p.ws + WS_BC) + (size_t)dir * MTOK * 8;
    const bf16* wupt = (const bf16*)(p.ws + WS_WUPT) + ((size_t)(l * 2 + dir) * 512 + h * 64) * 64;
    const bf16* aupt = (const bf16*)(p.ws + WS_AUPT) + ((size_t)(l * 2 + dir) * 512 + h * 64) * 64;

    LAS float* LP = (LAS float*)(lds + L_LP); LAS float* AP = (LAS float*)(lds + L_AP); LAS float* AS = (LAS float*)(lds + L_TW);
    LAS bf16* AT = (LAS bf16*)(lds + L_AT);   LAS bf16* RT = (LAS bf16*)(lds + L_RT);   LAS bf16* BH = (LAS bf16*)(lds + L_BH);   LAS bf16* KH = (LAS bf16*)(lds + L_KH);
    LAS bf16* VR = (LAS bf16*)(lds + L_VR);   LAS float* YS = (LAS float*)(lds + L_YS);
    LAS float* AAB = (LAS float*)(lds + L_AAB); LAS bf16* AAK = (LAS bf16*)(lds + L_AAK); LAS bf16* ARB = (LAS bf16*)(lds + L_ARB); LAS bf16* ARK = (LAS bf16*)(lds + L_ARK);
    LAS float* W1 = (LAS float*)(lds + L_W1);
    const int tv = w & 3;
    f32x4 hacc[4];
#pragma unroll
    for (int x = 0; x < 4; ++x) {
        if (lat && w < 4) hacc[x] = *(const f32x4*)(p.in[I_STATE] + ((((size_t)bseq * 2 + l) * 2 + dir) * 8 + h) * 4096 + (16 * tv + fr) * 64 + 16 * x + 4 * fg);
        else hacc[x] = (f32x4){0.f, 0.f, 0.f, 0.f}; }
    int ei = tid >> 3, ec8 = (tid & 7) * 8; const int hc8 = h * 64 + ec8;
    float kkp[8], kap[8], rkp[8];
#pragma unroll
    for (int e = 0; e < 8; ++e) { kkp[e] = p.in[I_KK][l * 512 + hc8 + e]; kap[e] = p.in[I_KA][l * 512 + hc8 + e]; rkp[e] = p.in[I_RK][l * 512 + hc8 + e]; }
#define SCAN_PREFETCH(SC) do { const int _t0 = opq(tid0), _ei = _t0 >> 3, _ec8 = (_t0 & 7) * 8; const int _step = (SC) * 64 + _ei, _t = dir ? L - 1 - _step : _step; \
        const bf16* _u = U + (size_t)(base + _t) * 1920; \
        nr = *(const u32x4*)(_u + R_OFF + h * 64 + _ec8); nk = *(const u32x4*)(_u + K_OFF + h * 64 + _ec8); nv = *(const u32x4*)(_u + V_OFF + h * 64 + _ec8); \
        ninv = KINV[(size_t)(base + _t) * 8 + h]; \
        const int _st2 = (SC) * 64 + 16 * (w >> 1) + (_t0 & 15), _t2 = dir ? L - 1 - _st2 : _st2; const bf16* _u2 = U + (size_t)(base + _t2) * 1920 + dir * 64 + ((_t0 & 63) >> 4) * 8; \
        paw0 = *(const bf16x8*)(_u2 + WD_OFF); paw1 = *(const bf16x8*)(_u2 + WD_OFF + 32); paa0 = *(const bf16x8*)(_u2 + AD_OFF); paa1 = *(const bf16x8*)(_u2 + AD_OFF + 32); } while (0)
    bf16x8 lbw[2][2], lba[2][2]; float lw0c[2], la0c[2];
#pragma unroll
    for (int x = 0; x < 2; ++x) { const int c = ((w & 1) * 2 + x) * 16 + fr;
        lbw[x][0] = *(const bf16x8*)(wupt + c * 64 + fg * 8); lbw[x][1] = *(const bf16x8*)(wupt + c * 64 + 32 + fg * 8);
        lba[x][0] = *(const bf16x8*)(aupt + c * 64 + fg * 8); lba[x][1] = *(const bf16x8*)(aupt + c * 64 + 32 + fg * 8);
        lw0c[x] = p.in[I_W0][(l * 2 + dir) * 512 + h * 64 + c]; la0c[x] = p.in[I_A0][(l * 2 + dir) * 512 + h * 64 + c]; }
    u32x4 nr, nk, nv; float ninv; bf16x8 paw0, paw1, paa0, paa1;
    SCAN_PREFETCH(0);
    __syncthreads();
#pragma unroll 1
    for (int sc = 0; sc < L / 64; ++sc) {
        tid = opq(tid0); fr = tid & 15; fg = (tid & 63) >> 4; ei = tid >> 3; ec8 = (tid & 7) * 8;
        const u32x4 cr = nr, ck = nk, cv = nv; const float kinv = ninv;
        { const int ti = w >> 1;
          const bf16x8 aw0 = paw0, aw1 = paw1, aa0 = paa0, aa1 = paa1;
          unsigned li[2], ls[2];
#pragma unroll
          for (int pr = 0; pr < 2; ++pr) { const int j0 = 4 * fg + 2 * pr, j1 = j0 + 1;
              li[pr] = (j0 <= fr ? 0x3f80u : 0u) | (j1 <= fr ? 0x3f800000u : 0u); ls[pr] = (j0 < fr ? 0x3f80u : 0u) | (j1 < fr ? 0x3f800000u : 0u); }
          const bf16x8 Li = __builtin_bit_cast(bf16x8, (u32x4){li[0], li[1], 0u, 0u}), Ls = __builtin_bit_cast(bf16x8, (u32x4){ls[0], ls[1], 0u, 0u});
#pragma unroll
          for (int x = 0; x < 2; ++x) { const int c = ((w & 1) * 2 + x) * 16 + fr;
              f32x4 cw = (f32x4){lw0c[x], lw0c[x], lw0c[x], lw0c[x]}, ca = (f32x4){la0c[x], la0c[x], la0c[x], la0c[x]};
              cw = MFMA16(aw0, lbw[x][0], cw); cw = MFMA16(aw1, lbw[x][1], cw); ca = MFMA16(aa0, lba[x][0], ca); ca = MFMA16(aa1, lba[x][1], ca);
              float lw[4], lo[4];
#pragma unroll
              for (int r = 0; r < 4; ++r) lw[r] = -0.6065306597126334f * fsigmoid(cw[r]);
              const unsigned h01 = cvt2(lw[0], lw[1]), h23 = cvt2(lw[2], lw[3]);
              lo[0] = lw[0] - bflo(h01); lo[1] = lw[1] - bfhi(h01); lo[2] = lw[2] - bflo(h23); lo[3] = lw[3] - bfhi(h23);
              const bf16x8 bh = __builtin_bit_cast(bf16x8, (u32x4){h01, h23, 0u, 0u}), bl = __builtin_bit_cast(bf16x8, (u32x4){cvt2(lo[0], lo[1]), cvt2(lo[2], lo[3]), 0u, 0u});
              f32x4 ci = (f32x4){0.f, 0.f, 0.f, 0.f}, cs = ci;
              ci = MFMA16(Li, bh, ci); ci = MFMA16(Li, bl, ci); cs = MFMA16(Ls, bh, cs); cs = MFMA16(Ls, bl, cs);
#pragma unroll
              for (int r = 0; r < 4; ++r) { const int o = (ti * 16 + 4 * fg + r) * LPS + c;
                  LP[o] = fexp(ci[r]); AP[o] = fexp(cs[r]); AS[o] = fsigmoid(ca[r]); } } }
        __syncthreads();
        tid = opq(tid0); fr = tid & 15; fg = (tid & 63) >> 4; ei = tid >> 3; ec8 = (tid & 7) * 8;
        float bcv;
        { const f32x4 g0 = *(const LAS f32x4*)(LP + ei * LPS + ec8), g1 = *(const LAS f32x4*)(LP + ei * LPS + ec8 + 4);
          const f32x4 p0 = *(const LAS f32x4*)(AP + ei * LPS + ec8), p1 = *(const LAS f32x4*)(AP + ei * LPS + ec8 + 4);
          const f32x4 s0 = *(const LAS f32x4*)(AS + ei * LPS + ec8), s1 = *(const LAS f32x4*)(AS + ei * LPS + ec8 + 4);
          float rr[8], kk[8], xa[8], xr[8], xb[8], xk[8], bc = 0.f;
          rr[0] = bflo(cr.x); rr[1] = bfhi(cr.x); rr[2] = bflo(cr.y); rr[3] = bfhi(cr.y); rr[4] = bflo(cr.z); rr[5] = bfhi(cr.z); rr[6] = bflo(cr.w); rr[7] = bfhi(cr.w);
          kk[0] = bflo(ck.x); kk[1] = bfhi(ck.x); kk[2] = bflo(ck.y); kk[3] = bfhi(ck.y); kk[4] = bflo(ck.z); kk[5] = bfhi(ck.z); kk[6] = bflo(ck.w); kk[7] = bfhi(ck.w);
#pragma unroll
          for (int e = 0; e < 8; ++e) { const float gi = e < 4 ? g0[e & 3] : g1[e & 3], gp = e < 4 ? p0[e & 3] : p1[e & 3], asg = e < 4 ? s0[e & 3] : s1[e & 3];
              const float kj = kk[e] * kkp[e] * kinv, kd = kk[e] * (1.0f + (asg - 1.0f) * kap[e]), ginv = frcp(gi);
              bc += rr[e] * kd * rkp[e];
              xa[e] = -kj * gp; xr[e] = rr[e] * gi; xb[e] = kj * asg * ginv; xk[e] = kd * ginv; }
          bcv = red8(bc);
          *(LAS u32x4*)(AT + ei * TS + ec8) = pack8(xa); *(LAS u32x4*)(RT + ei * TS + ec8) = pack8(xr); *(LAS u32x4*)(BH + ei * TS + ec8) = pack8(xb); *(LAS u32x4*)(KH + ei * TS + ec8) = pack8(xk);
          *(LAS u32x4*)(VR + ei * TS + ec8) = cv; }
        __syncthreads();
        tid = opq(tid0); fr = tid & 15; fg = (tid & 63) >> 4;
        { const int q = w >> 1, half = w & 1; const LAS bf16* Asrc = half ? RT : AT;
          const bf16x8 af0 = *(const LAS bf16x8*)(Asrc + (16 * q + fr) * TS + fg * 8), af1 = *(const LAS bf16x8*)(Asrc + (16 * q + fr) * TS + 32 + fg * 8);
#pragma unroll
          for (int x = 0; x < 2; ++x) { const LAS bf16* Bsrc = x ? KH : BH;
              const bf16x8 bf0 = *(const LAS bf16x8*)(Bsrc + (16 * q + fr) * TS + fg * 8), bf1_ = *(const LAS bf16x8*)(Bsrc + (16 * q + fr) * TS + 32 + fg * 8);
              f32x4 c = (f32x4){0.f, 0.f, 0.f, 0.f}; c = MFMA16(af0, bf0, c); c = MFMA16(af1, bf1_, c);
              f32x4 cm;
#pragma unroll
              for (int r = 0; r < 4; ++r) { const int i = 4 * fg + r, j = fr; cm[r] = (half ? j <= i : j < i) ? c[r] : 0.f; }
              if (half == 0 && x == 0) *(LAS f32x4*)(AAB + (q * 16 + fr) * 16 + 4 * fg) = cm;
              else { LAS bf16* dst = half == 0 ? AAK : (x == 0 ? ARB : ARK);
#pragma unroll
                  for (int r = 0; r < 4; ++r) dst[(q * 16 + 4 * fg + r) * 24 + fr] = (bf16)(cvt2(cm[r], 0.f) & 0xffffu); } }
          if (half == 0) {
              const unsigned kmask = fg < 2 ? 0xffffffffu : 0u;
              const bf16x8 afr = *(const LAS bf16x8*)(AAK + (q * 16 + fr) * 24 + (fg & 1) * 8);
              const bf16x8 af = __builtin_bit_cast(bf16x8, __builtin_bit_cast(u32x4, afr) & kmask);
#pragma unroll
              for (int tvv = 0; tvv < 4; ++tvv) {
                  const bf16x8 bfr = tr8(VR + (16 * q + 8 * (fg & 1) + (fr >> 2)) * TS + 16 * tvv + 4 * (fr & 3));
                  const bf16x8 bfv = __builtin_bit_cast(bf16x8, __builtin_bit_cast(u32x4, bfr) & kmask);
                  f32x4 c = (f32x4){0.f, 0.f, 0.f, 0.f}; c = MFMA16(af, bfv, c);
#pragma unroll
                  for (int r = 0; r < 4; ++r) W1[(q * 16 + 4 * fg + r) * LPS + 16 * tvv + fr] = c[r]; } } }
        __syncthreads();
        tid = opq(tid0);
        { const int q = tid >> 7, col = tid & 127; float x[16];
          if (col < 64) {
#pragma unroll
              for (int i = 0; i < 16; ++i) x[i] = bf1(AT[(16 * q + i) * TS + col]); }
          else {
#pragma unroll
              for (int i = 0; i < 16; ++i) x[i] = W1[(q * 16 + i) * LPS + col - 64]; }
#pragma unroll
          for (int j = 0; j < 15; ++j) {
              const LAS f32x4* ac = (const LAS f32x4*)(AAB + (q * 16 + j) * 16);
#pragma unroll
              for (int i4 = (j + 1) / 4; i4 < 4; ++i4) { const f32x4 a4 = ac[i4];
#pragma unroll
                  for (int e = 0; e < 4; ++e) if (i4 * 4 + e > j) x[i4 * 4 + e] += a4[e] * x[j]; } }
          if (col < 64) {
#pragma unroll
              for (int i = 0; i < 16; ++i) AT[(16 * q + i) * TS + col] = (bf16)(cvt2(x[i], 0.f) & 0xffffu); }
          else {
#pragma unroll
              for (int i = 0; i < 16; ++i) W1[(q * 16 + i) * LPS + col - 64] = x[i]; } }
        __syncthreads();
        if (sc + 1 < L / 64) SCAN_PREFETCH(sc + 1);
        if (w < 4) {
        tid = opq(tid0); fr = tid & 15; fg = (tid & 63) >> 4;
#pragma unroll
        for (int q = 0; q < 4; ++q) {
            bf16x8 hb[2];
#pragma unroll
            for (int ks = 0; ks < 2; ++ks) { u32x4 t; t.x = cvt2(hacc[2 * ks][0], hacc[2 * ks][1]); t.y = cvt2(hacc[2 * ks][2], hacc[2 * ks][3]);
                t.z = cvt2(hacc[2 * ks + 1][0], hacc[2 * ks + 1][1]); t.w = cvt2(hacc[2 * ks + 1][2], hacc[2 * ks + 1][3]); hb[ks] = __builtin_bit_cast(bf16x8, t); }
            bf16x8 aU[2], aR[2];
#pragma unroll
            for (int ks = 0; ks < 2; ++ks) {
                const u32x2 a0 = *(const LAS u32x2*)(AT + (16 * q + fr) * TS + 32 * ks + 4 * fg), a1 = *(const LAS u32x2*)(AT + (16 * q + fr) * TS + 32 * ks + 16 + 4 * fg);
                const u32x2 r0 = *(const LAS u32x2*)(RT + (16 * q + fr) * TS + 32 * ks + 4 * fg), r1 = *(const LAS u32x2*)(RT + (16 * q + fr) * TS + 32 * ks + 16 + 4 * fg);
                aU[ks] = __builtin_bit_cast(bf16x8, (u32x4){a0.x, a0.y, a1.x, a1.y}); aR[ks] = __builtin_bit_cast(bf16x8, (u32x4){r0.x, r0.y, r1.x, r1.y}); }
            f32x4 u, yacc = (f32x4){0.f, 0.f, 0.f, 0.f};
#pragma unroll
            for (int r = 0; r < 4; ++r) u[r] = W1[(q * 16 + 4 * fg + r) * LPS + 16 * tv + fr];
            u = MFMA16(aU[0], hb[0], u); u = MFMA16(aU[1], hb[1], u);
            yacc = MFMA16(aR[0], hb[0], yacc); yacc = MFMA16(aR[1], hb[1], yacc);
            const s16x4v vtr = __builtin_bit_cast(s16x4v, __builtin_amdgcn_ds_read_tr16_b64_v4i16((LAS s16x4v*)(VR + (16 * q + 4 * fg + (fr >> 2)) * TS + 16 * tv + 4 * (fr & 3))));
            const u32x2 vt2 = __builtin_bit_cast(u32x2, vtr);
            const bf16x8 bUV = __builtin_bit_cast(bf16x8, (u32x4){cvt2(u[0], u[1]), cvt2(u[2], u[3]), vt2.x, vt2.y});
            { const u32x2 y0 = *(const LAS u32x2*)(ARB + (q * 16 + fr) * 24 + 4 * fg), y1 = *(const LAS u32x2*)(ARK + (q * 16 + fr) * 24 + 4 * fg);
              yacc = MFMA16(__builtin_bit_cast(bf16x8, (u32x4){y0.x, y0.y, y1.x, y1.y}), bUV, yacc); }
#pragma unroll
            for (int r = 0; r < 4; ++r) YS[(16 * q + 4 * fg + r) * LPS + 16 * tv + fr] = yacc[r];
#pragma unroll
            for (int x = 0; x < 4; ++x) {
                const s16x4v bt = __builtin_bit_cast(s16x4v, __builtin_amdgcn_ds_read_tr16_b64_v4i16((LAS s16x4v*)(BH + (16 * q + 4 * fg + (fr >> 2)) * TS + 16 * x + 4 * (fr & 3))));
                const s16x4v kt = __builtin_bit_cast(s16x4v, __builtin_amdgcn_ds_read_tr16_b64_v4i16((LAS s16x4v*)(KH + (16 * q + 4 * fg + (fr >> 2)) * TS + 16 * x + 4 * (fr & 3))));
                const u32x2 b2 = __builtin_bit_cast(u32x2, bt), k2 = __builtin_bit_cast(u32x2, kt);
                const f32x4 ge = *(const LAS f32x4*)(LP + (16 * q + 15) * LPS + 16 * x + 4 * fg);
                hacc[x] = MFMA16(__builtin_bit_cast(bf16x8, (u32x4){b2.x, b2.y, k2.x, k2.y}), bUV, hacc[x]) * ge; }
        }
        }
        __syncthreads();
        tid = opq(tid0); ei = tid >> 3; ec8 = (tid & 7) * 8;
        { const int st2 = sc * 64 + ei, t2 = dir ? L - 1 - st2 : st2; bf16* yo = Yout + (size_t)(base + t2) * 512 + h * 64 + ec8;
          const f32x4 y0 = *(const LAS f32x4*)(YS + ei * LPS + ec8), y1 = *(const LAS f32x4*)(YS + ei * LPS + ec8 + 4);
          u32x4 yw; yw.x = cvt2(y0[0], y0[1]); yw.y = cvt2(y0[2], y0[3]); yw.z = cvt2(y1[0], y1[1]); yw.w = cvt2(y1[2], y1[3]);
          *(u32x4*)yo = yw;
          if ((tid & 7) == 0) BC[(size_t)(base + t2) * 8 + h] = bcv; }
    }
#undef SCAN_PREFETCH
    if (!lat && w < 4) {
#pragma unroll
        for (int x = 0; x < 4; ++x) *(f32x4*)(p.out + (size_t)MTOK * DM + ((((size_t)bseq * 2 + l) * 2 + dir) * 8 + h) * 4096 + (16 * tv + fr) * 64 + 16 * x + 4 * fg) = hacc[x]; }
    __syncthreads();
}

__device__ __forceinline__ void stage_upass(CKP& p, int l, int bid, int nb) {
    const int tid = opaque_tid(), sub = tid >= 240 ? 1 : 0, j = tid - sub * 240, col = 8 * j;
    const bf16* proj = (const bf16*)(p.ws + WS_PROJ); bf16* U = (bf16*)(p.ws + WS_U); float* KINV = (float*)(p.ws + WS_KINV);
    const float* mu = p.in[I_MU] + l * 1920;
    if (tid < 480) {
        const bool isk = col >= K_OFF && col < V_OFF;
        const float* kkp = p.in[I_KK] + l * 512 + (isk ? col - K_OFF : 0);
        const f32x4 k0 = *(const f32x4*)kkp, k1 = *(const f32x4*)(kkp + 4);
#pragma unroll 1
        for (int tok0 = bid * 2 + sub; tok0 < MTOK; tok0 += nb * 8) {
            float uu[4][8];
#pragma unroll
            for (int z = 0; z < 4; ++z) { const int tok = min(tok0 + z * nb * 2, MTOK - 1);
                const bool lat = tok >= NCTX; const int L = lat ? 1024 : 256, t = lat ? (tok - NCTX) & 1023 : tok & 255;
                shift8(proj, tok, t > 0, t < L - 1, col, mu, uu[z]); }
#pragma unroll
            for (int z = 0; z < 4; ++z) { const int tok = tok0 + z * nb * 2;
                float ss = 0.f;
#pragma unroll
                for (int e = 0; e < 8; ++e) { const float kn = uu[z][e] * (e < 4 ? k0[e & 3] : k1[e & 3]); ss += kn * kn; }
                ss = red8(ss);
                if (tok < MTOK) {
                    if (isk && (j & 7) == 0) KINV[(size_t)tok * 8 + ((col - K_OFF) >> 6)] = fminf(frsq(ss), 1e12f);
                    if (col >= WD_OFF && col < AD_OFF) {
#pragma unroll
                        for (int e = 0; e < 8; ++e) uu[z][e] = 1.0f - 2.0f * frcp(fexp(2.0f * uu[z][e]) + 1.0f); }
                    if (col >= GD_OFF) {
#pragma unroll
                        for (int e = 0; e < 8; ++e) uu[z][e] = fsigmoid(uu[z][e]); }
                    *(u32x4*)(U + (size_t)tok * 1920 + col) = pack8(uu[z]); } }
        }
    }
}

__device__ __forceinline__ void fnet1_item(CKP& p, int l, int item) {
    const int tid = opaque_tid(), lane = tid & 63, w = __builtin_amdgcn_readfirstlane(tid >> 6), fr = lane & 15, fg = lane >> 4;
    const int tb = item >> 2, g = item & 3, tok0 = tb * 64, tt = w & 3, cs = w >> 2;
    const bf16* proj = (const bf16*)(p.ws + WS_PROJ);
    const bf16* fwt = (const bf16*)(p.ws + WS_FW) + (size_t)((l * 4 + g) * 128 + cs * 64) * 64;
    const bf16* xr = proj + (size_t)(tok0 + 16 * tt + fr) * DINP + F_OFF + g * 64 + fg * 8;
    const bf16x8 a0 = *(const bf16x8*)xr, a1 = *(const bf16x8*)(xr + 32);
    const bool lat = tok0 >= NCTX;
    const int L = lat ? 1024 : 256, bq = lat ? (tok0 - NCTX) >> 10 : tok0 >> 8, t = (lat ? (tok0 - NCTX) & 1023 : tok0 & 255) + 16 * tt + 4 * fg;
    const float scale = lat ? (1.0f / 256.0f) : (1.0f / 128.0f);
    bf16* Y = (bf16*)(p.ws + WS_YCS) + (lat ? (size_t)8192 * 512 : 0);
#pragma unroll
    for (int ot = 0; ot < 4; ++ot) {
        const bf16x8 b0 = *(const bf16x8*)(fwt + (16 * ot + fr) * 64 + fg * 8), b1 = *(const bf16x8*)(fwt + (16 * ot + fr) * 64 + 32 + fg * 8);
        f32x4 c = (f32x4){0.f, 0.f, 0.f, 0.f}; c = MFMA16(a0, b0, c); c = MFMA16(a1, b1, c);
        u32x2 o; o.x = cvt2(c[0] * scale, c[1] * scale); o.y = cvt2(c[2] * scale, c[3] * scale);
        *(u32x2*)(Y + (size_t)((bq * 4 + g) * 64 + 16 * ot + fr) * (2 * L) + cs * L + t) = o; }
}

__device__ __forceinline__ void pool_item(CKP& p, int l, LAS unsigned char* lds, int item) {
    const int tid = opaque_tid(), tb = item >> 2, gi = item & 3, tok0 = tb * 64, hw = 1 << gi;
    const bf16* proj = (const bf16*)(p.ws + WS_PROJ);
    LAS bf16* DB = (LAS bf16*)lds;
    LAS float* CSUM = (LAS float*)(lds + 9216);
    const int ti = tid >> 3, c8 = (tid & 7) * 8, tok = tok0 + ti, col = P_OFF + gi * 64 + c8;
    { float sum[8], x[8];
#pragma unroll
      for (int j = 0; j < 8; ++j) sum[j] = 0.f;
      load8bf(proj + (size_t)tok * DINP + col, x);
      float cnt;
      if (tok < NCTX) { const int t = tok & 255, sb = tok - t, lo = max(t - hw, 0), hi = min(t + hw, 256);
          u32x4 wv[16];
#pragma unroll
          for (int q = 0; q < 16; ++q) { const int tq = min(t - hw + q, 255); wv[q] = (q < 2 * hw && tq >= 0) ? *(const u32x4*)(proj + (size_t)(sb + max(tq, 0)) * DINP + col) : (u32x4){0u, 0u, 0u, 0u}; }
#pragma unroll
          for (int q = 0; q < 16; ++q) if (q < 2 * hw) { const bool ok = t - hw + q >= 0 && t - hw + q < 256; const u32x4 w = wv[q];
              if (ok) { sum[0] += bflo(w.x); sum[1] += bfhi(w.x); sum[2] += bflo(w.y); sum[3] += bfhi(w.y); sum[4] += bflo(w.z); sum[5] += bfhi(w.z); sum[6] += bflo(w.w); sum[7] += bfhi(w.w); } }
          cnt = (float)(hi - lo); }
      else {
          const int t = (tok - NCTX) & 1023, sb = tok - t, r = t >> 6, c = t & 63, rlo = max(r - hw, 0), rhi = min(r + hw, 16), clo = max(c - hw, 0), chi = min(c + hw, 64);
          u32x4 wv[16];
#pragma unroll
          for (int q = 0; q < 16; ++q) { const int rq = r - hw + q; wv[q] = (q < 2 * hw && rq >= 0 && rq < 16) ? *(const u32x4*)(proj + (size_t)(sb + rq * 64 + c) * DINP + col) : (u32x4){0u, 0u, 0u, 0u}; }
#pragma unroll
          for (int q = 0; q < 16; ++q) { const u32x4 w = wv[q];
              sum[0] += bflo(w.x); sum[1] += bfhi(w.x); sum[2] += bflo(w.y); sum[3] += bfhi(w.y); sum[4] += bflo(w.z); sum[5] += bfhi(w.z); sum[6] += bflo(w.w); sum[7] += bfhi(w.w); }
          *(LAS f32x4*)(CSUM + ti * 68 + c8) = (f32x4){sum[0], sum[1], sum[2], sum[3]}; *(LAS f32x4*)(CSUM + ti * 68 + c8 + 4) = (f32x4){sum[4], sum[5], sum[6], sum[7]};
          __syncthreads();
#pragma unroll
          for (int j = 0; j < 8; ++j) sum[j] = 0.f;
          for (int cq = clo; cq < chi; ++cq) { const f32x4 a = *(const LAS f32x4*)(CSUM + cq * 68 + c8), b = *(const LAS f32x4*)(CSUM + cq * 68 + c8 + 4);
#pragma unroll
              for (int j = 0; j < 4; ++j) { sum[j] += a[j]; sum[4 + j] += b[j]; } }
          cnt = (float)((rhi - rlo) * (chi - clo)); }
      const float ic = frcp(cnt);
      float dd[8];
#pragma unroll
      for (int j = 0; j < 8; ++j) dd[j] = sum[j] * ic - x[j];
      *(LAS u32x4*)(DB + ti * 72 + c8) = pack8(dd); }
    __syncthreads();
    { const int lane = tid & 63, w = __builtin_amdgcn_readfirstlane(tid >> 6), fr = lane & 15, fg = lane >> 4, tt = w & 3;
      const bf16* wpt = (const bf16*)(p.ws + WS_WPT) + (size_t)(l * 4 + gi) * 4096;
      const bf16x8 b0 = *(const LAS bf16x8*)(DB + (16 * tt + fr) * 72 + fg * 8), b1 = *(const LAS bf16x8*)(DB + (16 * tt + fr) * 72 + 32 + fg * 8);
#pragma unroll
      for (int x = 0; x < 2; ++x) { const int ot = 2 * (w >> 2) + x;
          const bf16x8 a0 = *(const bf16x8*)(wpt + (16 * ot + fr) * 64 + fg * 8), a1 = *(const bf16x8*)(wpt + (16 * ot + fr) * 64 + 32 + fg * 8);
          f32x4 c = (f32x4){0.f, 0.f, 0.f, 0.f}; c = MFMA16(a0, b0, c); c = MFMA16(a1, b1, c);
          const f32x4 ps = *(const f32x4*)(p.in[I_PSCALE] + l * 256 + gi * 64 + 16 * ot + 4 * fg);
          c *= ps;
          u32x2 o; o.x = cvt2(c[0], c[1]); o.y = cvt2(c[2], c[3]);
          *(u32x2*)((bf16*)(p.ws + WS_MIXED) + (size_t)(tok0 + 16 * tt + fr) * DM + 768 + gi * 64 + 16 * ot + 4 * fg) = o; } }
    __syncthreads();
}

__device__ __forceinline__ float xsum_fg(float s, int fr, int fg) {
    s += __builtin_bit_cast(float, __builtin_amdgcn_ds_bpermute((((fg ^ 1) << 4) | fr) << 2, __builtin_bit_cast(int, s)));
    s += __builtin_bit_cast(float, __builtin_amdgcn_ds_bpermute((((fg ^ 2) << 4) | fr) << 2, __builtin_bit_cast(int, s)));
    return s;
}
__device__ __forceinline__ void stage_post(CKP& p, int l, int bid, int nb) {
    const int tid = opaque_tid(), lane = tid & 63, head = __builtin_amdgcn_readfirstlane(tid >> 6), fr = lane & 15, fg = lane >> 4;
    const bf16* Ub = (const bf16*)(p.ws + WS_U);
    const bf16* gupt = (const bf16*)(p.ws + WS_GUPT) + ((size_t)l * 512 + head * 64) * 128;
    const bf16* YF = (const bf16*)(p.ws + WS_YF); const bf16* YB = (const bf16*)(p.ws + WS_YB);
    const float* BC0 = (const float*)(p.ws + WS_BC); const float* BC1 = BC0 + (size_t)MTOK * 8;
    bf16* MIX = (bf16*)(p.ws + WS_MIXED);
    bf16x8 ag[4][4];
    f32x4 lnw[4], lnb[4];
#pragma unroll
    for (int t = 0; t < 4; ++t) {
#pragma unroll
        for (int ks = 0; ks < 4; ++ks) ag[t][ks] = *(const bf16x8*)(gupt + (16 * t + fr) * 128 + ks * 32 + fg * 8);
        lnw[t] = *(const f32x4*)(p.in[I_LNW] + l * 512 + head * 64 + 16 * t + 4 * fg); lnb[t] = *(const f32x4*)(p.in[I_LNB] + l * 512 + head * 64 + 16 * t + 4 * fg); }
#pragma unroll 1
    for (int item = bid; item < 768; item += nb) {
        const size_t tok = (size_t)item * 16 + fr;
        bf16x8 bs[4];
#pragma unroll
        for (int ks = 0; ks < 4; ++ks) bs[ks] = *(const bf16x8*)(Ub + tok * 1920 + GD_OFF + ks * 32 + fg * 8);
        f32x4 y[4]; u32x2 vw[4];
#pragma unroll
        for (int t = 0; t < 4; ++t) { const int c = head * 64 + 16 * t + 4 * fg;
            const u32x2 yf = *(const u32x2*)(YF + tok * 512 + c), yb = *(const u32x2*)(YB + tok * 512 + c);
            y[t] = (f32x4){bflo(yf.x) + bflo(yb.x), bfhi(yf.x) + bfhi(yb.x), bflo(yf.y) + bflo(yb.y), bfhi(yf.y) + bfhi(yb.y)}; vw[t] = *(const u32x2*)(Ub + tok * 1920 + V_OFF + c); }
        const float bc = BC0[tok * 8 + head] + BC1[tok * 8 + head];
        f32x4 g[4];
#pragma unroll
        for (int t = 0; t < 4; ++t) { g[t] = (f32x4){0.f, 0.f, 0.f, 0.f};
#pragma unroll
            for (int ks = 0; ks < 4; ++ks) g[t] = MFMA16(ag[t][ks], bs[ks], g[t]); }
        float s = 0.f;
#pragma unroll
        for (int t = 0; t < 4; ++t) s += (y[t][0] + y[t][1]) + (y[t][2] + y[t][3]);
        const float mean = xsum_fg(s, fr, fg) * (1.0f / 64.0f);
        float q = 0.f;
#pragma unroll
        for (int t = 0; t < 4; ++t) { y[t] = y[t] - mean; q += (y[t][0] * y[t][0] + y[t][1] * y[t][1]) + (y[t][2] * y[t][2] + y[t][3] * y[t][3]); }
        const float rstd = frsq(xsum_fg(q, fr, fg) * (1.0f / 64.0f) + 64e-5f);
#pragma unroll
        for (int t = 0; t < 4; ++t) { const f32x4 vv = (f32x4){bflo(vw[t].x), bfhi(vw[t].x), bflo(vw[t].y), bfhi(vw[t].y)};
            const f32x4 o = (y[t] * rstd * lnw[t] + lnb[t] + vv * bc) * g[t];
            u32x2 w; w.x = cvt2(o[0], o[1]); w.y = cvt2(o[2], o[3]);
            *(u32x2*)(MIX + tok * DM + head * 64 + 16 * t + 4 * fg) = w; }
    }
}

#define XB_TMO      128
#define XB_XCNT(j)  (256  + 64 * (j))
#define XB_XSUB(j)  (1280 + 64 * (j))
#define XB_XGEN(j)  (2304 + 64 * (j))
#define XB_TOP      3328
#define XB_TOPGEN   3392
#define XCD_BAR_WORDS 3456
#define XB_SPIN_CAP (1u << 18)

__device__ __forceinline__ unsigned xb_ld(unsigned* p)              { return __hip_atomic_load(p, __ATOMIC_RELAXED, __HIP_MEMORY_SCOPE_AGENT); }
__device__ __forceinline__ unsigned xb_add(unsigned* p, unsigned v) { return __hip_atomic_fetch_add(p, v, __ATOMIC_RELAXED, __HIP_MEMORY_SCOPE_AGENT); }
__device__ __forceinline__ unsigned xb_xcc_id() { return (unsigned)__builtin_amdgcn_s_getreg((3 << 11) | 20) & 0xFu; }
#define XB_SPIN(cond, bar) do { unsigned _sp = 0; while (cond) { __builtin_amdgcn_s_sleep(1); \
    if ((++_sp & 255u) == 0u) { if (xb_ld(&(bar)[XB_TMO])) break; if (_sp > XB_SPIN_CAP) { atomicAdd(&(bar)[XB_TMO], 1u); break; } } } } while (0)

struct XcdBarrier {
    unsigned* bar; unsigned x;
    volatile LAS unsigned* st;
};

__device__ __forceinline__ XcdBarrier xcd_barrier_post(unsigned* bar, volatile LAS unsigned* st) {
    XcdBarrier b; b.bar = bar; b.x = xb_xcc_id(); b.st = st;
    if (threadIdx.x == 0) (void)xb_add(&bar[XB_XCNT(b.x)], 1u);
    return b;
}
__device__ __forceinline__ void xcd_barrier_complete(unsigned* bar, unsigned x, unsigned& nloc, unsigned& nx) {
    const unsigned G = gridDim.x * gridDim.y * gridDim.z;
    unsigned sum, cnt, mine, sp = 0u;
    for (;;) {
        sum = 0u; cnt = 0u; mine = 0u;
#pragma unroll
        for (unsigned j = 0; j < 16; ++j) { const unsigned c = xb_ld(&bar[XB_XCNT(j)]); sum += c; cnt += (c > 0u) ? 1u : 0u; mine = (j == x) ? c : mine; }
        if (sum == G) break;
        __builtin_amdgcn_s_sleep(1);
        if ((++sp & 255u) == 0u) { if (xb_ld(&bar[XB_TMO])) break; if (sp > XB_SPIN_CAP) { atomicAdd(&bar[XB_TMO], 1u); break; } }
    }
    nloc = mine > 0u ? mine : 1u; nx = cnt > 0u ? cnt : 1u;
}

__device__ __forceinline__ void xcd_barrier(const XcdBarrier& b) {
    asm volatile("s_waitcnt vmcnt(0)" ::: "memory");
    __syncthreads();
    if (threadIdx.x == 0) {
        unsigned* bar = b.bar;
        __builtin_amdgcn_s_waitcnt(0);
        unsigned nloc = b.st[0], nx = b.st[1];
        if (nloc == 0u) { xcd_barrier_complete(bar, b.x, nloc, nx); b.st[0] = nloc; b.st[1] = nx; }
        const unsigned old = xb_add(&bar[XB_XSUB(b.x)], 1u);
        const unsigned gen = old / nloc;
        if (old + 1u == (gen + 1u) * nloc) {
            __builtin_amdgcn_fence(__ATOMIC_RELEASE, "agent");
            asm volatile("s_waitcnt vmcnt(0)" ::: "memory");
            const unsigned og = xb_add(&bar[XB_TOP], 1u);
            const unsigned tg = og / nx;
            if (og + 1u == (tg + 1u) * nx) xb_add(&bar[XB_TOPGEN], 1u);
            else XB_SPIN(xb_ld(&bar[XB_TOPGEN]) == tg, bar);
            __builtin_amdgcn_fence(__ATOMIC_ACQUIRE, "agent");
            xb_add(&bar[XB_XGEN(b.x)], 1u);
            asm volatile("s_waitcnt vmcnt(0)" ::: "memory");
        } else {
            XB_SPIN(xb_ld(&bar[XB_XGEN(b.x)]) == gen, bar);
            __builtin_amdgcn_fence(__ATOMIC_ACQUIRE, "agent");
            asm volatile("s_waitcnt vmcnt(0)" ::: "memory");
        }
    }
    __syncthreads();
}

struct EpiAny {
    static constexpr bool AFTER_DRAIN = false;
    int mode; bool PERM; int l;
    __device__ __forceinline__ void operator()(const f32x4 (&acc)[2][2][4][2], const pg8::Unit& u, int wr, int wc, int fr, int fq) const {
        CKP* kp = (CKP*)__builtin_amdgcn_kernarg_segment_ptr(); asm volatile("" : "+s"(kp)); CKP& p = *kp;
        unsigned char* ws = p.ws;
        const float* mod = (const float*)(ws + WS_MOD) + (size_t)l * 5 * 6144;
        float* SSQ = (float*)(ws + WS_CTL + 262144);
        bf16* Hb = (bf16*)(ws + WS_H); bf16* XB = (bf16*)(ws + WS_XB);
        if (mode == 7) {
#pragma unroll
            for (int a = 0; a < 2; ++a)
#pragma unroll
                for (int b = 0; b < 2; ++b)
#pragma unroll
                    for (int m = 0; m < 4; ++m)
#pragma unroll
                        for (int n = 0; n < 2; ++n) asm volatile("" :: "v"(acc[a][b][m][n]));
            return; }
        if (mode == 0) { const pg8::EpiBf<0> e{(bf16*)(ws + WS_PROJ), DINP}; e(acc, u, wr, wc, fr, fq); }
        else if (mode == 2) { const pg8::EpiResNorm<false, false> e{XB, mod + 5 * 1024, nullptr, nullptr, nullptr, nullptr, nullptr, SSQ + 49152}; e(acc, u, wr, wc, fr, fq); }
        else if (mode == 3) { const pg8::EpiFnet e{(bf16*)(ws + WS_MIXED), 0, 256}; e(acc, u, wr, wc, fr, fq); }
        else if (mode == 8) { const pg8::EpiFnet e{(bf16*)(ws + WS_MIXED), NCTX, 1024}; e(acc, u, wr, wc, fr, fq); }
        else if (mode == 4) { const pg8::EpiNormBf<0> e{(bf16*)(ws + WS_PROJ), DINP, SSQ + 16384, (const float*)(ws + WS_SWIN), DINP}; e(acc, u, wr, wc, fr, fq); }
        else if (mode == 5) { const pg8::EpiNormBf<1> e{(bf16*)(ws + WS_FF), DFF, SSQ + l * 32768, (const float*)(ws + WS_SW1) + (size_t)l * 5 * DFF, DFF}; e(acc, u, wr, wc, fr, fq); }
        else if (mode == 6) {
            if (l == 0) { const pg8::EpiResNorm<true, true> e{XB, mod + 2 * 1024, p.in[I_XP], p.in[I_XS], Hb, p.in[I_N2G], mod + 4 * 1024, SSQ}; e(acc, u, wr, wc, fr, fq); }
            else { const pg8::EpiResNorm<false, true> e{XB, mod + 2 * 1024, nullptr, nullptr, Hb, p.in[I_N2G] + DM, mod + 4 * 1024, SSQ + 32768}; e(acc, u, wr, wc, fr, fq); } }
        else { const pg8::EpiResNorm<false, true> e{XB, mod + 5 * 1024, nullptr, nullptr, Hb, p.in[I_N1G] + DM, mod + 5 * 6144 + 1 * 1024, SSQ + 16384}; e(acc, u, wr, wc, fr, fq); }
    }
};

constexpr int N_STEPS = 17;
__device__ __forceinline__ bool step_seam(int st) { return st < 16; }
__global__ void __launch_bounds__(NTHR, 2) mega_fwd(KP p_unused) {
    extern __shared__ __attribute__((aligned(16))) unsigned char lds_raw[];
    CKP* kp0 = (CKP*)__builtin_amdgcn_kernarg_segment_ptr();
    { LAS unsigned* ctlw = (LAS unsigned*)((LAS unsigned char*)lds_raw + RING_BYTES);
      for (int u = threadIdx.x; u < (LDS_BYTES - RING_BYTES) / 4; u += NTHR) ctlw[u] = 0u; }
    __syncthreads();
    const XcdBarrier bar = xcd_barrier_post((unsigned*)(kp0->ws + WS_CTL) + 4096, (volatile LAS unsigned*)((LAS unsigned char*)lds_raw + MISC_OFF + 32));
    const int ph_lo = kp0->ph_lo, ph_hi = kp0->ph_hi;
#pragma unroll 1
#ifdef REP_A
    for (int sti = ph_lo; sti < ph_hi + ((REP_B) >= 0 ? 2 : 1); ++sti) {
        const int st = sti <= (REP_A) ? sti : (((REP_B) < 0 || sti <= (REP_B) + 1) ? sti - 1 : sti - 2);
        const bool isdup = sti == (REP_A) || ((REP_B) >= 0 && sti == (REP_B) + 1); (void)isdup;
#else
    for (int st = ph_lo; st < ph_hi; ++st) {
#endif
        CKP* kp = kp0; asm volatile("" : "+s"(kp));
        CKP& p = *kp; unsigned char* ws = p.ws;
        int bid = blockIdx.x, nb = gridDim.x; unsigned ldsb = (unsigned)(size_t)(LAS unsigned char*)lds_raw;
        asm volatile("" : "+s"(bid), "+s"(nb), "+s"(ldsb));
        LAS unsigned char* lds = (LAS unsigned char*)(size_t)ldsb;
        const int l = st < 9 ? 0 : 1, s = st == 0 ? -1 : (st == 1 ? 0 : (st == 16 ? 8 : (st - 2) % 7 + 1));
        const float* mod = (const float*)(ws + WS_MOD) + (size_t)l * 5 * 6144;
#pragma unroll 1
        for (int job = 0; job < 2; ++job) {
            pg8::Gemm g{nullptr, nullptr, 0, 0, 0, 0, 0}; EpiAny E{-1, true, 0}; int corder = bid;
            if (job == 0) {
                if (s == 1) { g = pg8::Gemm{(const bf16*)(ws + WS_H), (const bf16*)(ws + WS_WIN) + (size_t)l * DINP * DM, MTOK, DINP, DM, DM, DM}; E = EpiAny{l == 0 ? 0 : 4, true, l}; }
                else if (s == 3) { g = pg8::Gemm{(const bf16*)(ws + WS_CS256), (const bf16*)(ws + WS_YCS), 256, 8192, 512, 512, 512}; E = EpiAny{3, true, l}; corder = (bid + nb - (nb >= 256 ? 192 : 0)) % nb; }
                else if (s == 5) { g = pg8::Gemm{(const bf16*)(ws + WS_MIXED), (const bf16*)(ws + WS_WOUT) + (size_t)l * DM * DM, MTOK, DM, DM, DM, DM}; E = EpiAny{6, true, l}; }
                else if (s == 6) { g = pg8::Gemm{(const bf16*)(ws + WS_H), (const bf16*)(ws + WS_W1) + (size_t)l * DFF * DM, MTOK, DFF, DM, DM, DM}; E = EpiAny{5, true, l}; }
                else if (s == 7) { g = pg8::Gemm{(const bf16*)(ws + WS_FF), (const bf16*)(ws + WS_W2) + (size_t)l * DM * DFF, MTOK, DM, DFF, DFF, DFF}; E = l == 0 ? EpiAny{9, true, l} : EpiAny{2, true, l}; }
            } else if (s == 3) { g = pg8::Gemm{(const bf16*)(ws + WS_CS1024), (const bf16*)(ws + WS_YCS) + (size_t)8192 * 512, 1024, 1024, 2048, 2048, 2048}; E = EpiAny{8, true, l}; corder = (bid + nb - (nb >= 256 ? 224 : 32)) % nb; }
#ifdef NOEPI_FIRST
            if (isdup && E.mode >= 0) E.mode = 7;
#endif
            if (E.mode >= 0) {
                pg8::StaticOrder S; S.init(g.M, g.N, nb, corder);
                pg8::gemm_phase<EpiAny, pg8::StaticOrder, true, true>(lds, g, S, E);
                __syncthreads();
            }
        }
        if (s == 3) {
            if (nb >= 256) {
                if (bid < 64) rwkv_item3(p, l, lds, bid);
                else { unsigned* ctr = (unsigned*)(ws + WS_CTL + 524288) + 64 * (2 + l); volatile LAS unsigned* slot = (volatile LAS unsigned*)(lds + RING_BYTES + 64);
#pragma unroll 1
                    for (;;) { __syncthreads(); if (threadIdx.x == 0) *slot = atomicAdd(ctr, 1u); __syncthreads(); const int it = (int)*slot; if (it >= 512) break; rwkv_item3(p, l, lds, 64 + it); } }
            } else for (int it = bid; it < 576; it += nb) rwkv_item3(p, l, lds, it);
            side_queue(p, l, lds);
        }
        if (s == -1) stage_prologue(p, lds, bid, nb);
        else if (s == 0) { stage_norm(p, 0, 0, bid, nb); stage_tables(p, bid, nb); }
        else if (s == 2) {
            stage_upass(p, l, bid, nb);
#pragma unroll 1
            for (int it = bid; it < 768; it += nb) fnet1_item(p, l, it);
#pragma unroll 1
            for (int it = bid; it < 768; it += nb) pool_item(p, l, lds, it);
        }
        else if (s == 4) stage_post(p, l, bid, nb);
        else if (s == 8) stage_final(p, bid, nb);
        #ifdef REP_A
        if (sti + 1 < ph_hi + ((REP_B) >= 0 ? 2 : 1)) xcd_barrier(bar);
#else
        if (st + 1 < ph_hi && step_seam(st)) xcd_barrier(bar);
#endif
    }
}

extern "C" void kernel_launch(void* const* d_in, const int* in_sizes, int n_in, void* d_out, int out_size, void* d_ws, size_t ws_size, hipStream_t stream) {
    static int grid = 0;
    if (grid == 0) {
        if (n_in != N_IN || ws_size < WS_END) { fprintf(stderr, "kernel_launch: unexpected inputs (n_in %d, ws %zu)\n", n_in, ws_size); grid = -1; return; }
        int dev = 0, cus = 0, per_cu = 0;
        (void)hipGetDevice(&dev); (void)hipDeviceGetAttribute(&cus, hipDeviceAttributeMultiprocessorCount, dev);
        (void)hipFuncSetAttribute((const void*)mega_fwd, hipFuncAttributeMaxDynamicSharedMemorySize, LDS_BYTES);
        if (hipOccupancyMaxActiveBlocksPerMultiprocessor(&per_cu, (const void*)mega_fwd, NTHR, LDS_BYTES) != hipSuccess || per_cu < 1) {
            fprintf(stderr, "kernel_launch: occupancy query reports %d blocks/CU\n", per_cu); (void)hipGetLastError(); grid = -1; return; }
        grid = cus * 1;
    }
    if (grid < 0) return;
    KP a{};
    for (int i = 0; i < N_IN; ++i) a.in[i] = (const float*)d_in[i];
    a.out = (float*)d_out; a.ws = (unsigned char*)d_ws; a.ph_lo = 0; a.ph_hi = N_STEPS;
    if (hipMemsetAsync((char*)d_ws + WS_CTL, 0, 1 * MiB, stream) != hipSuccess) { fprintf(stderr, "kernel_launch: memset failed\n"); return; }
    void* args[] = {&a};
    hipError_t e = hipLaunchCooperativeKernel((const void*)mega_fwd, dim3(grid), dim3(NTHR), args, LDS_BYTES, stream);
    if (e != hipSuccess) fprintf(stderr, "cooperative launch failed: %s (grid %d)\n", hipGetErrorString(e), grid);
}
```

```cpp
#include <hip/hip_runtime.h>
#include <hip/hip_cooperative_groups.h>
#include <cstdio>
#include <cstdint>
namespace cg = cooperative_groups;
__device__ __forceinline__ int opaque_tid() { int t = threadIdx.x; asm volatile("" : "+v"(t)); return t; }
namespace pg8 {
#define PG8_LAS __attribute__((address_space(3)))
typedef unsigned short bf16_t;
typedef short bf16x8 __attribute__((ext_vector_type(8)));
typedef float f32x4 __attribute__((ext_vector_type(4)));
typedef unsigned u32x4 __attribute__((ext_vector_type(4)));
constexpr int BM = 256, BK = 64, HALF = 128, HTB = HALF * BK * 2  , STAGE_BYTES = 8 * HTB, NXCD = 8, WGM = 8;

__host__ __device__ __forceinline__ int lds_byte(int r, int c) { const int st = (r >> 4) * 2 + (c >> 5), rr = r & 15, cc = c & 31, ob = rr * 64 + cc * 2; return st * 1024 + (ob ^ (((ob >> 9) & 1) << 5)); }
__host__ __device__ __forceinline__ void stage_rc(int b, int& R, int& C) { const int st = b / 1024, sb = b % 1024, swz = sb ^ (((sb >> 9) & 1) << 5); R = (st >> 1) * 16 + swz / 64; C = (st & 1) * 32 + (swz % 64) / 2; }
__host__ __device__ __forceinline__ int perm32(int rho) { const int n = rho >> 4, i = rho & 15; return 8 * (i >> 2) + 4 * n + (i & 3); }

struct Unit { int pm, pn; };
struct Gemm { const bf16_t* A; const bf16_t* Bt; int M, N, K, lda, ldb; };

struct StaticOrder {
    int nM, nN, nwg, G, c;
    __host__ __device__ void init(int M, int N, int G_, int c_) { nM = M / BM; nN = N / BM; nwg = nM * nN; G = G_; c = c_; }
    __host__ __device__ bool next(int i, Unit& u) const {
        const long L = (long)i * G + c; if (L >= nwg) return false;
        int wgid = (int)L; { const int q = nwg / NXCD, r = nwg % NXCD, xcd = wgid % NXCD, off = wgid / NXCD; wgid = (xcd < r ? xcd * (q + 1) : r * (q + 1) + (xcd - r) * q) + off; }
        const int nig = WGM * nN, gid = wgid / nig, fm = gid * WGM, gsz = (nM - fm) < WGM ? (nM - fm) : WGM;
        u.pm = fm + ((wgid % nig) % gsz); u.pn = (wgid % nig) / gsz; return true;
    }
    __device__ __forceinline__ void a_ready(const Unit&) const {}
    __device__ __forceinline__ void done(const Unit&) const {}
};

__device__ __forceinline__ unsigned cvt_pk_bf16(float lo, float hi) { unsigned r; asm volatile("v_cvt_pk_bf16_f32 %0, %1, %2" : "=v"(r) : "v"(lo), "v"(hi)); return r; }
typedef unsigned u32x2 __attribute__((ext_vector_type(2)));
template <int ACT  > struct EpiBf {
    static constexpr bool PERM = true, AFTER_DRAIN = false;
    bf16_t* O; int ldc;
    __device__ __forceinline__ void operator()(const f32x4 (&acc)[2][2][4][2], const Unit& u, int wr, int wc, int fr, int fq) const {
        const int row0 = u.pm * BM + wr * 64 + fr, col0 = u.pn * BM + wc * 32 + 8 * fq;
#pragma unroll
        for (int ai = 0; ai < 2; ++ai)
#pragma unroll
            for (int m = 0; m < 4; ++m) { bf16_t* rowp = O + (size_t)(row0 + ai * HALF + m * 16) * ldc + col0;
#pragma unroll
                for (int bj = 0; bj < 2; ++bj) { f32x4 v0 = acc[ai][bj][m][0], v1 = acc[ai][bj][m][1];
                    if (ACT == 1) {
#pragma unroll
                        for (int e = 0; e < 4; ++e) { float a = v0[e] > 0.f ? v0[e] : 0.f; v0[e] = a * a; float b = v1[e] > 0.f ? v1[e] : 0.f; v1[e] = b * b; } }
                    u32x4 w; w.x = cvt_pk_bf16(v0[0], v0[1]); w.y = cvt_pk_bf16(v0[2], v0[3]); w.z = cvt_pk_bf16(v1[0], v1[1]); w.w = cvt_pk_bf16(v1[2], v1[3]);
                    *(u32x4*)(rowp + bj * HALF) = w; } }
    }
};
struct EpiRes {
    static constexpr bool PERM = false, AFTER_DRAIN = false;
    float* X; const float* gate; const float* Xc; const float* Xl;
    __device__ __forceinline__ void operator()(const f32x4 (&acc)[2][2][4][2], const Unit& u, int wr, int wc, int fr, int fq) const {
        const int row0 = u.pm * BM + wr * 64 + fr, col0 = u.pn * BM + wc * 32 + 4 * fq;
        const int cond = u.pm < 32 ? 0 : 1 + ((u.pm - 32) >> 2);
        const float* gp = gate + cond * 6144 + col0;
        f32x4 gv[2][2];
#pragma unroll
        for (int bj = 0; bj < 2; ++bj)
#pragma unroll
            for (int n = 0; n < 2; ++n) gv[bj][n] = *(const f32x4*)(gp + bj * HALF + n * 16);
#pragma unroll
        for (int ai = 0; ai < 2; ++ai)
#pragma unroll
            for (int m = 0; m < 4; ++m) { const size_t ro = (size_t)(row0 + ai * HALF + m * 16) * 1024 + col0; float* rowp = X + ro; const float* srcp = u.pm < 32 ? Xc + ro : Xl + (ro - (size_t)8192 * 1024);
#pragma unroll
                for (int bj = 0; bj < 2; ++bj)
#pragma unroll
                    for (int n = 0; n < 2; ++n) { *(f32x4*)(rowp + bj * HALF + n * 16) = *(const f32x4*)(srcp + bj * HALF + n * 16) + gv[bj][n] * acc[ai][bj][m][n]; }
                if (m & 1) asm volatile("" ::: "memory"); }
    }
};
struct EpiFnet {
    static constexpr bool PERM = true, AFTER_DRAIN = false;
    bf16_t* MIX; int rowbase, L;
    __device__ __forceinline__ void operator()(const f32x4 (&acc)[2][2][4][2], const Unit& u, int wr, int wc, int fr, int fq) const {
        const int row0 = u.pm * BM + wr * 64 + fr, colw = wc * 32 + 8 * fq;
        bf16_t* base = MIX + (size_t)(rowbase + u.pn * L) * 1024 + 512 + colw;
#pragma unroll
        for (int ai = 0; ai < 2; ++ai)
#pragma unroll
            for (int m = 0; m < 4; ++m) { bf16_t* rowp = base + (size_t)(row0 + ai * HALF + m * 16) * 1024;
#pragma unroll
                for (int bj = 0; bj < 2; ++bj) { const f32x4 v0 = acc[ai][bj][m][0], v1 = acc[ai][bj][m][1];
                    u32x4 w; w.x = cvt_pk_bf16(v0[0], v0[1]); w.y = cvt_pk_bf16(v0[2], v0[3]); w.z = cvt_pk_bf16(v1[0], v1[1]); w.w = cvt_pk_bf16(v1[2], v1[3]);
                    *(u32x4*)(rowp + bj * HALF) = w; } }
    }
};

__device__ __forceinline__ float xsum_fq(float s, int fr, int fq) {
    s += __builtin_bit_cast(float, __builtin_amdgcn_ds_bpermute((((fq ^ 1) << 4) | fr) << 2, __builtin_bit_cast(int, s)));
    s += __builtin_bit_cast(float, __builtin_amdgcn_ds_bpermute((((fq ^ 2) << 4) | fr) << 2, __builtin_bit_cast(int, s)));
    return s;
}
template <int ACT> struct EpiNormBf {
    static constexpr bool PERM = true, AFTER_DRAIN = false;
    bf16_t* O; int ldc; const float* ssq; const float* sw; int swld;
    __device__ __forceinline__ void operator()(const f32x4 (&acc)[2][2][4][2], const Unit& u, int wr, int wc, int fr, int fq) const {
        const int row0 = u.pm * BM + wr * 64 + fr, col0 = u.pn * BM + wc * 32 + 8 * fq;
        const int cond = u.pm < 32 ? 0 : 1 + ((u.pm - 32) >> 2);
        f32x4 sv[2][2];
#pragma unroll
        for (int bj = 0; bj < 2; ++bj)
#pragma unroll
            for (int n = 0; n < 2; ++n) sv[bj][n] = *(const f32x4*)(sw + (size_t)cond * swld + col0 + bj * HALF + 4 * n);
        float rs[2][4];
#pragma unroll
        for (int ai = 0; ai < 2; ++ai)
#pragma unroll
            for (int m = 0; m < 4; ++m) rs[ai][m] = ssq[row0 + ai * HALF + m * 16];
#pragma unroll
        for (int ai = 0; ai < 2; ++ai)
#pragma unroll
            for (int m = 0; m < 4; ++m) rs[ai][m] = __builtin_amdgcn_rsqf(rs[ai][m] * (1.0f / 1024.0f) + 1e-6f);
#pragma unroll
        for (int ai = 0; ai < 2; ++ai)
#pragma unroll
            for (int m = 0; m < 4; ++m) { const int row = row0 + ai * HALF + m * 16; bf16_t* rowp = O + (size_t)row * ldc + col0;
                const float rstd = rs[ai][m];
#pragma unroll
                for (int bj = 0; bj < 2; ++bj) { f32x4 v0 = acc[ai][bj][m][0] * rstd + sv[bj][0], v1 = acc[ai][bj][m][1] * rstd + sv[bj][1];
                    if (ACT == 1) {
#pragma unroll
                        for (int e = 0; e < 4; ++e) { float a = v0[e] > 0.f ? v0[e] : 0.f; v0[e] = a * a; float b = v1[e] > 0.f ? v1[e] : 0.f; v1[e] = b * b; } }
                    u32x4 w; w.x = cvt_pk_bf16(v0[0], v0[1]); w.y = cvt_pk_bf16(v0[2], v0[3]); w.z = cvt_pk_bf16(v1[0], v1[1]); w.w = cvt_pk_bf16(v1[2], v1[3]);
                    *(u32x4*)(rowp + bj * HALF) = w; }
                if (m & 1) asm volatile("" ::: "memory"); }
    }
};
struct EpiResFinal {
    static constexpr bool PERM = true, AFTER_DRAIN = false;
    const bf16_t* XB; const float* gate; const float* gfin; float* out; float* ssq; unsigned* cnt;
    __device__ __forceinline__ void operator()(const f32x4 (&acc)[2][2][4][2], const Unit& u, int wr, int wc, int fr, int fq) const {
        const int row0 = u.pm * BM + wr * 64 + fr, col0 = u.pn * BM + wc * 32 + 8 * fq;
        const int cond = u.pm < 32 ? 0 : 1 + ((u.pm - 32) >> 2);
        f32x4 gt[2][2];
#pragma unroll
        for (int bj = 0; bj < 2; ++bj)
#pragma unroll
            for (int n = 0; n < 2; ++n) gt[bj][n] = *(const f32x4*)(gate + cond * 6144 + col0 + bj * HALF + n * 4);
#pragma unroll
        for (int ai = 0; ai < 2; ++ai)
#pragma unroll
            for (int m = 0; m < 4; ++m) { const int row = row0 + ai * HALF + m * 16; const unsigned ro = (unsigned)row * 1024u + (unsigned)col0;
                float sq = 0.f;
#pragma unroll
                for (int bj = 0; bj < 2; ++bj) { const u32x4 xw = *(const u32x4*)(XB + ro + bj * HALF);
                    f32x4 x0 = (f32x4){__builtin_bit_cast(float, xw.x << 16), __builtin_bit_cast(float, xw.x & 0xffff0000u), __builtin_bit_cast(float, xw.y << 16), __builtin_bit_cast(float, xw.y & 0xffff0000u)};
                    f32x4 x1 = (f32x4){__builtin_bit_cast(float, xw.z << 16), __builtin_bit_cast(float, xw.z & 0xffff0000u), __builtin_bit_cast(float, xw.w << 16), __builtin_bit_cast(float, xw.w & 0xffff0000u)};
                    x0 += gt[bj][0] * acc[ai][bj][m][0]; x1 += gt[bj][1] * acc[ai][bj][m][1];
                    sq += ((x0[0] * x0[0] + x0[1] * x0[1]) + (x0[2] * x0[2] + x0[3] * x0[3])) + ((x1[0] * x1[0] + x1[1] * x1[1]) + (x1[2] * x1[2] + x1[3] * x1[3])); }
                const float t = xsum_fq(sq, fr, fq); if (fq == 0) atomicAdd(ssq + row, t);
                if (m & 1) asm volatile("" ::: "memory"); }
        asm volatile("s_waitcnt vmcnt(0)" ::: "memory");
        unsigned* c = cnt + 64 * u.pm;
        if (fr == 0 && fq == 0) { __hip_atomic_fetch_add(c, 1u, __ATOMIC_RELAXED, __HIP_MEMORY_SCOPE_AGENT);
            for (unsigned spin = 0; __hip_atomic_load(c, __ATOMIC_RELAXED, __HIP_MEMORY_SCOPE_AGENT) < 32u && spin < (1u << 22); ++spin) __builtin_amdgcn_s_sleep(2); }
        asm volatile("" ::: "memory");
        f32x4 gv[2][2];
#pragma unroll
        for (int bj = 0; bj < 2; ++bj)
#pragma unroll
            for (int n = 0; n < 2; ++n) gv[bj][n] = *(const f32x4*)(gfin + col0 + bj * HALF + n * 4);
#pragma unroll
        for (int ai = 0; ai < 2; ++ai)
#pragma unroll
            for (int m = 0; m < 4; ++m) { const int row = row0 + ai * HALF + m * 16; const unsigned ro = (unsigned)row * 1024u + (unsigned)col0;
                const float rstd = __builtin_amdgcn_rsqf(__hip_atomic_load(ssq + row, __ATOMIC_RELAXED, __HIP_MEMORY_SCOPE_AGENT) * (1.0f / 1024.0f) + 1e-6f);
#pragma unroll
                for (int bj = 0; bj < 2; ++bj) { const u32x4 xw = *(const u32x4*)(XB + ro + bj * HALF);
                    f32x4 x0 = (f32x4){__builtin_bit_cast(float, xw.x << 16), __builtin_bit_cast(float, xw.x & 0xffff0000u), __builtin_bit_cast(float, xw.y << 16), __builtin_bit_cast(float, xw.y & 0xffff0000u)};
                    f32x4 x1 = (f32x4){__builtin_bit_cast(float, xw.z << 16), __builtin_bit_cast(float, xw.z & 0xffff0000u), __builtin_bit_cast(float, xw.w << 16), __builtin_bit_cast(float, xw.w & 0xffff0000u)};
                    f32x4 ga = gt[bj][0], gb = gt[bj][1]; asm volatile("" : "+v"(ga), "+v"(gb));
                    x0 += ga * acc[ai][bj][m][0]; x1 += gb * acc[ai][bj][m][1];
                    *(f32x4*)(out + ro + bj * HALF) = x0 * rstd * gv[bj][0]; *(f32x4*)(out + ro + bj * HALF + 4) = x1 * rstd * gv[bj][1]; }
                if (m & 1) asm volatile("" ::: "memory"); }
    }
};
template <bool SRC_F32, bool WRITE_H> struct EpiResNorm {
    static constexpr bool PERM = true, AFTER_DRAIN = false;
    bf16_t* XB; const float* gate; const float* Xc; const float* Xl; bf16_t* H; const float* gn; const float* scl; float* ssq;
    __device__ __forceinline__ void operator()(const f32x4 (&acc)[2][2][4][2], const Unit& u, int wr, int wc, int fr, int fq) const {
        const int row0 = u.pm * BM + wr * 64 + fr, col0 = u.pn * BM + wc * 32 + 8 * fq;
        const int cond = u.pm < 32 ? 0 : 1 + ((u.pm - 32) >> 2);
        const float* src = u.pm < 32 ? Xc : Xl - (size_t)8192 * 1024;
        f32x4 gt[2][2], gs[2][2];
#pragma unroll
        for (int bj = 0; bj < 2; ++bj)
#pragma unroll
            for (int n = 0; n < 2; ++n) { const int col = col0 + bj * HALF + n * 4;
                gt[bj][n] = *(const f32x4*)(gate + cond * 6144 + col);
                if (WRITE_H) gs[bj][n] = *(const f32x4*)(gn + col) * (*(const f32x4*)(scl + cond * 6144 + col) + 1.0f); }
#pragma unroll
        for (int ai = 0; ai < 2; ++ai)
#pragma unroll
            for (int m = 0; m < 4; ++m) { const int row = row0 + ai * HALF + m * 16; const unsigned ro = (unsigned)row * 1024u + (unsigned)col0;
                float sq = 0.f;
#pragma unroll
                for (int bj = 0; bj < 2; ++bj) { const unsigned o = ro + bj * HALF;
                    f32x4 x0, x1;
                    if (SRC_F32) { x0 = *(const f32x4*)(src + o); x1 = *(const f32x4*)(src + o + 4); }
                    else { const u32x4 xw = *(const u32x4*)(XB + o);
                        x0 = (f32x4){__builtin_bit_cast(float, xw.x << 16), __builtin_bit_cast(float, xw.x & 0xffff0000u), __builtin_bit_cast(float, xw.y << 16), __builtin_bit_cast(float, xw.y & 0xffff0000u)};
                        x1 = (f32x4){__builtin_bit_cast(float, xw.z << 16), __builtin_bit_cast(float, xw.z & 0xffff0000u), __builtin_bit_cast(float, xw.w << 16), __builtin_bit_cast(float, xw.w & 0xffff0000u)}; }
                    x0 += gt[bj][0] * acc[ai][bj][m][0]; x1 += gt[bj][1] * acc[ai][bj][m][1];
                    u32x4 xo; xo.x = cvt_pk_bf16(x0[0], x0[1]); xo.y = cvt_pk_bf16(x0[2], x0[3]); xo.z = cvt_pk_bf16(x1[0], x1[1]); xo.w = cvt_pk_bf16(x1[2], x1[3]);
                    *(u32x4*)(XB + o) = xo;
                    sq += ((x0[0] * x0[0] + x0[1] * x0[1]) + (x0[2] * x0[2] + x0[3] * x0[3])) + ((x1[0] * x1[0] + x1[1] * x1[1]) + (x1[2] * x1[2] + x1[3] * x1[3]));
                    if (WRITE_H) { const f32x4 h0 = x0 * gs[bj][0], h1 = x1 * gs[bj][1];
                        u32x4 w; w.x = cvt_pk_bf16(h0[0], h0[1]); w.y = cvt_pk_bf16(h0[2], h0[3]); w.z = cvt_pk_bf16(h1[0], h1[1]); w.w = cvt_pk_bf16(h1[2], h1[3]);
                        *(u32x4*)(H + o) = w; } }
                const float t = xsum_fq(sq, fr, fq); if (fq == 0) atomicAdd(ssq + row, t);
                asm volatile("" ::: "memory"); }
    }
};
template <class Epi, class Sched, bool ALIGN_EPI = false, bool SP2 = false>
__device__ __forceinline__ void gemm_phase(PG8_LAS unsigned char* lds, const Gemm g, const Sched& S, const Epi& E) {
    const int tid = opaque_tid(), wid = __builtin_amdgcn_readfirstlane(tid >> 6), lane = tid & 63, wr = wid >> 2, wc = wid & 3, fr = lane & 15, fq = lane >> 4;
    const int K = g.K, nt = K / BK;
    unsigned voffA[2], voffB[2];
#pragma unroll
    for (int i = 0; i < 2; ++i) { int R, C; stage_rc(tid * 16 + i * 8192, R, C); const int Rb = E.PERM ? ((R & ~31) + perm32(R & 31)) : R;
        voffA[i] = (unsigned)(R * g.lda + C) * 2u; voffB[i] = (unsigned)(Rb * g.ldb + C) * 2u; }
    const size_t kstep = (size_t)(BK * 2);
    const size_t hstepA = (size_t)HALF * g.lda * 2, hstepB = (size_t)HALF * g.ldb * 2;
    const size_t tstepA = 2 * hstepA, tstepB = 2 * hstepB;
    const unsigned ldsw = (unsigned)wid * 1024u;
    const int aoff = lds_byte(wr * 64 + fr, fq * 8), boff = lds_byte(wc * 32 + fr, fq * 8);
#define PG8_SA(b, h) (((b) * 2 + (h)) * HTB)
#define PG8_SB(b, h) ((4 + (b) * 2 + (h)) * HTB)
#define PG8_STAGE(bufoff, gbase, voff) do { _Pragma("unroll") for (int _i = 0; _i < 2; ++_i) \
        __builtin_amdgcn_global_load_lds((const unsigned*)((const char*)(gbase) + (voff)[_i]), (PG8_LAS unsigned*)(lds + (bufoff) + ldsw + _i * 8192), 16, 0, 0); } while (0)
#define PG8_LDA(dst, b, h) do { _Pragma("unroll") for (int m = 0; m < 4; ++m) _Pragma("unroll") for (int k = 0; k < 2; ++k) dst[m][k] = *(const PG8_LAS bf16x8*)(lds + PG8_SA(b, h) + aoff + m * 2048 + k * 1024); } while (0)
#define PG8_LDB(dst, b, h) do { _Pragma("unroll") for (int n = 0; n < 2; ++n) _Pragma("unroll") for (int k = 0; k < 2; ++k) dst[n][k] = *(const PG8_LAS bf16x8*)(lds + PG8_SB(b, h) + boff + n * 2048 + k * 1024); } while (0)
#define PG8_MMA(ai, bj, At, Bt) do { __builtin_amdgcn_s_setprio(1); _Pragma("unroll") for (int m = 0; m < 4; ++m) _Pragma("unroll") for (int n = 0; n < 2; ++n) _Pragma("unroll") for (int k = 0; k < 2; ++k) \
        acc[ai][bj][m][n] = __builtin_amdgcn_mfma_f32_16x16x32_bf16(Bt[n][k], At[m][k], acc[ai][bj][m][n], 0, 0, 0); __builtin_amdgcn_s_setprio(0); } while (0)
#define PG8_WAIT_V(n) asm volatile("s_waitcnt vmcnt(" #n ")" ::: "memory")
#define PG8_WAIT_L(n) asm volatile("s_waitcnt lgkmcnt(" #n ")" ::: "memory")
#define PG8_BAR __builtin_amdgcn_s_barrier()
#define PG8_SCHED __builtin_amdgcn_sched_barrier(0)
    Unit cur, nxt; int ui = 0;
    if (!S.next(0, cur)) return;
    f32x4 acc[2][2][4][2];
#pragma unroll
    for (int a = 0; a < 2; ++a)
#pragma unroll
        for (int b = 0; b < 2; ++b)
#pragma unroll
            for (int m = 0; m < 4; ++m)
#pragma unroll
                for (int n = 0; n < 2; ++n) acc[a][b][m][n] = (f32x4){0.f, 0.f, 0.f, 0.f};
    bf16x8 At[4][2], B0[2][2], B1[2][2];
    const char* cA = (const char*)g.A + (size_t)cur.pm * tstepA; const char* cB = (const char*)g.Bt + (size_t)cur.pn * tstepB;
    S.a_ready(cur);
    if constexpr (SP2) {
        PG8_STAGE(PG8_SB(0, 0), cB, voffB); PG8_STAGE(PG8_SB(0, 1), cB + hstepB, voffB); PG8_STAGE(PG8_SA(0, 0), cA, voffA); PG8_STAGE(PG8_SA(0, 1), cA + hstepA, voffA);
        if (wr == 1) PG8_BAR;
        PG8_WAIT_V(2); PG8_BAR;
        PG8_STAGE(PG8_SB(1, 0), cB + kstep, voffB); PG8_STAGE(PG8_SA(1, 0), cA + kstep, voffA); PG8_STAGE(PG8_SB(1, 1), cB + hstepB + kstep, voffB);
        PG8_WAIT_V(6); PG8_BAR;
    } else {
        PG8_STAGE(PG8_SB(0, 0), cB, voffB); PG8_STAGE(PG8_SA(0, 0), cA, voffA); PG8_STAGE(PG8_SB(0, 1), cB + hstepB, voffB); PG8_STAGE(PG8_SA(0, 1), cA + hstepA, voffA);
        if (wr == 1) PG8_BAR;
        PG8_WAIT_V(4); PG8_BAR;
        PG8_STAGE(PG8_SB(1, 0), cB + kstep, voffB); PG8_STAGE(PG8_SA(1, 0), cA + kstep, voffA); PG8_STAGE(PG8_SB(1, 1), cB + hstepB + kstep, voffB);
        PG8_WAIT_V(6); PG8_BAR;
    }
    for (;;) {
        const bool has_next = S.next(ui + 1, nxt);
        const char* nA = has_next ? (const char*)g.A + (size_t)nxt.pm * tstepA : cA; const char* nB = has_next ? (const char*)g.Bt + (size_t)nxt.pn * tstepB : cB;
        for (int t = 0; t < nt; t += 2) {
            const bool last = (t == nt - 2);
            const char* a1 = cA + (size_t)(t + 1) * kstep;
            const char* a2 = last ? nA : cA + (size_t)(t + 2) * kstep; const char* b2 = last ? nB : cB + (size_t)(t + 2) * kstep;
            const char* a3 = a2 + kstep; const char* b3 = b2 + kstep;
            if (last && has_next) S.a_ready(nxt);
            if constexpr (SP2) {
            PG8_LDB(B0, 0, 0); PG8_LDB(B1, 0, 1); PG8_SCHED; PG8_LDA(At, 0, 0); PG8_STAGE(PG8_SA(1, 1), a1 + hstepA, voffA);
            PG8_WAIT_V(8); PG8_WAIT_L(0); PG8_BAR; PG8_MMA(0, 0, At, B0); PG8_MMA(0, 1, At, B1); PG8_BAR; PG8_SCHED;
            PG8_LDA(At, 0, 1); PG8_STAGE(PG8_SB(0, 0), b2, voffB); PG8_STAGE(PG8_SB(0, 1), b2 + hstepB, voffB); PG8_STAGE(PG8_SA(0, 0), a2, voffA);
            PG8_WAIT_V(8); PG8_WAIT_L(0); PG8_BAR; PG8_MMA(1, 0, At, B0); PG8_MMA(1, 1, At, B1); PG8_BAR; PG8_SCHED;
            PG8_LDB(B0, 1, 0); PG8_LDB(B1, 1, 1); PG8_SCHED; PG8_LDA(At, 1, 0); PG8_STAGE(PG8_SA(0, 1), a2 + hstepA, voffA);
            PG8_WAIT_V(8); PG8_WAIT_L(0); PG8_BAR; PG8_MMA(0, 0, At, B0); PG8_MMA(0, 1, At, B1); PG8_BAR; PG8_SCHED;
            PG8_LDA(At, 1, 1); PG8_STAGE(PG8_SB(1, 0), b3, voffB); PG8_STAGE(PG8_SB(1, 1), b3 + hstepB, voffB); PG8_STAGE(PG8_SA(1, 0), a3, voffA);
            PG8_WAIT_V(8); PG8_WAIT_L(0); PG8_BAR; PG8_MMA(1, 0, At, B0); PG8_MMA(1, 1, At, B1); PG8_BAR; PG8_SCHED;
            } else {
            PG8_LDB(B0, 0, 0); PG8_SCHED; PG8_LDA(At, 0, 0); PG8_STAGE(PG8_SA(1, 1), a1 + hstepA, voffA);
            PG8_WAIT_L(8); PG8_BAR; PG8_WAIT_L(0); PG8_MMA(0, 0, At, B0); PG8_BAR; PG8_SCHED;
            PG8_LDB(B1, 0, 1); PG8_STAGE(PG8_SB(0, 0), b2, voffB);
            PG8_BAR; PG8_WAIT_L(0); PG8_MMA(0, 1, At, B1); PG8_BAR;
            PG8_LDA(At, 0, 1); PG8_STAGE(PG8_SA(0, 0), a2, voffA);
            PG8_BAR; PG8_WAIT_L(0); PG8_MMA(1, 0, At, B0); PG8_BAR; PG8_SCHED;
            PG8_STAGE(PG8_SB(0, 1), b2 + hstepB, voffB);
            PG8_WAIT_V(6); PG8_BAR; PG8_MMA(1, 1, At, B1); PG8_BAR;
            PG8_LDB(B0, 1, 0); PG8_SCHED; PG8_LDA(At, 1, 0); PG8_STAGE(PG8_SA(0, 1), a2 + hstepA, voffA);
            PG8_WAIT_L(8); PG8_BAR; PG8_WAIT_L(0); PG8_MMA(0, 0, At, B0); PG8_BAR; PG8_SCHED;
            PG8_LDB(B1, 1, 1); PG8_STAGE(PG8_SB(1, 0), b3, voffB);
            PG8_BAR; PG8_WAIT_L(0); PG8_MMA(0, 1, At, B1); PG8_BAR;
            PG8_LDA(At, 1, 1); PG8_STAGE(PG8_SA(1, 0), a3, voffA);
            PG8_BAR; PG8_WAIT_L(0); PG8_MMA(1, 0, At, B0); PG8_BAR; PG8_SCHED;
            PG8_STAGE(PG8_SB(1, 1), b3 + hstepB, voffB);
            PG8_WAIT_V(6); PG8_BAR; PG8_MMA(1, 1, At, B1); PG8_BAR;
            }
        }
        if constexpr (ALIGN_EPI) { if (wr == 0) PG8_BAR; }
        if constexpr (!Epi::AFTER_DRAIN) { int fr2 = fr, fq2 = fq; asm volatile("" : "+v"(fr2), "+v"(fq2)); E(acc, cur, wr, wc, fr2, fq2); S.done(cur); }
        if (!has_next) break;
#pragma unroll
        for (int a = 0; a < 2; ++a)
#pragma unroll
            for (int b = 0; b < 2; ++b)
#pragma unroll
                for (int m = 0; m < 4; ++m)
#pragma unroll
                    for (int n = 0; n < 2; ++n) acc[a][b][m][n] = (f32x4){0.f, 0.f, 0.f, 0.f};
        cur = nxt; cA = nA; cB = nB; ++ui;
        if constexpr (ALIGN_EPI) { if (wr == 1) PG8_BAR; }
    }
    PG8_WAIT_V(0);
    if constexpr (!ALIGN_EPI) { if (wr == 0) PG8_BAR; }
    PG8_BAR;
    if constexpr (Epi::AFTER_DRAIN) { E.fused(acc, cur, wr, wc, fr, fq, lds, wid, lane); S.done(cur); }
#undef PG8_SA
#undef PG8_SB
#undef PG8_STAGE
#undef PG8_LDA
#undef PG8_LDB
#undef PG8_MMA
#undef PG8_WAIT_V
#undef PG8_WAIT_L
#undef PG8_BAR
#undef PG8_SCHED
}
}

#define LAS __attribute__((address_space(3)))
typedef unsigned short bf16;
typedef float f32x4 __attribute__((ext_vector_type(4)));
typedef unsigned u32x4 __attribute__((ext_vector_type(4)));
typedef unsigned u32x2 __attribute__((ext_vector_type(2)));
constexpr int DM = 1024, NCTX = 8192, MTOK = 12288, DINP = 2560, DFF = 4096;
constexpr int R_OFF = 0, K_OFF = 512, V_OFF = 1024, WD_OFF = 1536, AD_OFF = 1664, GD_OFF = 1792, F_OFF = 1920, P_OFF = 2176, DIN = 2432;
constexpr size_t MiB = 1u << 20;
constexpr size_t WS_CTL = 0, WS_MOD = 1 * MiB, WS_FW = 1 * MiB + 512 * 1024, WS_BC = 2 * MiB, WS_CS256 = 3 * MiB, WS_CS1024 = 4 * MiB, WS_WIN = 8 * MiB, WS_WOUT = 18 * MiB,
                 WS_W1 = 22 * MiB, WS_W2 = 38 * MiB, WS_H = 54 * MiB, WS_MIXED = 78 * MiB, WS_PROJ = 102 * MiB, WS_YCS = 162 * MiB, WS_YF = 102 * MiB, WS_YB = 126 * MiB  , WS_U = 174 * MiB, WS_KINV = 220 * MiB, WS_GUPT = 221 * MiB,
                 WS_FF = 102 * MiB, WS_WUPT = 222 * MiB, WS_AUPT = 222 * MiB + 256 * 1024, WS_SSQ = 223 * MiB, WS_WPT = 223 * MiB + 512 * 1024, WS_SW1 = 224 * MiB, WS_SWIN = 224 * MiB + 256 * 1024, WS_XB = 226 * MiB, WS_END = 250 * MiB;
constexpr int LDS_BYTES = 147456, RING_BYTES = 131072, MISC_OFF = RING_BYTES + 320;
constexpr int NTHR = 512;
enum { I_XP = 0, I_XS, I_STATE, I_C, I_CCTX, I_WADA, I_BADA, I_N1G, I_WIN, I_MU, I_W0, I_WUP, I_A0, I_AUP, I_GUP, I_KK, I_KA, I_RK, I_LNW, I_LNB, I_WFNET, I_WPOOL, I_PSCALE, I_WOUT, I_N2G, I_WFF1, I_WFF2, I_FNG, N_IN };
struct KP { const float* in[N_IN]; float* out; unsigned char* ws; int ph_lo, ph_hi; };
typedef const __attribute__((address_space(4))) KP CKP;

__device__ __forceinline__ unsigned f2bf(float f) { unsigned u = __builtin_bit_cast(unsigned, f); return (u + 0x7fffu + ((u >> 16) & 1u)) >> 16; }
__device__ __forceinline__ unsigned pk2(float lo, float hi) { return f2bf(lo) | (f2bf(hi) << 16); }
__device__ __forceinline__ float bflo(unsigned w) { return __builtin_bit_cast(float, w << 16); }
__device__ __forceinline__ float bfhi(unsigned w) { return __builtin_bit_cast(float, w & 0xffff0000u); }
__device__ __forceinline__ float bf1(bf16 h) { return __builtin_bit_cast(float, (unsigned)h << 16); }
__device__ __forceinline__ float fexp(float x) { return __builtin_amdgcn_exp2f(x * 1.4426950408889634f); }
__device__ __forceinline__ float flog(float x) { return __builtin_amdgcn_logf(x) * 0.6931471805599453f; }
__device__ __forceinline__ float frcp(float x) { return __builtin_amdgcn_rcpf(x); }
__device__ __forceinline__ float frsq(float x) { return __builtin_amdgcn_rsqf(x); }
__device__ __forceinline__ float fsigmoid(float x) { return frcp(1.0f + fexp(-x)); }
template <int CTRL> __device__ __forceinline__ float dppf(float x) { return __builtin_bit_cast(float, __builtin_amdgcn_update_dpp(0, __builtin_bit_cast(int, x), CTRL, 0xF, 0xF, true)); }
__device__ __forceinline__ float red8(float x)  { x += dppf<0xB1>(x); x += dppf<0x4E>(x); x += dppf<0x141>(x); return x; }
__device__ __forceinline__ float red16(float x) { x += dppf<0xB1>(x); x += dppf<0x4E>(x); x += dppf<0x141>(x); x += dppf<0x140>(x); return x; }
__device__ __forceinline__ float wave_sum(float v) {
    v = red16(v);
    const float s0 = __builtin_bit_cast(float, __builtin_amdgcn_readlane(__builtin_bit_cast(int, v), 0)), s1 = __builtin_bit_cast(float, __builtin_amdgcn_readlane(__builtin_bit_cast(int, v), 16));
    const float s2 = __builtin_bit_cast(float, __builtin_amdgcn_readlane(__builtin_bit_cast(int, v), 32)), s3 = __builtin_bit_cast(float, __builtin_amdgcn_readlane(__builtin_bit_cast(int, v), 48));
    return (s0 + s1) + (s2 + s3);
}
__device__ __forceinline__ void load4bf(const bf16* p, float (&o)[4]) { const u32x2 w = *(const u32x2*)p; o[0] = bflo(w.x); o[1] = bfhi(w.x); o[2] = bflo(w.y); o[3] = bfhi(w.y); }
__device__ __forceinline__ void load8bf(const bf16* p, float (&o)[8]) { const u32x4 w = *(const u32x4*)p; o[0] = bflo(w.x); o[1] = bfhi(w.x); o[2] = bflo(w.y); o[3] = bfhi(w.y); o[4] = bflo(w.z); o[5] = bfhi(w.z); o[6] = bflo(w.w); o[7] = bfhi(w.w); }
__device__ __forceinline__ void shift4(const bf16* proj, int row, bool hasp, bool hasn, int col, const float* mu, float (&u)[4]) {
    float p[4], a[4] = {0.f, 0.f, 0.f, 0.f}, b[4] = {0.f, 0.f, 0.f, 0.f};
    load4bf(proj + (size_t)row * DINP + col, p);
    if (hasp) load4bf(proj + (size_t)(row - 1) * DINP + col, a);
    if (hasn) load4bf(proj + (size_t)(row + 1) * DINP + col, b);
    const f32x4 m = *(const f32x4*)(mu + col);
#pragma unroll
    for (int j = 0; j < 4; ++j) u[j] = p[j] + m[j] * (0.5f * (a[j] + b[j]) - p[j]);
}

__device__ __forceinline__ void transpose_item(const float* W, int K, int N, bf16* WT, LAS float* scr, int item, int lane) {
    const int nblk = N / 32, kb = item / nblk, nb = item % nblk, k0 = 64 * kb, n0 = 32 * nb;
#pragma unroll 8
    for (int i = 0; i < 32; ++i) { const int kk = 2 * i + (lane >> 5); scr[kk * 33 + (lane & 31)] = W[(size_t)(k0 + kk) * N + n0 + (lane & 31)]; }
    asm volatile("s_waitcnt lgkmcnt(0)" ::: "memory");
    const int c = lane & 7;
#pragma unroll
    for (int j = 0; j < 4; ++j) { const int n = (lane >> 3) + 8 * j; const LAS float* s = scr + (8 * c) * 33 + n;
        u32x4 o; o.x = pk2(s[0 * 33], s[1 * 33]); o.y = pk2(s[2 * 33], s[3 * 33]); o.z = pk2(s[4 * 33], s[5 * 33]); o.w = pk2(s[6 * 33], s[7 * 33]);
        *(u32x4*)(WT + (size_t)(n0 + n) * K + k0 + 8 * c) = o; }
    asm volatile("s_waitcnt lgkmcnt(0)" ::: "memory");
}
__device__ __forceinline__ void gemv5_cols(LAS float* sc, LAS float* red, const float* W, int ldw, int colw, const float* bias, float* out, int ldo, int colo, int tid) {
    const int cgi = tid & 15, kg = tid >> 4;
    f32x4 acc[5];
#pragma unroll
    for (int c = 0; c < 5; ++c) acc[c] = (f32x4){0.f, 0.f, 0.f, 0.f};
    const float* wp = W + (size_t)(kg * 32) * ldw + colw + cgi * 4;
#pragma unroll 8
    for (int kk = 0; kk < 32; ++kk) { const f32x4 w = *(const f32x4*)(wp + (size_t)kk * ldw);
#pragma unroll
        for (int c = 0; c < 5; ++c) acc[c] += sc[c * 1024 + kg * 32 + kk] * w; }
#pragma unroll
    for (int c = 0; c < 5; ++c) *(LAS f32x4*)(red + (kg * 5 + c) * 64 + cgi * 4) = acc[c];
    __syncthreads();
    if (tid < 320) { const int cond = tid >> 6, col = tid & 63; float sm = bias ? bias[colo + col] : 0.f;
        for (int g = 0; g < 32; ++g) sm += red[(g * 5 + cond) * 64 + col];
        out[(size_t)cond * ldo + colo + col] = sm; }
    __syncthreads();
}
__device__ __forceinline__ void mod_item(CKP& p, LAS unsigned char* lds, int it) {
    const int tid = opaque_tid(); unsigned char* ws = p.ws;
    LAS float* sc = (LAS float*)lds; LAS float* red = (LAS float*)(lds + 20480);
    const int l = it / 96, cgp = it % 96;
    for (int i = tid; i < 5 * 1024; i += NTHR) { const int cond = i >> 10, k = i & 1023; const float v = cond == 0 ? p.in[I_CCTX][k] : p.in[I_C][(cond - 1) * 1024 + k]; sc[i] = v * fsigmoid(v); }
    __syncthreads();
    gemv5_cols(sc, red, p.in[I_WADA] + (size_t)l * 1024 * 6144, 6144, cgp * 64, p.in[I_BADA] + l * 6144, (float*)(ws + WS_MOD) + (size_t)l * 5 * 6144, 6144, cgp * 64, tid);
}
constexpr int TI_IN = 16 * 76, TI_OUT = 16 * 32, TI_1 = 16 * 128, TI_2 = 64 * 32, TI_L = TI_IN + TI_OUT + TI_1 + TI_2;
__device__ __forceinline__ void transpose_range(CKP& p, LAS unsigned char* lds, int first, int last, int bid, int nb) {
    const int tid = opaque_tid(), lane = tid & 63, wave = tid >> 6;
    unsigned char* ws = p.ws;
    LAS float* scr = (LAS float*)(lds + wave * 16384);
#pragma unroll 1
    for (int it = first + bid * 8 + wave; it < last; it += nb * 8) {
        const int l = it / TI_L; int r = it % TI_L;
        if (r < TI_IN) { transpose_item(p.in[I_WIN] + (size_t)l * DM * DIN, DM, DIN, (bf16*)(ws + WS_WIN) + (size_t)l * DINP * DM, scr, r, lane); continue; } r -= TI_IN;
        if (r < TI_OUT) { transpose_item(p.in[I_WOUT] + (size_t)l * DM * DM, DM, DM, (bf16*)(ws + WS_WOUT) + (size_t)l * DM * DM, scr, r, lane); continue; } r -= TI_OUT;
        if (r < TI_1) { transpose_item(p.in[I_WFF1] + (size_t)l * DM * DFF, DM, DFF, (bf16*)(ws + WS_W1) + (size_t)l * DFF * DM, scr, r, lane); continue; } r -= TI_1;
        transpose_item(p.in[I_WFF2] + (size_t)l * DFF * DM, DFF, DM, (bf16*)(ws + WS_W2) + (size_t)l * DM * DFF, scr, r, lane);
    }
}
__device__ __forceinline__ void stage_prologue(CKP& p, LAS unsigned char* lds, int bid, int nb) {
    const int tid = opaque_tid();
    unsigned char* ws = p.ws;
    transpose_range(p, lds, 0, TI_IN, bid, nb);
    const int gt = bid * NTHR + tid, NGT = nb * NTHR;
#pragma unroll 1
    for (int i = gt; i < 2 * 128 * DM / 8; i += NGT) { const int l = i / (128 * DM / 8), r = i % (128 * DM / 8);
        u32x4 z = (u32x4){0u, 0u, 0u, 0u}; asm volatile("" : "+v"(z));
        *(u32x4*)((bf16*)(ws + WS_WIN) + (size_t)l * DINP * DM + (size_t)DIN * DM + (size_t)r * 8) = z; }
    __syncthreads();
#pragma unroll 1
    for (int it = bid; it < 192; it += nb) mod_item(p, lds, it);
}
__device__ __forceinline__ void stage_tables(CKP& p, int bid, int nb) {
    const int tid = opaque_tid(); unsigned char* ws = p.ws;
    const int gt = bid * NTHR + tid, NGT = nb * NTHR;
#pragma unroll 1
    for (int i = gt; i < 256 * 512 + 1024 * 2048; i += NGT) {
        int L, k, j; bf16* dst;
        if (i < 256 * 512) { L = 256; k = i / 512; j = i % 512; dst = (bf16*)(ws + WS_CS256) + i; }
        else { const int i2 = i - 256 * 512; L = 1024; k = i2 / 2048; j = i2 % 2048; dst = (bf16*)(ws + WS_CS1024) + i2; }
        const int jj = j >= L ? j - L : j; const int idx = (k * jj) & (L - 1);
        const float rev = (float)idx * (L == 256 ? (1.0f / 256.0f) : (1.0f / 1024.0f));
        *dst = (bf16)f2bf(j >= L ? -__builtin_amdgcn_sinf(rev) : __builtin_amdgcn_cosf(rev));
    }
#pragma unroll 1
    for (int i = gt; i < 2 * 4 * 64 * 128; i += NGT) {
        const int o = i & 127, c = (i >> 7) & 63, lg = i >> 13; const float* wf = p.in[I_WFNET] + (size_t)lg * 4096 + (o & 63);
        float acc = 0.f;
        if (o < 64) { for (int cp = 0; cp < 64; ++cp) acc += __builtin_amdgcn_cosf((float)((c * cp) & 63) * (1.0f / 64.0f)) * wf[cp * 64]; }
        else { for (int cp = 0; cp < 64; ++cp) acc += __builtin_amdgcn_sinf((float)((c * cp) & 63) * (1.0f / 64.0f)) * wf[cp * 64]; }
        ((bf16*)(ws + WS_FW))[(size_t)(lg * 128 + o) * 64 + c] = (bf16)f2bf(acc);
    }
#pragma unroll 1
    for (int i = gt; i < 2 * 4 * 64 * 64; i += NGT) { const int o = i & 63, c = (i >> 6) & 63, lg = i >> 12;
        ((bf16*)(ws + WS_WPT))[(size_t)(lg * 64 + o) * 64 + c] = (bf16)f2bf(p.in[I_WPOOL][i]); }
#pragma unroll 1
    for (int i = gt; i < 2 * 2 * 64 * 512; i += NGT) { const int c = i & 511, r = (i >> 9) & 63, ld = i >> 15;
        ((bf16*)(ws + WS_WUPT))[(size_t)(ld * 512 + c) * 64 + r] = (bf16)f2bf(p.in[I_WUP][i]);
        ((bf16*)(ws + WS_AUPT))[(size_t)(ld * 512 + c) * 64 + r] = (bf16)f2bf(p.in[I_AUP][i]); }
#pragma unroll 1
    for (int i = gt; i < 2 * 128 * 512; i += NGT) { const int c = i & 511, r = (i >> 9) & 127, ll = i >> 16;
        ((bf16*)(ws + WS_GUPT))[(size_t)(ll * 512 + c) * 128 + r] = (bf16)f2bf(p.in[I_GUP][i]); }
}
__device__ __forceinline__ void shiftw_item(CKP& p, LAS unsigned char* lds, int it) {
    const int tid = opaque_tid();
    unsigned char* ws = p.ws;
    LAS float* sc = (LAS float*)lds; LAS float* red = (LAS float*)(lds + 20480);
    const bool isin = it >= 128; const int l = isin ? 1 : it >> 6, blk = isin ? it - 128 : it & 63;
    const float* shv = (const float*)(ws + WS_MOD) + (size_t)l * 5 * 6144 + (isin ? 0 : 3 * 1024);
    for (int i = tid; i < 5 * 1024; i += NTHR) sc[i] = shv[(i >> 10) * 6144 + (i & 1023)];
    __syncthreads();
    if (isin) gemv5_cols(sc, red, p.in[I_WIN] + (size_t)DM * DIN, DIN, blk * 64, nullptr, (float*)(ws + WS_SWIN), DINP, blk * 64, tid);
    else gemv5_cols(sc, red, p.in[I_WFF1] + (size_t)l * DM * DFF, DFF, blk * 64, nullptr, (float*)(ws + WS_SW1) + (size_t)l * 5 * DFF, DFF, blk * 64, tid);
    if (it == 165) for (int i = tid; i < 5 * 128; i += NTHR) ((float*)(ws + WS_SWIN))[(i >> 7) * DINP + DIN + (i & 127)] = 0.f;
}
__device__ __forceinline__ void side_queue(CKP& p, int l, LAS unsigned char* lds) {
    const int tid = opaque_tid();
    unsigned* ctr = (unsigned*)(p.ws + WS_CTL + 524288) + 64 * l;
    volatile LAS unsigned* slot = (volatile LAS unsigned*)(lds + RING_BYTES + 64);
    const int nmd = 0, nsh = l == 0 ? 166 : 0, first = l == 0 ? TI_IN : TI_L + TI_IN, nch = ((l == 0 ? TI_L + TI_IN : 2 * TI_L) - first) / 8;
    __syncthreads();
#pragma unroll 1
    for (;;) {
        if (tid == 0) *slot = atomicAdd(ctr, 1u);
        __syncthreads();
        const int it = (int)*slot;
        __syncthreads();
        if (it >= nmd + nsh + nch) break;
        if (it < nmd) mod_item(p, lds, 96 + it);
        else if (it < nmd + nsh) shiftw_item(p, lds, it - nmd);
        else { const int c0 = first + 8 * (it - nmd - nsh); transpose_range(p, lds, c0, c0 + 8, 0, 1); }
        __syncthreads();
    }
}

__device__ __forceinline__ void stage_norm(CKP& p, int l, int which, int bid, int nb) {
    const int tid = opaque_tid(), lane = tid & 63, wave = tid >> 6;
    const float* g = p.in[which ? I_N2G : I_N1G] + l * DM;
    const float* mod = (const float*)(p.ws + WS_MOD) + (size_t)l * 5 * 6144 + (which ? 3 * 1024 : 0);
    bf16* H = (bf16*)(p.ws + WS_H);
#pragma unroll 1
    for (int row0 = bid * 8 + wave; row0 < MTOK; row0 += nb * 16) {
        f32x4 v[2][4]; float s[2];
#pragma unroll
        for (int z = 0; z < 2; ++z) { const int row = min(row0 + z * nb * 8, MTOK - 1);
            const float* xsrc = (l == 0 && which == 0) ? (row < NCTX ? p.in[I_XP] + (size_t)row * DM : p.in[I_XS] + (size_t)(row - NCTX) * DM) : p.out + (size_t)row * DM;
            const f32x4* xr = (const f32x4*)xsrc + lane;
#pragma unroll
            for (int j = 0; j < 4; ++j) v[z][j] = xr[64 * j]; }
#pragma unroll
        for (int z = 0; z < 2; ++z) { const int row = row0 + z * nb * 8;
            s[z] = 0.f;
#pragma unroll
            for (int j = 0; j < 4; ++j) s[z] += (v[z][j].x * v[z][j].x + v[z][j].y * v[z][j].y) + (v[z][j].z * v[z][j].z + v[z][j].w * v[z][j].w);
            const float rstd = frsq(wave_sum(s[z]) * (1.0f / DM) + 1e-6f);
            if (row < MTOK) {
                const int cond = row < NCTX ? 0 : 1 + ((row - NCTX) >> 10);
                const float* sh = mod + cond * 6144; const float* scl = sh + 1024;
                unsigned long long* o8 = (unsigned long long*)(H + (size_t)row * DM) + lane;
#pragma unroll
                for (int j = 0; j < 4; ++j) { const int col = 4 * lane + 256 * j; const f32x4 gg = *(const f32x4*)(g + col), a = *(const f32x4*)(sh + col), b = *(const f32x4*)(scl + col);
                    const f32x4 y = v[z][j] * rstd * gg * (b + 1.0f) + a;
                    o8[64 * j] = (unsigned long long)pk2(y.x, y.y) | ((unsigned long long)pk2(y.z, y.w) << 32); } } }
    }
}
__device__ __forceinline__ void stage_final(CKP& p, int bid, int nb) {
    const int tid = opaque_tid(), lane = tid & 63, wave = tid >> 6;
    const float* g = p.in[I_FNG];
    const bf16* XB = (const bf16*)(p.ws + WS_XB); const float* ssq = (const float*)(p.ws + WS_CTL + 262144) + 49152;
    const f32x4 g0 = *(const f32x4*)(g + 8 * lane), g1 = *(const f32x4*)(g + 8 * lane + 4), g2 = *(const f32x4*)(g + 512 + 8 * lane), g3 = *(const f32x4*)(g + 512 + 8 * lane + 4);
#pragma unroll 1
    for (int row = bid * 8 + wave; row < MTOK; row += nb * 8) {
        const float rstd = frsq(ssq[row] * (1.0f / DM) + 1e-6f);
        const u32x4 a = *(const u32x4*)(XB + (size_t)row * DM + 8 * lane), b = *(const u32x4*)(XB + (size_t)row * DM + 512 + 8 * lane);
        float* o = p.out + (size_t)row * DM + 8 * lane;
        *(f32x4*)o = (f32x4){bflo(a.x), bfhi(a.x), bflo(a.y), bfhi(a.y)} * rstd * g0; *(f32x4*)(o + 4) = (f32x4){bflo(a.z), bfhi(a.z), bflo(a.w), bfhi(a.w)} * rstd * g1;
        *(f32x4*)(o + 512) = (f32x4){bflo(b.x), bfhi(b.x), bflo(b.y), bfhi(b.y)} * rstd * g2; *(f32x4*)(o + 516) = (f32x4){bflo(b.z), bfhi(b.z), bflo(b.w), bfhi(b.w)} * rstd * g3;
    }
}


typedef short bf16x8 __attribute__((ext_vector_type(8)));
typedef float f32x2v __attribute__((ext_vector_type(2)));
typedef __bf16 bf16x2v __attribute__((ext_vector_type(2)));
#define MFMA16(a, b, c) __builtin_amdgcn_mfma_f32_16x16x32_bf16((a), (b), (c), 0, 0, 0)
__device__ __forceinline__ unsigned cvt2(float lo, float hi) { f32x2v v = {lo, hi}; bf16x2v b = __builtin_convertvector(v, bf16x2v); return __builtin_bit_cast(unsigned, b); }
__device__ __forceinline__ u32x4 pack8(const float (&x)[8]) { u32x4 w; w.x = cvt2(x[0], x[1]); w.y = cvt2(x[2], x[3]); w.z = cvt2(x[4], x[5]); w.w = cvt2(x[6], x[7]); return w; }
__device__ __forceinline__ void shift8(const bf16* proj, int row, bool hasp, bool hasn, int col, const float* mu, float (&u)[8]) {
    float p[8], a[8], b[8];
    load8bf(proj + (size_t)row * DINP + col, p);
    if (hasp) load8bf(proj + (size_t)(row - 1) * DINP + col, a); else {
#pragma unroll
        for (int j = 0; j < 8; ++j) a[j] = 0.f; }
    if (hasn) load8bf(proj + (size_t)(row + 1) * DINP + col, b); else {
#pragma unroll
        for (int j = 0; j < 8; ++j) b[j] = 0.f; }
    const f32x4 m0 = *(const f32x4*)(mu + col), m1 = *(const f32x4*)(mu + col + 4);
#pragma unroll
    for (int j = 0; j < 4; ++j) { u[j] = p[j] + m0[j] * (0.5f * (a[j] + b[j]) - p[j]); u[4 + j] = p[4 + j] + m1[j] * (0.5f * (a[4 + j] + b[4 + j]) - p[4 + j]); }
}
__device__ __forceinline__ int opq(int x) { asm volatile("" : "+v"(x)); return x; }
constexpr int TS = 72, TB = 64 * TS * 2;
constexpr int L_HT = 0, L_TW = 9216, L_AD = 18432, L_LP = 27648, L_AP = 45056, L_AT = 62464, L_RT = L_AT + TB, L_BH = L_RT + TB, L_KH = L_BH + TB, L_VR = L_KH + TB, L_YS = L_VR + TB;
constexpr int L_AAB = L_TW, L_AAK = L_AAB + 4096, L_ARB = L_AAK + 3072, L_ARK = L_ARB + 3072, L_UT = L_ARK + 3072, L_W1 = L_AP;
static_assert(L_UT + 64 * 24 * 2 <= L_LP && L_YS + 17408 <= RING_BYTES, "scan LDS map");
constexpr int LPS = 68;
#define LBAR() asm volatile("s_waitcnt lgkmcnt(0)\n\ts_barrier" ::: "memory")
typedef short s16x4v __attribute__((ext_vector_type(4)));
__device__ __forceinline__ bf16x8 tr8(const LAS bf16* p) {
    const s16x4v lo = __builtin_bit_cast(s16x4v, __builtin_amdgcn_ds_read_tr16_b64_v4i16((LAS s16x4v*)p));
    const s16x4v hi = __builtin_bit_cast(s16x4v, __builtin_amdgcn_ds_read_tr16_b64_v4i16((LAS s16x4v*)(p + 4 * TS)));
    return (bf16x8){lo[0], lo[1], lo[2], lo[3], hi[0], hi[1], hi[2], hi[3]};
}

__device__ __forceinline__ void rwkv_item3(CKP& p, int l, LAS unsigned char* lds, int item) {
    const int tid0 = opaque_tid(), w = __builtin_amdgcn_readfirstlane(tid0 >> 6);
    int tid = tid0, fr = tid & 15, fg = (tid & 63) >> 4;
    int bseq, h, dir, L, base; bool lat;
    if (item < 64) { lat = true; bseq = item >> 4; h = (item >> 1) & 7; dir = item & 1; L = 1024; base = NCTX + bseq * 1024; }
    else { const int i2 = item - 64; lat = false; bseq = i2 >> 4; h = (i2 >> 1) & 7; dir = i2 & 1; L = 256; base = bseq * 256; }
    const bf16* U = (const bf16*)(p.ws + WS_U);
    const float* KINV = (const float*)(p.ws + WS_KINV);
    bf16* Yout = (bf16*)(p.ws + (dir ? WS_YB : WS_YF));
    float* BC = (float*)(p.ws + WS_BC) + (size_t)dir * MTOK * 8;
    const bf16* wupt = (const bf16*)(p.ws + WS_WUPT) + ((size_t)(l * 2 + dir) * 512 + h * 64) * 64;
    const bf16* aupt = (const bf16*)(p.ws + WS_AUPT) + ((size_t)(l * 2 + dir) * 512 + h * 64) * 64;

    LAS float* LP = (LAS float*)(lds + L_LP); LAS float* AP = (LAS float*)(lds + L_AP); LAS float* AS = (LAS float*)(lds + L_TW);
    LAS bf16* AT = (LAS bf16*)(lds + L_AT);   LAS bf16* RT = (LAS bf16*)(lds + L_RT);   LAS bf16* BH = (LAS bf16*)(lds + L_BH);   LAS bf16* KH = (LAS bf16*)(lds + L_KH);
    LAS bf16* VR = (LAS bf16*)(lds + L_VR);   LAS float* YS = (LAS float*)(lds + L_YS);
    LAS float* AAB = (LAS float*)(lds + L_AAB); LAS bf16* AAK = (LAS bf16*)(lds + L_AAK); LAS bf16* ARB = (LAS bf16*)(lds + L_ARB); LAS bf16* ARK = (LAS bf16*)(lds + L_ARK);
    LAS float* W1 = (LAS float*)(lds + L_W1);
    const int tv = w & 3;
    f32x4 hacc[4];
#pragma unroll
    for (int x = 0; x < 4; ++x) {
        if (lat && w < 4) hacc[x] = *(const f32x4*)(p.in[I_STATE] + ((((size_t)bseq * 2 + l) * 2 + dir) * 8 + h) * 4096 + (16 * tv + fr) * 64 + 16 * x + 4 * fg);
        else hacc[x] = (f32x4){0.f, 0.f, 0.f, 0.f}; }
    int ei = tid >> 3, ec8 = (tid & 7) * 8; const int hc8 = h * 64 + ec8;
    float kkp[8], kap[8], rkp[8];
#pragma unroll
    for (int e = 0; e < 8; ++e) { kkp[e] = p.in[I_KK][l * 512 + hc8 + e]; kap[e] = p.in[I_KA][l * 512 + hc8 + e]; rkp[e] = p.in[I_RK][l * 512 + hc8 + e]; }
#define SCAN_PREFETCH(SC) do { const int _t0 = opq(tid0), _ei = _t0 >> 3, _ec8 = (_t0 & 7) * 8; const int _step = (SC) * 64 + _ei, _t = dir ? L - 1 - _step : _step; \
        const bf16* _u = U + (size_t)(base + _t) * 1920; \
        nr = *(const u32x4*)(_u + R_OFF + h * 64 + _ec8); nk = *(const u32x4*)(_u + K_OFF + h * 64 + _ec8); nv = *(const u32x4*)(_u + V_OFF + h * 64 + _ec8); \
        ninv = KINV[(size_t)(base + _t) * 8 + h]; \
        const int _st2 = (SC) * 64 + 16 * (w >> 1) + (_t0 & 15), _t2 = dir ? L - 1 - _st2 : _st2; const bf16* _u2 = U + (size_t)(base + _t2) * 1920 + dir * 64 + ((_t0 & 63) >> 4) * 8; \
        paw0 = *(const bf16x8*)(_u2 + WD_OFF); paw1 = *(const bf16x8*)(_u2 + WD_OFF + 32); paa0 = *(const bf16x8*)(_u2 + AD_OFF); paa1 = *(const bf16x8*)(_u2 + AD_OFF + 32); } while (0)
    bf16x8 lbw[2][2], lba[2][2]; float lw0c[2], la0c[2];
#pragma unroll
    for (int x = 0; x < 2; ++x) { const int c = ((w & 1) * 2 + x) * 16 + fr;
        lbw[x][0] = *(const bf16x8*)(wupt + c * 64 + fg * 8); lbw[x][1] = *(const bf16x8*)(wupt + c * 64 + 32 + fg * 8);
        lba[x][0] = *(const bf16x8*)(aupt + c * 64 + fg * 8); lba[x][1] = *(const bf16x8*)(aupt + c * 64 + 32 + fg * 8);
        lw0c[x] = p.in[I_W0][(l * 2 + dir) * 512 + h * 64 + c]; la0c[x] = p.in[I_A0][(l * 2 + dir) * 512 + h * 64 + c]; }
    u32x4 nr, nk, nv; float ninv; bf16x8 paw0, paw1, paa0, paa1;
    SCAN_PREFETCH(0);
    __syncthreads();
#pragma unroll 1
    for (int sc = 0; sc < L / 64; ++sc) {
        tid = opq(tid0); fr = tid & 15; fg = (tid & 63) >> 4; ei = tid >> 3; ec8 = (tid & 7) * 8;
        const u32x4 cr = nr, ck = nk, cv = nv; const float kinv = ninv;
        { const int ti = w >> 1;
          const bf16x8 aw0 = paw0, aw1 = paw1, aa0 = paa0, aa1 = paa1;
          unsigned li[2], ls[2];
#pragma unroll
          for (int pr = 0; pr < 2; ++pr) { const int j0 = 4 * fg + 2 * pr, j1 = j0 + 1;
              li[pr] = (j0 <= fr ? 0x3f80u : 0u) | (j1 <= fr ? 0x3f800000u : 0u); ls[pr] = (j0 < fr ? 0x3f80u : 0u) | (j1 < fr ? 0x3f800000u : 0u); }
          const bf16x8 Li = __builtin_bit_cast(bf16x8, (u32x4){li[0], li[1], 0u, 0u}), Ls = __builtin_bit_cast(bf16x8, (u32x4){ls[0], ls[1], 0u, 0u});
#pragma unroll
          for (int x = 0; x < 2; ++x) { const int c = ((w & 1) * 2 + x) * 16 + fr;
              f32x4 cw = (f32x4){lw0c[x], lw0c[x], lw0c[x], lw0c[x]}, ca = (f32x4){la0c[x], la0c[x], la0c[x], la0c[x]};
              cw = MFMA16(aw0, lbw[x][0], cw); cw = MFMA16(aw1, lbw[x][1], cw); ca = MFMA16(aa0, lba[x][0], ca); ca = MFMA16(aa1, lba[x][1], ca);
              float lw[4], lo[4];
#pragma unroll
              for (int r = 0; r < 4; ++r) lw[r] = -0.6065306597126334f * fsigmoid(cw[r]);
              const unsigned h01 = cvt2(lw[0], lw[1]), h23 = cvt2(lw[2], lw[3]);
              lo[0] = lw[0] - bflo(h01); lo[1] = lw[1] - bfhi(h01); lo[2] = lw[2] - bflo(h23); lo[3] = lw[3] - bfhi(h23);
              const bf16x8 bh = __builtin_bit_cast(bf16x8, (u32x4){h01, h23, 0u, 0u}), bl = __builtin_bit_cast(bf16x8, (u32x4){cvt2(lo[0], lo[1]), cvt2(lo[2], lo[3]), 0u, 0u});
              f32x4 ci = (f32x4){0.f, 0.f, 0.f, 0.f}, cs = ci;
              ci = MFMA16(Li, bh, ci); ci = MFMA16(Li, bl, ci); cs = MFMA16(Ls, bh, cs); cs = MFMA16(Ls, bl, cs);
#pragma unroll
              for (int r = 0; r < 4; ++r) { const int o = (ti * 16 + 4 * fg + r) * LPS + c;
                  LP[o] = fexp(ci[r]); AP[o] = fexp(cs[r]); AS[o] = fsigmoid(ca[r]); } } }
        __syncthreads();
        tid = opq(tid0); fr = tid & 15; fg = (tid & 63) >> 4; ei = tid >> 3; ec8 = (tid & 7) * 8;
        float bcv;
        { const f32x4 g0 = *(const LAS f32x4*)(LP + ei * LPS + ec8), g1 = *(const LAS f32x4*)(LP + ei * LPS + ec8 + 4);
          const f32x4 p0 = *(const LAS f32x4*)(AP + ei * LPS + ec8), p1 = *(const LAS f32x4*)(AP + ei * LPS + ec8 + 4);
          const f32x4 s0 = *(const LAS f32x4*)(AS + ei * LPS + ec8), s1 = *(const LAS f32x4*)(AS + ei * LPS + ec8 + 4);
          float rr[8], kk[8], xa[8], xr[8], xb[8], xk[8], bc = 0.f;
          rr[0] = bflo(cr.x); rr[1] = bfhi(cr.x); rr[2] = bflo(cr.y); rr[3] = bfhi(cr.y); rr[4] = bflo(cr.z); rr[5] = bfhi(cr.z); rr[6] = bflo(cr.w); rr[7] = bfhi(cr.w);
          kk[0] = bflo(ck.x); kk[1] = bfhi(ck.x); kk[2] = bflo(ck.y); kk[3] = bfhi(ck.y); kk[4] = bflo(ck.z); kk[5] = bfhi(ck.z); kk[6] = bflo(ck.w); kk[7] = bfhi(ck.w);
#pragma unroll
          for (int e = 0; e < 8; ++e) { const float gi = e < 4 ? g0[e & 3] : g1[e & 3], gp = e < 4 ? p0[e & 3] : p1[e & 3], asg = e < 4 ? s0[e & 3] : s1[e & 3];
              const float kj = kk[e] * kkp[e] * kinv, kd = kk[e] * (1.0f + (asg - 1.0f) * kap[e]), ginv = frcp(gi);
              bc += rr[e] * kd * rkp[e];
              xa[e] = -kj * gp; xr[e] = rr[e] * gi; xb[e] = kj * asg * ginv; xk[e] = kd * ginv; }
          bcv = red8(bc);
          *(LAS u32x4*)(AT + ei * TS + ec8) = pack8(xa); *(LAS u32x4*)(RT + ei * TS + ec8) = pack8(xr); *(LAS u32x4*)(BH + ei * TS + ec8) = pack8(xb); *(LAS u32x4*)(KH + ei * TS + ec8) = pack8(xk);
          *(LAS u32x4*)(VR + ei * TS + ec8) = cv; }
        __syncthreads();
        tid = opq(tid0); fr = tid & 15; fg = (tid & 63) >> 4;
        { const int q = w >> 1, half = w & 1; const LAS bf16* Asrc = half ? RT : AT;
          const bf16x8 af0 = *(const LAS bf16x8*)(Asrc + (16 * q + fr) * TS + fg * 8), af1 = *(const LAS bf16x8*)(Asrc + (16 * q + fr) * TS + 32 + fg * 8);
#pragma unroll
          for (int x = 0; x < 2; ++x) { const LAS bf16* Bsrc = x ? KH : BH;
              const bf16x8 bf0 = *(const LAS bf16x8*)(Bsrc + (16 * q + fr) * TS + fg * 8), bf1_ = *(const LAS bf16x8*)(Bsrc + (16 * q + fr) * TS + 32 + fg * 8);
              f32x4 c = (f32x4){0.f, 0.f, 0.f, 0.f}; c = MFMA16(af0, bf0, c); c = MFMA16(af1, bf1_, c);
              f32x4 cm;
#pragma unroll
              for (int r = 0; r < 4; ++r) { const int i = 4 * fg + r, j = fr; cm[r] = (half ? j <= i : j < i) ? c[r] : 0.f; }
              if (half == 0 && x == 0) *(LAS f32x4*)(AAB + (q * 16 + fr) * 16 + 4 * fg) = cm;
              else { LAS bf16* dst = half == 0 ? AAK : (x == 0 ? ARB : ARK);
#pragma unroll
                  for (int r = 0; r < 4; ++r) dst[(q * 16 + 4 * fg + r) * 24 + fr] = (bf16)(cvt2(cm[r], 0.f) & 0xffffu); } }
          if (half == 0) {
              const unsigned kmask = fg < 2 ? 0xffffffffu : 0u;
              const bf16x8 afr = *(const LAS bf16x8*)(AAK + (q * 16 + fr) * 24 + (fg & 1) * 8);
              const bf16x8 af = __builtin_bit_cast(bf16x8, __builtin_bit_cast(u32x4, afr) & kmask);
#pragma unroll
              for (int tvv = 0; tvv < 4; ++tvv) {
                  const bf16x8 bfr = tr8(VR + (16 * q + 8 * (fg & 1) + (fr >> 2)) * TS + 16 * tvv + 4 * (fr & 3));
                  const bf16x8 bfv = __builtin_bit_cast(bf16x8, __builtin_bit_cast(u32x4, bfr) & kmask);
                  f32x4 c = (f32x4){0.f, 0.f, 0.f, 0.f}; c = MFMA16(af, bfv, c);
#pragma unroll
                  for (int r = 0; r < 4; ++r) W1[(q * 16 + 4 * fg + r) * LPS + 16 * tvv + fr] = c[r]; } } }
        __syncthreads();
        tid = opq(tid0);
        { const int q = tid >> 7, col = tid & 127; float x[16];
          if (col < 64) {
#pragma unroll
              for (int i = 0; i < 16; ++i) x[i] = bf1(AT[(16 * q + i) * TS + col]); }
          else {
#pragma unroll
              for (int i = 0; i < 16; ++i) x[i] = W1[(q * 16 + i) * LPS + col - 64]; }
#pragma unroll
          for (int j = 0; j < 15; ++j) {
              const LAS f32x4* ac = (const LAS f32x4*)(AAB + (q * 16 + j) * 16);
#pragma unroll
              for (int i4 = (j + 1) / 4; i4 < 4; ++i4) { const f32x4 a4 = ac[i4];
#pragma unroll
                  for (int e = 0; e < 4; ++e) if (i4 * 4 + e > j) x[i4 * 4 + e] += a4[e] * x[j]; } }
          if (col < 64) {
#pragma unroll
              for (int i = 0; i < 16; ++i) AT[(16 * q + i) * TS + col] = (bf16)(cvt2(x[i], 0.f) & 0xffffu); }
          else {
#pragma unroll
              for (int i = 0; i < 16; ++i) W1[(q * 16 + i) * LPS + col - 64] = x[i]; } }
        __syncthreads();
        if (sc + 1 < L / 64) SCAN_PREFETCH(sc + 1);
        if (w < 4) {
        tid = opq(tid0); fr = tid & 15; fg = (tid & 63) >> 4;
#pragma unroll
        for (int q = 0; q < 4; ++q) {
            bf16x8 hb[2];
#pragma unroll
            for (int ks = 0; ks < 2; ++ks) { u32x4 t; t.x = cvt2(hacc[2 * ks][0], hacc[2 * ks][1]); t.y = cvt2(hacc[2 * ks][2], hacc[2 * ks][3]);
                t.z = cvt2(hacc[2 * ks + 1][0], hacc[2 * ks + 1][1]); t.w = cvt2(hacc[2 * ks + 1][2], hacc[2 * ks + 1][3]); hb[ks] = __builtin_bit_cast(bf16x8, t); }
            bf16x8 aU[2], aR[2];
#pragma unroll
            for (int ks = 0; ks < 2; ++ks) {
                const u32x2 a0 = *(const LAS u32x2*)(AT + (16 * q + fr) * TS + 32 * ks + 4 * fg), a1 = *(const LAS u32x2*)(AT + (16 * q + fr) * TS + 32 * ks + 16 + 4 * fg);
                const u32x2 r0 = *(const LAS u32x2*)(RT + (16 * q + fr) * TS + 32 * ks + 4 * fg), r1 = *(const LAS u32x2*)(RT + (16 * q + fr) * TS + 32 * ks + 16 + 4 * fg);
                aU[ks] = __builtin_bit_cast(bf16x8, (u32x4){a0.x, a0.y, a1.x, a1.y}); aR[ks] = __builtin_bit_cast(bf16x8, (u32x4){r0.x, r0.y, r1.x, r1.y}); }
            f32x4 u, yacc = (f32x4){0.f, 0.f, 0.f, 0.f};
#pragma unroll
            for (int r = 0; r < 4; ++r) u[r] = W1[(q * 16 + 4 * fg + r) * LPS + 16 * tv + fr];
            u = MFMA16(aU[0], hb[0], u); u = MFMA16(aU[1], hb[1], u);
            yacc = MFMA16(aR[0], hb[0], yacc); yacc = MFMA16(aR[1], hb[1], yacc);
            const s16x4v vtr = __builtin_bit_cast(s16x4v, __builtin_amdgcn_ds_read_tr16_b64_v4i16((LAS s16x4v*)(VR + (16 * q + 4 * fg + (fr >> 2)) * TS + 16 * tv + 4 * (fr & 3))));
            const u32x2 vt2 = __builtin_bit_cast(u32x2, vtr);
            const bf16x8 bUV = __builtin_bit_cast(bf16x8, (u32x4){cvt2(u[0], u[1]), cvt2(u[2], u[3]), vt2.x, vt2.y});
            { const u32x2 y0 = *(const LAS u32x2*)(ARB + (q * 16 + fr) * 24 + 4 * fg), y1 = *(const LAS u32x2*)(ARK + (q * 16 + fr) * 24 + 4 * fg);
              yacc = MFMA16(__builtin_bit_cast(bf16x8, (u32x4){y0.x, y0.y, y1.x, y1.y}), bUV, yacc); }
#pragma unroll
            for (int r = 0; r < 4; ++r) YS[(16 * q + 4 * fg + r) * LPS + 16 * tv + fr] = yacc[r];
#pragma unroll
            for (int x = 0; x < 4; ++x) {
                const s16x4v bt = __builtin_bit_cast(s16x4v, __builtin_amdgcn_ds_read_tr16_b64_v4i16((LAS s16x4v*)(BH + (16 * q + 4 * fg + (fr >> 2)) * TS + 16 * x + 4 * (fr & 3))));
                const s16x4v kt = __builtin_bit_cast(s16x4v, __builtin_amdgcn_ds_read_tr16_b64_v4i16((LAS s16x4v*)(KH + (16 * q + 4 * fg + (fr >> 2)) * TS + 16 * x + 4 * (fr & 3))));
                const u32x2 b2 = __builtin_bit_cast(u32x2, bt), k2 = __builtin_bit_cast(u32x2, kt);
                const f32x4 ge = *(const LAS f32x4*)(LP + (16 * q + 15) * LPS + 16 * x + 4 * fg);
                hacc[x] = MFMA16(__builtin_bit_cast(bf16x8, (u32x4){b2.x, b2.y, k2.x, k2.y}), bUV, hacc[x]) * ge; }
        }
        }
        __syncthreads();
        tid = opq(tid0); ei = tid >> 3; ec8 = (tid & 7) * 8;
        { const int st2 = sc * 64 + ei, t2 = dir ? L - 1 - st2 : st2; bf16* yo = Yout + (size_t)(base + t2) * 512 + h * 64 + ec8;
          const f32x4 y0 = *(const LAS f32x4*)(YS + ei * LPS + ec8), y1 = *(const LAS f32x4*)(YS + ei * LPS + ec8 + 4);
          u32x4 yw; yw.x = cvt2(y0[0], y0[1]); yw.y = cvt2(y0[2], y0[3]); yw.z = cvt2(y1[0], y1[1]); yw.w = cvt2(y1[2], y1[3]);
          *(u32x4*)yo = yw;
          if ((tid & 7) == 0) BC[(size_t)(base + t2) * 8 + h] = bcv; }
    }
#undef SCAN_PREFETCH
    if (!lat && w < 4) {
#pragma unroll
        for (int x = 0; x < 4; ++x) *(f32x4*)(p.out + (size_t)MTOK * DM + ((((size_t)bseq * 2 + l) * 2 + dir) * 8 + h) * 4096 + (16 * tv + fr) * 64 + 16 * x + 4 * fg) = hacc[x]; }
    __syncthreads();
}

__device__ __forceinline__ void stage_upass(CKP& p, int l, int bid, int nb) {
    const int tid = opaque_tid(), sub = tid >= 240 ? 1 : 0, j = tid - sub * 240, col = 8 * j;
    const bf16* proj = (const bf16*)(p.ws + WS_PROJ); bf16* U = (bf16*)(p.ws + WS_U); float* KINV = (float*)(p.ws + WS_KINV);
    const float* mu = p.in[I_MU] + l * 1920;
    if (tid < 480) {
        const bool isk = col >= K_OFF && col < V_OFF;
        const float* kkp = p.in[I_KK] + l * 512 + (isk ? col - K_OFF : 0);
        const f32x4 k0 = *(const f32x4*)kkp, k1 = *(const f32x4*)(kkp + 4);
#pragma unroll 1
        for (int tok0 = bid * 2 + sub; tok0 < MTOK; tok0 += nb * 8) {
            float uu[4][8];
#pragma unroll
            for (int z = 0; z < 4; ++z) { const int tok = min(tok0 + z * nb * 2, MTOK - 1);
                const bool lat = tok >= NCTX; const int L = lat ? 1024 : 256, t = lat ? (tok - NCTX) & 1023 : tok & 255;
                shift8(proj, tok, t > 0, t < L - 1, col, mu, uu[z]); }
#pragma unroll
            for (int z = 0; z < 4; ++z) { const int tok = tok0 + z * nb * 2;
                float ss = 0.f;
#pragma unroll
                for (int e = 0; e < 8; ++e) { const float kn = uu[z][e] * (e < 4 ? k0[e & 3] : k1[e & 3]); ss += kn * kn; }
                ss = red8(ss);
                if (tok < MTOK) {
                    if (isk && (j & 7) == 0) KINV[(size_t)tok * 8 + ((col - K_OFF) >> 6)] = fminf(frsq(ss), 1e12f);
                    if (col >= WD_OFF && col < AD_OFF) {
#pragma unroll
                        for (int e = 0; e < 8; ++e) uu[z][e] = 1.0f - 2.0f * frcp(fexp(2.0f * uu[z][e]) + 1.0f); }
                    if (col >= GD_OFF) {
#pragma unroll
                        for (int e = 0; e < 8; ++e) uu[z][e] = fsigmoid(uu[z][e]); }
                    *(u32x4*)(U + (size_t)tok * 1920 + col) = pack8(uu[z]); } }
        }
    }
}

__device__ __forceinline__ void fnet1_item(CKP& p, int l, int item) {
    const int tid = opaque_tid(), lane = tid & 63, w = __builtin_amdgcn_readfirstlane(tid >> 6), fr = lane & 15, fg = lane >> 4;
    const int tb = item >> 2, g = item & 3, tok0 = tb * 64, tt = w & 3, cs = w >> 2;
    const bf16* proj = (const bf16*)(p.ws + WS_PROJ);
    const bf16* fwt = (const bf16*)(p.ws + WS_FW) + (size_t)((l * 4 + g) * 128 + cs * 64) * 64;
    const bf16* xr = proj + (size_t)(tok0 + 16 * tt + fr) * DINP + F_OFF + g * 64 + fg * 8;
    const bf16x8 a0 = *(const bf16x8*)xr, a1 = *(const bf16x8*)(xr + 32);
    const bool lat = tok0 >= NCTX;
    const int L = lat ? 1024 : 256, bq = lat ? (tok0 - NCTX) >> 10 : tok0 >> 8, t = (lat ? (tok0 - NCTX) & 1023 : tok0 & 255) + 16 * tt + 4 * fg;
    const float scale = lat ? (1.0f / 256.0f) : (1.0f / 128.0f);
    bf16* Y = (bf16*)(p.ws + WS_YCS) + (lat ? (size_t)8192 * 512 : 0);
#pragma unroll
    for (int ot = 0; ot < 4; ++ot) {
        const bf16x8 b0 = *(const bf16x8*)(fwt + (16 * ot + fr) * 64 + fg * 8), b1 = *(const bf16x8*)(fwt + (16 * ot + fr) * 64 + 32 + fg * 8);
        f32x4 c = (f32x4){0.f, 0.f, 0.f, 0.f}; c = MFMA16(a0, b0, c); c = MFMA16(a1, b1, c);
        u32x2 o; o.x = cvt2(c[0] * scale, c[1] * scale); o.y = cvt2(c[2] * scale, c[3] * scale);
        *(u32x2*)(Y + (size_t)((bq * 4 + g) * 64 + 16 * ot + fr) * (2 * L) + cs * L + t) = o; }
}

__device__ __forceinline__ void pool_item(CKP& p, int l, LAS unsigned char* lds, int item) {
    const int tid = opaque_tid(), tb = item >> 2, gi = item & 3, tok0 = tb * 64, hw = 1 << gi;
    const bf16* proj = (const bf16*)(p.ws + WS_PROJ);
    LAS bf16* DB = (LAS bf16*)lds;
    LAS float* CSUM = (LAS float*)(lds + 9216);
    const int ti = tid >> 3, c8 = (tid & 7) * 8, tok = tok0 + ti, col = P_OFF + gi * 64 + c8;
    { float sum[8], x[8];
#pragma unroll
      for (int j = 0; j < 8; ++j) sum[j] = 0.f;
      load8bf(proj + (size_t)tok * DINP + col, x);
      float cnt;
      if (tok < NCTX) { const int t = tok & 255, sb = tok - t, lo = max(t - hw, 0), hi = min(t + hw, 256);
          u32x4 wv[16];
#pragma unroll
          for (int q = 0; q < 16; ++q) { const int tq = min(t - hw + q, 255); wv[q] = (q < 2 * hw && tq >= 0) ? *(const u32x4*)(proj + (size_t)(sb + max(tq, 0)) * DINP + col) : (u32x4){0u, 0u, 0u, 0u}; }
#pragma unroll
          for (int q = 0; q < 16; ++q) if (q < 2 * hw) { const bool ok = t - hw + q >= 0 && t - hw + q < 256; const u32x4 w = wv[q];
              if (ok) { sum[0] += bflo(w.x); sum[1] += bfhi(w.x); sum[2] += bflo(w.y); sum[3] += bfhi(w.y); sum[4] += bflo(w.z); sum[5] += bfhi(w.z); sum[6] += bflo(w.w); sum[7] += bfhi(w.w); } }
          cnt = (float)(hi - lo); }
      else {
          const int t = (tok - NCTX) & 1023, sb = tok - t, r = t >> 6, c = t & 63, rlo = max(r - hw, 0), rhi = min(r + hw, 16), clo = max(c - hw, 0), chi = min(c + hw, 64);
          u32x4 wv[16];
#pragma unroll
          for (int q = 0; q < 16; ++q) { const int rq = r - hw + q; wv[q] = (q < 2 * hw && rq >= 0 && rq < 16) ? *(const u32x4*)(proj + (size_t)(sb + rq * 64 + c) * DINP + col) : (u32x4){0u, 0u, 0u, 0u}; }
#pragma unroll
          for (int q = 0; q < 16; ++q) { const u32x4 w = wv[q];
              sum[0] += bflo(w.x); sum[1] += bfhi(w.x); sum[2] += bflo(w.y); sum[3] += bfhi(w.y); sum[4] += bflo(w.z); sum[5] += bfhi(w.z); sum[6] += bflo(w.w); sum[7] += bfhi(w.w); }
          *(LAS f32x4*)(CSUM + ti * 68 + c8) = (f32x4){sum[0], sum[1], sum[2], sum[3]}; *(LAS f32x4*)(CSUM + ti * 68 + c8 + 4) = (f32x4){sum[4], sum[5], sum[6], sum[7]};
          __syncthreads();
#pragma unroll
          for (int j = 0; j < 8; ++j) sum[j] = 0.f;
          for (int cq = clo; cq < chi; ++cq) { const f32x4 a = *(const LAS f32x4*)(CSUM + cq * 68 + c8), b = *(const LAS f32x4*)(CSUM + cq * 68 + c8 + 4);
#pragma unroll
              for (int j = 0; j < 4; ++j) { sum[j] += a[j]; sum[4 + j] += b[j]; } }
          cnt = (float)((rhi - rlo) * (chi - clo)); }
      const float ic = frcp(cnt);
      float dd[8];
#pragma unroll
      for (int j = 0; j < 8; ++j) dd[j] = sum[j] * ic - x[j];
      *(LAS u32x4*)(DB + ti * 72 + c8) = pack8(dd); }
    __syncthreads();
    { const int lane = tid & 63, w = __builtin_amdgcn_readfirstlane(tid >> 6), fr = lane & 15, fg = lane >> 4, tt = w & 3;
      const bf16* wpt = (const bf16*)(p.ws + WS_WPT) + (size_t)(l * 4 + gi) * 4096;
      const bf16x8 b0 = *(const LAS bf16x8*)(DB + (16 * tt + fr) * 72 + fg * 8), b1 = *(const LAS bf16x8*)(DB + (16 * tt + fr) * 72 + 32 + fg * 8);
#pragma unroll
      for (int x = 0; x < 2; ++x) { const int ot = 2 * (w >> 2) + x;
          const bf16x8 a0 = *(const bf16x8*)(wpt + (16 * ot + fr) * 64 + fg * 8), a1 = *(const bf16x8*)(wpt + (16 * ot + fr) * 64 + 32 + fg * 8);
          f32x4 c = (f32x4){0.f, 0.f, 0.f, 0.f}; c = MFMA16(a0, b0, c); c = MFMA16(a1, b1, c);
          const f32x4 ps = *(const f32x4*)(p.in[I_PSCALE] + l * 256 + gi * 64 + 16 * ot + 4 * fg);
          c *= ps;
          u32x2 o; o.x = cvt2(c[0], c[1]); o.y = cvt2(c[2], c[3]);
          *(u32x2*)((bf16*)(p.ws + WS_MIXED) + (size_t)(tok0 + 16 * tt + fr) * DM + 768 + gi * 64 + 16 * ot + 4 * fg) = o; } }
    __syncthreads();
}

__device__ __forceinline__ float xsum_fg(float s, int fr, int fg) {
    s += __builtin_bit_cast(float, __builtin_amdgcn_ds_bpermute((((fg ^ 1) << 4) | fr) << 2, __builtin_bit_cast(int, s)));
    s += __builtin_bit_cast(float, __builtin_amdgcn_ds_bpermute((((fg ^ 2) << 4) | fr) << 2, __builtin_bit_cast(int, s)));
    return s;
}
__device__ __forceinline__ void stage_post(CKP& p, int l, int bid, int nb) {
    const int tid = opaque_tid(), lane = tid & 63, head = __builtin_amdgcn_readfirstlane(tid >> 6), fr = lane & 15, fg = lane >> 4;
    const bf16* Ub = (const bf16*)(p.ws + WS_U);
    const bf16* gupt = (const bf16*)(p.ws + WS_GUPT) + ((size_t)l * 512 + head * 64) * 128;
    const bf16* YF = (const bf16*)(p.ws + WS_YF); const bf16* YB = (const bf16*)(p.ws + WS_YB);
    const float* BC0 = (const float*)(p.ws + WS_BC); const float* BC1 = BC0 + (size_t)MTOK * 8;
    bf16* MIX = (bf16*)(p.ws + WS_MIXED);
    bf16x8 ag[4][4];
    f32x4 lnw[4], lnb[4];
#pragma unroll
    for (int t = 0; t < 4; ++t) {
#pragma unroll
        for (int ks = 0; ks < 4; ++ks) ag[t][ks] = *(const bf16x8*)(gupt + (16 * t + fr) * 128 + ks * 32 + fg * 8);
        lnw[t] = *(const f32x4*)(p.in[I_LNW] + l * 512 + head * 64 + 16 * t + 4 * fg); lnb[t] = *(const f32x4*)(p.in[I_LNB] + l * 512 + head * 64 + 16 * t + 4 * fg); }
#pragma unroll 1
    for (int item = bid; item < 768; item += nb) {
        const size_t tok = (size_t)item * 16 + fr;
        bf16x8 bs[4];
#pragma unroll
        for (int ks = 0; ks < 4; ++ks) bs[ks] = *(const bf16x8*)(Ub + tok * 1920 + GD_OFF + ks * 32 + fg * 8);
        f32x4 y[4]; u32x2 vw[4];
#pragma unroll
        for (int t = 0; t < 4; ++t) { const int c = head * 64 + 16 * t + 4 * fg;
            const u32x2 yf = *(const u32x2*)(YF + tok * 512 + c), yb = *(const u32x2*)(YB + tok * 512 + c);
            y[t] = (f32x4){bflo(yf.x) + bflo(yb.x), bfhi(yf.x) + bfhi(yb.x), bflo(yf.y) + bflo(yb.y), bfhi(yf.y) + bfhi(yb.y)}; vw[t] = *(const u32x2*)(Ub + tok * 1920 + V_OFF + c); }
        const float bc = BC0[tok * 8 + head] + BC1[tok * 8 + head];
        f32x4 g[4];
#pragma unroll
        for (int t = 0; t < 4; ++t) { g[t] = (f32x4){0.f, 0.f, 0.f, 0.f};
#pragma unroll
            for (int ks = 0; ks < 4; ++ks) g[t] = MFMA16(ag[t][ks], bs[ks], g[t]); }
        float s = 0.f;
#pragma unroll
        for (int t = 0; t < 4; ++t) s += (y[t][0] + y[t][1]) + (y[t][2] + y[t][3]);
        const float mean = xsum_fg(s, fr, fg) * (1.0f / 64.0f);
        float q = 0.f;
#pragma unroll
        for (int t = 0; t < 4; ++t) { y[t] = y[t] - mean; q += (y[t][0] * y[t][0] + y[t][1] * y[t][1]) + (y[t][2] * y[t][2] + y[t][3] * y[t][3]); }
        const float rstd = frsq(xsum_fg(q, fr, fg) * (1.0f / 64.0f) + 64e-5f);
#pragma unroll
        for (int t = 0; t < 4; ++t) { const f32x4 vv = (f32x4){bflo(vw[t].x), bfhi(vw[t].x), bflo(vw[t].y), bfhi(vw[t].y)};
            const f32x4 o = (y[t] * rstd * lnw[t] + lnb[t] + vv * bc) * g[t];
            u32x2 w; w.x = cvt2(o[0], o[1]); w.y = cvt2(o[2], o[3]);
            *(u32x2*)(MIX + tok * DM + head * 64 + 16 * t + 4 * fg) = w; }
    }
}

#define XB_TMO      128
#define XB_XCNT(j)  (256  + 64 * (j))
#define XB_XSUB(j)  (1280 + 64 * (j))
#define XB_XGEN(j)  (2304 + 64 * (j))
#define XB_TOP      3328
#define XB_TOPGEN   3392
#define XCD_BAR_WORDS 3456
#define XB_SPIN_CAP (1u << 18)

__device__ __forceinline__ unsigned xb_ld(unsigned* p)              { return __hip_atomic_load(p, __ATOMIC_RELAXED, __HIP_MEMORY_SCOPE_AGENT); }
__device__ __forceinline__ unsigned xb_add(unsigned* p, unsigned v) { return __hip_atomic_fetch_add(p, v, __ATOMIC_RELAXED, __HIP_MEMORY_SCOPE_AGENT); }
__device__ __forceinline__ unsigned xb_xcc_id() { return (unsigned)__builtin_amdgcn_s_getreg((3 << 11) | 20) & 0xFu; }
#define XB_SPIN(cond, bar) do { unsigned _sp = 0; while (cond) { __builtin_amdgcn_s_sleep(1); \
    if ((++_sp & 255u) == 0u) { if (xb_ld(&(bar)[XB_TMO])) break; if (_sp > XB_SPIN_CAP) { atomicAdd(&(bar)[XB_TMO], 1u); break; } } } } while (0)

struct XcdBarrier {
    unsigned* bar; unsigned x;
    volatile LAS unsigned* st;
};

__device__ __forceinline__ XcdBarrier xcd_barrier_post(unsigned* bar, volatile LAS unsigned* st) {
    XcdBarrier b; b.bar = bar; b.x = xb_xcc_id(); b.st = st;
    if (threadIdx.x == 0) (void)xb_add(&bar[XB_XCNT(b.x)], 1u);
    return b;
}
__device__ __forceinline__ void xcd_barrier_complete(unsigned* bar, unsigned x, unsigned& nloc, unsigned& nx) {
    const unsigned G = gridDim.x * gridDim.y * gridDim.z;
    unsigned sum, cnt, mine, sp = 0u;
    for (;;) {
        sum = 0u; cnt = 0u; mine = 0u;
#pragma unroll
        for (unsigned j = 0; j < 16; ++j) { const unsigned c = xb_ld(&bar[XB_XCNT(j)]); sum += c; cnt += (c > 0u) ? 1u : 0u; mine = (j == x) ? c : mine; }
        if (sum == G) break;
        __builtin_amdgcn_s_sleep(1);
        if ((++sp & 255u) == 0u) { if (xb_ld(&bar[XB_TMO])) break; if (sp > XB_SPIN_CAP) { atomicAdd(&bar[XB_TMO], 1u); break; } }
    }
    nloc = mine > 0u ? mine : 1u; nx = cnt > 0u ? cnt : 1u;
}

__device__ __forceinline__ void xcd_barrier(const XcdBarrier& b) {
    asm volatile("s_waitcnt vmcnt(0)" ::: "memory");
    __syncthreads();
    if (threadIdx.x == 0) {
        unsigned* bar = b.bar;
        __builtin_amdgcn_s_waitcnt(0);
        unsigned nloc = b.st[0], nx = b.st[1];
        if (nloc == 0u) { xcd_barrier_complete(bar, b.x, nloc, nx); b.st[0] = nloc; b.st[1] = nx; }
        const unsigned old = xb_add(&bar[XB_XSUB(b.x)], 1u);
        const unsigned gen = old / nloc;
        if (old + 1u == (gen + 1u) * nloc) {
            __builtin_amdgcn_fence(__ATOMIC_RELEASE, "agent");
            asm volatile("s_waitcnt vmcnt(0)" ::: "memory");
            const unsigned og = xb_add(&bar[XB_TOP], 1u);
            const unsigned tg = og / nx;
            if (og + 1u == (tg + 1u) * nx) xb_add(&bar[XB_TOPGEN], 1u);
            else XB_SPIN(xb_ld(&bar[XB_TOPGEN]) == tg, bar);
            __builtin_amdgcn_fence(__ATOMIC_ACQUIRE, "agent");
            xb_add(&bar[XB_XGEN(b.x)], 1u);
            asm volatile("s_waitcnt vmcnt(0)" ::: "memory");
        } else {
            XB_SPIN(xb_ld(&bar[XB_XGEN(b.x)]) == gen, bar);
            __builtin_amdgcn_fence(__ATOMIC_ACQUIRE, "agent");
            asm volatile("s_waitcnt vmcnt(0)" ::: "memory");
        }
    }
    __syncthreads();
}

struct EpiAny {
    static constexpr bool AFTER_DRAIN = false;
    int mode; bool PERM; int l;
    __device__ __forceinline__ void operator()(const f32x4 (&acc)[2][2][4][2], const pg8::Unit& u, int wr, int wc, int fr, int fq) const {
        CKP* kp = (CKP*)__builtin_amdgcn_kernarg_segment_ptr(); asm volatile("" : "+s"(kp)); CKP& p = *kp;
        unsigned char* ws = p.ws;
        const float* mod = (const float*)(ws + WS_MOD) + (size_t)l * 5 * 6144;
        float* SSQ = (float*)(ws + WS_CTL + 262144);
        bf16* Hb = (bf16*)(ws + WS_H); bf16* XB = (bf16*)(ws + WS_XB);
        if (mode == 7) {
#pragma unroll
            for (int a = 0; a < 2; ++a)
#pragma unroll
                for (int b = 0; b < 2; ++b)
#pragma unroll
                    for (int m = 0; m < 4; ++m)
#pragma unroll
                        for (int n = 0; n < 2; ++n) asm volatile("" :: "v"(acc[a][b][m][n]));
            return; }
        if (mode == 0) { const pg8::EpiBf<0> e{(bf16*)(ws + WS_PROJ), DINP}; e(acc, u, wr, wc, fr, fq); }
        else if (mode == 2) { const pg8::EpiResFinal e{XB, mod + 5 * 1024, p.in[I_FNG], p.out, SSQ + 49152, (unsigned*)(ws + WS_CTL + 524288) + 64 * 16}; e(acc, u, wr, wc, fr, fq); }
        else if (mode == 3) { const pg8::EpiFnet e{(bf16*)(ws + WS_MIXED), 0, 256}; e(acc, u, wr, wc, fr, fq); }
        else if (mode == 8) { const pg8::EpiFnet e{(bf16*)(ws + WS_MIXED), NCTX, 1024}; e(acc, u, wr, wc, fr, fq); }
        else if (mode == 4) { const pg8::EpiNormBf<0> e{(bf16*)(ws + WS_PROJ), DINP, SSQ + 16384, (const float*)(ws + WS_SWIN), DINP}; e(acc, u, wr, wc, fr, fq); }
        else if (mode == 5) { const pg8::EpiNormBf<1> e{(bf16*)(ws + WS_FF), DFF, SSQ + l * 32768, (const float*)(ws + WS_SW1) + (size_t)l * 5 * DFF, DFF}; e(acc, u, wr, wc, fr, fq); }
        else if (mode == 6) {
            if (l == 0) { const pg8::EpiResNorm<true, true> e{XB, mod + 2 * 1024, p.in[I_XP], p.in[I_XS], Hb, p.in[I_N2G], mod + 4 * 1024, SSQ}; e(acc, u, wr, wc, fr, fq); }
            else { const pg8::EpiResNorm<false, true> e{XB, mod + 2 * 1024, nullptr, nullptr, Hb, p.in[I_N2G] + DM, mod + 4 * 1024, SSQ + 32768}; e(acc, u, wr, wc, fr, fq); } }
        else { const pg8::EpiResNorm<false, true> e{XB, mod + 5 * 1024, nullptr, nullptr, Hb, p.in[I_N1G] + DM, mod + 5 * 6144 + 1 * 1024, SSQ + 16384}; e(acc, u, wr, wc, fr, fq); }
    }
};

constexpr int N_STEPS = 16;
__device__ __forceinline__ bool step_seam(int st) { return st < 15; }
__global__ void __launch_bounds__(NTHR, 2) mega_fwd(KP p_unused) {
    extern __shared__ __attribute__((aligned(16))) unsigned char lds_raw[];
    CKP* kp0 = (CKP*)__builtin_amdgcn_kernarg_segment_ptr();
    { LAS unsigned* ctlw = (LAS unsigned*)((LAS unsigned char*)lds_raw + RING_BYTES);
      for (int u = threadIdx.x; u < (LDS_BYTES - RING_BYTES) / 4; u += NTHR) ctlw[u] = 0u; }
    __syncthreads();
    const XcdBarrier bar = xcd_barrier_post((unsigned*)(kp0->ws + WS_CTL) + 4096, (volatile LAS unsigned*)((LAS unsigned char*)lds_raw + MISC_OFF + 32));
    const int ph_lo = kp0->ph_lo, ph_hi = kp0->ph_hi;
#pragma unroll 1
#ifdef REP_A
    for (int sti = ph_lo; sti < ph_hi + ((REP_B) >= 0 ? 2 : 1); ++sti) {
        const int st = sti <= (REP_A) ? sti : (((REP_B) < 0 || sti <= (REP_B) + 1) ? sti - 1 : sti - 2);
        const bool isdup = sti == (REP_A) || ((REP_B) >= 0 && sti == (REP_B) + 1); (void)isdup;
#else
    for (int st = ph_lo; st < ph_hi; ++st) {
#endif
        CKP* kp = kp0; asm volatile("" : "+s"(kp));
        CKP& p = *kp; unsigned char* ws = p.ws;
        int bid = blockIdx.x, nb = gridDim.x; unsigned ldsb = (unsigned)(size_t)(LAS unsigned char*)lds_raw;
        asm volatile("" : "+s"(bid), "+s"(nb), "+s"(ldsb));
        LAS unsigned char* lds = (LAS unsigned char*)(size_t)ldsb;
        const int l = st < 9 ? 0 : 1, s = st == 0 ? -1 : (st == 1 ? 0 : ((st - 2) % 7 + 1));
        const float* mod = (const float*)(ws + WS_MOD) + (size_t)l * 5 * 6144;
#pragma unroll 1
        for (int job = 0; job < 2; ++job) {
            pg8::Gemm g{nullptr, nullptr, 0, 0, 0, 0, 0}; EpiAny E{-1, true, 0}; int corder = bid;
            if (job == 0) {
                if (s == 1) { g = pg8::Gemm{(const bf16*)(ws + WS_H), (const bf16*)(ws + WS_WIN) + (size_t)l * DINP * DM, MTOK, DINP, DM, DM, DM}; E = EpiAny{l == 0 ? 0 : 4, true, l}; }
                else if (s == 3) { g = pg8::Gemm{(const bf16*)(ws + WS_CS256), (const bf16*)(ws + WS_YCS), 256, 8192, 512, 512, 512}; E = EpiAny{3, true, l}; corder = (bid + nb - (nb >= 256 ? 192 : 0)) % nb; }
                else if (s == 5) { g = pg8::Gemm{(const bf16*)(ws + WS_MIXED), (const bf16*)(ws + WS_WOUT) + (size_t)l * DM * DM, MTOK, DM, DM, DM, DM}; E = EpiAny{6, true, l}; }
                else if (s == 6) { g = pg8::Gemm{(const bf16*)(ws + WS_H), (const bf16*)(ws + WS_W1) + (size_t)l * DFF * DM, MTOK, DFF, DM, DM, DM}; E = EpiAny{5, true, l}; }
                else if (s == 7) { g = pg8::Gemm{(const bf16*)(ws + WS_FF), (const bf16*)(ws + WS_W2) + (size_t)l * DM * DFF, MTOK, DM, DFF, DFF, DFF}; E = l == 0 ? EpiAny{9, true, l} : EpiAny{2, true, l}; }
            } else if (s == 3) { g = pg8::Gemm{(const bf16*)(ws + WS_CS1024), (const bf16*)(ws + WS_YCS) + (size_t)8192 * 512, 1024, 1024, 2048, 2048, 2048}; E = EpiAny{8, true, l}; corder = (bid + nb - (nb >= 256 ? 224 : 32)) % nb; }
#ifdef NOEPI_FIRST
            if (isdup && E.mode >= 0) E.mode = 7;
#endif
            if (E.mode >= 0) {
                pg8::StaticOrder S; S.init(g.M, g.N, nb, corder);
                pg8::gemm_phase<EpiAny, pg8::StaticOrder, true, true>(lds, g, S, E);
                __syncthreads();
            }
        }
        if (s == 3) {
            if (nb >= 256) {
                if (bid < 64) rwkv_item3(p, l, lds, bid);
                else { unsigned* ctr = (unsigned*)(ws + WS_CTL + 524288) + 64 * (2 + l); volatile LAS unsigned* slot = (volatile LAS unsigned*)(lds + RING_BYTES + 64);
#pragma unroll 1
                    for (;;) { __syncthreads(); if (threadIdx.x == 0) *slot = atomicAdd(ctr, 1u); __syncthreads(); const int it = (int)*slot; if (it >= 512) break; rwkv_item3(p, l, lds, 64 + it); } }
            } else for (int it = bid; it < 576; it += nb) rwkv_item3(p, l, lds, it);
            side_queue(p, l, lds);
        }
        if (s == -1) stage_prologue(p, lds, bid, nb);
        else if (s == 0) { stage_norm(p, 0, 0, bid, nb); stage_tables(p, bid, nb); }
        else if (s == 2) {
            stage_upass(p, l, bid, nb);
#ifdef DUP_U
            stage_upass(p, l, bid, nb);
#endif
#pragma unroll 1
            for (int it = bid; it < 768; it += nb) fnet1_item(p, l, it);
#ifdef DUP_F
#pragma unroll 1
            for (int it = bid; it < 768; it += nb) fnet1_item(p, l, it);
#endif
#pragma unroll 1
            for (int it = bid; it < 768; it += nb) pool_item(p, l, lds, it);
#ifdef DUP_P
#pragma unroll 1
            for (int it = bid; it < 768; it += nb) pool_item(p, l, lds, it);
#endif
        }
        else if (s == 4) stage_post(p, l, bid, nb);
        #ifdef REP_A
        if (sti + 1 < ph_hi + ((REP_B) >= 0 ? 2 : 1)) xcd_barrier(bar);
#else
        if (st + 1 < ph_hi && step_seam(st)) xcd_barrier(bar);
#endif
    }
}

extern "C" void kernel_launch(void* const* d_in, const int* in_sizes, int n_in, void* d_out, int out_size, void* d_ws, size_t ws_size, hipStream_t stream) {
    static int grid = 0;
    if (grid == 0) {
        if (n_in != N_IN || ws_size < WS_END) { fprintf(stderr, "kernel_launch: unexpected inputs (n_in %d, ws %zu)\n", n_in, ws_size); grid = -1; return; }
        int dev = 0, cus = 0, per_cu = 0;
        (void)hipGetDevice(&dev); (void)hipDeviceGetAttribute(&cus, hipDeviceAttributeMultiprocessorCount, dev);
        (void)hipFuncSetAttribute((const void*)mega_fwd, hipFuncAttributeMaxDynamicSharedMemorySize, LDS_BYTES);
        if (hipOccupancyMaxActiveBlocksPerMultiprocessor(&per_cu, (const void*)mega_fwd, NTHR, LDS_BYTES) != hipSuccess || per_cu < 1) {
            fprintf(stderr, "kernel_launch: occupancy query reports %d blocks/CU\n", per_cu); (void)hipGetLastError(); grid = -1; return; }
        grid = cus * 1;
    }
    if (grid < 0) return;
    KP a{};
    for (int i = 0; i < N_IN; ++i) a.in[i] = (const float*)d_in[i];
    a.out = (float*)d_out; a.ws = (unsigned char*)d_ws; a.ph_lo = 0; a.ph_hi = N_STEPS;
    if (hipMemsetAsync((char*)d_ws + WS_CTL, 0, 1 * MiB, stream) != hipSuccess) { fprintf(stderr, "kernel_launch: memset failed\n"); return; }
    void* args[] = {&a};
    hipError_t e = hipLaunchCooperativeKernel((const void*)mega_fwd, dim3(grid), dim3(NTHR), args, LDS_BYTES, stream);
    if (e != hipSuccess) fprintf(stderr, "cooperative launch failed: %s (grid %d)\n", hipGetErrorString(e), grid);
}
```

```cpp
#include <hip/hip_runtime.h>
#include <hip/hip_cooperative_groups.h>
#include <cstdio>
#include <cstdint>
namespace cg = cooperative_groups;
__device__ __forceinline__ int opaque_tid() { int t = threadIdx.x; asm volatile("" : "+v"(t)); return t; }
namespace pg8 {
#define PG8_LAS __attribute__((address_space(3)))
typedef unsigned short bf16_t;
typedef short bf16x8 __attribute__((ext_vector_type(8)));
typedef float f32x4 __attribute__((ext_vector_type(4)));
typedef unsigned u32x4 __attribute__((ext_vector_type(4)));
constexpr int BM = 256, BK = 64, HALF = 128, HTB = HALF * BK * 2  , STAGE_BYTES = 8 * HTB, NXCD = 8, WGM = 8;

__host__ __device__ __forceinline__ int lds_byte(int r, int c) { const int st = (r >> 4) * 2 + (c >> 5), rr = r & 15, cc = c & 31, ob = rr * 64 + cc * 2; return st * 1024 + (ob ^ (((ob >> 9) & 1) << 5)); }
__host__ __device__ __forceinline__ void stage_rc(int b, int& R, int& C) { const int st = b / 1024, sb = b % 1024, swz = sb ^ (((sb >> 9) & 1) << 5); R = (st >> 1) * 16 + swz / 64; C = (st & 1) * 32 + (swz % 64) / 2; }
__host__ __device__ __forceinline__ int perm32(int rho) { const int n = rho >> 4, i = rho & 15; return 8 * (i >> 2) + 4 * n + (i & 3); }

struct Unit { int pm, pn; };
struct Gemm { const bf16_t* A; const bf16_t* Bt; int M, N, K, lda, ldb; };

struct StaticOrder {
    int nM, nN, nwg, G, c;
    __host__ __device__ void init(int M, int N, int G_, int c_) { nM = M / BM; nN = N / BM; nwg = nM * nN; G = G_; c = c_; }
    __host__ __device__ bool next(int i, Unit& u) const {
        const long L = (long)i * G + c; if (L >= nwg) return false;
        int wgid = (int)L; { const int q = nwg / NXCD, r = nwg % NXCD, xcd = wgid % NXCD, off = wgid / NXCD; wgid = (xcd < r ? xcd * (q + 1) : r * (q + 1) + (xcd - r) * q) + off; }
        const int nig = WGM * nN, gid = wgid / nig, fm = gid * WGM, gsz = (nM - fm) < WGM ? (nM - fm) : WGM;
        u.pm = fm + ((wgid % nig) % gsz); u.pn = (wgid % nig) / gsz; return true;
    }
    __device__ __forceinline__ void a_ready(const Unit&) const {}
    __device__ __forceinline__ void done(const Unit&) const {}
};

__device__ __forceinline__ unsigned cvt_pk_bf16(float lo, float hi) { unsigned r; asm volatile("v_cvt_pk_bf16_f32 %0, %1, %2" : "=v"(r) : "v"(lo), "v"(hi)); return r; }
typedef unsigned u32x2 __attribute__((ext_vector_type(2)));
template <int ACT  > struct EpiBf {
    static constexpr bool PERM = true, AFTER_DRAIN = false;
    bf16_t* O; int ldc;
    __device__ __forceinline__ void operator()(const f32x4 (&acc)[2][2][4][2], const Unit& u, int wr, int wc, int fr, int fq) const {
        const int row0 = u.pm * BM + wr * 64 + fr, col0 = u.pn * BM + wc * 32 + 8 * fq;
#pragma unroll
        for (int ai = 0; ai < 2; ++ai)
#pragma unroll
            for (int m = 0; m < 4; ++m) { bf16_t* rowp = O + (size_t)(row0 + ai * HALF + m * 16) * ldc + col0;
#pragma unroll
                for (int bj = 0; bj < 2; ++bj) { f32x4 v0 = acc[ai][bj][m][0], v1 = acc[ai][bj][m][1];
                    if (ACT == 1) {
#pragma unroll
                        for (int e = 0; e < 4; ++e) { float a = v0[e] > 0.f ? v0[e] : 0.f; v0[e] = a * a; float b = v1[e] > 0.f ? v1[e] : 0.f; v1[e] = b * b; } }
                    u32x4 w; w.x = cvt_pk_bf16(v0[0], v0[1]); w.y = cvt_pk_bf16(v0[2], v0[3]); w.z = cvt_pk_bf16(v1[0], v1[1]); w.w = cvt_pk_bf16(v1[2], v1[3]);
                    *(u32x4*)(rowp + bj * HALF) = w; } }
    }
};
struct EpiRes {
    static constexpr bool PERM = false, AFTER_DRAIN = false;
    float* X; const float* gate; const float* Xc; const float* Xl;
    __device__ __forceinline__ void operator()(const f32x4 (&acc)[2][2][4][2], const Unit& u, int wr, int wc, int fr, int fq) const {
        const int row0 = u.pm * BM + wr * 64 + fr, col0 = u.pn * BM + wc * 32 + 4 * fq;
        const int cond = u.pm < 32 ? 0 : 1 + ((u.pm - 32) >> 2);
        const float* gp = gate + cond * 6144 + col0;
        f32x4 gv[2][2];
#pragma unroll
        for (int bj = 0; bj < 2; ++bj)
#pragma unroll
            for (int n = 0; n < 2; ++n) gv[bj][n] = *(const f32x4*)(gp + bj * HALF + n * 16);
#pragma unroll
        for (int ai = 0; ai < 2; ++ai)
#pragma unroll
            for (int m = 0; m < 4; ++m) { const size_t ro = (size_t)(row0 + ai * HALF + m * 16) * 1024 + col0; float* rowp = X + ro; const float* srcp = u.pm < 32 ? Xc + ro : Xl + (ro - (size_t)8192 * 1024);
#pragma unroll
                for (int bj = 0; bj < 2; ++bj)
#pragma unroll
                    for (int n = 0; n < 2; ++n) { *(f32x4*)(rowp + bj * HALF + n * 16) = *(const f32x4*)(srcp + bj * HALF + n * 16) + gv[bj][n] * acc[ai][bj][m][n]; }
                if (m & 1) asm volatile("" ::: "memory"); }
    }
};
struct EpiFnet {
    static constexpr bool PERM = true, AFTER_DRAIN = false;
    bf16_t* MIX; int rowbase, L;
    __device__ __forceinline__ void operator()(const f32x4 (&acc)[2][2][4][2], const Unit& u, int wr, int wc, int fr, int fq) const {
        const int row0 = u.pm * BM + wr * 64 + fr, colw = wc * 32 + 8 * fq;
        bf16_t* base = MIX + (size_t)(rowbase + u.pn * L) * 1024 + 512 + colw;
#pragma unroll
        for (int ai = 0; ai < 2; ++ai)
#pragma unroll
            for (int m = 0; m < 4; ++m) { bf16_t* rowp = base + (size_t)(row0 + ai * HALF + m * 16) * 1024;
#pragma unroll
                for (int bj = 0; bj < 2; ++bj) { const f32x4 v0 = acc[ai][bj][m][0], v1 = acc[ai][bj][m][1];
                    u32x4 w; w.x = cvt_pk_bf16(v0[0], v0[1]); w.y = cvt_pk_bf16(v0[2], v0[3]); w.z = cvt_pk_bf16(v1[0], v1[1]); w.w = cvt_pk_bf16(v1[2], v1[3]);
                    *(u32x4*)(rowp + bj * HALF) = w; } }
    }
};

__device__ __forceinline__ float xsum_fq(float s, int fr, int fq) {
    s += __builtin_bit_cast(float, __builtin_amdgcn_ds_bpermute((((fq ^ 1) << 4) | fr) << 2, __builtin_bit_cast(int, s)));
    s += __builtin_bit_cast(float, __builtin_amdgcn_ds_bpermute((((fq ^ 2) << 4) | fr) << 2, __builtin_bit_cast(int, s)));
    return s;
}
template <int ACT> struct EpiNormBf {
    static constexpr bool PERM = true, AFTER_DRAIN = false;
    bf16_t* O; int ldc; const float* ssq; const float* sw; int swld;
    __device__ __forceinline__ void operator()(const f32x4 (&acc)[2][2][4][2], const Unit& u, int wr, int wc, int fr, int fq) const {
        const int row0 = u.pm * BM + wr * 64 + fr, col0 = u.pn * BM + wc * 32 + 8 * fq;
        const int cond = u.pm < 32 ? 0 : 1 + ((u.pm - 32) >> 2);
        f32x4 sv[2][2];
#pragma unroll
        for (int bj = 0; bj < 2; ++bj)
#pragma unroll
            for (int n = 0; n < 2; ++n) sv[bj][n] = *(const f32x4*)(sw + (size_t)cond * swld + col0 + bj * HALF + 4 * n);
        float rs[2][4];
#pragma unroll
        for (int ai = 0; ai < 2; ++ai)
#pragma unroll
            for (int m = 0; m < 4; ++m) rs[ai][m] = ssq[row0 + ai * HALF + m * 16];
#pragma unroll
        for (int ai = 0; ai < 2; ++ai)
#pragma unroll
            for (int m = 0; m < 4; ++m) rs[ai][m] = __builtin_amdgcn_rsqf(rs[ai][m] * (1.0f / 1024.0f) + 1e-6f);
#pragma unroll
        for (int ai = 0; ai < 2; ++ai)
#pragma unroll
            for (int m = 0; m < 4; ++m) { const int row = row0 + ai * HALF + m * 16; bf16_t* rowp = O + (size_t)row * ldc + col0;
                const float rstd = rs[ai][m];
#pragma unroll
                for (int bj = 0; bj < 2; ++bj) { f32x4 v0 = acc[ai][bj][m][0] * rstd + sv[bj][0], v1 = acc[ai][bj][m][1] * rstd + sv[bj][1];
                    if (ACT == 1) {
#pragma unroll
                        for (int e = 0; e < 4; ++e) { float a = v0[e] > 0.f ? v0[e] : 0.f; v0[e] = a * a; float b = v1[e] > 0.f ? v1[e] : 0.f; v1[e] = b * b; } }
                    u32x4 w; w.x = cvt_pk_bf16(v0[0], v0[1]); w.y = cvt_pk_bf16(v0[2], v0[3]); w.z = cvt_pk_bf16(v1[0], v1[1]); w.w = cvt_pk_bf16(v1[2], v1[3]);
                    *(u32x4*)(rowp + bj * HALF) = w; }
                if (m & 1) asm volatile("" ::: "memory"); }
    }
};
struct EpiResFinal {
    static constexpr bool PERM = true, AFTER_DRAIN = false;
    const bf16_t* XB; const float* gate; const float* gfin; float* out; float* ssq; unsigned* cnt;
    __device__ __forceinline__ void operator()(const f32x4 (&acc)[2][2][4][2], const Unit& u, int wr, int wc, int fr, int fq) const {
        const int row0 = u.pm * BM + wr * 64 + fr, col0 = u.pn * BM + wc * 32 + 8 * fq;
        const int cond = u.pm < 32 ? 0 : 1 + ((u.pm - 32) >> 2);
        f32x4 gt[2][2];
#pragma unroll
        for (int bj = 0; bj < 2; ++bj)
#pragma unroll
            for (int n = 0; n < 2; ++n) gt[bj][n] = *(const f32x4*)(gate + cond * 6144 + col0 + bj * HALF + n * 4);
#pragma unroll
        for (int ai = 0; ai < 2; ++ai)
#pragma unroll
            for (int m = 0; m < 4; ++m) { const int row = row0 + ai * HALF + m * 16; const unsigned ro = (unsigned)row * 1024u + (unsigned)col0;
                float sq = 0.f;
#pragma unroll
                for (int bj = 0; bj < 2; ++bj) { const u32x4 xw = *(const u32x4*)(XB + ro + bj * HALF);
                    f32x4 x0 = (f32x4){__builtin_bit_cast(float, xw.x << 16), __builtin_bit_cast(float, xw.x & 0xffff0000u), __builtin_bit_cast(float, xw.y << 16), __builtin_bit_cast(float, xw.y & 0xffff0000u)};
                    f32x4 x1 = (f32x4){__builtin_bit_cast(float, xw.z << 16), __builtin_bit_cast(float, xw.z & 0xffff0000u), __builtin_bit_cast(float, xw.w << 16), __builtin_bit_cast(float, xw.w & 0xffff0000u)};
                    x0 += gt[bj][0] * acc[ai][bj][m][0]; x1 += gt[bj][1] * acc[ai][bj][m][1];
                    sq += ((x0[0] * x0[0] + x0[1] * x0[1]) + (x0[2] * x0[2] + x0[3] * x0[3])) + ((x1[0] * x1[0] + x1[1] * x1[1]) + (x1[2] * x1[2] + x1[3] * x1[3])); }
                const float t = xsum_fq(sq, fr, fq); if (fq == 0) atomicAdd(ssq + row, t);
                if (m & 1) asm volatile("" ::: "memory"); }
        asm volatile("s_waitcnt vmcnt(0)" ::: "memory");
        unsigned* c = cnt + 64 * u.pm;
        if (fr == 0 && fq == 0) { __hip_atomic_fetch_add(c, 1u, __ATOMIC_RELAXED, __HIP_MEMORY_SCOPE_AGENT);
            for (unsigned spin = 0; __hip_atomic_load(c, __ATOMIC_RELAXED, __HIP_MEMORY_SCOPE_AGENT) < 32u && spin < (1u << 22); ++spin) __builtin_amdgcn_s_sleep(2); }
        asm volatile("" ::: "memory");
        f32x4 gv[2][2];
#pragma unroll
        for (int bj = 0; bj < 2; ++bj)
#pragma unroll
            for (int n = 0; n < 2; ++n) gv[bj][n] = *(const f32x4*)(gfin + col0 + bj * HALF + n * 4);
#pragma unroll
        for (int ai = 0; ai < 2; ++ai)
#pragma unroll
            for (int m = 0; m < 4; ++m) { const int row = row0 + ai * HALF + m * 16; const unsigned ro = (unsigned)row * 1024u + (unsigned)col0;
                const float rstd = __builtin_amdgcn_rsqf(__hip_atomic_load(ssq + row, __ATOMIC_RELAXED, __HIP_MEMORY_SCOPE_AGENT) * (1.0f / 1024.0f) + 1e-6f);
#pragma unroll
                for (int bj = 0; bj < 2; ++bj) { const u32x4 xw = *(const u32x4*)(XB + ro + bj * HALF);
                    f32x4 x0 = (f32x4){__builtin_bit_cast(float, xw.x << 16), __builtin_bit_cast(float, xw.x & 0xffff0000u), __builtin_bit_cast(float, xw.y << 16), __builtin_bit_cast(float, xw.y & 0xffff0000u)};
                    f32x4 x1 = (f32x4){__builtin_bit_cast(float, xw.z << 16), __builtin_bit_cast(float, xw.z & 0xffff0000u), __builtin_bit_cast(float, xw.w << 16), __builtin_bit_cast(float, xw.w & 0xffff0000u)};
                    f32x4 ga = gt[bj][0], gb = gt[bj][1]; asm volatile("" : "+v"(ga), "+v"(gb));
                    x0 += ga * acc[ai][bj][m][0]; x1 += gb * acc[ai][bj][m][1];
                    *(f32x4*)(out + ro + bj * HALF) = x0 * rstd * gv[bj][0]; *(f32x4*)(out + ro + bj * HALF + 4) = x1 * rstd * gv[bj][1]; }
                if (m & 1) asm volatile("" ::: "memory"); }
    }
};
template <bool SRC_F32, bool WRITE_H> struct EpiResNorm {
    static constexpr bool PERM = true, AFTER_DRAIN = false;
    bf16_t* XB; const float* gate; const float* Xc; const float* Xl; bf16_t* H; const float* gn; const float* scl; float* ssq;
    __device__ __forceinline__ void operator()(const f32x4 (&acc)[2][2][4][2], const Unit& u, int wr, int wc, int fr, int fq) const {
        const int row0 = u.pm * BM + wr * 64 + fr, col0 = u.pn * BM + wc * 32 + 8 * fq;
        const int cond = u.pm < 32 ? 0 : 1 + ((u.pm - 32) >> 2);
        const float* src = u.pm < 32 ? Xc : Xl - (size_t)8192 * 1024;
        f32x4 gt[2][2], gs[2][2];
#pragma unroll
        for (int bj = 0; bj < 2; ++bj)
#pragma unroll
            for (int n = 0; n < 2; ++n) { const int col = col0 + bj * HALF + n * 4;
                gt[bj][n] = *(const f32x4*)(gate + cond * 6144 + col);
                if (WRITE_H) gs[bj][n] = *(const f32x4*)(gn + col) * (*(const f32x4*)(scl + cond * 6144 + col) + 1.0f); }
#pragma unroll
        for (int ai = 0; ai < 2; ++ai)
#pragma unroll
            for (int m = 0; m < 4; ++m) { const int row = row0 + ai * HALF + m * 16; const unsigned ro = (unsigned)row * 1024u + (unsigned)col0;
                float sq = 0.f;
#pragma unroll
                for (int bj = 0; bj < 2; ++bj) { const unsigned o = ro + bj * HALF;
                    f32x4 x0, x1;
                    if (SRC_F32) { x0 = *(const f32x4*)(src + o); x1 = *(const f32x4*)(src + o + 4); }
                    else { const u32x4 xw = *(const u32x4*)(XB + o);
                        x0 = (f32x4){__builtin_bit_cast(float, xw.x << 16), __builtin_bit_cast(float, xw.x & 0xffff0000u), __builtin_bit_cast(float, xw.y << 16), __builtin_bit_cast(float, xw.y & 0xffff0000u)};
                        x1 = (f32x4){__builtin_bit_cast(float, xw.z << 16), __builtin_bit_cast(float, xw.z & 0xffff0000u), __builtin_bit_cast(float, xw.w << 16), __builtin_bit_cast(float, xw.w & 0xffff0000u)}; }
                    x0 += gt[bj][0] * acc[ai][bj][m][0]; x1 += gt[bj][1] * acc[ai][bj][m][1];
                    u32x4 xo; xo.x = cvt_pk_bf16(x0[0], x0[1]); xo.y = cvt_pk_bf16(x0[2], x0[3]); xo.z = cvt_pk_bf16(x1[0], x1[1]); xo.w = cvt_pk_bf16(x1[2], x1[3]);
                    *(u32x4*)(XB + o) = xo;
                    sq += ((x0[0] * x0[0] + x0[1] * x0[1]) + (x0[2] * x0[2] + x0[3] * x0[3])) + ((x1[0] * x1[0] + x1[1] * x1[1]) + (x1[2] * x1[2] + x1[3] * x1[3]));
                    if (WRITE_H) { const f32x4 h0 = x0 * gs[bj][0], h1 = x1 * gs[bj][1];
                        u32x4 w; w.x = cvt_pk_bf16(h0[0], h0[1]); w.y = cvt_pk_bf16(h0[2], h0[3]); w.z = cvt_pk_bf16(h1[0], h1[1]); w.w = cvt_pk_bf16(h1[2], h1[3]);
                        *(u32x4*)(H + o) = w; } }
                const float t = xsum_fq(sq, fr, fq); if (fq == 0) atomicAdd(ssq + row, t);
                asm volatile("" ::: "memory"); }
    }
};
template <class Epi, class Sched, bool ALIGN_EPI = false, bool SP2 = false>
__device__ __forceinline__ void gemm_phase(PG8_LAS unsigned char* lds, const Gemm g, const Sched& S, const Epi& E) {
    const int tid = opaque_tid(), wid = __builtin_amdgcn_readfirstlane(tid >> 6), lane = tid & 63, wr = wid >> 2, wc = wid & 3, fr = lane & 15, fq = lane >> 4;
    const int K = g.K, nt = K / BK;
    unsigned voffA[2], voffB[2];
#pragma unroll
    for (int i = 0; i < 2; ++i) { int R, C; stage_rc(tid * 16 + i * 8192, R, C); const int Rb = E.PERM ? ((R & ~31) + perm32(R & 31)) : R;
        voffA[i] = (unsigned)(R * g.lda + C) * 2u; voffB[i] = (unsigned)(Rb * g.ldb + C) * 2u; }
    const size_t kstep = (size_t)(BK * 2);
    const size_t hstepA = (size_t)HALF * g.lda * 2, hstepB = (size_t)HALF * g.ldb * 2;
    const size_t tstepA = 2 * hstepA, tstepB = 2 * hstepB;
    const unsigned ldsw = (unsigned)wid * 1024u;
    const int aoff = lds_byte(wr * 64 + fr, fq * 8), boff = lds_byte(wc * 32 + fr, fq * 8);
#define PG8_SA(b, h) (((b) * 2 + (h)) * HTB)
#define PG8_SB(b, h) ((4 + (b) * 2 + (h)) * HTB)
#define PG8_STAGE(bufoff, gbase, voff) do { _Pragma("unroll") for (int _i = 0; _i < 2; ++_i) \
        __builtin_amdgcn_global_load_lds((const unsigned*)((const char*)(gbase) + (voff)[_i]), (PG8_LAS unsigned*)(lds + (bufoff) + ldsw + _i * 8192), 16, 0, 0); } while (0)
#define PG8_LDA(dst, b, h) do { _Pragma("unroll") for (int m = 0; m < 4; ++m) _Pragma("unroll") for (int k = 0; k < 2; ++k) dst[m][k] = *(const PG8_LAS bf16x8*)(lds + PG8_SA(b, h) + aoff + m * 2048 + k * 1024); } while (0)
#define PG8_LDB(dst, b, h) do { _Pragma("unroll") for (int n = 0; n < 2; ++n) _Pragma("unroll") for (int k = 0; k < 2; ++k) dst[n][k] = *(const PG8_LAS bf16x8*)(lds + PG8_SB(b, h) + boff + n * 2048 + k * 1024); } while (0)
#define PG8_MMA(ai, bj, At, Bt) do { __builtin_amdgcn_s_setprio(1); _Pragma("unroll") for (int m = 0; m < 4; ++m) _Pragma("unroll") for (int n = 0; n < 2; ++n) _Pragma("unroll") for (int k = 0; k < 2; ++k) \
        acc[ai][bj][m][n] = __builtin_amdgcn_mfma_f32_16x16x32_bf16(Bt[n][k], At[m][k], acc[ai][bj][m][n], 0, 0, 0); __builtin_amdgcn_s_setprio(0); } while (0)
#define PG8_WAIT_V(n) asm volatile("s_waitcnt vmcnt(" #n ")" ::: "memory")
#define PG8_WAIT_L(n) asm volatile("s_waitcnt lgkmcnt(" #n ")" ::: "memory")
#define PG8_BAR __builtin_amdgcn_s_barrier()
#define PG8_SCHED __builtin_amdgcn_sched_barrier(0)
    Unit cur, nxt; int ui = 0;
    if (!S.next(0, cur)) return;
    f32x4 acc[2][2][4][2];
#pragma unroll
    for (int a = 0; a < 2; ++a)
#pragma unroll
        for (int b = 0; b < 2; ++b)
#pragma unroll
            for (int m = 0; m < 4; ++m)
#pragma unroll
                for (int n = 0; n < 2; ++n) acc[a][b][m][n] = (f32x4){0.f, 0.f, 0.f, 0.f};
    bf16x8 At[4][2], B0[2][2], B1[2][2];
    const char* cA = (const char*)g.A + (size_t)cur.pm * tstepA; const char* cB = (const char*)g.Bt + (size_t)cur.pn * tstepB;
    S.a_ready(cur);
    if constexpr (SP2) {
        PG8_STAGE(PG8_SB(0, 0), cB, voffB); PG8_STAGE(PG8_SB(0, 1), cB + hstepB, voffB); PG8_STAGE(PG8_SA(0, 0), cA, voffA); PG8_STAGE(PG8_SA(0, 1), cA + hstepA, voffA);
        if (wr == 1) PG8_BAR;
        PG8_WAIT_V(2); PG8_BAR;
        PG8_STAGE(PG8_SB(1, 0), cB + kstep, voffB); PG8_STAGE(PG8_SA(1, 0), cA + kstep, voffA); PG8_STAGE(PG8_SB(1, 1), cB + hstepB + kstep, voffB);
        PG8_WAIT_V(6); PG8_BAR;
    } else {
        PG8_STAGE(PG8_SB(0, 0), cB, voffB); PG8_STAGE(PG8_SA(0, 0), cA, voffA); PG8_STAGE(PG8_SB(0, 1), cB + hstepB, voffB); PG8_STAGE(PG8_SA(0, 1), cA + hstepA, voffA);
        if (wr == 1) PG8_BAR;
        PG8_WAIT_V(4); PG8_BAR;
        PG8_STAGE(PG8_SB(1, 0), cB + kstep, voffB); PG8_STAGE(PG8_SA(1, 0), cA + kstep, voffA); PG8_STAGE(PG8_SB(1, 1), cB + hstepB + kstep, voffB);
        PG8_WAIT_V(6); PG8_BAR;
    }
    for (;;) {
        const bool has_next = S.next(ui + 1, nxt);
        const char* nA = has_next ? (const char*)g.A + (size_t)nxt.pm * tstepA : cA; const char* nB = has_next ? (const char*)g.Bt + (size_t)nxt.pn * tstepB : cB;
        for (int t = 0; t < nt; t += 2) {
            const bool last = (t == nt - 2);
            const char* a1 = cA + (size_t)(t + 1) * kstep;
            const char* a2 = last ? nA : cA + (size_t)(t + 2) * kstep; const char* b2 = last ? nB : cB + (size_t)(t + 2) * kstep;
            const char* a3 = a2 + kstep; const char* b3 = b2 + kstep;
            if (last && has_next) S.a_ready(nxt);
            if constexpr (SP2) {
            PG8_LDB(B0, 0, 0); PG8_LDB(B1, 0, 1); PG8_SCHED; PG8_LDA(At, 0, 0); PG8_STAGE(PG8_SA(1, 1), a1 + hstepA, voffA);
            PG8_WAIT_V(8); PG8_WAIT_L(0); PG8_BAR; PG8_MMA(0, 0, At, B0); PG8_MMA(0, 1, At, B1); PG8_BAR; PG8_SCHED;
            PG8_LDA(At, 0, 1); PG8_STAGE(PG8_SB(0, 0), b2, voffB); PG8_STAGE(PG8_SB(0, 1), b2 + hstepB, voffB); PG8_STAGE(PG8_SA(0, 0), a2, voffA);
            PG8_WAIT_V(8); PG8_WAIT_L(0); PG8_BAR; PG8_MMA(1, 0, At, B0); PG8_MMA(1, 1, At, B1); PG8_BAR; PG8_SCHED;
            PG8_LDB(B0, 1, 0); PG8_LDB(B1, 1, 1); PG8_SCHED; PG8_LDA(At, 1, 0); PG8_STAGE(PG8_SA(0, 1), a2 + hstepA, voffA);
            PG8_WAIT_V(8); PG8_WAIT_L(0); PG8_BAR; PG8_MMA(0, 0, At, B0); PG8_MMA(0, 1, At, B1); PG8_BAR; PG8_SCHED;
            PG8_LDA(At, 1, 1); PG8_STAGE(PG8_SB(1, 0), b3, voffB); PG8_STAGE(PG8_SB(1, 1), b3 + hstepB, voffB); PG8_STAGE(PG8_SA(1, 0), a3, voffA);
            PG8_WAIT_V(8); PG8_WAIT_L(0); PG8_BAR; PG8_MMA(1, 0, At, B0); PG8_MMA(1, 1, At, B1); PG8_BAR; PG8_SCHED;
            } else {
            PG8_LDB(B0, 0, 0); PG8_SCHED; PG8_LDA(At, 0, 0); PG8_STAGE(PG8_SA(1, 1), a1 + hstepA, voffA);
            PG8_WAIT_L(8); PG8_BAR; PG8_WAIT_L(0); PG8_MMA(0, 0, At, B0); PG8_BAR; PG8_SCHED;
            PG8_LDB(B1, 0, 1); PG8_STAGE(PG8_SB(0, 0), b2, voffB);
            PG8_BAR; PG8_WAIT_L(0); PG8_MMA(0, 1, At, B1); PG8_BAR;
            PG8_LDA(At, 0, 1); PG8_STAGE(PG8_SA(0, 0), a2, voffA);
            PG8_BAR; PG8_WAIT_L(0); PG8_MMA(1, 0, At, B0); PG8_BAR; PG8_SCHED;
            PG8_STAGE(PG8_SB(0, 1), b2 + hstepB, voffB);
            PG8_WAIT_V(6); PG8_BAR; PG8_MMA(1, 1, At, B1); PG8_BAR;
            PG8_LDB(B0, 1, 0); PG8_SCHED; PG8_LDA(At, 1, 0); PG8_STAGE(PG8_SA(0, 1), a2 + hstepA, voffA);
            PG8_WAIT_L(8); PG8_BAR; PG8_WAIT_L(0); PG8_MMA(0, 0, At, B0); PG8_BAR; PG8_SCHED;
            PG8_LDB(B1, 1, 1); PG8_STAGE(PG8_SB(1, 0), b3, voffB);
            PG8_BAR; PG8_WAIT_L(0); PG8_MMA(0, 1, At, B1); PG8_BAR;
            PG8_LDA(At, 1, 1); PG8_STAGE(PG8_SA(1, 0), a3, voffA);
            PG8_BAR; PG8_WAIT_L(0); PG8_MMA(1, 0, At, B0); PG8_BAR; PG8_SCHED;
            PG8_STAGE(PG8_SB(1, 1), b3 + hstepB, voffB);
            PG8_WAIT_V(6); PG8_BAR; PG8_MMA(1, 1, At, B1); PG8_BAR;
            }
        }
        if constexpr (ALIGN_EPI) { if (wr == 0) PG8_BAR; }
        if constexpr (!Epi::AFTER_DRAIN) { int fr2 = fr, fq2 = fq; asm volatile("" : "+v"(fr2), "+v"(fq2)); E(acc, cur, wr, wc, fr2, fq2); S.done(cur); }
        if (!has_next) break;
#pragma unroll
        for (int a = 0; a < 2; ++a)
#pragma unroll
            for (int b = 0; b < 2; ++b)
#pragma unroll
                for (int m = 0; m < 4; ++m)
#pragma unroll
                    for (int n = 0; n < 2; ++n) acc[a][b][m][n] = (f32x4){0.f, 0.f, 0.f, 0.f};
        cur = nxt; cA = nA; cB = nB; ++ui;
        if constexpr (ALIGN_EPI) { if (wr == 1) PG8_BAR; }
    }
    PG8_WAIT_V(0);
    if constexpr (!ALIGN_EPI) { if (wr == 0) PG8_BAR; }
    PG8_BAR;
    if constexpr (Epi::AFTER_DRAIN) { E.fused(acc, cur, wr, wc, fr, fq, lds, wid, lane); S.done(cur); }
#undef PG8_SA
#undef PG8_SB
#undef PG8_STAGE
#undef PG8_LDA
#undef PG8_LDB
#undef PG8_MMA
#undef PG8_WAIT_V
#undef PG8_WAIT_L
#undef PG8_BAR
#undef PG8_SCHED
}
}

#define LAS __attribute__((address_space(3)))
typedef unsigned short bf16;
typedef float f32x4 __attribute__((ext_vector_type(4)));
typedef unsigned u32x4 __attribute__((ext_vector_type(4)));
typedef unsigned u32x2 __attribute__((ext_vector_type(2)));
constexpr int DM = 1024, NCTX = 8192, MTOK = 12288, DINP = 2560, DFF = 4096;
constexpr int R_OFF = 0, K_OFF = 512, V_OFF = 1024, WD_OFF = 1536, AD_OFF = 1664, GD_OFF = 1792, F_OFF = 1920, P_OFF = 2176, DIN = 2432;
constexpr size_t MiB = 1u << 20;
constexpr size_t WS_CTL = 0, WS_MOD = 1 * MiB, WS_FW = 1 * MiB + 512 * 1024, WS_BC = 2 * MiB, WS_CS256 = 3 * MiB, WS_CS1024 = 4 * MiB, WS_WIN = 8 * MiB, WS_WOUT = 18 * MiB,
                 WS_W1 = 22 * MiB, WS_W2 = 38 * MiB, WS_H = 54 * MiB, WS_MIXED = 78 * MiB, WS_PROJ = 102 * MiB, WS_YCS = 162 * MiB, WS_YF = 102 * MiB, WS_YB = 126 * MiB  , WS_U = 174 * MiB, WS_KINV = 220 * MiB, WS_GUPT = 221 * MiB,
                 WS_FF = 102 * MiB, WS_WUPT = 222 * MiB, WS_AUPT = 222 * MiB + 256 * 1024, WS_SSQ = 223 * MiB, WS_WPT = 223 * MiB + 512 * 1024, WS_SW1 = 224 * MiB, WS_SWIN = 224 * MiB + 256 * 1024, WS_XB = 226 * MiB, WS_END = 250 * MiB;
constexpr int LDS_BYTES = 147456, RING_BYTES = 131072, MISC_OFF = RING_BYTES + 320;
constexpr int NTHR = 512;
enum { I_XP = 0, I_XS, I_STATE, I_C, I_CCTX, I_WADA, I_BADA, I_N1G, I_WIN, I_MU, I_W0, I_WUP, I_A0, I_AUP, I_GUP, I_KK, I_KA, I_RK, I_LNW, I_LNB, I_WFNET, I_WPOOL, I_PSCALE, I_WOUT, I_N2G, I_WFF1, I_WFF2, I_FNG, N_IN };
struct KP { const float* in[N_IN]; float* out; unsigned char* ws; int ph_lo, ph_hi; };
typedef const __attribute__((address_space(4))) KP CKP;

__device__ __forceinline__ unsigned f2bf(float f) { unsigned u = __builtin_bit_cast(unsigned, f); return (u + 0x7fffu + ((u >> 16) & 1u)) >> 16; }
__device__ __forceinline__ unsigned pk2(float lo, float hi) { return f2bf(lo) | (f2bf(hi) << 16); }
__device__ __forceinline__ float bflo(unsigned w) { return __builtin_bit_cast(float, w << 16); }
__device__ __forceinline__ float bfhi(unsigned w) { return __builtin_bit_cast(float, w & 0xffff0000u); }
__device__ __forceinline__ float bf1(bf16 h) { return __builtin_bit_cast(float, (unsigned)h << 16); }
__device__ __forceinline__ float fexp(float x) { return __builtin_amdgcn_exp2f(x * 1.4426950408889634f); }
__device__ __forceinline__ float flog(float x) { return __builtin_amdgcn_logf(x) * 0.6931471805599453f; }
__device__ __forceinline__ float frcp(float x) { return __builtin_amdgcn_rcpf(x); }
__device__ __forceinline__ float frsq(float x) { return __builtin_amdgcn_rsqf(x); }
__device__ __forceinline__ float fsigmoid(float x) { return frcp(1.0f + fexp(-x)); }
template <int CTRL> __device__ __forceinline__ float dppf(float x) { return __builtin_bit_cast(float, __builtin_amdgcn_update_dpp(0, __builtin_bit_cast(int, x), CTRL, 0xF, 0xF, true)); }
__device__ __forceinline__ float red8(float x)  { x += dppf<0xB1>(x); x += dppf<0x4E>(x); x += dppf<0x141>(x); return x; }
__device__ __forceinline__ float red16(float x) { x += dppf<0xB1>(x); x += dppf<0x4E>(x); x += dppf<0x141>(x); x += dppf<0x140>(x); return x; }
__device__ __forceinline__ float wave_sum(float v) {
    v = red16(v);
    const float s0 = __builtin_bit_cast(float, __builtin_amdgcn_readlane(__builtin_bit_cast(int, v), 0)), s1 = __builtin_bit_cast(float, __builtin_amdgcn_readlane(__builtin_bit_cast(int, v), 16));
    const float s2 = __builtin_bit_cast(float, __builtin_amdgcn_readlane(__builtin_bit_cast(int, v), 32)), s3 = __builtin_bit_cast(float, __builtin_amdgcn_readlane(__builtin_bit_cast(int, v), 48));
    return (s0 + s1) + (s2 + s3);
}
__device__ __forceinline__ void load4bf(const bf16* p, float (&o)[4]) { const u32x2 w = *(const u32x2*)p; o[0] = bflo(w.x); o[1] = bfhi(w.x); o[2] = bflo(w.y); o[3] = bfhi(w.y); }
__device__ __forceinline__ void load8bf(const bf16* p, float (&o)[8]) { const u32x4 w = *(const u32x4*)p; o[0] = bflo(w.x); o[1] = bfhi(w.x); o[2] = bflo(w.y); o[3] = bfhi(w.y); o[4] = bflo(w.z); o[5] = bfhi(w.z); o[6] = bflo(w.w); o[7] = bfhi(w.w); }
__device__ __forceinline__ void shift4(const bf16* proj, int row, bool hasp, bool hasn, int col, const float* mu, float (&u)[4]) {
    float p[4], a[4] = {0.f, 0.f, 0.f, 0.f}, b[4] = {0.f, 0.f, 0.f, 0.f};
    load4bf(proj + (size_t)row * DINP + col, p);
    if (hasp) load4bf(proj + (size_t)(row - 1) * DINP + col, a);
    if (hasn) load4bf(proj + (size_t)(row + 1) * DINP + col, b);
    const f32x4 m = *(const f32x4*)(mu + col);
#pragma unroll
    for (int j = 0; j < 4; ++j) u[j] = p[j] + m[j] * (0.5f * (a[j] + b[j]) - p[j]);
}

__device__ __forceinline__ void transpose_item(const float* W, int K, int N, bf16* WT, LAS float* scr, int item, int lane) {
    const int nblk = N / 32, kb = item / nblk, nb = item % nblk, k0 = 64 * kb, n0 = 32 * nb;
#pragma unroll 8
    for (int i = 0; i < 32; ++i) { const int kk = 2 * i + (lane >> 5); scr[kk * 33 + (lane & 31)] = W[(size_t)(k0 + kk) * N + n0 + (lane & 31)]; }
    asm volatile("s_waitcnt lgkmcnt(0)" ::: "memory");
    const int c = lane & 7;
#pragma unroll
    for (int j = 0; j < 4; ++j) { const int n = (lane >> 3) + 8 * j; const LAS float* s = scr + (8 * c) * 33 + n;
        u32x4 o; o.x = pk2(s[0 * 33], s[1 * 33]); o.y = pk2(s[2 * 33], s[3 * 33]); o.z = pk2(s[4 * 33], s[5 * 33]); o.w = pk2(s[6 * 33], s[7 * 33]);
        *(u32x4*)(WT + (size_t)(n0 + n) * K + k0 + 8 * c) = o; }
    asm volatile("s_waitcnt lgkmcnt(0)" ::: "memory");
}
__device__ __forceinline__ void gemv5_cols(LAS float* sc, LAS float* red, const float* W, int ldw, int colw, const float* bias, float* out, int ldo, int colo, int tid) {
    const int cgi = tid & 15, kg = tid >> 4;
    f32x4 acc[5];
#pragma unroll
    for (int c = 0; c < 5; ++c) acc[c] = (f32x4){0.f, 0.f, 0.f, 0.f};
    const float* wp = W + (size_t)(kg * 32) * ldw + colw + cgi * 4;
#pragma unroll 8
    for (int kk = 0; kk < 32; ++kk) { const f32x4 w = *(const f32x4*)(wp + (size_t)kk * ldw);
#pragma unroll
        for (int c = 0; c < 5; ++c) acc[c] += sc[c * 1024 + kg * 32 + kk] * w; }
#pragma unroll
    for (int c = 0; c < 5; ++c) *(LAS f32x4*)(red + (kg * 5 + c) * 64 + cgi * 4) = acc[c];
    __syncthreads();
    if (tid < 320) { const int cond = tid >> 6, col = tid & 63; float sm = bias ? bias[colo + col] : 0.f;
        for (int g = 0; g < 32; ++g) sm += red[(g * 5 + cond) * 64 + col];
        out[(size_t)cond * ldo + colo + col] = sm; }
    __syncthreads();
}
__device__ __forceinline__ void mod_item(CKP& p, LAS unsigned char* lds, int it) {
    const int tid = opaque_tid(); unsigned char* ws = p.ws;
    LAS float* sc = (LAS float*)lds; LAS float* red = (LAS float*)(lds + 20480);
    const int l = it / 96, cgp = it % 96;
    for (int i = tid; i < 5 * 1024; i += NTHR) { const int cond = i >> 10, k = i & 1023; const float v = cond == 0 ? p.in[I_CCTX][k] : p.in[I_C][(cond - 1) * 1024 + k]; sc[i] = v * fsigmoid(v); }
    __syncthreads();
    gemv5_cols(sc, red, p.in[I_WADA] + (size_t)l * 1024 * 6144, 6144, cgp * 64, p.in[I_BADA] + l * 6144, (float*)(ws + WS_MOD) + (size_t)l * 5 * 6144, 6144, cgp * 64, tid);
}
constexpr int TI_IN = 16 * 76, TI_OUT = 16 * 32, TI_1 = 16 * 128, TI_2 = 64 * 32, TI_L = TI_IN + TI_OUT + TI_1 + TI_2;
__device__ __forceinline__ void transpose_range(CKP& p, LAS unsigned char* lds, int first, int last, int bid, int nb) {
    const int tid = opaque_tid(), lane = tid & 63, wave = tid >> 6;
    unsigned char* ws = p.ws;
    LAS float* scr = (LAS float*)(lds + wave * 16384);
#pragma unroll 1
    for (int it = first + bid * 8 + wave; it < last; it += nb * 8) {
        const int l = it / TI_L; int r = it % TI_L;
        if (r < TI_IN) { transpose_item(p.in[I_WIN] + (size_t)l * DM * DIN, DM, DIN, (bf16*)(ws + WS_WIN) + (size_t)l * DINP * DM, scr, r, lane); continue; } r -= TI_IN;
        if (r < TI_OUT) { transpose_item(p.in[I_WOUT] + (size_t)l * DM * DM, DM, DM, (bf16*)(ws + WS_WOUT) + (size_t)l * DM * DM, scr, r, lane); continue; } r -= TI_OUT;
        if (r < TI_1) { transpose_item(p.in[I_WFF1] + (size_t)l * DM * DFF, DM, DFF, (bf16*)(ws + WS_W1) + (size_t)l * DFF * DM, scr, r, lane); continue; } r -= TI_1;
        transpose_item(p.in[I_WFF2] + (size_t)l * DFF * DM, DFF, DM, (bf16*)(ws + WS_W2) + (size_t)l * DM * DFF, scr, r, lane);
    }
}
__device__ __forceinline__ void stage_prologue(CKP& p, LAS unsigned char* lds, int bid, int nb) {
    const int tid = opaque_tid();
    unsigned char* ws = p.ws;
    transpose_range(p, lds, 0, TI_IN, bid, nb);
    const int gt = bid * NTHR + tid, NGT = nb * NTHR;
#pragma unroll 1
    for (int i = gt; i < 2 * 128 * DM / 8; i += NGT) { const int l = i / (128 * DM / 8), r = i % (128 * DM / 8);
        u32x4 z = (u32x4){0u, 0u, 0u, 0u}; asm volatile("" : "+v"(z));
        *(u32x4*)((bf16*)(ws + WS_WIN) + (size_t)l * DINP * DM + (size_t)DIN * DM + (size_t)r * 8) = z; }
    __syncthreads();
#pragma unroll 1
    for (int it = bid; it < 192; it += nb) mod_item(p, lds, it);
}
__device__ __forceinline__ void stage_tables(CKP& p, int bid, int nb) {
    const int tid = opaque_tid(); unsigned char* ws = p.ws;
    const int gt = bid * NTHR + tid, NGT = nb * NTHR;
#pragma unroll 1
    for (int i = gt; i < 256 * 512 + 1024 * 2048; i += NGT) {
        int L, k, j; bf16* dst;
        if (i < 256 * 512) { L = 256; k = i / 512; j = i % 512; dst = (bf16*)(ws + WS_CS256) + i; }
        else { const int i2 = i - 256 * 512; L = 1024; k = i2 / 2048; j = i2 % 2048; dst = (bf16*)(ws + WS_CS1024) + i2; }
        const int jj = j >= L ? j - L : j; const int idx = (k * jj) & (L - 1);
        const float rev = (float)idx * (L == 256 ? (1.0f / 256.0f) : (1.0f / 1024.0f));
        *dst = (bf16)f2bf(j >= L ? -__builtin_amdgcn_sinf(rev) : __builtin_amdgcn_cosf(rev));
    }
#pragma unroll 1
    for (int i = gt; i < 2 * 4 * 64 * 128; i += NGT) {
        const int o = i & 127, c = (i >> 7) & 63, lg = i >> 13; const float* wf = p.in[I_WFNET] + (size_t)lg * 4096 + (o & 63);
        float acc = 0.f;
        if (o < 64) { for (int cp = 0; cp < 64; ++cp) acc += __builtin_amdgcn_cosf((float)((c * cp) & 63) * (1.0f / 64.0f)) * wf[cp * 64]; }
        else { for (int cp = 0; cp < 64; ++cp) acc += __builtin_amdgcn_sinf((float)((c * cp) & 63) * (1.0f / 64.0f)) * wf[cp * 64]; }
        ((bf16*)(ws + WS_FW))[(size_t)(lg * 128 + o) * 64 + c] = (bf16)f2bf(acc);
    }
#pragma unroll 1
    for (int i = gt; i < 2 * 4 * 64 * 64; i += NGT) { const int o = i & 63, c = (i >> 6) & 63, lg = i >> 12;
        ((bf16*)(ws + WS_WPT))[(size_t)(lg * 64 + o) * 64 + c] = (bf16)f2bf(p.in[I_WPOOL][i]); }
#pragma unroll 1
    for (int i = gt; i < 2 * 2 * 64 * 512; i += NGT) { const int c = i & 511, r = (i >> 9) & 63, ld = i >> 15;
        ((bf16*)(ws + WS_WUPT))[(size_t)(ld * 512 + c) * 64 + r] = (bf16)f2bf(p.in[I_WUP][i]);
        ((bf16*)(ws + WS_AUPT))[(size_t)(ld * 512 + c) * 64 + r] = (bf16)f2bf(p.in[I_AUP][i]); }
#pragma unroll 1
    for (int i = gt; i < 2 * 128 * 512; i += NGT) { const int c = i & 511, r = (i >> 9) & 127, ll = i >> 16;
        ((bf16*)(ws + WS_GUPT))[(size_t)(ll * 512 + c) * 128 + r] = (bf16)f2bf(p.in[I_GUP][i]); }
}
__device__ __forceinline__ void shiftw_item(CKP& p, LAS unsigned char* lds, int it) {
    const int tid = opaque_tid();
    unsigned char* ws = p.ws;
    LAS float* sc = (LAS float*)lds; LAS float* red = (LAS float*)(lds + 20480);
    const bool isin = it >= 128; const int l = isin ? 1 : it >> 6, blk = isin ? it - 128 : it & 63;
    const float* shv = (const float*)(ws + WS_MOD) + (size_t)l * 5 * 6144 + (isin ? 0 : 3 * 1024);
    for (int i = tid; i < 5 * 1024; i += NTHR) sc[i] = shv[(i >> 10) * 6144 + (i & 1023)];
    __syncthreads();
    if (isin) gemv5_cols(sc, red, p.in[I_WIN] + (size_t)DM * DIN, DIN, blk * 64, nullptr, (float*)(ws + WS_SWIN), DINP, blk * 64, tid);
    else gemv5_cols(sc, red, p.in[I_WFF1] + (size_t)l * DM * DFF, DFF, blk * 64, nullptr, (float*)(ws + WS_SW1) + (size_t)l * 5 * DFF, DFF, blk * 64, tid);
    if (it == 165) for (int i = tid; i < 5 * 128; i += NTHR) ((float*)(ws + WS_SWIN))[(i >> 7) * DINP + DIN + (i & 127)] = 0.f;
}
__device__ __forceinline__ void side_queue(CKP& p, int l, LAS unsigned char* lds) {
    const int tid = opaque_tid();
    unsigned* ctr = (unsigned*)(p.ws + WS_CTL + 524288) + 64 * l;
    volatile LAS unsigned* slot = (volatile LAS unsigned*)(lds + RING_BYTES + 64);
    const int nmd = 0, nsh = l == 0 ? 166 : 0, first = l == 0 ? TI_IN : TI_L + TI_IN, nch = ((l == 0 ? TI_L + TI_IN : 2 * TI_L) - first) / 8;
    __syncthreads();
#pragma unroll 1
    for (;;) {
        if (tid == 0) *slot = atomicAdd(ctr, 1u);
        __syncthreads();
        const int it = (int)*slot;
        __syncthreads();
        if (it >= nmd + nsh + nch) break;
        if (it < nmd) mod_item(p, lds, 96 + it);
        else if (it < nmd + nsh) shiftw_item(p, lds, it - nmd);
        else { const int c0 = first + 8 * (it - nmd - nsh); transpose_range(p, lds, c0, c0 + 8, 0, 1); }
        __syncthreads();
    }
}

__device__ __forceinline__ void stage_norm(CKP& p, int l, int which, int bid, int nb) {
    const int tid = opaque_tid(), lane = tid & 63, wave = tid >> 6;
    const float* g = p.in[which ? I_N2G : I_N1G] + l * DM;
    const float* mod = (const float*)(p.ws + WS_MOD) + (size_t)l * 5 * 6144 + (which ? 3 * 1024 : 0);
    bf16* H = (bf16*)(p.ws + WS_H);
#pragma unroll 1
    for (int row0 = bid * 8 + wave; row0 < MTOK; row0 += nb * 16) {
        f32x4 v[2][4]; float s[2];
#pragma unroll
        for (int z = 0; z < 2; ++z) { const int row = min(row0 + z * nb * 8, MTOK - 1);
            const float* xsrc = (l == 0 && which == 0) ? (row < NCTX ? p.in[I_XP] + (size_t)row * DM : p.in[I_XS] + (size_t)(row - NCTX) * DM) : p.out + (size_t)row * DM;
            const f32x4* xr = (const f32x4*)xsrc + lane;
#pragma unroll
            for (int j = 0; j < 4; ++j) v[z][j] = xr[64 * j]; }
#pragma unroll
        for (int z = 0; z < 2; ++z) { const int row = row0 + z * nb * 8;
            s[z] = 0.f;
#pragma unroll
            for (int j = 0; j < 4; ++j) s[z] += (v[z][j].x * v[z][j].x + v[z][j].y * v[z][j].y) + (v[z][j].z * v[z][j].z + v[z][j].w * v[z][j].w);
            const float rstd = frsq(wave_sum(s[z]) * (1.0f / DM) + 1e-6f);
            if (row < MTOK) {
                const int cond = row < NCTX ? 0 : 1 + ((row - NCTX) >> 10);
                const float* sh = mod + cond * 6144; const float* scl = sh + 1024;
                unsigned long long* o8 = (unsigned long long*)(H + (size_t)row * DM) + lane;
#pragma unroll
                for (int j = 0; j < 4; ++j) { const int col = 4 * lane + 256 * j; const f32x4 gg = *(const f32x4*)(g + col), a = *(const f32x4*)(sh + col), b = *(const f32x4*)(scl + col);
                    const f32x4 y = v[z][j] * rstd * gg * (b + 1.0f) + a;
                    o8[64 * j] = (unsigned long long)pk2(y.x, y.y) | ((unsigned long long)pk2(y.z, y.w) << 32); } } }
    }
}
__device__ __forceinline__ void stage_final(CKP& p, int bid, int nb) {
    const int tid = opaque_tid(), lane = tid & 63, wave = tid >> 6;
    const float* g = p.in[I_FNG];
    const bf16* XB = (const bf16*)(p.ws + WS_XB); const float* ssq = (const float*)(p.ws + WS_CTL + 262144) + 49152;
    const f32x4 g0 = *(const f32x4*)(g + 8 * lane), g1 = *(const f32x4*)(g + 8 * lane + 4), g2 = *(const f32x4*)(g + 512 + 8 * lane), g3 = *(const f32x4*)(g + 512 + 8 * lane + 4);
#pragma unroll 1
    for (int row = bid * 8 + wave; row < MTOK; row += nb * 8) {
        const float rstd = frsq(ssq[row] * (1.0f / DM) + 1e-6f);
        const u32x4 a = *(const u32x4*)(XB + (size_t)row * DM + 8 * lane), b = *(const u32x4*)(XB + (size_t)row * DM + 512 + 8 * lane);
        float* o = p.out + (size_t)row * DM + 8 * lane;
        *(f32x4*)o = (f32x4){bflo(a.x), bfhi(a.x), bflo(a.y), bfhi(a.y)} * rstd * g0; *(f32x4*)(o + 4) = (f32x4){bflo(a.z), bfhi(a.z), bflo(a.w), bfhi(a.w)} * rstd * g1;
        *(f32x4*)(o + 512) = (f32x4){bflo(b.x), bfhi(b.x), bflo(b.y), bfhi(b.y)} * rstd * g2; *(f32x4*)(o + 516) = (f32x4){bflo(b.z), bfhi(b.z), bflo(b.w), bfhi(b.w)} * rstd * g3;
    }
}


typedef short bf16x8 __attribute__((ext_vector_type(8)));
typedef float f32x2v __attribute__((ext_vector_type(2)));
typedef __bf16 bf16x2v __attribute__((ext_vector_type(2)));
#define MFMA16(a, b, c) __builtin_amdgcn_mfma_f32_16x16x32_bf16((a), (b), (c), 0, 0, 0)
__device__ __forceinline__ unsigned cvt2(float lo, float hi) { f32x2v v = {lo, hi}; bf16x2v b = __builtin_convertvector(v, bf16x2v); return __builtin_bit_cast(unsigned, b); }
__device__ __forceinline__ u32x4 pack8(const float (&x)[8]) { u32x4 w; w.x = cvt2(x[0], x[1]); w.y = cvt2(x[2], x[3]); w.z = cvt2(x[4], x[5]); w.w = cvt2(x[6], x[7]); return w; }
__device__ __forceinline__ void shift8(const bf16* proj, int row, bool hasp, bool hasn, int col, const float* mu, float (&u)[8]) {
    float p[8], a[8], b[8];
    load8bf(proj + (size_t)row * DINP + col, p);
    if (hasp) load8bf(proj + (size_t)(row - 1) * DINP + col, a); else {
#pragma unroll
        for (int j = 0; j < 8; ++j) a[j] = 0.f; }
    if (hasn) load8bf(proj + (size_t)(row + 1) * DINP + col, b); else {
#pragma unroll
        for (int j = 0; j < 8; ++j) b[j] = 0.f; }
    const f32x4 m0 = *(const f32x4*)(mu + col), m1 = *(const f32x4*)(mu + col + 4);
#pragma unroll
    for (int j = 0; j < 4; ++j) { u[j] = p[j] + m0[j] * (0.5f * (a[j] + b[j]) - p[j]); u[4 + j] = p[4 + j] + m1[j] * (0.5f * (a[4 + j] + b[4 + j]) - p[4 + j]); }
}
__device__ __forceinline__ int opq(int x) { asm volatile("" : "+v"(x)); return x; }
constexpr int TS = 72, TB = 64 * TS * 2;
constexpr int L_HT = 0, L_TW = 9216, L_AD = 18432, L_LP = 27648, L_AP = 45056, L_AT = 62464, L_RT = L_AT + TB, L_BH = L_RT + TB, L_KH = L_BH + TB, L_VR = L_KH + TB, L_YS = L_VR + TB;
constexpr int L_AAB = L_TW, L_AAK = L_AAB + 4096, L_ARB = L_AAK + 3072, L_ARK = L_ARB + 3072, L_UT = L_ARK + 3072, L_W1 = L_AP;
static_assert(L_UT + 64 * 24 * 2 <= L_LP && L_YS + 17408 <= RING_BYTES, "scan LDS map");
constexpr int LPS = 68;
#define LBAR() asm volatile("s_waitcnt lgkmcnt(0)\n\ts_barrier" ::: "memory")
typedef short s16x4v __attribute__((ext_vector_type(4)));
__device__ __forceinline__ bf16x8 tr8(const LAS bf16* p) {
    const s16x4v lo = __builtin_bit_cast(s16x4v, __builtin_amdgcn_ds_read_tr16_b64_v4i16((LAS s16x4v*)p));
    const s16x4v hi = __builtin_bit_cast(s16x4v, __builtin_amdgcn_ds_read_tr16_b64_v4i16((LAS s16x4v*)(p + 4 * TS)));
    return (bf16x8){lo[0], lo[1], lo[2], lo[3], hi[0], hi[1], hi[2], hi[3]};
}

__device__ __forceinline__ void rwkv_item3(CKP& p, int l, LAS unsigned char* lds, int item) {
    const int tid0 = opaque_tid(), w = __builtin_amdgcn_readfirstlane(tid0 >> 6);
    int tid = tid0, fr = tid & 15, fg = (tid & 63) >> 4;
    int bseq, h, dir, L, base; bool lat;
    if (item < 64) { lat = true; bseq = item >> 4; h = (item >> 1) & 7; dir = item & 1; L = 1024; base = NCTX + bseq * 1024; }
    else { const int i2 = item - 64; lat = false; bseq = i2 >> 4; h = (i2 >> 1) & 7; dir = i2 & 1; L = 256; base = bseq * 256; }
    const bf16* U = (const bf16*)(p.ws + WS_U);
    const float* KINV = (const float*)(p.ws + WS_KINV);
    bf16* Yout = (bf16*)(p.ws + (dir ? WS_YB : WS_YF));
    float* BC = (float*)(p.ws + WS_BC) + (size_t)dir * MTOK * 8;
    const bf16* wupt = (const bf16*)(p.ws + WS_WUPT) + ((size_t)(l * 2 + dir) * 512 + h * 64) * 64;
    const bf16* aupt = (const bf16*)(p.ws + WS_AUPT) + ((size_t)(l * 2 + dir) * 512 + h * 64) * 64;

    LAS float* LP = (LAS float*)(lds + L_LP); LAS float* AP = (LAS float*)(lds + L_AP); LAS float* AS = (LAS float*)(lds + L_TW);
    LAS bf16* AT = (LAS bf16*)(lds + L_AT);   LAS bf16* RT = (LAS bf16*)(lds + L_RT);   LAS bf16* BH = (LAS bf16*)(lds + L_BH);   LAS bf16* KH = (LAS bf16*)(lds + L_KH);
    LAS bf16* VR = (LAS bf16*)(lds + L_VR);   LAS float* YS = (LAS float*)(lds + L_YS);
    LAS float* AAB = (LAS float*)(lds + L_AAB); LAS bf16* AAK = (LAS bf16*)(lds + L_AAK); LAS bf16* ARB = (LAS bf16*)(lds + L_ARB); LAS bf16* ARK = (LAS bf16*)(lds + L_ARK);
    LAS float* W1 = (LAS float*)(lds + L_W1);
    const int tv = w & 3;
    f32x4 hacc[4];
#pragma unroll
    for (int x = 0; x < 4; ++x) {
        if (lat && w < 4) hacc[x] = *(const f32x4*)(p.in[I_STATE] + ((((size_t)bseq * 2 + l) * 2 + dir) * 8 + h) * 4096 + (16 * tv + fr) * 64 + 16 * x + 4 * fg);
        else hacc[x] = (f32x4){0.f, 0.f, 0.f, 0.f}; }
    int ei = tid >> 3, ec8 = (tid & 7) * 8; const int hc8 = h * 64 + ec8;
    float kkp[8], kap[8], rkp[8];
#pragma unroll
    for (int e = 0; e < 8; ++e) { kkp[e] = p.in[I_KK][l * 512 + hc8 + e]; kap[e] = p.in[I_KA][l * 512 + hc8 + e]; rkp[e] = p.in[I_RK][l * 512 + hc8 + e]; }
#define SCAN_PREFETCH(SC) do { const int _t0 = opq(tid0), _ei = _t0 >> 3, _ec8 = (_t0 & 7) * 8; const int _step = (SC) * 64 + _ei, _t = dir ? L - 1 - _step : _step; \
        const bf16* _u = U + (size_t)(base + _t) * 1920; \
        nr = *(const u32x4*)(_u + R_OFF + h * 64 + _ec8); nk = *(const u32x4*)(_u + K_OFF + h * 64 + _ec8); nv = *(const u32x4*)(_u + V_OFF + h * 64 + _ec8); \
        ninv = KINV[(size_t)(base + _t) * 8 + h]; \
        const int _st2 = (SC) * 64 + 16 * (w >> 1) + (_t0 & 15), _t2 = dir ? L - 1 - _st2 : _st2; const bf16* _u2 = U + (size_t)(base + _t2) * 1920 + dir * 64 + ((_t0 & 63) >> 4) * 8; \
        paw0 = *(const bf16x8*)(_u2 + WD_OFF); paw1 = *(const bf16x8*)(_u2 + WD_OFF + 32); paa0 = *(const bf16x8*)(_u2 + AD_OFF); paa1 = *(const bf16x8*)(_u2 + AD_OFF + 32); } while (0)
    bf16x8 lbw[2][2], lba[2][2]; float lw0c[2], la0c[2];
#pragma unroll
    for (int x = 0; x < 2; ++x) { const int c = ((w & 1) * 2 + x) * 16 + fr;
        lbw[x][0] = *(const bf16x8*)(wupt + c * 64 + fg * 8); lbw[x][1] = *(const bf16x8*)(wupt + c * 64 + 32 + fg * 8);
        lba[x][0] = *(const bf16x8*)(aupt + c * 64 + fg * 8); lba[x][1] = *(const bf16x8*)(aupt + c * 64 + 32 + fg * 8);
        lw0c[x] = p.in[I_W0][(l * 2 + dir) * 512 + h * 64 + c]; la0c[x] = p.in[I_A0][(l * 2 + dir) * 512 + h * 64 + c]; }
    u32x4 nr, nk, nv; float ninv; bf16x8 paw0, paw1, paa0, paa1;
    SCAN_PREFETCH(0);
    __syncthreads();
#pragma unroll 1
    for (int sc = 0; sc < L / 64; ++sc) {
        tid = opq(tid0); fr = tid & 15; fg = (tid & 63) >> 4; ei = tid >> 3; ec8 = (tid & 7) * 8;
        const u32x4 cr = nr, ck = nk, cv = nv; const float kinv = ninv;
        { const int ti = w >> 1;
          const bf16x8 aw0 = paw0, aw1 = paw1, aa0 = paa0, aa1 = paa1;
          unsigned li[2], ls[2];
#pragma unroll
          for (int pr = 0; pr < 2; ++pr) { const int j0 = 4 * fg + 2 * pr, j1 = j0 + 1;
              li[pr] = (j0 <= fr ? 0x3f80u : 0u) | (j1 <= fr ? 0x3f800000u : 0u); ls[pr] = (j0 < fr ? 0x3f80u : 0u) | (j1 < fr ? 0x3f800000u : 0u); }
          const bf16x8 Li = __builtin_bit_cast(bf16x8, (u32x4){li[0], li[1], 0u, 0u}), Ls = __builtin_bit_cast(bf16x8, (u32x4){ls[0], ls[1], 0u, 0u});
#pragma unroll
          for (int x = 0; x < 2; ++x) { const int c = ((w & 1) * 2 + x) * 16 + fr;
              f32x4 cw = (f32x4){lw0c[x], lw0c[x], lw0c[x], lw0c[x]}, ca = (f32x4){la0c[x], la0c[x], la0c[x], la0c[x]};
              cw = MFMA16(aw0, lbw[x][0], cw); cw = MFMA16(aw1, lbw[x][1], cw); ca = MFMA16(aa0, lba[x][0], ca); ca = MFMA16(aa1, lba[x][1], ca);
              float lw[4], lo[4];
#pragma unroll
              for (int r = 0; r < 4; ++r) lw[r] = -0.6065306597126334f * fsigmoid(cw[r]);
              const unsigned h01 = cvt2(lw[0], lw[1]), h23 = cvt2(lw[2], lw[3]);
              lo[0] = lw[0] - bflo(h01); lo[1] = lw[1] - bfhi(h01); lo[2] = lw[2] - bflo(h23); lo[3] = lw[3] - bfhi(h23);
              const bf16x8 bh = __builtin_bit_cast(bf16x8, (u32x4){h01, h23, 0u, 0u}), bl = __builtin_bit_cast(bf16x8, (u32x4){cvt2(lo[0], lo[1]), cvt2(lo[2], lo[3]), 0u, 0u});
              f32x4 ci = (f32x4){0.f, 0.f, 0.f, 0.f}, cs = ci;
              ci = MFMA16(Li, bh, ci); ci = MFMA16(Li, bl, ci); cs = MFMA16(Ls, bh, cs); cs = MFMA16(Ls, bl, cs);
#pragma unroll
              for (int r = 0; r < 4; ++r) { const int o = (ti * 16 + 4 * fg + r) * LPS + c;
                  LP[o] = fexp(ci[r]); AP[o] = fexp(cs[r]); AS[o] = fsigmoid(ca[r]); } } }
        __syncthreads();
        tid = opq(tid0); fr = tid & 15; fg = (tid & 63) >> 4; ei = tid >> 3; ec8 = (tid & 7) * 8;
        float bcv;
        { const f32x4 g0 = *(const LAS f32x4*)(LP + ei * LPS + ec8), g1 = *(const LAS f32x4*)(LP + ei * LPS + ec8 + 4);
          const f32x4 p0 = *(const LAS f32x4*)(AP + ei * LPS + ec8), p1 = *(const LAS f32x4*)(AP + ei * LPS + ec8 + 4);
          const f32x4 s0 = *(const LAS f32x4*)(AS + ei * LPS + ec8), s1 = *(const LAS f32x4*)(AS + ei * LPS + ec8 + 4);
          float rr[8], kk[8], xa[8], xr[8], xb[8], xk[8], bc = 0.f;
          rr[0] = bflo(cr.x); rr[1] = bfhi(cr.x); rr[2] = bflo(cr.y); rr[3] = bfhi(cr.y); rr[4] = bflo(cr.z); rr[5] = bfhi(cr.z); rr[6] = bflo(cr.w); rr[7] = bfhi(cr.w);
          kk[0] = bflo(ck.x); kk[1] = bfhi(ck.x); kk[2] = bflo(ck.y); kk[3] = bfhi(ck.y); kk[4] = bflo(ck.z); kk[5] = bfhi(ck.z); kk[6] = bflo(ck.w); kk[7] = bfhi(ck.w);
#pragma unroll
          for (int e = 0; e < 8; ++e) { const float gi = e < 4 ? g0[e & 3] : g1[e & 3], gp = e < 4 ? p0[e & 3] : p1[e & 3], asg = e < 4 ? s0[e & 3] : s1[e & 3];
              const float kj = kk[e] * kkp[e] * kinv, kd = kk[e] * (1.0f + (asg - 1.0f) * kap[e]), ginv = frcp(gi);
              bc += rr[e] * kd * rkp[e];
              xa[e] = -kj * gp; xr[e] = rr[e] * gi; xb[e] = kj * asg * ginv; xk[e] = kd * ginv; }
          bcv = red8(bc);
          *(LAS u32x4*)(AT + ei * TS + ec8) = pack8(xa); *(LAS u32x4*)(RT + ei * TS + ec8) = pack8(xr); *(LAS u32x4*)(BH + ei * TS + ec8) = pack8(xb); *(LAS u32x4*)(KH + ei * TS + ec8) = pack8(xk);
          *(LAS u32x4*)(VR + ei * TS + ec8) = cv; }
        __syncthreads();
        tid = opq(tid0); fr = tid & 15; fg = (tid & 63) >> 4;
        { const int q = w >> 1, half = w & 1; const LAS bf16* Asrc = half ? RT : AT;
          const bf16x8 af0 = *(const LAS bf16x8*)(Asrc + (16 * q + fr) * TS + fg * 8), af1 = *(const LAS bf16x8*)(Asrc + (16 * q + fr) * TS + 32 + fg * 8);
#pragma unroll
          for (int x = 0; x < 2; ++x) { const LAS bf16* Bsrc = x ? KH : BH;
              const bf16x8 bf0 = *(const LAS bf16x8*)(Bsrc + (16 * q + fr) * TS + fg * 8), bf1_ = *(const LAS bf16x8*)(Bsrc + (16 * q + fr) * TS + 32 + fg * 8);
              f32x4 c = (f32x4){0.f, 0.f, 0.f, 0.f}; c = MFMA16(af0, bf0, c); c = MFMA16(af1, bf1_, c);
              f32x4 cm;
#pragma unroll
              for (int r = 0; r < 4; ++r) { const int i = 4 * fg + r, j = fr; cm[r] = (half ? j <= i : j < i) ? c[r] : 0.f; }
              if (half == 0 && x == 0) *(LAS f32x4*)(AAB + (q * 16 + fr) * 16 + 4 * fg) = cm;
              else { LAS bf16* dst = half == 0 ? AAK : (x == 0 ? ARB : ARK);
#pragma unroll
                  for (int r = 0; r < 4; ++r) dst[(q * 16 + 4 * fg + r) * 24 + fr] = (bf16)(cvt2(cm[r], 0.f) & 0xffffu); } }
          if (half == 0) {
              const unsigned kmask = fg < 2 ? 0xffffffffu : 0u;
              const bf16x8 afr = *(const LAS bf16x8*)(AAK + (q * 16 + fr) * 24 + (fg & 1) * 8);
              const bf16x8 af = __builtin_bit_cast(bf16x8, __builtin_bit_cast(u32x4, afr) & kmask);
#pragma unroll
              for (int tvv = 0; tvv < 4; ++tvv) {
                  const bf16x8 bfr = tr8(VR + (16 * q + 8 * (fg & 1) + (fr >> 2)) * TS + 16 * tvv + 4 * (fr & 3));
                  const bf16x8 bfv = __builtin_bit_cast(bf16x8, __builtin_bit_cast(u32x4, bfr) & kmask);
                  f32x4 c = (f32x4){0.f, 0.f, 0.f, 0.f}; c = MFMA16(af, bfv, c);
#pragma unroll
                  for (int r = 0; r < 4; ++r) W1[(q * 16 + 4 * fg + r) * LPS + 16 * tvv + fr] = c[r]; } } }
        __syncthreads();
        tid = opq(tid0);
        { const int q = tid >> 7, col = tid & 127; float x[16];
          if (col < 64) {
#pragma unroll
              for (int i = 0; i < 16; ++i) x[i] = bf1(AT[(16 * q + i) * TS + col]); }
          else {
#pragma unroll
              for (int i = 0; i < 16; ++i) x[i] = W1[(q * 16 + i) * LPS + col - 64]; }
#pragma unroll
          for (int j = 0; j < 15; ++j) {
              const LAS f32x4* ac = (const LAS f32x4*)(AAB + (q * 16 + j) * 16);
#pragma unroll
              for (int i4 = (j + 1) / 4; i4 < 4; ++i4) { const f32x4 a4 = ac[i4];
#pragma unroll
                  for (int e = 0; e < 4; ++e) if (i4 * 4 + e > j) x[i4 * 4 + e] += a4[e] * x[j]; } }
          if (col < 64) {
#pragma unroll
              for (int i = 0; i < 16; ++i) AT[(16 * q + i) * TS + col] = (bf16)(cvt2(x[i], 0.f) & 0xffffu); }
          else {
#pragma unroll
              for (int i = 0; i < 16; ++i) W1[(q * 16 + i) * LPS + col - 64] = x[i]; } }
        __syncthreads();
        if (sc + 1 < L / 64) SCAN_PREFETCH(sc + 1);
        if (w < 4) {
        tid = opq(tid0); fr = tid & 15; fg = (tid & 63) >> 4;
#pragma unroll
        for (int q = 0; q < 4; ++q) {
            bf16x8 hb[2];
#pragma unroll
            for (int ks = 0; ks < 2; ++ks) { u32x4 t; t.x = cvt2(hacc[2 * ks][0], hacc[2 * ks][1]); t.y = cvt2(hacc[2 * ks][2], hacc[2 * ks][3]);
                t.z = cvt2(hacc[2 * ks + 1][0], hacc[2 * ks + 1][1]); t.w = cvt2(hacc[2 * ks + 1][2], hacc[2 * ks + 1][3]); hb[ks] = __builtin_bit_cast(bf16x8, t); }
            bf16x8 aU[2], aR[2];
#pragma unroll
            for (int ks = 0; ks < 2; ++ks) {
                const u32x2 a0 = *(const LAS u32x2*)(AT + (16 * q + fr) * TS + 32 * ks + 4 * fg), a1 = *(const LAS u32x2*)(AT + (16 * q + fr) * TS + 32 * ks + 16 + 4 * fg);
                const u32x2 r0 = *(const LAS u32x2*)(RT + (16 * q + fr) * TS + 32 * ks + 4 * fg), r1 = *(const LAS u32x2*)(RT + (16 * q + fr) * TS + 32 * ks + 16 + 4 * fg);
                aU[ks] = __builtin_bit_cast(bf16x8, (u32x4){a0.x, a0.y, a1.x, a1.y}); aR[ks] = __builtin_bit_cast(bf16x8, (u32x4){r0.x, r0.y, r1.x, r1.y}); }
            f32x4 u, yacc = (f32x4){0.f, 0.f, 0.f, 0.f};
#pragma unroll
            for (int r = 0; r < 4; ++r) u[r] = W1[(q * 16 + 4 * fg + r) * LPS + 16 * tv + fr];
            u = MFMA16(aU[0], hb[0], u); u = MFMA16(aU[1], hb[1], u);
            yacc = MFMA16(aR[0], hb[0], yacc); yacc = MFMA16(aR[1], hb[1], yacc);
            const s16x4v vtr = __builtin_bit_cast(s16x4v, __builtin_amdgcn_ds_read_tr16_b64_v4i16((LAS s16x4v*)(VR + (16 * q + 4 * fg + (fr >> 2)) * TS + 16 * tv + 4 * (fr & 3))));
            const u32x2 vt2 = __builtin_bit_cast(u32x2, vtr);
            const bf16x8 bUV = __builtin_bit_cast(bf16x8, (u32x4){cvt2(u[0], u[1]), cvt2(u[2], u[3]), vt2.x, vt2.y});
            { const u32x2 y0 = *(const LAS u32x2*)(ARB + (q * 16 + fr) * 24 + 4 * fg), y1 = *(const LAS u32x2*)(ARK + (q * 16 + fr) * 24 + 4 * fg);
              yacc = MFMA16(__builtin_bit_cast(bf16x8, (u32x4){y0.x, y0.y, y1.x, y1.y}), bUV, yacc); }
#pragma unroll
            for (int r = 0; r < 4; ++r) YS[(16 * q + 4 * fg + r) * LPS + 16 * tv + fr] = yacc[r];
#pragma unroll
            for (int x = 0; x < 4; ++x) {
                const s16x4v bt = __builtin_bit_cast(s16x4v, __builtin_amdgcn_ds_read_tr16_b64_v4i16((LAS s16x4v*)(BH + (16 * q + 4 * fg + (fr >> 2)) * TS + 16 * x + 4 * (fr & 3))));
                const s16x4v kt = __builtin_bit_cast(s16x4v, __builtin_amdgcn_ds_read_tr16_b64_v4i16((LAS s16x4v*)(KH + (16 * q + 4 * fg + (fr >> 2)) * TS + 16 * x + 4 * (fr & 3))));
                const u32x2 b2 = __builtin_bit_cast(u32x2, bt), k2 = __builtin_bit_cast(u32x2, kt);
                const f32x4 ge = *(const LAS f32x4*)(LP + (16 * q + 15) * LPS + 16 * x + 4 * fg);
                hacc[x] = MFMA16(__builtin_bit_cast(bf16x8, (u32x4){b2.x, b2.y, k2.x, k2.y}), bUV, hacc[x]) * ge; }
        }
        }
        __syncthreads();
        tid = opq(tid0); ei = tid >> 3; ec8 = (tid & 7) * 8;
        { const int st2 = sc * 64 + ei, t2 = dir ? L - 1 - st2 : st2; bf16* yo = Yout + (size_t)(base + t2) * 512 + h * 64 + ec8;
          const f32x4 y0 = *(const LAS f32x4*)(YS + ei * LPS + ec8), y1 = *(const LAS f32x4*)(YS + ei * LPS + ec8 + 4);
          u32x4 yw; yw.x = cvt2(y0[0], y0[1]); yw.y = cvt2(y0[2], y0[3]); yw.z = cvt2(y1[0], y1[1]); yw.w = cvt2(y1[2], y1[3]);
          *(u32x4*)yo = yw;
          if ((tid & 7) == 0) BC[(size_t)(base + t2) * 8 + h] = bcv; }
    }
#undef SCAN_PREFETCH
    if (!lat && w < 4) {
#pragma unroll
        for (int x = 0; x < 4; ++x) *(f32x4*)(p.out + (size_t)MTOK * DM + ((((size_t)bseq * 2 + l) * 2 + dir) * 8 + h) * 4096 + (16 * tv + fr) * 64 + 16 * x + 4 * fg) = hacc[x]; }
    __syncthreads();
}

__device__ __forceinline__ void stage_upass(CKP& p, int l, int bid, int nb) {
    const int tid = opaque_tid(), sub = tid >= 240 ? 1 : 0, j = tid - sub * 240, col = 8 * j;
    const bf16* proj = (const bf16*)(p.ws + WS_PROJ); bf16* U = (bf16*)(p.ws + WS_U); float* KINV = (float*)(p.ws + WS_KINV);
    const float* mu = p.in[I_MU] + l * 1920;
    if (tid < 480) {
        const bool isk = col >= K_OFF && col < V_OFF;
        const float* kkp = p.in[I_KK] + l * 512 + (isk ? col - K_OFF : 0);
        const f32x4 k0 = *(const f32x4*)kkp, k1 = *(const f32x4*)(kkp + 4);
#pragma unroll 1
        for (int tok0 = bid * 2 + sub; tok0 < MTOK; tok0 += nb * 8) {
            float uu[4][8];
#pragma unroll
            for (int z = 0; z < 4; ++z) { const int tok = min(tok0 + z * nb * 2, MTOK - 1);
                const bool lat = tok >= NCTX; const int L = lat ? 1024 : 256, t = lat ? (tok - NCTX) & 1023 : tok & 255;
                shift8(proj, tok, t > 0, t < L - 1, col, mu, uu[z]); }
#pragma unroll
            for (int z = 0; z < 4; ++z) { const int tok = tok0 + z * nb * 2;
                float ss = 0.f;
#pragma unroll
                for (int e = 0; e < 8; ++e) { const float kn = uu[z][e] * (e < 4 ? k0[e & 3] : k1[e & 3]); ss += kn * kn; }
                ss = red8(ss);
                if (tok < MTOK) {
                    if (isk && (j & 7) == 0) KINV[(size_t)tok * 8 + ((col - K_OFF) >> 6)] = fminf(frsq(ss), 1e12f);
                    if (col >= WD_OFF && col < AD_OFF) {
#pragma unroll
                        for (int e = 0; e < 8; ++e) uu[z][e] = 1.0f - 2.0f * frcp(fexp(2.0f * uu[z][e]) + 1.0f); }
                    if (col >= GD_OFF) {
#pragma unroll
                        for (int e = 0; e < 8; ++e) uu[z][e] = fsigmoid(uu[z][e]); }
                    *(u32x4*)(U + (size_t)tok * 1920 + col) = pack8(uu[z]); } }
        }
    }
}

__device__ __forceinline__ void fnet1_item(CKP& p, int l, int item) {
    const int tid = opaque_tid(), lane = tid & 63, w = __builtin_amdgcn_readfirstlane(tid >> 6), fr = lane & 15, fg = lane >> 4;
    const int tb = item >> 2, g = item & 3, tok0 = tb * 64, tt = w & 3, cs = w >> 2;
    const bf16* proj = (const bf16*)(p.ws + WS_PROJ);
    const bf16* fwt = (const bf16*)(p.ws + WS_FW) + (size_t)((l * 4 + g) * 128 + cs * 64) * 64;
    const bf16* xr = proj + (size_t)(tok0 + 16 * tt + fr) * DINP + F_OFF + g * 64 + fg * 8;
    const bf16x8 a0 = *(const bf16x8*)xr, a1 = *(const bf16x8*)(xr + 32);
    const bool lat = tok0 >= NCTX;
    const int L = lat ? 1024 : 256, bq = lat ? (tok0 - NCTX) >> 10 : tok0 >> 8, t = (lat ? (tok0 - NCTX) & 1023 : tok0 & 255) + 16 * tt + 4 * fg;
    const float scale = lat ? (1.0f / 256.0f) : (1.0f / 128.0f);
    bf16* Y = (bf16*)(p.ws + WS_YCS) + (lat ? (size_t)8192 * 512 : 0);
#pragma unroll
    for (int ot = 0; ot < 4; ++ot) {
        const bf16x8 b0 = *(const bf16x8*)(fwt + (16 * ot + fr) * 64 + fg * 8), b1 = *(const bf16x8*)(fwt + (16 * ot + fr) * 64 + 32 + fg * 8);
        f32x4 c = (f32x4){0.f, 0.f, 0.f, 0.f}; c = MFMA16(a0, b0, c); c = MFMA16(a1, b1, c);
        u32x2 o; o.x = cvt2(c[0] * scale, c[1] * scale); o.y = cvt2(c[2] * scale, c[3] * scale);
        *(u32x2*)(Y + (size_t)((bq * 4 + g) * 64 + 16 * ot + fr) * (2 * L) + cs * L + t) = o; }
}

__device__ __forceinline__ void pool_item(CKP& p, int l, LAS unsigned char* lds, int item) {
    const int tid = opaque_tid(), tb = item >> 2, gi = item & 3, tok0 = tb * 64, hw = 1 << gi;
    const bf16* proj = (const bf16*)(p.ws + WS_PROJ);
    LAS bf16* DB = (LAS bf16*)lds;
    LAS float* CSUM = (LAS float*)(lds + 9216);
    const int ti = tid >> 3, c8 = (tid & 7) * 8, tok = tok0 + ti, col = P_OFF + gi * 64 + c8;
    { float sum[8], x[8];
#pragma unroll
      for (int j = 0; j < 8; ++j) sum[j] = 0.f;
      load8bf(proj + (size_t)tok * DINP + col, x);
      float cnt;
      if (tok < NCTX) { const int t = tok & 255, sb = tok - t, lo = max(t - hw, 0), hi = min(t + hw, 256);
          u32x4 wv[16];
#pragma unroll
          for (int q = 0; q < 16; ++q) { const int tq = min(t - hw + q, 255); wv[q] = (q < 2 * hw && tq >= 0) ? *(const u32x4*)(proj + (size_t)(sb + max(tq, 0)) * DINP + col) : (u32x4){0u, 0u, 0u, 0u}; }
#pragma unroll
          for (int q = 0; q < 16; ++q) if (q < 2 * hw) { const bool ok = t - hw + q >= 0 && t - hw + q < 256; const u32x4 w = wv[q];
              if (ok) { sum[0] += bflo(w.x); sum[1] += bfhi(w.x); sum[2] += bflo(w.y); sum[3] += bfhi(w.y); sum[4] += bflo(w.z); sum[5] += bfhi(w.z); sum[6] += bflo(w.w); sum[7] += bfhi(w.w); } }
          cnt = (float)(hi - lo); }
      else {
          const int t = (tok - NCTX) & 1023, sb = tok - t, r = t >> 6, c = t & 63, rlo = max(r - hw, 0), rhi = min(r + hw, 16), clo = max(c - hw, 0), chi = min(c + hw, 64);
          u32x4 wv[16];
#pragma unroll
          for (int q = 0; q < 16; ++q) { const int rq = r - hw + q; wv[q] = (q < 2 * hw && rq >= 0 && rq < 16) ? *(const u32x4*)(proj + (size_t)(sb + rq * 64 + c) * DINP + col) : (u32x4){0u, 0u, 0u, 0u}; }
#pragma unroll
          for (int q = 0; q < 16; ++q) { const u32x4 w = wv[q];
              sum[0] += bflo(w.x); sum[1] += bfhi(w.x); sum[2] += bflo(w.y); sum[3] += bfhi(w.y); sum[4] += bflo(w.z); sum[5] += bfhi(w.z); sum[6] += bflo(w.w); sum[7] += bfhi(w.w); }
          *(LAS f32x4*)(CSUM + ti * 68 + c8) = (f32x4){sum[0], sum[1], sum[2], sum[3]}; *(LAS f32x4*)(CSUM + ti * 68 + c8 + 4) = (f32x4){sum[4], sum[5], sum[6], sum[7]};
          __syncthreads();
#pragma unroll
          for (int j = 0; j < 8; ++j) sum[j] = 0.f;
          for (int cq = clo; cq < chi; ++cq) { const f32x4 a = *(const LAS f32x4*)(CSUM + cq * 68 + c8), b = *(const LAS f32x4*)(CSUM + cq * 68 + c8 + 4);
#pragma unroll
              for (int j = 0; j < 4; ++j) { sum[j] += a[j]; sum[4 + j] += b[j]; } }
          cnt = (float)((rhi - rlo) * (chi - clo)); }
      const float ic = frcp(cnt);
      float dd[8];
#pragma unroll
      for (int j = 0; j < 8; ++j) dd[j] = sum[j] * ic - x[j];
      *(LAS u32x4*)(DB + ti * 72 + c8) = pack8(dd); }
    __syncthreads();
    { const int lane = tid & 63, w = __builtin_amdgcn_readfirstlane(tid >> 6), fr = lane & 15, fg = lane >> 4, tt = w & 3;
      const bf16* wpt = (const bf16*)(p.ws + WS_WPT) + (size_t)(l * 4 + gi) * 4096;
      const bf16x8 b0 = *(const LAS bf16x8*)(DB + (16 * tt + fr) * 72 + fg * 8), b1 = *(const LAS bf16x8*)(DB + (16 * tt + fr) * 72 + 32 + fg * 8);
#pragma unroll
      for (int x = 0; x < 2; ++x) { const int ot = 2 * (w >> 2) + x;
          const bf16x8 a0 = *(const bf16x8*)(wpt + (16 * ot + fr) * 64 + fg * 8), a1 = *(const bf16x8*)(wpt + (16 * ot + fr) * 64 + 32 + fg * 8);
          f32x4 c = (f32x4){0.f, 0.f, 0.f, 0.f}; c = MFMA16(a0, b0, c); c = MFMA16(a1, b1, c);
          const f32x4 ps = *(const f32x4*)(p.in[I_PSCALE] + l * 256 + gi * 64 + 16 * ot + 4 * fg);
          c *= ps;
          u32x2 o; o.x = cvt2(c[0], c[1]); o.y = cvt2(c[2], c[3]);
          *(u32x2*)((bf16*)(p.ws + WS_MIXED) + (size_t)(tok0 + 16 * tt + fr) * DM + 768 + gi * 64 + 16 * ot + 4 * fg) = o; } }
    __syncthreads();
}

__device__ __forceinline__ float xsum_fg(float s, int fr, int fg) {
    s += __builtin_bit_cast(float, __builtin_amdgcn_ds_bpermute((((fg ^ 1) << 4) | fr) << 2, __builtin_bit_cast(int, s)));
    s += __builtin_bit_cast(float, __builtin_amdgcn_ds_bpermute((((fg ^ 2) << 4) | fr) << 2, __builtin_bit_cast(int, s)));
    return s;
}
__device__ __forceinline__ void stage_post(CKP& p, int l, int bid, int nb) {
    const int tid = opaque_tid(), lane = tid & 63, head = __builtin_amdgcn_readfirstlane(tid >> 6), fr = lane & 15, fg = lane >> 4;
    const bf16* Ub = (const bf16*)(p.ws + WS_U);
    const bf16* gupt = (const bf16*)(p.ws + WS_GUPT) + ((size_t)l * 512 + head * 64) * 128;
    const bf16* YF = (const bf16*)(p.ws + WS_YF); const bf16* YB = (const bf16*)(p.ws + WS_YB);
    const float* BC0 = (const float*)(p.ws + WS_BC); const float* BC1 = BC0 + (size_t)MTOK * 8;
    bf16* MIX = (bf16*)(p.ws + WS_MIXED);
    bf16x8 ag[4][4];
    f32x4 lnw[4], lnb[4];
#pragma unroll
    for (int t = 0; t < 4; ++t) {
#pragma unroll
        for (int ks = 0; ks < 4; ++ks) ag[t][ks] = *(const bf16x8*)(gupt + (16 * t + fr) * 128 + ks * 32 + fg * 8);
        lnw[t] = *(const f32x4*)(p.in[I_LNW] + l * 512 + head * 64 + 16 * t + 4 * fg); lnb[t] = *(const f32x4*)(p.in[I_LNB] + l * 512 + head * 64 + 16 * t + 4 * fg); }
#pragma unroll 1
    for (int item = bid; item < 768; item += nb) {
        const size_t tok = (size_t)item * 16 + fr;
        bf16x8 bs[4];
#pragma unroll
        for (int ks = 0; ks < 4; ++ks) bs[ks] = *(const bf16x8*)(Ub + tok * 1920 + GD_OFF + ks * 32 + fg * 8);
        f32x4 y[4]; u32x2 vw[4];
#pragma unroll
        for (int t = 0; t < 4; ++t) { const int c = head * 64 + 16 * t + 4 * fg;
            const u32x2 yf = *(const u32x2*)(YF + tok * 512 + c), yb = *(const u32x2*)(YB + tok * 512 + c);
            y[t] = (f32x4){bflo(yf.x) + bflo(yb.x), bfhi(yf.x) + bfhi(yb.x), bflo(yf.y) + bflo(yb.y), bfhi(yf.y) + bfhi(yb.y)}; vw[t] = *(const u32x2*)(Ub + tok * 1920 + V_OFF + c); }
        const float bc = BC0[tok * 8 + head] + BC1[tok * 8 + head];
        f32x4 g[4];
#pragma unroll
        for (int t = 0; t < 4; ++t) { g[t] = (f32x4){0.f, 0.f, 0.f, 0.f};
#pragma unroll
            for (int ks = 0; ks < 4; ++ks) g[t] = MFMA16(ag[t][ks], bs[ks], g[t]); }
        float s = 0.f;
#pragma unroll
        for (int t = 0; t < 4; ++t) s += (y[t][0] + y[t][1]) + (y[t][2] + y[t][3]);
        const float mean = xsum_fg(s, fr, fg) * (1.0f / 64.0f);
        float q = 0.f;
#pragma unroll
        for (int t = 0; t < 4; ++t) { y[t] = y[t] - mean; q += (y[t][0] * y[t][0] + y[t][1] * y[t][1]) + (y[t][2] * y[t][2] + y[t][3] * y[t][3]); }
        const float rstd = frsq(xsum_fg(q, fr, fg) * (1.0f / 64.0f) + 64e-5f);
#pragma unroll
        for (int t = 0; t < 4; ++t) { const f32x4 vv = (f32x4){bflo(vw[t].x), bfhi(vw[t].x), bflo(vw[t].y), bfhi(vw[t].y)};
            const f32x4 o = (y[t] * rstd * lnw[t] + lnb[t] + vv * bc) * g[t];
            u32x2 w; w.x = cvt2(o[0], o[1]); w.y = cvt2(o[2], o[3]);
            *(u32x2*)(MIX + tok * DM + head * 64 + 16 * t + 4 * fg) = w; }
    }
}

#define XB_TMO      128
#define XB_XCNT(j)  (256  + 64 * (j))
#define XB_XSUB(j)  (1280 + 64 * (j))
#define XB_XGEN(j)  (2304 + 64 * (j))
#define XB_TOP      3328
#define XB_TOPGEN   3392
#define XCD_BAR_WORDS 3456
#define XB_SPIN_CAP (1u << 18)

__device__ __forceinline__ unsigned xb_ld(unsigned* p)              { return __hip_atomic_load(p, __ATOMIC_RELAXED, __HIP_MEMORY_SCOPE_AGENT); }
__device__ __forceinline__ unsigned xb_add(unsigned* p, unsigned v) { return __hip_atomic_fetch_add(p, v, __ATOMIC_RELAXED, __HIP_MEMORY_SCOPE_AGENT); }
__device__ __forceinline__ unsigned xb_xcc_id() { return (unsigned)__builtin_amdgcn_s_getreg((3 << 11) | 20) & 0xFu; }
#define XB_SPIN(cond, bar) do { unsigned _sp = 0; while (cond) { __builtin_amdgcn_s_sleep(1); \
    if ((++_sp & 255u) == 0u) { if (xb_ld(&(bar)[XB_TMO])) break; if (_sp > XB_SPIN_CAP) { atomicAdd(&(bar)[XB_TMO], 1u); break; } } } } while (0)

struct XcdBarrier {
    unsigned* bar; unsigned x;
    volatile LAS unsigned* st;
};

__device__ __forceinline__ XcdBarrier xcd_barrier_post(unsigned* bar, volatile LAS unsigned* st) {
    XcdBarrier b; b.bar = bar; b.x = xb_xcc_id(); b.st = st;
    if (threadIdx.x == 0) (void)xb_add(&bar[XB_XCNT(b.x)], 1u);
    return b;
}
__device__ __forceinline__ void xcd_barrier_complete(unsigned* bar, unsigned x, unsigned& nloc, unsigned& nx) {
    const unsigned G = gridDim.x * gridDim.y * gridDim.z;
    unsigned sum, cnt, mine, sp = 0u;
    for (;;) {
        sum = 0u; cnt = 0u; mine = 0u;
#pragma unroll
        for (unsigned j = 0; j < 16; ++j) { const unsigned c = xb_ld(&bar[XB_XCNT(j)]); sum += c; cnt += (c > 0u) ? 1u : 0u; mine = (j == x) ? c : mine; }
        if (sum == G) break;
        __builtin_amdgcn_s_sleep(1);
        if ((++sp & 255u) == 0u) { if (xb_ld(&bar[XB_TMO])) break; if (sp > XB_SPIN_CAP) { atomicAdd(&bar[XB_TMO], 1u); break; } }
    }
    nloc = mine > 0u ? mine : 1u; nx = cnt > 0u ? cnt : 1u;
}

__device__ __forceinline__ void xcd_barrier(const XcdBarrier& b) {
    asm volatile("s_waitcnt vmcnt(0)" ::: "memory");
    __syncthreads();
    if (threadIdx.x == 0) {
        unsigned* bar = b.bar;
        __builtin_amdgcn_s_waitcnt(0);
        unsigned nloc = b.st[0], nx = b.st[1];
        if (nloc == 0u) { xcd_barrier_complete(bar, b.x, nloc, nx); b.st[0] = nloc; b.st[1] = nx; }
        const unsigned old = xb_add(&bar[XB_XSUB(b.x)], 1u);
        const unsigned gen = old / nloc;
        if (old + 1u == (gen + 1u) * nloc) {
            __builtin_amdgcn_fence(__ATOMIC_RELEASE, "agent");
            asm volatile("s_waitcnt vmcnt(0)" ::: "memory");
            const unsigned og = xb_add(&bar[XB_TOP], 1u);
            const unsigned tg = og / nx;
            __builtin_amdgcn_fence(__ATOMIC_ACQUIRE, "agent");
            if (og + 1u == (tg + 1u) * nx) xb_add(&bar[XB_TOPGEN], 1u);
            else XB_SPIN(xb_ld(&bar[XB_TOPGEN]) == tg, bar);
            xb_add(&bar[XB_XGEN(b.x)], 1u);
            asm volatile("s_waitcnt vmcnt(0)" ::: "memory");
        } else {
            __builtin_amdgcn_fence(__ATOMIC_ACQUIRE, "agent");
            XB_SPIN(xb_ld(&bar[XB_XGEN(b.x)]) == gen, bar);
            asm volatile("s_waitcnt vmcnt(0)" ::: "memory");
        }
    }
    __syncthreads();
}

struct EpiAny {
    static constexpr bool AFTER_DRAIN = false;
    int mode; bool PERM; int l;
    __device__ __forceinline__ void operator()(const f32x4 (&acc)[2][2][4][2], const pg8::Unit& u, int wr, int wc, int fr, int fq) const {
        CKP* kp = (CKP*)__builtin_amdgcn_kernarg_segment_ptr(); asm volatile("" : "+s"(kp)); CKP& p = *kp;
        unsigned char* ws = p.ws;
        const float* mod = (const float*)(ws + WS_MOD) + (size_t)l * 5 * 6144;
        float* SSQ = (float*)(ws + WS_CTL + 262144);
        bf16* Hb = (bf16*)(ws + WS_H); bf16* XB = (bf16*)(ws + WS_XB);
        if (mode == 7) {
#pragma unroll
            for (int a = 0; a < 2; ++a)
#pragma unroll
                for (int b = 0; b < 2; ++b)
#pragma unroll
                    for (int m = 0; m < 4; ++m)
#pragma unroll
                        for (int n = 0; n < 2; ++n) asm volatile("" :: "v"(acc[a][b][m][n]));
            return; }
        if (mode == 0) { const pg8::EpiBf<0> e{(bf16*)(ws + WS_PROJ), DINP}; e(acc, u, wr, wc, fr, fq); }
        else if (mode == 2) { const pg8::EpiResFinal e{XB, mod + 5 * 1024, p.in[I_FNG], p.out, SSQ + 49152, (unsigned*)(ws + WS_CTL + 524288) + 64 * 16}; e(acc, u, wr, wc, fr, fq); }
        else if (mode == 3) { const pg8::EpiFnet e{(bf16*)(ws + WS_MIXED), 0, 256}; e(acc, u, wr, wc, fr, fq); }
        else if (mode == 8) { const pg8::EpiFnet e{(bf16*)(ws + WS_MIXED), NCTX, 1024}; e(acc, u, wr, wc, fr, fq); }
        else if (mode == 4) { const pg8::EpiNormBf<0> e{(bf16*)(ws + WS_PROJ), DINP, SSQ + 16384, (const float*)(ws + WS_SWIN), DINP}; e(acc, u, wr, wc, fr, fq); }
        else if (mode == 5) { const pg8::EpiNormBf<1> e{(bf16*)(ws + WS_FF), DFF, SSQ + l * 32768, (const float*)(ws + WS_SW1) + (size_t)l * 5 * DFF, DFF}; e(acc, u, wr, wc, fr, fq); }
        else if (mode == 6) {
            if (l == 0) { const pg8::EpiResNorm<true, true> e{XB, mod + 2 * 1024, p.in[I_XP], p.in[I_XS], Hb, p.in[I_N2G], mod + 4 * 1024, SSQ}; e(acc, u, wr, wc, fr, fq); }
            else { const pg8::EpiResNorm<false, true> e{XB, mod + 2 * 1024, nullptr, nullptr, Hb, p.in[I_N2G] + DM, mod + 4 * 1024, SSQ + 32768}; e(acc, u, wr, wc, fr, fq); } }
        else { const pg8::EpiResNorm<false, true> e{XB, mod + 5 * 1024, nullptr, nullptr, Hb, p.in[I_N1G] + DM, mod + 5 * 6144 + 1 * 1024, SSQ + 16384}; e(acc, u, wr, wc, fr, fq); }
    }
};

constexpr int N_STEPS = 16;
__device__ __forceinline__ bool step_seam(int st) { return st < 15; }
__global__ void __launch_bounds__(NTHR, 2) mega_fwd(KP p_unused) {
    extern __shared__ __attribute__((aligned(16))) unsigned char lds_raw[];
    CKP* kp0 = (CKP*)__builtin_amdgcn_kernarg_segment_ptr();
    { LAS unsigned* ctlw = (LAS unsigned*)((LAS unsigned char*)lds_raw + RING_BYTES);
      for (int u = threadIdx.x; u < (LDS_BYTES - RING_BYTES) / 4; u += NTHR) ctlw[u] = 0u; }
    __syncthreads();
    const XcdBarrier bar = xcd_barrier_post((unsigned*)(kp0->ws + WS_CTL) + 4096, (volatile LAS unsigned*)((LAS unsigned char*)lds_raw + MISC_OFF + 32));
    const int ph_lo = kp0->ph_lo, ph_hi = kp0->ph_hi;
#pragma unroll 1
#ifdef REP_A
    for (int sti = ph_lo; sti < ph_hi + ((REP_B) >= 0 ? 2 : 1); ++sti) {
        const int st = sti <= (REP_A) ? sti : (((REP_B) < 0 || sti <= (REP_B) + 1) ? sti - 1 : sti - 2);
        const bool isdup = sti == (REP_A) || ((REP_B) >= 0 && sti == (REP_B) + 1); (void)isdup;
#else
    for (int st = ph_lo; st < ph_hi; ++st) {
#endif
        CKP* kp = kp0; asm volatile("" : "+s"(kp));
        CKP& p = *kp; unsigned char* ws = p.ws;
        int bid = blockIdx.x, nb = gridDim.x; unsigned ldsb = (unsigned)(size_t)(LAS unsigned char*)lds_raw;
        asm volatile("" : "+s"(bid), "+s"(nb), "+s"(ldsb));
        LAS unsigned char* lds = (LAS unsigned char*)(size_t)ldsb;
        const int l = st < 9 ? 0 : 1, s = st == 0 ? -1 : (st == 1 ? 0 : ((st - 2) % 7 + 1));
        const float* mod = (const float*)(ws + WS_MOD) + (size_t)l * 5 * 6144;
#pragma unroll 1
        for (int job = 0; job < 2; ++job) {
            pg8::Gemm g{nullptr, nullptr, 0, 0, 0, 0, 0}; EpiAny E{-1, true, 0}; int corder = bid;
            if (job == 0) {
                if (s == 1) { g = pg8::Gemm{(const bf16*)(ws + WS_H), (const bf16*)(ws + WS_WIN) + (size_t)l * DINP * DM, MTOK, DINP, DM, DM, DM}; E = EpiAny{l == 0 ? 0 : 4, true, l}; }
                else if (s == 3) { g = pg8::Gemm{(const bf16*)(ws + WS_CS256), (const bf16*)(ws + WS_YCS), 256, 8192, 512, 512, 512}; E = EpiAny{3, true, l}; corder = (bid + nb - (nb >= 256 ? 192 : 0)) % nb; }
                else if (s == 5) { g = pg8::Gemm{(const bf16*)(ws + WS_MIXED), (const bf16*)(ws + WS_WOUT) + (size_t)l * DM * DM, MTOK, DM, DM, DM, DM}; E = EpiAny{6, true, l}; }
                else if (s == 6) { g = pg8::Gemm{(const bf16*)(ws + WS_H), (const bf16*)(ws + WS_W1) + (size_t)l * DFF * DM, MTOK, DFF, DM, DM, DM}; E = EpiAny{5, true, l}; }
                else if (s == 7) { g = pg8::Gemm{(const bf16*)(ws + WS_FF), (const bf16*)(ws + WS_W2) + (size_t)l * DM * DFF, MTOK, DM, DFF, DFF, DFF}; E = l == 0 ? EpiAny{9, true, l} : EpiAny{2, true, l}; }
            } else if (s == 3) { g = pg8::Gemm{(const bf16*)(ws + WS_CS1024), (const bf16*)(ws + WS_YCS) + (size_t)8192 * 512, 1024, 1024, 2048, 2048, 2048}; E = EpiAny{8, true, l}; corder = (bid + nb - (nb >= 256 ? 224 : 32)) % nb; }
#ifdef NOEPI_FIRST
            if (isdup && E.mode >= 0) E.mode = 7;
#endif
            if (E.mode >= 0) {
                pg8::StaticOrder S; S.init(g.M, g.N, nb, corder);
                pg8::gemm_phase<EpiAny, pg8::StaticOrder, true, true>(lds, g, S, E);
                __syncthreads();
            }
        }
        if (s == 3) {
            if (nb >= 256) {
                if (bid < 64) rwkv_item3(p, l, lds, bid);
                else { unsigned* ctr = (unsigned*)(ws + WS_CTL + 524288) + 64 * (2 + l); volatile LAS unsigned* slot = (volatile LAS unsigned*)(lds + RING_BYTES + 64);
#pragma unroll 1
                    for (;;) { __syncthreads(); if (threadIdx.x == 0) *slot = atomicAdd(ctr, 1u); __syncthreads(); const int it = (int)*slot; if (it >= 512) break; rwkv_item3(p, l, lds, 64 + it); } }
            } else for (int it = bid; it < 576; it += nb) rwkv_item3(p, l, lds, it);
            side_queue(p, l, lds);
        }
        if (s == -1) stage_prologue(p, lds, bid, nb);
        else if (s == 0) { stage_norm(p, 0, 0, bid, nb); stage_tables(p, bid, nb); }
        else if (s == 2) {
            stage_upass(p, l, bid, nb);
#ifdef DUP_U
            stage_upass(p, l, bid, nb);
#endif
#pragma unroll 1
            for (int it = bid; it < 768; it += nb) fnet1_item(p, l, it);
#ifdef DUP_F
#pragma unroll 1
            for (int it = bid; it < 768; it += nb) fnet1_item(p, l, it);
#endif
#pragma unroll 1
            for (int it = bid; it < 768; it += nb) pool_item(p, l, lds, it);
#ifdef DUP_P
#pragma unroll 1
            for (int it = bid; it < 768; it += nb) pool_item(p, l, lds, it);
#endif
        }
        else if (s == 4) stage_post(p, l, bid, nb);
        #ifdef REP_A
        if (sti + 1 < ph_hi + ((REP_B) >= 0 ? 2 : 1)) xcd_barrier(bar);
#else
        if (st + 1 < ph_hi && step_seam(st)) xcd_barrier(bar);
#endif
    }
}

extern "C" void kernel_launch(void* const* d_in, const int* in_sizes, int n_in, void* d_out, int out_size, void* d_ws, size_t ws_size, hipStream_t stream) {
    static int grid = 0;
    if (grid == 0) {
        if (n_in != N_IN || ws_size < WS_END) { fprintf(stderr, "kernel_launch: unexpected inputs (n_in %d, ws %zu)\n", n_in, ws_size); grid = -1; return; }
        int dev = 0, cus = 0, per_cu = 0;
        (void)hipGetDevice(&dev); (void)hipDeviceGetAttribute(&cus, hipDeviceAttributeMultiprocessorCount, dev);
        (void)hipFuncSetAttribute((const void*)mega_fwd, hipFuncAttributeMaxDynamicSharedMemorySize, LDS_BYTES);
        if (hipOccupancyMaxActiveBlocksPerMultiprocessor(&per_cu, (const void*)mega_fwd, NTHR, LDS_BYTES) != hipSuccess || per_cu < 1) {
            fprintf(stderr, "kernel_launch: occupancy query reports %d blocks/CU\n", per_cu); (void)hipGetLastError(); grid = -1; return; }
        grid = cus * 1;
    }
    if (grid < 0) return;
    KP a{};
    for (int i = 0; i < N_IN; ++i) a.in[i] = (const float*)d_in[i];
    a.out = (float*)d_out; a.ws = (unsigned char*)d_ws; a.ph_lo = 0; a.ph_hi = N_STEPS;
    if (hipMemsetAsync((char*)d_ws + WS_CTL, 0, 1 * MiB, stream) != hipSuccess) { fprintf(stderr, "kernel_launch: memset failed\n"); return; }
    void* args[] = {&a};
    hipError_t e = hipLaunchCooperativeKernel((const void*)mega_fwd, dim3(grid), dim3(NTHR), args, LDS_BYTES, stream);
    if (e != hipSuccess) fprintf(stderr, "cooperative launch failed: %s (grid %d)\n", hipGetErrorString(e), grid);
}
```

```cpp
#include <hip/hip_runtime.h>
#include <hip/hip_cooperative_groups.h>
#include <cstdio>
#include <cstdint>
namespace cg = cooperative_groups;
__device__ __forceinline__ int opaque_tid() { int t = threadIdx.x; asm volatile("" : "+v"(t)); return t; }
namespace pg8 {
#define PG8_LAS __attribute__((address_space(3)))
typedef unsigned short bf16_t;
typedef short bf16x8 __attribute__((ext_vector_type(8)));
typedef float f32x4 __attribute__((ext_vector_type(4)));
typedef unsigned u32x4 __attribute__((ext_vector_type(4)));
constexpr int BM = 256, BK = 64, HALF = 128, HTB = HALF * BK * 2  , STAGE_BYTES = 8 * HTB, NXCD = 8, WGM = 8;

__host__ __device__ __forceinline__ int lds_byte(int r, int c) { const int st = (r >> 4) * 2 + (c >> 5), rr = r & 15, cc = c & 31, ob = rr * 64 + cc * 2; return st * 1024 + (ob ^ (((ob >> 9) & 1) << 5)); }
__host__ __device__ __forceinline__ void stage_rc(int b, int& R, int& C) { const int st = b / 1024, sb = b % 1024, swz = sb ^ (((sb >> 9) & 1) << 5); R = (st >> 1) * 16 + swz / 64; C = (st & 1) * 32 + (swz % 64) / 2; }
__host__ __device__ __forceinline__ int perm32(int rho) { const int n = rho >> 4, i = rho & 15; return 8 * (i >> 2) + 4 * n + (i & 3); }

struct Unit { int pm, pn; };
struct Gemm { const bf16_t* A; const bf16_t* Bt; int M, N, K, lda, ldb; };

struct StaticOrder {
    int nM, nN, nwg, G, c;
    __host__ __device__ void init(int M, int N, int G_, int c_) { nM = M / BM; nN = N / BM; nwg = nM * nN; G = G_; c = c_; }
    __host__ __device__ bool next(int i, Unit& u) const {
        const long L = (long)i * G + c; if (L >= nwg) return false;
        int wgid = (int)L; { const int q = nwg / NXCD, r = nwg % NXCD, xcd = wgid % NXCD, off = wgid / NXCD; wgid = (xcd < r ? xcd * (q + 1) : r * (q + 1) + (xcd - r) * q) + off; }
        const int nig = WGM * nN, gid = wgid / nig, fm = gid * WGM, gsz = (nM - fm) < WGM ? (nM - fm) : WGM;
        u.pm = fm + ((wgid % nig) % gsz); u.pn = (wgid % nig) / gsz; return true;
    }
    __device__ __forceinline__ void a_ready(const Unit&) const {}
    __device__ __forceinline__ void done(const Unit&) const {}
};

__device__ __forceinline__ unsigned cvt_pk_bf16(float lo, float hi) { unsigned r; asm volatile("v_cvt_pk_bf16_f32 %0, %1, %2" : "=v"(r) : "v"(lo), "v"(hi)); return r; }
typedef unsigned u32x2 __attribute__((ext_vector_type(2)));
template <int ACT  > struct EpiBf {
    static constexpr bool PERM = true, AFTER_DRAIN = false;
    bf16_t* O; int ldc;
    __device__ __forceinline__ void operator()(const f32x4 (&acc)[2][2][4][2], const Unit& u, int wr, int wc, int fr, int fq) const {
        const int row0 = u.pm * BM + wr * 64 + fr, col0 = u.pn * BM + wc * 32 + 8 * fq;
#pragma unroll
        for (int ai = 0; ai < 2; ++ai)
#pragma unroll
            for (int m = 0; m < 4; ++m) { bf16_t* rowp = O + (size_t)(row0 + ai * HALF + m * 16) * ldc + col0;
#pragma unroll
                for (int bj = 0; bj < 2; ++bj) { f32x4 v0 = acc[ai][bj][m][0], v1 = acc[ai][bj][m][1];
                    if (ACT == 1) {
#pragma unroll
                        for (int e = 0; e < 4; ++e) { float a = v0[e] > 0.f ? v0[e] : 0.f; v0[e] = a * a; float b = v1[e] > 0.f ? v1[e] : 0.f; v1[e] = b * b; } }
                    u32x4 w; w.x = cvt_pk_bf16(v0[0], v0[1]); w.y = cvt_pk_bf16(v0[2], v0[3]); w.z = cvt_pk_bf16(v1[0], v1[1]); w.w = cvt_pk_bf16(v1[2], v1[3]);
                    *(u32x4*)(rowp + bj * HALF) = w; } }
    }
};
struct EpiRes {
    static constexpr bool PERM = false, AFTER_DRAIN = false;
    float* X; const float* gate; const float* Xc; const float* Xl;
    __device__ __forceinline__ void operator()(const f32x4 (&acc)[2][2][4][2], const Unit& u, int wr, int wc, int fr, int fq) const {
        const int row0 = u.pm * BM + wr * 64 + fr, col0 = u.pn * BM + wc * 32 + 4 * fq;
        const int cond = u.pm < 32 ? 0 : 1 + ((u.pm - 32) >> 2);
        const float* gp = gate + cond * 6144 + col0;
        f32x4 gv[2][2];
#pragma unroll
        for (int bj = 0; bj < 2; ++bj)
#pragma unroll
            for (int n = 0; n < 2; ++n) gv[bj][n] = *(const f32x4*)(gp + bj * HALF + n * 16);
#pragma unroll
        for (int ai = 0; ai < 2; ++ai)
#pragma unroll
            for (int m = 0; m < 4; ++m) { const size_t ro = (size_t)(row0 + ai * HALF + m * 16) * 1024 + col0; float* rowp = X + ro; const float* srcp = u.pm < 32 ? Xc + ro : Xl + (ro - (size_t)8192 * 1024);
#pragma unroll
                for (int bj = 0; bj < 2; ++bj)
#pragma unroll
                    for (int n = 0; n < 2; ++n) { *(f32x4*)(rowp + bj * HALF + n * 16) = *(const f32x4*)(srcp + bj * HALF + n * 16) + gv[bj][n] * acc[ai][bj][m][n]; }
                if (m & 1) asm volatile("" ::: "memory"); }
    }
};
struct EpiFnet {
    static constexpr bool PERM = true, AFTER_DRAIN = false;
    bf16_t* MIX; int rowbase, L;
    __device__ __forceinline__ void operator()(const f32x4 (&acc)[2][2][4][2], const Unit& u, int wr, int wc, int fr, int fq) const {
        const int row0 = u.pm * BM + wr * 64 + fr, colw = wc * 32 + 8 * fq;
        bf16_t* base = MIX + (size_t)(rowbase + u.pn * L) * 1024 + 512 + colw;
#pragma unroll
        for (int ai = 0; ai < 2; ++ai)
#pragma unroll
            for (int m = 0; m < 4; ++m) { bf16_t* rowp = base + (size_t)(row0 + ai * HALF + m * 16) * 1024;
#pragma unroll
                for (int bj = 0; bj < 2; ++bj) { const f32x4 v0 = acc[ai][bj][m][0], v1 = acc[ai][bj][m][1];
                    u32x4 w; w.x = cvt_pk_bf16(v0[0], v0[1]); w.y = cvt_pk_bf16(v0[2], v0[3]); w.z = cvt_pk_bf16(v1[0], v1[1]); w.w = cvt_pk_bf16(v1[2], v1[3]);
                    *(u32x4*)(rowp + bj * HALF) = w; } }
    }
};

__device__ __forceinline__ float xsum_fq(float s, int fr, int fq) {
    s += __builtin_bit_cast(float, __builtin_amdgcn_ds_bpermute((((fq ^ 1) << 4) | fr) << 2, __builtin_bit_cast(int, s)));
    s += __builtin_bit_cast(float, __builtin_amdgcn_ds_bpermute((((fq ^ 2) << 4) | fr) << 2, __builtin_bit_cast(int, s)));
    return s;
}
template <int ACT> struct EpiNormBf {
    static constexpr bool PERM = true, AFTER_DRAIN = false;
    bf16_t* O; int ldc; const float* ssq; const float* sw; int swld;
    __device__ __forceinline__ void operator()(const f32x4 (&acc)[2][2][4][2], const Unit& u, int wr, int wc, int fr, int fq) const {
        const int row0 = u.pm * BM + wr * 64 + fr, col0 = u.pn * BM + wc * 32 + 8 * fq;
        const int cond = u.pm < 32 ? 0 : 1 + ((u.pm - 32) >> 2);
        f32x4 sv[2][2];
#pragma unroll
        for (int bj = 0; bj < 2; ++bj)
#pragma unroll
            for (int n = 0; n < 2; ++n) sv[bj][n] = *(const f32x4*)(sw + (size_t)cond * swld + col0 + bj * HALF + 4 * n);
        float rs[2][4];
#pragma unroll
        for (int ai = 0; ai < 2; ++ai)
#pragma unroll
            for (int m = 0; m < 4; ++m) rs[ai][m] = ssq[row0 + ai * HALF + m * 16];
#pragma unroll
        for (int ai = 0; ai < 2; ++ai)
#pragma unroll
            for (int m = 0; m < 4; ++m) rs[ai][m] = __builtin_amdgcn_rsqf(rs[ai][m] * (1.0f / 1024.0f) + 1e-6f);
#pragma unroll
        for (int ai = 0; ai < 2; ++ai)
#pragma unroll
            for (int m = 0; m < 4; ++m) { const int row = row0 + ai * HALF + m * 16; bf16_t* rowp = O + (size_t)row * ldc + col0;
                const float rstd = rs[ai][m];
#pragma unroll
                for (int bj = 0; bj < 2; ++bj) { f32x4 v0 = acc[ai][bj][m][0] * rstd + sv[bj][0], v1 = acc[ai][bj][m][1] * rstd + sv[bj][1];
                    if (ACT == 1) {
#pragma unroll
                        for (int e = 0; e < 4; ++e) { float a = v0[e] > 0.f ? v0[e] : 0.f; v0[e] = a * a; float b = v1[e] > 0.f ? v1[e] : 0.f; v1[e] = b * b; } }
                    u32x4 w; w.x = cvt_pk_bf16(v0[0], v0[1]); w.y = cvt_pk_bf16(v0[2], v0[3]); w.z = cvt_pk_bf16(v1[0], v1[1]); w.w = cvt_pk_bf16(v1[2], v1[3]);
                    *(u32x4*)(rowp + bj * HALF) = w; }
                if (m & 1) asm volatile("" ::: "memory"); }
    }
};
struct EpiResFinal {
    static constexpr bool PERM = true, AFTER_DRAIN = false;
    const bf16_t* XB; const float* gate; const float* gfin; float* out; float* ssq; unsigned* cnt;
    __device__ __forceinline__ void operator()(const f32x4 (&acc)[2][2][4][2], const Unit& u, int wr, int wc, int fr, int fq) const {
        const int row0 = u.pm * BM + wr * 64 + fr, col0 = u.pn * BM + wc * 32 + 8 * fq;
        const int cond = u.pm < 32 ? 0 : 1 + ((u.pm - 32) >> 2);
        f32x4 gt[2][2];
#pragma unroll
        for (int bj = 0; bj < 2; ++bj)
#pragma unroll
            for (int n = 0; n < 2; ++n) gt[bj][n] = *(const f32x4*)(gate + cond * 6144 + col0 + bj * HALF + n * 4);
#pragma unroll
        for (int ai = 0; ai < 2; ++ai) {
            u32x4 xb[4][2];
#pragma unroll
            for (int m = 0; m < 4; ++m)
#pragma unroll
                for (int bj = 0; bj < 2; ++bj) xb[m][bj] = *(const u32x4*)(XB + (unsigned)(row0 + ai * HALF + m * 16) * 1024u + (unsigned)col0 + bj * HALF);
#pragma unroll
            for (int m = 0; m < 4; ++m) { const int row = row0 + ai * HALF + m * 16;
                float sq = 0.f;
#pragma unroll
                for (int bj = 0; bj < 2; ++bj) { const u32x4 xw = xb[m][bj];
                    f32x4 x0 = (f32x4){__builtin_bit_cast(float, xw.x << 16), __builtin_bit_cast(float, xw.x & 0xffff0000u), __builtin_bit_cast(float, xw.y << 16), __builtin_bit_cast(float, xw.y & 0xffff0000u)};
                    f32x4 x1 = (f32x4){__builtin_bit_cast(float, xw.z << 16), __builtin_bit_cast(float, xw.z & 0xffff0000u), __builtin_bit_cast(float, xw.w << 16), __builtin_bit_cast(float, xw.w & 0xffff0000u)};
                    x0 += gt[bj][0] * acc[ai][bj][m][0]; x1 += gt[bj][1] * acc[ai][bj][m][1];
                    sq += ((x0[0] * x0[0] + x0[1] * x0[1]) + (x0[2] * x0[2] + x0[3] * x0[3])) + ((x1[0] * x1[0] + x1[1] * x1[1]) + (x1[2] * x1[2] + x1[3] * x1[3])); }
                const float t = xsum_fq(sq, fr, fq); if (fq == 0) atomicAdd(ssq + row, t); }
            asm volatile("" ::: "memory"); }
        asm volatile("s_waitcnt vmcnt(0)" ::: "memory");
        unsigned* c = cnt + 64 * u.pm;
        if (fr == 0 && fq == 0) { __hip_atomic_fetch_add(c, 1u, __ATOMIC_RELAXED, __HIP_MEMORY_SCOPE_AGENT);
            for (unsigned spin = 0; __hip_atomic_load(c, __ATOMIC_RELAXED, __HIP_MEMORY_SCOPE_AGENT) < 32u && spin < (1u << 22); ++spin) __builtin_amdgcn_s_sleep(2); }
        asm volatile("" ::: "memory");
        f32x4 gv[2][2];
#pragma unroll
        for (int bj = 0; bj < 2; ++bj)
#pragma unroll
            for (int n = 0; n < 2; ++n) gv[bj][n] = *(const f32x4*)(gfin + col0 + bj * HALF + n * 4);
#pragma unroll
        for (int ai = 0; ai < 2; ++ai) {
            u32x4 xb[4][2]; float rs[4];
#pragma unroll
            for (int m = 0; m < 4; ++m) { rs[m] = __hip_atomic_load(ssq + row0 + ai * HALF + m * 16, __ATOMIC_RELAXED, __HIP_MEMORY_SCOPE_AGENT);
#pragma unroll
                for (int bj = 0; bj < 2; ++bj) xb[m][bj] = *(const u32x4*)(XB + (unsigned)(row0 + ai * HALF + m * 16) * 1024u + (unsigned)col0 + bj * HALF); }
#pragma unroll
            for (int m = 0; m < 4; ++m) { const unsigned ro = (unsigned)(row0 + ai * HALF + m * 16) * 1024u + (unsigned)col0;
                const float rstd = __builtin_amdgcn_rsqf(rs[m] * (1.0f / 1024.0f) + 1e-6f);
#pragma unroll
                for (int bj = 0; bj < 2; ++bj) { const u32x4 xw = xb[m][bj];
                    f32x4 x0 = (f32x4){__builtin_bit_cast(float, xw.x << 16), __builtin_bit_cast(float, xw.x & 0xffff0000u), __builtin_bit_cast(float, xw.y << 16), __builtin_bit_cast(float, xw.y & 0xffff0000u)};
                    f32x4 x1 = (f32x4){__builtin_bit_cast(float, xw.z << 16), __builtin_bit_cast(float, xw.z & 0xffff0000u), __builtin_bit_cast(float, xw.w << 16), __builtin_bit_cast(float, xw.w & 0xffff0000u)};
                    f32x4 ga = gt[bj][0], gb = gt[bj][1]; asm volatile("" : "+v"(ga), "+v"(gb));
                    x0 += ga * acc[ai][bj][m][0]; x1 += gb * acc[ai][bj][m][1];
                    *(f32x4*)(out + ro + bj * HALF) = x0 * rstd * gv[bj][0]; *(f32x4*)(out + ro + bj * HALF + 4) = x1 * rstd * gv[bj][1]; } }
            asm volatile("" ::: "memory"); }
    }
};
template <bool SRC_F32, bool WRITE_H> struct EpiResNorm {
    static constexpr bool PERM = true, AFTER_DRAIN = false;
    bf16_t* XB; const float* gate; const float* Xc; const float* Xl; bf16_t* H; const float* gn; const float* scl; float* ssq;
    __device__ __forceinline__ void operator()(const f32x4 (&acc)[2][2][4][2], const Unit& u, int wr, int wc, int fr, int fq) const {
        const int row0 = u.pm * BM + wr * 64 + fr, col0 = u.pn * BM + wc * 32 + 8 * fq;
        const int cond = u.pm < 32 ? 0 : 1 + ((u.pm - 32) >> 2);
        const float* src = u.pm < 32 ? Xc : Xl - (size_t)8192 * 1024;
        f32x4 gt[2][2], gs[2][2];
#pragma unroll
        for (int bj = 0; bj < 2; ++bj)
#pragma unroll
            for (int n = 0; n < 2; ++n) { const int col = col0 + bj * HALF + n * 4;
                gt[bj][n] = *(const f32x4*)(gate + cond * 6144 + col);
                if (WRITE_H) gs[bj][n] = *(const f32x4*)(gn + col) * (*(const f32x4*)(scl + cond * 6144 + col) + 1.0f); }
        constexpr int NB = SRC_F32 ? 2 : 4;
#pragma unroll
        for (int ai = 0; ai < 2; ++ai)
#pragma unroll
        for (int mb = 0; mb < 4; mb += NB) {
            u32x4 xb[NB][2]; f32x4 xf[NB][2][2];
#pragma unroll
            for (int mm = 0; mm < NB; ++mm) { const unsigned ro = (unsigned)(row0 + ai * HALF + (mb + mm) * 16) * 1024u + (unsigned)col0;
#pragma unroll
                for (int bj = 0; bj < 2; ++bj) {
                    if (SRC_F32) { xf[mm][bj][0] = *(const f32x4*)(src + ro + bj * HALF); xf[mm][bj][1] = *(const f32x4*)(src + ro + bj * HALF + 4); }
                    else xb[mm][bj] = *(const u32x4*)(XB + ro + bj * HALF); } }
#pragma unroll
            for (int mm = 0; mm < NB; ++mm) { const int m = mb + mm; const int row = row0 + ai * HALF + m * 16; const unsigned ro = (unsigned)row * 1024u + (unsigned)col0;
                float sq = 0.f;
#pragma unroll
                for (int bj = 0; bj < 2; ++bj) { const unsigned o = ro + bj * HALF;
                    f32x4 x0, x1;
                    if (SRC_F32) { x0 = xf[mm][bj][0]; x1 = xf[mm][bj][1]; }
                    else { const u32x4 xw = xb[mm][bj];
                        x0 = (f32x4){__builtin_bit_cast(float, xw.x << 16), __builtin_bit_cast(float, xw.x & 0xffff0000u), __builtin_bit_cast(float, xw.y << 16), __builtin_bit_cast(float, xw.y & 0xffff0000u)};
                        x1 = (f32x4){__builtin_bit_cast(float, xw.z << 16), __builtin_bit_cast(float, xw.z & 0xffff0000u), __builtin_bit_cast(float, xw.w << 16), __builtin_bit_cast(float, xw.w & 0xffff0000u)}; }
                    x0 += gt[bj][0] * acc[ai][bj][m][0]; x1 += gt[bj][1] * acc[ai][bj][m][1];
                    u32x4 xo; xo.x = cvt_pk_bf16(x0[0], x0[1]); xo.y = cvt_pk_bf16(x0[2], x0[3]); xo.z = cvt_pk_bf16(x1[0], x1[1]); xo.w = cvt_pk_bf16(x1[2], x1[3]);
                    *(u32x4*)(XB + o) = xo;
                    sq += ((x0[0] * x0[0] + x0[1] * x0[1]) + (x0[2] * x0[2] + x0[3] * x0[3])) + ((x1[0] * x1[0] + x1[1] * x1[1]) + (x1[2] * x1[2] + x1[3] * x1[3]));
                    if (WRITE_H) { const f32x4 h0 = x0 * gs[bj][0], h1 = x1 * gs[bj][1];
                        u32x4 w; w.x = cvt_pk_bf16(h0[0], h0[1]); w.y = cvt_pk_bf16(h0[2], h0[3]); w.z = cvt_pk_bf16(h1[0], h1[1]); w.w = cvt_pk_bf16(h1[2], h1[3]);
                        *(u32x4*)(H + o) = w; } }
                const float t = xsum_fq(sq, fr, fq); if (fq == 0) atomicAdd(ssq + row, t);
            }
            asm volatile("" ::: "memory"); }
    }
};
template <class Epi, class Sched, bool ALIGN_EPI = false, bool SP2 = false>
__device__ __forceinline__ void gemm_phase(PG8_LAS unsigned char* lds, const Gemm g, const Sched& S, const Epi& E) {
    const int tid = opaque_tid(), wid = __builtin_amdgcn_readfirstlane(tid >> 6), lane = tid & 63, wr = wid >> 2, wc = wid & 3, fr = lane & 15, fq = lane >> 4;
    const int K = g.K, nt = K / BK;
    unsigned voffA[2], voffB[2];
#pragma unroll
    for (int i = 0; i < 2; ++i) { int R, C; stage_rc(tid * 16 + i * 8192, R, C); const int Rb = E.PERM ? ((R & ~31) + perm32(R & 31)) : R;
        voffA[i] = (unsigned)(R * g.lda + C) * 2u; voffB[i] = (unsigned)(Rb * g.ldb + C) * 2u; }
    const size_t kstep = (size_t)(BK * 2);
    const size_t hstepA = (size_t)HALF * g.lda * 2, hstepB = (size_t)HALF * g.ldb * 2;
    const size_t tstepA = 2 * hstepA, tstepB = 2 * hstepB;
    const unsigned ldsw = (unsigned)wid * 1024u;
    const int aoff = lds_byte(wr * 64 + fr, fq * 8), boff = lds_byte(wc * 32 + fr, fq * 8);
#define PG8_SA(b, h) (((b) * 2 + (h)) * HTB)
#define PG8_SB(b, h) ((4 + (b) * 2 + (h)) * HTB)
#define PG8_STAGE(bufoff, gbase, voff) do { _Pragma("unroll") for (int _i = 0; _i < 2; ++_i) \
        __builtin_amdgcn_global_load_lds((const unsigned*)((const char*)(gbase) + (voff)[_i]), (PG8_LAS unsigned*)(lds + (bufoff) + ldsw + _i * 8192), 16, 0, 0); } while (0)
#define PG8_LDA(dst, b, h) do { _Pragma("unroll") for (int m = 0; m < 4; ++m) _Pragma("unroll") for (int k = 0; k < 2; ++k) dst[m][k] = *(const PG8_LAS bf16x8*)(lds + PG8_SA(b, h) + aoff + m * 2048 + k * 1024); } while (0)
#define PG8_LDB(dst, b, h) do { _Pragma("unroll") for (int n = 0; n < 2; ++n) _Pragma("unroll") for (int k = 0; k < 2; ++k) dst[n][k] = *(const PG8_LAS bf16x8*)(lds + PG8_SB(b, h) + boff + n * 2048 + k * 1024); } while (0)
#define PG8_MMA(ai, bj, At, Bt) do { __builtin_amdgcn_s_setprio(1); _Pragma("unroll") for (int m = 0; m < 4; ++m) _Pragma("unroll") for (int n = 0; n < 2; ++n) _Pragma("unroll") for (int k = 0; k < 2; ++k) \
        acc[ai][bj][m][n] = __builtin_amdgcn_mfma_f32_16x16x32_bf16(Bt[n][k], At[m][k], acc[ai][bj][m][n], 0, 0, 0); __builtin_amdgcn_s_setprio(0); } while (0)
#define PG8_WAIT_V(n) asm volatile("s_waitcnt vmcnt(" #n ")" ::: "memory")
#define PG8_WAIT_L(n) asm volatile("s_waitcnt lgkmcnt(" #n ")" ::: "memory")
#define PG8_BAR __builtin_amdgcn_s_barrier()
#define PG8_SCHED __builtin_amdgcn_sched_barrier(0)
    Unit cur, nxt; int ui = 0;
    if (!S.next(0, cur)) return;
    f32x4 acc[2][2][4][2];
#pragma unroll
    for (int a = 0; a < 2; ++a)
#pragma unroll
        for (int b = 0; b < 2; ++b)
#pragma unroll
            for (int m = 0; m < 4; ++m)
#pragma unroll
                for (int n = 0; n < 2; ++n) acc[a][b][m][n] = (f32x4){0.f, 0.f, 0.f, 0.f};
    bf16x8 At[4][2], B0[2][2], B1[2][2];
    const char* cA = (const char*)g.A + (size_t)cur.pm * tstepA; const char* cB = (const char*)g.Bt + (size_t)cur.pn * tstepB;
    S.a_ready(cur);
    if constexpr (SP2) {
        PG8_STAGE(PG8_SB(0, 0), cB, voffB); PG8_STAGE(PG8_SB(0, 1), cB + hstepB, voffB); PG8_STAGE(PG8_SA(0, 0), cA, voffA); PG8_STAGE(PG8_SA(0, 1), cA + hstepA, voffA);
        if (wr == 1) PG8_BAR;
        PG8_WAIT_V(2); PG8_BAR;
        PG8_STAGE(PG8_SB(1, 0), cB + kstep, voffB); PG8_STAGE(PG8_SA(1, 0), cA + kstep, voffA); PG8_STAGE(PG8_SB(1, 1), cB + hstepB + kstep, voffB);
        PG8_WAIT_V(6); PG8_BAR;
    } else {
        PG8_STAGE(PG8_SB(0, 0), cB, voffB); PG8_STAGE(PG8_SA(0, 0), cA, voffA); PG8_STAGE(PG8_SB(0, 1), cB + hstepB, voffB); PG8_STAGE(PG8_SA(0, 1), cA + hstepA, voffA);
        if (wr == 1) PG8_BAR;
        PG8_WAIT_V(4); PG8_BAR;
        PG8_STAGE(PG8_SB(1, 0), cB + kstep, voffB); PG8_STAGE(PG8_SA(1, 0), cA + kstep, voffA); PG8_STAGE(PG8_SB(1, 1), cB + hstepB + kstep, voffB);
        PG8_WAIT_V(6); PG8_BAR;
    }
    for (;;) {
        const bool has_next = S.next(ui + 1, nxt);
        const char* nA = has_next ? (const char*)g.A + (size_t)nxt.pm * tstepA : cA; const char* nB = has_next ? (const char*)g.Bt + (size_t)nxt.pn * tstepB : cB;
        for (int t = 0; t < nt; t += 2) {
            const bool last = (t == nt - 2);
            const char* a1 = cA + (size_t)(t + 1) * kstep;
            const char* a2 = last ? nA : cA + (size_t)(t + 2) * kstep; const char* b2 = last ? nB : cB + (size_t)(t + 2) * kstep;
            const char* a3 = a2 + kstep; const char* b3 = b2 + kstep;
            if (last && has_next) S.a_ready(nxt);
            if constexpr (SP2) {
            PG8_LDB(B0, 0, 0); PG8_LDB(B1, 0, 1); PG8_SCHED; PG8_LDA(At, 0, 0); PG8_STAGE(PG8_SA(1, 1), a1 + hstepA, voffA);
            PG8_WAIT_V(8); PG8_WAIT_L(0); PG8_BAR; PG8_MMA(0, 0, At, B0); PG8_MMA(0, 1, At, B1); PG8_BAR; PG8_SCHED;
            PG8_LDA(At, 0, 1); PG8_STAGE(PG8_SB(0, 0), b2, voffB); PG8_STAGE(PG8_SB(0, 1), b2 + hstepB, voffB); PG8_STAGE(PG8_SA(0, 0), a2, voffA);
            PG8_WAIT_V(8); PG8_WAIT_L(0); PG8_BAR; PG8_MMA(1, 0, At, B0); PG8_MMA(1, 1, At, B1); PG8_BAR; PG8_SCHED;
            PG8_LDB(B0, 1, 0); PG8_LDB(B1, 1, 1); PG8_SCHED; PG8_LDA(At, 1, 0); PG8_STAGE(PG8_SA(0, 1), a2 + hstepA, voffA);
            PG8_WAIT_V(8); PG8_WAIT_L(0); PG8_BAR; PG8_MMA(0, 0, At, B0); PG8_MMA(0, 1, At, B1); PG8_BAR; PG8_SCHED;
            PG8_LDA(At, 1, 1); PG8_STAGE(PG8_SB(1, 0), b3, voffB); PG8_STAGE(PG8_SB(1, 1), b3 + hstepB, voffB); PG8_STAGE(PG8_SA(1, 0), a3, voffA);
            PG8_WAIT_V(8); PG8_WAIT_L(0); PG8_BAR; PG8_MMA(1, 0, At, B0); PG8_MMA(1, 1, At, B1); PG8_BAR; PG8_SCHED;
            } else {
            PG8_LDB(B0, 0, 0); PG8_SCHED; PG8_LDA(At, 0, 0); PG8_STAGE(PG8_SA(1, 1), a1 + hstepA, voffA);
            PG8_WAIT_L(8); PG8_BAR; PG8_WAIT_L(0); PG8_MMA(0, 0, At, B0); PG8_BAR; PG8_SCHED;
            PG8_LDB(B1, 0, 1); PG8_STAGE(PG8_SB(0, 0), b2, voffB);
            PG8_BAR; PG8_WAIT_L(0); PG8_MMA(0, 1, At, B1); PG8_BAR;
            PG8_LDA(At, 0, 1); PG8_STAGE(PG8_SA(0, 0), a2, voffA);
            PG8_BAR; PG8_WAIT_L(0); PG8_MMA(1, 0, At, B0); PG8_BAR; PG8_SCHED;
            PG8_STAGE(PG8_SB(0, 1), b2 + hstepB, voffB);
            PG8_WAIT_V(6); PG8_BAR; PG8_MMA(1, 1, At, B1); PG8_BAR;
            PG8_LDB(B0, 1, 0); PG8_SCHED; PG8_LDA(At, 1, 0); PG8_STAGE(PG8_SA(0, 1), a2 + hstepA, voffA);
            PG8_WAIT_L(8); PG8_BAR; PG8_WAIT_L(0); PG8_MMA(0, 0, At, B0); PG8_BAR; PG8_SCHED;
            PG8_LDB(B1, 1, 1); PG8_STAGE(PG8_SB(1, 0), b3, voffB);
            PG8_BAR; PG8_WAIT_L(0); PG8_MMA(0, 1, At, B1); PG8_BAR;
            PG8_LDA(At, 1, 1); PG8_STAGE(PG8_SA(1, 0), a3, voffA);
            PG8_BAR; PG8_WAIT_L(0); PG8_MMA(1, 0, At, B0); PG8_BAR; PG8_SCHED;
            PG8_STAGE(PG8_SB(1, 1), b3 + hstepB, voffB);
            PG8_WAIT_V(6); PG8_BAR; PG8_MMA(1, 1, At, B1); PG8_BAR;
            }
        }
        if constexpr (ALIGN_EPI) { if (wr == 0) PG8_BAR; }
        if constexpr (!Epi::AFTER_DRAIN) { int fr2 = fr, fq2 = fq; asm volatile("" : "+v"(fr2), "+v"(fq2)); E(acc, cur, wr, wc, fr2, fq2); S.done(cur); }
        if (!has_next) break;
#pragma unroll
        for (int a = 0; a < 2; ++a)
#pragma unroll
            for (int b = 0; b < 2; ++b)
#pragma unroll
                for (int m = 0; m < 4; ++m)
#pragma unroll
                    for (int n = 0; n < 2; ++n) acc[a][b][m][n] = (f32x4){0.f, 0.f, 0.f, 0.f};
        cur = nxt; cA = nA; cB = nB; ++ui;
        if constexpr (ALIGN_EPI) { if (wr == 1) PG8_BAR; }
    }
    PG8_WAIT_V(0);
    if constexpr (!ALIGN_EPI) { if (wr == 0) PG8_BAR; }
    PG8_BAR;
    if constexpr (Epi::AFTER_DRAIN) { E.fused(acc, cur, wr, wc, fr, fq, lds, wid, lane); S.done(cur); }
#undef PG8_SA
#undef PG8_SB
#undef PG8_STAGE
#undef PG8_LDA
#undef PG8_LDB
#undef PG8_MMA
#undef PG8_WAIT_V
#undef PG8_WAIT_L
#undef PG8_BAR
#undef PG8_SCHED
}
}

#define LAS __attribute__((address_space(3)))
typedef unsigned short bf16;
typedef float f32x4 __attribute__((ext_vector_type(4)));
typedef unsigned u32x4 __attribute__((ext_vector_type(4)));
typedef unsigned u32x2 __attribute__((ext_vector_type(2)));
constexpr int DM = 1024, NCTX = 8192, MTOK = 12288, DINP = 2560, DFF = 4096;
constexpr int R_OFF = 0, K_OFF = 512, V_OFF = 1024, WD_OFF = 1536, AD_OFF = 1664, GD_OFF = 1792, F_OFF = 1920, P_OFF = 2176, DIN = 2432;
constexpr size_t MiB = 1u << 20;
constexpr size_t WS_CTL = 0, WS_MOD = 1 * MiB, WS_FW = 1 * MiB + 512 * 1024, WS_BC = 2 * MiB, WS_CS256 = 3 * MiB, WS_CS1024 = 4 * MiB, WS_WIN = 8 * MiB, WS_WOUT = 18 * MiB,
                 WS_W1 = 22 * MiB, WS_W2 = 38 * MiB, WS_H = 54 * MiB, WS_MIXED = 78 * MiB, WS_PROJ = 102 * MiB, WS_YCS = 162 * MiB, WS_YF = 102 * MiB, WS_YB = 126 * MiB  , WS_U = 174 * MiB, WS_KINV = 220 * MiB, WS_GUPT = 221 * MiB,
                 WS_FF = 102 * MiB, WS_WUPT = 222 * MiB, WS_AUPT = 222 * MiB + 256 * 1024, WS_SSQ = 223 * MiB, WS_WPT = 223 * MiB + 512 * 1024, WS_SW1 = 224 * MiB, WS_SWIN = 224 * MiB + 256 * 1024, WS_XB = 226 * MiB, WS_END = 250 * MiB;
constexpr int LDS_BYTES = 147456, RING_BYTES = 131072, MISC_OFF = RING_BYTES + 320;
constexpr int NTHR = 512;
enum { I_XP = 0, I_XS, I_STATE, I_C, I_CCTX, I_WADA, I_BADA, I_N1G, I_WIN, I_MU, I_W0, I_WUP, I_A0, I_AUP, I_GUP, I_KK, I_KA, I_RK, I_LNW, I_LNB, I_WFNET, I_WPOOL, I_PSCALE, I_WOUT, I_N2G, I_WFF1, I_WFF2, I_FNG, N_IN };
struct KP { const float* in[N_IN]; float* out; unsigned char* ws; int ph_lo, ph_hi; };
typedef const __attribute__((address_space(4))) KP CKP;

__device__ __forceinline__ unsigned f2bf(float f) { unsigned u = __builtin_bit_cast(unsigned, f); return (u + 0x7fffu + ((u >> 16) & 1u)) >> 16; }
__device__ __forceinline__ unsigned pk2(float lo, float hi) { return f2bf(lo) | (f2bf(hi) << 16); }
__device__ __forceinline__ float bflo(unsigned w) { return __builtin_bit_cast(float, w << 16); }
__device__ __forceinline__ float bfhi(unsigned w) { return __builtin_bit_cast(float, w & 0xffff0000u); }
__device__ __forceinline__ float bf1(bf16 h) { return __builtin_bit_cast(float, (unsigned)h << 16); }
__device__ __forceinline__ float fexp(float x) { return __builtin_amdgcn_exp2f(x * 1.4426950408889634f); }
__device__ __forceinline__ float flog(float x) { return __builtin_amdgcn_logf(x) * 0.6931471805599453f; }
__device__ __forceinline__ float frcp(float x) { return __builtin_amdgcn_rcpf(x); }
__device__ __forceinline__ float frsq(float x) { return __builtin_amdgcn_rsqf(x); }
__device__ __forceinline__ float fsigmoid(float x) { return frcp(1.0f + fexp(-x)); }
template <int CTRL> __device__ __forceinline__ float dppf(float x) { return __builtin_bit_cast(float, __builtin_amdgcn_update_dpp(0, __builtin_bit_cast(int, x), CTRL, 0xF, 0xF, true)); }
__device__ __forceinline__ float red8(float x)  { x += dppf<0xB1>(x); x += dppf<0x4E>(x); x += dppf<0x141>(x); return x; }
__device__ __forceinline__ float red16(float x) { x += dppf<0xB1>(x); x += dppf<0x4E>(x); x += dppf<0x141>(x); x += dppf<0x140>(x); return x; }
__device__ __forceinline__ float wave_sum(float v) {
    v = red16(v);
    const float s0 = __builtin_bit_cast(float, __builtin_amdgcn_readlane(__builtin_bit_cast(int, v), 0)), s1 = __builtin_bit_cast(float, __builtin_amdgcn_readlane(__builtin_bit_cast(int, v), 16));
    const float s2 = __builtin_bit_cast(float, __builtin_amdgcn_readlane(__builtin_bit_cast(int, v), 32)), s3 = __builtin_bit_cast(float, __builtin_amdgcn_readlane(__builtin_bit_cast(int, v), 48));
    return (s0 + s1) + (s2 + s3);
}
__device__ __forceinline__ void load4bf(const bf16* p, float (&o)[4]) { const u32x2 w = *(const u32x2*)p; o[0] = bflo(w.x); o[1] = bfhi(w.x); o[2] = bflo(w.y); o[3] = bfhi(w.y); }
__device__ __forceinline__ void load8bf(const bf16* p, float (&o)[8]) { const u32x4 w = *(const u32x4*)p; o[0] = bflo(w.x); o[1] = bfhi(w.x); o[2] = bflo(w.y); o[3] = bfhi(w.y); o[4] = bflo(w.z); o[5] = bfhi(w.z); o[6] = bflo(w.w); o[7] = bfhi(w.w); }
__device__ __forceinline__ void shift4(const bf16* proj, int row, bool hasp, bool hasn, int col, const float* mu, float (&u)[4]) {
    float p[4], a[4] = {0.f, 0.f, 0.f, 0.f}, b[4] = {0.f, 0.f, 0.f, 0.f};
    load4bf(proj + (size_t)row * DINP + col, p);
    if (hasp) load4bf(proj + (size_t)(row - 1) * DINP + col, a);
    if (hasn) load4bf(proj + (size_t)(row + 1) * DINP + col, b);
    const f32x4 m = *(const f32x4*)(mu + col);
#pragma unroll
    for (int j = 0; j < 4; ++j) u[j] = p[j] + m[j] * (0.5f * (a[j] + b[j]) - p[j]);
}

__device__ __forceinline__ void transpose_item(const float* W, int K, int N, bf16* WT, LAS float* scr, int item, int lane) {
    const int nblk = N / 32, kb = item / nblk, nb = item % nblk, k0 = 64 * kb, n0 = 32 * nb;
#pragma unroll 8
    for (int i = 0; i < 32; ++i) { const int kk = 2 * i + (lane >> 5); scr[kk * 33 + (lane & 31)] = W[(size_t)(k0 + kk) * N + n0 + (lane & 31)]; }
    asm volatile("s_waitcnt lgkmcnt(0)" ::: "memory");
    const int c = lane & 7;
#pragma unroll
    for (int j = 0; j < 4; ++j) { const int n = (lane >> 3) + 8 * j; const LAS float* s = scr + (8 * c) * 33 + n;
        u32x4 o; o.x = pk2(s[0 * 33], s[1 * 33]); o.y = pk2(s[2 * 33], s[3 * 33]); o.z = pk2(s[4 * 33], s[5 * 33]); o.w = pk2(s[6 * 33], s[7 * 33]);
        *(u32x4*)(WT + (size_t)(n0 + n) * K + k0 + 8 * c) = o; }
    asm volatile("s_waitcnt lgkmcnt(0)" ::: "memory");
}
__device__ __forceinline__ void gemv5_cols(LAS float* sc, LAS float* red, const float* W, int ldw, int colw, const float* bias, float* out, int ldo, int colo, int tid) {
    const int cgi = tid & 15, kg = tid >> 4;
    f32x4 acc[5];
#pragma unroll
    for (int c = 0; c < 5; ++c) acc[c] = (f32x4){0.f, 0.f, 0.f, 0.f};
    const float* wp = W + (size_t)(kg * 32) * ldw + colw + cgi * 4;
#pragma unroll 8
    for (int kk = 0; kk < 32; ++kk) { const f32x4 w = *(const f32x4*)(wp + (size_t)kk * ldw);
#pragma unroll
        for (int c = 0; c < 5; ++c) acc[c] += sc[c * 1024 + kg * 32 + kk] * w; }
#pragma unroll
    for (int c = 0; c < 5; ++c) *(LAS f32x4*)(red + (kg * 5 + c) * 64 + cgi * 4) = acc[c];
    __syncthreads();
    if (tid < 320) { const int cond = tid >> 6, col = tid & 63; float sm = bias ? bias[colo + col] : 0.f;
        for (int g = 0; g < 32; ++g) sm += red[(g * 5 + cond) * 64 + col];
        out[(size_t)cond * ldo + colo + col] = sm; }
    __syncthreads();
}
__device__ __forceinline__ void mod_item(CKP& p, LAS unsigned char* lds, int it) {
    const int tid = opaque_tid(); unsigned char* ws = p.ws;
    LAS float* sc = (LAS float*)lds; LAS float* red = (LAS float*)(lds + 20480);
    const int l = it / 96, cgp = it % 96;
    for (int i = tid; i < 5 * 1024; i += NTHR) { const int cond = i >> 10, k = i & 1023; const float v = cond == 0 ? p.in[I_CCTX][k] : p.in[I_C][(cond - 1) * 1024 + k]; sc[i] = v * fsigmoid(v); }
    __syncthreads();
    gemv5_cols(sc, red, p.in[I_WADA] + (size_t)l * 1024 * 6144, 6144, cgp * 64, p.in[I_BADA] + l * 6144, (float*)(ws + WS_MOD) + (size_t)l * 5 * 6144, 6144, cgp * 64, tid);
}
constexpr int TI_IN = 16 * 76, TI_OUT = 16 * 32, TI_1 = 16 * 128, TI_2 = 64 * 32, TI_L = TI_IN + TI_OUT + TI_1 + TI_2;
__device__ __forceinline__ void transpose_range(CKP& p, LAS unsigned char* lds, int first, int last, int bid, int nb) {
    const int tid = opaque_tid(), lane = tid & 63, wave = tid >> 6;
    unsigned char* ws = p.ws;
    LAS float* scr = (LAS float*)(lds + wave * 16384);
#pragma unroll 1
    for (int it = first + bid * 8 + wave; it < last; it += nb * 8) {
        const int l = it / TI_L; int r = it % TI_L;
        if (r < TI_IN) { transpose_item(p.in[I_WIN] + (size_t)l * DM * DIN, DM, DIN, (bf16*)(ws + WS_WIN) + (size_t)l * DINP * DM, scr, r, lane); continue; } r -= TI_IN;
        if (r < TI_OUT) { transpose_item(p.in[I_WOUT] + (size_t)l * DM * DM, DM, DM, (bf16*)(ws + WS_WOUT) + (size_t)l * DM * DM, scr, r, lane); continue; } r -= TI_OUT;
        if (r < TI_1) { transpose_item(p.in[I_WFF1] + (size_t)l * DM * DFF, DM, DFF, (bf16*)(ws + WS_W1) + (size_t)l * DFF * DM, scr, r, lane); continue; } r -= TI_1;
        transpose_item(p.in[I_WFF2] + (size_t)l * DFF * DM, DFF, DM, (bf16*)(ws + WS_W2) + (size_t)l * DM * DFF, scr, r, lane);
    }
}
__device__ __forceinline__ void stage_prologue(CKP& p, LAS unsigned char* lds, int bid, int nb) {
    const int tid = opaque_tid();
    unsigned char* ws = p.ws;
    transpose_range(p, lds, 0, TI_IN, bid, nb);
    const int gt = bid * NTHR + tid, NGT = nb * NTHR;
#pragma unroll 1
    for (int i = gt; i < 2 * 128 * DM / 8; i += NGT) { const int l = i / (128 * DM / 8), r = i % (128 * DM / 8);
        u32x4 z = (u32x4){0u, 0u, 0u, 0u}; asm volatile("" : "+v"(z));
        *(u32x4*)((bf16*)(ws + WS_WIN) + (size_t)l * DINP * DM + (size_t)DIN * DM + (size_t)r * 8) = z; }
    __syncthreads();
#pragma unroll 1
    for (int it = bid; it < 192; it += nb) mod_item(p, lds, it);
}
__device__ __forceinline__ void stage_tables(CKP& p, int bid, int nb) {
    const int tid = opaque_tid(); unsigned char* ws = p.ws;
    const int gt = bid * NTHR + tid, NGT = nb * NTHR;
#pragma unroll 1
    for (int i = gt; i < 256 * 512 + 1024 * 2048; i += NGT) {
        int L, k, j; bf16* dst;
        if (i < 256 * 512) { L = 256; k = i / 512; j = i % 512; dst = (bf16*)(ws + WS_CS256) + i; }
        else { const int i2 = i - 256 * 512; L = 1024; k = i2 / 2048; j = i2 % 2048; dst = (bf16*)(ws + WS_CS1024) + i2; }
        const int jj = j >= L ? j - L : j; const int idx = (k * jj) & (L - 1);
        const float rev = (float)idx * (L == 256 ? (1.0f / 256.0f) : (1.0f / 1024.0f));
        *dst = (bf16)f2bf(j >= L ? -__builtin_amdgcn_sinf(rev) : __builtin_amdgcn_cosf(rev));
    }
#pragma unroll 1
    for (int i = gt; i < 2 * 4 * 64 * 128; i += NGT) {
        const int o = i & 127, c = (i >> 7) & 63, lg = i >> 13; const float* wf = p.in[I_WFNET] + (size_t)lg * 4096 + (o & 63);
        float acc = 0.f;
        if (o < 64) { for (int cp = 0; cp < 64; ++cp) acc += __builtin_amdgcn_cosf((float)((c * cp) & 63) * (1.0f / 64.0f)) * wf[cp * 64]; }
        else { for (int cp = 0; cp < 64; ++cp) acc += __builtin_amdgcn_sinf((float)((c * cp) & 63) * (1.0f / 64.0f)) * wf[cp * 64]; }
        ((bf16*)(ws + WS_FW))[(size_t)(lg * 128 + o) * 64 + c] = (bf16)f2bf(acc);
    }
#pragma unroll 1
    for (int i = gt; i < 2 * 4 * 64 * 64; i += NGT) { const int o = i & 63, c = (i >> 6) & 63, lg = i >> 12;
        ((bf16*)(ws + WS_WPT))[(size_t)(lg * 64 + o) * 64 + c] = (bf16)f2bf(p.in[I_WPOOL][i]); }
#pragma unroll 1
    for (int i = gt; i < 2 * 2 * 64 * 512; i += NGT) { const int c = i & 511, r = (i >> 9) & 63, ld = i >> 15;
        ((bf16*)(ws + WS_WUPT))[(size_t)(ld * 512 + c) * 64 + r] = (bf16)f2bf(p.in[I_WUP][i]);
        ((bf16*)(ws + WS_AUPT))[(size_t)(ld * 512 + c) * 64 + r] = (bf16)f2bf(p.in[I_AUP][i]); }
#pragma unroll 1
    for (int i = gt; i < 2 * 128 * 512; i += NGT) { const int c = i & 511, r = (i >> 9) & 127, ll = i >> 16;
        ((bf16*)(ws + WS_GUPT))[(size_t)(ll * 512 + c) * 128 + r] = (bf16)f2bf(p.in[I_GUP][i]); }
}
__device__ __forceinline__ void shiftw_item(CKP& p, LAS unsigned char* lds, int it) {
    const int tid = opaque_tid();
    unsigned char* ws = p.ws;
    LAS float* sc = (LAS float*)lds; LAS float* red = (LAS float*)(lds + 20480);
    const bool isin = it >= 128; const int l = isin ? 1 : it >> 6, blk = isin ? it - 128 : it & 63;
    const float* shv = (const float*)(ws + WS_MOD) + (size_t)l * 5 * 6144 + (isin ? 0 : 3 * 1024);
    for (int i = tid; i < 5 * 1024; i += NTHR) sc[i] = shv[(i >> 10) * 6144 + (i & 1023)];
    __syncthreads();
    if (isin) gemv5_cols(sc, red, p.in[I_WIN] + (size_t)DM * DIN, DIN, blk * 64, nullptr, (float*)(ws + WS_SWIN), DINP, blk * 64, tid);
    else gemv5_cols(sc, red, p.in[I_WFF1] + (size_t)l * DM * DFF, DFF, blk * 64, nullptr, (float*)(ws + WS_SW1) + (size_t)l * 5 * DFF, DFF, blk * 64, tid);
    if (it == 165) for (int i = tid; i < 5 * 128; i += NTHR) ((float*)(ws + WS_SWIN))[(i >> 7) * DINP + DIN + (i & 127)] = 0.f;
}
__device__ __forceinline__ void side_queue(CKP& p, int l, LAS unsigned char* lds) {
    const int tid = opaque_tid();
    unsigned* ctr = (unsigned*)(p.ws + WS_CTL + 524288) + 64 * l;
    volatile LAS unsigned* slot = (volatile LAS unsigned*)(lds + RING_BYTES + 64);
    const int nmd = 0, nsh = l == 0 ? 166 : 0, first = l == 0 ? TI_IN : TI_L + TI_IN, nch = ((l == 0 ? TI_L + TI_IN : 2 * TI_L) - first) / 8;
    __syncthreads();
#pragma unroll 1
    for (;;) {
        if (tid == 0) *slot = atomicAdd(ctr, 1u);
        __syncthreads();
        const int it = (int)*slot;
        __syncthreads();
        if (it >= nmd + nsh + nch) break;
        if (it < nmd) mod_item(p, lds, 96 + it);
        else if (it < nmd + nsh) shiftw_item(p, lds, it - nmd);
        else { const int c0 = first + 8 * (it - nmd - nsh); transpose_range(p, lds, c0, c0 + 8, 0, 1); }
        __syncthreads();
    }
}

__device__ __forceinline__ void stage_norm(CKP& p, int l, int which, int bid, int nb) {
    const int tid = opaque_tid(), lane = tid & 63, wave = tid >> 6;
    const float* g = p.in[which ? I_N2G : I_N1G] + l * DM;
    const float* mod = (const float*)(p.ws + WS_MOD) + (size_t)l * 5 * 6144 + (which ? 3 * 1024 : 0);
    bf16* H = (bf16*)(p.ws + WS_H);
#pragma unroll 1
    for (int row0 = bid * 8 + wave; row0 < MTOK; row0 += nb * 16) {
        f32x4 v[2][4]; float s[2];
#pragma unroll
        for (int z = 0; z < 2; ++z) { const int row = min(row0 + z * nb * 8, MTOK - 1);
            const float* xsrc = (l == 0 && which == 0) ? (row < NCTX ? p.in[I_XP] + (size_t)row * DM : p.in[I_XS] + (size_t)(row - NCTX) * DM) : p.out + (size_t)row * DM;
            const f32x4* xr = (const f32x4*)xsrc + lane;
#pragma unroll
            for (int j = 0; j < 4; ++j) v[z][j] = xr[64 * j]; }
#pragma unroll
        for (int z = 0; z < 2; ++z) { const int row = row0 + z * nb * 8;
            s[z] = 0.f;
#pragma unroll
            for (int j = 0; j < 4; ++j) s[z] += (v[z][j].x * v[z][j].x + v[z][j].y * v[z][j].y) + (v[z][j].z * v[z][j].z + v[z][j].w * v[z][j].w);
            const float rstd = frsq(wave_sum(s[z]) * (1.0f / DM) + 1e-6f);
            if (row < MTOK) {
                const int cond = row < NCTX ? 0 : 1 + ((row - NCTX) >> 10);
                const float* sh = mod + cond * 6144; const float* scl = sh + 1024;
                unsigned long long* o8 = (unsigned long long*)(H + (size_t)row * DM) + lane;
#pragma unroll
                for (int j = 0; j < 4; ++j) { const int col = 4 * lane + 256 * j; const f32x4 gg = *(const f32x4*)(g + col), a = *(const f32x4*)(sh + col), b = *(const f32x4*)(scl + col);
                    const f32x4 y = v[z][j] * rstd * gg * (b + 1.0f) + a;
                    o8[64 * j] = (unsigned long long)pk2(y.x, y.y) | ((unsigned long long)pk2(y.z, y.w) << 32); } } }
    }
}
__device__ __forceinline__ void stage_final(CKP& p, int bid, int nb) {
    const int tid = opaque_tid(), lane = tid & 63, wave = tid >> 6;
    const float* g = p.in[I_FNG];
    const bf16* XB = (const bf16*)(p.ws + WS_XB); const float* ssq = (const float*)(p.ws + WS_CTL + 262144) + 49152;
    const f32x4 g0 = *(const f32x4*)(g + 8 * lane), g1 = *(const f32x4*)(g + 8 * lane + 4), g2 = *(const f32x4*)(g + 512 + 8 * lane), g3 = *(const f32x4*)(g + 512 + 8 * lane + 4);
#pragma unroll 1
    for (int row = bid * 8 + wave; row < MTOK; row += nb * 8) {
        const float rstd = frsq(ssq[row] * (1.0f / DM) + 1e-6f);
        const u32x4 a = *(const u32x4*)(XB + (size_t)row * DM + 8 * lane), b = *(const u32x4*)(XB + (size_t)row * DM + 512 + 8 * lane);
        float* o = p.out + (size_t)row * DM + 8 * lane;
        *(f32x4*)o = (f32x4){bflo(a.x), bfhi(a.x), bflo(a.y), bfhi(a.y)} * rstd * g0; *(f32x4*)(o + 4) = (f32x4){bflo(a.z), bfhi(a.z), bflo(a.w), bfhi(a.w)} * rstd * g1;
        *(f32x4*)(o + 512) = (f32x4){bflo(b.x), bfhi(b.x), bflo(b.y), bfhi(b.y)} * rstd * g2; *(f32x4*)(o + 516) = (f32x4){bflo(b.z), bfhi(b.z), bflo(b.w), bfhi(b.w)} * rstd * g3;
    }
}


typedef short bf16x8 __attribute__((ext_vector_type(8)));
typedef float f32x2v __attribute__((ext_vector_type(2)));
typedef __bf16 bf16x2v __attribute__((ext_vector_type(2)));
#define MFMA16(a, b, c) __builtin_amdgcn_mfma_f32_16x16x32_bf16((a), (b), (c), 0, 0, 0)
__device__ __forceinline__ unsigned cvt2(float lo, float hi) { f32x2v v = {lo, hi}; bf16x2v b = __builtin_convertvector(v, bf16x2v); return __builtin_bit_cast(unsigned, b); }
__device__ __forceinline__ u32x4 pack8(const float (&x)[8]) { u32x4 w; w.x = cvt2(x[0], x[1]); w.y = cvt2(x[2], x[3]); w.z = cvt2(x[4], x[5]); w.w = cvt2(x[6], x[7]); return w; }
__device__ __forceinline__ void shift8(const bf16* proj, int row, bool hasp, bool hasn, int col, const float* mu, float (&u)[8]) {
    float p[8], a[8], b[8];
    load8bf(proj + (size_t)row * DINP + col, p);
    if (hasp) load8bf(proj + (size_t)(row - 1) * DINP + col, a); else {
#pragma unroll
        for (int j = 0; j < 8; ++j) a[j] = 0.f; }
    if (hasn) load8bf(proj + (size_t)(row + 1) * DINP + col, b); else {
#pragma unroll
        for (int j = 0; j < 8; ++j) b[j] = 0.f; }
    const f32x4 m0 = *(const f32x4*)(mu + col), m1 = *(const f32x4*)(mu + col + 4);
#pragma unroll
    for (int j = 0; j < 4; ++j) { u[j] = p[j] + m0[j] * (0.5f * (a[j] + b[j]) - p[j]); u[4 + j] = p[4 + j] + m1[j] * (0.5f * (a[4 + j] + b[4 + j]) - p[4 + j]); }
}
__device__ __forceinline__ int opq(int x) { asm volatile("" : "+v"(x)); return x; }
constexpr int TS = 72, TB = 64 * TS * 2;
constexpr int L_HT = 0, L_TW = 9216, L_AD = 18432, L_LP = 27648, L_AP = 45056, L_AT = 62464, L_RT = L_AT + TB, L_BH = L_RT + TB, L_KH = L_BH + TB, L_VR = L_KH + TB, L_YS = L_VR + TB;
constexpr int L_AAB = L_TW, L_AAK = L_AAB + 4096, L_ARB = L_AAK + 3072, L_ARK = L_ARB + 3072, L_UT = L_ARK + 3072, L_W1 = L_AP;
static_assert(L_UT + 64 * 24 * 2 <= L_LP && L_YS + 17408 <= RING_BYTES, "scan LDS map");
constexpr int LPS = 68;
#define LBAR() asm volatile("s_waitcnt lgkmcnt(0)\n\ts_barrier" ::: "memory")
typedef short s16x4v __attribute__((ext_vector_type(4)));
__device__ __forceinline__ bf16x8 tr8(const LAS bf16* p) {
    const s16x4v lo = __builtin_bit_cast(s16x4v, __builtin_amdgcn_ds_read_tr16_b64_v4i16((LAS s16x4v*)p));
    const s16x4v hi = __builtin_bit_cast(s16x4v, __builtin_amdgcn_ds_read_tr16_b64_v4i16((LAS s16x4v*)(p + 4 * TS)));
    return (bf16x8){lo[0], lo[1], lo[2], lo[3], hi[0], hi[1], hi[2], hi[3]};
}

__device__ __forceinline__ void rwkv_item3(CKP& p, int l, LAS unsigned char* lds, int item) {
    const int tid0 = opaque_tid(), w = __builtin_amdgcn_readfirstlane(tid0 >> 6);
    int tid = tid0, fr = tid & 15, fg = (tid & 63) >> 4;
    int bseq, h, dir, L, base; bool lat;
    if (item < 64) { lat = true; bseq = item >> 4; h = (item >> 1) & 7; dir = item & 1; L = 1024; base = NCTX + bseq * 1024; }
    else { const int i2 = item - 64; lat = false; bseq = i2 >> 4; h = (i2 >> 1) & 7; dir = i2 & 1; L = 256; base = bseq * 256; }
    const bf16* U = (const bf16*)(p.ws + WS_U);
    const float* KINV = (const float*)(p.ws + WS_KINV);
    bf16* Yout = (bf16*)(p.ws + (dir ? WS_YB : WS_YF));
    float* BC = (float*)(p.ws + WS_BC) + (size_t)dir * MTOK * 8;
    const bf16* wupt = (const bf16*)(p.ws + WS_WUPT) + ((size_t)(l * 2 + dir) * 512 + h * 64) * 64;
    const bf16* aupt = (const bf16*)(p.ws + WS_AUPT) + ((size_t)(l * 2 + dir) * 512 + h * 64) * 64;

    LAS float* LP = (LAS float*)(lds + L_LP); LAS float* AP = (LAS float*)(lds + L_AP); LAS float* AS = (LAS float*)(lds + L_TW);
    LAS bf16* AT = (LAS bf16*)(lds + L_AT);   LAS bf16* RT = (LAS bf16*)(lds + L_RT);   LAS bf16* BH = (LAS bf16*)(lds + L_BH);   LAS bf16* KH = (LAS bf16*)(lds + L_KH);
    LAS bf16* VR = (LAS bf16*)(lds + L_VR);   LAS float* YS = (LAS float*)(lds + L_YS);
    LAS float* AAB = (LAS float*)(lds + L_AAB); LAS bf16* AAK = (LAS bf16*)(lds + L_AAK); LAS bf16* ARB = (LAS bf16*)(lds + L_ARB); LAS bf16* ARK = (LAS bf16*)(lds + L_ARK);
    LAS float* W1 = (LAS float*)(lds + L_W1);
    const int tv = w & 3;
    f32x4 hacc[4];
#pragma unroll
    for (int x = 0; x < 4; ++x) {
        if (lat && w < 4) hacc[x] = *(const f32x4*)(p.in[I_STATE] + ((((size_t)bseq * 2 + l) * 2 + dir) * 8 + h) * 4096 + (16 * tv + fr) * 64 + 16 * x + 4 * fg);
        else hacc[x] = (f32x4){0.f, 0.f, 0.f, 0.f}; }
    int ei = tid >> 3, ec8 = (tid & 7) * 8; const int hc8 = h * 64 + ec8;
    float kkp[8], kap[8], rkp[8];
#pragma unroll
    for (int e = 0; e < 8; ++e) { kkp[e] = p.in[I_KK][l * 512 + hc8 + e]; kap[e] = p.in[I_KA][l * 512 + hc8 + e]; rkp[e] = p.in[I_RK][l * 512 + hc8 + e]; }
#define SCAN_PREFETCH(SC) do { const int _t0 = opq(tid0), _ei = _t0 >> 3, _ec8 = (_t0 & 7) * 8; const int _step = (SC) * 64 + _ei, _t = dir ? L - 1 - _step : _step; \
        const bf16* _u = U + (size_t)(base + _t) * 1920; \
        nr = *(const u32x4*)(_u + R_OFF + h * 64 + _ec8); nk = *(const u32x4*)(_u + K_OFF + h * 64 + _ec8); nv = *(const u32x4*)(_u + V_OFF + h * 64 + _ec8); \
        ninv = KINV[(size_t)(base + _t) * 8 + h]; \
        const int _st2 = (SC) * 64 + 16 * (w >> 1) + (_t0 & 15), _t2 = dir ? L - 1 - _st2 : _st2; const bf16* _u2 = U + (size_t)(base + _t2) * 1920 + dir * 64 + ((_t0 & 63) >> 4) * 8; \
        paw0 = *(const bf16x8*)(_u2 + WD_OFF); paw1 = *(const bf16x8*)(_u2 + WD_OFF + 32); paa0 = *(const bf16x8*)(_u2 + AD_OFF); paa1 = *(const bf16x8*)(_u2 + AD_OFF + 32); } while (0)
    bf16x8 lbw[2][2], lba[2][2]; float lw0c[2], la0c[2];
#pragma unroll
    for (int x = 0; x < 2; ++x) { const int c = ((w & 1) * 2 + x) * 16 + fr;
        lbw[x][0] = *(const bf16x8*)(wupt + c * 64 + fg * 8); lbw[x][1] = *(const bf16x8*)(wupt + c * 64 + 32 + fg * 8);
        lba[x][0] = *(const bf16x8*)(aupt + c * 64 + fg * 8); lba[x][1] = *(const bf16x8*)(aupt + c * 64 + 32 + fg * 8);
        lw0c[x] = p.in[I_W0][(l * 2 + dir) * 512 + h * 64 + c]; la0c[x] = p.in[I_A0][(l * 2 + dir) * 512 + h * 64 + c]; }
    u32x4 nr, nk, nv; float ninv; bf16x8 paw0, paw1, paa0, paa1;
    SCAN_PREFETCH(0);
    __syncthreads();
#pragma unroll 1
    for (int sc = 0; sc < L / 64; ++sc) {
        tid = opq(tid0); fr = tid & 15; fg = (tid & 63) >> 4; ei = tid >> 3; ec8 = (tid & 7) * 8;
        const u32x4 cr = nr, ck = nk, cv = nv; const float kinv = ninv;
        { const int ti = w >> 1;
          const bf16x8 aw0 = paw0, aw1 = paw1, aa0 = paa0, aa1 = paa1;
          unsigned li[2], ls[2];
#pragma unroll
          for (int pr = 0; pr < 2; ++pr) { const int j0 = 4 * fg + 2 * pr, j1 = j0 + 1;
              li[pr] = (j0 <= fr ? 0x3f80u : 0u) | (j1 <= fr ? 0x3f800000u : 0u); ls[pr] = (j0 < fr ? 0x3f80u : 0u) | (j1 < fr ? 0x3f800000u : 0u); }
          const bf16x8 Li = __builtin_bit_cast(bf16x8, (u32x4){li[0], li[1], 0u, 0u}), Ls = __builtin_bit_cast(bf16x8, (u32x4){ls[0], ls[1], 0u, 0u});
#pragma unroll
          for (int x = 0; x < 2; ++x) { const int c = ((w & 1) * 2 + x) * 16 + fr;
              f32x4 cw = (f32x4){lw0c[x], lw0c[x], lw0c[x], lw0c[x]}, ca = (f32x4){la0c[x], la0c[x], la0c[x], la0c[x]};
              cw = MFMA16(aw0, lbw[x][0], cw); cw = MFMA16(aw1, lbw[x][1], cw); ca = MFMA16(aa0, lba[x][0], ca); ca = MFMA16(aa1, lba[x][1], ca);
              float lw[4], lo[4];
#pragma unroll
              for (int r = 0; r < 4; ++r) lw[r] = -0.6065306597126334f * fsigmoid(cw[r]);
              const unsigned h01 = cvt2(lw[0], lw[1]), h23 = cvt2(lw[2], lw[3]);
              lo[0] = lw[0] - bflo(h01); lo[1] = lw[1] - bfhi(h01); lo[2] = lw[2] - bflo(h23); lo[3] = lw[3] - bfhi(h23);
              const bf16x8 bh = __builtin_bit_cast(bf16x8, (u32x4){h01, h23, 0u, 0u}), bl = __builtin_bit_cast(bf16x8, (u32x4){cvt2(lo[0], lo[1]), cvt2(lo[2], lo[3]), 0u, 0u});
              f32x4 ci = (f32x4){0.f, 0.f, 0.f, 0.f}, cs = ci;
              ci = MFMA16(Li, bh, ci); ci = MFMA16(Li, bl, ci); cs = MFMA16(Ls, bh, cs); cs = MFMA16(Ls, bl, cs);
#pragma unroll
              for (int r = 0; r < 4; ++r) { const int o = (ti * 16 + 4 * fg + r) * LPS + c;
                  LP[o] = fexp(ci[r]); AP[o] = fexp(cs[r]); AS[o] = fsigmoid(ca[r]); } } }
        __syncthreads();
        tid = opq(tid0); fr = tid & 15; fg = (tid & 63) >> 4; ei = tid >> 3; ec8 = (tid & 7) * 8;
        float bcv;
        { const f32x4 g0 = *(const LAS f32x4*)(LP + ei * LPS + ec8), g1 = *(const LAS f32x4*)(LP + ei * LPS + ec8 + 4);
          const f32x4 p0 = *(const LAS f32x4*)(AP + ei * LPS + ec8), p1 = *(const LAS f32x4*)(AP + ei * LPS + ec8 + 4);
          const f32x4 s0 = *(const LAS f32x4*)(AS + ei * LPS + ec8), s1 = *(const LAS f32x4*)(AS + ei * LPS + ec8 + 4);
          float rr[8], kk[8], xa[8], xr[8], xb[8], xk[8], bc = 0.f;
          rr[0] = bflo(cr.x); rr[1] = bfhi(cr.x); rr[2] = bflo(cr.y); rr[3] = bfhi(cr.y); rr[4] = bflo(cr.z); rr[5] = bfhi(cr.z); rr[6] = bflo(cr.w); rr[7] = bfhi(cr.w);
          kk[0] = bflo(ck.x); kk[1] = bfhi(ck.x); kk[2] = bflo(ck.y); kk[3] = bfhi(ck.y); kk[4] = bflo(ck.z); kk[5] = bfhi(ck.z); kk[6] = bflo(ck.w); kk[7] = bfhi(ck.w);
#pragma unroll
          for (int e = 0; e < 8; ++e) { const float gi = e < 4 ? g0[e & 3] : g1[e & 3], gp = e < 4 ? p0[e & 3] : p1[e & 3], asg = e < 4 ? s0[e & 3] : s1[e & 3];
              const float kj = kk[e] * kkp[e] * kinv, kd = kk[e] * (1.0f + (asg - 1.0f) * kap[e]), ginv = frcp(gi);
              bc += rr[e] * kd * rkp[e];
              xa[e] = -kj * gp; xr[e] = rr[e] * gi; xb[e] = kj * asg * ginv; xk[e] = kd * ginv; }
          bcv = red8(bc);
          *(LAS u32x4*)(AT + ei * TS + ec8) = pack8(xa); *(LAS u32x4*)(RT + ei * TS + ec8) = pack8(xr); *(LAS u32x4*)(BH + ei * TS + ec8) = pack8(xb); *(LAS u32x4*)(KH + ei * TS + ec8) = pack8(xk);
          *(LAS u32x4*)(VR + ei * TS + ec8) = cv; }
        __syncthreads();
        tid = opq(tid0); fr = tid & 15; fg = (tid & 63) >> 4;
        { const int q = w >> 1, half = w & 1; const LAS bf16* Asrc = half ? RT : AT;
          const bf16x8 af0 = *(const LAS bf16x8*)(Asrc + (16 * q + fr) * TS + fg * 8), af1 = *(const LAS bf16x8*)(Asrc + (16 * q + fr) * TS + 32 + fg * 8);
#pragma unroll
          for (int x = 0; x < 2; ++x) { const LAS bf16* Bsrc = x ? KH : BH;
              const bf16x8 bf0 = *(const LAS bf16x8*)(Bsrc + (16 * q + fr) * TS + fg * 8), bf1_ = *(const LAS bf16x8*)(Bsrc + (16 * q + fr) * TS + 32 + fg * 8);
              f32x4 c = (f32x4){0.f, 0.f, 0.f, 0.f}; c = MFMA16(af0, bf0, c); c = MFMA16(af1, bf1_, c);
              f32x4 cm;
#pragma unroll
              for (int r = 0; r < 4; ++r) { const int i = 4 * fg + r, j = fr; cm[r] = (half ? j <= i : j < i) ? c[r] : 0.f; }
              if (half == 0 && x == 0) *(LAS f32x4*)(AAB + (q * 16 + fr) * 16 + 4 * fg) = cm;
              else { LAS bf16* dst = half == 0 ? AAK : (x == 0 ? ARB : ARK);
#pragma unroll
                  for (int r = 0; r < 4; ++r) dst[(q * 16 + 4 * fg + r) * 24 + fr] = (bf16)(cvt2(cm[r], 0.f) & 0xffffu); } }
          if (half == 0) {
              const unsigned kmask = fg < 2 ? 0xffffffffu : 0u;
              const bf16x8 afr = *(const LAS bf16x8*)(AAK + (q * 16 + fr) * 24 + (fg & 1) * 8);
              const bf16x8 af = __builtin_bit_cast(bf16x8, __builtin_bit_cast(u32x4, afr) & kmask);
#pragma unroll
              for (int tvv = 0; tvv < 4; ++tvv) {
                  const bf16x8 bfr = tr8(VR + (16 * q + 8 * (fg & 1) + (fr >> 2)) * TS + 16 * tvv + 4 * (fr & 3));
                  const bf16x8 bfv = __builtin_bit_cast(bf16x8, __builtin_bit_cast(u32x4, bfr) & kmask);
                  f32x4 c = (f32x4){0.f, 0.f, 0.f, 0.f}; c = MFMA16(af, bfv, c);
#pragma unroll
                  for (int r = 0; r < 4; ++r) W1[(q * 16 + 4 * fg + r) * LPS + 16 * tvv + fr] = c[r]; } } }
        __syncthreads();
        tid = opq(tid0);
        { const int q = tid >> 7, col = tid & 127; float x[16];
          if (col < 64) {
#pragma unroll
              for (int i = 0; i < 16; ++i) x[i] = bf1(AT[(16 * q + i) * TS + col]); }
          else {
#pragma unroll
              for (int i = 0; i < 16; ++i) x[i] = W1[(q * 16 + i) * LPS + col - 64]; }
#pragma unroll
          for (int j = 0; j < 15; ++j) {
              const LAS f32x4* ac = (const LAS f32x4*)(AAB + (q * 16 + j) * 16);
#pragma unroll
              for (int i4 = (j + 1) / 4; i4 < 4; ++i4) { const f32x4 a4 = ac[i4];
#pragma unroll
                  for (int e = 0; e < 4; ++e) if (i4 * 4 + e > j) x[i4 * 4 + e] += a4[e] * x[j]; } }
          if (col < 64) {
#pragma unroll
              for (int i = 0; i < 16; ++i) AT[(16 * q + i) * TS + col] = (bf16)(cvt2(x[i], 0.f) & 0xffffu); }
          else {
#pragma unroll
              for (int i = 0; i < 16; ++i) W1[(q * 16 + i) * LPS + col - 64] = x[i]; } }
        __syncthreads();
        if (sc + 1 < L / 64) SCAN_PREFETCH(sc + 1);
        if (w < 4) {
        tid = opq(tid0); fr = tid & 15; fg = (tid & 63) >> 4;
#pragma unroll
        for (int q = 0; q < 4; ++q) {
            bf16x8 hb[2];
#pragma unroll
            for (int ks = 0; ks < 2; ++ks) { u32x4 t; t.x = cvt2(hacc[2 * ks][0], hacc[2 * ks][1]); t.y = cvt2(hacc[2 * ks][2], hacc[2 * ks][3]);
                t.z = cvt2(hacc[2 * ks + 1][0], hacc[2 * ks + 1][1]); t.w = cvt2(hacc[2 * ks + 1][2], hacc[2 * ks + 1][3]); hb[ks] = __builtin_bit_cast(bf16x8, t); }
            bf16x8 aU[2], aR[2];
#pragma unroll
            for (int ks = 0; ks < 2; ++ks) {
                const u32x2 a0 = *(const LAS u32x2*)(AT + (16 * q + fr) * TS + 32 * ks + 4 * fg), a1 = *(const LAS u32x2*)(AT + (16 * q + fr) * TS + 32 * ks + 16 + 4 * fg);
                const u32x2 r0 = *(const LAS u32x2*)(RT + (16 * q + fr) * TS + 32 * ks + 4 * fg), r1 = *(const LAS u32x2*)(RT + (16 * q + fr) * TS + 32 * ks + 16 + 4 * fg);
                aU[ks] = __builtin_bit_cast(bf16x8, (u32x4){a0.x, a0.y, a1.x, a1.y}); aR[ks] = __builtin_bit_cast(bf16x8, (u32x4){r0.x, r0.y, r1.x, r1.y}); }
            f32x4 u, yacc = (f32x4){0.f, 0.f, 0.f, 0.f};
#pragma unroll
            for (int r = 0; r < 4; ++r) u[r] = W1[(q * 16 + 4 * fg + r) * LPS + 16 * tv + fr];
            u = MFMA16(aU[0], hb[0], u); u = MFMA16(aU[1], hb[1], u);
            yacc = MFMA16(aR[0], hb[0], yacc); yacc = MFMA16(aR[1], hb[1], yacc);
            const s16x4v vtr = __builtin_bit_cast(s16x4v, __builtin_amdgcn_ds_read_tr16_b64_v4i16((LAS s16x4v*)(VR + (16 * q + 4 * fg + (fr >> 2)) * TS + 16 * tv + 4 * (fr & 3))));
            const u32x2 vt2 = __builtin_bit_cast(u32x2, vtr);
            const bf16x8 bUV = __builtin_bit_cast(bf16x8, (u32x4){cvt2(u[0], u[1]), cvt2(u[2], u[3]), vt2.x, vt2.y});
            { const u32x2 y0 = *(const LAS u32x2*)(ARB + (q * 16 + fr) * 24 + 4 * fg), y1 = *(const LAS u32x2*)(ARK + (q * 16 + fr) * 24 + 4 * fg);
              yacc = MFMA16(__builtin_bit_cast(bf16x8, (u32x4){y0.x, y0.y, y1.x, y1.y}), bUV, yacc); }
#pragma unroll
            for (int r = 0; r < 4; ++r) YS[(16 * q + 4 * fg + r) * LPS + 16 * tv + fr] = yacc[r];
#pragma unroll
            for (int x = 0; x < 4; ++x) {
                const s16x4v bt = __builtin_bit_cast(s16x4v, __builtin_amdgcn_ds_read_tr16_b64_v4i16((LAS s16x4v*)(BH + (16 * q + 4 * fg + (fr >> 2)) * TS + 16 * x + 4 * (fr & 3))));
                const s16x4v kt = __builtin_bit_cast(s16x4v, __builtin_amdgcn_ds_read_tr16_b64_v4i16((LAS s16x4v*)(KH + (16 * q + 4 * fg + (fr >> 2)) * TS + 16 * x + 4 * (fr & 3))));
                const u32x2 b2 = __builtin_bit_cast(u32x2, bt), k2 = __builtin_bit_cast(u32x2, kt);
                const f32x4 ge = *(const LAS f32x4*)(LP + (16 * q + 15) * LPS + 16 * x + 4 * fg);
                hacc[x] = MFMA16(__builtin_bit_cast(bf16x8, (u32x4){b2.x, b2.y, k2.x, k2.y}), bUV, hacc[x]) * ge; }
        }
        }
        __syncthreads();
        tid = opq(tid0); ei = tid >> 3; ec8 = (tid & 7) * 8;
        { const int st2 = sc * 64 + ei, t2 = dir ? L - 1 - st2 : st2; bf16* yo = Yout + (size_t)(base + t2) * 512 + h * 64 + ec8;
          const f32x4 y0 = *(const LAS f32x4*)(YS + ei * LPS + ec8), y1 = *(const LAS f32x4*)(YS + ei * LPS + ec8 + 4);
          u32x4 yw; yw.x = cvt2(y0[0], y0[1]); yw.y = cvt2(y0[2], y0[3]); yw.z = cvt2(y1[0], y1[1]); yw.w = cvt2(y1[2], y1[3]);
          *(u32x4*)yo = yw;
          if ((tid & 7) == 0) BC[(size_t)(base + t2) * 8 + h] = bcv; }
    }
#undef SCAN_PREFETCH
    if (!lat && w < 4) {
#pragma unroll
        for (int x = 0; x < 4; ++x) *(f32x4*)(p.out + (size_t)MTOK * DM + ((((size_t)bseq * 2 + l) * 2 + dir) * 8 + h) * 4096 + (16 * tv + fr) * 64 + 16 * x + 4 * fg) = hacc[x]; }
    __syncthreads();
}

__device__ __forceinline__ void stage_upass(CKP& p, int l, int bid, int nb) {
    const int tid = opaque_tid(), sub = tid >= 240 ? 1 : 0, j = tid - sub * 240, col = 8 * j;
    const bf16* proj = (const bf16*)(p.ws + WS_PROJ); bf16* U = (bf16*)(p.ws + WS_U); float* KINV = (float*)(p.ws + WS_KINV);
    const float* mu = p.in[I_MU] + l * 1920;
    if (tid < 480) {
        const bool isk = col >= K_OFF && col < V_OFF;
        const float* kkp = p.in[I_KK] + l * 512 + (isk ? col - K_OFF : 0);
        const f32x4 k0 = *(const f32x4*)kkp, k1 = *(const f32x4*)(kkp + 4);
#pragma unroll 1
        for (int tok0 = bid * 2 + sub; tok0 < MTOK; tok0 += nb * 8) {
            float uu[4][8];
#pragma unroll
            for (int z = 0; z < 4; ++z) { const int tok = min(tok0 + z * nb * 2, MTOK - 1);
                const bool lat = tok >= NCTX; const int L = lat ? 1024 : 256, t = lat ? (tok - NCTX) & 1023 : tok & 255;
                shift8(proj, tok, t > 0, t < L - 1, col, mu, uu[z]); }
#pragma unroll
            for (int z = 0; z < 4; ++z) { const int tok = tok0 + z * nb * 2;
                float ss = 0.f;
#pragma unroll
                for (int e = 0; e < 8; ++e) { const float kn = uu[z][e] * (e < 4 ? k0[e & 3] : k1[e & 3]); ss += kn * kn; }
                ss = red8(ss);
                if (tok < MTOK) {
                    if (isk && (j & 7) == 0) KINV[(size_t)tok * 8 + ((col - K_OFF) >> 6)] = fminf(frsq(ss), 1e12f);
                    if (col >= WD_OFF && col < AD_OFF) {
#pragma unroll
                        for (int e = 0; e < 8; ++e) uu[z][e] = 1.0f - 2.0f * frcp(fexp(2.0f * uu[z][e]) + 1.0f); }
                    if (col >= GD_OFF) {
#pragma unroll
                        for (int e = 0; e < 8; ++e) uu[z][e] = fsigmoid(uu[z][e]); }
                    *(u32x4*)(U + (size_t)tok * 1920 + col) = pack8(uu[z]); } }
        }
    }
}

__device__ __forceinline__ void fnet1_item(CKP& p, int l, int item) {
    const int tid = opaque_tid(), lane = tid & 63, w = __builtin_amdgcn_readfirstlane(tid >> 6), fr = lane & 15, fg = lane >> 4;
    const int tb = item >> 2, g = item & 3, tok0 = tb * 64, tt = w & 3, cs = w >> 2;
    const bf16* proj = (const bf16*)(p.ws + WS_PROJ);
    const bf16* fwt = (const bf16*)(p.ws + WS_FW) + (size_t)((l * 4 + g) * 128 + cs * 64) * 64;
    const bf16* xr = proj + (size_t)(tok0 + 16 * tt + fr) * DINP + F_OFF + g * 64 + fg * 8;
    const bf16x8 a0 = *(const bf16x8*)xr, a1 = *(const bf16x8*)(xr + 32);
    const bool lat = tok0 >= NCTX;
    const int L = lat ? 1024 : 256, bq = lat ? (tok0 - NCTX) >> 10 : tok0 >> 8, t = (lat ? (tok0 - NCTX) & 1023 : tok0 & 255) + 16 * tt + 4 * fg;
    const float scale = lat ? (1.0f / 256.0f) : (1.0f / 128.0f);
    bf16* Y = (bf16*)(p.ws + WS_YCS) + (lat ? (size_t)8192 * 512 : 0);
#pragma unroll
    for (int ot = 0; ot < 4; ++ot) {
        const bf16x8 b0 = *(const bf16x8*)(fwt + (16 * ot + fr) * 64 + fg * 8), b1 = *(const bf16x8*)(fwt + (16 * ot + fr) * 64 + 32 + fg * 8);
        f32x4 c = (f32x4){0.f, 0.f, 0.f, 0.f}; c = MFMA16(a0, b0, c); c = MFMA16(a1, b1, c);
        u32x2 o; o.x = cvt2(c[0] * scale, c[1] * scale); o.y = cvt2(c[2] * scale, c[3] * scale);
        *(u32x2*)(Y + (size_t)((bq * 4 + g) * 64 + 16 * ot + fr) * (2 * L) + cs * L + t) = o; }
}

__device__ __forceinline__ void pool_item(CKP& p, int l, LAS unsigned char* lds, int item) {
    const int tid = opaque_tid(), tb = item >> 2, gi = item & 3, tok0 = tb * 64, hw = 1 << gi;
    const bf16* proj = (const bf16*)(p.ws + WS_PROJ);
    LAS bf16* DB = (LAS bf16*)lds;
    LAS float* CSUM = (LAS float*)(lds + 9216);
    const int ti = tid >> 3, c8 = (tid & 7) * 8, tok = tok0 + ti, col = P_OFF + gi * 64 + c8;
    { float sum[8], x[8];
#pragma unroll
      for (int j = 0; j < 8; ++j) sum[j] = 0.f;
      load8bf(proj + (size_t)tok * DINP + col, x);
      float cnt;
      if (tok < NCTX) { const int t = tok & 255, sb = tok - t, lo = max(t - hw, 0), hi = min(t + hw, 256);
          u32x4 wv[16];
#pragma unroll
          for (int q = 0; q < 16; ++q) { const int tq = min(t - hw + q, 255); wv[q] = (q < 2 * hw && tq >= 0) ? *(const u32x4*)(proj + (size_t)(sb + max(tq, 0)) * DINP + col) : (u32x4){0u, 0u, 0u, 0u}; }
#pragma unroll
          for (int q = 0; q < 16; ++q) if (q < 2 * hw) { const bool ok = t - hw + q >= 0 && t - hw + q < 256; const u32x4 w = wv[q];
              if (ok) { sum[0] += bflo(w.x); sum[1] += bfhi(w.x); sum[2] += bflo(w.y); sum[3] += bfhi(w.y); sum[4] += bflo(w.z); sum[5] += bfhi(w.z); sum[6] += bflo(w.w); sum[7] += bfhi(w.w); } }
          cnt = (float)(hi - lo); }
      else {
          const int t = (tok - NCTX) & 1023, sb = tok - t, r = t >> 6, c = t & 63, rlo = max(r - hw, 0), rhi = min(r + hw, 16), clo = max(c - hw, 0), chi = min(c + hw, 64);
          u32x4 wv[16];
#pragma unroll
          for (int q = 0; q < 16; ++q) { const int rq = r - hw + q; wv[q] = (q < 2 * hw && rq >= 0 && rq < 16) ? *(const u32x4*)(proj + (size_t)(sb + rq * 64 + c) * DINP + col) : (u32x4){0u, 0u, 0u, 0u}; }
#pragma unroll
          for (int q = 0; q < 16; ++q) { const u32x4 w = wv[q];
              sum[0] += bflo(w.x); sum[1] += bfhi(w.x); sum[2] += bflo(w.y); sum[3] += bfhi(w.y); sum[4] += bflo(w.z); sum[5] += bfhi(w.z); sum[6] += bflo(w.w); sum[7] += bfhi(w.w); }
          *(LAS f32x4*)(CSUM + ti * 68 + c8) = (f32x4){sum[0], sum[1], sum[2], sum[3]}; *(LAS f32x4*)(CSUM + ti * 68 + c8 + 4) = (f32x4){sum[4], sum[5], sum[6], sum[7]};
          __syncthreads();
#pragma unroll
          for (int j = 0; j < 8; ++j) sum[j] = 0.f;
          for (int cq = clo; cq < chi; ++cq) { const f32x4 a = *(const LAS f32x4*)(CSUM + cq * 68 + c8), b = *(const LAS f32x4*)(CSUM + cq * 68 + c8 + 4);
#pragma unroll
              for (int j = 0; j < 4; ++j) { sum[j] += a[j]; sum[4 + j] += b[j]; } }
          cnt = (float)((rhi - rlo) * (chi - clo)); }
      const float ic = frcp(cnt);
      float dd[8];
#pragma unroll
      for (int j = 0; j < 8; ++j) dd[j] = sum[j] * ic - x[j];
      *(LAS u32x4*)(DB + ti * 72 + c8) = pack8(dd); }
    __syncthreads();
    { const int lane = tid & 63, w = __builtin_amdgcn_readfirstlane(tid >> 6), fr = lane & 15, fg = lane >> 4, tt = w & 3;
      const bf16* wpt = (const bf16*)(p.ws + WS_WPT) + (size_t)(l * 4 + gi) * 4096;
      const bf16x8 b0 = *(const LAS bf16x8*)(DB + (16 * tt + fr) * 72 + fg * 8), b1 = *(const LAS bf16x8*)(DB + (16 * tt + fr) * 72 + 32 + fg * 8);
#pragma unroll
      for (int x = 0; x < 2; ++x) { const int ot = 2 * (w >> 2) + x;
          const bf16x8 a0 = *(const bf16x8*)(wpt + (16 * ot + fr) * 64 + fg * 8), a1 = *(const bf16x8*)(wpt + (16 * ot + fr) * 64 + 32 + fg * 8);
          f32x4 c = (f32x4){0.f, 0.f, 0.f, 0.f}; c = MFMA16(a0, b0, c); c = MFMA16(a1, b1, c);
          const f32x4 ps = *(const f32x4*)(p.in[I_PSCALE] + l * 256 + gi * 64 + 16 * ot + 4 * fg);
          c *= ps;
          u32x2 o; o.x = cvt2(c[0], c[1]); o.y = cvt2(c[2], c[3]);
          *(u32x2*)((bf16*)(p.ws + WS_MIXED) + (size_t)(tok0 + 16 * tt + fr) * DM + 768 + gi * 64 + 16 * ot + 4 * fg) = o; } }
    __syncthreads();
}

__device__ __forceinline__ float xsum_fg(float s, int fr, int fg) {
    s += __builtin_bit_cast(float, __builtin_amdgcn_ds_bpermute((((fg ^ 1) << 4) | fr) << 2, __builtin_bit_cast(int, s)));
    s += __builtin_bit_cast(float, __builtin_amdgcn_ds_bpermute((((fg ^ 2) << 4) | fr) << 2, __builtin_bit_cast(int, s)));
    return s;
}
__device__ __forceinline__ void stage_post(CKP& p, int l, int bid, int nb) {
    const int tid = opaque_tid(), lane = tid & 63, head = __builtin_amdgcn_readfirstlane(tid >> 6), fr = lane & 15, fg = lane >> 4;
    const bf16* Ub = (const bf16*)(p.ws + WS_U);
    const bf16* gupt = (const bf16*)(p.ws + WS_GUPT) + ((size_t)l * 512 + head * 64) * 128;
    const bf16* YF = (const bf16*)(p.ws + WS_YF); const bf16* YB = (const bf16*)(p.ws + WS_YB);
    const float* BC0 = (const float*)(p.ws + WS_BC); const float* BC1 = BC0 + (size_t)MTOK * 8;
    bf16* MIX = (bf16*)(p.ws + WS_MIXED);
    bf16x8 ag[4][4];
    f32x4 lnw[4], lnb[4];
#pragma unroll
    for (int t = 0; t < 4; ++t) {
#pragma unroll
        for (int ks = 0; ks < 4; ++ks) ag[t][ks] = *(const bf16x8*)(gupt + (16 * t + fr) * 128 + ks * 32 + fg * 8);
        lnw[t] = *(const f32x4*)(p.in[I_LNW] + l * 512 + head * 64 + 16 * t + 4 * fg); lnb[t] = *(const f32x4*)(p.in[I_LNB] + l * 512 + head * 64 + 16 * t + 4 * fg); }
#pragma unroll 1
    for (int item = bid; item < 768; item += nb) {
        const size_t tok = (size_t)item * 16 + fr;
        bf16x8 bs[4];
#pragma unroll
        for (int ks = 0; ks < 4; ++ks) bs[ks] = *(const bf16x8*)(Ub + tok * 1920 + GD_OFF + ks * 32 + fg * 8);
        f32x4 y[4]; u32x2 vw[4];
#pragma unroll
        for (int t = 0; t < 4; ++t) { const int c = head * 64 + 16 * t + 4 * fg;
            const u32x2 yf = *(const u32x2*)(YF + tok * 512 + c), yb = *(const u32x2*)(YB + tok * 512 + c);
            y[t] = (f32x4){bflo(yf.x) + bflo(yb.x), bfhi(yf.x) + bfhi(yb.x), bflo(yf.y) + bflo(yb.y), bfhi(yf.y) + bfhi(yb.y)}; vw[t] = *(const u32x2*)(Ub + tok * 1920 + V_OFF + c); }
        const float bc = BC0[tok * 8 + head] + BC1[tok * 8 + head];
        f32x4 g[4];
#pragma unroll
        for (int t = 0; t < 4; ++t) { g[t] = (f32x4){0.f, 0.f, 0.f, 0.f};
#pragma unroll
            for (int ks = 0; ks < 4; ++ks) g[t] = MFMA16(ag[t][ks], bs[ks], g[t]); }
        float s = 0.f;
#pragma unroll
        for (int t = 0; t < 4; ++t) s += (y[t][0] + y[t][1]) + (y[t][2] + y[t][3]);
        const float mean = xsum_fg(s, fr, fg) * (1.0f / 64.0f);
        float q = 0.f;
#pragma unroll
        for (int t = 0; t < 4; ++t) { y[t] = y[t] - mean; q += (y[t][0] * y[t][0] + y[t][1] * y[t][1]) + (y[t][2] * y[t][2] + y[t][3] * y[t][3]); }
        const float rstd = frsq(xsum_fg(q, fr, fg) * (1.0f / 64.0f) + 64e-5f);
#pragma unroll
        for (int t = 0; t < 4; ++t) { const f32x4 vv = (f32x4){bflo(vw[t].x), bfhi(vw[t].x), bflo(vw[t].y), bfhi(vw[t].y)};
            const f32x4 o = (y[t] * rstd * lnw[t] + lnb[t] + vv * bc) * g[t];
            u32x2 w; w.x = cvt2(o[0], o[1]); w.y = cvt2(o[2], o[3]);
            *(u32x2*)(MIX + tok * DM + head * 64 + 16 * t + 4 * fg) = w; }
    }
}

#define XB_TMO      128
#define XB_XCNT(j)  (256  + 64 * (j))
#define XB_XSUB(j)  (1280 + 64 * (j))
#define XB_XGEN(j)  (2304 + 64 * (j))
#define XB_TOP      3328
#define XB_TOPGEN   3392
#define XCD_BAR_WORDS 3456
#define XB_SPIN_CAP (1u << 18)

__device__ __forceinline__ unsigned xb_ld(unsigned* p)              { return __hip_atomic_load(p, __ATOMIC_RELAXED, __HIP_MEMORY_SCOPE_AGENT); }
__device__ __forceinline__ unsigned xb_add(unsigned* p, unsigned v) { return __hip_atomic_fetch_add(p, v, __ATOMIC_RELAXED, __HIP_MEMORY_SCOPE_AGENT); }
__device__ __forceinline__ unsigned xb_xcc_id() { return (unsigned)__builtin_amdgcn_s_getreg((3 << 11) | 20) & 0xFu; }
#define XB_SPIN(cond, bar) do { unsigned _sp = 0; while (cond) { __builtin_amdgcn_s_sleep(1); \
    if ((++_sp & 255u) == 0u) { if (xb_ld(&(bar)[XB_TMO])) break; if (_sp > XB_SPIN_CAP) { atomicAdd(&(bar)[XB_TMO], 1u); break; } } } } while (0)

struct XcdBarrier {
    unsigned* bar; unsigned x;
    volatile LAS unsigned* st;
};

__device__ __forceinline__ XcdBarrier xcd_barrier_post(unsigned* bar, volatile LAS unsigned* st) {
    XcdBarrier b; b.bar = bar; b.x = xb_xcc_id(); b.st = st;
    if (threadIdx.x == 0) (void)xb_add(&bar[XB_XCNT(b.x)], 1u);
    return b;
}
__device__ __forceinline__ void xcd_barrier_complete(unsigned* bar, unsigned x, unsigned& nloc, unsigned& nx) {
    const unsigned G = gridDim.x * gridDim.y * gridDim.z;
    unsigned sum, cnt, mine, sp = 0u;
    for (;;) {
        sum = 0u; cnt = 0u; mine = 0u;
#pragma unroll
        for (unsigned j = 0; j < 16; ++j) { const unsigned c = xb_ld(&bar[XB_XCNT(j)]); sum += c; cnt += (c > 0u) ? 1u : 0u; mine = (j == x) ? c : mine; }
        if (sum == G) break;
        __builtin_amdgcn_s_sleep(1);
        if ((++sp & 255u) == 0u) { if (xb_ld(&bar[XB_TMO])) break; if (sp > XB_SPIN_CAP) { atomicAdd(&bar[XB_TMO], 1u); break; } }
    }
    nloc = mine > 0u ? mine : 1u; nx = cnt > 0u ? cnt : 1u;
}

__device__ __forceinline__ void xcd_barrier(const XcdBarrier& b) {
    asm volatile("s_waitcnt vmcnt(0)" ::: "memory");
    __syncthreads();
    if (threadIdx.x == 0) {
        unsigned* bar = b.bar;
        __builtin_amdgcn_s_waitcnt(0);
        unsigned nloc = b.st[0], nx = b.st[1];
        if (nloc == 0u) { xcd_barrier_complete(bar, b.x, nloc, nx); b.st[0] = nloc; b.st[1] = nx; }
        const unsigned old = xb_add(&bar[XB_XSUB(b.x)], 1u);
        const unsigned gen = old / nloc;
        if (old + 1u == (gen + 1u) * nloc) {
            __builtin_amdgcn_fence(__ATOMIC_RELEASE, "agent");
            asm volatile("s_waitcnt vmcnt(0)" ::: "memory");
            const unsigned og = xb_add(&bar[XB_TOP], 1u);
            const unsigned tg = og / nx;
            __builtin_amdgcn_fence(__ATOMIC_ACQUIRE, "agent");
            if (og + 1u == (tg + 1u) * nx) xb_add(&bar[XB_TOPGEN], 1u);
            else XB_SPIN(xb_ld(&bar[XB_TOPGEN]) == tg, bar);
            xb_add(&bar[XB_XGEN(b.x)], 1u);
            asm volatile("s_waitcnt vmcnt(0)" ::: "memory");
        } else {
            __builtin_amdgcn_fence(__ATOMIC_ACQUIRE, "agent");
            XB_SPIN(xb_ld(&bar[XB_XGEN(b.x)]) == gen, bar);
            asm volatile("s_waitcnt vmcnt(0)" ::: "memory");
        }
    }
    __syncthreads();
}

struct EpiAny {
    static constexpr bool AFTER_DRAIN = false;
    int mode; bool PERM; int l;
    __device__ __forceinline__ void operator()(const f32x4 (&acc)[2][2][4][2], const pg8::Unit& u, int wr, int wc, int fr, int fq) const {
        CKP* kp = (CKP*)__builtin_amdgcn_kernarg_segment_ptr(); asm volatile("" : "+s"(kp)); CKP& p = *kp;
        unsigned char* ws = p.ws;
        const float* mod = (const float*)(ws + WS_MOD) + (size_t)l * 5 * 6144;
        float* SSQ = (float*)(ws + WS_CTL + 262144);
        bf16* Hb = (bf16*)(ws + WS_H); bf16* XB = (bf16*)(ws + WS_XB);
        if (mode == 7) {
#pragma unroll
            for (int a = 0; a < 2; ++a)
#pragma unroll
                for (int b = 0; b < 2; ++b)
#pragma unroll
                    for (int m = 0; m < 4; ++m)
#pragma unroll
                        for (int n = 0; n < 2; ++n) asm volatile("" :: "v"(acc[a][b][m][n]));
            return; }
        if (mode == 0) { const pg8::EpiBf<0> e{(bf16*)(ws + WS_PROJ), DINP}; e(acc, u, wr, wc, fr, fq); }
        else if (mode == 2) { const pg8::EpiResFinal e{XB, mod + 5 * 1024, p.in[I_FNG], p.out, SSQ + 49152, (unsigned*)(ws + WS_CTL + 524288) + 64 * 16}; e(acc, u, wr, wc, fr, fq); }
        else if (mode == 3) { const pg8::EpiFnet e{(bf16*)(ws + WS_MIXED), 0, 256}; e(acc, u, wr, wc, fr, fq); }
        else if (mode == 8) { const pg8::EpiFnet e{(bf16*)(ws + WS_MIXED), NCTX, 1024}; e(acc, u, wr, wc, fr, fq); }
        else if (mode == 4) { const pg8::EpiNormBf<0> e{(bf16*)(ws + WS_PROJ), DINP, SSQ + 16384, (const float*)(ws + WS_SWIN), DINP}; e(acc, u, wr, wc, fr, fq); }
        else if (mode == 5) { const pg8::EpiNormBf<1> e{(bf16*)(ws + WS_FF), DFF, SSQ + l * 32768, (const float*)(ws + WS_SW1) + (size_t)l * 5 * DFF, DFF}; e(acc, u, wr, wc, fr, fq); }
        else if (mode == 6) {
            if (l == 0) { const pg8::EpiResNorm<true, true> e{XB, mod + 2 * 1024, p.in[I_XP], p.in[I_XS], Hb, p.in[I_N2G], mod + 4 * 1024, SSQ}; e(acc, u, wr, wc, fr, fq); }
            else { const pg8::EpiResNorm<false, true> e{XB, mod + 2 * 1024, nullptr, nullptr, Hb, p.in[I_N2G] + DM, mod + 4 * 1024, SSQ + 32768}; e(acc, u, wr, wc, fr, fq); } }
        else { const pg8::EpiResNorm<false, true> e{XB, mod + 5 * 1024, nullptr, nullptr, Hb, p.in[I_N1G] + DM, mod + 5 * 6144 + 1 * 1024, SSQ + 16384}; e(acc, u, wr, wc, fr, fq); }
    }
};

constexpr int N_STEPS = 16;
__device__ __forceinline__ bool step_seam(int st) { return st < 15; }
__global__ void __launch_bounds__(NTHR, 2) mega_fwd(KP p_unused) {
    extern __shared__ __attribute__((aligned(16))) unsigned char lds_raw[];
    CKP* kp0 = (CKP*)__builtin_amdgcn_kernarg_segment_ptr();
    { LAS unsigned* ctlw = (LAS unsigned*)((LAS unsigned char*)lds_raw + RING_BYTES);
      for (int u = threadIdx.x; u < (LDS_BYTES - RING_BYTES) / 4; u += NTHR) ctlw[u] = 0u; }
    __syncthreads();
    const XcdBarrier bar = xcd_barrier_post((unsigned*)(kp0->ws + WS_CTL) + 4096, (volatile LAS unsigned*)((LAS unsigned char*)lds_raw + MISC_OFF + 32));
    const int ph_lo = kp0->ph_lo, ph_hi = kp0->ph_hi;
#pragma unroll 1
#ifdef REP_A
    for (int sti = ph_lo; sti < ph_hi + ((REP_B) >= 0 ? 2 : 1); ++sti) {
        const int st = sti <= (REP_A) ? sti : (((REP_B) < 0 || sti <= (REP_B) + 1) ? sti - 1 : sti - 2);
        const bool isdup = sti == (REP_A) || ((REP_B) >= 0 && sti == (REP_B) + 1); (void)isdup;
#else
    for (int st = ph_lo; st < ph_hi; ++st) {
#endif
        CKP* kp = kp0; asm volatile("" : "+s"(kp));
        CKP& p = *kp; unsigned char* ws = p.ws;
        int bid = blockIdx.x, nb = gridDim.x; unsigned ldsb = (unsigned)(size_t)(LAS unsigned char*)lds_raw;
        asm volatile("" : "+s"(bid), "+s"(nb), "+s"(ldsb));
        LAS unsigned char* lds = (LAS unsigned char*)(size_t)ldsb;
        const int l = st < 9 ? 0 : 1, s = st == 0 ? -1 : (st == 1 ? 0 : ((st - 2) % 7 + 1));
        const float* mod = (const float*)(ws + WS_MOD) + (size_t)l * 5 * 6144;
#pragma unroll 1
        for (int job = 0; job < 2; ++job) {
            pg8::Gemm g{nullptr, nullptr, 0, 0, 0, 0, 0}; EpiAny E{-1, true, 0}; int corder = bid;
            if (job == 0) {
                if (s == 1) { g = pg8::Gemm{(const bf16*)(ws + WS_H), (const bf16*)(ws + WS_WIN) + (size_t)l * DINP * DM, MTOK, DINP, DM, DM, DM}; E = EpiAny{l == 0 ? 0 : 4, true, l}; }
                else if (s == 3) { g = pg8::Gemm{(const bf16*)(ws + WS_CS256), (const bf16*)(ws + WS_YCS), 256, 8192, 512, 512, 512}; E = EpiAny{3, true, l}; corder = (bid + nb - (nb >= 256 ? 192 : 0)) % nb; }
                else if (s == 5) { g = pg8::Gemm{(const bf16*)(ws + WS_MIXED), (const bf16*)(ws + WS_WOUT) + (size_t)l * DM * DM, MTOK, DM, DM, DM, DM}; E = EpiAny{6, true, l}; }
                else if (s == 6) { g = pg8::Gemm{(const bf16*)(ws + WS_H), (const bf16*)(ws + WS_W1) + (size_t)l * DFF * DM, MTOK, DFF, DM, DM, DM}; E = EpiAny{5, true, l}; }
                else if (s == 7) { g = pg8::Gemm{(const bf16*)(ws + WS_FF), (const bf16*)(ws + WS_W2) + (size_t)l * DM * DFF, MTOK, DM, DFF, DFF, DFF}; E = l == 0 ? EpiAny{9, true, l} : EpiAny{2, true, l}; }
            } else if (s == 3) { g = pg8::Gemm{(const bf16*)(ws + WS_CS1024), (const bf16*)(ws + WS_YCS) + (size_t)8192 * 512, 1024, 1024, 2048, 2048, 2048}; E = EpiAny{8, true, l}; corder = (bid + nb - (nb >= 256 ? 224 : 32)) % nb; }
#ifdef NOEPI_FIRST
            if (isdup && E.mode >= 0) E.mode = 7;
#endif
            if (E.mode >= 0) {
                pg8::StaticOrder S; S.init(g.M, g.N, nb, corder);
                pg8::gemm_phase<EpiAny, pg8::StaticOrder, true, true>(lds, g, S, E);
                __syncthreads();
            }
        }
        if (s == 3) {
            if (nb >= 256) {
                if (bid < 64) rwkv_item3(p, l, lds, bid);
                else { unsigned* ctr = (unsigned*)(ws + WS_CTL + 524288) + 64 * (2 + l); volatile LAS unsigned* slot = (volatile LAS unsigned*)(lds + RING_BYTES + 64);
#pragma unroll 1
                    for (;;) { __syncthreads(); if (threadIdx.x == 0) *slot = atomicAdd(ctr, 1u); __syncthreads(); const int it = (int)*slot; if (it >= 512) break; rwkv_item3(p, l, lds, 64 + it); } }
            } else for (int it = bid; it < 576; it += nb) rwkv_item3(p, l, lds, it);
            side_queue(p, l, lds);
        }
        if (s == -1) stage_prologue(p, lds, bid, nb);
        else if (s == 0) { stage_norm(p, 0, 0, bid, nb); stage_tables(p, bid, nb); }
        else if (s == 2) {
            stage_upass(p, l, bid, nb);
#ifdef DUP_U
            stage_upass(p, l, bid, nb);
#endif
#pragma unroll 1
            for (int it = bid; it < 768; it += nb) fnet1_item(p, l, it);
#ifdef DUP_F
#pragma unroll 1
            for (int it = bid; it < 768; it += nb) fnet1_item(p, l, it);
#endif
#pragma unroll 1
            for (int it = bid; it < 768; it += nb) pool_item(p, l, lds, it);
#ifdef DUP_P
#pragma unroll 1
            for (int it = bid; it < 768; it += nb) pool_item(p, l, lds, it);
#endif
        }
        else if (s == 4) stage_post(p, l, bid, nb);
        #ifdef REP_A
        if (sti + 1 < ph_hi + ((REP_B) >= 0 ? 2 : 1)) xcd_barrier(bar);
#else
        if (st + 1 < ph_hi && step_seam(st)) xcd_barrier(bar);
#endif
    }
}

extern "C" void kernel_launch(void* const* d_in, const int* in_sizes, int n_in, void* d_out, int out_size, void* d_ws, size_t ws_size, hipStream_t stream) {
    static int grid = 0;
    if (grid == 0) {
        if (n_in != N_IN || ws_size < WS_END) { fprintf(stderr, "kernel_launch: unexpected inputs (n_in %d, ws %zu)\n", n_in, ws_size); grid = -1; return; }
        int dev = 0, cus = 0, per_cu = 0;
        (void)hipGetDevice(&dev); (void)hipDeviceGetAttribute(&cus, hipDeviceAttributeMultiprocessorCount, dev);
        (void)hipFuncSetAttribute((const void*)mega_fwd, hipFuncAttributeMaxDynamicSharedMemorySize, LDS_BYTES);
        if (hipOccupancyMaxActiveBlocksPerMultiprocessor(&per_cu, (const void*)mega_fwd, NTHR, LDS_BYTES) != hipSuccess || per_cu < 1) {
            fprintf(stderr, "kernel_launch: occupancy query reports %d blocks/CU\n", per_cu); (void)hipGetLastError(); grid = -1; return; }
        grid = cus * 1;
    }
    if (grid < 0) return;
    KP a{};
    for (int i = 0; i < N_IN; ++i) a.in[i] = (const float*)d_in[i];
    a.out = (float*)d_out; a.ws = (unsigned char*)d_ws; a.ph_lo = 0; a.ph_hi = N_STEPS;
    if (hipMemsetAsync((char*)d_ws + WS_CTL, 0, 1 * MiB, stream) != hipSuccess) { fprintf(stderr, "kernel_launch: memset failed\n"); return; }
    void* args[] = {&a};
    hipError_t e = hipLaunchCooperativeKernel((const void*)mega_fwd, dim3(grid), dim3(NTHR), args, LDS_BYTES, stream);
    if (e != hipSuccess) fprintf(stderr, "cooperative launch failed: %s (grid %d)\n", hipGetErrorString(e), grid);
}
```

```cpp
#include <hip/hip_runtime.h>
#include <hip/hip_cooperative_groups.h>
#include <cstdio>
#include <cstdint>
namespace cg = cooperative_groups;
__device__ __forceinline__ int opaque_tid() { int t = threadIdx.x; asm volatile("" : "+v"(t)); return t; }
namespace pg8 {
#define PG8_LAS __attribute__((address_space(3)))
typedef unsigned short bf16_t;
typedef short bf16x8 __attribute__((ext_vector_type(8)));
typedef float f32x4 __attribute__((ext_vector_type(4)));
typedef unsigned u32x4 __attribute__((ext_vector_type(4)));
constexpr int BM = 256, BK = 64, HALF = 128, HTB = HALF * BK * 2  , STAGE_BYTES = 8 * HTB, NXCD = 8, WGM = 8;

__host__ __device__ __forceinline__ int lds_byte(int r, int c) { const int st = (r >> 4) * 2 + (c >> 5), rr = r & 15, cc = c & 31, ob = rr * 64 + cc * 2; return st * 1024 + (ob ^ (((ob >> 9) & 1) << 5)); }
__host__ __device__ __forceinline__ void stage_rc(int b, int& R, int& C) { const int st = b / 1024, sb = b % 1024, swz = sb ^ (((sb >> 9) & 1) << 5); R = (st >> 1) * 16 + swz / 64; C = (st & 1) * 32 + (swz % 64) / 2; }
__host__ __device__ __forceinline__ int perm32(int rho) { const int n = rho >> 4, i = rho & 15; return 8 * (i >> 2) + 4 * n + (i & 3); }

struct Unit { int pm, pn; };
struct Gemm { const bf16_t* A; const bf16_t* Bt; int M, N, K, lda, ldb; };

struct StaticOrder {
    int nM, nN, nwg, G, c;
    __host__ __device__ void init(int M, int N, int G_, int c_) { nM = M / BM; nN = N / BM; nwg = nM * nN; G = G_; c = c_; }
    __host__ __device__ bool next(int i, Unit& u) const {
        const long L = (long)i * G + c; if (L >= nwg) return false;
        int wgid = (int)L; { const int q = nwg / NXCD, r = nwg % NXCD, xcd = wgid % NXCD, off = wgid / NXCD; wgid = (xcd < r ? xcd * (q + 1) : r * (q + 1) + (xcd - r) * q) + off; }
        const int nig = WGM * nN, gid = wgid / nig, fm = gid * WGM, gsz = (nM - fm) < WGM ? (nM - fm) : WGM;
        u.pm = fm + ((wgid % nig) % gsz); u.pn = (wgid % nig) / gsz; return true;
    }
    __device__ __forceinline__ void a_ready(const Unit&) const {}
    __device__ __forceinline__ void done(const Unit&) const {}
};

__device__ __forceinline__ unsigned cvt_pk_bf16(float lo, float hi) { unsigned r; asm volatile("v_cvt_pk_bf16_f32 %0, %1, %2" : "=v"(r) : "v"(lo), "v"(hi)); return r; }
typedef unsigned u32x2 __attribute__((ext_vector_type(2)));
template <int ACT  > struct EpiBf {
    static constexpr bool PERM = true, AFTER_DRAIN = false;
    bf16_t* O; int ldc;
    __device__ __forceinline__ void operator()(const f32x4 (&acc)[2][2][4][2], const Unit& u, int wr, int wc, int fr, int fq) const {
        const int row0 = u.pm * BM + wr * 64 + fr, col0 = u.pn * BM + wc * 32 + 8 * fq;
#pragma unroll
        for (int ai = 0; ai < 2; ++ai)
#pragma unroll
            for (int m = 0; m < 4; ++m) { bf16_t* rowp = O + (size_t)(row0 + ai * HALF + m * 16) * ldc + col0;
#pragma unroll
                for (int bj = 0; bj < 2; ++bj) { f32x4 v0 = acc[ai][bj][m][0], v1 = acc[ai][bj][m][1];
                    if (ACT == 1) {
#pragma unroll
                        for (int e = 0; e < 4; ++e) { float a = v0[e] > 0.f ? v0[e] : 0.f; v0[e] = a * a; float b = v1[e] > 0.f ? v1[e] : 0.f; v1[e] = b * b; } }
                    u32x4 w; w.x = cvt_pk_bf16(v0[0], v0[1]); w.y = cvt_pk_bf16(v0[2], v0[3]); w.z = cvt_pk_bf16(v1[0], v1[1]); w.w = cvt_pk_bf16(v1[2], v1[3]);
                    *(u32x4*)(rowp + bj * HALF) = w; } }
    }
};
struct EpiRes {
    static constexpr bool PERM = false, AFTER_DRAIN = false;
    float* X; const float* gate; const float* Xc; const float* Xl;
    __device__ __forceinline__ void operator()(const f32x4 (&acc)[2][2][4][2], const Unit& u, int wr, int wc, int fr, int fq) const {
        const int row0 = u.pm * BM + wr * 64 + fr, col0 = u.pn * BM + wc * 32 + 4 * fq;
        const int cond = u.pm < 32 ? 0 : 1 + ((u.pm - 32) >> 2);
        const float* gp = gate + cond * 6144 + col0;
        f32x4 gv[2][2];
#pragma unroll
        for (int bj = 0; bj < 2; ++bj)
#pragma unroll
            for (int n = 0; n < 2; ++n) gv[bj][n] = *(const f32x4*)(gp + bj * HALF + n * 16);
#pragma unroll
        for (int ai = 0; ai < 2; ++ai)
#pragma unroll
            for (int m = 0; m < 4; ++m) { const size_t ro = (size_t)(row0 + ai * HALF + m * 16) * 1024 + col0; float* rowp = X + ro; const float* srcp = u.pm < 32 ? Xc + ro : Xl + (ro - (size_t)8192 * 1024);
#pragma unroll
                for (int bj = 0; bj < 2; ++bj)
#pragma unroll
                    for (int n = 0; n < 2; ++n) { *(f32x4*)(rowp + bj * HALF + n * 16) = *(const f32x4*)(srcp + bj * HALF + n * 16) + gv[bj][n] * acc[ai][bj][m][n]; }
                if (m & 1) asm volatile("" ::: "memory"); }
    }
};
struct EpiFnet {
    static constexpr bool PERM = true, AFTER_DRAIN = false;
    bf16_t* MIX; int rowbase, L;
    __device__ __forceinline__ void operator()(const f32x4 (&acc)[2][2][4][2], const Unit& u, int wr, int wc, int fr, int fq) const {
        const int row0 = u.pm * BM + wr * 64 + fr, colw = wc * 32 + 8 * fq;
        bf16_t* base = MIX + (size_t)(rowbase + u.pn * L) * 1024 + 512 + colw;
#pragma unroll
        for (int ai = 0; ai < 2; ++ai)
#pragma unroll
            for (int m = 0; m < 4; ++m) { bf16_t* rowp = base + (size_t)(row0 + ai * HALF + m * 16) * 1024;
#pragma unroll
                for (int bj = 0; bj < 2; ++bj) { const f32x4 v0 = acc[ai][bj][m][0], v1 = acc[ai][bj][m][1];
                    u32x4 w; w.x = cvt_pk_bf16(v0[0], v0[1]); w.y = cvt_pk_bf16(v0[2], v0[3]); w.z = cvt_pk_bf16(v1[0], v1[1]); w.w = cvt_pk_bf16(v1[2], v1[3]);
                    *(u32x4*)(rowp + bj * HALF) = w; } }
    }
};

__device__ __forceinline__ float xsum_fq(float s, int fr, int fq) {
    s += __builtin_bit_cast(float, __builtin_amdgcn_ds_bpermute((((fq ^ 1) << 4) | fr) << 2, __builtin_bit_cast(int, s)));
    s += __builtin_bit_cast(float, __builtin_amdgcn_ds_bpermute((((fq ^ 2) << 4) | fr) << 2, __builtin_bit_cast(int, s)));
    return s;
}
template <int ACT> struct EpiNormBf {
    static constexpr bool PERM = true, AFTER_DRAIN = false;
    bf16_t* O; int ldc; const float* ssq; const float* sw; int swld;
    __device__ __forceinline__ void operator()(const f32x4 (&acc)[2][2][4][2], const Unit& u, int wr, int wc, int fr, int fq) const {
        const int row0 = u.pm * BM + wr * 64 + fr, col0 = u.pn * BM + wc * 32 + 8 * fq;
        const int cond = u.pm < 32 ? 0 : 1 + ((u.pm - 32) >> 2);
        f32x4 sv[2][2];
#pragma unroll
        for (int bj = 0; bj < 2; ++bj)
#pragma unroll
            for (int n = 0; n < 2; ++n) sv[bj][n] = *(const f32x4*)(sw + (size_t)cond * swld + col0 + bj * HALF + 4 * n);
        float rs[2][4];
#pragma unroll
        for (int ai = 0; ai < 2; ++ai)
#pragma unroll
            for (int m = 0; m < 4; ++m) rs[ai][m] = ssq[row0 + ai * HALF + m * 16];
#pragma unroll
        for (int ai = 0; ai < 2; ++ai)
#pragma unroll
            for (int m = 0; m < 4; ++m) rs[ai][m] = __builtin_amdgcn_rsqf(rs[ai][m] * (1.0f / 1024.0f) + 1e-6f);
#pragma unroll
        for (int ai = 0; ai < 2; ++ai)
#pragma unroll
            for (int m = 0; m < 4; ++m) { const int row = row0 + ai * HALF + m * 16; bf16_t* rowp = O + (size_t)row * ldc + col0;
                const float rstd = rs[ai][m];
#pragma unroll
                for (int bj = 0; bj < 2; ++bj) { f32x4 v0 = acc[ai][bj][m][0] * rstd + sv[bj][0], v1 = acc[ai][bj][m][1] * rstd + sv[bj][1];
                    if (ACT == 1) {
#pragma unroll
                        for (int e = 0; e < 4; ++e) { float a = v0[e] > 0.f ? v0[e] : 0.f; v0[e] = a * a; float b = v1[e] > 0.f ? v1[e] : 0.f; v1[e] = b * b; } }
                    u32x4 w; w.x = cvt_pk_bf16(v0[0], v0[1]); w.y = cvt_pk_bf16(v0[2], v0[3]); w.z = cvt_pk_bf16(v1[0], v1[1]); w.w = cvt_pk_bf16(v1[2], v1[3]);
                    *(u32x4*)(rowp + bj * HALF) = w; }
                if (m & 1) asm volatile("" ::: "memory"); }
    }
};
struct EpiResFinal {
    static constexpr bool PERM = true, AFTER_DRAIN = false;
    const bf16_t* XB; const float* gate; const float* gfin; float* out; float* ssq; unsigned* cnt;
    __device__ __forceinline__ void operator()(const f32x4 (&acc)[2][2][4][2], const Unit& u, int wr, int wc, int fr, int fq) const {
        const int row0 = u.pm * BM + wr * 64 + fr, col0 = u.pn * BM + wc * 32 + 8 * fq;
        const int cond = u.pm < 32 ? 0 : 1 + ((u.pm - 32) >> 2);
        f32x4 gt[2][2];
#pragma unroll
        for (int bj = 0; bj < 2; ++bj)
#pragma unroll
            for (int n = 0; n < 2; ++n) gt[bj][n] = *(const f32x4*)(gate + cond * 6144 + col0 + bj * HALF + n * 4);
#pragma unroll
        for (int ai = 0; ai < 2; ++ai) {
            u32x4 xb[4][2];
#pragma unroll
            for (int m = 0; m < 4; ++m)
#pragma unroll
                for (int bj = 0; bj < 2; ++bj) xb[m][bj] = *(const u32x4*)(XB + (unsigned)(row0 + ai * HALF + m * 16) * 1024u + (unsigned)col0 + bj * HALF);
#pragma unroll
            for (int m = 0; m < 4; ++m) { const int row = row0 + ai * HALF + m * 16;
                float sq = 0.f;
#pragma unroll
                for (int bj = 0; bj < 2; ++bj) { const u32x4 xw = xb[m][bj];
                    f32x4 x0 = (f32x4){__builtin_bit_cast(float, xw.x << 16), __builtin_bit_cast(float, xw.x & 0xffff0000u), __builtin_bit_cast(float, xw.y << 16), __builtin_bit_cast(float, xw.y & 0xffff0000u)};
                    f32x4 x1 = (f32x4){__builtin_bit_cast(float, xw.z << 16), __builtin_bit_cast(float, xw.z & 0xffff0000u), __builtin_bit_cast(float, xw.w << 16), __builtin_bit_cast(float, xw.w & 0xffff0000u)};
                    x0 += gt[bj][0] * acc[ai][bj][m][0]; x1 += gt[bj][1] * acc[ai][bj][m][1];
                    sq += ((x0[0] * x0[0] + x0[1] * x0[1]) + (x0[2] * x0[2] + x0[3] * x0[3])) + ((x1[0] * x1[0] + x1[1] * x1[1]) + (x1[2] * x1[2] + x1[3] * x1[3])); }
                const float t = xsum_fq(sq, fr, fq); if (fq == 0) atomicAdd(ssq + row, t); }
            asm volatile("" ::: "memory"); }
        asm volatile("s_waitcnt vmcnt(0)" ::: "memory");
        unsigned* c = cnt + 64 * u.pm;
        if (fr == 0 && fq == 0) { __hip_atomic_fetch_add(c, 1u, __ATOMIC_RELAXED, __HIP_MEMORY_SCOPE_AGENT);
            for (unsigned spin = 0; __hip_atomic_load(c, __ATOMIC_RELAXED, __HIP_MEMORY_SCOPE_AGENT) < 32u && spin < (1u << 22); ++spin) __builtin_amdgcn_s_sleep(2); }
        asm volatile("" ::: "memory");
        f32x4 gv[2][2];
#pragma unroll
        for (int bj = 0; bj < 2; ++bj)
#pragma unroll
            for (int n = 0; n < 2; ++n) gv[bj][n] = *(const f32x4*)(gfin + col0 + bj * HALF + n * 4);
#pragma unroll
        for (int ai = 0; ai < 2; ++ai) {
            u32x4 xb[4][2]; float rs[4];
#pragma unroll
            for (int m = 0; m < 4; ++m) { rs[m] = __hip_atomic_load(ssq + row0 + ai * HALF + m * 16, __ATOMIC_RELAXED, __HIP_MEMORY_SCOPE_AGENT);
#pragma unroll
                for (int bj = 0; bj < 2; ++bj) xb[m][bj] = *(const u32x4*)(XB + (unsigned)(row0 + ai * HALF + m * 16) * 1024u + (unsigned)col0 + bj * HALF); }
#pragma unroll
            for (int m = 0; m < 4; ++m) { const unsigned ro = (unsigned)(row0 + ai * HALF + m * 16) * 1024u + (unsigned)col0;
                const float rstd = __builtin_amdgcn_rsqf(rs[m] * (1.0f / 1024.0f) + 1e-6f);
#pragma unroll
                for (int bj = 0; bj < 2; ++bj) { const u32x4 xw = xb[m][bj];
                    f32x4 x0 = (f32x4){__builtin_bit_cast(float, xw.x << 16), __builtin_bit_cast(float, xw.x & 0xffff0000u), __builtin_bit_cast(float, xw.y << 16), __builtin_bit_cast(float, xw.y & 0xffff0000u)};
                    f32x4 x1 = (f32x4){__builtin_bit_cast(float, xw.z << 16), __builtin_bit_cast(float, xw.z & 0xffff0000u), __builtin_bit_cast(float, xw.w << 16), __builtin_bit_cast(float, xw.w & 0xffff0000u)};
                    f32x4 ga = gt[bj][0], gb = gt[bj][1]; asm volatile("" : "+v"(ga), "+v"(gb));
                    x0 += ga * acc[ai][bj][m][0]; x1 += gb * acc[ai][bj][m][1];
                    *(f32x4*)(out + ro + bj * HALF) = x0 * rstd * gv[bj][0]; *(f32x4*)(out + ro + bj * HALF + 4) = x1 * rstd * gv[bj][1]; } }
            asm volatile("" ::: "memory"); }
    }
};
template <bool SRC_F32, bool WRITE_H> struct EpiResNorm {
    static constexpr bool PERM = true, AFTER_DRAIN = false;
    bf16_t* XB; const float* gate; const float* Xc; const float* Xl; bf16_t* H; const float* gn; const float* scl; float* ssq;
    __device__ __forceinline__ void operator()(const f32x4 (&acc)[2][2][4][2], const Unit& u, int wr, int wc, int fr, int fq) const {
        const int row0 = u.pm * BM + wr * 64 + fr, col0 = u.pn * BM + wc * 32 + 8 * fq;
        const int cond = u.pm < 32 ? 0 : 1 + ((u.pm - 32) >> 2);
        const float* src = u.pm < 32 ? Xc : Xl - (size_t)8192 * 1024;
        f32x4 gt[2][2], gs[2][2];
#pragma unroll
        for (int bj = 0; bj < 2; ++bj)
#pragma unroll
            for (int n = 0; n < 2; ++n) { const int col = col0 + bj * HALF + n * 4;
                gt[bj][n] = *(const f32x4*)(gate + cond * 6144 + col);
                if (WRITE_H) gs[bj][n] = *(const f32x4*)(gn + col) * (*(const f32x4*)(scl + cond * 6144 + col) + 1.0f); }
        constexpr int NB = SRC_F32 ? 2 : 4;
#pragma unroll
        for (int ai = 0; ai < 2; ++ai)
#pragma unroll
        for (int mb = 0; mb < 4; mb += NB) {
            u32x4 xb[NB][2]; f32x4 xf[NB][2][2];
#pragma unroll
            for (int mm = 0; mm < NB; ++mm) { const unsigned ro = (unsigned)(row0 + ai * HALF + (mb + mm) * 16) * 1024u + (unsigned)col0;
#pragma unroll
                for (int bj = 0; bj < 2; ++bj) {
                    if (SRC_F32) { xf[mm][bj][0] = *(const f32x4*)(src + ro + bj * HALF); xf[mm][bj][1] = *(const f32x4*)(src + ro + bj * HALF + 4); }
                    else xb[mm][bj] = *(const u32x4*)(XB + ro + bj * HALF); } }
#pragma unroll
            for (int mm = 0; mm < NB; ++mm) { const int m = mb + mm; const int row = row0 + ai * HALF + m * 16; const unsigned ro = (unsigned)row * 1024u + (unsigned)col0;
                float sq = 0.f;
#pragma unroll
                for (int bj = 0; bj < 2; ++bj) { const unsigned o = ro + bj * HALF;
                    f32x4 x0, x1;
                    if (SRC_F32) { x0 = xf[mm][bj][0]; x1 = xf[mm][bj][1]; }
                    else { const u32x4 xw = xb[mm][bj];
                        x0 = (f32x4){__builtin_bit_cast(float, xw.x << 16), __builtin_bit_cast(float, xw.x & 0xffff0000u), __builtin_bit_cast(float, xw.y << 16), __builtin_bit_cast(float, xw.y & 0xffff0000u)};
                        x1 = (f32x4){__builtin_bit_cast(float, xw.z << 16), __builtin_bit_cast(float, xw.z & 0xffff0000u), __builtin_bit_cast(float, xw.w << 16), __builtin_bit_cast(float, xw.w & 0xffff0000u)}; }
                    x0 += gt[bj][0] * acc[ai][bj][m][0]; x1 += gt[bj][1] * acc[ai][bj][m][1];
                    u32x4 xo; xo.x = cvt_pk_bf16(x0[0], x0[1]); xo.y = cvt_pk_bf16(x0[2], x0[3]); xo.z = cvt_pk_bf16(x1[0], x1[1]); xo.w = cvt_pk_bf16(x1[2], x1[3]);
                    *(u32x4*)(XB + o) = xo;
                    sq += ((x0[0] * x0[0] + x0[1] * x0[1]) + (x0[2] * x0[2] + x0[3] * x0[3])) + ((x1[0] * x1[0] + x1[1] * x1[1]) + (x1[2] * x1[2] + x1[3] * x1[3]));
                    if (WRITE_H) { const f32x4 h0 = x0 * gs[bj][0], h1 = x1 * gs[bj][1];
                        u32x4 w; w.x = cvt_pk_bf16(h0[0], h0[1]); w.y = cvt_pk_bf16(h0[2], h0[3]); w.z = cvt_pk_bf16(h1[0], h1[1]); w.w = cvt_pk_bf16(h1[2], h1[3]);
                        *(u32x4*)(H + o) = w; } }
                const float t = xsum_fq(sq, fr, fq); if (fq == 0) atomicAdd(ssq + row, t);
            }
            asm volatile("" ::: "memory"); }
    }
};
template <class Epi, class Sched, bool ALIGN_EPI = false, bool SP2 = false>
__device__ __forceinline__ void gemm_phase(PG8_LAS unsigned char* lds, const Gemm g, const Sched& S, const Epi& E) {
    const int tid = opaque_tid(), wid = __builtin_amdgcn_readfirstlane(tid >> 6), lane = tid & 63, wr = wid >> 2, wc = wid & 3, fr = lane & 15, fq = lane >> 4;
    const int K = g.K, nt = K / BK;
    unsigned voffA[2], voffB[2];
#pragma unroll
    for (int i = 0; i < 2; ++i) { int R, C; stage_rc(tid * 16 + i * 8192, R, C); const int Rb = E.PERM ? ((R & ~31) + perm32(R & 31)) : R;
        voffA[i] = (unsigned)(R * g.lda + C) * 2u; voffB[i] = (unsigned)(Rb * g.ldb + C) * 2u; }
    const size_t kstep = (size_t)(BK * 2);
    const size_t hstepA = (size_t)HALF * g.lda * 2, hstepB = (size_t)HALF * g.ldb * 2;
    const size_t tstepA = 2 * hstepA, tstepB = 2 * hstepB;
    const unsigned ldsw = (unsigned)wid * 1024u;
    const int aoff = lds_byte(wr * 64 + fr, fq * 8), boff = lds_byte(wc * 32 + fr, fq * 8);
#define PG8_SA(b, h) (((b) * 2 + (h)) * HTB)
#define PG8_SB(b, h) ((4 + (b) * 2 + (h)) * HTB)
#define PG8_STAGE(bufoff, gbase, voff) do { _Pragma("unroll") for (int _i = 0; _i < 2; ++_i) \
        __builtin_amdgcn_global_load_lds((const unsigned*)((const char*)(gbase) + (voff)[_i]), (PG8_LAS unsigned*)(lds + (bufoff) + ldsw + _i * 8192), 16, 0, 0); } while (0)
#define PG8_LDA(dst, b, h) do { _Pragma("unroll") for (int m = 0; m < 4; ++m) _Pragma("unroll") for (int k = 0; k < 2; ++k) dst[m][k] = *(const PG8_LAS bf16x8*)(lds + PG8_SA(b, h) + aoff + m * 2048 + k * 1024); } while (0)
#define PG8_LDB(dst, b, h) do { _Pragma("unroll") for (int n = 0; n < 2; ++n) _Pragma("unroll") for (int k = 0; k < 2; ++k) dst[n][k] = *(const PG8_LAS bf16x8*)(lds + PG8_SB(b, h) + boff + n * 2048 + k * 1024); } while (0)
#define PG8_MMA(ai, bj, At, Bt) do { __builtin_amdgcn_s_setprio(1); _Pragma("unroll") for (int m = 0; m < 4; ++m) _Pragma("unroll") for (int n = 0; n < 2; ++n) _Pragma("unroll") for (int k = 0; k < 2; ++k) \
        acc[ai][bj][m][n] = __builtin_amdgcn_mfma_f32_16x16x32_bf16(Bt[n][k], At[m][k], acc[ai][bj][m][n], 0, 0, 0); __builtin_amdgcn_s_setprio(0); } while (0)
#define PG8_WAIT_V(n) asm volatile("s_waitcnt vmcnt(" #n ")" ::: "memory")
#define PG8_WAIT_L(n) asm volatile("s_waitcnt lgkmcnt(" #n ")" ::: "memory")
#define PG8_BAR __builtin_amdgcn_s_barrier()
#define PG8_SCHED __builtin_amdgcn_sched_barrier(0)
    Unit cur, nxt; int ui = 0;
    if (!S.next(0, cur)) return;
    f32x4 acc[2][2][4][2];
#pragma unroll
    for (int a = 0; a < 2; ++a)
#pragma unroll
        for (int b = 0; b < 2; ++b)
#pragma unroll
            for (int m = 0; m < 4; ++m)
#pragma unroll
                for (int n = 0; n < 2; ++n) acc[a][b][m][n] = (f32x4){0.f, 0.f, 0.f, 0.f};
    bf16x8 At[4][2], B0[2][2], B1[2][2];
    const char* cA = (const char*)g.A + (size_t)cur.pm * tstepA; const char* cB = (const char*)g.Bt + (size_t)cur.pn * tstepB;
    S.a_ready(cur);
    if constexpr (SP2) {
        PG8_STAGE(PG8_SB(0, 0), cB, voffB); PG8_STAGE(PG8_SB(0, 1), cB + hstepB, voffB); PG8_STAGE(PG8_SA(0, 0), cA, voffA); PG8_STAGE(PG8_SA(0, 1), cA + hstepA, voffA);
        if (wr == 1) PG8_BAR;
        PG8_WAIT_V(2); PG8_BAR;
        PG8_STAGE(PG8_SB(1, 0), cB + kstep, voffB); PG8_STAGE(PG8_SA(1, 0), cA + kstep, voffA); PG8_STAGE(PG8_SB(1, 1), cB + hstepB + kstep, voffB);
        PG8_WAIT_V(6); PG8_BAR;
    } else {
        PG8_STAGE(PG8_SB(0, 0), cB, voffB); PG8_STAGE(PG8_SA(0, 0), cA, voffA); PG8_STAGE(PG8_SB(0, 1), cB + hstepB, voffB); PG8_STAGE(PG8_SA(0, 1), cA + hstepA, voffA);
        if (wr == 1) PG8_BAR;
        PG8_WAIT_V(4); PG8_BAR;
        PG8_STAGE(PG8_SB(1, 0), cB + kstep, voffB); PG8_STAGE(PG8_SA(1, 0), cA + kstep, voffA); PG8_STAGE(PG8_SB(1, 1), cB + hstepB + kstep, voffB);
        PG8_WAIT_V(6); PG8_BAR;
    }
    for (;;) {
        const bool has_next = S.next(ui + 1, nxt);
        const char* nA = has_next ? (const char*)g.A + (size_t)nxt.pm * tstepA : cA; const char* nB = has_next ? (const char*)g.Bt + (size_t)nxt.pn * tstepB : cB;
        for (int t = 0; t < nt; t += 2) {
            const bool last = (t == nt - 2);
            const char* a1 = cA + (size_t)(t + 1) * kstep;
            const char* a2 = last ? nA : cA + (size_t)(t + 2) * kstep; const char* b2 = last ? nB : cB + (size_t)(t + 2) * kstep;
            const char* a3 = a2 + kstep; const char* b3 = b2 + kstep;
            if (last && has_next) S.a_ready(nxt);
            if constexpr (SP2) {
            PG8_LDB(B0, 0, 0); PG8_LDB(B1, 0, 1); PG8_SCHED; PG8_LDA(At, 0, 0); PG8_STAGE(PG8_SA(1, 1), a1 + hstepA, voffA);
            PG8_WAIT_V(8); PG8_WAIT_L(0); PG8_BAR; PG8_MMA(0, 0, At, B0); PG8_MMA(0, 1, At, B1); PG8_BAR; PG8_SCHED;
            PG8_LDA(At, 0, 1); PG8_STAGE(PG8_SB(0, 0), b2, voffB); PG8_STAGE(PG8_SB(0, 1), b2 + hstepB, voffB); PG8_STAGE(PG8_SA(0, 0), a2, voffA);
            PG8_WAIT_V(8); PG8_WAIT_L(0); PG8_BAR; PG8_MMA(1, 0, At, B0); PG8_MMA(1, 1, At, B1); PG8_BAR; PG8_SCHED;
            PG8_LDB(B0, 1, 0); PG8_LDB(B1, 1, 1); PG8_SCHED; PG8_LDA(At, 1, 0); PG8_STAGE(PG8_SA(0, 1), a2 + hstepA, voffA);
            PG8_WAIT_V(8); PG8_WAIT_L(0); PG8_BAR; PG8_MMA(0, 0, At, B0); PG8_MMA(0, 1, At, B1); PG8_BAR; PG8_SCHED;
            PG8_LDA(At, 1, 1); PG8_STAGE(PG8_SB(1, 0), b3, voffB); PG8_STAGE(PG8_SB(1, 1), b3 + hstepB, voffB); PG8_STAGE(PG8_SA(1, 0), a3, voffA);
            PG8_WAIT_V(8); PG8_WAIT_L(0); PG8_BAR; PG8_MMA(1, 0, At, B0); PG8_MMA(1, 1, At, B1); PG8_BAR; PG8_SCHED;
            } else {
            PG8_LDB(B0, 0, 0); PG8_SCHED; PG8_LDA(At, 0, 0); PG8_STAGE(PG8_SA(1, 1), a1 + hstepA, voffA);
            PG8_WAIT_L(8); PG8_BAR; PG8_WAIT_L(0); PG8_MMA(0, 0, At, B0); PG8_BAR; PG8_SCHED;
            PG8_LDB(B1, 0, 1); PG8_STAGE(PG8_SB(0, 0), b2, voffB);
            PG8_BAR; PG8_WAIT_L(0); PG8_MMA(0, 1, At, B1); PG8_BAR;
            PG8_LDA(At, 0, 1); PG8_STAGE(PG8_SA(0, 0), a2, voffA);
            PG8_BAR; PG8_WAIT_L(0); PG8_MMA(1, 0, At, B0); PG8_BAR; PG8_SCHED;
            PG8_STAGE(PG8_SB(0, 1), b2 + hstepB, voffB);
            PG8_WAIT_V(6); PG8_BAR; PG8_MMA(1, 1, At, B1); PG8_BAR;
            PG8_LDB(B0, 1, 0); PG8_SCHED; PG8_LDA(At, 1, 0); PG8_STAGE(PG8_SA(0, 1), a2 + hstepA, voffA);
            PG8_WAIT_L(8); PG8_BAR; PG8_WAIT_L(0); PG8_MMA(0, 0, At, B0); PG8_BAR; PG8_SCHED;
            PG8_LDB(B1, 1, 1); PG8_STAGE(PG8_SB(1, 0), b3, voffB);
            PG8_BAR; PG8_WAIT_L(0); PG8_MMA(0, 1, At, B1); PG8_BAR;
            PG8_LDA(At, 1, 1); PG8_STAGE(PG8_SA(1, 0), a3, voffA);
            PG8_BAR; PG8_WAIT_L(0); PG8_MMA(1, 0, At, B0); PG8_BAR; PG8_SCHED;
            PG8_STAGE(PG8_SB(1, 1), b3 + hstepB, voffB);
            PG8_WAIT_V(6); PG8_BAR; PG8_MMA(1, 1, At, B1); PG8_BAR;
            }
        }
        if constexpr (ALIGN_EPI) { if (wr == 0) PG8_BAR; }
        if constexpr (!Epi::AFTER_DRAIN) { int fr2 = fr, fq2 = fq; asm volatile("" : "+v"(fr2), "+v"(fq2)); E(acc, cur, wr, wc, fr2, fq2); S.done(cur); }
        if (!has_next) break;
#pragma unroll
        for (int a = 0; a < 2; ++a)
#pragma unroll
            for (int b = 0; b < 2; ++b)
#pragma unroll
                for (int m = 0; m < 4; ++m)
#pragma unroll
                    for (int n = 0; n < 2; ++n) acc[a][b][m][n] = (f32x4){0.f, 0.f, 0.f, 0.f};
        cur = nxt; cA = nA; cB = nB; ++ui;
        if constexpr (ALIGN_EPI) { if (wr == 1) PG8_BAR; }
    }
    PG8_WAIT_V(0);
    if constexpr (!ALIGN_EPI) { if (wr == 0) PG8_BAR; }
    PG8_BAR;
    if constexpr (Epi::AFTER_DRAIN) { E.fused(acc, cur, wr, wc, fr, fq, lds, wid, lane); S.done(cur); }
#undef PG8_SA
#undef PG8_SB
#undef PG8_STAGE
#undef PG8_LDA
#undef PG8_LDB
#undef PG8_MMA
#undef PG8_WAIT_V
#undef PG8_WAIT_L
#undef PG8_BAR
#undef PG8_SCHED
}
}

#define LAS __attribute__((address_space(3)))
typedef unsigned short bf16;
typedef float f32x4 __attribute__((ext_vector_type(4)));
typedef unsigned u32x4 __attribute__((ext_vector_type(4)));
typedef unsigned u32x2 __attribute__((ext_vector_type(2)));
constexpr int DM = 1024, NCTX = 8192, MTOK = 12288, DINP = 2560, DFF = 4096;
constexpr int R_OFF = 0, K_OFF = 512, V_OFF = 1024, WD_OFF = 1536, AD_OFF = 1664, GD_OFF = 1792, F_OFF = 1920, P_OFF = 2176, DIN = 2432;
constexpr size_t MiB = 1u << 20;
constexpr size_t WS_CTL = 0, WS_MOD = 1 * MiB, WS_FW = 1 * MiB + 512 * 1024, WS_BC = 2 * MiB, WS_CS256 = 3 * MiB, WS_CS1024 = 4 * MiB, WS_WIN = 8 * MiB, WS_WOUT = 18 * MiB,
                 WS_W1 = 22 * MiB, WS_W2 = 38 * MiB, WS_H = 54 * MiB, WS_MIXED = 78 * MiB, WS_PROJ = 102 * MiB, WS_YCS = 162 * MiB, WS_YF = 102 * MiB, WS_YB = 126 * MiB  , WS_U = 174 * MiB, WS_KINV = 220 * MiB, WS_GUPT = 221 * MiB,
                 WS_FF = 102 * MiB, WS_WUPT = 222 * MiB, WS_AUPT = 222 * MiB + 256 * 1024, WS_SSQ = 223 * MiB, WS_WPT = 223 * MiB + 512 * 1024, WS_SW1 = 224 * MiB, WS_SWIN = 224 * MiB + 256 * 1024, WS_XB = 226 * MiB, WS_END = 250 * MiB;
constexpr int LDS_BYTES = 147456, RING_BYTES = 131072, MISC_OFF = RING_BYTES + 320;
constexpr int NTHR = 512;
enum { I_XP = 0, I_XS, I_STATE, I_C, I_CCTX, I_WADA, I_BADA, I_N1G, I_WIN, I_MU, I_W0, I_WUP, I_A0, I_AUP, I_GUP, I_KK, I_KA, I_RK, I_LNW, I_LNB, I_WFNET, I_WPOOL, I_PSCALE, I_WOUT, I_N2G, I_WFF1, I_WFF2, I_FNG, N_IN };
struct KP { const float* in[N_IN]; float* out; unsigned char* ws; int ph_lo, ph_hi; };
typedef const __attribute__((address_space(4))) KP CKP;

__device__ __forceinline__ unsigned f2bf(float f) { unsigned u = __builtin_bit_cast(unsigned, f); return (u + 0x7fffu + ((u >> 16) & 1u)) >> 16; }
__device__ __forceinline__ unsigned pk2(float lo, float hi) { return f2bf(lo) | (f2bf(hi) << 16); }
__device__ __forceinline__ float bflo(unsigned w) { return __builtin_bit_cast(float, w << 16); }
__device__ __forceinline__ float bfhi(unsigned w) { return __builtin_bit_cast(float, w & 0xffff0000u); }
__device__ __forceinline__ float bf1(bf16 h) { return __builtin_bit_cast(float, (unsigned)h << 16); }
__device__ __forceinline__ float fexp(float x) { return __builtin_amdgcn_exp2f(x * 1.4426950408889634f); }
__device__ __forceinline__ float flog(float x) { return __builtin_amdgcn_logf(x) * 0.6931471805599453f; }
__device__ __forceinline__ float frcp(float x) { return __builtin_amdgcn_rcpf(x); }
__device__ __forceinline__ float frsq(float x) { return __builtin_amdgcn_rsqf(x); }
__device__ __forceinline__ float fsigmoid(float x) { return frcp(1.0f + fexp(-x)); }
template <int CTRL> __device__ __forceinline__ float dppf(float x) { return __builtin_bit_cast(float, __builtin_amdgcn_update_dpp(0, __builtin_bit_cast(int, x), CTRL, 0xF, 0xF, true)); }
__device__ __forceinline__ float red8(float x)  { x += dppf<0xB1>(x); x += dppf<0x4E>(x); x += dppf<0x141>(x); return x; }
__device__ __forceinline__ float red16(float x) { x += dppf<0xB1>(x); x += dppf<0x4E>(x); x += dppf<0x141>(x); x += dppf<0x140>(x); return x; }
__device__ __forceinline__ float wave_sum(float v) {
    v = red16(v);
    const float s0 = __builtin_bit_cast(float, __builtin_amdgcn_readlane(__builtin_bit_cast(int, v), 0)), s1 = __builtin_bit_cast(float, __builtin_amdgcn_readlane(__builtin_bit_cast(int, v), 16));
    const float s2 = __builtin_bit_cast(float, __builtin_amdgcn_readlane(__builtin_bit_cast(int, v), 32)), s3 = __builtin_bit_cast(float, __builtin_amdgcn_readlane(__builtin_bit_cast(int, v), 48));
    return (s0 + s1) + (s2 + s3);
}
__device__ __forceinline__ void load4bf(const bf16* p, float (&o)[4]) { const u32x2 w = *(const u32x2*)p; o[0] = bflo(w.x); o[1] = bfhi(w.x); o[2] = bflo(w.y); o[3] = bfhi(w.y); }
__device__ __forceinline__ void load8bf(const bf16* p, float (&o)[8]) { const u32x4 w = *(const u32x4*)p; o[0] = bflo(w.x); o[1] = bfhi(w.x); o[2] = bflo(w.y); o[3] = bfhi(w.y); o[4] = bflo(w.z); o[5] = bfhi(w.z); o[6] = bflo(w.w); o[7] = bfhi(w.w); }
__device__ __forceinline__ void shift4(const bf16* proj, int row, bool hasp, bool hasn, int col, const float* mu, float (&u)[4]) {
    float p[4], a[4] = {0.f, 0.f, 0.f, 0.f}, b[4] = {0.f, 0.f, 0.f, 0.f};
    load4bf(proj + (size_t)row * DINP + col, p);
    if (hasp) load4bf(proj + (size_t)(row - 1) * DINP + col, a);
    if (hasn) load4bf(proj + (size_t)(row + 1) * DINP + col, b);
    const f32x4 m = *(const f32x4*)(mu + col);
#pragma unroll
    for (int j = 0; j < 4; ++j) u[j] = p[j] + m[j] * (0.5f * (a[j] + b[j]) - p[j]);
}

__device__ __forceinline__ void transpose_item(const float* W, int K, int N, bf16* WT, LAS float* scr, int item, int lane) {
    const int nblk = N / 32, kb = item / nblk, nb = item % nblk, k0 = 64 * kb, n0 = 32 * nb;
#pragma unroll 8
    for (int i = 0; i < 32; ++i) { const int kk = 2 * i + (lane >> 5); scr[kk * 33 + (lane & 31)] = W[(size_t)(k0 + kk) * N + n0 + (lane & 31)]; }
    asm volatile("s_waitcnt lgkmcnt(0)" ::: "memory");
    const int c = lane & 7;
#pragma unroll
    for (int j = 0; j < 4; ++j) { const int n = (lane >> 3) + 8 * j; const LAS float* s = scr + (8 * c) * 33 + n;
        u32x4 o; o.x = pk2(s[0 * 33], s[1 * 33]); o.y = pk2(s[2 * 33], s[3 * 33]); o.z = pk2(s[4 * 33], s[5 * 33]); o.w = pk2(s[6 * 33], s[7 * 33]);
        *(u32x4*)(WT + (size_t)(n0 + n) * K + k0 + 8 * c) = o; }
    asm volatile("s_waitcnt lgkmcnt(0)" ::: "memory");
}
__device__ __forceinline__ void gemv5_cols(LAS float* sc, LAS float* red, const float* W, int ldw, int colw, const float* bias, float* out, int ldo, int colo, int tid) {
    const int cgi = tid & 15, kg = tid >> 4;
    f32x4 acc[5];
#pragma unroll
    for (int c = 0; c < 5; ++c) acc[c] = (f32x4){0.f, 0.f, 0.f, 0.f};
    const float* wp = W + (size_t)(kg * 32) * ldw + colw + cgi * 4;
#pragma unroll 8
    for (int kk = 0; kk < 32; ++kk) { const f32x4 w = *(const f32x4*)(wp + (size_t)kk * ldw);
#pragma unroll
        for (int c = 0; c < 5; ++c) acc[c] += sc[c * 1024 + kg * 32 + kk] * w; }
#pragma unroll
    for (int c = 0; c < 5; ++c) *(LAS f32x4*)(red + (kg * 5 + c) * 64 + cgi * 4) = acc[c];
    __syncthreads();
    if (tid < 320) { const int cond = tid >> 6, col = tid & 63; float sm = bias ? bias[colo + col] : 0.f;
        for (int g = 0; g < 32; ++g) sm += red[(g * 5 + cond) * 64 + col];
        out[(size_t)cond * ldo + colo + col] = sm; }
    __syncthreads();
}
__device__ __forceinline__ void mod_item(CKP& p, LAS unsigned char* lds, int it) {
    const int tid = opaque_tid(); unsigned char* ws = p.ws;
    LAS float* sc = (LAS float*)lds; LAS float* red = (LAS float*)(lds + 20480);
    const int l = it / 96, cgp = it % 96;
    for (int i = tid; i < 5 * 1024; i += NTHR) { const int cond = i >> 10, k = i & 1023; const float v = cond == 0 ? p.in[I_CCTX][k] : p.in[I_C][(cond - 1) * 1024 + k]; sc[i] = v * fsigmoid(v); }
    __syncthreads();
    gemv5_cols(sc, red, p.in[I_WADA] + (size_t)l * 1024 * 6144, 6144, cgp * 64, p.in[I_BADA] + l * 6144, (float*)(ws + WS_MOD) + (size_t)l * 5 * 6144, 6144, cgp * 64, tid);
}
constexpr int TI_IN = 16 * 76, TI_OUT = 16 * 32, TI_1 = 16 * 128, TI_2 = 64 * 32, TI_L = TI_IN + TI_OUT + TI_1 + TI_2;
__device__ __forceinline__ void transpose_range(CKP& p, LAS unsigned char* lds, int first, int last, int bid, int nb) {
    const int tid = opaque_tid(), lane = tid & 63, wave = tid >> 6;
    unsigned char* ws = p.ws;
    LAS float* scr = (LAS float*)(lds + wave * 16384);
#pragma unroll 1
    for (int it = first + bid * 8 + wave; it < last; it += nb * 8) {
        const int l = it / TI_L; int r = it % TI_L;
        if (r < TI_IN) { transpose_item(p.in[I_WIN] + (size_t)l * DM * DIN, DM, DIN, (bf16*)(ws + WS_WIN) + (size_t)l * DINP * DM, scr, r, lane); continue; } r -= TI_IN;
        if (r < TI_OUT) { transpose_item(p.in[I_WOUT] + (size_t)l * DM * DM, DM, DM, (bf16*)(ws + WS_WOUT) + (size_t)l * DM * DM, scr, r, lane); continue; } r -= TI_OUT;
        if (r < TI_1) { transpose_item(p.in[I_WFF1] + (size_t)l * DM * DFF, DM, DFF, (bf16*)(ws + WS_W1) + (size_t)l * DFF * DM, scr, r, lane); continue; } r -= TI_1;
        transpose_item(p.in[I_WFF2] + (size_t)l * DFF * DM, DFF, DM, (bf16*)(ws + WS_W2) + (size_t)l * DM * DFF, scr, r, lane);
    }
}
__device__ __forceinline__ void stage_prologue(CKP& p, LAS unsigned char* lds, int bid, int nb) {
    const int tid = opaque_tid();
    unsigned char* ws = p.ws;
    transpose_range(p, lds, 0, TI_IN, bid, nb);
    const int gt = bid * NTHR + tid, NGT = nb * NTHR;
#pragma unroll 1
    for (int i = gt; i < 2 * 128 * DM / 8; i += NGT) { const int l = i / (128 * DM / 8), r = i % (128 * DM / 8);
        u32x4 z = (u32x4){0u, 0u, 0u, 0u}; asm volatile("" : "+v"(z));
        *(u32x4*)((bf16*)(ws + WS_WIN) + (size_t)l * DINP * DM + (size_t)DIN * DM + (size_t)r * 8) = z; }
    __syncthreads();
#pragma unroll 1
    for (int it = bid; it < 192; it += nb) mod_item(p, lds, it);
}
__device__ __forceinline__ void stage_tables(CKP& p, int bid, int nb) {
    const int tid = opaque_tid(); unsigned char* ws = p.ws;
    const int gt = bid * NTHR + tid, NGT = nb * NTHR;
#pragma unroll 1
    for (int i = gt; i < 256 * 512 + 1024 * 2048; i += NGT) {
        int L, k, j; bf16* dst;
        if (i < 256 * 512) { L = 256; k = i / 512; j = i % 512; dst = (bf16*)(ws + WS_CS256) + i; }
        else { const int i2 = i - 256 * 512; L = 1024; k = i2 / 2048; j = i2 % 2048; dst = (bf16*)(ws + WS_CS1024) + i2; }
        const int jj = j >= L ? j - L : j; const int idx = (k * jj) & (L - 1);
        const float rev = (float)idx * (L == 256 ? (1.0f / 256.0f) : (1.0f / 1024.0f));
        *dst = (bf16)f2bf(j >= L ? -__builtin_amdgcn_sinf(rev) : __builtin_amdgcn_cosf(rev));
    }
#pragma unroll 1
    for (int i = gt; i < 2 * 4 * 64 * 128; i += NGT) {
        const int o = i & 127, c = (i >> 7) & 63, lg = i >> 13; const float* wf = p.in[I_WFNET] + (size_t)lg * 4096 + (o & 63);
        float acc = 0.f;
        if (o < 64) { for (int cp = 0; cp < 64; ++cp) acc += __builtin_amdgcn_cosf((float)((c * cp) & 63) * (1.0f / 64.0f)) * wf[cp * 64]; }
        else { for (int cp = 0; cp < 64; ++cp) acc += __builtin_amdgcn_sinf((float)((c * cp) & 63) * (1.0f / 64.0f)) * wf[cp * 64]; }
        ((bf16*)(ws + WS_FW))[(size_t)(lg * 128 + o) * 64 + c] = (bf16)f2bf(acc);
    }
#pragma unroll 1
    for (int i = gt; i < 2 * 4 * 64 * 64; i += NGT) { const int o = i & 63, c = (i >> 6) & 63, lg = i >> 12;
        ((bf16*)(ws + WS_WPT))[(size_t)(lg * 64 + o) * 64 + c] = (bf16)f2bf(p.in[I_WPOOL][i]); }
#pragma unroll 1
    for (int i = gt; i < 2 * 2 * 64 * 512; i += NGT) { const int c = i & 511, r = (i >> 9) & 63, ld = i >> 15;
        ((bf16*)(ws + WS_WUPT))[(size_t)(ld * 512 + c) * 64 + r] = (bf16)f2bf(p.in[I_WUP][i]);
        ((bf16*)(ws + WS_AUPT))[(size_t)(ld * 512 + c) * 64 + r] = (bf16)f2bf(p.in[I_AUP][i]); }
#pragma unroll 1
    for (int i = gt; i < 2 * 128 * 512; i += NGT) { const int c = i & 511, r = (i >> 9) & 127, ll = i >> 16;
        ((bf16*)(ws + WS_GUPT))[(size_t)(ll * 512 + c) * 128 + r] = (bf16)f2bf(p.in[I_GUP][i]); }
}
__device__ __forceinline__ void shiftw_item(CKP& p, LAS unsigned char* lds, int it) {
    const int tid = opaque_tid();
    unsigned char* ws = p.ws;
    LAS float* sc = (LAS float*)lds; LAS float* red = (LAS float*)(lds + 20480);
    const bool isin = it >= 128; const int l = isin ? 1 : it >> 6, blk = isin ? it - 128 : it & 63;
    const float* shv = (const float*)(ws + WS_MOD) + (size_t)l * 5 * 6144 + (isin ? 0 : 3 * 1024);
    for (int i = tid; i < 5 * 1024; i += NTHR) sc[i] = shv[(i >> 10) * 6144 + (i & 1023)];
    __syncthreads();
    if (isin) gemv5_cols(sc, red, p.in[I_WIN] + (size_t)DM * DIN, DIN, blk * 64, nullptr, (float*)(ws + WS_SWIN), DINP, blk * 64, tid);
    else gemv5_cols(sc, red, p.in[I_WFF1] + (size_t)l * DM * DFF, DFF, blk * 64, nullptr, (float*)(ws + WS_SW1) + (size_t)l * 5 * DFF, DFF, blk * 64, tid);
    if (it == 165) for (int i = tid; i < 5 * 128; i += NTHR) ((float*)(ws + WS_SWIN))[(i >> 7) * DINP + DIN + (i & 127)] = 0.f;
}
__device__ __forceinline__ void side_queue(CKP& p, int l, LAS unsigned char* lds) {
    const int tid = opaque_tid();
    unsigned* ctr = (unsigned*)(p.ws + WS_CTL + 524288) + 64 * l;
    volatile LAS unsigned* slot = (volatile LAS unsigned*)(lds + RING_BYTES + 64);
    const int nmd = 0, nsh = l == 0 ? 166 : 0, first = l == 0 ? TI_IN : TI_L + TI_IN, nch = ((l == 0 ? TI_L + TI_IN : 2 * TI_L) - first) / 8;
    __syncthreads();
#pragma unroll 1
    for (;;) {
        if (tid == 0) *slot = atomicAdd(ctr, 1u);
        __syncthreads();
        const int it = (int)*slot;
        __syncthreads();
        if (it >= nmd + nsh + nch) break;
        if (it < nmd) mod_item(p, lds, 96 + it);
        else if (it < nmd + nsh) shiftw_item(p, lds, it - nmd);
        else { const int c0 = first + 8 * (it - nmd - nsh); transpose_range(p, lds, c0, c0 + 8, 0, 1); }
        __syncthreads();
    }
}

__device__ __forceinline__ void stage_norm(CKP& p, int l, int which, int bid, int nb) {
    const int tid = opaque_tid(), lane = tid & 63, wave = tid >> 6;
    const float* g = p.in[which ? I_N2G : I_N1G] + l * DM;
    const float* mod = (const float*)(p.ws + WS_MOD) + (size_t)l * 5 * 6144 + (which ? 3 * 1024 : 0);
    bf16* H = (bf16*)(p.ws + WS_H);
#pragma unroll 1
    for (int row0 = bid * 8 + wave; row0 < MTOK; row0 += nb * 16) {
        f32x4 v[2][4]; float s[2];
#pragma unroll
        for (int z = 0; z < 2; ++z) { const int row = min(row0 + z * nb * 8, MTOK - 1);
            const float* xsrc = (l == 0 && which == 0) ? (row < NCTX ? p.in[I_XP] + (size_t)row * DM : p.in[I_XS] + (size_t)(row - NCTX) * DM) : p.out + (size_t)row * DM;
            const f32x4* xr = (const f32x4*)xsrc + lane;
#pragma unroll
            for (int j = 0; j < 4; ++j) v[z][j] = xr[64 * j]; }
#pragma unroll
        for (int z = 0; z < 2; ++z) { const int row = row0 + z * nb * 8;
            s[z] = 0.f;
#pragma unroll
            for (int j = 0; j < 4; ++j) s[z] += (v[z][j].x * v[z][j].x + v[z][j].y * v[z][j].y) + (v[z][j].z * v[z][j].z + v[z][j].w * v[z][j].w);
            const float rstd = frsq(wave_sum(s[z]) * (1.0f / DM) + 1e-6f);
            if (row < MTOK) {
                const int cond = row < NCTX ? 0 : 1 + ((row - NCTX) >> 10);
                const float* sh = mod + cond * 6144; const float* scl = sh + 1024;
                unsigned long long* o8 = (unsigned long long*)(H + (size_t)row * DM) + lane;
#pragma unroll
                for (int j = 0; j < 4; ++j) { const int col = 4 * lane + 256 * j; const f32x4 gg = *(const f32x4*)(g + col), a = *(const f32x4*)(sh + col), b = *(const f32x4*)(scl + col);
                    const f32x4 y = v[z][j] * rstd * gg * (b + 1.0f) + a;
                    o8[64 * j] = (unsigned long long)pk2(y.x, y.y) | ((unsigned long long)pk2(y.z, y.w) << 32); } } }
    }
}
__device__ __forceinline__ void stage_final(CKP& p, int bid, int nb) {
    const int tid = opaque_tid(), lane = tid & 63, wave = tid >> 6;
    const float* g = p.in[I_FNG];
    const bf16* XB = (const bf16*)(p.ws + WS_XB); const float* ssq = (const float*)(p.ws + WS_CTL + 262144) + 49152;
    const f32x4 g0 = *(const f32x4*)(g + 8 * lane), g1 = *(const f32x4*)(g + 8 * lane + 4), g2 = *(const f32x4*)(g + 512 + 8 * lane), g3 = *(const f32x4*)(g + 512 + 8 * lane + 4);
#pragma unroll 1
    for (int row = bid * 8 + wave; row < MTOK; row += nb * 8) {
        const float rstd = frsq(ssq[row] * (1.0f / DM) + 1e-6f);
        const u32x4 a = *(const u32x4*)(XB + (size_t)row * DM + 8 * lane), b = *(const u32x4*)(XB + (size_t)row * DM + 512 + 8 * lane);
        float* o = p.out + (size_t)row * DM + 8 * lane;
        *(f32x4*)o = (f32x4){bflo(a.x), bfhi(a.x), bflo(a.y), bfhi(a.y)} * rstd * g0; *(f32x4*)(o + 4) = (f32x4){bflo(a.z), bfhi(a.z), bflo(a.w), bfhi(a.w)} * rstd * g1;
        *(f32x4*)(o + 512) = (f32x4){bflo(b.x), bfhi(b.x), bflo(b.y), bfhi(b.y)} * rstd * g2; *(f32x4*)(o + 516) = (f32x4){bflo(b.z), bfhi(b.z), bflo(b.w), bfhi(b.w)} * rstd * g3;
    }
}


typedef short bf16x8 __attribute__((ext_vector_type(8)));
typedef float f32x2v __attribute__((ext_vector_type(2)));
typedef __bf16 bf16x2v __attribute__((ext_vector_type(2)));
#define MFMA16(a, b, c) __builtin_amdgcn_mfma_f32_16x16x32_bf16((a), (b), (c), 0, 0, 0)
__device__ __forceinline__ unsigned cvt2(float lo, float hi) { f32x2v v = {lo, hi}; bf16x2v b = __builtin_convertvector(v, bf16x2v); return __builtin_bit_cast(unsigned, b); }
__device__ __forceinline__ u32x4 pack8(const float (&x)[8]) { u32x4 w; w.x = cvt2(x[0], x[1]); w.y = cvt2(x[2], x[3]); w.z = cvt2(x[4], x[5]); w.w = cvt2(x[6], x[7]); return w; }
__device__ __forceinline__ void shift8(const bf16* proj, int row, bool hasp, bool hasn, int col, const float* mu, float (&u)[8]) {
    float p[8], a[8], b[8];
    load8bf(proj + (size_t)row * DINP + col, p);
    if (hasp) load8bf(proj + (size_t)(row - 1) * DINP + col, a); else {
#pragma unroll
        for (int j = 0; j < 8; ++j) a[j] = 0.f; }
    if (hasn) load8bf(proj + (size_t)(row + 1) * DINP + col, b); else {
#pragma unroll
        for (int j = 0; j < 8; ++j) b[j] = 0.f; }
    const f32x4 m0 = *(const f32x4*)(mu + col), m1 = *(const f32x4*)(mu + col + 4);
#pragma unroll
    for (int j = 0; j < 4; ++j) { u[j] = p[j] + m0[j] * (0.5f * (a[j] + b[j]) - p[j]); u[4 + j] = p[4 + j] + m1[j] * (0.5f * (a[4 + j] + b[4 + j]) - p[4 + j]); }
}
__device__ __forceinline__ int opq(int x) { asm volatile("" : "+v"(x)); return x; }
constexpr int TS = 72, TB = 64 * TS * 2;
constexpr int L_HT = 0, L_TW = 9216, L_AD = 18432, L_LP = 27648, L_AP = 45056, L_AT = 62464, L_RT = L_AT + TB, L_BH = L_RT + TB, L_KH = L_BH + TB, L_VR = L_KH + TB, L_YS = L_VR + TB;
constexpr int L_AAB = L_TW, L_AAK = L_AAB + 4096, L_ARB = L_AAK + 3072, L_ARK = L_ARB + 3072, L_UT = L_ARK + 3072, L_W1 = L_AP;
static_assert(L_UT + 64 * 24 * 2 <= L_LP && L_YS + 17408 <= RING_BYTES, "scan LDS map");
constexpr int LPS = 68;
#define LBAR() asm volatile("s_waitcnt lgkmcnt(0)\n\ts_barrier" ::: "memory")
typedef short s16x4v __attribute__((ext_vector_type(4)));
__device__ __forceinline__ bf16x8 tr8(const LAS bf16* p) {
    const s16x4v lo = __builtin_bit_cast(s16x4v, __builtin_amdgcn_ds_read_tr16_b64_v4i16((LAS s16x4v*)p));
    const s16x4v hi = __builtin_bit_cast(s16x4v, __builtin_amdgcn_ds_read_tr16_b64_v4i16((LAS s16x4v*)(p + 4 * TS)));
    return (bf16x8){lo[0], lo[1], lo[2], lo[3], hi[0], hi[1], hi[2], hi[3]};
}

__device__ __forceinline__ void rwkv_item3(CKP& p, int l, LAS unsigned char* lds, int item) {
    const int tid0 = opaque_tid(), w = __builtin_amdgcn_readfirstlane(tid0 >> 6);
    int tid = tid0, fr = tid & 15, fg = (tid & 63) >> 4;
    int bseq, h, dir, L, base; bool lat;
    if (item < 64) { lat = true; bseq = item >> 4; h = (item >> 1) & 7; dir = item & 1; L = 1024; base = NCTX + bseq * 1024; }
    else { const int i2 = item - 64; lat = false; bseq = i2 >> 4; h = (i2 >> 1) & 7; dir = i2 & 1; L = 256; base = bseq * 256; }
    const bf16* U = (const bf16*)(p.ws + WS_U);
    const float* KINV = (const float*)(p.ws + WS_KINV);
    bf16* Yout = (bf16*)(p.ws + (dir ? WS_YB : WS_YF));
    float* BC = (float*)(p.ws + WS_BC) + (size_t)dir * MTOK * 8;
    const bf16* wupt = (const bf16*)(p.ws + WS_WUPT) + ((size_t)(l * 2 + dir) * 512 + h * 64) * 64;
    const bf16* aupt = (const bf16*)(p.ws + WS_AUPT) + ((size_t)(l * 2 + dir) * 512 + h * 64) * 64;

    LAS float* LP = (LAS float*)(lds + L_LP); LAS float* AP = (LAS float*)(lds + L_AP); LAS float* AS = (LAS float*)(lds + L_TW);
    LAS bf16* AT = (LAS bf16*)(lds + L_AT);   LAS bf16* RT = (LAS bf16*)(lds + L_RT);   LAS bf16* BH = (LAS bf16*)(lds + L_BH);   LAS bf16* KH = (LAS bf16*)(lds + L_KH);
    LAS bf16* VR = (LAS bf16*)(lds + L_VR);   LAS float* YS = (LAS float*)(lds + L_YS);
    LAS float* AAB = (LAS float*)(lds + L_AAB); LAS bf16* AAK = (LAS bf16*)(lds + L_AAK); LAS bf16* ARB = (LAS bf16*)(lds + L_ARB); LAS bf16* ARK = (LAS bf16*)(lds + L_ARK); LAS bf16* AAK1 = (LAS bf16*)(lds + L_UT);
    LAS float* W1 = (LAS float*)(lds + L_W1);
    const int tv = w & 3;
    f32x4 hacc[4];
#pragma unroll
    for (int x = 0; x < 4; ++x) {
        if (lat && w < 4) hacc[x] = *(const f32x4*)(p.in[I_STATE] + ((((size_t)bseq * 2 + l) * 2 + dir) * 8 + h) * 4096 + (16 * tv + fr) * 64 + 16 * x + 4 * fg);
        else hacc[x] = (f32x4){0.f, 0.f, 0.f, 0.f}; }
    int ei = tid >> 3, ec8 = (tid & 7) * 8; const int hc8 = h * 64 + ec8;
    float kkp[8], kap[8], rkp[8];
#pragma unroll
    for (int e = 0; e < 8; ++e) { kkp[e] = p.in[I_KK][l * 512 + hc8 + e]; kap[e] = p.in[I_KA][l * 512 + hc8 + e]; rkp[e] = p.in[I_RK][l * 512 + hc8 + e]; }
#define SCAN_PREFETCH(SC) do { const int _t0 = opq(tid0), _ei = _t0 >> 3, _ec8 = (_t0 & 7) * 8; const int _step = (SC) * 64 + _ei, _t = dir ? L - 1 - _step : _step; \
        const bf16* _u = U + (size_t)(base + _t) * 1920; \
        nr = *(const u32x4*)(_u + R_OFF + h * 64 + _ec8); nk = *(const u32x4*)(_u + K_OFF + h * 64 + _ec8); nv = *(const u32x4*)(_u + V_OFF + h * 64 + _ec8); \
        ninv = KINV[(size_t)(base + _t) * 8 + h]; \
        const int _st2 = (SC) * 64 + 16 * (w >> 1) + (_t0 & 15), _t2 = dir ? L - 1 - _st2 : _st2; const bf16* _u2 = U + (size_t)(base + _t2) * 1920 + dir * 64 + ((_t0 & 63) >> 4) * 8; \
        paw0 = *(const bf16x8*)(_u2 + WD_OFF); paw1 = *(const bf16x8*)(_u2 + WD_OFF + 32); paa0 = *(const bf16x8*)(_u2 + AD_OFF); paa1 = *(const bf16x8*)(_u2 + AD_OFF + 32); } while (0)
    bf16x8 lbw[2][2], lba[2][2]; float lw0c[2], la0c[2];
#pragma unroll
    for (int x = 0; x < 2; ++x) { const int c = ((w & 1) * 2 + x) * 16 + fr;
        lbw[x][0] = *(const bf16x8*)(wupt + c * 64 + fg * 8); lbw[x][1] = *(const bf16x8*)(wupt + c * 64 + 32 + fg * 8);
        lba[x][0] = *(const bf16x8*)(aupt + c * 64 + fg * 8); lba[x][1] = *(const bf16x8*)(aupt + c * 64 + 32 + fg * 8);
        lw0c[x] = p.in[I_W0][(l * 2 + dir) * 512 + h * 64 + c]; la0c[x] = p.in[I_A0][(l * 2 + dir) * 512 + h * 64 + c]; }
    u32x4 nr, nk, nv; float ninv; bf16x8 paw0, paw1, paa0, paa1;
    SCAN_PREFETCH(0);
    __syncthreads();
#pragma unroll 1
    for (int sc = 0; sc < L / 64; ++sc) {
        tid = opq(tid0); fr = tid & 15; fg = (tid & 63) >> 4; ei = tid >> 3; ec8 = (tid & 7) * 8;
        const u32x4 cr = nr, ck = nk, cv = nv; const float kinv = ninv;
        { const int ti = w >> 1;
          const bf16x8 aw0 = paw0, aw1 = paw1, aa0 = paa0, aa1 = paa1;
          unsigned li[2];
#pragma unroll
          for (int pr = 0; pr < 2; ++pr) { const int j0 = 4 * fg + 2 * pr, j1 = j0 + 1; li[pr] = (j0 <= fr ? 0x3f80u : 0u) | (j1 <= fr ? 0x3f800000u : 0u); }
          const bf16x8 Li = __builtin_bit_cast(bf16x8, (u32x4){li[0], li[1], 0u, 0u});
#pragma unroll
          for (int x = 0; x < 2; ++x) { const int c = ((w & 1) * 2 + x) * 16 + fr;
              f32x4 cw = (f32x4){lw0c[x], lw0c[x], lw0c[x], lw0c[x]}, ca = (f32x4){la0c[x], la0c[x], la0c[x], la0c[x]};
              cw = MFMA16(aw0, lbw[x][0], cw); cw = MFMA16(aw1, lbw[x][1], cw); ca = MFMA16(aa0, lba[x][0], ca); ca = MFMA16(aa1, lba[x][1], ca);
              float lw[4], lo[4];
#pragma unroll
              for (int r = 0; r < 4; ++r) lw[r] = -0.6065306597126334f * fsigmoid(cw[r]);
              const unsigned h01 = cvt2(lw[0], lw[1]), h23 = cvt2(lw[2], lw[3]);
              lo[0] = lw[0] - bflo(h01); lo[1] = lw[1] - bfhi(h01); lo[2] = lw[2] - bflo(h23); lo[3] = lw[3] - bfhi(h23);
              const bf16x8 bh = __builtin_bit_cast(bf16x8, (u32x4){h01, h23, 0u, 0u}), bl = __builtin_bit_cast(bf16x8, (u32x4){cvt2(lo[0], lo[1]), cvt2(lo[2], lo[3]), 0u, 0u});
              f32x4 ci = (f32x4){0.f, 0.f, 0.f, 0.f};
              ci = MFMA16(Li, bh, ci); ci = MFMA16(Li, bl, ci);
#pragma unroll
              for (int r = 0; r < 4; ++r) { const int o = (ti * 16 + 4 * fg + r) * LPS + c;
                  LP[o] = fexp(ci[r]); AS[o] = fsigmoid(ca[r]); } } }
        __syncthreads();
        tid = opq(tid0); fr = tid & 15; fg = (tid & 63) >> 4; ei = tid >> 3; ec8 = (tid & 7) * 8;
        float bcv;
        { const f32x4 g0 = *(const LAS f32x4*)(LP + ei * LPS + ec8), g1 = *(const LAS f32x4*)(LP + ei * LPS + ec8 + 4);
          const int ip = (ei & 15) ? ei - 1 : ei;
          f32x4 p0 = *(const LAS f32x4*)(LP + ip * LPS + ec8), p1 = *(const LAS f32x4*)(LP + ip * LPS + ec8 + 4);
          if ((ei & 15) == 0) { p0 = (f32x4){1.f, 1.f, 1.f, 1.f}; p1 = p0; }
          const f32x4 s0 = *(const LAS f32x4*)(AS + ei * LPS + ec8), s1 = *(const LAS f32x4*)(AS + ei * LPS + ec8 + 4);
          float rr[8], kk[8], xa[8], xr[8], xb[8], xk[8], bc = 0.f;
          rr[0] = bflo(cr.x); rr[1] = bfhi(cr.x); rr[2] = bflo(cr.y); rr[3] = bfhi(cr.y); rr[4] = bflo(cr.z); rr[5] = bfhi(cr.z); rr[6] = bflo(cr.w); rr[7] = bfhi(cr.w);
          kk[0] = bflo(ck.x); kk[1] = bfhi(ck.x); kk[2] = bflo(ck.y); kk[3] = bfhi(ck.y); kk[4] = bflo(ck.z); kk[5] = bfhi(ck.z); kk[6] = bflo(ck.w); kk[7] = bfhi(ck.w);
#pragma unroll
          for (int e = 0; e < 8; ++e) { const float gi = e < 4 ? g0[e & 3] : g1[e & 3], gp = e < 4 ? p0[e & 3] : p1[e & 3], asg = e < 4 ? s0[e & 3] : s1[e & 3];
              const float kj = kk[e] * kkp[e] * kinv, kd = kk[e] * (1.0f + (asg - 1.0f) * kap[e]), ginv = frcp(gi);
              bc += rr[e] * kd * rkp[e];
              xa[e] = -kj * gp; xr[e] = rr[e] * gi; xb[e] = kj * asg * ginv; xk[e] = kd * ginv; }
          bcv = red8(bc);
          *(LAS u32x4*)(AT + ei * TS + ec8) = pack8(xa); *(LAS u32x4*)(RT + ei * TS + ec8) = pack8(xr); *(LAS u32x4*)(BH + ei * TS + ec8) = pack8(xb); *(LAS u32x4*)(KH + ei * TS + ec8) = pack8(xk);
          *(LAS u32x4*)(VR + ei * TS + ec8) = cv; }
        __syncthreads();
        tid = opq(tid0); fr = tid & 15; fg = (tid & 63) >> 4;
        { const int q = w >> 1, half = w & 1; const LAS bf16* Asrc = half ? RT : AT;
          const bf16x8 af0 = *(const LAS bf16x8*)(Asrc + (16 * q + fr) * TS + fg * 8), af1 = *(const LAS bf16x8*)(Asrc + (16 * q + fr) * TS + 32 + fg * 8);
          const bf16x8 bb0 = *(const LAS bf16x8*)(BH + (16 * q + fr) * TS + fg * 8), bb1 = *(const LAS bf16x8*)(BH + (16 * q + fr) * TS + 32 + fg * 8);
          const bf16x8 bk0 = *(const LAS bf16x8*)(KH + (16 * q + fr) * TS + fg * 8), bk1 = *(const LAS bf16x8*)(KH + (16 * q + fr) * TS + 32 + fg * 8);
          LAS bf16* myak = half ? AAK1 : AAK;
          f32x4 cx = (f32x4){0.f, 0.f, 0.f, 0.f}, ck2 = cx, cak = cx;
          cx = MFMA16(af0, bb0, cx); cx = MFMA16(af1, bb1, cx);
          ck2 = MFMA16(af0, bk0, ck2); ck2 = MFMA16(af1, bk1, ck2);
          if (half) { const bf16x8 at0 = *(const LAS bf16x8*)(AT + (16 * q + fr) * TS + fg * 8), at1 = *(const LAS bf16x8*)(AT + (16 * q + fr) * TS + 32 + fg * 8);
              cak = MFMA16(at0, bk0, cak); cak = MFMA16(at1, bk1, cak); }
          else cak = ck2;
          f32x4 mx, mk, mak;
#pragma unroll
          for (int r = 0; r < 4; ++r) { const int i = 4 * fg + r, j = fr; const bool lo = half ? j <= i : j < i; mx[r] = lo ? cx[r] : 0.f; mk[r] = lo ? ck2[r] : 0.f; mak[r] = j < i ? cak[r] : 0.f; }
          if (half == 0) *(LAS f32x4*)(AAB + (q * 16 + fr) * 16 + 4 * fg) = mx;
#pragma unroll
          for (int r = 0; r < 4; ++r) { const int o = (q * 16 + 4 * fg + r) * 24 + fr;
              if (half) { ARB[o] = (bf16)(cvt2(mx[r], 0.f) & 0xffffu); ARK[o] = (bf16)(cvt2(mk[r], 0.f) & 0xffffu); }
              myak[o] = (bf16)(cvt2(mak[r], 0.f) & 0xffffu); }
          {
              const unsigned kmask = fg < 2 ? 0xffffffffu : 0u;
              const bf16x8 afr = *(const LAS bf16x8*)(myak + (q * 16 + fr) * 24 + (fg & 1) * 8);
              const bf16x8 af = __builtin_bit_cast(bf16x8, __builtin_bit_cast(u32x4, afr) & kmask);
#pragma unroll
              for (int x = 0; x < 2; ++x) { const int tvv = 2 * half + x;
                  const bf16x8 bfr = tr8(VR + (16 * q + 8 * (fg & 1) + (fr >> 2)) * TS + 16 * tvv + 4 * (fr & 3));
                  const bf16x8 bfv = __builtin_bit_cast(bf16x8, __builtin_bit_cast(u32x4, bfr) & kmask);
                  f32x4 c = (f32x4){0.f, 0.f, 0.f, 0.f}; c = MFMA16(af, bfv, c);
#pragma unroll
                  for (int r = 0; r < 4; ++r) W1[(q * 16 + 4 * fg + r) * LPS + 16 * tvv + fr] = c[r]; } } }
        __syncthreads();
        tid = opq(tid0);
        { const int q = tid >> 7, col = tid & 127; float x[16];
          if (col < 64) {
#pragma unroll
              for (int i = 0; i < 16; ++i) x[i] = bf1(AT[(16 * q + i) * TS + col]); }
          else {
#pragma unroll
              for (int i = 0; i < 16; ++i) x[i] = W1[(q * 16 + i) * LPS + col - 64]; }
#pragma unroll
          for (int j = 0; j < 15; ++j) {
              const LAS f32x4* ac = (const LAS f32x4*)(AAB + (q * 16 + j) * 16);
#pragma unroll
              for (int i4 = (j + 1) / 4; i4 < 4; ++i4) { const f32x4 a4 = ac[i4];
#pragma unroll
                  for (int e = 0; e < 4; ++e) if (i4 * 4 + e > j) x[i4 * 4 + e] += a4[e] * x[j]; } }
          if (col < 64) {
#pragma unroll
              for (int i = 0; i < 16; ++i) AT[(16 * q + i) * TS + col] = (bf16)(cvt2(x[i], 0.f) & 0xffffu); }
          else {
#pragma unroll
              for (int i = 0; i < 16; ++i) W1[(q * 16 + i) * LPS + col - 64] = x[i]; } }
        __syncthreads();
        if (sc + 1 < L / 64) SCAN_PREFETCH(sc + 1);
        if (w < 4) {
        tid = opq(tid0); fr = tid & 15; fg = (tid & 63) >> 4;
#pragma unroll
        for (int q = 0; q < 4; ++q) {
            bf16x8 hb[2];
#pragma unroll
            for (int ks = 0; ks < 2; ++ks) { u32x4 t; t.x = cvt2(hacc[2 * ks][0], hacc[2 * ks][1]); t.y = cvt2(hacc[2 * ks][2], hacc[2 * ks][3]);
                t.z = cvt2(hacc[2 * ks + 1][0], hacc[2 * ks + 1][1]); t.w = cvt2(hacc[2 * ks + 1][2], hacc[2 * ks + 1][3]); hb[ks] = __builtin_bit_cast(bf16x8, t); }
            bf16x8 aU[2], aR[2];
#pragma unroll
            for (int ks = 0; ks < 2; ++ks) {
                const u32x2 a0 = *(const LAS u32x2*)(AT + (16 * q + fr) * TS + 32 * ks + 4 * fg), a1 = *(const LAS u32x2*)(AT + (16 * q + fr) * TS + 32 * ks + 16 + 4 * fg);
                const u32x2 r0 = *(const LAS u32x2*)(RT + (16 * q + fr) * TS + 32 * ks + 4 * fg), r1 = *(const LAS u32x2*)(RT + (16 * q + fr) * TS + 32 * ks + 16 + 4 * fg);
                aU[ks] = __builtin_bit_cast(bf16x8, (u32x4){a0.x, a0.y, a1.x, a1.y}); aR[ks] = __builtin_bit_cast(bf16x8, (u32x4){r0.x, r0.y, r1.x, r1.y}); }
            f32x4 u, yacc = (f32x4){0.f, 0.f, 0.f, 0.f};
#pragma unroll
            for (int r = 0; r < 4; ++r) u[r] = W1[(q * 16 + 4 * fg + r) * LPS + 16 * tv + fr];
            u = MFMA16(aU[0], hb[0], u); u = MFMA16(aU[1], hb[1], u);
            yacc = MFMA16(aR[0], hb[0], yacc); yacc = MFMA16(aR[1], hb[1], yacc);
            const s16x4v vtr = __builtin_bit_cast(s16x4v, __builtin_amdgcn_ds_read_tr16_b64_v4i16((LAS s16x4v*)(VR + (16 * q + 4 * fg + (fr >> 2)) * TS + 16 * tv + 4 * (fr & 3))));
            const u32x2 vt2 = __builtin_bit_cast(u32x2, vtr);
            const bf16x8 bUV = __builtin_bit_cast(bf16x8, (u32x4){cvt2(u[0], u[1]), cvt2(u[2], u[3]), vt2.x, vt2.y});
            { const u32x2 y0 = *(const LAS u32x2*)(ARB + (q * 16 + fr) * 24 + 4 * fg), y1 = *(const LAS u32x2*)(ARK + (q * 16 + fr) * 24 + 4 * fg);
              yacc = MFMA16(__builtin_bit_cast(bf16x8, (u32x4){y0.x, y0.y, y1.x, y1.y}), bUV, yacc); }
#pragma unroll
            for (int r = 0; r < 4; ++r) YS[(16 * q + 4 * fg + r) * LPS + 16 * tv + fr] = yacc[r];
#pragma unroll
            for (int x = 0; x < 4; ++x) {
                const s16x4v bt = __builtin_bit_cast(s16x4v, __builtin_amdgcn_ds_read_tr16_b64_v4i16((LAS s16x4v*)(BH + (16 * q + 4 * fg + (fr >> 2)) * TS + 16 * x + 4 * (fr & 3))));
                const s16x4v kt = __builtin_bit_cast(s16x4v, __builtin_amdgcn_ds_read_tr16_b64_v4i16((LAS s16x4v*)(KH + (16 * q + 4 * fg + (fr >> 2)) * TS + 16 * x + 4 * (fr & 3))));
                const u32x2 b2 = __builtin_bit_cast(u32x2, bt), k2 = __builtin_bit_cast(u32x2, kt);
                const f32x4 ge = *(const LAS f32x4*)(LP + (16 * q + 15) * LPS + 16 * x + 4 * fg);
                hacc[x] = MFMA16(__builtin_bit_cast(bf16x8, (u32x4){b2.x, b2.y, k2.x, k2.y}), bUV, hacc[x]) * ge; }
        }
        }
        __syncthreads();
        tid = opq(tid0); ei = tid >> 3; ec8 = (tid & 7) * 8;
        { const int st2 = sc * 64 + ei, t2 = dir ? L - 1 - st2 : st2; bf16* yo = Yout + (size_t)(base + t2) * 512 + h * 64 + ec8;
          const f32x4 y0 = *(const LAS f32x4*)(YS + ei * LPS + ec8), y1 = *(const LAS f32x4*)(YS + ei * LPS + ec8 + 4);
          u32x4 yw; yw.x = cvt2(y0[0], y0[1]); yw.y = cvt2(y0[2], y0[3]); yw.z = cvt2(y1[0], y1[1]); yw.w = cvt2(y1[2], y1[3]);
          *(u32x4*)yo = yw;
          if ((tid & 7) == 0) BC[(size_t)(base + t2) * 8 + h] = bcv; }
    }
#undef SCAN_PREFETCH
    if (!lat && w < 4) {
#pragma unroll
        for (int x = 0; x < 4; ++x) *(f32x4*)(p.out + (size_t)MTOK * DM + ((((size_t)bseq * 2 + l) * 2 + dir) * 8 + h) * 4096 + (16 * tv + fr) * 64 + 16 * x + 4 * fg) = hacc[x]; }
    __syncthreads();
}

__device__ __forceinline__ void stage_upass(CKP& p, int l, int bid, int nb) {
    const int tid = opaque_tid(), sub = tid >= 240 ? 1 : 0, j = tid - sub * 240, col = 8 * j;
    const bf16* proj = (const bf16*)(p.ws + WS_PROJ); bf16* U = (bf16*)(p.ws + WS_U); float* KINV = (float*)(p.ws + WS_KINV);
    const float* mu = p.in[I_MU] + l * 1920;
    if (tid < 480) {
        const bool isk = col >= K_OFF && col < V_OFF;
        const float* kkp = p.in[I_KK] + l * 512 + (isk ? col - K_OFF : 0);
        const f32x4 k0 = *(const f32x4*)kkp, k1 = *(const f32x4*)(kkp + 4);
#pragma unroll 1
        for (int tok0 = bid * 2 + sub; tok0 < MTOK; tok0 += nb * 8) {
            float uu[4][8];
#pragma unroll
            for (int z = 0; z < 4; ++z) { const int tok = min(tok0 + z * nb * 2, MTOK - 1);
                const bool lat = tok >= NCTX; const int L = lat ? 1024 : 256, t = lat ? (tok - NCTX) & 1023 : tok & 255;
                shift8(proj, tok, t > 0, t < L - 1, col, mu, uu[z]); }
#pragma unroll
            for (int z = 0; z < 4; ++z) { const int tok = tok0 + z * nb * 2;
                float ss = 0.f;
#pragma unroll
                for (int e = 0; e < 8; ++e) { const float kn = uu[z][e] * (e < 4 ? k0[e & 3] : k1[e & 3]); ss += kn * kn; }
                ss = red8(ss);
                if (tok < MTOK) {
                    if (isk && (j & 7) == 0) KINV[(size_t)tok * 8 + ((col - K_OFF) >> 6)] = fminf(frsq(ss), 1e12f);
                    if (col >= WD_OFF && col < AD_OFF) {
#pragma unroll
                        for (int e = 0; e < 8; ++e) uu[z][e] = 1.0f - 2.0f * frcp(fexp(2.0f * uu[z][e]) + 1.0f); }
                    if (col >= GD_OFF) {
#pragma unroll
                        for (int e = 0; e < 8; ++e) uu[z][e] = fsigmoid(uu[z][e]); }
                    *(u32x4*)(U + (size_t)tok * 1920 + col) = pack8(uu[z]); } }
        }
    }
}

__device__ __forceinline__ void fnet1_item(CKP& p, int l, int item) {
    const int tid = opaque_tid(), lane = tid & 63, w = __builtin_amdgcn_readfirstlane(tid >> 6), fr = lane & 15, fg = lane >> 4;
    const int tb = item >> 2, g = item & 3, tok0 = tb * 64, tt = w & 3, cs = w >> 2;
    const bf16* proj = (const bf16*)(p.ws + WS_PROJ);
    const bf16* fwt = (const bf16*)(p.ws + WS_FW) + (size_t)((l * 4 + g) * 128 + cs * 64) * 64;
    const bf16* xr = proj + (size_t)(tok0 + 16 * tt + fr) * DINP + F_OFF + g * 64 + fg * 8;
    const bf16x8 a0 = *(const bf16x8*)xr, a1 = *(const bf16x8*)(xr + 32);
    const bool lat = tok0 >= NCTX;
    const int L = lat ? 1024 : 256, bq = lat ? (tok0 - NCTX) >> 10 : tok0 >> 8, t = (lat ? (tok0 - NCTX) & 1023 : tok0 & 255) + 16 * tt + 4 * fg;
    const float scale = lat ? (1.0f / 256.0f) : (1.0f / 128.0f);
    bf16* Y = (bf16*)(p.ws + WS_YCS) + (lat ? (size_t)8192 * 512 : 0);
#pragma unroll
    for (int ot = 0; ot < 4; ++ot) {
        const bf16x8 b0 = *(const bf16x8*)(fwt + (16 * ot + fr) * 64 + fg * 8), b1 = *(const bf16x8*)(fwt + (16 * ot + fr) * 64 + 32 + fg * 8);
        f32x4 c = (f32x4){0.f, 0.f, 0.f, 0.f}; c = MFMA16(a0, b0, c); c = MFMA16(a1, b1, c);
        u32x2 o; o.x = cvt2(c[0] * scale, c[1] * scale); o.y = cvt2(c[2] * scale, c[3] * scale);
        *(u32x2*)(Y + (size_t)((bq * 4 + g) * 64 + 16 * ot + fr) * (2 * L) + cs * L + t) = o; }
}

__device__ __forceinline__ void pool_item(CKP& p, int l, LAS unsigned char* lds, int item) {
    const int tid = opaque_tid(), tb = item >> 2, gi = item & 3, tok0 = tb * 64, hw = 1 << gi;
    const bf16* proj = (const bf16*)(p.ws + WS_PROJ);
    LAS bf16* DB = (LAS bf16*)lds;
    LAS float* CSUM = (LAS float*)(lds + 9216);
    const int ti = tid >> 3, c8 = (tid & 7) * 8, tok = tok0 + ti, col = P_OFF + gi * 64 + c8;
    { float sum[8], x[8];
#pragma unroll
      for (int j = 0; j < 8; ++j) sum[j] = 0.f;
      load8bf(proj + (size_t)tok * DINP + col, x);
      float cnt;
      if (tok < NCTX) { const int t = tok & 255, sb = tok - t, lo = max(t - hw, 0), hi = min(t + hw, 256);
          u32x4 wv[16];
#pragma unroll
          for (int q = 0; q < 16; ++q) { const int tq = min(t - hw + q, 255); wv[q] = (q < 2 * hw && tq >= 0) ? *(const u32x4*)(proj + (size_t)(sb + max(tq, 0)) * DINP + col) : (u32x4){0u, 0u, 0u, 0u}; }
#pragma unroll
          for (int q = 0; q < 16; ++q) if (q < 2 * hw) { const bool ok = t - hw + q >= 0 && t - hw + q < 256; const u32x4 w = wv[q];
              if (ok) { sum[0] += bflo(w.x); sum[1] += bfhi(w.x); sum[2] += bflo(w.y); sum[3] += bfhi(w.y); sum[4] += bflo(w.z); sum[5] += bfhi(w.z); sum[6] += bflo(w.w); sum[7] += bfhi(w.w); } }
          cnt = (float)(hi - lo); }
      else {
          const int t = (tok - NCTX) & 1023, sb = tok - t, r = t >> 6, c = t & 63, rlo = max(r - hw, 0), rhi = min(r + hw, 16), clo = max(c - hw, 0), chi = min(c + hw, 64);
          u32x4 wv[16];
#pragma unroll
          for (int q = 0; q < 16; ++q) { const int rq = r - hw + q; wv[q] = (q < 2 * hw && rq >= 0 && rq < 16) ? *(const u32x4*)(proj + (size_t)(sb + rq * 64 + c) * DINP + col) : (u32x4){0u, 0u, 0u, 0u}; }
#pragma unroll
          for (int q = 0; q < 16; ++q) { const u32x4 w = wv[q];
              sum[0] += bflo(w.x); sum[1] += bfhi(w.x); sum[2] += bflo(w.y); sum[3] += bfhi(w.y); sum[4] += bflo(w.z); sum[5] += bfhi(w.z); sum[6] += bflo(w.w); sum[7] += bfhi(w.w); }
          *(LAS f32x4*)(CSUM + ti * 68 + c8) = (f32x4){sum[0], sum[1], sum[2], sum[3]}; *(LAS f32x4*)(CSUM + ti * 68 + c8 + 4) = (f32x4){sum[4], sum[5], sum[6], sum[7]};
          __syncthreads();
#pragma unroll
          for (int j = 0; j < 8; ++j) sum[j] = 0.f;
          for (int cq = clo; cq < chi; ++cq) { const f32x4 a = *(const LAS f32x4*)(CSUM + cq * 68 + c8), b = *(const LAS f32x4*)(CSUM + cq * 68 + c8 + 4);
#pragma unroll
              for (int j = 0; j < 4; ++j) { sum[j] += a[j]; sum[4 + j] += b[j]; } }
          cnt = (float)((rhi - rlo) * (chi - clo)); }
      const float ic = frcp(cnt);
      float dd[8];
#pragma unroll
      for (int j = 0; j < 8; ++j) dd[j] = sum[j] * ic - x[j];
      *(LAS u32x4*)(DB + ti * 72 + c8) = pack8(dd); }
    __syncthreads();
    { const int lane = tid & 63, w = __builtin_amdgcn_readfirstlane(tid >> 6), fr = lane & 15, fg = lane >> 4, tt = w & 3;
      const bf16* wpt = (const bf16*)(p.ws + WS_WPT) + (size_t)(l * 4 + gi) * 4096;
      const bf16x8 b0 = *(const LAS bf16x8*)(DB + (16 * tt + fr) * 72 + fg * 8), b1 = *(const LAS bf16x8*)(DB + (16 * tt + fr) * 72 + 32 + fg * 8);
#pragma unroll
      for (int x = 0; x < 2; ++x) { const int ot = 2 * (w >> 2) + x;
          const bf16x8 a0 = *(const bf16x8*)(wpt + (16 * ot + fr) * 64 + fg * 8), a1 = *(const bf16x8*)(wpt + (16 * ot + fr) * 64 + 32 + fg * 8);
          f32x4 c = (f32x4){0.f, 0.f, 0.f, 0.f}; c = MFMA16(a0, b0, c); c = MFMA16(a1, b1, c);
          const f32x4 ps = *(const f32x4*)(p.in[I_PSCALE] + l * 256 + gi * 64 + 16 * ot + 4 * fg);
          c *= ps;
          u32x2 o; o.x = cvt2(c[0], c[1]); o.y = cvt2(c[2], c[3]);
          *(u32x2*)((bf16*)(p.ws + WS_MIXED) + (size_t)(tok0 + 16 * tt + fr) * DM + 768 + gi * 64 + 16 * ot + 4 * fg) = o; } }
    __syncthreads();
}

__device__ __forceinline__ float xsum_fg(float s, int fr, int fg) {
    s += __builtin_bit_cast(float, __builtin_amdgcn_ds_bpermute((((fg ^ 1) << 4) | fr) << 2, __builtin_bit_cast(int, s)));
    s += __builtin_bit_cast(float, __builtin_amdgcn_ds_bpermute((((fg ^ 2) << 4) | fr) << 2, __builtin_bit_cast(int, s)));
    return s;
}
__device__ __forceinline__ void stage_post(CKP& p, int l, int bid, int nb) {
    const int tid = opaque_tid(), lane = tid & 63, head = __builtin_amdgcn_readfirstlane(tid >> 6), fr = lane & 15, fg = lane >> 4;
    const bf16* Ub = (const bf16*)(p.ws + WS_U);
    const bf16* gupt = (const bf16*)(p.ws + WS_GUPT) + ((size_t)l * 512 + head * 64) * 128;
    const bf16* YF = (const bf16*)(p.ws + WS_YF); const bf16* YB = (const bf16*)(p.ws + WS_YB);
    const float* BC0 = (const float*)(p.ws + WS_BC); const float* BC1 = BC0 + (size_t)MTOK * 8;
    bf16* MIX = (bf16*)(p.ws + WS_MIXED);
    bf16x8 ag[4][4];
    f32x4 lnw[4], lnb[4];
#pragma unroll
    for (int t = 0; t < 4; ++t) {
#pragma unroll
        for (int ks = 0; ks < 4; ++ks) ag[t][ks] = *(const bf16x8*)(gupt + (16 * t + fr) * 128 + ks * 32 + fg * 8);
        lnw[t] = *(const f32x4*)(p.in[I_LNW] + l * 512 + head * 64 + 16 * t + 4 * fg); lnb[t] = *(const f32x4*)(p.in[I_LNB] + l * 512 + head * 64 + 16 * t + 4 * fg); }
#pragma unroll 1
    for (int item = bid; item < 768; item += nb) {
        const size_t tok = (size_t)item * 16 + fr;
        bf16x8 bs[4];
#pragma unroll
        for (int ks = 0; ks < 4; ++ks) bs[ks] = *(const bf16x8*)(Ub + tok * 1920 + GD_OFF + ks * 32 + fg * 8);
        f32x4 y[4]; u32x2 vw[4];
#pragma unroll
        for (int t = 0; t < 4; ++t) { const int c = head * 64 + 16 * t + 4 * fg;
            const u32x2 yf = *(const u32x2*)(YF + tok * 512 + c), yb = *(const u32x2*)(YB + tok * 512 + c);
            y[t] = (f32x4){bflo(yf.x) + bflo(yb.x), bfhi(yf.x) + bfhi(yb.x), bflo(yf.y) + bflo(yb.y), bfhi(yf.y) + bfhi(yb.y)}; vw[t] = *(const u32x2*)(Ub + tok * 1920 + V_OFF + c); }
        const float bc = BC0[tok * 8 + head] + BC1[tok * 8 + head];
        f32x4 g[4];
#pragma unroll
        for (int t = 0; t < 4; ++t) { g[t] = (f32x4){0.f, 0.f, 0.f, 0.f};
#pragma unroll
            for (int ks = 0; ks < 4; ++ks) g[t] = MFMA16(ag[t][ks], bs[ks], g[t]); }
        float s = 0.f;
#pragma unroll
        for (int t = 0; t < 4; ++t) s += (y[t][0] + y[t][1]) + (y[t][2] + y[t][3]);
        const float mean = xsum_fg(s, fr, fg) * (1.0f / 64.0f);
        float q = 0.f;
#pragma unroll
        for (int t = 0; t < 4; ++t) { y[t] = y[t] - mean; q += (y[t][0] * y[t][0] + y[t][1] * y[t][1]) + (y[t][2] * y[t][2] + y[t][3] * y[t][3]); }
        const float rstd = frsq(xsum_fg(q, fr, fg) * (1.0f / 64.0f) + 64e-5f);
#pragma unroll
        for (int t = 0; t < 4; ++t) { const f32x4 vv = (f32x4){bflo(vw[t].x), bfhi(vw[t].x), bflo(vw[t].y), bfhi(vw[t].y)};
            const f32x4 o = (y[t] * rstd * lnw[t] + lnb[t] + vv * bc) * g[t];
            u32x2 w; w.x = cvt2(o[0], o[1]); w.y = cvt2(o[2], o[3]);
            *(u32x2*)(MIX + tok * DM + head * 64 + 16 * t + 4 * fg) = w; }
    }
}

#define XB_TMO      128
#define XB_XCNT(j)  (256  + 64 * (j))
#define XB_XSUB(j)  (1280 + 64 * (j))
#define XB_XGEN(j)  (2304 + 64 * (j))
#define XB_TOP      3328
#define XB_TOPGEN   3392
#define XCD_BAR_WORDS 3456
#define XB_SPIN_CAP (1u << 18)

__device__ __forceinline__ unsigned xb_ld(unsigned* p)              { return __hip_atomic_load(p, __ATOMIC_RELAXED, __HIP_MEMORY_SCOPE_AGENT); }
__device__ __forceinline__ unsigned xb_add(unsigned* p, unsigned v) { return __hip_atomic_fetch_add(p, v, __ATOMIC_RELAXED, __HIP_MEMORY_SCOPE_AGENT); }
__device__ __forceinline__ unsigned xb_xcc_id() { return (unsigned)__builtin_amdgcn_s_getreg((3 << 11) | 20) & 0xFu; }
#define XB_SPIN(cond, bar) do { unsigned _sp = 0; while (cond) { __builtin_amdgcn_s_sleep(1); \
    if ((++_sp & 255u) == 0u) { if (xb_ld(&(bar)[XB_TMO])) break; if (_sp > XB_SPIN_CAP) { atomicAdd(&(bar)[XB_TMO], 1u); break; } } } } while (0)

struct XcdBarrier {
    unsigned* bar; unsigned x;
    volatile LAS unsigned* st;
};

__device__ __forceinline__ XcdBarrier xcd_barrier_post(unsigned* bar, volatile LAS unsigned* st) {
    XcdBarrier b; b.bar = bar; b.x = xb_xcc_id(); b.st = st;
    if (threadIdx.x == 0) (void)xb_add(&bar[XB_XCNT(b.x)], 1u);
    return b;
}
__device__ __forceinline__ void xcd_barrier_complete(unsigned* bar, unsigned x, unsigned& nloc, unsigned& nx) {
    const unsigned G = gridDim.x * gridDim.y * gridDim.z;
    unsigned sum, cnt, mine, sp = 0u;
    for (;;) {
        sum = 0u; cnt = 0u; mine = 0u;
#pragma unroll
        for (unsigned j = 0; j < 16; ++j) { const unsigned c = xb_ld(&bar[XB_XCNT(j)]); sum += c; cnt += (c > 0u) ? 1u : 0u; mine = (j == x) ? c : mine; }
        if (sum == G) break;
        __builtin_amdgcn_s_sleep(1);
        if ((++sp & 255u) == 0u) { if (xb_ld(&bar[XB_TMO])) break; if (sp > XB_SPIN_CAP) { atomicAdd(&bar[XB_TMO], 1u); break; } }
    }
    nloc = mine > 0u ? mine : 1u; nx = cnt > 0u ? cnt : 1u;
}

__device__ __forceinline__ void xcd_barrier(const XcdBarrier& b) {
    asm volatile("s_waitcnt vmcnt(0)" ::: "memory");
    __syncthreads();
    if (threadIdx.x == 0) {
        unsigned* bar = b.bar;
        __builtin_amdgcn_s_waitcnt(0);
        unsigned nloc = b.st[0], nx = b.st[1];
        if (nloc == 0u) { xcd_barrier_complete(bar, b.x, nloc, nx); b.st[0] = nloc; b.st[1] = nx; }
        const unsigned old = xb_add(&bar[XB_XSUB(b.x)], 1u);
        const unsigned gen = old / nloc;
        if (old + 1u == (gen + 1u) * nloc) {
            __builtin_amdgcn_fence(__ATOMIC_RELEASE, "agent");
            asm volatile("s_waitcnt vmcnt(0)" ::: "memory");
            const unsigned og = xb_add(&bar[XB_TOP], 1u);
            const unsigned tg = og / nx;
            __builtin_amdgcn_fence(__ATOMIC_ACQUIRE, "agent");
            if (og + 1u == (tg + 1u) * nx) xb_add(&bar[XB_TOPGEN], 1u);
            else XB_SPIN(xb_ld(&bar[XB_TOPGEN]) == tg, bar);
            xb_add(&bar[XB_XGEN(b.x)], 1u);
            asm volatile("s_waitcnt vmcnt(0)" ::: "memory");
        } else {
            __builtin_amdgcn_fence(__ATOMIC_ACQUIRE, "agent");
            XB_SPIN(xb_ld(&bar[XB_XGEN(b.x)]) == gen, bar);
            asm volatile("s_waitcnt vmcnt(0)" ::: "memory");
        }
    }
    __syncthreads();
}

struct EpiAny {
    static constexpr bool AFTER_DRAIN = false;
    int mode; bool PERM; int l;
    __device__ __forceinline__ void operator()(const f32x4 (&acc)[2][2][4][2], const pg8::Unit& u, int wr, int wc, int fr, int fq) const {
        CKP* kp = (CKP*)__builtin_amdgcn_kernarg_segment_ptr(); asm volatile("" : "+s"(kp)); CKP& p = *kp;
        unsigned char* ws = p.ws;
        const float* mod = (const float*)(ws + WS_MOD) + (size_t)l * 5 * 6144;
        float* SSQ = (float*)(ws + WS_CTL + 262144);
        bf16* Hb = (bf16*)(ws + WS_H); bf16* XB = (bf16*)(ws + WS_XB);
        if (mode == 7) {
#pragma unroll
            for (int a = 0; a < 2; ++a)
#pragma unroll
                for (int b = 0; b < 2; ++b)
#pragma unroll
                    for (int m = 0; m < 4; ++m)
#pragma unroll
                        for (int n = 0; n < 2; ++n) asm volatile("" :: "v"(acc[a][b][m][n]));
            return; }
        if (mode == 0) { const pg8::EpiBf<0> e{(bf16*)(ws + WS_PROJ), DINP}; e(acc, u, wr, wc, fr, fq); }
        else if (mode == 2) { const pg8::EpiResFinal e{XB, mod + 5 * 1024, p.in[I_FNG], p.out, SSQ + 49152, (unsigned*)(ws + WS_CTL + 524288) + 64 * 16}; e(acc, u, wr, wc, fr, fq); }
        else if (mode == 3) { const pg8::EpiFnet e{(bf16*)(ws + WS_MIXED), 0, 256}; e(acc, u, wr, wc, fr, fq); }
        else if (mode == 8) { const pg8::EpiFnet e{(bf16*)(ws + WS_MIXED), NCTX, 1024}; e(acc, u, wr, wc, fr, fq); }
        else if (mode == 4) { const pg8::EpiNormBf<0> e{(bf16*)(ws + WS_PROJ), DINP, SSQ + 16384, (const float*)(ws + WS_SWIN), DINP}; e(acc, u, wr, wc, fr, fq); }
        else if (mode == 5) { const pg8::EpiNormBf<1> e{(bf16*)(ws + WS_FF), DFF, SSQ + l * 32768, (const float*)(ws + WS_SW1) + (size_t)l * 5 * DFF, DFF}; e(acc, u, wr, wc, fr, fq); }
        else if (mode == 6) {
            if (l == 0) { const pg8::EpiResNorm<true, true> e{XB, mod + 2 * 1024, p.in[I_XP], p.in[I_XS], Hb, p.in[I_N2G], mod + 4 * 1024, SSQ}; e(acc, u, wr, wc, fr, fq); }
            else { const pg8::EpiResNorm<false, true> e{XB, mod + 2 * 1024, nullptr, nullptr, Hb, p.in[I_N2G] + DM, mod + 4 * 1024, SSQ + 32768}; e(acc, u, wr, wc, fr, fq); } }
        else { const pg8::EpiResNorm<false, true> e{XB, mod + 5 * 1024, nullptr, nullptr, Hb, p.in[I_N1G] + DM, mod + 5 * 6144 + 1 * 1024, SSQ + 16384}; e(acc, u, wr, wc, fr, fq); }
    }
};

constexpr int N_STEPS = 16;
__device__ __forceinline__ bool step_seam(int st) { return st < 15; }
__global__ void __launch_bounds__(NTHR, 2) mega_fwd(KP p_unused) {
    extern __shared__ __attribute__((aligned(16))) unsigned char lds_raw[];
    CKP* kp0 = (CKP*)__builtin_amdgcn_kernarg_segment_ptr();
    { LAS unsigned* ctlw = (LAS unsigned*)((LAS unsigned char*)lds_raw + RING_BYTES);
      for (int u = threadIdx.x; u < (LDS_BYTES - RING_BYTES) / 4; u += NTHR) ctlw[u] = 0u; }
    __syncthreads();
    const XcdBarrier bar = xcd_barrier_post((unsigned*)(kp0->ws + WS_CTL) + 4096, (volatile LAS unsigned*)((LAS unsigned char*)lds_raw + MISC_OFF + 32));
    const int ph_lo = kp0->ph_lo, ph_hi = kp0->ph_hi;
#pragma unroll 1
#ifdef REP_A
    for (int sti = ph_lo; sti < ph_hi + ((REP_B) >= 0 ? 2 : 1); ++sti) {
        const int st = sti <= (REP_A) ? sti : (((REP_B) < 0 || sti <= (REP_B) + 1) ? sti - 1 : sti - 2);
        const bool isdup = sti == (REP_A) || ((REP_B) >= 0 && sti == (REP_B) + 1); (void)isdup;
#else
    for (int st = ph_lo; st < ph_hi; ++st) {
#endif
        CKP* kp = kp0; asm volatile("" : "+s"(kp));
        CKP& p = *kp; unsigned char* ws = p.ws;
        int bid = blockIdx.x, nb = gridDim.x; unsigned ldsb = (unsigned)(size_t)(LAS unsigned char*)lds_raw;
        asm volatile("" : "+s"(bid), "+s"(nb), "+s"(ldsb));
        LAS unsigned char* lds = (LAS unsigned char*)(size_t)ldsb;
        const int l = st < 9 ? 0 : 1, s = st == 0 ? -1 : (st == 1 ? 0 : ((st - 2) % 7 + 1));
        const float* mod = (const float*)(ws + WS_MOD) + (size_t)l * 5 * 6144;
#pragma unroll 1
        for (int job = 0; job < 2; ++job) {
            pg8::Gemm g{nullptr, nullptr, 0, 0, 0, 0, 0}; EpiAny E{-1, true, 0}; int corder = bid;
            if (job == 0) {
                if (s == 1) { g = pg8::Gemm{(const bf16*)(ws + WS_H), (const bf16*)(ws + WS_WIN) + (size_t)l * DINP * DM, MTOK, DINP, DM, DM, DM}; E = EpiAny{l == 0 ? 0 : 4, true, l}; }
                else if (s == 3) { g = pg8::Gemm{(const bf16*)(ws + WS_CS256), (const bf16*)(ws + WS_YCS), 256, 8192, 512, 512, 512}; E = EpiAny{3, true, l}; corder = (bid + nb - (nb >= 256 ? 192 : 0)) % nb; }
                else if (s == 5) { g = pg8::Gemm{(const bf16*)(ws + WS_MIXED), (const bf16*)(ws + WS_WOUT) + (size_t)l * DM * DM, MTOK, DM, DM, DM, DM}; E = EpiAny{6, true, l}; }
                else if (s == 6) { g = pg8::Gemm{(const bf16*)(ws + WS_H), (const bf16*)(ws + WS_W1) + (size_t)l * DFF * DM, MTOK, DFF, DM, DM, DM}; E = EpiAny{5, true, l}; }
                else if (s == 7) { g = pg8::Gemm{(const bf16*)(ws + WS_FF), (const bf16*)(ws + WS_W2) + (size_t)l * DM * DFF, MTOK, DM, DFF, DFF, DFF}; E = l == 0 ? EpiAny{9, true, l} : EpiAny{2, true, l}; }
            } else if (s == 3) { g = pg8::Gemm{(const bf16*)(ws + WS_CS1024), (const bf16*)(ws + WS_YCS) + (size_t)8192 * 512, 1024, 1024, 2048, 2048, 2048}; E = EpiAny{8, true, l}; corder = (bid + nb - (nb >= 256 ? 224 : 32)) % nb; }
#ifdef NOEPI_FIRST
            if (isdup && E.mode >= 0) E.mode = 7;
#endif
            if (E.mode >= 0) {
                pg8::StaticOrder S; S.init(g.M, g.N, nb, corder);
                pg8::gemm_phase<EpiAny, pg8::StaticOrder, true, true>(lds, g, S, E);
                __syncthreads();
            }
        }
        if (s == 3) {
            if (nb >= 256) {
                if (bid < 64) rwkv_item3(p, l, lds, bid);
                else { unsigned* ctr = (unsigned*)(ws + WS_CTL + 524288) + 64 * (2 + l); volatile LAS unsigned* slot = (volatile LAS unsigned*)(lds + RING_BYTES + 64);
#pragma unroll 1
                    for (;;) { __syncthreads(); if (threadIdx.x == 0) *slot = atomicAdd(ctr, 1u); __syncthreads(); const int it = (int)*slot; if (it >= 512) break; rwkv_item3(p, l, lds, 64 + it); } }
            } else for (int it = bid; it < 576; it += nb) rwkv_item3(p, l, lds, it);
            side_queue(p, l, lds);
        }
        if (s == -1) stage_prologue(p, lds, bid, nb);
        else if (s == 0) { stage_norm(p, 0, 0, bid, nb); stage_tables(p, bid, nb); }
        else if (s == 2) {
            stage_upass(p, l, bid, nb);
#ifdef DUP_U
            stage_upass(p, l, bid, nb);
#endif
#pragma unroll 1
            for (int it = bid; it < 768; it += nb) fnet1_item(p, l, it);
#ifdef DUP_F
#pragma unroll 1
            for (int it = bid; it < 768; it += nb) fnet1_item(p, l, it);
#endif
#pragma unroll 1
            for (int it = bid; it < 768; it += nb) pool_item(p, l, lds, it);
#ifdef DUP_P
#pragma unroll 1
            for (int it = bid; it < 768; it += nb) pool_item(p, l, lds, it);
#endif
        }
        else if (s == 4) stage_post(p, l, bid, nb);
        #ifdef REP_A
        if (sti + 1 < ph_hi + ((REP_B) >= 0 ? 2 : 1)) xcd_barrier(bar);
#else
        if (st + 1 < ph_hi && step_seam(st)) xcd_barrier(bar);
#endif
    }
}

extern "C" void kernel_launch(void* const* d_in, const int* in_sizes, int n_in, void* d_out, int out_size, void* d_ws, size_t ws_size, hipStream_t stream) {
    static int grid = 0;
    if (grid == 0) {
        if (n_in != N_IN || ws_size < WS_END) { fprintf(stderr, "kernel_launch: unexpected inputs (n_in %d, ws %zu)\n", n_in, ws_size); grid = -1; return; }
        int dev = 0, cus = 0, per_cu = 0;
        (void)hipGetDevice(&dev); (void)hipDeviceGetAttribute(&cus, hipDeviceAttributeMultiprocessorCount, dev);
        (void)hipFuncSetAttribute((const void*)mega_fwd, hipFuncAttributeMaxDynamicSharedMemorySize, LDS_BYTES);
        if (hipOccupancyMaxActiveBlocksPerMultiprocessor(&per_cu, (const void*)mega_fwd, NTHR, LDS_BYTES) != hipSuccess || per_cu < 1) {
            fprintf(stderr, "kernel_launch: occupancy query reports %d blocks/CU\n", per_cu); (void)hipGetLastError(); grid = -1; return; }
        grid = cus * 1;
    }
    if (grid < 0) return;
    KP a{};
    for (int i = 0; i < N_IN; ++i) a.in[i] = (const float*)d_in[i];
    a.out = (float*)d_out; a.ws = (unsigned char*)d_ws; a.ph_lo = 0; a.ph_hi = N_STEPS;
    if (hipMemsetAsync((char*)d_ws + WS_CTL, 0, 1 * MiB, stream) != hipSuccess) { fprintf(stderr, "kernel_launch: memset failed\n"); return; }
    void* args[] = {&a};
    hipError_t e = hipLaunchCooperativeKernel((const void*)mega_fwd, dim3(grid), dim3(NTHR), args, LDS_BYTES, stream);
    if (e != hipSuccess) fprintf(stderr, "cooperative launch failed: %s (grid %d)\n", hipGetErrorString(e), grid);
}
```

```cpp
#include <hip/hip_runtime.h>
#include <hip/hip_cooperative_groups.h>
#include <cstdio>
#include <cstdint>
namespace cg = cooperative_groups;
__device__ __forceinline__ int opaque_tid() { int t = threadIdx.x; asm volatile("" : "+v"(t)); return t; }
namespace pg8 {
#define PG8_LAS __attribute__((address_space(3)))
typedef unsigned short bf16_t;
typedef short bf16x8 __attribute__((ext_vector_type(8)));
typedef float f32x4 __attribute__((ext_vector_type(4)));
typedef unsigned u32x4 __attribute__((ext_vector_type(4)));
constexpr int BM = 256, BK = 64, HALF = 128, HTB = HALF * BK * 2  , STAGE_BYTES = 8 * HTB, NXCD = 8, WGM = 8;

__host__ __device__ __forceinline__ int lds_byte(int r, int c) { const int st = (r >> 4) * 2 + (c >> 5), rr = r & 15, cc = c & 31, ob = rr * 64 + cc * 2; return st * 1024 + (ob ^ (((ob >> 9) & 1) << 5)); }
__host__ __device__ __forceinline__ void stage_rc(int b, int& R, int& C) { const int st = b / 1024, sb = b % 1024, swz = sb ^ (((sb >> 9) & 1) << 5); R = (st >> 1) * 16 + swz / 64; C = (st & 1) * 32 + (swz % 64) / 2; }
__host__ __device__ __forceinline__ int perm32(int rho) { const int n = rho >> 4, i = rho & 15; return 8 * (i >> 2) + 4 * n + (i & 3); }

struct Unit { int pm, pn; };
struct Gemm { const bf16_t* A; const bf16_t* Bt; int M, N, K, lda, ldb; };

struct StaticOrder {
    int nM, nN, nwg, G, c;
    __host__ __device__ void init(int M, int N, int G_, int c_) { nM = M / BM; nN = N / BM; nwg = nM * nN; G = G_; c = c_; }
    __host__ __device__ bool next(int i, Unit& u) const {
        const long L = (long)i * G + c; if (L >= nwg) return false;
        int wgid = (int)L; { const int q = nwg / NXCD, r = nwg % NXCD, xcd = wgid % NXCD, off = wgid / NXCD; wgid = (xcd < r ? xcd * (q + 1) : r * (q + 1) + (xcd - r) * q) + off; }
        const int nig = WGM * nN, gid = wgid / nig, fm = gid * WGM, gsz = (nM - fm) < WGM ? (nM - fm) : WGM;
        u.pm = fm + ((wgid % nig) % gsz); u.pn = (wgid % nig) / gsz; return true;
    }
    __device__ __forceinline__ void a_ready(const Unit&) const {}
    __device__ __forceinline__ void done(const Unit&) const {}
};

__device__ __forceinline__ unsigned cvt_pk_bf16(float lo, float hi) { unsigned r; asm volatile("v_cvt_pk_bf16_f32 %0, %1, %2" : "=v"(r) : "v"(lo), "v"(hi)); return r; }
typedef unsigned u32x2 __attribute__((ext_vector_type(2)));
template <int ACT  > struct EpiBf {
    static constexpr bool PERM = true, AFTER_DRAIN = false;
    bf16_t* O; int ldc;
    __device__ __forceinline__ void operator()(const f32x4 (&acc)[2][2][4][2], const Unit& u, int wr, int wc, int fr, int fq) const {
        const int row0 = u.pm * BM + wr * 64 + fr, col0 = u.pn * BM + wc * 32 + 8 * fq;
#pragma unroll
        for (int ai = 0; ai < 2; ++ai)
#pragma unroll
            for (int m = 0; m < 4; ++m) { bf16_t* rowp = O + (size_t)(row0 + ai * HALF + m * 16) * ldc + col0;
#pragma unroll
                for (int bj = 0; bj < 2; ++bj) { f32x4 v0 = acc[ai][bj][m][0], v1 = acc[ai][bj][m][1];
                    if (ACT == 1) {
#pragma unroll
                        for (int e = 0; e < 4; ++e) { float a = v0[e] > 0.f ? v0[e] : 0.f; v0[e] = a * a; float b = v1[e] > 0.f ? v1[e] : 0.f; v1[e] = b * b; } }
                    u32x4 w; w.x = cvt_pk_bf16(v0[0], v0[1]); w.y = cvt_pk_bf16(v0[2], v0[3]); w.z = cvt_pk_bf16(v1[0], v1[1]); w.w = cvt_pk_bf16(v1[2], v1[3]);
                    *(u32x4*)(rowp + bj * HALF) = w; } }
    }
};
struct EpiRes {
    static constexpr bool PERM = false, AFTER_DRAIN = false;
    float* X; const float* gate; const float* Xc; const float* Xl;
    __device__ __forceinline__ void operator()(const f32x4 (&acc)[2][2][4][2], const Unit& u, int wr, int wc, int fr, int fq) const {
        const int row0 = u.pm * BM + wr * 64 + fr, col0 = u.pn * BM + wc * 32 + 4 * fq;
        const int cond = u.pm < 32 ? 0 : 1 + ((u.pm - 32) >> 2);
        const float* gp = gate + cond * 6144 + col0;
        f32x4 gv[2][2];
#pragma unroll
        for (int bj = 0; bj < 2; ++bj)
#pragma unroll
            for (int n = 0; n < 2; ++n) gv[bj][n] = *(const f32x4*)(gp + bj * HALF + n * 16);
#pragma unroll
        for (int ai = 0; ai < 2; ++ai)
#pragma unroll
            for (int m = 0; m < 4; ++m) { const size_t ro = (size_t)(row0 + ai * HALF + m * 16) * 1024 + col0; float* rowp = X + ro; const float* srcp = u.pm < 32 ? Xc + ro : Xl + (ro - (size_t)8192 * 1024);
#pragma unroll
                for (int bj = 0; bj < 2; ++bj)
#pragma unroll
                    for (int n = 0; n < 2; ++n) { *(f32x4*)(rowp + bj * HALF + n * 16) = *(const f32x4*)(srcp + bj * HALF + n * 16) + gv[bj][n] * acc[ai][bj][m][n]; }
                if (m & 1) asm volatile("" ::: "memory"); }
    }
};
struct EpiFnet {
    static constexpr bool PERM = true, AFTER_DRAIN = false;
    bf16_t* MIX; int rowbase, L;
    __device__ __forceinline__ void operator()(const f32x4 (&acc)[2][2][4][2], const Unit& u, int wr, int wc, int fr, int fq) const {
        const int row0 = u.pm * BM + wr * 64 + fr, colw = wc * 32 + 8 * fq;
        bf16_t* base = MIX + (size_t)(rowbase + u.pn * L) * 1024 + 512 + colw;
#pragma unroll
        for (int ai = 0; ai < 2; ++ai)
#pragma unroll
            for (int m = 0; m < 4; ++m) { bf16_t* rowp = base + (size_t)(row0 + ai * HALF + m * 16) * 1024;
#pragma unroll
                for (int bj = 0; bj < 2; ++bj) { const f32x4 v0 = acc[ai][bj][m][0], v1 = acc[ai][bj][m][1];
                    u32x4 w; w.x = cvt_pk_bf16(v0[0], v0[1]); w.y = cvt_pk_bf16(v0[2], v0[3]); w.z = cvt_pk_bf16(v1[0], v1[1]); w.w = cvt_pk_bf16(v1[2], v1[3]);
                    *(u32x4*)(rowp + bj * HALF) = w; } }
    }
};

__device__ __forceinline__ float xsum_fq(float s, int fr, int fq) {
    s += __builtin_bit_cast(float, __builtin_amdgcn_ds_bpermute((((fq ^ 1) << 4) | fr) << 2, __builtin_bit_cast(int, s)));
    s += __builtin_bit_cast(float, __builtin_amdgcn_ds_bpermute((((fq ^ 2) << 4) | fr) << 2, __builtin_bit_cast(int, s)));
    return s;
}
template <int ACT> struct EpiNormBf {
    static constexpr bool PERM = true, AFTER_DRAIN = false;
    bf16_t* O; int ldc; const float* ssq; const float* sw; int swld;
    __device__ __forceinline__ void operator()(const f32x4 (&acc)[2][2][4][2], const Unit& u, int wr, int wc, int fr, int fq) const {
        const int row0 = u.pm * BM + wr * 64 + fr, col0 = u.pn * BM + wc * 32 + 8 * fq;
        const int cond = u.pm < 32 ? 0 : 1 + ((u.pm - 32) >> 2);
        f32x4 sv[2][2];
#pragma unroll
        for (int bj = 0; bj < 2; ++bj)
#pragma unroll
            for (int n = 0; n < 2; ++n) sv[bj][n] = *(const f32x4*)(sw + (size_t)cond * swld + col0 + bj * HALF + 4 * n);
        float rs[2][4];
#pragma unroll
        for (int ai = 0; ai < 2; ++ai)
#pragma unroll
            for (int m = 0; m < 4; ++m) rs[ai][m] = ssq[row0 + ai * HALF + m * 16];
#pragma unroll
        for (int ai = 0; ai < 2; ++ai)
#pragma unroll
            for (int m = 0; m < 4; ++m) rs[ai][m] = __builtin_amdgcn_rsqf(rs[ai][m] * (1.0f / 1024.0f) + 1e-6f);
#pragma unroll
        for (int ai = 0; ai < 2; ++ai)
#pragma unroll
            for (int m = 0; m < 4; ++m) { const int row = row0 + ai * HALF + m * 16; bf16_t* rowp = O + (size_t)row * ldc + col0;
                const float rstd = rs[ai][m];
#pragma unroll
                for (int bj = 0; bj < 2; ++bj) { f32x4 v0 = acc[ai][bj][m][0] * rstd + sv[bj][0], v1 = acc[ai][bj][m][1] * rstd + sv[bj][1];
                    if (ACT == 1) {
#pragma unroll
                        for (int e = 0; e < 4; ++e) { float a = v0[e] > 0.f ? v0[e] : 0.f; v0[e] = a * a; float b = v1[e] > 0.f ? v1[e] : 0.f; v1[e] = b * b; } }
                    u32x4 w; w.x = cvt_pk_bf16(v0[0], v0[1]); w.y = cvt_pk_bf16(v0[2], v0[3]); w.z = cvt_pk_bf16(v1[0], v1[1]); w.w = cvt_pk_bf16(v1[2], v1[3]);
                    *(u32x4*)(rowp + bj * HALF) = w; }
                if (m & 1) asm volatile("" ::: "memory"); }
    }
};
struct EpiResFinal {
    static constexpr bool PERM = true, AFTER_DRAIN = false;
    const bf16_t* XB; const float* gate; const float* gfin; float* out; float* ssq; unsigned* cnt;
    __device__ __forceinline__ void operator()(const f32x4 (&acc)[2][2][4][2], const Unit& u, int wr, int wc, int fr, int fq) const {
        const int row0 = u.pm * BM + wr * 64 + fr, col0 = u.pn * BM + wc * 32 + 8 * fq;
        const int cond = u.pm < 32 ? 0 : 1 + ((u.pm - 32) >> 2);
        f32x4 gt[2][2];
#pragma unroll
        for (int bj = 0; bj < 2; ++bj)
#pragma unroll
            for (int n = 0; n < 2; ++n) gt[bj][n] = *(const f32x4*)(gate + cond * 6144 + col0 + bj * HALF + n * 4);
#pragma unroll
        for (int ai = 0; ai < 2; ++ai) {
            u32x4 xb[4][2];
#pragma unroll
            for (int m = 0; m < 4; ++m)
#pragma unroll
                for (int bj = 0; bj < 2; ++bj) xb[m][bj] = *(const u32x4*)(XB + (unsigned)(row0 + ai * HALF + m * 16) * 1024u + (unsigned)col0 + bj * HALF);
#pragma unroll
            for (int m = 0; m < 4; ++m) { const int row = row0 + ai * HALF + m * 16;
                float sq = 0.f;
#pragma unroll
                for (int bj = 0; bj < 2; ++bj) { const u32x4 xw = xb[m][bj];
                    f32x4 x0 = (f32x4){__builtin_bit_cast(float, xw.x << 16), __builtin_bit_cast(float, xw.x & 0xffff0000u), __builtin_bit_cast(float, xw.y << 16), __builtin_bit_cast(float, xw.y & 0xffff0000u)};
                    f32x4 x1 = (f32x4){__builtin_bit_cast(float, xw.z << 16), __builtin_bit_cast(float, xw.z & 0xffff0000u), __builtin_bit_cast(float, xw.w << 16), __builtin_bit_cast(float, xw.w & 0xffff0000u)};
                    x0 += gt[bj][0] * acc[ai][bj][m][0]; x1 += gt[bj][1] * acc[ai][bj][m][1];
                    sq += ((x0[0] * x0[0] + x0[1] * x0[1]) + (x0[2] * x0[2] + x0[3] * x0[3])) + ((x1[0] * x1[0] + x1[1] * x1[1]) + (x1[2] * x1[2] + x1[3] * x1[3])); }
                const float t = xsum_fq(sq, fr, fq); if (fq == 0) atomicAdd(ssq + row, t); }
            asm volatile("" ::: "memory"); }
        asm volatile("s_waitcnt vmcnt(0)" ::: "memory");
        unsigned* c = cnt + 64 * u.pm;
        if (fr == 0 && fq == 0) { __hip_atomic_fetch_add(c, 1u, __ATOMIC_RELAXED, __HIP_MEMORY_SCOPE_AGENT);
            for (unsigned spin = 0; __hip_atomic_load(c, __ATOMIC_RELAXED, __HIP_MEMORY_SCOPE_AGENT) < 32u && spin < (1u << 22); ++spin) __builtin_amdgcn_s_sleep(2); }
        asm volatile("" ::: "memory");
        f32x4 gv[2][2];
#pragma unroll
        for (int bj = 0; bj < 2; ++bj)
#pragma unroll
            for (int n = 0; n < 2; ++n) gv[bj][n] = *(const f32x4*)(gfin + col0 + bj * HALF + n * 4);
#pragma unroll
        for (int ai = 0; ai < 2; ++ai) {
            u32x4 xb[4][2]; float rs[4];
#pragma unroll
            for (int m = 0; m < 4; ++m) { rs[m] = __hip_atomic_load(ssq + row0 + ai * HALF + m * 16, __ATOMIC_RELAXED, __HIP_MEMORY_SCOPE_AGENT);
#pragma unroll
                for (int bj = 0; bj < 2; ++bj) xb[m][bj] = *(const u32x4*)(XB + (unsigned)(row0 + ai * HALF + m * 16) * 1024u + (unsigned)col0 + bj * HALF); }
#pragma unroll
            for (int m = 0; m < 4; ++m) { const unsigned ro = (unsigned)(row0 + ai * HALF + m * 16) * 1024u + (unsigned)col0;
                const float rstd = __builtin_amdgcn_rsqf(rs[m] * (1.0f / 1024.0f) + 1e-6f);
#pragma unroll
                for (int bj = 0; bj < 2; ++bj) { const u32x4 xw = xb[m][bj];
                    f32x4 x0 = (f32x4){__builtin_bit_cast(float, xw.x << 16), __builtin_bit_cast(float, xw.x & 0xffff0000u), __builtin_bit_cast(float, xw.y << 16), __builtin_bit_cast(float, xw.y & 0xffff0000u)};
                    f32x4 x1 = (f32x4){__builtin_bit_cast(float, xw.z << 16), __builtin_bit_cast(float, xw.z & 0xffff0000u), __builtin_bit_cast(float, xw.w << 16), __builtin_bit_cast(float, xw.w & 0xffff0000u)};
                    f32x4 ga = gt[bj][0], gb = gt[bj][1]; asm volatile("" : "+v"(ga), "+v"(gb));
                    x0 += ga * acc[ai][bj][m][0]; x1 += gb * acc[ai][bj][m][1];
                    *(f32x4*)(out + ro + bj * HALF) = x0 * rstd * gv[bj][0]; *(f32x4*)(out + ro + bj * HALF + 4) = x1 * rstd * gv[bj][1]; } }
            asm volatile("" ::: "memory"); }
    }
};
template <bool SRC_F32, bool WRITE_H> struct EpiResNorm {
    static constexpr bool PERM = true, AFTER_DRAIN = false;
    bf16_t* XB; const float* gate; const float* Xc; const float* Xl; bf16_t* H; const float* gn; const float* scl; float* ssq;
    __device__ __forceinline__ void operator()(const f32x4 (&acc)[2][2][4][2], const Unit& u, int wr, int wc, int fr, int fq) const {
        const int row0 = u.pm * BM + wr * 64 + fr, col0 = u.pn * BM + wc * 32 + 8 * fq;
        const int cond = u.pm < 32 ? 0 : 1 + ((u.pm - 32) >> 2);
        const float* src = u.pm < 32 ? Xc : Xl - (size_t)8192 * 1024;
        f32x4 gt[2][2], gs[2][2];
#pragma unroll
        for (int bj = 0; bj < 2; ++bj)
#pragma unroll
            for (int n = 0; n < 2; ++n) { const int col = col0 + bj * HALF + n * 4;
                gt[bj][n] = *(const f32x4*)(gate + cond * 6144 + col);
                if (WRITE_H) gs[bj][n] = *(const f32x4*)(gn + col) * (*(const f32x4*)(scl + cond * 6144 + col) + 1.0f); }
        constexpr int NB = SRC_F32 ? 2 : 4;
#pragma unroll
        for (int ai = 0; ai < 2; ++ai)
#pragma unroll
        for (int mb = 0; mb < 4; mb += NB) {
            u32x4 xb[NB][2]; f32x4 xf[NB][2][2];
#pragma unroll
            for (int mm = 0; mm < NB; ++mm) { const unsigned ro = (unsigned)(row0 + ai * HALF + (mb + mm) * 16) * 1024u + (unsigned)col0;
#pragma unroll
                for (int bj = 0; bj < 2; ++bj) {
                    if (SRC_F32) { xf[mm][bj][0] = *(const f32x4*)(src + ro + bj * HALF); xf[mm][bj][1] = *(const f32x4*)(src + ro + bj * HALF + 4); }
                    else xb[mm][bj] = *(const u32x4*)(XB + ro + bj * HALF); } }
#pragma unroll
            for (int mm = 0; mm < NB; ++mm) { const int m = mb + mm; const int row = row0 + ai * HALF + m * 16; const unsigned ro = (unsigned)row * 1024u + (unsigned)col0;
                float sq = 0.f;
#pragma unroll
                for (int bj = 0; bj < 2; ++bj) { const unsigned o = ro + bj * HALF;
                    f32x4 x0, x1;
                    if (SRC_F32) { x0 = xf[mm][bj][0]; x1 = xf[mm][bj][1]; }
                    else { const u32x4 xw = xb[mm][bj];
                        x0 = (f32x4){__builtin_bit_cast(float, xw.x << 16), __builtin_bit_cast(float, xw.x & 0xffff0000u), __builtin_bit_cast(float, xw.y << 16), __builtin_bit_cast(float, xw.y & 0xffff0000u)};
                        x1 = (f32x4){__builtin_bit_cast(float, xw.z << 16), __builtin_bit_cast(float, xw.z & 0xffff0000u), __builtin_bit_cast(float, xw.w << 16), __builtin_bit_cast(float, xw.w & 0xffff0000u)}; }
                    x0 += gt[bj][0] * acc[ai][bj][m][0]; x1 += gt[bj][1] * acc[ai][bj][m][1];
                    u32x4 xo; xo.x = cvt_pk_bf16(x0[0], x0[1]); xo.y = cvt_pk_bf16(x0[2], x0[3]); xo.z = cvt_pk_bf16(x1[0], x1[1]); xo.w = cvt_pk_bf16(x1[2], x1[3]);
                    *(u32x4*)(XB + o) = xo;
                    sq += ((x0[0] * x0[0] + x0[1] * x0[1]) + (x0[2] * x0[2] + x0[3] * x0[3])) + ((x1[0] * x1[0] + x1[1] * x1[1]) + (x1[2] * x1[2] + x1[3] * x1[3]));
                    if (WRITE_H) { const f32x4 h0 = x0 * gs[bj][0], h1 = x1 * gs[bj][1];
                        u32x4 w; w.x = cvt_pk_bf16(h0[0], h0[1]); w.y = cvt_pk_bf16(h0[2], h0[3]); w.z = cvt_pk_bf16(h1[0], h1[1]); w.w = cvt_pk_bf16(h1[2], h1[3]);
                        *(u32x4*)(H + o) = w; } }
                const float t = xsum_fq(sq, fr, fq); if (fq == 0) atomicAdd(ssq + row, t);
            }
            asm volatile("" ::: "memory"); }
    }
};
template <class Epi, class Sched, bool ALIGN_EPI = false, bool SP2 = false>
__device__ __forceinline__ void gemm_phase(PG8_LAS unsigned char* lds, const Gemm g, const Sched& S, const Epi& E) {
    const int tid = opaque_tid(), wid = __builtin_amdgcn_readfirstlane(tid >> 6), lane = tid & 63, wr = wid >> 2, wc = wid & 3, fr = lane & 15, fq = lane >> 4;
    const int K = g.K, nt = K / BK;
    unsigned voffA[2], voffB[2];
#pragma unroll
    for (int i = 0; i < 2; ++i) { int R, C; stage_rc(tid * 16 + i * 8192, R, C); const int Rb = E.PERM ? ((R & ~31) + perm32(R & 31)) : R;
        voffA[i] = (unsigned)(R * g.lda + C) * 2u; voffB[i] = (unsigned)(Rb * g.ldb + C) * 2u; }
    const size_t kstep = (size_t)(BK * 2);
    const size_t hstepA = (size_t)HALF * g.lda * 2, hstepB = (size_t)HALF * g.ldb * 2;
    const size_t tstepA = 2 * hstepA, tstepB = 2 * hstepB;
    const unsigned ldsw = (unsigned)wid * 1024u;
    const int aoff = lds_byte(wr * 64 + fr, fq * 8), boff = lds_byte(wc * 32 + fr, fq * 8);
#define PG8_SA(b, h) (((b) * 2 + (h)) * HTB)
#define PG8_SB(b, h) ((4 + (b) * 2 + (h)) * HTB)
#define PG8_STAGE(bufoff, gbase, voff) do { _Pragma("unroll") for (int _i = 0; _i < 2; ++_i) \
        __builtin_amdgcn_global_load_lds((const unsigned*)((const char*)(gbase) + (voff)[_i]), (PG8_LAS unsigned*)(lds + (bufoff) + ldsw + _i * 8192), 16, 0, 0); } while (0)
#define PG8_LDA(dst, b, h) do { _Pragma("unroll") for (int m = 0; m < 4; ++m) _Pragma("unroll") for (int k = 0; k < 2; ++k) dst[m][k] = *(const PG8_LAS bf16x8*)(lds + PG8_SA(b, h) + aoff + m * 2048 + k * 1024); } while (0)
#define PG8_LDB(dst, b, h) do { _Pragma("unroll") for (int n = 0; n < 2; ++n) _Pragma("unroll") for (int k = 0; k < 2; ++k) dst[n][k] = *(const PG8_LAS bf16x8*)(lds + PG8_SB(b, h) + boff + n * 2048 + k * 1024); } while (0)
#define PG8_MMA(ai, bj, At, Bt) do { __builtin_amdgcn_s_setprio(1); _Pragma("unroll") for (int m = 0; m < 4; ++m) _Pragma("unroll") for (int n = 0; n < 2; ++n) _Pragma("unroll") for (int k = 0; k < 2; ++k) \
        acc[ai][bj][m][n] = __builtin_amdgcn_mfma_f32_16x16x32_bf16(Bt[n][k], At[m][k], acc[ai][bj][m][n], 0, 0, 0); __builtin_amdgcn_s_setprio(0); } while (0)
#define PG8_WAIT_V(n) asm volatile("s_waitcnt vmcnt(" #n ")" ::: "memory")
#define PG8_WAIT_L(n) asm volatile("s_waitcnt lgkmcnt(" #n ")" ::: "memory")
#define PG8_BAR __builtin_amdgcn_s_barrier()
#define PG8_SCHED __builtin_amdgcn_sched_barrier(0)
    Unit cur, nxt; int ui = 0;
    if (!S.next(0, cur)) return;
    f32x4 acc[2][2][4][2];
#pragma unroll
    for (int a = 0; a < 2; ++a)
#pragma unroll
        for (int b = 0; b < 2; ++b)
#pragma unroll
            for (int m = 0; m < 4; ++m)
#pragma unroll
                for (int n = 0; n < 2; ++n) acc[a][b][m][n] = (f32x4){0.f, 0.f, 0.f, 0.f};
    bf16x8 At[4][2], B0[2][2], B1[2][2];
    const char* cA = (const char*)g.A + (size_t)cur.pm * tstepA; const char* cB = (const char*)g.Bt + (size_t)cur.pn * tstepB;
    S.a_ready(cur);
    if constexpr (SP2) {
        PG8_STAGE(PG8_SB(0, 0), cB, voffB); PG8_STAGE(PG8_SB(0, 1), cB + hstepB, voffB); PG8_STAGE(PG8_SA(0, 0), cA, voffA); PG8_STAGE(PG8_SA(0, 1), cA + hstepA, voffA);
        if (wr == 1) PG8_BAR;
        PG8_WAIT_V(2); PG8_BAR;
        PG8_STAGE(PG8_SB(1, 0), cB + kstep, voffB); PG8_STAGE(PG8_SA(1, 0), cA + kstep, voffA); PG8_STAGE(PG8_SB(1, 1), cB + hstepB + kstep, voffB);
        PG8_WAIT_V(6); PG8_BAR;
    } else {
        PG8_STAGE(PG8_SB(0, 0), cB, voffB); PG8_STAGE(PG8_SA(0, 0), cA, voffA); PG8_STAGE(PG8_SB(0, 1), cB + hstepB, voffB); PG8_STAGE(PG8_SA(0, 1), cA + hstepA, voffA);
        if (wr == 1) PG8_BAR;
        PG8_WAIT_V(4); PG8_BAR;
        PG8_STAGE(PG8_SB(1, 0), cB + kstep, voffB); PG8_STAGE(PG8_SA(1, 0), cA + kstep, voffA); PG8_STAGE(PG8_SB(1, 1), cB + hstepB + kstep, voffB);
        PG8_WAIT_V(6); PG8_BAR;
    }
    for (;;) {
        const bool has_next = S.next(ui + 1, nxt);
        const char* nA = has_next ? (const char*)g.A + (size_t)nxt.pm * tstepA : cA; const char* nB = has_next ? (const char*)g.Bt + (size_t)nxt.pn * tstepB : cB;
        for (int t = 0; t < nt; t += 2) {
            const bool last = (t == nt - 2);
            const char* a1 = cA + (size_t)(t + 1) * kstep;
            const char* a2 = last ? nA : cA + (size_t)(t + 2) * kstep; const char* b2 = last ? nB : cB + (size_t)(t + 2) * kstep;
            const char* a3 = a2 + kstep; const char* b3 = b2 + kstep;
            if (last && has_next) S.a_ready(nxt);
            if constexpr (SP2) {
            PG8_LDB(B0, 0, 0); PG8_LDB(B1, 0, 1); PG8_SCHED; PG8_LDA(At, 0, 0); PG8_STAGE(PG8_SA(1, 1), a1 + hstepA, voffA);
            PG8_WAIT_V(8); PG8_WAIT_L(0); PG8_BAR; PG8_MMA(0, 0, At, B0); PG8_MMA(0, 1, At, B1); PG8_BAR; PG8_SCHED;
            PG8_LDA(At, 0, 1); PG8_STAGE(PG8_SB(0, 0), b2, voffB); PG8_STAGE(PG8_SB(0, 1), b2 + hstepB, voffB); PG8_STAGE(PG8_SA(0, 0), a2, voffA);
            PG8_WAIT_V(8); PG8_WAIT_L(0); PG8_BAR; PG8_MMA(1, 0, At, B0); PG8_MMA(1, 1, At, B1); PG8_BAR; PG8_SCHED;
            PG8_LDB(B0, 1, 0); PG8_LDB(B1, 1, 1); PG8_SCHED; PG8_LDA(At, 1, 0); PG8_STAGE(PG8_SA(0, 1), a2 + hstepA, voffA);
            PG8_WAIT_V(8); PG8_WAIT_L(0); PG8_BAR; PG8_MMA(0, 0, At, B0); PG8_MMA(0, 1, At, B1); PG8_BAR; PG8_SCHED;
            PG8_LDA(At, 1, 1); PG8_STAGE(PG8_SB(1, 0), b3, voffB); PG8_STAGE(PG8_SB(1, 1), b3 + hstepB, voffB); PG8_STAGE(PG8_SA(1, 0), a3, voffA);
            PG8_WAIT_V(8); PG8_WAIT_L(0); PG8_BAR; PG8_MMA(1, 0, At, B0); PG8_MMA(1, 1, At, B1); PG8_BAR; PG8_SCHED;
            } else {
            PG8_LDB(B0, 0, 0); PG8_SCHED; PG8_LDA(At, 0, 0); PG8_STAGE(PG8_SA(1, 1), a1 + hstepA, voffA);
            PG8_WAIT_L(8); PG8_BAR; PG8_WAIT_L(0); PG8_MMA(0, 0, At, B0); PG8_BAR; PG8_SCHED;
            PG8_LDB(B1, 0, 1); PG8_STAGE(PG8_SB(0, 0), b2, voffB);
            PG8_BAR; PG8_WAIT_L(0); PG8_MMA(0, 1, At, B1); PG8_BAR;
            PG8_LDA(At, 0, 1); PG8_STAGE(PG8_SA(0, 0), a2, voffA);
            PG8_BAR; PG8_WAIT_L(0); PG8_MMA(1, 0, At, B0); PG8_BAR; PG8_SCHED;
            PG8_STAGE(PG8_SB(0, 1), b2 + hstepB, voffB);
            PG8_WAIT_V(6); PG8_BAR; PG8_MMA(1, 1, At, B1); PG8_BAR;
            PG8_LDB(B0, 1, 0); PG8_SCHED; PG8_LDA(At, 1, 0); PG8_STAGE(PG8_SA(0, 1), a2 + hstepA, voffA);
            PG8_WAIT_L(8); PG8_BAR; PG8_WAIT_L(0); PG8_MMA(0, 0, At, B0); PG8_BAR; PG8_SCHED;
            PG8_LDB(B1, 1, 1); PG8_STAGE(PG8_SB(1, 0), b3, voffB);
            PG8_BAR; PG8_WAIT_L(0); PG8_MMA(0, 1, At, B1); PG8_BAR;
            PG8_LDA(At, 1, 1); PG8_STAGE(PG8_SA(1, 0), a3, voffA);
            PG8_BAR; PG8_WAIT_L(0); PG8_MMA(1, 0, At, B0); PG8_BAR; PG8_SCHED;
            PG8_STAGE(PG8_SB(1, 1), b3 + hstepB, voffB);
            PG8_WAIT_V(6); PG8_BAR; PG8_MMA(1, 1, At, B1); PG8_BAR;
            }
        }
        if constexpr (ALIGN_EPI) { if (wr == 0) PG8_BAR; }
        if constexpr (!Epi::AFTER_DRAIN) { int fr2 = fr, fq2 = fq; asm volatile("" : "+v"(fr2), "+v"(fq2)); E(acc, cur, wr, wc, fr2, fq2); S.done(cur); }
        if (!has_next) break;
#pragma unroll
        for (int a = 0; a < 2; ++a)
#pragma unroll
            for (int b = 0; b < 2; ++b)
#pragma unroll
                for (int m = 0; m < 4; ++m)
#pragma unroll
                    for (int n = 0; n < 2; ++n) acc[a][b][m][n] = (f32x4){0.f, 0.f, 0.f, 0.f};
        cur = nxt; cA = nA; cB = nB; ++ui;
        if constexpr (ALIGN_EPI) { if (wr == 1) PG8_BAR; }
    }
    PG8_WAIT_V(0);
    if constexpr (!ALIGN_EPI) { if (wr == 0) PG8_BAR; }
    PG8_BAR;
    if constexpr (Epi::AFTER_DRAIN) { E.fused(acc, cur, wr, wc, fr, fq, lds, wid, lane); S.done(cur); }
#undef PG8_SA
#undef PG8_SB
#undef PG8_STAGE
#undef PG8_LDA
#undef PG8_LDB
#undef PG8_MMA
#undef PG8_WAIT_V
#undef PG8_WAIT_L
#undef PG8_BAR
#undef PG8_SCHED
}
}

#define LAS __attribute__((address_space(3)))
typedef unsigned short bf16;
typedef float f32x4 __attribute__((ext_vector_type(4)));
typedef unsigned u32x4 __attribute__((ext_vector_type(4)));
typedef unsigned u32x2 __attribute__((ext_vector_type(2)));
constexpr int DM = 1024, NCTX = 8192, MTOK = 12288, DINP = 2560, DFF = 4096;
constexpr int R_OFF = 0, K_OFF = 512, V_OFF = 1024, WD_OFF = 1536, AD_OFF = 1664, GD_OFF = 1792, F_OFF = 1920, P_OFF = 2176, DIN = 2432;
constexpr size_t MiB = 1u << 20;
constexpr size_t WS_CTL = 0, WS_MOD = 1 * MiB, WS_FW = 1 * MiB + 512 * 1024, WS_BC = 2 * MiB, WS_CS256 = 3 * MiB, WS_CS1024 = 4 * MiB, WS_WIN = 8 * MiB, WS_WOUT = 18 * MiB,
                 WS_W1 = 22 * MiB, WS_W2 = 38 * MiB, WS_H = 54 * MiB, WS_MIXED = 78 * MiB, WS_PROJ = 102 * MiB, WS_YCS = 162 * MiB, WS_YF = 102 * MiB, WS_YB = 126 * MiB  , WS_U = 174 * MiB, WS_KINV = 220 * MiB, WS_GUPT = 221 * MiB,
                 WS_FF = 102 * MiB, WS_WUPT = 222 * MiB, WS_AUPT = 222 * MiB + 256 * 1024, WS_SSQ = 223 * MiB, WS_WPT = 223 * MiB + 512 * 1024, WS_SW1 = 224 * MiB, WS_SWIN = 224 * MiB + 256 * 1024, WS_XB = 226 * MiB, WS_END = 250 * MiB;
constexpr int LDS_BYTES = 147456, RING_BYTES = 131072, MISC_OFF = RING_BYTES + 320;
constexpr int NTHR = 512;
enum { I_XP = 0, I_XS, I_STATE, I_C, I_CCTX, I_WADA, I_BADA, I_N1G, I_WIN, I_MU, I_W0, I_WUP, I_A0, I_AUP, I_GUP, I_KK, I_KA, I_RK, I_LNW, I_LNB, I_WFNET, I_WPOOL, I_PSCALE, I_WOUT, I_N2G, I_WFF1, I_WFF2, I_FNG, N_IN };
struct KP { const float* in[N_IN]; float* out; unsigned char* ws; int ph_lo, ph_hi; };
typedef const __attribute__((address_space(4))) KP CKP;

__device__ __forceinline__ unsigned f2bf(float f) { unsigned u = __builtin_bit_cast(unsigned, f); return (u + 0x7fffu + ((u >> 16) & 1u)) >> 16; }
__device__ __forceinline__ unsigned pk2(float lo, float hi) { return f2bf(lo) | (f2bf(hi) << 16); }
__device__ __forceinline__ float bflo(unsigned w) { return __builtin_bit_cast(float, w << 16); }
__device__ __forceinline__ float bfhi(unsigned w) { return __builtin_bit_cast(float, w & 0xffff0000u); }
__device__ __forceinline__ float bf1(bf16 h) { return __builtin_bit_cast(float, (unsigned)h << 16); }
__device__ __forceinline__ float fexp(float x) { return __builtin_amdgcn_exp2f(x * 1.4426950408889634f); }
__device__ __forceinline__ float flog(float x) { return __builtin_amdgcn_logf(x) * 0.6931471805599453f; }
__device__ __forceinline__ float frcp(float x) { return __builtin_amdgcn_rcpf(x); }
__device__ __forceinline__ float frsq(float x) { return __builtin_amdgcn_rsqf(x); }
__device__ __forceinline__ float fsigmoid(float x) { return frcp(1.0f + fexp(-x)); }
template <int CTRL> __device__ __forceinline__ float dppf(float x) { return __builtin_bit_cast(float, __builtin_amdgcn_update_dpp(0, __builtin_bit_cast(int, x), CTRL, 0xF, 0xF, true)); }
__device__ __forceinline__ float red8(float x)  { x += dppf<0xB1>(x); x += dppf<0x4E>(x); x += dppf<0x141>(x); return x; }
__device__ __forceinline__ float red16(float x) { x += dppf<0xB1>(x); x += dppf<0x4E>(x); x += dppf<0x141>(x); x += dppf<0x140>(x); return x; }
__device__ __forceinline__ float wave_sum(float v) {
    v = red16(v);
    const float s0 = __builtin_bit_cast(float, __builtin_amdgcn_readlane(__builtin_bit_cast(int, v), 0)), s1 = __builtin_bit_cast(float, __builtin_amdgcn_readlane(__builtin_bit_cast(int, v), 16));
    const float s2 = __builtin_bit_cast(float, __builtin_amdgcn_readlane(__builtin_bit_cast(int, v), 32)), s3 = __builtin_bit_cast(float, __builtin_amdgcn_readlane(__builtin_bit_cast(int, v), 48));
    return (s0 + s1) + (s2 + s3);
}
__device__ __forceinline__ void load4bf(const bf16* p, float (&o)[4]) { const u32x2 w = *(const u32x2*)p; o[0] = bflo(w.x); o[1] = bfhi(w.x); o[2] = bflo(w.y); o[3] = bfhi(w.y); }
__device__ __forceinline__ void load8bf(const bf16* p, float (&o)[8]) { const u32x4 w = *(const u32x4*)p; o[0] = bflo(w.x); o[1] = bfhi(w.x); o[2] = bflo(w.y); o[3] = bfhi(w.y); o[4] = bflo(w.z); o[5] = bfhi(w.z); o[6] = bflo(w.w); o[7] = bfhi(w.w); }
__device__ __forceinline__ void shift4(const bf16* proj, int row, bool hasp, bool hasn, int col, const float* mu, float (&u)[4]) {
    float p[4], a[4] = {0.f, 0.f, 0.f, 0.f}, b[4] = {0.f, 0.f, 0.f, 0.f};
    load4bf(proj + (size_t)row * DINP + col, p);
    if (hasp) load4bf(proj + (size_t)(row - 1) * DINP + col, a);
    if (hasn) load4bf(proj + (size_t)(row + 1) * DINP + col, b);
    const f32x4 m = *(const f32x4*)(mu + col);
#pragma unroll
    for (int j = 0; j < 4; ++j) u[j] = p[j] + m[j] * (0.5f * (a[j] + b[j]) - p[j]);
}

__device__ __forceinline__ void transpose_item(const float* W, int K, int N, bf16* WT, LAS float* scr, int item, int lane) {
    const int nblk = N / 32, kb = item / nblk, nb = item % nblk, k0 = 64 * kb, n0 = 32 * nb;
    float tv[32];
#pragma unroll
    for (int i = 0; i < 32; ++i) tv[i] = W[(size_t)(k0 + 2 * i + (lane >> 5)) * N + n0 + (lane & 31)];
#pragma unroll
    for (int i = 0; i < 32; ++i) scr[(2 * i + (lane >> 5)) * 33 + (lane & 31)] = tv[i];
    asm volatile("s_waitcnt lgkmcnt(0)" ::: "memory");
    const int c = lane & 7;
#pragma unroll
    for (int j = 0; j < 4; ++j) { const int n = (lane >> 3) + 8 * j; const LAS float* s = scr + (8 * c) * 33 + n;
        u32x4 o; o.x = pk2(s[0 * 33], s[1 * 33]); o.y = pk2(s[2 * 33], s[3 * 33]); o.z = pk2(s[4 * 33], s[5 * 33]); o.w = pk2(s[6 * 33], s[7 * 33]);
        *(u32x4*)(WT + (size_t)(n0 + n) * K + k0 + 8 * c) = o; }
    asm volatile("s_waitcnt lgkmcnt(0)" ::: "memory");
}
__device__ __forceinline__ void gemv5_cols(LAS float* sc, LAS float* red, const float* W, int ldw, int colw, const float* bias, float* out, int ldo, int colo, int tid) {
    const int cgi = tid & 15, kg = tid >> 4;
    f32x4 acc[5];
#pragma unroll
    for (int c = 0; c < 5; ++c) acc[c] = (f32x4){0.f, 0.f, 0.f, 0.f};
    const float* wp = W + (size_t)(kg * 32) * ldw + colw + cgi * 4;
#pragma unroll 16
    for (int kk = 0; kk < 32; ++kk) { const f32x4 w = *(const f32x4*)(wp + (size_t)kk * ldw);
#pragma unroll
        for (int c = 0; c < 5; ++c) acc[c] += sc[c * 1024 + kg * 32 + kk] * w; }
#pragma unroll
    for (int c = 0; c < 5; ++c) *(LAS f32x4*)(red + (kg * 5 + c) * 64 + cgi * 4) = acc[c];
    __syncthreads();
    if (tid < 320) { const int cond = tid >> 6, col = tid & 63; float sm = bias ? bias[colo + col] : 0.f;
        for (int g = 0; g < 32; ++g) sm += red[(g * 5 + cond) * 64 + col];
        out[(size_t)cond * ldo + colo + col] = sm; }
    __syncthreads();
}
__device__ __forceinline__ void mod_item(CKP& p, LAS unsigned char* lds, int it) {
    const int tid = opaque_tid(); unsigned char* ws = p.ws;
    LAS float* sc = (LAS float*)lds; LAS float* red = (LAS float*)(lds + 20480);
    const int l = it / 96, cgp = it % 96;
    for (int i = tid; i < 5 * 1024; i += NTHR) { const int cond = i >> 10, k = i & 1023; const float v = cond == 0 ? p.in[I_CCTX][k] : p.in[I_C][(cond - 1) * 1024 + k]; sc[i] = v * fsigmoid(v); }
    __syncthreads();
    gemv5_cols(sc, red, p.in[I_WADA] + (size_t)l * 1024 * 6144, 6144, cgp * 64, p.in[I_BADA] + l * 6144, (float*)(ws + WS_MOD) + (size_t)l * 5 * 6144, 6144, cgp * 64, tid);
}
constexpr int TI_IN = 16 * 76, TI_OUT = 16 * 32, TI_1 = 16 * 128, TI_2 = 64 * 32, TI_L = TI_IN + TI_OUT + TI_1 + TI_2;
__device__ __forceinline__ void transpose_range(CKP& p, LAS unsigned char* lds, int first, int last, int bid, int nb) {
    const int tid = opaque_tid(), lane = tid & 63, wave = tid >> 6;
    unsigned char* ws = p.ws;
    LAS float* scr = (LAS float*)(lds + wave * 16384);
#pragma unroll 1
    for (int it = first + bid * 8 + wave; it < last; it += nb * 8) {
        const int l = it / TI_L; int r = it % TI_L;
        if (r < TI_IN) { transpose_item(p.in[I_WIN] + (size_t)l * DM * DIN, DM, DIN, (bf16*)(ws + WS_WIN) + (size_t)l * DINP * DM, scr, r, lane); continue; } r -= TI_IN;
        if (r < TI_OUT) { transpose_item(p.in[I_WOUT] + (size_t)l * DM * DM, DM, DM, (bf16*)(ws + WS_WOUT) + (size_t)l * DM * DM, scr, r, lane); continue; } r -= TI_OUT;
        if (r < TI_1) { transpose_item(p.in[I_WFF1] + (size_t)l * DM * DFF, DM, DFF, (bf16*)(ws + WS_W1) + (size_t)l * DFF * DM, scr, r, lane); continue; } r -= TI_1;
        transpose_item(p.in[I_WFF2] + (size_t)l * DFF * DM, DFF, DM, (bf16*)(ws + WS_W2) + (size_t)l * DM * DFF, scr, r, lane);
    }
}
__device__ __forceinline__ void stage_prologue(CKP& p, LAS unsigned char* lds, int bid, int nb) {
    const int tid = opaque_tid();
    unsigned char* ws = p.ws;
    transpose_range(p, lds, 0, TI_IN, bid, nb);
    const int gt = bid * NTHR + tid, NGT = nb * NTHR;
#pragma unroll 1
    for (int i = gt; i < 2 * 128 * DM / 8; i += NGT) { const int l = i / (128 * DM / 8), r = i % (128 * DM / 8);
        u32x4 z = (u32x4){0u, 0u, 0u, 0u}; asm volatile("" : "+v"(z));
        *(u32x4*)((bf16*)(ws + WS_WIN) + (size_t)l * DINP * DM + (size_t)DIN * DM + (size_t)r * 8) = z; }
    __syncthreads();
#pragma unroll 1
    for (int it = bid; it < 192; it += nb) mod_item(p, lds, it);
}
__device__ __forceinline__ void stage_tables(CKP& p, int bid, int nb) {
    const int tid = opaque_tid(); unsigned char* ws = p.ws;
    const int gt = bid * NTHR + tid, NGT = nb * NTHR;
#pragma unroll 1
    for (int i = gt; i < 256 * 512 + 1024 * 2048; i += NGT) {
        int L, k, j; bf16* dst;
        if (i < 256 * 512) { L = 256; k = i / 512; j = i % 512; dst = (bf16*)(ws + WS_CS256) + i; }
        else { const int i2 = i - 256 * 512; L = 1024; k = i2 / 2048; j = i2 % 2048; dst = (bf16*)(ws + WS_CS1024) + i2; }
        const int jj = j >= L ? j - L : j; const int idx = (k * jj) & (L - 1);
        const float rev = (float)idx * (L == 256 ? (1.0f / 256.0f) : (1.0f / 1024.0f));
        *dst = (bf16)f2bf(j >= L ? -__builtin_amdgcn_sinf(rev) : __builtin_amdgcn_cosf(rev));
    }
#pragma unroll 1
    for (int i = gt; i < 2 * 4 * 64 * 128; i += NGT) {
        const int o = i & 127, c = (i >> 7) & 63, lg = i >> 13; const float* wf = p.in[I_WFNET] + (size_t)lg * 4096 + (o & 63);
        float acc = 0.f;
        if (o < 64) { for (int cp = 0; cp < 64; ++cp) acc += __builtin_amdgcn_cosf((float)((c * cp) & 63) * (1.0f / 64.0f)) * wf[cp * 64]; }
        else { for (int cp = 0; cp < 64; ++cp) acc += __builtin_amdgcn_sinf((float)((c * cp) & 63) * (1.0f / 64.0f)) * wf[cp * 64]; }
        ((bf16*)(ws + WS_FW))[(size_t)(lg * 128 + o) * 64 + c] = (bf16)f2bf(acc);
    }
#pragma unroll 1
    for (int i = gt; i < 2 * 4 * 64 * 64; i += NGT) { const int o = i & 63, c = (i >> 6) & 63, lg = i >> 12;
        ((bf16*)(ws + WS_WPT))[(size_t)(lg * 64 + o) * 64 + c] = (bf16)f2bf(p.in[I_WPOOL][i]); }
#pragma unroll 1
    for (int i = gt; i < 2 * 2 * 64 * 512; i += NGT) { const int c = i & 511, r = (i >> 9) & 63, ld = i >> 15;
        ((bf16*)(ws + WS_WUPT))[(size_t)(ld * 512 + c) * 64 + r] = (bf16)f2bf(p.in[I_WUP][i]);
        ((bf16*)(ws + WS_AUPT))[(size_t)(ld * 512 + c) * 64 + r] = (bf16)f2bf(p.in[I_AUP][i]); }
#pragma unroll 1
    for (int i = gt; i < 2 * 128 * 512; i += NGT) { const int c = i & 511, r = (i >> 9) & 127, ll = i >> 16;
        ((bf16*)(ws + WS_GUPT))[(size_t)(ll * 512 + c) * 128 + r] = (bf16)f2bf(p.in[I_GUP][i]); }
}
__device__ __forceinline__ void shiftw_item(CKP& p, LAS unsigned char* lds, int it) {
    const int tid = opaque_tid();
    unsigned char* ws = p.ws;
    LAS float* sc = (LAS float*)lds; LAS float* red = (LAS float*)(lds + 20480);
    const bool isin = it >= 128; const int l = isin ? 1 : it >> 6, blk = isin ? it - 128 : it & 63;
    const float* shv = (const float*)(ws + WS_MOD) + (size_t)l * 5 * 6144 + (isin ? 0 : 3 * 1024);
    for (int i = tid; i < 5 * 1024; i += NTHR) sc[i] = shv[(i >> 10) * 6144 + (i & 1023)];
    __syncthreads();
    if (isin) gemv5_cols(sc, red, p.in[I_WIN] + (size_t)DM * DIN, DIN, blk * 64, nullptr, (float*)(ws + WS_SWIN), DINP, blk * 64, tid);
    else gemv5_cols(sc, red, p.in[I_WFF1] + (size_t)l * DM * DFF, DFF, blk * 64, nullptr, (float*)(ws + WS_SW1) + (size_t)l * 5 * DFF, DFF, blk * 64, tid);
    if (it == 165) for (int i = tid; i < 5 * 128; i += NTHR) ((float*)(ws + WS_SWIN))[(i >> 7) * DINP + DIN + (i & 127)] = 0.f;
}
__device__ __forceinline__ void side_queue(CKP& p, int l, LAS unsigned char* lds) {
    const int tid = opaque_tid();
    unsigned* ctr = (unsigned*)(p.ws + WS_CTL + 524288) + 64 * l;
    volatile LAS unsigned* slot = (volatile LAS unsigned*)(lds + RING_BYTES + 64);
    const int nmd = 0, nsh = l == 0 ? 166 : 0, first = l == 0 ? TI_IN : TI_L + TI_IN, nch = ((l == 0 ? TI_L + TI_IN : 2 * TI_L) - first) / 8;
    __syncthreads();
#pragma unroll 1
    for (;;) {
        if (tid == 0) *slot = atomicAdd(ctr, 1u);
        __syncthreads();
        const int it = (int)*slot;
        __syncthreads();
        if (it >= nmd + nsh + nch) break;
        if (it < nmd) mod_item(p, lds, 96 + it);
        else if (it < nmd + nsh) shiftw_item(p, lds, it - nmd);
        else { const int c0 = first + 8 * (it - nmd - nsh); transpose_range(p, lds, c0, c0 + 8, 0, 1); }
        __syncthreads();
    }
}

__device__ __forceinline__ void stage_norm(CKP& p, int l, int which, int bid, int nb) {
    const int tid = opaque_tid(), lane = tid & 63, wave = tid >> 6;
    const float* g = p.in[which ? I_N2G : I_N1G] + l * DM;
    const float* mod = (const float*)(p.ws + WS_MOD) + (size_t)l * 5 * 6144 + (which ? 3 * 1024 : 0);
    bf16* H = (bf16*)(p.ws + WS_H);
#pragma unroll 1
    for (int row0 = bid * 8 + wave; row0 < MTOK; row0 += nb * 16) {
        f32x4 v[2][4]; float s[2];
#pragma unroll
        for (int z = 0; z < 2; ++z) { const int row = min(row0 + z * nb * 8, MTOK - 1);
            const float* xsrc = (l == 0 && which == 0) ? (row < NCTX ? p.in[I_XP] + (size_t)row * DM : p.in[I_XS] + (size_t)(row - NCTX) * DM) : p.out + (size_t)row * DM;
            const f32x4* xr = (const f32x4*)xsrc + lane;
#pragma unroll
            for (int j = 0; j < 4; ++j) v[z][j] = xr[64 * j]; }
#pragma unroll
        for (int z = 0; z < 2; ++z) { const int row = row0 + z * nb * 8;
            s[z] = 0.f;
#pragma unroll
            for (int j = 0; j < 4; ++j) s[z] += (v[z][j].x * v[z][j].x + v[z][j].y * v[z][j].y) + (v[z][j].z * v[z][j].z + v[z][j].w * v[z][j].w);
            const float rstd = frsq(wave_sum(s[z]) * (1.0f / DM) + 1e-6f);
            if (row < MTOK) {
                const int cond = row < NCTX ? 0 : 1 + ((row - NCTX) >> 10);
                const float* sh = mod + cond * 6144; const float* scl = sh + 1024;
                unsigned long long* o8 = (unsigned long long*)(H + (size_t)row * DM) + lane;
#pragma unroll
                for (int j = 0; j < 4; ++j) { const int col = 4 * lane + 256 * j; const f32x4 gg = *(const f32x4*)(g + col), a = *(const f32x4*)(sh + col), b = *(const f32x4*)(scl + col);
                    const f32x4 y = v[z][j] * rstd * gg * (b + 1.0f) + a;
                    o8[64 * j] = (unsigned long long)pk2(y.x, y.y) | ((unsigned long long)pk2(y.z, y.w) << 32); } } }
    }
}
__device__ __forceinline__ void stage_final(CKP& p, int bid, int nb) {
    const int tid = opaque_tid(), lane = tid & 63, wave = tid >> 6;
    const float* g = p.in[I_FNG];
    const bf16* XB = (const bf16*)(p.ws + WS_XB); const float* ssq = (const float*)(p.ws + WS_CTL + 262144) + 49152;
    const f32x4 g0 = *(const f32x4*)(g + 8 * lane), g1 = *(const f32x4*)(g + 8 * lane + 4), g2 = *(const f32x4*)(g + 512 + 8 * lane), g3 = *(const f32x4*)(g + 512 + 8 * lane + 4);
#pragma unroll 1
    for (int row = bid * 8 + wave; row < MTOK; row += nb * 8) {
        const float rstd = frsq(ssq[row] * (1.0f / DM) + 1e-6f);
        const u32x4 a = *(const u32x4*)(XB + (size_t)row * DM + 8 * lane), b = *(const u32x4*)(XB + (size_t)row * DM + 512 + 8 * lane);
        float* o = p.out + (size_t)row * DM + 8 * lane;
        *(f32x4*)o = (f32x4){bflo(a.x), bfhi(a.x), bflo(a.y), bfhi(a.y)} * rstd * g0; *(f32x4*)(o + 4) = (f32x4){bflo(a.z), bfhi(a.z), bflo(a.w), bfhi(a.w)} * rstd * g1;
        *(f32x4*)(o + 512) = (f32x4){bflo(b.x), bfhi(b.x), bflo(b.y), bfhi(b.y)} * rstd * g2; *(f32x4*)(o + 516) = (f32x4){bflo(b.z), bfhi(b.z), bflo(b.w), bfhi(b.w)} * rstd * g3;
    }
}


typedef short bf16x8 __attribute__((ext_vector_type(8)));
typedef float f32x2v __attribute__((ext_vector_type(2)));
typedef __bf16 bf16x2v __attribute__((ext_vector_type(2)));
#define MFMA16(a, b, c) __builtin_amdgcn_mfma_f32_16x16x32_bf16((a), (b), (c), 0, 0, 0)
__device__ __forceinline__ unsigned cvt2(float lo, float hi) { f32x2v v = {lo, hi}; bf16x2v b = __builtin_convertvector(v, bf16x2v); return __builtin_bit_cast(unsigned, b); }
__device__ __forceinline__ u32x4 pack8(const float (&x)[8]) { u32x4 w; w.x = cvt2(x[0], x[1]); w.y = cvt2(x[2], x[3]); w.z = cvt2(x[4], x[5]); w.w = cvt2(x[6], x[7]); return w; }
__device__ __forceinline__ void shift8(const bf16* proj, int row, bool hasp, bool hasn, int col, const float* mu, float (&u)[8]) {
    float p[8], a[8], b[8];
    load8bf(proj + (size_t)row * DINP + col, p);
    if (hasp) load8bf(proj + (size_t)(row - 1) * DINP + col, a); else {
#pragma unroll
        for (int j = 0; j < 8; ++j) a[j] = 0.f; }
    if (hasn) load8bf(proj + (size_t)(row + 1) * DINP + col, b); else {
#pragma unroll
        for (int j = 0; j < 8; ++j) b[j] = 0.f; }
    const f32x4 m0 = *(const f32x4*)(mu + col), m1 = *(const f32x4*)(mu + col + 4);
#pragma unroll
    for (int j = 0; j < 4; ++j) { u[j] = p[j] + m0[j] * (0.5f * (a[j] + b[j]) - p[j]); u[4 + j] = p[4 + j] + m1[j] * (0.5f * (a[4 + j] + b[4 + j]) - p[4 + j]); }
}
__device__ __forceinline__ int opq(int x) { asm volatile("" : "+v"(x)); return x; }
constexpr int TS = 72, TB = 64 * TS * 2;
constexpr int L_HT = 0, L_TW = 9216, L_AD = 18432, L_LP = 27648, L_AP = 45056, L_AT = 62464, L_RT = L_AT + TB, L_BH = L_RT + TB, L_KH = L_BH + TB, L_VR = L_KH + TB, L_YS = L_VR + TB;
constexpr int L_AAB = L_TW, L_AAK = L_AAB + 4096, L_ARB = L_AAK + 3072, L_ARK = L_ARB + 3072, L_UT = L_ARK + 3072, L_W1 = L_AP;
static_assert(L_UT + 64 * 24 * 2 <= L_LP && L_YS + 17408 <= RING_BYTES, "scan LDS map");
constexpr int LPS = 68;
#define LBAR() asm volatile("s_waitcnt lgkmcnt(0)\n\ts_barrier" ::: "memory")
typedef short s16x4v __attribute__((ext_vector_type(4)));
__device__ __forceinline__ bf16x8 tr8(const LAS bf16* p) {
    const s16x4v lo = __builtin_bit_cast(s16x4v, __builtin_amdgcn_ds_read_tr16_b64_v4i16((LAS s16x4v*)p));
    const s16x4v hi = __builtin_bit_cast(s16x4v, __builtin_amdgcn_ds_read_tr16_b64_v4i16((LAS s16x4v*)(p + 4 * TS)));
    return (bf16x8){lo[0], lo[1], lo[2], lo[3], hi[0], hi[1], hi[2], hi[3]};
}

__device__ __forceinline__ void rwkv_item3(CKP& p, int l, LAS unsigned char* lds, int item) {
    const int tid0 = opaque_tid(), w = __builtin_amdgcn_readfirstlane(tid0 >> 6);
    int tid = tid0, fr = tid & 15, fg = (tid & 63) >> 4;
    int bseq, h, dir, L, base; bool lat;
    if (item < 64) { lat = true; bseq = item >> 4; h = (item >> 1) & 7; dir = item & 1; L = 1024; base = NCTX + bseq * 1024; }
    else { const int i2 = item - 64; lat = false; bseq = i2 >> 4; h = (i2 >> 1) & 7; dir = i2 & 1; L = 256; base = bseq * 256; }
    const bf16* U = (const bf16*)(p.ws + WS_U);
    const float* KINV = (const float*)(p.ws + WS_KINV);
    bf16* Yout = (bf16*)(p.ws + (dir ? WS_YB : WS_YF));
    float* BC = (float*)(p.ws + WS_BC) + (size_t)dir * MTOK * 8;
    const bf16* wupt = (const bf16*)(p.ws + WS_WUPT) + ((size_t)(l * 2 + dir) * 512 + h * 64) * 64;
    const bf16* aupt = (const bf16*)(p.ws + WS_AUPT) + ((size_t)(l * 2 + dir) * 512 + h * 64) * 64;

    LAS float* LP = (LAS float*)(lds + L_LP); LAS float* AP = (LAS float*)(lds + L_AP); LAS float* AS = (LAS float*)(lds + L_TW);
    LAS bf16* AT = (LAS bf16*)(lds + L_AT);   LAS bf16* RT = (LAS bf16*)(lds + L_RT);   LAS bf16* BH = (LAS bf16*)(lds + L_BH);   LAS bf16* KH = (LAS bf16*)(lds + L_KH);
    LAS bf16* VR = (LAS bf16*)(lds + L_VR);   LAS float* YS = (LAS float*)(lds + L_YS);
    LAS float* AAB = (LAS float*)(lds + L_AAB); LAS bf16* AAK = (LAS bf16*)(lds + L_AAK); LAS bf16* ARB = (LAS bf16*)(lds + L_ARB); LAS bf16* ARK = (LAS bf16*)(lds + L_ARK); LAS bf16* AAK1 = (LAS bf16*)(lds + L_UT);
    LAS float* W1 = (LAS float*)(lds + L_W1);
    const int tv = w & 3;
    f32x4 hacc[4];
#pragma unroll
    for (int x = 0; x < 4; ++x) {
        if (lat && w < 4) hacc[x] = *(const f32x4*)(p.in[I_STATE] + ((((size_t)bseq * 2 + l) * 2 + dir) * 8 + h) * 4096 + (16 * tv + fr) * 64 + 16 * x + 4 * fg);
        else hacc[x] = (f32x4){0.f, 0.f, 0.f, 0.f}; }
    int ei = tid >> 3, ec8 = (tid & 7) * 8; const int hc8 = h * 64 + ec8;
    float kkp[8], kap[8], rkp[8];
#pragma unroll
    for (int e = 0; e < 8; ++e) { kkp[e] = p.in[I_KK][l * 512 + hc8 + e]; kap[e] = p.in[I_KA][l * 512 + hc8 + e]; rkp[e] = p.in[I_RK][l * 512 + hc8 + e]; }
#define SCAN_PREFETCH(SC) do { const int _t0 = opq(tid0), _ei = _t0 >> 3, _ec8 = (_t0 & 7) * 8; const int _step = (SC) * 64 + _ei, _t = dir ? L - 1 - _step : _step; \
        const bf16* _u = U + (size_t)(base + _t) * 1920; \
        nr = *(const u32x4*)(_u + R_OFF + h * 64 + _ec8); nk = *(const u32x4*)(_u + K_OFF + h * 64 + _ec8); nv = *(const u32x4*)(_u + V_OFF + h * 64 + _ec8); \
        ninv = KINV[(size_t)(base + _t) * 8 + h]; \
        const int _st2 = (SC) * 64 + 16 * (w >> 1) + (_t0 & 15), _t2 = dir ? L - 1 - _st2 : _st2; const bf16* _u2 = U + (size_t)(base + _t2) * 1920 + dir * 64 + ((_t0 & 63) >> 4) * 8; \
        paw0 = *(const bf16x8*)(_u2 + WD_OFF); paw1 = *(const bf16x8*)(_u2 + WD_OFF + 32); paa0 = *(const bf16x8*)(_u2 + AD_OFF); paa1 = *(const bf16x8*)(_u2 + AD_OFF + 32); } while (0)
    bf16x8 lbw[2][2], lba[2][2]; float lw0c[2], la0c[2];
#pragma unroll
    for (int x = 0; x < 2; ++x) { const int c = ((w & 1) * 2 + x) * 16 + fr;
        lbw[x][0] = *(const bf16x8*)(wupt + c * 64 + fg * 8); lbw[x][1] = *(const bf16x8*)(wupt + c * 64 + 32 + fg * 8);
        lba[x][0] = *(const bf16x8*)(aupt + c * 64 + fg * 8); lba[x][1] = *(const bf16x8*)(aupt + c * 64 + 32 + fg * 8);
        lw0c[x] = p.in[I_W0][(l * 2 + dir) * 512 + h * 64 + c]; la0c[x] = p.in[I_A0][(l * 2 + dir) * 512 + h * 64 + c]; }
    u32x4 nr, nk, nv; float ninv; bf16x8 paw0, paw1, paa0, paa1;
    SCAN_PREFETCH(0);
    __syncthreads();
#pragma unroll 1
    for (int sc = 0; sc < L / 64; ++sc) {
        tid = opq(tid0); fr = tid & 15; fg = (tid & 63) >> 4; ei = tid >> 3; ec8 = (tid & 7) * 8;
        const u32x4 cr = nr, ck = nk, cv = nv; const float kinv = ninv;
        { const int ti = w >> 1;
          const bf16x8 aw0 = paw0, aw1 = paw1, aa0 = paa0, aa1 = paa1;
          unsigned li[2];
#pragma unroll
          for (int pr = 0; pr < 2; ++pr) { const int j0 = 4 * fg + 2 * pr, j1 = j0 + 1; li[pr] = (j0 <= fr ? 0x3f80u : 0u) | (j1 <= fr ? 0x3f800000u : 0u); }
          const bf16x8 Li = __builtin_bit_cast(bf16x8, (u32x4){li[0], li[1], 0u, 0u});
#pragma unroll
          for (int x = 0; x < 2; ++x) { const int c = ((w & 1) * 2 + x) * 16 + fr;
              f32x4 cw = (f32x4){lw0c[x], lw0c[x], lw0c[x], lw0c[x]}, ca = (f32x4){la0c[x], la0c[x], la0c[x], la0c[x]};
              cw = MFMA16(aw0, lbw[x][0], cw); cw = MFMA16(aw1, lbw[x][1], cw); ca = MFMA16(aa0, lba[x][0], ca); ca = MFMA16(aa1, lba[x][1], ca);
              float lw[4], lo[4];
#pragma unroll
              for (int r = 0; r < 4; ++r) lw[r] = -0.6065306597126334f * fsigmoid(cw[r]);
              const unsigned h01 = cvt2(lw[0], lw[1]), h23 = cvt2(lw[2], lw[3]);
              lo[0] = lw[0] - bflo(h01); lo[1] = lw[1] - bfhi(h01); lo[2] = lw[2] - bflo(h23); lo[3] = lw[3] - bfhi(h23);
              const bf16x8 bh = __builtin_bit_cast(bf16x8, (u32x4){h01, h23, 0u, 0u}), bl = __builtin_bit_cast(bf16x8, (u32x4){cvt2(lo[0], lo[1]), cvt2(lo[2], lo[3]), 0u, 0u});
              f32x4 ci = (f32x4){0.f, 0.f, 0.f, 0.f};
              ci = MFMA16(Li, bh, ci); ci = MFMA16(Li, bl, ci);
#pragma unroll
              for (int r = 0; r < 4; ++r) { const int o = (ti * 16 + 4 * fg + r) * LPS + c;
                  LP[o] = fexp(ci[r]); AS[o] = fsigmoid(ca[r]); } } }
        __syncthreads();
        tid = opq(tid0); fr = tid & 15; fg = (tid & 63) >> 4; ei = tid >> 3; ec8 = (tid & 7) * 8;
        float bcv;
        { const f32x4 g0 = *(const LAS f32x4*)(LP + ei * LPS + ec8), g1 = *(const LAS f32x4*)(LP + ei * LPS + ec8 + 4);
          const int ip = (ei & 15) ? ei - 1 : ei;
          f32x4 p0 = *(const LAS f32x4*)(LP + ip * LPS + ec8), p1 = *(const LAS f32x4*)(LP + ip * LPS + ec8 + 4);
          if ((ei & 15) == 0) { p0 = (f32x4){1.f, 1.f, 1.f, 1.f}; p1 = p0; }
          const f32x4 s0 = *(const LAS f32x4*)(AS + ei * LPS + ec8), s1 = *(const LAS f32x4*)(AS + ei * LPS + ec8 + 4);
          float rr[8], kk[8], xa[8], xr[8], xb[8], xk[8], bc = 0.f;
          rr[0] = bflo(cr.x); rr[1] = bfhi(cr.x); rr[2] = bflo(cr.y); rr[3] = bfhi(cr.y); rr[4] = bflo(cr.z); rr[5] = bfhi(cr.z); rr[6] = bflo(cr.w); rr[7] = bfhi(cr.w);
          kk[0] = bflo(ck.x); kk[1] = bfhi(ck.x); kk[2] = bflo(ck.y); kk[3] = bfhi(ck.y); kk[4] = bflo(ck.z); kk[5] = bfhi(ck.z); kk[6] = bflo(ck.w); kk[7] = bfhi(ck.w);
#pragma unroll
          for (int e = 0; e < 8; ++e) { const float gi = e < 4 ? g0[e & 3] : g1[e & 3], gp = e < 4 ? p0[e & 3] : p1[e & 3], asg = e < 4 ? s0[e & 3] : s1[e & 3];
              const float kj = kk[e] * kkp[e] * kinv, kd = kk[e] * (1.0f + (asg - 1.0f) * kap[e]), ginv = frcp(gi);
              bc += rr[e] * kd * rkp[e];
              xa[e] = -kj * gp; xr[e] = rr[e] * gi; xb[e] = kj * asg * ginv; xk[e] = kd * ginv; }
          bcv = red8(bc);
          *(LAS u32x4*)(AT + ei * TS + ec8) = pack8(xa); *(LAS u32x4*)(RT + ei * TS + ec8) = pack8(xr); *(LAS u32x4*)(BH + ei * TS + ec8) = pack8(xb); *(LAS u32x4*)(KH + ei * TS + ec8) = pack8(xk);
          *(LAS u32x4*)(VR + ei * TS + ec8) = cv; }
        __syncthreads();
        tid = opq(tid0); fr = tid & 15; fg = (tid & 63) >> 4;
        { const int q = w >> 1, half = w & 1; const LAS bf16* Asrc = half ? RT : AT;
          const bf16x8 af0 = *(const LAS bf16x8*)(Asrc + (16 * q + fr) * TS + fg * 8), af1 = *(const LAS bf16x8*)(Asrc + (16 * q + fr) * TS + 32 + fg * 8);
          const bf16x8 bb0 = *(const LAS bf16x8*)(BH + (16 * q + fr) * TS + fg * 8), bb1 = *(const LAS bf16x8*)(BH + (16 * q + fr) * TS + 32 + fg * 8);
          const bf16x8 bk0 = *(const LAS bf16x8*)(KH + (16 * q + fr) * TS + fg * 8), bk1 = *(const LAS bf16x8*)(KH + (16 * q + fr) * TS + 32 + fg * 8);
          LAS bf16* myak = half ? AAK1 : AAK;
          f32x4 cx = (f32x4){0.f, 0.f, 0.f, 0.f}, ck2 = cx, cak = cx;
          cx = MFMA16(af0, bb0, cx); cx = MFMA16(af1, bb1, cx);
          ck2 = MFMA16(af0, bk0, ck2); ck2 = MFMA16(af1, bk1, ck2);
          if (half) { const bf16x8 at0 = *(const LAS bf16x8*)(AT + (16 * q + fr) * TS + fg * 8), at1 = *(const LAS bf16x8*)(AT + (16 * q + fr) * TS + 32 + fg * 8);
              cak = MFMA16(at0, bk0, cak); cak = MFMA16(at1, bk1, cak); }
          else cak = ck2;
          f32x4 mx, mk, mak;
#pragma unroll
          for (int r = 0; r < 4; ++r) { const int i = 4 * fg + r, j = fr; const bool lo = half ? j <= i : j < i; mx[r] = lo ? cx[r] : 0.f; mk[r] = lo ? ck2[r] : 0.f; mak[r] = j < i ? cak[r] : 0.f; }
          if (half == 0) *(LAS f32x4*)(AAB + (q * 16 + fr) * 16 + 4 * fg) = mx;
#pragma unroll
          for (int r = 0; r < 4; ++r) { const int o = (q * 16 + 4 * fg + r) * 24 + fr;
              if (half) { ARB[o] = (bf16)(cvt2(mx[r], 0.f) & 0xffffu); ARK[o] = (bf16)(cvt2(mk[r], 0.f) & 0xffffu); }
              myak[o] = (bf16)(cvt2(mak[r], 0.f) & 0xffffu); }
          {
              const unsigned kmask = fg < 2 ? 0xffffffffu : 0u;
              const bf16x8 afr = *(const LAS bf16x8*)(myak + (q * 16 + fr) * 24 + (fg & 1) * 8);
              const bf16x8 af = __builtin_bit_cast(bf16x8, __builtin_bit_cast(u32x4, afr) & kmask);
#pragma unroll
              for (int x = 0; x < 2; ++x) { const int tvv = 2 * half + x;
                  const bf16x8 bfr = tr8(VR + (16 * q + 8 * (fg & 1) + (fr >> 2)) * TS + 16 * tvv + 4 * (fr & 3));
                  const bf16x8 bfv = __builtin_bit_cast(bf16x8, __builtin_bit_cast(u32x4, bfr) & kmask);
                  f32x4 c = (f32x4){0.f, 0.f, 0.f, 0.f}; c = MFMA16(af, bfv, c);
#pragma unroll
                  for (int r = 0; r < 4; ++r) W1[(q * 16 + 4 * fg + r) * LPS + 16 * tvv + fr] = c[r]; } } }
        __syncthreads();
        tid = opq(tid0);
        { const int q = tid >> 7, col = tid & 127; float x[16];
          if (col < 64) {
#pragma unroll
              for (int i = 0; i < 16; ++i) x[i] = bf1(AT[(16 * q + i) * TS + col]); }
          else {
#pragma unroll
              for (int i = 0; i < 16; ++i) x[i] = W1[(q * 16 + i) * LPS + col - 64]; }
#pragma unroll
          for (int j = 0; j < 15; ++j) {
              const LAS f32x4* ac = (const LAS f32x4*)(AAB + (q * 16 + j) * 16);
#pragma unroll
              for (int i4 = (j + 1) / 4; i4 < 4; ++i4) { const f32x4 a4 = ac[i4];
#pragma unroll
                  for (int e = 0; e < 4; ++e) if (i4 * 4 + e > j) x[i4 * 4 + e] += a4[e] * x[j]; } }
          if (col < 64) {
#pragma unroll
              for (int i = 0; i < 16; ++i) AT[(16 * q + i) * TS + col] = (bf16)(cvt2(x[i], 0.f) & 0xffffu); }
          else {
#pragma unroll
              for (int i = 0; i < 16; ++i) W1[(q * 16 + i) * LPS + col - 64] = x[i]; } }
        __syncthreads();
        if (sc + 1 < L / 64) SCAN_PREFETCH(sc + 1);
        if (w < 4) {
        tid = opq(tid0); fr = tid & 15; fg = (tid & 63) >> 4;
#pragma unroll
        for (int q = 0; q < 4; ++q) {
            bf16x8 hb[2];
#pragma unroll
            for (int ks = 0; ks < 2; ++ks) { u32x4 t; t.x = cvt2(hacc[2 * ks][0], hacc[2 * ks][1]); t.y = cvt2(hacc[2 * ks][2], hacc[2 * ks][3]);
                t.z = cvt2(hacc[2 * ks + 1][0], hacc[2 * ks + 1][1]); t.w = cvt2(hacc[2 * ks + 1][2], hacc[2 * ks + 1][3]); hb[ks] = __builtin_bit_cast(bf16x8, t); }
            bf16x8 aU[2], aR[2];
#pragma unroll
            for (int ks = 0; ks < 2; ++ks) {
                const u32x2 a0 = *(const LAS u32x2*)(AT + (16 * q + fr) * TS + 32 * ks + 4 * fg), a1 = *(const LAS u32x2*)(AT + (16 * q + fr) * TS + 32 * ks + 16 + 4 * fg);
                const u32x2 r0 = *(const LAS u32x2*)(RT + (16 * q + fr) * TS + 32 * ks + 4 * fg), r1 = *(const LAS u32x2*)(RT + (16 * q + fr) * TS + 32 * ks + 16 + 4 * fg);
                aU[ks] = __builtin_bit_cast(bf16x8, (u32x4){a0.x, a0.y, a1.x, a1.y}); aR[ks] = __builtin_bit_cast(bf16x8, (u32x4){r0.x, r0.y, r1.x, r1.y}); }
            f32x4 u, yacc = (f32x4){0.f, 0.f, 0.f, 0.f};
#pragma unroll
            for (int r = 0; r < 4; ++r) u[r] = W1[(q * 16 + 4 * fg + r) * LPS + 16 * tv + fr];
            u = MFMA16(aU[0], hb[0], u); u = MFMA16(aU[1], hb[1], u);
            yacc = MFMA16(aR[0], hb[0], yacc); yacc = MFMA16(aR[1], hb[1], yacc);
            const s16x4v vtr = __builtin_bit_cast(s16x4v, __builtin_amdgcn_ds_read_tr16_b64_v4i16((LAS s16x4v*)(VR + (16 * q + 4 * fg + (fr >> 2)) * TS + 16 * tv + 4 * (fr & 3))));
            const u32x2 vt2 = __builtin_bit_cast(u32x2, vtr);
            const bf16x8 bUV = __builtin_bit_cast(bf16x8, (u32x4){cvt2(u[0], u[1]), cvt2(u[2], u[3]), vt2.x, vt2.y});
            { const u32x2 y0 = *(const LAS u32x2*)(ARB + (q * 16 + fr) * 24 + 4 * fg), y1 = *(const LAS u32x2*)(ARK + (q * 16 + fr) * 24 + 4 * fg);
              yacc = MFMA16(__builtin_bit_cast(bf16x8, (u32x4){y0.x, y0.y, y1.x, y1.y}), bUV, yacc); }
#pragma unroll
            for (int r = 0; r < 4; ++r) YS[(16 * q + 4 * fg + r) * LPS + 16 * tv + fr] = yacc[r];
#pragma unroll
            for (int x = 0; x < 4; ++x) {
                const s16x4v bt = __builtin_bit_cast(s16x4v, __builtin_amdgcn_ds_read_tr16_b64_v4i16((LAS s16x4v*)(BH + (16 * q + 4 * fg + (fr >> 2)) * TS + 16 * x + 4 * (fr & 3))));
                const s16x4v kt = __builtin_bit_cast(s16x4v, __builtin_amdgcn_ds_read_tr16_b64_v4i16((LAS s16x4v*)(KH + (16 * q + 4 * fg + (fr >> 2)) * TS + 16 * x + 4 * (fr & 3))));
                const u32x2 b2 = __builtin_bit_cast(u32x2, bt), k2 = __builtin_bit_cast(u32x2, kt);
                const f32x4 ge = *(const LAS f32x4*)(LP + (16 * q + 15) * LPS + 16 * x + 4 * fg);
                hacc[x] = MFMA16(__builtin_bit_cast(bf16x8, (u32x4){b2.x, b2.y, k2.x, k2.y}), bUV, hacc[x]) * ge; }
        }
        }
        __syncthreads();
        tid = opq(tid0); ei = tid >> 3; ec8 = (tid & 7) * 8;
        { const int st2 = sc * 64 + ei, t2 = dir ? L - 1 - st2 : st2; bf16* yo = Yout + (size_t)(base + t2) * 512 + h * 64 + ec8;
          const f32x4 y0 = *(const LAS f32x4*)(YS + ei * LPS + ec8), y1 = *(const LAS f32x4*)(YS + ei * LPS + ec8 + 4);
          u32x4 yw; yw.x = cvt2(y0[0], y0[1]); yw.y = cvt2(y0[2], y0[3]); yw.z = cvt2(y1[0], y1[1]); yw.w = cvt2(y1[2], y1[3]);
          *(u32x4*)yo = yw;
          if ((tid & 7) == 0) BC[(size_t)(base + t2) * 8 + h] = bcv; }
    }
#undef SCAN_PREFETCH
    if (!lat && w < 4) {
#pragma unroll
        for (int x = 0; x < 4; ++x) *(f32x4*)(p.out + (size_t)MTOK * DM + ((((size_t)bseq * 2 + l) * 2 + dir) * 8 + h) * 4096 + (16 * tv + fr) * 64 + 16 * x + 4 * fg) = hacc[x]; }
    __syncthreads();
}

__device__ __forceinline__ void stage_upass(CKP& p, int l, int bid, int nb) {
    const int tid = opaque_tid(), sub = tid >= 240 ? 1 : 0, j = tid - sub * 240, col = 8 * j;
    const bf16* proj = (const bf16*)(p.ws + WS_PROJ); bf16* U = (bf16*)(p.ws + WS_U); float* KINV = (float*)(p.ws + WS_KINV);
    const float* mu = p.in[I_MU] + l * 1920;
    if (tid < 480) {
        const bool isk = col >= K_OFF && col < V_OFF;
        const float* kkp = p.in[I_KK] + l * 512 + (isk ? col - K_OFF : 0);
        const f32x4 k0 = *(const f32x4*)kkp, k1 = *(const f32x4*)(kkp + 4);
#pragma unroll 1
        for (int tok0 = bid * 2 + sub; tok0 < MTOK; tok0 += nb * 8) {
            float uu[4][8];
#pragma unroll
            for (int z = 0; z < 4; ++z) { const int tok = min(tok0 + z * nb * 2, MTOK - 1);
                const bool lat = tok >= NCTX; const int L = lat ? 1024 : 256, t = lat ? (tok - NCTX) & 1023 : tok & 255;
                shift8(proj, tok, t > 0, t < L - 1, col, mu, uu[z]); }
#pragma unroll
            for (int z = 0; z < 4; ++z) { const int tok = tok0 + z * nb * 2;
                float ss = 0.f;
#pragma unroll
                for (int e = 0; e < 8; ++e) { const float kn = uu[z][e] * (e < 4 ? k0[e & 3] : k1[e & 3]); ss += kn * kn; }
                ss = red8(ss);
                if (tok < MTOK) {
                    if (isk && (j & 7) == 0) KINV[(size_t)tok * 8 + ((col - K_OFF) >> 6)] = fminf(frsq(ss), 1e12f);
                    if (col >= WD_OFF && col < AD_OFF) {
#pragma unroll
                        for (int e = 0; e < 8; ++e) uu[z][e] = 1.0f - 2.0f * frcp(fexp(2.0f * uu[z][e]) + 1.0f); }
                    if (col >= GD_OFF) {
#pragma unroll
                        for (int e = 0; e < 8; ++e) uu[z][e] = fsigmoid(uu[z][e]); }
                    *(u32x4*)(U + (size_t)tok * 1920 + col) = pack8(uu[z]); } }
        }
    }
}

__device__ __forceinline__ void fnet1_item(CKP& p, int l, int item) {
    const int tid = opaque_tid(), lane = tid & 63, w = __builtin_amdgcn_readfirstlane(tid >> 6), fr = lane & 15, fg = lane >> 4;
    const int tb = item >> 2, g = item & 3, tok0 = tb * 64, tt = w & 3, cs = w >> 2;
    const bf16* proj = (const bf16*)(p.ws + WS_PROJ);
    const bf16* fwt = (const bf16*)(p.ws + WS_FW) + (size_t)((l * 4 + g) * 128 + cs * 64) * 64;
    const bf16* xr = proj + (size_t)(tok0 + 16 * tt + fr) * DINP + F_OFF + g * 64 + fg * 8;
    const bf16x8 a0 = *(const bf16x8*)xr, a1 = *(const bf16x8*)(xr + 32);
    const bool lat = tok0 >= NCTX;
    const int L = lat ? 1024 : 256, bq = lat ? (tok0 - NCTX) >> 10 : tok0 >> 8, t = (lat ? (tok0 - NCTX) & 1023 : tok0 & 255) + 16 * tt + 4 * fg;
    const float scale = lat ? (1.0f / 256.0f) : (1.0f / 128.0f);
    bf16* Y = (bf16*)(p.ws + WS_YCS) + (lat ? (size_t)8192 * 512 : 0);
#pragma unroll
    for (int ot = 0; ot < 4; ++ot) {
        const bf16x8 b0 = *(const bf16x8*)(fwt + (16 * ot + fr) * 64 + fg * 8), b1 = *(const bf16x8*)(fwt + (16 * ot + fr) * 64 + 32 + fg * 8);
        f32x4 c = (f32x4){0.f, 0.f, 0.f, 0.f}; c = MFMA16(a0, b0, c); c = MFMA16(a1, b1, c);
        u32x2 o; o.x = cvt2(c[0] * scale, c[1] * scale); o.y = cvt2(c[2] * scale, c[3] * scale);
        *(u32x2*)(Y + (size_t)((bq * 4 + g) * 64 + 16 * ot + fr) * (2 * L) + cs * L + t) = o; }
}

__device__ __forceinline__ void pool_item(CKP& p, int l, LAS unsigned char* lds, int item) {
    const int tid = opaque_tid(), tb = item >> 2, gi = item & 3, tok0 = tb * 64, hw = 1 << gi;
    const bf16* proj = (const bf16*)(p.ws + WS_PROJ);
    LAS bf16* DB = (LAS bf16*)lds;
    LAS float* CSUM = (LAS float*)(lds + 9216);
    const int ti = tid >> 3, c8 = (tid & 7) * 8, tok = tok0 + ti, col = P_OFF + gi * 64 + c8;
    { float sum[8], x[8];
#pragma unroll
      for (int j = 0; j < 8; ++j) sum[j] = 0.f;
      load8bf(proj + (size_t)tok * DINP + col, x);
      float cnt;
      if (tok < NCTX) { const int t = tok & 255, sb = tok - t, lo = max(t - hw, 0), hi = min(t + hw, 256);
          u32x4 wv[16];
#pragma unroll
          for (int q = 0; q < 16; ++q) { const int tq = min(t - hw + q, 255); wv[q] = (q < 2 * hw && tq >= 0) ? *(const u32x4*)(proj + (size_t)(sb + max(tq, 0)) * DINP + col) : (u32x4){0u, 0u, 0u, 0u}; }
#pragma unroll
          for (int q = 0; q < 16; ++q) if (q < 2 * hw) { const bool ok = t - hw + q >= 0 && t - hw + q < 256; const u32x4 w = wv[q];
              if (ok) { sum[0] += bflo(w.x); sum[1] += bfhi(w.x); sum[2] += bflo(w.y); sum[3] += bfhi(w.y); sum[4] += bflo(w.z); sum[5] += bfhi(w.z); sum[6] += bflo(w.w); sum[7] += bfhi(w.w); } }
          cnt = (float)(hi - lo); }
      else {
          const int t = (tok - NCTX) & 1023, sb = tok - t, r = t >> 6, c = t & 63, rlo = max(r - hw, 0), rhi = min(r + hw, 16), clo = max(c - hw, 0), chi = min(c + hw, 64);
          u32x4 wv[16];
#pragma unroll
          for (int q = 0; q < 16; ++q) { const int rq = r - hw + q; wv[q] = (q < 2 * hw && rq >= 0 && rq < 16) ? *(const u32x4*)(proj + (size_t)(sb + rq * 64 + c) * DINP + col) : (u32x4){0u, 0u, 0u, 0u}; }
#pragma unroll
          for (int q = 0; q < 16; ++q) { const u32x4 w = wv[q];
              sum[0] += bflo(w.x); sum[1] += bfhi(w.x); sum[2] += bflo(w.y); sum[3] += bfhi(w.y); sum[4] += bflo(w.z); sum[5] += bfhi(w.z); sum[6] += bflo(w.w); sum[7] += bfhi(w.w); }
          *(LAS f32x4*)(CSUM + ti * 68 + c8) = (f32x4){sum[0], sum[1], sum[2], sum[3]}; *(LAS f32x4*)(CSUM + ti * 68 + c8 + 4) = (f32x4){sum[4], sum[5], sum[6], sum[7]};
          __syncthreads();
#pragma unroll
          for (int j = 0; j < 8; ++j) sum[j] = 0.f;
          for (int cq = clo; cq < chi; ++cq) { const f32x4 a = *(const LAS f32x4*)(CSUM + cq * 68 + c8), b = *(const LAS f32x4*)(CSUM + cq * 68 + c8 + 4);
#pragma unroll
              for (int j = 0; j < 4; ++j) { sum[j] += a[j]; sum[4 + j] += b[j]; } }
          cnt = (float)((rhi - rlo) * (chi - clo)); }
      const float ic = frcp(cnt);
      float dd[8];
#pragma unroll
      for (int j = 0; j < 8; ++j) dd[j] = sum[j] * ic - x[j];
      *(LAS u32x4*)(DB + ti * 72 + c8) = pack8(dd); }
    __syncthreads();
    { const int lane = tid & 63, w = __builtin_amdgcn_readfirstlane(tid >> 6), fr = lane & 15, fg = lane >> 4, tt = w & 3;
      const bf16* wpt = (const bf16*)(p.ws + WS_WPT) + (size_t)(l * 4 + gi) * 4096;
      const bf16x8 b0 = *(const LAS bf16x8*)(DB + (16 * tt + fr) * 72 + fg * 8), b1 = *(const LAS bf16x8*)(DB + (16 * tt + fr) * 72 + 32 + fg * 8);
#pragma unroll
      for (int x = 0; x < 2; ++x) { const int ot = 2 * (w >> 2) + x;
          const bf16x8 a0 = *(const bf16x8*)(wpt + (16 * ot + fr) * 64 + fg * 8), a1 = *(const bf16x8*)(wpt + (16 * ot + fr) * 64 + 32 + fg * 8);
          f32x4 c = (f32x4){0.f, 0.f, 0.f, 0.f}; c = MFMA16(a0, b0, c); c = MFMA16(a1, b1, c);
          const f32x4 ps = *(const f32x4*)(p.in[I_PSCALE] + l * 256 + gi * 64 + 16 * ot + 4 * fg);
          c *= ps;
          u32x2 o; o.x = cvt2(c[0], c[1]); o.y = cvt2(c[2], c[3]);
          *(u32x2*)((bf16*)(p.ws + WS_MIXED) + (size_t)(tok0 + 16 * tt + fr) * DM + 768 + gi * 64 + 16 * ot + 4 * fg) = o; } }
    __syncthreads();
}

__device__ __forceinline__ float xsum_fg(float s, int fr, int fg) {
    s += __builtin_bit_cast(float, __builtin_amdgcn_ds_bpermute((((fg ^ 1) << 4) | fr) << 2, __builtin_bit_cast(int, s)));
    s += __builtin_bit_cast(float, __builtin_amdgcn_ds_bpermute((((fg ^ 2) << 4) | fr) << 2, __builtin_bit_cast(int, s)));
    return s;
}
__device__ __forceinline__ void stage_post(CKP& p, int l, int bid, int nb) {
    const int tid = opaque_tid(), lane = tid & 63, head = __builtin_amdgcn_readfirstlane(tid >> 6), fr = lane & 15, fg = lane >> 4;
    const bf16* Ub = (const bf16*)(p.ws + WS_U);
    const bf16* gupt = (const bf16*)(p.ws + WS_GUPT) + ((size_t)l * 512 + head * 64) * 128;
    const bf16* YF = (const bf16*)(p.ws + WS_YF); const bf16* YB = (const bf16*)(p.ws + WS_YB);
    const float* BC0 = (const float*)(p.ws + WS_BC); const float* BC1 = BC0 + (size_t)MTOK * 8;
    bf16* MIX = (bf16*)(p.ws + WS_MIXED);
    bf16x8 ag[4][4];
    f32x4 lnw[4], lnb[4];
#pragma unroll
    for (int t = 0; t < 4; ++t) {
#pragma unroll
        for (int ks = 0; ks < 4; ++ks) ag[t][ks] = *(const bf16x8*)(gupt + (16 * t + fr) * 128 + ks * 32 + fg * 8);
        lnw[t] = *(const f32x4*)(p.in[I_LNW] + l * 512 + head * 64 + 16 * t + 4 * fg); lnb[t] = *(const f32x4*)(p.in[I_LNB] + l * 512 + head * 64 + 16 * t + 4 * fg); }
#pragma unroll 1
    for (int item = bid; item < 768; item += nb) {
        const size_t tok = (size_t)item * 16 + fr;
        bf16x8 bs[4];
#pragma unroll
        for (int ks = 0; ks < 4; ++ks) bs[ks] = *(const bf16x8*)(Ub + tok * 1920 + GD_OFF + ks * 32 + fg * 8);
        f32x4 y[4]; u32x2 vw[4];
#pragma unroll
        for (int t = 0; t < 4; ++t) { const int c = head * 64 + 16 * t + 4 * fg;
            const u32x2 yf = *(const u32x2*)(YF + tok * 512 + c), yb = *(const u32x2*)(YB + tok * 512 + c);
            y[t] = (f32x4){bflo(yf.x) + bflo(yb.x), bfhi(yf.x) + bfhi(yb.x), bflo(yf.y) + bflo(yb.y), bfhi(yf.y) + bfhi(yb.y)}; vw[t] = *(const u32x2*)(Ub + tok * 1920 + V_OFF + c); }
        const float bc = BC0[tok * 8 + head] + BC1[tok * 8 + head];
        f32x4 g[4];
#pragma unroll
        for (int t = 0; t < 4; ++t) { g[t] = (f32x4){0.f, 0.f, 0.f, 0.f};
#pragma unroll
            for (int ks = 0; ks < 4; ++ks) g[t] = MFMA16(ag[t][ks], bs[ks], g[t]); }
        float s = 0.f;
#pragma unroll
        for (int t = 0; t < 4; ++t) s += (y[t][0] + y[t][1]) + (y[t][2] + y[t][3]);
        const float mean = xsum_fg(s, fr, fg) * (1.0f / 64.0f);
        float q = 0.f;
#pragma unroll
        for (int t = 0; t < 4; ++t) { y[t] = y[t] - mean; q += (y[t][0] * y[t][0] + y[t][1] * y[t][1]) + (y[t][2] * y[t][2] + y[t][3] * y[t][3]); }
        const float rstd = frsq(xsum_fg(q, fr, fg) * (1.0f / 64.0f) + 64e-5f);
#pragma unroll
        for (int t = 0; t < 4; ++t) { const f32x4 vv = (f32x4){bflo(vw[t].x), bfhi(vw[t].x), bflo(vw[t].y), bfhi(vw[t].y)};
            const f32x4 o = (y[t] * rstd * lnw[t] + lnb[t] + vv * bc) * g[t];
            u32x2 w; w.x = cvt2(o[0], o[1]); w.y = cvt2(o[2], o[3]);
            *(u32x2*)(MIX + tok * DM + head * 64 + 16 * t + 4 * fg) = w; }
    }
}

#define XB_TMO      128
#define XB_XCNT(j)  (256  + 64 * (j))
#define XB_XSUB(j)  (1280 + 64 * (j))
#define XB_XGEN(j)  (2304 + 64 * (j))
#define XB_TOP      3328
#define XB_TOPGEN   3392
#define XCD_BAR_WORDS 3456
#define XB_SPIN_CAP (1u << 18)

__device__ __forceinline__ unsigned xb_ld(unsigned* p)              { return __hip_atomic_load(p, __ATOMIC_RELAXED, __HIP_MEMORY_SCOPE_AGENT); }
__device__ __forceinline__ unsigned xb_add(unsigned* p, unsigned v) { return __hip_atomic_fetch_add(p, v, __ATOMIC_RELAXED, __HIP_MEMORY_SCOPE_AGENT); }
__device__ __forceinline__ unsigned xb_xcc_id() { return (unsigned)__builtin_amdgcn_s_getreg((3 << 11) | 20) & 0xFu; }
#define XB_SPIN(cond, bar) do { unsigned _sp = 0; while (cond) { __builtin_amdgcn_s_sleep(1); \
    if ((++_sp & 255u) == 0u) { if (xb_ld(&(bar)[XB_TMO])) break; if (_sp > XB_SPIN_CAP) { atomicAdd(&(bar)[XB_TMO], 1u); break; } } } } while (0)

struct XcdBarrier {
    unsigned* bar; unsigned x;
    volatile LAS unsigned* st;
};

__device__ __forceinline__ XcdBarrier xcd_barrier_post(unsigned* bar, volatile LAS unsigned* st) {
    XcdBarrier b; b.bar = bar; b.x = xb_xcc_id(); b.st = st;
    if (threadIdx.x == 0) (void)xb_add(&bar[XB_XCNT(b.x)], 1u);
    return b;
}
__device__ __forceinline__ void xcd_barrier_complete(unsigned* bar, unsigned x, unsigned& nloc, unsigned& nx) {
    const unsigned G = gridDim.x * gridDim.y * gridDim.z;
    unsigned sum, cnt, mine, sp = 0u;
    for (;;) {
        sum = 0u; cnt = 0u; mine = 0u;
#pragma unroll
        for (unsigned j = 0; j < 16; ++j) { const unsigned c = xb_ld(&bar[XB_XCNT(j)]); sum += c; cnt += (c > 0u) ? 1u : 0u; mine = (j == x) ? c : mine; }
        if (sum == G) break;
        __builtin_amdgcn_s_sleep(1);
        if ((++sp & 255u) == 0u) { if (xb_ld(&bar[XB_TMO])) break; if (sp > XB_SPIN_CAP) { atomicAdd(&bar[XB_TMO], 1u); break; } }
    }
    nloc = mine > 0u ? mine : 1u; nx = cnt > 0u ? cnt : 1u;
}

__device__ __forceinline__ void xcd_barrier(const XcdBarrier& b) {
    asm volatile("s_waitcnt vmcnt(0)" ::: "memory");
    __syncthreads();
    if (threadIdx.x == 0) {
        unsigned* bar = b.bar;
        __builtin_amdgcn_s_waitcnt(0);
        unsigned nloc = b.st[0], nx = b.st[1];
        if (nloc == 0u) { xcd_barrier_complete(bar, b.x, nloc, nx); b.st[0] = nloc; b.st[1] = nx; }
        const unsigned old = xb_add(&bar[XB_XSUB(b.x)], 1u);
        const unsigned gen = old / nloc;
        if (old + 1u == (gen + 1u) * nloc) {
            __builtin_amdgcn_fence(__ATOMIC_RELEASE, "agent");
            asm volatile("s_waitcnt vmcnt(0)" ::: "memory");
            const unsigned og = xb_add(&bar[XB_TOP], 1u);
            const unsigned tg = og / nx;
            __builtin_amdgcn_fence(__ATOMIC_ACQUIRE, "agent");
            if (og + 1u == (tg + 1u) * nx) xb_add(&bar[XB_TOPGEN], 1u);
            else XB_SPIN(xb_ld(&bar[XB_TOPGEN]) == tg, bar);
            xb_add(&bar[XB_XGEN(b.x)], 1u);
            asm volatile("s_waitcnt vmcnt(0)" ::: "memory");
        } else {
            __builtin_amdgcn_fence(__ATOMIC_ACQUIRE, "agent");
            XB_SPIN(xb_ld(&bar[XB_XGEN(b.x)]) == gen, bar);
            asm volatile("s_waitcnt vmcnt(0)" ::: "memory");
        }
    }
    __syncthreads();
}

struct EpiAny {
    static constexpr bool AFTER_DRAIN = false;
    int mode; bool PERM; int l;
    __device__ __forceinline__ void operator()(const f32x4 (&acc)[2][2][4][2], const pg8::Unit& u, int wr, int wc, int fr, int fq) const {
        CKP* kp = (CKP*)__builtin_amdgcn_kernarg_segment_ptr(); asm volatile("" : "+s"(kp)); CKP& p = *kp;
        unsigned char* ws = p.ws;
        const float* mod = (const float*)(ws + WS_MOD) + (size_t)l * 5 * 6144;
        float* SSQ = (float*)(ws + WS_CTL + 262144);
        bf16* Hb = (bf16*)(ws + WS_H); bf16* XB = (bf16*)(ws + WS_XB);
        if (mode == 7) {
#pragma unroll
            for (int a = 0; a < 2; ++a)
#pragma unroll
                for (int b = 0; b < 2; ++b)
#pragma unroll
                    for (int m = 0; m < 4; ++m)
#pragma unroll
                        for (int n = 0; n < 2; ++n) asm volatile("" :: "v"(acc[a][b][m][n]));
            return; }
        if (mode == 0) { const pg8::EpiBf<0> e{(bf16*)(ws + WS_PROJ), DINP}; e(acc, u, wr, wc, fr, fq); }
        else if (mode == 2) { const pg8::EpiResFinal e{XB, mod + 5 * 1024, p.in[I_FNG], p.out, SSQ + 49152, (unsigned*)(ws + WS_CTL + 524288) + 64 * 16}; e(acc, u, wr, wc, fr, fq); }
        else if (mode == 3) { const pg8::EpiFnet e{(bf16*)(ws + WS_MIXED), 0, 256}; e(acc, u, wr, wc, fr, fq); }
        else if (mode == 8) { const pg8::EpiFnet e{(bf16*)(ws + WS_MIXED), NCTX, 1024}; e(acc, u, wr, wc, fr, fq); }
        else if (mode == 4) { const pg8::EpiNormBf<0> e{(bf16*)(ws + WS_PROJ), DINP, SSQ + 16384, (const float*)(ws + WS_SWIN), DINP}; e(acc, u, wr, wc, fr, fq); }
        else if (mode == 5) { const pg8::EpiNormBf<1> e{(bf16*)(ws + WS_FF), DFF, SSQ + l * 32768, (const float*)(ws + WS_SW1) + (size_t)l * 5 * DFF, DFF}; e(acc, u, wr, wc, fr, fq); }
        else if (mode == 6) {
            if (l == 0) { const pg8::EpiResNorm<true, true> e{XB, mod + 2 * 1024, p.in[I_XP], p.in[I_XS], Hb, p.in[I_N2G], mod + 4 * 1024, SSQ}; e(acc, u, wr, wc, fr, fq); }
            else { const pg8::EpiResNorm<false, true> e{XB, mod + 2 * 1024, nullptr, nullptr, Hb, p.in[I_N2G] + DM, mod + 4 * 1024, SSQ + 32768}; e(acc, u, wr, wc, fr, fq); } }
        else { const pg8::EpiResNorm<false, true> e{XB, mod + 5 * 1024, nullptr, nullptr, Hb, p.in[I_N1G] + DM, mod + 5 * 6144 + 1 * 1024, SSQ + 16384}; e(acc, u, wr, wc, fr, fq); }
    }
};

constexpr int N_STEPS = 16;
__device__ __forceinline__ bool step_seam(int st) { return st < 15; }
__global__ void __launch_bounds__(NTHR, 2) mega_fwd(KP p_unused) {
    extern __shared__ __attribute__((aligned(16))) unsigned char lds_raw[];
    CKP* kp0 = (CKP*)__builtin_amdgcn_kernarg_segment_ptr();
    { LAS unsigned* ctlw = (LAS unsigned*)((LAS unsigned char*)lds_raw + RING_BYTES);
      for (int u = threadIdx.x; u < (LDS_BYTES - RING_BYTES) / 4; u += NTHR) ctlw[u] = 0u; }
    __syncthreads();
    const XcdBarrier bar = xcd_barrier_post((unsigned*)(kp0->ws + WS_CTL) + 4096, (volatile LAS unsigned*)((LAS unsigned char*)lds_raw + MISC_OFF + 32));
    const int ph_lo = kp0->ph_lo, ph_hi = kp0->ph_hi;
#pragma unroll 1
#ifdef REP_A
    for (int sti = ph_lo; sti < ph_hi + ((REP_B) >= 0 ? 2 : 1); ++sti) {
        const int st = sti <= (REP_A) ? sti : (((REP_B) < 0 || sti <= (REP_B) + 1) ? sti - 1 : sti - 2);
        const bool isdup = sti == (REP_A) || ((REP_B) >= 0 && sti == (REP_B) + 1); (void)isdup;
#else
    for (int st = ph_lo; st < ph_hi; ++st) {
#endif
        CKP* kp = kp0; asm volatile("" : "+s"(kp));
        CKP& p = *kp; unsigned char* ws = p.ws;
        int bid = blockIdx.x, nb = gridDim.x; unsigned ldsb = (unsigned)(size_t)(LAS unsigned char*)lds_raw;
        asm volatile("" : "+s"(bid), "+s"(nb), "+s"(ldsb));
        LAS unsigned char* lds = (LAS unsigned char*)(size_t)ldsb;
        const int l = st < 9 ? 0 : 1, s = st == 0 ? -1 : (st == 1 ? 0 : ((st - 2) % 7 + 1));
        const float* mod = (const float*)(ws + WS_MOD) + (size_t)l * 5 * 6144;
#pragma unroll 1
        for (int job = 0; job < 2; ++job) {
            pg8::Gemm g{nullptr, nullptr, 0, 0, 0, 0, 0}; EpiAny E{-1, true, 0}; int corder = bid;
            if (job == 0) {
                if (s == 1) { g = pg8::Gemm{(const bf16*)(ws + WS_H), (const bf16*)(ws + WS_WIN) + (size_t)l * DINP * DM, MTOK, DINP, DM, DM, DM}; E = EpiAny{l == 0 ? 0 : 4, true, l}; }
                else if (s == 3) { g = pg8::Gemm{(const bf16*)(ws + WS_CS256), (const bf16*)(ws + WS_YCS), 256, 8192, 512, 512, 512}; E = EpiAny{3, true, l}; corder = (bid + nb - (nb >= 256 ? 192 : 0)) % nb; }
                else if (s == 5) { g = pg8::Gemm{(const bf16*)(ws + WS_MIXED), (const bf16*)(ws + WS_WOUT) + (size_t)l * DM * DM, MTOK, DM, DM, DM, DM}; E = EpiAny{6, true, l}; }
                else if (s == 6) { g = pg8::Gemm{(const bf16*)(ws + WS_H), (const bf16*)(ws + WS_W1) + (size_t)l * DFF * DM, MTOK, DFF, DM, DM, DM}; E = EpiAny{5, true, l}; }
                else if (s == 7) { g = pg8::Gemm{(const bf16*)(ws + WS_FF), (const bf16*)(ws + WS_W2) + (size_t)l * DM * DFF, MTOK, DM, DFF, DFF, DFF}; E = l == 0 ? EpiAny{9, true, l} : EpiAny{2, true, l}; }
            } else if (s == 3) { g = pg8::Gemm{(const bf16*)(ws + WS_CS1024), (const bf16*)(ws + WS_YCS) + (size_t)8192 * 512, 1024, 1024, 2048, 2048, 2048}; E = EpiAny{8, true, l}; corder = (bid + nb - (nb >= 256 ? 224 : 32)) % nb; }
#ifdef NOEPI_FIRST
            if (isdup && E.mode >= 0) E.mode = 7;
#endif
            if (E.mode >= 0) {
                pg8::StaticOrder S; S.init(g.M, g.N, nb, corder);
                pg8::gemm_phase<EpiAny, pg8::StaticOrder, true, true>(lds, g, S, E);
                __syncthreads();
            }
        }
        if (s == 3) {
            if (nb >= 256) {
                if (bid < 64) rwkv_item3(p, l, lds, bid);
                else { unsigned* ctr = (unsigned*)(ws + WS_CTL + 524288) + 64 * (2 + l); volatile LAS unsigned* slot = (volatile LAS unsigned*)(lds + RING_BYTES + 64);
#pragma unroll 1
                    for (;;) { __syncthreads(); if (threadIdx.x == 0) *slot = atomicAdd(ctr, 1u); __syncthreads(); const int it = (int)*slot; if (it >= 512) break; rwkv_item3(p, l, lds, 64 + it); } }
            } else for (int it = bid; it < 576; it += nb) rwkv_item3(p, l, lds, it);
            side_queue(p, l, lds);
        }
        if (s == -1) stage_prologue(p, lds, bid, nb);
        else if (s == 0) { stage_norm(p, 0, 0, bid, nb); stage_tables(p, bid, nb); }
        else if (s == 2) {
            stage_upass(p, l, bid, nb);
#ifdef DUP_U
            stage_upass(p, l, bid, nb);
#endif
#pragma unroll 1
            for (int it = bid; it < 768; it += nb) fnet1_item(p, l, it);
#ifdef DUP_F
#pragma unroll 1
            for (int it = bid; it < 768; it += nb) fnet1_item(p, l, it);
#endif
#pragma unroll 1
            for (int it = bid; it < 768; it += nb) pool_item(p, l, lds, it);
#ifdef DUP_P
#pragma unroll 1
            for (int it = bid; it < 768; it += nb) pool_item(p, l, lds, it);
#endif
        }
        else if (s == 4) stage_post(p, l, bid, nb);
        #ifdef REP_A
        if (sti + 1 < ph_hi + ((REP_B) >= 0 ? 2 : 1)) xcd_barrier(bar);
#else
        if (st + 1 < ph_hi && step_seam(st)) xcd_barrier(bar);
#endif
    }
}

extern "C" void kernel_launch(void* const* d_in, const int* in_sizes, int n_in, void* d_out, int out_size, void* d_ws, size_t ws_size, hipStream_t stream) {
    static int grid = 0;
    if (grid == 0) {
        if (n_in != N_IN || ws_size < WS_END) { fprintf(stderr, "kernel_launch: unexpected inputs (n_in %d, ws %zu)\n", n_in, ws_size); grid = -1; return; }
        int dev = 0, cus = 0, per_cu = 0;
        (void)hipGetDevice(&dev); (void)hipDeviceGetAttribute(&cus, hipDeviceAttributeMultiprocessorCount, dev);
        (void)hipFuncSetAttribute((const void*)mega_fwd, hipFuncAttributeMaxDynamicSharedMemorySize, LDS_BYTES);
        if (hipOccupancyMaxActiveBlocksPerMultiprocessor(&per_cu, (const void*)mega_fwd, NTHR, LDS_BYTES) != hipSuccess || per_cu < 1) {
            fprintf(stderr, "kernel_launch: occupancy query reports %d blocks/CU\n", per_cu); (void)hipGetLastError(); grid = -1; return; }
        grid = cus * 1;
    }
    if (grid < 0) return;
    KP a{};
    for (int i = 0; i < N_IN; ++i) a.in[i] = (const float*)d_in[i];
    a.out = (float*)d_out; a.ws = (unsigned char*)d_ws; a.ph_lo = 0; a.ph_hi = N_STEPS;
    if (hipMemsetAsync((char*)d_ws + WS_CTL, 0, 1 * MiB, stream) != hipSuccess) { fprintf(stderr, "kernel_launch: memset failed\n"); return; }
    void* args[] = {&a};
    hipError_t e = hipLaunchCooperativeKernel((const void*)mega_fwd, dim3(grid), dim3(NTHR), args, LDS_BYTES, stream);
    if (e != hipSuccess) fprintf(stderr, "cooperative launch failed: %s (grid %d)\n", hipGetErrorString(e), grid);
}
```

```cpp
#include <hip/hip_runtime.h>
#include <hip/hip_cooperative_groups.h>
#include <cstdio>
#include <cstdint>
namespace cg = cooperative_groups;
__device__ __forceinline__ int opaque_tid() { int t = threadIdx.x; asm volatile("" : "+v"(t)); return t; }
namespace pg8 {
#define PG8_LAS __attribute__((address_space(3)))
typedef unsigned short bf16_t;
typedef short bf16x8 __attribute__((ext_vector_type(8)));
typedef float f32x4 __attribute__((ext_vector_type(4)));
typedef unsigned u32x4 __attribute__((ext_vector_type(4)));
constexpr int BM = 256, BK = 64, HALF = 128, HTB = HALF * BK * 2  , STAGE_BYTES = 8 * HTB, NXCD = 8, WGM = 8;

__host__ __device__ __forceinline__ int lds_byte(int r, int c) { const int st = (r >> 4) * 2 + (c >> 5), rr = r & 15, cc = c & 31, ob = rr * 64 + cc * 2; return st * 1024 + (ob ^ (((ob >> 9) & 1) << 5)); }
__host__ __device__ __forceinline__ void stage_rc(int b, int& R, int& C) { const int st = b / 1024, sb = b % 1024, swz = sb ^ (((sb >> 9) & 1) << 5); R = (st >> 1) * 16 + swz / 64; C = (st & 1) * 32 + (swz % 64) / 2; }
__host__ __device__ __forceinline__ int perm32(int rho) { const int n = rho >> 4, i = rho & 15; return 8 * (i >> 2) + 4 * n + (i & 3); }

struct Unit { int pm, pn; };
struct Gemm { const bf16_t* A; const bf16_t* Bt; int M, N, K, lda, ldb; };

struct StaticOrder {
    int nM, nN, nwg, G, c;
    __host__ __device__ void init(int M, int N, int G_, int c_) { nM = M / BM; nN = N / BM; nwg = nM * nN; G = G_; c = c_; }
    __host__ __device__ bool next(int i, Unit& u) const {
        const long L = (long)i * G + c; if (L >= nwg) return false;
        int wgid = (int)L; { const int q = nwg / NXCD, r = nwg % NXCD, xcd = wgid % NXCD, off = wgid / NXCD; wgid = (xcd < r ? xcd * (q + 1) : r * (q + 1) + (xcd - r) * q) + off; }
        const int nig = WGM * nN, gid = wgid / nig, fm = gid * WGM, gsz = (nM - fm) < WGM ? (nM - fm) : WGM;
        u.pm = fm + ((wgid % nig) % gsz); u.pn = (wgid % nig) / gsz; return true;
    }
    __device__ __forceinline__ void a_ready(const Unit&) const {}
    __device__ __forceinline__ void done(const Unit&) const {}
};

__device__ __forceinline__ unsigned cvt_pk_bf16(float lo, float hi) { unsigned r; asm volatile("v_cvt_pk_bf16_f32 %0, %1, %2" : "=v"(r) : "v"(lo), "v"(hi)); return r; }
typedef unsigned u32x2 __attribute__((ext_vector_type(2)));
template <int ACT  > struct EpiBf {
    static constexpr bool PERM = true, AFTER_DRAIN = false;
    bf16_t* O; int ldc;
    __device__ __forceinline__ void operator()(const f32x4 (&acc)[2][2][4][2], const Unit& u, int wr, int wc, int fr, int fq) const {
        const int row0 = u.pm * BM + wr * 64 + fr, col0 = u.pn * BM + wc * 32 + 8 * fq;
#pragma unroll
        for (int ai = 0; ai < 2; ++ai)
#pragma unroll
            for (int m = 0; m < 4; ++m) { bf16_t* rowp = O + (size_t)(row0 + ai * HALF + m * 16) * ldc + col0;
#pragma unroll
                for (int bj = 0; bj < 2; ++bj) { f32x4 v0 = acc[ai][bj][m][0], v1 = acc[ai][bj][m][1];
                    if (ACT == 1) {
#pragma unroll
                        for (int e = 0; e < 4; ++e) { float a = v0[e] > 0.f ? v0[e] : 0.f; v0[e] = a * a; float b = v1[e] > 0.f ? v1[e] : 0.f; v1[e] = b * b; } }
                    u32x4 w; w.x = cvt_pk_bf16(v0[0], v0[1]); w.y = cvt_pk_bf16(v0[2], v0[3]); w.z = cvt_pk_bf16(v1[0], v1[1]); w.w = cvt_pk_bf16(v1[2], v1[3]);
                    *(u32x4*)(rowp + bj * HALF) = w; } }
    }
};
struct EpiRes {
    static constexpr bool PERM = false, AFTER_DRAIN = false;
    float* X; const float* gate; const float* Xc; const float* Xl;
    __device__ __forceinline__ void operator()(const f32x4 (&acc)[2][2][4][2], const Unit& u, int wr, int wc, int fr, int fq) const {
        const int row0 = u.pm * BM + wr * 64 + fr, col0 = u.pn * BM + wc * 32 + 4 * fq;
        const int cond = u.pm < 32 ? 0 : 1 + ((u.pm - 32) >> 2);
        const float* gp = gate + cond * 6144 + col0;
        f32x4 gv[2][2];
#pragma unroll
        for (int bj = 0; bj < 2; ++bj)
#pragma unroll
            for (int n = 0; n < 2; ++n) gv[bj][n] = *(const f32x4*)(gp + bj * HALF + n * 16);
#pragma unroll
        for (int ai = 0; ai < 2; ++ai)
#pragma unroll
            for (int m = 0; m < 4; ++m) { const size_t ro = (size_t)(row0 + ai * HALF + m * 16) * 1024 + col0; float* rowp = X + ro; const float* srcp = u.pm < 32 ? Xc + ro : Xl + (ro - (size_t)8192 * 1024);
#pragma unroll
                for (int bj = 0; bj < 2; ++bj)
#pragma unroll
                    for (int n = 0; n < 2; ++n) { *(f32x4*)(rowp + bj * HALF + n * 16) = *(const f32x4*)(srcp + bj * HALF + n * 16) + gv[bj][n] * acc[ai][bj][m][n]; }
                if (m & 1) asm volatile("" ::: "memory"); }
    }
};
struct EpiFnet {
    static constexpr bool PERM = true, AFTER_DRAIN = false;
    bf16_t* MIX; int rowbase, L;
    __device__ __forceinline__ void operator()(const f32x4 (&acc)[2][2][4][2], const Unit& u, int wr, int wc, int fr, int fq) const {
        const int row0 = u.pm * BM + wr * 64 + fr, colw = wc * 32 + 8 * fq;
        bf16_t* base = MIX + (size_t)(rowbase + u.pn * L) * 1024 + 512 + colw;
#pragma unroll
        for (int ai = 0; ai < 2; ++ai)
#pragma unroll
            for (int m = 0; m < 4; ++m) { bf16_t* rowp = base + (size_t)(row0 + ai * HALF + m * 16) * 1024;
#pragma unroll
                for (int bj = 0; bj < 2; ++bj) { const f32x4 v0 = acc[ai][bj][m][0], v1 = acc[ai][bj][m][1];
                    u32x4 w; w.x = cvt_pk_bf16(v0[0], v0[1]); w.y = cvt_pk_bf16(v0[2], v0[3]); w.z = cvt_pk_bf16(v1[0], v1[1]); w.w = cvt_pk_bf16(v1[2], v1[3]);
                    *(u32x4*)(rowp + bj * HALF) = w; } }
    }
};

__device__ __forceinline__ float xsum_fq(float s, int fr, int fq) {
    s += __builtin_bit_cast(float, __builtin_amdgcn_ds_bpermute((((fq ^ 1) << 4) | fr) << 2, __builtin_bit_cast(int, s)));
    s += __builtin_bit_cast(float, __builtin_amdgcn_ds_bpermute((((fq ^ 2) << 4) | fr) << 2, __builtin_bit_cast(int, s)));
    return s;
}
template <int ACT> struct EpiNormBf {
    static constexpr bool PERM = true, AFTER_DRAIN = false;
    bf16_t* O; int ldc; const float* ssq; const float* sw; int swld;
    __device__ __forceinline__ void operator()(const f32x4 (&acc)[2][2][4][2], const Unit& u, int wr, int wc, int fr, int fq) const {
        const int row0 = u.pm * BM + wr * 64 + fr, col0 = u.pn * BM + wc * 32 + 8 * fq;
        const int cond = u.pm < 32 ? 0 : 1 + ((u.pm - 32) >> 2);
        f32x4 sv[2][2];
#pragma unroll
        for (int bj = 0; bj < 2; ++bj)
#pragma unroll
            for (int n = 0; n < 2; ++n) sv[bj][n] = *(const f32x4*)(sw + (size_t)cond * swld + col0 + bj * HALF + 4 * n);
        float rs[2][4];
#pragma unroll
        for (int ai = 0; ai < 2; ++ai)
#pragma unroll
            for (int m = 0; m < 4; ++m) rs[ai][m] = ssq[row0 + ai * HALF + m * 16];
#pragma unroll
        for (int ai = 0; ai < 2; ++ai)
#pragma unroll
            for (int m = 0; m < 4; ++m) rs[ai][m] = __builtin_amdgcn_rsqf(rs[ai][m] * (1.0f / 1024.0f) + 1e-6f);
#pragma unroll
        for (int ai = 0; ai < 2; ++ai)
#pragma unroll
            for (int m = 0; m < 4; ++m) { const int row = row0 + ai * HALF + m * 16; bf16_t* rowp = O + (size_t)row * ldc + col0;
                const float rstd = rs[ai][m];
#pragma unroll
                for (int bj = 0; bj < 2; ++bj) { f32x4 v0 = acc[ai][bj][m][0] * rstd + sv[bj][0], v1 = acc[ai][bj][m][1] * rstd + sv[bj][1];
                    if (ACT == 1) {
#pragma unroll
                        for (int e = 0; e < 4; ++e) { float a = v0[e] > 0.f ? v0[e] : 0.f; v0[e] = a * a; float b = v1[e] > 0.f ? v1[e] : 0.f; v1[e] = b * b; } }
                    u32x4 w; w.x = cvt_pk_bf16(v0[0], v0[1]); w.y = cvt_pk_bf16(v0[2], v0[3]); w.z = cvt_pk_bf16(v1[0], v1[1]); w.w = cvt_pk_bf16(v1[2], v1[3]);
                    *(u32x4*)(rowp + bj * HALF) = w; }
                if (m & 1) asm volatile("" ::: "memory"); }
    }
};
struct EpiResFinal {
    static constexpr bool PERM = true, AFTER_DRAIN = false;
    const bf16_t* XB; const float* gate; const float* gfin; float* out; float* ssq; unsigned* cnt;
    __device__ __forceinline__ void operator()(const f32x4 (&acc)[2][2][4][2], const Unit& u, int wr, int wc, int fr, int fq) const {
        const int row0 = u.pm * BM + wr * 64 + fr, col0 = u.pn * BM + wc * 32 + 8 * fq;
        const int cond = u.pm < 32 ? 0 : 1 + ((u.pm - 32) >> 2);
        f32x4 gt[2][2];
#pragma unroll
        for (int bj = 0; bj < 2; ++bj)
#pragma unroll
            for (int n = 0; n < 2; ++n) gt[bj][n] = *(const f32x4*)(gate + cond * 6144 + col0 + bj * HALF + n * 4);
#pragma unroll
        for (int ai = 0; ai < 2; ++ai) {
            u32x4 xb[4][2];
#pragma unroll
            for (int m = 0; m < 4; ++m)
#pragma unroll
                for (int bj = 0; bj < 2; ++bj) xb[m][bj] = *(const u32x4*)(XB + (unsigned)(row0 + ai * HALF + m * 16) * 1024u + (unsigned)col0 + bj * HALF);
#pragma unroll
            for (int m = 0; m < 4; ++m) { const int row = row0 + ai * HALF + m * 16;
                float sq = 0.f;
#pragma unroll
                for (int bj = 0; bj < 2; ++bj) { const u32x4 xw = xb[m][bj];
                    f32x4 x0 = (f32x4){__builtin_bit_cast(float, xw.x << 16), __builtin_bit_cast(float, xw.x & 0xffff0000u), __builtin_bit_cast(float, xw.y << 16), __builtin_bit_cast(float, xw.y & 0xffff0000u)};
                    f32x4 x1 = (f32x4){__builtin_bit_cast(float, xw.z << 16), __builtin_bit_cast(float, xw.z & 0xffff0000u), __builtin_bit_cast(float, xw.w << 16), __builtin_bit_cast(float, xw.w & 0xffff0000u)};
                    x0 += gt[bj][0] * acc[ai][bj][m][0]; x1 += gt[bj][1] * acc[ai][bj][m][1];
                    sq += ((x0[0] * x0[0] + x0[1] * x0[1]) + (x0[2] * x0[2] + x0[3] * x0[3])) + ((x1[0] * x1[0] + x1[1] * x1[1]) + (x1[2] * x1[2] + x1[3] * x1[3])); }
                const float t = xsum_fq(sq, fr, fq); if (fq == 0) atomicAdd(ssq + row, t); }
            asm volatile("" ::: "memory"); }
        asm volatile("s_waitcnt vmcnt(0)" ::: "memory");
        unsigned* c = cnt + 64 * u.pm;
        if (fr == 0 && fq == 0) { __hip_atomic_fetch_add(c, 1u, __ATOMIC_RELAXED, __HIP_MEMORY_SCOPE_AGENT);
            for (unsigned spin = 0; __hip_atomic_load(c, __ATOMIC_RELAXED, __HIP_MEMORY_SCOPE_AGENT) < 32u && spin < (1u << 22); ++spin) __builtin_amdgcn_s_sleep(2); }
        asm volatile("" ::: "memory");
        f32x4 gv[2][2];
#pragma unroll
        for (int bj = 0; bj < 2; ++bj)
#pragma unroll
            for (int n = 0; n < 2; ++n) gv[bj][n] = *(const f32x4*)(gfin + col0 + bj * HALF + n * 4);
#pragma unroll
        for (int ai = 0; ai < 2; ++ai) {
            u32x4 xb[4][2]; float rs[4];
#pragma unroll
            for (int m = 0; m < 4; ++m) { rs[m] = __hip_atomic_load(ssq + row0 + ai * HALF + m * 16, __ATOMIC_RELAXED, __HIP_MEMORY_SCOPE_AGENT);
#pragma unroll
                for (int bj = 0; bj < 2; ++bj) xb[m][bj] = *(const u32x4*)(XB + (unsigned)(row0 + ai * HALF + m * 16) * 1024u + (unsigned)col0 + bj * HALF); }
#pragma unroll
            for (int m = 0; m < 4; ++m) { const unsigned ro = (unsigned)(row0 + ai * HALF + m * 16) * 1024u + (unsigned)col0;
                const float rstd = __builtin_amdgcn_rsqf(rs[m] * (1.0f / 1024.0f) + 1e-6f);
#pragma unroll
                for (int bj = 0; bj < 2; ++bj) { const u32x4 xw = xb[m][bj];
                    f32x4 x0 = (f32x4){__builtin_bit_cast(float, xw.x << 16), __builtin_bit_cast(float, xw.x & 0xffff0000u), __builtin_bit_cast(float, xw.y << 16), __builtin_bit_cast(float, xw.y & 0xffff0000u)};
                    f32x4 x1 = (f32x4){__builtin_bit_cast(float, xw.z << 16), __builtin_bit_cast(float, xw.z & 0xffff0000u), __builtin_bit_cast(float, xw.w << 16), __builtin_bit_cast(float, xw.w & 0xffff0000u)};
                    f32x4 ga = gt[bj][0], gb = gt[bj][1]; asm volatile("" : "+v"(ga), "+v"(gb));
                    x0 += ga * acc[ai][bj][m][0]; x1 += gb * acc[ai][bj][m][1];
                    *(f32x4*)(out + ro + bj * HALF) = x0 * rstd * gv[bj][0]; *(f32x4*)(out + ro + bj * HALF + 4) = x1 * rstd * gv[bj][1]; } }
            asm volatile("" ::: "memory"); }
    }
};
template <bool SRC_F32, bool WRITE_H> struct EpiResNorm {
    static constexpr bool PERM = true, AFTER_DRAIN = false;
    bf16_t* XB; const float* gate; const float* Xc; const float* Xl; bf16_t* H; const float* gn; const float* scl; float* ssq;
    __device__ __forceinline__ void operator()(const f32x4 (&acc)[2][2][4][2], const Unit& u, int wr, int wc, int fr, int fq) const {
        const int row0 = u.pm * BM + wr * 64 + fr, col0 = u.pn * BM + wc * 32 + 8 * fq;
        const int cond = u.pm < 32 ? 0 : 1 + ((u.pm - 32) >> 2);
        const float* src = u.pm < 32 ? Xc : Xl - (size_t)8192 * 1024;
        f32x4 gt[2][2], gs[2][2];
#pragma unroll
        for (int bj = 0; bj < 2; ++bj)
#pragma unroll
            for (int n = 0; n < 2; ++n) { const int col = col0 + bj * HALF + n * 4;
                gt[bj][n] = *(const f32x4*)(gate + cond * 6144 + col);
                if (WRITE_H) gs[bj][n] = *(const f32x4*)(gn + col) * (*(const f32x4*)(scl + cond * 6144 + col) + 1.0f); }
        constexpr int NB = SRC_F32 ? 2 : 4;
#pragma unroll
        for (int ai = 0; ai < 2; ++ai)
#pragma unroll
        for (int mb = 0; mb < 4; mb += NB) {
            u32x4 xb[NB][2]; f32x4 xf[NB][2][2];
#pragma unroll
            for (int mm = 0; mm < NB; ++mm) { const unsigned ro = (unsigned)(row0 + ai * HALF + (mb + mm) * 16) * 1024u + (unsigned)col0;
#pragma unroll
                for (int bj = 0; bj < 2; ++bj) {
                    if (SRC_F32) { xf[mm][bj][0] = *(const f32x4*)(src + ro + bj * HALF); xf[mm][bj][1] = *(const f32x4*)(src + ro + bj * HALF + 4); }
                    else xb[mm][bj] = *(const u32x4*)(XB + ro + bj * HALF); } }
#pragma unroll
            for (int mm = 0; mm < NB; ++mm) { const int m = mb + mm; const int row = row0 + ai * HALF + m * 16; const unsigned ro = (unsigned)row * 1024u + (unsigned)col0;
                float sq = 0.f;
#pragma unroll
                for (int bj = 0; bj < 2; ++bj) { const unsigned o = ro + bj * HALF;
                    f32x4 x0, x1;
                    if (SRC_F32) { x0 = xf[mm][bj][0]; x1 = xf[mm][bj][1]; }
                    else { const u32x4 xw = xb[mm][bj];
                        x0 = (f32x4){__builtin_bit_cast(float, xw.x << 16), __builtin_bit_cast(float, xw.x & 0xffff0000u), __builtin_bit_cast(float, xw.y << 16), __builtin_bit_cast(float, xw.y & 0xffff0000u)};
                        x1 = (f32x4){__builtin_bit_cast(float, xw.z << 16), __builtin_bit_cast(float, xw.z & 0xffff0000u), __builtin_bit_cast(float, xw.w << 16), __builtin_bit_cast(float, xw.w & 0xffff0000u)}; }
                    x0 += gt[bj][0] * acc[ai][bj][m][0]; x1 += gt[bj][1] * acc[ai][bj][m][1];
                    u32x4 xo; xo.x = cvt_pk_bf16(x0[0], x0[1]); xo.y = cvt_pk_bf16(x0[2], x0[3]); xo.z = cvt_pk_bf16(x1[0], x1[1]); xo.w = cvt_pk_bf16(x1[2], x1[3]);
                    *(u32x4*)(XB + o) = xo;
                    sq += ((x0[0] * x0[0] + x0[1] * x0[1]) + (x0[2] * x0[2] + x0[3] * x0[3])) + ((x1[0] * x1[0] + x1[1] * x1[1]) + (x1[2] * x1[2] + x1[3] * x1[3]));
                    if (WRITE_H) { const f32x4 h0 = x0 * gs[bj][0], h1 = x1 * gs[bj][1];
                        u32x4 w; w.x = cvt_pk_bf16(h0[0], h0[1]); w.y = cvt_pk_bf16(h0[2], h0[3]); w.z = cvt_pk_bf16(h1[0], h1[1]); w.w = cvt_pk_bf16(h1[2], h1[3]);
                        *(u32x4*)(H + o) = w; } }
                const float t = xsum_fq(sq, fr, fq); if (fq == 0) atomicAdd(ssq + row, t);
            }
            asm volatile("" ::: "memory"); }
    }
};
template <class Epi, class Sched, bool ALIGN_EPI = false, bool SP2 = false>
__device__ __forceinline__ void gemm_phase(PG8_LAS unsigned char* lds, const Gemm g, const Sched& S, const Epi& E) {
    const int tid = opaque_tid(), wid = __builtin_amdgcn_readfirstlane(tid >> 6), lane = tid & 63, wr = wid >> 2, wc = wid & 3, fr = lane & 15, fq = lane >> 4;
    const int K = g.K, nt = K / BK;
    unsigned voffA[2], voffB[2];
#pragma unroll
    for (int i = 0; i < 2; ++i) { int R, C; stage_rc(tid * 16 + i * 8192, R, C); const int Rb = E.PERM ? ((R & ~31) + perm32(R & 31)) : R;
        voffA[i] = (unsigned)(R * g.lda + C) * 2u; voffB[i] = (unsigned)(Rb * g.ldb + C) * 2u; }
    const size_t kstep = (size_t)(BK * 2);
    const size_t hstepA = (size_t)HALF * g.lda * 2, hstepB = (size_t)HALF * g.ldb * 2;
    const size_t tstepA = 2 * hstepA, tstepB = 2 * hstepB;
    const unsigned ldsw = (unsigned)wid * 1024u;
    const int aoff = lds_byte(wr * 64 + fr, fq * 8), boff = lds_byte(wc * 32 + fr, fq * 8);
#define PG8_SA(b, h) (((b) * 2 + (h)) * HTB)
#define PG8_SB(b, h) ((4 + (b) * 2 + (h)) * HTB)
#define PG8_STAGE(bufoff, gbase, voff) do { _Pragma("unroll") for (int _i = 0; _i < 2; ++_i) \
        __builtin_amdgcn_global_load_lds((const unsigned*)((const char*)(gbase) + (voff)[_i]), (PG8_LAS unsigned*)(lds + (bufoff) + ldsw + _i * 8192), 16, 0, 0); } while (0)
#define PG8_LDA(dst, b, h) do { _Pragma("unroll") for (int m = 0; m < 4; ++m) _Pragma("unroll") for (int k = 0; k < 2; ++k) dst[m][k] = *(const PG8_LAS bf16x8*)(lds + PG8_SA(b, h) + aoff + m * 2048 + k * 1024); } while (0)
#define PG8_LDB(dst, b, h) do { _Pragma("unroll") for (int n = 0; n < 2; ++n) _Pragma("unroll") for (int k = 0; k < 2; ++k) dst[n][k] = *(const PG8_LAS bf16x8*)(lds + PG8_SB(b, h) + boff + n * 2048 + k * 1024); } while (0)
#define PG8_MMA(ai, bj, At, Bt) do { __builtin_amdgcn_s_setprio(1); _Pragma("unroll") for (int m = 0; m < 4; ++m) _Pragma("unroll") for (int n = 0; n < 2; ++n) _Pragma("unroll") for (int k = 0; k < 2; ++k) \
        acc[ai][bj][m][n] = __builtin_amdgcn_mfma_f32_16x16x32_bf16(Bt[n][k], At[m][k], acc[ai][bj][m][n], 0, 0, 0); __builtin_amdgcn_s_setprio(0); } while (0)
#define PG8_WAIT_V(n) asm volatile("s_waitcnt vmcnt(" #n ")" ::: "memory")
#define PG8_WAIT_L(n) asm volatile("s_waitcnt lgkmcnt(" #n ")" ::: "memory")
#define PG8_BAR __builtin_amdgcn_s_barrier()
#define PG8_SCHED __builtin_amdgcn_sched_barrier(0)
    Unit cur, nxt; int ui = 0;
    if (!S.next(0, cur)) return;
    f32x4 acc[2][2][4][2];
#pragma unroll
    for (int a = 0; a < 2; ++a)
#pragma unroll
        for (int b = 0; b < 2; ++b)
#pragma unroll
            for (int m = 0; m < 4; ++m)
#pragma unroll
                for (int n = 0; n < 2; ++n) acc[a][b][m][n] = (f32x4){0.f, 0.f, 0.f, 0.f};
    bf16x8 At[4][2], B0[2][2], B1[2][2];
    const char* cA = (const char*)g.A + (size_t)cur.pm * tstepA; const char* cB = (const char*)g.Bt + (size_t)cur.pn * tstepB;
    S.a_ready(cur);
    if constexpr (SP2) {
        PG8_STAGE(PG8_SB(0, 0), cB, voffB); PG8_STAGE(PG8_SB(0, 1), cB + hstepB, voffB); PG8_STAGE(PG8_SA(0, 0), cA, voffA); PG8_STAGE(PG8_SA(0, 1), cA + hstepA, voffA);
        if (wr == 1) PG8_BAR;
        PG8_WAIT_V(2); PG8_BAR;
        PG8_STAGE(PG8_SB(1, 0), cB + kstep, voffB); PG8_STAGE(PG8_SA(1, 0), cA + kstep, voffA); PG8_STAGE(PG8_SB(1, 1), cB + hstepB + kstep, voffB);
        PG8_WAIT_V(6); PG8_BAR;
    } else {
        PG8_STAGE(PG8_SB(0, 0), cB, voffB); PG8_STAGE(PG8_SA(0, 0), cA, voffA); PG8_STAGE(PG8_SB(0, 1), cB + hstepB, voffB); PG8_STAGE(PG8_SA(0, 1), cA + hstepA, voffA);
        if (wr == 1) PG8_BAR;
        PG8_WAIT_V(4); PG8_BAR;
        PG8_STAGE(PG8_SB(1, 0), cB + kstep, voffB); PG8_STAGE(PG8_SA(1, 0), cA + kstep, voffA); PG8_STAGE(PG8_SB(1, 1), cB + hstepB + kstep, voffB);
        PG8_WAIT_V(6); PG8_BAR;
    }
    for (;;) {
        const bool has_next = S.next(ui + 1, nxt);
        const char* nA = has_next ? (const char*)g.A + (size_t)nxt.pm * tstepA : cA; const char* nB = has_next ? (const char*)g.Bt + (size_t)nxt.pn * tstepB : cB;
        for (int t = 0; t < nt; t += 2) {
            const bool last = (t == nt - 2);
            const char* a1 = cA + (size_t)(t + 1) * kstep;
            const char* a2 = last ? nA : cA + (size_t)(t + 2) * kstep; const char* b2 = last ? nB : cB + (size_t)(t + 2) * kstep;
            const char* a3 = a2 + kstep; const char* b3 = b2 + kstep;
            if (last && has_next) S.a_ready(nxt);
            if constexpr (SP2) {
            PG8_LDB(B0, 0, 0); PG8_LDB(B1, 0, 1); PG8_SCHED; PG8_LDA(At, 0, 0); PG8_STAGE(PG8_SA(1, 1), a1 + hstepA, voffA);
            PG8_WAIT_V(8); PG8_WAIT_L(0); PG8_BAR; PG8_MMA(0, 0, At, B0); PG8_MMA(0, 1, At, B1); PG8_BAR; PG8_SCHED;
            PG8_LDA(At, 0, 1); PG8_STAGE(PG8_SB(0, 0), b2, voffB); PG8_STAGE(PG8_SB(0, 1), b2 + hstepB, voffB); PG8_STAGE(PG8_SA(0, 0), a2, voffA);
            PG8_WAIT_V(8); PG8_WAIT_L(0); PG8_BAR; PG8_MMA(1, 0, At, B0); PG8_MMA(1, 1, At, B1); PG8_BAR; PG8_SCHED;
            PG8_LDB(B0, 1, 0); PG8_LDB(B1, 1, 1); PG8_SCHED; PG8_LDA(At, 1, 0); PG8_STAGE(PG8_SA(0, 1), a2 + hstepA, voffA);
            PG8_WAIT_V(8); PG8_WAIT_L(0); PG8_BAR; PG8_MMA(0, 0, At, B0); PG8_MMA(0, 1, At, B1); PG8_BAR; PG8_SCHED;
            PG8_LDA(At, 1, 1); PG8_STAGE(PG8_SB(1, 0), b3, voffB); PG8_STAGE(PG8_SB(1, 1), b3 + hstepB, voffB); PG8_STAGE(PG8_SA(1, 0), a3, voffA);
            PG8_WAIT_V(8); PG8_WAIT_L(0); PG8_BAR; PG8_MMA(1, 0, At, B0); PG8_MMA(1, 1, At, B1); PG8_BAR; PG8_SCHED;
            } else {
            PG8_LDB(B0, 0, 0); PG8_SCHED; PG8_LDA(At, 0, 0); PG8_STAGE(PG8_SA(1, 1), a1 + hstepA, voffA);
            PG8_WAIT_L(8); PG8_BAR; PG8_WAIT_L(0); PG8_MMA(0, 0, At, B0); PG8_BAR; PG8_SCHED;
            PG8_LDB(B1, 0, 1); PG8_STAGE(PG8_SB(0, 0), b2, voffB);
            PG8_BAR; PG8_WAIT_L(0); PG8_MMA(0, 1, At, B1); PG8_BAR;
            PG8_LDA(At, 0, 1); PG8_STAGE(PG8_SA(0, 0), a2, voffA);
            PG8_BAR; PG8_WAIT_L(0); PG8_MMA(1, 0, At, B0); PG8_BAR; PG8_SCHED;
            PG8_STAGE(PG8_SB(0, 1), b2 + hstepB, voffB);
            PG8_WAIT_V(6); PG8_BAR; PG8_MMA(1, 1, At, B1); PG8_BAR;
            PG8_LDB(B0, 1, 0); PG8_SCHED; PG8_LDA(At, 1, 0); PG8_STAGE(PG8_SA(0, 1), a2 + hstepA, voffA);
            PG8_WAIT_L(8); PG8_BAR; PG8_WAIT_L(0); PG8_MMA(0, 0, At, B0); PG8_BAR; PG8_SCHED;
            PG8_LDB(B1, 1, 1); PG8_STAGE(PG8_SB(1, 0), b3, voffB);
            PG8_BAR; PG8_WAIT_L(0); PG8_MMA(0, 1, At, B1); PG8_BAR;
            PG8_LDA(At, 1, 1); PG8_STAGE(PG8_SA(1, 0), a3, voffA);
            PG8_BAR; PG8_WAIT_L(0); PG8_MMA(1, 0, At, B0); PG8_BAR; PG8_SCHED;
            PG8_STAGE(PG8_SB(1, 1), b3 + hstepB, voffB);
            PG8_WAIT_V(6); PG8_BAR; PG8_MMA(1, 1, At, B1); PG8_BAR;
            }
        }
        if constexpr (ALIGN_EPI) { if (wr == 0) PG8_BAR; }
        if constexpr (!Epi::AFTER_DRAIN) { int fr2 = fr, fq2 = fq; asm volatile("" : "+v"(fr2), "+v"(fq2)); E(acc, cur, wr, wc, fr2, fq2); S.done(cur); }
        if (!has_next) break;
#pragma unroll
        for (int a = 0; a < 2; ++a)
#pragma unroll
            for (int b = 0; b < 2; ++b)
#pragma unroll
                for (int m = 0; m < 4; ++m)
#pragma unroll
                    for (int n = 0; n < 2; ++n) acc[a][b][m][n] = (f32x4){0.f, 0.f, 0.f, 0.f};
        cur = nxt; cA = nA; cB = nB; ++ui;
        if constexpr (ALIGN_EPI) { if (wr == 1) PG8_BAR; }
    }
    PG8_WAIT_V(0);
    if constexpr (!ALIGN_EPI) { if (wr == 0) PG8_BAR; }
    PG8_BAR;
    if constexpr (Epi::AFTER_DRAIN) { E.fused(acc, cur, wr, wc, fr, fq, lds, wid, lane); S.done(cur); }
#undef PG8_SA
#undef PG8_SB
#undef PG8_STAGE
#undef PG8_LDA
#undef PG8_LDB
#undef PG8_MMA
#undef PG8_WAIT_V
#undef PG8_WAIT_L
#undef PG8_BAR
#undef PG8_SCHED
}
}

#define LAS __attribute__((address_space(3)))
typedef unsigned short bf16;
typedef float f32x4 __attribute__((ext_vector_type(4)));
typedef unsigned u32x4 __attribute__((ext_vector_type(4)));
typedef unsigned u32x2 __attribute__((ext_vector_type(2)));
constexpr int DM = 1024, NCTX = 8192, MTOK = 12288, DINP = 2560, DFF = 4096;
constexpr int R_OFF = 0, K_OFF = 512, V_OFF = 1024, WD_OFF = 1536, AD_OFF = 1664, GD_OFF = 1792, F_OFF = 1920, P_OFF = 2176, DIN = 2432;
constexpr size_t MiB = 1u << 20;
constexpr size_t WS_CTL = 0, WS_MOD = 1 * MiB, WS_FW = 1 * MiB + 512 * 1024, WS_BC = 2 * MiB, WS_CS256 = 3 * MiB, WS_CS1024 = 4 * MiB, WS_WIN = 8 * MiB, WS_WOUT = 18 * MiB,
                 WS_W1 = 22 * MiB, WS_W2 = 38 * MiB, WS_H = 54 * MiB, WS_MIXED = 78 * MiB, WS_PROJ = 102 * MiB, WS_YCS = 162 * MiB, WS_YF = 102 * MiB, WS_YB = 126 * MiB  , WS_U = 174 * MiB, WS_KINV = 220 * MiB, WS_GUPT = 221 * MiB,
                 WS_FF = 102 * MiB, WS_WUPT = 222 * MiB, WS_AUPT = 222 * MiB + 256 * 1024, WS_SSQ = 223 * MiB, WS_WPT = 223 * MiB + 512 * 1024, WS_SW1 = 224 * MiB, WS_SWIN = 224 * MiB + 256 * 1024, WS_XB = 226 * MiB, WS_END = 250 * MiB;
constexpr int LDS_BYTES = 147456, RING_BYTES = 131072, MISC_OFF = RING_BYTES + 320;
constexpr int NTHR = 512;
enum { I_XP = 0, I_XS, I_STATE, I_C, I_CCTX, I_WADA, I_BADA, I_N1G, I_WIN, I_MU, I_W0, I_WUP, I_A0, I_AUP, I_GUP, I_KK, I_KA, I_RK, I_LNW, I_LNB, I_WFNET, I_WPOOL, I_PSCALE, I_WOUT, I_N2G, I_WFF1, I_WFF2, I_FNG, N_IN };
struct KP { const float* in[N_IN]; float* out; unsigned char* ws; int ph_lo, ph_hi; };
typedef const __attribute__((address_space(4))) KP CKP;

__device__ __forceinline__ unsigned f2bf(float f) { unsigned u = __builtin_bit_cast(unsigned, f); return (u + 0x7fffu + ((u >> 16) & 1u)) >> 16; }
__device__ __forceinline__ unsigned pk2(float lo, float hi) { return f2bf(lo) | (f2bf(hi) << 16); }
__device__ __forceinline__ float bflo(unsigned w) { return __builtin_bit_cast(float, w << 16); }
__device__ __forceinline__ float bfhi(unsigned w) { return __builtin_bit_cast(float, w & 0xffff0000u); }
__device__ __forceinline__ float bf1(bf16 h) { return __builtin_bit_cast(float, (unsigned)h << 16); }
__device__ __forceinline__ float fexp(float x) { return __builtin_amdgcn_exp2f(x * 1.4426950408889634f); }
__device__ __forceinline__ float flog(float x) { return __builtin_amdgcn_logf(x) * 0.6931471805599453f; }
__device__ __forceinline__ float frcp(float x) { return __builtin_amdgcn_rcpf(x); }
__device__ __forceinline__ float frsq(float x) { return __builtin_amdgcn_rsqf(x); }
__device__ __forceinline__ float fsigmoid(float x) { return frcp(1.0f + fexp(-x)); }
template <int CTRL> __device__ __forceinline__ float dppf(float x) { return __builtin_bit_cast(float, __builtin_amdgcn_update_dpp(0, __builtin_bit_cast(int, x), CTRL, 0xF, 0xF, true)); }
__device__ __forceinline__ float red8(float x)  { x += dppf<0xB1>(x); x += dppf<0x4E>(x); x += dppf<0x141>(x); return x; }
__device__ __forceinline__ float red16(float x) { x += dppf<0xB1>(x); x += dppf<0x4E>(x); x += dppf<0x141>(x); x += dppf<0x140>(x); return x; }
__device__ __forceinline__ float wave_sum(float v) {
    v = red16(v);
    const float s0 = __builtin_bit_cast(float, __builtin_amdgcn_readlane(__builtin_bit_cast(int, v), 0)), s1 = __builtin_bit_cast(float, __builtin_amdgcn_readlane(__builtin_bit_cast(int, v), 16));
    const float s2 = __builtin_bit_cast(float, __builtin_amdgcn_readlane(__builtin_bit_cast(int, v), 32)), s3 = __builtin_bit_cast(float, __builtin_amdgcn_readlane(__builtin_bit_cast(int, v), 48));
    return (s0 + s1) + (s2 + s3);
}
__device__ __forceinline__ void load4bf(const bf16* p, float (&o)[4]) { const u32x2 w = *(const u32x2*)p; o[0] = bflo(w.x); o[1] = bfhi(w.x); o[2] = bflo(w.y); o[3] = bfhi(w.y); }
__device__ __forceinline__ void load8bf(const bf16* p, float (&o)[8]) { const u32x4 w = *(const u32x4*)p; o[0] = bflo(w.x); o[1] = bfhi(w.x); o[2] = bflo(w.y); o[3] = bfhi(w.y); o[4] = bflo(w.z); o[5] = bfhi(w.z); o[6] = bflo(w.w); o[7] = bfhi(w.w); }
__device__ __forceinline__ void shift4(const bf16* proj, int row, bool hasp, bool hasn, int col, const float* mu, float (&u)[4]) {
    float p[4], a[4] = {0.f, 0.f, 0.f, 0.f}, b[4] = {0.f, 0.f, 0.f, 0.f};
    load4bf(proj + (size_t)row * DINP + col, p);
    if (hasp) load4bf(proj + (size_t)(row - 1) * DINP + col, a);
    if (hasn) load4bf(proj + (size_t)(row + 1) * DINP + col, b);
    const f32x4 m = *(const f32x4*)(mu + col);
#pragma unroll
    for (int j = 0; j < 4; ++j) u[j] = p[j] + m[j] * (0.5f * (a[j] + b[j]) - p[j]);
}

__device__ __forceinline__ void gemv5_cols(LAS float* sc, LAS float* red, const float* W, int ldw, int colw, const float* bias, float* out, int ldo, int colo, int tid) {
    const int cgi = tid & 15, kg = tid >> 4;
    f32x4 acc[5];
#pragma unroll
    for (int c = 0; c < 5; ++c) acc[c] = (f32x4){0.f, 0.f, 0.f, 0.f};
    const float* wp = W + (size_t)(kg * 32) * ldw + colw + cgi * 4;
#pragma unroll 16
    for (int kk = 0; kk < 32; ++kk) { const f32x4 w = *(const f32x4*)(wp + (size_t)kk * ldw);
#pragma unroll
        for (int c = 0; c < 5; ++c) acc[c] += sc[c * 1024 + kg * 32 + kk] * w; }
#pragma unroll
    for (int c = 0; c < 5; ++c) *(LAS f32x4*)(red + (kg * 5 + c) * 64 + cgi * 4) = acc[c];
    __syncthreads();
    if (tid < 320) { const int cond = tid >> 6, col = tid & 63; float sm = bias ? bias[colo + col] : 0.f;
        for (int g = 0; g < 32; ++g) sm += red[(g * 5 + cond) * 64 + col];
        out[(size_t)cond * ldo + colo + col] = sm; }
    __syncthreads();
}
__device__ __forceinline__ void mod_item(CKP& p, LAS unsigned char* lds, int it) {
    const int tid = opaque_tid(); unsigned char* ws = p.ws;
    LAS float* sc = (LAS float*)lds; LAS float* red = (LAS float*)(lds + 20480);
    const int l = it / 96, cgp = it % 96;
    for (int i = tid; i < 5 * 1024; i += NTHR) { const int cond = i >> 10, k = i & 1023; const float v = cond == 0 ? p.in[I_CCTX][k] : p.in[I_C][(cond - 1) * 1024 + k]; sc[i] = v * fsigmoid(v); }
    __syncthreads();
    gemv5_cols(sc, red, p.in[I_WADA] + (size_t)l * 1024 * 6144, 6144, cgp * 64, p.in[I_BADA] + l * 6144, (float*)(ws + WS_MOD) + (size_t)l * 5 * 6144, 6144, cgp * 64, tid);
}
constexpr int TI_IN = 16 * 76, TI_OUT = 16 * 32, TI_1 = 16 * 128, TI_2 = 64 * 32, TI_L = TI_IN + TI_OUT + TI_1 + TI_2;
struct TrItem { const float* src; bf16* dst; const float* shv; float* sw; int N, K, swld; };
__device__ __forceinline__ TrItem tr_decode(CKP& p, int it) {
    unsigned char* ws = p.ws; const int l = it / TI_L; int r = it % TI_L;
    const float* W; bf16* WT; int K, N; const float* shv = nullptr; float* sw = nullptr; int swld = 0;
    if (r < TI_IN) { W = p.in[I_WIN] + (size_t)l * DM * DIN; K = DM; N = DIN; WT = (bf16*)(ws + WS_WIN) + (size_t)l * DINP * DM;
        if (l == 1) { shv = (const float*)(ws + WS_MOD) + (size_t)5 * 6144; sw = (float*)(ws + WS_SWIN); swld = DINP; } }
    else if ((r -= TI_IN) < TI_OUT) { W = p.in[I_WOUT] + (size_t)l * DM * DM; K = DM; N = DM; WT = (bf16*)(ws + WS_WOUT) + (size_t)l * DM * DM; }
    else if ((r -= TI_OUT) < TI_1) { W = p.in[I_WFF1] + (size_t)l * DM * DFF; K = DM; N = DFF; WT = (bf16*)(ws + WS_W1) + (size_t)l * DFF * DM;
        shv = (const float*)(ws + WS_MOD) + (size_t)l * 5 * 6144 + 3 * 1024; sw = (float*)(ws + WS_SW1) + (size_t)l * 5 * DFF; swld = DFF; }
    else { r -= TI_1; W = p.in[I_WFF2] + (size_t)l * DFF * DM; K = DFF; N = DM; WT = (bf16*)(ws + WS_W2) + (size_t)l * DM * DFF; }
    const int nblk = N / 32, k0 = 64 * (r / nblk), n0 = 32 * (r % nblk);
    return TrItem{W + (size_t)k0 * N + n0, WT + (size_t)n0 * K + k0, shv ? shv + k0 : nullptr, sw ? sw + n0 : nullptr, N, K, swld};
}
__device__ __forceinline__ void transpose_range(CKP& p, LAS unsigned char* lds, int first, int last, int bid, int nb) {
    const int tid = opaque_tid(), lane = tid & 63, wave = tid >> 6;
    LAS float* scr = (LAS float*)(lds + wave * 16384);
    int it = first + bid * 8 + wave;
    if (it >= last) return;
    TrItem cur = tr_decode(p, it);
    float tv[32];
#pragma unroll
    for (int i = 0; i < 32; ++i) tv[i] = cur.src[(size_t)(2 * i + (lane >> 5)) * cur.N + (lane & 31)];
#pragma unroll 1
    for (;;) {
        const int c = lane & 7;
        f32x4 sv[5][2];
        if (cur.shv) {
#pragma unroll
            for (int cd = 0; cd < 5; ++cd) { sv[cd][0] = *(const f32x4*)(cur.shv + cd * 6144 + 8 * c); sv[cd][1] = *(const f32x4*)(cur.shv + cd * 6144 + 8 * c + 4); } }
#pragma unroll
        for (int i = 0; i < 32; ++i) scr[(2 * i + (lane >> 5)) * 33 + (lane & 31)] = tv[i];
        const int nit = it + nb * 8; const bool more = nit < last;
        const TrItem nxt = tr_decode(p, more ? nit : it);
        if (more) {
#pragma unroll
            for (int i = 0; i < 32; ++i) tv[i] = nxt.src[(size_t)(2 * i + (lane >> 5)) * nxt.N + (lane & 31)]; }
        asm volatile("s_waitcnt lgkmcnt(0)" ::: "memory");
        if (cur.shv) {
#pragma unroll
            for (int j = 0; j < 4; ++j) { const int n = (lane >> 3) + 8 * j; const LAS float* sp = scr + (8 * c) * 33 + n;
                float v[8];
#pragma unroll
                for (int kk = 0; kk < 8; ++kk) v[kk] = sp[kk * 33];
                u32x4 o; o.x = pk2(v[0], v[1]); o.y = pk2(v[2], v[3]); o.z = pk2(v[4], v[5]); o.w = pk2(v[6], v[7]);
                *(u32x4*)(cur.dst + (size_t)n * cur.K + 8 * c) = o;
#pragma unroll
                for (int cd = 0; cd < 5; ++cd) {
                    float d = ((v[0] * sv[cd][0][0] + v[1] * sv[cd][0][1]) + (v[2] * sv[cd][0][2] + v[3] * sv[cd][0][3])) + ((v[4] * sv[cd][1][0] + v[5] * sv[cd][1][1]) + (v[6] * sv[cd][1][2] + v[7] * sv[cd][1][3]));
                    d += dppf<0xB1>(d); d += dppf<0x4E>(d); d += dppf<0x141>(d);
                    if (c == 0) atomicAdd(cur.sw + cd * cur.swld + n, d); } }
        } else {
#pragma unroll
            for (int j = 0; j < 4; ++j) { const int n = (lane >> 3) + 8 * j; const LAS float* sp = scr + (8 * c) * 33 + n;
                u32x4 o; o.x = pk2(sp[0 * 33], sp[1 * 33]); o.y = pk2(sp[2 * 33], sp[3 * 33]); o.z = pk2(sp[4 * 33], sp[5 * 33]); o.w = pk2(sp[6 * 33], sp[7 * 33]);
                *(u32x4*)(cur.dst + (size_t)n * cur.K + 8 * c) = o; }
        }
        asm volatile("s_waitcnt lgkmcnt(0)" ::: "memory");
        if (!more) break;
        cur = nxt; it = nit;
    }
}
__device__ __forceinline__ void stage_prologue(CKP& p, LAS unsigned char* lds, int bid, int nb) {
    const int tid = opaque_tid();
    unsigned char* ws = p.ws;
    transpose_range(p, lds, 0, TI_IN, bid, nb);
    const int gt = bid * NTHR + tid, NGT = nb * NTHR;
#pragma unroll 1
    for (int i = gt; i < 2 * 128 * DM / 8; i += NGT) { const int l = i / (128 * DM / 8), r = i % (128 * DM / 8);
        u32x4 z = (u32x4){0u, 0u, 0u, 0u}; asm volatile("" : "+v"(z));
        *(u32x4*)((bf16*)(ws + WS_WIN) + (size_t)l * DINP * DM + (size_t)DIN * DM + (size_t)r * 8) = z; }
#pragma unroll 1
    for (int i = gt; i < (5 * DINP + 2 * 5 * DFF) / 4; i += NGT) { f32x4 z = (f32x4){0.f, 0.f, 0.f, 0.f}; asm volatile("" : "+v"(z));
        if (i < 5 * DINP / 4) ((f32x4*)(ws + WS_SWIN))[i] = z; else ((f32x4*)(ws + WS_SW1))[i - 5 * DINP / 4] = z; }
    __syncthreads();
#pragma unroll 1
    for (int it = bid; it < 192; it += nb) mod_item(p, lds, it);
}
__device__ __forceinline__ void stage_tables(CKP& p, int bid, int nb) {
    const int tid = opaque_tid(); unsigned char* ws = p.ws;
    const int gt = bid * NTHR + tid, NGT = nb * NTHR;
#pragma unroll 1
    for (int i = gt; i < 256 * 512 + 1024 * 2048; i += NGT) {
        int L, k, j; bf16* dst;
        if (i < 256 * 512) { L = 256; k = i / 512; j = i % 512; dst = (bf16*)(ws + WS_CS256) + i; }
        else { const int i2 = i - 256 * 512; L = 1024; k = i2 / 2048; j = i2 % 2048; dst = (bf16*)(ws + WS_CS1024) + i2; }
        const int jj = j >= L ? j - L : j; const int idx = (k * jj) & (L - 1);
        const float rev = (float)idx * (L == 256 ? (1.0f / 256.0f) : (1.0f / 1024.0f));
        *dst = (bf16)f2bf(j >= L ? -__builtin_amdgcn_sinf(rev) : __builtin_amdgcn_cosf(rev));
    }
#pragma unroll 1
    for (int i = gt; i < 2 * 4 * 64 * 128; i += NGT) {
        const int o = i & 127, c = (i >> 7) & 63, lg = i >> 13; const float* wf = p.in[I_WFNET] + (size_t)lg * 4096 + (o & 63);
        float acc = 0.f;
        if (o < 64) { for (int cp = 0; cp < 64; ++cp) acc += __builtin_amdgcn_cosf((float)((c * cp) & 63) * (1.0f / 64.0f)) * wf[cp * 64]; }
        else { for (int cp = 0; cp < 64; ++cp) acc += __builtin_amdgcn_sinf((float)((c * cp) & 63) * (1.0f / 64.0f)) * wf[cp * 64]; }
        ((bf16*)(ws + WS_FW))[(size_t)(lg * 128 + o) * 64 + c] = (bf16)f2bf(acc);
    }
#pragma unroll 1
    for (int i = gt; i < 2 * 4 * 64 * 64; i += NGT) { const int o = i & 63, c = (i >> 6) & 63, lg = i >> 12;
        ((bf16*)(ws + WS_WPT))[(size_t)(lg * 64 + o) * 64 + c] = (bf16)f2bf(p.in[I_WPOOL][i]); }
#pragma unroll 1
    for (int i = gt; i < 2 * 2 * 64 * 512; i += NGT) { const int c = i & 511, r = (i >> 9) & 63, ld = i >> 15;
        ((bf16*)(ws + WS_WUPT))[(size_t)(ld * 512 + c) * 64 + r] = (bf16)f2bf(p.in[I_WUP][i]);
        ((bf16*)(ws + WS_AUPT))[(size_t)(ld * 512 + c) * 64 + r] = (bf16)f2bf(p.in[I_AUP][i]); }
#pragma unroll 1
    for (int i = gt; i < 2 * 128 * 512; i += NGT) { const int c = i & 511, r = (i >> 9) & 127, ll = i >> 16;
        ((bf16*)(ws + WS_GUPT))[(size_t)(ll * 512 + c) * 128 + r] = (bf16)f2bf(p.in[I_GUP][i]); }
}
__device__ __forceinline__ void side_queue(CKP& p, LAS unsigned char* lds, int qi, int nsh, int first, int csz, int nch) {
    const int tid = opaque_tid();
    unsigned* ctr = (unsigned*)(p.ws + WS_CTL + 524288) + 64 * qi;
    volatile LAS unsigned* slot = (volatile LAS unsigned*)(lds + RING_BYTES + 64);
    __syncthreads();
#pragma unroll 1
    for (;;) {
        if (tid == 0) *slot = atomicAdd(ctr, 1u);
        __syncthreads();
        const int it = (int)*slot;
        __syncthreads();
        if (it >= nsh + nch) break;
        { const int c0 = first + csz * (it - nsh); transpose_range(p, lds, c0, c0 + csz, 0, 1); }
        __syncthreads();
    }
}

__device__ __forceinline__ void stage_norm(CKP& p, int l, int which, int bid, int nb) {
    const int tid = opaque_tid(), lane = tid & 63, wave = tid >> 6;
    const float* g = p.in[which ? I_N2G : I_N1G] + l * DM;
    const float* mod = (const float*)(p.ws + WS_MOD) + (size_t)l * 5 * 6144 + (which ? 3 * 1024 : 0);
    bf16* H = (bf16*)(p.ws + WS_H);
#pragma unroll 1
    for (int row0 = bid * 8 + wave; row0 < MTOK; row0 += nb * 16) {
        f32x4 v[2][4]; float s[2];
#pragma unroll
        for (int z = 0; z < 2; ++z) { const int row = min(row0 + z * nb * 8, MTOK - 1);
            const float* xsrc = (l == 0 && which == 0) ? (row < NCTX ? p.in[I_XP] + (size_t)row * DM : p.in[I_XS] + (size_t)(row - NCTX) * DM) : p.out + (size_t)row * DM;
            const f32x4* xr = (const f32x4*)xsrc + lane;
#pragma unroll
            for (int j = 0; j < 4; ++j) v[z][j] = xr[64 * j]; }
#pragma unroll
        for (int z = 0; z < 2; ++z) { const int row = row0 + z * nb * 8;
            s[z] = 0.f;
#pragma unroll
            for (int j = 0; j < 4; ++j) s[z] += (v[z][j].x * v[z][j].x + v[z][j].y * v[z][j].y) + (v[z][j].z * v[z][j].z + v[z][j].w * v[z][j].w);
            const float rstd = frsq(wave_sum(s[z]) * (1.0f / DM) + 1e-6f);
            if (row < MTOK) {
                const int cond = row < NCTX ? 0 : 1 + ((row - NCTX) >> 10);
                const float* sh = mod + cond * 6144; const float* scl = sh + 1024;
                unsigned long long* o8 = (unsigned long long*)(H + (size_t)row * DM) + lane;
#pragma unroll
                for (int j = 0; j < 4; ++j) { const int col = 4 * lane + 256 * j; const f32x4 gg = *(const f32x4*)(g + col), a = *(const f32x4*)(sh + col), b = *(const f32x4*)(scl + col);
                    const f32x4 y = v[z][j] * rstd * gg * (b + 1.0f) + a;
                    o8[64 * j] = (unsigned long long)pk2(y.x, y.y) | ((unsigned long long)pk2(y.z, y.w) << 32); } } }
    }
}
__device__ __forceinline__ void stage_final(CKP& p, int bid, int nb) {
    const int tid = opaque_tid(), lane = tid & 63, wave = tid >> 6;
    const float* g = p.in[I_FNG];
    const bf16* XB = (const bf16*)(p.ws + WS_XB); const float* ssq = (const float*)(p.ws + WS_CTL + 262144) + 49152;
    const f32x4 g0 = *(const f32x4*)(g + 8 * lane), g1 = *(const f32x4*)(g + 8 * lane + 4), g2 = *(const f32x4*)(g + 512 + 8 * lane), g3 = *(const f32x4*)(g + 512 + 8 * lane + 4);
#pragma unroll 1
    for (int row = bid * 8 + wave; row < MTOK; row += nb * 8) {
        const float rstd = frsq(ssq[row] * (1.0f / DM) + 1e-6f);
        const u32x4 a = *(const u32x4*)(XB + (size_t)row * DM + 8 * lane), b = *(const u32x4*)(XB + (size_t)row * DM + 512 + 8 * lane);
        float* o = p.out + (size_t)row * DM + 8 * lane;
        *(f32x4*)o = (f32x4){bflo(a.x), bfhi(a.x), bflo(a.y), bfhi(a.y)} * rstd * g0; *(f32x4*)(o + 4) = (f32x4){bflo(a.z), bfhi(a.z), bflo(a.w), bfhi(a.w)} * rstd * g1;
        *(f32x4*)(o + 512) = (f32x4){bflo(b.x), bfhi(b.x), bflo(b.y), bfhi(b.y)} * rstd * g2; *(f32x4*)(o + 516) = (f32x4){bflo(b.z), bfhi(b.z), bflo(b.w), bfhi(b.w)} * rstd * g3;
    }
}


typedef short bf16x8 __attribute__((ext_vector_type(8)));
typedef float f32x2v __attribute__((ext_vector_type(2)));
typedef __bf16 bf16x2v __attribute__((ext_vector_type(2)));
#define MFMA16(a, b, c) __builtin_amdgcn_mfma_f32_16x16x32_bf16((a), (b), (c), 0, 0, 0)
__device__ __forceinline__ unsigned cvt2(float lo, float hi) { f32x2v v = {lo, hi}; bf16x2v b = __builtin_convertvector(v, bf16x2v); return __builtin_bit_cast(unsigned, b); }
__device__ __forceinline__ u32x4 pack8(const float (&x)[8]) { u32x4 w; w.x = cvt2(x[0], x[1]); w.y = cvt2(x[2], x[3]); w.z = cvt2(x[4], x[5]); w.w = cvt2(x[6], x[7]); return w; }
__device__ __forceinline__ void shift8(const bf16* proj, int row, bool hasp, bool hasn, int col, const float* mu, float (&u)[8]) {
    float p[8], a[8], b[8];
    load8bf(proj + (size_t)row * DINP + col, p);
    if (hasp) load8bf(proj + (size_t)(row - 1) * DINP + col, a); else {
#pragma unroll
        for (int j = 0; j < 8; ++j) a[j] = 0.f; }
    if (hasn) load8bf(proj + (size_t)(row + 1) * DINP + col, b); else {
#pragma unroll
        for (int j = 0; j < 8; ++j) b[j] = 0.f; }
    const f32x4 m0 = *(const f32x4*)(mu + col), m1 = *(const f32x4*)(mu + col + 4);
#pragma unroll
    for (int j = 0; j < 4; ++j) { u[j] = p[j] + m0[j] * (0.5f * (a[j] + b[j]) - p[j]); u[4 + j] = p[4 + j] + m1[j] * (0.5f * (a[4 + j] + b[4 + j]) - p[4 + j]); }
}
__device__ __forceinline__ int opq(int x) { asm volatile("" : "+v"(x)); return x; }
constexpr int TS = 72, TB = 64 * TS * 2;
constexpr int L_HT = 0, L_TW = 9216, L_AD = 18432, L_LP = 27648, L_AP = 45056, L_AT = 62464, L_RT = L_AT + TB, L_BH = L_RT + TB, L_KH = L_BH + TB, L_VR = L_KH + TB, L_YS = L_VR + TB;
constexpr int L_AAB = L_TW, L_AAK = L_AAB + 4096, L_ARB = L_AAK + 3072, L_ARK = L_ARB + 3072, L_UT = L_ARK + 3072, L_W1 = L_AP;
static_assert(L_UT + 64 * 24 * 2 <= L_LP && L_YS + 17408 <= RING_BYTES, "scan LDS map");
constexpr int LPS = 68;
#define LBAR() asm volatile("s_waitcnt lgkmcnt(0)\n\ts_barrier" ::: "memory")
typedef short s16x4v __attribute__((ext_vector_type(4)));
__device__ __forceinline__ bf16x8 tr8(const LAS bf16* p) {
    const s16x4v lo = __builtin_bit_cast(s16x4v, __builtin_amdgcn_ds_read_tr16_b64_v4i16((LAS s16x4v*)p));
    const s16x4v hi = __builtin_bit_cast(s16x4v, __builtin_amdgcn_ds_read_tr16_b64_v4i16((LAS s16x4v*)(p + 4 * TS)));
    return (bf16x8){lo[0], lo[1], lo[2], lo[3], hi[0], hi[1], hi[2], hi[3]};
}

__device__ __forceinline__ void rwkv_item3(CKP& p, int l, LAS unsigned char* lds, int item) {
    const int tid0 = opaque_tid(), w = __builtin_amdgcn_readfirstlane(tid0 >> 6);
    int tid = tid0, fr = tid & 15, fg = (tid & 63) >> 4;
    int bseq, h, dir, L, base; bool lat;
    if (item < 64) { lat = true; bseq = item >> 4; h = (item >> 1) & 7; dir = item & 1; L = 1024; base = NCTX + bseq * 1024; }
    else { const int i2 = item - 64; lat = false; bseq = i2 >> 4; h = (i2 >> 1) & 7; dir = i2 & 1; L = 256; base = bseq * 256; }
    const bf16* U = (const bf16*)(p.ws + WS_U);
    const float* KINV = (const float*)(p.ws + WS_KINV);
    bf16* Yout = (bf16*)(p.ws + (dir ? WS_YB : WS_YF));
    float* BC = (float*)(p.ws + WS_BC) + (size_t)dir * MTOK * 8;
    const bf16* wupt = (const bf16*)(p.ws + WS_WUPT) + ((size_t)(l * 2 + dir) * 512 + h * 64) * 64;
    const bf16* aupt = (const bf16*)(p.ws + WS_AUPT) + ((size_t)(l * 2 + dir) * 512 + h * 64) * 64;

    LAS float* LP = (LAS float*)(lds + L_LP); LAS float* AP = (LAS float*)(lds + L_AP); LAS float* AS = (LAS float*)(lds + L_TW);
    LAS bf16* AT = (LAS bf16*)(lds + L_AT);   LAS bf16* RT = (LAS bf16*)(lds + L_RT);   LAS bf16* BH = (LAS bf16*)(lds + L_BH);   LAS bf16* KH = (LAS bf16*)(lds + L_KH);
    LAS bf16* VR = (LAS bf16*)(lds + L_VR);   LAS float* YS = (LAS float*)(lds + L_YS);
    LAS float* AAB = (LAS float*)(lds + L_AAB); LAS bf16* AAK = (LAS bf16*)(lds + L_AAK); LAS bf16* ARB = (LAS bf16*)(lds + L_ARB); LAS bf16* ARK = (LAS bf16*)(lds + L_ARK); LAS bf16* AAK1 = (LAS bf16*)(lds + L_UT);
    LAS float* W1 = (LAS float*)(lds + L_W1);
    const int tv = w & 3;
    f32x4 hacc[4];
#pragma unroll
    for (int x = 0; x < 4; ++x) {
        if (lat && w < 4) hacc[x] = *(const f32x4*)(p.in[I_STATE] + ((((size_t)bseq * 2 + l) * 2 + dir) * 8 + h) * 4096 + (16 * tv + fr) * 64 + 16 * x + 4 * fg);
        else hacc[x] = (f32x4){0.f, 0.f, 0.f, 0.f}; }
    int ei = tid >> 3, ec8 = (tid & 7) * 8; const int hc8 = h * 64 + ec8;
    float kkp[8], kap[8], rkp[8];
#pragma unroll
    for (int e = 0; e < 8; ++e) { kkp[e] = p.in[I_KK][l * 512 + hc8 + e]; kap[e] = p.in[I_KA][l * 512 + hc8 + e]; rkp[e] = p.in[I_RK][l * 512 + hc8 + e]; }
#define SCAN_PREFETCH(SC) do { const int _t0 = opq(tid0), _ei = _t0 >> 3, _ec8 = (_t0 & 7) * 8; const int _step = (SC) * 64 + _ei, _t = dir ? L - 1 - _step : _step; \
        const bf16* _u = U + (size_t)(base + _t) * 1920; \
        nr = *(const u32x4*)(_u + R_OFF + h * 64 + _ec8); nk = *(const u32x4*)(_u + K_OFF + h * 64 + _ec8); nv = *(const u32x4*)(_u + V_OFF + h * 64 + _ec8); \
        ninv = KINV[(size_t)(base + _t) * 8 + h]; \
        const int _st2 = (SC) * 64 + 16 * (w >> 1) + (_t0 & 15), _t2 = dir ? L - 1 - _st2 : _st2; const bf16* _u2 = U + (size_t)(base + _t2) * 1920 + dir * 64 + ((_t0 & 63) >> 4) * 8; \
        paw0 = *(const bf16x8*)(_u2 + WD_OFF); paw1 = *(const bf16x8*)(_u2 + WD_OFF + 32); paa0 = *(const bf16x8*)(_u2 + AD_OFF); paa1 = *(const bf16x8*)(_u2 + AD_OFF + 32); } while (0)
    bf16x8 lbw[2][2], lba[2][2]; float lw0c[2], la0c[2];
#pragma unroll
    for (int x = 0; x < 2; ++x) { const int c = ((w & 1) * 2 + x) * 16 + fr;
        lbw[x][0] = *(const bf16x8*)(wupt + c * 64 + fg * 8); lbw[x][1] = *(const bf16x8*)(wupt + c * 64 + 32 + fg * 8);
        lba[x][0] = *(const bf16x8*)(aupt + c * 64 + fg * 8); lba[x][1] = *(const bf16x8*)(aupt + c * 64 + 32 + fg * 8);
        lw0c[x] = p.in[I_W0][(l * 2 + dir) * 512 + h * 64 + c]; la0c[x] = p.in[I_A0][(l * 2 + dir) * 512 + h * 64 + c]; }
    u32x4 nr, nk, nv; float ninv; bf16x8 paw0, paw1, paa0, paa1;
    SCAN_PREFETCH(0);
    __syncthreads();
#pragma unroll 1
    for (int sc = 0; sc < L / 64; ++sc) {
        tid = opq(tid0); fr = tid & 15; fg = (tid & 63) >> 4; ei = tid >> 3; ec8 = (tid & 7) * 8;
        const u32x4 cr = nr, ck = nk, cv = nv; const float kinv = ninv;
        { const int ti = w >> 1;
          const bf16x8 aw0 = paw0, aw1 = paw1, aa0 = paa0, aa1 = paa1;
          unsigned li[2];
#pragma unroll
          for (int pr = 0; pr < 2; ++pr) { const int j0 = 4 * fg + 2 * pr, j1 = j0 + 1; li[pr] = (j0 <= fr ? 0x3f80u : 0u) | (j1 <= fr ? 0x3f800000u : 0u); }
          const bf16x8 Li = __builtin_bit_cast(bf16x8, (u32x4){li[0], li[1], 0u, 0u});
#pragma unroll
          for (int x = 0; x < 2; ++x) { const int c = ((w & 1) * 2 + x) * 16 + fr;
              f32x4 cw = (f32x4){lw0c[x], lw0c[x], lw0c[x], lw0c[x]}, ca = (f32x4){la0c[x], la0c[x], la0c[x], la0c[x]};
              cw = MFMA16(aw0, lbw[x][0], cw); cw = MFMA16(aw1, lbw[x][1], cw); ca = MFMA16(aa0, lba[x][0], ca); ca = MFMA16(aa1, lba[x][1], ca);
              float lw[4], lo[4];
#pragma unroll
              for (int r = 0; r < 4; ++r) lw[r] = -0.6065306597126334f * fsigmoid(cw[r]);
              const unsigned h01 = cvt2(lw[0], lw[1]), h23 = cvt2(lw[2], lw[3]);
              lo[0] = lw[0] - bflo(h01); lo[1] = lw[1] - bfhi(h01); lo[2] = lw[2] - bflo(h23); lo[3] = lw[3] - bfhi(h23);
              const bf16x8 bh = __builtin_bit_cast(bf16x8, (u32x4){h01, h23, 0u, 0u}), bl = __builtin_bit_cast(bf16x8, (u32x4){cvt2(lo[0], lo[1]), cvt2(lo[2], lo[3]), 0u, 0u});
              f32x4 ci = (f32x4){0.f, 0.f, 0.f, 0.f};
              ci = MFMA16(Li, bh, ci); ci = MFMA16(Li, bl, ci);
#pragma unroll
              for (int r = 0; r < 4; ++r) { const int o = (ti * 16 + 4 * fg + r) * LPS + c;
                  LP[o] = fexp(ci[r]); AS[o] = fsigmoid(ca[r]); } } }
        __syncthreads();
        tid = opq(tid0); fr = tid & 15; fg = (tid & 63) >> 4; ei = tid >> 3; ec8 = (tid & 7) * 8;
        float bcv;
        { const f32x4 g0 = *(const LAS f32x4*)(LP + ei * LPS + ec8), g1 = *(const LAS f32x4*)(LP + ei * LPS + ec8 + 4);
          const int ip = (ei & 15) ? ei - 1 : ei;
          f32x4 p0 = *(const LAS f32x4*)(LP + ip * LPS + ec8), p1 = *(const LAS f32x4*)(LP + ip * LPS + ec8 + 4);
          if ((ei & 15) == 0) { p0 = (f32x4){1.f, 1.f, 1.f, 1.f}; p1 = p0; }
          const f32x4 s0 = *(const LAS f32x4*)(AS + ei * LPS + ec8), s1 = *(const LAS f32x4*)(AS + ei * LPS + ec8 + 4);
          float rr[8], kk[8], xa[8], xr[8], xb[8], xk[8], bc = 0.f;
          rr[0] = bflo(cr.x); rr[1] = bfhi(cr.x); rr[2] = bflo(cr.y); rr[3] = bfhi(cr.y); rr[4] = bflo(cr.z); rr[5] = bfhi(cr.z); rr[6] = bflo(cr.w); rr[7] = bfhi(cr.w);
          kk[0] = bflo(ck.x); kk[1] = bfhi(ck.x); kk[2] = bflo(ck.y); kk[3] = bfhi(ck.y); kk[4] = bflo(ck.z); kk[5] = bfhi(ck.z); kk[6] = bflo(ck.w); kk[7] = bfhi(ck.w);
#pragma unroll
          for (int e = 0; e < 8; ++e) { const float gi = e < 4 ? g0[e & 3] : g1[e & 3], gp = e < 4 ? p0[e & 3] : p1[e & 3], asg = e < 4 ? s0[e & 3] : s1[e & 3];
              const float kj = kk[e] * kkp[e] * kinv, kd = kk[e] * (1.0f + (asg - 1.0f) * kap[e]), ginv = frcp(gi);
              bc += rr[e] * kd * rkp[e];
              xa[e] = -kj * gp; xr[e] = rr[e] * gi; xb[e] = kj * asg * ginv; xk[e] = kd * ginv; }
          bcv = red8(bc);
          *(LAS u32x4*)(AT + ei * TS + ec8) = pack8(xa); *(LAS u32x4*)(RT + ei * TS + ec8) = pack8(xr); *(LAS u32x4*)(BH + ei * TS + ec8) = pack8(xb); *(LAS u32x4*)(KH + ei * TS + ec8) = pack8(xk);
          *(LAS u32x4*)(VR + ei * TS + ec8) = cv; }
        __syncthreads();
        tid = opq(tid0); fr = tid & 15; fg = (tid & 63) >> 4;
        { const int q = w >> 1, half = w & 1; const LAS bf16* Asrc = half ? RT : AT;
          const bf16x8 af0 = *(const LAS bf16x8*)(Asrc + (16 * q + fr) * TS + fg * 8), af1 = *(const LAS bf16x8*)(Asrc + (16 * q + fr) * TS + 32 + fg * 8);
          const bf16x8 bb0 = *(const LAS bf16x8*)(BH + (16 * q + fr) * TS + fg * 8), bb1 = *(const LAS bf16x8*)(BH + (16 * q + fr) * TS + 32 + fg * 8);
          const bf16x8 bk0 = *(const LAS bf16x8*)(KH + (16 * q + fr) * TS + fg * 8), bk1 = *(const LAS bf16x8*)(KH + (16 * q + fr) * TS + 32 + fg * 8);
          LAS bf16* myak = half ? AAK1 : AAK;
          f32x4 cx = (f32x4){0.f, 0.f, 0.f, 0.f}, ck2 = cx, cak = cx;
          cx = MFMA16(af0, bb0, cx); cx = MFMA16(af1, bb1, cx);
          ck2 = MFMA16(af0, bk0, ck2); ck2 = MFMA16(af1, bk1, ck2);
          if (half) { const bf16x8 at0 = *(const LAS bf16x8*)(AT + (16 * q + fr) * TS + fg * 8), at1 = *(const LAS bf16x8*)(AT + (16 * q + fr) * TS + 32 + fg * 8);
              cak = MFMA16(at0, bk0, cak); cak = MFMA16(at1, bk1, cak); }
          else cak = ck2;
          f32x4 mx, mk, mak;
#pragma unroll
          for (int r = 0; r < 4; ++r) { const int i = 4 * fg + r, j = fr; const bool lo = half ? j <= i : j < i; mx[r] = lo ? cx[r] : 0.f; mk[r] = lo ? ck2[r] : 0.f; mak[r] = j < i ? cak[r] : 0.f; }
          if (half == 0) *(LAS f32x4*)(AAB + (q * 16 + fr) * 16 + 4 * fg) = mx;
#pragma unroll
          for (int r = 0; r < 4; ++r) { const int o = (q * 16 + 4 * fg + r) * 24 + fr;
              if (half) { ARB[o] = (bf16)(cvt2(mx[r], 0.f) & 0xffffu); ARK[o] = (bf16)(cvt2(mk[r], 0.f) & 0xffffu); }
              myak[o] = (bf16)(cvt2(mak[r], 0.f) & 0xffffu); }
          {
              const unsigned kmask = fg < 2 ? 0xffffffffu : 0u;
              const bf16x8 afr = *(const LAS bf16x8*)(myak + (q * 16 + fr) * 24 + (fg & 1) * 8);
              const bf16x8 af = __builtin_bit_cast(bf16x8, __builtin_bit_cast(u32x4, afr) & kmask);
#pragma unroll
              for (int x = 0; x < 2; ++x) { const int tvv = 2 * half + x;
                  const bf16x8 bfr = tr8(VR + (16 * q + 8 * (fg & 1) + (fr >> 2)) * TS + 16 * tvv + 4 * (fr & 3));
                  const bf16x8 bfv = __builtin_bit_cast(bf16x8, __builtin_bit_cast(u32x4, bfr) & kmask);
                  f32x4 c = (f32x4){0.f, 0.f, 0.f, 0.f}; c = MFMA16(af, bfv, c);
#pragma unroll
                  for (int r = 0; r < 4; ++r) W1[(q * 16 + 4 * fg + r) * LPS + 16 * tvv + fr] = c[r]; } } }
        __syncthreads();
        tid = opq(tid0);
        { const int q = tid >> 7, col = tid & 127; float x[16];
          if (col < 64) {
#pragma unroll
              for (int i = 0; i < 16; ++i) x[i] = bf1(AT[(16 * q + i) * TS + col]); }
          else {
#pragma unroll
              for (int i = 0; i < 16; ++i) x[i] = W1[(q * 16 + i) * LPS + col - 64]; }
#pragma unroll
          for (int j = 0; j < 15; ++j) {
              const LAS f32x4* ac = (const LAS f32x4*)(AAB + (q * 16 + j) * 16);
#pragma unroll
              for (int i4 = (j + 1) / 4; i4 < 4; ++i4) { const f32x4 a4 = ac[i4];
#pragma unroll
                  for (int e = 0; e < 4; ++e) if (i4 * 4 + e > j) x[i4 * 4 + e] += a4[e] * x[j]; } }
          if (col < 64) {
#pragma unroll
              for (int i = 0; i < 16; ++i) AT[(16 * q + i) * TS + col] = (bf16)(cvt2(x[i], 0.f) & 0xffffu); }
          else {
#pragma unroll
              for (int i = 0; i < 16; ++i) W1[(q * 16 + i) * LPS + col - 64] = x[i]; } }
        __syncthreads();
        if (sc + 1 < L / 64) SCAN_PREFETCH(sc + 1);
        if (w < 4) {
        tid = opq(tid0); fr = tid & 15; fg = (tid & 63) >> 4;
#pragma unroll
        for (int q = 0; q < 4; ++q) {
            bf16x8 hb[2];
#pragma unroll
            for (int ks = 0; ks < 2; ++ks) { u32x4 t; t.x = cvt2(hacc[2 * ks][0], hacc[2 * ks][1]); t.y = cvt2(hacc[2 * ks][2], hacc[2 * ks][3]);
                t.z = cvt2(hacc[2 * ks + 1][0], hacc[2 * ks + 1][1]); t.w = cvt2(hacc[2 * ks + 1][2], hacc[2 * ks + 1][3]); hb[ks] = __builtin_bit_cast(bf16x8, t); }
            bf16x8 aU[2], aR[2];
#pragma unroll
            for (int ks = 0; ks < 2; ++ks) {
                const u32x2 a0 = *(const LAS u32x2*)(AT + (16 * q + fr) * TS + 32 * ks + 4 * fg), a1 = *(const LAS u32x2*)(AT + (16 * q + fr) * TS + 32 * ks + 16 + 4 * fg);
                const u32x2 r0 = *(const LAS u32x2*)(RT + (16 * q + fr) * TS + 32 * ks + 4 * fg), r1 = *(const LAS u32x2*)(RT + (16 * q + fr) * TS + 32 * ks + 16 + 4 * fg);
                aU[ks] = __builtin_bit_cast(bf16x8, (u32x4){a0.x, a0.y, a1.x, a1.y}); aR[ks] = __builtin_bit_cast(bf16x8, (u32x4){r0.x, r0.y, r1.x, r1.y}); }
            f32x4 u, yacc = (f32x4){0.f, 0.f, 0.f, 0.f};
#pragma unroll
            for (int r = 0; r < 4; ++r) u[r] = W1[(q * 16 + 4 * fg + r) * LPS + 16 * tv + fr];
            u = MFMA16(aU[0], hb[0], u); u = MFMA16(aU[1], hb[1], u);
            yacc = MFMA16(aR[0], hb[0], yacc); yacc = MFMA16(aR[1], hb[1], yacc);
            const s16x4v vtr = __builtin_bit_cast(s16x4v, __builtin_amdgcn_ds_read_tr16_b64_v4i16((LAS s16x4v*)(VR + (16 * q + 4 * fg + (fr >> 2)) * TS + 16 * tv + 4 * (fr & 3))));
            const u32x2 vt2 = __builtin_bit_cast(u32x2, vtr);
            const bf16x8 bUV = __builtin_bit_cast(bf16x8, (u32x4){cvt2(u[0], u[1]), cvt2(u[2], u[3]), vt2.x, vt2.y});
            { const u32x2 y0 = *(const LAS u32x2*)(ARB + (q * 16 + fr) * 24 + 4 * fg), y1 = *(const LAS u32x2*)(ARK + (q * 16 + fr) * 24 + 4 * fg);
              yacc = MFMA16(__builtin_bit_cast(bf16x8, (u32x4){y0.x, y0.y, y1.x, y1.y}), bUV, yacc); }
#pragma unroll
            for (int r = 0; r < 4; ++r) YS[(16 * q + 4 * fg + r) * LPS + 16 * tv + fr] = yacc[r];
#pragma unroll
            for (int x = 0; x < 4; ++x) {
                const s16x4v bt = __builtin_bit_cast(s16x4v, __builtin_amdgcn_ds_read_tr16_b64_v4i16((LAS s16x4v*)(BH + (16 * q + 4 * fg + (fr >> 2)) * TS + 16 * x + 4 * (fr & 3))));
                const s16x4v kt = __builtin_bit_cast(s16x4v, __builtin_amdgcn_ds_read_tr16_b64_v4i16((LAS s16x4v*)(KH + (16 * q + 4 * fg + (fr >> 2)) * TS + 16 * x + 4 * (fr & 3))));
                const u32x2 b2 = __builtin_bit_cast(u32x2, bt), k2 = __builtin_bit_cast(u32x2, kt);
                const f32x4 ge = *(const LAS f32x4*)(LP + (16 * q + 15) * LPS + 16 * x + 4 * fg);
                hacc[x] = MFMA16(__builtin_bit_cast(bf16x8, (u32x4){b2.x, b2.y, k2.x, k2.y}), bUV, hacc[x]) * ge; }
        }
        }
        __syncthreads();
        tid = opq(tid0); ei = tid >> 3; ec8 = (tid & 7) * 8;
        { const int st2 = sc * 64 + ei, t2 = dir ? L - 1 - st2 : st2; bf16* yo = Yout + (size_t)(base + t2) * 512 + h * 64 + ec8;
          const f32x4 y0 = *(const LAS f32x4*)(YS + ei * LPS + ec8), y1 = *(const LAS f32x4*)(YS + ei * LPS + ec8 + 4);
          u32x4 yw; yw.x = cvt2(y0[0], y0[1]); yw.y = cvt2(y0[2], y0[3]); yw.z = cvt2(y1[0], y1[1]); yw.w = cvt2(y1[2], y1[3]);
          *(u32x4*)yo = yw;
          if ((tid & 7) == 0) BC[(size_t)(base + t2) * 8 + h] = bcv; }
    }
#undef SCAN_PREFETCH
    if (!lat && w < 4) {
#pragma unroll
        for (int x = 0; x < 4; ++x) *(f32x4*)(p.out + (size_t)MTOK * DM + ((((size_t)bseq * 2 + l) * 2 + dir) * 8 + h) * 4096 + (16 * tv + fr) * 64 + 16 * x + 4 * fg) = hacc[x]; }
    __syncthreads();
}

__device__ __forceinline__ void stage_upass(CKP& p, int l, int bid, int nb) {
    const int tid = opaque_tid(), sub = tid >= 240 ? 1 : 0, j = tid - sub * 240, col = 8 * j;
    const bf16* proj = (const bf16*)(p.ws + WS_PROJ); bf16* U = (bf16*)(p.ws + WS_U); float* KINV = (float*)(p.ws + WS_KINV);
    const float* mu = p.in[I_MU] + l * 1920;
    if (tid < 480) {
        const bool isk = col >= K_OFF && col < V_OFF;
        const float* kkp = p.in[I_KK] + l * 512 + (isk ? col - K_OFF : 0);
        const f32x4 k0 = *(const f32x4*)kkp, k1 = *(const f32x4*)(kkp + 4);
#pragma unroll 1
        for (int tok0 = bid * 2 + sub; tok0 < MTOK; tok0 += nb * 8) {
            float uu[4][8];
#pragma unroll
            for (int z = 0; z < 4; ++z) { const int tok = min(tok0 + z * nb * 2, MTOK - 1);
                const bool lat = tok >= NCTX; const int L = lat ? 1024 : 256, t = lat ? (tok - NCTX) & 1023 : tok & 255;
                shift8(proj, tok, t > 0, t < L - 1, col, mu, uu[z]); }
#pragma unroll
            for (int z = 0; z < 4; ++z) { const int tok = tok0 + z * nb * 2;
                float ss = 0.f;
#pragma unroll
                for (int e = 0; e < 8; ++e) { const float kn = uu[z][e] * (e < 4 ? k0[e & 3] : k1[e & 3]); ss += kn * kn; }
                ss = red8(ss);
                if (tok < MTOK) {
                    if (isk && (j & 7) == 0) KINV[(size_t)tok * 8 + ((col - K_OFF) >> 6)] = fminf(frsq(ss), 1e12f);
                    if (col >= WD_OFF && col < AD_OFF) {
#pragma unroll
                        for (int e = 0; e < 8; ++e) uu[z][e] = 1.0f - 2.0f * frcp(fexp(2.0f * uu[z][e]) + 1.0f); }
                    if (col >= GD_OFF) {
#pragma unroll
                        for (int e = 0; e < 8; ++e) uu[z][e] = fsigmoid(uu[z][e]); }
                    *(u32x4*)(U + (size_t)tok * 1920 + col) = pack8(uu[z]); } }
        }
    }
}

__device__ __forceinline__ void fnet1_item(CKP& p, int l, int item) {
    const int tid = opaque_tid(), lane = tid & 63, w = __builtin_amdgcn_readfirstlane(tid >> 6), fr = lane & 15, fg = lane >> 4;
    const int tb = item >> 2, g = item & 3, tok0 = tb * 64, tt = w & 3, cs = w >> 2;
    const bf16* proj = (const bf16*)(p.ws + WS_PROJ);
    const bf16* fwt = (const bf16*)(p.ws + WS_FW) + (size_t)((l * 4 + g) * 128 + cs * 64) * 64;
    const bf16* xr = proj + (size_t)(tok0 + 16 * tt + fr) * DINP + F_OFF + g * 64 + fg * 8;
    const bf16x8 a0 = *(const bf16x8*)xr, a1 = *(const bf16x8*)(xr + 32);
    const bool lat = tok0 >= NCTX;
    const int L = lat ? 1024 : 256, bq = lat ? (tok0 - NCTX) >> 10 : tok0 >> 8, t = (lat ? (tok0 - NCTX) & 1023 : tok0 & 255) + 16 * tt + 4 * fg;
    const float scale = lat ? (1.0f / 256.0f) : (1.0f / 128.0f);
    bf16* Y = (bf16*)(p.ws + WS_YCS) + (lat ? (size_t)8192 * 512 : 0);
#pragma unroll
    for (int ot = 0; ot < 4; ++ot) {
        const bf16x8 b0 = *(const bf16x8*)(fwt + (16 * ot + fr) * 64 + fg * 8), b1 = *(const bf16x8*)(fwt + (16 * ot + fr) * 64 + 32 + fg * 8);
        f32x4 c = (f32x4){0.f, 0.f, 0.f, 0.f}; c = MFMA16(a0, b0, c); c = MFMA16(a1, b1, c);
        u32x2 o; o.x = cvt2(c[0] * scale, c[1] * scale); o.y = cvt2(c[2] * scale, c[3] * scale);
        *(u32x2*)(Y + (size_t)((bq * 4 + g) * 64 + 16 * ot + fr) * (2 * L) + cs * L + t) = o; }
}

__device__ __forceinline__ void pool_item(CKP& p, int l, LAS unsigned char* lds, int item) {
    const int tid = opaque_tid(), tb = item >> 2, gi = item & 3, tok0 = tb * 64, hw = 1 << gi;
    const bf16* proj = (const bf16*)(p.ws + WS_PROJ);
    LAS bf16* DB = (LAS bf16*)lds;
    LAS float* CSUM = (LAS float*)(lds + 9216);
    const int ti = tid >> 3, c8 = (tid & 7) * 8, tok = tok0 + ti, col = P_OFF + gi * 64 + c8;
    { float sum[8], x[8];
#pragma unroll
      for (int j = 0; j < 8; ++j) sum[j] = 0.f;
      load8bf(proj + (size_t)tok * DINP + col, x);
      float cnt;
      if (tok < NCTX) { const int t = tok & 255, sb = tok - t, lo = max(t - hw, 0), hi = min(t + hw, 256);
          u32x4 wv[16];
#pragma unroll
          for (int q = 0; q < 16; ++q) { const int tq = min(t - hw + q, 255); wv[q] = (q < 2 * hw && tq >= 0) ? *(const u32x4*)(proj + (size_t)(sb + max(tq, 0)) * DINP + col) : (u32x4){0u, 0u, 0u, 0u}; }
#pragma unroll
          for (int q = 0; q < 16; ++q) if (q < 2 * hw) { const bool ok = t - hw + q >= 0 && t - hw + q < 256; const u32x4 w = wv[q];
              if (ok) { sum[0] += bflo(w.x); sum[1] += bfhi(w.x); sum[2] += bflo(w.y); sum[3] += bfhi(w.y); sum[4] += bflo(w.z); sum[5] += bfhi(w.z); sum[6] += bflo(w.w); sum[7] += bfhi(w.w); } }
          cnt = (float)(hi - lo); }
      else {
          const int t = (tok - NCTX) & 1023, sb = tok - t, r = t >> 6, c = t & 63, rlo = max(r - hw, 0), rhi = min(r + hw, 16), clo = max(c - hw, 0), chi = min(c + hw, 64);
          u32x4 wv[16];
#pragma unroll
          for (int q = 0; q < 16; ++q) { const int rq = r - hw + q; wv[q] = (q < 2 * hw && rq >= 0 && rq < 16) ? *(const u32x4*)(proj + (size_t)(sb + rq * 64 + c) * DINP + col) : (u32x4){0u, 0u, 0u, 0u}; }
#pragma unroll
          for (int q = 0; q < 16; ++q) { const u32x4 w = wv[q];
              sum[0] += bflo(w.x); sum[1] += bfhi(w.x); sum[2] += bflo(w.y); sum[3] += bfhi(w.y); sum[4] += bflo(w.z); sum[5] += bfhi(w.z); sum[6] += bflo(w.w); sum[7] += bfhi(w.w); }
          *(LAS f32x4*)(CSUM + ti * 68 + c8) = (f32x4){sum[0], sum[1], sum[2], sum[3]}; *(LAS f32x4*)(CSUM + ti * 68 + c8 + 4) = (f32x4){sum[4], sum[5], sum[6], sum[7]};
          __syncthreads();
#pragma unroll
          for (int j = 0; j < 8; ++j) sum[j] = 0.f;
          for (int cq = clo; cq < chi; ++cq) { const f32x4 a = *(const LAS f32x4*)(CSUM + cq * 68 + c8), b = *(const LAS f32x4*)(CSUM + cq * 68 + c8 + 4);
#pragma unroll
              for (int j = 0; j < 4; ++j) { sum[j] += a[j]; sum[4 + j] += b[j]; } }
          cnt = (float)((rhi - rlo) * (chi - clo)); }
      const float ic = frcp(cnt);
      float dd[8];
#pragma unroll
      for (int j = 0; j < 8; ++j) dd[j] = sum[j] * ic - x[j];
      *(LAS u32x4*)(DB + ti * 72 + c8) = pack8(dd); }
    __syncthreads();
    { const int lane = tid & 63, w = __builtin_amdgcn_readfirstlane(tid >> 6), fr = lane & 15, fg = lane >> 4, tt = w & 3;
      const bf16* wpt = (const bf16*)(p.ws + WS_WPT) + (size_t)(l * 4 + gi) * 4096;
      const bf16x8 b0 = *(const LAS bf16x8*)(DB + (16 * tt + fr) * 72 + fg * 8), b1 = *(const LAS bf16x8*)(DB + (16 * tt + fr) * 72 + 32 + fg * 8);
#pragma unroll
      for (int x = 0; x < 2; ++x) { const int ot = 2 * (w >> 2) + x;
          const bf16x8 a0 = *(const bf16x8*)(wpt + (16 * ot + fr) * 64 + fg * 8), a1 = *(const bf16x8*)(wpt + (16 * ot + fr) * 64 + 32 + fg * 8);
          f32x4 c = (f32x4){0.f, 0.f, 0.f, 0.f}; c = MFMA16(a0, b0, c); c = MFMA16(a1, b1, c);
          const f32x4 ps = *(const f32x4*)(p.in[I_PSCALE] + l * 256 + gi * 64 + 16 * ot + 4 * fg);
          c *= ps;
          u32x2 o; o.x = cvt2(c[0], c[1]); o.y = cvt2(c[2], c[3]);
          *(u32x2*)((bf16*)(p.ws + WS_MIXED) + (size_t)(tok0 + 16 * tt + fr) * DM + 768 + gi * 64 + 16 * ot + 4 * fg) = o; } }
    __syncthreads();
}

__device__ __forceinline__ float xsum_fg(float s, int fr, int fg) {
    s += __builtin_bit_cast(float, __builtin_amdgcn_ds_bpermute((((fg ^ 1) << 4) | fr) << 2, __builtin_bit_cast(int, s)));
    s += __builtin_bit_cast(float, __builtin_amdgcn_ds_bpermute((((fg ^ 2) << 4) | fr) << 2, __builtin_bit_cast(int, s)));
    return s;
}
__device__ __forceinline__ void stage_post(CKP& p, int l, int bid, int nb) {
    const int tid = opaque_tid(), lane = tid & 63, head = __builtin_amdgcn_readfirstlane(tid >> 6), fr = lane & 15, fg = lane >> 4;
    const bf16* Ub = (const bf16*)(p.ws + WS_U);
    const bf16* gupt = (const bf16*)(p.ws + WS_GUPT) + ((size_t)l * 512 + head * 64) * 128;
    const bf16* YF = (const bf16*)(p.ws + WS_YF); const bf16* YB = (const bf16*)(p.ws + WS_YB);
    const float* BC0 = (const float*)(p.ws + WS_BC); const float* BC1 = BC0 + (size_t)MTOK * 8;
    bf16* MIX = (bf16*)(p.ws + WS_MIXED);
    bf16x8 ag[4][4];
    f32x4 lnw[4], lnb[4];
#pragma unroll
    for (int t = 0; t < 4; ++t) {
#pragma unroll
        for (int ks = 0; ks < 4; ++ks) ag[t][ks] = *(const bf16x8*)(gupt + (16 * t + fr) * 128 + ks * 32 + fg * 8);
        lnw[t] = *(const f32x4*)(p.in[I_LNW] + l * 512 + head * 64 + 16 * t + 4 * fg); lnb[t] = *(const f32x4*)(p.in[I_LNB] + l * 512 + head * 64 + 16 * t + 4 * fg); }
#pragma unroll 1
    for (int item = bid; item < 768; item += nb) {
        const size_t tok = (size_t)item * 16 + fr;
        bf16x8 bs[4];
#pragma unroll
        for (int ks = 0; ks < 4; ++ks) bs[ks] = *(const bf16x8*)(Ub + tok * 1920 + GD_OFF + ks * 32 + fg * 8);
        f32x4 y[4]; u32x2 vw[4];
#pragma unroll
        for (int t = 0; t < 4; ++t) { const int c = head * 64 + 16 * t + 4 * fg;
            const u32x2 yf = *(const u32x2*)(YF + tok * 512 + c), yb = *(const u32x2*)(YB + tok * 512 + c);
            y[t] = (f32x4){bflo(yf.x) + bflo(yb.x), bfhi(yf.x) + bfhi(yb.x), bflo(yf.y) + bflo(yb.y), bfhi(yf.y) + bfhi(yb.y)}; vw[t] = *(const u32x2*)(Ub + tok * 1920 + V_OFF + c); }
        const float bc = BC0[tok * 8 + head] + BC1[tok * 8 + head];
        f32x4 g[4];
#pragma unroll
        for (int t = 0; t < 4; ++t) { g[t] = (f32x4){0.f, 0.f, 0.f, 0.f};
#pragma unroll
            for (int ks = 0; ks < 4; ++ks) g[t] = MFMA16(ag[t][ks], bs[ks], g[t]); }
        float s = 0.f;
#pragma unroll
        for (int t = 0; t < 4; ++t) s += (y[t][0] + y[t][1]) + (y[t][2] + y[t][3]);
        const float mean = xsum_fg(s, fr, fg) * (1.0f / 64.0f);
        float q = 0.f;
#pragma unroll
        for (int t = 0; t < 4; ++t) { y[t] = y[t] - mean; q += (y[t][0] * y[t][0] + y[t][1] * y[t][1]) + (y[t][2] * y[t][2] + y[t][3] * y[t][3]); }
        const float rstd = frsq(xsum_fg(q, fr, fg) * (1.0f / 64.0f) + 64e-5f);
#pragma unroll
        for (int t = 0; t < 4; ++t) { const f32x4 vv = (f32x4){bflo(vw[t].x), bfhi(vw[t].x), bflo(vw[t].y), bfhi(vw[t].y)};
            const f32x4 o = (y[t] * rstd * lnw[t] + lnb[t] + vv * bc) * g[t];
            u32x2 w; w.x = cvt2(o[0], o[1]); w.y = cvt2(o[2], o[3]);
            *(u32x2*)(MIX + tok * DM + head * 64 + 16 * t + 4 * fg) = w; }
    }
}

#define XB_TMO      128
#define XB_XCNT(j)  (256  + 64 * (j))
#define XB_XSUB(j)  (1280 + 64 * (j))
#define XB_XGEN(j)  (2304 + 64 * (j))
#define XB_TOP      3328
#define XB_TOPGEN   3392
#define XCD_BAR_WORDS 3456
#define XB_SPIN_CAP (1u << 18)

__device__ __forceinline__ unsigned xb_ld(unsigned* p)              { return __hip_atomic_load(p, __ATOMIC_RELAXED, __HIP_MEMORY_SCOPE_AGENT); }
__device__ __forceinline__ unsigned xb_add(unsigned* p, unsigned v) { return __hip_atomic_fetch_add(p, v, __ATOMIC_RELAXED, __HIP_MEMORY_SCOPE_AGENT); }
__device__ __forceinline__ unsigned xb_xcc_id() { return (unsigned)__builtin_amdgcn_s_getreg((3 << 11) | 20) & 0xFu; }
#define XB_SPIN(cond, bar) do { unsigned _sp = 0; while (cond) { __builtin_amdgcn_s_sleep(1); \
    if ((++_sp & 255u) == 0u) { if (xb_ld(&(bar)[XB_TMO])) break; if (_sp > XB_SPIN_CAP) { atomicAdd(&(bar)[XB_TMO], 1u); break; } } } } while (0)

struct XcdBarrier {
    unsigned* bar; unsigned x;
    volatile LAS unsigned* st;
};

__device__ __forceinline__ XcdBarrier xcd_barrier_post(unsigned* bar, volatile LAS unsigned* st) {
    XcdBarrier b; b.bar = bar; b.x = xb_xcc_id(); b.st = st;
    if (threadIdx.x == 0) (void)xb_add(&bar[XB_XCNT(b.x)], 1u);
    return b;
}
__device__ __forceinline__ void xcd_barrier_complete(unsigned* bar, unsigned x, unsigned& nloc, unsigned& nx) {
    const unsigned G = gridDim.x * gridDim.y * gridDim.z;
    unsigned sum, cnt, mine, sp = 0u;
    for (;;) {
        sum = 0u; cnt = 0u; mine = 0u;
#pragma unroll
        for (unsigned j = 0; j < 16; ++j) { const unsigned c = xb_ld(&bar[XB_XCNT(j)]); sum += c; cnt += (c > 0u) ? 1u : 0u; mine = (j == x) ? c : mine; }
        if (sum == G) break;
        __builtin_amdgcn_s_sleep(1);
        if ((++sp & 255u) == 0u) { if (xb_ld(&bar[XB_TMO])) break; if (sp > XB_SPIN_CAP) { atomicAdd(&bar[XB_TMO], 1u); break; } }
    }
    nloc = mine > 0u ? mine : 1u; nx = cnt > 0u ? cnt : 1u;
}

__device__ __forceinline__ void xcd_barrier(const XcdBarrier& b) {
    asm volatile("s_waitcnt vmcnt(0)" ::: "memory");
    __syncthreads();
    if (threadIdx.x == 0) {
        unsigned* bar = b.bar;
        __builtin_amdgcn_s_waitcnt(0);
        unsigned nloc = b.st[0], nx = b.st[1];
        if (nloc == 0u) { xcd_barrier_complete(bar, b.x, nloc, nx); b.st[0] = nloc; b.st[1] = nx; }
        const unsigned old = xb_add(&bar[XB_XSUB(b.x)], 1u);
        const unsigned gen = old / nloc;
        if (old + 1u == (gen + 1u) * nloc) {
            __builtin_amdgcn_fence(__ATOMIC_RELEASE, "agent");
            asm volatile("s_waitcnt vmcnt(0)" ::: "memory");
            const unsigned og = xb_add(&bar[XB_TOP], 1u);
            const unsigned tg = og / nx;
            __builtin_amdgcn_fence(__ATOMIC_ACQUIRE, "agent");
            if (og + 1u == (tg + 1u) * nx) xb_add(&bar[XB_TOPGEN], 1u);
            else XB_SPIN(xb_ld(&bar[XB_TOPGEN]) == tg, bar);
            xb_add(&bar[XB_XGEN(b.x)], 1u);
            asm volatile("s_waitcnt vmcnt(0)" ::: "memory");
        } else {
            __builtin_amdgcn_fence(__ATOMIC_ACQUIRE, "agent");
            XB_SPIN(xb_ld(&bar[XB_XGEN(b.x)]) == gen, bar);
            asm volatile("s_waitcnt vmcnt(0)" ::: "memory");
        }
    }
    __syncthreads();
}

struct EpiAny {
    static constexpr bool AFTER_DRAIN = false;
    int mode; bool PERM; int l;
    __device__ __forceinline__ void operator()(const f32x4 (&acc)[2][2][4][2], const pg8::Unit& u, int wr, int wc, int fr, int fq) const {
        CKP* kp = (CKP*)__builtin_amdgcn_kernarg_segment_ptr(); asm volatile("" : "+s"(kp)); CKP& p = *kp;
        unsigned char* ws = p.ws;
        const float* mod = (const float*)(ws + WS_MOD) + (size_t)l * 5 * 6144;
        float* SSQ = (float*)(ws + WS_CTL + 262144);
        bf16* Hb = (bf16*)(ws + WS_H); bf16* XB = (bf16*)(ws + WS_XB);
        if (mode == 7) {
#pragma unroll
            for (int a = 0; a < 2; ++a)
#pragma unroll
                for (int b = 0; b < 2; ++b)
#pragma unroll
                    for (int m = 0; m < 4; ++m)
#pragma unroll
                        for (int n = 0; n < 2; ++n) asm volatile("" :: "v"(acc[a][b][m][n]));
            return; }
        if (mode == 0) { const pg8::EpiBf<0> e{(bf16*)(ws + WS_PROJ), DINP}; e(acc, u, wr, wc, fr, fq); }
        else if (mode == 2) { const pg8::EpiResFinal e{XB, mod + 5 * 1024, p.in[I_FNG], p.out, SSQ + 49152, (unsigned*)(ws + WS_CTL + 524288) + 64 * 16}; e(acc, u, wr, wc, fr, fq); }
        else if (mode == 3) { const pg8::EpiFnet e{(bf16*)(ws + WS_MIXED), 0, 256}; e(acc, u, wr, wc, fr, fq); }
        else if (mode == 8) { const pg8::EpiFnet e{(bf16*)(ws + WS_MIXED), NCTX, 1024}; e(acc, u, wr, wc, fr, fq); }
        else if (mode == 4) { const pg8::EpiNormBf<0> e{(bf16*)(ws + WS_PROJ), DINP, SSQ + 16384, (const float*)(ws + WS_SWIN), DINP}; e(acc, u, wr, wc, fr, fq); }
        else if (mode == 5) { const pg8::EpiNormBf<1> e{(bf16*)(ws + WS_FF), DFF, SSQ + l * 32768, (const float*)(ws + WS_SW1) + (size_t)l * 5 * DFF, DFF}; e(acc, u, wr, wc, fr, fq); }
        else if (mode == 6) {
            if (l == 0) { const pg8::EpiResNorm<true, true> e{XB, mod + 2 * 1024, p.in[I_XP], p.in[I_XS], Hb, p.in[I_N2G], mod + 4 * 1024, SSQ}; e(acc, u, wr, wc, fr, fq); }
            else { const pg8::EpiResNorm<false, true> e{XB, mod + 2 * 1024, nullptr, nullptr, Hb, p.in[I_N2G] + DM, mod + 4 * 1024, SSQ + 32768}; e(acc, u, wr, wc, fr, fq); } }
        else { const pg8::EpiResNorm<false, true> e{XB, mod + 5 * 1024, nullptr, nullptr, Hb, p.in[I_N1G] + DM, mod + 5 * 6144 + 1 * 1024, SSQ + 16384}; e(acc, u, wr, wc, fr, fq); }
    }
};

constexpr int N_STEPS = 16;
__device__ __forceinline__ bool step_seam(int st) { return st < 15; }
__global__ void __launch_bounds__(NTHR, 2) mega_fwd(KP p_unused) {
    extern __shared__ __attribute__((aligned(16))) unsigned char lds_raw[];
    CKP* kp0 = (CKP*)__builtin_amdgcn_kernarg_segment_ptr();
    { LAS unsigned* ctlw = (LAS unsigned*)((LAS unsigned char*)lds_raw + RING_BYTES);
      for (int u = threadIdx.x; u < (LDS_BYTES - RING_BYTES) / 4; u += NTHR) ctlw[u] = 0u; }
    __syncthreads();
    const XcdBarrier bar = xcd_barrier_post((unsigned*)(kp0->ws + WS_CTL) + 4096, (volatile LAS unsigned*)((LAS unsigned char*)lds_raw + MISC_OFF + 32));
    const int ph_lo = kp0->ph_lo, ph_hi = kp0->ph_hi;
#pragma unroll 1
#ifdef REP_A
    for (int sti = ph_lo; sti < ph_hi + ((REP_B) >= 0 ? 2 : 1); ++sti) {
        const int st = sti <= (REP_A) ? sti : (((REP_B) < 0 || sti <= (REP_B) + 1) ? sti - 1 : sti - 2);
        const bool isdup = sti == (REP_A) || ((REP_B) >= 0 && sti == (REP_B) + 1); (void)isdup;
#else
    for (int st = ph_lo; st < ph_hi; ++st) {
#endif
        CKP* kp = kp0; asm volatile("" : "+s"(kp));
        CKP& p = *kp; unsigned char* ws = p.ws;
        int bid = blockIdx.x, nb = gridDim.x; unsigned ldsb = (unsigned)(size_t)(LAS unsigned char*)lds_raw;
        asm volatile("" : "+s"(bid), "+s"(nb), "+s"(ldsb));
        LAS unsigned char* lds = (LAS unsigned char*)(size_t)ldsb;
        const int l = st < 9 ? 0 : 1, s = st == 0 ? -1 : (st == 1 ? 0 : ((st - 2) % 7 + 1));
        const float* mod = (const float*)(ws + WS_MOD) + (size_t)l * 5 * 6144;
#pragma unroll 1
        for (int job = 0; job < 2; ++job) {
            pg8::Gemm g{nullptr, nullptr, 0, 0, 0, 0, 0}; EpiAny E{-1, true, 0}; int corder = bid;
            if (job == 0) {
                if (s == 1) { g = pg8::Gemm{(const bf16*)(ws + WS_H), (const bf16*)(ws + WS_WIN) + (size_t)l * DINP * DM, MTOK, DINP, DM, DM, DM}; E = EpiAny{l == 0 ? 0 : 4, true, l}; }
                else if (s == 3) { g = pg8::Gemm{(const bf16*)(ws + WS_CS256), (const bf16*)(ws + WS_YCS), 256, 8192, 512, 512, 512}; E = EpiAny{3, true, l}; corder = (bid + nb - (nb >= 256 ? 192 : 0)) % nb; }
                else if (s == 5) { g = pg8::Gemm{(const bf16*)(ws + WS_MIXED), (const bf16*)(ws + WS_WOUT) + (size_t)l * DM * DM, MTOK, DM, DM, DM, DM}; E = EpiAny{6, true, l}; }
                else if (s == 6) { g = pg8::Gemm{(const bf16*)(ws + WS_H), (const bf16*)(ws + WS_W1) + (size_t)l * DFF * DM, MTOK, DFF, DM, DM, DM}; E = EpiAny{5, true, l}; }
                else if (s == 7) { g = pg8::Gemm{(const bf16*)(ws + WS_FF), (const bf16*)(ws + WS_W2) + (size_t)l * DM * DFF, MTOK, DM, DFF, DFF, DFF}; E = l == 0 ? EpiAny{9, true, l} : EpiAny{2, true, l}; }
            } else if (s == 3) { g = pg8::Gemm{(const bf16*)(ws + WS_CS1024), (const bf16*)(ws + WS_YCS) + (size_t)8192 * 512, 1024, 1024, 2048, 2048, 2048}; E = EpiAny{8, true, l}; corder = (bid + nb - (nb >= 256 ? 224 : 32)) % nb; }
#ifdef NOEPI_FIRST
            if (isdup && E.mode >= 0) E.mode = 7;
#endif
            if (E.mode >= 0) {
                pg8::StaticOrder S; S.init(g.M, g.N, nb, corder);
                pg8::gemm_phase<EpiAny, pg8::StaticOrder, true, true>(lds, g, S, E);
                __syncthreads();
            }
        }
        if (s == 3) {
            if (nb >= 256) {
                if (bid < 64) rwkv_item3(p, l, lds, bid);
                else { unsigned* ctr = (unsigned*)(ws + WS_CTL + 524288) + 64 * (2 + l); volatile LAS unsigned* slot = (volatile LAS unsigned*)(lds + RING_BYTES + 64);
#pragma unroll 1
                    for (;;) { __syncthreads(); if (threadIdx.x == 0) *slot = atomicAdd(ctr, 1u); __syncthreads(); const int it = (int)*slot; if (it >= 512) break; rwkv_item3(p, l, lds, 64 + it); } }
            } else for (int it = bid; it < 576; it += nb) rwkv_item3(p, l, lds, it);
        }
        if (s == 3 || s == 5) {
            int qi, first, csz, nch;
            if (s == 3) { qi = l; first = l == 0 ? TI_IN : TI_L + TI_IN; csz = 8; nch = (TI_OUT + TI_1) / 8; }
            else { qi = 4 + l; first = l * TI_L + TI_IN + TI_OUT + TI_1; csz = 32; nch = TI_2 / 32; }
            side_queue(p, lds, qi, 0, first, csz, nch);
            if (s == 3 && l == 0) side_queue(p, lds, 6, 0, TI_L, 8, TI_IN / 8);
        }
        if (s == -1) stage_prologue(p, lds, bid, nb);
        else if (s == 0) { stage_norm(p, 0, 0, bid, nb); stage_tables(p, bid, nb); }
        else if (s == 2) {
            stage_upass(p, l, bid, nb);
#ifdef DUP_U
            stage_upass(p, l, bid, nb);
#endif
#pragma unroll 1
            for (int it = bid; it < 768; it += nb) fnet1_item(p, l, it);
#ifdef DUP_F
#pragma unroll 1
            for (int it = bid; it < 768; it += nb) fnet1_item(p, l, it);
#endif
#pragma unroll 1
            for (int it = bid; it < 768; it += nb) pool_item(p, l, lds, it);
#ifdef DUP_P
#pragma unroll 1
            for (int it = bid; it < 768; it += nb) pool_item(p, l, lds, it);
#endif
        }
        else if (s == 4) stage_post(p, l, bid, nb);
        #ifdef REP_A
        if (sti + 1 < ph_hi + ((REP_B) >= 0 ? 2 : 1)) xcd_barrier(bar);
#else
        if (st + 1 < ph_hi && step_seam(st)) xcd_barrier(bar);
#endif
    }
}

extern "C" void kernel_launch(void* const* d_in, const int* in_sizes, int n_in, void* d_out, int out_size, void* d_ws, size_t ws_size, hipStream_t stream) {
    static int grid = 0;
    if (grid == 0) {
        if (n_in != N_IN || ws_size < WS_END) { fprintf(stderr, "kernel_launch: unexpected inputs (n_in %d, ws %zu)\n", n_in, ws_size); grid = -1; return; }
        int dev = 0, cus = 0, per_cu = 0;
        (void)hipGetDevice(&dev); (void)hipDeviceGetAttribute(&cus, hipDeviceAttributeMultiprocessorCount, dev);
        (void)hipFuncSetAttribute((const void*)mega_fwd, hipFuncAttributeMaxDynamicSharedMemorySize, LDS_BYTES);
        if (hipOccupancyMaxActiveBlocksPerMultiprocessor(&per_cu, (const void*)mega_fwd, NTHR, LDS_BYTES) != hipSuccess || per_cu < 1) {
            fprintf(stderr, "kernel_launch: occupancy query reports %d blocks/CU\n", per_cu); (void)hipGetLastError(); grid = -1; return; }
        grid = cus * 1;
    }
    if (grid < 0) return;
    KP a{};
    for (int i = 0; i < N_IN; ++i) a.in[i] = (const float*)d_in[i];
    a.out = (float*)d_out; a.ws = (unsigned char*)d_ws; a.ph_lo = 0; a.ph_hi = N_STEPS;
    if (hipMemsetAsync((char*)d_ws + WS_CTL, 0, 1 * MiB, stream) != hipSuccess) { fprintf(stderr, "kernel_launch: memset failed\n"); return; }
    void* args[] = {&a};
    hipError_t e = hipLaunchCooperativeKernel((const void*)mega_fwd, dim3(grid), dim3(NTHR), args, LDS_BYTES, stream);
    if (e != hipSuccess) fprintf(stderr, "cooperative launch failed: %s (grid %d)\n", hipGetErrorString(e), grid);
}
```

```cpp
#include <hip/hip_runtime.h>
#include <hip/hip_cooperative_groups.h>
#include <cstdio>
#include <cstdint>
namespace cg = cooperative_groups;
__device__ __forceinline__ int opaque_tid() { int t = threadIdx.x; asm volatile("" : "+v"(t)); return t; }
namespace pg8 {
#define PG8_LAS __attribute__((address_space(3)))
typedef unsigned short bf16_t;
typedef short bf16x8 __attribute__((ext_vector_type(8)));
typedef float f32x4 __attribute__((ext_vector_type(4)));
typedef unsigned u32x4 __attribute__((ext_vector_type(4)));
constexpr int BM = 256, BK = 64, HALF = 128, HTB = HALF * BK * 2  , STAGE_BYTES = 8 * HTB, NXCD = 8, WGM = 8;

__host__ __device__ __forceinline__ int lds_byte(int r, int c) { const int st = (r >> 4) * 2 + (c >> 5), rr = r & 15, cc = c & 31, ob = rr * 64 + cc * 2; return st * 1024 + (ob ^ (((ob >> 9) & 1) << 5)); }
__host__ __device__ __forceinline__ void stage_rc(int b, int& R, int& C) { const int st = b / 1024, sb = b % 1024, swz = sb ^ (((sb >> 9) & 1) << 5); R = (st >> 1) * 16 + swz / 64; C = (st & 1) * 32 + (swz % 64) / 2; }
__host__ __device__ __forceinline__ int perm32(int rho) { const int n = rho >> 4, i = rho & 15; return 8 * (i >> 2) + 4 * n + (i & 3); }

struct Unit { int pm, pn; };
struct Gemm { const bf16_t* A; const bf16_t* Bt; int M, N, K, lda, ldb; };

struct StaticOrder {
    int nM, nN, nwg, G, c;
    __host__ __device__ void init(int M, int N, int G_, int c_) { nM = M / BM; nN = N / BM; nwg = nM * nN; G = G_; c = c_; }
    __host__ __device__ bool next(int i, Unit& u) const {
        const long L = (long)i * G + c; if (L >= nwg) return false;
        int wgid = (int)L; { const int q = nwg / NXCD, r = nwg % NXCD, xcd = wgid % NXCD, off = wgid / NXCD; wgid = (xcd < r ? xcd * (q + 1) : r * (q + 1) + (xcd - r) * q) + off; }
        const int nig = WGM * nN, gid = wgid / nig, fm = gid * WGM, gsz = (nM - fm) < WGM ? (nM - fm) : WGM;
        u.pm = fm + ((wgid % nig) % gsz); u.pn = (wgid % nig) / gsz; return true;
    }
    __device__ __forceinline__ void a_ready(const Unit&) const {}
    __device__ __forceinline__ void done(const Unit&) const {}
};

__device__ __forceinline__ unsigned cvt_pk_bf16(float lo, float hi) { unsigned r; asm volatile("v_cvt_pk_bf16_f32 %0, %1, %2" : "=v"(r) : "v"(lo), "v"(hi)); return r; }
typedef unsigned u32x2 __attribute__((ext_vector_type(2)));
template <int ACT  > struct EpiBf {
    static constexpr bool PERM = true, AFTER_DRAIN = false;
    bf16_t* O; int ldc;
    __device__ __forceinline__ void operator()(const f32x4 (&acc)[2][2][4][2], const Unit& u, int wr, int wc, int fr, int fq) const {
        const int row0 = u.pm * BM + wr * 64 + fr, col0 = u.pn * BM + wc * 32 + 8 * fq;
#pragma unroll
        for (int ai = 0; ai < 2; ++ai)
#pragma unroll
            for (int m = 0; m < 4; ++m) { bf16_t* rowp = O + (size_t)(row0 + ai * HALF + m * 16) * ldc + col0;
#pragma unroll
                for (int bj = 0; bj < 2; ++bj) { f32x4 v0 = acc[ai][bj][m][0], v1 = acc[ai][bj][m][1];
                    if (ACT == 1) {
#pragma unroll
                        for (int e = 0; e < 4; ++e) { float a = v0[e] > 0.f ? v0[e] : 0.f; v0[e] = a * a; float b = v1[e] > 0.f ? v1[e] : 0.f; v1[e] = b * b; } }
                    u32x4 w; w.x = cvt_pk_bf16(v0[0], v0[1]); w.y = cvt_pk_bf16(v0[2], v0[3]); w.z = cvt_pk_bf16(v1[0], v1[1]); w.w = cvt_pk_bf16(v1[2], v1[3]);
                    *(u32x4*)(rowp + bj * HALF) = w; } }
    }
};
struct EpiRes {
    static constexpr bool PERM = false, AFTER_DRAIN = false;
    float* X; const float* gate; const float* Xc; const float* Xl;
    __device__ __forceinline__ void operator()(const f32x4 (&acc)[2][2][4][2], const Unit& u, int wr, int wc, int fr, int fq) const {
        const int row0 = u.pm * BM + wr * 64 + fr, col0 = u.pn * BM + wc * 32 + 4 * fq;
        const int cond = u.pm < 32 ? 0 : 1 + ((u.pm - 32) >> 2);
        const float* gp = gate + cond * 6144 + col0;
        f32x4 gv[2][2];
#pragma unroll
        for (int bj = 0; bj < 2; ++bj)
#pragma unroll
            for (int n = 0; n < 2; ++n) gv[bj][n] = *(const f32x4*)(gp + bj * HALF + n * 16);
#pragma unroll
        for (int ai = 0; ai < 2; ++ai)
#pragma unroll
            for (int m = 0; m < 4; ++m) { const size_t ro = (size_t)(row0 + ai * HALF + m * 16) * 1024 + col0; float* rowp = X + ro; const float* srcp = u.pm < 32 ? Xc + ro : Xl + (ro - (size_t)8192 * 1024);
#pragma unroll
                for (int bj = 0; bj < 2; ++bj)
#pragma unroll
                    for (int n = 0; n < 2; ++n) { *(f32x4*)(rowp + bj * HALF + n * 16) = *(const f32x4*)(srcp + bj * HALF + n * 16) + gv[bj][n] * acc[ai][bj][m][n]; }
                if (m & 1) asm volatile("" ::: "memory"); }
    }
};
struct EpiFnet {
    static constexpr bool PERM = true, AFTER_DRAIN = false;
    bf16_t* MIX; int rowbase, L;
    __device__ __forceinline__ void operator()(const f32x4 (&acc)[2][2][4][2], const Unit& u, int wr, int wc, int fr, int fq) const {
        const int row0 = u.pm * BM + wr * 64 + fr, colw = wc * 32 + 8 * fq;
        bf16_t* base = MIX + (size_t)(rowbase + u.pn * L) * 1024 + 512 + colw;
#pragma unroll
        for (int ai = 0; ai < 2; ++ai)
#pragma unroll
            for (int m = 0; m < 4; ++m) { bf16_t* rowp = base + (size_t)(row0 + ai * HALF + m * 16) * 1024;
#pragma unroll
                for (int bj = 0; bj < 2; ++bj) { const f32x4 v0 = acc[ai][bj][m][0], v1 = acc[ai][bj][m][1];
                    u32x4 w; w.x = cvt_pk_bf16(v0[0], v0[1]); w.y = cvt_pk_bf16(v0[2], v0[3]); w.z = cvt_pk_bf16(v1[0], v1[1]); w.w = cvt_pk_bf16(v1[2], v1[3]);
                    *(u32x4*)(rowp + bj * HALF) = w; } }
    }
};

__device__ __forceinline__ float xsum_fq(float s, int fr, int fq) {
    s += __builtin_bit_cast(float, __builtin_amdgcn_ds_bpermute((((fq ^ 1) << 4) | fr) << 2, __builtin_bit_cast(int, s)));
    s += __builtin_bit_cast(float, __builtin_amdgcn_ds_bpermute((((fq ^ 2) << 4) | fr) << 2, __builtin_bit_cast(int, s)));
    return s;
}
template <int ACT> struct EpiNormBf {
    static constexpr bool PERM = true, AFTER_DRAIN = false;
    bf16_t* O; int ldc; const float* ssq; const float* sw; int swld;
    __device__ __forceinline__ void operator()(const f32x4 (&acc)[2][2][4][2], const Unit& u, int wr, int wc, int fr, int fq) const {
        const int row0 = u.pm * BM + wr * 64 + fr, col0 = u.pn * BM + wc * 32 + 8 * fq;
        const int cond = u.pm < 32 ? 0 : 1 + ((u.pm - 32) >> 2);
        f32x4 sv[2][2];
#pragma unroll
        for (int bj = 0; bj < 2; ++bj)
#pragma unroll
            for (int n = 0; n < 2; ++n) sv[bj][n] = *(const f32x4*)(sw + (size_t)cond * swld + col0 + bj * HALF + 4 * n);
        float rs[2][4];
#pragma unroll
        for (int ai = 0; ai < 2; ++ai)
#pragma unroll
            for (int m = 0; m < 4; ++m) rs[ai][m] = ssq[row0 + ai * HALF + m * 16];
#pragma unroll
        for (int ai = 0; ai < 2; ++ai)
#pragma unroll
            for (int m = 0; m < 4; ++m) rs[ai][m] = __builtin_amdgcn_rsqf(rs[ai][m] * (1.0f / 1024.0f) + 1e-6f);
#pragma unroll
        for (int ai = 0; ai < 2; ++ai)
#pragma unroll
            for (int m = 0; m < 4; ++m) { const int row = row0 + ai * HALF + m * 16; bf16_t* rowp = O + (size_t)row * ldc + col0;
                const float rstd = rs[ai][m];
#pragma unroll
                for (int bj = 0; bj < 2; ++bj) { f32x4 v0 = acc[ai][bj][m][0] * rstd + sv[bj][0], v1 = acc[ai][bj][m][1] * rstd + sv[bj][1];
                    if (ACT == 1) {
#pragma unroll
                        for (int e = 0; e < 4; ++e) { float a = v0[e] > 0.f ? v0[e] : 0.f; v0[e] = a * a; float b = v1[e] > 0.f ? v1[e] : 0.f; v1[e] = b * b; } }
                    u32x4 w; w.x = cvt_pk_bf16(v0[0], v0[1]); w.y = cvt_pk_bf16(v0[2], v0[3]); w.z = cvt_pk_bf16(v1[0], v1[1]); w.w = cvt_pk_bf16(v1[2], v1[3]);
                    *(u32x4*)(rowp + bj * HALF) = w; }
                if (m & 1) asm volatile("" ::: "memory"); }
    }
};
struct EpiResFinal {
    static constexpr bool PERM = true, AFTER_DRAIN = false;
    const bf16_t* XB; const float* gate; const float* gfin; float* out; float* ssq; unsigned* cnt;
    __device__ __forceinline__ void operator()(const f32x4 (&acc)[2][2][4][2], const Unit& u, int wr, int wc, int fr, int fq) const {
        const int row0 = u.pm * BM + wr * 64 + fr, col0 = u.pn * BM + wc * 32 + 8 * fq;
        const int cond = u.pm < 32 ? 0 : 1 + ((u.pm - 32) >> 2);
        f32x4 gt[2][2];
#pragma unroll
        for (int bj = 0; bj < 2; ++bj)
#pragma unroll
            for (int n = 0; n < 2; ++n) gt[bj][n] = *(const f32x4*)(gate + cond * 6144 + col0 + bj * HALF + n * 4);
#pragma unroll
        for (int ai = 0; ai < 2; ++ai) {
            u32x4 xb[4][2];
#pragma unroll
            for (int m = 0; m < 4; ++m)
#pragma unroll
                for (int bj = 0; bj < 2; ++bj) xb[m][bj] = *(const u32x4*)(XB + (unsigned)(row0 + ai * HALF + m * 16) * 1024u + (unsigned)col0 + bj * HALF);
#pragma unroll
            for (int m = 0; m < 4; ++m) { const int row = row0 + ai * HALF + m * 16;
                float sq = 0.f;
#pragma unroll
                for (int bj = 0; bj < 2; ++bj) { const u32x4 xw = xb[m][bj];
                    f32x4 x0 = (f32x4){__builtin_bit_cast(float, xw.x << 16), __builtin_bit_cast(float, xw.x & 0xffff0000u), __builtin_bit_cast(float, xw.y << 16), __builtin_bit_cast(float, xw.y & 0xffff0000u)};
                    f32x4 x1 = (f32x4){__builtin_bit_cast(float, xw.z << 16), __builtin_bit_cast(float, xw.z & 0xffff0000u), __builtin_bit_cast(float, xw.w << 16), __builtin_bit_cast(float, xw.w & 0xffff0000u)};
                    x0 += gt[bj][0] * acc[ai][bj][m][0]; x1 += gt[bj][1] * acc[ai][bj][m][1];
                    sq += ((x0[0] * x0[0] + x0[1] * x0[1]) + (x0[2] * x0[2] + x0[3] * x0[3])) + ((x1[0] * x1[0] + x1[1] * x1[1]) + (x1[2] * x1[2] + x1[3] * x1[3])); }
                const float t = xsum_fq(sq, fr, fq); if (fq == 0) atomicAdd(ssq + row, t); }
            asm volatile("" ::: "memory"); }
        asm volatile("s_waitcnt vmcnt(0)" ::: "memory");
        unsigned* c = cnt + 64 * u.pm;
        if (fr == 0 && fq == 0) { __hip_atomic_fetch_add(c, 1u, __ATOMIC_RELAXED, __HIP_MEMORY_SCOPE_AGENT);
            for (unsigned spin = 0; __hip_atomic_load(c, __ATOMIC_RELAXED, __HIP_MEMORY_SCOPE_AGENT) < 32u && spin < (1u << 22); ++spin) __builtin_amdgcn_s_sleep(2); }
        asm volatile("" ::: "memory");
        f32x4 gv[2][2];
#pragma unroll
        for (int bj = 0; bj < 2; ++bj)
#pragma unroll
            for (int n = 0; n < 2; ++n) gv[bj][n] = *(const f32x4*)(gfin + col0 + bj * HALF + n * 4);
#pragma unroll
        for (int ai = 0; ai < 2; ++ai) {
            u32x4 xb[4][2]; float rs[4];
#pragma unroll
            for (int m = 0; m < 4; ++m) { rs[m] = __hip_atomic_load(ssq + row0 + ai * HALF + m * 16, __ATOMIC_RELAXED, __HIP_MEMORY_SCOPE_AGENT);
#pragma unroll
                for (int bj = 0; bj < 2; ++bj) xb[m][bj] = *(const u32x4*)(XB + (unsigned)(row0 + ai * HALF + m * 16) * 1024u + (unsigned)col0 + bj * HALF); }
#pragma unroll
            for (int m = 0; m < 4; ++m) { const unsigned ro = (unsigned)(row0 + ai * HALF + m * 16) * 1024u + (unsigned)col0;
                const float rstd = __builtin_amdgcn_rsqf(rs[m] * (1.0f / 1024.0f) + 1e-6f);
#pragma unroll
                for (int bj = 0; bj < 2; ++bj) { const u32x4 xw = xb[m][bj];
                    f32x4 x0 = (f32x4){__builtin_bit_cast(float, xw.x << 16), __builtin_bit_cast(float, xw.x & 0xffff0000u), __builtin_bit_cast(float, xw.y << 16), __builtin_bit_cast(float, xw.y & 0xffff0000u)};
                    f32x4 x1 = (f32x4){__builtin_bit_cast(float, xw.z << 16), __builtin_bit_cast(float, xw.z & 0xffff0000u), __builtin_bit_cast(float, xw.w << 16), __builtin_bit_cast(float, xw.w & 0xffff0000u)};
                    f32x4 ga = gt[bj][0], gb = gt[bj][1]; asm volatile("" : "+v"(ga), "+v"(gb));
                    x0 += ga * acc[ai][bj][m][0]; x1 += gb * acc[ai][bj][m][1];
                    *(f32x4*)(out + ro + bj * HALF) = x0 * rstd * gv[bj][0]; *(f32x4*)(out + ro + bj * HALF + 4) = x1 * rstd * gv[bj][1]; } }
            asm volatile("" ::: "memory"); }
    }
};
template <bool SRC_F32, bool WRITE_H> struct EpiResNorm {
    static constexpr bool PERM = true, AFTER_DRAIN = false;
    bf16_t* XB; const float* gate; const float* Xc; const float* Xl; bf16_t* H; const float* gn; const float* scl; float* ssq;
    __device__ __forceinline__ void operator()(const f32x4 (&acc)[2][2][4][2], const Unit& u, int wr, int wc, int fr, int fq) const {
        const int row0 = u.pm * BM + wr * 64 + fr, col0 = u.pn * BM + wc * 32 + 8 * fq;
        const int cond = u.pm < 32 ? 0 : 1 + ((u.pm - 32) >> 2);
        const float* src = u.pm < 32 ? Xc : Xl - (size_t)8192 * 1024;
        f32x4 gt[2][2], gs[2][2];
#pragma unroll
        for (int bj = 0; bj < 2; ++bj)
#pragma unroll
            for (int n = 0; n < 2; ++n) { const int col = col0 + bj * HALF + n * 4;
                gt[bj][n] = *(const f32x4*)(gate + cond * 6144 + col);
                if (WRITE_H) gs[bj][n] = *(const f32x4*)(gn + col) * (*(const f32x4*)(scl + cond * 6144 + col) + 1.0f); }
        constexpr int NB = SRC_F32 ? 2 : 4;
#pragma unroll
        for (int ai = 0; ai < 2; ++ai)
#pragma unroll
        for (int mb = 0; mb < 4; mb += NB) {
            u32x4 xb[NB][2]; f32x4 xf[NB][2][2];
#pragma unroll
            for (int mm = 0; mm < NB; ++mm) { const unsigned ro = (unsigned)(row0 + ai * HALF + (mb + mm) * 16) * 1024u + (unsigned)col0;
#pragma unroll
                for (int bj = 0; bj < 2; ++bj) {
                    if (SRC_F32) { xf[mm][bj][0] = *(const f32x4*)(src + ro + bj * HALF); xf[mm][bj][1] = *(const f32x4*)(src + ro + bj * HALF + 4); }
                    else xb[mm][bj] = *(const u32x4*)(XB + ro + bj * HALF); } }
#pragma unroll
            for (int mm = 0; mm < NB; ++mm) { const int m = mb + mm; const int row = row0 + ai * HALF + m * 16; const unsigned ro = (unsigned)row * 1024u + (unsigned)col0;
                float sq = 0.f;
#pragma unroll
                for (int bj = 0; bj < 2; ++bj) { const unsigned o = ro + bj * HALF;
                    f32x4 x0, x1;
                    if (SRC_F32) { x0 = xf[mm][bj][0]; x1 = xf[mm][bj][1]; }
                    else { const u32x4 xw = xb[mm][bj];
                        x0 = (f32x4){__builtin_bit_cast(float, xw.x << 16), __builtin_bit_cast(float, xw.x & 0xffff0000u), __builtin_bit_cast(float, xw.y << 16), __builtin_bit_cast(float, xw.y & 0xffff0000u)};
                        x1 = (f32x4){__builtin_bit_cast(float, xw.z << 16), __builtin_bit_cast(float, xw.z & 0xffff0000u), __builtin_bit_cast(float, xw.w << 16), __builtin_bit_cast(float, xw.w & 0xffff0000u)}; }
                    x0 += gt[bj][0] * acc[ai][bj][m][0]; x1 += gt[bj][1] * acc[ai][bj][m][1];
                    u32x4 xo; xo.x = cvt_pk_bf16(x0[0], x0[1]); xo.y = cvt_pk_bf16(x0[2], x0[3]); xo.z = cvt_pk_bf16(x1[0], x1[1]); xo.w = cvt_pk_bf16(x1[2], x1[3]);
                    *(u32x4*)(XB + o) = xo;
                    sq += ((x0[0] * x0[0] + x0[1] * x0[1]) + (x0[2] * x0[2] + x0[3] * x0[3])) + ((x1[0] * x1[0] + x1[1] * x1[1]) + (x1[2] * x1[2] + x1[3] * x1[3]));
                    if (WRITE_H) { const f32x4 h0 = x0 * gs[bj][0], h1 = x1 * gs[bj][1];
                        u32x4 w; w.x = cvt_pk_bf16(h0[0], h0[1]); w.y = cvt_pk_bf16(h0[2], h0[3]); w.z = cvt_pk_bf16(h1[0], h1[1]); w.w = cvt_pk_bf16(h1[2], h1[3]);
                        *(u32x4*)(H + o) = w; } }
                const float t = xsum_fq(sq, fr, fq); if (fq == 0) atomicAdd(ssq + row, t);
            }
            asm volatile("" ::: "memory"); }
    }
};
template <class Epi, class Sched, bool ALIGN_EPI = false, bool SP2 = false>
__device__ __forceinline__ void gemm_phase(PG8_LAS unsigned char* lds, const Gemm g, const Sched& S, const Epi& E) {
    const int tid = opaque_tid(), wid = __builtin_amdgcn_readfirstlane(tid >> 6), lane = tid & 63, wr = wid >> 2, wc = wid & 3, fr = lane & 15, fq = lane >> 4;
    const int K = g.K, nt = K / BK;
    unsigned voffA[2], voffB[2];
#pragma unroll
    for (int i = 0; i < 2; ++i) { int R, C; stage_rc(tid * 16 + i * 8192, R, C); const int Rb = E.PERM ? ((R & ~31) + perm32(R & 31)) : R;
        voffA[i] = (unsigned)(R * g.lda + C) * 2u; voffB[i] = (unsigned)(Rb * g.ldb + C) * 2u; }
    const size_t kstep = (size_t)(BK * 2);
    const size_t hstepA = (size_t)HALF * g.lda * 2, hstepB = (size_t)HALF * g.ldb * 2;
    const size_t tstepA = 2 * hstepA, tstepB = 2 * hstepB;
    const unsigned ldsw = (unsigned)wid * 1024u;
    const int aoff = lds_byte(wr * 64 + fr, fq * 8), boff = lds_byte(wc * 32 + fr, fq * 8);
#define PG8_SA(b, h) (((b) * 2 + (h)) * HTB)
#define PG8_SB(b, h) ((4 + (b) * 2 + (h)) * HTB)
#define PG8_STAGE(bufoff, gbase, voff) do { _Pragma("unroll") for (int _i = 0; _i < 2; ++_i) \
        __builtin_amdgcn_global_load_lds((const unsigned*)((const char*)(gbase) + (voff)[_i]), (PG8_LAS unsigned*)(lds + (bufoff) + ldsw + _i * 8192), 16, 0, 0); } while (0)
#define PG8_LDA(dst, b, h) do { _Pragma("unroll") for (int m = 0; m < 4; ++m) _Pragma("unroll") for (int k = 0; k < 2; ++k) dst[m][k] = *(const PG8_LAS bf16x8*)(lds + PG8_SA(b, h) + aoff + m * 2048 + k * 1024); } while (0)
#define PG8_LDB(dst, b, h) do { _Pragma("unroll") for (int n = 0; n < 2; ++n) _Pragma("unroll") for (int k = 0; k < 2; ++k) dst[n][k] = *(const PG8_LAS bf16x8*)(lds + PG8_SB(b, h) + boff + n * 2048 + k * 1024); } while (0)
#define PG8_MMA(ai, bj, At, Bt) do { __builtin_amdgcn_s_setprio(1); _Pragma("unroll") for (int m = 0; m < 4; ++m) _Pragma("unroll") for (int n = 0; n < 2; ++n) _Pragma("unroll") for (int k = 0; k < 2; ++k) \
        acc[ai][bj][m][n] = __builtin_amdgcn_mfma_f32_16x16x32_bf16(Bt[n][k], At[m][k], acc[ai][bj][m][n], 0, 0, 0); __builtin_amdgcn_s_setprio(0); } while (0)
#define PG8_WAIT_V(n) asm volatile("s_waitcnt vmcnt(" #n ")" ::: "memory")
#define PG8_WAIT_L(n) asm volatile("s_waitcnt lgkmcnt(" #n ")" ::: "memory")
#define PG8_BAR __builtin_amdgcn_s_barrier()
#define PG8_SCHED __builtin_amdgcn_sched_barrier(0)
    Unit cur, nxt; int ui = 0;
    if (!S.next(0, cur)) return;
    f32x4 acc[2][2][4][2];
#pragma unroll
    for (int a = 0; a < 2; ++a)
#pragma unroll
        for (int b = 0; b < 2; ++b)
#pragma unroll
            for (int m = 0; m < 4; ++m)
#pragma unroll
                for (int n = 0; n < 2; ++n) acc[a][b][m][n] = (f32x4){0.f, 0.f, 0.f, 0.f};
    bf16x8 At[4][2], B0[2][2], B1[2][2];
    const char* cA = (const char*)g.A + (size_t)cur.pm * tstepA; const char* cB = (const char*)g.Bt + (size_t)cur.pn * tstepB;
    S.a_ready(cur);
    if constexpr (SP2) {
        PG8_STAGE(PG8_SB(0, 0), cB, voffB); PG8_STAGE(PG8_SB(0, 1), cB + hstepB, voffB); PG8_STAGE(PG8_SA(0, 0), cA, voffA); PG8_STAGE(PG8_SA(0, 1), cA + hstepA, voffA);
        if (wr == 1) PG8_BAR;
        PG8_WAIT_V(2); PG8_BAR;
        PG8_STAGE(PG8_SB(1, 0), cB + kstep, voffB); PG8_STAGE(PG8_SA(1, 0), cA + kstep, voffA); PG8_STAGE(PG8_SB(1, 1), cB + hstepB + kstep, voffB);
        PG8_WAIT_V(6); PG8_BAR;
    } else {
        PG8_STAGE(PG8_SB(0, 0), cB, voffB); PG8_STAGE(PG8_SA(0, 0), cA, voffA); PG8_STAGE(PG8_SB(0, 1), cB + hstepB, voffB); PG8_STAGE(PG8_SA(0, 1), cA + hstepA, voffA);
        if (wr == 1) PG8_BAR;
        PG8_WAIT_V(4); PG8_BAR;
        PG8_STAGE(PG8_SB(1, 0), cB + kstep, voffB); PG8_STAGE(PG8_SA(1, 0), cA + kstep, voffA); PG8_STAGE(PG8_SB(1, 1), cB + hstepB + kstep, voffB);
        PG8_WAIT_V(6); PG8_BAR;
    }
    for (;;) {
        const bool has_next = S.next(ui + 1, nxt);
        const char* nA = has_next ? (const char*)g.A + (size_t)nxt.pm * tstepA : cA; const char* nB = has_next ? (const char*)g.Bt + (size_t)nxt.pn * tstepB : cB;
        for (int t = 0; t < nt; t += 2) {
            const bool last = (t == nt - 2);
            const char* a1 = cA + (size_t)(t + 1) * kstep;
            const char* a2 = last ? nA : cA + (size_t)(t + 2) * kstep; const char* b2 = last ? nB : cB + (size_t)(t + 2) * kstep;
            const char* a3 = a2 + kstep; const char* b3 = b2 + kstep;
            if (last && has_next) S.a_ready(nxt);
            if constexpr (SP2) {
            PG8_LDB(B0, 0, 0); PG8_LDB(B1, 0, 1); PG8_SCHED; PG8_LDA(At, 0, 0); PG8_STAGE(PG8_SA(1, 1), a1 + hstepA, voffA);
            PG8_WAIT_V(8); PG8_WAIT_L(0); PG8_BAR; PG8_MMA(0, 0, At, B0); PG8_MMA(0, 1, At, B1); PG8_BAR; PG8_SCHED;
            PG8_LDA(At, 0, 1); PG8_STAGE(PG8_SB(0, 0), b2, voffB); PG8_STAGE(PG8_SB(0, 1), b2 + hstepB, voffB); PG8_STAGE(PG8_SA(0, 0), a2, voffA);
            PG8_WAIT_V(8); PG8_WAIT_L(0); PG8_BAR; PG8_MMA(1, 0, At, B0); PG8_MMA(1, 1, At, B1); PG8_BAR; PG8_SCHED;
            PG8_LDB(B0, 1, 0); PG8_LDB(B1, 1, 1); PG8_SCHED; PG8_LDA(At, 1, 0); PG8_STAGE(PG8_SA(0, 1), a2 + hstepA, voffA);
            PG8_WAIT_V(8); PG8_WAIT_L(0); PG8_BAR; PG8_MMA(0, 0, At, B0); PG8_MMA(0, 1, At, B1); PG8_BAR; PG8_SCHED;
            PG8_LDA(At, 1, 1); PG8_STAGE(PG8_SB(1, 0), b3, voffB); PG8_STAGE(PG8_SB(1, 1), b3 + hstepB, voffB); PG8_STAGE(PG8_SA(1, 0), a3, voffA);
            PG8_WAIT_V(8); PG8_WAIT_L(0); PG8_BAR; PG8_MMA(1, 0, At, B0); PG8_MMA(1, 1, At, B1); PG8_BAR; PG8_SCHED;
            } else {
            PG8_LDB(B0, 0, 0); PG8_SCHED; PG8_LDA(At, 0, 0); PG8_STAGE(PG8_SA(1, 1), a1 + hstepA, voffA);
            PG8_WAIT_L(8); PG8_BAR; PG8_WAIT_L(0); PG8_MMA(0, 0, At, B0); PG8_BAR; PG8_SCHED;
            PG8_LDB(B1, 0, 1); PG8_STAGE(PG8_SB(0, 0), b2, voffB);
            PG8_BAR; PG8_WAIT_L(0); PG8_MMA(0, 1, At, B1); PG8_BAR;
            PG8_LDA(At, 0, 1); PG8_STAGE(PG8_SA(0, 0), a2, voffA);
            PG8_BAR; PG8_WAIT_L(0); PG8_MMA(1, 0, At, B0); PG8_BAR; PG8_SCHED;
            PG8_STAGE(PG8_SB(0, 1), b2 + hstepB, voffB);
            PG8_WAIT_V(6); PG8_BAR; PG8_MMA(1, 1, At, B1); PG8_BAR;
            PG8_LDB(B0, 1, 0); PG8_SCHED; PG8_LDA(At, 1, 0); PG8_STAGE(PG8_SA(0, 1), a2 + hstepA, voffA);
            PG8_WAIT_L(8); PG8_BAR; PG8_WAIT_L(0); PG8_MMA(0, 0, At, B0); PG8_BAR; PG8_SCHED;
            PG8_LDB(B1, 1, 1); PG8_STAGE(PG8_SB(1, 0), b3, voffB);
            PG8_BAR; PG8_WAIT_L(0); PG8_MMA(0, 1, At, B1); PG8_BAR;
            PG8_LDA(At, 1, 1); PG8_STAGE(PG8_SA(1, 0), a3, voffA);
            PG8_BAR; PG8_WAIT_L(0); PG8_MMA(1, 0, At, B0); PG8_BAR; PG8_SCHED;
            PG8_STAGE(PG8_SB(1, 1), b3 + hstepB, voffB);
            PG8_WAIT_V(6); PG8_BAR; PG8_MMA(1, 1, At, B1); PG8_BAR;
            }
        }
        if constexpr (ALIGN_EPI) { if (wr == 0) PG8_BAR; }
        if constexpr (!Epi::AFTER_DRAIN) { int fr2 = fr, fq2 = fq; asm volatile("" : "+v"(fr2), "+v"(fq2)); E(acc, cur, wr, wc, fr2, fq2); S.done(cur); }
        if (!has_next) break;
#pragma unroll
        for (int a = 0; a < 2; ++a)
#pragma unroll
            for (int b = 0; b < 2; ++b)
#pragma unroll
                for (int m = 0; m < 4; ++m)
#pragma unroll
                    for (int n = 0; n < 2; ++n) acc[a][b][m][n] = (f32x4){0.f, 0.f, 0.f, 0.f};
        cur = nxt; cA = nA; cB = nB; ++ui;
        if constexpr (ALIGN_EPI) { if (wr == 1) PG8_BAR; }
    }
    PG8_WAIT_V(0);
    if constexpr (!ALIGN_EPI) { if (wr == 0) PG8_BAR; }
    PG8_BAR;
    if constexpr (Epi::AFTER_DRAIN) { E.fused(acc, cur, wr, wc, fr, fq, lds, wid, lane); S.done(cur); }
#undef PG8_SA
#undef PG8_SB
#undef PG8_STAGE
#undef PG8_LDA
#undef PG8_LDB
#undef PG8_MMA
#undef PG8_WAIT_V
#undef PG8_WAIT_L
#undef PG8_BAR
#undef PG8_SCHED
}
}

#define LAS __attribute__((address_space(3)))
typedef unsigned short bf16;
typedef float f32x4 __attribute__((ext_vector_type(4)));
typedef unsigned u32x4 __attribute__((ext_vector_type(4)));
typedef unsigned u32x2 __attribute__((ext_vector_type(2)));
constexpr int DM = 1024, NCTX = 8192, MTOK = 12288, DINP = 2560, DFF = 4096;
constexpr int R_OFF = 0, K_OFF = 512, V_OFF = 1024, WD_OFF = 1536, AD_OFF = 1664, GD_OFF = 1792, F_OFF = 1920, P_OFF = 2176, DIN = 2432;
constexpr size_t MiB = 1u << 20;
constexpr size_t WS_CTL = 0, WS_MOD = 1 * MiB, WS_FW = 1 * MiB + 512 * 1024, WS_BC = 2 * MiB, WS_CS256 = 3 * MiB, WS_CS1024 = 4 * MiB, WS_WIN = 8 * MiB, WS_WOUT = 18 * MiB,
                 WS_W1 = 22 * MiB, WS_W2 = 38 * MiB, WS_H = 54 * MiB, WS_MIXED = 78 * MiB, WS_PROJ = 102 * MiB, WS_YCS = 162 * MiB, WS_YF = 102 * MiB, WS_YB = 126 * MiB  , WS_U = 174 * MiB, WS_KINV = 220 * MiB, WS_GUPT = 221 * MiB,
                 WS_FF = 102 * MiB, WS_WUPT = 222 * MiB, WS_AUPT = 222 * MiB + 256 * 1024, WS_SSQ = 223 * MiB, WS_WPT = 223 * MiB + 512 * 1024, WS_SW1 = 224 * MiB, WS_SWIN = 224 * MiB + 256 * 1024, WS_XB = 226 * MiB, WS_END = 250 * MiB;
constexpr int LDS_BYTES = 147456, RING_BYTES = 131072, MISC_OFF = RING_BYTES + 320;
constexpr int NTHR = 512;
enum { I_XP = 0, I_XS, I_STATE, I_C, I_CCTX, I_WADA, I_BADA, I_N1G, I_WIN, I_MU, I_W0, I_WUP, I_A0, I_AUP, I_GUP, I_KK, I_KA, I_RK, I_LNW, I_LNB, I_WFNET, I_WPOOL, I_PSCALE, I_WOUT, I_N2G, I_WFF1, I_WFF2, I_FNG, N_IN };
struct KP { const float* in[N_IN]; float* out; unsigned char* ws; int ph_lo, ph_hi; };
typedef const __attribute__((address_space(4))) KP CKP;

__device__ __forceinline__ unsigned f2bf(float f) { unsigned u = __builtin_bit_cast(unsigned, f); return (u + 0x7fffu + ((u >> 16) & 1u)) >> 16; }
__device__ __forceinline__ unsigned pk2(float lo, float hi) { return f2bf(lo) | (f2bf(hi) << 16); }
__device__ __forceinline__ float bflo(unsigned w) { return __builtin_bit_cast(float, w << 16); }
__device__ __forceinline__ float bfhi(unsigned w) { return __builtin_bit_cast(float, w & 0xffff0000u); }
__device__ __forceinline__ float bf1(bf16 h) { return __builtin_bit_cast(float, (unsigned)h << 16); }
__device__ __forceinline__ float fexp(float x) { return __builtin_amdgcn_exp2f(x * 1.4426950408889634f); }
__device__ __forceinline__ float flog(float x) { return __builtin_amdgcn_logf(x) * 0.6931471805599453f; }
__device__ __forceinline__ float frcp(float x) { return __builtin_amdgcn_rcpf(x); }
__device__ __forceinline__ float frsq(float x) { return __builtin_amdgcn_rsqf(x); }
__device__ __forceinline__ float fsigmoid(float x) { return frcp(1.0f + fexp(-x)); }
template <int CTRL> __device__ __forceinline__ float dppf(float x) { return __builtin_bit_cast(float, __builtin_amdgcn_update_dpp(0, __builtin_bit_cast(int, x), CTRL, 0xF, 0xF, true)); }
__device__ __forceinline__ float red8(float x)  { x += dppf<0xB1>(x); x += dppf<0x4E>(x); x += dppf<0x141>(x); return x; }
__device__ __forceinline__ float red16(float x) { x += dppf<0xB1>(x); x += dppf<0x4E>(x); x += dppf<0x141>(x); x += dppf<0x140>(x); return x; }
__device__ __forceinline__ float wave_sum(float v) {
    v = red16(v);
    const float s0 = __builtin_bit_cast(float, __builtin_amdgcn_readlane(__builtin_bit_cast(int, v), 0)), s1 = __builtin_bit_cast(float, __builtin_amdgcn_readlane(__builtin_bit_cast(int, v), 16));
    const float s2 = __builtin_bit_cast(float, __builtin_amdgcn_readlane(__builtin_bit_cast(int, v), 32)), s3 = __builtin_bit_cast(float, __builtin_amdgcn_readlane(__builtin_bit_cast(int, v), 48));
    return (s0 + s1) + (s2 + s3);
}
__device__ __forceinline__ void load4bf(const bf16* p, float (&o)[4]) { const u32x2 w = *(const u32x2*)p; o[0] = bflo(w.x); o[1] = bfhi(w.x); o[2] = bflo(w.y); o[3] = bfhi(w.y); }
__device__ __forceinline__ void load8bf(const bf16* p, float (&o)[8]) { const u32x4 w = *(const u32x4*)p; o[0] = bflo(w.x); o[1] = bfhi(w.x); o[2] = bflo(w.y); o[3] = bfhi(w.y); o[4] = bflo(w.z); o[5] = bfhi(w.z); o[6] = bflo(w.w); o[7] = bfhi(w.w); }
__device__ __forceinline__ void shift4(const bf16* proj, int row, bool hasp, bool hasn, int col, const float* mu, float (&u)[4]) {
    float p[4], a[4] = {0.f, 0.f, 0.f, 0.f}, b[4] = {0.f, 0.f, 0.f, 0.f};
    load4bf(proj + (size_t)row * DINP + col, p);
    if (hasp) load4bf(proj + (size_t)(row - 1) * DINP + col, a);
    if (hasn) load4bf(proj + (size_t)(row + 1) * DINP + col, b);
    const f32x4 m = *(const f32x4*)(mu + col);
#pragma unroll
    for (int j = 0; j < 4; ++j) u[j] = p[j] + m[j] * (0.5f * (a[j] + b[j]) - p[j]);
}

__device__ __forceinline__ void gemv5_cols(LAS float* sc, LAS float* red, const float* W, int ldw, int colw, const float* bias, float* out, int ldo, int colo, int tid) {
    const int cgi = tid & 15, kg = tid >> 4;
    f32x4 acc[5];
#pragma unroll
    for (int c = 0; c < 5; ++c) acc[c] = (f32x4){0.f, 0.f, 0.f, 0.f};
    const float* wp = W + (size_t)(kg * 32) * ldw + colw + cgi * 4;
#pragma unroll 16
    for (int kk = 0; kk < 32; ++kk) { const f32x4 w = *(const f32x4*)(wp + (size_t)kk * ldw);
#pragma unroll
        for (int c = 0; c < 5; ++c) acc[c] += sc[c * 1024 + kg * 32 + kk] * w; }
#pragma unroll
    for (int c = 0; c < 5; ++c) *(LAS f32x4*)(red + (kg * 5 + c) * 64 + cgi * 4) = acc[c];
    __syncthreads();
    if (tid < 320) { const int cond = tid >> 6, col = tid & 63; float sm = bias ? bias[colo + col] : 0.f;
        for (int g = 0; g < 32; ++g) sm += red[(g * 5 + cond) * 64 + col];
        out[(size_t)cond * ldo + colo + col] = sm; }
    __syncthreads();
}
__device__ __forceinline__ void mod_item(CKP& p, LAS unsigned char* lds, int it) {
    const int tid = opaque_tid(); unsigned char* ws = p.ws;
    LAS float* sc = (LAS float*)lds; LAS float* red = (LAS float*)(lds + 20480);
    const int l = it / 96, cgp = it % 96;
    for (int i = tid; i < 5 * 1024; i += NTHR) { const int cond = i >> 10, k = i & 1023; const float v = cond == 0 ? p.in[I_CCTX][k] : p.in[I_C][(cond - 1) * 1024 + k]; sc[i] = v * fsigmoid(v); }
    __syncthreads();
    gemv5_cols(sc, red, p.in[I_WADA] + (size_t)l * 1024 * 6144, 6144, cgp * 64, p.in[I_BADA] + l * 6144, (float*)(ws + WS_MOD) + (size_t)l * 5 * 6144, 6144, cgp * 64, tid);
}
constexpr int TI_IN = 16 * 76, TI_OUT = 16 * 32, TI_1 = 16 * 128, TI_2 = 64 * 32, TI_L = TI_IN + TI_OUT + TI_1 + TI_2;
struct TrItem { const float* src; bf16* dst; const float* shv; float* sw; int N, K, swld; };
__device__ __forceinline__ TrItem tr_decode(CKP& p, int it) {
    unsigned char* ws = p.ws; const int l = it / TI_L; int r = it % TI_L;
    const float* W; bf16* WT; int K, N; const float* shv = nullptr; float* sw = nullptr; int swld = 0;
    if (r < TI_IN) { W = p.in[I_WIN] + (size_t)l * DM * DIN; K = DM; N = DIN; WT = (bf16*)(ws + WS_WIN) + (size_t)l * DINP * DM;
        if (l == 1) { shv = (const float*)(ws + WS_MOD) + (size_t)5 * 6144; sw = (float*)(ws + WS_SWIN); swld = DINP; } }
    else if ((r -= TI_IN) < TI_OUT) { W = p.in[I_WOUT] + (size_t)l * DM * DM; K = DM; N = DM; WT = (bf16*)(ws + WS_WOUT) + (size_t)l * DM * DM; }
    else if ((r -= TI_OUT) < TI_1) { W = p.in[I_WFF1] + (size_t)l * DM * DFF; K = DM; N = DFF; WT = (bf16*)(ws + WS_W1) + (size_t)l * DFF * DM;
        shv = (const float*)(ws + WS_MOD) + (size_t)l * 5 * 6144 + 3 * 1024; sw = (float*)(ws + WS_SW1) + (size_t)l * 5 * DFF; swld = DFF; }
    else { r -= TI_1; W = p.in[I_WFF2] + (size_t)l * DFF * DM; K = DFF; N = DM; WT = (bf16*)(ws + WS_W2) + (size_t)l * DM * DFF; }
    const int nblk = N / 32, k0 = 64 * (r / nblk), n0 = 32 * (r % nblk);
    return TrItem{W + (size_t)k0 * N + n0, WT + (size_t)n0 * K + k0, shv ? shv + k0 : nullptr, sw ? sw + n0 : nullptr, N, K, swld};
}
__device__ __forceinline__ void transpose_range(CKP& p, LAS unsigned char* lds, int first, int last, int bid, int nb) {
    const int tid = opaque_tid(), lane = tid & 63, wave = tid >> 6;
    LAS float* scr = (LAS float*)(lds + wave * 16384);
    int it = first + bid * 8 + wave;
    if (it >= last) return;
    TrItem cur = tr_decode(p, it);
    float tv[32];
#pragma unroll
    for (int i = 0; i < 32; ++i) tv[i] = cur.src[(size_t)(2 * i + (lane >> 5)) * cur.N + (lane & 31)];
#pragma unroll 1
    for (;;) {
        const int c = lane & 7;
        f32x4 sv[5][2];
        if (cur.shv) {
#pragma unroll
            for (int cd = 0; cd < 5; ++cd) { sv[cd][0] = *(const f32x4*)(cur.shv + cd * 6144 + 8 * c); sv[cd][1] = *(const f32x4*)(cur.shv + cd * 6144 + 8 * c + 4); } }
#pragma unroll
        for (int i = 0; i < 32; ++i) scr[(2 * i + (lane >> 5)) * 33 + (lane & 31)] = tv[i];
        const int nit = it + nb * 8; const bool more = nit < last;
        const TrItem nxt = tr_decode(p, more ? nit : it);
        if (more) {
#pragma unroll
            for (int i = 0; i < 32; ++i) tv[i] = nxt.src[(size_t)(2 * i + (lane >> 5)) * nxt.N + (lane & 31)]; }
        asm volatile("s_waitcnt lgkmcnt(0)" ::: "memory");
        if (cur.shv) {
#pragma unroll
            for (int j = 0; j < 4; ++j) { const int n = (lane >> 3) + 8 * j; const LAS float* sp = scr + (8 * c) * 33 + n;
                float v[8];
#pragma unroll
                for (int kk = 0; kk < 8; ++kk) v[kk] = sp[kk * 33];
                u32x4 o; o.x = pk2(v[0], v[1]); o.y = pk2(v[2], v[3]); o.z = pk2(v[4], v[5]); o.w = pk2(v[6], v[7]);
                *(u32x4*)(cur.dst + (size_t)n * cur.K + 8 * c) = o;
#pragma unroll
                for (int cd = 0; cd < 5; ++cd) {
                    float d = ((v[0] * sv[cd][0][0] + v[1] * sv[cd][0][1]) + (v[2] * sv[cd][0][2] + v[3] * sv[cd][0][3])) + ((v[4] * sv[cd][1][0] + v[5] * sv[cd][1][1]) + (v[6] * sv[cd][1][2] + v[7] * sv[cd][1][3]));
                    d += dppf<0xB1>(d); d += dppf<0x4E>(d); d += dppf<0x141>(d);
                    if (c == 0) atomicAdd(cur.sw + cd * cur.swld + n, d); } }
        } else {
#pragma unroll
            for (int j = 0; j < 4; ++j) { const int n = (lane >> 3) + 8 * j; const LAS float* sp = scr + (8 * c) * 33 + n;
                u32x4 o; o.x = pk2(sp[0 * 33], sp[1 * 33]); o.y = pk2(sp[2 * 33], sp[3 * 33]); o.z = pk2(sp[4 * 33], sp[5 * 33]); o.w = pk2(sp[6 * 33], sp[7 * 33]);
                *(u32x4*)(cur.dst + (size_t)n * cur.K + 8 * c) = o; }
        }
        asm volatile("s_waitcnt lgkmcnt(0)" ::: "memory");
        if (!more) break;
        cur = nxt; it = nit;
    }
}
__device__ __forceinline__ void stage_prologue(CKP& p, LAS unsigned char* lds, int bid, int nb) {
    const int tid = opaque_tid();
    unsigned char* ws = p.ws;
    transpose_range(p, lds, 0, TI_IN, bid, nb);
    const int gt = bid * NTHR + tid, NGT = nb * NTHR;
#pragma unroll 1
    for (int i = gt; i < 2 * 128 * DM / 8; i += NGT) { const int l = i / (128 * DM / 8), r = i % (128 * DM / 8);
        u32x4 z = (u32x4){0u, 0u, 0u, 0u}; asm volatile("" : "+v"(z));
        *(u32x4*)((bf16*)(ws + WS_WIN) + (size_t)l * DINP * DM + (size_t)DIN * DM + (size_t)r * 8) = z; }
#pragma unroll 1
    for (int i = gt; i < (5 * DINP + 2 * 5 * DFF) / 4; i += NGT) { f32x4 z = (f32x4){0.f, 0.f, 0.f, 0.f}; asm volatile("" : "+v"(z));
        if (i < 5 * DINP / 4) ((f32x4*)(ws + WS_SWIN))[i] = z; else ((f32x4*)(ws + WS_SW1))[i - 5 * DINP / 4] = z; }
    __syncthreads();
#pragma unroll 1
    for (int it = bid; it < 192; it += nb) mod_item(p, lds, it);
}
__device__ __forceinline__ void stage_tables(CKP& p, int bid, int nb) {
    const int tid = opaque_tid(); unsigned char* ws = p.ws;
    const int gt = bid * NTHR + tid, NGT = nb * NTHR;
#pragma unroll 1
    for (int i = gt; i < 256 * 512 + 1024 * 2048; i += NGT) {
        int L, k, j; bf16* dst;
        if (i < 256 * 512) { L = 256; k = i / 512; j = i % 512; dst = (bf16*)(ws + WS_CS256) + i; }
        else { const int i2 = i - 256 * 512; L = 1024; k = i2 / 2048; j = i2 % 2048; dst = (bf16*)(ws + WS_CS1024) + i2; }
        const int jj = j >= L ? j - L : j; const int idx = (k * jj) & (L - 1);
        const float rev = (float)idx * (L == 256 ? (1.0f / 256.0f) : (1.0f / 1024.0f));
        *dst = (bf16)f2bf(j >= L ? -__builtin_amdgcn_sinf(rev) : __builtin_amdgcn_cosf(rev));
    }
#pragma unroll 1
    for (int i = gt; i < 2 * 4 * 64 * 128; i += NGT) {
        const int o = i & 127, c = (i >> 7) & 63, lg = i >> 13; const float* wf = p.in[I_WFNET] + (size_t)lg * 4096 + (o & 63);
        float acc = 0.f;
#pragma unroll 1
        for (int cp0 = 0; cp0 < 64; cp0 += 16) { float wv[16];
#pragma unroll
            for (int e = 0; e < 16; ++e) wv[e] = wf[(cp0 + e) * 64];
#pragma unroll
            for (int e = 0; e < 16; ++e) { const float rev = (float)((c * (cp0 + e)) & 63) * (1.0f / 64.0f) + (o < 64 ? 0.25f : 0.f);
                acc += __builtin_amdgcn_sinf(rev) * wv[e]; } }
        ((bf16*)(ws + WS_FW))[(size_t)(lg * 128 + o) * 64 + c] = (bf16)f2bf(acc);
    }
#pragma unroll 1
    for (int i = gt; i < 2 * 4 * 64 * 64; i += NGT) { const int o = i & 63, c = (i >> 6) & 63, lg = i >> 12;
        ((bf16*)(ws + WS_WPT))[(size_t)(lg * 64 + o) * 64 + c] = (bf16)f2bf(p.in[I_WPOOL][i]); }
#pragma unroll 1
    for (int i = gt; i < 2 * 2 * 64 * 512; i += NGT) { const int c = i & 511, r = (i >> 9) & 63, ld = i >> 15;
        ((bf16*)(ws + WS_WUPT))[(size_t)(ld * 512 + c) * 64 + r] = (bf16)f2bf(p.in[I_WUP][i]);
        ((bf16*)(ws + WS_AUPT))[(size_t)(ld * 512 + c) * 64 + r] = (bf16)f2bf(p.in[I_AUP][i]); }
#pragma unroll 1
    for (int i = gt; i < 2 * 128 * 512; i += NGT) { const int c = i & 511, r = (i >> 9) & 127, ll = i >> 16;
        ((bf16*)(ws + WS_GUPT))[(size_t)(ll * 512 + c) * 128 + r] = (bf16)f2bf(p.in[I_GUP][i]); }
}
__device__ __forceinline__ void side_queue(CKP& p, LAS unsigned char* lds, int qi, int nsh, int first, int csz, int nch) {
    const int tid = opaque_tid();
    unsigned* ctr = (unsigned*)(p.ws + WS_CTL + 524288) + 64 * qi;
    volatile LAS unsigned* slot = (volatile LAS unsigned*)(lds + RING_BYTES + 64);
    __syncthreads();
#pragma unroll 1
    for (;;) {
        if (tid == 0) *slot = atomicAdd(ctr, 1u);
        __syncthreads();
        const int it = (int)*slot;
        __syncthreads();
        if (it >= nsh + nch) break;
        { const int c0 = first + csz * (it - nsh); transpose_range(p, lds, c0, c0 + csz, 0, 1); }
        __syncthreads();
    }
}

__device__ __forceinline__ void stage_norm(CKP& p, int l, int which, int bid, int nb) {
    const int tid = opaque_tid(), lane = tid & 63, wave = tid >> 6;
    const float* g = p.in[which ? I_N2G : I_N1G] + l * DM;
    const float* mod = (const float*)(p.ws + WS_MOD) + (size_t)l * 5 * 6144 + (which ? 3 * 1024 : 0);
    bf16* H = (bf16*)(p.ws + WS_H);
#pragma unroll 1
    for (int row0 = bid * 8 + wave; row0 < MTOK; row0 += nb * 16) {
        f32x4 v[2][4]; float s[2];
#pragma unroll
        for (int z = 0; z < 2; ++z) { const int row = min(row0 + z * nb * 8, MTOK - 1);
            const float* xsrc = (l == 0 && which == 0) ? (row < NCTX ? p.in[I_XP] + (size_t)row * DM : p.in[I_XS] + (size_t)(row - NCTX) * DM) : p.out + (size_t)row * DM;
            const f32x4* xr = (const f32x4*)xsrc + lane;
#pragma unroll
            for (int j = 0; j < 4; ++j) v[z][j] = xr[64 * j]; }
#pragma unroll
        for (int z = 0; z < 2; ++z) { const int row = row0 + z * nb * 8;
            s[z] = 0.f;
#pragma unroll
            for (int j = 0; j < 4; ++j) s[z] += (v[z][j].x * v[z][j].x + v[z][j].y * v[z][j].y) + (v[z][j].z * v[z][j].z + v[z][j].w * v[z][j].w);
            const float rstd = frsq(wave_sum(s[z]) * (1.0f / DM) + 1e-6f);
            if (row < MTOK) {
                const int cond = row < NCTX ? 0 : 1 + ((row - NCTX) >> 10);
                const float* sh = mod + cond * 6144; const float* scl = sh + 1024;
                unsigned long long* o8 = (unsigned long long*)(H + (size_t)row * DM) + lane;
#pragma unroll
                for (int j = 0; j < 4; ++j) { const int col = 4 * lane + 256 * j; const f32x4 gg = *(const f32x4*)(g + col), a = *(const f32x4*)(sh + col), b = *(const f32x4*)(scl + col);
                    const f32x4 y = v[z][j] * rstd * gg * (b + 1.0f) + a;
                    o8[64 * j] = (unsigned long long)pk2(y.x, y.y) | ((unsigned long long)pk2(y.z, y.w) << 32); } } }
    }
}
__device__ __forceinline__ void stage_final(CKP& p, int bid, int nb) {
    const int tid = opaque_tid(), lane = tid & 63, wave = tid >> 6;
    const float* g = p.in[I_FNG];
    const bf16* XB = (const bf16*)(p.ws + WS_XB); const float* ssq = (const float*)(p.ws + WS_CTL + 262144) + 49152;
    const f32x4 g0 = *(const f32x4*)(g + 8 * lane), g1 = *(const f32x4*)(g + 8 * lane + 4), g2 = *(const f32x4*)(g + 512 + 8 * lane), g3 = *(const f32x4*)(g + 512 + 8 * lane + 4);
#pragma unroll 1
    for (int row = bid * 8 + wave; row < MTOK; row += nb * 8) {
        const float rstd = frsq(ssq[row] * (1.0f / DM) + 1e-6f);
        const u32x4 a = *(const u32x4*)(XB + (size_t)row * DM + 8 * lane), b = *(const u32x4*)(XB + (size_t)row * DM + 512 + 8 * lane);
        float* o = p.out + (size_t)row * DM + 8 * lane;
        *(f32x4*)o = (f32x4){bflo(a.x), bfhi(a.x), bflo(a.y), bfhi(a.y)} * rstd * g0; *(f32x4*)(o + 4) = (f32x4){bflo(a.z), bfhi(a.z), bflo(a.w), bfhi(a.w)} * rstd * g1;
        *(f32x4*)(o + 512) = (f32x4){bflo(b.x), bfhi(b.x), bflo(b.y), bfhi(b.y)} * rstd * g2; *(f32x4*)(o + 516) = (f32x4){bflo(b.z), bfhi(b.z), bflo(b.w), bfhi(b.w)} * rstd * g3;
    }
}


typedef short bf16x8 __attribute__((ext_vector_type(8)));
typedef float f32x2v __attribute__((ext_vector_type(2)));
typedef __bf16 bf16x2v __attribute__((ext_vector_type(2)));
#define MFMA16(a, b, c) __builtin_amdgcn_mfma_f32_16x16x32_bf16((a), (b), (c), 0, 0, 0)
__device__ __forceinline__ unsigned cvt2(float lo, float hi) { f32x2v v = {lo, hi}; bf16x2v b = __builtin_convertvector(v, bf16x2v); return __builtin_bit_cast(unsigned, b); }
__device__ __forceinline__ u32x4 pack8(const float (&x)[8]) { u32x4 w; w.x = cvt2(x[0], x[1]); w.y = cvt2(x[2], x[3]); w.z = cvt2(x[4], x[5]); w.w = cvt2(x[6], x[7]); return w; }
__device__ __forceinline__ void shift8(const bf16* proj, int row, bool hasp, bool hasn, int col, const float* mu, float (&u)[8]) {
    float p[8], a[8], b[8];
    load8bf(proj + (size_t)row * DINP + col, p);
    if (hasp) load8bf(proj + (size_t)(row - 1) * DINP + col, a); else {
#pragma unroll
        for (int j = 0; j < 8; ++j) a[j] = 0.f; }
    if (hasn) load8bf(proj + (size_t)(row + 1) * DINP + col, b); else {
#pragma unroll
        for (int j = 0; j < 8; ++j) b[j] = 0.f; }
    const f32x4 m0 = *(const f32x4*)(mu + col), m1 = *(const f32x4*)(mu + col + 4);
#pragma unroll
    for (int j = 0; j < 4; ++j) { u[j] = p[j] + m0[j] * (0.5f * (a[j] + b[j]) - p[j]); u[4 + j] = p[4 + j] + m1[j] * (0.5f * (a[4 + j] + b[4 + j]) - p[4 + j]); }
}
__device__ __forceinline__ int opq(int x) { asm volatile("" : "+v"(x)); return x; }
constexpr int TS = 72, TB = 64 * TS * 2;
constexpr int L_HT = 0, L_TW = 9216, L_AD = 18432, L_LP = 27648, L_AP = 45056, L_AT = 62464, L_RT = L_AT + TB, L_BH = L_RT + TB, L_KH = L_BH + TB, L_VR = L_KH + TB, L_YS = L_VR + TB;
constexpr int L_AAB = L_TW, L_AAK = L_AAB + 4096, L_ARB = L_AAK + 3072, L_ARK = L_ARB + 3072, L_UT = L_ARK + 3072, L_W1 = L_AP;
static_assert(L_UT + 64 * 24 * 2 <= L_LP && L_YS + 17408 <= RING_BYTES, "scan LDS map");
constexpr int LPS = 68;
#define LBAR() asm volatile("s_waitcnt lgkmcnt(0)\n\ts_barrier" ::: "memory")
typedef short s16x4v __attribute__((ext_vector_type(4)));
__device__ __forceinline__ bf16x8 tr8(const LAS bf16* p) {
    const s16x4v lo = __builtin_bit_cast(s16x4v, __builtin_amdgcn_ds_read_tr16_b64_v4i16((LAS s16x4v*)p));
    const s16x4v hi = __builtin_bit_cast(s16x4v, __builtin_amdgcn_ds_read_tr16_b64_v4i16((LAS s16x4v*)(p + 4 * TS)));
    return (bf16x8){lo[0], lo[1], lo[2], lo[3], hi[0], hi[1], hi[2], hi[3]};
}

__device__ __forceinline__ void rwkv_item3(CKP& p, int l, LAS unsigned char* lds, int item) {
    const int tid0 = opaque_tid(), w = __builtin_amdgcn_readfirstlane(tid0 >> 6);
    int tid = tid0, fr = tid & 15, fg = (tid & 63) >> 4;
    int bseq, h, dir, L, base; bool lat;
    if (item < 64) { lat = true; bseq = item >> 4; h = (item >> 1) & 7; dir = item & 1; L = 1024; base = NCTX + bseq * 1024; }
    else { const int i2 = item - 64; lat = false; bseq = i2 >> 4; h = (i2 >> 1) & 7; dir = i2 & 1; L = 256; base = bseq * 256; }
    const bf16* U = (const bf16*)(p.ws + WS_U);
    const float* KINV = (const float*)(p.ws + WS_KINV);
    bf16* Yout = (bf16*)(p.ws + (dir ? WS_YB : WS_YF));
    float* BC = (float*)(p.ws + WS_BC) + (size_t)dir * MTOK * 8;
    const bf16* wupt = (const bf16*)(p.ws + WS_WUPT) + ((size_t)(l * 2 + dir) * 512 + h * 64) * 64;
    const bf16* aupt = (const bf16*)(p.ws + WS_AUPT) + ((size_t)(l * 2 + dir) * 512 + h * 64) * 64;

    LAS float* LP = (LAS float*)(lds + L_LP); LAS float* AP = (LAS float*)(lds + L_AP); LAS float* AS = (LAS float*)(lds + L_TW);
    LAS bf16* AT = (LAS bf16*)(lds + L_AT);   LAS bf16* RT = (LAS bf16*)(lds + L_RT);   LAS bf16* BH = (LAS bf16*)(lds + L_BH);   LAS bf16* KH = (LAS bf16*)(lds + L_KH);
    LAS bf16* VR = (LAS bf16*)(lds + L_VR);   LAS float* YS = (LAS float*)(lds + L_YS);
    LAS float* AAB = (LAS float*)(lds + L_AAB); LAS bf16* AAK = (LAS bf16*)(lds + L_AAK); LAS bf16* ARB = (LAS bf16*)(lds + L_ARB); LAS bf16* ARK = (LAS bf16*)(lds + L_ARK); LAS bf16* AAK1 = (LAS bf16*)(lds + L_UT);
    LAS float* W1 = (LAS float*)(lds + L_W1);
    const int tv = w & 3;
    f32x4 hacc[4];
#pragma unroll
    for (int x = 0; x < 4; ++x) {
        if (lat && w < 4) hacc[x] = *(const f32x4*)(p.in[I_STATE] + ((((size_t)bseq * 2 + l) * 2 + dir) * 8 + h) * 4096 + (16 * tv + fr) * 64 + 16 * x + 4 * fg);
        else hacc[x] = (f32x4){0.f, 0.f, 0.f, 0.f}; }
    int ei = tid >> 3, ec8 = (tid & 7) * 8; const int hc8 = h * 64 + ec8;
    float kkp[8], kap[8], rkp[8];
#pragma unroll
    for (int e = 0; e < 8; ++e) { kkp[e] = p.in[I_KK][l * 512 + hc8 + e]; kap[e] = p.in[I_KA][l * 512 + hc8 + e]; rkp[e] = p.in[I_RK][l * 512 + hc8 + e]; }
#define SCAN_PREFETCH(SC) do { const int _t0 = opq(tid0), _ei = _t0 >> 3, _ec8 = (_t0 & 7) * 8; const int _step = (SC) * 64 + _ei, _t = dir ? L - 1 - _step : _step; \
        const bf16* _u = U + (size_t)(base + _t) * 1920; \
        nr = *(const u32x4*)(_u + R_OFF + h * 64 + _ec8); nk = *(const u32x4*)(_u + K_OFF + h * 64 + _ec8); nv = *(const u32x4*)(_u + V_OFF + h * 64 + _ec8); \
        ninv = KINV[(size_t)(base + _t) * 8 + h]; \
        const int _st2 = (SC) * 64 + 16 * (w >> 1) + (_t0 & 15), _t2 = dir ? L - 1 - _st2 : _st2; const bf16* _u2 = U + (size_t)(base + _t2) * 1920 + dir * 64 + ((_t0 & 63) >> 4) * 8; \
        paw0 = *(const bf16x8*)(_u2 + WD_OFF); paw1 = *(const bf16x8*)(_u2 + WD_OFF + 32); paa0 = *(const bf16x8*)(_u2 + AD_OFF); paa1 = *(const bf16x8*)(_u2 + AD_OFF + 32); } while (0)
    bf16x8 lbw[2][2], lba[2][2]; float lw0c[2], la0c[2];
#pragma unroll
    for (int x = 0; x < 2; ++x) { const int c = ((w & 1) * 2 + x) * 16 + fr;
        lbw[x][0] = *(const bf16x8*)(wupt + c * 64 + fg * 8); lbw[x][1] = *(const bf16x8*)(wupt + c * 64 + 32 + fg * 8);
        lba[x][0] = *(const bf16x8*)(aupt + c * 64 + fg * 8); lba[x][1] = *(const bf16x8*)(aupt + c * 64 + 32 + fg * 8);
        lw0c[x] = p.in[I_W0][(l * 2 + dir) * 512 + h * 64 + c]; la0c[x] = p.in[I_A0][(l * 2 + dir) * 512 + h * 64 + c]; }
    u32x4 nr, nk, nv; float ninv; bf16x8 paw0, paw1, paa0, paa1;
    SCAN_PREFETCH(0);
    __syncthreads();
#pragma unroll 1
    for (int sc = 0; sc < L / 64; ++sc) {
        tid = opq(tid0); fr = tid & 15; fg = (tid & 63) >> 4; ei = tid >> 3; ec8 = (tid & 7) * 8;
        const u32x4 cr = nr, ck = nk, cv = nv; const float kinv = ninv;
        { const int ti = w >> 1;
          const bf16x8 aw0 = paw0, aw1 = paw1, aa0 = paa0, aa1 = paa1;
          unsigned li[2];
#pragma unroll
          for (int pr = 0; pr < 2; ++pr) { const int j0 = 4 * fg + 2 * pr, j1 = j0 + 1; li[pr] = (j0 <= fr ? 0x3f80u : 0u) | (j1 <= fr ? 0x3f800000u : 0u); }
          const bf16x8 Li = __builtin_bit_cast(bf16x8, (u32x4){li[0], li[1], 0u, 0u});
#pragma unroll
          for (int x = 0; x < 2; ++x) { const int c = ((w & 1) * 2 + x) * 16 + fr;
              f32x4 cw = (f32x4){lw0c[x], lw0c[x], lw0c[x], lw0c[x]}, ca = (f32x4){la0c[x], la0c[x], la0c[x], la0c[x]};
              cw = MFMA16(aw0, lbw[x][0], cw); cw = MFMA16(aw1, lbw[x][1], cw); ca = MFMA16(aa0, lba[x][0], ca); ca = MFMA16(aa1, lba[x][1], ca);
              float lw[4], lo[4];
#pragma unroll
              for (int r = 0; r < 4; ++r) lw[r] = -0.6065306597126334f * fsigmoid(cw[r]);
              const unsigned h01 = cvt2(lw[0], lw[1]), h23 = cvt2(lw[2], lw[3]);
              lo[0] = lw[0] - bflo(h01); lo[1] = lw[1] - bfhi(h01); lo[2] = lw[2] - bflo(h23); lo[3] = lw[3] - bfhi(h23);
              const bf16x8 bh = __builtin_bit_cast(bf16x8, (u32x4){h01, h23, 0u, 0u}), bl = __builtin_bit_cast(bf16x8, (u32x4){cvt2(lo[0], lo[1]), cvt2(lo[2], lo[3]), 0u, 0u});
              f32x4 ci = (f32x4){0.f, 0.f, 0.f, 0.f};
              ci = MFMA16(Li, bh, ci); ci = MFMA16(Li, bl, ci);
#pragma unroll
              for (int r = 0; r < 4; ++r) { const int o = (ti * 16 + 4 * fg + r) * LPS + c;
                  LP[o] = fexp(ci[r]); AS[o] = fsigmoid(ca[r]); } } }
        __syncthreads();
        tid = opq(tid0); fr = tid & 15; fg = (tid & 63) >> 4; ei = tid >> 3; ec8 = (tid & 7) * 8;
        float bcv;
        { const f32x4 g0 = *(const LAS f32x4*)(LP + ei * LPS + ec8), g1 = *(const LAS f32x4*)(LP + ei * LPS + ec8 + 4);
          const int ip = (ei & 15) ? ei - 1 : ei;
          f32x4 p0 = *(const LAS f32x4*)(LP + ip * LPS + ec8), p1 = *(const LAS f32x4*)(LP + ip * LPS + ec8 + 4);
          if ((ei & 15) == 0) { p0 = (f32x4){1.f, 1.f, 1.f, 1.f}; p1 = p0; }
          const f32x4 s0 = *(const LAS f32x4*)(AS + ei * LPS + ec8), s1 = *(const LAS f32x4*)(AS + ei * LPS + ec8 + 4);
          float rr[8], kk[8], xa[8], xr[8], xb[8], xk[8], bc = 0.f;
          rr[0] = bflo(cr.x); rr[1] = bfhi(cr.x); rr[2] = bflo(cr.y); rr[3] = bfhi(cr.y); rr[4] = bflo(cr.z); rr[5] = bfhi(cr.z); rr[6] = bflo(cr.w); rr[7] = bfhi(cr.w);
          kk[0] = bflo(ck.x); kk[1] = bfhi(ck.x); kk[2] = bflo(ck.y); kk[3] = bfhi(ck.y); kk[4] = bflo(ck.z); kk[5] = bfhi(ck.z); kk[6] = bflo(ck.w); kk[7] = bfhi(ck.w);
#pragma unroll
          for (int e = 0; e < 8; ++e) { const float gi = e < 4 ? g0[e & 3] : g1[e & 3], gp = e < 4 ? p0[e & 3] : p1[e & 3], asg = e < 4 ? s0[e & 3] : s1[e & 3];
              const float kj = kk[e] * kkp[e] * kinv, kd = kk[e] * (1.0f + (asg - 1.0f) * kap[e]), ginv = frcp(gi);
              bc += rr[e] * kd * rkp[e];
              xa[e] = -kj * gp; xr[e] = rr[e] * gi; xb[e] = kj * asg * ginv; xk[e] = kd * ginv; }
          bcv = red8(bc);
          *(LAS u32x4*)(AT + ei * TS + ec8) = pack8(xa); *(LAS u32x4*)(RT + ei * TS + ec8) = pack8(xr); *(LAS u32x4*)(BH + ei * TS + ec8) = pack8(xb); *(LAS u32x4*)(KH + ei * TS + ec8) = pack8(xk);
          *(LAS u32x4*)(VR + ei * TS + ec8) = cv; }
        __syncthreads();
        tid = opq(tid0); fr = tid & 15; fg = (tid & 63) >> 4;
        { const int q = w >> 1, half = w & 1; const LAS bf16* Asrc = half ? RT : AT;
          const bf16x8 af0 = *(const LAS bf16x8*)(Asrc + (16 * q + fr) * TS + fg * 8), af1 = *(const LAS bf16x8*)(Asrc + (16 * q + fr) * TS + 32 + fg * 8);
          const bf16x8 bb0 = *(const LAS bf16x8*)(BH + (16 * q + fr) * TS + fg * 8), bb1 = *(const LAS bf16x8*)(BH + (16 * q + fr) * TS + 32 + fg * 8);
          const bf16x8 bk0 = *(const LAS bf16x8*)(KH + (16 * q + fr) * TS + fg * 8), bk1 = *(const LAS bf16x8*)(KH + (16 * q + fr) * TS + 32 + fg * 8);
          LAS bf16* myak = half ? AAK1 : AAK;
          f32x4 cx = (f32x4){0.f, 0.f, 0.f, 0.f}, ck2 = cx, cak = cx;
          cx = MFMA16(af0, bb0, cx); cx = MFMA16(af1, bb1, cx);
          ck2 = MFMA16(af0, bk0, ck2); ck2 = MFMA16(af1, bk1, ck2);
          if (half) { const bf16x8 at0 = *(const LAS bf16x8*)(AT + (16 * q + fr) * TS + fg * 8), at1 = *(const LAS bf16x8*)(AT + (16 * q + fr) * TS + 32 + fg * 8);
              cak = MFMA16(at0, bk0, cak); cak = MFMA16(at1, bk1, cak); }
          else cak = ck2;
          f32x4 mx, mk, mak;
#pragma unroll
          for (int r = 0; r < 4; ++r) { const int i = 4 * fg + r, j = fr; const bool lo = half ? j <= i : j < i; mx[r] = lo ? cx[r] : 0.f; mk[r] = lo ? ck2[r] : 0.f; mak[r] = j < i ? cak[r] : 0.f; }
          if (half == 0) *(LAS f32x4*)(AAB + (q * 16 + fr) * 16 + 4 * fg) = mx;
#pragma unroll
          for (int r = 0; r < 4; ++r) { const int o = (q * 16 + 4 * fg + r) * 24 + fr;
              if (half) { ARB[o] = (bf16)(cvt2(mx[r], 0.f) & 0xffffu); ARK[o] = (bf16)(cvt2(mk[r], 0.f) & 0xffffu); }
              myak[o] = (bf16)(cvt2(mak[r], 0.f) & 0xffffu); }
          {
              const unsigned kmask = fg < 2 ? 0xffffffffu : 0u;
              const bf16x8 afr = *(const LAS bf16x8*)(myak + (q * 16 + fr) * 24 + (fg & 1) * 8);
              const bf16x8 af = __builtin_bit_cast(bf16x8, __builtin_bit_cast(u32x4, afr) & kmask);
#pragma unroll
              for (int x = 0; x < 2; ++x) { const int tvv = 2 * half + x;
                  const bf16x8 bfr = tr8(VR + (16 * q + 8 * (fg & 1) + (fr >> 2)) * TS + 16 * tvv + 4 * (fr & 3));
                  const bf16x8 bfv = __builtin_bit_cast(bf16x8, __builtin_bit_cast(u32x4, bfr) & kmask);
                  f32x4 c = (f32x4){0.f, 0.f, 0.f, 0.f}; c = MFMA16(af, bfv, c);
#pragma unroll
                  for (int r = 0; r < 4; ++r) W1[(q * 16 + 4 * fg + r) * LPS + 16 * tvv + fr] = c[r]; } } }
        __syncthreads();
        tid = opq(tid0);
        { const int q = tid >> 7, col = tid & 127; float x[16];
          if (col < 64) {
#pragma unroll
              for (int i = 0; i < 16; ++i) x[i] = bf1(AT[(16 * q + i) * TS + col]); }
          else {
#pragma unroll
              for (int i = 0; i < 16; ++i) x[i] = W1[(q * 16 + i) * LPS + col - 64]; }
#pragma unroll
          for (int j = 0; j < 15; ++j) {
              const LAS f32x4* ac = (const LAS f32x4*)(AAB + (q * 16 + j) * 16);
#pragma unroll
              for (int i4 = (j + 1) / 4; i4 < 4; ++i4) { const f32x4 a4 = ac[i4];
#pragma unroll
                  for (int e = 0; e < 4; ++e) if (i4 * 4 + e > j) x[i4 * 4 + e] += a4[e] * x[j]; } }
          if (col < 64) {
#pragma unroll
              for (int i = 0; i < 16; ++i) AT[(16 * q + i) * TS + col] = (bf16)(cvt2(x[i], 0.f) & 0xffffu); }
          else {
#pragma unroll
              for (int i = 0; i < 16; ++i) W1[(q * 16 + i) * LPS + col - 64] = x[i]; } }
        __syncthreads();
        if (sc + 1 < L / 64) SCAN_PREFETCH(sc + 1);
        if (w < 4) {
        tid = opq(tid0); fr = tid & 15; fg = (tid & 63) >> 4;
#pragma unroll
        for (int q = 0; q < 4; ++q) {
            bf16x8 hb[2];
#pragma unroll
            for (int ks = 0; ks < 2; ++ks) { u32x4 t; t.x = cvt2(hacc[2 * ks][0], hacc[2 * ks][1]); t.y = cvt2(hacc[2 * ks][2], hacc[2 * ks][3]);
                t.z = cvt2(hacc[2 * ks + 1][0], hacc[2 * ks + 1][1]); t.w = cvt2(hacc[2 * ks + 1][2], hacc[2 * ks + 1][3]); hb[ks] = __builtin_bit_cast(bf16x8, t); }
            bf16x8 aU[2], aR[2];
#pragma unroll
            for (int ks = 0; ks < 2; ++ks) {
                const u32x2 a0 = *(const LAS u32x2*)(AT + (16 * q + fr) * TS + 32 * ks + 4 * fg), a1 = *(const LAS u32x2*)(AT + (16 * q + fr) * TS + 32 * ks + 16 + 4 * fg);
                const u32x2 r0 = *(const LAS u32x2*)(RT + (16 * q + fr) * TS + 32 * ks + 4 * fg), r1 = *(const LAS u32x2*)(RT + (16 * q + fr) * TS + 32 * ks + 16 + 4 * fg);
                aU[ks] = __builtin_bit_cast(bf16x8, (u32x4){a0.x, a0.y, a1.x, a1.y}); aR[ks] = __builtin_bit_cast(bf16x8, (u32x4){r0.x, r0.y, r1.x, r1.y}); }
            f32x4 u, yacc = (f32x4){0.f, 0.f, 0.f, 0.f};
#pragma unroll
            for (int r = 0; r < 4; ++r) u[r] = W1[(q * 16 + 4 * fg + r) * LPS + 16 * tv + fr];
            u = MFMA16(aU[0], hb[0], u); u = MFMA16(aU[1], hb[1], u);
            yacc = MFMA16(aR[0], hb[0], yacc); yacc = MFMA16(aR[1], hb[1], yacc);
            const s16x4v vtr = __builtin_bit_cast(s16x4v, __builtin_amdgcn_ds_read_tr16_b64_v4i16((LAS s16x4v*)(VR + (16 * q + 4 * fg + (fr >> 2)) * TS + 16 * tv + 4 * (fr & 3))));
            const u32x2 vt2 = __builtin_bit_cast(u32x2, vtr);
            const bf16x8 bUV = __builtin_bit_cast(bf16x8, (u32x4){cvt2(u[0], u[1]), cvt2(u[2], u[3]), vt2.x, vt2.y});
            { const u32x2 y0 = *(const LAS u32x2*)(ARB + (q * 16 + fr) * 24 + 4 * fg), y1 = *(const LAS u32x2*)(ARK + (q * 16 + fr) * 24 + 4 * fg);
              yacc = MFMA16(__builtin_bit_cast(bf16x8, (u32x4){y0.x, y0.y, y1.x, y1.y}), bUV, yacc); }
#pragma unroll
            for (int r = 0; r < 4; ++r) YS[(16 * q + 4 * fg + r) * LPS + 16 * tv + fr] = yacc[r];
#pragma unroll
            for (int x = 0; x < 4; ++x) {
                const s16x4v bt = __builtin_bit_cast(s16x4v, __builtin_amdgcn_ds_read_tr16_b64_v4i16((LAS s16x4v*)(BH + (16 * q + 4 * fg + (fr >> 2)) * TS + 16 * x + 4 * (fr & 3))));
                const s16x4v kt = __builtin_bit_cast(s16x4v, __builtin_amdgcn_ds_read_tr16_b64_v4i16((LAS s16x4v*)(KH + (16 * q + 4 * fg + (fr >> 2)) * TS + 16 * x + 4 * (fr & 3))));
                const u32x2 b2 = __builtin_bit_cast(u32x2, bt), k2 = __builtin_bit_cast(u32x2, kt);
                const f32x4 ge = *(const LAS f32x4*)(LP + (16 * q + 15) * LPS + 16 * x + 4 * fg);
                hacc[x] = MFMA16(__builtin_bit_cast(bf16x8, (u32x4){b2.x, b2.y, k2.x, k2.y}), bUV, hacc[x]) * ge; }
        }
        }
        __syncthreads();
        tid = opq(tid0); ei = tid >> 3; ec8 = (tid & 7) * 8;
        { const int st2 = sc * 64 + ei, t2 = dir ? L - 1 - st2 : st2; bf16* yo = Yout + (size_t)(base + t2) * 512 + h * 64 + ec8;
          const f32x4 y0 = *(const LAS f32x4*)(YS + ei * LPS + ec8), y1 = *(const LAS f32x4*)(YS + ei * LPS + ec8 + 4);
          u32x4 yw; yw.x = cvt2(y0[0], y0[1]); yw.y = cvt2(y0[2], y0[3]); yw.z = cvt2(y1[0], y1[1]); yw.w = cvt2(y1[2], y1[3]);
          *(u32x4*)yo = yw;
          if ((tid & 7) == 0) BC[(size_t)(base + t2) * 8 + h] = bcv; }
    }
#undef SCAN_PREFETCH
    if (!lat && w < 4) {
#pragma unroll
        for (int x = 0; x < 4; ++x) *(f32x4*)(p.out + (size_t)MTOK * DM + ((((size_t)bseq * 2 + l) * 2 + dir) * 8 + h) * 4096 + (16 * tv + fr) * 64 + 16 * x + 4 * fg) = hacc[x]; }
    __syncthreads();
}

__device__ __forceinline__ void stage_upass(CKP& p, int l, int bid, int nb) {
    const int tid = opaque_tid(), sub = tid >= 240 ? 1 : 0, j = tid - sub * 240, col = 8 * j;
    const bf16* proj = (const bf16*)(p.ws + WS_PROJ); bf16* U = (bf16*)(p.ws + WS_U); float* KINV = (float*)(p.ws + WS_KINV);
    const float* mu = p.in[I_MU] + l * 1920;
    if (tid < 480) {
        const bool isk = col >= K_OFF && col < V_OFF;
        const float* kkp = p.in[I_KK] + l * 512 + (isk ? col - K_OFF : 0);
        const f32x4 k0 = *(const f32x4*)kkp, k1 = *(const f32x4*)(kkp + 4);
#pragma unroll 1
        for (int tok0 = bid * 2 + sub; tok0 < MTOK; tok0 += nb * 8) {
            float uu[4][8];
#pragma unroll
            for (int z = 0; z < 4; ++z) { const int tok = min(tok0 + z * nb * 2, MTOK - 1);
                const bool lat = tok >= NCTX; const int L = lat ? 1024 : 256, t = lat ? (tok - NCTX) & 1023 : tok & 255;
                shift8(proj, tok, t > 0, t < L - 1, col, mu, uu[z]); }
#pragma unroll
            for (int z = 0; z < 4; ++z) { const int tok = tok0 + z * nb * 2;
                float ss = 0.f;
#pragma unroll
                for (int e = 0; e < 8; ++e) { const float kn = uu[z][e] * (e < 4 ? k0[e & 3] : k1[e & 3]); ss += kn * kn; }
                ss = red8(ss);
                if (tok < MTOK) {
                    if (isk && (j & 7) == 0) KINV[(size_t)tok * 8 + ((col - K_OFF) >> 6)] = fminf(frsq(ss), 1e12f);
                    if (col >= WD_OFF && col < AD_OFF) {
#pragma unroll
                        for (int e = 0; e < 8; ++e) uu[z][e] = 1.0f - 2.0f * frcp(fexp(2.0f * uu[z][e]) + 1.0f); }
                    if (col >= GD_OFF) {
#pragma unroll
                        for (int e = 0; e < 8; ++e) uu[z][e] = fsigmoid(uu[z][e]); }
                    *(u32x4*)(U + (size_t)tok * 1920 + col) = pack8(uu[z]); } }
        }
    }
}

__device__ __forceinline__ void fnet1_item(CKP& p, int l, int item) {
    const int tid = opaque_tid(), lane = tid & 63, w = __builtin_amdgcn_readfirstlane(tid >> 6), fr = lane & 15, fg = lane >> 4;
    const int tb = item >> 2, g = item & 3, tok0 = tb * 64, tt = w & 3, cs = w >> 2;
    const bf16* proj = (const bf16*)(p.ws + WS_PROJ);
    const bf16* fwt = (const bf16*)(p.ws + WS_FW) + (size_t)((l * 4 + g) * 128 + cs * 64) * 64;
    const bf16* xr = proj + (size_t)(tok0 + 16 * tt + fr) * DINP + F_OFF + g * 64 + fg * 8;
    const bf16x8 a0 = *(const bf16x8*)xr, a1 = *(const bf16x8*)(xr + 32);
    const bool lat = tok0 >= NCTX;
    const int L = lat ? 1024 : 256, bq = lat ? (tok0 - NCTX) >> 10 : tok0 >> 8, t = (lat ? (tok0 - NCTX) & 1023 : tok0 & 255) + 16 * tt + 4 * fg;
    const float scale = lat ? (1.0f / 256.0f) : (1.0f / 128.0f);
    bf16* Y = (bf16*)(p.ws + WS_YCS) + (lat ? (size_t)8192 * 512 : 0);
#pragma unroll
    for (int ot = 0; ot < 4; ++ot) {
        const bf16x8 b0 = *(const bf16x8*)(fwt + (16 * ot + fr) * 64 + fg * 8), b1 = *(const bf16x8*)(fwt + (16 * ot + fr) * 64 + 32 + fg * 8);
        f32x4 c = (f32x4){0.f, 0.f, 0.f, 0.f}; c = MFMA16(a0, b0, c); c = MFMA16(a1, b1, c);
        u32x2 o; o.x = cvt2(c[0] * scale, c[1] * scale); o.y = cvt2(c[2] * scale, c[3] * scale);
        *(u32x2*)(Y + (size_t)((bq * 4 + g) * 64 + 16 * ot + fr) * (2 * L) + cs * L + t) = o; }
}

__device__ __forceinline__ void pool_item(CKP& p, int l, LAS unsigned char* lds, int item) {
    const int tid = opaque_tid(), tb = item >> 2, gi = item & 3, tok0 = tb * 64, hw = 1 << gi;
    const bf16* proj = (const bf16*)(p.ws + WS_PROJ);
    LAS bf16* DB = (LAS bf16*)lds;
    LAS float* CSUM = (LAS float*)(lds + 9216);
    const int ti = tid >> 3, c8 = (tid & 7) * 8, tok = tok0 + ti, col = P_OFF + gi * 64 + c8;
    { float sum[8], x[8];
#pragma unroll
      for (int j = 0; j < 8; ++j) sum[j] = 0.f;
      load8bf(proj + (size_t)tok * DINP + col, x);
      float cnt;
      if (tok < NCTX) { const int t = tok & 255, sb = tok - t, lo = max(t - hw, 0), hi = min(t + hw, 256);
          u32x4 wv[16];
#pragma unroll
          for (int q = 0; q < 16; ++q) { const int tq = min(t - hw + q, 255); wv[q] = (q < 2 * hw && tq >= 0) ? *(const u32x4*)(proj + (size_t)(sb + max(tq, 0)) * DINP + col) : (u32x4){0u, 0u, 0u, 0u}; }
#pragma unroll
          for (int q = 0; q < 16; ++q) if (q < 2 * hw) { const bool ok = t - hw + q >= 0 && t - hw + q < 256; const u32x4 w = wv[q];
              if (ok) { sum[0] += bflo(w.x); sum[1] += bfhi(w.x); sum[2] += bflo(w.y); sum[3] += bfhi(w.y); sum[4] += bflo(w.z); sum[5] += bfhi(w.z); sum[6] += bflo(w.w); sum[7] += bfhi(w.w); } }
          cnt = (float)(hi - lo); }
      else {
          const int t = (tok - NCTX) & 1023, sb = tok - t, r = t >> 6, c = t & 63, rlo = max(r - hw, 0), rhi = min(r + hw, 16), clo = max(c - hw, 0), chi = min(c + hw, 64);
          u32x4 wv[16];
#pragma unroll
          for (int q = 0; q < 16; ++q) { const int rq = r - hw + q; wv[q] = (q < 2 * hw && rq >= 0 && rq < 16) ? *(const u32x4*)(proj + (size_t)(sb + rq * 64 + c) * DINP + col) : (u32x4){0u, 0u, 0u, 0u}; }
#pragma unroll
          for (int q = 0; q < 16; ++q) { const u32x4 w = wv[q];
              sum[0] += bflo(w.x); sum[1] += bfhi(w.x); sum[2] += bflo(w.y); sum[3] += bfhi(w.y); sum[4] += bflo(w.z); sum[5] += bfhi(w.z); sum[6] += bflo(w.w); sum[7] += bfhi(w.w); }
          *(LAS f32x4*)(CSUM + ti * 68 + c8) = (f32x4){sum[0], sum[1], sum[2], sum[3]}; *(LAS f32x4*)(CSUM + ti * 68 + c8 + 4) = (f32x4){sum[4], sum[5], sum[6], sum[7]};
          __syncthreads();
#pragma unroll
          for (int j = 0; j < 8; ++j) sum[j] = 0.f;
          for (int cq = clo; cq < chi; ++cq) { const f32x4 a = *(const LAS f32x4*)(CSUM + cq * 68 + c8), b = *(const LAS f32x4*)(CSUM + cq * 68 + c8 + 4);
#pragma unroll
              for (int j = 0; j < 4; ++j) { sum[j] += a[j]; sum[4 + j] += b[j]; } }
          cnt = (float)((rhi - rlo) * (chi - clo)); }
      const float ic = frcp(cnt);
      float dd[8];
#pragma unroll
      for (int j = 0; j < 8; ++j) dd[j] = sum[j] * ic - x[j];
      *(LAS u32x4*)(DB + ti * 72 + c8) = pack8(dd); }
    __syncthreads();
    { const int lane = tid & 63, w = __builtin_amdgcn_readfirstlane(tid >> 6), fr = lane & 15, fg = lane >> 4, tt = w & 3;
      const bf16* wpt = (const bf16*)(p.ws + WS_WPT) + (size_t)(l * 4 + gi) * 4096;
      const bf16x8 b0 = *(const LAS bf16x8*)(DB + (16 * tt + fr) * 72 + fg * 8), b1 = *(const LAS bf16x8*)(DB + (16 * tt + fr) * 72 + 32 + fg * 8);
#pragma unroll
      for (int x = 0; x < 2; ++x) { const int ot = 2 * (w >> 2) + x;
          const bf16x8 a0 = *(const bf16x8*)(wpt + (16 * ot + fr) * 64 + fg * 8), a1 = *(const bf16x8*)(wpt + (16 * ot + fr) * 64 + 32 + fg * 8);
          f32x4 c = (f32x4){0.f, 0.f, 0.f, 0.f}; c = MFMA16(a0, b0, c); c = MFMA16(a1, b1, c);
          const f32x4 ps = *(const f32x4*)(p.in[I_PSCALE] + l * 256 + gi * 64 + 16 * ot + 4 * fg);
          c *= ps;
          u32x2 o; o.x = cvt2(c[0], c[1]); o.y = cvt2(c[2], c[3]);
          *(u32x2*)((bf16*)(p.ws + WS_MIXED) + (size_t)(tok0 + 16 * tt + fr) * DM + 768 + gi * 64 + 16 * ot + 4 * fg) = o; } }
    __syncthreads();
}

__device__ __forceinline__ float xsum_fg(float s, int fr, int fg) {
    s += __builtin_bit_cast(float, __builtin_amdgcn_ds_bpermute((((fg ^ 1) << 4) | fr) << 2, __builtin_bit_cast(int, s)));
    s += __builtin_bit_cast(float, __builtin_amdgcn_ds_bpermute((((fg ^ 2) << 4) | fr) << 2, __builtin_bit_cast(int, s)));
    return s;
}
__device__ __forceinline__ void stage_post(CKP& p, int l, int bid, int nb) {
    const int tid = opaque_tid(), lane = tid & 63, head = __builtin_amdgcn_readfirstlane(tid >> 6), fr = lane & 15, fg = lane >> 4;
    const bf16* Ub = (const bf16*)(p.ws + WS_U);
    const bf16* gupt = (const bf16*)(p.ws + WS_GUPT) + ((size_t)l * 512 + head * 64) * 128;
    const bf16* YF = (const bf16*)(p.ws + WS_YF); const bf16* YB = (const bf16*)(p.ws + WS_YB);
    const float* BC0 = (const float*)(p.ws + WS_BC); const float* BC1 = BC0 + (size_t)MTOK * 8;
    bf16* MIX = (bf16*)(p.ws + WS_MIXED);
    bf16x8 ag[4][4];
    f32x4 lnw[4], lnb[4];
#pragma unroll
    for (int t = 0; t < 4; ++t) {
#pragma unroll
        for (int ks = 0; ks < 4; ++ks) ag[t][ks] = *(const bf16x8*)(gupt + (16 * t + fr) * 128 + ks * 32 + fg * 8);
        lnw[t] = *(const f32x4*)(p.in[I_LNW] + l * 512 + head * 64 + 16 * t + 4 * fg); lnb[t] = *(const f32x4*)(p.in[I_LNB] + l * 512 + head * 64 + 16 * t + 4 * fg); }
#pragma unroll 1
    for (int item = bid; item < 768; item += nb) {
        const size_t tok = (size_t)item * 16 + fr;
        bf16x8 bs[4];
#pragma unroll
        for (int ks = 0; ks < 4; ++ks) bs[ks] = *(const bf16x8*)(Ub + tok * 1920 + GD_OFF + ks * 32 + fg * 8);
        f32x4 y[4]; u32x2 vw[4];
#pragma unroll
        for (int t = 0; t < 4; ++t) { const int c = head * 64 + 16 * t + 4 * fg;
            const u32x2 yf = *(const u32x2*)(YF + tok * 512 + c), yb = *(const u32x2*)(YB + tok * 512 + c);
            y[t] = (f32x4){bflo(yf.x) + bflo(yb.x), bfhi(yf.x) + bfhi(yb.x), bflo(yf.y) + bflo(yb.y), bfhi(yf.y) + bfhi(yb.y)}; vw[t] = *(const u32x2*)(Ub + tok * 1920 + V_OFF + c); }
        const float bc = BC0[tok * 8 + head] + BC1[tok * 8 + head];
        f32x4 g[4];
#pragma unroll
        for (int t = 0; t < 4; ++t) { g[t] = (f32x4){0.f, 0.f, 0.f, 0.f};
#pragma unroll
            for (int ks = 0; ks < 4; ++ks) g[t] = MFMA16(ag[t][ks], bs[ks], g[t]); }
        float s = 0.f;
#pragma unroll
        for (int t = 0; t < 4; ++t) s += (y[t][0] + y[t][1]) + (y[t][2] + y[t][3]);
        const float mean = xsum_fg(s, fr, fg) * (1.0f / 64.0f);
        float q = 0.f;
#pragma unroll
        for (int t = 0; t < 4; ++t) { y[t] = y[t] - mean; q += (y[t][0] * y[t][0] + y[t][1] * y[t][1]) + (y[t][2] * y[t][2] + y[t][3] * y[t][3]); }
        const float rstd = frsq(xsum_fg(q, fr, fg) * (1.0f / 64.0f) + 64e-5f);
#pragma unroll
        for (int t = 0; t < 4; ++t) { const f32x4 vv = (f32x4){bflo(vw[t].x), bfhi(vw[t].x), bflo(vw[t].y), bfhi(vw[t].y)};
            const f32x4 o = (y[t] * rstd * lnw[t] + lnb[t] + vv * bc) * g[t];
            u32x2 w; w.x = cvt2(o[0], o[1]); w.y = cvt2(o[2], o[3]);
            *(u32x2*)(MIX + tok * DM + head * 64 + 16 * t + 4 * fg) = w; }
    }
}

#define XB_TMO      128
#define XB_XCNT(j)  (256  + 64 * (j))
#define XB_XSUB(j)  (1280 + 64 * (j))
#define XB_XGEN(j)  (2304 + 64 * (j))
#define XB_TOP      3328
#define XB_TOPGEN   3392
#define XCD_BAR_WORDS 3456
#define XB_SPIN_CAP (1u << 18)

__device__ __forceinline__ unsigned xb_ld(unsigned* p)              { return __hip_atomic_load(p, __ATOMIC_RELAXED, __HIP_MEMORY_SCOPE_AGENT); }
__device__ __forceinline__ unsigned xb_add(unsigned* p, unsigned v) { return __hip_atomic_fetch_add(p, v, __ATOMIC_RELAXED, __HIP_MEMORY_SCOPE_AGENT); }
__device__ __forceinline__ unsigned xb_xcc_id() { return (unsigned)__builtin_amdgcn_s_getreg((3 << 11) | 20) & 0xFu; }
#define XB_SPIN(cond, bar) do { unsigned _sp = 0; while (cond) { __builtin_amdgcn_s_sleep(1); \
    if ((++_sp & 255u) == 0u) { if (xb_ld(&(bar)[XB_TMO])) break; if (_sp > XB_SPIN_CAP) { atomicAdd(&(bar)[XB_TMO], 1u); break; } } } } while (0)

struct XcdBarrier {
    unsigned* bar; unsigned x;
    volatile LAS unsigned* st;
};

__device__ __forceinline__ XcdBarrier xcd_barrier_post(unsigned* bar, volatile LAS unsigned* st) {
    XcdBarrier b; b.bar = bar; b.x = xb_xcc_id(); b.st = st;
    if (threadIdx.x == 0) (void)xb_add(&bar[XB_XCNT(b.x)], 1u);
    return b;
}
__device__ __forceinline__ void xcd_barrier_complete(unsigned* bar, unsigned x, unsigned& nloc, unsigned& nx) {
    const unsigned G = gridDim.x * gridDim.y * gridDim.z;
    unsigned sum, cnt, mine, sp = 0u;
    for (;;) {
        sum = 0u; cnt = 0u; mine = 0u;
#pragma unroll
        for (unsigned j = 0; j < 16; ++j) { const unsigned c = xb_ld(&bar[XB_XCNT(j)]); sum += c; cnt += (c > 0u) ? 1u : 0u; mine = (j == x) ? c : mine; }
        if (sum == G) break;
        __builtin_amdgcn_s_sleep(1);
        if ((++sp & 255u) == 0u) { if (xb_ld(&bar[XB_TMO])) break; if (sp > XB_SPIN_CAP) { atomicAdd(&bar[XB_TMO], 1u); break; } }
    }
    nloc = mine > 0u ? mine : 1u; nx = cnt > 0u ? cnt : 1u;
}

__device__ __forceinline__ void xcd_barrier(const XcdBarrier& b) {
    asm volatile("s_waitcnt vmcnt(0)" ::: "memory");
    __syncthreads();
    if (threadIdx.x == 0) {
        unsigned* bar = b.bar;
        __builtin_amdgcn_s_waitcnt(0);
        unsigned nloc = b.st[0], nx = b.st[1];
        if (nloc == 0u) { xcd_barrier_complete(bar, b.x, nloc, nx); b.st[0] = nloc; b.st[1] = nx; }
        const unsigned old = xb_add(&bar[XB_XSUB(b.x)], 1u);
        const unsigned gen = old / nloc;
        if (old + 1u == (gen + 1u) * nloc) {
            __builtin_amdgcn_fence(__ATOMIC_RELEASE, "agent");
            asm volatile("s_waitcnt vmcnt(0)" ::: "memory");
            const unsigned og = xb_add(&bar[XB_TOP], 1u);
            const unsigned tg = og / nx;
            __builtin_amdgcn_fence(__ATOMIC_ACQUIRE, "agent");
            if (og + 1u == (tg + 1u) * nx) xb_add(&bar[XB_TOPGEN], 1u);
            else XB_SPIN(xb_ld(&bar[XB_TOPGEN]) == tg, bar);
            xb_add(&bar[XB_XGEN(b.x)], 1u);
            asm volatile("s_waitcnt vmcnt(0)" ::: "memory");
        } else {
            __builtin_amdgcn_fence(__ATOMIC_ACQUIRE, "agent");
            XB_SPIN(xb_ld(&bar[XB_XGEN(b.x)]) == gen, bar);
            asm volatile("s_waitcnt vmcnt(0)" ::: "memory");
        }
    }
    __syncthreads();
}

struct EpiAny {
    static constexpr bool AFTER_DRAIN = false;
    int mode; bool PERM; int l;
    __device__ __forceinline__ void operator()(const f32x4 (&acc)[2][2][4][2], const pg8::Unit& u, int wr, int wc, int fr, int fq) const {
        CKP* kp = (CKP*)__builtin_amdgcn_kernarg_segment_ptr(); asm volatile("" : "+s"(kp)); CKP& p = *kp;
        unsigned char* ws = p.ws;
        const float* mod = (const float*)(ws + WS_MOD) + (size_t)l * 5 * 6144;
        float* SSQ = (float*)(ws + WS_CTL + 262144);
        bf16* Hb = (bf16*)(ws + WS_H); bf16* XB = (bf16*)(ws + WS_XB);
        if (mode == 7) {
#pragma unroll
            for (int a = 0; a < 2; ++a)
#pragma unroll
                for (int b = 0; b < 2; ++b)
#pragma unroll
                    for (int m = 0; m < 4; ++m)
#pragma unroll
                        for (int n = 0; n < 2; ++n) asm volatile("" :: "v"(acc[a][b][m][n]));
            return; }
        if (mode == 0) { const pg8::EpiBf<0> e{(bf16*)(ws + WS_PROJ), DINP}; e(acc, u, wr, wc, fr, fq); }
        else if (mode == 2) { const pg8::EpiResFinal e{XB, mod + 5 * 1024, p.in[I_FNG], p.out, SSQ + 49152, (unsigned*)(ws + WS_CTL + 524288) + 64 * 16}; e(acc, u, wr, wc, fr, fq); }
        else if (mode == 3) { const pg8::EpiFnet e{(bf16*)(ws + WS_MIXED), 0, 256}; e(acc, u, wr, wc, fr, fq); }
        else if (mode == 8) { const pg8::EpiFnet e{(bf16*)(ws + WS_MIXED), NCTX, 1024}; e(acc, u, wr, wc, fr, fq); }
        else if (mode == 4) { const pg8::EpiNormBf<0> e{(bf16*)(ws + WS_PROJ), DINP, SSQ + 16384, (const float*)(ws + WS_SWIN), DINP}; e(acc, u, wr, wc, fr, fq); }
        else if (mode == 5) { const pg8::EpiNormBf<1> e{(bf16*)(ws + WS_FF), DFF, SSQ + l * 32768, (const float*)(ws + WS_SW1) + (size_t)l * 5 * DFF, DFF}; e(acc, u, wr, wc, fr, fq); }
        else if (mode == 6) {
            if (l == 0) { const pg8::EpiResNorm<true, true> e{XB, mod + 2 * 1024, p.in[I_XP], p.in[I_XS], Hb, p.in[I_N2G], mod + 4 * 1024, SSQ}; e(acc, u, wr, wc, fr, fq); }
            else { const pg8::EpiResNorm<false, true> e{XB, mod + 2 * 1024, nullptr, nullptr, Hb, p.in[I_N2G] + DM, mod + 4 * 1024, SSQ + 32768}; e(acc, u, wr, wc, fr, fq); } }
        else { const pg8::EpiResNorm<false, true> e{XB, mod + 5 * 1024, nullptr, nullptr, Hb, p.in[I_N1G] + DM, mod + 5 * 6144 + 1 * 1024, SSQ + 16384}; e(acc, u, wr, wc, fr, fq); }
    }
};

constexpr int N_STEPS = 16;
__device__ __forceinline__ bool step_seam(int st) { return st < 15; }
__global__ void __launch_bounds__(NTHR, 2) mega_fwd(KP p_unused) {
    extern __shared__ __attribute__((aligned(16))) unsigned char lds_raw[];
    CKP* kp0 = (CKP*)__builtin_amdgcn_kernarg_segment_ptr();
    { LAS unsigned* ctlw = (LAS unsigned*)((LAS unsigned char*)lds_raw + RING_BYTES);
      for (int u = threadIdx.x; u < (LDS_BYTES - RING_BYTES) / 4; u += NTHR) ctlw[u] = 0u; }
    __syncthreads();
    const XcdBarrier bar = xcd_barrier_post((unsigned*)(kp0->ws + WS_CTL) + 4096, (volatile LAS unsigned*)((LAS unsigned char*)lds_raw + MISC_OFF + 32));
    const int ph_lo = kp0->ph_lo, ph_hi = kp0->ph_hi;
#pragma unroll 1
#ifdef REP_A
    for (int sti = ph_lo; sti < ph_hi + ((REP_B) >= 0 ? 2 : 1); ++sti) {
        const int st = sti <= (REP_A) ? sti : (((REP_B) < 0 || sti <= (REP_B) + 1) ? sti - 1 : sti - 2);
        const bool isdup = sti == (REP_A) || ((REP_B) >= 0 && sti == (REP_B) + 1); (void)isdup;
#else
    for (int st = ph_lo; st < ph_hi; ++st) {
#endif
        CKP* kp = kp0; asm volatile("" : "+s"(kp));
        CKP& p = *kp; unsigned char* ws = p.ws;
        int bid = blockIdx.x, nb = gridDim.x; unsigned ldsb = (unsigned)(size_t)(LAS unsigned char*)lds_raw;
        asm volatile("" : "+s"(bid), "+s"(nb), "+s"(ldsb));
        LAS unsigned char* lds = (LAS unsigned char*)(size_t)ldsb;
        const int l = st < 9 ? 0 : 1, s = st == 0 ? -1 : (st == 1 ? 0 : ((st - 2) % 7 + 1));
        const float* mod = (const float*)(ws + WS_MOD) + (size_t)l * 5 * 6144;
#pragma unroll 1
        for (int job = 0; job < 2; ++job) {
            pg8::Gemm g{nullptr, nullptr, 0, 0, 0, 0, 0}; EpiAny E{-1, true, 0}; int corder = bid;
            if (job == 0) {
                if (s == 1) { g = pg8::Gemm{(const bf16*)(ws + WS_H), (const bf16*)(ws + WS_WIN) + (size_t)l * DINP * DM, MTOK, DINP, DM, DM, DM}; E = EpiAny{l == 0 ? 0 : 4, true, l}; }
                else if (s == 3) { g = pg8::Gemm{(const bf16*)(ws + WS_CS256), (const bf16*)(ws + WS_YCS), 256, 8192, 512, 512, 512}; E = EpiAny{3, true, l}; corder = (bid + nb - (nb >= 256 ? 192 : 0)) % nb; }
                else if (s == 5) { g = pg8::Gemm{(const bf16*)(ws + WS_MIXED), (const bf16*)(ws + WS_WOUT) + (size_t)l * DM * DM, MTOK, DM, DM, DM, DM}; E = EpiAny{6, true, l}; }
                else if (s == 6) { g = pg8::Gemm{(const bf16*)(ws + WS_H), (const bf16*)(ws + WS_W1) + (size_t)l * DFF * DM, MTOK, DFF, DM, DM, DM}; E = EpiAny{5, true, l}; }
                else if (s == 7) { g = pg8::Gemm{(const bf16*)(ws + WS_FF), (const bf16*)(ws + WS_W2) + (size_t)l * DM * DFF, MTOK, DM, DFF, DFF, DFF}; E = l == 0 ? EpiAny{9, true, l} : EpiAny{2, true, l}; }
            } else if (s == 3) { g = pg8::Gemm{(const bf16*)(ws + WS_CS1024), (const bf16*)(ws + WS_YCS) + (size_t)8192 * 512, 1024, 1024, 2048, 2048, 2048}; E = EpiAny{8, true, l}; corder = (bid + nb - (nb >= 256 ? 224 : 32)) % nb; }
#ifdef NOEPI_FIRST
            if (isdup && E.mode >= 0) E.mode = 7;
#endif
            if (E.mode >= 0) {
                pg8::StaticOrder S; S.init(g.M, g.N, nb, corder);
                pg8::gemm_phase<EpiAny, pg8::StaticOrder, true, true>(lds, g, S, E);
                __syncthreads();
            }
        }
        if (s == 3) {
            if (nb >= 256) {
                if (bid < 64) rwkv_item3(p, l, lds, bid);
                else { unsigned* ctr = (unsigned*)(ws + WS_CTL + 524288) + 64 * (2 + l); volatile LAS unsigned* slot = (volatile LAS unsigned*)(lds + RING_BYTES + 64);
#pragma unroll 1
                    for (;;) { __syncthreads(); if (threadIdx.x == 0) *slot = atomicAdd(ctr, 1u); __syncthreads(); const int it = (int)*slot; if (it >= 512) break; rwkv_item3(p, l, lds, 64 + it); } }
            } else for (int it = bid; it < 576; it += nb) rwkv_item3(p, l, lds, it);
        }
        if (s == 3 || s == 5) {
            int qi, first, csz, nch;
            if (s == 3) { qi = l; first = l == 0 ? TI_IN : TI_L + TI_IN; csz = 8; nch = (TI_OUT + TI_1) / 8; }
            else { qi = 4 + l; first = l * TI_L + TI_IN + TI_OUT + TI_1; csz = 32; nch = TI_2 / 32; }
            side_queue(p, lds, qi, 0, first, csz, nch);
            if (s == 3 && l == 0) side_queue(p, lds, 6, 0, TI_L, 8, TI_IN / 8);
        }
        if (s == -1) stage_prologue(p, lds, bid, nb);
        else if (s == 0) stage_norm(p, 0, 0, bid, nb);
        if ((s == -1 && nb >= 256 && bid >= 192) || (s == 0 && nb < 256)) stage_tables(p, nb >= 256 ? bid - 192 : bid, nb >= 256 ? nb - 192 : nb);
        else if (s == 2) {
            stage_upass(p, l, bid, nb);
#ifdef DUP_U
            stage_upass(p, l, bid, nb);
#endif
#pragma unroll 1
            for (int it = bid; it < 768; it += nb) fnet1_item(p, l, it);
#ifdef DUP_F
#pragma unroll 1
            for (int it = bid; it < 768; it += nb) fnet1_item(p, l, it);
#endif
#pragma unroll 1
            for (int it = bid; it < 768; it += nb) pool_item(p, l, lds, it);
#ifdef DUP_P
#pragma unroll 1
            for (int it = bid; it < 768; it += nb) pool_item(p, l, lds, it);
#endif
        }
        else if (s == 4) stage_post(p, l, bid, nb);
        #ifdef REP_A
        if (sti + 1 < ph_hi + ((REP_B) >= 0 ? 2 : 1)) xcd_barrier(bar);
#else
        if (st + 1 < ph_hi && step_seam(st)) xcd_barrier(bar);
#endif
    }
}

extern "C" void kernel_launch(void* const* d_in, const int* in_sizes, int n_in, void* d_out, int out_size, void* d_ws, size_t ws_size, hipStream_t stream) {
    static int grid = 0;
    if (grid == 0) {
        if (n_in != N_IN || ws_size < WS_END) { fprintf(stderr, "kernel_launch: unexpected inputs (n_in %d, ws %zu)\n", n_in, ws_size); grid = -1; return; }
        int dev = 0, cus = 0, per_cu = 0;
        (void)hipGetDevice(&dev); (void)hipDeviceGetAttribute(&cus, hipDeviceAttributeMultiprocessorCount, dev);
        (void)hipFuncSetAttribute((const void*)mega_fwd, hipFuncAttributeMaxDynamicSharedMemorySize, LDS_BYTES);
        if (hipOccupancyMaxActiveBlocksPerMultiprocessor(&per_cu, (const void*)mega_fwd, NTHR, LDS_BYTES) != hipSuccess || per_cu < 1) {
            fprintf(stderr, "kernel_launch: occupancy query reports %d blocks/CU\n", per_cu); (void)hipGetLastError(); grid = -1; return; }
        grid = cus * 1;
    }
    if (grid < 0) return;
    KP a{};
    for (int i = 0; i < N_IN; ++i) a.in[i] = (const float*)d_in[i];
    a.out = (float*)d_out; a.ws = (unsigned char*)d_ws; a.ph_lo = 0; a.ph_hi = N_STEPS;
    if (hipMemsetAsync((char*)d_ws + WS_CTL, 0, 1 * MiB, stream) != hipSuccess) { fprintf(stderr, "kernel_launch: memset failed\n"); return; }
    void* args[] = {&a};
    hipError_t e = hipLaunchCooperativeKernel((const void*)mega_fwd, dim3(grid), dim3(NTHR), args, LDS_BYTES, stream);
    if (e != hipSuccess) fprintf(stderr, "cooperative launch failed: %s (grid %d)\n", hipGetErrorString(e), grid);
}
```

```cpp
#include <hip/hip_runtime.h>
#include <hip/hip_cooperative_groups.h>
#include <cstdio>
#include <cstdint>
namespace cg = cooperative_groups;
__device__ __forceinline__ int opaque_tid() { int t = threadIdx.x; asm volatile("" : "+v"(t)); return t; }
namespace pg8 {
#define PG8_LAS __attribute__((address_space(3)))
typedef unsigned short bf16_t;
typedef short bf16x8 __attribute__((ext_vector_type(8)));
typedef float f32x4 __attribute__((ext_vector_type(4)));
typedef unsigned u32x4 __attribute__((ext_vector_type(4)));
constexpr int BM = 256, BK = 64, HALF = 128, HTB = HALF * BK * 2  , STAGE_BYTES = 8 * HTB, NXCD = 8, WGM = 8;

__host__ __device__ __forceinline__ int lds_byte(int r, int c) { const int st = (r >> 4) * 2 + (c >> 5), rr = r & 15, cc = c & 31, ob = rr * 64 + cc * 2; return st * 1024 + (ob ^ (((ob >> 9) & 1) << 5)); }
__host__ __device__ __forceinline__ void stage_rc(int b, int& R, int& C) { const int st = b / 1024, sb = b % 1024, swz = sb ^ (((sb >> 9) & 1) << 5); R = (st >> 1) * 16 + swz / 64; C = (st & 1) * 32 + (swz % 64) / 2; }
__host__ __device__ __forceinline__ int perm32(int rho) { const int n = rho >> 4, i = rho & 15; return 8 * (i >> 2) + 4 * n + (i & 3); }

struct Unit { int pm, pn; };
struct Gemm { const bf16_t* A; const bf16_t* Bt; int M, N, K, lda, ldb; };

struct StaticOrder {
    int nM, nN, nwg, G, c;
    __host__ __device__ void init(int M, int N, int G_, int c_) { nM = M / BM; nN = N / BM; nwg = nM * nN; G = G_; c = c_; }
    __host__ __device__ bool next(int i, Unit& u) const {
        const long L = (long)i * G + c; if (L >= nwg) return false;
        int wgid = (int)L; { const int q = nwg / NXCD, r = nwg % NXCD, xcd = wgid % NXCD, off = wgid / NXCD; wgid = (xcd < r ? xcd * (q + 1) : r * (q + 1) + (xcd - r) * q) + off; }
        const int nig = WGM * nN, gid = wgid / nig, fm = gid * WGM, gsz = (nM - fm) < WGM ? (nM - fm) : WGM;
        u.pm = fm + ((wgid % nig) % gsz); u.pn = (wgid % nig) / gsz; return true;
    }
    __device__ __forceinline__ void a_ready(const Unit&) const {}
    __device__ __forceinline__ void done(const Unit&) const {}
};

__device__ __forceinline__ unsigned cvt_pk_bf16(float lo, float hi) { unsigned r; asm volatile("v_cvt_pk_bf16_f32 %0, %1, %2" : "=v"(r) : "v"(lo), "v"(hi)); return r; }
typedef unsigned u32x2 __attribute__((ext_vector_type(2)));
template <int ACT  > struct EpiBf {
    static constexpr bool PERM = true, AFTER_DRAIN = false;
    bf16_t* O; int ldc;
    __device__ __forceinline__ void operator()(const f32x4 (&acc)[2][2][4][2], const Unit& u, int wr, int wc, int fr, int fq) const {
        const int row0 = u.pm * BM + wr * 64 + fr, col0 = u.pn * BM + wc * 32 + 8 * fq;
#pragma unroll
        for (int ai = 0; ai < 2; ++ai)
#pragma unroll
            for (int m = 0; m < 4; ++m) { bf16_t* rowp = O + (size_t)(row0 + ai * HALF + m * 16) * ldc + col0;
#pragma unroll
                for (int bj = 0; bj < 2; ++bj) { f32x4 v0 = acc[ai][bj][m][0], v1 = acc[ai][bj][m][1];
                    if (ACT == 1) {
#pragma unroll
                        for (int e = 0; e < 4; ++e) { float a = v0[e] > 0.f ? v0[e] : 0.f; v0[e] = a * a; float b = v1[e] > 0.f ? v1[e] : 0.f; v1[e] = b * b; } }
                    u32x4 w; w.x = cvt_pk_bf16(v0[0], v0[1]); w.y = cvt_pk_bf16(v0[2], v0[3]); w.z = cvt_pk_bf16(v1[0], v1[1]); w.w = cvt_pk_bf16(v1[2], v1[3]);
                    *(u32x4*)(rowp + bj * HALF) = w; } }
    }
};
struct EpiRes {
    static constexpr bool PERM = false, AFTER_DRAIN = false;
    float* X; const float* gate; const float* Xc; const float* Xl;
    __device__ __forceinline__ void operator()(const f32x4 (&acc)[2][2][4][2], const Unit& u, int wr, int wc, int fr, int fq) const {
        const int row0 = u.pm * BM + wr * 64 + fr, col0 = u.pn * BM + wc * 32 + 4 * fq;
        const int cond = u.pm < 32 ? 0 : 1 + ((u.pm - 32) >> 2);
        const float* gp = gate + cond * 6144 + col0;
        f32x4 gv[2][2];
#pragma unroll
        for (int bj = 0; bj < 2; ++bj)
#pragma unroll
            for (int n = 0; n < 2; ++n) gv[bj][n] = *(const f32x4*)(gp + bj * HALF + n * 16);
#pragma unroll
        for (int ai = 0; ai < 2; ++ai)
#pragma unroll
            for (int m = 0; m < 4; ++m) { const size_t ro = (size_t)(row0 + ai * HALF + m * 16) * 1024 + col0; float* rowp = X + ro; const float* srcp = u.pm < 32 ? Xc + ro : Xl + (ro - (size_t)8192 * 1024);
#pragma unroll
                for (int bj = 0; bj < 2; ++bj)
#pragma unroll
                    for (int n = 0; n < 2; ++n) { *(f32x4*)(rowp + bj * HALF + n * 16) = *(const f32x4*)(srcp + bj * HALF + n * 16) + gv[bj][n] * acc[ai][bj][m][n]; }
                if (m & 1) asm volatile("" ::: "memory"); }
    }
};
struct EpiFnet {
    static constexpr bool PERM = true, AFTER_DRAIN = false;
    bf16_t* MIX; int rowbase, L;
    __device__ __forceinline__ void operator()(const f32x4 (&acc)[2][2][4][2], const Unit& u, int wr, int wc, int fr, int fq) const {
        const int row0 = u.pm * BM + wr * 64 + fr, colw = wc * 32 + 8 * fq;
        bf16_t* base = MIX + (size_t)(rowbase + u.pn * L) * 1024 + 512 + colw;
#pragma unroll
        for (int ai = 0; ai < 2; ++ai)
#pragma unroll
            for (int m = 0; m < 4; ++m) { bf16_t* rowp = base + (size_t)(row0 + ai * HALF + m * 16) * 1024;
#pragma unroll
                for (int bj = 0; bj < 2; ++bj) { const f32x4 v0 = acc[ai][bj][m][0], v1 = acc[ai][bj][m][1];
                    u32x4 w; w.x = cvt_pk_bf16(v0[0], v0[1]); w.y = cvt_pk_bf16(v0[2], v0[3]); w.z = cvt_pk_bf16(v1[0], v1[1]); w.w = cvt_pk_bf16(v1[2], v1[3]);
                    *(u32x4*)(rowp + bj * HALF) = w; } }
    }
};

__device__ __forceinline__ float xsum_fq(float s, int fr, int fq) {
    s += __builtin_bit_cast(float, __builtin_amdgcn_ds_bpermute((((fq ^ 1) << 4) | fr) << 2, __builtin_bit_cast(int, s)));
    s += __builtin_bit_cast(float, __builtin_amdgcn_ds_bpermute((((fq ^ 2) << 4) | fr) << 2, __builtin_bit_cast(int, s)));
    return s;
}
template <int ACT> struct EpiNormBf {
    static constexpr bool PERM = true, AFTER_DRAIN = false;
    bf16_t* O; int ldc; const float* ssq; const float* sw; int swld;
    __device__ __forceinline__ void operator()(const f32x4 (&acc)[2][2][4][2], const Unit& u, int wr, int wc, int fr, int fq) const {
        const int row0 = u.pm * BM + wr * 64 + fr, col0 = u.pn * BM + wc * 32 + 8 * fq;
        const int cond = u.pm < 32 ? 0 : 1 + ((u.pm - 32) >> 2);
        f32x4 sv[2][2];
#pragma unroll
        for (int bj = 0; bj < 2; ++bj)
#pragma unroll
            for (int n = 0; n < 2; ++n) sv[bj][n] = *(const f32x4*)(sw + (size_t)cond * swld + col0 + bj * HALF + 4 * n);
        float rs[2][4];
#pragma unroll
        for (int ai = 0; ai < 2; ++ai)
#pragma unroll
            for (int m = 0; m < 4; ++m) rs[ai][m] = ssq[row0 + ai * HALF + m * 16];
#pragma unroll
        for (int ai = 0; ai < 2; ++ai)
#pragma unroll
            for (int m = 0; m < 4; ++m) rs[ai][m] = __builtin_amdgcn_rsqf(rs[ai][m] * (1.0f / 1024.0f) + 1e-6f);
#pragma unroll
        for (int ai = 0; ai < 2; ++ai)
#pragma unroll
            for (int m = 0; m < 4; ++m) { const int row = row0 + ai * HALF + m * 16; bf16_t* rowp = O + (size_t)row * ldc + col0;
                const float rstd = rs[ai][m];
#pragma unroll
                for (int bj = 0; bj < 2; ++bj) { f32x4 v0 = acc[ai][bj][m][0] * rstd + sv[bj][0], v1 = acc[ai][bj][m][1] * rstd + sv[bj][1];
                    if (ACT == 1) {
#pragma unroll
                        for (int e = 0; e < 4; ++e) { float a = v0[e] > 0.f ? v0[e] : 0.f; v0[e] = a * a; float b = v1[e] > 0.f ? v1[e] : 0.f; v1[e] = b * b; } }
                    u32x4 w; w.x = cvt_pk_bf16(v0[0], v0[1]); w.y = cvt_pk_bf16(v0[2], v0[3]); w.z = cvt_pk_bf16(v1[0], v1[1]); w.w = cvt_pk_bf16(v1[2], v1[3]);
                    *(u32x4*)(rowp + bj * HALF) = w; }
                if (m & 1) asm volatile("" ::: "memory"); }
    }
};
struct EpiResFinal {
    static constexpr bool PERM = true, AFTER_DRAIN = false;
    const bf16_t* XB; const float* gate; const float* gfin; float* out; float* ssq; unsigned* cnt;
    __device__ __forceinline__ void operator()(const f32x4 (&acc)[2][2][4][2], const Unit& u, int wr, int wc, int fr, int fq) const {
        const int row0 = u.pm * BM + wr * 64 + fr, col0 = u.pn * BM + wc * 32 + 8 * fq;
        const int cond = u.pm < 32 ? 0 : 1 + ((u.pm - 32) >> 2);
        f32x4 gt[2][2];
#pragma unroll
        for (int bj = 0; bj < 2; ++bj)
#pragma unroll
            for (int n = 0; n < 2; ++n) gt[bj][n] = *(const f32x4*)(gate + cond * 6144 + col0 + bj * HALF + n * 4);
#pragma unroll
        for (int ai = 0; ai < 2; ++ai) {
            u32x4 xb[4][2];
#pragma unroll
            for (int m = 0; m < 4; ++m)
#pragma unroll
                for (int bj = 0; bj < 2; ++bj) xb[m][bj] = *(const u32x4*)(XB + (unsigned)(row0 + ai * HALF + m * 16) * 1024u + (unsigned)col0 + bj * HALF);
#pragma unroll
            for (int m = 0; m < 4; ++m) { const int row = row0 + ai * HALF + m * 16;
                float sq = 0.f;
#pragma unroll
                for (int bj = 0; bj < 2; ++bj) { const u32x4 xw = xb[m][bj];
                    f32x4 x0 = (f32x4){__builtin_bit_cast(float, xw.x << 16), __builtin_bit_cast(float, xw.x & 0xffff0000u), __builtin_bit_cast(float, xw.y << 16), __builtin_bit_cast(float, xw.y & 0xffff0000u)};
                    f32x4 x1 = (f32x4){__builtin_bit_cast(float, xw.z << 16), __builtin_bit_cast(float, xw.z & 0xffff0000u), __builtin_bit_cast(float, xw.w << 16), __builtin_bit_cast(float, xw.w & 0xffff0000u)};
                    x0 += gt[bj][0] * acc[ai][bj][m][0]; x1 += gt[bj][1] * acc[ai][bj][m][1];
                    sq += ((x0[0] * x0[0] + x0[1] * x0[1]) + (x0[2] * x0[2] + x0[3] * x0[3])) + ((x1[0] * x1[0] + x1[1] * x1[1]) + (x1[2] * x1[2] + x1[3] * x1[3])); }
                const float t = xsum_fq(sq, fr, fq); if (fq == 0) atomicAdd(ssq + row, t); }
            asm volatile("" ::: "memory"); }
        asm volatile("s_waitcnt vmcnt(0)" ::: "memory");
        unsigned* c = cnt + 64 * u.pm;
        if (fr == 0 && fq == 0) { __hip_atomic_fetch_add(c, 1u, __ATOMIC_RELAXED, __HIP_MEMORY_SCOPE_AGENT);
            for (unsigned spin = 0; __hip_atomic_load(c, __ATOMIC_RELAXED, __HIP_MEMORY_SCOPE_AGENT) < 32u && spin < (1u << 22); ++spin) __builtin_amdgcn_s_sleep(2); }
        asm volatile("" ::: "memory");
        f32x4 gv[2][2];
#pragma unroll
        for (int bj = 0; bj < 2; ++bj)
#pragma unroll
            for (int n = 0; n < 2; ++n) gv[bj][n] = *(const f32x4*)(gfin + col0 + bj * HALF + n * 4);
#pragma unroll
        for (int ai = 0; ai < 2; ++ai) {
            u32x4 xb[4][2]; float rs[4];
#pragma unroll
            for (int m = 0; m < 4; ++m) { rs[m] = __hip_atomic_load(ssq + row0 + ai * HALF + m * 16, __ATOMIC_RELAXED, __HIP_MEMORY_SCOPE_AGENT);
#pragma unroll
                for (int bj = 0; bj < 2; ++bj) xb[m][bj] = *(const u32x4*)(XB + (unsigned)(row0 + ai * HALF + m * 16) * 1024u + (unsigned)col0 + bj * HALF); }
#pragma unroll
            for (int m = 0; m < 4; ++m) { const unsigned ro = (unsigned)(row0 + ai * HALF + m * 16) * 1024u + (unsigned)col0;
                const float rstd = __builtin_amdgcn_rsqf(rs[m] * (1.0f / 1024.0f) + 1e-6f);
#pragma unroll
                for (int bj = 0; bj < 2; ++bj) { const u32x4 xw = xb[m][bj];
                    f32x4 x0 = (f32x4){__builtin_bit_cast(float, xw.x << 16), __builtin_bit_cast(float, xw.x & 0xffff0000u), __builtin_bit_cast(float, xw.y << 16), __builtin_bit_cast(float, xw.y & 0xffff0000u)};
                    f32x4 x1 = (f32x4){__builtin_bit_cast(float, xw.z << 16), __builtin_bit_cast(float, xw.z & 0xffff0000u), __builtin_bit_cast(float, xw.w << 16), __builtin_bit_cast(float, xw.w & 0xffff0000u)};
                    f32x4 ga = gt[bj][0], gb = gt[bj][1]; asm volatile("" : "+v"(ga), "+v"(gb));
                    x0 += ga * acc[ai][bj][m][0]; x1 += gb * acc[ai][bj][m][1];
                    *(f32x4*)(out + ro + bj * HALF) = x0 * rstd * gv[bj][0]; *(f32x4*)(out + ro + bj * HALF + 4) = x1 * rstd * gv[bj][1]; } }
            asm volatile("" ::: "memory"); }
    }
};
template <bool SRC_F32, bool WRITE_H> struct EpiResNorm {
    static constexpr bool PERM = true, AFTER_DRAIN = false;
    bf16_t* XB; const float* gate; const float* Xc; const float* Xl; bf16_t* H; const float* gn; const float* scl; float* ssq;
    __device__ __forceinline__ void operator()(const f32x4 (&acc)[2][2][4][2], const Unit& u, int wr, int wc, int fr, int fq) const {
        const int row0 = u.pm * BM + wr * 64 + fr, col0 = u.pn * BM + wc * 32 + 8 * fq;
        const int cond = u.pm < 32 ? 0 : 1 + ((u.pm - 32) >> 2);
        const float* src = u.pm < 32 ? Xc : Xl - (size_t)8192 * 1024;
        f32x4 gt[2][2], gs[2][2];
#pragma unroll
        for (int bj = 0; bj < 2; ++bj)
#pragma unroll
            for (int n = 0; n < 2; ++n) { const int col = col0 + bj * HALF + n * 4;
                gt[bj][n] = *(const f32x4*)(gate + cond * 6144 + col);
                if (WRITE_H) gs[bj][n] = *(const f32x4*)(gn + col) * (*(const f32x4*)(scl + cond * 6144 + col) + 1.0f); }
        constexpr int NB = SRC_F32 ? 2 : 4;
#pragma unroll
        for (int ai = 0; ai < 2; ++ai)
#pragma unroll
        for (int mb = 0; mb < 4; mb += NB) {
            u32x4 xb[NB][2]; f32x4 xf[NB][2][2];
#pragma unroll
            for (int mm = 0; mm < NB; ++mm) { const unsigned ro = (unsigned)(row0 + ai * HALF + (mb + mm) * 16) * 1024u + (unsigned)col0;
#pragma unroll
                for (int bj = 0; bj < 2; ++bj) {
                    if (SRC_F32) { xf[mm][bj][0] = *(const f32x4*)(src + ro + bj * HALF); xf[mm][bj][1] = *(const f32x4*)(src + ro + bj * HALF + 4); }
                    else xb[mm][bj] = *(const u32x4*)(XB + ro + bj * HALF); } }
#pragma unroll
            for (int mm = 0; mm < NB; ++mm) { const int m = mb + mm; const int row = row0 + ai * HALF + m * 16; const unsigned ro = (unsigned)row * 1024u + (unsigned)col0;
                float sq = 0.f;
#pragma unroll
                for (int bj = 0; bj < 2; ++bj) { const unsigned o = ro + bj * HALF;
                    f32x4 x0, x1;
                    if (SRC_F32) { x0 = xf[mm][bj][0]; x1 = xf[mm][bj][1]; }
                    else { const u32x4 xw = xb[mm][bj];
                        x0 = (f32x4){__builtin_bit_cast(float, xw.x << 16), __builtin_bit_cast(float, xw.x & 0xffff0000u), __builtin_bit_cast(float, xw.y << 16), __builtin_bit_cast(float, xw.y & 0xffff0000u)};
                        x1 = (f32x4){__builtin_bit_cast(float, xw.z << 16), __builtin_bit_cast(float, xw.z & 0xffff0000u), __builtin_bit_cast(float, xw.w << 16), __builtin_bit_cast(float, xw.w & 0xffff0000u)}; }
                    x0 += gt[bj][0] * acc[ai][bj][m][0]; x1 += gt[bj][1] * acc[ai][bj][m][1];
                    u32x4 xo; xo.x = cvt_pk_bf16(x0[0], x0[1]); xo.y = cvt_pk_bf16(x0[2], x0[3]); xo.z = cvt_pk_bf16(x1[0], x1[1]); xo.w = cvt_pk_bf16(x1[2], x1[3]);
                    *(u32x4*)(XB + o) = xo;
                    sq += ((x0[0] * x0[0] + x0[1] * x0[1]) + (x0[2] * x0[2] + x0[3] * x0[3])) + ((x1[0] * x1[0] + x1[1] * x1[1]) + (x1[2] * x1[2] + x1[3] * x1[3]));
                    if (WRITE_H) { const f32x4 h0 = x0 * gs[bj][0], h1 = x1 * gs[bj][1];
                        u32x4 w; w.x = cvt_pk_bf16(h0[0], h0[1]); w.y = cvt_pk_bf16(h0[2], h0[3]); w.z = cvt_pk_bf16(h1[0], h1[1]); w.w = cvt_pk_bf16(h1[2], h1[3]);
                        *(u32x4*)(H + o) = w; } }
                const float t = xsum_fq(sq, fr, fq); if (fq == 0) atomicAdd(ssq + row, t);
            }
            asm volatile("" ::: "memory"); }
    }
};
template <class Epi, class Sched, bool ALIGN_EPI = false, bool SP2 = false>
__device__ __forceinline__ void gemm_phase(PG8_LAS unsigned char* lds, const Gemm g, const Sched& S, const Epi& E) {
    const int tid = opaque_tid(), wid = __builtin_amdgcn_readfirstlane(tid >> 6), lane = tid & 63, wr = wid >> 2, wc = wid & 3, fr = lane & 15, fq = lane >> 4;
    const int K = g.K, nt = K / BK;
    unsigned voffA[2], voffB[2];
#pragma unroll
    for (int i = 0; i < 2; ++i) { int R, C; stage_rc(tid * 16 + i * 8192, R, C); const int Rb = E.PERM ? ((R & ~31) + perm32(R & 31)) : R;
        voffA[i] = (unsigned)(R * g.lda + C) * 2u; voffB[i] = (unsigned)(Rb * g.ldb + C) * 2u; }
    const size_t kstep = (size_t)(BK * 2);
    const size_t hstepA = (size_t)HALF * g.lda * 2, hstepB = (size_t)HALF * g.ldb * 2;
    const size_t tstepA = 2 * hstepA, tstepB = 2 * hstepB;
    const unsigned ldsw = (unsigned)wid * 1024u;
    const int aoff = lds_byte(wr * 64 + fr, fq * 8), boff = lds_byte(wc * 32 + fr, fq * 8);
#define PG8_SA(b, h) (((b) * 2 + (h)) * HTB)
#define PG8_SB(b, h) ((4 + (b) * 2 + (h)) * HTB)
#define PG8_STAGE(bufoff, gbase, voff) do { _Pragma("unroll") for (int _i = 0; _i < 2; ++_i) \
        __builtin_amdgcn_global_load_lds((const unsigned*)((const char*)(gbase) + (voff)[_i]), (PG8_LAS unsigned*)(lds + (bufoff) + ldsw + _i * 8192), 16, 0, 0); } while (0)
#define PG8_LDA(dst, b, h) do { _Pragma("unroll") for (int m = 0; m < 4; ++m) _Pragma("unroll") for (int k = 0; k < 2; ++k) dst[m][k] = *(const PG8_LAS bf16x8*)(lds + PG8_SA(b, h) + aoff + m * 2048 + k * 1024); } while (0)
#define PG8_LDB(dst, b, h) do { _Pragma("unroll") for (int n = 0; n < 2; ++n) _Pragma("unroll") for (int k = 0; k < 2; ++k) dst[n][k] = *(const PG8_LAS bf16x8*)(lds + PG8_SB(b, h) + boff + n * 2048 + k * 1024); } while (0)
#define PG8_MMA(ai, bj, At, Bt) do { __builtin_amdgcn_s_setprio(1); _Pragma("unroll") for (int m = 0; m < 4; ++m) _Pragma("unroll") for (int n = 0; n < 2; ++n) _Pragma("unroll") for (int k = 0; k < 2; ++k) \
        acc[ai][bj][m][n] = __builtin_amdgcn_mfma_f32_16x16x32_bf16(Bt[n][k], At[m][k], acc[ai][bj][m][n], 0, 0, 0); __builtin_amdgcn_s_setprio(0); } while (0)
#define PG8_WAIT_V(n) asm volatile("s_waitcnt vmcnt(" #n ")" ::: "memory")
#define PG8_WAIT_L(n) asm volatile("s_waitcnt lgkmcnt(" #n ")" ::: "memory")
#define PG8_BAR __builtin_amdgcn_s_barrier()
#define PG8_SCHED __builtin_amdgcn_sched_barrier(0)
    Unit cur, nxt; int ui = 0;
    if (!S.next(0, cur)) return;
    f32x4 acc[2][2][4][2];
#pragma unroll
    for (int a = 0; a < 2; ++a)
#pragma unroll
        for (int b = 0; b < 2; ++b)
#pragma unroll
            for (int m = 0; m < 4; ++m)
#pragma unroll
                for (int n = 0; n < 2; ++n) acc[a][b][m][n] = (f32x4){0.f, 0.f, 0.f, 0.f};
    bf16x8 At[4][2], B0[2][2], B1[2][2];
    const char* cA = (const char*)g.A + (size_t)cur.pm * tstepA; const char* cB = (const char*)g.Bt + (size_t)cur.pn * tstepB;
    S.a_ready(cur);
    if constexpr (SP2) {
        PG8_STAGE(PG8_SB(0, 0), cB, voffB); PG8_STAGE(PG8_SB(0, 1), cB + hstepB, voffB); PG8_STAGE(PG8_SA(0, 0), cA, voffA); PG8_STAGE(PG8_SA(0, 1), cA + hstepA, voffA);
        if (wr == 1) PG8_BAR;
        PG8_WAIT_V(2); PG8_BAR;
        PG8_STAGE(PG8_SB(1, 0), cB + kstep, voffB); PG8_STAGE(PG8_SA(1, 0), cA + kstep, voffA); PG8_STAGE(PG8_SB(1, 1), cB + hstepB + kstep, voffB);
        PG8_WAIT_V(6); PG8_BAR;
    } else {
        PG8_STAGE(PG8_SB(0, 0), cB, voffB); PG8_STAGE(PG8_SA(0, 0), cA, voffA); PG8_STAGE(PG8_SB(0, 1), cB + hstepB, voffB); PG8_STAGE(PG8_SA(0, 1), cA + hstepA, voffA);
        if (wr == 1) PG8_BAR;
        PG8_WAIT_V(4); PG8_BAR;
        PG8_STAGE(PG8_SB(1, 0), cB + kstep, voffB); PG8_STAGE(PG8_SA(1, 0), cA + kstep, voffA); PG8_STAGE(PG8_SB(1, 1), cB + hstepB + kstep, voffB);
        PG8_WAIT_V(6); PG8_BAR;
    }
    for (;;) {
        const bool has_next = S.next(ui + 1, nxt);
        const char* nA = has_next ? (const char*)g.A + (size_t)nxt.pm * tstepA : cA; const char* nB = has_next ? (const char*)g.Bt + (size_t)nxt.pn * tstepB : cB;
        for (int t = 0; t < nt; t += 2) {
            const bool last = (t == nt - 2);
            const char* a1 = cA + (size_t)(t + 1) * kstep;
            const char* a2 = last ? nA : cA + (size_t)(t + 2) * kstep; const char* b2 = last ? nB : cB + (size_t)(t + 2) * kstep;
            const char* a3 = a2 + kstep; const char* b3 = b2 + kstep;
            if (last && has_next) S.a_ready(nxt);
            if constexpr (SP2) {
            PG8_LDB(B0, 0, 0); PG8_LDB(B1, 0, 1); PG8_SCHED; PG8_LDA(At, 0, 0); PG8_STAGE(PG8_SA(1, 1), a1 + hstepA, voffA);
            PG8_WAIT_V(8); PG8_WAIT_L(0); PG8_BAR; PG8_MMA(0, 0, At, B0); PG8_MMA(0, 1, At, B1); PG8_BAR; PG8_SCHED;
            PG8_LDA(At, 0, 1); PG8_STAGE(PG8_SB(0, 0), b2, voffB); PG8_STAGE(PG8_SB(0, 1), b2 + hstepB, voffB); PG8_STAGE(PG8_SA(0, 0), a2, voffA);
            PG8_WAIT_V(8); PG8_WAIT_L(0); PG8_BAR; PG8_MMA(1, 0, At, B0); PG8_MMA(1, 1, At, B1); PG8_BAR; PG8_SCHED;
            PG8_LDB(B0, 1, 0); PG8_LDB(B1, 1, 1); PG8_SCHED; PG8_LDA(At, 1, 0); PG8_STAGE(PG8_SA(0, 1), a2 + hstepA, voffA);
            PG8_WAIT_V(8); PG8_WAIT_L(0); PG8_BAR; PG8_MMA(0, 0, At, B0); PG8_MMA(0, 1, At, B1); PG8_BAR; PG8_SCHED;
            PG8_LDA(At, 1, 1); PG8_STAGE(PG8_SB(1, 0), b3, voffB); PG8_STAGE(PG8_SB(1, 1), b3 + hstepB, voffB); PG8_STAGE(PG8_SA(1, 0), a3, voffA);
            PG8_WAIT_V(8); PG8_WAIT_L(0); PG8_BAR; PG8_MMA(1, 0, At, B0); PG8_MMA(1, 1, At, B1); PG8_BAR; PG8_SCHED;
            } else {
            PG8_LDB(B0, 0, 0); PG8_SCHED; PG8_LDA(At, 0, 0); PG8_STAGE(PG8_SA(1, 1), a1 + hstepA, voffA);
            PG8_WAIT_L(8); PG8_BAR; PG8_WAIT_L(0); PG8_MMA(0, 0, At, B0); PG8_BAR; PG8_SCHED;
            PG8_LDB(B1, 0, 1); PG8_STAGE(PG8_SB(0, 0), b2, voffB);
            PG8_BAR; PG8_WAIT_L(0); PG8_MMA(0, 1, At, B1); PG8_BAR;
            PG8_LDA(At, 0, 1); PG8_STAGE(PG8_SA(0, 0), a2, voffA);
            PG8_BAR; PG8_WAIT_L(0); PG8_MMA(1, 0, At, B0); PG8_BAR; PG8_SCHED;
            PG8_STAGE(PG8_SB(0, 1), b2 + hstepB, voffB);
            PG8_WAIT_V(6); PG8_BAR; PG8_MMA(1, 1, At, B1); PG8_BAR;
            PG8_LDB(B0, 1, 0); PG8_SCHED; PG8_LDA(At, 1, 0); PG8_STAGE(PG8_SA(0, 1), a2 + hstepA, voffA);
            PG8_WAIT_L(8); PG8_BAR; PG8_WAIT_L(0); PG8_MMA(0, 0, At, B0); PG8_BAR; PG8_SCHED;
            PG8_LDB(B1, 1, 1); PG8_STAGE(PG8_SB(1, 0), b3, voffB);
            PG8_BAR; PG8_WAIT_L(0); PG8_MMA(0, 1, At, B1); PG8_BAR;
            PG8_LDA(At, 1, 1); PG8_STAGE(PG8_SA(1, 0), a3, voffA);
            PG8_BAR; PG8_WAIT_L(0); PG8_MMA(1, 0, At, B0); PG8_BAR; PG8_SCHED;
            PG8_STAGE(PG8_SB(1, 1), b3 + hstepB, voffB);
            PG8_WAIT_V(6); PG8_BAR; PG8_MMA(1, 1, At, B1); PG8_BAR;
            }
        }
        if constexpr (ALIGN_EPI) { if (wr == 0) PG8_BAR; }
        if constexpr (!Epi::AFTER_DRAIN) { int fr2 = fr, fq2 = fq; asm volatile("" : "+v"(fr2), "+v"(fq2)); E(acc, cur, wr, wc, fr2, fq2); S.done(cur); }
        if (!has_next) break;
#pragma unroll
        for (int a = 0; a < 2; ++a)
#pragma unroll
            for (int b = 0; b < 2; ++b)
#pragma unroll
                for (int m = 0; m < 4; ++m)
#pragma unroll
                    for (int n = 0; n < 2; ++n) acc[a][b][m][n] = (f32x4){0.f, 0.f, 0.f, 0.f};
        cur = nxt; cA = nA; cB = nB; ++ui;
        if constexpr (ALIGN_EPI) { if (wr == 1) PG8_BAR; }
    }
    PG8_WAIT_V(0);
    if constexpr (!ALIGN_EPI) { if (wr == 0) PG8_BAR; }
    PG8_BAR;
    if constexpr (Epi::AFTER_DRAIN) { E.fused(acc, cur, wr, wc, fr, fq, lds, wid, lane); S.done(cur); }
#undef PG8_SA
#undef PG8_SB
#undef PG8_STAGE
#undef PG8_LDA
#undef PG8_LDB
#undef PG8_MMA
#undef PG8_WAIT_V
#undef PG8_WAIT_L
#undef PG8_BAR
#undef PG8_SCHED
}
}

#define LAS __attribute__((address_space(3)))
typedef unsigned short bf16;
typedef float f32x4 __attribute__((ext_vector_type(4)));
typedef unsigned u32x4 __attribute__((ext_vector_type(4)));
typedef unsigned u32x2 __attribute__((ext_vector_type(2)));
constexpr int DM = 1024, NCTX = 8192, MTOK = 12288, DINP = 2560, DFF = 4096;
constexpr int R_OFF = 0, K_OFF = 512, V_OFF = 1024, WD_OFF = 1536, AD_OFF = 1664, GD_OFF = 1792, F_OFF = 1920, P_OFF = 2176, DIN = 2432;
constexpr size_t MiB = 1u << 20;
constexpr size_t WS_CTL = 0, WS_MOD = 1 * MiB, WS_FW = 1 * MiB + 512 * 1024, WS_BC = 2 * MiB, WS_CS256 = 3 * MiB, WS_CS1024 = 4 * MiB, WS_WIN = 8 * MiB, WS_WOUT = 18 * MiB,
                 WS_W1 = 22 * MiB, WS_W2 = 38 * MiB, WS_H = 54 * MiB, WS_MIXED = 78 * MiB, WS_PROJ = 102 * MiB, WS_YCS = 162 * MiB, WS_YF = 102 * MiB, WS_YB = 126 * MiB  , WS_U = 174 * MiB, WS_KINV = 220 * MiB, WS_GUPT = 221 * MiB,
                 WS_FF = 102 * MiB, WS_WUPT = 222 * MiB, WS_AUPT = 222 * MiB + 256 * 1024, WS_SSQ = 223 * MiB, WS_WPT = 223 * MiB + 512 * 1024, WS_SW1 = 224 * MiB, WS_SWIN = 224 * MiB + 256 * 1024, WS_XB = 226 * MiB, WS_END = 250 * MiB;
constexpr int LDS_BYTES = 147456, RING_BYTES = 131072, MISC_OFF = RING_BYTES + 320;
constexpr int NTHR = 512;
enum { I_XP = 0, I_XS, I_STATE, I_C, I_CCTX, I_WADA, I_BADA, I_N1G, I_WIN, I_MU, I_W0, I_WUP, I_A0, I_AUP, I_GUP, I_KK, I_KA, I_RK, I_LNW, I_LNB, I_WFNET, I_WPOOL, I_PSCALE, I_WOUT, I_N2G, I_WFF1, I_WFF2, I_FNG, N_IN };
struct KP { const float* in[N_IN]; float* out; unsigned char* ws; int ph_lo, ph_hi; };
typedef const __attribute__((address_space(4))) KP CKP;

__device__ __forceinline__ unsigned f2bf(float f) { unsigned u = __builtin_bit_cast(unsigned, f); return (u + 0x7fffu + ((u >> 16) & 1u)) >> 16; }
__device__ __forceinline__ unsigned pk2(float lo, float hi) { return f2bf(lo) | (f2bf(hi) << 16); }
__device__ __forceinline__ float bflo(unsigned w) { return __builtin_bit_cast(float, w << 16); }
__device__ __forceinline__ float bfhi(unsigned w) { return __builtin_bit_cast(float, w & 0xffff0000u); }
__device__ __forceinline__ float bf1(bf16 h) { return __builtin_bit_cast(float, (unsigned)h << 16); }
__device__ __forceinline__ float fexp(float x) { return __builtin_amdgcn_exp2f(x * 1.4426950408889634f); }
__device__ __forceinline__ float flog(float x) { return __builtin_amdgcn_logf(x) * 0.6931471805599453f; }
__device__ __forceinline__ float frcp(float x) { return __builtin_amdgcn_rcpf(x); }
__device__ __forceinline__ float frsq(float x) { return __builtin_amdgcn_rsqf(x); }
__device__ __forceinline__ float fsigmoid(float x) { return frcp(1.0f + fexp(-x)); }
template <int CTRL> __device__ __forceinline__ float dppf(float x) { return __builtin_bit_cast(float, __builtin_amdgcn_update_dpp(0, __builtin_bit_cast(int, x), CTRL, 0xF, 0xF, true)); }
__device__ __forceinline__ float red8(float x)  { x += dppf<0xB1>(x); x += dppf<0x4E>(x); x += dppf<0x141>(x); return x; }
__device__ __forceinline__ float red16(float x) { x += dppf<0xB1>(x); x += dppf<0x4E>(x); x += dppf<0x141>(x); x += dppf<0x140>(x); return x; }
__device__ __forceinline__ float wave_sum(float v) {
    v = red16(v);
    const float s0 = __builtin_bit_cast(float, __builtin_amdgcn_readlane(__builtin_bit_cast(int, v), 0)), s1 = __builtin_bit_cast(float, __builtin_amdgcn_readlane(__builtin_bit_cast(int, v), 16));
    const float s2 = __builtin_bit_cast(float, __builtin_amdgcn_readlane(__builtin_bit_cast(int, v), 32)), s3 = __builtin_bit_cast(float, __builtin_amdgcn_readlane(__builtin_bit_cast(int, v), 48));
    return (s0 + s1) + (s2 + s3);
}
__device__ __forceinline__ void load4bf(const bf16* p, float (&o)[4]) { const u32x2 w = *(const u32x2*)p; o[0] = bflo(w.x); o[1] = bfhi(w.x); o[2] = bflo(w.y); o[3] = bfhi(w.y); }
__device__ __forceinline__ void load8bf(const bf16* p, float (&o)[8]) { const u32x4 w = *(const u32x4*)p; o[0] = bflo(w.x); o[1] = bfhi(w.x); o[2] = bflo(w.y); o[3] = bfhi(w.y); o[4] = bflo(w.z); o[5] = bfhi(w.z); o[6] = bflo(w.w); o[7] = bfhi(w.w); }
__device__ __forceinline__ void shift4(const bf16* proj, int row, bool hasp, bool hasn, int col, const float* mu, float (&u)[4]) {
    float p[4], a[4] = {0.f, 0.f, 0.f, 0.f}, b[4] = {0.f, 0.f, 0.f, 0.f};
    load4bf(proj + (size_t)row * DINP + col, p);
    if (hasp) load4bf(proj + (size_t)(row - 1) * DINP + col, a);
    if (hasn) load4bf(proj + (size_t)(row + 1) * DINP + col, b);
    const f32x4 m = *(const f32x4*)(mu + col);
#pragma unroll
    for (int j = 0; j < 4; ++j) u[j] = p[j] + m[j] * (0.5f * (a[j] + b[j]) - p[j]);
}

__device__ __forceinline__ void gemv5_cols(LAS float* sc, LAS float* red, const float* W, int ldw, int colw, const float* bias, float* out, int ldo, int colo, int tid) {
    const int cgi = tid & 15, kg = tid >> 4;
    f32x4 acc[5];
#pragma unroll
    for (int c = 0; c < 5; ++c) acc[c] = (f32x4){0.f, 0.f, 0.f, 0.f};
    const float* wp = W + (size_t)(kg * 32) * ldw + colw + cgi * 4;
#pragma unroll 16
    for (int kk = 0; kk < 32; ++kk) { const f32x4 w = *(const f32x4*)(wp + (size_t)kk * ldw);
#pragma unroll
        for (int c = 0; c < 5; ++c) acc[c] += sc[c * 1024 + kg * 32 + kk] * w; }
#pragma unroll
    for (int c = 0; c < 5; ++c) *(LAS f32x4*)(red + (kg * 5 + c) * 64 + cgi * 4) = acc[c];
    __syncthreads();
    if (tid < 320) { const int cond = tid >> 6, col = tid & 63; float sm = bias ? bias[colo + col] : 0.f;
        for (int g = 0; g < 32; ++g) sm += red[(g * 5 + cond) * 64 + col];
        out[(size_t)cond * ldo + colo + col] = sm; }
    __syncthreads();
}
__device__ __forceinline__ void mod_item(CKP& p, LAS unsigned char* lds, int it) {
    const int tid = opaque_tid(); unsigned char* ws = p.ws;
    LAS float* sc = (LAS float*)lds; LAS float* red = (LAS float*)(lds + 20480);
    const int l = it / 96, cgp = it % 96;
    for (int i = tid; i < 5 * 1024; i += NTHR) { const int cond = i >> 10, k = i & 1023; const float v = cond == 0 ? p.in[I_CCTX][k] : p.in[I_C][(cond - 1) * 1024 + k]; sc[i] = v * fsigmoid(v); }
    __syncthreads();
    gemv5_cols(sc, red, p.in[I_WADA] + (size_t)l * 1024 * 6144, 6144, cgp * 64, p.in[I_BADA] + l * 6144, (float*)(ws + WS_MOD) + (size_t)l * 5 * 6144, 6144, cgp * 64, tid);
}
constexpr int TI_IN = 16 * 76, TI_OUT = 16 * 32, TI_1 = 16 * 128, TI_2 = 64 * 32, TI_L = TI_IN + TI_OUT + TI_1 + TI_2;
struct TrItem { const float* src; bf16* dst; const float* shv; float* sw; int N, K, swld; };
__device__ __forceinline__ TrItem tr_decode(CKP& p, int it) {
    unsigned char* ws = p.ws; const int l = it / TI_L; int r = it % TI_L;
    const float* W; bf16* WT; int K, N; const float* shv = nullptr; float* sw = nullptr; int swld = 0;
    if (r < TI_IN) { W = p.in[I_WIN] + (size_t)l * DM * DIN; K = DM; N = DIN; WT = (bf16*)(ws + WS_WIN) + (size_t)l * DINP * DM;
        if (l == 1) { shv = (const float*)(ws + WS_MOD) + (size_t)5 * 6144; sw = (float*)(ws + WS_SWIN); swld = DINP; } }
    else if ((r -= TI_IN) < TI_OUT) { W = p.in[I_WOUT] + (size_t)l * DM * DM; K = DM; N = DM; WT = (bf16*)(ws + WS_WOUT) + (size_t)l * DM * DM; }
    else if ((r -= TI_OUT) < TI_1) { W = p.in[I_WFF1] + (size_t)l * DM * DFF; K = DM; N = DFF; WT = (bf16*)(ws + WS_W1) + (size_t)l * DFF * DM;
        shv = (const float*)(ws + WS_MOD) + (size_t)l * 5 * 6144 + 3 * 1024; sw = (float*)(ws + WS_SW1) + (size_t)l * 5 * DFF; swld = DFF; }
    else { r -= TI_1; W = p.in[I_WFF2] + (size_t)l * DFF * DM; K = DFF; N = DM; WT = (bf16*)(ws + WS_W2) + (size_t)l * DM * DFF; }
    const int nblk = N / 32, k0 = 64 * (r / nblk), n0 = 32 * (r % nblk);
    return TrItem{W + (size_t)k0 * N + n0, WT + (size_t)n0 * K + k0, shv ? shv + k0 : nullptr, sw ? sw + n0 : nullptr, N, K, swld};
}
__device__ __forceinline__ void transpose_range(CKP& p, LAS unsigned char* lds, int first, int last, int bid, int nb) {
    const int tid = opaque_tid(), lane = tid & 63, wave = tid >> 6;
    LAS float* scr = (LAS float*)(lds + wave * 16384);
    int it = first + bid * 8 + wave;
    if (it >= last) return;
    TrItem cur = tr_decode(p, it);
    float tv[32];
#pragma unroll
    for (int i = 0; i < 32; ++i) tv[i] = cur.src[(size_t)(2 * i + (lane >> 5)) * cur.N + (lane & 31)];
#pragma unroll 1
    for (;;) {
        const int c = lane & 7;
        f32x4 sv[5][2];
        if (cur.shv) {
#pragma unroll
            for (int cd = 0; cd < 5; ++cd) { sv[cd][0] = *(const f32x4*)(cur.shv + cd * 6144 + 8 * c); sv[cd][1] = *(const f32x4*)(cur.shv + cd * 6144 + 8 * c + 4); } }
#pragma unroll
        for (int i = 0; i < 32; ++i) scr[(2 * i + (lane >> 5)) * 33 + (lane & 31)] = tv[i];
        const int nit = it + nb * 8; const bool more = nit < last;
        const TrItem nxt = tr_decode(p, more ? nit : it);
        if (more) {
#pragma unroll
            for (int i = 0; i < 32; ++i) tv[i] = nxt.src[(size_t)(2 * i + (lane >> 5)) * nxt.N + (lane & 31)]; }
        asm volatile("s_waitcnt lgkmcnt(0)" ::: "memory");
        if (cur.shv) {
#pragma unroll
            for (int j = 0; j < 4; ++j) { const int n = (lane >> 3) + 8 * j; const LAS float* sp = scr + (8 * c) * 33 + n;
                float v[8];
#pragma unroll
                for (int kk = 0; kk < 8; ++kk) v[kk] = sp[kk * 33];
                u32x4 o; o.x = pk2(v[0], v[1]); o.y = pk2(v[2], v[3]); o.z = pk2(v[4], v[5]); o.w = pk2(v[6], v[7]);
                *(u32x4*)(cur.dst + (size_t)n * cur.K + 8 * c) = o;
#pragma unroll
                for (int cd = 0; cd < 5; ++cd) {
                    float d = ((v[0] * sv[cd][0][0] + v[1] * sv[cd][0][1]) + (v[2] * sv[cd][0][2] + v[3] * sv[cd][0][3])) + ((v[4] * sv[cd][1][0] + v[5] * sv[cd][1][1]) + (v[6] * sv[cd][1][2] + v[7] * sv[cd][1][3]));
                    d += dppf<0xB1>(d); d += dppf<0x4E>(d); d += dppf<0x141>(d);
                    if (c == 0) atomicAdd(cur.sw + cd * cur.swld + n, d); } }
        } else {
#pragma unroll
            for (int j = 0; j < 4; ++j) { const int n = (lane >> 3) + 8 * j; const LAS float* sp = scr + (8 * c) * 33 + n;
                u32x4 o; o.x = pk2(sp[0 * 33], sp[1 * 33]); o.y = pk2(sp[2 * 33], sp[3 * 33]); o.z = pk2(sp[4 * 33], sp[5 * 33]); o.w = pk2(sp[6 * 33], sp[7 * 33]);
                *(u32x4*)(cur.dst + (size_t)n * cur.K + 8 * c) = o; }
        }
        asm volatile("s_waitcnt lgkmcnt(0)" ::: "memory");
        if (!more) break;
        cur = nxt; it = nit;
    }
}
__device__ __forceinline__ void stage_prologue(CKP& p, LAS unsigned char* lds, int bid, int nb) {
    const int tid = opaque_tid();
    unsigned char* ws = p.ws;
    transpose_range(p, lds, 0, TI_IN, bid, nb);
    const int gt = bid * NTHR + tid, NGT = nb * NTHR;
#pragma unroll 1
    for (int i = gt; i < 2 * 128 * DM / 8; i += NGT) { const int l = i / (128 * DM / 8), r = i % (128 * DM / 8);
        u32x4 z = (u32x4){0u, 0u, 0u, 0u}; asm volatile("" : "+v"(z));
        *(u32x4*)((bf16*)(ws + WS_WIN) + (size_t)l * DINP * DM + (size_t)DIN * DM + (size_t)r * 8) = z; }
#pragma unroll 1
    for (int i = gt; i < (5 * DINP + 2 * 5 * DFF) / 4; i += NGT) { f32x4 z = (f32x4){0.f, 0.f, 0.f, 0.f}; asm volatile("" : "+v"(z));
        if (i < 5 * DINP / 4) ((f32x4*)(ws + WS_SWIN))[i] = z; else ((f32x4*)(ws + WS_SW1))[i - 5 * DINP / 4] = z; }
    __syncthreads();
#pragma unroll 1
    for (int it = bid; it < 192; it += nb) mod_item(p, lds, it);
}
__device__ __forceinline__ void stage_tables(CKP& p, int bid, int nb) {
    const int tid = opaque_tid(); unsigned char* ws = p.ws;
    const int gt = bid * NTHR + tid, NGT = nb * NTHR;
#pragma unroll 1
    for (int i = gt; i < 256 * 512 + 1024 * 2048; i += NGT) {
        int L, k, j; bf16* dst;
        if (i < 256 * 512) { L = 256; k = i / 512; j = i % 512; dst = (bf16*)(ws + WS_CS256) + i; }
        else { const int i2 = i - 256 * 512; L = 1024; k = i2 / 2048; j = i2 % 2048; dst = (bf16*)(ws + WS_CS1024) + i2; }
        const int jj = j >= L ? j - L : j; const int idx = (k * jj) & (L - 1);
        const float rev = (float)idx * (L == 256 ? (1.0f / 256.0f) : (1.0f / 1024.0f));
        *dst = (bf16)f2bf(j >= L ? -__builtin_amdgcn_sinf(rev) : __builtin_amdgcn_cosf(rev));
    }
#pragma unroll 1
    for (int i = gt; i < 2 * 4 * 64 * 128; i += NGT) {
        const int o = i & 127, c = (i >> 7) & 63, lg = i >> 13; const float* wf = p.in[I_WFNET] + (size_t)lg * 4096 + (o & 63);
        float acc = 0.f;
#pragma unroll 1
        for (int cp0 = 0; cp0 < 64; cp0 += 16) { float wv[16];
#pragma unroll
            for (int e = 0; e < 16; ++e) wv[e] = wf[(cp0 + e) * 64];
#pragma unroll
            for (int e = 0; e < 16; ++e) { const float rev = (float)((c * (cp0 + e)) & 63) * (1.0f / 64.0f) + (o < 64 ? 0.25f : 0.f);
                acc += __builtin_amdgcn_sinf(rev) * wv[e]; } }
        ((bf16*)(ws + WS_FW))[(size_t)(lg * 128 + o) * 64 + c] = (bf16)f2bf(acc);
    }
#pragma unroll 1
    for (int i = gt; i < 2 * 4 * 64 * 64; i += NGT) { const int o = i & 63, c = (i >> 6) & 63, lg = i >> 12;
        ((bf16*)(ws + WS_WPT))[(size_t)(lg * 64 + o) * 64 + c] = (bf16)f2bf(p.in[I_WPOOL][i]); }
#pragma unroll 1
    for (int i = gt; i < 2 * 2 * 64 * 512; i += NGT) { const int c = i & 511, r = (i >> 9) & 63, ld = i >> 15;
        ((bf16*)(ws + WS_WUPT))[(size_t)(ld * 512 + c) * 64 + r] = (bf16)f2bf(p.in[I_WUP][i]);
        ((bf16*)(ws + WS_AUPT))[(size_t)(ld * 512 + c) * 64 + r] = (bf16)f2bf(p.in[I_AUP][i]); }
#pragma unroll 1
    for (int i = gt; i < 2 * 128 * 512; i += NGT) { const int c = i & 511, r = (i >> 9) & 127, ll = i >> 16;
        ((bf16*)(ws + WS_GUPT))[(size_t)(ll * 512 + c) * 128 + r] = (bf16)f2bf(p.in[I_GUP][i]); }
}
__device__ __forceinline__ void side_queue(CKP& p, LAS unsigned char* lds, int qi, int nsh, int first, int csz, int nch) {
    const int tid = opaque_tid();
    unsigned* ctr = (unsigned*)(p.ws + WS_CTL + 524288) + 64 * qi;
    volatile LAS unsigned* slot = (volatile LAS unsigned*)(lds + RING_BYTES + 64);
    __syncthreads();
#pragma unroll 1
    for (;;) {
        if (tid == 0) *slot = atomicAdd(ctr, 1u);
        __syncthreads();
        const int it = (int)*slot;
        __syncthreads();
        if (it >= nsh + nch) break;
        { const int c0 = first + csz * (it - nsh); transpose_range(p, lds, c0, c0 + csz, 0, 1); }
        __syncthreads();
    }
}

__device__ __forceinline__ void stage_norm(CKP& p, int l, int which, int bid, int nb) {
    const int tid = opaque_tid(), lane = tid & 63, wave = tid >> 6;
    const float* g = p.in[which ? I_N2G : I_N1G] + l * DM;
    const float* mod = (const float*)(p.ws + WS_MOD) + (size_t)l * 5 * 6144 + (which ? 3 * 1024 : 0);
    bf16* H = (bf16*)(p.ws + WS_H);
#pragma unroll 1
    for (int row0 = bid * 8 + wave; row0 < MTOK; row0 += nb * 16) {
        f32x4 v[2][4]; float s[2];
#pragma unroll
        for (int z = 0; z < 2; ++z) { const int row = min(row0 + z * nb * 8, MTOK - 1);
            const float* xsrc = (l == 0 && which == 0) ? (row < NCTX ? p.in[I_XP] + (size_t)row * DM : p.in[I_XS] + (size_t)(row - NCTX) * DM) : p.out + (size_t)row * DM;
            const f32x4* xr = (const f32x4*)xsrc + lane;
#pragma unroll
            for (int j = 0; j < 4; ++j) v[z][j] = xr[64 * j]; }
#pragma unroll
        for (int z = 0; z < 2; ++z) { const int row = row0 + z * nb * 8;
            s[z] = 0.f;
#pragma unroll
            for (int j = 0; j < 4; ++j) s[z] += (v[z][j].x * v[z][j].x + v[z][j].y * v[z][j].y) + (v[z][j].z * v[z][j].z + v[z][j].w * v[z][j].w);
            const float rstd = frsq(wave_sum(s[z]) * (1.0f / DM) + 1e-6f);
            if (row < MTOK) {
                const int cond = row < NCTX ? 0 : 1 + ((row - NCTX) >> 10);
                const float* sh = mod + cond * 6144; const float* scl = sh + 1024;
                unsigned long long* o8 = (unsigned long long*)(H + (size_t)row * DM) + lane;
#pragma unroll
                for (int j = 0; j < 4; ++j) { const int col = 4 * lane + 256 * j; const f32x4 gg = *(const f32x4*)(g + col), a = *(const f32x4*)(sh + col), b = *(const f32x4*)(scl + col);
                    const f32x4 y = v[z][j] * rstd * gg * (b + 1.0f) + a;
                    o8[64 * j] = (unsigned long long)pk2(y.x, y.y) | ((unsigned long long)pk2(y.z, y.w) << 32); } } }
    }
}
__device__ __forceinline__ void stage_final(CKP& p, int bid, int nb) {
    const int tid = opaque_tid(), lane = tid & 63, wave = tid >> 6;
    const float* g = p.in[I_FNG];
    const bf16* XB = (const bf16*)(p.ws + WS_XB); const float* ssq = (const float*)(p.ws + WS_CTL + 262144) + 49152;
    const f32x4 g0 = *(const f32x4*)(g + 8 * lane), g1 = *(const f32x4*)(g + 8 * lane + 4), g2 = *(const f32x4*)(g + 512 + 8 * lane), g3 = *(const f32x4*)(g + 512 + 8 * lane + 4);
#pragma unroll 1
    for (int row = bid * 8 + wave; row < MTOK; row += nb * 8) {
        const float rstd = frsq(ssq[row] * (1.0f / DM) + 1e-6f);
        const u32x4 a = *(const u32x4*)(XB + (size_t)row * DM + 8 * lane), b = *(const u32x4*)(XB + (size_t)row * DM + 512 + 8 * lane);
        float* o = p.out + (size_t)row * DM + 8 * lane;
        *(f32x4*)o = (f32x4){bflo(a.x), bfhi(a.x), bflo(a.y), bfhi(a.y)} * rstd * g0; *(f32x4*)(o + 4) = (f32x4){bflo(a.z), bfhi(a.z), bflo(a.w), bfhi(a.w)} * rstd * g1;
        *(f32x4*)(o + 512) = (f32x4){bflo(b.x), bfhi(b.x), bflo(b.y), bfhi(b.y)} * rstd * g2; *(f32x4*)(o + 516) = (f32x4){bflo(b.z), bfhi(b.z), bflo(b.w), bfhi(b.w)} * rstd * g3;
    }
}


typedef short bf16x8 __attribute__((ext_vector_type(8)));
typedef float f32x2v __attribute__((ext_vector_type(2)));
typedef __bf16 bf16x2v __attribute__((ext_vector_type(2)));
#define MFMA16(a, b, c) __builtin_amdgcn_mfma_f32_16x16x32_bf16((a), (b), (c), 0, 0, 0)
__device__ __forceinline__ unsigned cvt2(float lo, float hi) { f32x2v v = {lo, hi}; bf16x2v b = __builtin_convertvector(v, bf16x2v); return __builtin_bit_cast(unsigned, b); }
__device__ __forceinline__ u32x4 pack8(const float (&x)[8]) { u32x4 w; w.x = cvt2(x[0], x[1]); w.y = cvt2(x[2], x[3]); w.z = cvt2(x[4], x[5]); w.w = cvt2(x[6], x[7]); return w; }
__device__ __forceinline__ void shift8(const bf16* proj, int row, bool hasp, bool hasn, int col, const float* mu, float (&u)[8]) {
    float p[8], a[8], b[8];
    load8bf(proj + (size_t)row * DINP + col, p);
    if (hasp) load8bf(proj + (size_t)(row - 1) * DINP + col, a); else {
#pragma unroll
        for (int j = 0; j < 8; ++j) a[j] = 0.f; }
    if (hasn) load8bf(proj + (size_t)(row + 1) * DINP + col, b); else {
#pragma unroll
        for (int j = 0; j < 8; ++j) b[j] = 0.f; }
    const f32x4 m0 = *(const f32x4*)(mu + col), m1 = *(const f32x4*)(mu + col + 4);
#pragma unroll
    for (int j = 0; j < 4; ++j) { u[j] = p[j] + m0[j] * (0.5f * (a[j] + b[j]) - p[j]); u[4 + j] = p[4 + j] + m1[j] * (0.5f * (a[4 + j] + b[4 + j]) - p[4 + j]); }
}
__device__ __forceinline__ int opq(int x) { asm volatile("" : "+v"(x)); return x; }
constexpr int TS = 72, TB = 64 * TS * 2;
constexpr int L_HT = 0, L_TW = 9216, L_AD = 18432, L_LP = 27648, L_AP = 45056, L_AT = 62464, L_RT = L_AT + TB, L_BH = L_RT + TB, L_KH = L_BH + TB, L_VR = L_KH + TB, L_YS = L_VR + TB;
constexpr int L_AAB = L_TW, L_AAK = L_AAB + 4096, L_ARB = L_AAK + 3072, L_ARK = L_ARB + 3072, L_UT = L_ARK + 3072, L_W1 = L_AP;
static_assert(L_UT + 64 * 24 * 2 <= L_LP && L_YS + 17408 <= RING_BYTES, "scan LDS map");
constexpr int LPS = 68;
#define LBAR() asm volatile("s_waitcnt lgkmcnt(0)\n\ts_barrier" ::: "memory")
typedef short s16x4v __attribute__((ext_vector_type(4)));
__device__ __forceinline__ bf16x8 tr8(const LAS bf16* p) {
    const s16x4v lo = __builtin_bit_cast(s16x4v, __builtin_amdgcn_ds_read_tr16_b64_v4i16((LAS s16x4v*)p));
    const s16x4v hi = __builtin_bit_cast(s16x4v, __builtin_amdgcn_ds_read_tr16_b64_v4i16((LAS s16x4v*)(p + 4 * TS)));
    return (bf16x8){lo[0], lo[1], lo[2], lo[3], hi[0], hi[1], hi[2], hi[3]};
}

__device__ __forceinline__ void rwkv_item3(CKP& p, int l, LAS unsigned char* lds, int item) {
    const int tid0 = opaque_tid(), w = __builtin_amdgcn_readfirstlane(tid0 >> 6);
    int tid = tid0, fr = tid & 15, fg = (tid & 63) >> 4;
    int bseq, h, dir, L, base; bool lat;
    if (item < 64) { lat = true; bseq = item >> 4; h = (item >> 1) & 7; dir = item & 1; L = 1024; base = NCTX + bseq * 1024; }
    else { const int i2 = item - 64; lat = false; bseq = i2 >> 4; h = (i2 >> 1) & 7; dir = i2 & 1; L = 256; base = bseq * 256; }
    const bf16* U = (const bf16*)(p.ws + WS_U);
    const float* KINV = (const float*)(p.ws + WS_KINV);
    bf16* Yout = (bf16*)(p.ws + (dir ? WS_YB : WS_YF));
    float* BC = (float*)(p.ws + WS_BC) + (size_t)dir * MTOK * 8;
    const bf16* wupt = (const bf16*)(p.ws + WS_WUPT) + ((size_t)(l * 2 + dir) * 512 + h * 64) * 64;
    const bf16* aupt = (const bf16*)(p.ws + WS_AUPT) + ((size_t)(l * 2 + dir) * 512 + h * 64) * 64;

    LAS float* LP = (LAS float*)(lds + L_LP); LAS float* AP = (LAS float*)(lds + L_AP); LAS float* AS = (LAS float*)(lds + L_TW);
    LAS bf16* AT = (LAS bf16*)(lds + L_AT);   LAS bf16* RT = (LAS bf16*)(lds + L_RT);   LAS bf16* BH = (LAS bf16*)(lds + L_BH);   LAS bf16* KH = (LAS bf16*)(lds + L_KH);
    LAS bf16* VR = (LAS bf16*)(lds + L_VR);   LAS float* YS = (LAS float*)(lds + L_YS);
    LAS float* AAB = (LAS float*)(lds + L_AAB); LAS bf16* AAK = (LAS bf16*)(lds + L_AAK); LAS bf16* ARB = (LAS bf16*)(lds + L_ARB); LAS bf16* ARK = (LAS bf16*)(lds + L_ARK); LAS bf16* AAK1 = (LAS bf16*)(lds + L_UT);
    LAS float* W1 = (LAS float*)(lds + L_W1);
    const int tv = w & 3;
    f32x4 hacc[4];
#pragma unroll
    for (int x = 0; x < 4; ++x) {
        if (lat && w < 4) hacc[x] = *(const f32x4*)(p.in[I_STATE] + ((((size_t)bseq * 2 + l) * 2 + dir) * 8 + h) * 4096 + (16 * tv + fr) * 64 + 16 * x + 4 * fg);
        else hacc[x] = (f32x4){0.f, 0.f, 0.f, 0.f}; }
    int ei = tid >> 3, ec8 = (tid & 7) * 8; const int hc8 = h * 64 + ec8;
    float kkp[8], kap[8], rkp[8];
#pragma unroll
    for (int e = 0; e < 8; ++e) { kkp[e] = p.in[I_KK][l * 512 + hc8 + e]; kap[e] = p.in[I_KA][l * 512 + hc8 + e]; rkp[e] = p.in[I_RK][l * 512 + hc8 + e]; }
#define SCAN_PREFETCH(SC) do { const int _t0 = opq(tid0), _ei = _t0 >> 3, _ec8 = (_t0 & 7) * 8; const int _step = (SC) * 64 + _ei, _t = dir ? L - 1 - _step : _step; \
        const bf16* _u = U + (size_t)(base + _t) * 1920; \
        nr = *(const u32x4*)(_u + R_OFF + h * 64 + _ec8); nk = *(const u32x4*)(_u + K_OFF + h * 64 + _ec8); nv = *(const u32x4*)(_u + V_OFF + h * 64 + _ec8); \
        ninv = KINV[(size_t)(base + _t) * 8 + h]; \
        const int _st2 = (SC) * 64 + 16 * (w >> 1) + (_t0 & 15), _t2 = dir ? L - 1 - _st2 : _st2; const bf16* _u2 = U + (size_t)(base + _t2) * 1920 + dir * 64 + ((_t0 & 63) >> 4) * 8; \
        paw0 = *(const bf16x8*)(_u2 + WD_OFF); paw1 = *(const bf16x8*)(_u2 + WD_OFF + 32); paa0 = *(const bf16x8*)(_u2 + AD_OFF); paa1 = *(const bf16x8*)(_u2 + AD_OFF + 32); } while (0)
    bf16x8 lbw[2][2], lba[2][2]; float lw0c[2], la0c[2];
#pragma unroll
    for (int x = 0; x < 2; ++x) { const int c = ((w & 1) * 2 + x) * 16 + fr;
        lbw[x][0] = *(const bf16x8*)(wupt + c * 64 + fg * 8); lbw[x][1] = *(const bf16x8*)(wupt + c * 64 + 32 + fg * 8);
        lba[x][0] = *(const bf16x8*)(aupt + c * 64 + fg * 8); lba[x][1] = *(const bf16x8*)(aupt + c * 64 + 32 + fg * 8);
        lw0c[x] = p.in[I_W0][(l * 2 + dir) * 512 + h * 64 + c]; la0c[x] = p.in[I_A0][(l * 2 + dir) * 512 + h * 64 + c]; }
    u32x4 nr, nk, nv; float ninv; bf16x8 paw0, paw1, paa0, paa1;
    SCAN_PREFETCH(0);
    __syncthreads();
#pragma unroll 1
    for (int sc = 0; sc < L / 64; ++sc) {
        tid = opq(tid0); fr = tid & 15; fg = (tid & 63) >> 4; ei = tid >> 3; ec8 = (tid & 7) * 8;
        const u32x4 cr = nr, ck = nk, cv = nv; const float kinv = ninv;
        { const int ti = w >> 1;
          const bf16x8 aw0 = paw0, aw1 = paw1, aa0 = paa0, aa1 = paa1;
          unsigned li[2];
#pragma unroll
          for (int pr = 0; pr < 2; ++pr) { const int j0 = 4 * fg + 2 * pr, j1 = j0 + 1; li[pr] = (j0 <= fr ? 0x3f80u : 0u) | (j1 <= fr ? 0x3f800000u : 0u); }
          const bf16x8 Li = __builtin_bit_cast(bf16x8, (u32x4){li[0], li[1], 0u, 0u});
#pragma unroll
          for (int x = 0; x < 2; ++x) { const int c = ((w & 1) * 2 + x) * 16 + fr;
              f32x4 cw = (f32x4){lw0c[x], lw0c[x], lw0c[x], lw0c[x]}, ca = (f32x4){la0c[x], la0c[x], la0c[x], la0c[x]};
              cw = MFMA16(aw0, lbw[x][0], cw); cw = MFMA16(aw1, lbw[x][1], cw); ca = MFMA16(aa0, lba[x][0], ca); ca = MFMA16(aa1, lba[x][1], ca);
              float lw[4], lo[4];
#pragma unroll
              for (int r = 0; r < 4; ++r) lw[r] = -0.6065306597126334f * fsigmoid(cw[r]);
              const unsigned h01 = cvt2(lw[0], lw[1]), h23 = cvt2(lw[2], lw[3]);
              lo[0] = lw[0] - bflo(h01); lo[1] = lw[1] - bfhi(h01); lo[2] = lw[2] - bflo(h23); lo[3] = lw[3] - bfhi(h23);
              const bf16x8 bh = __builtin_bit_cast(bf16x8, (u32x4){h01, h23, 0u, 0u}), bl = __builtin_bit_cast(bf16x8, (u32x4){cvt2(lo[0], lo[1]), cvt2(lo[2], lo[3]), 0u, 0u});
              f32x4 ci = (f32x4){0.f, 0.f, 0.f, 0.f};
              ci = MFMA16(Li, bh, ci); ci = MFMA16(Li, bl, ci);
#pragma unroll
              for (int r = 0; r < 4; ++r) { const int o = (ti * 16 + 4 * fg + r) * LPS + c;
                  LP[o] = fexp(ci[r]); AS[o] = fsigmoid(ca[r]); } } }
        __syncthreads();
        tid = opq(tid0); fr = tid & 15; fg = (tid & 63) >> 4; ei = tid >> 3; ec8 = (tid & 7) * 8;
        float bcv;
        { const f32x4 g0 = *(const LAS f32x4*)(LP + ei * LPS + ec8), g1 = *(const LAS f32x4*)(LP + ei * LPS + ec8 + 4);
          const int ip = (ei & 15) ? ei - 1 : ei;
          f32x4 p0 = *(const LAS f32x4*)(LP + ip * LPS + ec8), p1 = *(const LAS f32x4*)(LP + ip * LPS + ec8 + 4);
          if ((ei & 15) == 0) { p0 = (f32x4){1.f, 1.f, 1.f, 1.f}; p1 = p0; }
          const f32x4 s0 = *(const LAS f32x4*)(AS + ei * LPS + ec8), s1 = *(const LAS f32x4*)(AS + ei * LPS + ec8 + 4);
          float rr[8], kk[8], xa[8], xr[8], xb[8], xk[8], bc = 0.f;
          rr[0] = bflo(cr.x); rr[1] = bfhi(cr.x); rr[2] = bflo(cr.y); rr[3] = bfhi(cr.y); rr[4] = bflo(cr.z); rr[5] = bfhi(cr.z); rr[6] = bflo(cr.w); rr[7] = bfhi(cr.w);
          kk[0] = bflo(ck.x); kk[1] = bfhi(ck.x); kk[2] = bflo(ck.y); kk[3] = bfhi(ck.y); kk[4] = bflo(ck.z); kk[5] = bfhi(ck.z); kk[6] = bflo(ck.w); kk[7] = bfhi(ck.w);
#pragma unroll
          for (int e = 0; e < 8; ++e) { const float gi = e < 4 ? g0[e & 3] : g1[e & 3], gp = e < 4 ? p0[e & 3] : p1[e & 3], asg = e < 4 ? s0[e & 3] : s1[e & 3];
              const float kj = kk[e] * kkp[e] * kinv, kd = kk[e] * (1.0f + (asg - 1.0f) * kap[e]), ginv = frcp(gi);
              bc += rr[e] * kd * rkp[e];
              xa[e] = -kj * gp; xr[e] = rr[e] * gi; xb[e] = kj * asg * ginv; xk[e] = kd * ginv; }
          bcv = red8(bc);
          *(LAS u32x4*)(AT + ei * TS + ec8) = pack8(xa); *(LAS u32x4*)(RT + ei * TS + ec8) = pack8(xr); *(LAS u32x4*)(BH + ei * TS + ec8) = pack8(xb); *(LAS u32x4*)(KH + ei * TS + ec8) = pack8(xk);
          *(LAS u32x4*)(VR + ei * TS + ec8) = cv; }
        __syncthreads();
        tid = opq(tid0); fr = tid & 15; fg = (tid & 63) >> 4;
        { const int q = w >> 1, half = w & 1; const LAS bf16* Asrc = half ? RT : AT;
          const bf16x8 af0 = *(const LAS bf16x8*)(Asrc + (16 * q + fr) * TS + fg * 8), af1 = *(const LAS bf16x8*)(Asrc + (16 * q + fr) * TS + 32 + fg * 8);
          const bf16x8 bb0 = *(const LAS bf16x8*)(BH + (16 * q + fr) * TS + fg * 8), bb1 = *(const LAS bf16x8*)(BH + (16 * q + fr) * TS + 32 + fg * 8);
          const bf16x8 bk0 = *(const LAS bf16x8*)(KH + (16 * q + fr) * TS + fg * 8), bk1 = *(const LAS bf16x8*)(KH + (16 * q + fr) * TS + 32 + fg * 8);
          LAS bf16* myak = half ? AAK1 : AAK;
          f32x4 cx = (f32x4){0.f, 0.f, 0.f, 0.f}, ck2 = cx, cak = cx;
          cx = MFMA16(af0, bb0, cx); cx = MFMA16(af1, bb1, cx);
          ck2 = MFMA16(af0, bk0, ck2); ck2 = MFMA16(af1, bk1, ck2);
          if (half) { const bf16x8 at0 = *(const LAS bf16x8*)(AT + (16 * q + fr) * TS + fg * 8), at1 = *(const LAS bf16x8*)(AT + (16 * q + fr) * TS + 32 + fg * 8);
              cak = MFMA16(at0, bk0, cak); cak = MFMA16(at1, bk1, cak); }
          else cak = ck2;
          f32x4 mx, mk, mak;
#pragma unroll
          for (int r = 0; r < 4; ++r) { const int i = 4 * fg + r, j = fr; const bool lo = half ? j <= i : j < i; mx[r] = lo ? cx[r] : 0.f; mk[r] = lo ? ck2[r] : 0.f; mak[r] = j < i ? cak[r] : 0.f; }
          if (half == 0) *(LAS f32x4*)(AAB + (q * 16 + fr) * 16 + 4 * fg) = mx;
#pragma unroll
          for (int r = 0; r < 4; ++r) { const int o = (q * 16 + 4 * fg + r) * 24 + fr;
              if (half) { ARB[o] = (bf16)(cvt2(mx[r], 0.f) & 0xffffu); ARK[o] = (bf16)(cvt2(mk[r], 0.f) & 0xffffu); }
              myak[o] = (bf16)(cvt2(mak[r], 0.f) & 0xffffu); }
          {
              const unsigned kmask = fg < 2 ? 0xffffffffu : 0u;
              const bf16x8 afr = *(const LAS bf16x8*)(myak + (q * 16 + fr) * 24 + (fg & 1) * 8);
              const bf16x8 af = __builtin_bit_cast(bf16x8, __builtin_bit_cast(u32x4, afr) & kmask);
#pragma unroll
              for (int x = 0; x < 2; ++x) { const int tvv = 2 * half + x;
                  const bf16x8 bfr = tr8(VR + (16 * q + 8 * (fg & 1) + (fr >> 2)) * TS + 16 * tvv + 4 * (fr & 3));
                  const bf16x8 bfv = __builtin_bit_cast(bf16x8, __builtin_bit_cast(u32x4, bfr) & kmask);
                  f32x4 c = (f32x4){0.f, 0.f, 0.f, 0.f}; c = MFMA16(af, bfv, c);
#pragma unroll
                  for (int r = 0; r < 4; ++r) W1[(q * 16 + 4 * fg + r) * LPS + 16 * tvv + fr] = c[r]; } } }
        __syncthreads();
        tid = opq(tid0);
        if (w < 4) { const int q = w, col = tid & 63; float x[16], z[16];
#pragma unroll
          for (int i = 0; i < 16; ++i) { x[i] = bf1(AT[(16 * q + i) * TS + col]); z[i] = W1[(q * 16 + i) * LPS + col]; }
#pragma unroll
          for (int j = 0; j < 15; ++j) {
              const LAS f32x4* ac = (const LAS f32x4*)(AAB + (q * 16 + j) * 16);
#pragma unroll
              for (int i4 = (j + 1) / 4; i4 < 4; ++i4) { const f32x4 a4 = ac[i4];
#pragma unroll
                  for (int e = 0; e < 4; ++e) if (i4 * 4 + e > j) { x[i4 * 4 + e] += a4[e] * x[j]; z[i4 * 4 + e] += a4[e] * z[j]; } } }
#pragma unroll
          for (int i = 0; i < 16; ++i) { AT[(16 * q + i) * TS + col] = (bf16)(cvt2(x[i], 0.f) & 0xffffu); W1[(q * 16 + i) * LPS + col] = z[i]; } }
        __syncthreads();
        if (sc + 1 < L / 64) SCAN_PREFETCH(sc + 1);
        if (w < 4) {
        tid = opq(tid0); fr = tid & 15; fg = (tid & 63) >> 4;
#pragma unroll
        for (int q = 0; q < 4; ++q) {
            bf16x8 hb[2];
#pragma unroll
            for (int ks = 0; ks < 2; ++ks) { u32x4 t; t.x = cvt2(hacc[2 * ks][0], hacc[2 * ks][1]); t.y = cvt2(hacc[2 * ks][2], hacc[2 * ks][3]);
                t.z = cvt2(hacc[2 * ks + 1][0], hacc[2 * ks + 1][1]); t.w = cvt2(hacc[2 * ks + 1][2], hacc[2 * ks + 1][3]); hb[ks] = __builtin_bit_cast(bf16x8, t); }
            bf16x8 aU[2], aR[2];
#pragma unroll
            for (int ks = 0; ks < 2; ++ks) {
                const u32x2 a0 = *(const LAS u32x2*)(AT + (16 * q + fr) * TS + 32 * ks + 4 * fg), a1 = *(const LAS u32x2*)(AT + (16 * q + fr) * TS + 32 * ks + 16 + 4 * fg);
                const u32x2 r0 = *(const LAS u32x2*)(RT + (16 * q + fr) * TS + 32 * ks + 4 * fg), r1 = *(const LAS u32x2*)(RT + (16 * q + fr) * TS + 32 * ks + 16 + 4 * fg);
                aU[ks] = __builtin_bit_cast(bf16x8, (u32x4){a0.x, a0.y, a1.x, a1.y}); aR[ks] = __builtin_bit_cast(bf16x8, (u32x4){r0.x, r0.y, r1.x, r1.y}); }
            f32x4 u, yacc = (f32x4){0.f, 0.f, 0.f, 0.f};
#pragma unroll
            for (int r = 0; r < 4; ++r) u[r] = W1[(q * 16 + 4 * fg + r) * LPS + 16 * tv + fr];
            u = MFMA16(aU[0], hb[0], u); u = MFMA16(aU[1], hb[1], u);
            yacc = MFMA16(aR[0], hb[0], yacc); yacc = MFMA16(aR[1], hb[1], yacc);
            const s16x4v vtr = __builtin_bit_cast(s16x4v, __builtin_amdgcn_ds_read_tr16_b64_v4i16((LAS s16x4v*)(VR + (16 * q + 4 * fg + (fr >> 2)) * TS + 16 * tv + 4 * (fr & 3))));
            const u32x2 vt2 = __builtin_bit_cast(u32x2, vtr);
            const bf16x8 bUV = __builtin_bit_cast(bf16x8, (u32x4){cvt2(u[0], u[1]), cvt2(u[2], u[3]), vt2.x, vt2.y});
            { const u32x2 y0 = *(const LAS u32x2*)(ARB + (q * 16 + fr) * 24 + 4 * fg), y1 = *(const LAS u32x2*)(ARK + (q * 16 + fr) * 24 + 4 * fg);
              yacc = MFMA16(__builtin_bit_cast(bf16x8, (u32x4){y0.x, y0.y, y1.x, y1.y}), bUV, yacc); }
#pragma unroll
            for (int r = 0; r < 4; ++r) YS[(16 * q + 4 * fg + r) * LPS + 16 * tv + fr] = yacc[r];
#pragma unroll
            for (int x = 0; x < 4; ++x) {
                const s16x4v bt = __builtin_bit_cast(s16x4v, __builtin_amdgcn_ds_read_tr16_b64_v4i16((LAS s16x4v*)(BH + (16 * q + 4 * fg + (fr >> 2)) * TS + 16 * x + 4 * (fr & 3))));
                const s16x4v kt = __builtin_bit_cast(s16x4v, __builtin_amdgcn_ds_read_tr16_b64_v4i16((LAS s16x4v*)(KH + (16 * q + 4 * fg + (fr >> 2)) * TS + 16 * x + 4 * (fr & 3))));
                const u32x2 b2 = __builtin_bit_cast(u32x2, bt), k2 = __builtin_bit_cast(u32x2, kt);
                const f32x4 ge = *(const LAS f32x4*)(LP + (16 * q + 15) * LPS + 16 * x + 4 * fg);
                hacc[x] = MFMA16(__builtin_bit_cast(bf16x8, (u32x4){b2.x, b2.y, k2.x, k2.y}), bUV, hacc[x]) * ge; }
        }
        }
        __syncthreads();
        tid = opq(tid0); ei = tid >> 3; ec8 = (tid & 7) * 8;
        { const int st2 = sc * 64 + ei, t2 = dir ? L - 1 - st2 : st2; bf16* yo = Yout + (size_t)(base + t2) * 512 + h * 64 + ec8;
          const f32x4 y0 = *(const LAS f32x4*)(YS + ei * LPS + ec8), y1 = *(const LAS f32x4*)(YS + ei * LPS + ec8 + 4);
          u32x4 yw; yw.x = cvt2(y0[0], y0[1]); yw.y = cvt2(y0[2], y0[3]); yw.z = cvt2(y1[0], y1[1]); yw.w = cvt2(y1[2], y1[3]);
          *(u32x4*)yo = yw;
          if ((tid & 7) == 0) BC[(size_t)(base + t2) * 8 + h] = bcv; }
    }
#undef SCAN_PREFETCH
    if (!lat && w < 4) {
#pragma unroll
        for (int x = 0; x < 4; ++x) *(f32x4*)(p.out + (size_t)MTOK * DM + ((((size_t)bseq * 2 + l) * 2 + dir) * 8 + h) * 4096 + (16 * tv + fr) * 64 + 16 * x + 4 * fg) = hacc[x]; }
    __syncthreads();
}

__device__ __forceinline__ void stage_upass(CKP& p, int l, int bid, int nb) {
    const int tid = opaque_tid(), sub = tid >= 240 ? 1 : 0, j = tid - sub * 240, col = 8 * j;
    const bf16* proj = (const bf16*)(p.ws + WS_PROJ); bf16* U = (bf16*)(p.ws + WS_U); float* KINV = (float*)(p.ws + WS_KINV);
    const float* mu = p.in[I_MU] + l * 1920;
    if (tid < 480) {
        const bool isk = col >= K_OFF && col < V_OFF;
        const float* kkp = p.in[I_KK] + l * 512 + (isk ? col - K_OFF : 0);
        const f32x4 k0 = *(const f32x4*)kkp, k1 = *(const f32x4*)(kkp + 4);
#pragma unroll 1
        for (int tok0 = bid * 2 + sub; tok0 < MTOK; tok0 += nb * 8) {
            float uu[4][8];
#pragma unroll
            for (int z = 0; z < 4; ++z) { const int tok = min(tok0 + z * nb * 2, MTOK - 1);
                const bool lat = tok >= NCTX; const int L = lat ? 1024 : 256, t = lat ? (tok - NCTX) & 1023 : tok & 255;
                shift8(proj, tok, t > 0, t < L - 1, col, mu, uu[z]); }
#pragma unroll
            for (int z = 0; z < 4; ++z) { const int tok = tok0 + z * nb * 2;
                float ss = 0.f;
#pragma unroll
                for (int e = 0; e < 8; ++e) { const float kn = uu[z][e] * (e < 4 ? k0[e & 3] : k1[e & 3]); ss += kn * kn; }
                ss = red8(ss);
                if (tok < MTOK) {
                    if (isk && (j & 7) == 0) KINV[(size_t)tok * 8 + ((col - K_OFF) >> 6)] = fminf(frsq(ss), 1e12f);
                    if (col >= WD_OFF && col < AD_OFF) {
#pragma unroll
                        for (int e = 0; e < 8; ++e) uu[z][e] = 1.0f - 2.0f * frcp(fexp(2.0f * uu[z][e]) + 1.0f); }
                    if (col >= GD_OFF) {
#pragma unroll
                        for (int e = 0; e < 8; ++e) uu[z][e] = fsigmoid(uu[z][e]); }
                    *(u32x4*)(U + (size_t)tok * 1920 + col) = pack8(uu[z]); } }
        }
    }
}

__device__ __forceinline__ void fnet1_item(CKP& p, int l, int item) {
    const int tid = opaque_tid(), lane = tid & 63, w = __builtin_amdgcn_readfirstlane(tid >> 6), fr = lane & 15, fg = lane >> 4;
    const int tb = item >> 2, g = item & 3, tok0 = tb * 64, tt = w & 3, cs = w >> 2;
    const bf16* proj = (const bf16*)(p.ws + WS_PROJ);
    const bf16* fwt = (const bf16*)(p.ws + WS_FW) + (size_t)((l * 4 + g) * 128 + cs * 64) * 64;
    const bf16* xr = proj + (size_t)(tok0 + 16 * tt + fr) * DINP + F_OFF + g * 64 + fg * 8;
    const bf16x8 a0 = *(const bf16x8*)xr, a1 = *(const bf16x8*)(xr + 32);
    const bool lat = tok0 >= NCTX;
    const int L = lat ? 1024 : 256, bq = lat ? (tok0 - NCTX) >> 10 : tok0 >> 8, t = (lat ? (tok0 - NCTX) & 1023 : tok0 & 255) + 16 * tt + 4 * fg;
    const float scale = lat ? (1.0f / 256.0f) : (1.0f / 128.0f);
    bf16* Y = (bf16*)(p.ws + WS_YCS) + (lat ? (size_t)8192 * 512 : 0);
#pragma unroll
    for (int ot = 0; ot < 4; ++ot) {
        const bf16x8 b0 = *(const bf16x8*)(fwt + (16 * ot + fr) * 64 + fg * 8), b1 = *(const bf16x8*)(fwt + (16 * ot + fr) * 64 + 32 + fg * 8);
        f32x4 c = (f32x4){0.f, 0.f, 0.f, 0.f}; c = MFMA16(a0, b0, c); c = MFMA16(a1, b1, c);
        u32x2 o; o.x = cvt2(c[0] * scale, c[1] * scale); o.y = cvt2(c[2] * scale, c[3] * scale);
        *(u32x2*)(Y + (size_t)((bq * 4 + g) * 64 + 16 * ot + fr) * (2 * L) + cs * L + t) = o; }
}

__device__ __forceinline__ void pool_item(CKP& p, int l, LAS unsigned char* lds, int item) {
    const int tid = opaque_tid(), tb = item >> 2, gi = item & 3, tok0 = tb * 64, hw = 1 << gi;
    const bf16* proj = (const bf16*)(p.ws + WS_PROJ);
    LAS bf16* DB = (LAS bf16*)lds;
    LAS float* CSUM = (LAS float*)(lds + 9216);
    const int ti = tid >> 3, c8 = (tid & 7) * 8, tok = tok0 + ti, col = P_OFF + gi * 64 + c8;
    { float sum[8], x[8];
#pragma unroll
      for (int j = 0; j < 8; ++j) sum[j] = 0.f;
      load8bf(proj + (size_t)tok * DINP + col, x);
      float cnt;
      if (tok < NCTX) { const int t = tok & 255, sb = tok - t, lo = max(t - hw, 0), hi = min(t + hw, 256);
          u32x4 wv[16];
#pragma unroll
          for (int q = 0; q < 16; ++q) { const int tq = min(t - hw + q, 255); wv[q] = (q < 2 * hw && tq >= 0) ? *(const u32x4*)(proj + (size_t)(sb + max(tq, 0)) * DINP + col) : (u32x4){0u, 0u, 0u, 0u}; }
#pragma unroll
          for (int q = 0; q < 16; ++q) if (q < 2 * hw) { const bool ok = t - hw + q >= 0 && t - hw + q < 256; const u32x4 w = wv[q];
              if (ok) { sum[0] += bflo(w.x); sum[1] += bfhi(w.x); sum[2] += bflo(w.y); sum[3] += bfhi(w.y); sum[4] += bflo(w.z); sum[5] += bfhi(w.z); sum[6] += bflo(w.w); sum[7] += bfhi(w.w); } }
          cnt = (float)(hi - lo); }
      else {
          const int t = (tok - NCTX) & 1023, sb = tok - t, r = t >> 6, c = t & 63, rlo = max(r - hw, 0), rhi = min(r + hw, 16), clo = max(c - hw, 0), chi = min(c + hw, 64);
          u32x4 wv[16];
#pragma unroll
          for (int q = 0; q < 16; ++q) { const int rq = r - hw + q; wv[q] = (q < 2 * hw && rq >= 0 && rq < 16) ? *(const u32x4*)(proj + (size_t)(sb + rq * 64 + c) * DINP + col) : (u32x4){0u, 0u, 0u, 0u}; }
#pragma unroll
          for (int q = 0; q < 16; ++q) { const u32x4 w = wv[q];
              sum[0] += bflo(w.x); sum[1] += bfhi(w.x); sum[2] += bflo(w.y); sum[3] += bfhi(w.y); sum[4] += bflo(w.z); sum[5] += bfhi(w.z); sum[6] += bflo(w.w); sum[7] += bfhi(w.w); }
          *(LAS f32x4*)(CSUM + ti * 68 + c8) = (f32x4){sum[0], sum[1], sum[2], sum[3]}; *(LAS f32x4*)(CSUM + ti * 68 + c8 + 4) = (f32x4){sum[4], sum[5], sum[6], sum[7]};
          __syncthreads();
#pragma unroll
          for (int j = 0; j < 8; ++j) sum[j] = 0.f;
          for (int cq = clo; cq < chi; ++cq) { const f32x4 a = *(const LAS f32x4*)(CSUM + cq * 68 + c8), b = *(const LAS f32x4*)(CSUM + cq * 68 + c8 + 4);
#pragma unroll
              for (int j = 0; j < 4; ++j) { sum[j] += a[j]; sum[4 + j] += b[j]; } }
          cnt = (float)((rhi - rlo) * (chi - clo)); }
      const float ic = frcp(cnt);
      float dd[8];
#pragma unroll
      for (int j = 0; j < 8; ++j) dd[j] = sum[j] * ic - x[j];
      *(LAS u32x4*)(DB + ti * 72 + c8) = pack8(dd); }
    __syncthreads();
    { const int lane = tid & 63, w = __builtin_amdgcn_readfirstlane(tid >> 6), fr = lane & 15, fg = lane >> 4, tt = w & 3;
      const bf16* wpt = (const bf16*)(p.ws + WS_WPT) + (size_t)(l * 4 + gi) * 4096;
      const bf16x8 b0 = *(const LAS bf16x8*)(DB + (16 * tt + fr) * 72 + fg * 8), b1 = *(const LAS bf16x8*)(DB + (16 * tt + fr) * 72 + 32 + fg * 8);
#pragma unroll
      for (int x = 0; x < 2; ++x) { const int ot = 2 * (w >> 2) + x;
          const bf16x8 a0 = *(const bf16x8*)(wpt + (16 * ot + fr) * 64 + fg * 8), a1 = *(const bf16x8*)(wpt + (16 * ot + fr) * 64 + 32 + fg * 8);
          f32x4 c = (f32x4){0.f, 0.f, 0.f, 0.f}; c = MFMA16(a0, b0, c); c = MFMA16(a1, b1, c);
          const f32x4 ps = *(const f32x4*)(p.in[I_PSCALE] + l * 256 + gi * 64 + 16 * ot + 4 * fg);
          c *= ps;
          u32x2 o; o.x = cvt2(c[0], c[1]); o.y = cvt2(c[2], c[3]);
          *(u32x2*)((bf16*)(p.ws + WS_MIXED) + (size_t)(tok0 + 16 * tt + fr) * DM + 768 + gi * 64 + 16 * ot + 4 * fg) = o; } }
    __syncthreads();
}

__device__ __forceinline__ float xsum_fg(float s, int fr, int fg) {
    s += __builtin_bit_cast(float, __builtin_amdgcn_ds_bpermute((((fg ^ 1) << 4) | fr) << 2, __builtin_bit_cast(int, s)));
    s += __builtin_bit_cast(float, __builtin_amdgcn_ds_bpermute((((fg ^ 2) << 4) | fr) << 2, __builtin_bit_cast(int, s)));
    return s;
}
__device__ __forceinline__ void stage_post(CKP& p, int l, int bid, int nb) {
    const int tid = opaque_tid(), lane = tid & 63, head = __builtin_amdgcn_readfirstlane(tid >> 6), fr = lane & 15, fg = lane >> 4;
    const bf16* Ub = (const bf16*)(p.ws + WS_U);
    const bf16* gupt = (const bf16*)(p.ws + WS_GUPT) + ((size_t)l * 512 + head * 64) * 128;
    const bf16* YF = (const bf16*)(p.ws + WS_YF); const bf16* YB = (const bf16*)(p.ws + WS_YB);
    const float* BC0 = (const float*)(p.ws + WS_BC); const float* BC1 = BC0 + (size_t)MTOK * 8;
    bf16* MIX = (bf16*)(p.ws + WS_MIXED);
    bf16x8 ag[4][4];
    f32x4 lnw[4], lnb[4];
#pragma unroll
    for (int t = 0; t < 4; ++t) {
#pragma unroll
        for (int ks = 0; ks < 4; ++ks) ag[t][ks] = *(const bf16x8*)(gupt + (16 * t + fr) * 128 + ks * 32 + fg * 8);
        lnw[t] = *(const f32x4*)(p.in[I_LNW] + l * 512 + head * 64 + 16 * t + 4 * fg); lnb[t] = *(const f32x4*)(p.in[I_LNB] + l * 512 + head * 64 + 16 * t + 4 * fg); }
#pragma unroll 1
    for (int item = bid; item < 768; item += nb) {
        const size_t tok = (size_t)item * 16 + fr;
        bf16x8 bs[4];
#pragma unroll
        for (int ks = 0; ks < 4; ++ks) bs[ks] = *(const bf16x8*)(Ub + tok * 1920 + GD_OFF + ks * 32 + fg * 8);
        f32x4 y[4]; u32x2 vw[4];
#pragma unroll
        for (int t = 0; t < 4; ++t) { const int c = head * 64 + 16 * t + 4 * fg;
            const u32x2 yf = *(const u32x2*)(YF + tok * 512 + c), yb = *(const u32x2*)(YB + tok * 512 + c);
            y[t] = (f32x4){bflo(yf.x) + bflo(yb.x), bfhi(yf.x) + bfhi(yb.x), bflo(yf.y) + bflo(yb.y), bfhi(yf.y) + bfhi(yb.y)}; vw[t] = *(const u32x2*)(Ub + tok * 1920 + V_OFF + c); }
        const float bc = BC0[tok * 8 + head] + BC1[tok * 8 + head];
        f32x4 g[4];
#pragma unroll
        for (int t = 0; t < 4; ++t) { g[t] = (f32x4){0.f, 0.f, 0.f, 0.f};
#pragma unroll
            for (int ks = 0; ks < 4; ++ks) g[t] = MFMA16(ag[t][ks], bs[ks], g[t]); }
        float s = 0.f;
#pragma unroll
        for (int t = 0; t < 4; ++t) s += (y[t][0] + y[t][1]) + (y[t][2] + y[t][3]);
        const float mean = xsum_fg(s, fr, fg) * (1.0f / 64.0f);
        float q = 0.f;
#pragma unroll
        for (int t = 0; t < 4; ++t) { y[t] = y[t] - mean; q += (y[t][0] * y[t][0] + y[t][1] * y[t][1]) + (y[t][2] * y[t][2] + y[t][3] * y[t][3]); }
        const float rstd = frsq(xsum_fg(q, fr, fg) * (1.0f / 64.0f) + 64e-5f);
#pragma unroll
        for (int t = 0; t < 4; ++t) { const f32x4 vv = (f32x4){bflo(vw[t].x), bfhi(vw[t].x), bflo(vw[t].y), bfhi(vw[t].y)};
            const f32x4 o = (y[t] * rstd * lnw[t] + lnb[t] + vv * bc) * g[t];
            u32x2 w; w.x = cvt2(o[0], o[1]); w.y = cvt2(o[2], o[3]);
            *(u32x2*)(MIX + tok * DM + head * 64 + 16 * t + 4 * fg) = w; }
    }
}

#define XB_TMO      128
#define XB_XCNT(j)  (256  + 64 * (j))
#define XB_XSUB(j)  (1280 + 64 * (j))
#define XB_XGEN(j)  (2304 + 64 * (j))
#define XB_TOP      3328
#define XB_TOPGEN   3392
#define XCD_BAR_WORDS 3456
#define XB_SPIN_CAP (1u << 18)

__device__ __forceinline__ unsigned xb_ld(unsigned* p)              { return __hip_atomic_load(p, __ATOMIC_RELAXED, __HIP_MEMORY_SCOPE_AGENT); }
__device__ __forceinline__ unsigned xb_add(unsigned* p, unsigned v) { return __hip_atomic_fetch_add(p, v, __ATOMIC_RELAXED, __HIP_MEMORY_SCOPE_AGENT); }
__device__ __forceinline__ unsigned xb_xcc_id() { return (unsigned)__builtin_amdgcn_s_getreg((3 << 11) | 20) & 0xFu; }
#define XB_SPIN(cond, bar) do { unsigned _sp = 0; while (cond) { __builtin_amdgcn_s_sleep(1); \
    if ((++_sp & 255u) == 0u) { if (xb_ld(&(bar)[XB_TMO])) break; if (_sp > XB_SPIN_CAP) { atomicAdd(&(bar)[XB_TMO], 1u); break; } } } } while (0)

struct XcdBarrier {
    unsigned* bar; unsigned x;
    volatile LAS unsigned* st;
};

__device__ __forceinline__ XcdBarrier xcd_barrier_post(unsigned* bar, volatile LAS unsigned* st) {
    XcdBarrier b; b.bar = bar; b.x = xb_xcc_id(); b.st = st;
    if (threadIdx.x == 0) (void)xb_add(&bar[XB_XCNT(b.x)], 1u);
    return b;
}
__device__ __forceinline__ void xcd_barrier_complete(unsigned* bar, unsigned x, unsigned& nloc, unsigned& nx) {
    const unsigned G = gridDim.x * gridDim.y * gridDim.z;
    unsigned sum, cnt, mine, sp = 0u;
    for (;;) {
        sum = 0u; cnt = 0u; mine = 0u;
#pragma unroll
        for (unsigned j = 0; j < 16; ++j) { const unsigned c = xb_ld(&bar[XB_XCNT(j)]); sum += c; cnt += (c > 0u) ? 1u : 0u; mine = (j == x) ? c : mine; }
        if (sum == G) break;
        __builtin_amdgcn_s_sleep(1);
        if ((++sp & 255u) == 0u) { if (xb_ld(&bar[XB_TMO])) break; if (sp > XB_SPIN_CAP) { atomicAdd(&bar[XB_TMO], 1u); break; } }
    }
    nloc = mine > 0u ? mine : 1u; nx = cnt > 0u ? cnt : 1u;
}

__device__ __forceinline__ void xcd_barrier(const XcdBarrier& b) {
    asm volatile("s_waitcnt vmcnt(0)" ::: "memory");
    __syncthreads();
    if (threadIdx.x == 0) {
        unsigned* bar = b.bar;
        __builtin_amdgcn_s_waitcnt(0);
        unsigned nloc = b.st[0], nx = b.st[1];
        if (nloc == 0u) { xcd_barrier_complete(bar, b.x, nloc, nx); b.st[0] = nloc; b.st[1] = nx; }
        const unsigned old = xb_add(&bar[XB_XSUB(b.x)], 1u);
        const unsigned gen = old / nloc;
        if (old + 1u == (gen + 1u) * nloc) {
            __builtin_amdgcn_fence(__ATOMIC_RELEASE, "agent");
            asm volatile("s_waitcnt vmcnt(0)" ::: "memory");
            const unsigned og = xb_add(&bar[XB_TOP], 1u);
            const unsigned tg = og / nx;
            __builtin_amdgcn_fence(__ATOMIC_ACQUIRE, "agent");
            if (og + 1u == (tg + 1u) * nx) xb_add(&bar[XB_TOPGEN], 1u);
            else XB_SPIN(xb_ld(&bar[XB_TOPGEN]) == tg, bar);
            xb_add(&bar[XB_XGEN(b.x)], 1u);
            asm volatile("s_waitcnt vmcnt(0)" ::: "memory");
        } else {
            __builtin_amdgcn_fence(__ATOMIC_ACQUIRE, "agent");
            XB_SPIN(xb_ld(&bar[XB_XGEN(b.x)]) == gen, bar);
            asm volatile("s_waitcnt vmcnt(0)" ::: "memory");
        }
    }
    __syncthreads();
}

struct EpiAny {
    static constexpr bool AFTER_DRAIN = false;
    int mode; bool PERM; int l;
    __device__ __forceinline__ void operator()(const f32x4 (&acc)[2][2][4][2], const pg8::Unit& u, int wr, int wc, int fr, int fq) const {
        CKP* kp = (CKP*)__builtin_amdgcn_kernarg_segment_ptr(); asm volatile("" : "+s"(kp)); CKP& p = *kp;
        unsigned char* ws = p.ws;
        const float* mod = (const float*)(ws + WS_MOD) + (size_t)l * 5 * 6144;
        float* SSQ = (float*)(ws + WS_CTL + 262144);
        bf16* Hb = (bf16*)(ws + WS_H); bf16* XB = (bf16*)(ws + WS_XB);
        if (mode == 7) {
#pragma unroll
            for (int a = 0; a < 2; ++a)
#pragma unroll
                for (int b = 0; b < 2; ++b)
#pragma unroll
                    for (int m = 0; m < 4; ++m)
#pragma unroll
                        for (int n = 0; n < 2; ++n) asm volatile("" :: "v"(acc[a][b][m][n]));
            return; }
        if (mode == 0) { const pg8::EpiBf<0> e{(bf16*)(ws + WS_PROJ), DINP}; e(acc, u, wr, wc, fr, fq); }
        else if (mode == 2) { const pg8::EpiResFinal e{XB, mod + 5 * 1024, p.in[I_FNG], p.out, SSQ + 49152, (unsigned*)(ws + WS_CTL + 524288) + 64 * 16}; e(acc, u, wr, wc, fr, fq); }
        else if (mode == 3) { const pg8::EpiFnet e{(bf16*)(ws + WS_MIXED), 0, 256}; e(acc, u, wr, wc, fr, fq); }
        else if (mode == 8) { const pg8::EpiFnet e{(bf16*)(ws + WS_MIXED), NCTX, 1024}; e(acc, u, wr, wc, fr, fq); }
        else if (mode == 4) { const pg8::EpiNormBf<0> e{(bf16*)(ws + WS_PROJ), DINP, SSQ + 16384, (const float*)(ws + WS_SWIN), DINP}; e(acc, u, wr, wc, fr, fq); }
        else if (mode == 5) { const pg8::EpiNormBf<1> e{(bf16*)(ws + WS_FF), DFF, SSQ + l * 32768, (const float*)(ws + WS_SW1) + (size_t)l * 5 * DFF, DFF}; e(acc, u, wr, wc, fr, fq); }
        else if (mode == 6) {
            if (l == 0) { const pg8::EpiResNorm<true, true> e{XB, mod + 2 * 1024, p.in[I_XP], p.in[I_XS], Hb, p.in[I_N2G], mod + 4 * 1024, SSQ}; e(acc, u, wr, wc, fr, fq); }
            else { const pg8::EpiResNorm<false, true> e{XB, mod + 2 * 1024, nullptr, nullptr, Hb, p.in[I_N2G] + DM, mod + 4 * 1024, SSQ + 32768}; e(acc, u, wr, wc, fr, fq); } }
        else { const pg8::EpiResNorm<false, true> e{XB, mod + 5 * 1024, nullptr, nullptr, Hb, p.in[I_N1G] + DM, mod + 5 * 6144 + 1 * 1024, SSQ + 16384}; e(acc, u, wr, wc, fr, fq); }
    }
};

constexpr int N_STEPS = 16;
__device__ __forceinline__ bool step_seam(int st) { return st < 15; }
__global__ void __launch_bounds__(NTHR, 2) mega_fwd(KP p_unused) {
    extern __shared__ __attribute__((aligned(16))) unsigned char lds_raw[];
    CKP* kp0 = (CKP*)__builtin_amdgcn_kernarg_segment_ptr();
    { LAS unsigned* ctlw = (LAS unsigned*)((LAS unsigned char*)lds_raw + RING_BYTES);
      for (int u = threadIdx.x; u < (LDS_BYTES - RING_BYTES) / 4; u += NTHR) ctlw[u] = 0u; }
    __syncthreads();
    const XcdBarrier bar = xcd_barrier_post((unsigned*)(kp0->ws + WS_CTL) + 4096, (volatile LAS unsigned*)((LAS unsigned char*)lds_raw + MISC_OFF + 32));
    const int ph_lo = kp0->ph_lo, ph_hi = kp0->ph_hi;
#pragma unroll 1
#ifdef REP_A
    for (int sti = ph_lo; sti < ph_hi + ((REP_B) >= 0 ? 2 : 1); ++sti) {
        const int st = sti <= (REP_A) ? sti : (((REP_B) < 0 || sti <= (REP_B) + 1) ? sti - 1 : sti - 2);
        const bool isdup = sti == (REP_A) || ((REP_B) >= 0 && sti == (REP_B) + 1); (void)isdup;
#else
    for (int st = ph_lo; st < ph_hi; ++st) {
#endif
        CKP* kp = kp0; asm volatile("" : "+s"(kp));
        CKP& p = *kp; unsigned char* ws = p.ws;
        int bid = blockIdx.x, nb = gridDim.x; unsigned ldsb = (unsigned)(size_t)(LAS unsigned char*)lds_raw;
        asm volatile("" : "+s"(bid), "+s"(nb), "+s"(ldsb));
        LAS unsigned char* lds = (LAS unsigned char*)(size_t)ldsb;
        const int l = st < 9 ? 0 : 1, s = st == 0 ? -1 : (st == 1 ? 0 : ((st - 2) % 7 + 1));
        const float* mod = (const float*)(ws + WS_MOD) + (size_t)l * 5 * 6144;
#pragma unroll 1
        for (int job = 0; job < 2; ++job) {
            pg8::Gemm g{nullptr, nullptr, 0, 0, 0, 0, 0}; EpiAny E{-1, true, 0}; int corder = bid;
            if (job == 0) {
                if (s == 1) { g = pg8::Gemm{(const bf16*)(ws + WS_H), (const bf16*)(ws + WS_WIN) + (size_t)l * DINP * DM, MTOK, DINP, DM, DM, DM}; E = EpiAny{l == 0 ? 0 : 4, true, l}; }
                else if (s == 3) { g = pg8::Gemm{(const bf16*)(ws + WS_CS256), (const bf16*)(ws + WS_YCS), 256, 8192, 512, 512, 512}; E = EpiAny{3, true, l}; corder = (bid + nb - (nb >= 256 ? 192 : 0)) % nb; }
                else if (s == 5) { g = pg8::Gemm{(const bf16*)(ws + WS_MIXED), (const bf16*)(ws + WS_WOUT) + (size_t)l * DM * DM, MTOK, DM, DM, DM, DM}; E = EpiAny{6, true, l}; }
                else if (s == 6) { g = pg8::Gemm{(const bf16*)(ws + WS_H), (const bf16*)(ws + WS_W1) + (size_t)l * DFF * DM, MTOK, DFF, DM, DM, DM}; E = EpiAny{5, true, l}; }
                else if (s == 7) { g = pg8::Gemm{(const bf16*)(ws + WS_FF), (const bf16*)(ws + WS_W2) + (size_t)l * DM * DFF, MTOK, DM, DFF, DFF, DFF}; E = l == 0 ? EpiAny{9, true, l} : EpiAny{2, true, l}; }
            } else if (s == 3) { g = pg8::Gemm{(const bf16*)(ws + WS_CS1024), (const bf16*)(ws + WS_YCS) + (size_t)8192 * 512, 1024, 1024, 2048, 2048, 2048}; E = EpiAny{8, true, l}; corder = (bid + nb - (nb >= 256 ? 224 : 32)) % nb; }
#ifdef NOEPI_FIRST
            if (isdup && E.mode >= 0) E.mode = 7;
#endif
            if (E.mode >= 0) {
                pg8::StaticOrder S; S.init(g.M, g.N, nb, corder);
                pg8::gemm_phase<EpiAny, pg8::StaticOrder, true, true>(lds, g, S, E);
                __syncthreads();
            }
        }
        if (s == 3) {
            if (nb >= 256) {
                if (bid < 64) rwkv_item3(p, l, lds, bid);
                else { unsigned* ctr = (unsigned*)(ws + WS_CTL + 524288) + 64 * (2 + l); volatile LAS unsigned* slot = (volatile LAS unsigned*)(lds + RING_BYTES + 64);
#pragma unroll 1
                    for (;;) { __syncthreads(); if (threadIdx.x == 0) *slot = atomicAdd(ctr, 1u); __syncthreads(); const int it = (int)*slot; if (it >= 512) break; rwkv_item3(p, l, lds, 64 + it); } }
            } else for (int it = bid; it < 576; it += nb) rwkv_item3(p, l, lds, it);
        }
        if (s == 3 || s == 5) {
            int qi, first, csz, nch;
            if (s == 3) { qi = l; first = l == 0 ? TI_IN : TI_L + TI_IN; csz = 8; nch = (TI_OUT + TI_1) / 8; }
            else { qi = 4 + l; first = l * TI_L + TI_IN + TI_OUT + TI_1; csz = 32; nch = TI_2 / 32; }
            side_queue(p, lds, qi, 0, first, csz, nch);
            if (s == 3 && l == 0) side_queue(p, lds, 6, 0, TI_L, 8, TI_IN / 8);
        }
        if (s == -1) stage_prologue(p, lds, bid, nb);
        else if (s == 0) stage_norm(p, 0, 0, bid, nb);
        if ((s == -1 && nb >= 256 && bid >= 192) || (s == 0 && nb < 256)) stage_tables(p, nb >= 256 ? bid - 192 : bid, nb >= 256 ? nb - 192 : nb);
        else if (s == 2) {
            stage_upass(p, l, bid, nb);
#ifdef DUP_U
            stage_upass(p, l, bid, nb);
#endif
#pragma unroll 1
            for (int it = bid; it < 768; it += nb) fnet1_item(p, l, it);
#ifdef DUP_F
#pragma unroll 1
            for (int it = bid; it < 768; it += nb) fnet1_item(p, l, it);
#endif
#pragma unroll 1
            for (int it = bid; it < 768; it += nb) pool_item(p, l, lds, it);
#ifdef DUP_P
#pragma unroll 1
            for (int it = bid; it < 768; it += nb) pool_item(p, l, lds, it);
#endif
        }
        else if (s == 4) stage_post(p, l, bid, nb);
        #ifdef REP_A
        if (sti + 1 < ph_hi + ((REP_B) >= 0 ? 2 : 1)) xcd_barrier(bar);
#else
        if (st + 1 < ph_hi && step_seam(st)) xcd_barrier(bar);
#endif
    }
}

extern "C" void kernel_launch(void* const* d_in, const int* in_sizes, int n_in, void* d_out, int out_size, void* d_ws, size_t ws_size, hipStream_t stream) {
    static int grid = 0;
    if (grid == 0) {
        if (n_in != N_IN || ws_size < WS_END) { fprintf(stderr, "kernel_launch: unexpected inputs (n_in %d, ws %zu)\n", n_in, ws_size); grid = -1; return; }
        int dev = 0, cus = 0, per_cu = 0;
        (void)hipGetDevice(&dev); (void)hipDeviceGetAttribute(&cus, hipDeviceAttributeMultiprocessorCount, dev);
        (void)hipFuncSetAttribute((const void*)mega_fwd, hipFuncAttributeMaxDynamicSharedMemorySize, LDS_BYTES);
        if (hipOccupancyMaxActiveBlocksPerMultiprocessor(&per_cu, (const void*)mega_fwd, NTHR, LDS_BYTES) != hipSuccess || per_cu < 1) {
            fprintf(stderr, "kernel_launch: occupancy query reports %d blocks/CU\n", per_cu); (void)hipGetLastError(); grid = -1; return; }
        grid = cus * 1;
    }
    if (grid < 0) return;
    KP a{};
    for (int i = 0; i < N_IN; ++i) a.in[i] = (const float*)d_in[i];
    a.out = (float*)d_out; a.ws = (unsigned char*)d_ws; a.ph_lo = 0; a.ph_hi = N_STEPS;
    if (hipMemsetAsync((char*)d_ws + WS_CTL, 0, 1 * MiB, stream) != hipSuccess) { fprintf(stderr, "kernel_launch: memset failed\n"); return; }
    void* args[] = {&a};
    hipError_t e = hipLaunchCooperativeKernel((const void*)mega_fwd, dim3(grid), dim3(NTHR), args, LDS_BYTES, stream);
    if (e != hipSuccess) fprintf(stderr, "cooperative launch failed: %s (grid %d)\n", hipGetErrorString(e), grid);
}
```

```cpp
#include <hip/hip_runtime.h>
#include <hip/hip_cooperative_groups.h>
#include <cstdio>
#include <cstdint>
namespace cg = cooperative_groups;
__device__ __forceinline__ int opaque_tid() { int t = threadIdx.x; asm volatile("" : "+v"(t)); return t; }
namespace pg8 {
#define PG8_LAS __attribute__((address_space(3)))
typedef unsigned short bf16_t;
typedef short bf16x8 __attribute__((ext_vector_type(8)));
typedef float f32x4 __attribute__((ext_vector_type(4)));
typedef unsigned u32x4 __attribute__((ext_vector_type(4)));
constexpr int BM = 256, BK = 64, HALF = 128, HTB = HALF * BK * 2  , STAGE_BYTES = 8 * HTB, NXCD = 8, WGM = 8;

__host__ __device__ __forceinline__ int lds_byte(int r, int c) { const int st = (r >> 4) * 2 + (c >> 5), rr = r & 15, cc = c & 31, ob = rr * 64 + cc * 2; return st * 1024 + (ob ^ (((ob >> 9) & 1) << 5)); }
__host__ __device__ __forceinline__ void stage_rc(int b, int& R, int& C) { const int st = b / 1024, sb = b % 1024, swz = sb ^ (((sb >> 9) & 1) << 5); R = (st >> 1) * 16 + swz / 64; C = (st & 1) * 32 + (swz % 64) / 2; }
__host__ __device__ __forceinline__ int perm32(int rho) { const int n = rho >> 4, i = rho & 15; return 8 * (i >> 2) + 4 * n + (i & 3); }

struct Unit { int pm, pn; };
struct Gemm { const bf16_t* A; const bf16_t* Bt; int M, N, K, lda, ldb; };

struct StaticOrder {
    int nM, nN, nwg, G, c;
    __host__ __device__ void init(int M, int N, int G_, int c_) { nM = M / BM; nN = N / BM; nwg = nM * nN; G = G_; c = c_; }
    __host__ __device__ bool next(int i, Unit& u) const {
        const long L = (long)i * G + c; if (L >= nwg) return false;
        int wgid = (int)L; { const int q = nwg / NXCD, r = nwg % NXCD, xcd = wgid % NXCD, off = wgid / NXCD; wgid = (xcd < r ? xcd * (q + 1) : r * (q + 1) + (xcd - r) * q) + off; }
        const int nig = WGM * nN, gid = wgid / nig, fm = gid * WGM, gsz = (nM - fm) < WGM ? (nM - fm) : WGM;
        u.pm = fm + ((wgid % nig) % gsz); u.pn = (wgid % nig) / gsz; return true;
    }
    __device__ __forceinline__ void a_ready(const Unit&) const {}
    __device__ __forceinline__ void done(const Unit&) const {}
};

__device__ __forceinline__ unsigned cvt_pk_bf16(float lo, float hi) { unsigned r; asm volatile("v_cvt_pk_bf16_f32 %0, %1, %2" : "=v"(r) : "v"(lo), "v"(hi)); return r; }
typedef unsigned u32x2 __attribute__((ext_vector_type(2)));
template <int ACT  > struct EpiBf {
    static constexpr bool PERM = true, AFTER_DRAIN = false;
    bf16_t* O; int ldc;
    __device__ __forceinline__ void operator()(const f32x4 (&acc)[2][2][4][2], const Unit& u, int wr, int wc, int fr, int fq) const {
        const int row0 = u.pm * BM + wr * 64 + fr, col0 = u.pn * BM + wc * 32 + 8 * fq;
#pragma unroll
        for (int ai = 0; ai < 2; ++ai)
#pragma unroll
            for (int m = 0; m < 4; ++m) { bf16_t* rowp = O + (size_t)(row0 + ai * HALF + m * 16) * ldc + col0;
#pragma unroll
                for (int bj = 0; bj < 2; ++bj) { f32x4 v0 = acc[ai][bj][m][0], v1 = acc[ai][bj][m][1];
                    if (ACT == 1) {
#pragma unroll
                        for (int e = 0; e < 4; ++e) { float a = v0[e] > 0.f ? v0[e] : 0.f; v0[e] = a * a; float b = v1[e] > 0.f ? v1[e] : 0.f; v1[e] = b * b; } }
                    u32x4 w; w.x = cvt_pk_bf16(v0[0], v0[1]); w.y = cvt_pk_bf16(v0[2], v0[3]); w.z = cvt_pk_bf16(v1[0], v1[1]); w.w = cvt_pk_bf16(v1[2], v1[3]);
                    *(u32x4*)(rowp + bj * HALF) = w; } }
    }
};
struct EpiRes {
    static constexpr bool PERM = false, AFTER_DRAIN = false;
    float* X; const float* gate; const float* Xc; const float* Xl;
    __device__ __forceinline__ void operator()(const f32x4 (&acc)[2][2][4][2], const Unit& u, int wr, int wc, int fr, int fq) const {
        const int row0 = u.pm * BM + wr * 64 + fr, col0 = u.pn * BM + wc * 32 + 4 * fq;
        const int cond = u.pm < 32 ? 0 : 1 + ((u.pm - 32) >> 2);
        const float* gp = gate + cond * 6144 + col0;
        f32x4 gv[2][2];
#pragma unroll
        for (int bj = 0; bj < 2; ++bj)
#pragma unroll
            for (int n = 0; n < 2; ++n) gv[bj][n] = *(const f32x4*)(gp + bj * HALF + n * 16);
#pragma unroll
        for (int ai = 0; ai < 2; ++ai)
#pragma unroll
            for (int m = 0; m < 4; ++m) { const size_t ro = (size_t)(row0 + ai * HALF + m * 16) * 1024 + col0; float* rowp = X + ro; const float* srcp = u.pm < 32 ? Xc + ro : Xl + (ro - (size_t)8192 * 1024);
#pragma unroll
                for (int bj = 0; bj < 2; ++bj)
#pragma unroll
                    for (int n = 0; n < 2; ++n) { *(f32x4*)(rowp + bj * HALF + n * 16) = *(const f32x4*)(srcp + bj * HALF + n * 16) + gv[bj][n] * acc[ai][bj][m][n]; }
                if (m & 1) asm volatile("" ::: "memory"); }
    }
};
struct EpiFnet {
    static constexpr bool PERM = true, AFTER_DRAIN = false;
    bf16_t* MIX; int rowbase, L;
    __device__ __forceinline__ void operator()(const f32x4 (&acc)[2][2][4][2], const Unit& u, int wr, int wc, int fr, int fq) const {
        const int row0 = u.pm * BM + wr * 64 + fr, colw = wc * 32 + 8 * fq;
        bf16_t* base = MIX + (size_t)(rowbase + u.pn * L) * 1024 + 512 + colw;
#pragma unroll
        for (int ai = 0; ai < 2; ++ai)
#pragma unroll
            for (int m = 0; m < 4; ++m) { bf16_t* rowp = base + (size_t)(row0 + ai * HALF + m * 16) * 1024;
#pragma unroll
                for (int bj = 0; bj < 2; ++bj) { const f32x4 v0 = acc[ai][bj][m][0], v1 = acc[ai][bj][m][1];
                    u32x4 w; w.x = cvt_pk_bf16(v0[0], v0[1]); w.y = cvt_pk_bf16(v0[2], v0[3]); w.z = cvt_pk_bf16(v1[0], v1[1]); w.w = cvt_pk_bf16(v1[2], v1[3]);
                    *(u32x4*)(rowp + bj * HALF) = w; } }
    }
};

__device__ __forceinline__ float xsum_fq(float s, int fr, int fq) {
    s += __builtin_bit_cast(float, __builtin_amdgcn_ds_bpermute((((fq ^ 1) << 4) | fr) << 2, __builtin_bit_cast(int, s)));
    s += __builtin_bit_cast(float, __builtin_amdgcn_ds_bpermute((((fq ^ 2) << 4) | fr) << 2, __builtin_bit_cast(int, s)));
    return s;
}
template <int ACT> struct EpiNormBf {
    static constexpr bool PERM = true, AFTER_DRAIN = false;
    bf16_t* O; int ldc; const float* ssq; const float* sw; int swld;
    __device__ __forceinline__ void operator()(const f32x4 (&acc)[2][2][4][2], const Unit& u, int wr, int wc, int fr, int fq) const {
        const int row0 = u.pm * BM + wr * 64 + fr, col0 = u.pn * BM + wc * 32 + 8 * fq;
        const int cond = u.pm < 32 ? 0 : 1 + ((u.pm - 32) >> 2);
        f32x4 sv[2][2];
#pragma unroll
        for (int bj = 0; bj < 2; ++bj)
#pragma unroll
            for (int n = 0; n < 2; ++n) sv[bj][n] = *(const f32x4*)(sw + (size_t)cond * swld + col0 + bj * HALF + 4 * n);
        float rs[2][4];
#pragma unroll
        for (int ai = 0; ai < 2; ++ai)
#pragma unroll
            for (int m = 0; m < 4; ++m) rs[ai][m] = ssq[row0 + ai * HALF + m * 16];
#pragma unroll
        for (int ai = 0; ai < 2; ++ai)
#pragma unroll
            for (int m = 0; m < 4; ++m) rs[ai][m] = __builtin_amdgcn_rsqf(rs[ai][m] * (1.0f / 1024.0f) + 1e-6f);
#pragma unroll
        for (int ai = 0; ai < 2; ++ai)
#pragma unroll
            for (int m = 0; m < 4; ++m) { const int row = row0 + ai * HALF + m * 16; bf16_t* rowp = O + (size_t)row * ldc + col0;
                const float rstd = rs[ai][m];
#pragma unroll
                for (int bj = 0; bj < 2; ++bj) { f32x4 v0 = acc[ai][bj][m][0] * rstd + sv[bj][0], v1 = acc[ai][bj][m][1] * rstd + sv[bj][1];
                    if (ACT == 1) {
#pragma unroll
                        for (int e = 0; e < 4; ++e) { float a = v0[e] > 0.f ? v0[e] : 0.f; v0[e] = a * a; float b = v1[e] > 0.f ? v1[e] : 0.f; v1[e] = b * b; } }
                    u32x4 w; w.x = cvt_pk_bf16(v0[0], v0[1]); w.y = cvt_pk_bf16(v0[2], v0[3]); w.z = cvt_pk_bf16(v1[0], v1[1]); w.w = cvt_pk_bf16(v1[2], v1[3]);
                    *(u32x4*)(rowp + bj * HALF) = w; }
                if (m & 1) asm volatile("" ::: "memory"); }
    }
};
struct EpiResFinal {
    static constexpr bool PERM = true, AFTER_DRAIN = false;
    const bf16_t* XB; const float* gate; const float* gfin; float* out; float* ssq; unsigned* cnt;
    __device__ __forceinline__ void operator()(const f32x4 (&acc)[2][2][4][2], const Unit& u, int wr, int wc, int fr, int fq) const {
        const int row0 = u.pm * BM + wr * 64 + fr, col0 = u.pn * BM + wc * 32 + 8 * fq;
        const int cond = u.pm < 32 ? 0 : 1 + ((u.pm - 32) >> 2);
        f32x4 gt[2][2];
#pragma unroll
        for (int bj = 0; bj < 2; ++bj)
#pragma unroll
            for (int n = 0; n < 2; ++n) gt[bj][n] = *(const f32x4*)(gate + cond * 6144 + col0 + bj * HALF + n * 4);
#pragma unroll
        for (int ai = 0; ai < 2; ++ai) {
            u32x4 xb[4][2];
#pragma unroll
            for (int m = 0; m < 4; ++m)
#pragma unroll
                for (int bj = 0; bj < 2; ++bj) xb[m][bj] = *(const u32x4*)(XB + (unsigned)(row0 + ai * HALF + m * 16) * 1024u + (unsigned)col0 + bj * HALF);
#pragma unroll
            for (int m = 0; m < 4; ++m) { const int row = row0 + ai * HALF + m * 16;
                float sq = 0.f;
#pragma unroll
                for (int bj = 0; bj < 2; ++bj) { const u32x4 xw = xb[m][bj];
                    f32x4 x0 = (f32x4){__builtin_bit_cast(float, xw.x << 16), __builtin_bit_cast(float, xw.x & 0xffff0000u), __builtin_bit_cast(float, xw.y << 16), __builtin_bit_cast(float, xw.y & 0xffff0000u)};
                    f32x4 x1 = (f32x4){__builtin_bit_cast(float, xw.z << 16), __builtin_bit_cast(float, xw.z & 0xffff0000u), __builtin_bit_cast(float, xw.w << 16), __builtin_bit_cast(float, xw.w & 0xffff0000u)};
                    x0 += gt[bj][0] * acc[ai][bj][m][0]; x1 += gt[bj][1] * acc[ai][bj][m][1];
                    sq += ((x0[0] * x0[0] + x0[1] * x0[1]) + (x0[2] * x0[2] + x0[3] * x0[3])) + ((x1[0] * x1[0] + x1[1] * x1[1]) + (x1[2] * x1[2] + x1[3] * x1[3])); }
                const float t = xsum_fq(sq, fr, fq); if (fq == 0) atomicAdd(ssq + row, t); }
            asm volatile("" ::: "memory"); }
        asm volatile("s_waitcnt vmcnt(0)" ::: "memory");
        unsigned* c = cnt + 64 * u.pm;
        if (fr == 0 && fq == 0) { __hip_atomic_fetch_add(c, 1u, __ATOMIC_RELAXED, __HIP_MEMORY_SCOPE_AGENT);
            for (unsigned spin = 0; __hip_atomic_load(c, __ATOMIC_RELAXED, __HIP_MEMORY_SCOPE_AGENT) < 32u && spin < (1u << 22); ++spin) __builtin_amdgcn_s_sleep(2); }
        asm volatile("" ::: "memory");
        f32x4 gv[2][2];
#pragma unroll
        for (int bj = 0; bj < 2; ++bj)
#pragma unroll
            for (int n = 0; n < 2; ++n) gv[bj][n] = *(const f32x4*)(gfin + col0 + bj * HALF + n * 4);
#pragma unroll
        for (int ai = 0; ai < 2; ++ai) {
            u32x4 xb[4][2]; float rs[4];
#pragma unroll
            for (int m = 0; m < 4; ++m) { rs[m] = __hip_atomic_load(ssq + row0 + ai * HALF + m * 16, __ATOMIC_RELAXED, __HIP_MEMORY_SCOPE_AGENT);
#pragma unroll
                for (int bj = 0; bj < 2; ++bj) xb[m][bj] = *(const u32x4*)(XB + (unsigned)(row0 + ai * HALF + m * 16) * 1024u + (unsigned)col0 + bj * HALF); }
#pragma unroll
            for (int m = 0; m < 4; ++m) { const unsigned ro = (unsigned)(row0 + ai * HALF + m * 16) * 1024u + (unsigned)col0;
                const float rstd = __builtin_amdgcn_rsqf(rs[m] * (1.0f / 1024.0f) + 1e-6f);
#pragma unroll
                for (int bj = 0; bj < 2; ++bj) { const u32x4 xw = xb[m][bj];
                    f32x4 x0 = (f32x4){__builtin_bit_cast(float, xw.x << 16), __builtin_bit_cast(float, xw.x & 0xffff0000u), __builtin_bit_cast(float, xw.y << 16), __builtin_bit_cast(float, xw.y & 0xffff0000u)};
                    f32x4 x1 = (f32x4){__builtin_bit_cast(float, xw.z << 16), __builtin_bit_cast(float, xw.z & 0xffff0000u), __builtin_bit_cast(float, xw.w << 16), __builtin_bit_cast(float, xw.w & 0xffff0000u)};
                    f32x4 ga = gt[bj][0], gb = gt[bj][1]; asm volatile("" : "+v"(ga), "+v"(gb));
                    x0 += ga * acc[ai][bj][m][0]; x1 += gb * acc[ai][bj][m][1];
                    *(f32x4*)(out + ro + bj * HALF) = x0 * rstd * gv[bj][0]; *(f32x4*)(out + ro + bj * HALF + 4) = x1 * rstd * gv[bj][1]; } }
            asm volatile("" ::: "memory"); }
    }
};
template <bool SRC_F32, bool WRITE_H> struct EpiResNorm {
    static constexpr bool PERM = true, AFTER_DRAIN = false;
    bf16_t* XB; const float* gate; const float* Xc; const float* Xl; bf16_t* H; const float* gn; const float* scl; float* ssq;
    __device__ __forceinline__ void operator()(const f32x4 (&acc)[2][2][4][2], const Unit& u, int wr, int wc, int fr, int fq) const {
        const int row0 = u.pm * BM + wr * 64 + fr, col0 = u.pn * BM + wc * 32 + 8 * fq;
        const int cond = u.pm < 32 ? 0 : 1 + ((u.pm - 32) >> 2);
        const float* src = u.pm < 32 ? Xc : Xl - (size_t)8192 * 1024;
        f32x4 gt[2][2], gs[2][2];
#pragma unroll
        for (int bj = 0; bj < 2; ++bj)
#pragma unroll
            for (int n = 0; n < 2; ++n) { const int col = col0 + bj * HALF + n * 4;
                gt[bj][n] = *(const f32x4*)(gate + cond * 6144 + col);
                if (WRITE_H) gs[bj][n] = *(const f32x4*)(gn + col) * (*(const f32x4*)(scl + cond * 6144 + col) + 1.0f); }
        constexpr int NB = SRC_F32 ? 2 : 4;
#pragma unroll
        for (int ai = 0; ai < 2; ++ai)
#pragma unroll
        for (int mb = 0; mb < 4; mb += NB) {
            u32x4 xb[NB][2]; f32x4 xf[NB][2][2];
#pragma unroll
            for (int mm = 0; mm < NB; ++mm) { const unsigned ro = (unsigned)(row0 + ai * HALF + (mb + mm) * 16) * 1024u + (unsigned)col0;
#pragma unroll
                for (int bj = 0; bj < 2; ++bj) {
                    if (SRC_F32) { xf[mm][bj][0] = *(const f32x4*)(src + ro + bj * HALF); xf[mm][bj][1] = *(const f32x4*)(src + ro + bj * HALF + 4); }
                    else xb[mm][bj] = *(const u32x4*)(XB + ro + bj * HALF); } }
#pragma unroll
            for (int mm = 0; mm < NB; ++mm) { const int m = mb + mm; const int row = row0 + ai * HALF + m * 16; const unsigned ro = (unsigned)row * 1024u + (unsigned)col0;
                float sq = 0.f;
#pragma unroll
                for (int bj = 0; bj < 2; ++bj) { const unsigned o = ro + bj * HALF;
                    f32x4 x0, x1;
                    if (SRC_F32) { x0 = xf[mm][bj][0]; x1 = xf[mm][bj][1]; }
                    else { const u32x4 xw = xb[mm][bj];
                        x0 = (f32x4){__builtin_bit_cast(float, xw.x << 16), __builtin_bit_cast(float, xw.x & 0xffff0000u), __builtin_bit_cast(float, xw.y << 16), __builtin_bit_cast(float, xw.y & 0xffff0000u)};
                        x1 = (f32x4){__builtin_bit_cast(float, xw.z << 16), __builtin_bit_cast(float, xw.z & 0xffff0000u), __builtin_bit_cast(float, xw.w << 16), __builtin_bit_cast(float, xw.w & 0xffff0000u)}; }
                    x0 += gt[bj][0] * acc[ai][bj][m][0]; x1 += gt[bj][1] * acc[ai][bj][m][1];
                    u32x4 xo; xo.x = cvt_pk_bf16(x0[0], x0[1]); xo.y = cvt_pk_bf16(x0[2], x0[3]); xo.z = cvt_pk_bf16(x1[0], x1[1]); xo.w = cvt_pk_bf16(x1[2], x1[3]);
                    *(u32x4*)(XB + o) = xo;
                    sq += ((x0[0] * x0[0] + x0[1] * x0[1]) + (x0[2] * x0[2] + x0[3] * x0[3])) + ((x1[0] * x1[0] + x1[1] * x1[1]) + (x1[2] * x1[2] + x1[3] * x1[3]));
                    if (WRITE_H) { const f32x4 h0 = x0 * gs[bj][0], h1 = x1 * gs[bj][1];
                        u32x4 w; w.x = cvt_pk_bf16(h0[0], h0[1]); w.y = cvt_pk_bf16(h0[2], h0[3]); w.z = cvt_pk_bf16(h1[0], h1[1]); w.w = cvt_pk_bf16(h1[2], h1[3]);
                        *(u32x4*)(H + o) = w; } }
                const float t = xsum_fq(sq, fr, fq); if (fq == 0) atomicAdd(ssq + row, t);
            }
            asm volatile("" ::: "memory"); }
    }
};
template <class Epi, class Sched, bool ALIGN_EPI = false, bool SP2 = false>
__device__ __forceinline__ void gemm_phase(PG8_LAS unsigned char* lds, const Gemm g, const Sched& S, const Epi& E) {
    const int tid = opaque_tid(), wid = __builtin_amdgcn_readfirstlane(tid >> 6), lane = tid & 63, wr = wid >> 2, wc = wid & 3, fr = lane & 15, fq = lane >> 4;
    const int K = g.K, nt = K / BK;
    unsigned voffA[2], voffB[2];
#pragma unroll
    for (int i = 0; i < 2; ++i) { int R, C; stage_rc(tid * 16 + i * 8192, R, C); const int Rb = E.PERM ? ((R & ~31) + perm32(R & 31)) : R;
        voffA[i] = (unsigned)(R * g.lda + C) * 2u; voffB[i] = (unsigned)(Rb * g.ldb + C) * 2u; }
    const size_t kstep = (size_t)(BK * 2);
    const size_t hstepA = (size_t)HALF * g.lda * 2, hstepB = (size_t)HALF * g.ldb * 2;
    const size_t tstepA = 2 * hstepA, tstepB = 2 * hstepB;
    const unsigned ldsw = (unsigned)wid * 1024u;
    const int aoff = lds_byte(wr * 64 + fr, fq * 8), boff = lds_byte(wc * 32 + fr, fq * 8);
#define PG8_SA(b, h) (((b) * 2 + (h)) * HTB)
#define PG8_SB(b, h) ((4 + (b) * 2 + (h)) * HTB)
#define PG8_STAGE(bufoff, gbase, voff) do { _Pragma("unroll") for (int _i = 0; _i < 2; ++_i) \
        __builtin_amdgcn_global_load_lds((const unsigned*)((const char*)(gbase) + (voff)[_i]), (PG8_LAS unsigned*)(lds + (bufoff) + ldsw + _i * 8192), 16, 0, 0); } while (0)
#define PG8_LDA(dst, b, h) do { _Pragma("unroll") for (int m = 0; m < 4; ++m) _Pragma("unroll") for (int k = 0; k < 2; ++k) dst[m][k] = *(const PG8_LAS bf16x8*)(lds + PG8_SA(b, h) + aoff + m * 2048 + k * 1024); } while (0)
#define PG8_LDB(dst, b, h) do { _Pragma("unroll") for (int n = 0; n < 2; ++n) _Pragma("unroll") for (int k = 0; k < 2; ++k) dst[n][k] = *(const PG8_LAS bf16x8*)(lds + PG8_SB(b, h) + boff + n * 2048 + k * 1024); } while (0)
#define PG8_MMA(ai, bj, At, Bt) do { __builtin_amdgcn_s_setprio(1); _Pragma("unroll") for (int m = 0; m < 4; ++m) _Pragma("unroll") for (int n = 0; n < 2; ++n) _Pragma("unroll") for (int k = 0; k < 2; ++k) \
        acc[ai][bj][m][n] = __builtin_amdgcn_mfma_f32_16x16x32_bf16(Bt[n][k], At[m][k], acc[ai][bj][m][n], 0, 0, 0); __builtin_amdgcn_s_setprio(0); } while (0)
#define PG8_WAIT_V(n) asm volatile("s_waitcnt vmcnt(" #n ")" ::: "memory")
#define PG8_WAIT_L(n) asm volatile("s_waitcnt lgkmcnt(" #n ")" ::: "memory")
#define PG8_BAR __builtin_amdgcn_s_barrier()
#define PG8_SCHED __builtin_amdgcn_sched_barrier(0)
    Unit cur, nxt; int ui = 0;
    if (!S.next(0, cur)) return;
    f32x4 acc[2][2][4][2];
#pragma unroll
    for (int a = 0; a < 2; ++a)
#pragma unroll
        for (int b = 0; b < 2; ++b)
#pragma unroll
            for (int m = 0; m < 4; ++m)
#pragma unroll
                for (int n = 0; n < 2; ++n) acc[a][b][m][n] = (f32x4){0.f, 0.f, 0.f, 0.f};
    bf16x8 At[4][2], B0[2][2], B1[2][2];
    const char* cA = (const char*)g.A + (size_t)cur.pm * tstepA; const char* cB = (const char*)g.Bt + (size_t)cur.pn * tstepB;
    S.a_ready(cur);
    if constexpr (SP2) {
        PG8_STAGE(PG8_SB(0, 0), cB, voffB); PG8_STAGE(PG8_SB(0, 1), cB + hstepB, voffB); PG8_STAGE(PG8_SA(0, 0), cA, voffA); PG8_STAGE(PG8_SA(0, 1), cA + hstepA, voffA);
        if (wr == 1) PG8_BAR;
        PG8_WAIT_V(2); PG8_BAR;
        PG8_STAGE(PG8_SB(1, 0), cB + kstep, voffB); PG8_STAGE(PG8_SA(1, 0), cA + kstep, voffA); PG8_STAGE(PG8_SB(1, 1), cB + hstepB + kstep, voffB);
        PG8_WAIT_V(6); PG8_BAR;
    } else {
        PG8_STAGE(PG8_SB(0, 0), cB, voffB); PG8_STAGE(PG8_SA(0, 0), cA, voffA); PG8_STAGE(PG8_SB(0, 1), cB + hstepB, voffB); PG8_STAGE(PG8_SA(0, 1), cA + hstepA, voffA);
        if (wr == 1) PG8_BAR;
        PG8_WAIT_V(4); PG8_BAR;
        PG8_STAGE(PG8_SB(1, 0), cB + kstep, voffB); PG8_STAGE(PG8_SA(1, 0), cA + kstep, voffA); PG8_STAGE(PG8_SB(1, 1), cB + hstepB + kstep, voffB);
        PG8_WAIT_V(6); PG8_BAR;
    }
    for (;;) {
        const bool has_next = S.next(ui + 1, nxt);
        const char* nA = has_next ? (const char*)g.A + (size_t)nxt.pm * tstepA : cA; const char* nB = has_next ? (const char*)g.Bt + (size_t)nxt.pn * tstepB : cB;
        for (int t = 0; t < nt; t += 2) {
            const bool last = (t == nt - 2);
            const char* a1 = cA + (size_t)(t + 1) * kstep;
            const char* a2 = last ? nA : cA + (size_t)(t + 2) * kstep; const char* b2 = last ? nB : cB + (size_t)(t + 2) * kstep;
            const char* a3 = a2 + kstep; const char* b3 = b2 + kstep;
            if (last && has_next) S.a_ready(nxt);
            if constexpr (SP2) {
            PG8_LDB(B0, 0, 0); PG8_LDB(B1, 0, 1); PG8_SCHED; PG8_LDA(At, 0, 0); PG8_STAGE(PG8_SA(1, 1), a1 + hstepA, voffA);
            PG8_WAIT_V(8); PG8_WAIT_L(0); PG8_BAR; PG8_MMA(0, 0, At, B0); PG8_MMA(0, 1, At, B1); PG8_BAR; PG8_SCHED;
            PG8_LDA(At, 0, 1); PG8_STAGE(PG8_SB(0, 0), b2, voffB); PG8_STAGE(PG8_SB(0, 1), b2 + hstepB, voffB); PG8_STAGE(PG8_SA(0, 0), a2, voffA);
            PG8_WAIT_V(8); PG8_WAIT_L(0); PG8_BAR; PG8_MMA(1, 0, At, B0); PG8_MMA(1, 1, At, B1); PG8_BAR; PG8_SCHED;
            PG8_LDB(B0, 1, 0); PG8_LDB(B1, 1, 1); PG8_SCHED; PG8_LDA(At, 1, 0); PG8_STAGE(PG8_SA(0, 1), a2 + hstepA, voffA);
            PG8_WAIT_V(8); PG8_WAIT_L(0); PG8_BAR; PG8_MMA(0, 0, At, B0); PG8_MMA(0, 1, At, B1); PG8_BAR; PG8_SCHED;
            PG8_LDA(At, 1, 1); PG8_STAGE(PG8_SB(1, 0), b3, voffB); PG8_STAGE(PG8_SB(1, 1), b3 + hstepB, voffB); PG8_STAGE(PG8_SA(1, 0), a3, voffA);
            PG8_WAIT_V(8); PG8_WAIT_L(0); PG8_BAR; PG8_MMA(1, 0, At, B0); PG8_MMA(1, 1, At, B1); PG8_BAR; PG8_SCHED;
            } else {
            PG8_LDB(B0, 0, 0); PG8_SCHED; PG8_LDA(At, 0, 0); PG8_STAGE(PG8_SA(1, 1), a1 + hstepA, voffA);
            PG8_WAIT_L(8); PG8_BAR; PG8_WAIT_L(0); PG8_MMA(0, 0, At, B0); PG8_BAR; PG8_SCHED;
            PG8_LDB(B1, 0, 1); PG8_STAGE(PG8_SB(0, 0), b2, voffB);
            PG8_BAR; PG8_WAIT_L(0); PG8_MMA(0, 1, At, B1); PG8_BAR;
            PG8_LDA(At, 0, 1); PG8_STAGE(PG8_SA(0, 0), a2, voffA);
            PG8_BAR; PG8_WAIT_L(0); PG8_MMA(1, 0, At, B0); PG8_BAR; PG8_SCHED;
            PG8_STAGE(PG8_SB(0, 1), b2 + hstepB, voffB);
            PG8_WAIT_V(6); PG8_BAR; PG8_MMA(1, 1, At, B1); PG8_BAR;
            PG8_LDB(B0, 1, 0); PG8_SCHED; PG8_LDA(At, 1, 0); PG8_STAGE(PG8_SA(0, 1), a2 + hstepA, voffA);
            PG8_WAIT_L(8); PG8_BAR; PG8_WAIT_L(0); PG8_MMA(0, 0, At, B0); PG8_BAR; PG8_SCHED;
            PG8_LDB(B1, 1, 1); PG8_STAGE(PG8_SB(1, 0), b3, voffB);
            PG8_BAR; PG8_WAIT_L(0); PG8_MMA(0, 1, At, B1); PG8_BAR;
            PG8_LDA(At, 1, 1); PG8_STAGE(PG8_SA(1, 0), a3, voffA);
            PG8_BAR; PG8_WAIT_L(0); PG8_MMA(1, 0, At, B0); PG8_BAR; PG8_SCHED;
            PG8_STAGE(PG8_SB(1, 1), b3 + hstepB, voffB);
            PG8_WAIT_V(6); PG8_BAR; PG8_MMA(1, 1, At, B1); PG8_BAR;
            }
        }
        if constexpr (ALIGN_EPI) { if (wr == 0) PG8_BAR; }
        if constexpr (!Epi::AFTER_DRAIN) { int fr2 = fr, fq2 = fq; asm volatile("" : "+v"(fr2), "+v"(fq2)); E(acc, cur, wr, wc, fr2, fq2); S.done(cur); }
        if (!has_next) break;
#pragma unroll
        for (int a = 0; a < 2; ++a)
#pragma unroll
            for (int b = 0; b < 2; ++b)
#pragma unroll
                for (int m = 0; m < 4; ++m)
#pragma unroll
                    for (int n = 0; n < 2; ++n) acc[a][b][m][n] = (f32x4){0.f, 0.f, 0.f, 0.f};
        cur = nxt; cA = nA; cB = nB; ++ui;
        if constexpr (ALIGN_EPI) { if (wr == 1) PG8_BAR; }
    }
    PG8_WAIT_V(0);
    if constexpr (!ALIGN_EPI) { if (wr == 0) PG8_BAR; }
    PG8_BAR;
    if constexpr (Epi::AFTER_DRAIN) { E.fused(acc, cur, wr, wc, fr, fq, lds, wid, lane); S.done(cur); }
#undef PG8_SA
#undef PG8_SB
#undef PG8_STAGE
#undef PG8_LDA
#undef PG8_LDB
#undef PG8_MMA
#undef PG8_WAIT_V
#undef PG8_WAIT_L
#undef PG8_BAR
#undef PG8_SCHED
}
}

#define LAS __attribute__((address_space(3)))
typedef unsigned short bf16;
typedef float f32x4 __attribute__((ext_vector_type(4)));
typedef unsigned u32x4 __attribute__((ext_vector_type(4)));
typedef unsigned u32x2 __attribute__((ext_vector_type(2)));
constexpr int DM = 1024, NCTX = 8192, MTOK = 12288, DINP = 2560, DFF = 4096;
constexpr int R_OFF = 0, K_OFF = 512, V_OFF = 1024, WD_OFF = 1536, AD_OFF = 1664, GD_OFF = 1792, F_OFF = 1920, P_OFF = 2176, DIN = 2432;
constexpr size_t MiB = 1u << 20;
constexpr size_t WS_CTL = 0, WS_MOD = 1 * MiB, WS_FW = 1 * MiB + 512 * 1024, WS_BC = 2 * MiB, WS_CS256 = 3 * MiB, WS_CS1024 = 4 * MiB, WS_WIN = 8 * MiB, WS_WOUT = 18 * MiB,
                 WS_W1 = 22 * MiB, WS_W2 = 38 * MiB, WS_H = 54 * MiB, WS_MIXED = 78 * MiB, WS_PROJ = 102 * MiB, WS_YCS = 162 * MiB, WS_YF = 102 * MiB, WS_YB = 126 * MiB  , WS_U = 174 * MiB, WS_KINV = 220 * MiB, WS_GUPT = 221 * MiB,
                 WS_FF = 102 * MiB, WS_WUPT = 222 * MiB, WS_AUPT = 222 * MiB + 256 * 1024, WS_SSQ = 223 * MiB, WS_WPT = 223 * MiB + 512 * 1024, WS_SW1 = 224 * MiB, WS_SWIN = 224 * MiB + 256 * 1024, WS_XB = 226 * MiB, WS_END = 250 * MiB;
constexpr int LDS_BYTES = 161792, RING_BYTES = 131072, MISC_OFF = RING_BYTES + 320;
constexpr int NTHR = 512;
enum { I_XP = 0, I_XS, I_STATE, I_C, I_CCTX, I_WADA, I_BADA, I_N1G, I_WIN, I_MU, I_W0, I_WUP, I_A0, I_AUP, I_GUP, I_KK, I_KA, I_RK, I_LNW, I_LNB, I_WFNET, I_WPOOL, I_PSCALE, I_WOUT, I_N2G, I_WFF1, I_WFF2, I_FNG, N_IN };
struct KP { const float* in[N_IN]; float* out; unsigned char* ws; int ph_lo, ph_hi; };
typedef const __attribute__((address_space(4))) KP CKP;

__device__ __forceinline__ unsigned f2bf(float f) { unsigned u = __builtin_bit_cast(unsigned, f); return (u + 0x7fffu + ((u >> 16) & 1u)) >> 16; }
__device__ __forceinline__ unsigned pk2(float lo, float hi) { return f2bf(lo) | (f2bf(hi) << 16); }
__device__ __forceinline__ float bflo(unsigned w) { return __builtin_bit_cast(float, w << 16); }
__device__ __forceinline__ float bfhi(unsigned w) { return __builtin_bit_cast(float, w & 0xffff0000u); }
__device__ __forceinline__ float bf1(bf16 h) { return __builtin_bit_cast(float, (unsigned)h << 16); }
__device__ __forceinline__ float fexp(float x) { return __builtin_amdgcn_exp2f(x * 1.4426950408889634f); }
__device__ __forceinline__ float flog(float x) { return __builtin_amdgcn_logf(x) * 0.6931471805599453f; }
__device__ __forceinline__ float frcp(float x) { return __builtin_amdgcn_rcpf(x); }
__device__ __forceinline__ float frsq(float x) { return __builtin_amdgcn_rsqf(x); }
__device__ __forceinline__ float fsigmoid(float x) { return frcp(1.0f + fexp(-x)); }
template <int CTRL> __device__ __forceinline__ float dppf(float x) { return __builtin_bit_cast(float, __builtin_amdgcn_update_dpp(0, __builtin_bit_cast(int, x), CTRL, 0xF, 0xF, true)); }
__device__ __forceinline__ float red8(float x)  { x += dppf<0xB1>(x); x += dppf<0x4E>(x); x += dppf<0x141>(x); return x; }
__device__ __forceinline__ float red16(float x) { x += dppf<0xB1>(x); x += dppf<0x4E>(x); x += dppf<0x141>(x); x += dppf<0x140>(x); return x; }
__device__ __forceinline__ float wave_sum(float v) {
    v = red16(v);
    const float s0 = __builtin_bit_cast(float, __builtin_amdgcn_readlane(__builtin_bit_cast(int, v), 0)), s1 = __builtin_bit_cast(float, __builtin_amdgcn_readlane(__builtin_bit_cast(int, v), 16));
    const float s2 = __builtin_bit_cast(float, __builtin_amdgcn_readlane(__builtin_bit_cast(int, v), 32)), s3 = __builtin_bit_cast(float, __builtin_amdgcn_readlane(__builtin_bit_cast(int, v), 48));
    return (s0 + s1) + (s2 + s3);
}
__device__ __forceinline__ void load4bf(const bf16* p, float (&o)[4]) { const u32x2 w = *(const u32x2*)p; o[0] = bflo(w.x); o[1] = bfhi(w.x); o[2] = bflo(w.y); o[3] = bfhi(w.y); }
__device__ __forceinline__ void load8bf(const bf16* p, float (&o)[8]) { const u32x4 w = *(const u32x4*)p; o[0] = bflo(w.x); o[1] = bfhi(w.x); o[2] = bflo(w.y); o[3] = bfhi(w.y); o[4] = bflo(w.z); o[5] = bfhi(w.z); o[6] = bflo(w.w); o[7] = bfhi(w.w); }
__device__ __forceinline__ void shift4(const bf16* proj, int row, bool hasp, bool hasn, int col, const float* mu, float (&u)[4]) {
    float p[4], a[4] = {0.f, 0.f, 0.f, 0.f}, b[4] = {0.f, 0.f, 0.f, 0.f};
    load4bf(proj + (size_t)row * DINP + col, p);
    if (hasp) load4bf(proj + (size_t)(row - 1) * DINP + col, a);
    if (hasn) load4bf(proj + (size_t)(row + 1) * DINP + col, b);
    const f32x4 m = *(const f32x4*)(mu + col);
#pragma unroll
    for (int j = 0; j < 4; ++j) u[j] = p[j] + m[j] * (0.5f * (a[j] + b[j]) - p[j]);
}

__device__ __forceinline__ void gemv5_cols(LAS float* sc, LAS float* red, const float* W, int ldw, int colw, const float* bias, float* out, int ldo, int colo, int tid, const float* cctx, const float* cvec) {
    const int cgi = tid & 15, kg = tid >> 4;
    f32x4 acc[5];
#pragma unroll
    for (int c = 0; c < 5; ++c) acc[c] = (f32x4){0.f, 0.f, 0.f, 0.f};
    const float* wp = W + (size_t)(kg * 32) * ldw + colw + cgi * 4;
    f32x4 wv[16];
#pragma unroll
    for (int kk = 0; kk < 16; ++kk) wv[kk] = *(const f32x4*)(wp + (size_t)kk * ldw);
    for (int i = tid; i < 5 * 1024; i += NTHR) { const int cond = i >> 10, k = i & 1023; const float v = cond == 0 ? cctx[k] : cvec[(cond - 1) * 1024 + k]; sc[i] = v * fsigmoid(v); }
    __syncthreads();
#pragma unroll
    for (int half = 0; half < 2; ++half) {
        f32x4 wn[16];
        if (half == 0) {
#pragma unroll
            for (int kk = 0; kk < 16; ++kk) wn[kk] = *(const f32x4*)(wp + (size_t)(16 + kk) * ldw); }
#pragma unroll
        for (int kk = 0; kk < 16; ++kk) {
#pragma unroll
            for (int c = 0; c < 5; ++c) acc[c] += sc[c * 1024 + kg * 32 + half * 16 + kk] * wv[kk]; }
        if (half == 0) {
#pragma unroll
            for (int kk = 0; kk < 16; ++kk) wv[kk] = wn[kk]; } }
#pragma unroll
    for (int c = 0; c < 5; ++c) *(LAS f32x4*)(red + (kg * 5 + c) * 64 + cgi * 4) = acc[c];
    __syncthreads();
    if (tid < 320) { const int cond = tid >> 6, col = tid & 63; float sm = bias ? bias[colo + col] : 0.f;
        for (int g = 0; g < 32; ++g) sm += red[(g * 5 + cond) * 64 + col];
        out[(size_t)cond * ldo + colo + col] = sm; }
    __syncthreads();
}
__device__ __forceinline__ void mod_item(CKP& p, LAS unsigned char* lds, int it) {
    const int tid = opaque_tid(); unsigned char* ws = p.ws;
    LAS float* sc = (LAS float*)lds; LAS float* red = (LAS float*)(lds + 20480);
    const int l = it / 96, cgp = it % 96;
    gemv5_cols(sc, red, p.in[I_WADA] + (size_t)l * 1024 * 6144, 6144, cgp * 64, p.in[I_BADA] + l * 6144, (float*)(ws + WS_MOD) + (size_t)l * 5 * 6144, 6144, cgp * 64, tid, p.in[I_CCTX], p.in[I_C]);
}
constexpr int TI_IN = 16 * 76, TI_OUT = 16 * 32, TI_1 = 16 * 128, TI_2 = 64 * 32, TI_L = TI_IN + TI_OUT + TI_1 + TI_2;
struct TrItem { const float* src; bf16* dst; const float* shv; float* sw; int N, K, swld; };
__device__ __forceinline__ TrItem tr_decode(CKP& p, int it) {
    unsigned char* ws = p.ws; const int l = it / TI_L; int r = it % TI_L;
    const float* W; bf16* WT; int K, N; const float* shv = nullptr; float* sw = nullptr; int swld = 0;
    if (r < TI_IN) { W = p.in[I_WIN] + (size_t)l * DM * DIN; K = DM; N = DIN; WT = (bf16*)(ws + WS_WIN) + (size_t)l * DINP * DM;
        if (l == 1) { shv = (const float*)(ws + WS_MOD) + (size_t)5 * 6144; sw = (float*)(ws + WS_SWIN); swld = DINP; } }
    else if ((r -= TI_IN) < TI_OUT) { W = p.in[I_WOUT] + (size_t)l * DM * DM; K = DM; N = DM; WT = (bf16*)(ws + WS_WOUT) + (size_t)l * DM * DM; }
    else if ((r -= TI_OUT) < TI_1) { W = p.in[I_WFF1] + (size_t)l * DM * DFF; K = DM; N = DFF; WT = (bf16*)(ws + WS_W1) + (size_t)l * DFF * DM;
        shv = (const float*)(ws + WS_MOD) + (size_t)l * 5 * 6144 + 3 * 1024; sw = (float*)(ws + WS_SW1) + (size_t)l * 5 * DFF; swld = DFF; }
    else { r -= TI_1; W = p.in[I_WFF2] + (size_t)l * DFF * DM; K = DFF; N = DM; WT = (bf16*)(ws + WS_W2) + (size_t)l * DM * DFF; }
    const int nblk = N / 32, k0 = 64 * (r / nblk), n0 = 32 * (r % nblk);
    return TrItem{W + (size_t)k0 * N + n0, WT + (size_t)n0 * K + k0, shv ? shv + k0 : nullptr, sw ? sw + n0 : nullptr, N, K, swld};
}
typedef short bf16x8 __attribute__((ext_vector_type(8)));
typedef short s16x4v __attribute__((ext_vector_type(4)));
__device__ __forceinline__ void transpose_range(CKP& p, LAS unsigned char* lds, int first, int last, int bid, int nb) {
    const int tid = opaque_tid(), lane = tid & 63, wave = tid >> 6;
    LAS bf16* T = (LAS bf16*)(lds + wave * 16384);
    int it = first + bid * 8 + wave;
    if (it >= last) return;
    TrItem cur = tr_decode(p, it);
    const int lr = lane >> 3, lc4 = (lane & 7) * 4, g = lane >> 4, nn = lane & 15;
    f32x4 tv[8];
#pragma unroll
    for (int i = 0; i < 8; ++i) tv[i] = *(const f32x4*)(cur.src + (size_t)(lr + 8 * i) * cur.N + lc4);
#pragma unroll 1
    for (;;) {
        bf16x8 sa[2];
        if (cur.shv) {
#pragma unroll
            for (int ks = 0; ks < 2; ++ks) { f32x4 a0 = (f32x4){0.f, 0.f, 0.f, 0.f}, a1 = a0;
                if (nn < 5) { a0 = *(const f32x4*)(cur.shv + nn * 6144 + 32 * ks + 8 * g); a1 = *(const f32x4*)(cur.shv + nn * 6144 + 32 * ks + 8 * g + 4); }
                sa[ks] = __builtin_bit_cast(bf16x8, (u32x4){pk2(a0[0], a0[1]), pk2(a0[2], a0[3]), pk2(a1[0], a1[1]), pk2(a1[2], a1[3])}); } }
#pragma unroll
        for (int i = 0; i < 8; ++i) *(LAS u32x2*)(T + (lr + 8 * i) * 40 + lc4) = (u32x2){pk2(tv[i][0], tv[i][1]), pk2(tv[i][2], tv[i][3])};
        const int nit = it + nb * 8; const bool more = nit < last;
        const TrItem nxt = tr_decode(p, more ? nit : it);
        if (more) {
#pragma unroll
            for (int i = 0; i < 8; ++i) tv[i] = *(const f32x4*)(nxt.src + (size_t)(lr + 8 * i) * nxt.N + lc4); }
        asm volatile("s_waitcnt lgkmcnt(0)" ::: "memory");
        f32x4 cacc[2] = {(f32x4){0.f, 0.f, 0.f, 0.f}, (f32x4){0.f, 0.f, 0.f, 0.f}};
#pragma unroll
        for (int j = 0; j < 4; ++j) { const int nh = j >> 1, ks = j & 1, R0 = 8 * (4 * ks + g), C0 = 16 * nh;
            const LAS bf16* pp = T + (R0 + (nn >> 2)) * 40 + C0 + 4 * (nn & 3);
            const u32x2 lo = __builtin_bit_cast(u32x2, __builtin_amdgcn_ds_read_tr16_b64_v4i16((LAS s16x4v*)pp));
            const u32x2 hi = __builtin_bit_cast(u32x2, __builtin_amdgcn_ds_read_tr16_b64_v4i16((LAS s16x4v*)(pp + 4 * 40)));
            const u32x4 o = (u32x4){lo.x, lo.y, hi.x, hi.y};
            *(u32x4*)(cur.dst + (size_t)(C0 + nn) * cur.K + R0) = o;
            if (cur.shv) cacc[nh] = __builtin_amdgcn_mfma_f32_16x16x32_bf16(sa[ks], __builtin_bit_cast(bf16x8, o), cacc[nh], 0, 0, 0); }
        if (cur.shv) {
#pragma unroll
            for (int nh = 0; nh < 2; ++nh) {
                if (g == 0) {
#pragma unroll
                    for (int r = 0; r < 4; ++r) atomicAdd(cur.sw + r * cur.swld + 16 * nh + nn, cacc[nh][r]); }
                else if (g == 1) atomicAdd(cur.sw + 4 * cur.swld + 16 * nh + nn, cacc[nh][0]); } }
        asm volatile("s_waitcnt lgkmcnt(0)" ::: "memory");
        if (!more) break;
        cur = nxt; it = nit;
    }
}
__device__ __forceinline__ void stage_prologue(CKP& p, LAS unsigned char* lds, int bid, int nb) {
    const int tid = opaque_tid();
    unsigned char* ws = p.ws;
    transpose_range(p, lds, 0, TI_IN, bid, nb);
    const int gt = bid * NTHR + tid, NGT = nb * NTHR;
#pragma unroll 1
    for (int i = gt; i < 2 * 128 * DM / 8; i += NGT) { const int l = i / (128 * DM / 8), r = i % (128 * DM / 8);
        u32x4 z = (u32x4){0u, 0u, 0u, 0u}; asm volatile("" : "+v"(z));
        *(u32x4*)((bf16*)(ws + WS_WIN) + (size_t)l * DINP * DM + (size_t)DIN * DM + (size_t)r * 8) = z; }
#pragma unroll 1
    for (int i = gt; i < (5 * DINP + 2 * 5 * DFF) / 4; i += NGT) { f32x4 z = (f32x4){0.f, 0.f, 0.f, 0.f}; asm volatile("" : "+v"(z));
        if (i < 5 * DINP / 4) ((f32x4*)(ws + WS_SWIN))[i] = z; else ((f32x4*)(ws + WS_SW1))[i - 5 * DINP / 4] = z; }
    __syncthreads();
#pragma unroll 1
    for (int it = bid; it < 192; it += nb) mod_item(p, lds, it);
}
__device__ __forceinline__ void stage_tables(CKP& p, int bid, int nb) {
    const int tid = opaque_tid(); unsigned char* ws = p.ws;
    const int gt = bid * NTHR + tid, NGT = nb * NTHR;
    float tw[4], tu[4], ta[4], tg[4];
#pragma unroll
    for (int k = 0; k < 4; ++k) { const int i = gt + k * NGT;
        tw[k] = i < 2 * 4 * 64 * 64 ? p.in[I_WPOOL][i] : 0.f;
        tu[k] = i < 2 * 2 * 64 * 512 ? p.in[I_WUP][i] : 0.f; ta[k] = i < 2 * 2 * 64 * 512 ? p.in[I_AUP][i] : 0.f;
        tg[k] = i < 2 * 128 * 512 ? p.in[I_GUP][i] : 0.f; }
#pragma unroll 1
    for (int i = gt; i < 256 * 512 + 1024 * 2048; i += NGT) {
        int L, k, j; bf16* dst;
        if (i < 256 * 512) { L = 256; k = i / 512; j = i % 512; dst = (bf16*)(ws + WS_CS256) + i; }
        else { const int i2 = i - 256 * 512; L = 1024; k = i2 / 2048; j = i2 % 2048; dst = (bf16*)(ws + WS_CS1024) + i2; }
        const int jj = j >= L ? j - L : j; const int idx = (k * jj) & (L - 1);
        const float rev = (float)idx * (L == 256 ? (1.0f / 256.0f) : (1.0f / 1024.0f));
        *dst = (bf16)f2bf(j >= L ? -__builtin_amdgcn_sinf(rev) : __builtin_amdgcn_cosf(rev));
    }
#pragma unroll
    for (int k = 0; k < 4; ++k) { const int i = gt + k * NGT;
        if (i < 2 * 4 * 64 * 64) { const int o = i & 63, c = (i >> 6) & 63, lg = i >> 12; ((bf16*)(ws + WS_WPT))[(size_t)(lg * 64 + o) * 64 + c] = (bf16)f2bf(tw[k]); }
        if (i < 2 * 2 * 64 * 512) { const int c = i & 511, r = (i >> 9) & 63, ld = i >> 15;
            ((bf16*)(ws + WS_WUPT))[(size_t)(ld * 512 + c) * 64 + r] = (bf16)f2bf(tu[k]); ((bf16*)(ws + WS_AUPT))[(size_t)(ld * 512 + c) * 64 + r] = (bf16)f2bf(ta[k]); }
        if (i < 2 * 128 * 512) { const int c = i & 511, r = (i >> 9) & 127, ll = i >> 16; ((bf16*)(ws + WS_GUPT))[(size_t)(ll * 512 + c) * 128 + r] = (bf16)f2bf(tg[k]); } }
#pragma unroll 1
    for (int i = gt + 4 * NGT; i < 2 * 4 * 64 * 64; i += NGT) { const int o = i & 63, c = (i >> 6) & 63, lg = i >> 12;
        ((bf16*)(ws + WS_WPT))[(size_t)(lg * 64 + o) * 64 + c] = (bf16)f2bf(p.in[I_WPOOL][i]); }
#pragma unroll 1
    for (int i = gt + 4 * NGT; i < 2 * 2 * 64 * 512; i += NGT) { const int c = i & 511, r = (i >> 9) & 63, ld = i >> 15;
        ((bf16*)(ws + WS_WUPT))[(size_t)(ld * 512 + c) * 64 + r] = (bf16)f2bf(p.in[I_WUP][i]);
        ((bf16*)(ws + WS_AUPT))[(size_t)(ld * 512 + c) * 64 + r] = (bf16)f2bf(p.in[I_AUP][i]); }
#pragma unroll 1
    for (int i = gt + 4 * NGT; i < 2 * 128 * 512; i += NGT) { const int c = i & 511, r = (i >> 9) & 127, ll = i >> 16;
        ((bf16*)(ws + WS_GUPT))[(size_t)(ll * 512 + c) * 128 + r] = (bf16)f2bf(p.in[I_GUP][i]); }
#pragma unroll 1
    for (int i = gt; i < 2 * 4 * 64 * 128; i += NGT) {
        const int o = i & 127, c = (i >> 7) & 63, lg = i >> 13; const float* wf = p.in[I_WFNET] + (size_t)lg * 4096 + (o & 63);
        float wv[64];
#pragma unroll
        for (int e = 0; e < 64; ++e) wv[e] = wf[e * 64];
        float acc = 0.f;
#pragma unroll
        for (int e = 0; e < 64; ++e) { const float rev = (float)((c * e) & 63) * (1.0f / 64.0f) + (o < 64 ? 0.25f : 0.f);
            acc += __builtin_amdgcn_sinf(rev) * wv[e]; }
        ((bf16*)(ws + WS_FW))[(size_t)(lg * 128 + o) * 64 + c] = (bf16)f2bf(acc);
    }
}
__device__ __forceinline__ void side_queue(CKP& p, LAS unsigned char* lds, int qi, int nsh, int first, int csz, int nch) {
    const int tid = opaque_tid();
    unsigned* ctr = (unsigned*)(p.ws + WS_CTL + 524288) + 64 * qi;
    volatile LAS unsigned* slot = (volatile LAS unsigned*)(lds + RING_BYTES + 64);
    __syncthreads();
#pragma unroll 1
    for (;;) {
        if (tid == 0) *slot = atomicAdd(ctr, 1u);
        __syncthreads();
        const int it = (int)*slot;
        __syncthreads();
        if (it >= nsh + nch) break;
        { const int c0 = first + csz * (it - nsh); transpose_range(p, lds, c0, c0 + csz, 0, 1); }
        __syncthreads();
    }
}

__device__ __forceinline__ void stage_norm(CKP& p, int l, int which, int bid, int nb) {
    const int tid = opaque_tid(), lane = tid & 63, wave = tid >> 6;
    const float* g = p.in[which ? I_N2G : I_N1G] + l * DM;
    const float* mod = (const float*)(p.ws + WS_MOD) + (size_t)l * 5 * 6144 + (which ? 3 * 1024 : 0);
    bf16* H = (bf16*)(p.ws + WS_H);
    f32x4 gg[4];
#pragma unroll
    for (int j = 0; j < 4; ++j) gg[j] = *(const f32x4*)(g + 4 * lane + 256 * j);
#pragma unroll 1
    for (int row0 = bid * 8 + wave; row0 < MTOK; row0 += nb * 16) {
        f32x4 v[2][4], sa[2][4], sb[2][4]; float s[2];
#pragma unroll
        for (int z = 0; z < 2; ++z) { const int row = min(row0 + z * nb * 8, MTOK - 1);
            const float* xsrc = (l == 0 && which == 0) ? (row < NCTX ? p.in[I_XP] + (size_t)row * DM : p.in[I_XS] + (size_t)(row - NCTX) * DM) : p.out + (size_t)row * DM;
            const f32x4* xr = (const f32x4*)xsrc + lane;
            const int cond = row < NCTX ? 0 : 1 + ((row - NCTX) >> 10);
            const float* sh = mod + cond * 6144; const float* scl = sh + 1024;
#pragma unroll
            for (int j = 0; j < 4; ++j) { v[z][j] = xr[64 * j]; sa[z][j] = *(const f32x4*)(sh + 4 * lane + 256 * j); sb[z][j] = *(const f32x4*)(scl + 4 * lane + 256 * j); } }
#pragma unroll
        for (int z = 0; z < 2; ++z) { const int row = row0 + z * nb * 8;
            s[z] = 0.f;
#pragma unroll
            for (int j = 0; j < 4; ++j) s[z] += (v[z][j].x * v[z][j].x + v[z][j].y * v[z][j].y) + (v[z][j].z * v[z][j].z + v[z][j].w * v[z][j].w);
            const float rstd = frsq(wave_sum(s[z]) * (1.0f / DM) + 1e-6f);
            if (row < MTOK) {
                unsigned long long* o8 = (unsigned long long*)(H + (size_t)row * DM) + lane;
#pragma unroll
                for (int j = 0; j < 4; ++j) {
                    const f32x4 y = v[z][j] * rstd * gg[j] * (sb[z][j] + 1.0f) + sa[z][j];
                    o8[64 * j] = (unsigned long long)pk2(y.x, y.y) | ((unsigned long long)pk2(y.z, y.w) << 32); } } }
    }
}
__device__ __forceinline__ void stage_final(CKP& p, int bid, int nb) {
    const int tid = opaque_tid(), lane = tid & 63, wave = tid >> 6;
    const float* g = p.in[I_FNG];
    const bf16* XB = (const bf16*)(p.ws + WS_XB); const float* ssq = (const float*)(p.ws + WS_CTL + 262144) + 49152;
    const f32x4 g0 = *(const f32x4*)(g + 8 * lane), g1 = *(const f32x4*)(g + 8 * lane + 4), g2 = *(const f32x4*)(g + 512 + 8 * lane), g3 = *(const f32x4*)(g + 512 + 8 * lane + 4);
#pragma unroll 1
    for (int row = bid * 8 + wave; row < MTOK; row += nb * 8) {
        const float rstd = frsq(ssq[row] * (1.0f / DM) + 1e-6f);
        const u32x4 a = *(const u32x4*)(XB + (size_t)row * DM + 8 * lane), b = *(const u32x4*)(XB + (size_t)row * DM + 512 + 8 * lane);
        float* o = p.out + (size_t)row * DM + 8 * lane;
        *(f32x4*)o = (f32x4){bflo(a.x), bfhi(a.x), bflo(a.y), bfhi(a.y)} * rstd * g0; *(f32x4*)(o + 4) = (f32x4){bflo(a.z), bfhi(a.z), bflo(a.w), bfhi(a.w)} * rstd * g1;
        *(f32x4*)(o + 512) = (f32x4){bflo(b.x), bfhi(b.x), bflo(b.y), bfhi(b.y)} * rstd * g2; *(f32x4*)(o + 516) = (f32x4){bflo(b.z), bfhi(b.z), bflo(b.w), bfhi(b.w)} * rstd * g3;
    }
}


typedef short bf16x8 __attribute__((ext_vector_type(8)));
typedef float f32x2v __attribute__((ext_vector_type(2)));
typedef __bf16 bf16x2v __attribute__((ext_vector_type(2)));
#define MFMA16(a, b, c) __builtin_amdgcn_mfma_f32_16x16x32_bf16((a), (b), (c), 0, 0, 0)
__device__ __forceinline__ unsigned cvt2(float lo, float hi) { f32x2v v = {lo, hi}; bf16x2v b = __builtin_convertvector(v, bf16x2v); return __builtin_bit_cast(unsigned, b); }
__device__ __forceinline__ u32x4 pack8(const float (&x)[8]) { u32x4 w; w.x = cvt2(x[0], x[1]); w.y = cvt2(x[2], x[3]); w.z = cvt2(x[4], x[5]); w.w = cvt2(x[6], x[7]); return w; }
__device__ __forceinline__ void shift8(const bf16* proj, int row, bool hasp, bool hasn, int col, const float* mu, float (&u)[8]) {
    float p[8], a[8], b[8];
    load8bf(proj + (size_t)row * DINP + col, p);
    if (hasp) load8bf(proj + (size_t)(row - 1) * DINP + col, a); else {
#pragma unroll
        for (int j = 0; j < 8; ++j) a[j] = 0.f; }
    if (hasn) load8bf(proj + (size_t)(row + 1) * DINP + col, b); else {
#pragma unroll
        for (int j = 0; j < 8; ++j) b[j] = 0.f; }
    const f32x4 m0 = *(const f32x4*)(mu + col), m1 = *(const f32x4*)(mu + col + 4);
#pragma unroll
    for (int j = 0; j < 4; ++j) { u[j] = p[j] + m0[j] * (0.5f * (a[j] + b[j]) - p[j]); u[4 + j] = p[4 + j] + m1[j] * (0.5f * (a[4 + j] + b[4 + j]) - p[4 + j]); }
}
__device__ __forceinline__ int opq(int x) { asm volatile("" : "+v"(x)); return x; }
constexpr int TS = 72, TB = 64 * TS * 2;
constexpr int L_HT = 0, L_TW = 9216, L_AD = 18432, L_LP = 27648, L_AP = 45056, L_AT = 62464, L_RT = L_AT + TB, L_BH = L_RT + TB, L_KH = L_BH + TB, L_VR = L_KH + TB, L_YS = L_VR + TB;
constexpr int L_AAB = L_TW, L_AAK = L_AAB + 4096, L_ARB = L_AAK + 3072, L_ARK = L_ARB + 3072, L_UT = L_ARK + 3072, L_W1 = L_AP;
static_assert(L_UT + 64 * 24 * 2 <= L_LP && L_YS + 17408 <= RING_BYTES, "scan LDS map");
constexpr int LPS = 68;
#define LBAR() asm volatile("s_waitcnt lgkmcnt(0)\n\ts_barrier" ::: "memory")
typedef short s16x4v __attribute__((ext_vector_type(4)));
__device__ __forceinline__ bf16x8 tr8(const LAS bf16* p) {
    const s16x4v lo = __builtin_bit_cast(s16x4v, __builtin_amdgcn_ds_read_tr16_b64_v4i16((LAS s16x4v*)p));
    const s16x4v hi = __builtin_bit_cast(s16x4v, __builtin_amdgcn_ds_read_tr16_b64_v4i16((LAS s16x4v*)(p + 4 * TS)));
    return (bf16x8){lo[0], lo[1], lo[2], lo[3], hi[0], hi[1], hi[2], hi[3]};
}

__device__ __forceinline__ void rwkv_item3(CKP& p, int l, LAS unsigned char* lds, int item) {
    const int tid0 = opaque_tid(), w = __builtin_amdgcn_readfirstlane(tid0 >> 6);
    int tid = tid0, fr = tid & 15, fg = (tid & 63) >> 4;
    int bseq, h, dir, L, base; bool lat;
    if (item < 64) { lat = true; bseq = item >> 4; h = (item >> 1) & 7; dir = item & 1; L = 1024; base = NCTX + bseq * 1024; }
    else { const int i2 = item - 64; lat = false; bseq = i2 >> 4; h = (i2 >> 1) & 7; dir = i2 & 1; L = 256; base = bseq * 256; }
    const bf16* U = (const bf16*)(p.ws + WS_U);
    const float* KINV = (const float*)(p.ws + WS_KINV);
    bf16* Yout = (bf16*)(p.ws + (dir ? WS_YB : WS_YF));
    float* BC = (float*)(p.ws + WS_BC) + (size_t)dir * MTOK * 8;
    const bf16* wupt = (const bf16*)(p.ws + WS_WUPT) + ((size_t)(l * 2 + dir) * 512 + h * 64) * 64;
    const bf16* aupt = (const bf16*)(p.ws + WS_AUPT) + ((size_t)(l * 2 + dir) * 512 + h * 64) * 64;

    LAS float* LP = (LAS float*)(lds + L_LP); LAS float* AP = (LAS float*)(lds + L_AP); LAS float* AS = (LAS float*)(lds + L_TW);
    LAS bf16* AT = (LAS bf16*)(lds + L_AT);   LAS bf16* RT = (LAS bf16*)(lds + L_RT);   LAS bf16* BH = (LAS bf16*)(lds + L_BH);   LAS bf16* KH = (LAS bf16*)(lds + L_KH);
    LAS bf16* ATT = (LAS bf16*)(lds + RING_BYTES + 1024);     LAS bf16* VR = (LAS bf16*)(lds + L_VR);   LAS float* YS = (LAS float*)(lds + L_YS);
    LAS float* AAB = (LAS float*)(lds + L_AAB); LAS bf16* ARB = (LAS bf16*)(lds + L_ARB); LAS bf16* ARK = (LAS bf16*)(lds + L_ARK);
    LAS float* W1 = (LAS float*)(lds + RING_BYTES + 1024 + 9216);
    const int tv = w & 3;
    f32x4 hacc[4];
#pragma unroll
    for (int x = 0; x < 4; ++x) {
        if (lat && w < 4) hacc[x] = *(const f32x4*)(p.in[I_STATE] + ((((size_t)bseq * 2 + l) * 2 + dir) * 8 + h) * 4096 + (16 * tv + fr) * 64 + 16 * x + 4 * fg);
        else hacc[x] = (f32x4){0.f, 0.f, 0.f, 0.f}; }
    int ei = tid >> 3, ec8 = (tid & 7) * 8; const int hc8 = h * 64 + ec8;
    float kkp[8], kap[8], rkp[8];
#pragma unroll
    for (int e = 0; e < 8; ++e) { kkp[e] = p.in[I_KK][l * 512 + hc8 + e]; kap[e] = p.in[I_KA][l * 512 + hc8 + e]; rkp[e] = p.in[I_RK][l * 512 + hc8 + e]; }
#define SCAN_PREFETCH(SC) do { const int _t0 = opq(tid0), _ei = _t0 >> 3, _ec8 = (_t0 & 7) * 8; const int _step = (SC) * 64 + _ei, _t = dir ? L - 1 - _step : _step; \
        const bf16* _u = U + (size_t)(base + _t) * 1920; \
        nr = *(const u32x4*)(_u + R_OFF + h * 64 + _ec8); nk = *(const u32x4*)(_u + K_OFF + h * 64 + _ec8); nv = *(const u32x4*)(_u + V_OFF + h * 64 + _ec8); \
        ninv = KINV[(size_t)(base + _t) * 8 + h]; \
        const int _st2 = (SC) * 64 + 16 * (w >> 1) + (_t0 & 15), _t2 = dir ? L - 1 - _st2 : _st2; const bf16* _u2 = U + (size_t)(base + _t2) * 1920 + dir * 64 + ((_t0 & 63) >> 4) * 8; \
        paw0 = *(const bf16x8*)(_u2 + WD_OFF); paw1 = *(const bf16x8*)(_u2 + WD_OFF + 32); paa0 = *(const bf16x8*)(_u2 + AD_OFF); paa1 = *(const bf16x8*)(_u2 + AD_OFF + 32); } while (0)
    bf16x8 lbw[2][2], lba[2][2]; float lw0c[2]; f32x4 la0v[2];
#pragma unroll
    for (int x = 0; x < 2; ++x) { const int c = ((w & 1) * 2 + x) * 16 + fr;
        lbw[x][0] = *(const bf16x8*)(wupt + c * 64 + fg * 8); lbw[x][1] = *(const bf16x8*)(wupt + c * 64 + 32 + fg * 8);
        lba[x][0] = *(const bf16x8*)(aupt + c * 64 + fg * 8); lba[x][1] = *(const bf16x8*)(aupt + c * 64 + 32 + fg * 8);
        lw0c[x] = p.in[I_W0][(l * 2 + dir) * 512 + h * 64 + c]; la0v[x] = *(const f32x4*)(p.in[I_A0] + (l * 2 + dir) * 512 + h * 64 + ((w & 1) * 2 + x) * 16 + 4 * fg); }
    u32x4 nr, nk, nv; float ninv; bf16x8 paw0, paw1, paa0, paa1;
    SCAN_PREFETCH(0);
    __syncthreads();
#pragma unroll 1
    for (int sc = 0; sc < L / 64; ++sc) {
        tid = opq(tid0); fr = tid & 15; fg = (tid & 63) >> 4; ei = tid >> 3; ec8 = (tid & 7) * 8;
        const u32x4 cr = nr, ck = nk, cv = nv; const float kinv = ninv;
        { const int ti = w >> 1;
          const bf16x8 aw0 = paw0, aw1 = paw1, aa0 = paa0, aa1 = paa1;
          unsigned li[2];
#pragma unroll
          for (int pr = 0; pr < 2; ++pr) { const int j0 = 4 * fg + 2 * pr, j1 = j0 + 1; li[pr] = (j0 <= fr ? 0x3f80u : 0u) | (j1 <= fr ? 0x3f800000u : 0u); }
          const bf16x8 Li = __builtin_bit_cast(bf16x8, (u32x4){li[0], li[1], 0u, 0u});
#pragma unroll
          for (int x = 0; x < 2; ++x) { const int c = ((w & 1) * 2 + x) * 16 + fr;
              f32x4 cw = (f32x4){lw0c[x], lw0c[x], lw0c[x], lw0c[x]}, ca = la0v[x];
              cw = MFMA16(aw0, lbw[x][0], cw); cw = MFMA16(aw1, lbw[x][1], cw); ca = MFMA16(lba[x][0], aa0, ca); ca = MFMA16(lba[x][1], aa1, ca);
              float lw[4], lo[4];
#pragma unroll
              for (int r = 0; r < 4; ++r) lw[r] = -0.6065306597126334f * fsigmoid(cw[r]);
              const unsigned h01 = cvt2(lw[0], lw[1]), h23 = cvt2(lw[2], lw[3]);
              lo[0] = lw[0] - bflo(h01); lo[1] = lw[1] - bfhi(h01); lo[2] = lw[2] - bflo(h23); lo[3] = lw[3] - bfhi(h23);
              const bf16x8 bh = __builtin_bit_cast(bf16x8, (u32x4){h01, h23, 0u, 0u}), bl = __builtin_bit_cast(bf16x8, (u32x4){cvt2(lo[0], lo[1]), cvt2(lo[2], lo[3]), 0u, 0u});
              f32x4 ci = (f32x4){0.f, 0.f, 0.f, 0.f};
              ci = MFMA16(bh, Li, ci); ci = MFMA16(bl, Li, ci);
              const int o = (ti * 16 + fr) * LPS + ((w & 1) * 2 + x) * 16 + 4 * fg;
              *(LAS f32x4*)(LP + o) = (f32x4){fexp(ci[0]), fexp(ci[1]), fexp(ci[2]), fexp(ci[3])};
              *(LAS f32x4*)(AS + o) = (f32x4){fsigmoid(ca[0]), fsigmoid(ca[1]), fsigmoid(ca[2]), fsigmoid(ca[3])}; } }
        __syncthreads();
        tid = opq(tid0); fr = tid & 15; fg = (tid & 63) >> 4; ei = tid >> 3; ec8 = (tid & 7) * 8;
        float bcv;
        { const f32x4 g0 = *(const LAS f32x4*)(LP + ei * LPS + ec8), g1 = *(const LAS f32x4*)(LP + ei * LPS + ec8 + 4);
          const int ip = (ei & 15) ? ei - 1 : ei;
          f32x4 p0 = *(const LAS f32x4*)(LP + ip * LPS + ec8), p1 = *(const LAS f32x4*)(LP + ip * LPS + ec8 + 4);
          if ((ei & 15) == 0) { p0 = (f32x4){1.f, 1.f, 1.f, 1.f}; p1 = p0; }
          const f32x4 s0 = *(const LAS f32x4*)(AS + ei * LPS + ec8), s1 = *(const LAS f32x4*)(AS + ei * LPS + ec8 + 4);
          float rr[8], kk[8], xa[8], xr[8], xb[8], xk[8], bc = 0.f;
          rr[0] = bflo(cr.x); rr[1] = bfhi(cr.x); rr[2] = bflo(cr.y); rr[3] = bfhi(cr.y); rr[4] = bflo(cr.z); rr[5] = bfhi(cr.z); rr[6] = bflo(cr.w); rr[7] = bfhi(cr.w);
          kk[0] = bflo(ck.x); kk[1] = bfhi(ck.x); kk[2] = bflo(ck.y); kk[3] = bfhi(ck.y); kk[4] = bflo(ck.z); kk[5] = bfhi(ck.z); kk[6] = bflo(ck.w); kk[7] = bfhi(ck.w);
#pragma unroll
          for (int e = 0; e < 8; ++e) { const float gi = e < 4 ? g0[e & 3] : g1[e & 3], gp = e < 4 ? p0[e & 3] : p1[e & 3], asg = e < 4 ? s0[e & 3] : s1[e & 3];
              const float kj = kk[e] * kkp[e] * kinv, kd = kk[e] * (1.0f + (asg - 1.0f) * kap[e]), ginv = frcp(gi);
              bc += rr[e] * kd * rkp[e];
              xa[e] = -kj * gp; xr[e] = rr[e] * gi; xb[e] = kj * asg * ginv; xk[e] = kd * ginv; }
          bcv = red8(bc);
          *(LAS u32x4*)(AT + ei * TS + ec8) = pack8(xa); *(LAS u32x4*)(RT + ei * TS + ec8) = pack8(xr); *(LAS u32x4*)(BH + ei * TS + ec8) = pack8(xb); *(LAS u32x4*)(KH + ei * TS + ec8) = pack8(xk);
          *(LAS u32x4*)(VR + ei * TS + ec8) = cv; }
        __syncthreads();
        tid = opq(tid0); fr = tid & 15; fg = (tid & 63) >> 4;
        { const int q = w >> 1, half = w & 1; const LAS bf16* Asrc = half ? RT : AT;
          const bf16x8 af0 = *(const LAS bf16x8*)(Asrc + (16 * q + fr) * TS + fg * 8), af1 = *(const LAS bf16x8*)(Asrc + (16 * q + fr) * TS + 32 + fg * 8);
          const bf16x8 bb0 = *(const LAS bf16x8*)(BH + (16 * q + fr) * TS + fg * 8), bb1 = *(const LAS bf16x8*)(BH + (16 * q + fr) * TS + 32 + fg * 8);
          const bf16x8 bk0 = *(const LAS bf16x8*)(KH + (16 * q + fr) * TS + fg * 8), bk1 = *(const LAS bf16x8*)(KH + (16 * q + fr) * TS + 32 + fg * 8);
          bf16x8 at0 = af0, at1 = af1;
          if (half) { at0 = *(const LAS bf16x8*)(AT + (16 * q + fr) * TS + fg * 8); at1 = *(const LAS bf16x8*)(AT + (16 * q + fr) * TS + 32 + fg * 8); }
          u32x2 vt[2];
#pragma unroll
          for (int x = 0; x < 2; ++x) vt[x] = __builtin_bit_cast(u32x2, __builtin_amdgcn_ds_read_tr16_b64_v4i16((LAS s16x4v*)(VR + (16 * q + 4 * fg + (fr >> 2)) * TS + 16 * (2 * half + x) + 4 * (fr & 3))));
          f32x4 cakT = (f32x4){0.f, 0.f, 0.f, 0.f};
          cakT = MFMA16(bk0, at0, cakT); cakT = MFMA16(bk1, at1, cakT);
          if (half == 0) { f32x4 cx = (f32x4){0.f, 0.f, 0.f, 0.f};
              cx = MFMA16(af0, bb0, cx); cx = MFMA16(af1, bb1, cx);
              f32x4 mx;
#pragma unroll
              for (int r = 0; r < 4; ++r) mx[r] = fr < 4 * fg + r ? cx[r] : 0.f;
              *(LAS f32x4*)(AAB + (q * 16 + fr) * 16 + 4 * fg) = mx; }
          else { f32x4 crb = (f32x4){0.f, 0.f, 0.f, 0.f}, crk = crb;
              crb = MFMA16(bb0, af0, crb); crb = MFMA16(bb1, af1, crb);
              crk = MFMA16(bk0, af0, crk); crk = MFMA16(bk1, af1, crk);
              f32x4 mb, mk;
#pragma unroll
              for (int r = 0; r < 4; ++r) { const bool lo = 4 * fg + r <= fr; mb[r] = lo ? crb[r] : 0.f; mk[r] = lo ? crk[r] : 0.f; }
              *(LAS u32x2*)(ARB + (q * 16 + fr) * 24 + 4 * fg) = (u32x2){cvt2(mb[0], mb[1]), cvt2(mb[2], mb[3])};
              *(LAS u32x2*)(ARK + (q * 16 + fr) * 24 + 4 * fg) = (u32x2){cvt2(mk[0], mk[1]), cvt2(mk[2], mk[3])}; }
          {
              f32x4 mak;
#pragma unroll
              for (int r = 0; r < 4; ++r) mak[r] = (4 * fg + r) < fr ? cakT[r] : 0.f;
              const bf16x8 af = __builtin_bit_cast(bf16x8, (u32x4){cvt2(mak[0], mak[1]), cvt2(mak[2], mak[3]), 0u, 0u});
#pragma unroll
              for (int x = 0; x < 2; ++x) { const int tvv = 2 * half + x;
                  const bf16x8 bfv = __builtin_bit_cast(bf16x8, (u32x4){vt[x].x, vt[x].y, 0u, 0u});
                  f32x4 c = (f32x4){0.f, 0.f, 0.f, 0.f}; c = MFMA16(af, bfv, c);
                  *(LAS f32x4*)(W1 + (q * 64 + 16 * tvv + fr) * 20 + 4 * fg) = c; } } }
        __syncthreads();
        tid = opq(tid0);
        if (w < 4) { const int q = w, col = tid & 63; float x[16], z[16];
#pragma unroll
          for (int k4 = 0; k4 < 4; ++k4) {
              const u32x2 t2 = __builtin_bit_cast(u32x2, __builtin_amdgcn_ds_read_tr16_b64_v4i16((LAS s16x4v*)(AT + (16 * q + 4 * k4 + ((col & 15) >> 2)) * TS + (col & 48) + 4 * (col & 3))));
              x[4 * k4] = bflo(t2.x); x[4 * k4 + 1] = bfhi(t2.x); x[4 * k4 + 2] = bflo(t2.y); x[4 * k4 + 3] = bfhi(t2.y); }
#pragma unroll
          for (int i4 = 0; i4 < 4; ++i4) { const f32x4 zz = *(const LAS f32x4*)(W1 + (q * 64 + col) * 20 + 4 * i4); z[4 * i4] = zz[0]; z[4 * i4 + 1] = zz[1]; z[4 * i4 + 2] = zz[2]; z[4 * i4 + 3] = zz[3]; }
#pragma unroll
          for (int j = 0; j < 15; ++j) {
              const LAS f32x4* ac = (const LAS f32x4*)(AAB + (q * 16 + j) * 16);
#pragma unroll
              for (int i4 = (j + 1) / 4; i4 < 4; ++i4) { const f32x4 a4 = ac[i4];
#pragma unroll
                  for (int e = 0; e < 4; ++e) if (i4 * 4 + e > j) { x[i4 * 4 + e] += a4[e] * x[j]; z[i4 * 4 + e] += a4[e] * z[j]; } } }
#pragma unroll
          for (int i4 = 0; i4 < 4; ++i4) *(LAS f32x4*)(W1 + (q * 64 + col) * 20 + 4 * i4) = (f32x4){z[4 * i4], z[4 * i4 + 1], z[4 * i4 + 2], z[4 * i4 + 3]};
          *(LAS u32x4*)(ATT + col * TS + 16 * q) = (u32x4){cvt2(x[0], x[1]), cvt2(x[2], x[3]), cvt2(x[4], x[5]), cvt2(x[6], x[7])};
          *(LAS u32x4*)(ATT + col * TS + 16 * q + 8) = (u32x4){cvt2(x[8], x[9]), cvt2(x[10], x[11]), cvt2(x[12], x[13]), cvt2(x[14], x[15])}; }
        __syncthreads();
        if (sc + 1 < L / 64) SCAN_PREFETCH(sc + 1);
        if (w < 4) {
        tid = opq(tid0); fr = tid & 15; fg = (tid & 63) >> 4;
#pragma unroll
        for (int q = 0; q < 4; ++q) {
            bf16x8 hb[2];
#pragma unroll
            for (int ks = 0; ks < 2; ++ks) { u32x4 t; t.x = cvt2(hacc[2 * ks][0], hacc[2 * ks][1]); t.y = cvt2(hacc[2 * ks][2], hacc[2 * ks][3]);
                t.z = cvt2(hacc[2 * ks + 1][0], hacc[2 * ks + 1][1]); t.w = cvt2(hacc[2 * ks + 1][2], hacc[2 * ks + 1][3]); hb[ks] = __builtin_bit_cast(bf16x8, t); }
            bf16x8 aU[2], aR[2];
#pragma unroll
            for (int ks = 0; ks < 2; ++ks) {
                const u32x2 a0 = __builtin_bit_cast(u32x2, __builtin_amdgcn_ds_read_tr16_b64_v4i16((LAS s16x4v*)(ATT + (32 * ks + 4 * fg + (fr >> 2)) * TS + 16 * q + 4 * (fr & 3))));
                const u32x2 a1 = __builtin_bit_cast(u32x2, __builtin_amdgcn_ds_read_tr16_b64_v4i16((LAS s16x4v*)(ATT + (32 * ks + 16 + 4 * fg + (fr >> 2)) * TS + 16 * q + 4 * (fr & 3))));
                const u32x2 r0 = *(const LAS u32x2*)(RT + (16 * q + fr) * TS + 32 * ks + 4 * fg), r1 = *(const LAS u32x2*)(RT + (16 * q + fr) * TS + 32 * ks + 16 + 4 * fg);
                aU[ks] = __builtin_bit_cast(bf16x8, (u32x4){a0.x, a0.y, a1.x, a1.y}); aR[ks] = __builtin_bit_cast(bf16x8, (u32x4){r0.x, r0.y, r1.x, r1.y}); }
            f32x4 u, yacc = (f32x4){0.f, 0.f, 0.f, 0.f};
            u = *(const LAS f32x4*)(W1 + (q * 64 + 16 * tv + fr) * 20 + 4 * fg);
            u = MFMA16(aU[0], hb[0], u); u = MFMA16(aU[1], hb[1], u);
            yacc = MFMA16(aR[0], hb[0], yacc); yacc = MFMA16(aR[1], hb[1], yacc);
            const s16x4v vtr = __builtin_bit_cast(s16x4v, __builtin_amdgcn_ds_read_tr16_b64_v4i16((LAS s16x4v*)(VR + (16 * q + 4 * fg + (fr >> 2)) * TS + 16 * tv + 4 * (fr & 3))));
            const u32x2 vt2 = __builtin_bit_cast(u32x2, vtr);
            const bf16x8 bUV = __builtin_bit_cast(bf16x8, (u32x4){cvt2(u[0], u[1]), cvt2(u[2], u[3]), vt2.x, vt2.y});
            { const u32x2 y0 = *(const LAS u32x2*)(ARB + (q * 16 + fr) * 24 + 4 * fg), y1 = *(const LAS u32x2*)(ARK + (q * 16 + fr) * 24 + 4 * fg);
              yacc = MFMA16(__builtin_bit_cast(bf16x8, (u32x4){y0.x, y0.y, y1.x, y1.y}), bUV, yacc); }
#pragma unroll
            for (int r = 0; r < 4; ++r) YS[(16 * q + 4 * fg + r) * LPS + 16 * tv + fr] = yacc[r];
#pragma unroll
            for (int x = 0; x < 4; ++x) {
                const s16x4v bt = __builtin_bit_cast(s16x4v, __builtin_amdgcn_ds_read_tr16_b64_v4i16((LAS s16x4v*)(BH + (16 * q + 4 * fg + (fr >> 2)) * TS + 16 * x + 4 * (fr & 3))));
                const s16x4v kt = __builtin_bit_cast(s16x4v, __builtin_amdgcn_ds_read_tr16_b64_v4i16((LAS s16x4v*)(KH + (16 * q + 4 * fg + (fr >> 2)) * TS + 16 * x + 4 * (fr & 3))));
                const u32x2 b2 = __builtin_bit_cast(u32x2, bt), k2 = __builtin_bit_cast(u32x2, kt);
                const f32x4 ge = *(const LAS f32x4*)(LP + (16 * q + 15) * LPS + 16 * x + 4 * fg);
                hacc[x] = MFMA16(__builtin_bit_cast(bf16x8, (u32x4){b2.x, b2.y, k2.x, k2.y}), bUV, hacc[x]) * ge; }
        }
        }
        __syncthreads();
        tid = opq(tid0); ei = tid >> 3; ec8 = (tid & 7) * 8;
        { const int st2 = sc * 64 + ei, t2 = dir ? L - 1 - st2 : st2; bf16* yo = Yout + (size_t)(base + t2) * 512 + h * 64 + ec8;
          const f32x4 y0 = *(const LAS f32x4*)(YS + ei * LPS + ec8), y1 = *(const LAS f32x4*)(YS + ei * LPS + ec8 + 4);
          u32x4 yw; yw.x = cvt2(y0[0], y0[1]); yw.y = cvt2(y0[2], y0[3]); yw.z = cvt2(y1[0], y1[1]); yw.w = cvt2(y1[2], y1[3]);
          *(u32x4*)yo = yw;
          if ((tid & 7) == 0) BC[(size_t)(base + t2) * 8 + h] = bcv; }
    }
#undef SCAN_PREFETCH
    if (!lat && w < 4) {
#pragma unroll
        for (int x = 0; x < 4; ++x) *(f32x4*)(p.out + (size_t)MTOK * DM + ((((size_t)bseq * 2 + l) * 2 + dir) * 8 + h) * 4096 + (16 * tv + fr) * 64 + 16 * x + 4 * fg) = hacc[x]; }
    __syncthreads();
}

__device__ __forceinline__ void stage_upass(CKP& p, int l, int bid, int nb) {
    const int tid = opaque_tid(), sub = tid >= 240 ? 1 : 0, j = tid - sub * 240, col = 8 * j;
    const bf16* proj = (const bf16*)(p.ws + WS_PROJ); bf16* U = (bf16*)(p.ws + WS_U); float* KINV = (float*)(p.ws + WS_KINV);
    const float* mu = p.in[I_MU] + l * 1920;
    if (tid < 480) {
        const bool isk = col >= K_OFF && col < V_OFF;
        const float* kkp = p.in[I_KK] + l * 512 + (isk ? col - K_OFF : 0);
        const f32x4 k0 = *(const f32x4*)kkp, k1 = *(const f32x4*)(kkp + 4);
        const f32x4 m0 = *(const f32x4*)(mu + col), m1 = *(const f32x4*)(mu + col + 4);
        constexpr int NG = MTOK / 6;
        u32x4 w[2][8];
        int g = 4 * (bid * 2 + sub);
#define UP_LOAD(B, G) do { _Pragma("unroll") for (int i = 0; i < 8; ++i) { const int row = min(max((G) * 6 - 1 + i, 0), MTOK - 1); w[B][i] = *(const u32x4*)(proj + (size_t)row * DINP + col); } } while (0)
        if (g < NG) UP_LOAD(0, g);
#pragma unroll 1
        for (int it = 0; g < NG; ++it) {
            const int gn = ((it & 3) == 3) ? g + 1 + 4 * (nb * 2 - 1) : g + 1;
#pragma unroll
            for (int half = 0; half < 2; ++half) if ((it & 1) == half) {
                if (gn < NG) UP_LOAD(half ^ 1, gn);
#pragma unroll
                for (int z = 0; z < 6; ++z) { const int tok = g * 6 + z;
                    const bool lat = tok >= NCTX; const int L = lat ? 1024 : 256, t = lat ? (tok - NCTX) & 1023 : tok & 255;
                    const bool hasp = t > 0, hasn = t < L - 1;
                    const u32x4 wp = w[half][z], wc = w[half][z + 1], wn = w[half][z + 2];
                    float pc[8], pa[8], pb[8], uu[8];
                    pc[0] = bflo(wc.x); pc[1] = bfhi(wc.x); pc[2] = bflo(wc.y); pc[3] = bfhi(wc.y); pc[4] = bflo(wc.z); pc[5] = bfhi(wc.z); pc[6] = bflo(wc.w); pc[7] = bfhi(wc.w);
                    pa[0] = bflo(wp.x); pa[1] = bfhi(wp.x); pa[2] = bflo(wp.y); pa[3] = bfhi(wp.y); pa[4] = bflo(wp.z); pa[5] = bfhi(wp.z); pa[6] = bflo(wp.w); pa[7] = bfhi(wp.w);
                    pb[0] = bflo(wn.x); pb[1] = bfhi(wn.x); pb[2] = bflo(wn.y); pb[3] = bfhi(wn.y); pb[4] = bflo(wn.z); pb[5] = bfhi(wn.z); pb[6] = bflo(wn.w); pb[7] = bfhi(wn.w);
#pragma unroll
                    for (int e = 0; e < 8; ++e) { const float a = hasp ? pa[e] : 0.f, b = hasn ? pb[e] : 0.f; uu[e] = pc[e] + (e < 4 ? m0[e & 3] : m1[e & 3]) * (0.5f * (a + b) - pc[e]); }
                    float ss = 0.f;
#pragma unroll
                    for (int e = 0; e < 8; ++e) { const float kn = uu[e] * (e < 4 ? k0[e & 3] : k1[e & 3]); ss += kn * kn; }
                    ss = red8(ss);
                    if (isk && (j & 7) == 0) KINV[(size_t)tok * 8 + ((col - K_OFF) >> 6)] = fminf(frsq(ss), 1e12f);
                    if (col >= WD_OFF && col < AD_OFF) {
#pragma unroll
                        for (int e = 0; e < 8; ++e) uu[e] = 1.0f - 2.0f * frcp(fexp(2.0f * uu[e]) + 1.0f); }
                    if (col >= GD_OFF) {
#pragma unroll
                        for (int e = 0; e < 8; ++e) uu[e] = fsigmoid(uu[e]); }
                    *(u32x4*)(U + (size_t)tok * 1920 + col) = pack8(uu); }
            }
            g = gn;
        }
#undef UP_LOAD
    }
}

__device__ __forceinline__ void stage_fnet1(CKP& p, int l, int bid, int nb) {
    const int tid = opaque_tid(), lane = tid & 63, w = __builtin_amdgcn_readfirstlane(tid >> 6), fr = lane & 15, fg = lane >> 4;
    const int tt = w & 3, cs = w >> 2;
    const bf16* proj = (const bf16*)(p.ws + WS_PROJ);
#pragma unroll 1
    for (int it0 = bid; it0 < 768; it0 += 3 * nb) {
        const int g = it0 & 3;
        const bool same = (nb & 3) == 0;
        const bf16* fwt = (const bf16*)(p.ws + WS_FW) + (size_t)((l * 4 + g) * 128 + cs * 64) * 64;
        bf16x8 a0[3], a1[3], b0[4], b1[4];
#pragma unroll
        for (int k = 0; k < 3; ++k) { const int item = min(it0 + k * nb, 767), tok0 = (item >> 2) * 64;
            const bf16* xr = proj + (size_t)(tok0 + 16 * tt + fr) * DINP + F_OFF + (item & 3) * 64 + fg * 8;
            a0[k] = *(const bf16x8*)xr; a1[k] = *(const bf16x8*)(xr + 32); }
#pragma unroll
        for (int ot = 0; ot < 4; ++ot) { b0[ot] = *(const bf16x8*)(fwt + (16 * ot + fr) * 64 + fg * 8); b1[ot] = *(const bf16x8*)(fwt + (16 * ot + fr) * 64 + 32 + fg * 8); }
#pragma unroll
        for (int k = 0; k < 3; ++k) { const int item = it0 + k * nb;
            if (item < 768) {
                const int gk = item & 3, tok0 = (item >> 2) * 64;
                const bool lat = tok0 >= NCTX;
                const int L = lat ? 1024 : 256, bq = lat ? (tok0 - NCTX) >> 10 : tok0 >> 8, t = (lat ? (tok0 - NCTX) & 1023 : tok0 & 255) + 16 * tt + 4 * fg;
                const float scale = lat ? (1.0f / 256.0f) : (1.0f / 128.0f);
                bf16* Y = (bf16*)(p.ws + WS_YCS) + (lat ? (size_t)8192 * 512 : 0);
                const bf16* fwk = (const bf16*)(p.ws + WS_FW) + (size_t)((l * 4 + gk) * 128 + cs * 64) * 64;
#pragma unroll
                for (int ot = 0; ot < 4; ++ot) {
                    bf16x8 c0 = b0[ot], c1 = b1[ot];
                    if (!same) { c0 = *(const bf16x8*)(fwk + (16 * ot + fr) * 64 + fg * 8); c1 = *(const bf16x8*)(fwk + (16 * ot + fr) * 64 + 32 + fg * 8); }
                    f32x4 c = (f32x4){0.f, 0.f, 0.f, 0.f}; c = MFMA16(a0[k], c0, c); c = MFMA16(a1[k], c1, c);
                    u32x2 o; o.x = cvt2(c[0] * scale, c[1] * scale); o.y = cvt2(c[2] * scale, c[3] * scale);
                    *(u32x2*)(Y + (size_t)((bq * 4 + gk) * 64 + 16 * ot + fr) * (2 * L) + cs * L + t) = o; } } }
    }
}

__device__ __forceinline__ void stage_pool3(CKP& p, int l, LAS unsigned char* lds, int bid) {
    const int tid = opaque_tid(), gi = bid & 3, hw = 1 << gi, tb0 = bid >> 2;
    const bf16* proj = (const bf16*)(p.ws + WS_PROJ);
    LAS bf16* DB = (LAS bf16*)lds;
    LAS float* CSUM = (LAS float*)(lds + 9216);
    LAS bf16* RS = (LAS bf16*)(lds + 32768);
    const int ti = tid >> 3, c8 = (tid & 7) * 8, colg = P_OFF + gi * 64;
    u32x4 rs[2][2];
#pragma unroll
    for (int k = 0; k < 2; ++k) { const int tok0 = (tb0 + 64 * k) * 64, sb = tok0 & ~255;
#pragma unroll
        for (int z = 0; z < 2; ++z) { const int i = tid + 512 * z, row = i >> 3, tq = tok0 - hw + row;
            rs[k][z] = (i < 640 && row < 64 + 2 * hw && tq >= sb && tq < sb + 256) ? *(const u32x4*)(proj + (size_t)tq * DINP + colg + (i & 7) * 8) : (u32x4){0u, 0u, 0u, 0u}; } }
    const int tok0c = (tb0 + 128) * 64, tokc = tok0c + ti, tl = (tokc - NCTX) & 1023, sbc = tokc - tl, rl = tl >> 6, cl = tl & 63;
    u32x4 xc = *(const u32x4*)(proj + (size_t)tokc * DINP + colg + c8), wv[16];
#pragma unroll
    for (int q = 0; q < 16; ++q) { const int rq = rl - hw + q; wv[q] = (q < 2 * hw && rq >= 0 && rq < 16) ? *(const u32x4*)(proj + (size_t)(sbc + rq * 64 + cl) * DINP + colg + c8) : (u32x4){0u, 0u, 0u, 0u}; }
#pragma unroll
    for (int k = 0; k < 2; ++k)
#pragma unroll
        for (int z = 0; z < 2; ++z) { const int i = tid + 512 * z; if (i < 640) *(LAS u32x4*)(RS + k * 80 * 72 + (i >> 3) * 72 + (i & 7) * 8) = rs[k][z]; }
    __syncthreads();
    const int lane = tid & 63, w = __builtin_amdgcn_readfirstlane(tid >> 6), fr = lane & 15, fg = lane >> 4, tt = w & 3;
    const bf16* wpt = (const bf16*)(p.ws + WS_WPT) + (size_t)(l * 4 + gi) * 4096;
    bf16x8 a0[2], a1[2]; f32x4 ps[2];
#pragma unroll
    for (int x = 0; x < 2; ++x) { const int ot = 2 * (w >> 2) + x;
        a0[x] = *(const bf16x8*)(wpt + (16 * ot + fr) * 64 + fg * 8); a1[x] = *(const bf16x8*)(wpt + (16 * ot + fr) * 64 + 32 + fg * 8);
        ps[x] = *(const f32x4*)(p.in[I_PSCALE] + l * 256 + gi * 64 + 16 * ot + 4 * fg); }
    auto finish = [&](int tok0) {
        const bf16x8 b0 = *(const LAS bf16x8*)(DB + (16 * tt + fr) * 72 + fg * 8), b1 = *(const LAS bf16x8*)(DB + (16 * tt + fr) * 72 + 32 + fg * 8);
#pragma unroll
        for (int x = 0; x < 2; ++x) { const int ot = 2 * (w >> 2) + x;
            f32x4 c = (f32x4){0.f, 0.f, 0.f, 0.f}; c = MFMA16(a0[x], b0, c); c = MFMA16(a1[x], b1, c);
            c *= ps[x];
            u32x2 o; o.x = cvt2(c[0], c[1]); o.y = cvt2(c[2], c[3]);
            *(u32x2*)((bf16*)(p.ws + WS_MIXED) + (size_t)(tok0 + 16 * tt + fr) * DM + 768 + gi * 64 + 16 * ot + 4 * fg) = o; } };
#pragma unroll 1
    for (int k = 0; k < 2; ++k) { const int tok0 = (tb0 + 64 * k) * 64, t = (tok0 + ti) & 255, lo = max(t - hw, 0), hi = min(t + hw, 256);
        const LAS bf16* R = RS + k * 80 * 72;
        float sum[8];
#pragma unroll
        for (int j = 0; j < 8; ++j) sum[j] = 0.f;
#pragma unroll 1
        for (int q = 0; q < 2 * hw; ++q) { const u32x4 v = *(const LAS u32x4*)(R + (ti + q) * 72 + c8);
            sum[0] += bflo(v.x); sum[1] += bfhi(v.x); sum[2] += bflo(v.y); sum[3] += bfhi(v.y); sum[4] += bflo(v.z); sum[5] += bfhi(v.z); sum[6] += bflo(v.w); sum[7] += bfhi(v.w); }
        const u32x4 xv = *(const LAS u32x4*)(R + (ti + hw) * 72 + c8);
        const float ic = frcp((float)(hi - lo));
        float dd[8]; const float x[8] = {bflo(xv.x), bfhi(xv.x), bflo(xv.y), bfhi(xv.y), bflo(xv.z), bfhi(xv.z), bflo(xv.w), bfhi(xv.w)};
#pragma unroll
        for (int j = 0; j < 8; ++j) dd[j] = sum[j] * ic - x[j];
        *(LAS u32x4*)(DB + ti * 72 + c8) = pack8(dd);
        __syncthreads();
        finish(tok0);
        __syncthreads(); }
    { float sum[8];
#pragma unroll
      for (int j = 0; j < 8; ++j) sum[j] = 0.f;
#pragma unroll
      for (int q = 0; q < 16; ++q) { const u32x4 v = wv[q];
          sum[0] += bflo(v.x); sum[1] += bfhi(v.x); sum[2] += bflo(v.y); sum[3] += bfhi(v.y); sum[4] += bflo(v.z); sum[5] += bfhi(v.z); sum[6] += bflo(v.w); sum[7] += bfhi(v.w); }
      *(LAS f32x4*)(CSUM + ti * 68 + c8) = (f32x4){sum[0], sum[1], sum[2], sum[3]}; *(LAS f32x4*)(CSUM + ti * 68 + c8 + 4) = (f32x4){sum[4], sum[5], sum[6], sum[7]};
      __syncthreads();
      const int rlo = max(rl - hw, 0), rhi = min(rl + hw, 16), clo = max(cl - hw, 0), chi = min(cl + hw, 64);
#pragma unroll
      for (int j = 0; j < 8; ++j) sum[j] = 0.f;
      for (int cq = clo; cq < chi; ++cq) { const f32x4 a = *(const LAS f32x4*)(CSUM + cq * 68 + c8), b = *(const LAS f32x4*)(CSUM + cq * 68 + c8 + 4);
#pragma unroll
          for (int j = 0; j < 4; ++j) { sum[j] += a[j]; sum[4 + j] += b[j]; } }
      const float ic = frcp((float)((rhi - rlo) * (chi - clo)));
      float dd[8]; const float x[8] = {bflo(xc.x), bfhi(xc.x), bflo(xc.y), bfhi(xc.y), bflo(xc.z), bfhi(xc.z), bflo(xc.w), bfhi(xc.w)};
#pragma unroll
      for (int j = 0; j < 8; ++j) dd[j] = sum[j] * ic - x[j];
      *(LAS u32x4*)(DB + ti * 72 + c8) = pack8(dd);
      __syncthreads();
      finish(tok0c);
      __syncthreads(); }
}
__device__ __forceinline__ void pool_item(CKP& p, int l, LAS unsigned char* lds, int item) {
    const int tid = opaque_tid(), tb = item >> 2, gi = item & 3, tok0 = tb * 64, hw = 1 << gi;
    const bf16* proj = (const bf16*)(p.ws + WS_PROJ);
    LAS bf16* DB = (LAS bf16*)lds;
    LAS float* CSUM = (LAS float*)(lds + 9216);
    const int ti = tid >> 3, c8 = (tid & 7) * 8, tok = tok0 + ti, col = P_OFF + gi * 64 + c8;
    { float sum[8], x[8];
#pragma unroll
      for (int j = 0; j < 8; ++j) sum[j] = 0.f;
      load8bf(proj + (size_t)tok * DINP + col, x);
      float cnt;
      if (tok < NCTX) { const int t = tok & 255, sb = tok - t, lo = max(t - hw, 0), hi = min(t + hw, 256);
          u32x4 wv[16];
#pragma unroll
          for (int q = 0; q < 16; ++q) { const int tq = min(t - hw + q, 255); wv[q] = (q < 2 * hw && tq >= 0) ? *(const u32x4*)(proj + (size_t)(sb + max(tq, 0)) * DINP + col) : (u32x4){0u, 0u, 0u, 0u}; }
#pragma unroll
          for (int q = 0; q < 16; ++q) if (q < 2 * hw) { const bool ok = t - hw + q >= 0 && t - hw + q < 256; const u32x4 w = wv[q];
              if (ok) { sum[0] += bflo(w.x); sum[1] += bfhi(w.x); sum[2] += bflo(w.y); sum[3] += bfhi(w.y); sum[4] += bflo(w.z); sum[5] += bfhi(w.z); sum[6] += bflo(w.w); sum[7] += bfhi(w.w); } }
          cnt = (float)(hi - lo); }
      else {
          const int t = (tok - NCTX) & 1023, sb = tok - t, r = t >> 6, c = t & 63, rlo = max(r - hw, 0), rhi = min(r + hw, 16), clo = max(c - hw, 0), chi = min(c + hw, 64);
          u32x4 wv[16];
#pragma unroll
          for (int q = 0; q < 16; ++q) { const int rq = r - hw + q; wv[q] = (q < 2 * hw && rq >= 0 && rq < 16) ? *(const u32x4*)(proj + (size_t)(sb + rq * 64 + c) * DINP + col) : (u32x4){0u, 0u, 0u, 0u}; }
#pragma unroll
          for (int q = 0; q < 16; ++q) { const u32x4 w = wv[q];
              sum[0] += bflo(w.x); sum[1] += bfhi(w.x); sum[2] += bflo(w.y); sum[3] += bfhi(w.y); sum[4] += bflo(w.z); sum[5] += bfhi(w.z); sum[6] += bflo(w.w); sum[7] += bfhi(w.w); }
          *(LAS f32x4*)(CSUM + ti * 68 + c8) = (f32x4){sum[0], sum[1], sum[2], sum[3]}; *(LAS f32x4*)(CSUM + ti * 68 + c8 + 4) = (f32x4){sum[4], sum[5], sum[6], sum[7]};
          __syncthreads();
#pragma unroll
          for (int j = 0; j < 8; ++j) sum[j] = 0.f;
          for (int cq = clo; cq < chi; ++cq) { const f32x4 a = *(const LAS f32x4*)(CSUM + cq * 68 + c8), b = *(const LAS f32x4*)(CSUM + cq * 68 + c8 + 4);
#pragma unroll
              for (int j = 0; j < 4; ++j) { sum[j] += a[j]; sum[4 + j] += b[j]; } }
          cnt = (float)((rhi - rlo) * (chi - clo)); }
      const float ic = frcp(cnt);
      float dd[8];
#pragma unroll
      for (int j = 0; j < 8; ++j) dd[j] = sum[j] * ic - x[j];
      *(LAS u32x4*)(DB + ti * 72 + c8) = pack8(dd); }
    __syncthreads();
    { const int lane = tid & 63, w = __builtin_amdgcn_readfirstlane(tid >> 6), fr = lane & 15, fg = lane >> 4, tt = w & 3;
      const bf16* wpt = (const bf16*)(p.ws + WS_WPT) + (size_t)(l * 4 + gi) * 4096;
      const bf16x8 b0 = *(const LAS bf16x8*)(DB + (16 * tt + fr) * 72 + fg * 8), b1 = *(const LAS bf16x8*)(DB + (16 * tt + fr) * 72 + 32 + fg * 8);
#pragma unroll
      for (int x = 0; x < 2; ++x) { const int ot = 2 * (w >> 2) + x;
          const bf16x8 a0 = *(const bf16x8*)(wpt + (16 * ot + fr) * 64 + fg * 8), a1 = *(const bf16x8*)(wpt + (16 * ot + fr) * 64 + 32 + fg * 8);
          f32x4 c = (f32x4){0.f, 0.f, 0.f, 0.f}; c = MFMA16(a0, b0, c); c = MFMA16(a1, b1, c);
          const f32x4 ps = *(const f32x4*)(p.in[I_PSCALE] + l * 256 + gi * 64 + 16 * ot + 4 * fg);
          c *= ps;
          u32x2 o; o.x = cvt2(c[0], c[1]); o.y = cvt2(c[2], c[3]);
          *(u32x2*)((bf16*)(p.ws + WS_MIXED) + (size_t)(tok0 + 16 * tt + fr) * DM + 768 + gi * 64 + 16 * ot + 4 * fg) = o; } }
    __syncthreads();
}

__device__ __forceinline__ float xsum_fg(float s, int fr, int fg) {
    s += __builtin_bit_cast(float, __builtin_amdgcn_ds_bpermute((((fg ^ 1) << 4) | fr) << 2, __builtin_bit_cast(int, s)));
    s += __builtin_bit_cast(float, __builtin_amdgcn_ds_bpermute((((fg ^ 2) << 4) | fr) << 2, __builtin_bit_cast(int, s)));
    return s;
}
__device__ __forceinline__ void stage_post(CKP& p, int l, LAS unsigned char* lds, int bid, int nb) {
    const int tid = opaque_tid(), lane = tid & 63, head = __builtin_amdgcn_readfirstlane(tid >> 6), fr = lane & 15, fg = lane >> 4;
    const bf16* Ub = (const bf16*)(p.ws + WS_U);
    const bf16* gupt = (const bf16*)(p.ws + WS_GUPT) + ((size_t)l * 512 + head * 64) * 128;
    const bf16* YF = (const bf16*)(p.ws + WS_YF); const bf16* YB = (const bf16*)(p.ws + WS_YB);
    const float* BC0 = (const float*)(p.ws + WS_BC); const float* BC1 = BC0 + (size_t)MTOK * 8;
    bf16* MIX = (bf16*)(p.ws + WS_MIXED);
    bf16x8 ag[4][4];
    f32x4 lnw[4], lnb[4];
#pragma unroll
    for (int t = 0; t < 4; ++t) {
#pragma unroll
        for (int ks = 0; ks < 4; ++ks) ag[t][ks] = *(const bf16x8*)(gupt + (16 * t + fr) * 128 + ks * 32 + fg * 8);
        lnw[t] = *(const f32x4*)(p.in[I_LNW] + l * 512 + head * 64 + 16 * t + 4 * fg); lnb[t] = *(const f32x4*)(p.in[I_LNB] + l * 512 + head * 64 + 16 * t + 4 * fg); }
    LAS bf16* GS = (LAS bf16*)(lds + 65536);
    { const int tid0 = opaque_tid();
#pragma unroll
      for (int z = 0; z < 2; ++z) { const int i = tid0 + 512 * z, k = i >> 8, r = (i >> 4) & 15, c = i & 15, item = bid + k * nb;
          if (item < 768) *(LAS u32x4*)(GS + (k * 16 + r) * 136 + c * 8) = *(const u32x4*)(Ub + ((size_t)item * 16 + r) * 1920 + GD_OFF + c * 8); } }
    __syncthreads();
#pragma unroll 1
    for (int item = bid, kq = 0; item < 768; item += nb, ++kq) {
        const size_t tok = (size_t)item * 16 + fr;
        bf16x8 bs[4];
        if (kq < 4) {
#pragma unroll
            for (int ks = 0; ks < 4; ++ks) bs[ks] = *(const LAS bf16x8*)(GS + (kq * 16 + fr) * 136 + ks * 32 + fg * 8); }
        else {
#pragma unroll
            for (int ks = 0; ks < 4; ++ks) bs[ks] = *(const bf16x8*)(Ub + tok * 1920 + GD_OFF + ks * 32 + fg * 8); }
        f32x4 y[4]; u32x2 vw[4];
        { LAS bf16* T = (LAS bf16*)(lds + head * 8192);
          u32x4 ld[3][2];
#pragma unroll
          for (int z = 0; z < 2; ++z) { const size_t tk = (size_t)item * 16 + (lane >> 3) + 8 * z; const int ch = head * 64 + (lane & 7) * 8;
              ld[0][z] = *(const u32x4*)(YF + tk * 512 + ch); ld[1][z] = *(const u32x4*)(YB + tk * 512 + ch); ld[2][z] = *(const u32x4*)(Ub + tk * 1920 + V_OFF + ch); }
#pragma unroll
          for (int a = 0; a < 3; ++a)
#pragma unroll
              for (int z = 0; z < 2; ++z) *(LAS u32x4*)(T + a * 16 * 72 + ((lane >> 3) + 8 * z) * 72 + (lane & 7) * 8) = ld[a][z];
          asm volatile("s_waitcnt lgkmcnt(0)" ::: "memory");
#pragma unroll
          for (int t = 0; t < 4; ++t) { const int o = fr * 72 + 16 * t + 4 * fg;
              const u32x2 yf = *(const LAS u32x2*)(T + o), yb = *(const LAS u32x2*)(T + 16 * 72 + o);
              y[t] = (f32x4){bflo(yf.x) + bflo(yb.x), bfhi(yf.x) + bfhi(yb.x), bflo(yf.y) + bflo(yb.y), bfhi(yf.y) + bfhi(yb.y)}; vw[t] = *(const LAS u32x2*)(T + 2 * 16 * 72 + o); }
          asm volatile("s_waitcnt lgkmcnt(0)" ::: "memory"); }
        const float bc = BC0[tok * 8 + head] + BC1[tok * 8 + head];
        f32x4 g[4];
#pragma unroll
        for (int t = 0; t < 4; ++t) { g[t] = (f32x4){0.f, 0.f, 0.f, 0.f};
#pragma unroll
            for (int ks = 0; ks < 4; ++ks) g[t] = MFMA16(ag[t][ks], bs[ks], g[t]); }
        float s = 0.f;
#pragma unroll
        for (int t = 0; t < 4; ++t) s += (y[t][0] + y[t][1]) + (y[t][2] + y[t][3]);
        const float mean = xsum_fg(s, fr, fg) * (1.0f / 64.0f);
        float q = 0.f;
#pragma unroll
        for (int t = 0; t < 4; ++t) { y[t] = y[t] - mean; q += (y[t][0] * y[t][0] + y[t][1] * y[t][1]) + (y[t][2] * y[t][2] + y[t][3] * y[t][3]); }
        const float rstd = frsq(xsum_fg(q, fr, fg) * (1.0f / 64.0f) + 64e-5f);
        { LAS bf16* T = (LAS bf16*)(lds + head * 8192);
#pragma unroll
          for (int t = 0; t < 4; ++t) { const f32x4 vv = (f32x4){bflo(vw[t].x), bfhi(vw[t].x), bflo(vw[t].y), bfhi(vw[t].y)};
              const f32x4 o = (y[t] * rstd * lnw[t] + lnb[t] + vv * bc) * g[t];
              u32x2 w; w.x = cvt2(o[0], o[1]); w.y = cvt2(o[2], o[3]);
              *(LAS u32x2*)(T + fr * 72 + 16 * t + 4 * fg) = w; }
          asm volatile("s_waitcnt lgkmcnt(0)" ::: "memory");
#pragma unroll
          for (int z = 0; z < 2; ++z) { const int r = (lane >> 3) + 8 * z;
              *(u32x4*)(MIX + ((size_t)item * 16 + r) * DM + head * 64 + (lane & 7) * 8) = *(const LAS u32x4*)(T + r * 72 + (lane & 7) * 8); }
          asm volatile("s_waitcnt lgkmcnt(0)" ::: "memory"); }
    }
}

#define XB_TMO      128
#define XB_XCNT(j)  (256  + 64 * (j))
#define XB_XSUB(j)  (1280 + 64 * (j))
#define XB_XGEN(j)  (2304 + 64 * (j))
#define XB_TOP      3328
#define XB_TOPGEN   3392
#define XCD_BAR_WORDS 3456
#define XB_SPIN_CAP (1u << 18)

__device__ __forceinline__ unsigned xb_ld(unsigned* p)              { return __hip_atomic_load(p, __ATOMIC_RELAXED, __HIP_MEMORY_SCOPE_AGENT); }
__device__ __forceinline__ unsigned xb_add(unsigned* p, unsigned v) { return __hip_atomic_fetch_add(p, v, __ATOMIC_RELAXED, __HIP_MEMORY_SCOPE_AGENT); }
__device__ __forceinline__ unsigned xb_xcc_id() { return (unsigned)__builtin_amdgcn_s_getreg((3 << 11) | 20) & 0xFu; }
#define XB_SPIN(cond, bar) do { unsigned _sp = 0; while (cond) { __builtin_amdgcn_s_sleep(1); \
    if ((++_sp & 255u) == 0u) { if (xb_ld(&(bar)[XB_TMO])) break; if (_sp > XB_SPIN_CAP) { atomicAdd(&(bar)[XB_TMO], 1u); break; } } } } while (0)

struct XcdBarrier {
    unsigned* bar; unsigned x;
    volatile LAS unsigned* st;
};

__device__ __forceinline__ XcdBarrier xcd_barrier_post(unsigned* bar, volatile LAS unsigned* st) {
    XcdBarrier b; b.bar = bar; b.x = xb_xcc_id(); b.st = st;
    if (threadIdx.x == 0) (void)xb_add(&bar[XB_XCNT(b.x)], 1u);
    return b;
}
__device__ __forceinline__ void xcd_barrier_complete(unsigned* bar, unsigned x, unsigned& nloc, unsigned& nx) {
    const unsigned G = gridDim.x * gridDim.y * gridDim.z;
    unsigned sum, cnt, mine, sp = 0u;
    for (;;) {
        sum = 0u; cnt = 0u; mine = 0u;
#pragma unroll
        for (unsigned j = 0; j < 16; ++j) { const unsigned c = xb_ld(&bar[XB_XCNT(j)]); sum += c; cnt += (c > 0u) ? 1u : 0u; mine = (j == x) ? c : mine; }
        if (sum == G) break;
        __builtin_amdgcn_s_sleep(1);
        if ((++sp & 255u) == 0u) { if (xb_ld(&bar[XB_TMO])) break; if (sp > XB_SPIN_CAP) { atomicAdd(&bar[XB_TMO], 1u); break; } }
    }
    nloc = mine > 0u ? mine : 1u; nx = cnt > 0u ? cnt : 1u;
}

__device__ __forceinline__ void xcd_barrier(const XcdBarrier& b) {
    asm volatile("s_waitcnt vmcnt(0)" ::: "memory");
    __syncthreads();
    if (threadIdx.x == 0) {
        unsigned* bar = b.bar;
        __builtin_amdgcn_s_waitcnt(0);
        unsigned nloc = b.st[0], nx = b.st[1];
        if (nloc == 0u) { xcd_barrier_complete(bar, b.x, nloc, nx); b.st[0] = nloc; b.st[1] = nx; }
        const unsigned old = xb_add(&bar[XB_XSUB(b.x)], 1u);
        const unsigned gen = old / nloc;
        if (old + 1u == (gen + 1u) * nloc) {
            __builtin_amdgcn_fence(__ATOMIC_RELEASE, "agent");
            asm volatile("s_waitcnt vmcnt(0)" ::: "memory");
            const unsigned og = xb_add(&bar[XB_TOP], 1u);
            const unsigned tg = og / nx;
            __builtin_amdgcn_fence(__ATOMIC_ACQUIRE, "agent");
            if (og + 1u == (tg + 1u) * nx) xb_add(&bar[XB_TOPGEN], 1u);
            else XB_SPIN(xb_ld(&bar[XB_TOPGEN]) == tg, bar);
            xb_add(&bar[XB_XGEN(b.x)], 1u);
            asm volatile("s_waitcnt vmcnt(0)" ::: "memory");
        } else {
            __builtin_amdgcn_fence(__ATOMIC_ACQUIRE, "agent");
            XB_SPIN(xb_ld(&bar[XB_XGEN(b.x)]) == gen, bar);
            asm volatile("s_waitcnt vmcnt(0)" ::: "memory");
        }
    }
    __syncthreads();
}

struct EpiAny {
    static constexpr bool AFTER_DRAIN = false;
    int mode; bool PERM; int l;
    __device__ __forceinline__ void operator()(const f32x4 (&acc)[2][2][4][2], const pg8::Unit& u, int wr, int wc, int fr, int fq) const {
        CKP* kp = (CKP*)__builtin_amdgcn_kernarg_segment_ptr(); asm volatile("" : "+s"(kp)); CKP& p = *kp;
        unsigned char* ws = p.ws;
        const float* mod = (const float*)(ws + WS_MOD) + (size_t)l * 5 * 6144;
        float* SSQ = (float*)(ws + WS_CTL + 262144);
        bf16* Hb = (bf16*)(ws + WS_H); bf16* XB = (bf16*)(ws + WS_XB);
        if (mode == 7) {
#pragma unroll
            for (int a = 0; a < 2; ++a)
#pragma unroll
                for (int b = 0; b < 2; ++b)
#pragma unroll
                    for (int m = 0; m < 4; ++m)
#pragma unroll
                        for (int n = 0; n < 2; ++n) asm volatile("" :: "v"(acc[a][b][m][n]));
            return; }
        if (mode == 0) { const pg8::EpiBf<0> e{(bf16*)(ws + WS_PROJ), DINP}; e(acc, u, wr, wc, fr, fq); }
        else if (mode == 2) { const pg8::EpiResFinal e{XB, mod + 5 * 1024, p.in[I_FNG], p.out, SSQ + 49152, (unsigned*)(ws + WS_CTL + 524288) + 64 * 16}; e(acc, u, wr, wc, fr, fq); }
        else if (mode == 3) { const pg8::EpiFnet e{(bf16*)(ws + WS_MIXED), 0, 256}; e(acc, u, wr, wc, fr, fq); }
        else if (mode == 8) { const pg8::EpiFnet e{(bf16*)(ws + WS_MIXED), NCTX, 1024}; e(acc, u, wr, wc, fr, fq); }
        else if (mode == 4) { const pg8::EpiNormBf<0> e{(bf16*)(ws + WS_PROJ), DINP, SSQ + 16384, (const float*)(ws + WS_SWIN), DINP}; e(acc, u, wr, wc, fr, fq); }
        else if (mode == 5) { const pg8::EpiNormBf<1> e{(bf16*)(ws + WS_FF), DFF, SSQ + l * 32768, (const float*)(ws + WS_SW1) + (size_t)l * 5 * DFF, DFF}; e(acc, u, wr, wc, fr, fq); }
        else if (mode == 6) {
            if (l == 0) { const pg8::EpiResNorm<true, true> e{XB, mod + 2 * 1024, p.in[I_XP], p.in[I_XS], Hb, p.in[I_N2G], mod + 4 * 1024, SSQ}; e(acc, u, wr, wc, fr, fq); }
            else { const pg8::EpiResNorm<false, true> e{XB, mod + 2 * 1024, nullptr, nullptr, Hb, p.in[I_N2G] + DM, mod + 4 * 1024, SSQ + 32768}; e(acc, u, wr, wc, fr, fq); } }
        else { const pg8::EpiResNorm<false, true> e{XB, mod + 5 * 1024, nullptr, nullptr, Hb, p.in[I_N1G] + DM, mod + 5 * 6144 + 1 * 1024, SSQ + 16384}; e(acc, u, wr, wc, fr, fq); }
    }
};

constexpr int N_STEPS = 16;
__device__ __forceinline__ bool step_seam(int st) { return st < 15; }
__global__ void __launch_bounds__(NTHR, 2) mega_fwd(KP p_unused) {
    extern __shared__ __attribute__((aligned(16))) unsigned char lds_raw[];
    CKP* kp0 = (CKP*)__builtin_amdgcn_kernarg_segment_ptr();
    { LAS unsigned* ctlw = (LAS unsigned*)((LAS unsigned char*)lds_raw + RING_BYTES);
      for (int u = threadIdx.x; u < (LDS_BYTES - RING_BYTES) / 4; u += NTHR) ctlw[u] = 0u; }
    __syncthreads();
    const XcdBarrier bar = xcd_barrier_post((unsigned*)(kp0->ws + WS_CTL) + 4096, (volatile LAS unsigned*)((LAS unsigned char*)lds_raw + MISC_OFF + 32));
    const int ph_lo = kp0->ph_lo, ph_hi = kp0->ph_hi;
#pragma unroll 1
#ifdef REP_A
    for (int sti = ph_lo; sti < ph_hi + ((REP_B) >= 0 ? 2 : 1); ++sti) {
        const int st = sti <= (REP_A) ? sti : (((REP_B) < 0 || sti <= (REP_B) + 1) ? sti - 1 : sti - 2);
        const bool isdup = sti == (REP_A) || ((REP_B) >= 0 && sti == (REP_B) + 1); (void)isdup;
#else
    for (int st = ph_lo; st < ph_hi; ++st) {
#endif
        CKP* kp = kp0; asm volatile("" : "+s"(kp));
        CKP& p = *kp; unsigned char* ws = p.ws;
        int bid = blockIdx.x, nb = gridDim.x; unsigned ldsb = (unsigned)(size_t)(LAS unsigned char*)lds_raw;
        asm volatile("" : "+s"(bid), "+s"(nb), "+s"(ldsb));
        LAS unsigned char* lds = (LAS unsigned char*)(size_t)ldsb;
        const int l = st < 9 ? 0 : 1, s = st == 0 ? -1 : (st == 1 ? 0 : ((st - 2) % 7 + 1));
        const float* mod = (const float*)(ws + WS_MOD) + (size_t)l * 5 * 6144;
#pragma unroll 1
        for (int job = 0; job < 2; ++job) {
            pg8::Gemm g{nullptr, nullptr, 0, 0, 0, 0, 0}; EpiAny E{-1, true, 0}; int corder = bid;
            if (job == 0) {
                if (s == 1) { g = pg8::Gemm{(const bf16*)(ws + WS_H), (const bf16*)(ws + WS_WIN) + (size_t)l * DINP * DM, MTOK, DINP, DM, DM, DM}; E = EpiAny{l == 0 ? 0 : 4, true, l}; }
                else if (s == 3) { g = pg8::Gemm{(const bf16*)(ws + WS_CS256), (const bf16*)(ws + WS_YCS), 256, 8192, 512, 512, 512}; E = EpiAny{3, true, l}; corder = (bid + nb - (nb >= 256 ? 192 : 0)) % nb; }
                else if (s == 5) { g = pg8::Gemm{(const bf16*)(ws + WS_MIXED), (const bf16*)(ws + WS_WOUT) + (size_t)l * DM * DM, MTOK, DM, DM, DM, DM}; E = EpiAny{6, true, l}; }
                else if (s == 6) { g = pg8::Gemm{(const bf16*)(ws + WS_H), (const bf16*)(ws + WS_W1) + (size_t)l * DFF * DM, MTOK, DFF, DM, DM, DM}; E = EpiAny{5, true, l}; }
                else if (s == 7) { g = pg8::Gemm{(const bf16*)(ws + WS_FF), (const bf16*)(ws + WS_W2) + (size_t)l * DM * DFF, MTOK, DM, DFF, DFF, DFF}; E = l == 0 ? EpiAny{9, true, l} : EpiAny{2, true, l}; }
            } else if (s == 3) { g = pg8::Gemm{(const bf16*)(ws + WS_CS1024), (const bf16*)(ws + WS_YCS) + (size_t)8192 * 512, 1024, 1024, 2048, 2048, 2048}; E = EpiAny{8, true, l}; corder = (bid + nb - (nb >= 256 ? 224 : 32)) % nb; }
#ifdef NOEPI_FIRST
            if (isdup && E.mode >= 0) E.mode = 7;
#endif
            if (E.mode >= 0) {
                pg8::StaticOrder S; S.init(g.M, g.N, nb, corder);
                pg8::gemm_phase<EpiAny, pg8::StaticOrder, true, true>(lds, g, S, E);
                __syncthreads();
            }
        }
        if (s == 3) {
            if (nb >= 256) {
                if (bid < 64) rwkv_item3(p, l, lds, bid);
                else { unsigned* ctr = (unsigned*)(ws + WS_CTL + 524288) + 64 * (2 + l); volatile LAS unsigned* slot = (volatile LAS unsigned*)(lds + RING_BYTES + 64);
#pragma unroll 1
                    for (;;) { __syncthreads(); if (threadIdx.x == 0) *slot = atomicAdd(ctr, 1u); __syncthreads(); const int it = (int)*slot; if (it >= 512) break; rwkv_item3(p, l, lds, 64 + it); } }
            } else for (int it = bid; it < 576; it += nb) rwkv_item3(p, l, lds, it);
        }
        if (s == 3 || s == 5) {
            int qi, first, csz, nch;
            if (s == 3) { qi = l; first = l == 0 ? TI_IN : TI_L + TI_IN; csz = 8; nch = (TI_OUT + TI_1) / 8; }
            else { qi = 4 + l; first = l * TI_L + TI_IN + TI_OUT + TI_1; csz = 32; nch = TI_2 / 32; }
            side_queue(p, lds, qi, 0, first, csz, nch);
            if (s == 3 && l == 0) side_queue(p, lds, 6, 0, TI_L, 8, TI_IN / 8);
        }
        if (s == -1) stage_prologue(p, lds, bid, nb);
        else if (s == 0) stage_norm(p, 0, 0, bid, nb);
        if ((s == -1 && nb >= 256 && bid >= 192) || (s == 0 && nb < 256)) stage_tables(p, nb >= 256 ? bid - 192 : bid, nb >= 256 ? nb - 192 : nb);
        else if (s == 2) {
            stage_upass(p, l, bid, nb);
#ifdef DUP_U
            stage_upass(p, l, bid, nb);
#endif
            stage_fnet1(p, l, bid, nb);
            if (nb == 256) stage_pool3(p, l, lds, bid);
            else {
#pragma unroll 1
                for (int it = bid; it < 768; it += nb) pool_item(p, l, lds, it); }
        }
        else if (s == 4) stage_post(p, l, lds, bid, nb);
        #ifdef REP_A
        if (sti + 1 < ph_hi + ((REP_B) >= 0 ? 2 : 1)) xcd_barrier(bar);
#else
        if (st + 1 < ph_hi && step_seam(st)) xcd_barrier(bar);
#endif
    }
}

extern "C" void kernel_launch(void* const* d_in, const int* in_sizes, int n_in, void* d_out, int out_size, void* d_ws, size_t ws_size, hipStream_t stream) {
    static int grid = 0;
    if (grid == 0) {
        if (n_in != N_IN || ws_size < WS_END) { fprintf(stderr, "kernel_launch: unexpected inputs (n_in %d, ws %zu)\n", n_in, ws_size); grid = -1; return; }
        int dev = 0, cus = 0, per_cu = 0;
        (void)hipGetDevice(&dev); (void)hipDeviceGetAttribute(&cus, hipDeviceAttributeMultiprocessorCount, dev);
        (void)hipFuncSetAttribute((const void*)mega_fwd, hipFuncAttributeMaxDynamicSharedMemorySize, LDS_BYTES);
        if (hipOccupancyMaxActiveBlocksPerMultiprocessor(&per_cu, (const void*)mega_fwd, NTHR, LDS_BYTES) != hipSuccess || per_cu < 1) {
            fprintf(stderr, "kernel_launch: occupancy query reports %d blocks/CU\n", per_cu); (void)hipGetLastError(); grid = -1; return; }
        grid = cus * 1;
    }
    if (grid < 0) return;
    KP a{};
    for (int i = 0; i < N_IN; ++i) a.in[i] = (const float*)d_in[i];
    a.out = (float*)d_out; a.ws = (unsigned char*)d_ws; a.ph_lo = 0; a.ph_hi = N_STEPS;
    if (hipMemsetAsync((char*)d_ws + WS_CTL, 0, 1 * MiB, stream) != hipSuccess) { fprintf(stderr, "kernel_launch: memset failed\n"); return; }
    void* args[] = {&a};
    hipError_t e = hipLaunchCooperativeKernel((const void*)mega_fwd, dim3(grid), dim3(NTHR), args, LDS_BYTES, stream);
    if (e != hipSuccess) fprintf(stderr, "cooperative launch failed: %s (grid %d)\n", hipGetErrorString(e), grid);
}
```
